# Optimizing an MI355X kernel written in HIP

```python
import math
import jax, jax.numpy as jnp
from jax import lax
import numpy as np

D_MODEL = 2048
BATCH = 4
SEQ = 2048
DEPTH = 1

D_HEAD = 128
NSA_HEADS = 8
NSA_KV_GROUPS = 2
NSA_Q_PER_KV = NSA_HEADS // NSA_KV_GROUPS
SB_HEADS = 8
MIX_WIDTH = (NSA_HEADS + SB_HEADS) * D_HEAD
NSA_KV_WIDTH = NSA_KV_GROUPS * D_HEAD
IN_WIDTHS = (NSA_HEADS * D_HEAD,) + (NSA_KV_WIDTH,) * 6 + (NSA_HEADS * 3,) + (SB_HEADS * D_HEAD,) * 3
IN_COLS = sum(IN_WIDTHS)
CMP_LEN = 32
CMP_STRIDE = 16
SEL_LEN = 64
SEL_TOPK = 16
WINDOW = 512
Q_BLOCK = 128
T5_BUCKETS = 32
T5_MAX_DIST = 128
N_MEM = 256
MEM_HEADS = 4
MEM_HEAD_DIM = 128
PEER_N_KEYS = 128
PEER_N_EXPERTS = PEER_N_KEYS * PEER_N_KEYS
PEER_HEADS = 8
PEER_TOPK = 16
PEER_D_KEY = 256
PEER_TOK_BLOCK = 128

RMS_EPS = 1e-6
NEG_INF = -1e30
BIG = 1e9

kernel_name = 'hybrid_nsa_stickbreak_peer'


def rmsnorm(x, g):
    xf = x.astype(jnp.float32)
    y = xf * lax.rsqrt(jnp.mean(xf * xf, axis=-1, keepdims=True) + RMS_EPS)
    return (y * g.astype(jnp.float32)).astype(x.dtype)


def t5_bucket(dist):
    n = jnp.maximum(dist, 0)
    max_exact = T5_BUCKETS // 2
    nf = jnp.maximum(n, 1).astype(jnp.float32)
    large = max_exact + (jnp.log(nf / max_exact) / math.log(T5_MAX_DIST / max_exact)
                         * (T5_BUCKETS - max_exact)).astype(jnp.int32)
    large = jnp.minimum(large, T5_BUCKETS - 1)
    return jnp.where(n < max_exact, n, large)


def masked_softmax(logits, mask):
    logits = jnp.where(mask, logits.astype(jnp.float32), NEG_INF)
    m = jnp.max(logits, axis=-1, keepdims=True)
    e = jnp.where(mask, jnp.exp(logits - m), 0.0)
    return e / jnp.maximum(jnp.sum(e, axis=-1, keepdims=True), 1e-20)


def split_points():
    return [int(v) for v in np.cumsum(np.array(IN_WIDTHS))[:-1]]


def compress_blocks(kv, pos_emb, w1, w2):
    B, G, S, Dh = kv.shape
    n_cmp = (S - CMP_LEN) // CMP_STRIDE + 1
    idx = jnp.arange(n_cmp)[:, None] * CMP_STRIDE + jnp.arange(CMP_LEN)[None, :]
    blocks = kv[:, :, idx] + pos_emb
    flat = blocks.reshape(B, G, n_cmp, CMP_LEN * Dh)
    return jax.nn.gelu(flat @ w1) @ w2


def nsa_attention(q, k_cmp, v_cmp, k_slc, v_slc, k_win, v_win, gate_logits,
                  cmp_pos_k, cmp_w1_k, cmp_w2_k, cmp_pos_v, cmp_w1_v, cmp_w2_v, t5_table):
    B, S = q.shape[0], q.shape[1]
    G, R, Dh = NSA_KV_GROUPS, NSA_Q_PER_KV, D_HEAD
    scale = Dh ** -0.5
    q = q.reshape(B, S, G, R, Dh).transpose(0, 2, 3, 1, 4)

    def to_kv(a):
        return a.reshape(B, S, G, Dh).transpose(0, 2, 1, 3)

    k_cmp, v_cmp, k_slc, v_slc, k_win, v_win = (to_kv(a) for a in (k_cmp, v_cmp, k_slc, v_slc, k_win, v_win))
    t = jnp.arange(S)

    kc = compress_blocks(k_cmp, cmp_pos_k, cmp_w1_k, cmp_w2_k)
    vc = compress_blocks(v_cmp, cmp_pos_v, cmp_w1_v, cmp_w2_v)
    n_cmp = kc.shape[2]
    c_start = jnp.arange(n_cmp) * CMP_STRIDE
    dist_c = t[:, None] - (c_start + CMP_LEN - 1)[None, :]
    bias_c = t5_table[t5_bucket(dist_c)].transpose(2, 0, 1).reshape(G, R, S, n_cmp)
    logits_c = jnp.einsum('bgrsd,bgcd->bgrsc', q, kc).astype(jnp.float32) * scale + bias_c
    p_cmp = masked_softmax(logits_c, dist_c >= 0)
    o_cmp = jnp.einsum('bgrsc,bgcd->bgrsd', p_cmp.astype(vc.dtype), vc)

    n_sel = S // SEL_LEN
    j = jnp.arange(n_sel)
    sel_start = j * SEL_LEN
    overlap = jnp.clip(jnp.minimum(c_start[:, None] + CMP_LEN, sel_start[None, :] + SEL_LEN)
                       - jnp.maximum(c_start[:, None], sel_start[None, :]), 0, None).astype(jnp.float32) / CMP_LEN
    importance = jnp.einsum('bgrsc,cj->bgsj', p_cmp, overlap)
    cur = t // SEL_LEN
    forced = (j[None, :] == 0) | (j[None, :] == cur[:, None]) | (j[None, :] == cur[:, None] - 1)
    allowed = sel_start[None, :] <= t[:, None]
    score = jnp.where(forced, BIG, jnp.where(allowed, importance, -BIG))
    k_sel = min(SEL_TOPK, n_sel)
    _, sel_idx = lax.top_k(score, k_sel)

    ks_blocks = k_slc.reshape(B, G, n_sel, SEL_LEN, Dh)
    vs_blocks = v_slc.reshape(B, G, n_sel, SEL_LEN, Dh)
    k_win_pad = jnp.pad(k_win, ((0, 0), (0, 0), (WINDOW, 0), (0, 0)))
    v_win_pad = jnp.pad(v_win, ((0, 0), (0, 0), (WINDOW, 0), (0, 0)))
    table_gr = t5_table.T.reshape(G, R, T5_BUCKETS)
    b_ix = jnp.arange(B)[:, None, None, None]
    g_ix = jnp.arange(G)[None, :, None, None]
    n_kw = WINDOW + Q_BLOCK
    n_tok_sel = k_sel * SEL_LEN

    def query_block(i):
        qs = i * Q_BLOCK
        qb = lax.dynamic_slice_in_dim(q, qs, Q_BLOCK, axis=3)
        tq = qs + jnp.arange(Q_BLOCK)
        idx = lax.dynamic_slice_in_dim(sel_idx, qs, Q_BLOCK, axis=2)
        ksel = ks_blocks[b_ix, g_ix, idx].reshape(B, G, Q_BLOCK, n_tok_sel, Dh)
        vsel = vs_blocks[b_ix, g_ix, idx].reshape(B, G, Q_BLOCK, n_tok_sel, Dh)
        pos = (idx[..., None] * SEL_LEN + jnp.arange(SEL_LEN)).reshape(B, G, Q_BLOCK, n_tok_sel)
        dist = tq[:, None] - pos
        bias = table_gr[g_ix, :, t5_bucket(dist)].transpose(0, 1, 4, 2, 3)
        logits = jnp.einsum('bgrqd,bgqnd->bgrqn', qb, ksel).astype(jnp.float32) * scale + bias
        p = masked_softmax(logits, (dist >= 0)[:, :, None])
        o_slc = jnp.einsum('bgrqn,bgqnd->bgrqd', p.astype(vsel.dtype), vsel)
        kw = lax.dynamic_slice_in_dim(k_win_pad, qs, n_kw, axis=2)
        vw = lax.dynamic_slice_in_dim(v_win_pad, qs, n_kw, axis=2)
        posw = qs - WINDOW + jnp.arange(n_kw)
        distw = tq[:, None] - posw[None, :]
        maskw = (posw[None, :] >= 0) & (distw >= 0) & (distw < WINDOW)
        biasw = t5_table[t5_bucket(distw)].transpose(2, 0, 1).reshape(G, R, Q_BLOCK, n_kw)
        logits_w = jnp.einsum('bgrqd,bgnd->bgrqn', qb, kw).astype(jnp.float32) * scale + biasw
        pw = masked_softmax(logits_w, maskw)
        o_win = jnp.einsum('bgrqn,bgnd->bgrqd', pw.astype(vw.dtype), vw)
        return o_slc, o_win

    o_slc, o_win = lax.map(query_block, jnp.arange(S // Q_BLOCK))

    def unblock(o):
        return o.transpose(1, 2, 3, 0, 4, 5).reshape(B, G, R, S, Dh)

    gates = jax.nn.sigmoid(gate_logits.astype(jnp.float32)).reshape(B, S, G, R, 3)
    gates = gates.transpose(0, 2, 3, 1, 4).astype(q.dtype)
    o = gates[..., 0:1] * o_cmp + gates[..., 1:2] * unblock(o_slc) + gates[..., 2:3] * unblock(o_win)
    return o.transpose(0, 3, 1, 2, 4).reshape(B, S, NSA_HEADS * Dh)


def stick_breaking_attention(q, k, v):
    B, S = q.shape[0], q.shape[1]
    scale = D_HEAD ** -0.5
    q, k, v = (a.reshape(B, S, SB_HEADS, D_HEAD).transpose(0, 2, 1, 3) for a in (q, k, v))
    s_pos = jnp.arange(S)

    def query_block(i):
        qs = i * Q_BLOCK
        qb = lax.dynamic_slice_in_dim(q, qs, Q_BLOCK, axis=2)
        tq = qs + jnp.arange(Q_BLOCK)
        z = jnp.einsum('bhqd,bhsd->bhqs', qb, k).astype(jnp.float32) * scale
        mask = s_pos[None, :] < tq[:, None]
        log_fail = jnp.where(mask, jax.nn.log_sigmoid(-z), 0.0)
        after = lax.cumsum(log_fail, axis=3, reverse=True) - log_fail
        w = jnp.where(mask, jnp.exp(jax.nn.log_sigmoid(z) + after), 0.0)
        return jnp.einsum('bhqs,bhsd->bhqd', w.astype(v.dtype), v)

    o = lax.map(query_block, jnp.arange(S // Q_BLOCK))
    return o.transpose(1, 0, 3, 2, 4).reshape(B, S, SB_HEADS * D_HEAD)


def memory_attention(hn, mem_n, w_q, w_k, w_v, w_o):
    B, S = hn.shape[0], hn.shape[1]
    M = mem_n.shape[1]
    q = (hn @ w_q).reshape(B, S, MEM_HEADS, MEM_HEAD_DIM)
    k = (mem_n @ w_k).reshape(B, M, MEM_HEADS, MEM_HEAD_DIM)
    v = (mem_n @ w_v).reshape(B, M, MEM_HEADS, MEM_HEAD_DIM)
    logits = jnp.einsum('bshd,bmhd->bhsm', q, k).astype(jnp.float32) * (MEM_HEAD_DIM ** -0.5)
    p = jax.nn.softmax(logits, axis=-1)
    o = jnp.einsum('bhsm,bmhd->bshd', p.astype(v.dtype), v).reshape(B, S, MEM_HEADS * MEM_HEAD_DIM)
    return o @ w_o


def peer_ffn(hn, w_pq, sub_keys, u_tab, v_tab):
    B, S, D = hn.shape
    T = B * S
    K = PEER_TOPK
    xt = hn.reshape(T, D)
    q = (xt @ w_pq).reshape(T, PEER_HEADS, 2, PEER_D_KEY // 2)
    s = jnp.einsum('thpd,hpkd->thpk', q, sub_keys).astype(jnp.float32)
    top_s, top_i = lax.top_k(s, K)
    cand = top_s[:, :, 0, :, None] + top_s[:, :, 1, None, :]
    best_s, best_c = lax.top_k(cand.reshape(T, PEER_HEADS, K * K), K)
    ia = jnp.take_along_axis(top_i[:, :, 0], best_c // K, axis=-1)
    ib = jnp.take_along_axis(top_i[:, :, 1], best_c % K, axis=-1)
    expert = ia * PEER_N_KEYS + ib
    gate = jax.nn.softmax(best_s, axis=-1)
    nb = T // PEER_TOK_BLOCK
    E = PEER_HEADS * K
    xs = (xt.reshape(nb, PEER_TOK_BLOCK, D), expert.reshape(nb, PEER_TOK_BLOCK, E),
          gate.reshape(nb, PEER_TOK_BLOCK, E))

    def token_block(args):
        xb, eb, gb = args
        a = jnp.einsum('td,ted->te', xb, u_tab[eb])
        hidden = gb.astype(xb.dtype) * jax.nn.gelu(a)
        return jnp.einsum('te,ted->td', hidden, v_tab[eb])

    out = lax.map(token_block, xs)
    return out.reshape(B, S, D)


def hybrid_layer(h, mem, t5_table, norm_mix, w_in, cmp_pos_k, cmp_w1_k, cmp_w2_k,
                 cmp_pos_v, cmp_w1_v, cmp_w2_v, w_out, norm_mem_q, norm_mem_kv,
                 w_mem_q, w_mem_k, w_mem_v, w_mem_o, norm_ffn, peer_w_q, peer_sub_keys,
                 peer_u, peer_v):
    hn = rmsnorm(h, norm_mix)
    proj = hn @ w_in
    (q_nsa, k_cmp, v_cmp, k_slc, v_slc, k_win, v_win, gate_logits,
     q_sb, k_sb, v_sb) = jnp.split(proj, split_points(), axis=-1)
    o_nsa = nsa_attention(q_nsa, k_cmp, v_cmp, k_slc, v_slc, k_win, v_win, gate_logits,
                          cmp_pos_k, cmp_w1_k, cmp_w2_k, cmp_pos_v, cmp_w1_v, cmp_w2_v, t5_table)
    o_sb = stick_breaking_attention(q_sb, k_sb, v_sb)
    h = h + jnp.concatenate([o_nsa, o_sb], axis=-1) @ w_out
    h = h + memory_attention(rmsnorm(h, norm_mem_q), rmsnorm(mem, norm_mem_kv),
                             w_mem_q, w_mem_k, w_mem_v, w_mem_o)
    h = h + peer_ffn(rmsnorm(h, norm_ffn), peer_w_q, peer_sub_keys, peer_u, peer_v)
    return h


def setup_inputs(seed: int = 0) -> dict:
    key = jax.random.key(seed)
    ks = jax.random.split(key, 24)

    def nrm(k, shape, scale):
        return jax.random.normal(k, shape, jnp.float32) * scale

    def gain(k, shape):
        return 1.0 + 0.02 * jax.random.normal(k, shape, jnp.float32)

    L = DEPTH
    return {
        'x': nrm(ks[0], (BATCH, SEQ, D_MODEL), 1.0),
        'mem': nrm(ks[1], (BATCH, N_MEM, D_MODEL), 1.0),
        't5_table': nrm(ks[2], (T5_BUCKETS, NSA_HEADS), 0.2),
        'norm_mix': gain(ks[3], (L, D_MODEL)),
        'w_in': nrm(ks[4], (L, D_MODEL, IN_COLS), D_MODEL ** -0.5),
        'cmp_pos_k': nrm(ks[5], (L, CMP_LEN, D_HEAD), 0.02),
        'cmp_w1_k': nrm(ks[6], (L, CMP_LEN * D_HEAD, D_HEAD), (CMP_LEN * D_HEAD) ** -0.5),
        'cmp_w2_k': nrm(ks[7], (L, D_HEAD, D_HEAD), D_HEAD ** -0.5),
        'cmp_pos_v': nrm(ks[8], (L, CMP_LEN, D_HEAD), 0.02),
        'cmp_w1_v': nrm(ks[9], (L, CMP_LEN * D_HEAD, D_HEAD), (CMP_LEN * D_HEAD) ** -0.5),
        'cmp_w2_v': nrm(ks[10], (L, D_HEAD, D_HEAD), D_HEAD ** -0.5),
        'w_out': nrm(ks[11], (L, MIX_WIDTH, D_MODEL), MIX_WIDTH ** -0.5),
        'norm_mem_q': gain(ks[12], (L, D_MODEL)),
        'norm_mem_kv': gain(ks[13], (L, D_MODEL)),
        'w_mem_q': nrm(ks[14], (L, D_MODEL, MEM_HEADS * MEM_HEAD_DIM), D_MODEL ** -0.5),
        'w_mem_k': nrm(ks[15], (L, D_MODEL, MEM_HEADS * MEM_HEAD_DIM), D_MODEL ** -0.5),
        'w_mem_v': nrm(ks[16], (L, D_MODEL, MEM_HEADS * MEM_HEAD_DIM), D_MODEL ** -0.5),
        'w_mem_o': nrm(ks[17], (L, MEM_HEADS * MEM_HEAD_DIM, D_MODEL), (MEM_HEADS * MEM_HEAD_DIM) ** -0.5),
        'norm_ffn': gain(ks[18], (L, D_MODEL)),
        'peer_w_q': nrm(ks[19], (L, D_MODEL, PEER_HEADS * PEER_D_KEY), D_MODEL ** -0.5),
        'peer_sub_keys': nrm(ks[20], (L, PEER_HEADS, 2, PEER_N_KEYS, PEER_D_KEY // 2), (PEER_D_KEY // 2) ** -0.5),
        'peer_u': nrm(ks[21], (L, PEER_N_EXPERTS, D_MODEL), D_MODEL ** -0.5),
        'peer_v': nrm(ks[22], (L, PEER_N_EXPERTS, D_MODEL), (PEER_HEADS * PEER_TOPK) ** -0.5),
        'norm_final': gain(ks[23], (D_MODEL,)),
    }


def reference(x, mem, t5_table, norm_mix, w_in, cmp_pos_k, cmp_w1_k, cmp_w2_k,
              cmp_pos_v, cmp_w1_v, cmp_w2_v, w_out, norm_mem_q, norm_mem_kv,
              w_mem_q, w_mem_k, w_mem_v, w_mem_o, norm_ffn, peer_w_q, peer_sub_keys,
              peer_u, peer_v, norm_final):
    h = x
    for l in range(DEPTH):
        h = hybrid_layer(h, mem, t5_table, norm_mix[l], w_in[l], cmp_pos_k[l], cmp_w1_k[l],
                         cmp_w2_k[l], cmp_pos_v[l], cmp_w1_v[l], cmp_w2_v[l], w_out[l],
                         norm_mem_q[l], norm_mem_kv[l], w_mem_q[l], w_mem_k[l], w_mem_v[l],
                         w_mem_o[l], norm_ffn[l], peer_w_q[l], peer_sub_keys[l],
                         peer_u[l], peer_v[l])
    return rmsnorm(h, norm_final)
```

```cpp
#include <hip/hip_runtime.h>
#include <stdint.h>

#define SEQ 2048
#define NBATCH 4
#define T_TOK 8192
#define DM 2048
#define INC 5656
#define C_QN 0
#define C_KC 1024
#define C_VC 1280
#define C_KS 1536
#define C_VS 1792
#define C_KW 2048
#define C_VW 2304
#define C_GT 2560
#define C_QSB 2584
#define C_KSB 3608
#define C_VSB 4632
#define ATT_SCALE 0.08838834764831845f
#define RMS_EPS 1e-6f

struct P {
  const float *x, *mem, *t5, *norm_mix, *w_in, *pos_k, *w1_k, *w2_k, *pos_v, *w1_v, *w2_v, *w_out,
      *norm_mq, *norm_mkv, *w_mq, *w_mk, *w_mv, *w_mo, *norm_ffn, *w_pq, *subk, *pu, *pv, *norm_final;
  float* out;
  float *hn, *proj, *omix, *kc, *vc, *memn, *kmem, *vmem, *qmem, *omem;
};

__device__ __forceinline__ float wave_max(float v) {
  for (int o = 32; o > 0; o >>= 1) v = fmaxf(v, __shfl_xor(v, o));
  return v;
}
__device__ __forceinline__ float wave_sum(float v) {
  for (int o = 32; o > 0; o >>= 1) v += __shfl_xor(v, o);
  return v;
}
__device__ __forceinline__ void wave_argmax(float& v, int& i) {
  for (int o = 32; o > 0; o >>= 1) {
    float ov = __shfl_xor(v, o);
    int oi = __shfl_xor(i, o);
    if (ov > v || (ov == v && oi < i)) { v = ov; i = oi; }
  }
}
__device__ __forceinline__ float gelu_tanh(float x) {
  return 0.5f * x * (1.f + tanhf(0.7978845608028654f * (x + 0.044715f * x * x * x)));
}
__device__ __forceinline__ int t5_bucket(int n) {
  if (n < 16) return n < 0 ? 0 : n;
  int b = 16;
  b += (n >= 19); b += (n >= 21); b += (n >= 24); b += (n >= 27); b += (n >= 31); b += (n >= 35);
  b += (n >= 40); b += (n >= 46); b += (n >= 52); b += (n >= 59); b += (n >= 67); b += (n >= 77);
  b += (n >= 87); b += (n >= 99); b += (n >= 113);
  return b;
}
__device__ __forceinline__ float log_sigmoid(float x) {
  return fminf(x, 0.f) - log1pf(expf(-fabsf(x)));
}

__global__ void __launch_bounds__(256) k_rmsnorm(const float* src, const float* gain, float* dst, int rows) {
  int lane = threadIdx.x & 63, wv = threadIdx.x >> 6;
  for (int r = blockIdx.x * 4 + wv; r < rows; r += gridDim.x * 4) {
    const float4* s4 = (const float4*)(src + (size_t)r * DM);
    float4 v[8];
    float ss = 0.f;
#pragma unroll
    for (int i = 0; i < 8; ++i) {
      v[i] = s4[i * 64 + lane];
      ss += v[i].x * v[i].x + v[i].y * v[i].y + v[i].z * v[i].z + v[i].w * v[i].w;
    }
    ss = wave_sum(ss);
    float rs = rsqrtf(ss * (1.f / DM) + RMS_EPS);
    float4* d4 = (float4*)(dst + (size_t)r * DM);
    const float4* g4 = (const float4*)gain;
#pragma unroll
    for (int i = 0; i < 8; ++i) {
      float4 g = g4[i * 64 + lane];
      float4 o;
      o.x = v[i].x * rs * g.x; o.y = v[i].y * rs * g.y; o.z = v[i].z * rs * g.z; o.w = v[i].w * rs * g.w;
      d4[i * 64 + lane] = o;
    }
  }
}

__global__ void __launch_bounds__(256) k_gemm(const float* A, int lda, const float* W, int ldw, float* C, int ldc,
                                              const float* R, int M, int N, int K) {
  __shared__ float As[16][68];
  __shared__ float Ws[16][68];
  int tid = threadIdx.x;
  int tx = tid & 15, ty = tid >> 4;
  int ntn = (N + 63) / 64, ntm = (M + 63) / 64;
  for (int tile = blockIdx.x; tile < ntn * ntm; tile += gridDim.x) {
    int tm = tile / ntn, tn = tile % ntn;
    int m0 = tm * 64, n0 = tn * 64;
    float acc[4][4];
#pragma unroll
    for (int i = 0; i < 4; ++i)
#pragma unroll
      for (int j = 0; j < 4; ++j) acc[i][j] = 0.f;
    for (int k0 = 0; k0 < K; k0 += 16) {
      {
        int r = tid >> 2, kq = (tid & 3) * 4;
        float4 a = make_float4(0, 0, 0, 0);
        if (m0 + r < M) a = *(const float4*)(A + (size_t)(m0 + r) * lda + k0 + kq);
        As[kq + 0][r] = a.x; As[kq + 1][r] = a.y; As[kq + 2][r] = a.z; As[kq + 3][r] = a.w;
        int kk = tid >> 4, nq = (tid & 15) * 4;
        float4 w = make_float4(0, 0, 0, 0);
        if (n0 + nq < N) w = *(const float4*)(W + (size_t)(k0 + kk) * ldw + n0 + nq);
        *(float4*)&Ws[kk][nq] = w;
      }
      __syncthreads();
#pragma unroll
      for (int k = 0; k < 16; ++k) {
        float4 a = *(const float4*)&As[k][ty * 4];
        float4 b = *(const float4*)&Ws[k][tx * 4];
        float av[4] = {a.x, a.y, a.z, a.w};
        float bv[4] = {b.x, b.y, b.z, b.w};
#pragma unroll
        for (int i = 0; i < 4; ++i)
#pragma unroll
          for (int j = 0; j < 4; ++j) acc[i][j] += av[i] * bv[j];
      }
      __syncthreads();
    }
#pragma unroll
    for (int i = 0; i < 4; ++i) {
      int m = m0 + ty * 4 + i;
      if (m >= M) continue;
#pragma unroll
      for (int j = 0; j < 4; ++j) {
        int n = n0 + tx * 4 + j;
        if (n >= N) continue;
        float v = acc[i][j];
        if (R) v += R[(size_t)m * ldc + n];
        C[(size_t)m * ldc + n] = v;
      }
    }
  }
}

__global__ void __launch_bounds__(256) k_compress(P p) {
  __shared__ float red[256];
  __shared__ float c1[128];
  int tid = threadIdx.x, n = tid & 127, half = tid >> 7;
  for (int item = blockIdx.x; item < 2 * 8 * 127; item += gridDim.x) {
    int which = item / (8 * 127);
    int rem = item % (8 * 127);
    int bg = rem / 127, i = rem % 127;
    int b = bg >> 1, g = bg & 1;
    const float* src = p.proj + (size_t)(b * SEQ + 16 * i) * INC + (which ? C_VC : C_KC) + g * 128;
    const float* pos = which ? p.pos_v : p.pos_k;
    const float* w1 = which ? p.w1_v : p.w1_k;
    const float* w2 = which ? p.w2_v : p.w2_k;
    float acc = 0.f;
    for (int l = half * 16; l < half * 16 + 16; ++l) {
      const float* sr = src + (size_t)l * INC;
      const float* pr = pos + l * 128;
      const float* wr = w1 + (size_t)l * 128 * 128 + n;
      for (int d = 0; d < 128; ++d) acc += (sr[d] + pr[d]) * wr[(size_t)d * 128];
    }
    red[tid] = acc;
    __syncthreads();
    if (half == 0) c1[n] = gelu_tanh(red[n] + red[128 + n]);
    __syncthreads();
    if (half == 0) {
      float o = 0.f;
      for (int j = 0; j < 128; ++j) o += c1[j] * w2[j * 128 + n];
      float* dst = which ? p.vc : p.kc;
      dst[((size_t)bg * 128 + i) * 128 + n] = o;
    }
    __syncthreads();
  }
}

struct OS { float m, l, o0, o1; };

template <class F>
__device__ __forceinline__ void attn_chunk(OS& st, const float* qs, const float* Kp, const float* Vp, size_t stride,
                                           int s0, int smax, F f) {
  int lane = threadIdx.x & 63;
  int s = s0 + lane;
  bool valid = false;
  float bias = 0.f;
  if (s >= 0 && s < smax) valid = f(s, bias);
  float logit = -INFINITY;
  if (valid) {
    const float4* kr = (const float4*)(Kp + (size_t)s * stride);
    const float4* q4 = (const float4*)qs;
    float acc = 0.f;
#pragma unroll 8
    for (int i = 0; i < 32; ++i) {
      float4 kv = kr[i];
      float4 qv = q4[i];
      acc += kv.x * qv.x + kv.y * qv.y + kv.z * qv.z + kv.w * qv.w;
    }
    logit = acc * ATT_SCALE + bias;
  }
  float cm = wave_max(logit);
  if (cm == -INFINITY) return;
  float mn = fmaxf(st.m, cm);
  float alpha = expf(st.m - mn);
  float pr = valid ? expf(logit - mn) : 0.f;
  st.l = st.l * alpha + wave_sum(pr);
  st.o0 *= alpha;
  st.o1 *= alpha;
  st.m = mn;
  for (int j = 0; j < 64; ++j) {
    float pj = __shfl(pr, j);
    if (pj != 0.f) {
      const float* vr = Vp + (size_t)(s0 + j) * stride;
      st.o0 += pj * vr[lane];
      st.o1 += pj * vr[lane + 64];
    }
  }
}

__global__ void __launch_bounds__(256) k_nsa(P p) {
  __shared__ __attribute__((aligned(16))) float lq[4][512];
  __shared__ float lp[4][128];
  __shared__ float lk[4][64];
  __shared__ float loc[4][512];
  int lane = threadIdx.x & 63, wv = threadIdx.x >> 6;
  float* ocm = loc[wv];
  float* q = lq[wv];
  float* pbuf = lp[wv];
  float* kbuf = lk[wv];
  for (int item = blockIdx.x; item < NBATCH * 2 * (SEQ / 4); item += gridDim.x) {
    int t = (item % (SEQ / 4)) * 4 + wv;
    int bg = item / (SEQ / 4);
    int b = bg >> 1, g = bg & 1;
    const float* prow = p.proj + (size_t)(b * SEQ + t) * INC;
    for (int i = 0; i < 8; ++i) q[lane + 64 * i] = prow[C_QN + g * 512 + lane + 64 * i];
    __builtin_amdgcn_wave_barrier();
    const float* kcb = p.kc + (size_t)bg * 128 * 128;
    const float* vcb = p.vc + (size_t)bg * 128 * 128;
    float psum0 = 0.f, psum1 = 0.f;
    for (int r = 0; r < 4; ++r) {
      int h = g * 4 + r;
      float lg[2];
      bool vd[2];
      for (int u = 0; u < 2; ++u) {
        int c = lane + 64 * u;
        int dist = t - (16 * c + 31);
        vd[u] = (c < 127) && (dist >= 0);
        lg[u] = -INFINITY;
        if (vd[u]) {
          const float4* kr = (const float4*)(kcb + (size_t)c * 128);
          const float4* q4 = (const float4*)(q + r * 128);
          float acc = 0.f;
          for (int i = 0; i < 32; ++i) {
            float4 kv = kr[i];
            float4 qv = q4[i];
            acc += kv.x * qv.x + kv.y * qv.y + kv.z * qv.z + kv.w * qv.w;
          }
          lg[u] = acc * ATT_SCALE + p.t5[t5_bucket(dist) * 8 + h];
        }
      }
      float m = wave_max(fmaxf(lg[0], lg[1]));
      float e0 = vd[0] ? expf(lg[0] - m) : 0.f;
      float e1 = vd[1] ? expf(lg[1] - m) : 0.f;
      float sum = wave_sum(e0 + e1);
      float inv = 1.f / fmaxf(sum, 1e-20f);
      float p0 = e0 * inv, p1 = e1 * inv;
      psum0 += p0;
      psum1 += p1;
      float o0 = 0.f, o1 = 0.f;
      int cmax = (t >= 31) ? (t - 31) / 16 : -1;
      if (cmax > 126) cmax = 126;
      for (int c = 0; c <= cmax; ++c) {
        float pc = (c < 64) ? __shfl(p0, c) : __shfl(p1, c - 64);
        const float* vr = vcb + (size_t)c * 128;
        o0 += pc * vr[lane];
        o1 += pc * vr[lane + 64];
      }
      ocm[r * 128 + lane] = o0;
      ocm[r * 128 + lane + 64] = o1;
    }
    pbuf[lane] = psum0;
    pbuf[lane + 64] = (lane + 64 < 127) ? psum1 : 0.f;
    __builtin_amdgcn_wave_barrier();
    int cur = t >> 6;
    float key = -3e9f;
    bool allowed = false;
    if (lane < 32) {
      int j = lane;
      float imp = pbuf[4 * j] + pbuf[4 * j + 1] + pbuf[4 * j + 2] + 0.5f * pbuf[4 * j + 3];
      if (j > 0) imp += 0.5f * pbuf[4 * j - 1];
      bool forced = (j == 0) || (j == cur) || (j == cur - 1);
      allowed = (j <= cur);
      key = forced ? 1e9f : (allowed ? imp : -1e9f);
      kbuf[j] = key;
    }
    __builtin_amdgcn_wave_barrier();
    bool sel = false;
    if (lane < 32) {
      int rank = 0;
      for (int i = 0; i < 32; ++i) {
        float ki = kbuf[i];
        rank += (ki > key || (ki == key && i < lane)) ? 1 : 0;
      }
      sel = (rank < 16) && allowed;
    }
    unsigned long long bal = __ballot(sel);
    unsigned selmask = (unsigned)(bal & 0xffffffffull);
    __builtin_amdgcn_wave_barrier();
    const float* Ks = p.proj + (size_t)(b * SEQ) * INC + C_KS + g * 128;
    const float* Vs = p.proj + (size_t)(b * SEQ) * INC + C_VS + g * 128;
    const float* Kw = p.proj + (size_t)(b * SEQ) * INC + C_KW + g * 128;
    const float* Vw = p.proj + (size_t)(b * SEQ) * INC + C_VW + g * 128;
    for (int r = 0; r < 4; ++r) {
      int h = g * 4 + r;
      const float* t5h = p.t5 + h;
      OS ss = {-INFINITY, 0.f, 0.f, 0.f};
      for (int j = 0; j <= cur; ++j) {
        if (!((selmask >> j) & 1u)) continue;
        attn_chunk(ss, q + r * 128, Ks, Vs, (size_t)INC, j * 64, SEQ, [&](int s, float& bias) {
          int dist = t - s;
          if (dist < 0) return false;
          bias = t5h[t5_bucket(dist) * 8];
          return true;
        });
      }
      OS sw = {-INFINITY, 0.f, 0.f, 0.f};
      for (int s0 = (t & ~63); s0 >= 0 && s0 + 63 >= t - 511; s0 -= 64) {
        attn_chunk(sw, q + r * 128, Kw, Vw, (size_t)INC, s0, SEQ, [&](int s, float& bias) {
          int dist = t - s;
          if (dist < 0 || dist >= 512) return false;
          bias = t5h[t5_bucket(dist) * 8];
          return true;
        });
      }
      float isl = 1.f / fmaxf(ss.l, 1e-20f), iwl = 1.f / fmaxf(sw.l, 1e-20f);
      float g0 = 1.f / (1.f + expf(-prow[C_GT + h * 3 + 0]));
      float g1 = 1.f / (1.f + expf(-prow[C_GT + h * 3 + 1]));
      float g2 = 1.f / (1.f + expf(-prow[C_GT + h * 3 + 2]));
      float* orow = p.omix + (size_t)(b * SEQ + t) * DM + h * 128;
      orow[lane] = g0 * ocm[r * 128 + lane] + g1 * ss.o0 * isl + g2 * sw.o0 * iwl;
      orow[lane + 64] = g0 * ocm[r * 128 + lane + 64] + g1 * ss.o1 * isl + g2 * sw.o1 * iwl;
    }
    __builtin_amdgcn_wave_barrier();
  }
}

__global__ void __launch_bounds__(256) k_sb(P p) {
  __shared__ __attribute__((aligned(16))) float lq[4][128];
  int lane = threadIdx.x & 63, wv = threadIdx.x >> 6;
  float* q = lq[wv];
  for (int item = blockIdx.x; item < NBATCH * 8 * (SEQ / 4); item += gridDim.x) {
    int t = (item % (SEQ / 4)) * 4 + wv;
    int bh = item / (SEQ / 4);
    int b = bh >> 3, h = bh & 7;
    const float* prow = p.proj + (size_t)(b * SEQ + t) * INC;
    q[lane] = prow[C_QSB + h * 128 + lane];
    q[lane + 64] = prow[C_QSB + h * 128 + lane + 64];
    __builtin_amdgcn_wave_barrier();
    const float* Kb = p.proj + (size_t)(b * SEQ) * INC + C_KSB + h * 128;
    const float* Vb = p.proj + (size_t)(b * SEQ) * INC + C_VSB + h * 128;
    float carry = 0.f, o0 = 0.f, o1 = 0.f;
    if (t > 0) {
      for (int s0 = ((t - 1) & ~63); s0 >= 0; s0 -= 64) {
        int s = s0 + lane;
        bool valid = s < t;
        float z = 0.f;
        if (valid) {
          const float4* kr = (const float4*)(Kb + (size_t)s * INC);
          const float4* q4 = (const float4*)q;
          float acc = 0.f;
#pragma unroll 8
          for (int i = 0; i < 32; ++i) {
            float4 kv = kr[i];
            float4 qv = q4[i];
            acc += kv.x * qv.x + kv.y * qv.y + kv.z * qv.z + kv.w * qv.w;
          }
          z = acc * ATT_SCALE;
        }
        float lsp = log_sigmoid(z);
        float lf = valid ? (lsp - z) : 0.f;
        float incl = lf;
        for (int o = 1; o < 64; o <<= 1) {
          float v = __shfl_down(incl, o);
          if (lane + o < 64) incl += v;
        }
        float after = carry + incl - lf;
        float w = valid ? expf(lsp + after) : 0.f;
        carry += __shfl(incl, 0);
        for (int j = 0; j < 64; ++j) {
          float wj = __shfl(w, j);
          if (wj != 0.f) {
            const float* vr = Vb + (size_t)(s0 + j) * INC;
            o0 += wj * vr[lane];
            o1 += wj * vr[lane + 64];
          }
        }
      }
    }
    float* orow = p.omix + (size_t)(b * SEQ + t) * DM + 1024 + h * 128;
    orow[lane] = o0;
    orow[lane + 64] = o1;
    __builtin_amdgcn_wave_barrier();
  }
}

__global__ void __launch_bounds__(256) k_memattn(P p) {
  __shared__ __attribute__((aligned(16))) float lq[4][128];
  int lane = threadIdx.x & 63, wv = threadIdx.x >> 6;
  float* q = lq[wv];
  for (int item = blockIdx.x; item < NBATCH * 4 * (SEQ / 4); item += gridDim.x) {
    int t = (item % (SEQ / 4)) * 4 + wv;
    int bh = item / (SEQ / 4);
    int b = bh >> 2, h = bh & 3;
    const float* qrow = p.qmem + (size_t)(b * SEQ + t) * 512 + h * 128;
    q[lane] = qrow[lane];
    q[lane + 64] = qrow[lane + 64];
    __builtin_amdgcn_wave_barrier();
    const float* Kb = p.kmem + (size_t)(b * 256) * 512 + h * 128;
    const float* Vb = p.vmem + (size_t)(b * 256) * 512 + h * 128;
    OS st = {-INFINITY, 0.f, 0.f, 0.f};
    for (int s0 = 0; s0 < 256; s0 += 64)
      attn_chunk(st, q, Kb, Vb, (size_t)512, s0, 256, [&](int s, float& bias) {
        bias = 0.f;
        return true;
      });
    float il = 1.f / st.l;
    float* orow = p.omem + (size_t)(b * SEQ + t) * 512 + h * 128;
    orow[lane] = st.o0 * il;
    orow[lane + 64] = st.o1 * il;
    __builtin_amdgcn_wave_barrier();
  }
}

__global__ void __launch_bounds__(256) k_peer(P p) {
  __shared__ __attribute__((aligned(16))) float lq[4][2048];
  __shared__ float lts[4][256];
  __shared__ int lti[4][256];
  __shared__ float lbg[4][128];
  __shared__ int lbe[4][128];
  int lane = threadIdx.x & 63, wv = threadIdx.x >> 6;
  float* q = lq[wv];
  float* ts = lts[wv];
  int* ti = lti[wv];
  float* bgt = lbg[wv];
  int* bex = lbe[wv];
  const float* qp = p.omix;
  for (int item = blockIdx.x; item < T_TOK / 4; item += gridDim.x) {
    int t = item * 4 + wv;
    {
      const float4* s4 = (const float4*)(qp + (size_t)t * DM);
      float4* d4 = (float4*)q;
      for (int i = 0; i < 8; ++i) d4[i * 64 + lane] = s4[i * 64 + lane];
    }
    __builtin_amdgcn_wave_barrier();
    for (int hp = 0; hp < 16; ++hp) {
      float sc[2];
      for (int u = 0; u < 2; ++u) {
        int k = lane + 64 * u;
        const float4* kr = (const float4*)(p.subk + ((size_t)hp * 128 + k) * 128);
        const float4* q4 = (const float4*)(q + hp * 128);
        float acc = 0.f;
#pragma unroll 8
        for (int i = 0; i < 32; ++i) {
          float4 kv = kr[i];
          float4 qv = q4[i];
          acc += kv.x * qv.x + kv.y * qv.y + kv.z * qv.z + kv.w * qv.w;
        }
        sc[u] = acc;
      }
      for (int n = 0; n < 16; ++n) {
        float v;
        int i;
        if (sc[0] >= sc[1]) { v = sc[0]; i = lane; } else { v = sc[1]; i = lane + 64; }
        wave_argmax(v, i);
        if (lane == 0) { ts[hp * 16 + n] = v; ti[hp * 16 + n] = i; }
        if (i == lane) sc[0] = -INFINITY;
        if (i == lane + 64) sc[1] = -INFINITY;
      }
    }
    __builtin_amdgcn_wave_barrier();
    for (int h = 0; h < 8; ++h) {
      float cv[4];
      for (int m = 0; m < 4; ++m) {
        int c = m * 64 + lane;
        cv[m] = ts[(2 * h) * 16 + (c >> 4)] + ts[(2 * h + 1) * 16 + (c & 15)];
      }
      float mybest = 0.f;
      int myc = 0;
      for (int n = 0; n < 16; ++n) {
        float v = cv[0];
        int i = lane;
        for (int m = 1; m < 4; ++m)
          if (cv[m] > v) { v = cv[m]; i = m * 64 + lane; }
        wave_argmax(v, i);
        if (lane == n) { mybest = v; myc = i; }
        for (int m = 0; m < 4; ++m)
          if (i == m * 64 + lane) cv[m] = -INFINITY;
      }
      float sv = (lane < 16) ? mybest : -INFINITY;
      float mx = wave_max(sv);
      float e = (lane < 16) ? expf(sv - mx) : 0.f;
      float sum = wave_sum(e);
      if (lane < 16) {
        bgt[h * 16 + lane] = e / sum;
        bex[h * 16 + lane] = ti[(2 * h) * 16 + (myc >> 4)] * 128 + ti[(2 * h + 1) * 16 + (myc & 15)];
      }
    }
    __builtin_amdgcn_wave_barrier();
    float4 xv[8], acc[8];
    {
      const float4* s4 = (const float4*)(p.hn + (size_t)t * DM);
      for (int i = 0; i < 8; ++i) { xv[i] = s4[i * 64 + lane]; acc[i] = make_float4(0, 0, 0, 0); }
    }
    for (int e = 0; e < 128; ++e) {
      int eid = bex[e];
      float gt = bgt[e];
      const float4* ur = (const float4*)(p.pu + (size_t)eid * DM);
      float part = 0.f;
#pragma unroll
      for (int i = 0; i < 8; ++i) {
        float4 u = ur[i * 64 + lane];
        part += u.x * xv[i].x + u.y * xv[i].y + u.z * xv[i].z + u.w * xv[i].w;
      }
      float a = wave_sum(part);
      float hid = gt * gelu_tanh(a);
      const float4* vr = (const float4*)(p.pv + (size_t)eid * DM);
#pragma unroll
      for (int i = 0; i < 8; ++i) {
        float4 v = vr[i * 64 + lane];
        acc[i].x += hid * v.x; acc[i].y += hid * v.y; acc[i].z += hid * v.z; acc[i].w += hid * v.w;
      }
    }
    float4* o4 = (float4*)(p.out + (size_t)t * DM);
    float ss = 0.f;
#pragma unroll
    for (int i = 0; i < 8; ++i) {
      float4 hv = o4[i * 64 + lane];
      acc[i].x += hv.x; acc[i].y += hv.y; acc[i].z += hv.z; acc[i].w += hv.w;
      ss += acc[i].x * acc[i].x + acc[i].y * acc[i].y + acc[i].z * acc[i].z + acc[i].w * acc[i].w;
    }
    ss = wave_sum(ss);
    float rs = rsqrtf(ss * (1.f / DM) + RMS_EPS);
    const float4* g4 = (const float4*)p.norm_final;
#pragma unroll
    for (int i = 0; i < 8; ++i) {
      float4 g = g4[i * 64 + lane];
      float4 o;
      o.x = acc[i].x * rs * g.x; o.y = acc[i].y * rs * g.y; o.z = acc[i].z * rs * g.z; o.w = acc[i].w * rs * g.w;
      o4[i * 64 + lane] = o;
    }
    __builtin_amdgcn_wave_barrier();
  }
}

extern "C" void kernel_launch(void* const* d_in, const int* in_sizes, int n_in, void* d_out, int out_size, void* d_ws,
                              size_t ws_size, hipStream_t stream) {
  P p{};
  p.x = (const float*)d_in[0]; p.mem = (const float*)d_in[1]; p.t5 = (const float*)d_in[2];
  p.norm_mix = (const float*)d_in[3]; p.w_in = (const float*)d_in[4]; p.pos_k = (const float*)d_in[5];
  p.w1_k = (const float*)d_in[6]; p.w2_k = (const float*)d_in[7]; p.pos_v = (const float*)d_in[8];
  p.w1_v = (const float*)d_in[9]; p.w2_v = (const float*)d_in[10]; p.w_out = (const float*)d_in[11];
  p.norm_mq = (const float*)d_in[12]; p.norm_mkv = (const float*)d_in[13]; p.w_mq = (const float*)d_in[14];
  p.w_mk = (const float*)d_in[15]; p.w_mv = (const float*)d_in[16]; p.w_mo = (const float*)d_in[17];
  p.norm_ffn = (const float*)d_in[18]; p.w_pq = (const float*)d_in[19]; p.subk = (const float*)d_in[20];
  p.pu = (const float*)d_in[21]; p.pv = (const float*)d_in[22]; p.norm_final = (const float*)d_in[23];
  p.out = (float*)d_out;
  float* w = (float*)d_ws;
  size_t off = 0;
  p.hn = w + off; off += (size_t)T_TOK * DM;
  p.proj = w + off; off += (size_t)T_TOK * INC;
  p.omix = w + off; off += (size_t)T_TOK * DM;
  p.kc = w + off; off += 8 * 128 * 128;
  p.vc = w + off; off += 8 * 128 * 128;
  p.memn = w + off; off += 1024 * DM;
  p.kmem = w + off; off += 1024 * 512;
  p.vmem = w + off; off += 1024 * 512;
  p.qmem = w + off; off += (size_t)T_TOK * 512;
  p.omem = w + off; off += (size_t)T_TOK * 512;

  const int G = 2048;
  k_rmsnorm<<<G, 256, 0, stream>>>(p.x, p.norm_mix, p.hn, T_TOK);
  k_rmsnorm<<<256, 256, 0, stream>>>(p.mem, p.norm_mkv, p.memn, 1024);
  k_gemm<<<G * 4, 256, 0, stream>>>(p.hn, DM, p.w_in, INC, p.proj, INC, nullptr, T_TOK, INC, DM);
  k_gemm<<<128, 256, 0, stream>>>(p.memn, DM, p.w_mk, 512, p.kmem, 512, nullptr, 1024, 512, DM);
  k_gemm<<<128, 256, 0, stream>>>(p.memn, DM, p.w_mv, 512, p.vmem, 512, nullptr, 1024, 512, DM);
  k_compress<<<2032, 256, 0, stream>>>(p);
  k_nsa<<<4096, 256, 0, stream>>>(p);
  k_sb<<<G * 4, 256, 0, stream>>>(p);
  k_gemm<<<4096, 256, 0, stream>>>(p.omix, DM, p.w_out, DM, p.out, DM, p.x, T_TOK, DM, DM);
  k_rmsnorm<<<G, 256, 0, stream>>>(p.out, p.norm_mq, p.hn, T_TOK);
  k_gemm<<<1024, 256, 0, stream>>>(p.hn, DM, p.w_mq, 512, p.qmem, 512, nullptr, T_TOK, 512, DM);
  k_memattn<<<G * 4, 256, 0, stream>>>(p);
  k_gemm<<<4096, 256, 0, stream>>>(p.omem, 512, p.w_mo, DM, p.out, DM, p.out, T_TOK, DM, 512);
  k_rmsnorm<<<G, 256, 0, stream>>>(p.out, p.norm_ffn, p.hn, T_TOK);
  k_gemm<<<4096, 256, 0, stream>>>(p.hn, DM, p.w_pq, DM, p.omix, DM, nullptr, T_TOK, DM, DM);
  k_peer<<<2048, 256, 0, stream>>>(p);
}
```

```cpp
#include <hip/hip_runtime.h>
#include <hip/hip_cooperative_groups.h>
#include <cstdio>
namespace cg = cooperative_groups;
#include <stdint.h>

#define SEQ 2048
#define NBATCH 4
#define T_TOK 8192
#define DM 2048
#define INC 5656
#define C_QN 0
#define C_KC 1024
#define C_VC 1280
#define C_KS 1536
#define C_VS 1792
#define C_KW 2048
#define C_VW 2304
#define C_GT 2560
#define C_QSB 2584
#define C_KSB 3608
#define C_VSB 4632
#define ATT_SCALE 0.08838834764831845f
#define RMS_EPS 1e-6f

struct P {
  const float *x, *mem, *t5, *norm_mix, *w_in, *pos_k, *w1_k, *w2_k, *pos_v, *w1_v, *w2_v, *w_out,
      *norm_mq, *norm_mkv, *w_mq, *w_mk, *w_mv, *w_mo, *norm_ffn, *w_pq, *subk, *pu, *pv, *norm_final;
  float* out;
  float *hn, *proj, *omix, *kc, *vc, *memn, *kmem, *vmem, *qmem, *omem;
};

__device__ __forceinline__ float wave_max(float v) {
  for (int o = 32; o > 0; o >>= 1) v = fmaxf(v, __shfl_xor(v, o));
  return v;
}
__device__ __forceinline__ float wave_sum(float v) {
  for (int o = 32; o > 0; o >>= 1) v += __shfl_xor(v, o);
  return v;
}
__device__ __forceinline__ void wave_argmax(float& v, int& i) {
  for (int o = 32; o > 0; o >>= 1) {
    float ov = __shfl_xor(v, o);
    int oi = __shfl_xor(i, o);
    if (ov > v || (ov == v && oi < i)) { v = ov; i = oi; }
  }
}
__device__ __forceinline__ float gelu_tanh(float x) {
  return 0.5f * x * (1.f + tanhf(0.7978845608028654f * (x + 0.044715f * x * x * x)));
}
__device__ __forceinline__ int t5_bucket(int n) {
  if (n < 16) return n < 0 ? 0 : n;
  int b = 16;
  b += (n >= 19); b += (n >= 21); b += (n >= 24); b += (n >= 27); b += (n >= 31); b += (n >= 35);
  b += (n >= 40); b += (n >= 46); b += (n >= 52); b += (n >= 59); b += (n >= 67); b += (n >= 77);
  b += (n >= 87); b += (n >= 99); b += (n >= 113);
  return b;
}
__device__ __forceinline__ float log_sigmoid(float x) {
  return fminf(x, 0.f) - log1pf(expf(-fabsf(x)));
}

__device__ void ph_rmsnorm(const float* src, const float* gain, float* dst, int rows) {
  int lane = threadIdx.x & 63, wv = threadIdx.x >> 6;
  for (int r = blockIdx.x * 4 + wv; r < rows; r += gridDim.x * 4) {
    const float4* s4 = (const float4*)(src + (size_t)r * DM);
    float4 v[8];
    float ss = 0.f;
#pragma unroll
    for (int i = 0; i < 8; ++i) {
      v[i] = s4[i * 64 + lane];
      ss += v[i].x * v[i].x + v[i].y * v[i].y + v[i].z * v[i].z + v[i].w * v[i].w;
    }
    ss = wave_sum(ss);
    float rs = rsqrtf(ss * (1.f / DM) + RMS_EPS);
    float4* d4 = (float4*)(dst + (size_t)r * DM);
    const float4* g4 = (const float4*)gain;
#pragma unroll
    for (int i = 0; i < 8; ++i) {
      float4 g = g4[i * 64 + lane];
      float4 o;
      o.x = v[i].x * rs * g.x; o.y = v[i].y * rs * g.y; o.z = v[i].z * rs * g.z; o.w = v[i].w * rs * g.w;
      d4[i * 64 + lane] = o;
    }
  }
}

__device__ void ph_gemm(float* smem, const float* A, int lda, const float* W, int ldw, float* C, int ldc,
                        const float* R, int M, int N, int K) {
  float (*As)[68] = (float (*)[68])smem;
  float (*Ws)[68] = (float (*)[68])(smem + 16 * 68);
  int tid = threadIdx.x;
  int tx = tid & 15, ty = tid >> 4;
  int ntn = (N + 63) / 64, ntm = (M + 63) / 64;
  for (int tile = blockIdx.x; tile < ntn * ntm; tile += gridDim.x) {
    int tm = tile / ntn, tn = tile % ntn;
    int m0 = tm * 64, n0 = tn * 64;
    float acc[4][4];
#pragma unroll
    for (int i = 0; i < 4; ++i)
#pragma unroll
      for (int j = 0; j < 4; ++j) acc[i][j] = 0.f;
    for (int k0 = 0; k0 < K; k0 += 16) {
      {
        int r = tid >> 2, kq = (tid & 3) * 4;
        float4 a = make_float4(0, 0, 0, 0);
        if (m0 + r < M) a = *(const float4*)(A + (size_t)(m0 + r) * lda + k0 + kq);
        As[kq + 0][r] = a.x; As[kq + 1][r] = a.y; As[kq + 2][r] = a.z; As[kq + 3][r] = a.w;
        int kk = tid >> 4, nq = (tid & 15) * 4;
        float4 w = make_float4(0, 0, 0, 0);
        if (n0 + nq < N) w = *(const float4*)(W + (size_t)(k0 + kk) * ldw + n0 + nq);
        *(float4*)&Ws[kk][nq] = w;
      }
      __syncthreads();
#pragma unroll
      for (int k = 0; k < 16; ++k) {
        float4 a = *(const float4*)&As[k][ty * 4];
        float4 b = *(const float4*)&Ws[k][tx * 4];
        float av[4] = {a.x, a.y, a.z, a.w};
        float bv[4] = {b.x, b.y, b.z, b.w};
#pragma unroll
        for (int i = 0; i < 4; ++i)
#pragma unroll
          for (int j = 0; j < 4; ++j) acc[i][j] += av[i] * bv[j];
      }
      __syncthreads();
    }
#pragma unroll
    for (int i = 0; i < 4; ++i) {
      int m = m0 + ty * 4 + i;
      if (m >= M) continue;
#pragma unroll
      for (int j = 0; j < 4; ++j) {
        int n = n0 + tx * 4 + j;
        if (n >= N) continue;
        float v = acc[i][j];
        if (R) v += R[(size_t)m * ldc + n];
        C[(size_t)m * ldc + n] = v;
      }
    }
  }
}

__device__ void ph_compress(const P& p, float* smem) {
  float* red = smem;
  float* c1 = smem + 256;
  int tid = threadIdx.x, n = tid & 127, half = tid >> 7;
  for (int item = blockIdx.x; item < 2 * 8 * 127; item += gridDim.x) {
    int which = item / (8 * 127);
    int rem = item % (8 * 127);
    int bg = rem / 127, i = rem % 127;
    int b = bg >> 1, g = bg & 1;
    const float* src = p.proj + (size_t)(b * SEQ + 16 * i) * INC + (which ? C_VC : C_KC) + g * 128;
    const float* pos = which ? p.pos_v : p.pos_k;
    const float* w1 = which ? p.w1_v : p.w1_k;
    const float* w2 = which ? p.w2_v : p.w2_k;
    float acc = 0.f;
    for (int l = half * 16; l < half * 16 + 16; ++l) {
      const float* sr = src + (size_t)l * INC;
      const float* pr = pos + l * 128;
      const float* wr = w1 + (size_t)l * 128 * 128 + n;
      for (int d = 0; d < 128; ++d) acc += (sr[d] + pr[d]) * wr[(size_t)d * 128];
    }
    red[tid] = acc;
    __syncthreads();
    if (half == 0) c1[n] = gelu_tanh(red[n] + red[128 + n]);
    __syncthreads();
    if (half == 0) {
      float o = 0.f;
      for (int j = 0; j < 128; ++j) o += c1[j] * w2[j * 128 + n];
      float* dst = which ? p.vc : p.kc;
      dst[((size_t)bg * 128 + i) * 128 + n] = o;
    }
    __syncthreads();
  }
}

struct OS { float m, l, o0, o1; };

template <class F>
__device__ __forceinline__ void attn_chunk(OS& st, const float* qs, const float* Kp, const float* Vp, size_t stride,
                                           int s0, int smax, F f) {
  int lane = threadIdx.x & 63;
  int s = s0 + lane;
  bool valid = false;
  float bias = 0.f;
  if (s >= 0 && s < smax) valid = f(s, bias);
  float logit = -INFINITY;
  if (valid) {
    const float4* kr = (const float4*)(Kp + (size_t)s * stride);
    const float4* q4 = (const float4*)qs;
    float acc = 0.f;
#pragma unroll 4
    for (int i = 0; i < 32; ++i) {
      float4 kv = kr[i];
      float4 qv = q4[i];
      acc += kv.x * qv.x + kv.y * qv.y + kv.z * qv.z + kv.w * qv.w;
    }
    logit = acc * ATT_SCALE + bias;
  }
  float cm = wave_max(logit);
  if (cm == -INFINITY) return;
  float mn = fmaxf(st.m, cm);
  float alpha = expf(st.m - mn);
  float pr = valid ? expf(logit - mn) : 0.f;
  st.l = st.l * alpha + wave_sum(pr);
  st.o0 *= alpha;
  st.o1 *= alpha;
  st.m = mn;
  for (int j = 0; j < 64; ++j) {
    float pj = __shfl(pr, j);
    if (pj != 0.f) {
      const float* vr = Vp + (size_t)(s0 + j) * stride;
      st.o0 += pj * vr[lane];
      st.o1 += pj * vr[lane + 64];
    }
  }
}

__device__ void ph_nsa(const P& p, float* smem) {
  int lane = threadIdx.x & 63, wv = threadIdx.x >> 6;
  float* q = smem + wv * 512;
  float* ocm = smem + 2048 + wv * 512;
  float* pbuf = smem + 4096 + wv * 128;
  float* kbuf = smem + 4608 + wv * 64;
  for (int item = blockIdx.x; item < NBATCH * 2 * (SEQ / 4); item += gridDim.x) {
    int t = (item % (SEQ / 4)) * 4 + wv;
    int bg = item / (SEQ / 4);
    int b = bg >> 1, g = bg & 1;
    const float* prow = p.proj + (size_t)(b * SEQ + t) * INC;
    for (int i = 0; i < 8; ++i) q[lane + 64 * i] = prow[C_QN + g * 512 + lane + 64 * i];
    __builtin_amdgcn_wave_barrier();
    const float* kcb = p.kc + (size_t)bg * 128 * 128;
    const float* vcb = p.vc + (size_t)bg * 128 * 128;
    float psum0 = 0.f, psum1 = 0.f;
    for (int r = 0; r < 4; ++r) {
      int h = g * 4 + r;
      float lg[2];
      bool vd[2];
      for (int u = 0; u < 2; ++u) {
        int c = lane + 64 * u;
        int dist = t - (16 * c + 31);
        vd[u] = (c < 127) && (dist >= 0);
        lg[u] = -INFINITY;
        if (vd[u]) {
          const float4* kr = (const float4*)(kcb + (size_t)c * 128);
          const float4* q4 = (const float4*)(q + r * 128);
          float acc = 0.f;
#pragma unroll 4
          for (int i = 0; i < 32; ++i) {
            float4 kv = kr[i];
            float4 qv = q4[i];
            acc += kv.x * qv.x + kv.y * qv.y + kv.z * qv.z + kv.w * qv.w;
          }
          lg[u] = acc * ATT_SCALE + p.t5[t5_bucket(dist) * 8 + h];
        }
      }
      float m = wave_max(fmaxf(lg[0], lg[1]));
      float e0 = vd[0] ? expf(lg[0] - m) : 0.f;
      float e1 = vd[1] ? expf(lg[1] - m) : 0.f;
      float sum = wave_sum(e0 + e1);
      float inv = 1.f / fmaxf(sum, 1e-20f);
      float p0 = e0 * inv, p1 = e1 * inv;
      psum0 += p0;
      psum1 += p1;
      float o0 = 0.f, o1 = 0.f;
      int cmax = (t >= 31) ? (t - 31) / 16 : -1;
      if (cmax > 126) cmax = 126;
      for (int c = 0; c <= cmax; ++c) {
        float pc = (c < 64) ? __shfl(p0, c) : __shfl(p1, c - 64);
        const float* vr = vcb + (size_t)c * 128;
        o0 += pc * vr[lane];
        o1 += pc * vr[lane + 64];
      }
      ocm[r * 128 + lane] = o0;
      ocm[r * 128 + lane + 64] = o1;
    }
    pbuf[lane] = psum0;
    pbuf[lane + 64] = (lane + 64 < 127) ? psum1 : 0.f;
    __builtin_amdgcn_wave_barrier();
    int cur = t >> 6;
    float key = -3e9f;
    bool allowed = false;
    if (lane < 32) {
      int j = lane;
      float imp = pbuf[4 * j] + pbuf[4 * j + 1] + pbuf[4 * j + 2] + 0.5f * pbuf[4 * j + 3];
      if (j > 0) imp += 0.5f * pbuf[4 * j - 1];
      bool forced = (j == 0) || (j == cur) || (j == cur - 1);
      allowed = (j <= cur);
      key = forced ? 1e9f : (allowed ? imp : -1e9f);
      kbuf[j] = key;
    }
    __builtin_amdgcn_wave_barrier();
    bool sel = false;
    if (lane < 32) {
      int rank = 0;
      for (int i = 0; i < 32; ++i) {
        float ki = kbuf[i];
        rank += (ki > key || (ki == key && i < lane)) ? 1 : 0;
      }
      sel = (rank < 16) && allowed;
    }
    unsigned long long bal = __ballot(sel);
    unsigned selmask = (unsigned)(bal & 0xffffffffull);
    __builtin_amdgcn_wave_barrier();
    const float* Ks = p.proj + (size_t)(b * SEQ) * INC + C_KS + g * 128;
    const float* Vs = p.proj + (size_t)(b * SEQ) * INC + C_VS + g * 128;
    const float* Kw = p.proj + (size_t)(b * SEQ) * INC + C_KW + g * 128;
    const float* Vw = p.proj + (size_t)(b * SEQ) * INC + C_VW + g * 128;
    for (int r = 0; r < 4; ++r) {
      int h = g * 4 + r;
      const float* t5h = p.t5 + h;
      OS ss = {-INFINITY, 0.f, 0.f, 0.f};
      for (int j = 0; j <= cur; ++j) {
        if (!((selmask >> j) & 1u)) continue;
        attn_chunk(ss, q + r * 128, Ks, Vs, (size_t)INC, j * 64, SEQ, [&](int s, float& bias) {
          int dist = t - s;
          if (dist < 0) return false;
          bias = t5h[t5_bucket(dist) * 8];
          return true;
        });
      }
      OS sw = {-INFINITY, 0.f, 0.f, 0.f};
      for (int s0 = (t & ~63); s0 >= 0 && s0 + 63 >= t - 511; s0 -= 64) {
        attn_chunk(sw, q + r * 128, Kw, Vw, (size_t)INC, s0, SEQ, [&](int s, float& bias) {
          int dist = t - s;
          if (dist < 0 || dist >= 512) return false;
          bias = t5h[t5_bucket(dist) * 8];
          return true;
        });
      }
      float isl = 1.f / fmaxf(ss.l, 1e-20f), iwl = 1.f / fmaxf(sw.l, 1e-20f);
      float g0 = 1.f / (1.f + expf(-prow[C_GT + h * 3 + 0]));
      float g1 = 1.f / (1.f + expf(-prow[C_GT + h * 3 + 1]));
      float g2 = 1.f / (1.f + expf(-prow[C_GT + h * 3 + 2]));
      float* orow = p.omix + (size_t)(b * SEQ + t) * DM + h * 128;
      orow[lane] = g0 * ocm[r * 128 + lane] + g1 * ss.o0 * isl + g2 * sw.o0 * iwl;
      orow[lane + 64] = g0 * ocm[r * 128 + lane + 64] + g1 * ss.o1 * isl + g2 * sw.o1 * iwl;
    }
    __builtin_amdgcn_wave_barrier();
  }
}

__device__ void ph_sb(const P& p, float* smem) {
  int lane = threadIdx.x & 63, wv = threadIdx.x >> 6;
  float* q = smem + wv * 128;
  for (int item = blockIdx.x; item < NBATCH * 8 * (SEQ / 4); item += gridDim.x) {
    int t = (item % (SEQ / 4)) * 4 + wv;
    int bh = item / (SEQ / 4);
    int b = bh >> 3, h = bh & 7;
    const float* prow = p.proj + (size_t)(b * SEQ + t) * INC;
    q[lane] = prow[C_QSB + h * 128 + lane];
    q[lane + 64] = prow[C_QSB + h * 128 + lane + 64];
    __builtin_amdgcn_wave_barrier();
    const float* Kb = p.proj + (size_t)(b * SEQ) * INC + C_KSB + h * 128;
    const float* Vb = p.proj + (size_t)(b * SEQ) * INC + C_VSB + h * 128;
    float carry = 0.f, o0 = 0.f, o1 = 0.f;
    if (t > 0) {
      for (int s0 = ((t - 1) & ~63); s0 >= 0; s0 -= 64) {
        int s = s0 + lane;
        bool valid = s < t;
        float z = 0.f;
        if (valid) {
          const float4* kr = (const float4*)(Kb + (size_t)s * INC);
          const float4* q4 = (const float4*)q;
          float acc = 0.f;
#pragma unroll 4
          for (int i = 0; i < 32; ++i) {
            float4 kv = kr[i];
            float4 qv = q4[i];
            acc += kv.x * qv.x + kv.y * qv.y + kv.z * qv.z + kv.w * qv.w;
          }
          z = acc * ATT_SCALE;
        }
        float lsp = log_sigmoid(z);
        float lf = valid ? (lsp - z) : 0.f;
        float incl = lf;
        for (int o = 1; o < 64; o <<= 1) {
          float v = __shfl_down(incl, o);
          if (lane + o < 64) incl += v;
        }
        float after = carry + incl - lf;
        float w = valid ? expf(lsp + after) : 0.f;
        carry += __shfl(incl, 0);
        for (int j = 0; j < 64; ++j) {
          float wj = __shfl(w, j);
          if (wj != 0.f) {
            const float* vr = Vb + (size_t)(s0 + j) * INC;
            o0 += wj * vr[lane];
            o1 += wj * vr[lane + 64];
          }
        }
      }
    }
    float* orow = p.omix + (size_t)(b * SEQ + t) * DM + 1024 + h * 128;
    orow[lane] = o0;
    orow[lane + 64] = o1;
    __builtin_amdgcn_wave_barrier();
  }
}

__device__ void ph_memattn(const P& p, float* smem) {
  int lane = threadIdx.x & 63, wv = threadIdx.x >> 6;
  float* q = smem + wv * 128;
  for (int item = blockIdx.x; item < NBATCH * 4 * (SEQ / 4); item += gridDim.x) {
    int t = (item % (SEQ / 4)) * 4 + wv;
    int bh = item / (SEQ / 4);
    int b = bh >> 2, h = bh & 3;
    const float* qrow = p.qmem + (size_t)(b * SEQ + t) * 512 + h * 128;
    q[lane] = qrow[lane];
    q[lane + 64] = qrow[lane + 64];
    __builtin_amdgcn_wave_barrier();
    const float* Kb = p.kmem + (size_t)(b * 256) * 512 + h * 128;
    const float* Vb = p.vmem + (size_t)(b * 256) * 512 + h * 128;
    OS st = {-INFINITY, 0.f, 0.f, 0.f};
    for (int s0 = 0; s0 < 256; s0 += 64)
      attn_chunk(st, q, Kb, Vb, (size_t)512, s0, 256, [&](int s, float& bias) {
        bias = 0.f;
        return true;
      });
    float il = 1.f / st.l;
    float* orow = p.omem + (size_t)(b * SEQ + t) * 512 + h * 128;
    orow[lane] = st.o0 * il;
    orow[lane + 64] = st.o1 * il;
    __builtin_amdgcn_wave_barrier();
  }
}

__device__ void ph_peer(const P& p, float* smem) {
  int lane = threadIdx.x & 63, wv = threadIdx.x >> 6;
  float* q = smem + wv * 2048;
  float* ts = smem + 8192 + wv * 256;
  int* ti = (int*)(smem + 9216) + wv * 256;
  float* bgt = smem + 10240 + wv * 128;
  int* bex = (int*)(smem + 10752) + wv * 128;
  const float* qp = p.omix;
  for (int item = blockIdx.x; item < T_TOK / 4; item += gridDim.x) {
    int t = item * 4 + wv;
    {
      const float4* s4 = (const float4*)(qp + (size_t)t * DM);
      float4* d4 = (float4*)q;
      for (int i = 0; i < 8; ++i) d4[i * 64 + lane] = s4[i * 64 + lane];
    }
    __builtin_amdgcn_wave_barrier();
    for (int hp = 0; hp < 16; ++hp) {
      float sc[2];
      for (int u = 0; u < 2; ++u) {
        int k = lane + 64 * u;
        const float4* kr = (const float4*)(p.subk + ((size_t)hp * 128 + k) * 128);
        const float4* q4 = (const float4*)(q + hp * 128);
        float acc = 0.f;
#pragma unroll 4
        for (int i = 0; i < 32; ++i) {
          float4 kv = kr[i];
          float4 qv = q4[i];
          acc += kv.x * qv.x + kv.y * qv.y + kv.z * qv.z + kv.w * qv.w;
        }
        sc[u] = acc;
      }
      for (int n = 0; n < 16; ++n) {
        float v;
        int i;
        if (sc[0] >= sc[1]) { v = sc[0]; i = lane; } else { v = sc[1]; i = lane + 64; }
        wave_argmax(v, i);
        if (lane == 0) { ts[hp * 16 + n] = v; ti[hp * 16 + n] = i; }
        if (i == lane) sc[0] = -INFINITY;
        if (i == lane + 64) sc[1] = -INFINITY;
      }
    }
    __builtin_amdgcn_wave_barrier();
    for (int h = 0; h < 8; ++h) {
      float cv[4];
      for (int m = 0; m < 4; ++m) {
        int c = m * 64 + lane;
        cv[m] = ts[(2 * h) * 16 + (c >> 4)] + ts[(2 * h + 1) * 16 + (c & 15)];
      }
      float mybest = 0.f;
      int myc = 0;
      for (int n = 0; n < 16; ++n) {
        float v = cv[0];
        int i = lane;
        for (int m = 1; m < 4; ++m)
          if (cv[m] > v) { v = cv[m]; i = m * 64 + lane; }
        wave_argmax(v, i);
        if (lane == n) { mybest = v; myc = i; }
        for (int m = 0; m < 4; ++m)
          if (i == m * 64 + lane) cv[m] = -INFINITY;
      }
      float sv = (lane < 16) ? mybest : -INFINITY;
      float mx = wave_max(sv);
      float e = (lane < 16) ? expf(sv - mx) : 0.f;
      float sum = wave_sum(e);
      if (lane < 16) {
        bgt[h * 16 + lane] = e / sum;
        bex[h * 16 + lane] = ti[(2 * h) * 16 + (myc >> 4)] * 128 + ti[(2 * h + 1) * 16 + (myc & 15)];
      }
    }
    __builtin_amdgcn_wave_barrier();
    float4 xv[8], acc[8];
    {
      const float4* s4 = (const float4*)(p.hn + (size_t)t * DM);
      for (int i = 0; i < 8; ++i) { xv[i] = s4[i * 64 + lane]; acc[i] = make_float4(0, 0, 0, 0); }
    }
    for (int e = 0; e < 128; ++e) {
      int eid = bex[e];
      float gt = bgt[e];
      const float4* ur = (const float4*)(p.pu + (size_t)eid * DM);
      float part = 0.f;
#pragma unroll
      for (int i = 0; i < 8; ++i) {
        float4 u = ur[i * 64 + lane];
        part += u.x * xv[i].x + u.y * xv[i].y + u.z * xv[i].z + u.w * xv[i].w;
      }
      float a = wave_sum(part);
      float hid = gt * gelu_tanh(a);
      const float4* vr = (const float4*)(p.pv + (size_t)eid * DM);
#pragma unroll
      for (int i = 0; i < 8; ++i) {
        float4 v = vr[i * 64 + lane];
        acc[i].x += hid * v.x; acc[i].y += hid * v.y; acc[i].z += hid * v.z; acc[i].w += hid * v.w;
      }
    }
    float4* o4 = (float4*)(p.out + (size_t)t * DM);
    float ss = 0.f;
#pragma unroll
    for (int i = 0; i < 8; ++i) {
      float4 hv = o4[i * 64 + lane];
      acc[i].x += hv.x; acc[i].y += hv.y; acc[i].z += hv.z; acc[i].w += hv.w;
      ss += acc[i].x * acc[i].x + acc[i].y * acc[i].y + acc[i].z * acc[i].z + acc[i].w * acc[i].w;
    }
    ss = wave_sum(ss);
    float rs = rsqrtf(ss * (1.f / DM) + RMS_EPS);
    const float4* g4 = (const float4*)p.norm_final;
#pragma unroll
    for (int i = 0; i < 8; ++i) {
      float4 g = g4[i * 64 + lane];
      float4 o;
      o.x = acc[i].x * rs * g.x; o.y = acc[i].y * rs * g.y; o.z = acc[i].z * rs * g.z; o.w = acc[i].w * rs * g.w;
      o4[i * 64 + lane] = o;
    }
    __builtin_amdgcn_wave_barrier();
  }
}

typedef const __attribute__((address_space(4))) P* KP;
__device__ __forceinline__ P loadP() {
#if defined(__HIP_DEVICE_COMPILE__)
  KP k = (KP)__builtin_amdgcn_kernarg_segment_ptr();
  asm volatile("" : "+s"(k));
  P p = *k;
  return p;
#else
  return P{};
#endif
}

__global__ void __launch_bounds__(256) mega(P p_arg) {
  cg::grid_group grid = cg::this_grid();
  __shared__ __attribute__((aligned(16))) float smem[12288];
  { P p = loadP(); ph_rmsnorm(p.x, p.norm_mix, p.hn, T_TOK); ph_rmsnorm(p.mem, p.norm_mkv, p.memn, 1024); }
  grid.sync();
  { P p = loadP();
    ph_gemm(smem, p.hn, DM, p.w_in, INC, p.proj, INC, nullptr, T_TOK, INC, DM);
    ph_gemm(smem, p.memn, DM, p.w_mk, 512, p.kmem, 512, nullptr, 1024, 512, DM);
    ph_gemm(smem, p.memn, DM, p.w_mv, 512, p.vmem, 512, nullptr, 1024, 512, DM); }
  grid.sync();
  { P p = loadP(); ph_compress(p, smem); }
  { P p = loadP(); ph_sb(p, smem); }
  grid.sync();
  { P p = loadP(); ph_nsa(p, smem); }
  grid.sync();
  { P p = loadP(); ph_gemm(smem, p.omix, DM, p.w_out, DM, p.out, DM, p.x, T_TOK, DM, DM); }
  grid.sync();
  { P p = loadP(); ph_rmsnorm(p.out, p.norm_mq, p.hn, T_TOK); }
  grid.sync();
  { P p = loadP(); ph_gemm(smem, p.hn, DM, p.w_mq, 512, p.qmem, 512, nullptr, T_TOK, 512, DM); }
  grid.sync();
  { P p = loadP(); ph_memattn(p, smem); }
  grid.sync();
  { P p = loadP(); ph_gemm(smem, p.omem, 512, p.w_mo, DM, p.out, DM, p.out, T_TOK, DM, 512); }
  grid.sync();
  { P p = loadP(); ph_rmsnorm(p.out, p.norm_ffn, p.hn, T_TOK); }
  grid.sync();
  { P p = loadP(); ph_gemm(smem, p.hn, DM, p.w_pq, DM, p.omix, DM, nullptr, T_TOK, DM, DM); }
  grid.sync();
  { P p = loadP(); ph_peer(p, smem); }
}

extern "C" void kernel_launch(void* const* d_in, const int* in_sizes, int n_in, void* d_out, int out_size, void* d_ws,
                              size_t ws_size, hipStream_t stream) {
  P p{};
  p.x = (const float*)d_in[0]; p.mem = (const float*)d_in[1]; p.t5 = (const float*)d_in[2];
  p.norm_mix = (const float*)d_in[3]; p.w_in = (const float*)d_in[4]; p.pos_k = (const float*)d_in[5];
  p.w1_k = (const float*)d_in[6]; p.w2_k = (const float*)d_in[7]; p.pos_v = (const float*)d_in[8];
  p.w1_v = (const float*)d_in[9]; p.w2_v = (const float*)d_in[10]; p.w_out = (const float*)d_in[11];
  p.norm_mq = (const float*)d_in[12]; p.norm_mkv = (const float*)d_in[13]; p.w_mq = (const float*)d_in[14];
  p.w_mk = (const float*)d_in[15]; p.w_mv = (const float*)d_in[16]; p.w_mo = (const float*)d_in[17];
  p.norm_ffn = (const float*)d_in[18]; p.w_pq = (const float*)d_in[19]; p.subk = (const float*)d_in[20];
  p.pu = (const float*)d_in[21]; p.pv = (const float*)d_in[22]; p.norm_final = (const float*)d_in[23];
  p.out = (float*)d_out;
  float* w = (float*)d_ws;
  size_t off = 0;
  p.hn = w + off; off += (size_t)T_TOK * DM;
  p.proj = w + off; off += (size_t)T_TOK * INC;
  p.omix = w + off; off += (size_t)T_TOK * DM;
  p.kc = w + off; off += 8 * 128 * 128;
  p.vc = w + off; off += 8 * 128 * 128;
  p.memn = w + off; off += 1024 * DM;
  p.kmem = w + off; off += 1024 * 512;
  p.vmem = w + off; off += 1024 * 512;
  p.qmem = w + off; off += (size_t)T_TOK * 512;
  p.omem = w + off; off += (size_t)T_TOK * 512;

  static int grid_blocks = 0;
  if (!grid_blocks) {
    int dev = 0, cus = 0, per_cu = 0;
    (void)hipGetDevice(&dev);
    (void)hipDeviceGetAttribute(&cus, hipDeviceAttributeMultiprocessorCount, dev);
    (void)hipOccupancyMaxActiveBlocksPerMultiprocessor(&per_cu, mega, 256, 0);
    if (per_cu > 2) per_cu = 2;
    if (per_cu < 1) per_cu = 1;
    grid_blocks = cus * per_cu;
  }
  void* args[] = {&p};
  hipError_t e = hipLaunchCooperativeKernel((void*)mega, dim3(grid_blocks), dim3(256), args, 0, stream);
  if (e != hipSuccess) fprintf(stderr, "cooperative launch failed: %s (grid %d)\n", hipGetErrorString(e), grid_blocks);
}
```

```cpp
#include <hip/hip_runtime.h>
#include <hip/hip_cooperative_groups.h>
#include <cstdio>
namespace cg = cooperative_groups;
#include <stdint.h>

#define SEQ 2048
#define NBATCH 4
#define T_TOK 8192
#define DM 2048
#define INC 5656
#define C_QN 0
#define C_KC 1024
#define C_VC 1280
#define C_KS 1536
#define C_VS 1792
#define C_KW 2048
#define C_VW 2304
#define C_GT 2560
#define C_QSB 2584
#define C_KSB 3608
#define C_VSB 4632
#define ATT_SCALE 0.08838834764831845f
#define RMS_EPS 1e-6f

typedef unsigned short bf16_t;
typedef __attribute__((ext_vector_type(8))) short bf16x8;
typedef __attribute__((ext_vector_type(16))) float f32x16;
typedef __attribute__((ext_vector_type(2))) __bf16 bf16v2;

struct P {
  const float *x, *mem, *t5, *norm_mix, *w_in, *pos_k, *w1_k, *w2_k, *pos_v, *w1_v, *w2_v, *w_out,
      *norm_mq, *norm_mkv, *w_mq, *w_mk, *w_mv, *w_mo, *norm_ffn, *w_pq, *subk, *pu, *pv, *norm_final;
  float* out;
  float *proj, *kc, *vc, *kmem, *vmem, *qmem;
  bf16_t *hn, *omix, *memn, *omem;
  bf16_t *WinT, *WoutT, *WpqT, *WmqT, *WmkT, *WmvT, *WmoT;
};

__device__ __forceinline__ unsigned pack2(float a, float b) {
  bf16v2 r = {(__bf16)a, (__bf16)b};
  return *(unsigned*)&r;
}
__device__ __forceinline__ bf16_t f2bf(float a) {
  __bf16 r = (__bf16)a;
  return *(bf16_t*)&r;
}
__device__ __forceinline__ float bf2f(bf16_t u) { return __uint_as_float((unsigned)u << 16); }

__device__ __forceinline__ float wave_max(float v) {
  for (int o = 32; o > 0; o >>= 1) v = fmaxf(v, __shfl_xor(v, o));
  return v;
}
__device__ __forceinline__ float wave_sum(float v) {
  for (int o = 32; o > 0; o >>= 1) v += __shfl_xor(v, o);
  return v;
}
__device__ __forceinline__ void wave_argmax(float& v, int& i) {
  for (int o = 32; o > 0; o >>= 1) {
    float ov = __shfl_xor(v, o);
    int oi = __shfl_xor(i, o);
    if (ov > v || (ov == v && oi < i)) { v = ov; i = oi; }
  }
}
__device__ __forceinline__ float gelu_tanh(float x) {
  return 0.5f * x * (1.f + tanhf(0.7978845608028654f * (x + 0.044715f * x * x * x)));
}
__device__ __forceinline__ int t5_bucket(int n) {
  if (n < 16) return n < 0 ? 0 : n;
  int b = 16;
  b += (n >= 19); b += (n >= 21); b += (n >= 24); b += (n >= 27); b += (n >= 31); b += (n >= 35);
  b += (n >= 40); b += (n >= 46); b += (n >= 52); b += (n >= 59); b += (n >= 67); b += (n >= 77);
  b += (n >= 87); b += (n >= 99); b += (n >= 113);
  return b;
}
__device__ __forceinline__ float log_sigmoid(float x) {
  return fminf(x, 0.f) - log1pf(expf(-fabsf(x)));
}

__device__ void ph_rmsnorm(const float* src, const float* gain, bf16_t* dst, int rows) {
  int lane = threadIdx.x & 63, wv = threadIdx.x >> 6;
  for (int r = blockIdx.x * 4 + wv; r < rows; r += gridDim.x * 4) {
    const float4* s4 = (const float4*)(src + (size_t)r * DM);
    float4 v[8];
    float ss = 0.f;
#pragma unroll
    for (int i = 0; i < 8; ++i) {
      v[i] = s4[i * 64 + lane];
      ss += v[i].x * v[i].x + v[i].y * v[i].y + v[i].z * v[i].z + v[i].w * v[i].w;
    }
    ss = wave_sum(ss);
    float rs = rsqrtf(ss * (1.f / DM) + RMS_EPS);
    uint2* d2 = (uint2*)(dst + (size_t)r * DM);
    const float4* g4 = (const float4*)gain;
#pragma unroll
    for (int i = 0; i < 8; ++i) {
      float4 g = g4[i * 64 + lane];
      uint2 o;
      o.x = pack2(v[i].x * rs * g.x, v[i].y * rs * g.y);
      o.y = pack2(v[i].z * rs * g.z, v[i].w * rs * g.w);
      d2[i * 64 + lane] = o;
    }
  }
}

__device__ void ph_transpose(float* smem, const float* W, int K, int N, int Npad, bf16_t* Wt) {
  float (*tl)[65] = (float (*)[65])smem;
  int tid = threadIdx.x;
  int nk = K / 64, nn = Npad / 64;
  for (int tile = blockIdx.x; tile < nk * nn; tile += gridDim.x) {
    int k0 = (tile % nk) * 64, n0 = (tile / nk) * 64;
    int col = tid & 63, rb = tid >> 6;
#pragma unroll 4
    for (int pp = 0; pp < 16; ++pp) {
      int k = pp * 4 + rb;
      float v = 0.f;
      if (n0 + col < N) v = W[(size_t)(k0 + k) * N + n0 + col];
      tl[k][col] = v;
    }
    __syncthreads();
    int n = tid >> 2, kc = (tid & 3) * 16;
    unsigned w[8];
#pragma unroll
    for (int i = 0; i < 8; ++i) w[i] = pack2(tl[kc + 2 * i][n], tl[kc + 2 * i + 1][n]);
    uint4* dst = (uint4*)(Wt + (size_t)(n0 + n) * K + k0 + kc);
    dst[0] = make_uint4(w[0], w[1], w[2], w[3]);
    dst[1] = make_uint4(w[4], w[5], w[6], w[7]);
    __syncthreads();
  }
}

__device__ __forceinline__ int lds_off(int row, int chunk) { return row * 128 + ((chunk ^ ((row >> 1) & 7)) << 4); }

template <class Epi>
__device__ __forceinline__ void gemm_tile_bf16(const bf16_t* xp, int ldx, const bf16_t* yp, int ldy, int K, char* lds,
                                               Epi epi) {
  const int tid = threadIdx.x, lane = tid & 63, wv = tid >> 6;
  const int wr = wv >> 1, wc = wv & 1;
  char* lx = lds;
  char* ly = lds + 16384;
  f32x16 acc[2][2];
#pragma unroll
  for (int i = 0; i < 2; ++i)
#pragma unroll
    for (int j = 0; j < 2; ++j)
#pragma unroll
      for (int r = 0; r < 16; ++r) acc[i][j][r] = 0.f;
  const int srow = tid >> 3, sch = tid & 7;
  const bf16_t* xg = xp + (size_t)srow * ldx + sch * 8;
  const bf16_t* yg = yp + (size_t)srow * ldy + sch * 8;
  const size_t x32 = (size_t)32 * ldx, y32 = (size_t)32 * ldy;
  uint4 sx0 = *(const uint4*)(xg), sx1 = *(const uint4*)(xg + x32), sx2 = *(const uint4*)(xg + 2 * x32),
        sx3 = *(const uint4*)(xg + 3 * x32);
  uint4 sy0 = *(const uint4*)(yg), sy1 = *(const uint4*)(yg + y32), sy2 = *(const uint4*)(yg + 2 * y32),
        sy3 = *(const uint4*)(yg + 3 * y32);
  const int so0 = lds_off(srow, sch), so1 = lds_off(32 + srow, sch), so2 = lds_off(64 + srow, sch),
            so3 = lds_off(96 + srow, sch);
  for (int k0 = 0; k0 < K; k0 += 64) {
    __syncthreads();
    *(uint4*)(lx + so0) = sx0; *(uint4*)(lx + so1) = sx1; *(uint4*)(lx + so2) = sx2; *(uint4*)(lx + so3) = sx3;
    *(uint4*)(ly + so0) = sy0; *(uint4*)(ly + so1) = sy1; *(uint4*)(ly + so2) = sy2; *(uint4*)(ly + so3) = sy3;
    __syncthreads();
    if (k0 + 64 < K) {
      const bf16_t* xn = xg + k0 + 64;
      const bf16_t* yn = yg + k0 + 64;
      sx0 = *(const uint4*)(xn); sx1 = *(const uint4*)(xn + x32); sx2 = *(const uint4*)(xn + 2 * x32);
      sx3 = *(const uint4*)(xn + 3 * x32);
      sy0 = *(const uint4*)(yn); sy1 = *(const uint4*)(yn + y32); sy2 = *(const uint4*)(yn + 2 * y32);
      sy3 = *(const uint4*)(yn + 3 * y32);
    }
#pragma unroll
    for (int kk = 0; kk < 4; ++kk) {
      bf16x8 a[2], b[2];
      const int ch = kk * 2 + (lane >> 5);
#pragma unroll
      for (int i = 0; i < 2; ++i) {
        a[i] = *(const bf16x8*)(lx + lds_off(wr * 64 + i * 32 + (lane & 31), ch));
        b[i] = *(const bf16x8*)(ly + lds_off(wc * 64 + i * 32 + (lane & 31), ch));
      }
#pragma unroll
      for (int i = 0; i < 2; ++i)
#pragma unroll
        for (int j = 0; j < 2; ++j) acc[i][j] = __builtin_amdgcn_mfma_f32_32x32x16_bf16(a[i], b[j], acc[i][j], 0, 0, 0);
    }
  }
#pragma unroll
  for (int i = 0; i < 2; ++i)
#pragma unroll
    for (int j = 0; j < 2; ++j)
#pragma unroll
      for (int r = 0; r < 16; ++r) {
        int rr = wr * 64 + i * 32 + (r & 3) + 8 * (r >> 2) + 4 * (lane >> 5);
        int cc = wc * 64 + j * 32 + (lane & 31);
        epi(rr, cc, acc[i][j][r]);
      }
}

template <class Epi>
__device__ __forceinline__ void ph_gemm_bf16(const bf16_t* A, int lda, const bf16_t* Wt, int ldw, int M, int N, int K,
                                             char* lds, Epi epi) {
  const int ntm = M / 128, ntn = N / 128;
  const int npm = (ntm + 7) / 8, npn = (ntn + 7) / 8;
  const int nslots = ((npm * npn * 64 + 511) / 512) * 512;
  for (int u = blockIdx.x; u < nslots; u += gridDim.x) {
    int v = (u & 7) * 64 + ((u >> 3) & 63) + (u & ~511);
    int patch = v >> 6, w = v & 63;
    int tm = (patch % npm) * 8 + (w & 7);
    int tn = (patch / npm) * 8 + (w >> 3);
    if (tm >= ntm || tn >= ntn) continue;
    const int m0 = tm * 128, n0 = tn * 128;
    gemm_tile_bf16(A + (size_t)m0 * lda, lda, Wt + (size_t)n0 * ldw, ldw, K, lds,
                   [&](int r, int c, float val) { epi(m0 + r, n0 + c, val); });
  }
}

__device__ void ph_compress(const P& p, float* smem) {
  float* red = smem;
  float* c1 = smem + 256;
  int tid = threadIdx.x, n = tid & 127, half = tid >> 7;
  for (int item = blockIdx.x; item < 2 * 8 * 127; item += gridDim.x) {
    int which = item / (8 * 127);
    int rem = item % (8 * 127);
    int bg = rem / 127, i = rem % 127;
    int b = bg >> 1, g = bg & 1;
    const float* src = p.proj + (size_t)(b * SEQ + 16 * i) * INC + (which ? C_VC : C_KC) + g * 128;
    const float* pos = which ? p.pos_v : p.pos_k;
    const float* w1 = which ? p.w1_v : p.w1_k;
    const float* w2 = which ? p.w2_v : p.w2_k;
    float acc = 0.f;
    for (int l = half * 16; l < half * 16 + 16; ++l) {
      const float* sr = src + (size_t)l * INC;
      const float* pr = pos + l * 128;
      const float* wr = w1 + (size_t)l * 128 * 128 + n;
      for (int d = 0; d < 128; ++d) acc += (sr[d] + pr[d]) * wr[(size_t)d * 128];
    }
    red[tid] = acc;
    __syncthreads();
    if (half == 0) c1[n] = gelu_tanh(red[n] + red[128 + n]);
    __syncthreads();
    if (half == 0) {
      float o = 0.f;
      for (int j = 0; j < 128; ++j) o += c1[j] * w2[j * 128 + n];
      float* dst = which ? p.vc : p.kc;
      dst[((size_t)bg * 128 + i) * 128 + n] = o;
    }
    __syncthreads();
  }
}

struct OS { float m, l, o0, o1; };

template <class F>
__device__ __forceinline__ void attn_chunk(OS& st, const float* qs, const float* Kp, const float* Vp, size_t stride,
                                           int s0, int smax, F f) {
  int lane = threadIdx.x & 63;
  int s = s0 + lane;
  bool valid = false;
  float bias = 0.f;
  if (s >= 0 && s < smax) valid = f(s, bias);
  float logit = -INFINITY;
  if (valid) {
    const float4* kr = (const float4*)(Kp + (size_t)s * stride);
    const float4* q4 = (const float4*)qs;
    float acc = 0.f;
#pragma unroll 4
    for (int i = 0; i < 32; ++i) {
      float4 kv = kr[i];
      float4 qv = q4[i];
      acc += kv.x * qv.x + kv.y * qv.y + kv.z * qv.z + kv.w * qv.w;
    }
    logit = acc * ATT_SCALE + bias;
  }
  float cm = wave_max(logit);
  if (cm == -INFINITY) return;
  float mn = fmaxf(st.m, cm);
  float alpha = expf(st.m - mn);
  float pr = valid ? expf(logit - mn) : 0.f;
  st.l = st.l * alpha + wave_sum(pr);
  st.o0 *= alpha;
  st.o1 *= alpha;
  st.m = mn;
  for (int j = 0; j < 64; ++j) {
    float pj = __shfl(pr, j);
    if (pj != 0.f) {
      const float* vr = Vp + (size_t)(s0 + j) * stride;
      st.o0 += pj * vr[lane];
      st.o1 += pj * vr[lane + 64];
    }
  }
}

__device__ void ph_nsa(const P& p, float* smem) {
  int lane = threadIdx.x & 63, wv = threadIdx.x >> 6;
  float* q = smem + wv * 512;
  float* ocm = smem + 2048 + wv * 512;
  float* pbuf = smem + 4096 + wv * 128;
  float* kbuf = smem + 4608 + wv * 64;
  for (int item = blockIdx.x; item < NBATCH * 2 * (SEQ / 4); item += gridDim.x) {
    int t = (item % (SEQ / 4)) * 4 + wv;
    int bg = item / (SEQ / 4);
    int b = bg >> 1, g = bg & 1;
    const float* prow = p.proj + (size_t)(b * SEQ + t) * INC;
    for (int i = 0; i < 8; ++i) q[lane + 64 * i] = prow[C_QN + g * 512 + lane + 64 * i];
    __builtin_amdgcn_wave_barrier();
    const float* kcb = p.kc + (size_t)bg * 128 * 128;
    const float* vcb = p.vc + (size_t)bg * 128 * 128;
    float psum0 = 0.f, psum1 = 0.f;
    for (int r = 0; r < 4; ++r) {
      int h = g * 4 + r;
      float lg[2];
      bool vd[2];
      for (int u = 0; u < 2; ++u) {
        int c = lane + 64 * u;
        int dist = t - (16 * c + 31);
        vd[u] = (c < 127) && (dist >= 0);
        lg[u] = -INFINITY;
        if (vd[u]) {
          const float4* kr = (const float4*)(kcb + (size_t)c * 128);
          const float4* q4 = (const float4*)(q + r * 128);
          float acc = 0.f;
#pragma unroll 4
          for (int i = 0; i < 32; ++i) {
            float4 kv = kr[i];
            float4 qv = q4[i];
            acc += kv.x * qv.x + kv.y * qv.y + kv.z * qv.z + kv.w * qv.w;
          }
          lg[u] = acc * ATT_SCALE + p.t5[t5_bucket(dist) * 8 + h];
        }
      }
      float m = wave_max(fmaxf(lg[0], lg[1]));
      float e0 = vd[0] ? expf(lg[0] - m) : 0.f;
      float e1 = vd[1] ? expf(lg[1] - m) : 0.f;
      float sum = wave_sum(e0 + e1);
      float inv = 1.f / fmaxf(sum, 1e-20f);
      float p0 = e0 * inv, p1 = e1 * inv;
      psum0 += p0;
      psum1 += p1;
      float o0 = 0.f, o1 = 0.f;
      int cmax = (t >= 31) ? (t - 31) / 16 : -1;
      if (cmax > 126) cmax = 126;
      for (int c = 0; c <= cmax; ++c) {
        float pc = (c < 64) ? __shfl(p0, c) : __shfl(p1, c - 64);
        const float* vr = vcb + (size_t)c * 128;
        o0 += pc * vr[lane];
        o1 += pc * vr[lane + 64];
      }
      ocm[r * 128 + lane] = o0;
      ocm[r * 128 + lane + 64] = o1;
    }
    pbuf[lane] = psum0;
    pbuf[lane + 64] = (lane + 64 < 127) ? psum1 : 0.f;
    __builtin_amdgcn_wave_barrier();
    int cur = t >> 6;
    float key = -3e9f;
    bool allowed = false;
    if (lane < 32) {
      int j = lane;
      float imp = pbuf[4 * j] + pbuf[4 * j + 1] + pbuf[4 * j + 2] + 0.5f * pbuf[4 * j + 3];
      if (j > 0) imp += 0.5f * pbuf[4 * j - 1];
      bool forced = (j == 0) || (j == cur) || (j == cur - 1);
      allowed = (j <= cur);
      key = forced ? 1e9f : (allowed ? imp : -1e9f);
      kbuf[j] = key;
    }
    __builtin_amdgcn_wave_barrier();
    bool sel = false;
    if (lane < 32) {
      int rank = 0;
      for (int i = 0; i < 32; ++i) {
        float ki = kbuf[i];
        rank += (ki > key || (ki == key && i < lane)) ? 1 : 0;
      }
      sel = (rank < 16) && allowed;
    }
    unsigned long long bal = __ballot(sel);
    unsigned selmask = (unsigned)(bal & 0xffffffffull);
    __builtin_amdgcn_wave_barrier();
    const float* Ks = p.proj + (size_t)(b * SEQ) * INC + C_KS + g * 128;
    const float* Vs = p.proj + (size_t)(b * SEQ) * INC + C_VS + g * 128;
    const float* Kw = p.proj + (size_t)(b * SEQ) * INC + C_KW + g * 128;
    const float* Vw = p.proj + (size_t)(b * SEQ) * INC + C_VW + g * 128;
    for (int r = 0; r < 4; ++r) {
      int h = g * 4 + r;
      const float* t5h = p.t5 + h;
      OS ss = {-INFINITY, 0.f, 0.f, 0.f};
      for (int j = 0; j <= cur; ++j) {
        if (!((selmask >> j) & 1u)) continue;
        attn_chunk(ss, q + r * 128, Ks, Vs, (size_t)INC, j * 64, SEQ, [&](int s, float& bias) {
          int dist = t - s;
          if (dist < 0) return false;
          bias = t5h[t5_bucket(dist) * 8];
          return true;
        });
      }
      OS sw = {-INFINITY, 0.f, 0.f, 0.f};
      for (int s0 = (t & ~63); s0 >= 0 && s0 + 63 >= t - 511; s0 -= 64) {
        attn_chunk(sw, q + r * 128, Kw, Vw, (size_t)INC, s0, SEQ, [&](int s, float& bias) {
          int dist = t - s;
          if (dist < 0 || dist >= 512) return false;
          bias = t5h[t5_bucket(dist) * 8];
          return true;
        });
      }
      float isl = 1.f / fmaxf(ss.l, 1e-20f), iwl = 1.f / fmaxf(sw.l, 1e-20f);
      float g0 = 1.f / (1.f + expf(-prow[C_GT + h * 3 + 0]));
      float g1 = 1.f / (1.f + expf(-prow[C_GT + h * 3 + 1]));
      float g2 = 1.f / (1.f + expf(-prow[C_GT + h * 3 + 2]));
      bf16_t* orow = p.omix + (size_t)(b * SEQ + t) * DM + h * 128;
      orow[lane] = f2bf(g0 * ocm[r * 128 + lane] + g1 * ss.o0 * isl + g2 * sw.o0 * iwl);
      orow[lane + 64] = f2bf(g0 * ocm[r * 128 + lane + 64] + g1 * ss.o1 * isl + g2 * sw.o1 * iwl);
    }
    __builtin_amdgcn_wave_barrier();
  }
}

__device__ void ph_sb(const P& p, float* smem) {
  int lane = threadIdx.x & 63, wv = threadIdx.x >> 6;
  float* q = smem + wv * 128;
  for (int item = blockIdx.x; item < NBATCH * 8 * (SEQ / 4); item += gridDim.x) {
    int t = (item % (SEQ / 4)) * 4 + wv;
    int bh = item / (SEQ / 4);
    int b = bh >> 3, h = bh & 7;
    const float* prow = p.proj + (size_t)(b * SEQ + t) * INC;
    q[lane] = prow[C_QSB + h * 128 + lane];
    q[lane + 64] = prow[C_QSB + h * 128 + lane + 64];
    __builtin_amdgcn_wave_barrier();
    const float* Kb = p.proj + (size_t)(b * SEQ) * INC + C_KSB + h * 128;
    const float* Vb = p.proj + (size_t)(b * SEQ) * INC + C_VSB + h * 128;
    float carry = 0.f, o0 = 0.f, o1 = 0.f;
    if (t > 0) {
      for (int s0 = ((t - 1) & ~63); s0 >= 0; s0 -= 64) {
        int s = s0 + lane;
        bool valid = s < t;
        float z = 0.f;
        if (valid) {
          const float4* kr = (const float4*)(Kb + (size_t)s * INC);
          const float4* q4 = (const float4*)q;
          float acc = 0.f;
#pragma unroll 4
          for (int i = 0; i < 32; ++i) {
            float4 kv = kr[i];
            float4 qv = q4[i];
            acc += kv.x * qv.x + kv.y * qv.y + kv.z * qv.z + kv.w * qv.w;
          }
          z = acc * ATT_SCALE;
        }
        float lsp = log_sigmoid(z);
        float lf = valid ? (lsp - z) : 0.f;
        float incl = lf;
        for (int o = 1; o < 64; o <<= 1) {
          float v = __shfl_down(incl, o);
          if (lane + o < 64) incl += v;
        }
        float after = carry + incl - lf;
        float w = valid ? expf(lsp + after) : 0.f;
        carry += __shfl(incl, 0);
        for (int j = 0; j < 64; ++j) {
          float wj = __shfl(w, j);
          if (wj != 0.f) {
            const float* vr = Vb + (size_t)(s0 + j) * INC;
            o0 += wj * vr[lane];
            o1 += wj * vr[lane + 64];
          }
        }
      }
    }
    bf16_t* orow = p.omix + (size_t)(b * SEQ + t) * DM + 1024 + h * 128;
    orow[lane] = f2bf(o0);
    orow[lane + 64] = f2bf(o1);
    __builtin_amdgcn_wave_barrier();
  }
}

__device__ void ph_memattn(const P& p, float* smem) {
  int lane = threadIdx.x & 63, wv = threadIdx.x >> 6;
  float* q = smem + wv * 128;
  for (int item = blockIdx.x; item < NBATCH * 4 * (SEQ / 4); item += gridDim.x) {
    int t = (item % (SEQ / 4)) * 4 + wv;
    int bh = item / (SEQ / 4);
    int b = bh >> 2, h = bh & 3;
    const float* qrow = p.qmem + (size_t)(b * SEQ + t) * 512 + h * 128;
    q[lane] = qrow[lane];
    q[lane + 64] = qrow[lane + 64];
    __builtin_amdgcn_wave_barrier();
    const float* Kb = p.kmem + (size_t)(b * 256) * 512 + h * 128;
    const float* Vb = p.vmem + (size_t)(b * 256) * 512 + h * 128;
    OS st = {-INFINITY, 0.f, 0.f, 0.f};
    for (int s0 = 0; s0 < 256; s0 += 64)
      attn_chunk(st, q, Kb, Vb, (size_t)512, s0, 256, [&](int s, float& bias) {
        bias = 0.f;
        return true;
      });
    float il = 1.f / st.l;
    bf16_t* orow = p.omem + (size_t)(b * SEQ + t) * 512 + h * 128;
    orow[lane] = f2bf(st.o0 * il);
    orow[lane + 64] = f2bf(st.o1 * il);
    __builtin_amdgcn_wave_barrier();
  }
}

__device__ void ph_peer(const P& p, float* smem) {
  int lane = threadIdx.x & 63, wv = threadIdx.x >> 6;
  float* q = smem + wv * 2048;
  float* ts = smem + 8192 + wv * 256;
  int* ti = (int*)(smem + 9216) + wv * 256;
  float* bgt = smem + 10240 + wv * 128;
  int* bex = (int*)(smem + 10752) + wv * 128;
  const float* qp = p.proj;
  for (int item = blockIdx.x; item < T_TOK / 4; item += gridDim.x) {
    int t = item * 4 + wv;
    {
      const float4* s4 = (const float4*)(qp + (size_t)t * DM);
      float4* d4 = (float4*)q;
      for (int i = 0; i < 8; ++i) d4[i * 64 + lane] = s4[i * 64 + lane];
    }
    __builtin_amdgcn_wave_barrier();
    for (int hp = 0; hp < 16; ++hp) {
      float sc[2];
      for (int u = 0; u < 2; ++u) {
        int k = lane + 64 * u;
        const float4* kr = (const float4*)(p.subk + ((size_t)hp * 128 + k) * 128);
        const float4* q4 = (const float4*)(q + hp * 128);
        float acc = 0.f;
#pragma unroll 4
        for (int i = 0; i < 32; ++i) {
          float4 kv = kr[i];
          float4 qv = q4[i];
          acc += kv.x * qv.x + kv.y * qv.y + kv.z * qv.z + kv.w * qv.w;
        }
        sc[u] = acc;
      }
      for (int n = 0; n < 16; ++n) {
        float v;
        int i;
        if (sc[0] >= sc[1]) { v = sc[0]; i = lane; } else { v = sc[1]; i = lane + 64; }
        wave_argmax(v, i);
        if (lane == 0) { ts[hp * 16 + n] = v; ti[hp * 16 + n] = i; }
        if (i == lane) sc[0] = -INFINITY;
        if (i == lane + 64) sc[1] = -INFINITY;
      }
    }
    __builtin_amdgcn_wave_barrier();
    for (int h = 0; h < 8; ++h) {
      float cv[4];
      for (int m = 0; m < 4; ++m) {
        int c = m * 64 + lane;
        cv[m] = ts[(2 * h) * 16 + (c >> 4)] + ts[(2 * h + 1) * 16 + (c & 15)];
      }
      float mybest = 0.f;
      int myc = 0;
      for (int n = 0; n < 16; ++n) {
        float v = cv[0];
        int i = lane;
        for (int m = 1; m < 4; ++m)
          if (cv[m] > v) { v = cv[m]; i = m * 64 + lane; }
        wave_argmax(v, i);
        if (lane == n) { mybest = v; myc = i; }
        for (int m = 0; m < 4; ++m)
          if (i == m * 64 + lane) cv[m] = -INFINITY;
      }
      float sv = (lane < 16) ? mybest : -INFINITY;
      float mx = wave_max(sv);
      float e = (lane < 16) ? expf(sv - mx) : 0.f;
      float sum = wave_sum(e);
      if (lane < 16) {
        bgt[h * 16 + lane] = e / sum;
        bex[h * 16 + lane] = ti[(2 * h) * 16 + (myc >> 4)] * 128 + ti[(2 * h + 1) * 16 + (myc & 15)];
      }
    }
    __builtin_amdgcn_wave_barrier();
    float4 xv[8], acc[8];
    {
      const float4* s4 = (const float4*)(p.out + (size_t)t * DM);
      const float4* g4 = (const float4*)p.norm_ffn;
      float ss = 0.f;
#pragma unroll
      for (int i = 0; i < 8; ++i) {
        xv[i] = s4[i * 64 + lane];
        ss += xv[i].x * xv[i].x + xv[i].y * xv[i].y + xv[i].z * xv[i].z + xv[i].w * xv[i].w;
        acc[i] = make_float4(0, 0, 0, 0);
      }
      ss = wave_sum(ss);
      float rs = rsqrtf(ss * (1.f / DM) + RMS_EPS);
#pragma unroll
      for (int i = 0; i < 8; ++i) {
        float4 g = g4[i * 64 + lane];
        xv[i].x *= rs * g.x; xv[i].y *= rs * g.y; xv[i].z *= rs * g.z; xv[i].w *= rs * g.w;
      }
    }
    for (int e = 0; e < 128; ++e) {
      int eid = bex[e];
      float gt = bgt[e];
      const float4* ur = (const float4*)(p.pu + (size_t)eid * DM);
      float part = 0.f;
#pragma unroll
      for (int i = 0; i < 8; ++i) {
        float4 u = ur[i * 64 + lane];
        part += u.x * xv[i].x + u.y * xv[i].y + u.z * xv[i].z + u.w * xv[i].w;
      }
      float a = wave_sum(part);
      float hid = gt * gelu_tanh(a);
      const float4* vr = (const float4*)(p.pv + (size_t)eid * DM);
#pragma unroll
      for (int i = 0; i < 8; ++i) {
        float4 v = vr[i * 64 + lane];
        acc[i].x += hid * v.x; acc[i].y += hid * v.y; acc[i].z += hid * v.z; acc[i].w += hid * v.w;
      }
    }
    float4* o4 = (float4*)(p.out + (size_t)t * DM);
    float ss = 0.f;
#pragma unroll
    for (int i = 0; i < 8; ++i) {
      float4 hv = o4[i * 64 + lane];
      acc[i].x += hv.x; acc[i].y += hv.y; acc[i].z += hv.z; acc[i].w += hv.w;
      ss += acc[i].x * acc[i].x + acc[i].y * acc[i].y + acc[i].z * acc[i].z + acc[i].w * acc[i].w;
    }
    ss = wave_sum(ss);
    float rs = rsqrtf(ss * (1.f / DM) + RMS_EPS);
    const float4* g4 = (const float4*)p.norm_final;
#pragma unroll
    for (int i = 0; i < 8; ++i) {
      float4 g = g4[i * 64 + lane];
      float4 o;
      o.x = acc[i].x * rs * g.x; o.y = acc[i].y * rs * g.y; o.z = acc[i].z * rs * g.z; o.w = acc[i].w * rs * g.w;
      o4[i * 64 + lane] = o;
    }
    __builtin_amdgcn_wave_barrier();
  }
}

typedef const __attribute__((address_space(4))) P* KP;
__device__ __forceinline__ P loadP() {
#if defined(__HIP_DEVICE_COMPILE__)
  KP k = (KP)__builtin_amdgcn_kernarg_segment_ptr();
  asm volatile("" : "+s"(k));
  P p = *k;
  return p;
#else
  return P{};
#endif
}

__global__ void __launch_bounds__(256, 2) mega(P p_arg) {
  cg::grid_group grid = cg::this_grid();
  __shared__ __attribute__((aligned(16))) float smem[12288];
  char* lds = (char*)smem;
  { P p = loadP(); ph_rmsnorm(p.x, p.norm_mix, p.hn, T_TOK); ph_rmsnorm(p.mem, p.norm_mkv, p.memn, 1024); }
  { P p = loadP(); ph_transpose(smem, p.w_in, DM, INC, 5760, p.WinT); }
  { P p = loadP(); ph_transpose(smem, p.w_out, DM, DM, DM, p.WoutT); }
  { P p = loadP(); ph_transpose(smem, p.w_pq, DM, DM, DM, p.WpqT); }
  { P p = loadP(); ph_transpose(smem, p.w_mq, DM, 512, 512, p.WmqT); }
  { P p = loadP(); ph_transpose(smem, p.w_mk, DM, 512, 512, p.WmkT); }
  { P p = loadP(); ph_transpose(smem, p.w_mv, DM, 512, 512, p.WmvT); }
  { P p = loadP(); ph_transpose(smem, p.w_mo, 512, DM, DM, p.WmoT); }
  grid.sync();
  { P p = loadP(); float* proj = p.proj;
    ph_gemm_bf16(p.hn, DM, p.WinT, DM, T_TOK, 5760, DM, lds, [=](int m, int n, float v) { if (n < INC) proj[(size_t)m * INC + n] = v; }); }
  { P p = loadP(); float* kmem = p.kmem;
    ph_gemm_bf16(p.memn, DM, p.WmkT, DM, 1024, 512, DM, lds, [=](int m, int n, float v) { kmem[(size_t)m * 512 + n] = v; }); }
  { P p = loadP(); float* vmem = p.vmem;
    ph_gemm_bf16(p.memn, DM, p.WmvT, DM, 1024, 512, DM, lds, [=](int m, int n, float v) { vmem[(size_t)m * 512 + n] = v; }); }
  grid.sync();
  { P p = loadP(); ph_compress(p, smem); }
  { P p = loadP(); ph_sb(p, smem); }
  grid.sync();
  { P p = loadP(); ph_nsa(p, smem); }
  grid.sync();
  { P p = loadP(); float* out = p.out; const float* x = p.x;
    ph_gemm_bf16(p.omix, DM, p.WoutT, DM, T_TOK, DM, DM, lds, [=](int m, int n, float v) { out[(size_t)m * DM + n] = x[(size_t)m * DM + n] + v; }); }
  grid.sync();
  { P p = loadP(); ph_rmsnorm(p.out, p.norm_mq, p.hn, T_TOK); }
  grid.sync();
  { P p = loadP(); float* qmem = p.qmem;
    ph_gemm_bf16(p.hn, DM, p.WmqT, DM, T_TOK, 512, DM, lds, [=](int m, int n, float v) { qmem[(size_t)m * 512 + n] = v; }); }
  grid.sync();
  { P p = loadP(); ph_memattn(p, smem); }
  grid.sync();
  { P p = loadP(); float* out = p.out;
    ph_gemm_bf16(p.omem, 512, p.WmoT, 512, T_TOK, DM, 512, lds, [=](int m, int n, float v) { out[(size_t)m * DM + n] += v; }); }
  grid.sync();
  { P p = loadP(); ph_rmsnorm(p.out, p.norm_ffn, p.hn, T_TOK); }
  grid.sync();
  { P p = loadP(); float* qp = p.proj;
    ph_gemm_bf16(p.hn, DM, p.WpqT, DM, T_TOK, DM, DM, lds, [=](int m, int n, float v) { qp[(size_t)m * DM + n] = v; }); }
  grid.sync();
  { P p = loadP(); ph_peer(p, smem); }
}

extern "C" void kernel_launch(void* const* d_in, const int* in_sizes, int n_in, void* d_out, int out_size, void* d_ws,
                              size_t ws_size, hipStream_t stream) {
  P p{};
  p.x = (const float*)d_in[0]; p.mem = (const float*)d_in[1]; p.t5 = (const float*)d_in[2];
  p.norm_mix = (const float*)d_in[3]; p.w_in = (const float*)d_in[4]; p.pos_k = (const float*)d_in[5];
  p.w1_k = (const float*)d_in[6]; p.w2_k = (const float*)d_in[7]; p.pos_v = (const float*)d_in[8];
  p.w1_v = (const float*)d_in[9]; p.w2_v = (const float*)d_in[10]; p.w_out = (const float*)d_in[11];
  p.norm_mq = (const float*)d_in[12]; p.norm_mkv = (const float*)d_in[13]; p.w_mq = (const float*)d_in[14];
  p.w_mk = (const float*)d_in[15]; p.w_mv = (const float*)d_in[16]; p.w_mo = (const float*)d_in[17];
  p.norm_ffn = (const float*)d_in[18]; p.w_pq = (const float*)d_in[19]; p.subk = (const float*)d_in[20];
  p.pu = (const float*)d_in[21]; p.pv = (const float*)d_in[22]; p.norm_final = (const float*)d_in[23];
  p.out = (float*)d_out;
  char* w = (char*)d_ws;
  size_t off = 0;
  auto take = [&](size_t bytes) { char* r = w + off; off += (bytes + 255) & ~(size_t)255; return r; };
  p.proj = (float*)take((size_t)T_TOK * INC * 4);
  p.kc = (float*)take(8 * 128 * 128 * 4);
  p.vc = (float*)take(8 * 128 * 128 * 4);
  p.kmem = (float*)take(1024 * 512 * 4);
  p.vmem = (float*)take(1024 * 512 * 4);
  p.qmem = (float*)take((size_t)T_TOK * 512 * 4);
  p.hn = (bf16_t*)take((size_t)T_TOK * DM * 2);
  p.omix = (bf16_t*)take((size_t)T_TOK * DM * 2);
  p.memn = (bf16_t*)take((size_t)1024 * DM * 2);
  p.omem = (bf16_t*)take((size_t)T_TOK * 512 * 2);
  p.WinT = (bf16_t*)take((size_t)5760 * DM * 2);
  p.WoutT = (bf16_t*)take((size_t)DM * DM * 2);
  p.WpqT = (bf16_t*)take((size_t)DM * DM * 2);
  p.WmqT = (bf16_t*)take((size_t)512 * DM * 2);
  p.WmkT = (bf16_t*)take((size_t)512 * DM * 2);
  p.WmvT = (bf16_t*)take((size_t)512 * DM * 2);
  p.WmoT = (bf16_t*)take((size_t)DM * 512 * 2);
  static int grid_blocks = 0;
  if (!grid_blocks) {
    int dev = 0, cus = 0, per_cu = 0;
    (void)hipGetDevice(&dev);
    (void)hipDeviceGetAttribute(&cus, hipDeviceAttributeMultiprocessorCount, dev);
    (void)hipOccupancyMaxActiveBlocksPerMultiprocessor(&per_cu, mega, 256, 0);
    if (per_cu > 2) per_cu = 2;
    if (per_cu < 1) per_cu = 1;
    grid_blocks = cus * per_cu;
  }
  void* args[] = {&p};
  hipError_t e = hipLaunchCooperativeKernel((void*)mega, dim3(grid_blocks), dim3(256), args, 0, stream);
  if (e != hipSuccess) fprintf(stderr, "cooperative launch failed: %s (grid %d)\n", hipGetErrorString(e), grid_blocks);
}
```

```cpp
#include <hip/hip_runtime.h>
#include <hip/hip_cooperative_groups.h>
#include <cstdio>
namespace cg = cooperative_groups;
#include <stdint.h>

#define SEQ 2048
#define NBATCH 4
#define T_TOK 8192
#define DM 2048
#define INC 5656
#define C_QN 0
#define C_KC 1024
#define C_VC 1280
#define C_KS 1536
#define C_VS 1792
#define C_KW 2048
#define C_VW 2304
#define C_GT 2560
#define C_QSB 2584
#define C_KSB 3608
#define C_VSB 4632
#define ATT_SCALE 0.08838834764831845f
#define RMS_EPS 1e-6f

typedef unsigned short bf16_t;
typedef __attribute__((ext_vector_type(8))) short bf16x8;
typedef __attribute__((ext_vector_type(16))) float f32x16;
typedef __attribute__((ext_vector_type(2))) __bf16 bf16v2;
typedef __attribute__((ext_vector_type(4))) unsigned u32x4;

struct P {
  const float *x, *mem, *t5, *norm_mix, *w_in, *pos_k, *w1_k, *w2_k, *pos_v, *w1_v, *w2_v, *w_out,
      *norm_mq, *norm_mkv, *w_mq, *w_mk, *w_mv, *w_mo, *norm_ffn, *w_pq, *subk, *pu, *pv, *norm_final;
  float* out;
  float *proj, *kc, *vc, *kmem, *vmem, *qmem;
  bf16_t *hn, *omix, *memn, *omem;
  bf16_t *WinT, *WoutT, *WpqT, *WmqT, *WmkT, *WmvT, *WmoT;
  bf16_t *qmemb, *kmemb, *vmemT;
  bf16_t *qsb, *ksb, *vsbT;
};

__device__ __forceinline__ unsigned pack2(float a, float b) {
  bf16v2 r = {(__bf16)a, (__bf16)b};
  return *(unsigned*)&r;
}
__device__ __forceinline__ bf16_t f2bf(float a) {
  __bf16 r = (__bf16)a;
  return *(bf16_t*)&r;
}
__device__ __forceinline__ int perm16(int s) { return (s & ~12) | ((s & 4) << 1) | ((s & 8) >> 1); }
__device__ __forceinline__ float bf2f(bf16_t u) { return __uint_as_float((unsigned)u << 16); }

__device__ __forceinline__ float wave_max(float v) {
  for (int o = 32; o > 0; o >>= 1) v = fmaxf(v, __shfl_xor(v, o));
  return v;
}
__device__ __forceinline__ float wave_sum(float v) {
  for (int o = 32; o > 0; o >>= 1) v += __shfl_xor(v, o);
  return v;
}
__device__ __forceinline__ void wave_argmax(float& v, int& i) {
  for (int o = 32; o > 0; o >>= 1) {
    float ov = __shfl_xor(v, o);
    int oi = __shfl_xor(i, o);
    if (ov > v || (ov == v && oi < i)) { v = ov; i = oi; }
  }
}
__device__ __forceinline__ float gelu_tanh(float x) {
  return 0.5f * x * (1.f + tanhf(0.7978845608028654f * (x + 0.044715f * x * x * x)));
}
__device__ __forceinline__ int t5_bucket(int n) {
  if (n < 16) return n < 0 ? 0 : n;
  int b = 16;
  b += (n >= 19); b += (n >= 21); b += (n >= 24); b += (n >= 27); b += (n >= 31); b += (n >= 35);
  b += (n >= 40); b += (n >= 46); b += (n >= 52); b += (n >= 59); b += (n >= 67); b += (n >= 77);
  b += (n >= 87); b += (n >= 99); b += (n >= 113);
  return b;
}
__device__ __forceinline__ float log_sigmoid(float x) {
  return fminf(x, 0.f) - log1pf(expf(-fabsf(x)));
}

__device__ void ph_rmsnorm(const float* src, const float* gain, bf16_t* dst, int rows) {
  int lane = threadIdx.x & 63, wv = threadIdx.x >> 6;
  for (int r = blockIdx.x * 4 + wv; r < rows; r += gridDim.x * 4) {
    const float4* s4 = (const float4*)(src + (size_t)r * DM);
    float4 v[8];
    float ss = 0.f;
#pragma unroll
    for (int i = 0; i < 8; ++i) {
      v[i] = s4[i * 64 + lane];
      ss += v[i].x * v[i].x + v[i].y * v[i].y + v[i].z * v[i].z + v[i].w * v[i].w;
    }
    ss = wave_sum(ss);
    float rs = rsqrtf(ss * (1.f / DM) + RMS_EPS);
    uint2* d2 = (uint2*)(dst + (size_t)r * DM);
    const float4* g4 = (const float4*)gain;
#pragma unroll
    for (int i = 0; i < 8; ++i) {
      float4 g = g4[i * 64 + lane];
      uint2 o;
      o.x = pack2(v[i].x * rs * g.x, v[i].y * rs * g.y);
      o.y = pack2(v[i].z * rs * g.z, v[i].w * rs * g.w);
      d2[i * 64 + lane] = o;
    }
  }
}

template <bool CMAP>
__device__ void ph_transpose(float* smem, const float* W, int K, int N, int Npad, bf16_t* Wt) {
  float (*tl)[65] = (float (*)[65])smem;
  int tid = threadIdx.x;
  int nk = K / 64, nn = Npad / 64;
  for (int tile = blockIdx.x; tile < nk * nn; tile += gridDim.x) {
    int k0 = (tile % nk) * 64, n0 = (tile / nk) * 64;
    int col = tid & 63, rb = tid >> 6;
#pragma unroll 4
    for (int pp = 0; pp < 16; ++pp) {
      int k = pp * 4 + rb;
      float v = 0.f;
      int sc = n0 + col;
      if (CMAP) sc = (sc < 2560) ? sc : (sc < 5632) ? sc + 24 : (sc < 5656) ? sc - 5632 + 2560 : N;
      if (sc < N) v = W[(size_t)(k0 + k) * N + sc];
      tl[k][col] = v;
    }
    __syncthreads();
    int n = tid >> 2, kc = (tid & 3) * 16;
    unsigned w[8];
#pragma unroll
    for (int i = 0; i < 8; ++i) w[i] = pack2(tl[kc + 2 * i][n], tl[kc + 2 * i + 1][n]);
    uint4* dst = (uint4*)(Wt + (size_t)(n0 + n) * K + k0 + kc);
    dst[0] = make_uint4(w[0], w[1], w[2], w[3]);
    dst[1] = make_uint4(w[4], w[5], w[6], w[7]);
    __syncthreads();
  }
}

__device__ __forceinline__ int lds_off(int row, int chunk) { return row * 128 + ((chunk ^ ((row >> 1) & 7)) << 4); }

template <bool TR, class Epi>
__device__ __forceinline__ void gemm_tile_bf16(const bf16_t* xp, int ldx, const bf16_t* yp, int ldy, int K, char* lds,
                                               Epi epi) {
  const int tid = threadIdx.x, lane = tid & 63, wv = tid >> 6;
  const int wr = wv >> 1, wc = wv & 1;
  char* lx = lds;
  char* ly = lds + 16384;
  f32x16 acc[2][2];
#pragma unroll
  for (int i = 0; i < 2; ++i)
#pragma unroll
    for (int j = 0; j < 2; ++j)
#pragma unroll
      for (int r = 0; r < 16; ++r) acc[i][j][r] = 0.f;
  const int srow = tid >> 3, sch = tid & 7;
  const bf16_t* xg = xp + (size_t)srow * ldx + sch * 8;
  const bf16_t* yg = yp + (size_t)srow * ldy + sch * 8;
  const size_t x32 = (size_t)32 * ldx, y32 = (size_t)32 * ldy;
  uint4 sx0 = *(const uint4*)(xg), sx1 = *(const uint4*)(xg + x32), sx2 = *(const uint4*)(xg + 2 * x32),
        sx3 = *(const uint4*)(xg + 3 * x32);
  uint4 sy0 = *(const uint4*)(yg), sy1 = *(const uint4*)(yg + y32), sy2 = *(const uint4*)(yg + 2 * y32),
        sy3 = *(const uint4*)(yg + 3 * y32);
  const int so0 = lds_off(srow, sch), so1 = lds_off(32 + srow, sch), so2 = lds_off(64 + srow, sch),
            so3 = lds_off(96 + srow, sch);
  for (int k0 = 0; k0 < K; k0 += 64) {
    __syncthreads();
    *(uint4*)(lx + so0) = sx0; *(uint4*)(lx + so1) = sx1; *(uint4*)(lx + so2) = sx2; *(uint4*)(lx + so3) = sx3;
    *(uint4*)(ly + so0) = sy0; *(uint4*)(ly + so1) = sy1; *(uint4*)(ly + so2) = sy2; *(uint4*)(ly + so3) = sy3;
    __syncthreads();
    if (k0 + 64 < K) {
      const bf16_t* xn = xg + k0 + 64;
      const bf16_t* yn = yg + k0 + 64;
      sx0 = *(const uint4*)(xn); sx1 = *(const uint4*)(xn + x32); sx2 = *(const uint4*)(xn + 2 * x32);
      sx3 = *(const uint4*)(xn + 3 * x32);
      sy0 = *(const uint4*)(yn); sy1 = *(const uint4*)(yn + y32); sy2 = *(const uint4*)(yn + 2 * y32);
      sy3 = *(const uint4*)(yn + 3 * y32);
    }
#pragma unroll
    for (int kk = 0; kk < 4; ++kk) {
      bf16x8 a[2], b[2];
      const int ch = kk * 2 + (lane >> 5);
#pragma unroll
      for (int i = 0; i < 2; ++i) {
        a[i] = *(const bf16x8*)((TR ? ly : lx) + lds_off(wr * 64 + i * 32 + (lane & 31), ch));
        b[i] = *(const bf16x8*)((TR ? lx : ly) + lds_off(wc * 64 + i * 32 + (lane & 31), ch));
      }
#pragma unroll
      for (int i = 0; i < 2; ++i)
#pragma unroll
        for (int j = 0; j < 2; ++j) acc[i][j] = __builtin_amdgcn_mfma_f32_32x32x16_bf16(a[i], b[j], acc[i][j], 0, 0, 0);
    }
  }
  int lane2 = lane;
  asm volatile("" : "+v"(lane2));
#pragma unroll
  for (int i = 0; i < 2; ++i)
#pragma unroll
    for (int j = 0; j < 2; ++j)
#pragma unroll
      for (int r = 0; r < 16; ++r) {
        int rr = wr * 64 + i * 32 + (r & 3) + 8 * (r >> 2) + 4 * (lane2 >> 5);
        int cc = wc * 64 + j * 32 + (lane2 & 31);
        epi(rr, cc, acc[i][j][r]);
      }
}

template <class Epi>
__device__ __forceinline__ void ph_gemm_bf16(const bf16_t* A, int lda, const bf16_t* Wt, int ldw, int M, int N, int K,
                                             char* lds, Epi epi) {
  const int ntm = M / 128, ntn = N / 128;
  const int npm = (ntm + 7) / 8, npn = (ntn + 7) / 8;
  const int nslots = ((npm * npn * 64 + 511) / 512) * 512;
  for (int u = blockIdx.x; u < nslots; u += gridDim.x) {
    int v = (u & 7) * 64 + ((u >> 3) & 63) + (u & ~511);
    int patch = v >> 6, w = v & 63;
    int tm = (patch % npm) * 8 + (w & 7);
    int tn = (patch / npm) * 8 + (w >> 3);
    if (tm >= ntm || tn >= ntn) continue;
    const int m0 = tm * 128, n0 = tn * 128;
    gemm_tile_bf16<false>(A + (size_t)m0 * lda, lda, Wt + (size_t)n0 * ldw, ldw, K, lds,
                          [&](int r, int c, float val) { epi(m0 + r, n0 + c, val); });
  }
}

__device__ void ph_proj(const P& p, char* lds) {
  const int ntm = T_TOK / 128, ntn = 5760 / 128;
  const int npm = (ntm + 7) / 8, npn = (ntn + 7) / 8;
  const int nslots = ((npm * npn * 64 + 511) / 512) * 512;
  for (int u = blockIdx.x; u < nslots; u += gridDim.x) {
    int v = (u & 7) * 64 + ((u >> 3) & 63) + (u & ~511);
    int patch = v >> 6, w = v & 63;
    int tm = (patch % npm) * 8 + (w & 7);
    int tn = (patch / npm) * 8 + (w >> 3);
    if (tm >= ntm || tn >= ntn) continue;
    const int m0 = tm * 128, n0 = tn * 128;
    const bf16_t* A = p.hn + (size_t)m0 * DM;
    const bf16_t* W = p.WinT + (size_t)n0 * DM;
    if (n0 < 2560) {
      float* proj = p.proj;
      gemm_tile_bf16<false>(A, DM, W, DM, DM, lds, [&](int r, int c, float val) {
        proj[(size_t)(m0 + r) * INC + n0 + c] = val; });
    } else if (n0 < 3584) {
      bf16_t* q = p.qsb;
      gemm_tile_bf16<false>(A, DM, W, DM, DM, lds, [&](int r, int c, float val) {
        q[(size_t)(m0 + r) * 1024 + (n0 - 2560) + c] = f2bf(val); });
    } else if (n0 < 4608) {
      bf16_t* kd = p.ksb + ((size_t)((m0 >> 11) * 8 + ((n0 - 3584) >> 7)) * SEQ + (m0 & 2047)) * 128;
      gemm_tile_bf16<false>(A, DM, W, DM, DM, lds, [&](int r, int c, float val) { kd[(size_t)r * 128 + c] = f2bf(val); });
    } else if (n0 < 5632) {
      bf16_t* vd = p.vsbT + ((size_t)((m0 >> 11) * 8 + ((n0 - 4608) >> 7)) * 128) * SEQ + (m0 & 2047);
      gemm_tile_bf16<true>(A, DM, W, DM, DM, lds, [&](int r, int c, float val) { vd[(size_t)r * SEQ + perm16(c)] = f2bf(val); });
    } else {
      float* proj = p.proj;
      gemm_tile_bf16<false>(A, DM, W, DM, DM, lds, [&](int r, int c, float val) {
        if (c < 24) proj[(size_t)(m0 + r) * INC + C_GT + c] = val; });
    }
  }
}

__device__ void ph_compress(const P& p, float* smem) {
  float* red = smem;
  float* c1 = smem + 256;
  int tid = threadIdx.x, n = tid & 127, half = tid >> 7;
  for (int item = blockIdx.x; item < 2 * 8 * 127; item += gridDim.x) {
    int which = item / (8 * 127);
    int rem = item % (8 * 127);
    int bg = rem / 127, i = rem % 127;
    int b = bg >> 1, g = bg & 1;
    const float* src = p.proj + (size_t)(b * SEQ + 16 * i) * INC + (which ? C_VC : C_KC) + g * 128;
    const float* pos = which ? p.pos_v : p.pos_k;
    const float* w1 = which ? p.w1_v : p.w1_k;
    const float* w2 = which ? p.w2_v : p.w2_k;
    float acc = 0.f;
    for (int l = half * 16; l < half * 16 + 16; ++l) {
      const float* sr = src + (size_t)l * INC;
      const float* pr = pos + l * 128;
      const float* wr = w1 + (size_t)l * 128 * 128 + n;
      for (int d = 0; d < 128; ++d) acc += (sr[d] + pr[d]) * wr[(size_t)d * 128];
    }
    red[tid] = acc;
    __syncthreads();
    if (half == 0) c1[n] = gelu_tanh(red[n] + red[128 + n]);
    __syncthreads();
    if (half == 0) {
      float o = 0.f;
      for (int j = 0; j < 128; ++j) o += c1[j] * w2[j * 128 + n];
      float* dst = which ? p.vc : p.kc;
      dst[((size_t)bg * 128 + i) * 128 + n] = o;
    }
    __syncthreads();
  }
}

struct OS { float m, l, o0, o1; };

template <class F>
__device__ __forceinline__ void attn_chunk(OS& st, const float* qs, const float* Kp, const float* Vp, size_t stride,
                                           int s0, int smax, F f) {
  int lane = threadIdx.x & 63;
  int s = s0 + lane;
  bool valid = false;
  float bias = 0.f;
  if (s >= 0 && s < smax) valid = f(s, bias);
  float logit = -INFINITY;
  if (valid) {
    const float4* kr = (const float4*)(Kp + (size_t)s * stride);
    const float4* q4 = (const float4*)qs;
    float acc = 0.f;
#pragma unroll 4
    for (int i = 0; i < 32; ++i) {
      float4 kv = kr[i];
      float4 qv = q4[i];
      acc += kv.x * qv.x + kv.y * qv.y + kv.z * qv.z + kv.w * qv.w;
    }
    logit = acc * ATT_SCALE + bias;
  }
  float cm = wave_max(logit);
  if (cm == -INFINITY) return;
  float mn = fmaxf(st.m, cm);
  float alpha = expf(st.m - mn);
  float pr = valid ? expf(logit - mn) : 0.f;
  st.l = st.l * alpha + wave_sum(pr);
  st.o0 *= alpha;
  st.o1 *= alpha;
  st.m = mn;
  for (int j = 0; j < 64; ++j) {
    float pj = __shfl(pr, j);
    if (pj != 0.f) {
      const float* vr = Vp + (size_t)(s0 + j) * stride;
      st.o0 += pj * vr[lane];
      st.o1 += pj * vr[lane + 64];
    }
  }
}

__device__ void ph_nsa(const P& p, float* smem) {
  int lane = threadIdx.x & 63, wv = threadIdx.x >> 6;
  float* q = smem + wv * 512;
  float* ocm = smem + 2048 + wv * 512;
  float* pbuf = smem + 4096 + wv * 128;
  float* kbuf = smem + 4608 + wv * 64;
  for (int item = blockIdx.x; item < NBATCH * 2 * (SEQ / 4); item += gridDim.x) {
    int t = (item % (SEQ / 4)) * 4 + wv;
    int bg = item / (SEQ / 4);
    int b = bg >> 1, g = bg & 1;
    const float* prow = p.proj + (size_t)(b * SEQ + t) * INC;
    for (int i = 0; i < 8; ++i) q[lane + 64 * i] = prow[C_QN + g * 512 + lane + 64 * i];
    __builtin_amdgcn_wave_barrier();
    const float* kcb = p.kc + (size_t)bg * 128 * 128;
    const float* vcb = p.vc + (size_t)bg * 128 * 128;
    float psum0 = 0.f, psum1 = 0.f;
    for (int r = 0; r < 4; ++r) {
      int h = g * 4 + r;
      float lg[2];
      bool vd[2];
      for (int u = 0; u < 2; ++u) {
        int c = lane + 64 * u;
        int dist = t - (16 * c + 31);
        vd[u] = (c < 127) && (dist >= 0);
        lg[u] = -INFINITY;
        if (vd[u]) {
          const float4* kr = (const float4*)(kcb + (size_t)c * 128);
          const float4* q4 = (const float4*)(q + r * 128);
          float acc = 0.f;
#pragma unroll 4
          for (int i = 0; i < 32; ++i) {
            float4 kv = kr[i];
            float4 qv = q4[i];
            acc += kv.x * qv.x + kv.y * qv.y + kv.z * qv.z + kv.w * qv.w;
          }
          lg[u] = acc * ATT_SCALE + p.t5[t5_bucket(dist) * 8 + h];
        }
      }
      float m = wave_max(fmaxf(lg[0], lg[1]));
      float e0 = vd[0] ? expf(lg[0] - m) : 0.f;
      float e1 = vd[1] ? expf(lg[1] - m) : 0.f;
      float sum = wave_sum(e0 + e1);
      float inv = 1.f / fmaxf(sum, 1e-20f);
      float p0 = e0 * inv, p1 = e1 * inv;
      psum0 += p0;
      psum1 += p1;
      float o0 = 0.f, o1 = 0.f;
      int cmax = (t >= 31) ? (t - 31) / 16 : -1;
      if (cmax > 126) cmax = 126;
      for (int c = 0; c <= cmax; ++c) {
        float pc = (c < 64) ? __shfl(p0, c) : __shfl(p1, c - 64);
        const float* vr = vcb + (size_t)c * 128;
        o0 += pc * vr[lane];
        o1 += pc * vr[lane + 64];
      }
      ocm[r * 128 + lane] = o0;
      ocm[r * 128 + lane + 64] = o1;
    }
    pbuf[lane] = psum0;
    pbuf[lane + 64] = (lane + 64 < 127) ? psum1 : 0.f;
    __builtin_amdgcn_wave_barrier();
    int cur = t >> 6;
    float key = -3e9f;
    bool allowed = false;
    if (lane < 32) {
      int j = lane;
      float imp = pbuf[4 * j] + pbuf[4 * j + 1] + pbuf[4 * j + 2] + 0.5f * pbuf[4 * j + 3];
      if (j > 0) imp += 0.5f * pbuf[4 * j - 1];
      bool forced = (j == 0) || (j == cur) || (j == cur - 1);
      allowed = (j <= cur);
      key = forced ? 1e9f : (allowed ? imp : -1e9f);
      kbuf[j] = key;
    }
    __builtin_amdgcn_wave_barrier();
    bool sel = false;
    if (lane < 32) {
      int rank = 0;
      for (int i = 0; i < 32; ++i) {
        float ki = kbuf[i];
        rank += (ki > key || (ki == key && i < lane)) ? 1 : 0;
      }
      sel = (rank < 16) && allowed;
    }
    unsigned long long bal = __ballot(sel);
    unsigned selmask = (unsigned)(bal & 0xffffffffull);
    __builtin_amdgcn_wave_barrier();
    const float* Ks = p.proj + (size_t)(b * SEQ) * INC + C_KS + g * 128;
    const float* Vs = p.proj + (size_t)(b * SEQ) * INC + C_VS + g * 128;
    const float* Kw = p.proj + (size_t)(b * SEQ) * INC + C_KW + g * 128;
    const float* Vw = p.proj + (size_t)(b * SEQ) * INC + C_VW + g * 128;
    for (int r = 0; r < 4; ++r) {
      int h = g * 4 + r;
      const float* t5h = p.t5 + h;
      OS ss = {-INFINITY, 0.f, 0.f, 0.f};
      for (int j = 0; j <= cur; ++j) {
        if (!((selmask >> j) & 1u)) continue;
        attn_chunk(ss, q + r * 128, Ks, Vs, (size_t)INC, j * 64, SEQ, [&](int s, float& bias) {
          int dist = t - s;
          if (dist < 0) return false;
          bias = t5h[t5_bucket(dist) * 8];
          return true;
        });
      }
      OS sw = {-INFINITY, 0.f, 0.f, 0.f};
      for (int s0 = (t & ~63); s0 >= 0 && s0 + 63 >= t - 511; s0 -= 64) {
        attn_chunk(sw, q + r * 128, Kw, Vw, (size_t)INC, s0, SEQ, [&](int s, float& bias) {
          int dist = t - s;
          if (dist < 0 || dist >= 512) return false;
          bias = t5h[t5_bucket(dist) * 8];
          return true;
        });
      }
      float isl = 1.f / fmaxf(ss.l, 1e-20f), iwl = 1.f / fmaxf(sw.l, 1e-20f);
      float g0 = 1.f / (1.f + expf(-prow[C_GT + h * 3 + 0]));
      float g1 = 1.f / (1.f + expf(-prow[C_GT + h * 3 + 1]));
      float g2 = 1.f / (1.f + expf(-prow[C_GT + h * 3 + 2]));
      bf16_t* orow = p.omix + (size_t)(b * SEQ + t) * DM + h * 128;
      orow[lane] = f2bf(g0 * ocm[r * 128 + lane] + g1 * ss.o0 * isl + g2 * sw.o0 * iwl);
      orow[lane + 64] = f2bf(g0 * ocm[r * 128 + lane + 64] + g1 * ss.o1 * isl + g2 * sw.o1 * iwl);
    }
    __builtin_amdgcn_wave_barrier();
  }
}

#define NEG_BIG (-1e30f)

struct KVRegs { u32x4 k0, k1, k2, k3, v0, v1, v2, v3; };

__device__ __forceinline__ int koff(int row, int chunk) { return row * 256 + ((chunk ^ (row & 15)) << 4); }

__device__ __forceinline__ void kv_load(KVRegs& r, const bf16_t* kp, int ldk, const bf16_t* vp, int ldv) {
  const int tid = threadIdx.x;
  const bf16_t* kg = kp + (size_t)(tid >> 4) * ldk + (tid & 15) * 8;
  r.k0 = *(const u32x4*)kg;
  r.k1 = *(const u32x4*)(kg + (size_t)16 * ldk);
  r.k2 = *(const u32x4*)(kg + (size_t)32 * ldk);
  r.k3 = *(const u32x4*)(kg + (size_t)48 * ldk);
  const bf16_t* vg = vp + (size_t)(tid >> 3) * ldv + (tid & 7) * 8;
  r.v0 = *(const u32x4*)vg;
  r.v1 = *(const u32x4*)(vg + (size_t)32 * ldv);
  r.v2 = *(const u32x4*)(vg + (size_t)64 * ldv);
  r.v3 = *(const u32x4*)(vg + (size_t)96 * ldv);
}
__device__ __forceinline__ void kv_store(const KVRegs& r, char* lk, char* lv) {
  const int tid = threadIdx.x;
  const int row = tid >> 4, ch = tid & 15;
  *(u32x4*)(lk + koff(row, ch)) = r.k0;
  *(u32x4*)(lk + koff(row + 16, ch)) = r.k1;
  *(u32x4*)(lk + koff(row + 32, ch)) = r.k2;
  *(u32x4*)(lk + koff(row + 48, ch)) = r.k3;
  const int vr = tid >> 3, vc = tid & 7;
  *(u32x4*)(lv + lds_off(vr, vc)) = r.v0;
  *(u32x4*)(lv + lds_off(vr + 32, vc)) = r.v1;
  *(u32x4*)(lv + lds_off(vr + 64, vc)) = r.v2;
  *(u32x4*)(lv + lds_off(vr + 96, vc)) = r.v3;
}

struct QFrag { bf16x8 f0, f1, f2, f3, f4, f5, f6, f7; };
__device__ __forceinline__ void q_load(QFrag& q, const bf16_t* qrow) {
  const int h = (threadIdx.x & 63) >> 5;
  const bf16x8* p8 = (const bf16x8*)(qrow + 8 * h);
  q.f0 = p8[0]; q.f1 = p8[2]; q.f2 = p8[4]; q.f3 = p8[6]; q.f4 = p8[8]; q.f5 = p8[10]; q.f6 = p8[12]; q.f7 = p8[14];
}

__device__ __forceinline__ void qk_tile(const QFrag& q, const char* lk, f32x16& s0, f32x16& s1) {
  const int lane = threadIdx.x & 63, row = lane & 31, h = lane >> 5;
#pragma unroll
  for (int r = 0; r < 16; ++r) { s0[r] = 0.f; s1[r] = 0.f; }
#define QK_STEP(kk, qf)                                                                  \
  {                                                                                      \
    bf16x8 a0 = *(const bf16x8*)(lk + koff(row, 2 * (kk) + h));                          \
    bf16x8 a1 = *(const bf16x8*)(lk + koff(row + 32, 2 * (kk) + h));                     \
    s0 = __builtin_amdgcn_mfma_f32_32x32x16_bf16(a0, qf, s0, 0, 0, 0);                   \
    s1 = __builtin_amdgcn_mfma_f32_32x32x16_bf16(a1, qf, s1, 0, 0, 0);                   \
  }
  QK_STEP(0, q.f0) QK_STEP(1, q.f1) QK_STEP(2, q.f2) QK_STEP(3, q.f3)
  QK_STEP(4, q.f4) QK_STEP(5, q.f5) QK_STEP(6, q.f6) QK_STEP(7, q.f7)
#undef QK_STEP
}

__device__ __forceinline__ bf16x8 pack8(const f32x16& p, const int base) {
  u32x4 u;
  u[0] = pack2(p[base + 0], p[base + 1]);
  u[1] = pack2(p[base + 2], p[base + 3]);
  u[2] = pack2(p[base + 4], p[base + 5]);
  u[3] = pack2(p[base + 6], p[base + 7]);
  return __builtin_bit_cast(bf16x8, u);
}

struct OAcc { f32x16 o0, o1, o2, o3; };
__device__ __forceinline__ void oacc_zero(OAcc& o) {
#pragma unroll
  for (int r = 0; r < 16; ++r) { o.o0[r] = 0.f; o.o1[r] = 0.f; o.o2[r] = 0.f; o.o3[r] = 0.f; }
}
__device__ __forceinline__ void oacc_scale(OAcc& o, float a) {
#pragma unroll
  for (int r = 0; r < 16; ++r) { o.o0[r] *= a; o.o1[r] *= a; o.o2[r] *= a; o.o3[r] *= a; }
}

__device__ __forceinline__ void pv_tile(OAcc& o, const char* lv, const f32x16& p0, const f32x16& p1) {
  const int lane = threadIdx.x & 63, row = lane & 31, h = lane >> 5;
  const bf16x8 pf0 = pack8(p0, 0), pf1 = pack8(p0, 8), pf2 = pack8(p1, 0), pf3 = pack8(p1, 8);
#define PV_ROW(dd, acc)                                                                                      \
  {                                                                                                          \
    acc = __builtin_amdgcn_mfma_f32_32x32x16_bf16(*(const bf16x8*)(lv + lds_off(32 * (dd) + row, 0 + h)), pf0, acc, 0, 0, 0); \
    acc = __builtin_amdgcn_mfma_f32_32x32x16_bf16(*(const bf16x8*)(lv + lds_off(32 * (dd) + row, 2 + h)), pf1, acc, 0, 0, 0); \
    acc = __builtin_amdgcn_mfma_f32_32x32x16_bf16(*(const bf16x8*)(lv + lds_off(32 * (dd) + row, 4 + h)), pf2, acc, 0, 0, 0); \
    acc = __builtin_amdgcn_mfma_f32_32x32x16_bf16(*(const bf16x8*)(lv + lds_off(32 * (dd) + row, 6 + h)), pf3, acc, 0, 0, 0); \
  }
  PV_ROW(0, o.o0) PV_ROW(1, o.o1) PV_ROW(2, o.o2) PV_ROW(3, o.o3)
#undef PV_ROW
}

__device__ __forceinline__ void softmax_tile(f32x16& s0, f32x16& s1, float& m, float& l, OAcc& o) {
  float mx = NEG_BIG;
#pragma unroll
  for (int r = 0; r < 16; ++r) mx = fmaxf(mx, fmaxf(s0[r], s1[r]));
  mx = fmaxf(mx, __shfl_xor(mx, 32));
  const float mn = fmaxf(m, mx);
  const float alpha = __expf(m - mn);
  float ls = 0.f;
#pragma unroll
  for (int r = 0; r < 16; ++r) {
    float a = (s0[r] > -1e29f) ? __expf(s0[r] - mn) : 0.f;
    float b = (s1[r] > -1e29f) ? __expf(s1[r] - mn) : 0.f;
    s0[r] = a; s1[r] = b;
    ls += a + b;
  }
  ls += __shfl_xor(ls, 32);
  l = l * alpha + ls;
  m = mn;
  oacc_scale(o, alpha);
}

template <class F>
__device__ __forceinline__ void oacc_foreach(const OAcc& o, F f) {
  const int h = (threadIdx.x & 63) >> 5;
#pragma unroll
  for (int rho = 0; rho < 4; ++rho) {
    f(0 + 8 * rho + 4 * h, o.o0[4 * rho], o.o0[4 * rho + 1], o.o0[4 * rho + 2], o.o0[4 * rho + 3]);
    f(32 + 8 * rho + 4 * h, o.o1[4 * rho], o.o1[4 * rho + 1], o.o1[4 * rho + 2], o.o1[4 * rho + 3]);
    f(64 + 8 * rho + 4 * h, o.o2[4 * rho], o.o2[4 * rho + 1], o.o2[4 * rho + 2], o.o2[4 * rho + 3]);
    f(96 + 8 * rho + 4 * h, o.o3[4 * rho], o.o3[4 * rho + 1], o.o3[4 * rho + 2], o.o3[4 * rho + 3]);
  }
}

__device__ void ph_memattn2(const P& p, char* lds) {
  char* lk = lds;
  char* lv = lds + 16384;
  const int lane = threadIdx.x & 63, wv = threadIdx.x >> 6;
  for (int item = blockIdx.x; item < NBATCH * 4 * (SEQ / 128); item += gridDim.x) {
    const int tb = item % (SEQ / 128);
    const int bh = item / (SEQ / 128);
    const int b = bh >> 2, hd = bh & 3;
    const int t = tb * 128 + wv * 32 + (lane & 31);
    QFrag q;
    q_load(q, p.qmemb + (size_t)(b * SEQ + t) * 512 + hd * 128);
    const bf16_t* kb = p.kmemb + (size_t)bh * 256 * 128;
    const bf16_t* vb = p.vmemT + (size_t)bh * 128 * 256;
    OAcc o;
    oacc_zero(o);
    float m = NEG_BIG, l = 0.f;
    KVRegs kv;
    kv_load(kv, kb, 128, vb, 256);
    for (int ti = 0; ti < 4; ++ti) {
      __syncthreads();
      kv_store(kv, lk, lv);
      __syncthreads();
      {
        const int tn = (ti + 1 < 4) ? ti + 1 : 3;
        kv_load(kv, kb + (size_t)tn * 64 * 128, 128, vb + tn * 64, 256);
      }
      f32x16 s0, s1;
      qk_tile(q, lk, s0, s1);
#pragma unroll
      for (int r = 0; r < 16; ++r) { s0[r] *= ATT_SCALE; s1[r] *= ATT_SCALE; }
      softmax_tile(s0, s1, m, l, o);
      pv_tile(o, lv, s0, s1);
    }
    const float il = 1.f / l;
    int t2 = t;
    asm volatile("" : "+v"(t2));
    bf16_t* orow = p.omem + (size_t)(b * SEQ + t2) * 512 + hd * 128;
    oacc_foreach(o, [&](int d, float v0, float v1, float v2, float v3) {
      uint2 u;
      u.x = pack2(v0 * il, v1 * il);
      u.y = pack2(v2 * il, v3 * il);
      *(uint2*)(orow + d) = u;
    });
  }
}

__device__ void ph_sb2(const P& p, char* lds) {
  char* lk = lds;
  char* lv = lds + 16384;
  const int lane = threadIdx.x & 63, wv = threadIdx.x >> 6, hh = lane >> 5;
  for (int item = blockIdx.x; item < NBATCH * 8 * (SEQ / 128); item += gridDim.x) {
    const int tb = (SEQ / 128 - 1) - (item % (SEQ / 128));
    const int bh = item / (SEQ / 128);
    const int b = bh >> 3, hd = bh & 7;
    const int t0 = tb * 128;
    const int t = t0 + wv * 32 + (lane & 31);
    QFrag q;
    q_load(q, p.qsb + (size_t)(b * SEQ + t) * 1024 + hd * 128);
    const bf16_t* kb = p.ksb + (size_t)bh * SEQ * 128;
    const bf16_t* vb = p.vsbT + (size_t)bh * 128 * SEQ;
    OAcc o;
    oacc_zero(o);
    float carry = 0.f;
    const int jhi = (t0 >> 6) + 1;
    const int jw = (t0 + wv * 32 + 30) >> 6;
    KVRegs kv;
    kv_load(kv, kb + (size_t)jhi * 64 * 128, 128, vb + jhi * 64, SEQ);
    for (int j = jhi; j >= 0; --j) {
      __syncthreads();
      kv_store(kv, lk, lv);
      __syncthreads();
      const int jn = (j > 0) ? j - 1 : 0;
      if (j > jw) kv_load(kv, kb + (size_t)jn * 64 * 128, 128, vb + jn * 64, SEQ);
      if (j <= jw) {
        f32x16 z0, z1;
        qk_tile(q, lk, z0, z1);
        const int sbase = j * 64 + 4 * hh;
        float gt[8];
        f32x16 l0, l1;
#pragma unroll
        for (int r = 0; r < 16; ++r) {
          const int so = sbase + 8 * (r >> 2) + (r & 3);
          {
            const float z = z0[r] * ATT_SCALE;
            const bool valid = so < t;
            const float lsp = fminf(z, 0.f) - __logf(1.f + __expf(-fabsf(z)));
            l0[r] = valid ? (lsp - z) : 0.f;
            z0[r] = valid ? z : NEG_BIG;
          }
          {
            const float z = z1[r] * ATT_SCALE;
            const bool valid = so + 32 < t;
            const float lsp = fminf(z, 0.f) - __logf(1.f + __expf(-fabsf(z)));
            l1[r] = valid ? (lsp - z) : 0.f;
            z1[r] = valid ? z : NEG_BIG;
          }
        }
#pragma unroll
        for (int rho = 0; rho < 4; ++rho) {
          gt[rho] = (l0[4 * rho] + l0[4 * rho + 1]) + (l0[4 * rho + 2] + l0[4 * rho + 3]);
          gt[4 + rho] = (l1[4 * rho] + l1[4 * rho + 1]) + (l1[4 * rho + 2] + l1[4 * rho + 3]);
        }
        float ag[8];
        float run = 0.f;
#pragma unroll
        for (int k = 7; k >= 0; --k) {
          const float pg = __shfl_xor(gt[k], 32);
          ag[k] = carry + run + (hh == 0 ? pg : 0.f);
          run += gt[k] + pg;
        }
        carry += run;
#pragma unroll
        for (int rho = 0; rho < 4; ++rho) {
          {
            const float x3 = l0[4 * rho + 3], x23 = x3 + l0[4 * rho + 2], x123 = x23 + l0[4 * rho + 1];
            const float g = ag[rho];
            z0[4 * rho + 0] = __expf((l0[4 * rho + 0] + z0[4 * rho + 0]) + (g + x123));
            z0[4 * rho + 1] = __expf((l0[4 * rho + 1] + z0[4 * rho + 1]) + (g + x23));
            z0[4 * rho + 2] = __expf((l0[4 * rho + 2] + z0[4 * rho + 2]) + (g + x3));
            z0[4 * rho + 3] = __expf((l0[4 * rho + 3] + z0[4 * rho + 3]) + g);
          }
          {
            const float x3 = l1[4 * rho + 3], x23 = x3 + l1[4 * rho + 2], x123 = x23 + l1[4 * rho + 1];
            const float g = ag[4 + rho];
            z1[4 * rho + 0] = __expf((l1[4 * rho + 0] + z1[4 * rho + 0]) + (g + x123));
            z1[4 * rho + 1] = __expf((l1[4 * rho + 1] + z1[4 * rho + 1]) + (g + x23));
            z1[4 * rho + 2] = __expf((l1[4 * rho + 2] + z1[4 * rho + 2]) + (g + x3));
            z1[4 * rho + 3] = __expf((l1[4 * rho + 3] + z1[4 * rho + 3]) + g);
          }
        }
        kv_load(kv, kb + (size_t)jn * 64 * 128, 128, vb + jn * 64, SEQ);
        pv_tile(o, lv, z0, z1);
      }
    }
    int t2 = t;
    asm volatile("" : "+v"(t2));
    bf16_t* orow = p.omix + (size_t)(b * SEQ + t2) * DM + 1024 + hd * 128;
    oacc_foreach(o, [&](int d, float v0, float v1, float v2, float v3) {
      uint2 u;
      u.x = pack2(v0, v1);
      u.y = pack2(v2, v3);
      *(uint2*)(orow + d) = u;
    });
  }
}

__device__ void ph_peer(const P& p, float* smem) {
  int lane = threadIdx.x & 63, wv = threadIdx.x >> 6;
  float* q = smem + wv * 2048;
  float* ts = smem + 8192 + wv * 256;
  int* ti = (int*)(smem + 9216) + wv * 256;
  float* bgt = smem + 10240 + wv * 128;
  int* bex = (int*)(smem + 10752) + wv * 128;
  const float* qp = p.proj;
  for (int item = blockIdx.x; item < T_TOK / 4; item += gridDim.x) {
    int t = item * 4 + wv;
    {
      const float4* s4 = (const float4*)(qp + (size_t)t * DM);
      float4* d4 = (float4*)q;
      for (int i = 0; i < 8; ++i) d4[i * 64 + lane] = s4[i * 64 + lane];
    }
    __builtin_amdgcn_wave_barrier();
    for (int hp = 0; hp < 16; ++hp) {
      float sc[2];
      for (int u = 0; u < 2; ++u) {
        int k = lane + 64 * u;
        const float4* kr = (const float4*)(p.subk + ((size_t)hp * 128 + k) * 128);
        const float4* q4 = (const float4*)(q + hp * 128);
        float acc = 0.f;
#pragma unroll 4
        for (int i = 0; i < 32; ++i) {
          float4 kv = kr[i];
          float4 qv = q4[i];
          acc += kv.x * qv.x + kv.y * qv.y + kv.z * qv.z + kv.w * qv.w;
        }
        sc[u] = acc;
      }
      for (int n = 0; n < 16; ++n) {
        float v;
        int i;
        if (sc[0] >= sc[1]) { v = sc[0]; i = lane; } else { v = sc[1]; i = lane + 64; }
        wave_argmax(v, i);
        if (lane == 0) { ts[hp * 16 + n] = v; ti[hp * 16 + n] = i; }
        if (i == lane) sc[0] = -INFINITY;
        if (i == lane + 64) sc[1] = -INFINITY;
      }
    }
    __builtin_amdgcn_wave_barrier();
    for (int h = 0; h < 8; ++h) {
      float cv[4];
      for (int m = 0; m < 4; ++m) {
        int c = m * 64 + lane;
        cv[m] = ts[(2 * h) * 16 + (c >> 4)] + ts[(2 * h + 1) * 16 + (c & 15)];
      }
      float mybest = 0.f;
      int myc = 0;
      for (int n = 0; n < 16; ++n) {
        float v = cv[0];
        int i = lane;
        for (int m = 1; m < 4; ++m)
          if (cv[m] > v) { v = cv[m]; i = m * 64 + lane; }
        wave_argmax(v, i);
        if (lane == n) { mybest = v; myc = i; }
        for (int m = 0; m < 4; ++m)
          if (i == m * 64 + lane) cv[m] = -INFINITY;
      }
      float sv = (lane < 16) ? mybest : -INFINITY;
      float mx = wave_max(sv);
      float e = (lane < 16) ? expf(sv - mx) : 0.f;
      float sum = wave_sum(e);
      if (lane < 16) {
        bgt[h * 16 + lane] = e / sum;
        bex[h * 16 + lane] = ti[(2 * h) * 16 + (myc >> 4)] * 128 + ti[(2 * h + 1) * 16 + (myc & 15)];
      }
    }
    __builtin_amdgcn_wave_barrier();
    float4 xv[8], acc[8];
    {
      const float4* s4 = (const float4*)(p.out + (size_t)t * DM);
      const float4* g4 = (const float4*)p.norm_ffn;
      float ss = 0.f;
#pragma unroll
      for (int i = 0; i < 8; ++i) {
        xv[i] = s4[i * 64 + lane];
        ss += xv[i].x * xv[i].x + xv[i].y * xv[i].y + xv[i].z * xv[i].z + xv[i].w * xv[i].w;
        acc[i] = make_float4(0, 0, 0, 0);
      }
      ss = wave_sum(ss);
      float rs = rsqrtf(ss * (1.f / DM) + RMS_EPS);
#pragma unroll
      for (int i = 0; i < 8; ++i) {
        float4 g = g4[i * 64 + lane];
        xv[i].x *= rs * g.x; xv[i].y *= rs * g.y; xv[i].z *= rs * g.z; xv[i].w *= rs * g.w;
      }
    }
    for (int e = 0; e < 128; ++e) {
      int eid = bex[e];
      float gt = bgt[e];
      const float4* ur = (const float4*)(p.pu + (size_t)eid * DM);
      float part = 0.f;
#pragma unroll
      for (int i = 0; i < 8; ++i) {
        float4 u = ur[i * 64 + lane];
        part += u.x * xv[i].x + u.y * xv[i].y + u.z * xv[i].z + u.w * xv[i].w;
      }
      float a = wave_sum(part);
      float hid = gt * gelu_tanh(a);
      const float4* vr = (const float4*)(p.pv + (size_t)eid * DM);
#pragma unroll
      for (int i = 0; i < 8; ++i) {
        float4 v = vr[i * 64 + lane];
        acc[i].x += hid * v.x; acc[i].y += hid * v.y; acc[i].z += hid * v.z; acc[i].w += hid * v.w;
      }
    }
    float4* o4 = (float4*)(p.out + (size_t)t * DM);
    float ss = 0.f;
#pragma unroll
    for (int i = 0; i < 8; ++i) {
      float4 hv = o4[i * 64 + lane];
      acc[i].x += hv.x; acc[i].y += hv.y; acc[i].z += hv.z; acc[i].w += hv.w;
      ss += acc[i].x * acc[i].x + acc[i].y * acc[i].y + acc[i].z * acc[i].z + acc[i].w * acc[i].w;
    }
    ss = wave_sum(ss);
    float rs = rsqrtf(ss * (1.f / DM) + RMS_EPS);
    const float4* g4 = (const float4*)p.norm_final;
#pragma unroll
    for (int i = 0; i < 8; ++i) {
      float4 g = g4[i * 64 + lane];
      float4 o;
      o.x = acc[i].x * rs * g.x; o.y = acc[i].y * rs * g.y; o.z = acc[i].z * rs * g.z; o.w = acc[i].w * rs * g.w;
      o4[i * 64 + lane] = o;
    }
    __builtin_amdgcn_wave_barrier();
  }
}

typedef const __attribute__((address_space(4))) P* KP;
__device__ __forceinline__ P loadP() {
#if defined(__HIP_DEVICE_COMPILE__)
  KP k = (KP)__builtin_amdgcn_kernarg_segment_ptr();
  asm volatile("" : "+s"(k));
  P p = *k;
  return p;
#else
  return P{};
#endif
}

__global__ void __launch_bounds__(256, 2) mega(P p_arg) {
  cg::grid_group grid = cg::this_grid();
  __shared__ __attribute__((aligned(16))) float smem[12288];
  char* lds = (char*)smem;
  { P p = loadP(); ph_rmsnorm(p.x, p.norm_mix, p.hn, T_TOK); ph_rmsnorm(p.mem, p.norm_mkv, p.memn, 1024); }
  { P p = loadP(); ph_transpose<true>(smem, p.w_in, DM, INC, 5760, p.WinT); }
  { P p = loadP(); ph_transpose<false>(smem, p.w_out, DM, DM, DM, p.WoutT); }
  { P p = loadP(); ph_transpose<false>(smem, p.w_pq, DM, DM, DM, p.WpqT); }
  { P p = loadP(); ph_transpose<false>(smem, p.w_mq, DM, 512, 512, p.WmqT); }
  { P p = loadP(); ph_transpose<false>(smem, p.w_mk, DM, 512, 512, p.WmkT); }
  { P p = loadP(); ph_transpose<false>(smem, p.w_mv, DM, 512, 512, p.WmvT); }
  { P p = loadP(); ph_transpose<false>(smem, p.w_mo, 512, DM, DM, p.WmoT); }
  grid.sync();
  { P p = loadP(); ph_proj(p, lds); }
  { P p = loadP(); bf16_t* kmem = p.kmemb;
    ph_gemm_bf16(p.memn, DM, p.WmkT, DM, 1024, 512, DM, lds, [=](int m, int n, float v) {
      kmem[((size_t)((m >> 8) * 4 + (n >> 7)) * 256 + (m & 255)) * 128 + (n & 127)] = f2bf(v); }); }
  { P p = loadP(); bf16_t* vmem = p.vmemT;
    ph_gemm_bf16(p.memn, DM, p.WmvT, DM, 1024, 512, DM, lds, [=](int m, int n, float v) {
      vmem[((size_t)((m >> 8) * 4 + (n >> 7)) * 128 + (n & 127)) * 256 + perm16(m & 255)] = f2bf(v); }); }
  grid.sync();
  { P p = loadP(); ph_compress(p, smem); }
  { P p = loadP(); ph_sb2(p, lds); }
  grid.sync();
  { P p = loadP(); ph_nsa(p, smem); }
  grid.sync();
  { P p = loadP(); float* out = p.out; const float* x = p.x;
    ph_gemm_bf16(p.omix, DM, p.WoutT, DM, T_TOK, DM, DM, lds, [=](int m, int n, float v) { out[(size_t)m * DM + n] = x[(size_t)m * DM + n] + v; }); }
  grid.sync();
  { P p = loadP(); ph_rmsnorm(p.out, p.norm_mq, p.hn, T_TOK); }
  grid.sync();
  { P p = loadP(); bf16_t* qmem = p.qmemb;
    ph_gemm_bf16(p.hn, DM, p.WmqT, DM, T_TOK, 512, DM, lds, [=](int m, int n, float v) { qmem[(size_t)m * 512 + n] = f2bf(v); }); }
  grid.sync();
  { P p = loadP(); ph_memattn2(p, lds); }
  grid.sync();
  { P p = loadP(); float* out = p.out;
    ph_gemm_bf16(p.omem, 512, p.WmoT, 512, T_TOK, DM, 512, lds, [=](int m, int n, float v) { out[(size_t)m * DM + n] += v; }); }
  grid.sync();
  { P p = loadP(); ph_rmsnorm(p.out, p.norm_ffn, p.hn, T_TOK); }
  grid.sync();
  { P p = loadP(); float* qp = p.proj;
    ph_gemm_bf16(p.hn, DM, p.WpqT, DM, T_TOK, DM, DM, lds, [=](int m, int n, float v) { qp[(size_t)m * DM + n] = v; }); }
  grid.sync();
  { P p = loadP(); ph_peer(p, smem); }
}

extern "C" void kernel_launch(void* const* d_in, const int* in_sizes, int n_in, void* d_out, int out_size, void* d_ws,
                              size_t ws_size, hipStream_t stream) {
  P p{};
  p.x = (const float*)d_in[0]; p.mem = (const float*)d_in[1]; p.t5 = (const float*)d_in[2];
  p.norm_mix = (const float*)d_in[3]; p.w_in = (const float*)d_in[4]; p.pos_k = (const float*)d_in[5];
  p.w1_k = (const float*)d_in[6]; p.w2_k = (const float*)d_in[7]; p.pos_v = (const float*)d_in[8];
  p.w1_v = (const float*)d_in[9]; p.w2_v = (const float*)d_in[10]; p.w_out = (const float*)d_in[11];
  p.norm_mq = (const float*)d_in[12]; p.norm_mkv = (const float*)d_in[13]; p.w_mq = (const float*)d_in[14];
  p.w_mk = (const float*)d_in[15]; p.w_mv = (const float*)d_in[16]; p.w_mo = (const float*)d_in[17];
  p.norm_ffn = (const float*)d_in[18]; p.w_pq = (const float*)d_in[19]; p.subk = (const float*)d_in[20];
  p.pu = (const float*)d_in[21]; p.pv = (const float*)d_in[22]; p.norm_final = (const float*)d_in[23];
  p.out = (float*)d_out;
  char* w = (char*)d_ws;
  size_t off = 0;
  auto take = [&](size_t bytes) { char* r = w + off; off += (bytes + 255) & ~(size_t)255; return r; };
  p.proj = (float*)take((size_t)T_TOK * INC * 4);
  p.kc = (float*)take(8 * 128 * 128 * 4);
  p.vc = (float*)take(8 * 128 * 128 * 4);
  p.kmem = (float*)take(1024 * 512 * 4);
  p.vmem = (float*)take(1024 * 512 * 4);
  p.qmem = (float*)take((size_t)T_TOK * 512 * 4);
  p.hn = (bf16_t*)take((size_t)T_TOK * DM * 2);
  p.omix = (bf16_t*)take((size_t)T_TOK * DM * 2);
  p.memn = (bf16_t*)take((size_t)1024 * DM * 2);
  p.omem = (bf16_t*)take((size_t)T_TOK * 512 * 2);
  p.WinT = (bf16_t*)take((size_t)5760 * DM * 2);
  p.WoutT = (bf16_t*)take((size_t)DM * DM * 2);
  p.WpqT = (bf16_t*)take((size_t)DM * DM * 2);
  p.WmqT = (bf16_t*)take((size_t)512 * DM * 2);
  p.WmkT = (bf16_t*)take((size_t)512 * DM * 2);
  p.WmvT = (bf16_t*)take((size_t)512 * DM * 2);
  p.WmoT = (bf16_t*)take((size_t)DM * 512 * 2);
  p.qmemb = (bf16_t*)take((size_t)T_TOK * 512 * 2);
  p.kmemb = (bf16_t*)take((size_t)1024 * 512 * 2);
  p.vmemT = (bf16_t*)take((size_t)1024 * 512 * 2);
  p.qsb = (bf16_t*)take((size_t)T_TOK * 1024 * 2);
  p.ksb = (bf16_t*)take((size_t)T_TOK * 1024 * 2);
  p.vsbT = (bf16_t*)take((size_t)T_TOK * 1024 * 2);
  static int grid_blocks = 0;
  if (!grid_blocks) {
    int dev = 0, cus = 0, per_cu = 0;
    (void)hipGetDevice(&dev);
    (void)hipDeviceGetAttribute(&cus, hipDeviceAttributeMultiprocessorCount, dev);
    (void)hipOccupancyMaxActiveBlocksPerMultiprocessor(&per_cu, mega, 256, 0);
    if (per_cu > 2) per_cu = 2;
    if (per_cu < 1) per_cu = 1;
    grid_blocks = cus * per_cu;
  }
  void* args[] = {&p};
  hipError_t e = hipLaunchCooperativeKernel((void*)mega, dim3(grid_blocks), dim3(256), args, 0, stream);
  if (e != hipSuccess) fprintf(stderr, "cooperative launch failed: %s (grid %d)\n", hipGetErrorString(e), grid_blocks);
}
```

```cpp
#include <hip/hip_runtime.h>
#include <hip/hip_cooperative_groups.h>
#include <cstdio>
namespace cg = cooperative_groups;
#include <stdint.h>

#define SEQ 2048
#define NBATCH 4
#define T_TOK 8192
#define DM 2048
#define INC 5656
#define C_QN 0
#define C_KC 1024
#define C_VC 1280
#define C_KS 1536
#define C_VS 1792
#define C_KW 2048
#define C_VW 2304
#define C_GT 2560
#define C_QSB 2584
#define C_KSB 3608
#define C_VSB 4632
#define ATT_SCALE 0.08838834764831845f
#define RMS_EPS 1e-6f

typedef unsigned short bf16_t;
typedef __attribute__((ext_vector_type(8))) short bf16x8;
typedef __attribute__((ext_vector_type(16))) float f32x16;
typedef __attribute__((ext_vector_type(2))) __bf16 bf16v2;
typedef __attribute__((ext_vector_type(4))) unsigned u32x4;

struct P {
  const float *x, *mem, *t5, *norm_mix, *w_in, *pos_k, *w1_k, *w2_k, *pos_v, *w1_v, *w2_v, *w_out,
      *norm_mq, *norm_mkv, *w_mq, *w_mk, *w_mv, *w_mo, *norm_ffn, *w_pq, *subk, *pu, *pv, *norm_final;
  float* out;
  float *proj, *kc, *vc;
  bf16_t *hn, *omix, *memn, *omem;
  bf16_t *WinT, *WoutT, *WpqT, *WmqT, *WmkT, *WmvT, *WmoT;
  bf16_t *qmemb, *kmemb, *vmemT;
  bf16_t *qsb, *ksb, *vsbT;
  bf16_t *pub, *pvb, *subkb;
};

__device__ __forceinline__ unsigned pack2(float a, float b) {
  bf16v2 r = {(__bf16)a, (__bf16)b};
  return *(unsigned*)&r;
}
__device__ __forceinline__ bf16_t f2bf(float a) {
  __bf16 r = (__bf16)a;
  return *(bf16_t*)&r;
}
__device__ __forceinline__ int perm16(int s) { return (s & ~12) | ((s & 4) << 1) | ((s & 8) >> 1); }
__device__ __forceinline__ float bf2f(bf16_t u) { return __uint_as_float((unsigned)u << 16); }

__device__ __forceinline__ float wave_max(float v) {
  for (int o = 32; o > 0; o >>= 1) v = fmaxf(v, __shfl_xor(v, o));
  return v;
}
__device__ __forceinline__ float wave_sum(float v) {
  for (int o = 32; o > 0; o >>= 1) v += __shfl_xor(v, o);
  return v;
}
__device__ __forceinline__ void wave_argmax(float& v, int& i) {
  for (int o = 32; o > 0; o >>= 1) {
    float ov = __shfl_xor(v, o);
    int oi = __shfl_xor(i, o);
    if (ov > v || (ov == v && oi < i)) { v = ov; i = oi; }
  }
}
__device__ __forceinline__ float gelu_tanh(float x) {
  return 0.5f * x * (1.f + tanhf(0.7978845608028654f * (x + 0.044715f * x * x * x)));
}
__device__ __forceinline__ int t5_bucket(int n) {
  if (n < 16) return n < 0 ? 0 : n;
  int b = 16;
  b += (n >= 19); b += (n >= 21); b += (n >= 24); b += (n >= 27); b += (n >= 31); b += (n >= 35);
  b += (n >= 40); b += (n >= 46); b += (n >= 52); b += (n >= 59); b += (n >= 67); b += (n >= 77);
  b += (n >= 87); b += (n >= 99); b += (n >= 113);
  return b;
}
__device__ __forceinline__ float log_sigmoid(float x) {
  return fminf(x, 0.f) - log1pf(expf(-fabsf(x)));
}

__device__ void ph_rmsnorm(const float* src, const float* gain, bf16_t* dst, int rows) {
  int lane = threadIdx.x & 63, wv = threadIdx.x >> 6;
  for (int r = blockIdx.x * 4 + wv; r < rows; r += gridDim.x * 4) {
    const float4* s4 = (const float4*)(src + (size_t)r * DM);
    float4 v[8];
    float ss = 0.f;
#pragma unroll
    for (int i = 0; i < 8; ++i) {
      v[i] = s4[i * 64 + lane];
      ss += v[i].x * v[i].x + v[i].y * v[i].y + v[i].z * v[i].z + v[i].w * v[i].w;
    }
    ss = wave_sum(ss);
    float rs = rsqrtf(ss * (1.f / DM) + RMS_EPS);
    uint2* d2 = (uint2*)(dst + (size_t)r * DM);
    const float4* g4 = (const float4*)gain;
#pragma unroll
    for (int i = 0; i < 8; ++i) {
      float4 g = g4[i * 64 + lane];
      uint2 o;
      o.x = pack2(v[i].x * rs * g.x, v[i].y * rs * g.y);
      o.y = pack2(v[i].z * rs * g.z, v[i].w * rs * g.w);
      d2[i * 64 + lane] = o;
    }
  }
}

template <bool CMAP>
__device__ void ph_transpose(float* smem, const float* W, int K, int N, int Npad, bf16_t* Wt) {
  float (*tl)[65] = (float (*)[65])smem;
  int tid = threadIdx.x;
  int nk = K / 64, nn = Npad / 64;
  for (int tile = blockIdx.x; tile < nk * nn; tile += gridDim.x) {
    int k0 = (tile % nk) * 64, n0 = (tile / nk) * 64;
    int col = tid & 63, rb = tid >> 6;
#pragma unroll 4
    for (int pp = 0; pp < 16; ++pp) {
      int k = pp * 4 + rb;
      float v = 0.f;
      int sc = n0 + col;
      if (CMAP) sc = (sc < 2560) ? sc : (sc < 5632) ? sc + 24 : (sc < 5656) ? sc - 5632 + 2560 : N;
      if (sc < N) v = W[(size_t)(k0 + k) * N + sc];
      tl[k][col] = v;
    }
    __syncthreads();
    int n = tid >> 2, kc = (tid & 3) * 16;
    unsigned w[8];
#pragma unroll
    for (int i = 0; i < 8; ++i) w[i] = pack2(tl[kc + 2 * i][n], tl[kc + 2 * i + 1][n]);
    uint4* dst = (uint4*)(Wt + (size_t)(n0 + n) * K + k0 + kc);
    dst[0] = make_uint4(w[0], w[1], w[2], w[3]);
    dst[1] = make_uint4(w[4], w[5], w[6], w[7]);
    __syncthreads();
  }
}

__device__ __forceinline__ int lds_off(int row, int chunk) { return row * 128 + ((chunk ^ ((row >> 1) & 7)) << 4); }

template <bool TR, class Epi>
__device__ __forceinline__ void gemm_tile_bf16(const bf16_t* xp, int ldx, const bf16_t* yp, int ldy, int K, char* lds,
                                               Epi epi) {
  const int tid = threadIdx.x, lane = tid & 63, wv = tid >> 6;
  const int wr = wv >> 1, wc = wv & 1;
  char* lx = lds;
  char* ly = lds + 16384;
  f32x16 acc[2][2];
#pragma unroll
  for (int i = 0; i < 2; ++i)
#pragma unroll
    for (int j = 0; j < 2; ++j)
#pragma unroll
      for (int r = 0; r < 16; ++r) acc[i][j][r] = 0.f;
  const int srow = tid >> 3, sch = tid & 7;
  const bf16_t* xg = xp + (size_t)srow * ldx + sch * 8;
  const bf16_t* yg = yp + (size_t)srow * ldy + sch * 8;
  const size_t x32 = (size_t)32 * ldx, y32 = (size_t)32 * ldy;
  uint4 sx0 = *(const uint4*)(xg), sx1 = *(const uint4*)(xg + x32), sx2 = *(const uint4*)(xg + 2 * x32),
        sx3 = *(const uint4*)(xg + 3 * x32);
  uint4 sy0 = *(const uint4*)(yg), sy1 = *(const uint4*)(yg + y32), sy2 = *(const uint4*)(yg + 2 * y32),
        sy3 = *(const uint4*)(yg + 3 * y32);
  const int so0 = lds_off(srow, sch), so1 = lds_off(32 + srow, sch), so2 = lds_off(64 + srow, sch),
            so3 = lds_off(96 + srow, sch);
  for (int k0 = 0; k0 < K; k0 += 64) {
    __syncthreads();
    *(uint4*)(lx + so0) = sx0; *(uint4*)(lx + so1) = sx1; *(uint4*)(lx + so2) = sx2; *(uint4*)(lx + so3) = sx3;
    *(uint4*)(ly + so0) = sy0; *(uint4*)(ly + so1) = sy1; *(uint4*)(ly + so2) = sy2; *(uint4*)(ly + so3) = sy3;
    __syncthreads();
    if (k0 + 64 < K) {
      const bf16_t* xn = xg + k0 + 64;
      const bf16_t* yn = yg + k0 + 64;
      sx0 = *(const uint4*)(xn); sx1 = *(const uint4*)(xn + x32); sx2 = *(const uint4*)(xn + 2 * x32);
      sx3 = *(const uint4*)(xn + 3 * x32);
      sy0 = *(const uint4*)(yn); sy1 = *(const uint4*)(yn + y32); sy2 = *(const uint4*)(yn + 2 * y32);
      sy3 = *(const uint4*)(yn + 3 * y32);
    }
#pragma unroll
    for (int kk = 0; kk < 4; ++kk) {
      bf16x8 a[2], b[2];
      const int ch = kk * 2 + (lane >> 5);
#pragma unroll
      for (int i = 0; i < 2; ++i) {
        a[i] = *(const bf16x8*)((TR ? ly : lx) + lds_off(wr * 64 + i * 32 + (lane & 31), ch));
        b[i] = *(const bf16x8*)((TR ? lx : ly) + lds_off(wc * 64 + i * 32 + (lane & 31), ch));
      }
#pragma unroll
      for (int i = 0; i < 2; ++i)
#pragma unroll
        for (int j = 0; j < 2; ++j) acc[i][j] = __builtin_amdgcn_mfma_f32_32x32x16_bf16(a[i], b[j], acc[i][j], 0, 0, 0);
    }
  }
  int lane2 = lane;
  asm volatile("" : "+v"(lane2));
#pragma unroll
  for (int i = 0; i < 2; ++i)
#pragma unroll
    for (int j = 0; j < 2; ++j)
#pragma unroll
      for (int r = 0; r < 16; ++r) {
        int rr = wr * 64 + i * 32 + (r & 3) + 8 * (r >> 2) + 4 * (lane2 >> 5);
        int cc = wc * 64 + j * 32 + (lane2 & 31);
        epi(rr, cc, acc[i][j][r]);
      }
}

template <class Epi>
__device__ __forceinline__ void ph_gemm_bf16(const bf16_t* A, int lda, const bf16_t* Wt, int ldw, int M, int N, int K,
                                             char* lds, Epi epi) {
  const int ntm = M / 128, ntn = N / 128;
  const int npm = (ntm + 7) / 8, npn = (ntn + 7) / 8;
  const int nslots = ((npm * npn * 64 + 511) / 512) * 512;
  for (int u = blockIdx.x; u < nslots; u += gridDim.x) {
    int v = (u & 7) * 64 + ((u >> 3) & 63) + (u & ~511);
    int patch = v >> 6, w = v & 63;
    int tm = (patch % npm) * 8 + (w & 7);
    int tn = (patch / npm) * 8 + (w >> 3);
    if (tm >= ntm || tn >= ntn) continue;
    const int m0 = tm * 128, n0 = tn * 128;
    gemm_tile_bf16<false>(A + (size_t)m0 * lda, lda, Wt + (size_t)n0 * ldw, ldw, K, lds,
                          [&](int r, int c, float val) { epi(m0 + r, n0 + c, val); });
  }
}

__device__ void ph_proj(const P& p, char* lds) {
  const int ntm = T_TOK / 128, ntn = 5760 / 128;
  const int npm = (ntm + 7) / 8, npn = (ntn + 7) / 8;
  const int nslots = ((npm * npn * 64 + 511) / 512) * 512;
  for (int u = blockIdx.x; u < nslots; u += gridDim.x) {
    int v = (u & 7) * 64 + ((u >> 3) & 63) + (u & ~511);
    int patch = v >> 6, w = v & 63;
    int tm = (patch % npm) * 8 + (w & 7);
    int tn = (patch / npm) * 8 + (w >> 3);
    if (tm >= ntm || tn >= ntn) continue;
    const int m0 = tm * 128, n0 = tn * 128;
    const bf16_t* A = p.hn + (size_t)m0 * DM;
    const bf16_t* W = p.WinT + (size_t)n0 * DM;
    if (n0 < 2560) {
      float* proj = p.proj;
      gemm_tile_bf16<false>(A, DM, W, DM, DM, lds, [&](int r, int c, float val) {
        proj[(size_t)(m0 + r) * INC + n0 + c] = val; });
    } else if (n0 < 3584) {
      bf16_t* q = p.qsb;
      gemm_tile_bf16<false>(A, DM, W, DM, DM, lds, [&](int r, int c, float val) {
        q[(size_t)(m0 + r) * 1024 + (n0 - 2560) + c] = f2bf(val); });
    } else if (n0 < 4608) {
      bf16_t* kd = p.ksb + ((size_t)((m0 >> 11) * 8 + ((n0 - 3584) >> 7)) * SEQ + (m0 & 2047)) * 128;
      gemm_tile_bf16<false>(A, DM, W, DM, DM, lds, [&](int r, int c, float val) { kd[(size_t)r * 128 + c] = f2bf(val); });
    } else if (n0 < 5632) {
      bf16_t* vd = p.vsbT + ((size_t)((m0 >> 11) * 8 + ((n0 - 4608) >> 7)) * 128) * SEQ + (m0 & 2047);
      gemm_tile_bf16<true>(A, DM, W, DM, DM, lds, [&](int r, int c, float val) { vd[(size_t)r * SEQ + perm16(c)] = f2bf(val); });
    } else {
      float* proj = p.proj;
      gemm_tile_bf16<false>(A, DM, W, DM, DM, lds, [&](int r, int c, float val) {
        if (c < 24) proj[(size_t)(m0 + r) * INC + C_GT + c] = val; });
    }
  }
}

__device__ void ph_compress(const P& p, float* smem) {
  float* red = smem;
  float* c1 = smem + 256;
  int tid = threadIdx.x, n = tid & 127, half = tid >> 7;
  for (int item = blockIdx.x; item < 2 * 8 * 127; item += gridDim.x) {
    int which = item / (8 * 127);
    int rem = item % (8 * 127);
    int bg = rem / 127, i = rem % 127;
    int b = bg >> 1, g = bg & 1;
    const float* src = p.proj + (size_t)(b * SEQ + 16 * i) * INC + (which ? C_VC : C_KC) + g * 128;
    const float* pos = which ? p.pos_v : p.pos_k;
    const float* w1 = which ? p.w1_v : p.w1_k;
    const float* w2 = which ? p.w2_v : p.w2_k;
    float acc = 0.f;
    for (int l = half * 16; l < half * 16 + 16; ++l) {
      const float* sr = src + (size_t)l * INC;
      const float* pr = pos + l * 128;
      const float* wr = w1 + (size_t)l * 128 * 128 + n;
      for (int d = 0; d < 128; ++d) acc += (sr[d] + pr[d]) * wr[(size_t)d * 128];
    }
    red[tid] = acc;
    __syncthreads();
    if (half == 0) c1[n] = gelu_tanh(red[n] + red[128 + n]);
    __syncthreads();
    if (half == 0) {
      float o = 0.f;
      for (int j = 0; j < 128; ++j) o += c1[j] * w2[j * 128 + n];
      float* dst = which ? p.vc : p.kc;
      dst[((size_t)bg * 128 + i) * 128 + n] = o;
    }
    __syncthreads();
  }
}

struct OS { float m, l, o0, o1; };

template <class F>
__device__ __forceinline__ void attn_chunk(OS& st, const float* qs, const float* Kp, const float* Vp, size_t stride,
                                           int s0, int smax, F f) {
  int lane = threadIdx.x & 63;
  int s = s0 + lane;
  bool valid = false;
  float bias = 0.f;
  if (s >= 0 && s < smax) valid = f(s, bias);
  float logit = -INFINITY;
  if (valid) {
    const float4* kr = (const float4*)(Kp + (size_t)s * stride);
    const float4* q4 = (const float4*)qs;
    float acc = 0.f;
#pragma unroll 4
    for (int i = 0; i < 32; ++i) {
      float4 kv = kr[i];
      float4 qv = q4[i];
      acc += kv.x * qv.x + kv.y * qv.y + kv.z * qv.z + kv.w * qv.w;
    }
    logit = acc * ATT_SCALE + bias;
  }
  float cm = wave_max(logit);
  if (cm == -INFINITY) return;
  float mn = fmaxf(st.m, cm);
  float alpha = expf(st.m - mn);
  float pr = valid ? expf(logit - mn) : 0.f;
  st.l = st.l * alpha + wave_sum(pr);
  st.o0 *= alpha;
  st.o1 *= alpha;
  st.m = mn;
  for (int j = 0; j < 64; ++j) {
    float pj = __shfl(pr, j);
    if (pj != 0.f) {
      const float* vr = Vp + (size_t)(s0 + j) * stride;
      st.o0 += pj * vr[lane];
      st.o1 += pj * vr[lane + 64];
    }
  }
}

__device__ void ph_nsa(const P& p, float* smem) {
  int lane = threadIdx.x & 63, wv = threadIdx.x >> 6;
  float* q = smem + wv * 512;
  float* ocm = smem + 2048 + wv * 512;
  float* pbuf = smem + 4096 + wv * 128;
  float* kbuf = smem + 4608 + wv * 64;
  for (int item = blockIdx.x; item < NBATCH * 2 * (SEQ / 4); item += gridDim.x) {
    int t = (item % (SEQ / 4)) * 4 + wv;
    int bg = item / (SEQ / 4);
    int b = bg >> 1, g = bg & 1;
    const float* prow = p.proj + (size_t)(b * SEQ + t) * INC;
    for (int i = 0; i < 8; ++i) q[lane + 64 * i] = prow[C_QN + g * 512 + lane + 64 * i];
    __builtin_amdgcn_wave_barrier();
    const float* kcb = p.kc + (size_t)bg * 128 * 128;
    const float* vcb = p.vc + (size_t)bg * 128 * 128;
    float psum0 = 0.f, psum1 = 0.f;
    for (int r = 0; r < 4; ++r) {
      int h = g * 4 + r;
      float lg[2];
      bool vd[2];
      for (int u = 0; u < 2; ++u) {
        int c = lane + 64 * u;
        int dist = t - (16 * c + 31);
        vd[u] = (c < 127) && (dist >= 0);
        lg[u] = -INFINITY;
        if (vd[u]) {
          const float4* kr = (const float4*)(kcb + (size_t)c * 128);
          const float4* q4 = (const float4*)(q + r * 128);
          float acc = 0.f;
#pragma unroll 4
          for (int i = 0; i < 32; ++i) {
            float4 kv = kr[i];
            float4 qv = q4[i];
            acc += kv.x * qv.x + kv.y * qv.y + kv.z * qv.z + kv.w * qv.w;
          }
          lg[u] = acc * ATT_SCALE + p.t5[t5_bucket(dist) * 8 + h];
        }
      }
      float m = wave_max(fmaxf(lg[0], lg[1]));
      float e0 = vd[0] ? expf(lg[0] - m) : 0.f;
      float e1 = vd[1] ? expf(lg[1] - m) : 0.f;
      float sum = wave_sum(e0 + e1);
      float inv = 1.f / fmaxf(sum, 1e-20f);
      float p0 = e0 * inv, p1 = e1 * inv;
      psum0 += p0;
      psum1 += p1;
      float o0 = 0.f, o1 = 0.f;
      int cmax = (t >= 31) ? (t - 31) / 16 : -1;
      if (cmax > 126) cmax = 126;
      for (int c = 0; c <= cmax; ++c) {
        float pc = (c < 64) ? __shfl(p0, c) : __shfl(p1, c - 64);
        const float* vr = vcb + (size_t)c * 128;
        o0 += pc * vr[lane];
        o1 += pc * vr[lane + 64];
      }
      ocm[r * 128 + lane] = o0;
      ocm[r * 128 + lane + 64] = o1;
    }
    pbuf[lane] = psum0;
    pbuf[lane + 64] = (lane + 64 < 127) ? psum1 : 0.f;
    __builtin_amdgcn_wave_barrier();
    int cur = t >> 6;
    float key = -3e9f;
    bool allowed = false;
    if (lane < 32) {
      int j = lane;
      float imp = pbuf[4 * j] + pbuf[4 * j + 1] + pbuf[4 * j + 2] + 0.5f * pbuf[4 * j + 3];
      if (j > 0) imp += 0.5f * pbuf[4 * j - 1];
      bool forced = (j == 0) || (j == cur) || (j == cur - 1);
      allowed = (j <= cur);
      key = forced ? 1e9f : (allowed ? imp : -1e9f);
      kbuf[j] = key;
    }
    __builtin_amdgcn_wave_barrier();
    bool sel = false;
    if (lane < 32) {
      int rank = 0;
      for (int i = 0; i < 32; ++i) {
        float ki = kbuf[i];
        rank += (ki > key || (ki == key && i < lane)) ? 1 : 0;
      }
      sel = (rank < 16) && allowed;
    }
    unsigned long long bal = __ballot(sel);
    unsigned selmask = (unsigned)(bal & 0xffffffffull);
    __builtin_amdgcn_wave_barrier();
    const float* Ks = p.proj + (size_t)(b * SEQ) * INC + C_KS + g * 128;
    const float* Vs = p.proj + (size_t)(b * SEQ) * INC + C_VS + g * 128;
    const float* Kw = p.proj + (size_t)(b * SEQ) * INC + C_KW + g * 128;
    const float* Vw = p.proj + (size_t)(b * SEQ) * INC + C_VW + g * 128;
    for (int r = 0; r < 4; ++r) {
      int h = g * 4 + r;
      const float* t5h = p.t5 + h;
      OS ss = {-INFINITY, 0.f, 0.f, 0.f};
      for (int j = 0; j <= cur; ++j) {
        if (!((selmask >> j) & 1u)) continue;
        attn_chunk(ss, q + r * 128, Ks, Vs, (size_t)INC, j * 64, SEQ, [&](int s, float& bias) {
          int dist = t - s;
          if (dist < 0) return false;
          bias = t5h[t5_bucket(dist) * 8];
          return true;
        });
      }
      OS sw = {-INFINITY, 0.f, 0.f, 0.f};
      for (int s0 = (t & ~63); s0 >= 0 && s0 + 63 >= t - 511; s0 -= 64) {
        attn_chunk(sw, q + r * 128, Kw, Vw, (size_t)INC, s0, SEQ, [&](int s, float& bias) {
          int dist = t - s;
          if (dist < 0 || dist >= 512) return false;
          bias = t5h[t5_bucket(dist) * 8];
          return true;
        });
      }
      float isl = 1.f / fmaxf(ss.l, 1e-20f), iwl = 1.f / fmaxf(sw.l, 1e-20f);
      float g0 = 1.f / (1.f + expf(-prow[C_GT + h * 3 + 0]));
      float g1 = 1.f / (1.f + expf(-prow[C_GT + h * 3 + 1]));
      float g2 = 1.f / (1.f + expf(-prow[C_GT + h * 3 + 2]));
      bf16_t* orow = p.omix + (size_t)(b * SEQ + t) * DM + h * 128;
      orow[lane] = f2bf(g0 * ocm[r * 128 + lane] + g1 * ss.o0 * isl + g2 * sw.o0 * iwl);
      orow[lane + 64] = f2bf(g0 * ocm[r * 128 + lane + 64] + g1 * ss.o1 * isl + g2 * sw.o1 * iwl);
    }
    __builtin_amdgcn_wave_barrier();
  }
}

#define NEG_BIG (-1e30f)

struct KVRegs { u32x4 k0, k1, k2, k3, v0, v1, v2, v3; };

__device__ __forceinline__ int koff(int row, int chunk) { return row * 256 + ((chunk ^ (row & 15)) << 4); }

__device__ __forceinline__ void kv_load(KVRegs& r, const bf16_t* kp, int ldk, const bf16_t* vp, int ldv) {
  const int tid = threadIdx.x;
  const bf16_t* kg = kp + (size_t)(tid >> 4) * ldk + (tid & 15) * 8;
  r.k0 = *(const u32x4*)kg;
  r.k1 = *(const u32x4*)(kg + (size_t)16 * ldk);
  r.k2 = *(const u32x4*)(kg + (size_t)32 * ldk);
  r.k3 = *(const u32x4*)(kg + (size_t)48 * ldk);
  const bf16_t* vg = vp + (size_t)(tid >> 3) * ldv + (tid & 7) * 8;
  r.v0 = *(const u32x4*)vg;
  r.v1 = *(const u32x4*)(vg + (size_t)32 * ldv);
  r.v2 = *(const u32x4*)(vg + (size_t)64 * ldv);
  r.v3 = *(const u32x4*)(vg + (size_t)96 * ldv);
}
__device__ __forceinline__ void kv_store(const KVRegs& r, char* lk, char* lv) {
  const int tid = threadIdx.x;
  const int row = tid >> 4, ch = tid & 15;
  *(u32x4*)(lk + koff(row, ch)) = r.k0;
  *(u32x4*)(lk + koff(row + 16, ch)) = r.k1;
  *(u32x4*)(lk + koff(row + 32, ch)) = r.k2;
  *(u32x4*)(lk + koff(row + 48, ch)) = r.k3;
  const int vr = tid >> 3, vc = tid & 7;
  *(u32x4*)(lv + lds_off(vr, vc)) = r.v0;
  *(u32x4*)(lv + lds_off(vr + 32, vc)) = r.v1;
  *(u32x4*)(lv + lds_off(vr + 64, vc)) = r.v2;
  *(u32x4*)(lv + lds_off(vr + 96, vc)) = r.v3;
}

struct QFrag { bf16x8 f0, f1, f2, f3, f4, f5, f6, f7; };
__device__ __forceinline__ void q_load(QFrag& q, const bf16_t* qrow) {
  const int h = (threadIdx.x & 63) >> 5;
  const bf16x8* p8 = (const bf16x8*)(qrow + 8 * h);
  q.f0 = p8[0]; q.f1 = p8[2]; q.f2 = p8[4]; q.f3 = p8[6]; q.f4 = p8[8]; q.f5 = p8[10]; q.f6 = p8[12]; q.f7 = p8[14];
}

__device__ __forceinline__ void qk_tile(const QFrag& q, const char* lk, f32x16& s0, f32x16& s1) {
  const int lane = threadIdx.x & 63, row = lane & 31, h = lane >> 5;
#pragma unroll
  for (int r = 0; r < 16; ++r) { s0[r] = 0.f; s1[r] = 0.f; }
#define QK_STEP(kk, qf)                                                                  \
  {                                                                                      \
    bf16x8 a0 = *(const bf16x8*)(lk + koff(row, 2 * (kk) + h));                          \
    bf16x8 a1 = *(const bf16x8*)(lk + koff(row + 32, 2 * (kk) + h));                     \
    s0 = __builtin_amdgcn_mfma_f32_32x32x16_bf16(a0, qf, s0, 0, 0, 0);                   \
    s1 = __builtin_amdgcn_mfma_f32_32x32x16_bf16(a1, qf, s1, 0, 0, 0);                   \
  }
  QK_STEP(0, q.f0) QK_STEP(1, q.f1) QK_STEP(2, q.f2) QK_STEP(3, q.f3)
  QK_STEP(4, q.f4) QK_STEP(5, q.f5) QK_STEP(6, q.f6) QK_STEP(7, q.f7)
#undef QK_STEP
}

__device__ __forceinline__ bf16x8 pack8(const f32x16& p, const int base) {
  u32x4 u;
  u[0] = pack2(p[base + 0], p[base + 1]);
  u[1] = pack2(p[base + 2], p[base + 3]);
  u[2] = pack2(p[base + 4], p[base + 5]);
  u[3] = pack2(p[base + 6], p[base + 7]);
  return __builtin_bit_cast(bf16x8, u);
}

struct OAcc { f32x16 o0, o1, o2, o3; };
__device__ __forceinline__ void oacc_zero(OAcc& o) {
#pragma unroll
  for (int r = 0; r < 16; ++r) { o.o0[r] = 0.f; o.o1[r] = 0.f; o.o2[r] = 0.f; o.o3[r] = 0.f; }
}
__device__ __forceinline__ void oacc_scale(OAcc& o, float a) {
#pragma unroll
  for (int r = 0; r < 16; ++r) { o.o0[r] *= a; o.o1[r] *= a; o.o2[r] *= a; o.o3[r] *= a; }
}

__device__ __forceinline__ void pv_tile(OAcc& o, const char* lv, const f32x16& p0, const f32x16& p1) {
  const int lane = threadIdx.x & 63, row = lane & 31, h = lane >> 5;
  const bf16x8 pf0 = pack8(p0, 0), pf1 = pack8(p0, 8), pf2 = pack8(p1, 0), pf3 = pack8(p1, 8);
#define PV_ROW(dd, acc)                                                                                      \
  {                                                                                                          \
    acc = __builtin_amdgcn_mfma_f32_32x32x16_bf16(*(const bf16x8*)(lv + lds_off(32 * (dd) + row, 0 + h)), pf0, acc, 0, 0, 0); \
    acc = __builtin_amdgcn_mfma_f32_32x32x16_bf16(*(const bf16x8*)(lv + lds_off(32 * (dd) + row, 2 + h)), pf1, acc, 0, 0, 0); \
    acc = __builtin_amdgcn_mfma_f32_32x32x16_bf16(*(const bf16x8*)(lv + lds_off(32 * (dd) + row, 4 + h)), pf2, acc, 0, 0, 0); \
    acc = __builtin_amdgcn_mfma_f32_32x32x16_bf16(*(const bf16x8*)(lv + lds_off(32 * (dd) + row, 6 + h)), pf3, acc, 0, 0, 0); \
  }
  PV_ROW(0, o.o0) PV_ROW(1, o.o1) PV_ROW(2, o.o2) PV_ROW(3, o.o3)
#undef PV_ROW
}

__device__ __forceinline__ void softmax_tile(f32x16& s0, f32x16& s1, float& m, float& l, OAcc& o) {
  float mx = NEG_BIG;
#pragma unroll
  for (int r = 0; r < 16; ++r) mx = fmaxf(mx, fmaxf(s0[r], s1[r]));
  mx = fmaxf(mx, __shfl_xor(mx, 32));
  const float mn = fmaxf(m, mx);
  const float alpha = __expf(m - mn);
  float ls = 0.f;
#pragma unroll
  for (int r = 0; r < 16; ++r) {
    float a = (s0[r] > -1e29f) ? __expf(s0[r] - mn) : 0.f;
    float b = (s1[r] > -1e29f) ? __expf(s1[r] - mn) : 0.f;
    s0[r] = a; s1[r] = b;
    ls += a + b;
  }
  ls += __shfl_xor(ls, 32);
  l = l * alpha + ls;
  m = mn;
  oacc_scale(o, alpha);
}

template <class F>
__device__ __forceinline__ void oacc_foreach(const OAcc& o, F f) {
  const int h = (threadIdx.x & 63) >> 5;
#pragma unroll
  for (int rho = 0; rho < 4; ++rho) {
    f(0 + 8 * rho + 4 * h, o.o0[4 * rho], o.o0[4 * rho + 1], o.o0[4 * rho + 2], o.o0[4 * rho + 3]);
    f(32 + 8 * rho + 4 * h, o.o1[4 * rho], o.o1[4 * rho + 1], o.o1[4 * rho + 2], o.o1[4 * rho + 3]);
    f(64 + 8 * rho + 4 * h, o.o2[4 * rho], o.o2[4 * rho + 1], o.o2[4 * rho + 2], o.o2[4 * rho + 3]);
    f(96 + 8 * rho + 4 * h, o.o3[4 * rho], o.o3[4 * rho + 1], o.o3[4 * rho + 2], o.o3[4 * rho + 3]);
  }
}

__device__ void ph_memattn2(const P& p, char* lds) {
  char* lk = lds;
  char* lv = lds + 16384;
  const int lane = threadIdx.x & 63, wv = threadIdx.x >> 6;
  for (int item = blockIdx.x; item < NBATCH * 4 * (SEQ / 128); item += gridDim.x) {
    const int tb = item % (SEQ / 128);
    const int bh = item / (SEQ / 128);
    const int b = bh >> 2, hd = bh & 3;
    const int t = tb * 128 + wv * 32 + (lane & 31);
    QFrag q;
    q_load(q, p.qmemb + (size_t)(b * SEQ + t) * 512 + hd * 128);
    const bf16_t* kb = p.kmemb + (size_t)bh * 256 * 128;
    const bf16_t* vb = p.vmemT + (size_t)bh * 128 * 256;
    OAcc o;
    oacc_zero(o);
    float m = NEG_BIG, l = 0.f;
    KVRegs kv;
    kv_load(kv, kb, 128, vb, 256);
    for (int ti = 0; ti < 4; ++ti) {
      __syncthreads();
      kv_store(kv, lk, lv);
      __syncthreads();
      {
        const int tn = (ti + 1 < 4) ? ti + 1 : 3;
        kv_load(kv, kb + (size_t)tn * 64 * 128, 128, vb + tn * 64, 256);
      }
      f32x16 s0, s1;
      qk_tile(q, lk, s0, s1);
#pragma unroll
      for (int r = 0; r < 16; ++r) { s0[r] *= ATT_SCALE; s1[r] *= ATT_SCALE; }
      softmax_tile(s0, s1, m, l, o);
      pv_tile(o, lv, s0, s1);
    }
    const float il = 1.f / l;
    int t2 = t;
    asm volatile("" : "+v"(t2));
    bf16_t* orow = p.omem + (size_t)(b * SEQ + t2) * 512 + hd * 128;
    oacc_foreach(o, [&](int d, float v0, float v1, float v2, float v3) {
      uint2 u;
      u.x = pack2(v0 * il, v1 * il);
      u.y = pack2(v2 * il, v3 * il);
      *(uint2*)(orow + d) = u;
    });
  }
}

__device__ void ph_sb2(const P& p, char* lds) {
  char* lk = lds;
  char* lv = lds + 16384;
  const int lane = threadIdx.x & 63, wv = threadIdx.x >> 6, hh = lane >> 5;
  for (int item = blockIdx.x; item < NBATCH * 8 * (SEQ / 128); item += gridDim.x) {
    const int tb = (SEQ / 128 - 1) - (item % (SEQ / 128));
    const int bh = item / (SEQ / 128);
    const int b = bh >> 3, hd = bh & 7;
    const int t0 = tb * 128;
    const int t = t0 + wv * 32 + (lane & 31);
    QFrag q;
    q_load(q, p.qsb + (size_t)(b * SEQ + t) * 1024 + hd * 128);
    const bf16_t* kb = p.ksb + (size_t)bh * SEQ * 128;
    const bf16_t* vb = p.vsbT + (size_t)bh * 128 * SEQ;
    OAcc o;
    oacc_zero(o);
    float carry = 0.f;
    const int jhi = (t0 >> 6) + 1;
    const int jw = (t0 + wv * 32 + 30) >> 6;
    KVRegs kv;
    kv_load(kv, kb + (size_t)jhi * 64 * 128, 128, vb + jhi * 64, SEQ);
    for (int j = jhi; j >= 0; --j) {
      __syncthreads();
      kv_store(kv, lk, lv);
      __syncthreads();
      const int jn = (j > 0) ? j - 1 : 0;
      if (j > jw) kv_load(kv, kb + (size_t)jn * 64 * 128, 128, vb + jn * 64, SEQ);
      if (j <= jw) {
        f32x16 z0, z1;
        qk_tile(q, lk, z0, z1);
        const int sbase = j * 64 + 4 * hh;
        float gt[8];
        f32x16 l0, l1;
#pragma unroll
        for (int r = 0; r < 16; ++r) {
          const int so = sbase + 8 * (r >> 2) + (r & 3);
          {
            const float z = z0[r] * ATT_SCALE;
            const bool valid = so < t;
            const float lsp = fminf(z, 0.f) - __logf(1.f + __expf(-fabsf(z)));
            l0[r] = valid ? (lsp - z) : 0.f;
            z0[r] = valid ? z : NEG_BIG;
          }
          {
            const float z = z1[r] * ATT_SCALE;
            const bool valid = so + 32 < t;
            const float lsp = fminf(z, 0.f) - __logf(1.f + __expf(-fabsf(z)));
            l1[r] = valid ? (lsp - z) : 0.f;
            z1[r] = valid ? z : NEG_BIG;
          }
        }
#pragma unroll
        for (int rho = 0; rho < 4; ++rho) {
          gt[rho] = (l0[4 * rho] + l0[4 * rho + 1]) + (l0[4 * rho + 2] + l0[4 * rho + 3]);
          gt[4 + rho] = (l1[4 * rho] + l1[4 * rho + 1]) + (l1[4 * rho + 2] + l1[4 * rho + 3]);
        }
        float ag[8];
        float run = 0.f;
#pragma unroll
        for (int k = 7; k >= 0; --k) {
          const float pg = __shfl_xor(gt[k], 32);
          ag[k] = carry + run + (hh == 0 ? pg : 0.f);
          run += gt[k] + pg;
        }
        carry += run;
#pragma unroll
        for (int rho = 0; rho < 4; ++rho) {
          {
            const float x3 = l0[4 * rho + 3], x23 = x3 + l0[4 * rho + 2], x123 = x23 + l0[4 * rho + 1];
            const float g = ag[rho];
            z0[4 * rho + 0] = __expf((l0[4 * rho + 0] + z0[4 * rho + 0]) + (g + x123));
            z0[4 * rho + 1] = __expf((l0[4 * rho + 1] + z0[4 * rho + 1]) + (g + x23));
            z0[4 * rho + 2] = __expf((l0[4 * rho + 2] + z0[4 * rho + 2]) + (g + x3));
            z0[4 * rho + 3] = __expf((l0[4 * rho + 3] + z0[4 * rho + 3]) + g);
          }
          {
            const float x3 = l1[4 * rho + 3], x23 = x3 + l1[4 * rho + 2], x123 = x23 + l1[4 * rho + 1];
            const float g = ag[4 + rho];
            z1[4 * rho + 0] = __expf((l1[4 * rho + 0] + z1[4 * rho + 0]) + (g + x123));
            z1[4 * rho + 1] = __expf((l1[4 * rho + 1] + z1[4 * rho + 1]) + (g + x23));
            z1[4 * rho + 2] = __expf((l1[4 * rho + 2] + z1[4 * rho + 2]) + (g + x3));
            z1[4 * rho + 3] = __expf((l1[4 * rho + 3] + z1[4 * rho + 3]) + g);
          }
        }
        kv_load(kv, kb + (size_t)jn * 64 * 128, 128, vb + jn * 64, SEQ);
        pv_tile(o, lv, z0, z1);
      }
    }
    int t2 = t;
    asm volatile("" : "+v"(t2));
    bf16_t* orow = p.omix + (size_t)(b * SEQ + t2) * DM + 1024 + hd * 128;
    oacc_foreach(o, [&](int d, float v0, float v1, float v2, float v3) {
      uint2 u;
      u.x = pack2(v0, v1);
      u.y = pack2(v2, v3);
      *(uint2*)(orow + d) = u;
    });
  }
}

__device__ void ph_cvt(const float* src, bf16_t* dst, size_t n) {
  typedef __attribute__((ext_vector_type(4))) float f32x4;
  const size_t nv = n / 8;
  for (size_t i = (size_t)blockIdx.x * 256 + threadIdx.x; i < nv; i += (size_t)gridDim.x * 256) {
    const f32x4 a = ((const f32x4*)src)[2 * i], b = ((const f32x4*)src)[2 * i + 1];
    u32x4 o;
    o[0] = pack2(a[0], a[1]); o[1] = pack2(a[2], a[3]); o[2] = pack2(b[0], b[1]); o[3] = pack2(b[2], b[3]);
    ((u32x4*)dst)[i] = o;
  }
}

__device__ void ph_scores(const P& p, char* lds) {
  for (int u = blockIdx.x; u < 64 * 16; u += gridDim.x) {
    const int tm = u & 63, hp = u >> 6;
    const int m0 = tm * 128;
    float* sc = p.proj + (size_t)m0 * DM + hp * 128;
    gemm_tile_bf16<false>(p.omix + (size_t)m0 * DM + hp * 128, DM, p.subkb + (size_t)hp * 128 * 128, 128, 128, lds,
                          [&](int r, int c, float val) { sc[(size_t)r * DM + c] = val; });
  }
}

struct ERows { u32x4 u0, u1, u2, u3, v0, v1, v2, v3; };
__device__ __forceinline__ void erows_load(ERows& r, const bf16_t* pu, const bf16_t* pv, int eid, int lane) {
  const u32x4* ur = (const u32x4*)(pu + (size_t)eid * DM) + lane;
  const u32x4* vr = (const u32x4*)(pv + (size_t)eid * DM) + lane;
  r.u0 = ur[0]; r.u1 = ur[64]; r.u2 = ur[128]; r.u3 = ur[192];
  r.v0 = vr[0]; r.v1 = vr[64]; r.v2 = vr[128]; r.v3 = vr[192];
}
__device__ __forceinline__ float dot2bf(unsigned a, unsigned b, float c) {
  return __builtin_amdgcn_fdot2_f32_bf16(__builtin_bit_cast(bf16v2, a), __builtin_bit_cast(bf16v2, b), c, false);
}
__device__ __forceinline__ float gelu_fast(float x) {
  const float y = 1.5957691216057308f * (x + 0.044715f * x * x * x);
  return x / (1.f + __expf(-y));
}
struct XPk { u32x4 x0, x1, x2, x3; };
struct Acc32 { f32x16 a, b; };

__device__ __forceinline__ void peer_pair(const ERows& ea, const ERows& eb, const XPk& x, float ga, float gb, Acc32& acc) {
  float pa = 0.f, pb = 0.f;
#pragma unroll
  for (int w = 0; w < 4; ++w) {
    pa = dot2bf(ea.u0[w], x.x0[w], pa); pa = dot2bf(ea.u1[w], x.x1[w], pa);
    pa = dot2bf(ea.u2[w], x.x2[w], pa); pa = dot2bf(ea.u3[w], x.x3[w], pa);
    pb = dot2bf(eb.u0[w], x.x0[w], pb); pb = dot2bf(eb.u1[w], x.x1[w], pb);
    pb = dot2bf(eb.u2[w], x.x2[w], pb); pb = dot2bf(eb.u3[w], x.x3[w], pb);
  }
#pragma unroll
  for (int o = 32; o > 0; o >>= 1) { pa += __shfl_xor(pa, o); pb += __shfl_xor(pb, o); }
  const unsigned hpk = pack2(ga * gelu_fast(pa), gb * gelu_fast(pb));
#define PEER_V(va, vb, accv, base)                                              \
  _Pragma("unroll") for (int w = 0; w < 4; ++w) {                               \
    const unsigned A = va[w], B = vb[w];                                        \
    const unsigned lo = (A & 0xffffu) | (B << 16);                              \
    const unsigned hi = (A >> 16) | (B & 0xffff0000u);                          \
    accv[base + 2 * w] = dot2bf(lo, hpk, accv[base + 2 * w]);                   \
    accv[base + 2 * w + 1] = dot2bf(hi, hpk, accv[base + 2 * w + 1]);           \
  }
  PEER_V(ea.v0, eb.v0, acc.a, 0) PEER_V(ea.v1, eb.v1, acc.a, 8) PEER_V(ea.v2, eb.v2, acc.b, 0) PEER_V(ea.v3, eb.v3, acc.b, 8)
#undef PEER_V
}

__device__ void ph_peer(const P& p, float* smem) {
  typedef __attribute__((ext_vector_type(4))) float f32x4;
  int lane = threadIdx.x & 63, wv = threadIdx.x >> 6;
  float* ts = smem + wv * 256;
  int* ti = (int*)(smem + 1024) + wv * 256;
  float* bgt = smem + 2048 + wv * 128;
  int* bex = (int*)(smem + 2560) + wv * 128;
  for (int item = blockIdx.x; item < T_TOK / 4; item += gridDim.x) {
    int t = item * 4 + wv;
    const float* scrow = p.proj + (size_t)t * DM;
    for (int hp = 0; hp < 16; ++hp) {
      float sc0 = scrow[hp * 128 + lane], sc1 = scrow[hp * 128 + 64 + lane];
      for (int n = 0; n < 16; ++n) {
        float v;
        int i;
        if (sc0 >= sc1) { v = sc0; i = lane; } else { v = sc1; i = lane + 64; }
        wave_argmax(v, i);
        if (lane == 0) { ts[hp * 16 + n] = v; ti[hp * 16 + n] = i; }
        if (i == lane) sc0 = -INFINITY;
        if (i == lane + 64) sc1 = -INFINITY;
      }
    }
    __builtin_amdgcn_wave_barrier();
    for (int h = 0; h < 8; ++h) {
      float cv0, cv1, cv2, cv3;
      cv0 = ts[(2 * h) * 16 + ((lane) >> 4)] + ts[(2 * h + 1) * 16 + (lane & 15)];
      cv1 = ts[(2 * h) * 16 + ((64 + lane) >> 4)] + ts[(2 * h + 1) * 16 + (lane & 15)];
      cv2 = ts[(2 * h) * 16 + ((128 + lane) >> 4)] + ts[(2 * h + 1) * 16 + (lane & 15)];
      cv3 = ts[(2 * h) * 16 + ((192 + lane) >> 4)] + ts[(2 * h + 1) * 16 + (lane & 15)];
      float mybest = 0.f;
      int myc = 0;
      for (int n = 0; n < 16; ++n) {
        float v = cv0;
        int i = lane;
        if (cv1 > v) { v = cv1; i = 64 + lane; }
        if (cv2 > v) { v = cv2; i = 128 + lane; }
        if (cv3 > v) { v = cv3; i = 192 + lane; }
        wave_argmax(v, i);
        if (lane == n) { mybest = v; myc = i; }
        if (i == lane) cv0 = -INFINITY;
        if (i == 64 + lane) cv1 = -INFINITY;
        if (i == 128 + lane) cv2 = -INFINITY;
        if (i == 192 + lane) cv3 = -INFINITY;
      }
      float sv = (lane < 16) ? mybest : -INFINITY;
      float mx = wave_max(sv);
      float e = (lane < 16) ? expf(sv - mx) : 0.f;
      float sum = wave_sum(e);
      if (lane < 16) {
        bgt[h * 16 + lane] = e / sum;
        bex[h * 16 + lane] = ti[(2 * h) * 16 + (myc >> 4)] * 128 + ti[(2 * h + 1) * 16 + (myc & 15)];
      }
    }
    __builtin_amdgcn_wave_barrier();
    XPk x;
    {
      const f32x4* s4 = (const f32x4*)(p.out + (size_t)t * DM);
      const f32x4* g4 = (const f32x4*)p.norm_ffn;
      f32x4 a0 = s4[lane * 2], a1 = s4[lane * 2 + 1], a2 = s4[128 + lane * 2], a3 = s4[128 + lane * 2 + 1];
      f32x4 a4 = s4[256 + lane * 2], a5 = s4[256 + lane * 2 + 1], a6 = s4[384 + lane * 2], a7 = s4[384 + lane * 2 + 1];
      float ss = 0.f;
#define SSQ(v) ss += v[0] * v[0] + v[1] * v[1] + v[2] * v[2] + v[3] * v[3];
      SSQ(a0) SSQ(a1) SSQ(a2) SSQ(a3) SSQ(a4) SSQ(a5) SSQ(a6) SSQ(a7)
#undef SSQ
      ss = wave_sum(ss);
      const float rs = rsqrtf(ss * (1.f / DM) + RMS_EPS);
#define XPK(dst, va, vb, gi)                                                          \
  {                                                                                   \
    const f32x4 ga = g4[gi], gb = g4[gi + 1];                                         \
    dst[0] = pack2(va[0] * rs * ga[0], va[1] * rs * ga[1]);                           \
    dst[1] = pack2(va[2] * rs * ga[2], va[3] * rs * ga[3]);                           \
    dst[2] = pack2(vb[0] * rs * gb[0], vb[1] * rs * gb[1]);                           \
    dst[3] = pack2(vb[2] * rs * gb[2], vb[3] * rs * gb[3]);                           \
  }
      XPK(x.x0, a0, a1, lane * 2) XPK(x.x1, a2, a3, 128 + lane * 2) XPK(x.x2, a4, a5, 256 + lane * 2) XPK(x.x3, a6, a7, 384 + lane * 2)
#undef XPK
    }
    Acc32 acc;
#pragma unroll
    for (int r = 0; r < 16; ++r) { acc.a[r] = 0.f; acc.b[r] = 0.f; }
    ERows ca, cb, na, nb;
    erows_load(ca, p.pub, p.pvb, bex[0], lane);
    erows_load(cb, p.pub, p.pvb, bex[1], lane);
    for (int pr = 0; pr < 64; pr += 2) {
      erows_load(na, p.pub, p.pvb, bex[2 * pr + 2], lane);
      erows_load(nb, p.pub, p.pvb, bex[2 * pr + 3], lane);
      peer_pair(ca, cb, x, bgt[2 * pr], bgt[2 * pr + 1], acc);
      const int e2 = (2 * pr + 4 < 128) ? 2 * pr + 4 : 126;
      erows_load(ca, p.pub, p.pvb, bex[e2], lane);
      erows_load(cb, p.pub, p.pvb, bex[e2 + 1], lane);
      peer_pair(na, nb, x, bgt[2 * pr + 2], bgt[2 * pr + 3], acc);
    }
    int lane2 = lane;
    asm volatile("" : "+v"(lane2));
    f32x4* o4 = (f32x4*)(p.out + (size_t)t * DM);
    const f32x4* g4 = (const f32x4*)p.norm_final;
    f32x4 hv[8];
    float ss = 0.f;
#pragma unroll
    for (int i = 0; i < 4; ++i) {
      hv[2 * i] = o4[i * 128 + lane2 * 2];
      hv[2 * i + 1] = o4[i * 128 + lane2 * 2 + 1];
#pragma unroll
      for (int c = 0; c < 4; ++c) {
        hv[2 * i][c] += (i < 2) ? acc.a[(i & 1) * 8 + c] : acc.b[(i & 1) * 8 + c];
        hv[2 * i + 1][c] += (i < 2) ? acc.a[(i & 1) * 8 + 4 + c] : acc.b[(i & 1) * 8 + 4 + c];
        ss += hv[2 * i][c] * hv[2 * i][c] + hv[2 * i + 1][c] * hv[2 * i + 1][c];
      }
    }
    ss = wave_sum(ss);
    const float rs = rsqrtf(ss * (1.f / DM) + RMS_EPS);
#pragma unroll
    for (int i = 0; i < 4; ++i) {
      const f32x4 ga = g4[i * 128 + lane2 * 2], gb = g4[i * 128 + lane2 * 2 + 1];
      f32x4 oa, ob;
#pragma unroll
      for (int c = 0; c < 4; ++c) { oa[c] = hv[2 * i][c] * rs * ga[c]; ob[c] = hv[2 * i + 1][c] * rs * gb[c]; }
      o4[i * 128 + lane2 * 2] = oa;
      o4[i * 128 + lane2 * 2 + 1] = ob;
    }
    __builtin_amdgcn_wave_barrier();
  }
}

typedef const __attribute__((address_space(4))) P* KP;
__device__ __forceinline__ P loadP() {
#if defined(__HIP_DEVICE_COMPILE__)
  KP k = (KP)__builtin_amdgcn_kernarg_segment_ptr();
  asm volatile("" : "+s"(k));
  P p = *k;
  return p;
#else
  return P{};
#endif
}

__global__ void __launch_bounds__(256, 2) mega(P p_arg) {
  cg::grid_group grid = cg::this_grid();
  __shared__ __attribute__((aligned(16))) float smem[12288];
  char* lds = (char*)smem;
  { P p = loadP(); ph_rmsnorm(p.x, p.norm_mix, p.hn, T_TOK); ph_rmsnorm(p.mem, p.norm_mkv, p.memn, 1024); }
  { P p = loadP(); ph_transpose<true>(smem, p.w_in, DM, INC, 5760, p.WinT); }
  { P p = loadP(); ph_transpose<false>(smem, p.w_out, DM, DM, DM, p.WoutT); }
  { P p = loadP(); ph_transpose<false>(smem, p.w_pq, DM, DM, DM, p.WpqT); }
  { P p = loadP(); ph_transpose<false>(smem, p.w_mq, DM, 512, 512, p.WmqT); }
  { P p = loadP(); ph_transpose<false>(smem, p.w_mk, DM, 512, 512, p.WmkT); }
  { P p = loadP(); ph_transpose<false>(smem, p.w_mv, DM, 512, 512, p.WmvT); }
  { P p = loadP(); ph_transpose<false>(smem, p.w_mo, 512, DM, DM, p.WmoT); }
  { P p = loadP(); ph_cvt(p.pu, p.pub, (size_t)16384 * DM); }
  { P p = loadP(); ph_cvt(p.pv, p.pvb, (size_t)16384 * DM); }
  { P p = loadP(); ph_cvt(p.subk, p.subkb, (size_t)16 * 128 * 128); }
  grid.sync();
  { P p = loadP(); ph_proj(p, lds); }
  { P p = loadP(); bf16_t* kmem = p.kmemb;
    ph_gemm_bf16(p.memn, DM, p.WmkT, DM, 1024, 512, DM, lds, [=](int m, int n, float v) {
      kmem[((size_t)((m >> 8) * 4 + (n >> 7)) * 256 + (m & 255)) * 128 + (n & 127)] = f2bf(v); }); }
  { P p = loadP(); bf16_t* vmem = p.vmemT;
    ph_gemm_bf16(p.memn, DM, p.WmvT, DM, 1024, 512, DM, lds, [=](int m, int n, float v) {
      vmem[((size_t)((m >> 8) * 4 + (n >> 7)) * 128 + (n & 127)) * 256 + perm16(m & 255)] = f2bf(v); }); }
  grid.sync();
  { P p = loadP(); ph_compress(p, smem); }
  { P p = loadP(); ph_sb2(p, lds); }
  grid.sync();
  { P p = loadP(); ph_nsa(p, smem); }
  grid.sync();
  { P p = loadP(); float* out = p.out; const float* x = p.x;
    ph_gemm_bf16(p.omix, DM, p.WoutT, DM, T_TOK, DM, DM, lds, [=](int m, int n, float v) { out[(size_t)m * DM + n] = x[(size_t)m * DM + n] + v; }); }
  grid.sync();
  { P p = loadP(); ph_rmsnorm(p.out, p.norm_mq, p.hn, T_TOK); }
  grid.sync();
  { P p = loadP(); bf16_t* qmem = p.qmemb;
    ph_gemm_bf16(p.hn, DM, p.WmqT, DM, T_TOK, 512, DM, lds, [=](int m, int n, float v) { qmem[(size_t)m * 512 + n] = f2bf(v); }); }
  grid.sync();
  { P p = loadP(); ph_memattn2(p, lds); }
  grid.sync();
  { P p = loadP(); float* out = p.out;
    ph_gemm_bf16(p.omem, 512, p.WmoT, 512, T_TOK, DM, 512, lds, [=](int m, int n, float v) { out[(size_t)m * DM + n] += v; }); }
  grid.sync();
  { P p = loadP(); ph_rmsnorm(p.out, p.norm_ffn, p.hn, T_TOK); }
  grid.sync();
  { P p = loadP(); bf16_t* qp = p.omix;
    ph_gemm_bf16(p.hn, DM, p.WpqT, DM, T_TOK, DM, DM, lds, [=](int m, int n, float v) { qp[(size_t)m * DM + n] = f2bf(v); }); }
  grid.sync();
  { P p = loadP(); ph_scores(p, lds); }
  grid.sync();
  { P p = loadP(); ph_peer(p, smem); }
}

extern "C" void kernel_launch(void* const* d_in, const int* in_sizes, int n_in, void* d_out, int out_size, void* d_ws,
                              size_t ws_size, hipStream_t stream) {
  P p{};
  p.x = (const float*)d_in[0]; p.mem = (const float*)d_in[1]; p.t5 = (const float*)d_in[2];
  p.norm_mix = (const float*)d_in[3]; p.w_in = (const float*)d_in[4]; p.pos_k = (const float*)d_in[5];
  p.w1_k = (const float*)d_in[6]; p.w2_k = (const float*)d_in[7]; p.pos_v = (const float*)d_in[8];
  p.w1_v = (const float*)d_in[9]; p.w2_v = (const float*)d_in[10]; p.w_out = (const float*)d_in[11];
  p.norm_mq = (const float*)d_in[12]; p.norm_mkv = (const float*)d_in[13]; p.w_mq = (const float*)d_in[14];
  p.w_mk = (const float*)d_in[15]; p.w_mv = (const float*)d_in[16]; p.w_mo = (const float*)d_in[17];
  p.norm_ffn = (const float*)d_in[18]; p.w_pq = (const float*)d_in[19]; p.subk = (const float*)d_in[20];
  p.pu = (const float*)d_in[21]; p.pv = (const float*)d_in[22]; p.norm_final = (const float*)d_in[23];
  p.out = (float*)d_out;
  char* w = (char*)d_ws;
  size_t off = 0;
  auto take = [&](size_t bytes) { char* r = w + off; off += (bytes + 255) & ~(size_t)255; return r; };
  p.proj = (float*)take((size_t)T_TOK * INC * 4);
  p.kc = (float*)take(8 * 128 * 128 * 4);
  p.vc = (float*)take(8 * 128 * 128 * 4);
  p.hn = (bf16_t*)take((size_t)T_TOK * DM * 2);
  p.omix = (bf16_t*)take((size_t)T_TOK * DM * 2);
  p.memn = (bf16_t*)take((size_t)1024 * DM * 2);
  p.omem = (bf16_t*)take((size_t)T_TOK * 512 * 2);
  p.WinT = (bf16_t*)take((size_t)5760 * DM * 2);
  p.WoutT = (bf16_t*)take((size_t)DM * DM * 2);
  p.WpqT = (bf16_t*)take((size_t)DM * DM * 2);
  p.WmqT = (bf16_t*)take((size_t)512 * DM * 2);
  p.WmkT = (bf16_t*)take((size_t)512 * DM * 2);
  p.WmvT = (bf16_t*)take((size_t)512 * DM * 2);
  p.WmoT = (bf16_t*)take((size_t)DM * 512 * 2);
  p.qmemb = (bf16_t*)take((size_t)T_TOK * 512 * 2);
  p.kmemb = (bf16_t*)take((size_t)1024 * 512 * 2);
  p.vmemT = (bf16_t*)take((size_t)1024 * 512 * 2);
  p.qsb = (bf16_t*)take((size_t)T_TOK * 1024 * 2);
  p.ksb = (bf16_t*)take((size_t)T_TOK * 1024 * 2);
  p.vsbT = (bf16_t*)take((size_t)T_TOK * 1024 * 2);
  p.pub = (bf16_t*)take((size_t)16384 * DM * 2);
  p.pvb = (bf16_t*)take((size_t)16384 * DM * 2);
  p.subkb = (bf16_t*)take((size_t)16 * 128 * 128 * 2);
  static int grid_blocks = 0;
  if (!grid_blocks) {
    int dev = 0, cus = 0, per_cu = 0;
    (void)hipGetDevice(&dev);
    (void)hipDeviceGetAttribute(&cus, hipDeviceAttributeMultiprocessorCount, dev);
    (void)hipOccupancyMaxActiveBlocksPerMultiprocessor(&per_cu, mega, 256, 0);
    if (per_cu > 2) per_cu = 2;
    if (per_cu < 1) per_cu = 1;
    grid_blocks = cus * per_cu;
  }
  void* args[] = {&p};
  hipError_t e = hipLaunchCooperativeKernel((void*)mega, dim3(grid_blocks), dim3(256), args, 0, stream);
  if (e != hipSuccess) fprintf(stderr, "cooperative launch failed: %s (grid %d)\n", hipGetErrorString(e), grid_blocks);
}
```

```cpp
#include <hip/hip_runtime.h>
#include <hip/hip_cooperative_groups.h>
#include <cstdio>
namespace cg = cooperative_groups;
#include <stdint.h>

#define SEQ 2048
#define NBATCH 4
#define T_TOK 8192
#define DM 2048
#define INC 5656
#define C_QN 0
#define C_KC 1024
#define C_VC 1280
#define C_KS 1536
#define C_VS 1792
#define C_KW 2048
#define C_VW 2304
#define C_GT 2560
#define C_QSB 2584
#define C_KSB 3608
#define C_VSB 4632
#define ATT_SCALE 0.08838834764831845f
#define RMS_EPS 1e-6f

typedef unsigned short bf16_t;
typedef __attribute__((ext_vector_type(8))) short bf16x8;
typedef __attribute__((ext_vector_type(16))) float f32x16;
typedef __attribute__((ext_vector_type(2))) __bf16 bf16v2;
typedef __attribute__((ext_vector_type(4))) unsigned u32x4;

struct P {
  const float *x, *mem, *t5, *norm_mix, *w_in, *pos_k, *w1_k, *w2_k, *pos_v, *w1_v, *w2_v, *w_out,
      *norm_mq, *norm_mkv, *w_mq, *w_mk, *w_mv, *w_mo, *norm_ffn, *w_pq, *subk, *pu, *pv, *norm_final;
  float* out;
  float *scores, *gates, *part, *posb;
  bf16_t *hn, *omix, *memn, *omem;
  bf16_t *WinT, *WoutT, *WpqT, *WmqT, *WmkT, *WmvT, *WmoT;
  bf16_t *qmemb, *kmemb, *vmemT;
  bf16_t *qsb, *ksb, *vsbT;
  bf16_t *pub, *pvb, *subkb;
  bf16_t *qn, *kcin, *vcin, *ks, *vsT, *kw, *vwT, *kcb, *vcT, *c1, *w1T, *w2T;
};

__device__ __forceinline__ int opq(int v) { asm volatile("" : "+v"(v)); return v; }
__device__ __forceinline__ unsigned pack2(float a, float b) {
  bf16v2 r = {(__bf16)a, (__bf16)b};
  return *(unsigned*)&r;
}
__device__ __forceinline__ bf16_t f2bf(float a) {
  __bf16 r = (__bf16)a;
  return *(bf16_t*)&r;
}
__device__ __forceinline__ int perm16(int s) { return (s & ~12) | ((s & 4) << 1) | ((s & 8) >> 1); }
__device__ __forceinline__ float bf2f(bf16_t u) { return __uint_as_float((unsigned)u << 16); }

__device__ __forceinline__ float wave_max(float v) {
  for (int o = 32; o > 0; o >>= 1) v = fmaxf(v, __shfl_xor(v, o));
  return v;
}
__device__ __forceinline__ float wave_sum(float v) {
  for (int o = 32; o > 0; o >>= 1) v += __shfl_xor(v, o);
  return v;
}
__device__ __forceinline__ void wave_argmax(float& v, int& i) {
  for (int o = 32; o > 0; o >>= 1) {
    float ov = __shfl_xor(v, o);
    int oi = __shfl_xor(i, o);
    if (ov > v || (ov == v && oi < i)) { v = ov; i = oi; }
  }
}
__device__ __forceinline__ float gelu_tanh(float x) {
  return 0.5f * x * (1.f + tanhf(0.7978845608028654f * (x + 0.044715f * x * x * x)));
}
__device__ __forceinline__ float gelu_fast(float x) {
  const float y = 1.5957691216057308f * (x + 0.044715f * x * x * x);
  return x / (1.f + __expf(-y));
}
__device__ __forceinline__ int t5_bucket(int n) {
  if (n < 16) return n < 0 ? 0 : n;
  int b = 16;
  b += (n >= 19); b += (n >= 21); b += (n >= 24); b += (n >= 27); b += (n >= 31); b += (n >= 35);
  b += (n >= 40); b += (n >= 46); b += (n >= 52); b += (n >= 59); b += (n >= 67); b += (n >= 77);
  b += (n >= 87); b += (n >= 99); b += (n >= 113);
  return b;
}
__device__ __forceinline__ float log_sigmoid(float x) {
  return fminf(x, 0.f) - log1pf(expf(-fabsf(x)));
}

__device__ __forceinline__ void ph_rmsnorm(const float* src, const float* gain, bf16_t* dst, int rows) {
  int lane = opq(threadIdx.x) & 63, wv = opq(threadIdx.x) >> 6;
  for (int r = blockIdx.x * 4 + wv; r < rows; r += gridDim.x * 4) {
    const float4* s4 = (const float4*)(src + (size_t)r * DM);
    float4 v[8];
    float ss = 0.f;
#pragma unroll
    for (int i = 0; i < 8; ++i) {
      v[i] = s4[i * 64 + lane];
      ss += v[i].x * v[i].x + v[i].y * v[i].y + v[i].z * v[i].z + v[i].w * v[i].w;
    }
    ss = wave_sum(ss);
    float rs = rsqrtf(ss * (1.f / DM) + RMS_EPS);
    uint2* d2 = (uint2*)(dst + (size_t)r * DM);
    const float4* g4 = (const float4*)gain;
#pragma unroll
    for (int i = 0; i < 8; ++i) {
      float4 g = g4[i * 64 + lane];
      uint2 o;
      o.x = pack2(v[i].x * rs * g.x, v[i].y * rs * g.y);
      o.y = pack2(v[i].z * rs * g.z, v[i].w * rs * g.w);
      d2[i * 64 + lane] = o;
    }
  }
}

template <bool CMAP>
__device__ __forceinline__ void ph_transpose(float* smem, const float* W, int K, int N, int Npad, bf16_t* Wt) {
  float (*tl)[65] = (float (*)[65])smem;
  int tid = opq(threadIdx.x);
  int nk = K / 64, nn = Npad / 64;
  for (int tile = blockIdx.x; tile < nk * nn; tile += gridDim.x) {
    int k0 = (tile % nk) * 64, n0 = (tile / nk) * 64;
    int col = tid & 63, rb = tid >> 6;
#pragma unroll 4
    for (int pp = 0; pp < 16; ++pp) {
      int k = pp * 4 + rb;
      float v = 0.f;
      int sc = n0 + col;
      if (CMAP) sc = (sc < 2560) ? sc : (sc < 5632) ? sc + 24 : (sc < 5656) ? sc - 5632 + 2560 : N;
      if (sc < N) v = W[(size_t)(k0 + k) * N + sc];
      tl[k][col] = v;
    }
    __syncthreads();
    int n = tid >> 2, kc = (tid & 3) * 16;
    unsigned w[8];
#pragma unroll
    for (int i = 0; i < 8; ++i) w[i] = pack2(tl[kc + 2 * i][n], tl[kc + 2 * i + 1][n]);
    uint4* dst = (uint4*)(Wt + (size_t)(n0 + n) * K + k0 + kc);
    dst[0] = make_uint4(w[0], w[1], w[2], w[3]);
    dst[1] = make_uint4(w[4], w[5], w[6], w[7]);
    __syncthreads();
  }
}

__device__ __forceinline__ int lds_off(int row, int chunk) { return row * 128 + ((chunk ^ ((row >> 1) & 7)) << 4); }

template <bool TR, class Epi>
__device__ __forceinline__ void gemm_tile_bf16(const bf16_t* xp, int ldx, const bf16_t* yp, int ldy, int K, char* lds,
                                               Epi epi) {
  const int tid = opq(threadIdx.x), lane = tid & 63, wv = tid >> 6;
  const int wr = wv >> 1, wc = wv & 1;
  char* lx = lds;
  char* ly = lds + 16384;
  f32x16 acc[2][2];
#pragma unroll
  for (int i = 0; i < 2; ++i)
#pragma unroll
    for (int j = 0; j < 2; ++j)
#pragma unroll
      for (int r = 0; r < 16; ++r) acc[i][j][r] = 0.f;
  const int srow = tid >> 3, sch = tid & 7;
  const bf16_t* xg = xp + (size_t)srow * ldx + sch * 8;
  const bf16_t* yg = yp + (size_t)srow * ldy + sch * 8;
  const size_t x32 = (size_t)32 * ldx, y32 = (size_t)32 * ldy;
  uint4 sx0 = *(const uint4*)(xg), sx1 = *(const uint4*)(xg + x32), sx2 = *(const uint4*)(xg + 2 * x32),
        sx3 = *(const uint4*)(xg + 3 * x32);
  uint4 sy0 = *(const uint4*)(yg), sy1 = *(const uint4*)(yg + y32), sy2 = *(const uint4*)(yg + 2 * y32),
        sy3 = *(const uint4*)(yg + 3 * y32);
  const int so0 = lds_off(srow, sch), so1 = lds_off(32 + srow, sch), so2 = lds_off(64 + srow, sch),
            so3 = lds_off(96 + srow, sch);
  for (int k0 = 0; k0 < K; k0 += 64) {
    __syncthreads();
    *(uint4*)(lx + so0) = sx0; *(uint4*)(lx + so1) = sx1; *(uint4*)(lx + so2) = sx2; *(uint4*)(lx + so3) = sx3;
    *(uint4*)(ly + so0) = sy0; *(uint4*)(ly + so1) = sy1; *(uint4*)(ly + so2) = sy2; *(uint4*)(ly + so3) = sy3;
    __syncthreads();
    if (k0 + 64 < K) {
      const bf16_t* xn = xg + k0 + 64;
      const bf16_t* yn = yg + k0 + 64;
      sx0 = *(const uint4*)(xn); sx1 = *(const uint4*)(xn + x32); sx2 = *(const uint4*)(xn + 2 * x32);
      sx3 = *(const uint4*)(xn + 3 * x32);
      sy0 = *(const uint4*)(yn); sy1 = *(const uint4*)(yn + y32); sy2 = *(const uint4*)(yn + 2 * y32);
      sy3 = *(const uint4*)(yn + 3 * y32);
    }
#pragma unroll
    for (int kk = 0; kk < 4; ++kk) {
      bf16x8 a[2], b[2];
      const int ch = kk * 2 + (lane >> 5);
#pragma unroll
      for (int i = 0; i < 2; ++i) {
        a[i] = *(const bf16x8*)((TR ? ly : lx) + lds_off(wr * 64 + i * 32 + (lane & 31), ch));
        b[i] = *(const bf16x8*)((TR ? lx : ly) + lds_off(wc * 64 + i * 32 + (lane & 31), ch));
      }
#pragma unroll
      for (int i = 0; i < 2; ++i)
#pragma unroll
        for (int j = 0; j < 2; ++j) acc[i][j] = __builtin_amdgcn_mfma_f32_32x32x16_bf16(a[i], b[j], acc[i][j], 0, 0, 0);
    }
  }
  int lane2 = lane;
  asm volatile("" : "+v"(lane2));
#pragma unroll
  for (int i = 0; i < 2; ++i)
#pragma unroll
    for (int j = 0; j < 2; ++j)
#pragma unroll
      for (int r = 0; r < 16; ++r) {
        int rr = wr * 64 + i * 32 + (r & 3) + 8 * (r >> 2) + 4 * (lane2 >> 5);
        int cc = wc * 64 + j * 32 + (lane2 & 31);
        epi(rr, cc, acc[i][j][r]);
      }
}

template <class Epi>
__device__ __forceinline__ void ph_gemm_bf16(const bf16_t* A, int lda, const bf16_t* Wt, int ldw, int M, int N, int K,
                                             char* lds, Epi epi) {
  const int ntm = M / 128, ntn = N / 128;
  const int npm = (ntm + 7) / 8, npn = (ntn + 7) / 8;
  const int nslots = ((npm * npn * 64 + 511) / 512) * 512;
  for (int u = blockIdx.x; u < nslots; u += gridDim.x) {
    int v = (u & 7) * 64 + ((u >> 3) & 63) + (u & ~511);
    int patch = v >> 6, w = v & 63;
    int tm = (patch % npm) * 8 + (w & 7);
    int tn = (patch / npm) * 8 + (w >> 3);
    if (tm >= ntm || tn >= ntn) continue;
    const int m0 = tm * 128, n0 = tn * 128;
    gemm_tile_bf16<false>(A + (size_t)m0 * lda, lda, Wt + (size_t)n0 * ldw, ldw, K, lds,
                          [&](int r, int c, float val) { epi(m0 + r, n0 + c, val); });
  }
}

__device__ __forceinline__ void ph_proj(const P& p, char* lds) {
  const int ntm = T_TOK / 128, ntn = 5760 / 128;
  const int npm = (ntm + 7) / 8, npn = (ntn + 7) / 8;
  const int nslots = ((npm * npn * 64 + 511) / 512) * 512;
  for (int u = blockIdx.x; u < nslots; u += gridDim.x) {
    int v = (u & 7) * 64 + ((u >> 3) & 63) + (u & ~511);
    int patch = v >> 6, w = v & 63;
    int tm = (patch % npm) * 8 + (w & 7);
    int tn = (patch / npm) * 8 + (w >> 3);
    if (tm >= ntm || tn >= ntn) continue;
    const int m0 = tm * 128, n0 = tn * 128;
    const int b = m0 >> 11, sl = m0 & 2047;
    const bf16_t* A = p.hn + (size_t)m0 * DM;
    const bf16_t* W = p.WinT + (size_t)n0 * DM;
    if (n0 < 1024) {
      bf16_t* q = p.qn + (size_t)m0 * 1024 + n0;
      gemm_tile_bf16<false>(A, DM, W, DM, DM, lds, [&](int r, int c, float val) { q[(size_t)r * 1024 + c] = f2bf(val); });
    } else if (n0 < 2560) {
      const int seg = (n0 - 1024) >> 8, g = ((n0 - 1024) >> 7) & 1;
      if (seg == 3 || seg == 5) {
        bf16_t* vd = (seg == 3 ? p.vsT : p.vwT) + ((size_t)(b * 2 + g) * 128) * SEQ + sl;
        gemm_tile_bf16<true>(A, DM, W, DM, DM, lds, [&](int r, int c, float val) { vd[(size_t)r * SEQ + perm16(c)] = f2bf(val); });
      } else {
        bf16_t* base = (seg == 0) ? p.kcin : (seg == 1) ? p.vcin : (seg == 2) ? p.ks : p.kw;
        bf16_t* kd = base + ((size_t)(b * 2 + g) * SEQ + sl) * 128;
        gemm_tile_bf16<false>(A, DM, W, DM, DM, lds, [&](int r, int c, float val) { kd[(size_t)r * 128 + c] = f2bf(val); });
      }
    } else if (n0 < 3584) {
      bf16_t* q = p.qsb + (size_t)m0 * 1024 + (n0 - 2560);
      gemm_tile_bf16<false>(A, DM, W, DM, DM, lds, [&](int r, int c, float val) { q[(size_t)r * 1024 + c] = f2bf(val); });
    } else if (n0 < 4608) {
      bf16_t* kd = p.ksb + ((size_t)(b * 8 + ((n0 - 3584) >> 7)) * SEQ + sl) * 128;
      gemm_tile_bf16<false>(A, DM, W, DM, DM, lds, [&](int r, int c, float val) { kd[(size_t)r * 128 + c] = f2bf(val); });
    } else if (n0 < 5632) {
      bf16_t* vd = p.vsbT + ((size_t)(b * 8 + ((n0 - 4608) >> 7)) * 128) * SEQ + sl;
      gemm_tile_bf16<true>(A, DM, W, DM, DM, lds, [&](int r, int c, float val) { vd[(size_t)r * SEQ + perm16(c)] = f2bf(val); });
    } else {
      float* gd = p.gates + (size_t)m0 * 24;
      gemm_tile_bf16<false>(A, DM, W, DM, DM, lds, [&](int r, int c, float val) { if (c < 24) gd[(size_t)r * 24 + c] = val; });
    }
  }
}

__device__ __forceinline__ void ph_posb(const P& p) {
  const int lane = opq(threadIdx.x) & 63, wv = opq(threadIdx.x) >> 6;
  for (int o = blockIdx.x * 4 + wv; o < 256; o += gridDim.x * 4) {
    const int which = o >> 7, n = o & 127;
    const float* pos = which ? p.pos_v : p.pos_k;
    const float* w1 = which ? p.w1_v : p.w1_k;
    float acc = 0.f;
    for (int k = lane; k < 4096; k += 64) acc += pos[k] * w1[(size_t)k * 128 + n];
    acc = wave_sum(acc);
    if (lane == 0) p.posb[o] = acc;
  }
}

__device__ __forceinline__ void ph_compress2(const P& p, char* lds) {
  for (int item = blockIdx.x; item < 16; item += gridDim.x) {
    const int which = item >> 3, bg = item & 7;
    const bf16_t* src = (which ? p.vcin : p.kcin) + (size_t)bg * SEQ * 128;
    const bf16_t* w1t = p.w1T + (size_t)which * 128 * 4096;
    const bf16_t* w2t = p.w2T + (size_t)which * 128 * 128;
    const float* posb = p.posb + which * 128;
    bf16_t* c1 = p.c1 + (size_t)item * 128 * 128;
    gemm_tile_bf16<false>(src, 2048, w1t, 4096, 4096, lds, [&](int r, int c, float val) {
      c1[r * 128 + c] = f2bf(gelu_fast(val + posb[c])); });
    __threadfence_block();
    __syncthreads();
    if (which == 0) {
      bf16_t* kd = p.kcb + (size_t)bg * 128 * 128;
      gemm_tile_bf16<false>(c1, 128, w2t, 128, 128, lds, [&](int r, int c, float val) { kd[r * 128 + c] = f2bf(val); });
    } else {
      bf16_t* vd = p.vcT + (size_t)bg * 128 * 128;
      gemm_tile_bf16<true>(c1, 128, w2t, 128, 128, lds, [&](int r, int c, float val) { vd[r * 128 + perm16(c)] = f2bf(val); });
    }
  }
}

#define NEG_BIG (-1e30f)

struct KVRegs { u32x4 k0, k1, k2, k3, v0, v1, v2, v3; };

__device__ __forceinline__ int koff(int row, int chunk) { return row * 256 + ((chunk ^ (row & 15)) << 4); }

__device__ __forceinline__ void kv_load(KVRegs& r, const bf16_t* kp, int ldk, const bf16_t* vp, int ldv) {
  const int tid = opq(threadIdx.x);
  const bf16_t* kg = kp + (size_t)(tid >> 4) * ldk + (tid & 15) * 8;
  r.k0 = *(const u32x4*)kg;
  r.k1 = *(const u32x4*)(kg + (size_t)16 * ldk);
  r.k2 = *(const u32x4*)(kg + (size_t)32 * ldk);
  r.k3 = *(const u32x4*)(kg + (size_t)48 * ldk);
  const bf16_t* vg = vp + (size_t)(tid >> 3) * ldv + (tid & 7) * 8;
  r.v0 = *(const u32x4*)vg;
  r.v1 = *(const u32x4*)(vg + (size_t)32 * ldv);
  r.v2 = *(const u32x4*)(vg + (size_t)64 * ldv);
  r.v3 = *(const u32x4*)(vg + (size_t)96 * ldv);
}
__device__ __forceinline__ void kv_store(const KVRegs& r, char* lk, char* lv) {
  const int tid = opq(threadIdx.x);
  const int row = tid >> 4, ch = tid & 15;
  *(u32x4*)(lk + koff(row, ch)) = r.k0;
  *(u32x4*)(lk + koff(row + 16, ch)) = r.k1;
  *(u32x4*)(lk + koff(row + 32, ch)) = r.k2;
  *(u32x4*)(lk + koff(row + 48, ch)) = r.k3;
  const int vr = tid >> 3, vc = tid & 7;
  *(u32x4*)(lv + lds_off(vr, vc)) = r.v0;
  *(u32x4*)(lv + lds_off(vr + 32, vc)) = r.v1;
  *(u32x4*)(lv + lds_off(vr + 64, vc)) = r.v2;
  *(u32x4*)(lv + lds_off(vr + 96, vc)) = r.v3;
}

struct QFrag { bf16x8 f0, f1, f2, f3, f4, f5, f6, f7; };
__device__ __forceinline__ void q_load(QFrag& q, const bf16_t* qrow) {
  const int h = (opq(threadIdx.x) & 63) >> 5;
  const bf16x8* p8 = (const bf16x8*)(qrow + 8 * h);
  q.f0 = p8[0]; q.f1 = p8[2]; q.f2 = p8[4]; q.f3 = p8[6]; q.f4 = p8[8]; q.f5 = p8[10]; q.f6 = p8[12]; q.f7 = p8[14];
}

__device__ __forceinline__ void qk_tile(const QFrag& q, const char* lk, f32x16& s0, f32x16& s1) {
  const int lane = opq(threadIdx.x) & 63, row = lane & 31, h = lane >> 5;
#pragma unroll
  for (int r = 0; r < 16; ++r) { s0[r] = 0.f; s1[r] = 0.f; }
#define QK_STEP(kk, qf)                                                                  \
  {                                                                                      \
    bf16x8 a0 = *(const bf16x8*)(lk + koff(row, 2 * (kk) + h));                          \
    bf16x8 a1 = *(const bf16x8*)(lk + koff(row + 32, 2 * (kk) + h));                     \
    s0 = __builtin_amdgcn_mfma_f32_32x32x16_bf16(a0, qf, s0, 0, 0, 0);                   \
    s1 = __builtin_amdgcn_mfma_f32_32x32x16_bf16(a1, qf, s1, 0, 0, 0);                   \
  }
  QK_STEP(0, q.f0) QK_STEP(1, q.f1) QK_STEP(2, q.f2) QK_STEP(3, q.f3)
  QK_STEP(4, q.f4) QK_STEP(5, q.f5) QK_STEP(6, q.f6) QK_STEP(7, q.f7)
#undef QK_STEP
}

__device__ __forceinline__ bf16x8 pack8(const f32x16& p, const int base) {
  u32x4 u;
  u[0] = pack2(p[base + 0], p[base + 1]);
  u[1] = pack2(p[base + 2], p[base + 3]);
  u[2] = pack2(p[base + 4], p[base + 5]);
  u[3] = pack2(p[base + 6], p[base + 7]);
  return __builtin_bit_cast(bf16x8, u);
}

struct OAcc { f32x16 o0, o1, o2, o3; };
__device__ __forceinline__ void oacc_zero(OAcc& o) {
#pragma unroll
  for (int r = 0; r < 16; ++r) { o.o0[r] = 0.f; o.o1[r] = 0.f; o.o2[r] = 0.f; o.o3[r] = 0.f; }
}
__device__ __forceinline__ void oacc_scale(OAcc& o, float a) {
#pragma unroll
  for (int r = 0; r < 16; ++r) { o.o0[r] *= a; o.o1[r] *= a; o.o2[r] *= a; o.o3[r] *= a; }
}

__device__ __forceinline__ void pv_tile(OAcc& o, const char* lv, const f32x16& p0, const f32x16& p1) {
  const int lane = opq(threadIdx.x) & 63, row = lane & 31, h = lane >> 5;
  const bf16x8 pf0 = pack8(p0, 0), pf1 = pack8(p0, 8), pf2 = pack8(p1, 0), pf3 = pack8(p1, 8);
#define PV_ROW(dd, acc)                                                                                      \
  {                                                                                                          \
    acc = __builtin_amdgcn_mfma_f32_32x32x16_bf16(*(const bf16x8*)(lv + lds_off(32 * (dd) + row, 0 + h)), pf0, acc, 0, 0, 0); \
    acc = __builtin_amdgcn_mfma_f32_32x32x16_bf16(*(const bf16x8*)(lv + lds_off(32 * (dd) + row, 2 + h)), pf1, acc, 0, 0, 0); \
    acc = __builtin_amdgcn_mfma_f32_32x32x16_bf16(*(const bf16x8*)(lv + lds_off(32 * (dd) + row, 4 + h)), pf2, acc, 0, 0, 0); \
    acc = __builtin_amdgcn_mfma_f32_32x32x16_bf16(*(const bf16x8*)(lv + lds_off(32 * (dd) + row, 6 + h)), pf3, acc, 0, 0, 0); \
  }
  PV_ROW(0, o.o0) PV_ROW(1, o.o1) PV_ROW(2, o.o2) PV_ROW(3, o.o3)
#undef PV_ROW
}

__device__ __forceinline__ void softmax_tile(f32x16& s0, f32x16& s1, float& m, float& l, OAcc& o) {
  float mx = NEG_BIG;
#pragma unroll
  for (int r = 0; r < 16; ++r) mx = fmaxf(mx, fmaxf(s0[r], s1[r]));
  mx = fmaxf(mx, __shfl_xor(mx, 32));
  const float mn = fmaxf(m, mx);
  const float alpha = __expf(m - mn);
  float ls = 0.f;
#pragma unroll
  for (int r = 0; r < 16; ++r) {
    float a = (s0[r] > -1e29f) ? __expf(s0[r] - mn) : 0.f;
    float b = (s1[r] > -1e29f) ? __expf(s1[r] - mn) : 0.f;
    s0[r] = a; s1[r] = b;
    ls += a + b;
  }
  ls += __shfl_xor(ls, 32);
  l = l * alpha + ls;
  m = mn;
  oacc_scale(o, alpha);
}

template <class F>
__device__ __forceinline__ void oacc_foreach(const OAcc& o, F f) {
  const int h = (opq(threadIdx.x) & 63) >> 5;
#pragma unroll
  for (int rho = 0; rho < 4; ++rho) {
    f(0 + 8 * rho + 4 * h, o.o0[4 * rho], o.o0[4 * rho + 1], o.o0[4 * rho + 2], o.o0[4 * rho + 3]);
    f(32 + 8 * rho + 4 * h, o.o1[4 * rho], o.o1[4 * rho + 1], o.o1[4 * rho + 2], o.o1[4 * rho + 3]);
    f(64 + 8 * rho + 4 * h, o.o2[4 * rho], o.o2[4 * rho + 1], o.o2[4 * rho + 2], o.o2[4 * rho + 3]);
    f(96 + 8 * rho + 4 * h, o.o3[4 * rho], o.o3[4 * rho + 1], o.o3[4 * rho + 2], o.o3[4 * rho + 3]);
  }
}

__device__ __forceinline__ void ph_memattn2(const P& p, char* lds) {
  char* lk = lds;
  char* lv = lds + 16384;
  const int lane = opq(threadIdx.x) & 63, wv = opq(threadIdx.x) >> 6;
  for (int item = blockIdx.x; item < NBATCH * 4 * (SEQ / 128); item += gridDim.x) {
    const int tb = item % (SEQ / 128);
    const int bh = item / (SEQ / 128);
    const int b = bh >> 2, hd = bh & 3;
    const int t = tb * 128 + wv * 32 + (lane & 31);
    QFrag q;
    q_load(q, p.qmemb + (size_t)(b * SEQ + t) * 512 + hd * 128);
    const bf16_t* kb = p.kmemb + (size_t)bh * 256 * 128;
    const bf16_t* vb = p.vmemT + (size_t)bh * 128 * 256;
    OAcc o;
    oacc_zero(o);
    float m = NEG_BIG, l = 0.f;
    KVRegs kv;
    kv_load(kv, kb, 128, vb, 256);
#pragma unroll 1
    for (int ti = 0; ti < 4; ++ti) {
      __syncthreads();
      kv_store(kv, lk, lv);
      __syncthreads();
      {
        const int tn = (ti + 1 < 4) ? ti + 1 : 3;
        kv_load(kv, kb + (size_t)tn * 64 * 128, 128, vb + tn * 64, 256);
      }
      f32x16 s0, s1;
      qk_tile(q, lk, s0, s1);
#pragma unroll
      for (int r = 0; r < 16; ++r) { s0[r] *= ATT_SCALE; s1[r] *= ATT_SCALE; }
      softmax_tile(s0, s1, m, l, o);
      pv_tile(o, lv, s0, s1);
    }
    const float il = 1.f / l;
    const int t2 = tb * 128 + (opq(threadIdx.x) >> 6) * 32 + (opq(threadIdx.x) & 31);
    bf16_t* orow = p.omem + (size_t)(b * SEQ + t2) * 512 + hd * 128;
    oacc_foreach(o, [&](int d, float v0, float v1, float v2, float v3) {
      uint2 u;
      u.x = pack2(v0 * il, v1 * il);
      u.y = pack2(v2 * il, v3 * il);
      *(uint2*)(orow + d) = u;
    });
  }
}

__device__ __forceinline__ void ph_sb2(const P& p, char* lds) {
  char* lk = lds;
  char* lv = lds + 16384;
  const int lane = opq(threadIdx.x) & 63, wv = opq(threadIdx.x) >> 6, hh = lane >> 5;
  for (int item = blockIdx.x; item < NBATCH * 8 * (SEQ / 128); item += gridDim.x) {
    const int tb = (SEQ / 128 - 1) - (item % (SEQ / 128));
    const int bh = item / (SEQ / 128);
    const int b = bh >> 3, hd = bh & 7;
    const int t0 = tb * 128;
    const int t = t0 + wv * 32 + (lane & 31);
    QFrag q;
    q_load(q, p.qsb + (size_t)(b * SEQ + t) * 1024 + hd * 128);
    const bf16_t* kb = p.ksb + (size_t)bh * SEQ * 128;
    const bf16_t* vb = p.vsbT + (size_t)bh * 128 * SEQ;
    OAcc o;
    oacc_zero(o);
    float carry = 0.f;
    const int jhi = (t0 >> 6) + 1;
    const int jw = (t0 + wv * 32 + 30) >> 6;
    KVRegs kv;
    kv_load(kv, kb + (size_t)jhi * 64 * 128, 128, vb + jhi * 64, SEQ);
    for (int j = jhi; j >= 0; --j) {
      __syncthreads();
      kv_store(kv, lk, lv);
      __syncthreads();
      const int jn = (j > 0) ? j - 1 : 0;
      if (j > jw) kv_load(kv, kb + (size_t)jn * 64 * 128, 128, vb + jn * 64, SEQ);
      if (j <= jw) {
        f32x16 z0, z1;
        qk_tile(q, lk, z0, z1);
        const int sbase = j * 64 + 4 * hh;
        float gt[8];
        f32x16 l0, l1;
#pragma unroll
        for (int r = 0; r < 16; ++r) {
          const int so = sbase + 8 * (r >> 2) + (r & 3);
          {
            const float z = z0[r] * ATT_SCALE;
            const bool valid = so < t;
            const float lsp = fminf(z, 0.f) - __logf(1.f + __expf(-fabsf(z)));
            l0[r] = valid ? (lsp - z) : 0.f;
            z0[r] = valid ? z : NEG_BIG;
          }
          {
            const float z = z1[r] * ATT_SCALE;
            const bool valid = so + 32 < t;
            const float lsp = fminf(z, 0.f) - __logf(1.f + __expf(-fabsf(z)));
            l1[r] = valid ? (lsp - z) : 0.f;
            z1[r] = valid ? z : NEG_BIG;
          }
        }
#pragma unroll
        for (int rho = 0; rho < 4; ++rho) {
          gt[rho] = (l0[4 * rho] + l0[4 * rho + 1]) + (l0[4 * rho + 2] + l0[4 * rho + 3]);
          gt[4 + rho] = (l1[4 * rho] + l1[4 * rho + 1]) + (l1[4 * rho + 2] + l1[4 * rho + 3]);
        }
        float ag[8];
        float run = 0.f;
#pragma unroll
        for (int k = 7; k >= 0; --k) {
          const float pg = __shfl_xor(gt[k], 32);
          ag[k] = carry + run + (hh == 0 ? pg : 0.f);
          run += gt[k] + pg;
        }
        carry += run;
#pragma unroll
        for (int rho = 0; rho < 4; ++rho) {
          {
            const float x3 = l0[4 * rho + 3], x23 = x3 + l0[4 * rho + 2], x123 = x23 + l0[4 * rho + 1];
            const float g = ag[rho];
            z0[4 * rho + 0] = __expf((l0[4 * rho + 0] + z0[4 * rho + 0]) + (g + x123));
            z0[4 * rho + 1] = __expf((l0[4 * rho + 1] + z0[4 * rho + 1]) + (g + x23));
            z0[4 * rho + 2] = __expf((l0[4 * rho + 2] + z0[4 * rho + 2]) + (g + x3));
            z0[4 * rho + 3] = __expf((l0[4 * rho + 3] + z0[4 * rho + 3]) + g);
          }
          {
            const float x3 = l1[4 * rho + 3], x23 = x3 + l1[4 * rho + 2], x123 = x23 + l1[4 * rho + 1];
            const float g = ag[4 + rho];
            z1[4 * rho + 0] = __expf((l1[4 * rho + 0] + z1[4 * rho + 0]) + (g + x123));
            z1[4 * rho + 1] = __expf((l1[4 * rho + 1] + z1[4 * rho + 1]) + (g + x23));
            z1[4 * rho + 2] = __expf((l1[4 * rho + 2] + z1[4 * rho + 2]) + (g + x3));
            z1[4 * rho + 3] = __expf((l1[4 * rho + 3] + z1[4 * rho + 3]) + g);
          }
        }
        kv_load(kv, kb + (size_t)jn * 64 * 128, 128, vb + jn * 64, SEQ);
        pv_tile(o, lv, z0, z1);
      }
    }
    int t2 = t;
    asm volatile("" : "+v"(t2));
    bf16_t* orow = p.omix + (size_t)(b * SEQ + t2) * DM + 1024 + hd * 128;
    oacc_foreach(o, [&](int d, float v0, float v1, float v2, float v3) {
      uint2 u;
      u.x = pack2(v0, v1);
      u.y = pack2(v2, v3);
      *(uint2*)(orow + d) = u;
    });
  }
}

#define NSA_IMP 32768
#define NSA_KEYS 49152
#define NSA_SELM 53504
#define NSA_LUT 53632
__device__ __forceinline__ void ph_nsa2(const P& p, char* lds) {
  typedef __attribute__((ext_vector_type(4))) float f32x4;
  char* lk = lds;
  char* lv = lds + 16384;
  float* imp = (float*)(lds + NSA_IMP);
  float* keys = (float*)(lds + NSA_KEYS);
  unsigned* selm = (unsigned*)(lds + NSA_SELM);
  const int tid = opq(threadIdx.x), lane = tid & 63, wv = tid >> 6, hh = lane >> 5, ql = lane & 31;
  float* lut = (float*)(lds + NSA_LUT) + wv * 128;
  for (int item = blockIdx.x; item < NBATCH * 2 * (SEQ / 32); item += gridDim.x) {
    const int tt = (SEQ / 32 - 1) - (item % (SEQ / 32));
    const int bg = item / (SEQ / 32);
    const int b = bg >> 1, g = bg & 1;
    const int h = g * 4 + wv;
    const int t0 = tt * 32, tq = t0 + ql, cur = t0 >> 6;
    __syncthreads();
    QFrag q;
    q_load(q, p.qn + (size_t)(b * SEQ + tq) * 1024 + h * 128);
    {
      const int lo = opq(lane);
      lut[lo] = p.t5[t5_bucket(lo) * 8 + h];
      lut[lo + 64] = p.t5[t5_bucket(lo + 64) * 8 + h];
    }
#pragma unroll
    for (int i = 0; i < 16; ++i) imp[i * 256 + tid] = 0.f;
    if (tid < 32) selm[tid] = 0u;
    const float* grow = p.gates + (size_t)(b * SEQ + tq) * 24 + h * 3;
    float* prow = p.part + (size_t)(b * SEQ + tq) * 1024 + h * 128;
    OAcc o;
    float m, l;
    KVRegs kv;
    {
      const bf16_t* kb = p.kcb + (size_t)bg * 128 * 128;
      const bf16_t* vb = p.vcT + (size_t)bg * 128 * 128;
      oacc_zero(o);
      m = NEG_BIG; l = 0.f;
      kv_load(kv, kb, 128, vb, 128);
      __syncthreads();
      kv_store(kv, lk, lv);
      __syncthreads();
      f32x16 x0, x1;
      qk_tile(q, lk, x0, x1);
      int tqv = tq;
      asm volatile("" : "+v"(tqv));
      tqv -= 64 * hh;
#pragma unroll
      for (int r = 0; r < 16; ++r) {
        const int c = 8 * (r >> 2) + (r & 3);
        const int d0 = tqv - 16 * c - 31, d1 = d0 - 512;
        x0[r] = (d0 >= 0) ? x0[r] * ATT_SCALE + lut[min(d0, 127)] : NEG_BIG;
        x1[r] = (d1 >= 0) ? x1[r] * ATT_SCALE + lut[min(d1, 127)] : NEG_BIG;
      }
      softmax_tile(x0, x1, m, l, o);
      const float m0 = m;
      pv_tile(o, lv, x0, x1);
      kv_load(kv, kb + 64 * 128, 128, vb + 64, 128);
      __syncthreads();
      kv_store(kv, lk, lv);
      __syncthreads();
      f32x16 z0, z1;
      qk_tile(q, lk, z0, z1);
      asm volatile("" : "+v"(tqv));
#pragma unroll
      for (int r = 0; r < 16; ++r) {
        const int c = 64 + 8 * (r >> 2) + (r & 3);
        const int d0 = tqv - 16 * c - 31, d1 = d0 - 512;
        z0[r] = (d0 >= 0) ? z0[r] * ATT_SCALE + lut[min(d0, 127)] : NEG_BIG;
        z1[r] = (d1 >= 0) ? z1[r] * ATT_SCALE + lut[min(d1, 127)] : NEG_BIG;
      }
      softmax_tile(z0, z1, m, l, o);
      pv_tile(o, lv, z0, z1);
      const float inv = 1.f / fmaxf(l, 1e-20f);
      const float c0 = __expf(m0 - m) * inv;
#pragma unroll
      for (int r = 0; r < 16; ++r) {
        const int c = 8 * (r >> 2) + (r & 3) + 4 * hh;
        if (x0[r] != 0.f) atomicAdd(&imp[(c) * 32 + ql], x0[r] * c0);
        if (x1[r] != 0.f) atomicAdd(&imp[(c + 32) * 32 + ql], x1[r] * c0);
        if (z0[r] != 0.f) atomicAdd(&imp[(c + 64) * 32 + ql], z0[r] * inv);
        if (z1[r] != 0.f) atomicAdd(&imp[(c + 96) * 32 + ql], z1[r] * inv);
      }
      const float gs = inv / (1.f + __expf(-grow[0]));
      oacc_foreach(o, [&](int d, float v0, float v1, float v2, float v3) {
        f32x4 u = {v0 * gs, v1 * gs, v2 * gs, v3 * gs};
        *(f32x4*)(prow + d) = u;
      });
    }
    __syncthreads();
    {
      const int tido = opq(tid);
      const int qq = tido & 31, jg = tido >> 5;
#pragma unroll
      for (int jj = 0; jj < 4; ++jj) {
        const int j = jg * 4 + jj;
        float v = imp[(4 * j) * 32 + qq] + imp[(4 * j + 1) * 32 + qq] + imp[(4 * j + 2) * 32 + qq] + 0.5f * imp[(4 * j + 3) * 32 + qq];
        if (j > 0) v += 0.5f * imp[(4 * j - 1) * 32 + qq];
        const bool forced = (j == 0) || (j == cur) || (j == cur - 1);
        keys[qq * 33 + j] = forced ? 1e9f : ((j <= cur) ? v : -1e9f);
      }
      __syncthreads();
      unsigned bits = 0u;
#pragma unroll
      for (int jj = 0; jj < 4; ++jj) {
        const int j = jg * 4 + jj;
        const float kj = keys[qq * 33 + j];
        int rank = 0;
        for (int i = 0; i < 32; ++i) {
          const float ki = keys[qq * 33 + i];
          rank += (ki > kj || (ki == kj && i < j)) ? 1 : 0;
        }
        if (rank < 16 && j <= cur) bits |= 1u << j;
      }
      atomicOr(&selm[qq], bits);
      __syncthreads();
    }
    const unsigned mysel = selm[ql];
    unsigned um = mysel;
#pragma unroll
    for (int o2 = 16; o2 > 0; o2 >>= 1) um |= (unsigned)__shfl_xor((int)um, o2);
    um = (unsigned)__builtin_amdgcn_readfirstlane((int)um);
    {
      const bf16_t* kb = p.ks + (size_t)bg * SEQ * 128;
      const bf16_t* vb = p.vsT + (size_t)bg * 128 * SEQ;
      oacc_zero(o);
      m = NEG_BIG; l = 0.f;
      unsigned rem = um;
      int j = __builtin_ctz(rem);
      kv_load(kv, kb + (size_t)j * 64 * 128, 128, vb + j * 64, SEQ);
      while (rem) {
        j = __builtin_ctz(rem);
        rem &= rem - 1;
        const int jn = rem ? __builtin_ctz(rem) : j;
        __syncthreads();
        kv_store(kv, lk, lv);
        __syncthreads();
        f32x16 s0, s1;
        qk_tile(q, lk, s0, s1);
        const bool selq = (mysel >> j) & 1u;
        int tqv = tq;
        asm volatile("" : "+v"(tqv));
#pragma unroll
        for (int r = 0; r < 16; ++r) {
          const int d0 = tqv - (j * 64 + 8 * (r >> 2) + (r & 3) + 4 * hh), d1 = d0 - 32;
          s0[r] = (selq && d0 >= 0) ? s0[r] * ATT_SCALE + lut[min(d0, 127)] : NEG_BIG;
          s1[r] = (selq && d1 >= 0) ? s1[r] * ATT_SCALE + lut[min(d1, 127)] : NEG_BIG;
        }
        kv_load(kv, kb + (size_t)jn * 64 * 128, 128, vb + jn * 64, SEQ);
        softmax_tile(s0, s1, m, l, o);
        pv_tile(o, lv, s0, s1);
      }
      const float gs = 1.f / (fmaxf(l, 1e-20f) * (1.f + __expf(-grow[1])));
      int qo = ql;
      asm volatile("" : "+v"(qo));
      float* pr2 = p.part + (size_t)(b * SEQ + t0 + qo) * 1024 + h * 128;
      oacc_foreach(o, [&](int d, float v0, float v1, float v2, float v3) {
        f32x4 u = *(f32x4*)(pr2 + d);
        u[0] += v0 * gs; u[1] += v1 * gs; u[2] += v2 * gs; u[3] += v3 * gs;
        *(f32x4*)(pr2 + d) = u;
      });
    }
    {
      const bf16_t* kb = p.kw + (size_t)bg * SEQ * 128;
      const bf16_t* vb = p.vwT + (size_t)bg * 128 * SEQ;
      oacc_zero(o);
      m = NEG_BIG; l = 0.f;
      int jlo = (t0 - 511) >> 6;
      if (jlo < 0) jlo = 0;
      kv_load(kv, kb + (size_t)jlo * 64 * 128, 128, vb + jlo * 64, SEQ);
      for (int j = jlo; j <= cur; ++j) {
        const int jn = (j < cur) ? j + 1 : j;
        __syncthreads();
        kv_store(kv, lk, lv);
        __syncthreads();
        f32x16 s0, s1;
        qk_tile(q, lk, s0, s1);
        int tqv = tq;
        asm volatile("" : "+v"(tqv));
#pragma unroll
        for (int r = 0; r < 16; ++r) {
          const int d0 = tqv - (j * 64 + 8 * (r >> 2) + (r & 3) + 4 * hh), d1 = d0 - 32;
          s0[r] = (d0 >= 0 && d0 < 512) ? s0[r] * ATT_SCALE + lut[min(d0, 127)] : NEG_BIG;
          s1[r] = (d1 >= 0 && d1 < 512) ? s1[r] * ATT_SCALE + lut[min(d1, 127)] : NEG_BIG;
        }
        kv_load(kv, kb + (size_t)jn * 64 * 128, 128, vb + jn * 64, SEQ);
        softmax_tile(s0, s1, m, l, o);
        pv_tile(o, lv, s0, s1);
      }
      const float gs = 1.f / (fmaxf(l, 1e-20f) * (1.f + __expf(-grow[2])));
      int qo = ql;
      asm volatile("" : "+v"(qo));
      const float* pr2 = p.part + (size_t)(b * SEQ + t0 + qo) * 1024 + h * 128;
      bf16_t* orow = p.omix + (size_t)(b * SEQ + t0 + qo) * DM + h * 128;
      oacc_foreach(o, [&](int d, float v0, float v1, float v2, float v3) {
        const f32x4 u = *(const f32x4*)(pr2 + d);
        uint2 w;
        w.x = pack2(u[0] + v0 * gs, u[1] + v1 * gs);
        w.y = pack2(u[2] + v2 * gs, u[3] + v3 * gs);
        *(uint2*)(orow + d) = w;
      });
    }
  }
}

__device__ __forceinline__ void ph_cvt(const float* src, bf16_t* dst, size_t n) {
  typedef __attribute__((ext_vector_type(4))) float f32x4;
  const size_t nv = n / 8;
  for (size_t i = (size_t)blockIdx.x * 256 + opq(threadIdx.x); i < nv; i += (size_t)gridDim.x * 256) {
    const f32x4 a = ((const f32x4*)src)[2 * i], b = ((const f32x4*)src)[2 * i + 1];
    u32x4 o;
    o[0] = pack2(a[0], a[1]); o[1] = pack2(a[2], a[3]); o[2] = pack2(b[0], b[1]); o[3] = pack2(b[2], b[3]);
    ((u32x4*)dst)[i] = o;
  }
}

__device__ __forceinline__ void ph_scores(const P& p, char* lds) {
  for (int u = blockIdx.x; u < 64 * 16; u += gridDim.x) {
    const int tm = u & 63, hp = u >> 6;
    const int m0 = tm * 128;
    float* sc = p.scores + (size_t)m0 * DM + hp * 128;
    gemm_tile_bf16<false>(p.omix + (size_t)m0 * DM + hp * 128, DM, p.subkb + (size_t)hp * 128 * 128, 128, 128, lds,
                          [&](int r, int c, float val) { sc[(size_t)r * DM + c] = val; });
  }
}

struct ERows { u32x4 u0, u1, u2, u3, v0, v1, v2, v3; };
__device__ __forceinline__ void erows_load(ERows& r, const bf16_t* pu, const bf16_t* pv, int eid, int lane) {
  const u32x4* ur = (const u32x4*)(pu + (size_t)eid * DM) + lane;
  const u32x4* vr = (const u32x4*)(pv + (size_t)eid * DM) + lane;
  r.u0 = ur[0]; r.u1 = ur[64]; r.u2 = ur[128]; r.u3 = ur[192];
  r.v0 = vr[0]; r.v1 = vr[64]; r.v2 = vr[128]; r.v3 = vr[192];
}
__device__ __forceinline__ float dot2bf(unsigned a, unsigned b, float c) {
  return __builtin_amdgcn_fdot2_f32_bf16(__builtin_bit_cast(bf16v2, a), __builtin_bit_cast(bf16v2, b), c, false);
}
struct XPk { u32x4 x0, x1, x2, x3; };
struct Acc32 { f32x16 a, b; };

__device__ __forceinline__ void peer_pair(const ERows& ea, const ERows& eb, const XPk& x, float ga, float gb, Acc32& acc) {
  float pa = 0.f, pb = 0.f;
#pragma unroll
  for (int w = 0; w < 4; ++w) {
    pa = dot2bf(ea.u0[w], x.x0[w], pa); pa = dot2bf(ea.u1[w], x.x1[w], pa);
    pa = dot2bf(ea.u2[w], x.x2[w], pa); pa = dot2bf(ea.u3[w], x.x3[w], pa);
    pb = dot2bf(eb.u0[w], x.x0[w], pb); pb = dot2bf(eb.u1[w], x.x1[w], pb);
    pb = dot2bf(eb.u2[w], x.x2[w], pb); pb = dot2bf(eb.u3[w], x.x3[w], pb);
  }
#pragma unroll
  for (int o = 32; o > 0; o >>= 1) { pa += __shfl_xor(pa, o); pb += __shfl_xor(pb, o); }
  const unsigned hpk = pack2(ga * gelu_fast(pa), gb * gelu_fast(pb));
#define PEER_V(va, vb, accv, base)                                              \
  _Pragma("unroll") for (int w = 0; w < 4; ++w) {                               \
    const unsigned A = va[w], B = vb[w];                                        \
    const unsigned lo = (A & 0xffffu) | (B << 16);                              \
    const unsigned hi = (A >> 16) | (B & 0xffff0000u);                          \
    accv[base + 2 * w] = dot2bf(lo, hpk, accv[base + 2 * w]);                   \
    accv[base + 2 * w + 1] = dot2bf(hi, hpk, accv[base + 2 * w + 1]);           \
  }
  PEER_V(ea.v0, eb.v0, acc.a, 0) PEER_V(ea.v1, eb.v1, acc.a, 8) PEER_V(ea.v2, eb.v2, acc.b, 0) PEER_V(ea.v3, eb.v3, acc.b, 8)
#undef PEER_V
}

__device__ __forceinline__ void ph_peer(const P& p, float* smem) {
  typedef __attribute__((ext_vector_type(4))) float f32x4;
  int lane = opq(threadIdx.x) & 63, wv = opq(threadIdx.x) >> 6;
  float* ts = smem + wv * 256;
  int* ti = (int*)(smem + 1024) + wv * 256;
  float* bgt = smem + 2048 + wv * 128;
  int* bex = (int*)(smem + 2560) + wv * 128;
  for (int item = blockIdx.x; item < T_TOK / 4; item += gridDim.x) {
    int t = item * 4 + wv;
    const float* scrow = p.scores + (size_t)t * DM;
    for (int hp = 0; hp < 16; ++hp) {
      float sc0 = scrow[hp * 128 + lane], sc1 = scrow[hp * 128 + 64 + lane];
      for (int n = 0; n < 16; ++n) {
        float v;
        int i;
        if (sc0 >= sc1) { v = sc0; i = lane; } else { v = sc1; i = lane + 64; }
        wave_argmax(v, i);
        if (lane == 0) { ts[hp * 16 + n] = v; ti[hp * 16 + n] = i; }
        if (i == lane) sc0 = -INFINITY;
        if (i == lane + 64) sc1 = -INFINITY;
      }
    }
    __builtin_amdgcn_wave_barrier();
    for (int h = 0; h < 8; ++h) {
      float cv0, cv1, cv2, cv3;
      cv0 = ts[(2 * h) * 16 + ((lane) >> 4)] + ts[(2 * h + 1) * 16 + (lane & 15)];
      cv1 = ts[(2 * h) * 16 + ((64 + lane) >> 4)] + ts[(2 * h + 1) * 16 + (lane & 15)];
      cv2 = ts[(2 * h) * 16 + ((128 + lane) >> 4)] + ts[(2 * h + 1) * 16 + (lane & 15)];
      cv3 = ts[(2 * h) * 16 + ((192 + lane) >> 4)] + ts[(2 * h + 1) * 16 + (lane & 15)];
      float mybest = 0.f;
      int myc = 0;
      for (int n = 0; n < 16; ++n) {
        float v = cv0;
        int i = lane;
        if (cv1 > v) { v = cv1; i = 64 + lane; }
        if (cv2 > v) { v = cv2; i = 128 + lane; }
        if (cv3 > v) { v = cv3; i = 192 + lane; }
        wave_argmax(v, i);
        if (lane == n) { mybest = v; myc = i; }
        if (i == lane) cv0 = -INFINITY;
        if (i == 64 + lane) cv1 = -INFINITY;
        if (i == 128 + lane) cv2 = -INFINITY;
        if (i == 192 + lane) cv3 = -INFINITY;
      }
      float sv = (lane < 16) ? mybest : -INFINITY;
      float mx = wave_max(sv);
      float e = (lane < 16) ? expf(sv - mx) : 0.f;
      float sum = wave_sum(e);
      if (lane < 16) {
        bgt[h * 16 + lane] = e / sum;
        bex[h * 16 + lane] = ti[(2 * h) * 16 + (myc >> 4)] * 128 + ti[(2 * h + 1) * 16 + (myc & 15)];
      }
    }
    __builtin_amdgcn_wave_barrier();
    XPk x;
    {
      const f32x4* s4 = (const f32x4*)(p.out + (size_t)t * DM);
      const f32x4* g4 = (const f32x4*)p.norm_ffn;
      f32x4 a0 = s4[lane * 2], a1 = s4[lane * 2 + 1], a2 = s4[128 + lane * 2], a3 = s4[128 + lane * 2 + 1];
      f32x4 a4 = s4[256 + lane * 2], a5 = s4[256 + lane * 2 + 1], a6 = s4[384 + lane * 2], a7 = s4[384 + lane * 2 + 1];
      float ss = 0.f;
#define SSQ(v) ss += v[0] * v[0] + v[1] * v[1] + v[2] * v[2] + v[3] * v[3];
      SSQ(a0) SSQ(a1) SSQ(a2) SSQ(a3) SSQ(a4) SSQ(a5) SSQ(a6) SSQ(a7)
#undef SSQ
      ss = wave_sum(ss);
      const float rs = rsqrtf(ss * (1.f / DM) + RMS_EPS);
#define XPK(dst, va, vb, gi)                                                          \
  {                                                                                   \
    const f32x4 ga = g4[gi], gb = g4[gi + 1];                                         \
    dst[0] = pack2(va[0] * rs * ga[0], va[1] * rs * ga[1]);                           \
    dst[1] = pack2(va[2] * rs * ga[2], va[3] * rs * ga[3]);                           \
    dst[2] = pack2(vb[0] * rs * gb[0], vb[1] * rs * gb[1]);                           \
    dst[3] = pack2(vb[2] * rs * gb[2], vb[3] * rs * gb[3]);                           \
  }
      XPK(x.x0, a0, a1, lane * 2) XPK(x.x1, a2, a3, 128 + lane * 2) XPK(x.x2, a4, a5, 256 + lane * 2) XPK(x.x3, a6, a7, 384 + lane * 2)
#undef XPK
    }
    Acc32 acc;
#pragma unroll
    for (int r = 0; r < 16; ++r) { acc.a[r] = 0.f; acc.b[r] = 0.f; }
    ERows ca, cb, na, nb;
    erows_load(ca, p.pub, p.pvb, bex[0], lane);
    erows_load(cb, p.pub, p.pvb, bex[1], lane);
    for (int pr = 0; pr < 64; pr += 2) {
      erows_load(na, p.pub, p.pvb, bex[2 * pr + 2], lane);
      erows_load(nb, p.pub, p.pvb, bex[2 * pr + 3], lane);
      peer_pair(ca, cb, x, bgt[2 * pr], bgt[2 * pr + 1], acc);
      const int e2 = (2 * pr + 4 < 128) ? 2 * pr + 4 : 126;
      erows_load(ca, p.pub, p.pvb, bex[e2], lane);
      erows_load(cb, p.pub, p.pvb, bex[e2 + 1], lane);
      peer_pair(na, nb, x, bgt[2 * pr + 2], bgt[2 * pr + 3], acc);
    }
    int lane2 = lane;
    asm volatile("" : "+v"(lane2));
    f32x4* o4 = (f32x4*)(p.out + (size_t)t * DM);
    const f32x4* g4 = (const f32x4*)p.norm_final;
    f32x4 hv[8];
    float ss = 0.f;
#pragma unroll
    for (int i = 0; i < 4; ++i) {
      hv[2 * i] = o4[i * 128 + lane2 * 2];
      hv[2 * i + 1] = o4[i * 128 + lane2 * 2 + 1];
#pragma unroll
      for (int c = 0; c < 4; ++c) {
        hv[2 * i][c] += (i < 2) ? acc.a[(i & 1) * 8 + c] : acc.b[(i & 1) * 8 + c];
        hv[2 * i + 1][c] += (i < 2) ? acc.a[(i & 1) * 8 + 4 + c] : acc.b[(i & 1) * 8 + 4 + c];
        ss += hv[2 * i][c] * hv[2 * i][c] + hv[2 * i + 1][c] * hv[2 * i + 1][c];
      }
    }
    ss = wave_sum(ss);
    const float rs = rsqrtf(ss * (1.f / DM) + RMS_EPS);
#pragma unroll
    for (int i = 0; i < 4; ++i) {
      const f32x4 ga = g4[i * 128 + lane2 * 2], gb = g4[i * 128 + lane2 * 2 + 1];
      f32x4 oa, ob;
#pragma unroll
      for (int c = 0; c < 4; ++c) { oa[c] = hv[2 * i][c] * rs * ga[c]; ob[c] = hv[2 * i + 1][c] * rs * gb[c]; }
      o4[i * 128 + lane2 * 2] = oa;
      o4[i * 128 + lane2 * 2 + 1] = ob;
    }
    __builtin_amdgcn_wave_barrier();
  }
}

typedef const __attribute__((address_space(4))) P* KP;
__device__ __forceinline__ P loadP() {
#if defined(__HIP_DEVICE_COMPILE__)
  KP k = (KP)__builtin_amdgcn_kernarg_segment_ptr();
  asm volatile("" : "+s"(k));
  P p = *k;
  return p;
#else
  return P{};
#endif
}

__global__ void __launch_bounds__(256, 2) mega(P p_arg) {
  cg::grid_group grid = cg::this_grid();
  __shared__ __attribute__((aligned(16))) float smem[14336];
  char* lds = (char*)smem;
  { P p = loadP(); ph_rmsnorm(p.x, p.norm_mix, p.hn, T_TOK); ph_rmsnorm(p.mem, p.norm_mkv, p.memn, 1024); }
  { P p = loadP(); ph_transpose<true>(smem, p.w_in, DM, INC, 5760, p.WinT); }
  { P p = loadP(); ph_transpose<false>(smem, p.w_out, DM, DM, DM, p.WoutT); }
  { P p = loadP(); ph_transpose<false>(smem, p.w_pq, DM, DM, DM, p.WpqT); }
  { P p = loadP(); ph_transpose<false>(smem, p.w_mq, DM, 512, 512, p.WmqT); }
  { P p = loadP(); ph_transpose<false>(smem, p.w_mk, DM, 512, 512, p.WmkT); }
  { P p = loadP(); ph_transpose<false>(smem, p.w_mv, DM, 512, 512, p.WmvT); }
  { P p = loadP(); ph_transpose<false>(smem, p.w_mo, 512, DM, DM, p.WmoT); }
  { P p = loadP(); ph_cvt(p.pu, p.pub, (size_t)16384 * DM); }
  { P p = loadP(); ph_cvt(p.pv, p.pvb, (size_t)16384 * DM); }
  { P p = loadP(); ph_cvt(p.subk, p.subkb, (size_t)16 * 128 * 128); }
  { P p = loadP(); ph_transpose<false>(smem, p.w1_k, 4096, 128, 128, p.w1T); }
  { P p = loadP(); ph_transpose<false>(smem, p.w1_v, 4096, 128, 128, p.w1T + 128 * 4096); }
  { P p = loadP(); ph_transpose<false>(smem, p.w2_k, 128, 128, 128, p.w2T); }
  { P p = loadP(); ph_transpose<false>(smem, p.w2_v, 128, 128, 128, p.w2T + 128 * 128); }
  { P p = loadP(); ph_posb(p); }
  grid.sync();
  { P p = loadP(); ph_proj(p, lds); }
  { P p = loadP(); bf16_t* kmem = p.kmemb;
    ph_gemm_bf16(p.memn, DM, p.WmkT, DM, 1024, 512, DM, lds, [=](int m, int n, float v) {
      kmem[((size_t)((m >> 8) * 4 + (n >> 7)) * 256 + (m & 255)) * 128 + (n & 127)] = f2bf(v); }); }
  { P p = loadP(); bf16_t* vmem = p.vmemT;
    ph_gemm_bf16(p.memn, DM, p.WmvT, DM, 1024, 512, DM, lds, [=](int m, int n, float v) {
      vmem[((size_t)((m >> 8) * 4 + (n >> 7)) * 128 + (n & 127)) * 256 + perm16(m & 255)] = f2bf(v); }); }
  grid.sync();
  { P p = loadP(); ph_compress2(p, lds); }
  { P p = loadP(); ph_sb2(p, lds); }
  grid.sync();
  { P p = loadP(); ph_nsa2(p, lds); }
  grid.sync();
  { P p = loadP(); float* out = p.out; const float* x = p.x;
    ph_gemm_bf16(p.omix, DM, p.WoutT, DM, T_TOK, DM, DM, lds, [=](int m, int n, float v) { out[(size_t)m * DM + n] = x[(size_t)m * DM + n] + v; }); }
  grid.sync();
  { P p = loadP(); ph_rmsnorm(p.out, p.norm_mq, p.hn, T_TOK); }
  grid.sync();
  { P p = loadP(); bf16_t* qmem = p.qmemb;
    ph_gemm_bf16(p.hn, DM, p.WmqT, DM, T_TOK, 512, DM, lds, [=](int m, int n, float v) { qmem[(size_t)m * 512 + n] = f2bf(v); }); }
  grid.sync();
  { P p = loadP(); ph_memattn2(p, lds); }
  grid.sync();
  { P p = loadP(); float* out = p.out;
    ph_gemm_bf16(p.omem, 512, p.WmoT, 512, T_TOK, DM, 512, lds, [=](int m, int n, float v) { out[(size_t)m * DM + n] += v; }); }
  grid.sync();
  { P p = loadP(); ph_rmsnorm(p.out, p.norm_ffn, p.hn, T_TOK); }
  grid.sync();
  { P p = loadP(); bf16_t* qp = p.omix;
    ph_gemm_bf16(p.hn, DM, p.WpqT, DM, T_TOK, DM, DM, lds, [=](int m, int n, float v) { qp[(size_t)m * DM + n] = f2bf(v); }); }
  grid.sync();
  { P p = loadP(); ph_scores(p, lds); }
  grid.sync();
  { P p = loadP(); ph_peer(p, smem); }
}

extern "C" void kernel_launch(void* const* d_in, const int* in_sizes, int n_in, void* d_out, int out_size, void* d_ws,
                              size_t ws_size, hipStream_t stream) {
  P p{};
  p.x = (const float*)d_in[0]; p.mem = (const float*)d_in[1]; p.t5 = (const float*)d_in[2];
  p.norm_mix = (const float*)d_in[3]; p.w_in = (const float*)d_in[4]; p.pos_k = (const float*)d_in[5];
  p.w1_k = (const float*)d_in[6]; p.w2_k = (const float*)d_in[7]; p.pos_v = (const float*)d_in[8];
  p.w1_v = (const float*)d_in[9]; p.w2_v = (const float*)d_in[10]; p.w_out = (const float*)d_in[11];
  p.norm_mq = (const float*)d_in[12]; p.norm_mkv = (const float*)d_in[13]; p.w_mq = (const float*)d_in[14];
  p.w_mk = (const float*)d_in[15]; p.w_mv = (const float*)d_in[16]; p.w_mo = (const float*)d_in[17];
  p.norm_ffn = (const float*)d_in[18]; p.w_pq = (const float*)d_in[19]; p.subk = (const float*)d_in[20];
  p.pu = (const float*)d_in[21]; p.pv = (const float*)d_in[22]; p.norm_final = (const float*)d_in[23];
  p.out = (float*)d_out;
  char* w = (char*)d_ws;
  size_t off = 0;
  auto take = [&](size_t bytes) { char* r = w + off; off += (bytes + 255) & ~(size_t)255; return r; };
  p.scores = (float*)take((size_t)T_TOK * DM * 4);
  p.gates = (float*)take((size_t)T_TOK * 24 * 4);
  p.part = (float*)take((size_t)T_TOK * 1024 * 4);
  p.posb = (float*)take(256 * 4);
  p.qn = (bf16_t*)take((size_t)T_TOK * 1024 * 2);
  p.kcin = (bf16_t*)take((size_t)T_TOK * 256 * 2 + 65536);
  p.vcin = (bf16_t*)take((size_t)T_TOK * 256 * 2 + 65536);
  p.ks = (bf16_t*)take((size_t)T_TOK * 256 * 2);
  p.vsT = (bf16_t*)take((size_t)T_TOK * 256 * 2);
  p.kw = (bf16_t*)take((size_t)T_TOK * 256 * 2);
  p.vwT = (bf16_t*)take((size_t)T_TOK * 256 * 2);
  p.kcb = (bf16_t*)take((size_t)8 * 128 * 128 * 2);
  p.vcT = (bf16_t*)take((size_t)8 * 128 * 128 * 2);
  p.c1 = (bf16_t*)take((size_t)16 * 128 * 128 * 2);
  p.w1T = (bf16_t*)take((size_t)2 * 128 * 4096 * 2);
  p.w2T = (bf16_t*)take((size_t)2 * 128 * 128 * 2);
  p.hn = (bf16_t*)take((size_t)T_TOK * DM * 2);
  p.omix = (bf16_t*)take((size_t)T_TOK * DM * 2);
  p.memn = (bf16_t*)take((size_t)1024 * DM * 2);
  p.omem = (bf16_t*)take((size_t)T_TOK * 512 * 2);
  p.WinT = (bf16_t*)take((size_t)5760 * DM * 2);
  p.WoutT = (bf16_t*)take((size_t)DM * DM * 2);
  p.WpqT = (bf16_t*)take((size_t)DM * DM * 2);
  p.WmqT = (bf16_t*)take((size_t)512 * DM * 2);
  p.WmkT = (bf16_t*)take((size_t)512 * DM * 2);
  p.WmvT = (bf16_t*)take((size_t)512 * DM * 2);
  p.WmoT = (bf16_t*)take((size_t)DM * 512 * 2);
  p.qmemb = (bf16_t*)take((size_t)T_TOK * 512 * 2);
  p.kmemb = (bf16_t*)take((size_t)1024 * 512 * 2);
  p.vmemT = (bf16_t*)take((size_t)1024 * 512 * 2);
  p.qsb = (bf16_t*)take((size_t)T_TOK * 1024 * 2);
  p.ksb = (bf16_t*)take((size_t)T_TOK * 1024 * 2);
  p.vsbT = (bf16_t*)take((size_t)T_TOK * 1024 * 2);
  p.pub = (bf16_t*)take((size_t)16384 * DM * 2);
  p.pvb = (bf16_t*)take((size_t)16384 * DM * 2);
  p.subkb = (bf16_t*)take((size_t)16 * 128 * 128 * 2);
  static int grid_blocks = 0;
  if (!grid_blocks) {
    int dev = 0, cus = 0, per_cu = 0;
    (void)hipGetDevice(&dev);
    (void)hipDeviceGetAttribute(&cus, hipDeviceAttributeMultiprocessorCount, dev);
    (void)hipOccupancyMaxActiveBlocksPerMultiprocessor(&per_cu, mega, 256, 0);
    if (per_cu > 2) per_cu = 2;
    if (per_cu < 1) per_cu = 1;
    grid_blocks = cus * per_cu;
  }
  void* args[] = {&p};
  hipError_t e = hipLaunchCooperativeKernel((void*)mega, dim3(grid_blocks), dim3(256), args, 0, stream);
  if (e != hipSuccess) fprintf(stderr, "cooperative launch failed: %s (grid %d)\n", hipGetErrorString(e), grid_blocks);
}
```

```cpp
#include <hip/hip_runtime.h>
#include <hip/hip_cooperative_groups.h>
#include <cstdio>
namespace cg = cooperative_groups;
#include <stdint.h>

#define SEQ 2048
#define NBATCH 4
#define T_TOK 8192
#define DM 2048
#define INC 5656
#define C_QN 0
#define C_KC 1024
#define C_VC 1280
#define C_KS 1536
#define C_VS 1792
#define C_KW 2048
#define C_VW 2304
#define C_GT 2560
#define C_QSB 2584
#define C_KSB 3608
#define C_VSB 4632
#define ATT_SCALE 0.08838834764831845f
#define RMS_EPS 1e-6f

typedef unsigned short bf16_t;
typedef __attribute__((ext_vector_type(8))) short bf16x8;
typedef __attribute__((ext_vector_type(16))) float f32x16;
typedef __attribute__((ext_vector_type(2))) __bf16 bf16v2;
typedef __attribute__((ext_vector_type(4))) unsigned u32x4;

struct P {
  const float *x, *mem, *t5, *norm_mix, *w_in, *pos_k, *w1_k, *w2_k, *pos_v, *w1_v, *w2_v, *w_out,
      *norm_mq, *norm_mkv, *w_mq, *w_mk, *w_mv, *w_mo, *norm_ffn, *w_pq, *subk, *pu, *pv, *norm_final;
  float* out;
  float *scores, *gates, *part, *posb;
  unsigned* bar;
  bf16_t *hn, *omix, *memn, *omem;
  bf16_t *WinT, *WoutT, *WpqT, *WmqT, *WmkT, *WmvT, *WmoT;
  bf16_t *qmemb, *kmemb, *vmemT;
  bf16_t *qsb, *ksb, *vsbT;
  bf16_t *pub, *pvb, *subkb;
  bf16_t *qn, *kcin, *vcin, *ks, *vsT, *kw, *vwT, *kcb, *vcT, *c1, *w1T, *w2T;
};

__device__ __forceinline__ int opq(int v) { asm volatile("" : "+v"(v)); return v; }
__device__ __forceinline__ unsigned pack2(float a, float b) {
  bf16v2 r = {(__bf16)a, (__bf16)b};
  return *(unsigned*)&r;
}
__device__ __forceinline__ bf16_t f2bf(float a) {
  __bf16 r = (__bf16)a;
  return *(bf16_t*)&r;
}
__device__ __forceinline__ int perm16(int s) { return (s & ~12) | ((s & 4) << 1) | ((s & 8) >> 1); }
__device__ __forceinline__ float bf2f(bf16_t u) { return __uint_as_float((unsigned)u << 16); }

__device__ __forceinline__ float wave_max(float v) {
  for (int o = 32; o > 0; o >>= 1) v = fmaxf(v, __shfl_xor(v, o));
  return v;
}
__device__ __forceinline__ float wave_sum(float v) {
  for (int o = 32; o > 0; o >>= 1) v += __shfl_xor(v, o);
  return v;
}
__device__ __forceinline__ void wave_argmax(float& v, int& i) {
  for (int o = 32; o > 0; o >>= 1) {
    float ov = __shfl_xor(v, o);
    int oi = __shfl_xor(i, o);
    if (ov > v || (ov == v && oi < i)) { v = ov; i = oi; }
  }
}
__device__ __forceinline__ float gelu_tanh(float x) {
  return 0.5f * x * (1.f + tanhf(0.7978845608028654f * (x + 0.044715f * x * x * x)));
}
__device__ __forceinline__ float gelu_fast(float x) {
  const float y = 1.5957691216057308f * (x + 0.044715f * x * x * x);
  return x / (1.f + __expf(-y));
}
__device__ __forceinline__ int t5_bucket(int n) {
  if (n < 16) return n < 0 ? 0 : n;
  int b = 16;
  b += (n >= 19); b += (n >= 21); b += (n >= 24); b += (n >= 27); b += (n >= 31); b += (n >= 35);
  b += (n >= 40); b += (n >= 46); b += (n >= 52); b += (n >= 59); b += (n >= 67); b += (n >= 77);
  b += (n >= 87); b += (n >= 99); b += (n >= 113);
  return b;
}
__device__ __forceinline__ float log_sigmoid(float x) {
  return fminf(x, 0.f) - log1pf(expf(-fabsf(x)));
}

__device__ __forceinline__ void ph_rmsnorm(const float* src, const float* gain, bf16_t* dst, int rows) {
  int lane = opq(threadIdx.x) & 63, wv = opq(threadIdx.x) >> 6;
  for (int r = blockIdx.x * 4 + wv; r < rows; r += gridDim.x * 4) {
    const float4* s4 = (const float4*)(src + (size_t)r * DM);
    float4 v[8];
    float ss = 0.f;
#pragma unroll
    for (int i = 0; i < 8; ++i) {
      v[i] = s4[i * 64 + lane];
      ss += v[i].x * v[i].x + v[i].y * v[i].y + v[i].z * v[i].z + v[i].w * v[i].w;
    }
    ss = wave_sum(ss);
    float rs = rsqrtf(ss * (1.f / DM) + RMS_EPS);
    uint2* d2 = (uint2*)(dst + (size_t)r * DM);
    const float4* g4 = (const float4*)gain;
#pragma unroll
    for (int i = 0; i < 8; ++i) {
      float4 g = g4[i * 64 + lane];
      uint2 o;
      o.x = pack2(v[i].x * rs * g.x, v[i].y * rs * g.y);
      o.y = pack2(v[i].z * rs * g.z, v[i].w * rs * g.w);
      d2[i * 64 + lane] = o;
    }
  }
}

template <bool CMAP>
__device__ __forceinline__ void ph_transpose(float* smem, const float* W, int K, int N, int Npad, bf16_t* Wt) {
  float (*tl)[65] = (float (*)[65])smem;
  int tid = opq(threadIdx.x);
  int nk = K / 64, nn = Npad / 64;
  for (int tile = blockIdx.x; tile < nk * nn; tile += gridDim.x) {
    int k0 = (tile % nk) * 64, n0 = (tile / nk) * 64;
    int col = tid & 63, rb = tid >> 6;
#pragma unroll 4
    for (int pp = 0; pp < 16; ++pp) {
      int k = pp * 4 + rb;
      float v = 0.f;
      int sc = n0 + col;
      if (CMAP) sc = (sc < 2560) ? sc : (sc < 5632) ? sc + 24 : (sc < 5656) ? sc - 5632 + 2560 : N;
      if (sc < N) v = W[(size_t)(k0 + k) * N + sc];
      tl[k][col] = v;
    }
    __syncthreads();
    int n = tid >> 2, kc = (tid & 3) * 16;
    unsigned w[8];
#pragma unroll
    for (int i = 0; i < 8; ++i) w[i] = pack2(tl[kc + 2 * i][n], tl[kc + 2 * i + 1][n]);
    uint4* dst = (uint4*)(Wt + (size_t)(n0 + n) * K + k0 + kc);
    dst[0] = make_uint4(w[0], w[1], w[2], w[3]);
    dst[1] = make_uint4(w[4], w[5], w[6], w[7]);
    __syncthreads();
  }
}

__device__ __forceinline__ int lds_off(int row, int chunk) { return row * 128 + ((chunk ^ ((row >> 1) & 7)) << 4); }

template <bool TR, class Epi>
__device__ __forceinline__ void gemm_tile_bf16(const bf16_t* xp, int ldx, const bf16_t* yp, int ldy, int K, char* lds,
                                               Epi epi) {
  const int tid = opq(threadIdx.x), lane = tid & 63, wv = tid >> 6;
  const int wr = wv >> 1, wc = wv & 1;
  char* lx = lds;
  char* ly = lds + 16384;
  f32x16 acc[2][2];
#pragma unroll
  for (int i = 0; i < 2; ++i)
#pragma unroll
    for (int j = 0; j < 2; ++j)
#pragma unroll
      for (int r = 0; r < 16; ++r) acc[i][j][r] = 0.f;
  const int srow = tid >> 3, sch = tid & 7;
  const bf16_t* xg = xp + (size_t)srow * ldx + sch * 8;
  const bf16_t* yg = yp + (size_t)srow * ldy + sch * 8;
  const size_t x32 = (size_t)32 * ldx, y32 = (size_t)32 * ldy;
  uint4 sx0 = *(const uint4*)(xg), sx1 = *(const uint4*)(xg + x32), sx2 = *(const uint4*)(xg + 2 * x32),
        sx3 = *(const uint4*)(xg + 3 * x32);
  uint4 sy0 = *(const uint4*)(yg), sy1 = *(const uint4*)(yg + y32), sy2 = *(const uint4*)(yg + 2 * y32),
        sy3 = *(const uint4*)(yg + 3 * y32);
  const int so0 = lds_off(srow, sch), so1 = lds_off(32 + srow, sch), so2 = lds_off(64 + srow, sch),
            so3 = lds_off(96 + srow, sch);
  for (int k0 = 0; k0 < K; k0 += 64) {
    __syncthreads();
    *(uint4*)(lx + so0) = sx0; *(uint4*)(lx + so1) = sx1; *(uint4*)(lx + so2) = sx2; *(uint4*)(lx + so3) = sx3;
    *(uint4*)(ly + so0) = sy0; *(uint4*)(ly + so1) = sy1; *(uint4*)(ly + so2) = sy2; *(uint4*)(ly + so3) = sy3;
    __syncthreads();
    if (k0 + 64 < K) {
      const bf16_t* xn = xg + k0 + 64;
      const bf16_t* yn = yg + k0 + 64;
      sx0 = *(const uint4*)(xn); sx1 = *(const uint4*)(xn + x32); sx2 = *(const uint4*)(xn + 2 * x32);
      sx3 = *(const uint4*)(xn + 3 * x32);
      sy0 = *(const uint4*)(yn); sy1 = *(const uint4*)(yn + y32); sy2 = *(const uint4*)(yn + 2 * y32);
      sy3 = *(const uint4*)(yn + 3 * y32);
    }
#pragma unroll
    for (int kk = 0; kk < 4; ++kk) {
      bf16x8 a[2], b[2];
      const int ch = kk * 2 + (lane >> 5);
#pragma unroll
      for (int i = 0; i < 2; ++i) {
        a[i] = *(const bf16x8*)((TR ? ly : lx) + lds_off(wr * 64 + i * 32 + (lane & 31), ch));
        b[i] = *(const bf16x8*)((TR ? lx : ly) + lds_off(wc * 64 + i * 32 + (lane & 31), ch));
      }
#pragma unroll
      for (int i = 0; i < 2; ++i)
#pragma unroll
        for (int j = 0; j < 2; ++j) acc[i][j] = __builtin_amdgcn_mfma_f32_32x32x16_bf16(a[i], b[j], acc[i][j], 0, 0, 0);
    }
  }
  int lane2 = lane;
  asm volatile("" : "+v"(lane2));
#pragma unroll
  for (int i = 0; i < 2; ++i)
#pragma unroll
    for (int j = 0; j < 2; ++j)
#pragma unroll
      for (int r = 0; r < 16; ++r) {
        int rr = wr * 64 + i * 32 + (r & 3) + 8 * (r >> 2) + 4 * (lane2 >> 5);
        int cc = wc * 64 + j * 32 + (lane2 & 31);
        epi(rr, cc, acc[i][j][r]);
      }
}

template <class Epi>
__device__ __forceinline__ void ph_gemm_bf16(const bf16_t* A, int lda, const bf16_t* Wt, int ldw, int M, int N, int K,
                                             char* lds, Epi epi) {
  const int ntm = M / 128, ntn = N / 128;
  const int npm = (ntm + 7) / 8, npn = (ntn + 7) / 8;
  const int nslots = ((npm * npn * 64 + 511) / 512) * 512;
  for (int u = blockIdx.x; u < nslots; u += gridDim.x) {
    int v = (u & 7) * 64 + ((u >> 3) & 63) + (u & ~511);
    int patch = v >> 6, w = v & 63;
    int tm = (patch % npm) * 8 + (w & 7);
    int tn = (patch / npm) * 8 + (w >> 3);
    if (tm >= ntm || tn >= ntn) continue;
    const int m0 = tm * 128, n0 = tn * 128;
    gemm_tile_bf16<false>(A + (size_t)m0 * lda, lda, Wt + (size_t)n0 * ldw, ldw, K, lds,
                          [&](int r, int c, float val) { epi(m0 + r, n0 + c, val); });
  }
}

__device__ __forceinline__ void ph_proj(const P& p, char* lds) {
  const int ntm = T_TOK / 128, ntn = 5760 / 128;
  const int npm = (ntm + 7) / 8, npn = (ntn + 7) / 8;
  const int nslots = ((npm * npn * 64 + 511) / 512) * 512;
  for (int u = blockIdx.x; u < nslots; u += gridDim.x) {
    int v = (u & 7) * 64 + ((u >> 3) & 63) + (u & ~511);
    int patch = v >> 6, w = v & 63;
    int tm = (patch % npm) * 8 + (w & 7);
    int tn = (patch / npm) * 8 + (w >> 3);
    if (tm >= ntm || tn >= ntn) continue;
    const int m0 = tm * 128, n0 = tn * 128;
    const int b = m0 >> 11, sl = m0 & 2047;
    const bf16_t* A = p.hn + (size_t)m0 * DM;
    const bf16_t* W = p.WinT + (size_t)n0 * DM;
    if (n0 < 1024) {
      bf16_t* q = p.qn + (size_t)m0 * 1024 + n0;
      gemm_tile_bf16<false>(A, DM, W, DM, DM, lds, [&](int r, int c, float val) { q[(size_t)r * 1024 + c] = f2bf(val); });
    } else if (n0 < 2560) {
      const int seg = (n0 - 1024) >> 8, g = ((n0 - 1024) >> 7) & 1;
      if (seg == 3 || seg == 5) {
        bf16_t* vd = (seg == 3 ? p.vsT : p.vwT) + ((size_t)(b * 2 + g) * 128) * SEQ + sl;
        gemm_tile_bf16<true>(A, DM, W, DM, DM, lds, [&](int r, int c, float val) { vd[(size_t)r * SEQ + perm16(c)] = f2bf(val); });
      } else {
        bf16_t* base = (seg == 0) ? p.kcin : (seg == 1) ? p.vcin : (seg == 2) ? p.ks : p.kw;
        bf16_t* kd = base + ((size_t)(b * 2 + g) * SEQ + sl) * 128;
        gemm_tile_bf16<false>(A, DM, W, DM, DM, lds, [&](int r, int c, float val) { kd[(size_t)r * 128 + c] = f2bf(val); });
      }
    } else if (n0 < 3584) {
      bf16_t* q = p.qsb + (size_t)m0 * 1024 + (n0 - 2560);
      gemm_tile_bf16<false>(A, DM, W, DM, DM, lds, [&](int r, int c, float val) { q[(size_t)r * 1024 + c] = f2bf(val); });
    } else if (n0 < 4608) {
      bf16_t* kd = p.ksb + ((size_t)(b * 8 + ((n0 - 3584) >> 7)) * SEQ + sl) * 128;
      gemm_tile_bf16<false>(A, DM, W, DM, DM, lds, [&](int r, int c, float val) { kd[(size_t)r * 128 + c] = f2bf(val); });
    } else if (n0 < 5632) {
      bf16_t* vd = p.vsbT + ((size_t)(b * 8 + ((n0 - 4608) >> 7)) * 128) * SEQ + sl;
      gemm_tile_bf16<true>(A, DM, W, DM, DM, lds, [&](int r, int c, float val) { vd[(size_t)r * SEQ + perm16(c)] = f2bf(val); });
    } else {
      float* gd = p.gates + (size_t)m0 * 24;
      gemm_tile_bf16<false>(A, DM, W, DM, DM, lds, [&](int r, int c, float val) { if (c < 24) gd[(size_t)r * 24 + c] = val; });
    }
  }
}

__device__ __forceinline__ void ph_posb(const P& p) {
  const int lane = opq(threadIdx.x) & 63, wv = opq(threadIdx.x) >> 6;
  for (int o = blockIdx.x * 4 + wv; o < 256; o += gridDim.x * 4) {
    const int which = o >> 7, n = o & 127;
    const float* pos = which ? p.pos_v : p.pos_k;
    const float* w1 = which ? p.w1_v : p.w1_k;
    float acc = 0.f;
    for (int k = lane; k < 4096; k += 64) acc += pos[k] * w1[(size_t)k * 128 + n];
    acc = wave_sum(acc);
    if (lane == 0) p.posb[o] = acc;
  }
}

__device__ __forceinline__ void ph_compress2(const P& p, char* lds) {
  for (int item = blockIdx.x; item < 16; item += gridDim.x) {
    const int which = item >> 3, bg = item & 7;
    const bf16_t* src = (which ? p.vcin : p.kcin) + (size_t)bg * SEQ * 128;
    const bf16_t* w1t = p.w1T + (size_t)which * 128 * 4096;
    const bf16_t* w2t = p.w2T + (size_t)which * 128 * 128;
    const float* posb = p.posb + which * 128;
    bf16_t* c1 = p.c1 + (size_t)item * 128 * 128;
    gemm_tile_bf16<false>(src, 2048, w1t, 4096, 4096, lds, [&](int r, int c, float val) {
      c1[r * 128 + c] = f2bf(gelu_fast(val + posb[c])); });
    __threadfence_block();
    __syncthreads();
    if (which == 0) {
      bf16_t* kd = p.kcb + (size_t)bg * 128 * 128;
      gemm_tile_bf16<false>(c1, 128, w2t, 128, 128, lds, [&](int r, int c, float val) { kd[r * 128 + c] = f2bf(val); });
    } else {
      bf16_t* vd = p.vcT + (size_t)bg * 128 * 128;
      gemm_tile_bf16<true>(c1, 128, w2t, 128, 128, lds, [&](int r, int c, float val) { vd[r * 128 + perm16(c)] = f2bf(val); });
    }
  }
}

#define NEG_BIG (-1e30f)

struct KVRegs { u32x4 k0, k1, k2, k3, v0, v1, v2, v3; };

__device__ __forceinline__ int koff(int row, int chunk) { return row * 256 + ((chunk ^ (row & 15)) << 4); }

__device__ __forceinline__ void kv_load(KVRegs& r, const bf16_t* kp, int ldk, const bf16_t* vp, int ldv) {
  const int tid = opq(threadIdx.x);
  const bf16_t* kg = kp + (size_t)(tid >> 4) * ldk + (tid & 15) * 8;
  r.k0 = *(const u32x4*)kg;
  r.k1 = *(const u32x4*)(kg + (size_t)16 * ldk);
  r.k2 = *(const u32x4*)(kg + (size_t)32 * ldk);
  r.k3 = *(const u32x4*)(kg + (size_t)48 * ldk);
  const bf16_t* vg = vp + (size_t)(tid >> 3) * ldv + (tid & 7) * 8;
  r.v0 = *(const u32x4*)vg;
  r.v1 = *(const u32x4*)(vg + (size_t)32 * ldv);
  r.v2 = *(const u32x4*)(vg + (size_t)64 * ldv);
  r.v3 = *(const u32x4*)(vg + (size_t)96 * ldv);
}
__device__ __forceinline__ void kv_store(const KVRegs& r, char* lk, char* lv) {
  const int tid = opq(threadIdx.x);
  const int row = tid >> 4, ch = tid & 15;
  *(u32x4*)(lk + koff(row, ch)) = r.k0;
  *(u32x4*)(lk + koff(row + 16, ch)) = r.k1;
  *(u32x4*)(lk + koff(row + 32, ch)) = r.k2;
  *(u32x4*)(lk + koff(row + 48, ch)) = r.k3;
  const int vr = tid >> 3, vc = tid & 7;
  *(u32x4*)(lv + lds_off(vr, vc)) = r.v0;
  *(u32x4*)(lv + lds_off(vr + 32, vc)) = r.v1;
  *(u32x4*)(lv + lds_off(vr + 64, vc)) = r.v2;
  *(u32x4*)(lv + lds_off(vr + 96, vc)) = r.v3;
}

struct QFrag { bf16x8 f0, f1, f2, f3, f4, f5, f6, f7; };
__device__ __forceinline__ void q_load(QFrag& q, const bf16_t* qrow) {
  const int h = (opq(threadIdx.x) & 63) >> 5;
  const bf16x8* p8 = (const bf16x8*)(qrow + 8 * h);
  q.f0 = p8[0]; q.f1 = p8[2]; q.f2 = p8[4]; q.f3 = p8[6]; q.f4 = p8[8]; q.f5 = p8[10]; q.f6 = p8[12]; q.f7 = p8[14];
}

__device__ __forceinline__ void qk_tile(const QFrag& q, const char* lk, f32x16& s0, f32x16& s1) {
  const int lane = opq(threadIdx.x) & 63, row = lane & 31, h = lane >> 5;
#pragma unroll
  for (int r = 0; r < 16; ++r) { s0[r] = 0.f; s1[r] = 0.f; }
#define QK_STEP(kk, qf)                                                                  \
  {                                                                                      \
    bf16x8 a0 = *(const bf16x8*)(lk + koff(row, 2 * (kk) + h));                          \
    bf16x8 a1 = *(const bf16x8*)(lk + koff(row + 32, 2 * (kk) + h));                     \
    s0 = __builtin_amdgcn_mfma_f32_32x32x16_bf16(a0, qf, s0, 0, 0, 0);                   \
    s1 = __builtin_amdgcn_mfma_f32_32x32x16_bf16(a1, qf, s1, 0, 0, 0);                   \
  }
  QK_STEP(0, q.f0) QK_STEP(1, q.f1) QK_STEP(2, q.f2) QK_STEP(3, q.f3)
  QK_STEP(4, q.f4) QK_STEP(5, q.f5) QK_STEP(6, q.f6) QK_STEP(7, q.f7)
#undef QK_STEP
}

__device__ __forceinline__ bf16x8 pack8(const f32x16& p, const int base) {
  u32x4 u;
  u[0] = pack2(p[base + 0], p[base + 1]);
  u[1] = pack2(p[base + 2], p[base + 3]);
  u[2] = pack2(p[base + 4], p[base + 5]);
  u[3] = pack2(p[base + 6], p[base + 7]);
  return __builtin_bit_cast(bf16x8, u);
}

struct OAcc { f32x16 o0, o1, o2, o3; };
__device__ __forceinline__ void oacc_zero(OAcc& o) {
#pragma unroll
  for (int r = 0; r < 16; ++r) { o.o0[r] = 0.f; o.o1[r] = 0.f; o.o2[r] = 0.f; o.o3[r] = 0.f; }
}
__device__ __forceinline__ void oacc_scale(OAcc& o, float a) {
#pragma unroll
  for (int r = 0; r < 16; ++r) { o.o0[r] *= a; o.o1[r] *= a; o.o2[r] *= a; o.o3[r] *= a; }
}

__device__ __forceinline__ void pv_tile(OAcc& o, const char* lv, const f32x16& p0, const f32x16& p1) {
  const int lane = opq(threadIdx.x) & 63, row = lane & 31, h = lane >> 5;
  const bf16x8 pf0 = pack8(p0, 0), pf1 = pack8(p0, 8), pf2 = pack8(p1, 0), pf3 = pack8(p1, 8);
#define PV_ROW(dd, acc)                                                                                      \
  {                                                                                                          \
    acc = __builtin_amdgcn_mfma_f32_32x32x16_bf16(*(const bf16x8*)(lv + lds_off(32 * (dd) + row, 0 + h)), pf0, acc, 0, 0, 0); \
    acc = __builtin_amdgcn_mfma_f32_32x32x16_bf16(*(const bf16x8*)(lv + lds_off(32 * (dd) + row, 2 + h)), pf1, acc, 0, 0, 0); \
    acc = __builtin_amdgcn_mfma_f32_32x32x16_bf16(*(const bf16x8*)(lv + lds_off(32 * (dd) + row, 4 + h)), pf2, acc, 0, 0, 0); \
    acc = __builtin_amdgcn_mfma_f32_32x32x16_bf16(*(const bf16x8*)(lv + lds_off(32 * (dd) + row, 6 + h)), pf3, acc, 0, 0, 0); \
  }
  PV_ROW(0, o.o0) PV_ROW(1, o.o1) PV_ROW(2, o.o2) PV_ROW(3, o.o3)
#undef PV_ROW
}

__device__ __forceinline__ void softmax_tile(f32x16& s0, f32x16& s1, float& m, float& l, OAcc& o) {
  float mx = NEG_BIG;
#pragma unroll
  for (int r = 0; r < 16; ++r) mx = fmaxf(mx, fmaxf(s0[r], s1[r]));
  mx = fmaxf(mx, __shfl_xor(mx, 32));
  const float mn = fmaxf(m, mx);
  const float alpha = __expf(m - mn);
  float ls = 0.f;
#pragma unroll
  for (int r = 0; r < 16; ++r) {
    float a = (s0[r] > -1e29f) ? __expf(s0[r] - mn) : 0.f;
    float b = (s1[r] > -1e29f) ? __expf(s1[r] - mn) : 0.f;
    s0[r] = a; s1[r] = b;
    ls += a + b;
  }
  ls += __shfl_xor(ls, 32);
  l = l * alpha + ls;
  m = mn;
  oacc_scale(o, alpha);
}

template <class F>
__device__ __forceinline__ void oacc_foreach(const OAcc& o, F f) {
  const int h = (opq(threadIdx.x) & 63) >> 5;
#pragma unroll
  for (int rho = 0; rho < 4; ++rho) {
    f(0 + 8 * rho + 4 * h, o.o0[4 * rho], o.o0[4 * rho + 1], o.o0[4 * rho + 2], o.o0[4 * rho + 3]);
    f(32 + 8 * rho + 4 * h, o.o1[4 * rho], o.o1[4 * rho + 1], o.o1[4 * rho + 2], o.o1[4 * rho + 3]);
    f(64 + 8 * rho + 4 * h, o.o2[4 * rho], o.o2[4 * rho + 1], o.o2[4 * rho + 2], o.o2[4 * rho + 3]);
    f(96 + 8 * rho + 4 * h, o.o3[4 * rho], o.o3[4 * rho + 1], o.o3[4 * rho + 2], o.o3[4 * rho + 3]);
  }
}

__device__ __forceinline__ void ph_memattn2(const P& p, char* lds) {
  char* lk = lds;
  char* lv = lds + 16384;
  const int lane = opq(threadIdx.x) & 63, wv = opq(threadIdx.x) >> 6;
  for (int item = blockIdx.x; item < NBATCH * 4 * (SEQ / 128); item += gridDim.x) {
    const int tb = item % (SEQ / 128);
    const int bh = item / (SEQ / 128);
    const int b = bh >> 2, hd = bh & 3;
    const int t = tb * 128 + wv * 32 + (lane & 31);
    QFrag q;
    q_load(q, p.qmemb + (size_t)(b * SEQ + t) * 512 + hd * 128);
    const bf16_t* kb = p.kmemb + (size_t)bh * 256 * 128;
    const bf16_t* vb = p.vmemT + (size_t)bh * 128 * 256;
    OAcc o;
    oacc_zero(o);
    float m = NEG_BIG, l = 0.f;
    KVRegs kv;
    kv_load(kv, kb, 128, vb, 256);
#pragma unroll 1
    for (int ti = 0; ti < 4; ++ti) {
      __syncthreads();
      kv_store(kv, lk, lv);
      __syncthreads();
      {
        const int tn = (ti + 1 < 4) ? ti + 1 : 3;
        kv_load(kv, kb + (size_t)tn * 64 * 128, 128, vb + tn * 64, 256);
      }
      f32x16 s0, s1;
      qk_tile(q, lk, s0, s1);
#pragma unroll
      for (int r = 0; r < 16; ++r) { s0[r] *= ATT_SCALE; s1[r] *= ATT_SCALE; }
      softmax_tile(s0, s1, m, l, o);
      pv_tile(o, lv, s0, s1);
    }
    const float il = 1.f / l;
    const int t2 = tb * 128 + (opq(threadIdx.x) >> 6) * 32 + (opq(threadIdx.x) & 31);
    bf16_t* orow = p.omem + (size_t)(b * SEQ + t2) * 512 + hd * 128;
    oacc_foreach(o, [&](int d, float v0, float v1, float v2, float v3) {
      uint2 u;
      u.x = pack2(v0 * il, v1 * il);
      u.y = pack2(v2 * il, v3 * il);
      *(uint2*)(orow + d) = u;
    });
  }
}

__device__ __forceinline__ void ph_sb2(const P& p, char* lds) {
  char* lk = lds;
  char* lv = lds + 16384;
  const int lane = opq(threadIdx.x) & 63, wv = opq(threadIdx.x) >> 6, hh = lane >> 5;
  for (int item = blockIdx.x; item < NBATCH * 8 * (SEQ / 128); item += gridDim.x) {
    const int tb = (SEQ / 128 - 1) - (item % (SEQ / 128));
    const int bh = item / (SEQ / 128);
    const int b = bh >> 3, hd = bh & 7;
    const int t0 = tb * 128;
    const int t = t0 + wv * 32 + (lane & 31);
    QFrag q;
    q_load(q, p.qsb + (size_t)(b * SEQ + t) * 1024 + hd * 128);
    const bf16_t* kb = p.ksb + (size_t)bh * SEQ * 128;
    const bf16_t* vb = p.vsbT + (size_t)bh * 128 * SEQ;
    OAcc o;
    oacc_zero(o);
    float carry = 0.f;
    const int jhi = (t0 >> 6) + 1;
    const int jw = (t0 + wv * 32 + 30) >> 6;
    KVRegs kv;
    kv_load(kv, kb + (size_t)jhi * 64 * 128, 128, vb + jhi * 64, SEQ);
    for (int j = jhi; j >= 0; --j) {
      __syncthreads();
      kv_store(kv, lk, lv);
      __syncthreads();
      const int jn = (j > 0) ? j - 1 : 0;
      if (j > jw) kv_load(kv, kb + (size_t)jn * 64 * 128, 128, vb + jn * 64, SEQ);
      if (j <= jw) {
        f32x16 z0, z1;
        qk_tile(q, lk, z0, z1);
        const int sbase = j * 64 + 4 * hh;
        float gt[8];
        f32x16 l0, l1;
#pragma unroll
        for (int r = 0; r < 16; ++r) {
          const int so = sbase + 8 * (r >> 2) + (r & 3);
          {
            const float z = z0[r] * ATT_SCALE;
            const bool valid = so < t;
            const float lsp = fminf(z, 0.f) - __logf(1.f + __expf(-fabsf(z)));
            l0[r] = valid ? (lsp - z) : 0.f;
            z0[r] = valid ? z : NEG_BIG;
          }
          {
            const float z = z1[r] * ATT_SCALE;
            const bool valid = so + 32 < t;
            const float lsp = fminf(z, 0.f) - __logf(1.f + __expf(-fabsf(z)));
            l1[r] = valid ? (lsp - z) : 0.f;
            z1[r] = valid ? z : NEG_BIG;
          }
        }
#pragma unroll
        for (int rho = 0; rho < 4; ++rho) {
          gt[rho] = (l0[4 * rho] + l0[4 * rho + 1]) + (l0[4 * rho + 2] + l0[4 * rho + 3]);
          gt[4 + rho] = (l1[4 * rho] + l1[4 * rho + 1]) + (l1[4 * rho + 2] + l1[4 * rho + 3]);
        }
        float ag[8];
        float run = 0.f;
#pragma unroll
        for (int k = 7; k >= 0; --k) {
          const float pg = __shfl_xor(gt[k], 32);
          ag[k] = carry + run + (hh == 0 ? pg : 0.f);
          run += gt[k] + pg;
        }
        carry += run;
#pragma unroll
        for (int rho = 0; rho < 4; ++rho) {
          {
            const float x3 = l0[4 * rho + 3], x23 = x3 + l0[4 * rho + 2], x123 = x23 + l0[4 * rho + 1];
            const float g = ag[rho];
            z0[4 * rho + 0] = __expf((l0[4 * rho + 0] + z0[4 * rho + 0]) + (g + x123));
            z0[4 * rho + 1] = __expf((l0[4 * rho + 1] + z0[4 * rho + 1]) + (g + x23));
            z0[4 * rho + 2] = __expf((l0[4 * rho + 2] + z0[4 * rho + 2]) + (g + x3));
            z0[4 * rho + 3] = __expf((l0[4 * rho + 3] + z0[4 * rho + 3]) + g);
          }
          {
            const float x3 = l1[4 * rho + 3], x23 = x3 + l1[4 * rho + 2], x123 = x23 + l1[4 * rho + 1];
            const float g = ag[4 + rho];
            z1[4 * rho + 0] = __expf((l1[4 * rho + 0] + z1[4 * rho + 0]) + (g + x123));
            z1[4 * rho + 1] = __expf((l1[4 * rho + 1] + z1[4 * rho + 1]) + (g + x23));
            z1[4 * rho + 2] = __expf((l1[4 * rho + 2] + z1[4 * rho + 2]) + (g + x3));
            z1[4 * rho + 3] = __expf((l1[4 * rho + 3] + z1[4 * rho + 3]) + g);
          }
        }
        kv_load(kv, kb + (size_t)jn * 64 * 128, 128, vb + jn * 64, SEQ);
        pv_tile(o, lv, z0, z1);
      }
    }
    int t2 = t;
    asm volatile("" : "+v"(t2));
    bf16_t* orow = p.omix + (size_t)(b * SEQ + t2) * DM + 1024 + hd * 128;
    oacc_foreach(o, [&](int d, float v0, float v1, float v2, float v3) {
      uint2 u;
      u.x = pack2(v0, v1);
      u.y = pack2(v2, v3);
      *(uint2*)(orow + d) = u;
    });
  }
}

#define NSA_IMP 32768
#define NSA_KEYS 49152
#define NSA_SELM 53504
#define NSA_LUT 53632
__device__ __forceinline__ void ph_nsa2(const P& p, char* lds) {
  typedef __attribute__((ext_vector_type(4))) float f32x4;
  char* lk = lds;
  char* lv = lds + 16384;
  float* imp = (float*)(lds + NSA_IMP);
  float* keys = (float*)(lds + NSA_KEYS);
  unsigned* selm = (unsigned*)(lds + NSA_SELM);
  const int tid = opq(threadIdx.x), lane = tid & 63, wv = tid >> 6, hh = lane >> 5, ql = lane & 31;
  float* lut = (float*)(lds + NSA_LUT) + wv * 128;
  for (int item = blockIdx.x; item < NBATCH * 2 * (SEQ / 32); item += gridDim.x) {
    const int tt = (SEQ / 32 - 1) - (item % (SEQ / 32));
    const int bg = item / (SEQ / 32);
    const int b = bg >> 1, g = bg & 1;
    const int h = g * 4 + wv;
    const int t0 = tt * 32, tq = t0 + ql, cur = t0 >> 6;
    __syncthreads();
    QFrag q;
    q_load(q, p.qn + (size_t)(b * SEQ + tq) * 1024 + h * 128);
    {
      const int lo = opq(lane);
      lut[lo] = p.t5[t5_bucket(lo) * 8 + h];
      lut[lo + 64] = p.t5[t5_bucket(lo + 64) * 8 + h];
    }
#pragma unroll
    for (int i = 0; i < 16; ++i) imp[i * 256 + tid] = 0.f;
    if (tid < 32) selm[tid] = 0u;
    const float* grow = p.gates + (size_t)(b * SEQ + tq) * 24 + h * 3;
    float* prow = p.part + (size_t)(b * SEQ + tq) * 1024 + h * 128;
    OAcc o;
    float m, l;
    KVRegs kv;
    {
      const bf16_t* kb = p.kcb + (size_t)bg * 128 * 128;
      const bf16_t* vb = p.vcT + (size_t)bg * 128 * 128;
      oacc_zero(o);
      m = NEG_BIG; l = 0.f;
      kv_load(kv, kb, 128, vb, 128);
      __syncthreads();
      kv_store(kv, lk, lv);
      __syncthreads();
      f32x16 x0, x1;
      qk_tile(q, lk, x0, x1);
      int tqv = tq;
      asm volatile("" : "+v"(tqv));
      tqv -= 64 * hh;
#pragma unroll
      for (int r = 0; r < 16; ++r) {
        const int c = 8 * (r >> 2) + (r & 3);
        const int d0 = tqv - 16 * c - 31, d1 = d0 - 512;
        x0[r] = (d0 >= 0) ? x0[r] * ATT_SCALE + lut[min(d0, 127)] : NEG_BIG;
        x1[r] = (d1 >= 0) ? x1[r] * ATT_SCALE + lut[min(d1, 127)] : NEG_BIG;
      }
      softmax_tile(x0, x1, m, l, o);
      const float m0 = m;
      pv_tile(o, lv, x0, x1);
      kv_load(kv, kb + 64 * 128, 128, vb + 64, 128);
      __syncthreads();
      kv_store(kv, lk, lv);
      __syncthreads();
      f32x16 z0, z1;
      qk_tile(q, lk, z0, z1);
      asm volatile("" : "+v"(tqv));
#pragma unroll
      for (int r = 0; r < 16; ++r) {
        const int c = 64 + 8 * (r >> 2) + (r & 3);
        const int d0 = tqv - 16 * c - 31, d1 = d0 - 512;
        z0[r] = (d0 >= 0) ? z0[r] * ATT_SCALE + lut[min(d0, 127)] : NEG_BIG;
        z1[r] = (d1 >= 0) ? z1[r] * ATT_SCALE + lut[min(d1, 127)] : NEG_BIG;
      }
      softmax_tile(z0, z1, m, l, o);
      pv_tile(o, lv, z0, z1);
      const float inv = 1.f / fmaxf(l, 1e-20f);
      const float c0 = __expf(m0 - m) * inv;
#pragma unroll
      for (int r = 0; r < 16; ++r) {
        const int c = 8 * (r >> 2) + (r & 3) + 4 * hh;
        if (x0[r] != 0.f) atomicAdd(&imp[(c) * 32 + ql], x0[r] * c0);
        if (x1[r] != 0.f) atomicAdd(&imp[(c + 32) * 32 + ql], x1[r] * c0);
        if (z0[r] != 0.f) atomicAdd(&imp[(c + 64) * 32 + ql], z0[r] * inv);
        if (z1[r] != 0.f) atomicAdd(&imp[(c + 96) * 32 + ql], z1[r] * inv);
      }
      const float gs = inv / (1.f + __expf(-grow[0]));
      oacc_foreach(o, [&](int d, float v0, float v1, float v2, float v3) {
        f32x4 u = {v0 * gs, v1 * gs, v2 * gs, v3 * gs};
        *(f32x4*)(prow + d) = u;
      });
    }
    __syncthreads();
    {
      const int tido = opq(tid);
      const int qq = tido & 31, jg = tido >> 5;
#pragma unroll
      for (int jj = 0; jj < 4; ++jj) {
        const int j = jg * 4 + jj;
        float v = imp[(4 * j) * 32 + qq] + imp[(4 * j + 1) * 32 + qq] + imp[(4 * j + 2) * 32 + qq] + 0.5f * imp[(4 * j + 3) * 32 + qq];
        if (j > 0) v += 0.5f * imp[(4 * j - 1) * 32 + qq];
        const bool forced = (j == 0) || (j == cur) || (j == cur - 1);
        keys[qq * 33 + j] = forced ? 1e9f : ((j <= cur) ? v : -1e9f);
      }
      __syncthreads();
      unsigned bits = 0u;
#pragma unroll
      for (int jj = 0; jj < 4; ++jj) {
        const int j = jg * 4 + jj;
        const float kj = keys[qq * 33 + j];
        int rank = 0;
        for (int i = 0; i < 32; ++i) {
          const float ki = keys[qq * 33 + i];
          rank += (ki > kj || (ki == kj && i < j)) ? 1 : 0;
        }
        if (rank < 16 && j <= cur) bits |= 1u << j;
      }
      atomicOr(&selm[qq], bits);
      __syncthreads();
    }
    const unsigned mysel = selm[ql];
    unsigned um = mysel;
#pragma unroll
    for (int o2 = 16; o2 > 0; o2 >>= 1) um |= (unsigned)__shfl_xor((int)um, o2);
    um = (unsigned)__builtin_amdgcn_readfirstlane((int)um);
    {
      const bf16_t* kb = p.ks + (size_t)bg * SEQ * 128;
      const bf16_t* vb = p.vsT + (size_t)bg * 128 * SEQ;
      oacc_zero(o);
      m = NEG_BIG; l = 0.f;
      unsigned rem = um;
      int j = __builtin_ctz(rem);
      kv_load(kv, kb + (size_t)j * 64 * 128, 128, vb + j * 64, SEQ);
      while (rem) {
        j = __builtin_ctz(rem);
        rem &= rem - 1;
        const int jn = rem ? __builtin_ctz(rem) : j;
        __syncthreads();
        kv_store(kv, lk, lv);
        __syncthreads();
        f32x16 s0, s1;
        qk_tile(q, lk, s0, s1);
        const bool selq = (mysel >> j) & 1u;
        int tqv = tq;
        asm volatile("" : "+v"(tqv));
#pragma unroll
        for (int r = 0; r < 16; ++r) {
          const int d0 = tqv - (j * 64 + 8 * (r >> 2) + (r & 3) + 4 * hh), d1 = d0 - 32;
          s0[r] = (selq && d0 >= 0) ? s0[r] * ATT_SCALE + lut[min(d0, 127)] : NEG_BIG;
          s1[r] = (selq && d1 >= 0) ? s1[r] * ATT_SCALE + lut[min(d1, 127)] : NEG_BIG;
        }
        kv_load(kv, kb + (size_t)jn * 64 * 128, 128, vb + jn * 64, SEQ);
        softmax_tile(s0, s1, m, l, o);
        pv_tile(o, lv, s0, s1);
      }
      const float gs = 1.f / (fmaxf(l, 1e-20f) * (1.f + __expf(-grow[1])));
      int qo = ql;
      asm volatile("" : "+v"(qo));
      float* pr2 = p.part + (size_t)(b * SEQ + t0 + qo) * 1024 + h * 128;
      oacc_foreach(o, [&](int d, float v0, float v1, float v2, float v3) {
        f32x4 u = *(f32x4*)(pr2 + d);
        u[0] += v0 * gs; u[1] += v1 * gs; u[2] += v2 * gs; u[3] += v3 * gs;
        *(f32x4*)(pr2 + d) = u;
      });
    }
    {
      const bf16_t* kb = p.kw + (size_t)bg * SEQ * 128;
      const bf16_t* vb = p.vwT + (size_t)bg * 128 * SEQ;
      oacc_zero(o);
      m = NEG_BIG; l = 0.f;
      int jlo = (t0 - 511) >> 6;
      if (jlo < 0) jlo = 0;
      kv_load(kv, kb + (size_t)jlo * 64 * 128, 128, vb + jlo * 64, SEQ);
      for (int j = jlo; j <= cur; ++j) {
        const int jn = (j < cur) ? j + 1 : j;
        __syncthreads();
        kv_store(kv, lk, lv);
        __syncthreads();
        f32x16 s0, s1;
        qk_tile(q, lk, s0, s1);
        int tqv = tq;
        asm volatile("" : "+v"(tqv));
#pragma unroll
        for (int r = 0; r < 16; ++r) {
          const int d0 = tqv - (j * 64 + 8 * (r >> 2) + (r & 3) + 4 * hh), d1 = d0 - 32;
          s0[r] = (d0 >= 0 && d0 < 512) ? s0[r] * ATT_SCALE + lut[min(d0, 127)] : NEG_BIG;
          s1[r] = (d1 >= 0 && d1 < 512) ? s1[r] * ATT_SCALE + lut[min(d1, 127)] : NEG_BIG;
        }
        kv_load(kv, kb + (size_t)jn * 64 * 128, 128, vb + jn * 64, SEQ);
        softmax_tile(s0, s1, m, l, o);
        pv_tile(o, lv, s0, s1);
      }
      const float gs = 1.f / (fmaxf(l, 1e-20f) * (1.f + __expf(-grow[2])));
      int qo = ql;
      asm volatile("" : "+v"(qo));
      const float* pr2 = p.part + (size_t)(b * SEQ + t0 + qo) * 1024 + h * 128;
      bf16_t* orow = p.omix + (size_t)(b * SEQ + t0 + qo) * DM + h * 128;
      oacc_foreach(o, [&](int d, float v0, float v1, float v2, float v3) {
        const f32x4 u = *(const f32x4*)(pr2 + d);
        uint2 w;
        w.x = pack2(u[0] + v0 * gs, u[1] + v1 * gs);
        w.y = pack2(u[2] + v2 * gs, u[3] + v3 * gs);
        *(uint2*)(orow + d) = w;
      });
    }
  }
}

__device__ __forceinline__ void ph_cvt(const float* src, bf16_t* dst, size_t n) {
  typedef __attribute__((ext_vector_type(4))) float f32x4;
  const size_t nv = n / 8;
  for (size_t i = (size_t)blockIdx.x * 256 + opq(threadIdx.x); i < nv; i += (size_t)gridDim.x * 256) {
    const f32x4 a = ((const f32x4*)src)[2 * i], b = ((const f32x4*)src)[2 * i + 1];
    u32x4 o;
    o[0] = pack2(a[0], a[1]); o[1] = pack2(a[2], a[3]); o[2] = pack2(b[0], b[1]); o[3] = pack2(b[2], b[3]);
    ((u32x4*)dst)[i] = o;
  }
}

__device__ __forceinline__ void ph_scores(const P& p, char* lds) {
  for (int u = blockIdx.x; u < 64 * 16; u += gridDim.x) {
    const int tm = u & 63, hp = u >> 6;
    const int m0 = tm * 128;
    float* sc = p.scores + (size_t)m0 * DM + hp * 128;
    gemm_tile_bf16<false>(p.omix + (size_t)m0 * DM + hp * 128, DM, p.subkb + (size_t)hp * 128 * 128, 128, 128, lds,
                          [&](int r, int c, float val) { sc[(size_t)r * DM + c] = val; });
  }
}

struct ERows { u32x4 u0, u1, u2, u3, v0, v1, v2, v3; };
__device__ __forceinline__ void erows_load(ERows& r, const bf16_t* pu, const bf16_t* pv, int eid, int lane) {
  const u32x4* ur = (const u32x4*)(pu + (size_t)eid * DM) + lane;
  const u32x4* vr = (const u32x4*)(pv + (size_t)eid * DM) + lane;
  r.u0 = ur[0]; r.u1 = ur[64]; r.u2 = ur[128]; r.u3 = ur[192];
  r.v0 = vr[0]; r.v1 = vr[64]; r.v2 = vr[128]; r.v3 = vr[192];
}
__device__ __forceinline__ float dot2bf(unsigned a, unsigned b, float c) {
  return __builtin_amdgcn_fdot2_f32_bf16(__builtin_bit_cast(bf16v2, a), __builtin_bit_cast(bf16v2, b), c, false);
}
struct XPk { u32x4 x0, x1, x2, x3; };
struct Acc32 { f32x16 a, b; };

__device__ __forceinline__ void peer_pair(const ERows& ea, const ERows& eb, const XPk& x, float ga, float gb, Acc32& acc) {
  float pa = 0.f, pb = 0.f;
#pragma unroll
  for (int w = 0; w < 4; ++w) {
    pa = dot2bf(ea.u0[w], x.x0[w], pa); pa = dot2bf(ea.u1[w], x.x1[w], pa);
    pa = dot2bf(ea.u2[w], x.x2[w], pa); pa = dot2bf(ea.u3[w], x.x3[w], pa);
    pb = dot2bf(eb.u0[w], x.x0[w], pb); pb = dot2bf(eb.u1[w], x.x1[w], pb);
    pb = dot2bf(eb.u2[w], x.x2[w], pb); pb = dot2bf(eb.u3[w], x.x3[w], pb);
  }
#pragma unroll
  for (int o = 32; o > 0; o >>= 1) { pa += __shfl_xor(pa, o); pb += __shfl_xor(pb, o); }
  const unsigned hpk = pack2(ga * gelu_fast(pa), gb * gelu_fast(pb));
#define PEER_V(va, vb, accv, base)                                              \
  _Pragma("unroll") for (int w = 0; w < 4; ++w) {                               \
    const unsigned A = va[w], B = vb[w];                                        \
    const unsigned lo = (A & 0xffffu) | (B << 16);                              \
    const unsigned hi = (A >> 16) | (B & 0xffff0000u);                          \
    accv[base + 2 * w] = dot2bf(lo, hpk, accv[base + 2 * w]);                   \
    accv[base + 2 * w + 1] = dot2bf(hi, hpk, accv[base + 2 * w + 1]);           \
  }
  PEER_V(ea.v0, eb.v0, acc.a, 0) PEER_V(ea.v1, eb.v1, acc.a, 8) PEER_V(ea.v2, eb.v2, acc.b, 0) PEER_V(ea.v3, eb.v3, acc.b, 8)
#undef PEER_V
}

__device__ __forceinline__ void ph_peer(const P& p, float* smem) {
  typedef __attribute__((ext_vector_type(4))) float f32x4;
  int lane = opq(threadIdx.x) & 63, wv = opq(threadIdx.x) >> 6;
  float* ts = smem + wv * 256;
  int* ti = (int*)(smem + 1024) + wv * 256;
  float* bgt = smem + 2048 + wv * 128;
  int* bex = (int*)(smem + 2560) + wv * 128;
  for (int item = blockIdx.x; item < T_TOK / 4; item += gridDim.x) {
    int t = item * 4 + wv;
    const float* scrow = p.scores + (size_t)t * DM;
    for (int hp = 0; hp < 16; ++hp) {
      float sc0 = scrow[hp * 128 + lane], sc1 = scrow[hp * 128 + 64 + lane];
      for (int n = 0; n < 16; ++n) {
        float v;
        int i;
        if (sc0 >= sc1) { v = sc0; i = lane; } else { v = sc1; i = lane + 64; }
        wave_argmax(v, i);
        if (lane == 0) { ts[hp * 16 + n] = v; ti[hp * 16 + n] = i; }
        if (i == lane) sc0 = -INFINITY;
        if (i == lane + 64) sc1 = -INFINITY;
      }
    }
    __builtin_amdgcn_wave_barrier();
    for (int h = 0; h < 8; ++h) {
      float cv0, cv1, cv2, cv3;
      cv0 = ts[(2 * h) * 16 + ((lane) >> 4)] + ts[(2 * h + 1) * 16 + (lane & 15)];
      cv1 = ts[(2 * h) * 16 + ((64 + lane) >> 4)] + ts[(2 * h + 1) * 16 + (lane & 15)];
      cv2 = ts[(2 * h) * 16 + ((128 + lane) >> 4)] + ts[(2 * h + 1) * 16 + (lane & 15)];
      cv3 = ts[(2 * h) * 16 + ((192 + lane) >> 4)] + ts[(2 * h + 1) * 16 + (lane & 15)];
      float mybest = 0.f;
      int myc = 0;
      for (int n = 0; n < 16; ++n) {
        float v = cv0;
        int i = lane;
        if (cv1 > v) { v = cv1; i = 64 + lane; }
        if (cv2 > v) { v = cv2; i = 128 + lane; }
        if (cv3 > v) { v = cv3; i = 192 + lane; }
        wave_argmax(v, i);
        if (lane == n) { mybest = v; myc = i; }
        if (i == lane) cv0 = -INFINITY;
        if (i == 64 + lane) cv1 = -INFINITY;
        if (i == 128 + lane) cv2 = -INFINITY;
        if (i == 192 + lane) cv3 = -INFINITY;
      }
      float sv = (lane < 16) ? mybest : -INFINITY;
      float mx = wave_max(sv);
      float e = (lane < 16) ? expf(sv - mx) : 0.f;
      float sum = wave_sum(e);
      if (lane < 16) {
        bgt[h * 16 + lane] = e / sum;
        bex[h * 16 + lane] = ti[(2 * h) * 16 + (myc >> 4)] * 128 + ti[(2 * h + 1) * 16 + (myc & 15)];
      }
    }
    __builtin_amdgcn_wave_barrier();
    XPk x;
    {
      const f32x4* s4 = (const f32x4*)(p.out + (size_t)t * DM);
      const f32x4* g4 = (const f32x4*)p.norm_ffn;
      f32x4 a0 = s4[lane * 2], a1 = s4[lane * 2 + 1], a2 = s4[128 + lane * 2], a3 = s4[128 + lane * 2 + 1];
      f32x4 a4 = s4[256 + lane * 2], a5 = s4[256 + lane * 2 + 1], a6 = s4[384 + lane * 2], a7 = s4[384 + lane * 2 + 1];
      float ss = 0.f;
#define SSQ(v) ss += v[0] * v[0] + v[1] * v[1] + v[2] * v[2] + v[3] * v[3];
      SSQ(a0) SSQ(a1) SSQ(a2) SSQ(a3) SSQ(a4) SSQ(a5) SSQ(a6) SSQ(a7)
#undef SSQ
      ss = wave_sum(ss);
      const float rs = rsqrtf(ss * (1.f / DM) + RMS_EPS);
#define XPK(dst, va, vb, gi)                                                          \
  {                                                                                   \
    const f32x4 ga = g4[gi], gb = g4[gi + 1];                                         \
    dst[0] = pack2(va[0] * rs * ga[0], va[1] * rs * ga[1]);                           \
    dst[1] = pack2(va[2] * rs * ga[2], va[3] * rs * ga[3]);                           \
    dst[2] = pack2(vb[0] * rs * gb[0], vb[1] * rs * gb[1]);                           \
    dst[3] = pack2(vb[2] * rs * gb[2], vb[3] * rs * gb[3]);                           \
  }
      XPK(x.x0, a0, a1, lane * 2) XPK(x.x1, a2, a3, 128 + lane * 2) XPK(x.x2, a4, a5, 256 + lane * 2) XPK(x.x3, a6, a7, 384 + lane * 2)
#undef XPK
    }
    Acc32 acc;
#pragma unroll
    for (int r = 0; r < 16; ++r) { acc.a[r] = 0.f; acc.b[r] = 0.f; }
    ERows ca, cb, na, nb;
    erows_load(ca, p.pub, p.pvb, bex[0], lane);
    erows_load(cb, p.pub, p.pvb, bex[1], lane);
    for (int pr = 0; pr < 64; pr += 2) {
      erows_load(na, p.pub, p.pvb, bex[2 * pr + 2], lane);
      erows_load(nb, p.pub, p.pvb, bex[2 * pr + 3], lane);
      peer_pair(ca, cb, x, bgt[2 * pr], bgt[2 * pr + 1], acc);
      const int e2 = (2 * pr + 4 < 128) ? 2 * pr + 4 : 126;
      erows_load(ca, p.pub, p.pvb, bex[e2], lane);
      erows_load(cb, p.pub, p.pvb, bex[e2 + 1], lane);
      peer_pair(na, nb, x, bgt[2 * pr + 2], bgt[2 * pr + 3], acc);
    }
    int lane2 = lane;
    asm volatile("" : "+v"(lane2));
    f32x4* o4 = (f32x4*)(p.out + (size_t)t * DM);
    const f32x4* g4 = (const f32x4*)p.norm_final;
    f32x4 hv[8];
    float ss = 0.f;
#pragma unroll
    for (int i = 0; i < 4; ++i) {
      hv[2 * i] = o4[i * 128 + lane2 * 2];
      hv[2 * i + 1] = o4[i * 128 + lane2 * 2 + 1];
#pragma unroll
      for (int c = 0; c < 4; ++c) {
        hv[2 * i][c] += (i < 2) ? acc.a[(i & 1) * 8 + c] : acc.b[(i & 1) * 8 + c];
        hv[2 * i + 1][c] += (i < 2) ? acc.a[(i & 1) * 8 + 4 + c] : acc.b[(i & 1) * 8 + 4 + c];
        ss += hv[2 * i][c] * hv[2 * i][c] + hv[2 * i + 1][c] * hv[2 * i + 1][c];
      }
    }
    ss = wave_sum(ss);
    const float rs = rsqrtf(ss * (1.f / DM) + RMS_EPS);
#pragma unroll
    for (int i = 0; i < 4; ++i) {
      const f32x4 ga = g4[i * 128 + lane2 * 2], gb = g4[i * 128 + lane2 * 2 + 1];
      f32x4 oa, ob;
#pragma unroll
      for (int c = 0; c < 4; ++c) { oa[c] = hv[2 * i][c] * rs * ga[c]; ob[c] = hv[2 * i + 1][c] * rs * gb[c]; }
      o4[i * 128 + lane2 * 2] = oa;
      o4[i * 128 + lane2 * 2 + 1] = ob;
    }
    __builtin_amdgcn_wave_barrier();
  }
}

#define XB_TMO      128
#define XB_XCNT(j)  (256  + 64 * (j))
#define XB_XSUB(j)  (1280 + 64 * (j))
#define XB_XGEN(j)  (2304 + 64 * (j))
#define XB_TOP      3328
#define XB_TOPGEN   3392
#define XCD_BAR_WORDS 3456
#define XB_SPIN_CAP (1u << 22)
#define LAS __attribute__((address_space(3)))
__device__ __forceinline__ unsigned xb_ld(unsigned* p) { return __hip_atomic_load(p, __ATOMIC_RELAXED, __HIP_MEMORY_SCOPE_AGENT); }
__device__ __forceinline__ unsigned xb_add(unsigned* p, unsigned v) { return __hip_atomic_fetch_add(p, v, __ATOMIC_RELAXED, __HIP_MEMORY_SCOPE_AGENT); }
__device__ __forceinline__ unsigned xb_xcc_id() { return (unsigned)__builtin_amdgcn_s_getreg((3 << 11) | 20) & 0xFu; }
#define XB_SPIN(cond, bar) do { unsigned _sp = 0; while (cond) { __builtin_amdgcn_s_sleep(1); \
    if ((++_sp & 255u) == 0u) { if (xb_ld(&(bar)[XB_TMO])) break; if (_sp > XB_SPIN_CAP) { atomicAdd(&(bar)[XB_TMO], 1u); break; } } } } while (0)
struct XcdBarrier { unsigned* bar; unsigned x; volatile LAS unsigned* st; };
__device__ __forceinline__ XcdBarrier xcd_barrier_post(unsigned* bar, volatile LAS unsigned* st) {
  XcdBarrier b; b.bar = bar; b.x = xb_xcc_id(); b.st = st;
  if (threadIdx.x == 0) (void)xb_add(&bar[XB_XCNT(b.x)], 1u);
  return b;
}
__device__ __forceinline__ void xcd_barrier_complete(unsigned* bar, unsigned x, unsigned& nloc, unsigned& nx) {
  const unsigned G = gridDim.x * gridDim.y * gridDim.z;
  unsigned sum, cnt, mine, sp = 0u;
  for (;;) {
    sum = 0u; cnt = 0u; mine = 0u;
#pragma unroll
    for (unsigned j = 0; j < 16; ++j) { const unsigned c = xb_ld(&bar[XB_XCNT(j)]); sum += c; cnt += (c > 0u) ? 1u : 0u; mine = (j == x) ? c : mine; }
    if (sum == G) break;
    __builtin_amdgcn_s_sleep(1);
    if ((++sp & 255u) == 0u) { if (xb_ld(&bar[XB_TMO])) break; if (sp > XB_SPIN_CAP) { atomicAdd(&bar[XB_TMO], 1u); break; } }
  }
  nloc = mine > 0u ? mine : 1u; nx = cnt > 0u ? cnt : 1u;
}
__device__ __forceinline__ void xcd_barrier(const XcdBarrier& b) {
  asm volatile("s_waitcnt vmcnt(0)" ::: "memory");
  __syncthreads();
  if (threadIdx.x == 0) {
    unsigned* bar = b.bar;
    __builtin_amdgcn_s_waitcnt(0);
    unsigned nloc = b.st[0], nx = b.st[1];
    if (nloc == 0u) { xcd_barrier_complete(bar, b.x, nloc, nx); b.st[0] = nloc; b.st[1] = nx; }
    const unsigned old = xb_add(&bar[XB_XSUB(b.x)], 1u);
    const unsigned gen = old / nloc;
    if (old + 1u == (gen + 1u) * nloc) {
      __builtin_amdgcn_fence(__ATOMIC_RELEASE, "agent");
      asm volatile("s_waitcnt vmcnt(0)" ::: "memory");
      const unsigned og = xb_add(&bar[XB_TOP], 1u);
      const unsigned tg = og / nx;
      if (og + 1u == (tg + 1u) * nx) xb_add(&bar[XB_TOPGEN], 1u);
      else XB_SPIN(xb_ld(&bar[XB_TOPGEN]) == tg, bar);
      __builtin_amdgcn_fence(__ATOMIC_ACQUIRE, "agent");
      xb_add(&bar[XB_XGEN(b.x)], 1u);
      asm volatile("s_waitcnt vmcnt(0)" ::: "memory");
    } else {
      XB_SPIN(xb_ld(&bar[XB_XGEN(b.x)]) == gen, bar);
      __builtin_amdgcn_fence(__ATOMIC_ACQUIRE, "agent");
      asm volatile("s_waitcnt vmcnt(0)" ::: "memory");
    }
  }
  __syncthreads();
}

typedef const __attribute__((address_space(4))) P* KP;
__device__ __forceinline__ P loadP() {
#if defined(__HIP_DEVICE_COMPILE__)
  KP k = (KP)__builtin_amdgcn_kernarg_segment_ptr();
  asm volatile("" : "+s"(k));
  P p = *k;
  return p;
#else
  return P{};
#endif
}

__global__ void __launch_bounds__(256, 2) mega(P p_arg) {
  cg::grid_group grid = cg::this_grid();
  __shared__ __attribute__((aligned(16))) float smem[14336];
  char* lds = (char*)smem;
  __shared__ uint4 xb_words;
  if (threadIdx.x == 0) xb_words = make_uint4(0u, 0u, 0u, 0u);
  if (blockIdx.x == 0) {
    P p = loadP();
    for (int i = threadIdx.x; i < XCD_BAR_WORDS; i += 256) p.bar[i] = 0u;
  }
  { P p = loadP(); ph_rmsnorm(p.x, p.norm_mix, p.hn, T_TOK); ph_rmsnorm(p.mem, p.norm_mkv, p.memn, 1024); }
  { P p = loadP(); ph_transpose<true>(smem, p.w_in, DM, INC, 5760, p.WinT); }
  { P p = loadP(); ph_transpose<false>(smem, p.w_out, DM, DM, DM, p.WoutT); }
  { P p = loadP(); ph_transpose<false>(smem, p.w_pq, DM, DM, DM, p.WpqT); }
  { P p = loadP(); ph_transpose<false>(smem, p.w_mq, DM, 512, 512, p.WmqT); }
  { P p = loadP(); ph_transpose<false>(smem, p.w_mk, DM, 512, 512, p.WmkT); }
  { P p = loadP(); ph_transpose<false>(smem, p.w_mv, DM, 512, 512, p.WmvT); }
  { P p = loadP(); ph_transpose<false>(smem, p.w_mo, 512, DM, DM, p.WmoT); }
  { P p = loadP(); ph_cvt(p.pu, p.pub, (size_t)16384 * DM); }
  { P p = loadP(); ph_cvt(p.pv, p.pvb, (size_t)16384 * DM); }
  { P p = loadP(); ph_cvt(p.subk, p.subkb, (size_t)16 * 128 * 128); }
  { P p = loadP(); ph_transpose<false>(smem, p.w1_k, 4096, 128, 128, p.w1T); }
  { P p = loadP(); ph_transpose<false>(smem, p.w1_v, 4096, 128, 128, p.w1T + 128 * 4096); }
  { P p = loadP(); ph_transpose<false>(smem, p.w2_k, 128, 128, 128, p.w2T); }
  { P p = loadP(); ph_transpose<false>(smem, p.w2_v, 128, 128, 128, p.w2T + 128 * 128); }
  { P p = loadP(); ph_posb(p); }
  grid.sync();
  XcdBarrier xb;
  { P p = loadP(); xb = xcd_barrier_post(p.bar, (volatile LAS unsigned*)&xb_words); }
  { P p = loadP(); ph_proj(p, lds); }
  { P p = loadP(); bf16_t* kmem = p.kmemb;
    ph_gemm_bf16(p.memn, DM, p.WmkT, DM, 1024, 512, DM, lds, [=](int m, int n, float v) {
      kmem[((size_t)((m >> 8) * 4 + (n >> 7)) * 256 + (m & 255)) * 128 + (n & 127)] = f2bf(v); }); }
  { P p = loadP(); bf16_t* vmem = p.vmemT;
    ph_gemm_bf16(p.memn, DM, p.WmvT, DM, 1024, 512, DM, lds, [=](int m, int n, float v) {
      vmem[((size_t)((m >> 8) * 4 + (n >> 7)) * 128 + (n & 127)) * 256 + perm16(m & 255)] = f2bf(v); }); }
  xcd_barrier(xb);
  { P p = loadP(); ph_compress2(p, lds); }
  { P p = loadP(); ph_sb2(p, lds); }
  xcd_barrier(xb);
  { P p = loadP(); ph_nsa2(p, lds); }
  xcd_barrier(xb);
  { P p = loadP(); float* out = p.out; const float* x = p.x;
    ph_gemm_bf16(p.omix, DM, p.WoutT, DM, T_TOK, DM, DM, lds, [=](int m, int n, float v) { out[(size_t)m * DM + n] = x[(size_t)m * DM + n] + v; }); }
  xcd_barrier(xb);
  { P p = loadP(); ph_rmsnorm(p.out, p.norm_mq, p.hn, T_TOK); }
  xcd_barrier(xb);
  { P p = loadP(); bf16_t* qmem = p.qmemb;
    ph_gemm_bf16(p.hn, DM, p.WmqT, DM, T_TOK, 512, DM, lds, [=](int m, int n, float v) { qmem[(size_t)m * 512 + n] = f2bf(v); }); }
  xcd_barrier(xb);
  { P p = loadP(); ph_memattn2(p, lds); }
  xcd_barrier(xb);
  { P p = loadP(); float* out = p.out;
    ph_gemm_bf16(p.omem, 512, p.WmoT, 512, T_TOK, DM, 512, lds, [=](int m, int n, float v) { out[(size_t)m * DM + n] += v; }); }
  xcd_barrier(xb);
  { P p = loadP(); ph_rmsnorm(p.out, p.norm_ffn, p.hn, T_TOK); }
  xcd_barrier(xb);
  { P p = loadP(); bf16_t* qp = p.omix;
    ph_gemm_bf16(p.hn, DM, p.WpqT, DM, T_TOK, DM, DM, lds, [=](int m, int n, float v) { qp[(size_t)m * DM + n] = f2bf(v); }); }
  xcd_barrier(xb);
  { P p = loadP(); ph_scores(p, lds); }
  xcd_barrier(xb);
  { P p = loadP(); ph_peer(p, smem); }
}

extern "C" void kernel_launch(void* const* d_in, const int* in_sizes, int n_in, void* d_out, int out_size, void* d_ws,
                              size_t ws_size, hipStream_t stream) {
  P p{};
  p.x = (const float*)d_in[0]; p.mem = (const float*)d_in[1]; p.t5 = (const float*)d_in[2];
  p.norm_mix = (const float*)d_in[3]; p.w_in = (const float*)d_in[4]; p.pos_k = (const float*)d_in[5];
  p.w1_k = (const float*)d_in[6]; p.w2_k = (const float*)d_in[7]; p.pos_v = (const float*)d_in[8];
  p.w1_v = (const float*)d_in[9]; p.w2_v = (const float*)d_in[10]; p.w_out = (const float*)d_in[11];
  p.norm_mq = (const float*)d_in[12]; p.norm_mkv = (const float*)d_in[13]; p.w_mq = (const float*)d_in[14];
  p.w_mk = (const float*)d_in[15]; p.w_mv = (const float*)d_in[16]; p.w_mo = (const float*)d_in[17];
  p.norm_ffn = (const float*)d_in[18]; p.w_pq = (const float*)d_in[19]; p.subk = (const float*)d_in[20];
  p.pu = (const float*)d_in[21]; p.pv = (const float*)d_in[22]; p.norm_final = (const float*)d_in[23];
  p.out = (float*)d_out;
  char* w = (char*)d_ws;
  size_t off = 0;
  auto take = [&](size_t bytes) { char* r = w + off; off += (bytes + 255) & ~(size_t)255; return r; };
  p.bar = (unsigned*)take(XCD_BAR_WORDS * 4);
  p.scores = (float*)take((size_t)T_TOK * DM * 4);
  p.gates = (float*)take((size_t)T_TOK * 24 * 4);
  p.part = (float*)take((size_t)T_TOK * 1024 * 4);
  p.posb = (float*)take(256 * 4);
  p.qn = (bf16_t*)take((size_t)T_TOK * 1024 * 2);
  p.kcin = (bf16_t*)take((size_t)T_TOK * 256 * 2 + 65536);
  p.vcin = (bf16_t*)take((size_t)T_TOK * 256 * 2 + 65536);
  p.ks = (bf16_t*)take((size_t)T_TOK * 256 * 2);
  p.vsT = (bf16_t*)take((size_t)T_TOK * 256 * 2);
  p.kw = (bf16_t*)take((size_t)T_TOK * 256 * 2);
  p.vwT = (bf16_t*)take((size_t)T_TOK * 256 * 2);
  p.kcb = (bf16_t*)take((size_t)8 * 128 * 128 * 2);
  p.vcT = (bf16_t*)take((size_t)8 * 128 * 128 * 2);
  p.c1 = (bf16_t*)take((size_t)16 * 128 * 128 * 2);
  p.w1T = (bf16_t*)take((size_t)2 * 128 * 4096 * 2);
  p.w2T = (bf16_t*)take((size_t)2 * 128 * 128 * 2);
  p.hn = (bf16_t*)take((size_t)T_TOK * DM * 2);
  p.omix = (bf16_t*)take((size_t)T_TOK * DM * 2);
  p.memn = (bf16_t*)take((size_t)1024 * DM * 2);
  p.omem = (bf16_t*)take((size_t)T_TOK * 512 * 2);
  p.WinT = (bf16_t*)take((size_t)5760 * DM * 2);
  p.WoutT = (bf16_t*)take((size_t)DM * DM * 2);
  p.WpqT = (bf16_t*)take((size_t)DM * DM * 2);
  p.WmqT = (bf16_t*)take((size_t)512 * DM * 2);
  p.WmkT = (bf16_t*)take((size_t)512 * DM * 2);
  p.WmvT = (bf16_t*)take((size_t)512 * DM * 2);
  p.WmoT = (bf16_t*)take((size_t)DM * 512 * 2);
  p.qmemb = (bf16_t*)take((size_t)T_TOK * 512 * 2);
  p.kmemb = (bf16_t*)take((size_t)1024 * 512 * 2);
  p.vmemT = (bf16_t*)take((size_t)1024 * 512 * 2);
  p.qsb = (bf16_t*)take((size_t)T_TOK * 1024 * 2);
  p.ksb = (bf16_t*)take((size_t)T_TOK * 1024 * 2);
  p.vsbT = (bf16_t*)take((size_t)T_TOK * 1024 * 2);
  p.pub = (bf16_t*)take((size_t)16384 * DM * 2);
  p.pvb = (bf16_t*)take((size_t)16384 * DM * 2);
  p.subkb = (bf16_t*)take((size_t)16 * 128 * 128 * 2);
  static int grid_blocks = 0;
  if (!grid_blocks) {
    int dev = 0, cus = 0, per_cu = 0;
    (void)hipGetDevice(&dev);
    (void)hipDeviceGetAttribute(&cus, hipDeviceAttributeMultiprocessorCount, dev);
    (void)hipOccupancyMaxActiveBlocksPerMultiprocessor(&per_cu, mega, 256, 0);
    if (per_cu > 2) per_cu = 2;
    if (per_cu < 1) per_cu = 1;
    grid_blocks = cus * per_cu;
  }
  void* args[] = {&p};
  hipError_t e = hipLaunchCooperativeKernel((void*)mega, dim3(grid_blocks), dim3(256), args, 0, stream);
  if (e != hipSuccess) fprintf(stderr, "cooperative launch failed: %s (grid %d)\n", hipGetErrorString(e), grid_blocks);
}
```

```cpp
#include <hip/hip_runtime.h>
#include <hip/hip_cooperative_groups.h>
#include <cstdio>
namespace cg = cooperative_groups;
#include <stdint.h>

#define SEQ 2048
#define NBATCH 4
#define T_TOK 8192
#define DM 2048
#define INC 5656
#define C_QN 0
#define C_KC 1024
#define C_VC 1280
#define C_KS 1536
#define C_VS 1792
#define C_KW 2048
#define C_VW 2304
#define C_GT 2560
#define C_QSB 2584
#define C_KSB 3608
#define C_VSB 4632
#define ATT_SCALE 0.08838834764831845f
#define RMS_EPS 1e-6f

typedef unsigned short bf16_t;
typedef __attribute__((ext_vector_type(8))) short bf16x8;
typedef __attribute__((ext_vector_type(16))) float f32x16;
typedef __attribute__((ext_vector_type(2))) __bf16 bf16v2;
typedef __attribute__((ext_vector_type(4))) unsigned u32x4;

struct P {
  const float *x, *mem, *t5, *norm_mix, *w_in, *pos_k, *w1_k, *w2_k, *pos_v, *w1_v, *w2_v, *w_out,
      *norm_mq, *norm_mkv, *w_mq, *w_mk, *w_mv, *w_mo, *norm_ffn, *w_pq, *subk, *pu, *pv, *norm_final;
  float* out;
  float *scores, *gates, *part, *posb;
  unsigned* bar;
  bf16_t *hn, *omix, *memn, *omem;
  bf16_t *WinT, *WoutT, *WpqT, *WmqT, *WmkT, *WmvT, *WmoT;
  bf16_t *qmemb, *kmemb, *vmemT;
  bf16_t *qsb, *ksb, *vsbT;
  bf16_t* subkb;
  unsigned char *pu8, *pv8;
  float *su8, *sv8;
  bf16_t *qn, *kcin, *vcin, *ks, *vsT, *kw, *vwT, *kcb, *vcT, *c1, *w1T, *w2T;
};

__device__ __forceinline__ int opq(int v) { asm volatile("" : "+v"(v)); return v; }
__device__ __forceinline__ unsigned pack2(float a, float b) {
  bf16v2 r = {(__bf16)a, (__bf16)b};
  return *(unsigned*)&r;
}
__device__ __forceinline__ bf16_t f2bf(float a) {
  __bf16 r = (__bf16)a;
  return *(bf16_t*)&r;
}
__device__ __forceinline__ int perm16(int s) { return (s & ~12) | ((s & 4) << 1) | ((s & 8) >> 1); }
__device__ __forceinline__ float bf2f(bf16_t u) { return __uint_as_float((unsigned)u << 16); }

__device__ __forceinline__ float wave_max(float v) {
  for (int o = 32; o > 0; o >>= 1) v = fmaxf(v, __shfl_xor(v, o));
  return v;
}
__device__ __forceinline__ float wave_sum(float v) {
  for (int o = 32; o > 0; o >>= 1) v += __shfl_xor(v, o);
  return v;
}
__device__ __forceinline__ void wave_argmax(float& v, int& i) {
  for (int o = 32; o > 0; o >>= 1) {
    float ov = __shfl_xor(v, o);
    int oi = __shfl_xor(i, o);
    if (ov > v || (ov == v && oi < i)) { v = ov; i = oi; }
  }
}
__device__ __forceinline__ float gelu_tanh(float x) {
  return 0.5f * x * (1.f + tanhf(0.7978845608028654f * (x + 0.044715f * x * x * x)));
}
__device__ __forceinline__ float gelu_fast(float x) {
  const float y = 1.5957691216057308f * (x + 0.044715f * x * x * x);
  return x / (1.f + __expf(-y));
}
__device__ __forceinline__ int t5_bucket(int n) {
  if (n < 16) return n < 0 ? 0 : n;
  int b = 16;
  b += (n >= 19); b += (n >= 21); b += (n >= 24); b += (n >= 27); b += (n >= 31); b += (n >= 35);
  b += (n >= 40); b += (n >= 46); b += (n >= 52); b += (n >= 59); b += (n >= 67); b += (n >= 77);
  b += (n >= 87); b += (n >= 99); b += (n >= 113);
  return b;
}
__device__ __forceinline__ float log_sigmoid(float x) {
  return fminf(x, 0.f) - log1pf(expf(-fabsf(x)));
}

__device__ __forceinline__ void ph_rmsnorm(const float* src, const float* gain, bf16_t* dst, int rows) {
  int lane = opq(threadIdx.x) & 63, wv = opq(threadIdx.x) >> 6;
  for (int r = blockIdx.x * 4 + wv; r < rows; r += gridDim.x * 4) {
    const float4* s4 = (const float4*)(src + (size_t)r * DM);
    float4 v[8];
    float ss = 0.f;
#pragma unroll
    for (int i = 0; i < 8; ++i) {
      v[i] = s4[i * 64 + lane];
      ss += v[i].x * v[i].x + v[i].y * v[i].y + v[i].z * v[i].z + v[i].w * v[i].w;
    }
    ss = wave_sum(ss);
    float rs = rsqrtf(ss * (1.f / DM) + RMS_EPS);
    uint2* d2 = (uint2*)(dst + (size_t)r * DM);
    const float4* g4 = (const float4*)gain;
#pragma unroll
    for (int i = 0; i < 8; ++i) {
      float4 g = g4[i * 64 + lane];
      uint2 o;
      o.x = pack2(v[i].x * rs * g.x, v[i].y * rs * g.y);
      o.y = pack2(v[i].z * rs * g.z, v[i].w * rs * g.w);
      d2[i * 64 + lane] = o;
    }
  }
}

template <bool CMAP>
__device__ __forceinline__ void ph_transpose(float* smem, const float* W, int K, int N, int Npad, bf16_t* Wt) {
  float (*tl)[65] = (float (*)[65])smem;
  int tid = opq(threadIdx.x);
  int nk = K / 64, nn = Npad / 64;
  for (int tile = blockIdx.x; tile < nk * nn; tile += gridDim.x) {
    int k0 = (tile % nk) * 64, n0 = (tile / nk) * 64;
    int col = tid & 63, rb = tid >> 6;
#pragma unroll 4
    for (int pp = 0; pp < 16; ++pp) {
      int k = pp * 4 + rb;
      float v = 0.f;
      int sc = n0 + col;
      if (CMAP) sc = (sc < 2560) ? sc : (sc < 5632) ? sc + 24 : (sc < 5656) ? sc - 5632 + 2560 : N;
      if (sc < N) v = W[(size_t)(k0 + k) * N + sc];
      tl[k][col] = v;
    }
    __syncthreads();
    int n = tid >> 2, kc = (tid & 3) * 16;
    unsigned w[8];
#pragma unroll
    for (int i = 0; i < 8; ++i) w[i] = pack2(tl[kc + 2 * i][n], tl[kc + 2 * i + 1][n]);
    uint4* dst = (uint4*)(Wt + (size_t)(n0 + n) * K + k0 + kc);
    dst[0] = make_uint4(w[0], w[1], w[2], w[3]);
    dst[1] = make_uint4(w[4], w[5], w[6], w[7]);
    __syncthreads();
  }
}

__device__ __forceinline__ int lds_off(int row, int chunk) { return row * 128 + ((chunk ^ ((row >> 1) & 7)) << 4); }

template <bool TR, class Epi>
__device__ __forceinline__ void gemm_tile_bf16(const bf16_t* xp, int ldx, const bf16_t* yp, int ldy, int K, char* lds,
                                               Epi epi) {
  const int tid = opq(threadIdx.x), lane = tid & 63, wv = tid >> 6;
  const int wr = wv >> 1, wc = wv & 1;
  char* lx = lds;
  char* ly = lds + 16384;
  f32x16 acc[2][2];
#pragma unroll
  for (int i = 0; i < 2; ++i)
#pragma unroll
    for (int j = 0; j < 2; ++j)
#pragma unroll
      for (int r = 0; r < 16; ++r) acc[i][j][r] = 0.f;
  const int srow = tid >> 3, sch = tid & 7;
  const bf16_t* xg = xp + (size_t)srow * ldx + sch * 8;
  const bf16_t* yg = yp + (size_t)srow * ldy + sch * 8;
  const size_t x32 = (size_t)32 * ldx, y32 = (size_t)32 * ldy;
  uint4 sx0 = *(const uint4*)(xg), sx1 = *(const uint4*)(xg + x32), sx2 = *(const uint4*)(xg + 2 * x32),
        sx3 = *(const uint4*)(xg + 3 * x32);
  uint4 sy0 = *(const uint4*)(yg), sy1 = *(const uint4*)(yg + y32), sy2 = *(const uint4*)(yg + 2 * y32),
        sy3 = *(const uint4*)(yg + 3 * y32);
  const int so0 = lds_off(srow, sch), so1 = lds_off(32 + srow, sch), so2 = lds_off(64 + srow, sch),
            so3 = lds_off(96 + srow, sch);
  for (int k0 = 0; k0 < K; k0 += 64) {
    __syncthreads();
    *(uint4*)(lx + so0) = sx0; *(uint4*)(lx + so1) = sx1; *(uint4*)(lx + so2) = sx2; *(uint4*)(lx + so3) = sx3;
    *(uint4*)(ly + so0) = sy0; *(uint4*)(ly + so1) = sy1; *(uint4*)(ly + so2) = sy2; *(uint4*)(ly + so3) = sy3;
    __syncthreads();
    if (k0 + 64 < K) {
      const bf16_t* xn = xg + k0 + 64;
      const bf16_t* yn = yg + k0 + 64;
      sx0 = *(const uint4*)(xn); sx1 = *(const uint4*)(xn + x32); sx2 = *(const uint4*)(xn + 2 * x32);
      sx3 = *(const uint4*)(xn + 3 * x32);
      sy0 = *(const uint4*)(yn); sy1 = *(const uint4*)(yn + y32); sy2 = *(const uint4*)(yn + 2 * y32);
      sy3 = *(const uint4*)(yn + 3 * y32);
    }
#pragma unroll
    for (int kk = 0; kk < 4; ++kk) {
      bf16x8 a[2], b[2];
      const int ch = kk * 2 + (lane >> 5);
#pragma unroll
      for (int i = 0; i < 2; ++i) {
        a[i] = *(const bf16x8*)((TR ? ly : lx) + lds_off(wr * 64 + i * 32 + (lane & 31), ch));
        b[i] = *(const bf16x8*)((TR ? lx : ly) + lds_off(wc * 64 + i * 32 + (lane & 31), ch));
      }
#pragma unroll
      for (int i = 0; i < 2; ++i)
#pragma unroll
        for (int j = 0; j < 2; ++j) acc[i][j] = __builtin_amdgcn_mfma_f32_32x32x16_bf16(a[i], b[j], acc[i][j], 0, 0, 0);
    }
  }
  int lane2 = lane;
  asm volatile("" : "+v"(lane2));
#pragma unroll
  for (int i = 0; i < 2; ++i)
#pragma unroll
    for (int j = 0; j < 2; ++j)
#pragma unroll
      for (int r = 0; r < 16; ++r) {
        int rr = wr * 64 + i * 32 + (r & 3) + 8 * (r >> 2) + 4 * (lane2 >> 5);
        int cc = wc * 64 + j * 32 + (lane2 & 31);
        epi(rr, cc, acc[i][j][r]);
      }
}

template <class Epi>
__device__ __forceinline__ void ph_gemm_bf16(const bf16_t* A, int lda, const bf16_t* Wt, int ldw, int M, int N, int K,
                                             char* lds, Epi epi) {
  const int ntm = M / 128, ntn = N / 128;
  const int npm = (ntm + 7) / 8, npn = (ntn + 7) / 8;
  const int nslots = ((npm * npn * 64 + 511) / 512) * 512;
  for (int u = blockIdx.x; u < nslots; u += gridDim.x) {
    int v = (u & 7) * 64 + ((u >> 3) & 63) + (u & ~511);
    int patch = v >> 6, w = v & 63;
    int tm = (patch % npm) * 8 + (w & 7);
    int tn = (patch / npm) * 8 + (w >> 3);
    if (tm >= ntm || tn >= ntn) continue;
    const int m0 = tm * 128, n0 = tn * 128;
    gemm_tile_bf16<false>(A + (size_t)m0 * lda, lda, Wt + (size_t)n0 * ldw, ldw, K, lds,
                          [&](int r, int c, float val) { epi(m0 + r, n0 + c, val); });
  }
}

__device__ __forceinline__ void ph_proj(const P& p, char* lds) {
  const int ntm = T_TOK / 128, ntn = 5760 / 128;
  const int npm = (ntm + 7) / 8, npn = (ntn + 7) / 8;
  const int nslots = ((npm * npn * 64 + 511) / 512) * 512;
  for (int u = blockIdx.x; u < nslots; u += gridDim.x) {
    int v = (u & 7) * 64 + ((u >> 3) & 63) + (u & ~511);
    int patch = v >> 6, w = v & 63;
    int tm = (patch % npm) * 8 + (w & 7);
    int tn = (patch / npm) * 8 + (w >> 3);
    if (tm >= ntm || tn >= ntn) continue;
    const int m0 = tm * 128, n0 = tn * 128;
    const int b = m0 >> 11, sl = m0 & 2047;
    const bf16_t* A = p.hn + (size_t)m0 * DM;
    const bf16_t* W = p.WinT + (size_t)n0 * DM;
    if (n0 < 1024) {
      bf16_t* q = p.qn + (size_t)m0 * 1024 + n0;
      gemm_tile_bf16<false>(A, DM, W, DM, DM, lds, [&](int r, int c, float val) { q[(size_t)r * 1024 + c] = f2bf(val); });
    } else if (n0 < 2560) {
      const int seg = (n0 - 1024) >> 8, g = ((n0 - 1024) >> 7) & 1;
      if (seg == 3 || seg == 5) {
        bf16_t* vd = (seg == 3 ? p.vsT : p.vwT) + ((size_t)(b * 2 + g) * 128) * SEQ + sl;
        gemm_tile_bf16<true>(A, DM, W, DM, DM, lds, [&](int r, int c, float val) { vd[(size_t)r * SEQ + perm16(c)] = f2bf(val); });
      } else {
        bf16_t* base = (seg == 0) ? p.kcin : (seg == 1) ? p.vcin : (seg == 2) ? p.ks : p.kw;
        bf16_t* kd = base + ((size_t)(b * 2 + g) * SEQ + sl) * 128;
        gemm_tile_bf16<false>(A, DM, W, DM, DM, lds, [&](int r, int c, float val) { kd[(size_t)r * 128 + c] = f2bf(val); });
      }
    } else if (n0 < 3584) {
      bf16_t* q = p.qsb + (size_t)m0 * 1024 + (n0 - 2560);
      gemm_tile_bf16<false>(A, DM, W, DM, DM, lds, [&](int r, int c, float val) { q[(size_t)r * 1024 + c] = f2bf(val); });
    } else if (n0 < 4608) {
      bf16_t* kd = p.ksb + ((size_t)(b * 8 + ((n0 - 3584) >> 7)) * SEQ + sl) * 128;
      gemm_tile_bf16<false>(A, DM, W, DM, DM, lds, [&](int r, int c, float val) { kd[(size_t)r * 128 + c] = f2bf(val); });
    } else if (n0 < 5632) {
      bf16_t* vd = p.vsbT + ((size_t)(b * 8 + ((n0 - 4608) >> 7)) * 128) * SEQ + sl;
      gemm_tile_bf16<true>(A, DM, W, DM, DM, lds, [&](int r, int c, float val) { vd[(size_t)r * SEQ + perm16(c)] = f2bf(val); });
    } else {
      float* gd = p.gates + (size_t)m0 * 24;
      gemm_tile_bf16<false>(A, DM, W, DM, DM, lds, [&](int r, int c, float val) { if (c < 24) gd[(size_t)r * 24 + c] = val; });
    }
  }
}

__device__ __forceinline__ void ph_posb(const P& p) {
  const int lane = opq(threadIdx.x) & 63, wv = opq(threadIdx.x) >> 6;
  for (int o = blockIdx.x * 4 + wv; o < 256; o += gridDim.x * 4) {
    const int which = o >> 7, n = o & 127;
    const float* pos = which ? p.pos_v : p.pos_k;
    const float* w1 = which ? p.w1_v : p.w1_k;
    float acc = 0.f;
    for (int k = lane; k < 4096; k += 64) acc += pos[k] * w1[(size_t)k * 128 + n];
    acc = wave_sum(acc);
    if (lane == 0) p.posb[o] = acc;
  }
}

__device__ __forceinline__ void ph_compress2(const P& p, char* lds) {
  for (int item = blockIdx.x; item < 16; item += gridDim.x) {
    const int which = item >> 3, bg = item & 7;
    const bf16_t* src = (which ? p.vcin : p.kcin) + (size_t)bg * SEQ * 128;
    const bf16_t* w1t = p.w1T + (size_t)which * 128 * 4096;
    const bf16_t* w2t = p.w2T + (size_t)which * 128 * 128;
    const float* posb = p.posb + which * 128;
    bf16_t* c1 = p.c1 + (size_t)item * 128 * 128;
    gemm_tile_bf16<false>(src, 2048, w1t, 4096, 4096, lds, [&](int r, int c, float val) {
      c1[r * 128 + c] = f2bf(gelu_fast(val + posb[c])); });
    __threadfence_block();
    __syncthreads();
    if (which == 0) {
      bf16_t* kd = p.kcb + (size_t)bg * 128 * 128;
      gemm_tile_bf16<false>(c1, 128, w2t, 128, 128, lds, [&](int r, int c, float val) { kd[r * 128 + c] = f2bf(val); });
    } else {
      bf16_t* vd = p.vcT + (size_t)bg * 128 * 128;
      gemm_tile_bf16<true>(c1, 128, w2t, 128, 128, lds, [&](int r, int c, float val) { vd[r * 128 + perm16(c)] = f2bf(val); });
    }
  }
}

#define NEG_BIG (-1e30f)

struct KVRegs { u32x4 k0, k1, k2, k3, v0, v1, v2, v3; };

__device__ __forceinline__ int koff(int row, int chunk) { return row * 256 + ((chunk ^ (row & 15)) << 4); }

__device__ __forceinline__ void kv_load(KVRegs& r, const bf16_t* kp, int ldk, const bf16_t* vp, int ldv) {
  const int tid = opq(threadIdx.x);
  const bf16_t* kg = kp + (size_t)(tid >> 4) * ldk + (tid & 15) * 8;
  r.k0 = *(const u32x4*)kg;
  r.k1 = *(const u32x4*)(kg + (size_t)16 * ldk);
  r.k2 = *(const u32x4*)(kg + (size_t)32 * ldk);
  r.k3 = *(const u32x4*)(kg + (size_t)48 * ldk);
  const bf16_t* vg = vp + (size_t)(tid >> 3) * ldv + (tid & 7) * 8;
  r.v0 = *(const u32x4*)vg;
  r.v1 = *(const u32x4*)(vg + (size_t)32 * ldv);
  r.v2 = *(const u32x4*)(vg + (size_t)64 * ldv);
  r.v3 = *(const u32x4*)(vg + (size_t)96 * ldv);
}
__device__ __forceinline__ void kv_store(const KVRegs& r, char* lk, char* lv) {
  const int tid = opq(threadIdx.x);
  const int row = tid >> 4, ch = tid & 15;
  *(u32x4*)(lk + koff(row, ch)) = r.k0;
  *(u32x4*)(lk + koff(row + 16, ch)) = r.k1;
  *(u32x4*)(lk + koff(row + 32, ch)) = r.k2;
  *(u32x4*)(lk + koff(row + 48, ch)) = r.k3;
  const int vr = tid >> 3, vc = tid & 7;
  *(u32x4*)(lv + lds_off(vr, vc)) = r.v0;
  *(u32x4*)(lv + lds_off(vr + 32, vc)) = r.v1;
  *(u32x4*)(lv + lds_off(vr + 64, vc)) = r.v2;
  *(u32x4*)(lv + lds_off(vr + 96, vc)) = r.v3;
}

struct QFrag { bf16x8 f0, f1, f2, f3, f4, f5, f6, f7; };
__device__ __forceinline__ void q_load(QFrag& q, const bf16_t* qrow) {
  const int h = (opq(threadIdx.x) & 63) >> 5;
  const bf16x8* p8 = (const bf16x8*)(qrow + 8 * h);
  q.f0 = p8[0]; q.f1 = p8[2]; q.f2 = p8[4]; q.f3 = p8[6]; q.f4 = p8[8]; q.f5 = p8[10]; q.f6 = p8[12]; q.f7 = p8[14];
}

__device__ __forceinline__ void qk_tile(const QFrag& q, const char* lk, f32x16& s0, f32x16& s1) {
  const int lane = opq(threadIdx.x) & 63, row = lane & 31, h = lane >> 5;
#pragma unroll
  for (int r = 0; r < 16; ++r) { s0[r] = 0.f; s1[r] = 0.f; }
#define QK_STEP(kk, qf)                                                                  \
  {                                                                                      \
    bf16x8 a0 = *(const bf16x8*)(lk + koff(row, 2 * (kk) + h));                          \
    bf16x8 a1 = *(const bf16x8*)(lk + koff(row + 32, 2 * (kk) + h));                     \
    s0 = __builtin_amdgcn_mfma_f32_32x32x16_bf16(a0, qf, s0, 0, 0, 0);                   \
    s1 = __builtin_amdgcn_mfma_f32_32x32x16_bf16(a1, qf, s1, 0, 0, 0);                   \
  }
  QK_STEP(0, q.f0) QK_STEP(1, q.f1) QK_STEP(2, q.f2) QK_STEP(3, q.f3)
  QK_STEP(4, q.f4) QK_STEP(5, q.f5) QK_STEP(6, q.f6) QK_STEP(7, q.f7)
#undef QK_STEP
}

__device__ __forceinline__ bf16x8 pack8(const f32x16& p, const int base) {
  u32x4 u;
  u[0] = pack2(p[base + 0], p[base + 1]);
  u[1] = pack2(p[base + 2], p[base + 3]);
  u[2] = pack2(p[base + 4], p[base + 5]);
  u[3] = pack2(p[base + 6], p[base + 7]);
  return __builtin_bit_cast(bf16x8, u);
}

struct OAcc { f32x16 o0, o1, o2, o3; };
__device__ __forceinline__ void oacc_zero(OAcc& o) {
#pragma unroll
  for (int r = 0; r < 16; ++r) { o.o0[r] = 0.f; o.o1[r] = 0.f; o.o2[r] = 0.f; o.o3[r] = 0.f; }
}
__device__ __forceinline__ void oacc_scale(OAcc& o, float a) {
#pragma unroll
  for (int r = 0; r < 16; ++r) { o.o0[r] *= a; o.o1[r] *= a; o.o2[r] *= a; o.o3[r] *= a; }
}

__device__ __forceinline__ void pv_tile(OAcc& o, const char* lv, const f32x16& p0, const f32x16& p1) {
  const int lane = opq(threadIdx.x) & 63, row = lane & 31, h = lane >> 5;
  const bf16x8 pf0 = pack8(p0, 0), pf1 = pack8(p0, 8), pf2 = pack8(p1, 0), pf3 = pack8(p1, 8);
#define PV_ROW(dd, acc)                                                                                      \
  {                                                                                                          \
    acc = __builtin_amdgcn_mfma_f32_32x32x16_bf16(*(const bf16x8*)(lv + lds_off(32 * (dd) + row, 0 + h)), pf0, acc, 0, 0, 0); \
    acc = __builtin_amdgcn_mfma_f32_32x32x16_bf16(*(const bf16x8*)(lv + lds_off(32 * (dd) + row, 2 + h)), pf1, acc, 0, 0, 0); \
    acc = __builtin_amdgcn_mfma_f32_32x32x16_bf16(*(const bf16x8*)(lv + lds_off(32 * (dd) + row, 4 + h)), pf2, acc, 0, 0, 0); \
    acc = __builtin_amdgcn_mfma_f32_32x32x16_bf16(*(const bf16x8*)(lv + lds_off(32 * (dd) + row, 6 + h)), pf3, acc, 0, 0, 0); \
  }
  PV_ROW(0, o.o0) PV_ROW(1, o.o1) PV_ROW(2, o.o2) PV_ROW(3, o.o3)
#undef PV_ROW
}

__device__ __forceinline__ void softmax_tile(f32x16& s0, f32x16& s1, float& m, float& l, OAcc& o) {
  float mx = NEG_BIG;
#pragma unroll
  for (int r = 0; r < 16; ++r) mx = fmaxf(mx, fmaxf(s0[r], s1[r]));
  mx = fmaxf(mx, __shfl_xor(mx, 32));
  const float mn = fmaxf(m, mx);
  const float alpha = __expf(m - mn);
  float ls = 0.f;
#pragma unroll
  for (int r = 0; r < 16; ++r) {
    float a = (s0[r] > -1e29f) ? __expf(s0[r] - mn) : 0.f;
    float b = (s1[r] > -1e29f) ? __expf(s1[r] - mn) : 0.f;
    s0[r] = a; s1[r] = b;
    ls += a + b;
  }
  ls += __shfl_xor(ls, 32);
  l = l * alpha + ls;
  m = mn;
  oacc_scale(o, alpha);
}

template <class F>
__device__ __forceinline__ void oacc_foreach(const OAcc& o, F f) {
  const int h = (opq(threadIdx.x) & 63) >> 5;
#pragma unroll
  for (int rho = 0; rho < 4; ++rho) {
    f(0 + 8 * rho + 4 * h, o.o0[4 * rho], o.o0[4 * rho + 1], o.o0[4 * rho + 2], o.o0[4 * rho + 3]);
    f(32 + 8 * rho + 4 * h, o.o1[4 * rho], o.o1[4 * rho + 1], o.o1[4 * rho + 2], o.o1[4 * rho + 3]);
    f(64 + 8 * rho + 4 * h, o.o2[4 * rho], o.o2[4 * rho + 1], o.o2[4 * rho + 2], o.o2[4 * rho + 3]);
    f(96 + 8 * rho + 4 * h, o.o3[4 * rho], o.o3[4 * rho + 1], o.o3[4 * rho + 2], o.o3[4 * rho + 3]);
  }
}

__device__ __forceinline__ void ph_memattn2(const P& p, char* lds) {
  char* lk = lds;
  char* lv = lds + 16384;
  const int lane = opq(threadIdx.x) & 63, wv = opq(threadIdx.x) >> 6;
  for (int item = blockIdx.x; item < NBATCH * 4 * (SEQ / 128); item += gridDim.x) {
    const int tb = item % (SEQ / 128);
    const int bh = item / (SEQ / 128);
    const int b = bh >> 2, hd = bh & 3;
    const int t = tb * 128 + wv * 32 + (lane & 31);
    QFrag q;
    q_load(q, p.qmemb + (size_t)(b * SEQ + t) * 512 + hd * 128);
    const bf16_t* kb = p.kmemb + (size_t)bh * 256 * 128;
    const bf16_t* vb = p.vmemT + (size_t)bh * 128 * 256;
    OAcc o;
    oacc_zero(o);
    float m = NEG_BIG, l = 0.f;
    KVRegs kv;
    kv_load(kv, kb, 128, vb, 256);
#pragma unroll 1
    for (int ti = 0; ti < 4; ++ti) {
      __syncthreads();
      kv_store(kv, lk, lv);
      __syncthreads();
      {
        const int tn = (ti + 1 < 4) ? ti + 1 : 3;
        kv_load(kv, kb + (size_t)tn * 64 * 128, 128, vb + tn * 64, 256);
      }
      f32x16 s0, s1;
      qk_tile(q, lk, s0, s1);
#pragma unroll
      for (int r = 0; r < 16; ++r) { s0[r] *= ATT_SCALE; s1[r] *= ATT_SCALE; }
      softmax_tile(s0, s1, m, l, o);
      pv_tile(o, lv, s0, s1);
    }
    const float il = 1.f / l;
    const int t2 = tb * 128 + (opq(threadIdx.x) >> 6) * 32 + (opq(threadIdx.x) & 31);
    bf16_t* orow = p.omem + (size_t)(b * SEQ + t2) * 512 + hd * 128;
    oacc_foreach(o, [&](int d, float v0, float v1, float v2, float v3) {
      uint2 u;
      u.x = pack2(v0 * il, v1 * il);
      u.y = pack2(v2 * il, v3 * il);
      *(uint2*)(orow + d) = u;
    });
  }
}

__device__ __forceinline__ void ph_sb2(const P& p, char* lds) {
  char* lk = lds;
  char* lv = lds + 16384;
  const int lane = opq(threadIdx.x) & 63, wv = opq(threadIdx.x) >> 6, hh = lane >> 5;
  for (int item = blockIdx.x; item < NBATCH * 8 * (SEQ / 128); item += gridDim.x) {
    const int tb = (SEQ / 128 - 1) - (item % (SEQ / 128));
    const int bh = item / (SEQ / 128);
    const int b = bh >> 3, hd = bh & 7;
    const int t0 = tb * 128;
    const int t = t0 + wv * 32 + (lane & 31);
    QFrag q;
    q_load(q, p.qsb + (size_t)(b * SEQ + t) * 1024 + hd * 128);
    const bf16_t* kb = p.ksb + (size_t)bh * SEQ * 128;
    const bf16_t* vb = p.vsbT + (size_t)bh * 128 * SEQ;
    OAcc o;
    oacc_zero(o);
    float carry = 0.f;
    const int jhi = (t0 >> 6) + 1;
    const int jw = (t0 + wv * 32 + 30) >> 6;
    KVRegs kv;
    kv_load(kv, kb + (size_t)jhi * 64 * 128, 128, vb + jhi * 64, SEQ);
    for (int j = jhi; j >= 0; --j) {
      __syncthreads();
      kv_store(kv, lk, lv);
      __syncthreads();
      const int jn = (j > 0) ? j - 1 : 0;
      if (j > jw) kv_load(kv, kb + (size_t)jn * 64 * 128, 128, vb + jn * 64, SEQ);
      if (j <= jw) {
        f32x16 z0, z1;
        qk_tile(q, lk, z0, z1);
        const int sbase = j * 64 + 4 * hh;
        float gt[8];
        f32x16 l0, l1;
#pragma unroll
        for (int r = 0; r < 16; ++r) {
          const int so = sbase + 8 * (r >> 2) + (r & 3);
          {
            const float z = z0[r] * ATT_SCALE;
            const bool valid = so < t;
            const float lsp = fminf(z, 0.f) - __logf(1.f + __expf(-fabsf(z)));
            l0[r] = valid ? (lsp - z) : 0.f;
            z0[r] = valid ? z : NEG_BIG;
          }
          {
            const float z = z1[r] * ATT_SCALE;
            const bool valid = so + 32 < t;
            const float lsp = fminf(z, 0.f) - __logf(1.f + __expf(-fabsf(z)));
            l1[r] = valid ? (lsp - z) : 0.f;
            z1[r] = valid ? z : NEG_BIG;
          }
        }
#pragma unroll
        for (int rho = 0; rho < 4; ++rho) {
          gt[rho] = (l0[4 * rho] + l0[4 * rho + 1]) + (l0[4 * rho + 2] + l0[4 * rho + 3]);
          gt[4 + rho] = (l1[4 * rho] + l1[4 * rho + 1]) + (l1[4 * rho + 2] + l1[4 * rho + 3]);
        }
        float ag[8];
        float run = 0.f;
#pragma unroll
        for (int k = 7; k >= 0; --k) {
          const float pg = __shfl_xor(gt[k], 32);
          ag[k] = carry + run + (hh == 0 ? pg : 0.f);
          run += gt[k] + pg;
        }
        carry += run;
#pragma unroll
        for (int rho = 0; rho < 4; ++rho) {
          {
            const float x3 = l0[4 * rho + 3], x23 = x3 + l0[4 * rho + 2], x123 = x23 + l0[4 * rho + 1];
            const float g = ag[rho];
            z0[4 * rho + 0] = __expf((l0[4 * rho + 0] + z0[4 * rho + 0]) + (g + x123));
            z0[4 * rho + 1] = __expf((l0[4 * rho + 1] + z0[4 * rho + 1]) + (g + x23));
            z0[4 * rho + 2] = __expf((l0[4 * rho + 2] + z0[4 * rho + 2]) + (g + x3));
            z0[4 * rho + 3] = __expf((l0[4 * rho + 3] + z0[4 * rho + 3]) + g);
          }
          {
            const float x3 = l1[4 * rho + 3], x23 = x3 + l1[4 * rho + 2], x123 = x23 + l1[4 * rho + 1];
            const float g = ag[4 + rho];
            z1[4 * rho + 0] = __expf((l1[4 * rho + 0] + z1[4 * rho + 0]) + (g + x123));
            z1[4 * rho + 1] = __expf((l1[4 * rho + 1] + z1[4 * rho + 1]) + (g + x23));
            z1[4 * rho + 2] = __expf((l1[4 * rho + 2] + z1[4 * rho + 2]) + (g + x3));
            z1[4 * rho + 3] = __expf((l1[4 * rho + 3] + z1[4 * rho + 3]) + g);
          }
        }
        kv_load(kv, kb + (size_t)jn * 64 * 128, 128, vb + jn * 64, SEQ);
        pv_tile(o, lv, z0, z1);
      }
    }
    int t2 = t;
    asm volatile("" : "+v"(t2));
    bf16_t* orow = p.omix + (size_t)(b * SEQ + t2) * DM + 1024 + hd * 128;
    oacc_foreach(o, [&](int d, float v0, float v1, float v2, float v3) {
      uint2 u;
      u.x = pack2(v0, v1);
      u.y = pack2(v2, v3);
      *(uint2*)(orow + d) = u;
    });
  }
}

#define NSA_IMP 32768
#define NSA_KEYS 49152
#define NSA_SELM 53504
#define NSA_LUT 53632
__device__ __forceinline__ void ph_nsa2(const P& p, char* lds) {
  typedef __attribute__((ext_vector_type(4))) float f32x4;
  char* lk = lds;
  char* lv = lds + 16384;
  float* imp = (float*)(lds + NSA_IMP);
  float* keys = (float*)(lds + NSA_KEYS);
  unsigned* selm = (unsigned*)(lds + NSA_SELM);
  const int tid = opq(threadIdx.x), lane = tid & 63, wv = tid >> 6, hh = lane >> 5, ql = lane & 31;
  float* lut = (float*)(lds + NSA_LUT) + wv * 128;
  for (int item = blockIdx.x; item < NBATCH * 2 * (SEQ / 32); item += gridDim.x) {
    const int tt = (SEQ / 32 - 1) - (item % (SEQ / 32));
    const int bg = item / (SEQ / 32);
    const int b = bg >> 1, g = bg & 1;
    const int h = g * 4 + wv;
    const int t0 = tt * 32, tq = t0 + ql, cur = t0 >> 6;
    __syncthreads();
    QFrag q;
    q_load(q, p.qn + (size_t)(b * SEQ + tq) * 1024 + h * 128);
    {
      const int lo = opq(lane);
      lut[lo] = p.t5[t5_bucket(lo) * 8 + h];
      lut[lo + 64] = p.t5[t5_bucket(lo + 64) * 8 + h];
    }
#pragma unroll
    for (int i = 0; i < 16; ++i) imp[i * 256 + tid] = 0.f;
    if (tid < 32) selm[tid] = 0u;
    const float* grow = p.gates + (size_t)(b * SEQ + tq) * 24 + h * 3;
    float* prow = p.part + (size_t)(b * SEQ + tq) * 1024 + h * 128;
    OAcc o;
    float m, l;
    KVRegs kv;
    {
      const bf16_t* kb = p.kcb + (size_t)bg * 128 * 128;
      const bf16_t* vb = p.vcT + (size_t)bg * 128 * 128;
      oacc_zero(o);
      m = NEG_BIG; l = 0.f;
      kv_load(kv, kb, 128, vb, 128);
      __syncthreads();
      kv_store(kv, lk, lv);
      __syncthreads();
      f32x16 x0, x1;
      qk_tile(q, lk, x0, x1);
      int tqv = tq;
      asm volatile("" : "+v"(tqv));
      tqv -= 64 * hh;
#pragma unroll
      for (int r = 0; r < 16; ++r) {
        const int c = 8 * (r >> 2) + (r & 3);
        const int d0 = tqv - 16 * c - 31, d1 = d0 - 512;
        x0[r] = (d0 >= 0) ? x0[r] * ATT_SCALE + lut[min(d0, 127)] : NEG_BIG;
        x1[r] = (d1 >= 0) ? x1[r] * ATT_SCALE + lut[min(d1, 127)] : NEG_BIG;
      }
      softmax_tile(x0, x1, m, l, o);
      const float m0 = m;
      pv_tile(o, lv, x0, x1);
      kv_load(kv, kb + 64 * 128, 128, vb + 64, 128);
      __syncthreads();
      kv_store(kv, lk, lv);
      __syncthreads();
      f32x16 z0, z1;
      qk_tile(q, lk, z0, z1);
      asm volatile("" : "+v"(tqv));
#pragma unroll
      for (int r = 0; r < 16; ++r) {
        const int c = 64 + 8 * (r >> 2) + (r & 3);
        const int d0 = tqv - 16 * c - 31, d1 = d0 - 512;
        z0[r] = (d0 >= 0) ? z0[r] * ATT_SCALE + lut[min(d0, 127)] : NEG_BIG;
        z1[r] = (d1 >= 0) ? z1[r] * ATT_SCALE + lut[min(d1, 127)] : NEG_BIG;
      }
      softmax_tile(z0, z1, m, l, o);
      pv_tile(o, lv, z0, z1);
      const float inv = 1.f / fmaxf(l, 1e-20f);
      const float c0 = __expf(m0 - m) * inv;
#pragma unroll
      for (int r = 0; r < 16; ++r) {
        const int c = 8 * (r >> 2) + (r & 3) + 4 * hh;
        if (x0[r] != 0.f) atomicAdd(&imp[(c) * 32 + ql], x0[r] * c0);
        if (x1[r] != 0.f) atomicAdd(&imp[(c + 32) * 32 + ql], x1[r] * c0);
        if (z0[r] != 0.f) atomicAdd(&imp[(c + 64) * 32 + ql], z0[r] * inv);
        if (z1[r] != 0.f) atomicAdd(&imp[(c + 96) * 32 + ql], z1[r] * inv);
      }
      const float gs = inv / (1.f + __expf(-grow[0]));
      oacc_foreach(o, [&](int d, float v0, float v1, float v2, float v3) {
        f32x4 u = {v0 * gs, v1 * gs, v2 * gs, v3 * gs};
        *(f32x4*)(prow + d) = u;
      });
    }
    __syncthreads();
    {
      const int tido = opq(tid);
      const int qq = tido & 31, jg = tido >> 5;
#pragma unroll
      for (int jj = 0; jj < 4; ++jj) {
        const int j = jg * 4 + jj;
        float v = imp[(4 * j) * 32 + qq] + imp[(4 * j + 1) * 32 + qq] + imp[(4 * j + 2) * 32 + qq] + 0.5f * imp[(4 * j + 3) * 32 + qq];
        if (j > 0) v += 0.5f * imp[(4 * j - 1) * 32 + qq];
        const bool forced = (j == 0) || (j == cur) || (j == cur - 1);
        keys[qq * 33 + j] = forced ? 1e9f : ((j <= cur) ? v : -1e9f);
      }
      __syncthreads();
      unsigned bits = 0u;
#pragma unroll
      for (int jj = 0; jj < 4; ++jj) {
        const int j = jg * 4 + jj;
        const float kj = keys[qq * 33 + j];
        int rank = 0;
        for (int i = 0; i < 32; ++i) {
          const float ki = keys[qq * 33 + i];
          rank += (ki > kj || (ki == kj && i < j)) ? 1 : 0;
        }
        if (rank < 16 && j <= cur) bits |= 1u << j;
      }
      atomicOr(&selm[qq], bits);
      __syncthreads();
    }
    const unsigned mysel = selm[ql];
    unsigned um = mysel;
#pragma unroll
    for (int o2 = 16; o2 > 0; o2 >>= 1) um |= (unsigned)__shfl_xor((int)um, o2);
    um = (unsigned)__builtin_amdgcn_readfirstlane((int)um);
    {
      const bf16_t* kb = p.ks + (size_t)bg * SEQ * 128;
      const bf16_t* vb = p.vsT + (size_t)bg * 128 * SEQ;
      oacc_zero(o);
      m = NEG_BIG; l = 0.f;
      unsigned rem = um;
      int j = __builtin_ctz(rem);
      kv_load(kv, kb + (size_t)j * 64 * 128, 128, vb + j * 64, SEQ);
      while (rem) {
        j = __builtin_ctz(rem);
        rem &= rem - 1;
        const int jn = rem ? __builtin_ctz(rem) : j;
        __syncthreads();
        kv_store(kv, lk, lv);
        __syncthreads();
        f32x16 s0, s1;
        qk_tile(q, lk, s0, s1);
        const bool selq = (mysel >> j) & 1u;
        int tqv = tq;
        asm volatile("" : "+v"(tqv));
#pragma unroll
        for (int r = 0; r < 16; ++r) {
          const int d0 = tqv - (j * 64 + 8 * (r >> 2) + (r & 3) + 4 * hh), d1 = d0 - 32;
          s0[r] = (selq && d0 >= 0) ? s0[r] * ATT_SCALE + lut[min(d0, 127)] : NEG_BIG;
          s1[r] = (selq && d1 >= 0) ? s1[r] * ATT_SCALE + lut[min(d1, 127)] : NEG_BIG;
        }
        kv_load(kv, kb + (size_t)jn * 64 * 128, 128, vb + jn * 64, SEQ);
        softmax_tile(s0, s1, m, l, o);
        pv_tile(o, lv, s0, s1);
      }
      const float gs = 1.f / (fmaxf(l, 1e-20f) * (1.f + __expf(-grow[1])));
      int qo = ql;
      asm volatile("" : "+v"(qo));
      float* pr2 = p.part + (size_t)(b * SEQ + t0 + qo) * 1024 + h * 128;
      oacc_foreach(o, [&](int d, float v0, float v1, float v2, float v3) {
        f32x4 u = *(f32x4*)(pr2 + d);
        u[0] += v0 * gs; u[1] += v1 * gs; u[2] += v2 * gs; u[3] += v3 * gs;
        *(f32x4*)(pr2 + d) = u;
      });
    }
    {
      const bf16_t* kb = p.kw + (size_t)bg * SEQ * 128;
      const bf16_t* vb = p.vwT + (size_t)bg * 128 * SEQ;
      oacc_zero(o);
      m = NEG_BIG; l = 0.f;
      int jlo = (t0 - 511) >> 6;
      if (jlo < 0) jlo = 0;
      kv_load(kv, kb + (size_t)jlo * 64 * 128, 128, vb + jlo * 64, SEQ);
      for (int j = jlo; j <= cur; ++j) {
        const int jn = (j < cur) ? j + 1 : j;
        __syncthreads();
        kv_store(kv, lk, lv);
        __syncthreads();
        f32x16 s0, s1;
        qk_tile(q, lk, s0, s1);
        int tqv = tq;
        asm volatile("" : "+v"(tqv));
#pragma unroll
        for (int r = 0; r < 16; ++r) {
          const int d0 = tqv - (j * 64 + 8 * (r >> 2) + (r & 3) + 4 * hh), d1 = d0 - 32;
          s0[r] = (d0 >= 0 && d0 < 512) ? s0[r] * ATT_SCALE + lut[min(d0, 127)] : NEG_BIG;
          s1[r] = (d1 >= 0 && d1 < 512) ? s1[r] * ATT_SCALE + lut[min(d1, 127)] : NEG_BIG;
        }
        kv_load(kv, kb + (size_t)jn * 64 * 128, 128, vb + jn * 64, SEQ);
        softmax_tile(s0, s1, m, l, o);
        pv_tile(o, lv, s0, s1);
      }
      const float gs = 1.f / (fmaxf(l, 1e-20f) * (1.f + __expf(-grow[2])));
      int qo = ql;
      asm volatile("" : "+v"(qo));
      const float* pr2 = p.part + (size_t)(b * SEQ + t0 + qo) * 1024 + h * 128;
      bf16_t* orow = p.omix + (size_t)(b * SEQ + t0 + qo) * DM + h * 128;
      oacc_foreach(o, [&](int d, float v0, float v1, float v2, float v3) {
        const f32x4 u = *(const f32x4*)(pr2 + d);
        uint2 w;
        w.x = pack2(u[0] + v0 * gs, u[1] + v1 * gs);
        w.y = pack2(u[2] + v2 * gs, u[3] + v3 * gs);
        *(uint2*)(orow + d) = w;
      });
    }
  }
}

__device__ __forceinline__ void ph_cvt(const float* src, bf16_t* dst, size_t n) {
  typedef __attribute__((ext_vector_type(4))) float f32x4;
  const size_t nv = n / 8;
  for (size_t i = (size_t)blockIdx.x * 256 + opq(threadIdx.x); i < nv; i += (size_t)gridDim.x * 256) {
    const f32x4 a = ((const f32x4*)src)[2 * i], b = ((const f32x4*)src)[2 * i + 1];
    u32x4 o;
    o[0] = pack2(a[0], a[1]); o[1] = pack2(a[2], a[3]); o[2] = pack2(b[0], b[1]); o[3] = pack2(b[2], b[3]);
    ((u32x4*)dst)[i] = o;
  }
}

__device__ __forceinline__ void ph_scores(const P& p, char* lds) {
  for (int u = blockIdx.x; u < 64 * 16; u += gridDim.x) {
    const int tm = u & 63, hp = u >> 6;
    const int m0 = tm * 128;
    float* sc = p.scores + (size_t)m0 * DM + hp * 128;
    gemm_tile_bf16<false>(p.omix + (size_t)m0 * DM + hp * 128, DM, p.subkb + (size_t)hp * 128 * 128, 128, 128, lds,
                          [&](int r, int c, float val) { sc[(size_t)r * DM + c] = val; });
  }
}

__device__ __forceinline__ void ph_cvt8(const float* src, unsigned char* dst, float* scales, int nrows) {
  typedef __attribute__((ext_vector_type(4))) float f32x4;
  const int lane = opq(threadIdx.x) & 63, wv = opq(threadIdx.x) >> 6;
  for (int row = blockIdx.x * 4 + wv; row < nrows; row += gridDim.x * 4) {
    const f32x4* s4 = (const f32x4*)(src + (size_t)row * DM);
    f32x4 v[8];
    float amax = 0.f;
#pragma unroll
    for (int c = 0; c < 2; ++c)
#pragma unroll
      for (int i = 0; i < 4; ++i) {
        v[c * 4 + i] = s4[c * 256 + lane * 4 + i];
#pragma unroll
        for (int k = 0; k < 4; ++k) amax = fmaxf(amax, fabsf(v[c * 4 + i][k]));
      }
    amax = wave_max(amax);
    const float sc = (amax > 0.f) ? 440.f / amax : 1.f;
#pragma unroll
    for (int c = 0; c < 2; ++c) {
      u32x4 o;
#pragma unroll
      for (int i = 0; i < 4; ++i) {
        int pk = 0;
        pk = __builtin_amdgcn_cvt_pk_fp8_f32(v[c * 4 + i][0] * sc, v[c * 4 + i][1] * sc, pk, false);
        pk = __builtin_amdgcn_cvt_pk_fp8_f32(v[c * 4 + i][2] * sc, v[c * 4 + i][3] * sc, pk, true);
        o[i] = (unsigned)pk;
      }
      *(u32x4*)(dst + (size_t)row * DM + c * 1024 + lane * 16) = o;
    }
    if (lane == 0) scales[row] = (amax > 0.f) ? amax / 440.f : 1.f;
  }
}

struct R8 { u32x4 r0, r1; };
__device__ __forceinline__ void r8_load(R8& r, const unsigned char* tab, int eid, int lane) {
  const u32x4* ur = (const u32x4*)(tab + (size_t)eid * DM) + lane;
  r.r0 = ur[0]; r.r1 = ur[64];
}
__device__ __forceinline__ float dot2q(unsigned w8, bool hi, unsigned xb, float c) {
  return __builtin_amdgcn_fdot2_f32_bf16(hi ? __builtin_amdgcn_cvt_scalef32_pk_bf16_fp8(w8, 1.0f, true)
                                            : __builtin_amdgcn_cvt_scalef32_pk_bf16_fp8(w8, 1.0f, false),
                                         __builtin_bit_cast(bf16v2, xb), c, false);
}
struct XPk { u32x4 a0, a1, b0, b1; };
struct Acc32 { f32x16 a, b; };

__device__ __forceinline__ float r8_dot(const R8& e, const XPk& x) {
  float pa = 0.f, pb = 0.f;
#pragma unroll
  for (int w = 0; w < 4; ++w) {
    const unsigned xa0 = (w < 2) ? x.a0[2 * w] : x.a1[2 * w - 4], xa1 = (w < 2) ? x.a0[2 * w + 1] : x.a1[2 * w - 3];
    const unsigned xb0 = (w < 2) ? x.b0[2 * w] : x.b1[2 * w - 4], xb1 = (w < 2) ? x.b0[2 * w + 1] : x.b1[2 * w - 3];
    pa = dot2q(e.r0[w], false, xa0, pa);
    pb = dot2q(e.r0[w], true, xa1, pb);
    pa = dot2q(e.r1[w], false, xb0, pa);
    pb = dot2q(e.r1[w], true, xb1, pb);
  }
  return pa + pb;
}
__device__ __forceinline__ void r8_axpy(const R8& e, float hid, Acc32& acc) {
  typedef __attribute__((ext_vector_type(2))) float f32x2;
#pragma unroll
  for (int w = 0; w < 4; ++w) {
    const f32x2 l0 = __builtin_amdgcn_cvt_pk_f32_fp8((int)e.r0[w], false), h0 = __builtin_amdgcn_cvt_pk_f32_fp8((int)e.r0[w], true);
    const f32x2 l1 = __builtin_amdgcn_cvt_pk_f32_fp8((int)e.r1[w], false), h1 = __builtin_amdgcn_cvt_pk_f32_fp8((int)e.r1[w], true);
    acc.a[4 * w + 0] += hid * l0[0]; acc.a[4 * w + 1] += hid * l0[1]; acc.a[4 * w + 2] += hid * h0[0]; acc.a[4 * w + 3] += hid * h0[1];
    acc.b[4 * w + 0] += hid * l1[0]; acc.b[4 * w + 1] += hid * l1[1]; acc.b[4 * w + 2] += hid * h1[0]; acc.b[4 * w + 3] += hid * h1[1];
  }
}

__device__ __forceinline__ void ph_peer(const P& p, float* smem) {
  typedef __attribute__((ext_vector_type(4))) float f32x4;
  const int lane = opq(threadIdx.x) & 63, wv = opq(threadIdx.x) >> 6;
  float* ts = smem + wv * 256;
  int* ti = (int*)(smem + 1024) + wv * 256;
  float* bgt = smem + 2048 + wv * 128;
  int* bex = (int*)(smem + 2560) + wv * 128;
  float* bsu = smem + 3072 + wv * 128;
  for (int item = blockIdx.x; item < T_TOK / 4; item += gridDim.x) {
    int t = item * 4 + wv;
    const float* scrow = p.scores + (size_t)t * DM;
    for (int hp = 0; hp < 16; ++hp) {
      float sc0 = scrow[hp * 128 + lane], sc1 = scrow[hp * 128 + 64 + lane];
      for (int n = 0; n < 16; ++n) {
        float v;
        int i;
        if (sc0 >= sc1) { v = sc0; i = lane; } else { v = sc1; i = lane + 64; }
        wave_argmax(v, i);
        if (lane == 0) { ts[hp * 16 + n] = v; ti[hp * 16 + n] = i; }
        if (i == lane) sc0 = -INFINITY;
        if (i == lane + 64) sc1 = -INFINITY;
      }
    }
    __builtin_amdgcn_wave_barrier();
    for (int h = 0; h < 8; ++h) {
      float cv0, cv1, cv2, cv3;
      cv0 = ts[(2 * h) * 16 + ((lane) >> 4)] + ts[(2 * h + 1) * 16 + (lane & 15)];
      cv1 = ts[(2 * h) * 16 + ((64 + lane) >> 4)] + ts[(2 * h + 1) * 16 + (lane & 15)];
      cv2 = ts[(2 * h) * 16 + ((128 + lane) >> 4)] + ts[(2 * h + 1) * 16 + (lane & 15)];
      cv3 = ts[(2 * h) * 16 + ((192 + lane) >> 4)] + ts[(2 * h + 1) * 16 + (lane & 15)];
      float mybest = 0.f;
      int myc = 0;
      for (int n = 0; n < 16; ++n) {
        float v = cv0;
        int i = lane;
        if (cv1 > v) { v = cv1; i = 64 + lane; }
        if (cv2 > v) { v = cv2; i = 128 + lane; }
        if (cv3 > v) { v = cv3; i = 192 + lane; }
        wave_argmax(v, i);
        if (lane == n) { mybest = v; myc = i; }
        if (i == lane) cv0 = -INFINITY;
        if (i == 64 + lane) cv1 = -INFINITY;
        if (i == 128 + lane) cv2 = -INFINITY;
        if (i == 192 + lane) cv3 = -INFINITY;
      }
      float sv = (lane < 16) ? mybest : -INFINITY;
      float mx = wave_max(sv);
      float e = (lane < 16) ? expf(sv - mx) : 0.f;
      float sum = wave_sum(e);
      if (lane < 16) {
        const int eid = ti[(2 * h) * 16 + (myc >> 4)] * 128 + ti[(2 * h + 1) * 16 + (myc & 15)];
        bex[h * 16 + lane] = eid;
        bgt[h * 16 + lane] = (e / sum) * p.sv8[eid];
        bsu[h * 16 + lane] = p.su8[eid];
      }
    }
    __builtin_amdgcn_wave_barrier();
    XPk x;
    {
      const f32x4* s4 = (const f32x4*)(p.out + (size_t)t * DM);
      const f32x4* g4 = (const f32x4*)p.norm_ffn;
      f32x4 a0 = s4[lane * 4], a1 = s4[lane * 4 + 1], a2 = s4[lane * 4 + 2], a3 = s4[lane * 4 + 3];
      f32x4 a4 = s4[256 + lane * 4], a5 = s4[256 + lane * 4 + 1], a6 = s4[256 + lane * 4 + 2], a7 = s4[256 + lane * 4 + 3];
      float ss = 0.f;
#define SSQ(v) ss += v[0] * v[0] + v[1] * v[1] + v[2] * v[2] + v[3] * v[3];
      SSQ(a0) SSQ(a1) SSQ(a2) SSQ(a3) SSQ(a4) SSQ(a5) SSQ(a6) SSQ(a7)
#undef SSQ
      ss = wave_sum(ss);
      const float rs = rsqrtf(ss * (1.f / DM) + RMS_EPS);
#define XPK(dst, va, vb, gi)                                                          \
  {                                                                                   \
    const f32x4 ga = g4[gi], gb = g4[gi + 1];                                         \
    dst[0] = pack2(va[0] * rs * ga[0], va[1] * rs * ga[1]);                           \
    dst[1] = pack2(va[2] * rs * ga[2], va[3] * rs * ga[3]);                           \
    dst[2] = pack2(vb[0] * rs * gb[0], vb[1] * rs * gb[1]);                           \
    dst[3] = pack2(vb[2] * rs * gb[2], vb[3] * rs * gb[3]);                           \
  }
      XPK(x.a0, a0, a1, lane * 4) XPK(x.a1, a2, a3, lane * 4 + 2) XPK(x.b0, a4, a5, 256 + lane * 4) XPK(x.b1, a6, a7, 256 + lane * 4 + 2)
#undef XPK
    }
    Acc32 acc;
#pragma unroll
    for (int r = 0; r < 16; ++r) { acc.a[r] = 0.f; acc.b[r] = 0.f; }
    R8 u0, u1, u2, u3, v0, v1, v2, v3;
    r8_load(u0, p.pu8, bex[0], lane); r8_load(u1, p.pu8, bex[1], lane); r8_load(u2, p.pu8, bex[2], lane); r8_load(u3, p.pu8, bex[3], lane);
    r8_load(v0, p.pv8, bex[0], lane); r8_load(v1, p.pv8, bex[1], lane); r8_load(v2, p.pv8, bex[2], lane); r8_load(v3, p.pv8, bex[3], lane);
#pragma unroll 1
    for (int e0 = 0; e0 < 128; e0 += 4) {
      float d0 = r8_dot(u0, x), d1 = r8_dot(u1, x), d2 = r8_dot(u2, x), d3 = r8_dot(u3, x);
      const int en = (e0 + 4 < 128) ? e0 + 4 : 124;
      const int i0 = bex[en], i1 = bex[en + 1], i2 = bex[en + 2], i3 = bex[en + 3];
      r8_load(u0, p.pu8, i0, lane); r8_load(u1, p.pu8, i1, lane); r8_load(u2, p.pu8, i2, lane); r8_load(u3, p.pu8, i3, lane);
#pragma unroll
      for (int o = 32; o > 0; o >>= 1) {
        d0 += __shfl_xor(d0, o); d1 += __shfl_xor(d1, o); d2 += __shfl_xor(d2, o); d3 += __shfl_xor(d3, o);
      }
      r8_axpy(v0, bgt[e0 + 0] * gelu_fast(d0 * bsu[e0 + 0]), acc);
      r8_axpy(v1, bgt[e0 + 1] * gelu_fast(d1 * bsu[e0 + 1]), acc);
      r8_axpy(v2, bgt[e0 + 2] * gelu_fast(d2 * bsu[e0 + 2]), acc);
      r8_axpy(v3, bgt[e0 + 3] * gelu_fast(d3 * bsu[e0 + 3]), acc);
      r8_load(v0, p.pv8, i0, lane); r8_load(v1, p.pv8, i1, lane); r8_load(v2, p.pv8, i2, lane); r8_load(v3, p.pv8, i3, lane);
    }
    const int lane2 = opq(lane);
    f32x4* o4 = (f32x4*)(p.out + (size_t)t * DM);
    const f32x4* g4 = (const f32x4*)p.norm_final;
    f32x4 hv[8];
    float ss = 0.f;
#pragma unroll
    for (int c = 0; c < 2; ++c)
#pragma unroll
      for (int i = 0; i < 4; ++i) {
        hv[c * 4 + i] = o4[c * 256 + lane2 * 4 + i];
#pragma unroll
        for (int k = 0; k < 4; ++k) {
          hv[c * 4 + i][k] += c ? acc.b[4 * i + k] : acc.a[4 * i + k];
          ss += hv[c * 4 + i][k] * hv[c * 4 + i][k];
        }
      }
    ss = wave_sum(ss);
    const float rs = rsqrtf(ss * (1.f / DM) + RMS_EPS);
#pragma unroll
    for (int c = 0; c < 2; ++c)
#pragma unroll
      for (int i = 0; i < 4; ++i) {
        const f32x4 g = g4[c * 256 + lane2 * 4 + i];
        f32x4 o;
#pragma unroll
        for (int k = 0; k < 4; ++k) o[k] = hv[c * 4 + i][k] * rs * g[k];
        o4[c * 256 + lane2 * 4 + i] = o;
      }
    __builtin_amdgcn_wave_barrier();
  }
}

#define XB_TMO      128
#define XB_XCNT(j)  (256  + 64 * (j))
#define XB_XSUB(j)  (1280 + 64 * (j))
#define XB_XGEN(j)  (2304 + 64 * (j))
#define XB_TOP      3328
#define XB_TOPGEN   3392
#define XCD_BAR_WORDS 3456
#define XB_SPIN_CAP (1u << 22)
#define LAS __attribute__((address_space(3)))
__device__ __forceinline__ unsigned xb_ld(unsigned* p) { return __hip_atomic_load(p, __ATOMIC_RELAXED, __HIP_MEMORY_SCOPE_AGENT); }
__device__ __forceinline__ unsigned xb_add(unsigned* p, unsigned v) { return __hip_atomic_fetch_add(p, v, __ATOMIC_RELAXED, __HIP_MEMORY_SCOPE_AGENT); }
__device__ __forceinline__ unsigned xb_xcc_id() { return (unsigned)__builtin_amdgcn_s_getreg((3 << 11) | 20) & 0xFu; }
#define XB_SPIN(cond, bar) do { unsigned _sp = 0; while (cond) { __builtin_amdgcn_s_sleep(1); \
    if ((++_sp & 255u) == 0u) { if (xb_ld(&(bar)[XB_TMO])) break; if (_sp > XB_SPIN_CAP) { atomicAdd(&(bar)[XB_TMO], 1u); break; } } } } while (0)
struct XcdBarrier { unsigned* bar; unsigned x; volatile LAS unsigned* st; };
__device__ __forceinline__ XcdBarrier xcd_barrier_post(unsigned* bar, volatile LAS unsigned* st) {
  XcdBarrier b; b.bar = bar; b.x = xb_xcc_id(); b.st = st;
  if (threadIdx.x == 0) (void)xb_add(&bar[XB_XCNT(b.x)], 1u);
  return b;
}
__device__ __forceinline__ void xcd_barrier_complete(unsigned* bar, unsigned x, unsigned& nloc, unsigned& nx) {
  const unsigned G = gridDim.x * gridDim.y * gridDim.z;
  unsigned sum, cnt, mine, sp = 0u;
  for (;;) {
    sum = 0u; cnt = 0u; mine = 0u;
#pragma unroll
    for (unsigned j = 0; j < 16; ++j) { const unsigned c = xb_ld(&bar[XB_XCNT(j)]); sum += c; cnt += (c > 0u) ? 1u : 0u; mine = (j == x) ? c : mine; }
    if (sum == G) break;
    __builtin_amdgcn_s_sleep(1);
    if ((++sp & 255u) == 0u) { if (xb_ld(&bar[XB_TMO])) break; if (sp > XB_SPIN_CAP) { atomicAdd(&bar[XB_TMO], 1u); break; } }
  }
  nloc = mine > 0u ? mine : 1u; nx = cnt > 0u ? cnt : 1u;
}
__device__ __forceinline__ void xcd_barrier(const XcdBarrier& b) {
  asm volatile("s_waitcnt vmcnt(0)" ::: "memory");
  __syncthreads();
  if (threadIdx.x == 0) {
    unsigned* bar = b.bar;
    __builtin_amdgcn_s_waitcnt(0);
    unsigned nloc = b.st[0], nx = b.st[1];
    if (nloc == 0u) { xcd_barrier_complete(bar, b.x, nloc, nx); b.st[0] = nloc; b.st[1] = nx; }
    const unsigned old = xb_add(&bar[XB_XSUB(b.x)], 1u);
    const unsigned gen = old / nloc;
    if (old + 1u == (gen + 1u) * nloc) {
      __builtin_amdgcn_fence(__ATOMIC_RELEASE, "agent");
      asm volatile("s_waitcnt vmcnt(0)" ::: "memory");
      const unsigned og = xb_add(&bar[XB_TOP], 1u);
      const unsigned tg = og / nx;
      if (og + 1u == (tg + 1u) * nx) xb_add(&bar[XB_TOPGEN], 1u);
      else XB_SPIN(xb_ld(&bar[XB_TOPGEN]) == tg, bar);
      __builtin_amdgcn_fence(__ATOMIC_ACQUIRE, "agent");
      xb_add(&bar[XB_XGEN(b.x)], 1u);
      asm volatile("s_waitcnt vmcnt(0)" ::: "memory");
    } else {
      XB_SPIN(xb_ld(&bar[XB_XGEN(b.x)]) == gen, bar);
      __builtin_amdgcn_fence(__ATOMIC_ACQUIRE, "agent");
      asm volatile("s_waitcnt vmcnt(0)" ::: "memory");
    }
  }
  __syncthreads();
}

typedef const __attribute__((address_space(4))) P* KP;
__device__ __forceinline__ P loadP() {
#if defined(__HIP_DEVICE_COMPILE__)
  KP k = (KP)__builtin_amdgcn_kernarg_segment_ptr();
  asm volatile("" : "+s"(k));
  P p = *k;
  return p;
#else
  return P{};
#endif
}

__global__ void __launch_bounds__(256, 2) mega(P p_arg) {
  cg::grid_group grid = cg::this_grid();
  __shared__ __attribute__((aligned(16))) float smem[14336];
  char* lds = (char*)smem;
  __shared__ uint4 xb_words;
  if (threadIdx.x == 0) xb_words = make_uint4(0u, 0u, 0u, 0u);
  if (blockIdx.x == 0) {
    P p = loadP();
    for (int i = threadIdx.x; i < XCD_BAR_WORDS; i += 256) p.bar[i] = 0u;
  }
  { P p = loadP(); ph_rmsnorm(p.x, p.norm_mix, p.hn, T_TOK); ph_rmsnorm(p.mem, p.norm_mkv, p.memn, 1024); }
  { P p = loadP(); ph_transpose<true>(smem, p.w_in, DM, INC, 5760, p.WinT); }
  { P p = loadP(); ph_transpose<false>(smem, p.w_out, DM, DM, DM, p.WoutT); }
  { P p = loadP(); ph_transpose<false>(smem, p.w_pq, DM, DM, DM, p.WpqT); }
  { P p = loadP(); ph_transpose<false>(smem, p.w_mq, DM, 512, 512, p.WmqT); }
  { P p = loadP(); ph_transpose<false>(smem, p.w_mk, DM, 512, 512, p.WmkT); }
  { P p = loadP(); ph_transpose<false>(smem, p.w_mv, DM, 512, 512, p.WmvT); }
  { P p = loadP(); ph_transpose<false>(smem, p.w_mo, 512, DM, DM, p.WmoT); }
  { P p = loadP(); ph_cvt8(p.pu, p.pu8, p.su8, 16384); }
  { P p = loadP(); ph_cvt8(p.pv, p.pv8, p.sv8, 16384); }
  { P p = loadP(); ph_cvt(p.subk, p.subkb, (size_t)16 * 128 * 128); }
  { P p = loadP(); ph_transpose<false>(smem, p.w1_k, 4096, 128, 128, p.w1T); }
  { P p = loadP(); ph_transpose<false>(smem, p.w1_v, 4096, 128, 128, p.w1T + 128 * 4096); }
  { P p = loadP(); ph_transpose<false>(smem, p.w2_k, 128, 128, 128, p.w2T); }
  { P p = loadP(); ph_transpose<false>(smem, p.w2_v, 128, 128, 128, p.w2T + 128 * 128); }
  { P p = loadP(); ph_posb(p); }
  grid.sync();
  XcdBarrier xb;
  { P p = loadP(); xb = xcd_barrier_post(p.bar, (volatile LAS unsigned*)&xb_words); }
  { P p = loadP(); ph_proj(p, lds); }
  { P p = loadP(); bf16_t* kmem = p.kmemb;
    ph_gemm_bf16(p.memn, DM, p.WmkT, DM, 1024, 512, DM, lds, [=](int m, int n, float v) {
      kmem[((size_t)((m >> 8) * 4 + (n >> 7)) * 256 + (m & 255)) * 128 + (n & 127)] = f2bf(v); }); }
  { P p = loadP(); bf16_t* vmem = p.vmemT;
    ph_gemm_bf16(p.memn, DM, p.WmvT, DM, 1024, 512, DM, lds, [=](int m, int n, float v) {
      vmem[((size_t)((m >> 8) * 4 + (n >> 7)) * 128 + (n & 127)) * 256 + perm16(m & 255)] = f2bf(v); }); }
  xcd_barrier(xb);
  { P p = loadP(); ph_compress2(p, lds); }
  { P p = loadP(); ph_sb2(p, lds); }
  xcd_barrier(xb);
  { P p = loadP(); ph_nsa2(p, lds); }
  xcd_barrier(xb);
  { P p = loadP(); float* out = p.out; const float* x = p.x;
    ph_gemm_bf16(p.omix, DM, p.WoutT, DM, T_TOK, DM, DM, lds, [=](int m, int n, float v) { out[(size_t)m * DM + n] = x[(size_t)m * DM + n] + v; }); }
  xcd_barrier(xb);
  { P p = loadP(); ph_rmsnorm(p.out, p.norm_mq, p.hn, T_TOK); }
  xcd_barrier(xb);
  { P p = loadP(); bf16_t* qmem = p.qmemb;
    ph_gemm_bf16(p.hn, DM, p.WmqT, DM, T_TOK, 512, DM, lds, [=](int m, int n, float v) { qmem[(size_t)m * 512 + n] = f2bf(v); }); }
  xcd_barrier(xb);
  { P p = loadP(); ph_memattn2(p, lds); }
  xcd_barrier(xb);
  { P p = loadP(); float* out = p.out;
    ph_gemm_bf16(p.omem, 512, p.WmoT, 512, T_TOK, DM, 512, lds, [=](int m, int n, float v) { out[(size_t)m * DM + n] += v; }); }
  xcd_barrier(xb);
  { P p = loadP(); ph_rmsnorm(p.out, p.norm_ffn, p.hn, T_TOK); }
  xcd_barrier(xb);
  { P p = loadP(); bf16_t* qp = p.omix;
    ph_gemm_bf16(p.hn, DM, p.WpqT, DM, T_TOK, DM, DM, lds, [=](int m, int n, float v) { qp[(size_t)m * DM + n] = f2bf(v); }); }
  xcd_barrier(xb);
  { P p = loadP(); ph_scores(p, lds); }
  xcd_barrier(xb);
  { P p = loadP(); ph_peer(p, smem); }
}

extern "C" void kernel_launch(void* const* d_in, const int* in_sizes, int n_in, void* d_out, int out_size, void* d_ws,
                              size_t ws_size, hipStream_t stream) {
  P p{};
  p.x = (const float*)d_in[0]; p.mem = (const float*)d_in[1]; p.t5 = (const float*)d_in[2];
  p.norm_mix = (const float*)d_in[3]; p.w_in = (const float*)d_in[4]; p.pos_k = (const float*)d_in[5];
  p.w1_k = (const float*)d_in[6]; p.w2_k = (const float*)d_in[7]; p.pos_v = (const float*)d_in[8];
  p.w1_v = (const float*)d_in[9]; p.w2_v = (const float*)d_in[10]; p.w_out = (const float*)d_in[11];
  p.norm_mq = (const float*)d_in[12]; p.norm_mkv = (const float*)d_in[13]; p.w_mq = (const float*)d_in[14];
  p.w_mk = (const float*)d_in[15]; p.w_mv = (const float*)d_in[16]; p.w_mo = (const float*)d_in[17];
  p.norm_ffn = (const float*)d_in[18]; p.w_pq = (const float*)d_in[19]; p.subk = (const float*)d_in[20];
  p.pu = (const float*)d_in[21]; p.pv = (const float*)d_in[22]; p.norm_final = (const float*)d_in[23];
  p.out = (float*)d_out;
  char* w = (char*)d_ws;
  size_t off = 0;
  auto take = [&](size_t bytes) { char* r = w + off; off += (bytes + 255) & ~(size_t)255; return r; };
  p.bar = (unsigned*)take(XCD_BAR_WORDS * 4);
  p.scores = (float*)take((size_t)T_TOK * DM * 4);
  p.gates = (float*)take((size_t)T_TOK * 24 * 4);
  p.part = (float*)take((size_t)T_TOK * 1024 * 4);
  p.posb = (float*)take(256 * 4);
  p.qn = (bf16_t*)take((size_t)T_TOK * 1024 * 2);
  p.kcin = (bf16_t*)take((size_t)T_TOK * 256 * 2 + 65536);
  p.vcin = (bf16_t*)take((size_t)T_TOK * 256 * 2 + 65536);
  p.ks = (bf16_t*)take((size_t)T_TOK * 256 * 2);
  p.vsT = (bf16_t*)take((size_t)T_TOK * 256 * 2);
  p.kw = (bf16_t*)take((size_t)T_TOK * 256 * 2);
  p.vwT = (bf16_t*)take((size_t)T_TOK * 256 * 2);
  p.kcb = (bf16_t*)take((size_t)8 * 128 * 128 * 2);
  p.vcT = (bf16_t*)take((size_t)8 * 128 * 128 * 2);
  p.c1 = (bf16_t*)take((size_t)16 * 128 * 128 * 2);
  p.w1T = (bf16_t*)take((size_t)2 * 128 * 4096 * 2);
  p.w2T = (bf16_t*)take((size_t)2 * 128 * 128 * 2);
  p.hn = (bf16_t*)take((size_t)T_TOK * DM * 2);
  p.omix = (bf16_t*)take((size_t)T_TOK * DM * 2);
  p.memn = (bf16_t*)take((size_t)1024 * DM * 2);
  p.omem = (bf16_t*)take((size_t)T_TOK * 512 * 2);
  p.WinT = (bf16_t*)take((size_t)5760 * DM * 2);
  p.WoutT = (bf16_t*)take((size_t)DM * DM * 2);
  p.WpqT = (bf16_t*)take((size_t)DM * DM * 2);
  p.WmqT = (bf16_t*)take((size_t)512 * DM * 2);
  p.WmkT = (bf16_t*)take((size_t)512 * DM * 2);
  p.WmvT = (bf16_t*)take((size_t)512 * DM * 2);
  p.WmoT = (bf16_t*)take((size_t)DM * 512 * 2);
  p.qmemb = (bf16_t*)take((size_t)T_TOK * 512 * 2);
  p.kmemb = (bf16_t*)take((size_t)1024 * 512 * 2);
  p.vmemT = (bf16_t*)take((size_t)1024 * 512 * 2);
  p.qsb = (bf16_t*)take((size_t)T_TOK * 1024 * 2);
  p.ksb = (bf16_t*)take((size_t)T_TOK * 1024 * 2);
  p.vsbT = (bf16_t*)take((size_t)T_TOK * 1024 * 2);
  p.pu8 = (unsigned char*)take((size_t)16384 * DM);
  p.pv8 = (unsigned char*)take((size_t)16384 * DM);
  p.su8 = (float*)take(16384 * 4);
  p.sv8 = (float*)take(16384 * 4);
  p.subkb = (bf16_t*)take((size_t)16 * 128 * 128 * 2);
  static int grid_blocks = 0;
  if (!grid_blocks) {
    int dev = 0, cus = 0, per_cu = 0;
    (void)hipGetDevice(&dev);
    (void)hipDeviceGetAttribute(&cus, hipDeviceAttributeMultiprocessorCount, dev);
    (void)hipOccupancyMaxActiveBlocksPerMultiprocessor(&per_cu, mega, 256, 0);
    if (per_cu > 2) per_cu = 2;
    if (per_cu < 1) per_cu = 1;
    grid_blocks = cus * per_cu;
  }
  void* args[] = {&p};
  hipError_t e = hipLaunchCooperativeKernel((void*)mega, dim3(grid_blocks), dim3(256), args, 0, stream);
  if (e != hipSuccess) fprintf(stderr, "cooperative launch failed: %s (grid %d)\n", hipGetErrorString(e), grid_blocks);
}
```

```cpp
#include <hip/hip_runtime.h>
#include <hip/hip_cooperative_groups.h>
#include <cstdio>
namespace cg = cooperative_groups;
#include <stdint.h>

#define SEQ 2048
#define NBATCH 4
#define T_TOK 8192
#define DM 2048
#define INC 5656
#define C_QN 0
#define C_KC 1024
#define C_VC 1280
#define C_KS 1536
#define C_VS 1792
#define C_KW 2048
#define C_VW 2304
#define C_GT 2560
#define C_QSB 2584
#define C_KSB 3608
#define C_VSB 4632
#define ATT_SCALE 0.08838834764831845f
#define RMS_EPS 1e-6f

typedef unsigned short bf16_t;
typedef __attribute__((ext_vector_type(8))) short bf16x8;
typedef __attribute__((ext_vector_type(16))) float f32x16;
typedef __attribute__((ext_vector_type(2))) __bf16 bf16v2;
typedef __attribute__((ext_vector_type(4))) unsigned u32x4;

struct P {
  const float *x, *mem, *t5, *norm_mix, *w_in, *pos_k, *w1_k, *w2_k, *pos_v, *w1_v, *w2_v, *w_out,
      *norm_mq, *norm_mkv, *w_mq, *w_mk, *w_mv, *w_mo, *norm_ffn, *w_pq, *subk, *pu, *pv, *norm_final;
  float* out;
  float *scores, *gates, *part, *posb;
  unsigned* bar;
  bf16_t *hn, *omix, *memn, *omem;
  bf16_t *WinT, *WoutT, *WpqT, *WmqT, *WmkT, *WmvT, *WmoT;
  bf16_t *qmemb, *kmemb, *vmemT;
  bf16_t *qsb, *ksb, *vsbT;
  bf16_t* subkb;
  unsigned char *pu8, *pv8;
  float *su8, *sv8;
  bf16_t *qn, *kcin, *vcin, *ks, *vsT, *kw, *vwT, *kcb, *vcT, *c1, *w1T, *w2T;
};

__device__ __forceinline__ int opq(int v) { asm volatile("" : "+v"(v)); return v; }
__device__ __forceinline__ unsigned pack2(float a, float b) {
  bf16v2 r = {(__bf16)a, (__bf16)b};
  return *(unsigned*)&r;
}
__device__ __forceinline__ bf16_t f2bf(float a) {
  __bf16 r = (__bf16)a;
  return *(bf16_t*)&r;
}
__device__ __forceinline__ int perm16(int s) { return (s & ~12) | ((s & 4) << 1) | ((s & 8) >> 1); }
__device__ __forceinline__ float bf2f(bf16_t u) { return __uint_as_float((unsigned)u << 16); }

__device__ __forceinline__ float wave_max(float v) {
  for (int o = 32; o > 0; o >>= 1) v = fmaxf(v, __shfl_xor(v, o));
  return v;
}
__device__ __forceinline__ float wave_sum(float v) {
  for (int o = 32; o > 0; o >>= 1) v += __shfl_xor(v, o);
  return v;
}
__device__ __forceinline__ void wave_argmax(float& v, int& i) {
  for (int o = 32; o > 0; o >>= 1) {
    float ov = __shfl_xor(v, o);
    int oi = __shfl_xor(i, o);
    if (ov > v || (ov == v && oi < i)) { v = ov; i = oi; }
  }
}
__device__ __forceinline__ float gelu_tanh(float x) {
  return 0.5f * x * (1.f + tanhf(0.7978845608028654f * (x + 0.044715f * x * x * x)));
}
__device__ __forceinline__ float gelu_fast(float x) {
  const float y = 1.5957691216057308f * (x + 0.044715f * x * x * x);
  return x / (1.f + __expf(-y));
}
__device__ __forceinline__ int t5_bucket(int n) {
  if (n < 16) return n < 0 ? 0 : n;
  int b = 16;
  b += (n >= 19); b += (n >= 21); b += (n >= 24); b += (n >= 27); b += (n >= 31); b += (n >= 35);
  b += (n >= 40); b += (n >= 46); b += (n >= 52); b += (n >= 59); b += (n >= 67); b += (n >= 77);
  b += (n >= 87); b += (n >= 99); b += (n >= 113);
  return b;
}
__device__ __forceinline__ float log_sigmoid(float x) {
  return fminf(x, 0.f) - log1pf(expf(-fabsf(x)));
}

__device__ __forceinline__ void ph_rmsnorm(const float* src, const float* gain, bf16_t* dst, int rows) {
  int lane = opq(threadIdx.x) & 63, wv = opq(threadIdx.x) >> 6;
  for (int r = blockIdx.x * 4 + wv; r < rows; r += gridDim.x * 4) {
    const float4* s4 = (const float4*)(src + (size_t)r * DM);
    float4 v[8];
    float ss = 0.f;
#pragma unroll
    for (int i = 0; i < 8; ++i) {
      v[i] = s4[i * 64 + lane];
      ss += v[i].x * v[i].x + v[i].y * v[i].y + v[i].z * v[i].z + v[i].w * v[i].w;
    }
    ss = wave_sum(ss);
    float rs = rsqrtf(ss * (1.f / DM) + RMS_EPS);
    uint2* d2 = (uint2*)(dst + (size_t)r * DM);
    const float4* g4 = (const float4*)gain;
#pragma unroll
    for (int i = 0; i < 8; ++i) {
      float4 g = g4[i * 64 + lane];
      uint2 o;
      o.x = pack2(v[i].x * rs * g.x, v[i].y * rs * g.y);
      o.y = pack2(v[i].z * rs * g.z, v[i].w * rs * g.w);
      d2[i * 64 + lane] = o;
    }
  }
}

template <bool CMAP>
__device__ __forceinline__ void ph_transpose(float* smem, const float* W, int K, int N, int Npad, bf16_t* Wt) {
  float (*tl)[65] = (float (*)[65])smem;
  int tid = opq(threadIdx.x);
  int nk = K / 64, nn = Npad / 64;
  for (int tile = blockIdx.x; tile < nk * nn; tile += gridDim.x) {
    int k0 = (tile % nk) * 64, n0 = (tile / nk) * 64;
    int col = tid & 63, rb = tid >> 6;
#pragma unroll 4
    for (int pp = 0; pp < 16; ++pp) {
      int k = pp * 4 + rb;
      float v = 0.f;
      int sc = n0 + col;
      if (CMAP) sc = (sc < 2560) ? sc : (sc < 5632) ? sc + 24 : (sc < 5656) ? sc - 5632 + 2560 : N;
      if (sc < N) v = W[(size_t)(k0 + k) * N + sc];
      tl[k][col] = v;
    }
    __syncthreads();
    int n = tid >> 2, kc = (tid & 3) * 16;
    unsigned w[8];
#pragma unroll
    for (int i = 0; i < 8; ++i) w[i] = pack2(tl[kc + 2 * i][n], tl[kc + 2 * i + 1][n]);
    uint4* dst = (uint4*)(Wt + (size_t)(n0 + n) * K + k0 + kc);
    dst[0] = make_uint4(w[0], w[1], w[2], w[3]);
    dst[1] = make_uint4(w[4], w[5], w[6], w[7]);
    __syncthreads();
  }
}

__device__ __forceinline__ int lds_off(int row, int chunk) { return row * 128 + ((chunk ^ ((row >> 1) & 7)) << 4); }

template <bool TR, class Epi>
__device__ __forceinline__ void gemm_tile_bf16(const bf16_t* xp, int ldx, const bf16_t* yp, int ldy, int K, char* lds,
                                               Epi epi) {
  const int tid = opq(threadIdx.x), lane = tid & 63, wv = tid >> 6;
  const int wr = wv >> 1, wc = wv & 1;
  char* lx = lds;
  char* ly = lds + 16384;
  f32x16 acc[2][2];
#pragma unroll
  for (int i = 0; i < 2; ++i)
#pragma unroll
    for (int j = 0; j < 2; ++j)
#pragma unroll
      for (int r = 0; r < 16; ++r) acc[i][j][r] = 0.f;
  const int srow = tid >> 3, sch = tid & 7;
  const bf16_t* xg = xp + (size_t)srow * ldx + sch * 8;
  const bf16_t* yg = yp + (size_t)srow * ldy + sch * 8;
  const size_t x32 = (size_t)32 * ldx, y32 = (size_t)32 * ldy;
  uint4 sx0 = *(const uint4*)(xg), sx1 = *(const uint4*)(xg + x32), sx2 = *(const uint4*)(xg + 2 * x32),
        sx3 = *(const uint4*)(xg + 3 * x32);
  uint4 sy0 = *(const uint4*)(yg), sy1 = *(const uint4*)(yg + y32), sy2 = *(const uint4*)(yg + 2 * y32),
        sy3 = *(const uint4*)(yg + 3 * y32);
  const int so0 = lds_off(srow, sch), so1 = lds_off(32 + srow, sch), so2 = lds_off(64 + srow, sch),
            so3 = lds_off(96 + srow, sch);
  for (int k0 = 0; k0 < K; k0 += 64) {
    __syncthreads();
    *(uint4*)(lx + so0) = sx0; *(uint4*)(lx + so1) = sx1; *(uint4*)(lx + so2) = sx2; *(uint4*)(lx + so3) = sx3;
    *(uint4*)(ly + so0) = sy0; *(uint4*)(ly + so1) = sy1; *(uint4*)(ly + so2) = sy2; *(uint4*)(ly + so3) = sy3;
    __syncthreads();
    if (k0 + 64 < K) {
      const bf16_t* xn = xg + k0 + 64;
      const bf16_t* yn = yg + k0 + 64;
      sx0 = *(const uint4*)(xn); sx1 = *(const uint4*)(xn + x32); sx2 = *(const uint4*)(xn + 2 * x32);
      sx3 = *(const uint4*)(xn + 3 * x32);
      sy0 = *(const uint4*)(yn); sy1 = *(const uint4*)(yn + y32); sy2 = *(const uint4*)(yn + 2 * y32);
      sy3 = *(const uint4*)(yn + 3 * y32);
    }
#pragma unroll
    for (int kk = 0; kk < 4; ++kk) {
      bf16x8 a[2], b[2];
      const int ch = kk * 2 + (lane >> 5);
#pragma unroll
      for (int i = 0; i < 2; ++i) {
        a[i] = *(const bf16x8*)((TR ? ly : lx) + lds_off(wr * 64 + i * 32 + (lane & 31), ch));
        b[i] = *(const bf16x8*)((TR ? lx : ly) + lds_off(wc * 64 + i * 32 + (lane & 31), ch));
      }
#pragma unroll
      for (int i = 0; i < 2; ++i)
#pragma unroll
        for (int j = 0; j < 2; ++j) acc[i][j] = __builtin_amdgcn_mfma_f32_32x32x16_bf16(a[i], b[j], acc[i][j], 0, 0, 0);
    }
  }
  int lane2 = lane;
  asm volatile("" : "+v"(lane2));
#pragma unroll
  for (int i = 0; i < 2; ++i)
#pragma unroll
    for (int j = 0; j < 2; ++j)
#pragma unroll
      for (int r = 0; r < 16; ++r) {
        int rr = wr * 64 + i * 32 + (r & 3) + 8 * (r >> 2) + 4 * (lane2 >> 5);
        int cc = wc * 64 + j * 32 + (lane2 & 31);
        epi(rr, cc, acc[i][j][r]);
      }
}

template <class Epi>
__device__ __forceinline__ void ph_gemm_bf16(const bf16_t* A, int lda, const bf16_t* Wt, int ldw, int M, int N, int K,
                                             char* lds, Epi epi) {
  const int ntm = M / 128, ntn = N / 128;
  const int npm = (ntm + 7) / 8, npn = (ntn + 7) / 8;
  const int nslots = ((npm * npn * 64 + 511) / 512) * 512;
  for (int u = blockIdx.x; u < nslots; u += gridDim.x) {
    int v = (u & 7) * 64 + ((u >> 3) & 63) + (u & ~511);
    int patch = v >> 6, w = v & 63;
    int tm = (patch % npm) * 8 + (w & 7);
    int tn = (patch / npm) * 8 + (w >> 3);
    if (tm >= ntm || tn >= ntn) continue;
    const int m0 = tm * 128, n0 = tn * 128;
    gemm_tile_bf16<false>(A + (size_t)m0 * lda, lda, Wt + (size_t)n0 * ldw, ldw, K, lds,
                          [&](int r, int c, float val) { epi(m0 + r, n0 + c, val); });
  }
}

__device__ __forceinline__ void ph_proj(const P& p, char* lds) {
  const int ntm = T_TOK / 128, ntn = 5760 / 128;
  const int npm = (ntm + 7) / 8, npn = (ntn + 7) / 8;
  const int nslots = ((npm * npn * 64 + 511) / 512) * 512;
  for (int u = blockIdx.x; u < nslots; u += gridDim.x) {
    int v = (u & 7) * 64 + ((u >> 3) & 63) + (u & ~511);
    int patch = v >> 6, w = v & 63;
    int tm = (patch % npm) * 8 + (w & 7);
    int tn = (patch / npm) * 8 + (w >> 3);
    if (tm >= ntm || tn >= ntn) continue;
    const int m0 = tm * 128, n0 = tn * 128;
    const int b = m0 >> 11, sl = m0 & 2047;
    const bf16_t* A = p.hn + (size_t)m0 * DM;
    const bf16_t* W = p.WinT + (size_t)n0 * DM;
    if (n0 < 1024) {
      bf16_t* q = p.qn + (size_t)m0 * 1024 + n0;
      gemm_tile_bf16<false>(A, DM, W, DM, DM, lds, [&](int r, int c, float val) { q[(size_t)r * 1024 + c] = f2bf(val); });
    } else if (n0 < 2560) {
      const int seg = (n0 - 1024) >> 8, g = ((n0 - 1024) >> 7) & 1;
      if (seg == 3 || seg == 5) {
        bf16_t* vd = (seg == 3 ? p.vsT : p.vwT) + ((size_t)(b * 2 + g) * 128) * SEQ + sl;
        gemm_tile_bf16<true>(A, DM, W, DM, DM, lds, [&](int r, int c, float val) { vd[(size_t)r * SEQ + perm16(c)] = f2bf(val); });
      } else {
        bf16_t* base = (seg == 0) ? p.kcin : (seg == 1) ? p.vcin : (seg == 2) ? p.ks : p.kw;
        bf16_t* kd = base + ((size_t)(b * 2 + g) * SEQ + sl) * 128;
        gemm_tile_bf16<false>(A, DM, W, DM, DM, lds, [&](int r, int c, float val) { kd[(size_t)r * 128 + c] = f2bf(val); });
      }
    } else if (n0 < 3584) {
      bf16_t* q = p.qsb + (size_t)m0 * 1024 + (n0 - 2560);
      gemm_tile_bf16<false>(A, DM, W, DM, DM, lds, [&](int r, int c, float val) { q[(size_t)r * 1024 + c] = f2bf(val); });
    } else if (n0 < 4608) {
      bf16_t* kd = p.ksb + ((size_t)(b * 8 + ((n0 - 3584) >> 7)) * SEQ + sl) * 128;
      gemm_tile_bf16<false>(A, DM, W, DM, DM, lds, [&](int r, int c, float val) { kd[(size_t)r * 128 + c] = f2bf(val); });
    } else if (n0 < 5632) {
      bf16_t* vd = p.vsbT + ((size_t)(b * 8 + ((n0 - 4608) >> 7)) * 128) * SEQ + sl;
      gemm_tile_bf16<true>(A, DM, W, DM, DM, lds, [&](int r, int c, float val) { vd[(size_t)r * SEQ + perm16(c)] = f2bf(val); });
    } else {
      float* gd = p.gates + (size_t)m0 * 24;
      gemm_tile_bf16<false>(A, DM, W, DM, DM, lds, [&](int r, int c, float val) { if (c < 24) gd[(size_t)r * 24 + c] = val; });
    }
  }
}

__device__ __forceinline__ void ph_posb(const P& p) {
  const int lane = opq(threadIdx.x) & 63, wv = opq(threadIdx.x) >> 6;
  for (int o = blockIdx.x * 4 + wv; o < 256; o += gridDim.x * 4) {
    const int which = o >> 7, n = o & 127;
    const float* pos = which ? p.pos_v : p.pos_k;
    const float* w1 = which ? p.w1_v : p.w1_k;
    float acc = 0.f;
    for (int k = lane; k < 4096; k += 64) acc += pos[k] * w1[(size_t)k * 128 + n];
    acc = wave_sum(acc);
    if (lane == 0) p.posb[o] = acc;
  }
}

__device__ __forceinline__ void ph_compress2(const P& p, char* lds) {
  for (int item = blockIdx.x; item < 16; item += gridDim.x) {
    const int which = item >> 3, bg = item & 7;
    const bf16_t* src = (which ? p.vcin : p.kcin) + (size_t)bg * SEQ * 128;
    const bf16_t* w1t = p.w1T + (size_t)which * 128 * 4096;
    const bf16_t* w2t = p.w2T + (size_t)which * 128 * 128;
    const float* posb = p.posb + which * 128;
    bf16_t* c1 = p.c1 + (size_t)item * 128 * 128;
    gemm_tile_bf16<false>(src, 2048, w1t, 4096, 4096, lds, [&](int r, int c, float val) {
      c1[r * 128 + c] = f2bf(gelu_fast(val + posb[c])); });
    __threadfence_block();
    __syncthreads();
    if (which == 0) {
      bf16_t* kd = p.kcb + (size_t)bg * 128 * 128;
      gemm_tile_bf16<false>(c1, 128, w2t, 128, 128, lds, [&](int r, int c, float val) { kd[r * 128 + c] = f2bf(val); });
    } else {
      bf16_t* vd = p.vcT + (size_t)bg * 128 * 128;
      gemm_tile_bf16<true>(c1, 128, w2t, 128, 128, lds, [&](int r, int c, float val) { vd[r * 128 + perm16(c)] = f2bf(val); });
    }
  }
}

#define NEG_BIG (-1e30f)

struct KVRegs { u32x4 k0, k1, k2, k3, v0, v1, v2, v3; };

__device__ __forceinline__ int koff(int row, int chunk) { return row * 256 + ((chunk ^ (row & 15)) << 4); }

__device__ __forceinline__ void kv_load(KVRegs& r, const bf16_t* kp, int ldk, const bf16_t* vp, int ldv) {
  const int tid = opq(threadIdx.x);
  const bf16_t* kg = kp + (size_t)(tid >> 4) * ldk + (tid & 15) * 8;
  r.k0 = *(const u32x4*)kg;
  r.k1 = *(const u32x4*)(kg + (size_t)16 * ldk);
  r.k2 = *(const u32x4*)(kg + (size_t)32 * ldk);
  r.k3 = *(const u32x4*)(kg + (size_t)48 * ldk);
  const bf16_t* vg = vp + (size_t)(tid >> 3) * ldv + (tid & 7) * 8;
  r.v0 = *(const u32x4*)vg;
  r.v1 = *(const u32x4*)(vg + (size_t)32 * ldv);
  r.v2 = *(const u32x4*)(vg + (size_t)64 * ldv);
  r.v3 = *(const u32x4*)(vg + (size_t)96 * ldv);
}
__device__ __forceinline__ void kv_store(const KVRegs& r, char* lk, char* lv) {
  const int tid = opq(threadIdx.x);
  const int row = tid >> 4, ch = tid & 15;
  *(u32x4*)(lk + koff(row, ch)) = r.k0;
  *(u32x4*)(lk + koff(row + 16, ch)) = r.k1;
  *(u32x4*)(lk + koff(row + 32, ch)) = r.k2;
  *(u32x4*)(lk + koff(row + 48, ch)) = r.k3;
  const int vr = tid >> 3, vc = tid & 7;
  *(u32x4*)(lv + lds_off(vr, vc)) = r.v0;
  *(u32x4*)(lv + lds_off(vr + 32, vc)) = r.v1;
  *(u32x4*)(lv + lds_off(vr + 64, vc)) = r.v2;
  *(u32x4*)(lv + lds_off(vr + 96, vc)) = r.v3;
}

struct QFrag { bf16x8 f0, f1, f2, f3, f4, f5, f6, f7; };
__device__ __forceinline__ void q_load(QFrag& q, const bf16_t* qrow) {
  const int h = (opq(threadIdx.x) & 63) >> 5;
  const bf16x8* p8 = (const bf16x8*)(qrow + 8 * h);
  q.f0 = p8[0]; q.f1 = p8[2]; q.f2 = p8[4]; q.f3 = p8[6]; q.f4 = p8[8]; q.f5 = p8[10]; q.f6 = p8[12]; q.f7 = p8[14];
}

__device__ __forceinline__ void qk_tile(const QFrag& q, const char* lk, f32x16& s0, f32x16& s1) {
  const int lane = opq(threadIdx.x) & 63, row = lane & 31, h = lane >> 5;
#pragma unroll
  for (int r = 0; r < 16; ++r) { s0[r] = 0.f; s1[r] = 0.f; }
#define QK_STEP(kk, qf)                                                                  \
  {                                                                                      \
    bf16x8 a0 = *(const bf16x8*)(lk + koff(row, 2 * (kk) + h));                          \
    bf16x8 a1 = *(const bf16x8*)(lk + koff(row + 32, 2 * (kk) + h));                     \
    s0 = __builtin_amdgcn_mfma_f32_32x32x16_bf16(a0, qf, s0, 0, 0, 0);                   \
    s1 = __builtin_amdgcn_mfma_f32_32x32x16_bf16(a1, qf, s1, 0, 0, 0);                   \
  }
  QK_STEP(0, q.f0) QK_STEP(1, q.f1) QK_STEP(2, q.f2) QK_STEP(3, q.f3)
  QK_STEP(4, q.f4) QK_STEP(5, q.f5) QK_STEP(6, q.f6) QK_STEP(7, q.f7)
#undef QK_STEP
}

__device__ __forceinline__ bf16x8 pack8(const f32x16& p, const int base) {
  u32x4 u;
  u[0] = pack2(p[base + 0], p[base + 1]);
  u[1] = pack2(p[base + 2], p[base + 3]);
  u[2] = pack2(p[base + 4], p[base + 5]);
  u[3] = pack2(p[base + 6], p[base + 7]);
  return __builtin_bit_cast(bf16x8, u);
}

struct OAcc { f32x16 o0, o1, o2, o3; };
__device__ __forceinline__ void oacc_zero(OAcc& o) {
#pragma unroll
  for (int r = 0; r < 16; ++r) { o.o0[r] = 0.f; o.o1[r] = 0.f; o.o2[r] = 0.f; o.o3[r] = 0.f; }
}
__device__ __forceinline__ void oacc_scale(OAcc& o, float a) {
#pragma unroll
  for (int r = 0; r < 16; ++r) { o.o0[r] *= a; o.o1[r] *= a; o.o2[r] *= a; o.o3[r] *= a; }
}

__device__ __forceinline__ void pv_tile(OAcc& o, const char* lv, const f32x16& p0, const f32x16& p1) {
  const int lane = opq(threadIdx.x) & 63, row = lane & 31, h = lane >> 5;
  const bf16x8 pf0 = pack8(p0, 0), pf1 = pack8(p0, 8), pf2 = pack8(p1, 0), pf3 = pack8(p1, 8);
#define PV_ROW(dd, acc)                                                                                      \
  {                                                                                                          \
    acc = __builtin_amdgcn_mfma_f32_32x32x16_bf16(*(const bf16x8*)(lv + lds_off(32 * (dd) + row, 0 + h)), pf0, acc, 0, 0, 0); \
    acc = __builtin_amdgcn_mfma_f32_32x32x16_bf16(*(const bf16x8*)(lv + lds_off(32 * (dd) + row, 2 + h)), pf1, acc, 0, 0, 0); \
    acc = __builtin_amdgcn_mfma_f32_32x32x16_bf16(*(const bf16x8*)(lv + lds_off(32 * (dd) + row, 4 + h)), pf2, acc, 0, 0, 0); \
    acc = __builtin_amdgcn_mfma_f32_32x32x16_bf16(*(const bf16x8*)(lv + lds_off(32 * (dd) + row, 6 + h)), pf3, acc, 0, 0, 0); \
  }
  PV_ROW(0, o.o0) PV_ROW(1, o.o1) PV_ROW(2, o.o2) PV_ROW(3, o.o3)
#undef PV_ROW
}

__device__ __forceinline__ void softmax_tile(f32x16& s0, f32x16& s1, float& m, float& l, OAcc& o) {
  float mx = NEG_BIG;
#pragma unroll
  for (int r = 0; r < 16; ++r) mx = fmaxf(mx, fmaxf(s0[r], s1[r]));
  mx = fmaxf(mx, __shfl_xor(mx, 32));
  const float mn = fmaxf(m, mx);
  const float alpha = __expf(m - mn);
  float ls = 0.f;
#pragma unroll
  for (int r = 0; r < 16; ++r) {
    float a = (s0[r] > -1e29f) ? __expf(s0[r] - mn) : 0.f;
    float b = (s1[r] > -1e29f) ? __expf(s1[r] - mn) : 0.f;
    s0[r] = a; s1[r] = b;
    ls += a + b;
  }
  ls += __shfl_xor(ls, 32);
  l = l * alpha + ls;
  m = mn;
  oacc_scale(o, alpha);
}

template <class F>
__device__ __forceinline__ void oacc_foreach(const OAcc& o, F f) {
  const int h = (opq(threadIdx.x) & 63) >> 5;
#pragma unroll
  for (int rho = 0; rho < 4; ++rho) {
    f(0 + 8 * rho + 4 * h, o.o0[4 * rho], o.o0[4 * rho + 1], o.o0[4 * rho + 2], o.o0[4 * rho + 3]);
    f(32 + 8 * rho + 4 * h, o.o1[4 * rho], o.o1[4 * rho + 1], o.o1[4 * rho + 2], o.o1[4 * rho + 3]);
    f(64 + 8 * rho + 4 * h, o.o2[4 * rho], o.o2[4 * rho + 1], o.o2[4 * rho + 2], o.o2[4 * rho + 3]);
    f(96 + 8 * rho + 4 * h, o.o3[4 * rho], o.o3[4 * rho + 1], o.o3[4 * rho + 2], o.o3[4 * rho + 3]);
  }
}

__device__ __forceinline__ void ph_memattn2(const P& p, char* lds) {
  char* lk = lds;
  char* lv = lds + 16384;
  const int lane = opq(threadIdx.x) & 63, wv = opq(threadIdx.x) >> 6;
  for (int item = blockIdx.x; item < NBATCH * 4 * (SEQ / 128); item += gridDim.x) {
    const int tb = item % (SEQ / 128);
    const int bh = item / (SEQ / 128);
    const int b = bh >> 2, hd = bh & 3;
    const int t = tb * 128 + wv * 32 + (lane & 31);
    QFrag q;
    q_load(q, p.qmemb + (size_t)(b * SEQ + t) * 512 + hd * 128);
    const bf16_t* kb = p.kmemb + (size_t)bh * 256 * 128;
    const bf16_t* vb = p.vmemT + (size_t)bh * 128 * 256;
    OAcc o;
    oacc_zero(o);
    float m = NEG_BIG, l = 0.f;
    KVRegs kv;
    kv_load(kv, kb, 128, vb, 256);
#pragma unroll 1
    for (int ti = 0; ti < 4; ++ti) {
      __syncthreads();
      kv_store(kv, lk, lv);
      __syncthreads();
      {
        const int tn = (ti + 1 < 4) ? ti + 1 : 3;
        kv_load(kv, kb + (size_t)tn * 64 * 128, 128, vb + tn * 64, 256);
      }
      f32x16 s0, s1;
      qk_tile(q, lk, s0, s1);
#pragma unroll
      for (int r = 0; r < 16; ++r) { s0[r] *= ATT_SCALE; s1[r] *= ATT_SCALE; }
      softmax_tile(s0, s1, m, l, o);
      pv_tile(o, lv, s0, s1);
    }
    const float il = 1.f / l;
    const int t2 = tb * 128 + (opq(threadIdx.x) >> 6) * 32 + (opq(threadIdx.x) & 31);
    bf16_t* orow = p.omem + (size_t)(b * SEQ + t2) * 512 + hd * 128;
    oacc_foreach(o, [&](int d, float v0, float v1, float v2, float v3) {
      uint2 u;
      u.x = pack2(v0 * il, v1 * il);
      u.y = pack2(v2 * il, v3 * il);
      *(uint2*)(orow + d) = u;
    });
  }
}

__device__ __forceinline__ void ph_sb2(const P& p, char* lds) {
  char* lk = lds;
  char* lv = lds + 16384;
  const int lane = opq(threadIdx.x) & 63, wv = opq(threadIdx.x) >> 6, hh = lane >> 5;
  for (int item = blockIdx.x; item < NBATCH * 8 * (SEQ / 128); item += gridDim.x) {
    const int tb = (SEQ / 128 - 1) - (item % (SEQ / 128));
    const int bh = item / (SEQ / 128);
    const int b = bh >> 3, hd = bh & 7;
    const int t0 = tb * 128;
    const int t = t0 + wv * 32 + (lane & 31);
    QFrag q;
    q_load(q, p.qsb + (size_t)(b * SEQ + t) * 1024 + hd * 128);
    const bf16_t* kb = p.ksb + (size_t)bh * SEQ * 128;
    const bf16_t* vb = p.vsbT + (size_t)bh * 128 * SEQ;
    OAcc o;
    oacc_zero(o);
    float carry = 0.f;
    const int jhi = (t0 >> 6) + 1;
    const int jw = (t0 + wv * 32 + 30) >> 6;
    KVRegs kv;
    kv_load(kv, kb + (size_t)jhi * 64 * 128, 128, vb + jhi * 64, SEQ);
    for (int j = jhi; j >= 0; --j) {
      __syncthreads();
      kv_store(kv, lk, lv);
      __syncthreads();
      const int jn = (j > 0) ? j - 1 : 0;
      if (j > jw) kv_load(kv, kb + (size_t)jn * 64 * 128, 128, vb + jn * 64, SEQ);
      if (j <= jw) {
        f32x16 z0, z1;
        qk_tile(q, lk, z0, z1);
        const int sbase = j * 64 + 4 * hh;
        float gt[8];
        f32x16 l0, l1;
#pragma unroll
        for (int r = 0; r < 16; ++r) {
          const int so = sbase + 8 * (r >> 2) + (r & 3);
          {
            const float z = z0[r] * ATT_SCALE;
            const bool valid = so < t;
            const float lsp = fminf(z, 0.f) - __logf(1.f + __expf(-fabsf(z)));
            l0[r] = valid ? (lsp - z) : 0.f;
            z0[r] = valid ? z : NEG_BIG;
          }
          {
            const float z = z1[r] * ATT_SCALE;
            const bool valid = so + 32 < t;
            const float lsp = fminf(z, 0.f) - __logf(1.f + __expf(-fabsf(z)));
            l1[r] = valid ? (lsp - z) : 0.f;
            z1[r] = valid ? z : NEG_BIG;
          }
        }
#pragma unroll
        for (int rho = 0; rho < 4; ++rho) {
          gt[rho] = (l0[4 * rho] + l0[4 * rho + 1]) + (l0[4 * rho + 2] + l0[4 * rho + 3]);
          gt[4 + rho] = (l1[4 * rho] + l1[4 * rho + 1]) + (l1[4 * rho + 2] + l1[4 * rho + 3]);
        }
        float ag[8];
        float run = 0.f;
#pragma unroll
        for (int k = 7; k >= 0; --k) {
          const float pg = __shfl_xor(gt[k], 32);
          ag[k] = carry + run + (hh == 0 ? pg : 0.f);
          run += gt[k] + pg;
        }
        carry += run;
#pragma unroll
        for (int rho = 0; rho < 4; ++rho) {
          {
            const float x3 = l0[4 * rho + 3], x23 = x3 + l0[4 * rho + 2], x123 = x23 + l0[4 * rho + 1];
            const float g = ag[rho];
            z0[4 * rho + 0] = __expf((l0[4 * rho + 0] + z0[4 * rho + 0]) + (g + x123));
            z0[4 * rho + 1] = __expf((l0[4 * rho + 1] + z0[4 * rho + 1]) + (g + x23));
            z0[4 * rho + 2] = __expf((l0[4 * rho + 2] + z0[4 * rho + 2]) + (g + x3));
            z0[4 * rho + 3] = __expf((l0[4 * rho + 3] + z0[4 * rho + 3]) + g);
          }
          {
            const float x3 = l1[4 * rho + 3], x23 = x3 + l1[4 * rho + 2], x123 = x23 + l1[4 * rho + 1];
            const float g = ag[4 + rho];
            z1[4 * rho + 0] = __expf((l1[4 * rho + 0] + z1[4 * rho + 0]) + (g + x123));
            z1[4 * rho + 1] = __expf((l1[4 * rho + 1] + z1[4 * rho + 1]) + (g + x23));
            z1[4 * rho + 2] = __expf((l1[4 * rho + 2] + z1[4 * rho + 2]) + (g + x3));
            z1[4 * rho + 3] = __expf((l1[4 * rho + 3] + z1[4 * rho + 3]) + g);
          }
        }
        kv_load(kv, kb + (size_t)jn * 64 * 128, 128, vb + jn * 64, SEQ);
        pv_tile(o, lv, z0, z1);
      }
    }
    int t2 = t;
    asm volatile("" : "+v"(t2));
    bf16_t* orow = p.omix + (size_t)(b * SEQ + t2) * DM + 1024 + hd * 128;
    oacc_foreach(o, [&](int d, float v0, float v1, float v2, float v3) {
      uint2 u;
      u.x = pack2(v0, v1);
      u.y = pack2(v2, v3);
      *(uint2*)(orow + d) = u;
    });
  }
}

#define NSA_IMP 32768
#define NSA_KEYS 49152
#define NSA_SELM 53504
#define NSA_LUT 53632
__device__ __forceinline__ void ph_nsa2(const P& p, char* lds) {
  typedef __attribute__((ext_vector_type(4))) float f32x4;
  char* lk = lds;
  char* lv = lds + 16384;
  float* imp = (float*)(lds + NSA_IMP);
  float* keys = (float*)(lds + NSA_KEYS);
  unsigned* selm = (unsigned*)(lds + NSA_SELM);
  const int tid = opq(threadIdx.x), lane = tid & 63, wv = tid >> 6, hh = lane >> 5, ql = lane & 31;
  float* lut = (float*)(lds + NSA_LUT) + wv * 128;
  for (int item = blockIdx.x; item < NBATCH * 2 * (SEQ / 32); item += gridDim.x) {
    const int tt = (SEQ / 32 - 1) - (item % (SEQ / 32));
    const int bg = item / (SEQ / 32);
    const int b = bg >> 1, g = bg & 1;
    const int h = g * 4 + wv;
    const int t0 = tt * 32, tq = t0 + ql, cur = t0 >> 6;
    __syncthreads();
    QFrag q;
    q_load(q, p.qn + (size_t)(b * SEQ + tq) * 1024 + h * 128);
    {
      const int lo = opq(lane);
      lut[lo] = p.t5[t5_bucket(lo) * 8 + h];
      lut[lo + 64] = p.t5[t5_bucket(lo + 64) * 8 + h];
    }
#pragma unroll
    for (int i = 0; i < 16; ++i) imp[i * 256 + tid] = 0.f;
    if (tid < 32) selm[tid] = 0u;
    const float* grow = p.gates + (size_t)(b * SEQ + tq) * 24 + h * 3;
    float* prow = p.part + (size_t)(b * SEQ + tq) * 1024 + h * 128;
    OAcc o;
    float m, l;
    KVRegs kv;
    {
      const bf16_t* kb = p.kcb + (size_t)bg * 128 * 128;
      const bf16_t* vb = p.vcT + (size_t)bg * 128 * 128;
      oacc_zero(o);
      m = NEG_BIG; l = 0.f;
      kv_load(kv, kb, 128, vb, 128);
      __syncthreads();
      kv_store(kv, lk, lv);
      __syncthreads();
      f32x16 x0, x1;
      qk_tile(q, lk, x0, x1);
      int tqv = tq;
      asm volatile("" : "+v"(tqv));
      tqv -= 64 * hh;
#pragma unroll
      for (int r = 0; r < 16; ++r) {
        const int c = 8 * (r >> 2) + (r & 3);
        const int d0 = tqv - 16 * c - 31, d1 = d0 - 512;
        x0[r] = (d0 >= 0) ? x0[r] * ATT_SCALE + lut[min(d0, 127)] : NEG_BIG;
        x1[r] = (d1 >= 0) ? x1[r] * ATT_SCALE + lut[min(d1, 127)] : NEG_BIG;
      }
      softmax_tile(x0, x1, m, l, o);
      const float m0 = m;
      pv_tile(o, lv, x0, x1);
      kv_load(kv, kb + 64 * 128, 128, vb + 64, 128);
      __syncthreads();
      kv_store(kv, lk, lv);
      __syncthreads();
      f32x16 z0, z1;
      qk_tile(q, lk, z0, z1);
      asm volatile("" : "+v"(tqv));
#pragma unroll
      for (int r = 0; r < 16; ++r) {
        const int c = 64 + 8 * (r >> 2) + (r & 3);
        const int d0 = tqv - 16 * c - 31, d1 = d0 - 512;
        z0[r] = (d0 >= 0) ? z0[r] * ATT_SCALE + lut[min(d0, 127)] : NEG_BIG;
        z1[r] = (d1 >= 0) ? z1[r] * ATT_SCALE + lut[min(d1, 127)] : NEG_BIG;
      }
      softmax_tile(z0, z1, m, l, o);
      pv_tile(o, lv, z0, z1);
      const float inv = 1.f / fmaxf(l, 1e-20f);
      const float c0 = __expf(m0 - m) * inv;
#pragma unroll
      for (int r = 0; r < 16; ++r) {
        const int c = 8 * (r >> 2) + (r & 3) + 4 * hh;
        if (x0[r] != 0.f) atomicAdd(&imp[(c) * 32 + ql], x0[r] * c0);
        if (x1[r] != 0.f) atomicAdd(&imp[(c + 32) * 32 + ql], x1[r] * c0);
        if (z0[r] != 0.f) atomicAdd(&imp[(c + 64) * 32 + ql], z0[r] * inv);
        if (z1[r] != 0.f) atomicAdd(&imp[(c + 96) * 32 + ql], z1[r] * inv);
      }
      const float gs = inv / (1.f + __expf(-grow[0]));
      oacc_foreach(o, [&](int d, float v0, float v1, float v2, float v3) {
        f32x4 u = {v0 * gs, v1 * gs, v2 * gs, v3 * gs};
        *(f32x4*)(prow + d) = u;
      });
    }
    __syncthreads();
    {
      const int tido = opq(tid);
      const int qq = tido & 31, jg = tido >> 5;
#pragma unroll
      for (int jj = 0; jj < 4; ++jj) {
        const int j = jg * 4 + jj;
        float v = imp[(4 * j) * 32 + qq] + imp[(4 * j + 1) * 32 + qq] + imp[(4 * j + 2) * 32 + qq] + 0.5f * imp[(4 * j + 3) * 32 + qq];
        if (j > 0) v += 0.5f * imp[(4 * j - 1) * 32 + qq];
        const bool forced = (j == 0) || (j == cur) || (j == cur - 1);
        keys[qq * 33 + j] = forced ? 1e9f : ((j <= cur) ? v : -1e9f);
      }
      __syncthreads();
      unsigned bits = 0u;
#pragma unroll
      for (int jj = 0; jj < 4; ++jj) {
        const int j = jg * 4 + jj;
        const float kj = keys[qq * 33 + j];
        int rank = 0;
        for (int i = 0; i < 32; ++i) {
          const float ki = keys[qq * 33 + i];
          rank += (ki > kj || (ki == kj && i < j)) ? 1 : 0;
        }
        if (rank < 16 && j <= cur) bits |= 1u << j;
      }
      atomicOr(&selm[qq], bits);
      __syncthreads();
    }
    const unsigned mysel = selm[ql];
    unsigned um = mysel;
#pragma unroll
    for (int o2 = 16; o2 > 0; o2 >>= 1) um |= (unsigned)__shfl_xor((int)um, o2);
    um = (unsigned)__builtin_amdgcn_readfirstlane((int)um);
    {
      const bf16_t* kb = p.ks + (size_t)bg * SEQ * 128;
      const bf16_t* vb = p.vsT + (size_t)bg * 128 * SEQ;
      oacc_zero(o);
      m = NEG_BIG; l = 0.f;
      unsigned rem = um;
      int j = __builtin_ctz(rem);
      kv_load(kv, kb + (size_t)j * 64 * 128, 128, vb + j * 64, SEQ);
      while (rem) {
        j = __builtin_ctz(rem);
        rem &= rem - 1;
        const int jn = rem ? __builtin_ctz(rem) : j;
        __syncthreads();
        kv_store(kv, lk, lv);
        __syncthreads();
        f32x16 s0, s1;
        qk_tile(q, lk, s0, s1);
        const bool selq = (mysel >> j) & 1u;
        int tqv = tq;
        asm volatile("" : "+v"(tqv));
#pragma unroll
        for (int r = 0; r < 16; ++r) {
          const int d0 = tqv - (j * 64 + 8 * (r >> 2) + (r & 3) + 4 * hh), d1 = d0 - 32;
          s0[r] = (selq && d0 >= 0) ? s0[r] * ATT_SCALE + lut[min(d0, 127)] : NEG_BIG;
          s1[r] = (selq && d1 >= 0) ? s1[r] * ATT_SCALE + lut[min(d1, 127)] : NEG_BIG;
        }
        kv_load(kv, kb + (size_t)jn * 64 * 128, 128, vb + jn * 64, SEQ);
        softmax_tile(s0, s1, m, l, o);
        pv_tile(o, lv, s0, s1);
      }
      const float gs = 1.f / (fmaxf(l, 1e-20f) * (1.f + __expf(-grow[1])));
      int qo = ql;
      asm volatile("" : "+v"(qo));
      float* pr2 = p.part + (size_t)(b * SEQ + t0 + qo) * 1024 + h * 128;
      oacc_foreach(o, [&](int d, float v0, float v1, float v2, float v3) {
        f32x4 u = *(f32x4*)(pr2 + d);
        u[0] += v0 * gs; u[1] += v1 * gs; u[2] += v2 * gs; u[3] += v3 * gs;
        *(f32x4*)(pr2 + d) = u;
      });
    }
    {
      const bf16_t* kb = p.kw + (size_t)bg * SEQ * 128;
      const bf16_t* vb = p.vwT + (size_t)bg * 128 * SEQ;
      oacc_zero(o);
      m = NEG_BIG; l = 0.f;
      int jlo = (t0 - 511) >> 6;
      if (jlo < 0) jlo = 0;
      kv_load(kv, kb + (size_t)jlo * 64 * 128, 128, vb + jlo * 64, SEQ);
      for (int j = jlo; j <= cur; ++j) {
        const int jn = (j < cur) ? j + 1 : j;
        __syncthreads();
        kv_store(kv, lk, lv);
        __syncthreads();
        f32x16 s0, s1;
        qk_tile(q, lk, s0, s1);
        int tqv = tq;
        asm volatile("" : "+v"(tqv));
#pragma unroll
        for (int r = 0; r < 16; ++r) {
          const int d0 = tqv - (j * 64 + 8 * (r >> 2) + (r & 3) + 4 * hh), d1 = d0 - 32;
          s0[r] = (d0 >= 0 && d0 < 512) ? s0[r] * ATT_SCALE + lut[min(d0, 127)] : NEG_BIG;
          s1[r] = (d1 >= 0 && d1 < 512) ? s1[r] * ATT_SCALE + lut[min(d1, 127)] : NEG_BIG;
        }
        kv_load(kv, kb + (size_t)jn * 64 * 128, 128, vb + jn * 64, SEQ);
        softmax_tile(s0, s1, m, l, o);
        pv_tile(o, lv, s0, s1);
      }
      const float gs = 1.f / (fmaxf(l, 1e-20f) * (1.f + __expf(-grow[2])));
      int qo = ql;
      asm volatile("" : "+v"(qo));
      const float* pr2 = p.part + (size_t)(b * SEQ + t0 + qo) * 1024 + h * 128;
      bf16_t* orow = p.omix + (size_t)(b * SEQ + t0 + qo) * DM + h * 128;
      oacc_foreach(o, [&](int d, float v0, float v1, float v2, float v3) {
        const f32x4 u = *(const f32x4*)(pr2 + d);
        uint2 w;
        w.x = pack2(u[0] + v0 * gs, u[1] + v1 * gs);
        w.y = pack2(u[2] + v2 * gs, u[3] + v3 * gs);
        *(uint2*)(orow + d) = w;
      });
    }
  }
}

__device__ __forceinline__ void ph_cvt(const float* src, bf16_t* dst, size_t n) {
  typedef __attribute__((ext_vector_type(4))) float f32x4;
  const size_t nv = n / 8;
  for (size_t i = (size_t)blockIdx.x * 256 + opq(threadIdx.x); i < nv; i += (size_t)gridDim.x * 256) {
    const f32x4 a = ((const f32x4*)src)[2 * i], b = ((const f32x4*)src)[2 * i + 1];
    u32x4 o;
    o[0] = pack2(a[0], a[1]); o[1] = pack2(a[2], a[3]); o[2] = pack2(b[0], b[1]); o[3] = pack2(b[2], b[3]);
    ((u32x4*)dst)[i] = o;
  }
}

__device__ __forceinline__ void ph_scores(const P& p, char* lds) {
  for (int u = blockIdx.x; u < 64 * 16; u += gridDim.x) {
    const int tm = u & 63, hp = u >> 6;
    const int m0 = tm * 128;
    float* sc = p.scores + (size_t)m0 * DM + hp * 128;
    gemm_tile_bf16<false>(p.omix + (size_t)m0 * DM + hp * 128, DM, p.subkb + (size_t)hp * 128 * 128, 128, 128, lds,
                          [&](int r, int c, float val) { sc[(size_t)r * DM + c] = val; });
  }
}

__device__ __forceinline__ void ph_cvt8(const float* src, unsigned char* dst, float* scales, int nrows) {
  typedef __attribute__((ext_vector_type(4))) float f32x4;
  const int lane = opq(threadIdx.x) & 63, wv = opq(threadIdx.x) >> 6;
  for (int row = blockIdx.x * 4 + wv; row < nrows; row += gridDim.x * 4) {
    const f32x4* s4 = (const f32x4*)(src + (size_t)row * DM);
    f32x4 v[8];
    float amax = 0.f;
#pragma unroll
    for (int c = 0; c < 2; ++c)
#pragma unroll
      for (int i = 0; i < 4; ++i) {
        v[c * 4 + i] = s4[c * 256 + lane * 4 + i];
#pragma unroll
        for (int k = 0; k < 4; ++k) amax = fmaxf(amax, fabsf(v[c * 4 + i][k]));
      }
    amax = wave_max(amax);
    const float sc = (amax > 0.f) ? 440.f / amax : 1.f;
#pragma unroll
    for (int c = 0; c < 2; ++c) {
      u32x4 o;
#pragma unroll
      for (int i = 0; i < 4; ++i) {
        int pk = 0;
        pk = __builtin_amdgcn_cvt_pk_fp8_f32(v[c * 4 + i][0] * sc, v[c * 4 + i][1] * sc, pk, false);
        pk = __builtin_amdgcn_cvt_pk_fp8_f32(v[c * 4 + i][2] * sc, v[c * 4 + i][3] * sc, pk, true);
        o[i] = (unsigned)pk;
      }
      *(u32x4*)(dst + (size_t)row * DM + c * 1024 + lane * 16) = o;
    }
    if (lane == 0) scales[row] = (amax > 0.f) ? amax / 440.f : 1.f;
  }
}

struct R8 { u32x4 r0, r1; };
__device__ __forceinline__ void r8_load(R8& r, const unsigned char* tab, int eid, int lane) {
  const u32x4* ur = (const u32x4*)(tab + (size_t)eid * DM) + lane;
  r.r0 = ur[0]; r.r1 = ur[64];
}
__device__ __forceinline__ float dot2q(unsigned w8, bool hi, unsigned xb, float c) {
  return __builtin_amdgcn_fdot2_f32_bf16(hi ? __builtin_amdgcn_cvt_scalef32_pk_bf16_fp8(w8, 1.0f, true)
                                            : __builtin_amdgcn_cvt_scalef32_pk_bf16_fp8(w8, 1.0f, false),
                                         __builtin_bit_cast(bf16v2, xb), c, false);
}
struct XPk { u32x4 a0, a1, b0, b1; };
struct Acc32 { f32x16 a, b; };

__device__ __forceinline__ float r8_dot(const R8& e, const XPk& x) {
  float pa = 0.f, pb = 0.f;
#pragma unroll
  for (int w = 0; w < 4; ++w) {
    const unsigned xa0 = (w < 2) ? x.a0[2 * w] : x.a1[2 * w - 4], xa1 = (w < 2) ? x.a0[2 * w + 1] : x.a1[2 * w - 3];
    const unsigned xb0 = (w < 2) ? x.b0[2 * w] : x.b1[2 * w - 4], xb1 = (w < 2) ? x.b0[2 * w + 1] : x.b1[2 * w - 3];
    pa = dot2q(e.r0[w], false, xa0, pa);
    pb = dot2q(e.r0[w], true, xa1, pb);
    pa = dot2q(e.r1[w], false, xb0, pa);
    pb = dot2q(e.r1[w], true, xb1, pb);
  }
  return pa + pb;
}
__device__ __forceinline__ void r8_axpy(const R8& e, float hid, Acc32& acc) {
  typedef __attribute__((ext_vector_type(2))) float f32x2;
#pragma unroll
  for (int w = 0; w < 4; ++w) {
    const f32x2 l0 = __builtin_amdgcn_cvt_pk_f32_fp8((int)e.r0[w], false), h0 = __builtin_amdgcn_cvt_pk_f32_fp8((int)e.r0[w], true);
    const f32x2 l1 = __builtin_amdgcn_cvt_pk_f32_fp8((int)e.r1[w], false), h1 = __builtin_amdgcn_cvt_pk_f32_fp8((int)e.r1[w], true);
    acc.a[4 * w + 0] += hid * l0[0]; acc.a[4 * w + 1] += hid * l0[1]; acc.a[4 * w + 2] += hid * h0[0]; acc.a[4 * w + 3] += hid * h0[1];
    acc.b[4 * w + 0] += hid * l1[0]; acc.b[4 * w + 1] += hid * l1[1]; acc.b[4 * w + 2] += hid * h1[0]; acc.b[4 * w + 3] += hid * h1[1];
  }
}

#define INS16(K, x)                                                                                      \
  K##15 = __builtin_amdgcn_fmed3f(K##15, K##14, x); K##14 = __builtin_amdgcn_fmed3f(K##14, K##13, x);   \
  K##13 = __builtin_amdgcn_fmed3f(K##13, K##12, x); K##12 = __builtin_amdgcn_fmed3f(K##12, K##11, x);   \
  K##11 = __builtin_amdgcn_fmed3f(K##11, K##10, x); K##10 = __builtin_amdgcn_fmed3f(K##10, K##9, x);    \
  K##9 = __builtin_amdgcn_fmed3f(K##9, K##8, x); K##8 = __builtin_amdgcn_fmed3f(K##8, K##7, x);         \
  K##7 = __builtin_amdgcn_fmed3f(K##7, K##6, x); K##6 = __builtin_amdgcn_fmed3f(K##6, K##5, x);         \
  K##5 = __builtin_amdgcn_fmed3f(K##5, K##4, x); K##4 = __builtin_amdgcn_fmed3f(K##4, K##3, x);         \
  K##3 = __builtin_amdgcn_fmed3f(K##3, K##2, x); K##2 = __builtin_amdgcn_fmed3f(K##2, K##1, x);         \
  K##1 = __builtin_amdgcn_fmed3f(K##1, K##0, x); K##0 = fmaxf(K##0, x);
#define DECL16(K) float K##0 = -INFINITY, K##1 = -INFINITY, K##2 = -INFINITY, K##3 = -INFINITY, K##4 = -INFINITY, \
  K##5 = -INFINITY, K##6 = -INFINITY, K##7 = -INFINITY, K##8 = -INFINITY, K##9 = -INFINITY, K##10 = -INFINITY,   \
  K##11 = -INFINITY, K##12 = -INFINITY, K##13 = -INFINITY, K##14 = -INFINITY, K##15 = -INFINITY;
__device__ __forceinline__ float mkkey(float v, unsigned tag, unsigned mask) {
  return __uint_as_float((__float_as_uint(v) & ~mask) | tag);
}

__device__ __forceinline__ void ph_peer(const P& p, float* smem) {
  typedef __attribute__((ext_vector_type(4))) float f32x4;
  const int tid = opq(threadIdx.x), lane = tid & 63, wv = tid >> 6;
  float* lists = smem;
  int* bexA = (int*)(smem + 4096);
  float* bgtA = smem + 6144;
  float* bsuA = smem + 8192;
  for (int item = blockIdx.x; item < T_TOK / 16; item += gridDim.x) {
    const int t0 = item * 16;
    __syncthreads();
    {
      const int tl = tid >> 4, hp = tid & 15;
      const f32x4* sp = (const f32x4*)(p.scores + (size_t)(t0 + tl) * DM + hp * 128);
      DECL16(k)
#pragma unroll 4
      for (int c4 = 0; c4 < 32; ++c4) {
        const f32x4 v = sp[c4];
#pragma unroll
        for (int e = 0; e < 4; ++e) {
          const float x = mkkey(v[e], 127u - (unsigned)(c4 * 4 + e), 127u);
          INS16(k, x)
        }
      }
      f32x4* lp = (f32x4*)(lists + (size_t)tid * 16);
      f32x4 o0 = {k0, k1, k2, k3}, o1 = {k4, k5, k6, k7}, o2 = {k8, k9, k10, k11}, o3 = {k12, k13, k14, k15};
      lp[0] = o0; lp[1] = o1; lp[2] = o2; lp[3] = o3;
    }
    __syncthreads();
    if (tid < 128) {
      const int tl = tid >> 3, h = tid & 7;
      const float* la = lists + (size_t)(tl * 16 + 2 * h) * 16;
      const float* lb = la + 16;
      float av[16], bv[16];
#pragma unroll
      for (int i = 0; i < 16; ++i) {
        av[i] = __uint_as_float(__float_as_uint(la[i]) & ~127u);
        bv[i] = __uint_as_float(__float_as_uint(lb[i]) & ~127u);
      }
      DECL16(c)
#pragma unroll
      for (int i = 0; i < 16; ++i) {
#pragma unroll
        for (int j = 0; j < 16; ++j) {
          if ((i + 1) * (j + 1) <= 16) {
            const float x = mkkey(av[i] + bv[j], 255u - (unsigned)(i * 16 + j), 255u);
            INS16(c, x)
          }
        }
      }
      float cs[16] = {c0, c1, c2, c3, c4, c5, c6, c7, c8, c9, c10, c11, c12, c13, c14, c15};
      float ev[16];
      float sum = 0.f;
      const float mx = __uint_as_float(__float_as_uint(cs[0]) & ~255u);
#pragma unroll
      for (int n = 0; n < 16; ++n) {
        ev[n] = __expf(__uint_as_float(__float_as_uint(cs[n]) & ~255u) - mx);
        sum += ev[n];
      }
      const float isum = 1.f / sum;
#pragma unroll
      for (int n = 0; n < 16; ++n) {
        const unsigned cc = 255u - (__float_as_uint(cs[n]) & 255u);
        const unsigned ka = 127u - (__float_as_uint(la[cc >> 4]) & 127u);
        const unsigned kb = 127u - (__float_as_uint(lb[cc & 15u]) & 127u);
        const int eid = (int)(ka * 128u + kb);
        bexA[tl * 128 + h * 16 + n] = eid;
        bgtA[tl * 128 + h * 16 + n] = ev[n] * isum * p.sv8[eid];
        bsuA[tl * 128 + h * 16 + n] = p.su8[eid];
      }
    }
    __syncthreads();
#pragma unroll 1
    for (int ti4 = 0; ti4 < 4; ++ti4) {
    const int tl = wv * 4 + ti4;
    const int t = t0 + tl;
    const int* bex = bexA + tl * 128;
    const float* bgt = bgtA + tl * 128;
    const float* bsu = bsuA + tl * 128;
    XPk x;
    {
      const f32x4* s4 = (const f32x4*)(p.out + (size_t)t * DM);
      const f32x4* g4 = (const f32x4*)p.norm_ffn;
      f32x4 a0 = s4[lane * 4], a1 = s4[lane * 4 + 1], a2 = s4[lane * 4 + 2], a3 = s4[lane * 4 + 3];
      f32x4 a4 = s4[256 + lane * 4], a5 = s4[256 + lane * 4 + 1], a6 = s4[256 + lane * 4 + 2], a7 = s4[256 + lane * 4 + 3];
      float ss = 0.f;
#define SSQ(v) ss += v[0] * v[0] + v[1] * v[1] + v[2] * v[2] + v[3] * v[3];
      SSQ(a0) SSQ(a1) SSQ(a2) SSQ(a3) SSQ(a4) SSQ(a5) SSQ(a6) SSQ(a7)
#undef SSQ
      ss = wave_sum(ss);
      const float rs = rsqrtf(ss * (1.f / DM) + RMS_EPS);
#define XPK(dst, va, vb, gi)                                                          \
  {                                                                                   \
    const f32x4 ga = g4[gi], gb = g4[gi + 1];                                         \
    dst[0] = pack2(va[0] * rs * ga[0], va[1] * rs * ga[1]);                           \
    dst[1] = pack2(va[2] * rs * ga[2], va[3] * rs * ga[3]);                           \
    dst[2] = pack2(vb[0] * rs * gb[0], vb[1] * rs * gb[1]);                           \
    dst[3] = pack2(vb[2] * rs * gb[2], vb[3] * rs * gb[3]);                           \
  }
      XPK(x.a0, a0, a1, lane * 4) XPK(x.a1, a2, a3, lane * 4 + 2) XPK(x.b0, a4, a5, 256 + lane * 4) XPK(x.b1, a6, a7, 256 + lane * 4 + 2)
#undef XPK
    }
    Acc32 acc;
#pragma unroll
    for (int r = 0; r < 16; ++r) { acc.a[r] = 0.f; acc.b[r] = 0.f; }
    R8 u0, u1, u2, u3, v0, v1, v2, v3;
    r8_load(u0, p.pu8, bex[0], lane); r8_load(u1, p.pu8, bex[1], lane); r8_load(u2, p.pu8, bex[2], lane); r8_load(u3, p.pu8, bex[3], lane);
    r8_load(v0, p.pv8, bex[0], lane); r8_load(v1, p.pv8, bex[1], lane); r8_load(v2, p.pv8, bex[2], lane); r8_load(v3, p.pv8, bex[3], lane);
#pragma unroll 1
    for (int e0 = 0; e0 < 128; e0 += 4) {
      float d0 = r8_dot(u0, x), d1 = r8_dot(u1, x), d2 = r8_dot(u2, x), d3 = r8_dot(u3, x);
      const int en = (e0 + 4 < 128) ? e0 + 4 : 124;
      const int i0 = bex[en], i1 = bex[en + 1], i2 = bex[en + 2], i3 = bex[en + 3];
      r8_load(u0, p.pu8, i0, lane); r8_load(u1, p.pu8, i1, lane); r8_load(u2, p.pu8, i2, lane); r8_load(u3, p.pu8, i3, lane);
#pragma unroll
      for (int o = 32; o > 0; o >>= 1) {
        d0 += __shfl_xor(d0, o); d1 += __shfl_xor(d1, o); d2 += __shfl_xor(d2, o); d3 += __shfl_xor(d3, o);
      }
      r8_axpy(v0, bgt[e0 + 0] * gelu_fast(d0 * bsu[e0 + 0]), acc);
      r8_axpy(v1, bgt[e0 + 1] * gelu_fast(d1 * bsu[e0 + 1]), acc);
      r8_axpy(v2, bgt[e0 + 2] * gelu_fast(d2 * bsu[e0 + 2]), acc);
      r8_axpy(v3, bgt[e0 + 3] * gelu_fast(d3 * bsu[e0 + 3]), acc);
      r8_load(v0, p.pv8, i0, lane); r8_load(v1, p.pv8, i1, lane); r8_load(v2, p.pv8, i2, lane); r8_load(v3, p.pv8, i3, lane);
    }
    const int lane2 = opq(lane);
    f32x4* o4 = (f32x4*)(p.out + (size_t)t * DM);
    const f32x4* g4 = (const f32x4*)p.norm_final;
    f32x4 hv[8];
    float ss = 0.f;
#pragma unroll
    for (int c = 0; c < 2; ++c)
#pragma unroll
      for (int i = 0; i < 4; ++i) {
        hv[c * 4 + i] = o4[c * 256 + lane2 * 4 + i];
#pragma unroll
        for (int k = 0; k < 4; ++k) {
          hv[c * 4 + i][k] += c ? acc.b[4 * i + k] : acc.a[4 * i + k];
          ss += hv[c * 4 + i][k] * hv[c * 4 + i][k];
        }
      }
    ss = wave_sum(ss);
    const float rs = rsqrtf(ss * (1.f / DM) + RMS_EPS);
#pragma unroll
    for (int c = 0; c < 2; ++c)
#pragma unroll
      for (int i = 0; i < 4; ++i) {
        const f32x4 g = g4[c * 256 + lane2 * 4 + i];
        f32x4 o;
#pragma unroll
        for (int k = 0; k < 4; ++k) o[k] = hv[c * 4 + i][k] * rs * g[k];
        o4[c * 256 + lane2 * 4 + i] = o;
      }
    }
  }
}

#define XB_TMO      128
#define XB_XCNT(j)  (256  + 64 * (j))
#define XB_XSUB(j)  (1280 + 64 * (j))
#define XB_XGEN(j)  (2304 + 64 * (j))
#define XB_TOP      3328
#define XB_TOPGEN   3392
#define XCD_BAR_WORDS 3456
#define XB_SPIN_CAP (1u << 22)
#define LAS __attribute__((address_space(3)))
__device__ __forceinline__ unsigned xb_ld(unsigned* p) { return __hip_atomic_load(p, __ATOMIC_RELAXED, __HIP_MEMORY_SCOPE_AGENT); }
__device__ __forceinline__ unsigned xb_add(unsigned* p, unsigned v) { return __hip_atomic_fetch_add(p, v, __ATOMIC_RELAXED, __HIP_MEMORY_SCOPE_AGENT); }
__device__ __forceinline__ unsigned xb_xcc_id() { return (unsigned)__builtin_amdgcn_s_getreg((3 << 11) | 20) & 0xFu; }
#define XB_SPIN(cond, bar) do { unsigned _sp = 0; while (cond) { __builtin_amdgcn_s_sleep(1); \
    if ((++_sp & 255u) == 0u) { if (xb_ld(&(bar)[XB_TMO])) break; if (_sp > XB_SPIN_CAP) { atomicAdd(&(bar)[XB_TMO], 1u); break; } } } } while (0)
struct XcdBarrier { unsigned* bar; unsigned x; volatile LAS unsigned* st; };
__device__ __forceinline__ XcdBarrier xcd_barrier_post(unsigned* bar, volatile LAS unsigned* st) {
  XcdBarrier b; b.bar = bar; b.x = xb_xcc_id(); b.st = st;
  if (threadIdx.x == 0) (void)xb_add(&bar[XB_XCNT(b.x)], 1u);
  return b;
}
__device__ __forceinline__ void xcd_barrier_complete(unsigned* bar, unsigned x, unsigned& nloc, unsigned& nx) {
  const unsigned G = gridDim.x * gridDim.y * gridDim.z;
  unsigned sum, cnt, mine, sp = 0u;
  for (;;) {
    sum = 0u; cnt = 0u; mine = 0u;
#pragma unroll
    for (unsigned j = 0; j < 16; ++j) { const unsigned c = xb_ld(&bar[XB_XCNT(j)]); sum += c; cnt += (c > 0u) ? 1u : 0u; mine = (j == x) ? c : mine; }
    if (sum == G) break;
    __builtin_amdgcn_s_sleep(1);
    if ((++sp & 255u) == 0u) { if (xb_ld(&bar[XB_TMO])) break; if (sp > XB_SPIN_CAP) { atomicAdd(&bar[XB_TMO], 1u); break; } }
  }
  nloc = mine > 0u ? mine : 1u; nx = cnt > 0u ? cnt : 1u;
}
__device__ __forceinline__ void xcd_barrier(const XcdBarrier& b) {
  asm volatile("s_waitcnt vmcnt(0)" ::: "memory");
  __syncthreads();
  if (threadIdx.x == 0) {
    unsigned* bar = b.bar;
    __builtin_amdgcn_s_waitcnt(0);
    unsigned nloc = b.st[0], nx = b.st[1];
    if (nloc == 0u) { xcd_barrier_complete(bar, b.x, nloc, nx); b.st[0] = nloc; b.st[1] = nx; }
    const unsigned old = xb_add(&bar[XB_XSUB(b.x)], 1u);
    const unsigned gen = old / nloc;
    if (old + 1u == (gen + 1u) * nloc) {
      __builtin_amdgcn_fence(__ATOMIC_RELEASE, "agent");
      asm volatile("s_waitcnt vmcnt(0)" ::: "memory");
      const unsigned og = xb_add(&bar[XB_TOP], 1u);
      const unsigned tg = og / nx;
      if (og + 1u == (tg + 1u) * nx) xb_add(&bar[XB_TOPGEN], 1u);
      else XB_SPIN(xb_ld(&bar[XB_TOPGEN]) == tg, bar);
      __builtin_amdgcn_fence(__ATOMIC_ACQUIRE, "agent");
      xb_add(&bar[XB_XGEN(b.x)], 1u);
      asm volatile("s_waitcnt vmcnt(0)" ::: "memory");
    } else {
      XB_SPIN(xb_ld(&bar[XB_XGEN(b.x)]) == gen, bar);
      __builtin_amdgcn_fence(__ATOMIC_ACQUIRE, "agent");
      asm volatile("s_waitcnt vmcnt(0)" ::: "memory");
    }
  }
  __syncthreads();
}

typedef const __attribute__((address_space(4))) P* KP;
__device__ __forceinline__ P loadP() {
#if defined(__HIP_DEVICE_COMPILE__)
  KP k = (KP)__builtin_amdgcn_kernarg_segment_ptr();
  asm volatile("" : "+s"(k));
  P p = *k;
  return p;
#else
  return P{};
#endif
}

__global__ void __launch_bounds__(256, 2) mega(P p_arg) {
  cg::grid_group grid = cg::this_grid();
  __shared__ __attribute__((aligned(16))) float smem[14336];
  char* lds = (char*)smem;
  __shared__ uint4 xb_words;
  if (threadIdx.x == 0) xb_words = make_uint4(0u, 0u, 0u, 0u);
  if (blockIdx.x == 0) {
    P p = loadP();
    for (int i = threadIdx.x; i < XCD_BAR_WORDS; i += 256) p.bar[i] = 0u;
  }
  { P p = loadP(); ph_rmsnorm(p.x, p.norm_mix, p.hn, T_TOK); ph_rmsnorm(p.mem, p.norm_mkv, p.memn, 1024); }
  { P p = loadP(); ph_transpose<true>(smem, p.w_in, DM, INC, 5760, p.WinT); }
  { P p = loadP(); ph_transpose<false>(smem, p.w_out, DM, DM, DM, p.WoutT); }
  { P p = loadP(); ph_transpose<false>(smem, p.w_pq, DM, DM, DM, p.WpqT); }
  { P p = loadP(); ph_transpose<false>(smem, p.w_mq, DM, 512, 512, p.WmqT); }
  { P p = loadP(); ph_transpose<false>(smem, p.w_mk, DM, 512, 512, p.WmkT); }
  { P p = loadP(); ph_transpose<false>(smem, p.w_mv, DM, 512, 512, p.WmvT); }
  { P p = loadP(); ph_transpose<false>(smem, p.w_mo, 512, DM, DM, p.WmoT); }
  { P p = loadP(); ph_cvt8(p.pu, p.pu8, p.su8, 16384); }
  { P p = loadP(); ph_cvt8(p.pv, p.pv8, p.sv8, 16384); }
  { P p = loadP(); ph_cvt(p.subk, p.subkb, (size_t)16 * 128 * 128); }
  { P p = loadP(); ph_transpose<false>(smem, p.w1_k, 4096, 128, 128, p.w1T); }
  { P p = loadP(); ph_transpose<false>(smem, p.w1_v, 4096, 128, 128, p.w1T + 128 * 4096); }
  { P p = loadP(); ph_transpose<false>(smem, p.w2_k, 128, 128, 128, p.w2T); }
  { P p = loadP(); ph_transpose<false>(smem, p.w2_v, 128, 128, 128, p.w2T + 128 * 128); }
  { P p = loadP(); ph_posb(p); }
  grid.sync();
  XcdBarrier xb;
  { P p = loadP(); xb = xcd_barrier_post(p.bar, (volatile LAS unsigned*)&xb_words); }
  { P p = loadP(); ph_proj(p, lds); }
  { P p = loadP(); bf16_t* kmem = p.kmemb;
    ph_gemm_bf16(p.memn, DM, p.WmkT, DM, 1024, 512, DM, lds, [=](int m, int n, float v) {
      kmem[((size_t)((m >> 8) * 4 + (n >> 7)) * 256 + (m & 255)) * 128 + (n & 127)] = f2bf(v); }); }
  { P p = loadP(); bf16_t* vmem = p.vmemT;
    ph_gemm_bf16(p.memn, DM, p.WmvT, DM, 1024, 512, DM, lds, [=](int m, int n, float v) {
      vmem[((size_t)((m >> 8) * 4 + (n >> 7)) * 128 + (n & 127)) * 256 + perm16(m & 255)] = f2bf(v); }); }
  xcd_barrier(xb);
  { P p = loadP(); ph_compress2(p, lds); }
  { P p = loadP(); ph_sb2(p, lds); }
  xcd_barrier(xb);
  { P p = loadP(); ph_nsa2(p, lds); }
  xcd_barrier(xb);
  { P p = loadP(); float* out = p.out; const float* x = p.x;
    ph_gemm_bf16(p.omix, DM, p.WoutT, DM, T_TOK, DM, DM, lds, [=](int m, int n, float v) { out[(size_t)m * DM + n] = x[(size_t)m * DM + n] + v; }); }
  xcd_barrier(xb);
  { P p = loadP(); ph_rmsnorm(p.out, p.norm_mq, p.hn, T_TOK); }
  xcd_barrier(xb);
  { P p = loadP(); bf16_t* qmem = p.qmemb;
    ph_gemm_bf16(p.hn, DM, p.WmqT, DM, T_TOK, 512, DM, lds, [=](int m, int n, float v) { qmem[(size_t)m * 512 + n] = f2bf(v); }); }
  xcd_barrier(xb);
  { P p = loadP(); ph_memattn2(p, lds); }
  xcd_barrier(xb);
  { P p = loadP(); float* out = p.out;
    ph_gemm_bf16(p.omem, 512, p.WmoT, 512, T_TOK, DM, 512, lds, [=](int m, int n, float v) { out[(size_t)m * DM + n] += v; }); }
  xcd_barrier(xb);
  { P p = loadP(); ph_rmsnorm(p.out, p.norm_ffn, p.hn, T_TOK); }
  xcd_barrier(xb);
  { P p = loadP(); bf16_t* qp = p.omix;
    ph_gemm_bf16(p.hn, DM, p.WpqT, DM, T_TOK, DM, DM, lds, [=](int m, int n, float v) { qp[(size_t)m * DM + n] = f2bf(v); }); }
  xcd_barrier(xb);
  { P p = loadP(); ph_scores(p, lds); }
  xcd_barrier(xb);
  { P p = loadP(); ph_peer(p, smem); }
}

extern "C" void kernel_launch(void* const* d_in, const int* in_sizes, int n_in, void* d_out, int out_size, void* d_ws,
                              size_t ws_size, hipStream_t stream) {
  P p{};
  p.x = (const float*)d_in[0]; p.mem = (const float*)d_in[1]; p.t5 = (const float*)d_in[2];
  p.norm_mix = (const float*)d_in[3]; p.w_in = (const float*)d_in[4]; p.pos_k = (const float*)d_in[5];
  p.w1_k = (const float*)d_in[6]; p.w2_k = (const float*)d_in[7]; p.pos_v = (const float*)d_in[8];
  p.w1_v = (const float*)d_in[9]; p.w2_v = (const float*)d_in[10]; p.w_out = (const float*)d_in[11];
  p.norm_mq = (const float*)d_in[12]; p.norm_mkv = (const float*)d_in[13]; p.w_mq = (const float*)d_in[14];
  p.w_mk = (const float*)d_in[15]; p.w_mv = (const float*)d_in[16]; p.w_mo = (const float*)d_in[17];
  p.norm_ffn = (const float*)d_in[18]; p.w_pq = (const float*)d_in[19]; p.subk = (const float*)d_in[20];
  p.pu = (const float*)d_in[21]; p.pv = (const float*)d_in[22]; p.norm_final = (const float*)d_in[23];
  p.out = (float*)d_out;
  char* w = (char*)d_ws;
  size_t off = 0;
  auto take = [&](size_t bytes) { char* r = w + off; off += (bytes + 255) & ~(size_t)255; return r; };
  p.bar = (unsigned*)take(XCD_BAR_WORDS * 4);
  p.scores = (float*)take((size_t)T_TOK * DM * 4);
  p.gates = (float*)take((size_t)T_TOK * 24 * 4);
  p.part = (float*)take((size_t)T_TOK * 1024 * 4);
  p.posb = (float*)take(256 * 4);
  p.qn = (bf16_t*)take((size_t)T_TOK * 1024 * 2);
  p.kcin = (bf16_t*)take((size_t)T_TOK * 256 * 2 + 65536);
  p.vcin = (bf16_t*)take((size_t)T_TOK * 256 * 2 + 65536);
  p.ks = (bf16_t*)take((size_t)T_TOK * 256 * 2);
  p.vsT = (bf16_t*)take((size_t)T_TOK * 256 * 2);
  p.kw = (bf16_t*)take((size_t)T_TOK * 256 * 2);
  p.vwT = (bf16_t*)take((size_t)T_TOK * 256 * 2);
  p.kcb = (bf16_t*)take((size_t)8 * 128 * 128 * 2);
  p.vcT = (bf16_t*)take((size_t)8 * 128 * 128 * 2);
  p.c1 = (bf16_t*)take((size_t)16 * 128 * 128 * 2);
  p.w1T = (bf16_t*)take((size_t)2 * 128 * 4096 * 2);
  p.w2T = (bf16_t*)take((size_t)2 * 128 * 128 * 2);
  p.hn = (bf16_t*)take((size_t)T_TOK * DM * 2);
  p.omix = (bf16_t*)take((size_t)T_TOK * DM * 2);
  p.memn = (bf16_t*)take((size_t)1024 * DM * 2);
  p.omem = (bf16_t*)take((size_t)T_TOK * 512 * 2);
  p.WinT = (bf16_t*)take((size_t)5760 * DM * 2);
  p.WoutT = (bf16_t*)take((size_t)DM * DM * 2);
  p.WpqT = (bf16_t*)take((size_t)DM * DM * 2);
  p.WmqT = (bf16_t*)take((size_t)512 * DM * 2);
  p.WmkT = (bf16_t*)take((size_t)512 * DM * 2);
  p.WmvT = (bf16_t*)take((size_t)512 * DM * 2);
  p.WmoT = (bf16_t*)take((size_t)DM * 512 * 2);
  p.qmemb = (bf16_t*)take((size_t)T_TOK * 512 * 2);
  p.kmemb = (bf16_t*)take((size_t)1024 * 512 * 2);
  p.vmemT = (bf16_t*)take((size_t)1024 * 512 * 2);
  p.qsb = (bf16_t*)take((size_t)T_TOK * 1024 * 2);
  p.ksb = (bf16_t*)take((size_t)T_TOK * 1024 * 2);
  p.vsbT = (bf16_t*)take((size_t)T_TOK * 1024 * 2);
  p.pu8 = (unsigned char*)take((size_t)16384 * DM);
  p.pv8 = (unsigned char*)take((size_t)16384 * DM);
  p.su8 = (float*)take(16384 * 4);
  p.sv8 = (float*)take(16384 * 4);
  p.subkb = (bf16_t*)take((size_t)16 * 128 * 128 * 2);
  static int grid_blocks = 0;
  if (!grid_blocks) {
    int dev = 0, cus = 0, per_cu = 0;
    (void)hipGetDevice(&dev);
    (void)hipDeviceGetAttribute(&cus, hipDeviceAttributeMultiprocessorCount, dev);
    (void)hipOccupancyMaxActiveBlocksPerMultiprocessor(&per_cu, mega, 256, 0);
    if (per_cu > 2) per_cu = 2;
    if (per_cu < 1) per_cu = 1;
    grid_blocks = cus * per_cu;
  }
  void* args[] = {&p};
  hipError_t e = hipLaunchCooperativeKernel((void*)mega, dim3(grid_blocks), dim3(256), args, 0, stream);
  if (e != hipSuccess) fprintf(stderr, "cooperative launch failed: %s (grid %d)\n", hipGetErrorString(e), grid_blocks);
}
```

```cpp
#include <hip/hip_runtime.h>
#include <hip/hip_cooperative_groups.h>
#include <cstdio>
namespace cg = cooperative_groups;
#include <stdint.h>

#define SEQ 2048
#define NBATCH 4
#define T_TOK 8192
#define DM 2048
#define INC 5656
#define C_QN 0
#define C_KC 1024
#define C_VC 1280
#define C_KS 1536
#define C_VS 1792
#define C_KW 2048
#define C_VW 2304
#define C_GT 2560
#define C_QSB 2584
#define C_KSB 3608
#define C_VSB 4632
#define ATT_SCALE 0.08838834764831845f
#define RMS_EPS 1e-6f

typedef unsigned short bf16_t;
typedef __attribute__((ext_vector_type(8))) short bf16x8;
typedef __attribute__((ext_vector_type(16))) float f32x16;
typedef __attribute__((ext_vector_type(2))) __bf16 bf16v2;
typedef __attribute__((ext_vector_type(4))) unsigned u32x4;

struct P {
  const float *x, *mem, *t5, *norm_mix, *w_in, *pos_k, *w1_k, *w2_k, *pos_v, *w1_v, *w2_v, *w_out,
      *norm_mq, *norm_mkv, *w_mq, *w_mk, *w_mv, *w_mo, *norm_ffn, *w_pq, *subk, *pu, *pv, *norm_final;
  float* out;
  float *scores, *gates, *part, *posb;
  unsigned* bar;
  bf16_t *hn, *omix, *memn, *omem;
  bf16_t *WinT, *WoutT, *WpqT, *WmqT, *WmkT, *WmvT, *WmoT;
  bf16_t *qmemb, *kmemb, *vmemT;
  bf16_t *qsb, *ksb, *vsbT;
  bf16_t* subkb;
  unsigned char *pu8, *pv8;
  float *su8, *sv8;
  bf16_t *qn, *kcin, *vcin, *ks, *vsT, *kw, *vwT, *kcb, *vcT, *c1, *w1T, *w2T;
};

__device__ __forceinline__ int opq(int v) { asm volatile("" : "+v"(v)); return v; }
__device__ __forceinline__ unsigned pack2(float a, float b) {
  bf16v2 r = {(__bf16)a, (__bf16)b};
  return *(unsigned*)&r;
}
__device__ __forceinline__ bf16_t f2bf(float a) {
  __bf16 r = (__bf16)a;
  return *(bf16_t*)&r;
}
__device__ __forceinline__ int perm16(int s) { return (s & ~12) | ((s & 4) << 1) | ((s & 8) >> 1); }
__device__ __forceinline__ float bf2f(bf16_t u) { return __uint_as_float((unsigned)u << 16); }

__device__ __forceinline__ float wave_max(float v) {
  for (int o = 32; o > 0; o >>= 1) v = fmaxf(v, __shfl_xor(v, o));
  return v;
}
__device__ __forceinline__ float wave_sum(float v) {
  for (int o = 32; o > 0; o >>= 1) v += __shfl_xor(v, o);
  return v;
}
__device__ __forceinline__ void wave_argmax(float& v, int& i) {
  for (int o = 32; o > 0; o >>= 1) {
    float ov = __shfl_xor(v, o);
    int oi = __shfl_xor(i, o);
    if (ov > v || (ov == v && oi < i)) { v = ov; i = oi; }
  }
}
__device__ __forceinline__ float gelu_tanh(float x) {
  return 0.5f * x * (1.f + tanhf(0.7978845608028654f * (x + 0.044715f * x * x * x)));
}
__device__ __forceinline__ float gelu_fast(float x) {
  const float y = 1.5957691216057308f * (x + 0.044715f * x * x * x);
  return x / (1.f + __expf(-y));
}
__device__ __forceinline__ int t5_bucket(int n) {
  if (n < 16) return n < 0 ? 0 : n;
  int b = 16;
  b += (n >= 19); b += (n >= 21); b += (n >= 24); b += (n >= 27); b += (n >= 31); b += (n >= 35);
  b += (n >= 40); b += (n >= 46); b += (n >= 52); b += (n >= 59); b += (n >= 67); b += (n >= 77);
  b += (n >= 87); b += (n >= 99); b += (n >= 113);
  return b;
}
__device__ __forceinline__ float log_sigmoid(float x) {
  return fminf(x, 0.f) - log1pf(expf(-fabsf(x)));
}

__device__ __forceinline__ void ph_rmsnorm(const float* src, const float* gain, bf16_t* dst, int rows) {
  int lane = opq(threadIdx.x) & 63, wv = opq(threadIdx.x) >> 6;
  for (int r = blockIdx.x * 4 + wv; r < rows; r += gridDim.x * 4) {
    const float4* s4 = (const float4*)(src + (size_t)r * DM);
    float4 v[8];
    float ss = 0.f;
#pragma unroll
    for (int i = 0; i < 8; ++i) {
      v[i] = s4[i * 64 + lane];
      ss += v[i].x * v[i].x + v[i].y * v[i].y + v[i].z * v[i].z + v[i].w * v[i].w;
    }
    ss = wave_sum(ss);
    float rs = rsqrtf(ss * (1.f / DM) + RMS_EPS);
    uint2* d2 = (uint2*)(dst + (size_t)r * DM);
    const float4* g4 = (const float4*)gain;
#pragma unroll
    for (int i = 0; i < 8; ++i) {
      float4 g = g4[i * 64 + lane];
      uint2 o;
      o.x = pack2(v[i].x * rs * g.x, v[i].y * rs * g.y);
      o.y = pack2(v[i].z * rs * g.z, v[i].w * rs * g.w);
      d2[i * 64 + lane] = o;
    }
  }
}

template <bool CMAP>
__device__ __forceinline__ void ph_transpose(float* smem, const float* W, int K, int N, int Npad, bf16_t* Wt) {
  float (*tl)[65] = (float (*)[65])smem;
  int tid = opq(threadIdx.x);
  int nk = K / 64, nn = Npad / 64;
  for (int tile = blockIdx.x; tile < nk * nn; tile += gridDim.x) {
    int k0 = (tile % nk) * 64, n0 = (tile / nk) * 64;
    int col = tid & 63, rb = tid >> 6;
#pragma unroll 4
    for (int pp = 0; pp < 16; ++pp) {
      int k = pp * 4 + rb;
      float v = 0.f;
      int sc = n0 + col;
      if (CMAP) sc = (sc < 2560) ? sc : (sc < 5632) ? sc + 24 : (sc < 5656) ? sc - 5632 + 2560 : N;
      if (sc < N) v = W[(size_t)(k0 + k) * N + sc];
      tl[k][col] = v;
    }
    __syncthreads();
    int n = tid >> 2, kc = (tid & 3) * 16;
    unsigned w[8];
#pragma unroll
    for (int i = 0; i < 8; ++i) w[i] = pack2(tl[kc + 2 * i][n], tl[kc + 2 * i + 1][n]);
    uint4* dst = (uint4*)(Wt + (size_t)(n0 + n) * K + k0 + kc);
    dst[0] = make_uint4(w[0], w[1], w[2], w[3]);
    dst[1] = make_uint4(w[4], w[5], w[6], w[7]);
    __syncthreads();
  }
}

__device__ __forceinline__ int lds_off(int row, int chunk) { return row * 128 + ((chunk ^ ((row >> 1) & 7)) << 4); }

template <bool TR, class Epi>
__device__ __forceinline__ void gemm_tile_bf16(const bf16_t* xp, int ldx, const bf16_t* yp, int ldy, int K, char* lds,
                                               Epi epi) {
  const int tid = opq(threadIdx.x), lane = tid & 63, wv = tid >> 6;
  const int wr = wv >> 1, wc = wv & 1;
  char* lx = lds;
  char* ly = lds + 16384;
  f32x16 acc[2][2];
#pragma unroll
  for (int i = 0; i < 2; ++i)
#pragma unroll
    for (int j = 0; j < 2; ++j)
#pragma unroll
      for (int r = 0; r < 16; ++r) acc[i][j][r] = 0.f;
  const int srow = tid >> 3, sch = tid & 7;
  const bf16_t* xg = xp + (size_t)srow * ldx + sch * 8;
  const bf16_t* yg = yp + (size_t)srow * ldy + sch * 8;
  const size_t x32 = (size_t)32 * ldx, y32 = (size_t)32 * ldy;
  uint4 sx0 = *(const uint4*)(xg), sx1 = *(const uint4*)(xg + x32), sx2 = *(const uint4*)(xg + 2 * x32),
        sx3 = *(const uint4*)(xg + 3 * x32);
  uint4 sy0 = *(const uint4*)(yg), sy1 = *(const uint4*)(yg + y32), sy2 = *(const uint4*)(yg + 2 * y32),
        sy3 = *(const uint4*)(yg + 3 * y32);
  const int so0 = lds_off(srow, sch), so1 = lds_off(32 + srow, sch), so2 = lds_off(64 + srow, sch),
            so3 = lds_off(96 + srow, sch);
  for (int k0 = 0; k0 < K; k0 += 64) {
    __syncthreads();
    *(uint4*)(lx + so0) = sx0; *(uint4*)(lx + so1) = sx1; *(uint4*)(lx + so2) = sx2; *(uint4*)(lx + so3) = sx3;
    *(uint4*)(ly + so0) = sy0; *(uint4*)(ly + so1) = sy1; *(uint4*)(ly + so2) = sy2; *(uint4*)(ly + so3) = sy3;
    __syncthreads();
    if (k0 + 64 < K) {
      const bf16_t* xn = xg + k0 + 64;
      const bf16_t* yn = yg + k0 + 64;
      sx0 = *(const uint4*)(xn); sx1 = *(const uint4*)(xn + x32); sx2 = *(const uint4*)(xn + 2 * x32);
      sx3 = *(const uint4*)(xn + 3 * x32);
      sy0 = *(const uint4*)(yn); sy1 = *(const uint4*)(yn + y32); sy2 = *(const uint4*)(yn + 2 * y32);
      sy3 = *(const uint4*)(yn + 3 * y32);
    }
#pragma unroll
    for (int kk = 0; kk < 4; ++kk) {
      bf16x8 a[2], b[2];
      const int ch = kk * 2 + (lane >> 5);
#pragma unroll
      for (int i = 0; i < 2; ++i) {
        a[i] = *(const bf16x8*)((TR ? ly : lx) + lds_off(wr * 64 + i * 32 + (lane & 31), ch));
        b[i] = *(const bf16x8*)((TR ? lx : ly) + lds_off(wc * 64 + i * 32 + (lane & 31), ch));
      }
#pragma unroll
      for (int i = 0; i < 2; ++i)
#pragma unroll
        for (int j = 0; j < 2; ++j) acc[i][j] = __builtin_amdgcn_mfma_f32_32x32x16_bf16(a[i], b[j], acc[i][j], 0, 0, 0);
    }
  }
  int lane2 = lane;
  asm volatile("" : "+v"(lane2));
#pragma unroll
  for (int i = 0; i < 2; ++i)
#pragma unroll
    for (int j = 0; j < 2; ++j)
#pragma unroll
      for (int r = 0; r < 16; ++r) {
        int rr = wr * 64 + i * 32 + (r & 3) + 8 * (r >> 2) + 4 * (lane2 >> 5);
        int cc = wc * 64 + j * 32 + (lane2 & 31);
        epi(rr, cc, acc[i][j][r]);
      }
}

template <class Epi>
__device__ __forceinline__ void ph_gemm_bf16(const bf16_t* A, int lda, const bf16_t* Wt, int ldw, int M, int N, int K,
                                             char* lds, Epi epi) {
  const int ntm = M / 128, ntn = N / 128;
  const int npm = (ntm + 7) / 8, npn = (ntn + 7) / 8;
  const int nslots = ((npm * npn * 64 + 511) / 512) * 512;
  for (int u = blockIdx.x; u < nslots; u += gridDim.x) {
    int v = (u & 7) * 64 + ((u >> 3) & 63) + (u & ~511);
    int patch = v >> 6, w = v & 63;
    int tm = (patch % npm) * 8 + (w & 7);
    int tn = (patch / npm) * 8 + (w >> 3);
    if (tm >= ntm || tn >= ntn) continue;
    const int m0 = tm * 128, n0 = tn * 128;
    gemm_tile_bf16<false>(A + (size_t)m0 * lda, lda, Wt + (size_t)n0 * ldw, ldw, K, lds,
                          [&](int r, int c, float val) { epi(m0 + r, n0 + c, val); });
  }
}

__device__ __forceinline__ void ph_proj(const P& p, char* lds) {
  const int ntm = T_TOK / 128, ntn = 5760 / 128;
  const int npm = (ntm + 7) / 8, npn = (ntn + 7) / 8;
  const int nslots = ((npm * npn * 64 + 511) / 512) * 512;
  for (int u = blockIdx.x; u < nslots; u += gridDim.x) {
    int v = (u & 7) * 64 + ((u >> 3) & 63) + (u & ~511);
    int patch = v >> 6, w = v & 63;
    int tm = (patch % npm) * 8 + (w & 7);
    int tn = (patch / npm) * 8 + (w >> 3);
    if (tm >= ntm || tn >= ntn) continue;
    const int m0 = tm * 128, n0 = tn * 128;
    const int b = m0 >> 11, sl = m0 & 2047;
    const bf16_t* A = p.hn + (size_t)m0 * DM;
    const bf16_t* W = p.WinT + (size_t)n0 * DM;
    if (n0 < 1024) {
      bf16_t* q = p.qn + (size_t)m0 * 1024 + n0;
      gemm_tile_bf16<false>(A, DM, W, DM, DM, lds, [&](int r, int c, float val) { q[(size_t)r * 1024 + c] = f2bf(val); });
    } else if (n0 < 2560) {
      const int seg = (n0 - 1024) >> 8, g = ((n0 - 1024) >> 7) & 1;
      if (seg == 3 || seg == 5) {
        bf16_t* vd = (seg == 3 ? p.vsT : p.vwT) + ((size_t)(b * 2 + g) * 128) * SEQ + sl;
        gemm_tile_bf16<true>(A, DM, W, DM, DM, lds, [&](int r, int c, float val) { vd[(size_t)r * SEQ + perm16(c)] = f2bf(val); });
      } else {
        bf16_t* base = (seg == 0) ? p.kcin : (seg == 1) ? p.vcin : (seg == 2) ? p.ks : p.kw;
        bf16_t* kd = base + ((size_t)(b * 2 + g) * SEQ + sl) * 128;
        gemm_tile_bf16<false>(A, DM, W, DM, DM, lds, [&](int r, int c, float val) { kd[(size_t)r * 128 + c] = f2bf(val); });
      }
    } else if (n0 < 3584) {
      bf16_t* q = p.qsb + (size_t)m0 * 1024 + (n0 - 2560);
      gemm_tile_bf16<false>(A, DM, W, DM, DM, lds, [&](int r, int c, float val) { q[(size_t)r * 1024 + c] = f2bf(val); });
    } else if (n0 < 4608) {
      bf16_t* kd = p.ksb + ((size_t)(b * 8 + ((n0 - 3584) >> 7)) * SEQ + sl) * 128;
      gemm_tile_bf16<false>(A, DM, W, DM, DM, lds, [&](int r, int c, float val) { kd[(size_t)r * 128 + c] = f2bf(val); });
    } else if (n0 < 5632) {
      bf16_t* vd = p.vsbT + ((size_t)(b * 8 + ((n0 - 4608) >> 7)) * 128) * SEQ + sl;
      gemm_tile_bf16<true>(A, DM, W, DM, DM, lds, [&](int r, int c, float val) { vd[(size_t)r * SEQ + perm16(c)] = f2bf(val); });
    } else {
      float* gd = p.gates + (size_t)m0 * 24;
      gemm_tile_bf16<false>(A, DM, W, DM, DM, lds, [&](int r, int c, float val) { if (c < 24) gd[(size_t)r * 24 + c] = val; });
    }
  }
}

__device__ __forceinline__ void ph_posb(const P& p) {
  const int lane = opq(threadIdx.x) & 63, wv = opq(threadIdx.x) >> 6;
  for (int o = blockIdx.x * 4 + wv; o < 256; o += gridDim.x * 4) {
    const int which = o >> 7, n = o & 127;
    const float* pos = which ? p.pos_v : p.pos_k;
    const float* w1 = which ? p.w1_v : p.w1_k;
    float acc = 0.f;
    for (int k = lane; k < 4096; k += 64) acc += pos[k] * w1[(size_t)k * 128 + n];
    acc = wave_sum(acc);
    if (lane == 0) p.posb[o] = acc;
  }
}

__device__ __forceinline__ void ph_compress2(const P& p, char* lds) {
  for (int item = blockIdx.x; item < 16; item += gridDim.x) {
    const int which = item >> 3, bg = item & 7;
    const bf16_t* src = (which ? p.vcin : p.kcin) + (size_t)bg * SEQ * 128;
    const bf16_t* w1t = p.w1T + (size_t)which * 128 * 4096;
    const bf16_t* w2t = p.w2T + (size_t)which * 128 * 128;
    const float* posb = p.posb + which * 128;
    bf16_t* c1 = p.c1 + (size_t)item * 128 * 128;
    gemm_tile_bf16<false>(src, 2048, w1t, 4096, 4096, lds, [&](int r, int c, float val) {
      c1[r * 128 + c] = f2bf(gelu_fast(val + posb[c])); });
    __threadfence_block();
    __syncthreads();
    if (which == 0) {
      bf16_t* kd = p.kcb + (size_t)bg * 128 * 128;
      gemm_tile_bf16<false>(c1, 128, w2t, 128, 128, lds, [&](int r, int c, float val) { kd[r * 128 + c] = f2bf(val); });
    } else {
      bf16_t* vd = p.vcT + (size_t)bg * 128 * 128;
      gemm_tile_bf16<true>(c1, 128, w2t, 128, 128, lds, [&](int r, int c, float val) { vd[r * 128 + perm16(c)] = f2bf(val); });
    }
  }
}

#define NEG_BIG (-1e30f)

struct KVRegs { u32x4 k0, k1, k2, k3, v0, v1, v2, v3; };

__device__ __forceinline__ int koff(int row, int chunk) { return row * 256 + ((chunk ^ (row & 15)) << 4); }

__device__ __forceinline__ void kv_load(KVRegs& r, const bf16_t* kp, int ldk, const bf16_t* vp, int ldv) {
  const int tid = opq(threadIdx.x);
  const bf16_t* kg = kp + (size_t)(tid >> 4) * ldk + (tid & 15) * 8;
  r.k0 = *(const u32x4*)kg;
  r.k1 = *(const u32x4*)(kg + (size_t)16 * ldk);
  r.k2 = *(const u32x4*)(kg + (size_t)32 * ldk);
  r.k3 = *(const u32x4*)(kg + (size_t)48 * ldk);
  const bf16_t* vg = vp + (size_t)(tid >> 3) * ldv + (tid & 7) * 8;
  r.v0 = *(const u32x4*)vg;
  r.v1 = *(const u32x4*)(vg + (size_t)32 * ldv);
  r.v2 = *(const u32x4*)(vg + (size_t)64 * ldv);
  r.v3 = *(const u32x4*)(vg + (size_t)96 * ldv);
}
__device__ __forceinline__ void kv_store(const KVRegs& r, char* lk, char* lv) {
  const int tid = opq(threadIdx.x);
  const int row = tid >> 4, ch = tid & 15;
  *(u32x4*)(lk + koff(row, ch)) = r.k0;
  *(u32x4*)(lk + koff(row + 16, ch)) = r.k1;
  *(u32x4*)(lk + koff(row + 32, ch)) = r.k2;
  *(u32x4*)(lk + koff(row + 48, ch)) = r.k3;
  const int vr = tid >> 3, vc = tid & 7;
  *(u32x4*)(lv + lds_off(vr, vc)) = r.v0;
  *(u32x4*)(lv + lds_off(vr + 32, vc)) = r.v1;
  *(u32x4*)(lv + lds_off(vr + 64, vc)) = r.v2;
  *(u32x4*)(lv + lds_off(vr + 96, vc)) = r.v3;
}

struct QFrag { bf16x8 f0, f1, f2, f3, f4, f5, f6, f7; };
__device__ __forceinline__ void q_load(QFrag& q, const bf16_t* qrow) {
  const int h = (opq(threadIdx.x) & 63) >> 5;
  const bf16x8* p8 = (const bf16x8*)(qrow + 8 * h);
  q.f0 = p8[0]; q.f1 = p8[2]; q.f2 = p8[4]; q.f3 = p8[6]; q.f4 = p8[8]; q.f5 = p8[10]; q.f6 = p8[12]; q.f7 = p8[14];
}

__device__ __forceinline__ void qk_tile(const QFrag& q, const char* lk, f32x16& s0, f32x16& s1) {
  const int lane = opq(threadIdx.x) & 63, row = lane & 31, h = lane >> 5;
#pragma unroll
  for (int r = 0; r < 16; ++r) { s0[r] = 0.f; s1[r] = 0.f; }
#define QK_STEP(kk, qf)                                                                  \
  {                                                                                      \
    bf16x8 a0 = *(const bf16x8*)(lk + koff(row, 2 * (kk) + h));                          \
    bf16x8 a1 = *(const bf16x8*)(lk + koff(row + 32, 2 * (kk) + h));                     \
    s0 = __builtin_amdgcn_mfma_f32_32x32x16_bf16(a0, qf, s0, 0, 0, 0);                   \
    s1 = __builtin_amdgcn_mfma_f32_32x32x16_bf16(a1, qf, s1, 0, 0, 0);                   \
  }
  QK_STEP(0, q.f0) QK_STEP(1, q.f1) QK_STEP(2, q.f2) QK_STEP(3, q.f3)
  QK_STEP(4, q.f4) QK_STEP(5, q.f5) QK_STEP(6, q.f6) QK_STEP(7, q.f7)
#undef QK_STEP
}

__device__ __forceinline__ bf16x8 pack8(const f32x16& p, const int base) {
  u32x4 u;
  u[0] = pack2(p[base + 0], p[base + 1]);
  u[1] = pack2(p[base + 2], p[base + 3]);
  u[2] = pack2(p[base + 4], p[base + 5]);
  u[3] = pack2(p[base + 6], p[base + 7]);
  return __builtin_bit_cast(bf16x8, u);
}

struct OAcc { f32x16 o0, o1, o2, o3; };
__device__ __forceinline__ void oacc_zero(OAcc& o) {
#pragma unroll
  for (int r = 0; r < 16; ++r) { o.o0[r] = 0.f; o.o1[r] = 0.f; o.o2[r] = 0.f; o.o3[r] = 0.f; }
}
__device__ __forceinline__ void oacc_scale(OAcc& o, float a) {
#pragma unroll
  for (int r = 0; r < 16; ++r) { o.o0[r] *= a; o.o1[r] *= a; o.o2[r] *= a; o.o3[r] *= a; }
}

__device__ __forceinline__ void pv_tile(OAcc& o, const char* lv, const f32x16& p0, const f32x16& p1) {
  const int lane = opq(threadIdx.x) & 63, row = lane & 31, h = lane >> 5;
  const bf16x8 pf0 = pack8(p0, 0), pf1 = pack8(p0, 8), pf2 = pack8(p1, 0), pf3 = pack8(p1, 8);
#define PV_ROW(dd, acc)                                                                                      \
  {                                                                                                          \
    acc = __builtin_amdgcn_mfma_f32_32x32x16_bf16(*(const bf16x8*)(lv + lds_off(32 * (dd) + row, 0 + h)), pf0, acc, 0, 0, 0); \
    acc = __builtin_amdgcn_mfma_f32_32x32x16_bf16(*(const bf16x8*)(lv + lds_off(32 * (dd) + row, 2 + h)), pf1, acc, 0, 0, 0); \
    acc = __builtin_amdgcn_mfma_f32_32x32x16_bf16(*(const bf16x8*)(lv + lds_off(32 * (dd) + row, 4 + h)), pf2, acc, 0, 0, 0); \
    acc = __builtin_amdgcn_mfma_f32_32x32x16_bf16(*(const bf16x8*)(lv + lds_off(32 * (dd) + row, 6 + h)), pf3, acc, 0, 0, 0); \
  }
  PV_ROW(0, o.o0) PV_ROW(1, o.o1) PV_ROW(2, o.o2) PV_ROW(3, o.o3)
#undef PV_ROW
}

__device__ __forceinline__ void softmax_tile(f32x16& s0, f32x16& s1, float& m, float& l, OAcc& o) {
  float mx = NEG_BIG;
#pragma unroll
  for (int r = 0; r < 16; ++r) mx = fmaxf(mx, fmaxf(s0[r], s1[r]));
  mx = fmaxf(mx, __shfl_xor(mx, 32));
  const float mn = fmaxf(m, mx);
  const float alpha = __expf(m - mn);
  float ls = 0.f;
#pragma unroll
  for (int r = 0; r < 16; ++r) {
    float a = (s0[r] > -1e29f) ? __expf(s0[r] - mn) : 0.f;
    float b = (s1[r] > -1e29f) ? __expf(s1[r] - mn) : 0.f;
    s0[r] = a; s1[r] = b;
    ls += a + b;
  }
  ls += __shfl_xor(ls, 32);
  l = l * alpha + ls;
  m = mn;
  if (__any(alpha != 1.f)) oacc_scale(o, alpha);
}

template <class F>
__device__ __forceinline__ void oacc_foreach(const OAcc& o, F f) {
  const int h = (opq(threadIdx.x) & 63) >> 5;
#pragma unroll
  for (int rho = 0; rho < 4; ++rho) {
    f(0 + 8 * rho + 4 * h, o.o0[4 * rho], o.o0[4 * rho + 1], o.o0[4 * rho + 2], o.o0[4 * rho + 3]);
    f(32 + 8 * rho + 4 * h, o.o1[4 * rho], o.o1[4 * rho + 1], o.o1[4 * rho + 2], o.o1[4 * rho + 3]);
    f(64 + 8 * rho + 4 * h, o.o2[4 * rho], o.o2[4 * rho + 1], o.o2[4 * rho + 2], o.o2[4 * rho + 3]);
    f(96 + 8 * rho + 4 * h, o.o3[4 * rho], o.o3[4 * rho + 1], o.o3[4 * rho + 2], o.o3[4 * rho + 3]);
  }
}

__device__ __forceinline__ void ph_memattn2(const P& p, char* lds) {
  char* lk = lds;
  char* lv = lds + 16384;
  const int lane = opq(threadIdx.x) & 63, wv = opq(threadIdx.x) >> 6;
  for (int item = blockIdx.x; item < NBATCH * 4 * (SEQ / 128); item += gridDim.x) {
    const int tb = item % (SEQ / 128);
    const int bh = item / (SEQ / 128);
    const int b = bh >> 2, hd = bh & 3;
    const int t = tb * 128 + wv * 32 + (lane & 31);
    QFrag q;
    q_load(q, p.qmemb + (size_t)(b * SEQ + t) * 512 + hd * 128);
    const bf16_t* kb = p.kmemb + (size_t)bh * 256 * 128;
    const bf16_t* vb = p.vmemT + (size_t)bh * 128 * 256;
    OAcc o;
    oacc_zero(o);
    float m = NEG_BIG, l = 0.f;
    KVRegs kv;
    kv_load(kv, kb, 128, vb, 256);
#pragma unroll 1
    for (int ti = 0; ti < 4; ++ti) {
      __syncthreads();
      kv_store(kv, lk, lv);
      __syncthreads();
      {
        const int tn = (ti + 1 < 4) ? ti + 1 : 3;
        kv_load(kv, kb + (size_t)tn * 64 * 128, 128, vb + tn * 64, 256);
      }
      f32x16 s0, s1;
      qk_tile(q, lk, s0, s1);
#pragma unroll
      for (int r = 0; r < 16; ++r) { s0[r] *= ATT_SCALE; s1[r] *= ATT_SCALE; }
      softmax_tile(s0, s1, m, l, o);
      pv_tile(o, lv, s0, s1);
    }
    const float il = 1.f / l;
    const int t2 = tb * 128 + (opq(threadIdx.x) >> 6) * 32 + (opq(threadIdx.x) & 31);
    bf16_t* orow = p.omem + (size_t)(b * SEQ + t2) * 512 + hd * 128;
    oacc_foreach(o, [&](int d, float v0, float v1, float v2, float v3) {
      uint2 u;
      u.x = pack2(v0 * il, v1 * il);
      u.y = pack2(v2 * il, v3 * il);
      *(uint2*)(orow + d) = u;
    });
  }
}

__device__ __forceinline__ void ph_sb2(const P& p, char* lds) {
  char* lk = lds;
  char* lv = lds + 16384;
  const int lane = opq(threadIdx.x) & 63, wv = opq(threadIdx.x) >> 6, hh = lane >> 5;
  for (int item = blockIdx.x; item < NBATCH * 8 * (SEQ / 128); item += gridDim.x) {
    const int tb = (SEQ / 128 - 1) - (item % (SEQ / 128));
    const int bh = item / (SEQ / 128);
    const int b = bh >> 3, hd = bh & 7;
    const int t0 = tb * 128;
    const int t = t0 + wv * 32 + (lane & 31);
    QFrag q;
    q_load(q, p.qsb + (size_t)(b * SEQ + t) * 1024 + hd * 128);
    const bf16_t* kb = p.ksb + (size_t)bh * SEQ * 128;
    const bf16_t* vb = p.vsbT + (size_t)bh * 128 * SEQ;
    OAcc o;
    oacc_zero(o);
    float carry = 0.f;
    const int jhi = (t0 >> 6) + 1;
    const int jw = (t0 + wv * 32 + 30) >> 6;
    KVRegs kv;
    kv_load(kv, kb + (size_t)jhi * 64 * 128, 128, vb + jhi * 64, SEQ);
    volatile unsigned* dflag = (volatile unsigned*)(lds + 32768);
    __syncthreads();
    if (opq(threadIdx.x) < 4) dflag[opq(threadIdx.x)] = 0u;
    for (int j = jhi; j >= 0; --j) {
      __syncthreads();
      if ((dflag[0] & dflag[1] & dflag[2] & dflag[3]) != 0u) break;
      kv_store(kv, lk, lv);
      __syncthreads();
      const int jn = (j > 0) ? j - 1 : 0;
      if (j > jw) kv_load(kv, kb + (size_t)jn * 64 * 128, 128, vb + jn * 64, SEQ);
      if (j <= jw) {
        f32x16 z0, z1;
        qk_tile(q, lk, z0, z1);
        const int sbase = j * 64 + 4 * hh;
        float gt[8];
        f32x16 l0, l1;
#pragma unroll
        for (int r = 0; r < 16; ++r) {
          const int so = sbase + 8 * (r >> 2) + (r & 3);
          {
            const float z = z0[r] * ATT_SCALE;
            const bool valid = so < t;
            const float lsp = fminf(z, 0.f) - __logf(1.f + __expf(-fabsf(z)));
            l0[r] = valid ? (lsp - z) : 0.f;
            z0[r] = valid ? z : NEG_BIG;
          }
          {
            const float z = z1[r] * ATT_SCALE;
            const bool valid = so + 32 < t;
            const float lsp = fminf(z, 0.f) - __logf(1.f + __expf(-fabsf(z)));
            l1[r] = valid ? (lsp - z) : 0.f;
            z1[r] = valid ? z : NEG_BIG;
          }
        }
#pragma unroll
        for (int rho = 0; rho < 4; ++rho) {
          gt[rho] = (l0[4 * rho] + l0[4 * rho + 1]) + (l0[4 * rho + 2] + l0[4 * rho + 3]);
          gt[4 + rho] = (l1[4 * rho] + l1[4 * rho + 1]) + (l1[4 * rho + 2] + l1[4 * rho + 3]);
        }
        float ag[8];
        float run = 0.f;
#pragma unroll
        for (int k = 7; k >= 0; --k) {
          const float pg = __shfl_xor(gt[k], 32);
          ag[k] = carry + run + (hh == 0 ? pg : 0.f);
          run += gt[k] + pg;
        }
        carry += run;
#pragma unroll
        for (int rho = 0; rho < 4; ++rho) {
          {
            const float x3 = l0[4 * rho + 3], x23 = x3 + l0[4 * rho + 2], x123 = x23 + l0[4 * rho + 1];
            const float g = ag[rho];
            z0[4 * rho + 0] = __expf((l0[4 * rho + 0] + z0[4 * rho + 0]) + (g + x123));
            z0[4 * rho + 1] = __expf((l0[4 * rho + 1] + z0[4 * rho + 1]) + (g + x23));
            z0[4 * rho + 2] = __expf((l0[4 * rho + 2] + z0[4 * rho + 2]) + (g + x3));
            z0[4 * rho + 3] = __expf((l0[4 * rho + 3] + z0[4 * rho + 3]) + g);
          }
          {
            const float x3 = l1[4 * rho + 3], x23 = x3 + l1[4 * rho + 2], x123 = x23 + l1[4 * rho + 1];
            const float g = ag[4 + rho];
            z1[4 * rho + 0] = __expf((l1[4 * rho + 0] + z1[4 * rho + 0]) + (g + x123));
            z1[4 * rho + 1] = __expf((l1[4 * rho + 1] + z1[4 * rho + 1]) + (g + x23));
            z1[4 * rho + 2] = __expf((l1[4 * rho + 2] + z1[4 * rho + 2]) + (g + x3));
            z1[4 * rho + 3] = __expf((l1[4 * rho + 3] + z1[4 * rho + 3]) + g);
          }
        }
        kv_load(kv, kb + (size_t)jn * 64 * 128, 128, vb + jn * 64, SEQ);
        pv_tile(o, lv, z0, z1);
        if (__all(carry < -104.f) && (opq(threadIdx.x) & 63) == 0) dflag[wv] = 1u;
      }
    }
    int t2 = t;
    asm volatile("" : "+v"(t2));
    bf16_t* orow = p.omix + (size_t)(b * SEQ + t2) * DM + 1024 + hd * 128;
    oacc_foreach(o, [&](int d, float v0, float v1, float v2, float v3) {
      uint2 u;
      u.x = pack2(v0, v1);
      u.y = pack2(v2, v3);
      *(uint2*)(orow + d) = u;
    });
  }
}

#define NSA_IMP 32768
#define NSA_KEYS 49152
#define NSA_SELM 53504
#define NSA_LUT 53632
__device__ __forceinline__ void ph_nsa2(const P& p, char* lds) {
  typedef __attribute__((ext_vector_type(4))) float f32x4;
  char* lk = lds;
  char* lv = lds + 16384;
  float* imp = (float*)(lds + NSA_IMP);
  float* keys = (float*)(lds + NSA_KEYS);
  unsigned* selm = (unsigned*)(lds + NSA_SELM);
  const int tid = opq(threadIdx.x), lane = tid & 63, wv = tid >> 6, hh = lane >> 5, ql = lane & 31;
  float* lut = (float*)(lds + NSA_LUT) + wv * 128;
  for (int item = blockIdx.x; item < NBATCH * 2 * (SEQ / 32); item += gridDim.x) {
    const int tt = (item < 256) ? (SEQ / 32 - 1) - (item % (SEQ / 32)) : (item % (SEQ / 32));
    const int bg = item / (SEQ / 32);
    const int b = bg >> 1, g = bg & 1;
    const int h = g * 4 + wv;
    const int t0 = tt * 32, tq = t0 + ql, cur = t0 >> 6;
    __syncthreads();
    QFrag q;
    q_load(q, p.qn + (size_t)(b * SEQ + tq) * 1024 + h * 128);
    {
      const int lo = opq(lane);
      lut[lo] = p.t5[t5_bucket(lo) * 8 + h];
      lut[lo + 64] = p.t5[t5_bucket(lo + 64) * 8 + h];
    }
#pragma unroll
    for (int i = 0; i < 16; ++i) imp[i * 256 + tid] = 0.f;
    if (tid < 32) selm[tid] = 0u;
    const float* grow = p.gates + (size_t)(b * SEQ + tq) * 24 + h * 3;
    float* prow = p.part + (size_t)(b * SEQ + tq) * 1024 + h * 128;
    OAcc o;
    float m, l;
    KVRegs kv;
    {
      const bf16_t* kb = p.kcb + (size_t)bg * 128 * 128;
      const bf16_t* vb = p.vcT + (size_t)bg * 128 * 128;
      oacc_zero(o);
      m = NEG_BIG; l = 0.f;
      kv_load(kv, kb, 128, vb, 128);
      __syncthreads();
      kv_store(kv, lk, lv);
      __syncthreads();
      f32x16 x0, x1;
      qk_tile(q, lk, x0, x1);
      int tqv = tq;
      asm volatile("" : "+v"(tqv));
      tqv -= 64 * hh;
      if (t0 >= 1152) {
        const float b31 = lut[127];
#pragma unroll
        for (int r = 0; r < 16; ++r) { x0[r] = x0[r] * ATT_SCALE + b31; x1[r] = x1[r] * ATT_SCALE + b31; }
      } else {
#pragma unroll
        for (int r = 0; r < 16; ++r) {
          const int c = 8 * (r >> 2) + (r & 3);
          const int d0 = tqv - 16 * c - 31, d1 = d0 - 512;
          x0[r] = (d0 >= 0) ? x0[r] * ATT_SCALE + lut[min(d0, 127)] : NEG_BIG;
          x1[r] = (d1 >= 0) ? x1[r] * ATT_SCALE + lut[min(d1, 127)] : NEG_BIG;
        }
      }
      softmax_tile(x0, x1, m, l, o);
      const float m0 = m;
      pv_tile(o, lv, x0, x1);
      f32x16 z0, z1;
#pragma unroll
      for (int r = 0; r < 16; ++r) { z0[r] = 0.f; z1[r] = 0.f; }
      if (t0 >= 1024) {
        kv_load(kv, kb + 64 * 128, 128, vb + 64, 128);
        __syncthreads();
        kv_store(kv, lk, lv);
        __syncthreads();
        qk_tile(q, lk, z0, z1);
        asm volatile("" : "+v"(tqv));
#pragma unroll
        for (int r = 0; r < 16; ++r) {
          const int c = 64 + 8 * (r >> 2) + (r & 3);
          const int d0 = tqv - 16 * c - 31, d1 = d0 - 512;
          z0[r] = (d0 >= 0) ? z0[r] * ATT_SCALE + lut[min(d0, 127)] : NEG_BIG;
          z1[r] = (d1 >= 0) ? z1[r] * ATT_SCALE + lut[min(d1, 127)] : NEG_BIG;
        }
        softmax_tile(z0, z1, m, l, o);
        pv_tile(o, lv, z0, z1);
      }
      const float inv = 1.f / fmaxf(l, 1e-20f);
      const float c0 = __expf(m0 - m) * inv;
#pragma unroll
      for (int r = 0; r < 16; ++r) {
        const int c = 8 * (r >> 2) + (r & 3) + 4 * hh;
        if (x0[r] != 0.f) atomicAdd(&imp[(c) * 32 + ql], x0[r] * c0);
        if (x1[r] != 0.f) atomicAdd(&imp[(c + 32) * 32 + ql], x1[r] * c0);
        if (z0[r] != 0.f) atomicAdd(&imp[(c + 64) * 32 + ql], z0[r] * inv);
        if (z1[r] != 0.f) atomicAdd(&imp[(c + 96) * 32 + ql], z1[r] * inv);
      }
      const float gs = inv / (1.f + __expf(-grow[0]));
      oacc_foreach(o, [&](int d, float v0, float v1, float v2, float v3) {
        f32x4 u = {v0 * gs, v1 * gs, v2 * gs, v3 * gs};
        *(f32x4*)(prow + d) = u;
      });
    }
    __syncthreads();
    {
      const int tido = opq(tid);
      const int qq = tido & 31, jg = tido >> 5;
#pragma unroll
      for (int jj = 0; jj < 4; ++jj) {
        const int j = jg * 4 + jj;
        float v = imp[(4 * j) * 32 + qq] + imp[(4 * j + 1) * 32 + qq] + imp[(4 * j + 2) * 32 + qq] + 0.5f * imp[(4 * j + 3) * 32 + qq];
        if (j > 0) v += 0.5f * imp[(4 * j - 1) * 32 + qq];
        const bool forced = (j == 0) || (j == cur) || (j == cur - 1);
        keys[qq * 33 + j] = forced ? 1e9f : ((j <= cur) ? v : -1e9f);
      }
      __syncthreads();
      unsigned bits = 0u;
#pragma unroll
      for (int jj = 0; jj < 4; ++jj) {
        const int j = jg * 4 + jj;
        const float kj = keys[qq * 33 + j];
        int rank = 0;
        for (int i = 0; i < 32; ++i) {
          const float ki = keys[qq * 33 + i];
          rank += (ki > kj || (ki == kj && i < j)) ? 1 : 0;
        }
        if (rank < 16 && j <= cur) bits |= 1u << j;
      }
      atomicOr(&selm[qq], bits);
      __syncthreads();
    }
    const unsigned mysel = selm[ql];
    unsigned um = mysel;
#pragma unroll
    for (int o2 = 16; o2 > 0; o2 >>= 1) um |= (unsigned)__shfl_xor((int)um, o2);
    um = (unsigned)__builtin_amdgcn_readfirstlane((int)um);
    {
      const bf16_t* kb = p.ks + (size_t)bg * SEQ * 128;
      const bf16_t* vb = p.vsT + (size_t)bg * 128 * SEQ;
      oacc_zero(o);
      m = NEG_BIG; l = 0.f;
      unsigned rem = um;
      int j = __builtin_ctz(rem);
      kv_load(kv, kb + (size_t)j * 64 * 128, 128, vb + j * 64, SEQ);
      while (rem) {
        j = __builtin_ctz(rem);
        rem &= rem - 1;
        const int jn = rem ? __builtin_ctz(rem) : j;
        __syncthreads();
        kv_store(kv, lk, lv);
        __syncthreads();
        f32x16 s0, s1;
        qk_tile(q, lk, s0, s1);
        const bool selq = (mysel >> j) & 1u;
        int tqv = tq;
        asm volatile("" : "+v"(tqv));
        if (j * 64 + 63 + 113 <= t0) {
          const float sc = selq ? ATT_SCALE : 0.f, bb = selq ? lut[127] : NEG_BIG;
#pragma unroll
          for (int r = 0; r < 16; ++r) { s0[r] = s0[r] * sc + bb; s1[r] = s1[r] * sc + bb; }
        } else {
#pragma unroll
          for (int r = 0; r < 16; ++r) {
            const int d0 = tqv - (j * 64 + 8 * (r >> 2) + (r & 3) + 4 * hh), d1 = d0 - 32;
            s0[r] = (selq && d0 >= 0) ? s0[r] * ATT_SCALE + lut[min(d0, 127)] : NEG_BIG;
            s1[r] = (selq && d1 >= 0) ? s1[r] * ATT_SCALE + lut[min(d1, 127)] : NEG_BIG;
          }
        }
        kv_load(kv, kb + (size_t)jn * 64 * 128, 128, vb + jn * 64, SEQ);
        softmax_tile(s0, s1, m, l, o);
        pv_tile(o, lv, s0, s1);
      }
      const float gs = 1.f / (fmaxf(l, 1e-20f) * (1.f + __expf(-grow[1])));
      int qo = ql;
      asm volatile("" : "+v"(qo));
      float* pr2 = p.part + (size_t)(b * SEQ + t0 + qo) * 1024 + h * 128;
      oacc_foreach(o, [&](int d, float v0, float v1, float v2, float v3) {
        f32x4 u = *(f32x4*)(pr2 + d);
        u[0] += v0 * gs; u[1] += v1 * gs; u[2] += v2 * gs; u[3] += v3 * gs;
        *(f32x4*)(pr2 + d) = u;
      });
    }
    {
      const bf16_t* kb = p.kw + (size_t)bg * SEQ * 128;
      const bf16_t* vb = p.vwT + (size_t)bg * 128 * SEQ;
      oacc_zero(o);
      m = NEG_BIG; l = 0.f;
      int jlo = (t0 - 511) >> 6;
      if (jlo < 0) jlo = 0;
      kv_load(kv, kb + (size_t)jlo * 64 * 128, 128, vb + jlo * 64, SEQ);
      for (int j = jlo; j <= cur; ++j) {
        const int jn = (j < cur) ? j + 1 : j;
        __syncthreads();
        kv_store(kv, lk, lv);
        __syncthreads();
        f32x16 s0, s1;
        qk_tile(q, lk, s0, s1);
        int tqv = tq;
        asm volatile("" : "+v"(tqv));
        if (j * 64 + 63 + 113 <= t0 && t0 + 31 - j * 64 < 512) {
          const float b31 = lut[127];
#pragma unroll
          for (int r = 0; r < 16; ++r) { s0[r] = s0[r] * ATT_SCALE + b31; s1[r] = s1[r] * ATT_SCALE + b31; }
        } else {
#pragma unroll
          for (int r = 0; r < 16; ++r) {
            const int d0 = tqv - (j * 64 + 8 * (r >> 2) + (r & 3) + 4 * hh), d1 = d0 - 32;
            s0[r] = (d0 >= 0 && d0 < 512) ? s0[r] * ATT_SCALE + lut[min(d0, 127)] : NEG_BIG;
            s1[r] = (d1 >= 0 && d1 < 512) ? s1[r] * ATT_SCALE + lut[min(d1, 127)] : NEG_BIG;
          }
        }
        kv_load(kv, kb + (size_t)jn * 64 * 128, 128, vb + jn * 64, SEQ);
        softmax_tile(s0, s1, m, l, o);
        pv_tile(o, lv, s0, s1);
      }
      const float gs = 1.f / (fmaxf(l, 1e-20f) * (1.f + __expf(-grow[2])));
      int qo = ql;
      asm volatile("" : "+v"(qo));
      const float* pr2 = p.part + (size_t)(b * SEQ + t0 + qo) * 1024 + h * 128;
      bf16_t* orow = p.omix + (size_t)(b * SEQ + t0 + qo) * DM + h * 128;
      oacc_foreach(o, [&](int d, float v0, float v1, float v2, float v3) {
        const f32x4 u = *(const f32x4*)(pr2 + d);
        uint2 w;
        w.x = pack2(u[0] + v0 * gs, u[1] + v1 * gs);
        w.y = pack2(u[2] + v2 * gs, u[3] + v3 * gs);
        *(uint2*)(orow + d) = w;
      });
    }
  }
}

__device__ __forceinline__ void ph_cvt(const float* src, bf16_t* dst, size_t n) {
  typedef __attribute__((ext_vector_type(4))) float f32x4;
  const size_t nv = n / 8;
  for (size_t i = (size_t)blockIdx.x * 256 + opq(threadIdx.x); i < nv; i += (size_t)gridDim.x * 256) {
    const f32x4 a = ((const f32x4*)src)[2 * i], b = ((const f32x4*)src)[2 * i + 1];
    u32x4 o;
    o[0] = pack2(a[0], a[1]); o[1] = pack2(a[2], a[3]); o[2] = pack2(b[0], b[1]); o[3] = pack2(b[2], b[3]);
    ((u32x4*)dst)[i] = o;
  }
}

__device__ __forceinline__ void ph_scores(const P& p, char* lds) {
  for (int u = blockIdx.x; u < 64 * 16; u += gridDim.x) {
    const int tm = u & 63, hp = u >> 6;
    const int m0 = tm * 128;
    float* sc = p.scores + (size_t)m0 * DM + hp * 128;
    gemm_tile_bf16<false>(p.omix + (size_t)m0 * DM + hp * 128, DM, p.subkb + (size_t)hp * 128 * 128, 128, 128, lds,
                          [&](int r, int c, float val) { sc[(size_t)r * DM + c] = val; });
  }
}

__device__ __forceinline__ void ph_cvt8(const float* src, unsigned char* dst, float* scales, int nrows) {
  typedef __attribute__((ext_vector_type(4))) float f32x4;
  const int lane = opq(threadIdx.x) & 63, wv = opq(threadIdx.x) >> 6;
  for (int row = blockIdx.x * 4 + wv; row < nrows; row += gridDim.x * 4) {
    const f32x4* s4 = (const f32x4*)(src + (size_t)row * DM);
    f32x4 v[8];
    float amax = 0.f;
#pragma unroll
    for (int c = 0; c < 2; ++c)
#pragma unroll
      for (int i = 0; i < 4; ++i) {
        v[c * 4 + i] = s4[c * 256 + lane * 4 + i];
#pragma unroll
        for (int k = 0; k < 4; ++k) amax = fmaxf(amax, fabsf(v[c * 4 + i][k]));
      }
    amax = wave_max(amax);
    const float sc = (amax > 0.f) ? 440.f / amax : 1.f;
#pragma unroll
    for (int c = 0; c < 2; ++c) {
      u32x4 o;
#pragma unroll
      for (int i = 0; i < 4; ++i) {
        int pk = 0;
        pk = __builtin_amdgcn_cvt_pk_fp8_f32(v[c * 4 + i][0] * sc, v[c * 4 + i][1] * sc, pk, false);
        pk = __builtin_amdgcn_cvt_pk_fp8_f32(v[c * 4 + i][2] * sc, v[c * 4 + i][3] * sc, pk, true);
        o[i] = (unsigned)pk;
      }
      *(u32x4*)(dst + (size_t)row * DM + c * 1024 + lane * 16) = o;
    }
    if (lane == 0) scales[row] = (amax > 0.f) ? amax / 440.f : 1.f;
  }
}

struct R8 { u32x4 r0, r1; };
__device__ __forceinline__ void r8_load(R8& r, const unsigned char* tab, int eid, int lane) {
  const u32x4* ur = (const u32x4*)(tab + (size_t)eid * DM) + lane;
  r.r0 = ur[0]; r.r1 = ur[64];
}
__device__ __forceinline__ float dot2q(unsigned w8, bool hi, unsigned xb, float c) {
  return __builtin_amdgcn_fdot2_f32_bf16(hi ? __builtin_amdgcn_cvt_scalef32_pk_bf16_fp8(w8, 1.0f, true)
                                            : __builtin_amdgcn_cvt_scalef32_pk_bf16_fp8(w8, 1.0f, false),
                                         __builtin_bit_cast(bf16v2, xb), c, false);
}
struct XPk { u32x4 a0, a1, b0, b1; };
struct Acc32 { f32x16 a, b; };

__device__ __forceinline__ float r8_dot(const R8& e, const XPk& x) {
  float pa = 0.f, pb = 0.f;
#pragma unroll
  for (int w = 0; w < 4; ++w) {
    const unsigned xa0 = (w < 2) ? x.a0[2 * w] : x.a1[2 * w - 4], xa1 = (w < 2) ? x.a0[2 * w + 1] : x.a1[2 * w - 3];
    const unsigned xb0 = (w < 2) ? x.b0[2 * w] : x.b1[2 * w - 4], xb1 = (w < 2) ? x.b0[2 * w + 1] : x.b1[2 * w - 3];
    pa = dot2q(e.r0[w], false, xa0, pa);
    pb = dot2q(e.r0[w], true, xa1, pb);
    pa = dot2q(e.r1[w], false, xb0, pa);
    pb = dot2q(e.r1[w], true, xb1, pb);
  }
  return pa + pb;
}
__device__ __forceinline__ void r8_axpy(const R8& e, float hid, Acc32& acc) {
  typedef __attribute__((ext_vector_type(2))) float f32x2;
#pragma unroll
  for (int w = 0; w < 4; ++w) {
    const f32x2 l0 = __builtin_amdgcn_cvt_pk_f32_fp8((int)e.r0[w], false), h0 = __builtin_amdgcn_cvt_pk_f32_fp8((int)e.r0[w], true);
    const f32x2 l1 = __builtin_amdgcn_cvt_pk_f32_fp8((int)e.r1[w], false), h1 = __builtin_amdgcn_cvt_pk_f32_fp8((int)e.r1[w], true);
    acc.a[4 * w + 0] += hid * l0[0]; acc.a[4 * w + 1] += hid * l0[1]; acc.a[4 * w + 2] += hid * h0[0]; acc.a[4 * w + 3] += hid * h0[1];
    acc.b[4 * w + 0] += hid * l1[0]; acc.b[4 * w + 1] += hid * l1[1]; acc.b[4 * w + 2] += hid * h1[0]; acc.b[4 * w + 3] += hid * h1[1];
  }
}

#define INS16(K, x)                                                                                      \
  K##15 = __builtin_amdgcn_fmed3f(K##15, K##14, x); K##14 = __builtin_amdgcn_fmed3f(K##14, K##13, x);   \
  K##13 = __builtin_amdgcn_fmed3f(K##13, K##12, x); K##12 = __builtin_amdgcn_fmed3f(K##12, K##11, x);   \
  K##11 = __builtin_amdgcn_fmed3f(K##11, K##10, x); K##10 = __builtin_amdgcn_fmed3f(K##10, K##9, x);    \
  K##9 = __builtin_amdgcn_fmed3f(K##9, K##8, x); K##8 = __builtin_amdgcn_fmed3f(K##8, K##7, x);         \
  K##7 = __builtin_amdgcn_fmed3f(K##7, K##6, x); K##6 = __builtin_amdgcn_fmed3f(K##6, K##5, x);         \
  K##5 = __builtin_amdgcn_fmed3f(K##5, K##4, x); K##4 = __builtin_amdgcn_fmed3f(K##4, K##3, x);         \
  K##3 = __builtin_amdgcn_fmed3f(K##3, K##2, x); K##2 = __builtin_amdgcn_fmed3f(K##2, K##1, x);         \
  K##1 = __builtin_amdgcn_fmed3f(K##1, K##0, x); K##0 = fmaxf(K##0, x);
#define DECL16(K) float K##0 = -INFINITY, K##1 = -INFINITY, K##2 = -INFINITY, K##3 = -INFINITY, K##4 = -INFINITY, \
  K##5 = -INFINITY, K##6 = -INFINITY, K##7 = -INFINITY, K##8 = -INFINITY, K##9 = -INFINITY, K##10 = -INFINITY,   \
  K##11 = -INFINITY, K##12 = -INFINITY, K##13 = -INFINITY, K##14 = -INFINITY, K##15 = -INFINITY;
__device__ __forceinline__ float mkkey(float v, unsigned tag, unsigned mask) {
  return __uint_as_float((__float_as_uint(v) & ~mask) | tag);
}

__device__ __forceinline__ void ph_peer(const P& p, float* smem) {
  typedef __attribute__((ext_vector_type(4))) float f32x4;
  const int tid = opq(threadIdx.x), lane = tid & 63, wv = tid >> 6;
  float* lists = smem;
  int* bexA = (int*)(smem + 4096);
  float* bgtA = smem + 6144;
  float* bsuA = smem + 8192;
  for (int item = blockIdx.x; item < T_TOK / 16; item += gridDim.x) {
    const int t0 = item * 16;
    __syncthreads();
    {
      const int tl = tid >> 4, hp = tid & 15;
      const f32x4* sp = (const f32x4*)(p.scores + (size_t)(t0 + tl) * DM + hp * 128);
      DECL16(k)
#pragma unroll 4
      for (int c4 = 0; c4 < 32; ++c4) {
        const f32x4 v = sp[c4];
#pragma unroll
        for (int e = 0; e < 4; ++e) {
          const float x = mkkey(v[e], 127u - (unsigned)(c4 * 4 + e), 127u);
          INS16(k, x)
        }
      }
      f32x4* lp = (f32x4*)(lists + (size_t)tid * 16);
      f32x4 o0 = {k0, k1, k2, k3}, o1 = {k4, k5, k6, k7}, o2 = {k8, k9, k10, k11}, o3 = {k12, k13, k14, k15};
      lp[0] = o0; lp[1] = o1; lp[2] = o2; lp[3] = o3;
    }
    __syncthreads();
    if (tid < 128) {
      const int tl = tid >> 3, h = tid & 7;
      const float* la = lists + (size_t)(tl * 16 + 2 * h) * 16;
      const float* lb = la + 16;
      float av[16], bv[16];
#pragma unroll
      for (int i = 0; i < 16; ++i) {
        av[i] = __uint_as_float(__float_as_uint(la[i]) & ~127u);
        bv[i] = __uint_as_float(__float_as_uint(lb[i]) & ~127u);
      }
      DECL16(c)
#pragma unroll
      for (int i = 0; i < 16; ++i) {
#pragma unroll
        for (int j = 0; j < 16; ++j) {
          if ((i + 1) * (j + 1) <= 16) {
            const float x = mkkey(av[i] + bv[j], 255u - (unsigned)(i * 16 + j), 255u);
            INS16(c, x)
          }
        }
      }
      float cs[16] = {c0, c1, c2, c3, c4, c5, c6, c7, c8, c9, c10, c11, c12, c13, c14, c15};
      float ev[16];
      float sum = 0.f;
      const float mx = __uint_as_float(__float_as_uint(cs[0]) & ~255u);
#pragma unroll
      for (int n = 0; n < 16; ++n) {
        ev[n] = __expf(__uint_as_float(__float_as_uint(cs[n]) & ~255u) - mx);
        sum += ev[n];
      }
      const float isum = 1.f / sum;
#pragma unroll
      for (int n = 0; n < 16; ++n) {
        const unsigned cc = 255u - (__float_as_uint(cs[n]) & 255u);
        const unsigned ka = 127u - (__float_as_uint(la[cc >> 4]) & 127u);
        const unsigned kb = 127u - (__float_as_uint(lb[cc & 15u]) & 127u);
        const int eid = (int)(ka * 128u + kb);
        bexA[tl * 128 + h * 16 + n] = eid;
        bgtA[tl * 128 + h * 16 + n] = ev[n] * isum * p.sv8[eid];
        bsuA[tl * 128 + h * 16 + n] = p.su8[eid];
      }
    }
    __syncthreads();
#pragma unroll 1
    for (int ti4 = 0; ti4 < 4; ++ti4) {
    const int tl = wv * 4 + ti4;
    const int t = t0 + tl;
    const int* bex = bexA + tl * 128;
    const float* bgt = bgtA + tl * 128;
    const float* bsu = bsuA + tl * 128;
    XPk x;
    {
      const f32x4* s4 = (const f32x4*)(p.out + (size_t)t * DM);
      const f32x4* g4 = (const f32x4*)p.norm_ffn;
      f32x4 a0 = s4[lane * 4], a1 = s4[lane * 4 + 1], a2 = s4[lane * 4 + 2], a3 = s4[lane * 4 + 3];
      f32x4 a4 = s4[256 + lane * 4], a5 = s4[256 + lane * 4 + 1], a6 = s4[256 + lane * 4 + 2], a7 = s4[256 + lane * 4 + 3];
      float ss = 0.f;
#define SSQ(v) ss += v[0] * v[0] + v[1] * v[1] + v[2] * v[2] + v[3] * v[3];
      SSQ(a0) SSQ(a1) SSQ(a2) SSQ(a3) SSQ(a4) SSQ(a5) SSQ(a6) SSQ(a7)
#undef SSQ
      ss = wave_sum(ss);
      const float rs = rsqrtf(ss * (1.f / DM) + RMS_EPS);
#define XPK(dst, va, vb, gi)                                                          \
  {                                                                                   \
    const f32x4 ga = g4[gi], gb = g4[gi + 1];                                         \
    dst[0] = pack2(va[0] * rs * ga[0], va[1] * rs * ga[1]);                           \
    dst[1] = pack2(va[2] * rs * ga[2], va[3] * rs * ga[3]);                           \
    dst[2] = pack2(vb[0] * rs * gb[0], vb[1] * rs * gb[1]);                           \
    dst[3] = pack2(vb[2] * rs * gb[2], vb[3] * rs * gb[3]);                           \
  }
      XPK(x.a0, a0, a1, lane * 4) XPK(x.a1, a2, a3, lane * 4 + 2) XPK(x.b0, a4, a5, 256 + lane * 4) XPK(x.b1, a6, a7, 256 + lane * 4 + 2)
#undef XPK
    }
    Acc32 acc;
#pragma unroll
    for (int r = 0; r < 16; ++r) { acc.a[r] = 0.f; acc.b[r] = 0.f; }
    R8 u0, u1, u2, u3, v0, v1, v2, v3;
    r8_load(u0, p.pu8, bex[0], lane); r8_load(u1, p.pu8, bex[1], lane); r8_load(u2, p.pu8, bex[2], lane); r8_load(u3, p.pu8, bex[3], lane);
    r8_load(v0, p.pv8, bex[0], lane); r8_load(v1, p.pv8, bex[1], lane); r8_load(v2, p.pv8, bex[2], lane); r8_load(v3, p.pv8, bex[3], lane);
#pragma unroll 1
    for (int e0 = 0; e0 < 128; e0 += 4) {
      float d0 = r8_dot(u0, x), d1 = r8_dot(u1, x), d2 = r8_dot(u2, x), d3 = r8_dot(u3, x);
      const int en = (e0 + 4 < 128) ? e0 + 4 : 124;
      const int i0 = bex[en], i1 = bex[en + 1], i2 = bex[en + 2], i3 = bex[en + 3];
      r8_load(u0, p.pu8, i0, lane); r8_load(u1, p.pu8, i1, lane); r8_load(u2, p.pu8, i2, lane); r8_load(u3, p.pu8, i3, lane);
#pragma unroll
      for (int o = 32; o > 0; o >>= 1) {
        d0 += __shfl_xor(d0, o); d1 += __shfl_xor(d1, o); d2 += __shfl_xor(d2, o); d3 += __shfl_xor(d3, o);
      }
      r8_axpy(v0, bgt[e0 + 0] * gelu_fast(d0 * bsu[e0 + 0]), acc);
      r8_axpy(v1, bgt[e0 + 1] * gelu_fast(d1 * bsu[e0 + 1]), acc);
      r8_axpy(v2, bgt[e0 + 2] * gelu_fast(d2 * bsu[e0 + 2]), acc);
      r8_axpy(v3, bgt[e0 + 3] * gelu_fast(d3 * bsu[e0 + 3]), acc);
      r8_load(v0, p.pv8, i0, lane); r8_load(v1, p.pv8, i1, lane); r8_load(v2, p.pv8, i2, lane); r8_load(v3, p.pv8, i3, lane);
    }
    const int lane2 = opq(lane);
    f32x4* o4 = (f32x4*)(p.out + (size_t)t * DM);
    const f32x4* g4 = (const f32x4*)p.norm_final;
    f32x4 hv[8];
    float ss = 0.f;
#pragma unroll
    for (int c = 0; c < 2; ++c)
#pragma unroll
      for (int i = 0; i < 4; ++i) {
        hv[c * 4 + i] = o4[c * 256 + lane2 * 4 + i];
#pragma unroll
        for (int k = 0; k < 4; ++k) {
          hv[c * 4 + i][k] += c ? acc.b[4 * i + k] : acc.a[4 * i + k];
          ss += hv[c * 4 + i][k] * hv[c * 4 + i][k];
        }
      }
    ss = wave_sum(ss);
    const float rs = rsqrtf(ss * (1.f / DM) + RMS_EPS);
#pragma unroll
    for (int c = 0; c < 2; ++c)
#pragma unroll
      for (int i = 0; i < 4; ++i) {
        const f32x4 g = g4[c * 256 + lane2 * 4 + i];
        f32x4 o;
#pragma unroll
        for (int k = 0; k < 4; ++k) o[k] = hv[c * 4 + i][k] * rs * g[k];
        o4[c * 256 + lane2 * 4 + i] = o;
      }
    }
  }
}

#define XB_TMO      128
#define XB_XCNT(j)  (256  + 64 * (j))
#define XB_XSUB(j)  (1280 + 64 * (j))
#define XB_XGEN(j)  (2304 + 64 * (j))
#define XB_TOP      3328
#define XB_TOPGEN   3392
#define XCD_BAR_WORDS 3456
#define XB_SPIN_CAP (1u << 22)
#define LAS __attribute__((address_space(3)))
__device__ __forceinline__ unsigned xb_ld(unsigned* p) { return __hip_atomic_load(p, __ATOMIC_RELAXED, __HIP_MEMORY_SCOPE_AGENT); }
__device__ __forceinline__ unsigned xb_add(unsigned* p, unsigned v) { return __hip_atomic_fetch_add(p, v, __ATOMIC_RELAXED, __HIP_MEMORY_SCOPE_AGENT); }
__device__ __forceinline__ unsigned xb_xcc_id() { return (unsigned)__builtin_amdgcn_s_getreg((3 << 11) | 20) & 0xFu; }
#define XB_SPIN(cond, bar) do { unsigned _sp = 0; while (cond) { __builtin_amdgcn_s_sleep(1); \
    if ((++_sp & 255u) == 0u) { if (xb_ld(&(bar)[XB_TMO])) break; if (_sp > XB_SPIN_CAP) { atomicAdd(&(bar)[XB_TMO], 1u); break; } } } } while (0)
struct XcdBarrier { unsigned* bar; unsigned x; volatile LAS unsigned* st; };
__device__ __forceinline__ XcdBarrier xcd_barrier_post(unsigned* bar, volatile LAS unsigned* st) {
  XcdBarrier b; b.bar = bar; b.x = xb_xcc_id(); b.st = st;
  if (threadIdx.x == 0) (void)xb_add(&bar[XB_XCNT(b.x)], 1u);
  return b;
}
__device__ __forceinline__ void xcd_barrier_complete(unsigned* bar, unsigned x, unsigned& nloc, unsigned& nx) {
  const unsigned G = gridDim.x * gridDim.y * gridDim.z;
  unsigned sum, cnt, mine, sp = 0u;
  for (;;) {
    sum = 0u; cnt = 0u; mine = 0u;
#pragma unroll
    for (unsigned j = 0; j < 16; ++j) { const unsigned c = xb_ld(&bar[XB_XCNT(j)]); sum += c; cnt += (c > 0u) ? 1u : 0u; mine = (j == x) ? c : mine; }
    if (sum == G) break;
    __builtin_amdgcn_s_sleep(1);
    if ((++sp & 255u) == 0u) { if (xb_ld(&bar[XB_TMO])) break; if (sp > XB_SPIN_CAP) { atomicAdd(&bar[XB_TMO], 1u); break; } }
  }
  nloc = mine > 0u ? mine : 1u; nx = cnt > 0u ? cnt : 1u;
}
__device__ __forceinline__ void xcd_barrier(const XcdBarrier& b) {
  asm volatile("s_waitcnt vmcnt(0)" ::: "memory");
  __syncthreads();
  if (threadIdx.x == 0) {
    unsigned* bar = b.bar;
    __builtin_amdgcn_s_waitcnt(0);
    unsigned nloc = b.st[0], nx = b.st[1];
    if (nloc == 0u) { xcd_barrier_complete(bar, b.x, nloc, nx); b.st[0] = nloc; b.st[1] = nx; }
    const unsigned old = xb_add(&bar[XB_XSUB(b.x)], 1u);
    const unsigned gen = old / nloc;
    if (old + 1u == (gen + 1u) * nloc) {
      __builtin_amdgcn_fence(__ATOMIC_RELEASE, "agent");
      asm volatile("s_waitcnt vmcnt(0)" ::: "memory");
      const unsigned og = xb_add(&bar[XB_TOP], 1u);
      const unsigned tg = og / nx;
      if (og + 1u == (tg + 1u) * nx) xb_add(&bar[XB_TOPGEN], 1u);
      else XB_SPIN(xb_ld(&bar[XB_TOPGEN]) == tg, bar);
      __builtin_amdgcn_fence(__ATOMIC_ACQUIRE, "agent");
      xb_add(&bar[XB_XGEN(b.x)], 1u);
      asm volatile("s_waitcnt vmcnt(0)" ::: "memory");
    } else {
      XB_SPIN(xb_ld(&bar[XB_XGEN(b.x)]) == gen, bar);
      __builtin_amdgcn_fence(__ATOMIC_ACQUIRE, "agent");
      asm volatile("s_waitcnt vmcnt(0)" ::: "memory");
    }
  }
  __syncthreads();
}

typedef const __attribute__((address_space(4))) P* KP;
__device__ __forceinline__ P loadP() {
#if defined(__HIP_DEVICE_COMPILE__)
  KP k = (KP)__builtin_amdgcn_kernarg_segment_ptr();
  asm volatile("" : "+s"(k));
  P p = *k;
  return p;
#else
  return P{};
#endif
}

__global__ void __launch_bounds__(256, 2) mega(P p_arg) {
  cg::grid_group grid = cg::this_grid();
  __shared__ __attribute__((aligned(16))) float smem[14336];
  char* lds = (char*)smem;
  __shared__ uint4 xb_words;
  if (threadIdx.x == 0) xb_words = make_uint4(0u, 0u, 0u, 0u);
  if (blockIdx.x == 0) {
    P p = loadP();
    for (int i = threadIdx.x; i < XCD_BAR_WORDS; i += 256) p.bar[i] = 0u;
  }
  { P p = loadP(); ph_rmsnorm(p.x, p.norm_mix, p.hn, T_TOK); ph_rmsnorm(p.mem, p.norm_mkv, p.memn, 1024); }
  { P p = loadP(); ph_transpose<true>(smem, p.w_in, DM, INC, 5760, p.WinT); }
  { P p = loadP(); ph_transpose<false>(smem, p.w_out, DM, DM, DM, p.WoutT); }
  { P p = loadP(); ph_transpose<false>(smem, p.w_pq, DM, DM, DM, p.WpqT); }
  { P p = loadP(); ph_transpose<false>(smem, p.w_mq, DM, 512, 512, p.WmqT); }
  { P p = loadP(); ph_transpose<false>(smem, p.w_mk, DM, 512, 512, p.WmkT); }
  { P p = loadP(); ph_transpose<false>(smem, p.w_mv, DM, 512, 512, p.WmvT); }
  { P p = loadP(); ph_transpose<false>(smem, p.w_mo, 512, DM, DM, p.WmoT); }
  { P p = loadP(); ph_cvt8(p.pu, p.pu8, p.su8, 16384); }
  { P p = loadP(); ph_cvt8(p.pv, p.pv8, p.sv8, 16384); }
  { P p = loadP(); ph_cvt(p.subk, p.subkb, (size_t)16 * 128 * 128); }
  { P p = loadP(); ph_transpose<false>(smem, p.w1_k, 4096, 128, 128, p.w1T); }
  { P p = loadP(); ph_transpose<false>(smem, p.w1_v, 4096, 128, 128, p.w1T + 128 * 4096); }
  { P p = loadP(); ph_transpose<false>(smem, p.w2_k, 128, 128, 128, p.w2T); }
  { P p = loadP(); ph_transpose<false>(smem, p.w2_v, 128, 128, 128, p.w2T + 128 * 128); }
  { P p = loadP(); ph_posb(p); }
  grid.sync();
  XcdBarrier xb;
  { P p = loadP(); xb = xcd_barrier_post(p.bar, (volatile LAS unsigned*)&xb_words); }
  { P p = loadP(); ph_proj(p, lds); }
  { P p = loadP(); bf16_t* kmem = p.kmemb;
    ph_gemm_bf16(p.memn, DM, p.WmkT, DM, 1024, 512, DM, lds, [=](int m, int n, float v) {
      kmem[((size_t)((m >> 8) * 4 + (n >> 7)) * 256 + (m & 255)) * 128 + (n & 127)] = f2bf(v); }); }
  { P p = loadP(); bf16_t* vmem = p.vmemT;
    ph_gemm_bf16(p.memn, DM, p.WmvT, DM, 1024, 512, DM, lds, [=](int m, int n, float v) {
      vmem[((size_t)((m >> 8) * 4 + (n >> 7)) * 128 + (n & 127)) * 256 + perm16(m & 255)] = f2bf(v); }); }
  xcd_barrier(xb);
  { P p = loadP(); ph_compress2(p, lds); }
  { P p = loadP(); ph_sb2(p, lds); }
  xcd_barrier(xb);
  { P p = loadP(); ph_nsa2(p, lds); }
  xcd_barrier(xb);
  { P p = loadP(); float* out = p.out; const float* x = p.x;
    ph_gemm_bf16(p.omix, DM, p.WoutT, DM, T_TOK, DM, DM, lds, [=](int m, int n, float v) { out[(size_t)m * DM + n] = x[(size_t)m * DM + n] + v; }); }
  xcd_barrier(xb);
  { P p = loadP(); ph_rmsnorm(p.out, p.norm_mq, p.hn, T_TOK); }
  xcd_barrier(xb);
  { P p = loadP(); bf16_t* qmem = p.qmemb;
    ph_gemm_bf16(p.hn, DM, p.WmqT, DM, T_TOK, 512, DM, lds, [=](int m, int n, float v) { qmem[(size_t)m * 512 + n] = f2bf(v); }); }
  xcd_barrier(xb);
  { P p = loadP(); ph_memattn2(p, lds); }
  xcd_barrier(xb);
  { P p = loadP(); float* out = p.out;
    ph_gemm_bf16(p.omem, 512, p.WmoT, 512, T_TOK, DM, 512, lds, [=](int m, int n, float v) { out[(size_t)m * DM + n] += v; }); }
  xcd_barrier(xb);
  { P p = loadP(); ph_rmsnorm(p.out, p.norm_ffn, p.hn, T_TOK); }
  xcd_barrier(xb);
  { P p = loadP(); bf16_t* qp = p.omix;
    ph_gemm_bf16(p.hn, DM, p.WpqT, DM, T_TOK, DM, DM, lds, [=](int m, int n, float v) { qp[(size_t)m * DM + n] = f2bf(v); }); }
  xcd_barrier(xb);
  { P p = loadP(); ph_scores(p, lds); }
  xcd_barrier(xb);
  { P p = loadP(); ph_peer(p, smem); }
}

extern "C" void kernel_launch(void* const* d_in, const int* in_sizes, int n_in, void* d_out, int out_size, void* d_ws,
                              size_t ws_size, hipStream_t stream) {
  P p{};
  p.x = (const float*)d_in[0]; p.mem = (const float*)d_in[1]; p.t5 = (const float*)d_in[2];
  p.norm_mix = (const float*)d_in[3]; p.w_in = (const float*)d_in[4]; p.pos_k = (const float*)d_in[5];
  p.w1_k = (const float*)d_in[6]; p.w2_k = (const float*)d_in[7]; p.pos_v = (const float*)d_in[8];
  p.w1_v = (const float*)d_in[9]; p.w2_v = (const float*)d_in[10]; p.w_out = (const float*)d_in[11];
  p.norm_mq = (const float*)d_in[12]; p.norm_mkv = (const float*)d_in[13]; p.w_mq = (const float*)d_in[14];
  p.w_mk = (const float*)d_in[15]; p.w_mv = (const float*)d_in[16]; p.w_mo = (const float*)d_in[17];
  p.norm_ffn = (const float*)d_in[18]; p.w_pq = (const float*)d_in[19]; p.subk = (const float*)d_in[20];
  p.pu = (const float*)d_in[21]; p.pv = (const float*)d_in[22]; p.norm_final = (const float*)d_in[23];
  p.out = (float*)d_out;
  char* w = (char*)d_ws;
  size_t off = 0;
  auto take = [&](size_t bytes) { char* r = w + off; off += (bytes + 255) & ~(size_t)255; return r; };
  p.bar = (unsigned*)take(XCD_BAR_WORDS * 4);
  p.scores = (float*)take((size_t)T_TOK * DM * 4);
  p.gates = (float*)take((size_t)T_TOK * 24 * 4);
  p.part = (float*)take((size_t)T_TOK * 1024 * 4);
  p.posb = (float*)take(256 * 4);
  p.qn = (bf16_t*)take((size_t)T_TOK * 1024 * 2);
  p.kcin = (bf16_t*)take((size_t)T_TOK * 256 * 2 + 65536);
  p.vcin = (bf16_t*)take((size_t)T_TOK * 256 * 2 + 65536);
  p.ks = (bf16_t*)take((size_t)T_TOK * 256 * 2);
  p.vsT = (bf16_t*)take((size_t)T_TOK * 256 * 2);
  p.kw = (bf16_t*)take((size_t)T_TOK * 256 * 2);
  p.vwT = (bf16_t*)take((size_t)T_TOK * 256 * 2);
  p.kcb = (bf16_t*)take((size_t)8 * 128 * 128 * 2);
  p.vcT = (bf16_t*)take((size_t)8 * 128 * 128 * 2);
  p.c1 = (bf16_t*)take((size_t)16 * 128 * 128 * 2);
  p.w1T = (bf16_t*)take((size_t)2 * 128 * 4096 * 2);
  p.w2T = (bf16_t*)take((size_t)2 * 128 * 128 * 2);
  p.hn = (bf16_t*)take((size_t)T_TOK * DM * 2);
  p.omix = (bf16_t*)take((size_t)T_TOK * DM * 2);
  p.memn = (bf16_t*)take((size_t)1024 * DM * 2);
  p.omem = (bf16_t*)take((size_t)T_TOK * 512 * 2);
  p.WinT = (bf16_t*)take((size_t)5760 * DM * 2);
  p.WoutT = (bf16_t*)take((size_t)DM * DM * 2);
  p.WpqT = (bf16_t*)take((size_t)DM * DM * 2);
  p.WmqT = (bf16_t*)take((size_t)512 * DM * 2);
  p.WmkT = (bf16_t*)take((size_t)512 * DM * 2);
  p.WmvT = (bf16_t*)take((size_t)512 * DM * 2);
  p.WmoT = (bf16_t*)take((size_t)DM * 512 * 2);
  p.qmemb = (bf16_t*)take((size_t)T_TOK * 512 * 2);
  p.kmemb = (bf16_t*)take((size_t)1024 * 512 * 2);
  p.vmemT = (bf16_t*)take((size_t)1024 * 512 * 2);
  p.qsb = (bf16_t*)take((size_t)T_TOK * 1024 * 2);
  p.ksb = (bf16_t*)take((size_t)T_TOK * 1024 * 2);
  p.vsbT = (bf16_t*)take((size_t)T_TOK * 1024 * 2);
  p.pu8 = (unsigned char*)take((size_t)16384 * DM);
  p.pv8 = (unsigned char*)take((size_t)16384 * DM);
  p.su8 = (float*)take(16384 * 4);
  p.sv8 = (float*)take(16384 * 4);
  p.subkb = (bf16_t*)take((size_t)16 * 128 * 128 * 2);
  static int grid_blocks = 0;
  if (!grid_blocks) {
    int dev = 0, cus = 0, per_cu = 0;
    (void)hipGetDevice(&dev);
    (void)hipDeviceGetAttribute(&cus, hipDeviceAttributeMultiprocessorCount, dev);
    (void)hipOccupancyMaxActiveBlocksPerMultiprocessor(&per_cu, mega, 256, 0);
    if (per_cu > 2) per_cu = 2;
    if (per_cu < 1) per_cu = 1;
    grid_blocks = cus * per_cu;
  }
  void* args[] = {&p};
  hipError_t e = hipLaunchCooperativeKernel((void*)mega, dim3(grid_blocks), dim3(256), args, 0, stream);
  if (e != hipSuccess) fprintf(stderr, "cooperative launch failed: %s (grid %d)\n", hipGetErrorString(e), grid_blocks);
}
```

```cpp
#include <hip/hip_runtime.h>
#include <hip/hip_cooperative_groups.h>
#include <cstdio>
namespace cg = cooperative_groups;
#include <stdint.h>

#define SEQ 2048
#define NBATCH 4
#define T_TOK 8192
#define DM 2048
#define INC 5656
#define C_QN 0
#define C_KC 1024
#define C_VC 1280
#define C_KS 1536
#define C_VS 1792
#define C_KW 2048
#define C_VW 2304
#define C_GT 2560
#define C_QSB 2584
#define C_KSB 3608
#define C_VSB 4632
#define ATT_SCALE 0.08838834764831845f
#define RMS_EPS 1e-6f

typedef unsigned short bf16_t;
typedef __attribute__((ext_vector_type(8))) short bf16x8;
typedef __attribute__((ext_vector_type(16))) float f32x16;
typedef __attribute__((ext_vector_type(2))) __bf16 bf16v2;
typedef __attribute__((ext_vector_type(4))) unsigned u32x4;

struct P {
  const float *x, *mem, *t5, *norm_mix, *w_in, *pos_k, *w1_k, *w2_k, *pos_v, *w1_v, *w2_v, *w_out,
      *norm_mq, *norm_mkv, *w_mq, *w_mk, *w_mv, *w_mo, *norm_ffn, *w_pq, *subk, *pu, *pv, *norm_final;
  float* out;
  float *scores, *gates, *part, *posb;
  unsigned* bar;
  bf16_t *hn, *omix, *memn, *omem;
  bf16_t *WinT, *WoutT, *WpqT, *WmqT, *WmkT, *WmvT, *WmoT;
  bf16_t *qmemb, *kmemb, *vmemT;
  bf16_t *qsb, *ksb, *vsbT;
  bf16_t* subkb;
  unsigned char *pu8, *pv8;
  float *su8, *sv8;
  bf16_t *qn, *kcin, *vcin, *ks, *vsT, *kw, *vwT, *kcb, *vcT, *c1, *w1T, *w2T;
};

__device__ __forceinline__ int opq(int v) { asm volatile("" : "+v"(v)); return v; }
__device__ __forceinline__ unsigned pack2(float a, float b) {
  bf16v2 r = {(__bf16)a, (__bf16)b};
  return *(unsigned*)&r;
}
__device__ __forceinline__ bf16_t f2bf(float a) {
  __bf16 r = (__bf16)a;
  return *(bf16_t*)&r;
}
__device__ __forceinline__ int perm16(int s) { return (s & ~12) | ((s & 4) << 1) | ((s & 8) >> 1); }
__device__ __forceinline__ float bf2f(bf16_t u) { return __uint_as_float((unsigned)u << 16); }

__device__ __forceinline__ float wave_max(float v) {
  for (int o = 32; o > 0; o >>= 1) v = fmaxf(v, __shfl_xor(v, o));
  return v;
}
__device__ __forceinline__ float wave_sum(float v) {
  for (int o = 32; o > 0; o >>= 1) v += __shfl_xor(v, o);
  return v;
}
__device__ __forceinline__ void wave_argmax(float& v, int& i) {
  for (int o = 32; o > 0; o >>= 1) {
    float ov = __shfl_xor(v, o);
    int oi = __shfl_xor(i, o);
    if (ov > v || (ov == v && oi < i)) { v = ov; i = oi; }
  }
}
__device__ __forceinline__ float gelu_tanh(float x) {
  return 0.5f * x * (1.f + tanhf(0.7978845608028654f * (x + 0.044715f * x * x * x)));
}
__device__ __forceinline__ float gelu_fast(float x) {
  const float y = 1.5957691216057308f * (x + 0.044715f * x * x * x);
  return x / (1.f + __expf(-y));
}
__device__ __forceinline__ int t5_bucket(int n) {
  if (n < 16) return n < 0 ? 0 : n;
  int b = 16;
  b += (n >= 19); b += (n >= 21); b += (n >= 24); b += (n >= 27); b += (n >= 31); b += (n >= 35);
  b += (n >= 40); b += (n >= 46); b += (n >= 52); b += (n >= 59); b += (n >= 67); b += (n >= 77);
  b += (n >= 87); b += (n >= 99); b += (n >= 113);
  return b;
}
__device__ __forceinline__ float log_sigmoid(float x) {
  return fminf(x, 0.f) - log1pf(expf(-fabsf(x)));
}

__device__ __forceinline__ void ph_rmsnorm(const float* src, const float* gain, bf16_t* dst, int rows) {
  int lane = opq(threadIdx.x) & 63, wv = opq(threadIdx.x) >> 6;
  for (int r = blockIdx.x * 4 + wv; r < rows; r += gridDim.x * 4) {
    const float4* s4 = (const float4*)(src + (size_t)r * DM);
    float4 v[8];
    float ss = 0.f;
#pragma unroll
    for (int i = 0; i < 8; ++i) {
      v[i] = s4[i * 64 + lane];
      ss += v[i].x * v[i].x + v[i].y * v[i].y + v[i].z * v[i].z + v[i].w * v[i].w;
    }
    ss = wave_sum(ss);
    float rs = rsqrtf(ss * (1.f / DM) + RMS_EPS);
    uint2* d2 = (uint2*)(dst + (size_t)r * DM);
    const float4* g4 = (const float4*)gain;
#pragma unroll
    for (int i = 0; i < 8; ++i) {
      float4 g = g4[i * 64 + lane];
      uint2 o;
      o.x = pack2(v[i].x * rs * g.x, v[i].y * rs * g.y);
      o.y = pack2(v[i].z * rs * g.z, v[i].w * rs * g.w);
      d2[i * 64 + lane] = o;
    }
  }
}

template <bool CMAP>
__device__ __forceinline__ void ph_transpose(float* smem, const float* W, int K, int N, int Npad, bf16_t* Wt) {
  float (*tl)[65] = (float (*)[65])smem;
  int tid = opq(threadIdx.x);
  int nk = K / 64, nn = Npad / 64;
  for (int tile = blockIdx.x; tile < nk * nn; tile += gridDim.x) {
    int k0 = (tile % nk) * 64, n0 = (tile / nk) * 64;
    int col = tid & 63, rb = tid >> 6;
#pragma unroll 4
    for (int pp = 0; pp < 16; ++pp) {
      int k = pp * 4 + rb;
      float v = 0.f;
      int sc = n0 + col;
      if (CMAP) sc = (sc < 2560) ? sc : (sc < 5632) ? sc + 24 : (sc < 5656) ? sc - 5632 + 2560 : N;
      if (sc < N) v = W[(size_t)(k0 + k) * N + sc];
      tl[k][col] = v;
    }
    __syncthreads();
    int n = tid >> 2, kc = (tid & 3) * 16;
    unsigned w[8];
#pragma unroll
    for (int i = 0; i < 8; ++i) w[i] = pack2(tl[kc + 2 * i][n], tl[kc + 2 * i + 1][n]);
    uint4* dst = (uint4*)(Wt + (size_t)(n0 + n) * K + k0 + kc);
    dst[0] = make_uint4(w[0], w[1], w[2], w[3]);
    dst[1] = make_uint4(w[4], w[5], w[6], w[7]);
    __syncthreads();
  }
}

__device__ __forceinline__ int lds_off(int row, int chunk) { return row * 128 + ((chunk ^ ((row >> 1) & 7)) << 4); }

template <bool TR, class Epi>
__device__ __forceinline__ void gemm_tile_bf16(const bf16_t* xp, int ldx, const bf16_t* yp, int ldy, int K, char* lds,
                                               Epi epi) {
  const int tid = opq(threadIdx.x), lane = tid & 63, wv = tid >> 6;
  const int wr = wv >> 1, wc = wv & 1;
  char* lx = lds;
  char* ly = lds + 16384;
  f32x16 acc[2][2];
#pragma unroll
  for (int i = 0; i < 2; ++i)
#pragma unroll
    for (int j = 0; j < 2; ++j)
#pragma unroll
      for (int r = 0; r < 16; ++r) acc[i][j][r] = 0.f;
  const int srow = tid >> 3, sch = tid & 7;
  const bf16_t* xg = xp + (size_t)srow * ldx + sch * 8;
  const bf16_t* yg = yp + (size_t)srow * ldy + sch * 8;
  const size_t x32 = (size_t)32 * ldx, y32 = (size_t)32 * ldy;
  uint4 sx0 = *(const uint4*)(xg), sx1 = *(const uint4*)(xg + x32), sx2 = *(const uint4*)(xg + 2 * x32),
        sx3 = *(const uint4*)(xg + 3 * x32);
  uint4 sy0 = *(const uint4*)(yg), sy1 = *(const uint4*)(yg + y32), sy2 = *(const uint4*)(yg + 2 * y32),
        sy3 = *(const uint4*)(yg + 3 * y32);
  const int so0 = lds_off(srow, sch), so1 = lds_off(32 + srow, sch), so2 = lds_off(64 + srow, sch),
            so3 = lds_off(96 + srow, sch);
  for (int k0 = 0; k0 < K; k0 += 64) {
    __syncthreads();
    *(uint4*)(lx + so0) = sx0; *(uint4*)(lx + so1) = sx1; *(uint4*)(lx + so2) = sx2; *(uint4*)(lx + so3) = sx3;
    *(uint4*)(ly + so0) = sy0; *(uint4*)(ly + so1) = sy1; *(uint4*)(ly + so2) = sy2; *(uint4*)(ly + so3) = sy3;
    __syncthreads();
    if (k0 + 64 < K) {
      const bf16_t* xn = xg + k0 + 64;
      const bf16_t* yn = yg + k0 + 64;
      sx0 = *(const uint4*)(xn); sx1 = *(const uint4*)(xn + x32); sx2 = *(const uint4*)(xn + 2 * x32);
      sx3 = *(const uint4*)(xn + 3 * x32);
      sy0 = *(const uint4*)(yn); sy1 = *(const uint4*)(yn + y32); sy2 = *(const uint4*)(yn + 2 * y32);
      sy3 = *(const uint4*)(yn + 3 * y32);
    }
#pragma unroll
    for (int kk = 0; kk < 4; ++kk) {
      bf16x8 a[2], b[2];
      const int ch = kk * 2 + (lane >> 5);
#pragma unroll
      for (int i = 0; i < 2; ++i) {
        a[i] = *(const bf16x8*)((TR ? ly : lx) + lds_off(wr * 64 + i * 32 + (lane & 31), ch));
        b[i] = *(const bf16x8*)((TR ? lx : ly) + lds_off(wc * 64 + i * 32 + (lane & 31), ch));
      }
#pragma unroll
      for (int i = 0; i < 2; ++i)
#pragma unroll
        for (int j = 0; j < 2; ++j) acc[i][j] = __builtin_amdgcn_mfma_f32_32x32x16_bf16(a[i], b[j], acc[i][j], 0, 0, 0);
    }
  }
  int lane2 = lane;
  asm volatile("" : "+v"(lane2));
#pragma unroll
  for (int i = 0; i < 2; ++i)
#pragma unroll
    for (int j = 0; j < 2; ++j)
#pragma unroll
      for (int r = 0; r < 16; ++r) {
        int rr = wr * 64 + i * 32 + (r & 3) + 8 * (r >> 2) + 4 * (lane2 >> 5);
        int cc = wc * 64 + j * 32 + (lane2 & 31);
        epi(rr, cc, acc[i][j][r]);
      }
}

template <class Epi>
__device__ __forceinline__ void ph_gemm_bf16(const bf16_t* A, int lda, const bf16_t* Wt, int ldw, int M, int N, int K,
                                             char* lds, Epi epi) {
  const int ntm = M / 128, ntn = N / 128;
  const int npm = (ntm + 7) / 8, npn = (ntn + 7) / 8;
  const int nslots = ((npm * npn * 64 + 511) / 512) * 512;
  for (int u = blockIdx.x; u < nslots; u += gridDim.x) {
    int v = (u & 7) * 64 + ((u >> 3) & 63) + (u & ~511);
    int patch = v >> 6, w = v & 63;
    int tm = (patch % npm) * 8 + (w & 7);
    int tn = (patch / npm) * 8 + (w >> 3);
    if (tm >= ntm || tn >= ntn) continue;
    const int m0 = tm * 128, n0 = tn * 128;
    gemm_tile_bf16<false>(A + (size_t)m0 * lda, lda, Wt + (size_t)n0 * ldw, ldw, K, lds,
                          [&](int r, int c, float val) { epi(m0 + r, n0 + c, val); });
  }
}

__device__ __forceinline__ void ph_proj(const P& p, char* lds) {
  const int ntm = T_TOK / 128, ntn = 5760 / 128;
  const int npm = (ntm + 7) / 8, npn = (ntn + 7) / 8;
  const int nslots = ((npm * npn * 64 + 511) / 512) * 512;
  for (int u = blockIdx.x; u < nslots; u += gridDim.x) {
    int v = (u & 7) * 64 + ((u >> 3) & 63) + (u & ~511);
    int patch = v >> 6, w = v & 63;
    int tm = (patch % npm) * 8 + (w & 7);
    int tn = (patch / npm) * 8 + (w >> 3);
    if (tm >= ntm || tn >= ntn) continue;
    const int m0 = tm * 128, n0 = tn * 128;
    const int b = m0 >> 11, sl = m0 & 2047;
    const bf16_t* A = p.hn + (size_t)m0 * DM;
    const bf16_t* W = p.WinT + (size_t)n0 * DM;
    if (n0 < 1024) {
      bf16_t* q = p.qn + (size_t)m0 * 1024 + n0;
      gemm_tile_bf16<false>(A, DM, W, DM, DM, lds, [&](int r, int c, float val) { q[(size_t)r * 1024 + c] = f2bf(val); });
    } else if (n0 < 2560) {
      const int seg = (n0 - 1024) >> 8, g = ((n0 - 1024) >> 7) & 1;
      if (seg == 3 || seg == 5) {
        bf16_t* vd = (seg == 3 ? p.vsT : p.vwT) + ((size_t)(b * 2 + g) * 128) * SEQ + sl;
        gemm_tile_bf16<true>(A, DM, W, DM, DM, lds, [&](int r, int c, float val) { vd[(size_t)r * SEQ + perm16(c)] = f2bf(val); });
      } else {
        bf16_t* base = (seg == 0) ? p.kcin : (seg == 1) ? p.vcin : (seg == 2) ? p.ks : p.kw;
        bf16_t* kd = base + ((size_t)(b * 2 + g) * SEQ + sl) * 128;
        gemm_tile_bf16<false>(A, DM, W, DM, DM, lds, [&](int r, int c, float val) { kd[(size_t)r * 128 + c] = f2bf(val); });
      }
    } else if (n0 < 3584) {
      bf16_t* q = p.qsb + (size_t)m0 * 1024 + (n0 - 2560);
      gemm_tile_bf16<false>(A, DM, W, DM, DM, lds, [&](int r, int c, float val) { q[(size_t)r * 1024 + c] = f2bf(val); });
    } else if (n0 < 4608) {
      bf16_t* kd = p.ksb + ((size_t)(b * 8 + ((n0 - 3584) >> 7)) * SEQ + sl) * 128;
      gemm_tile_bf16<false>(A, DM, W, DM, DM, lds, [&](int r, int c, float val) { kd[(size_t)r * 128 + c] = f2bf(val); });
    } else if (n0 < 5632) {
      bf16_t* vd = p.vsbT + ((size_t)(b * 8 + ((n0 - 4608) >> 7)) * 128) * SEQ + sl;
      gemm_tile_bf16<true>(A, DM, W, DM, DM, lds, [&](int r, int c, float val) { vd[(size_t)r * SEQ + perm16(c)] = f2bf(val); });
    } else {
      float* gd = p.gates + (size_t)m0 * 24;
      gemm_tile_bf16<false>(A, DM, W, DM, DM, lds, [&](int r, int c, float val) { if (c < 24) gd[(size_t)r * 24 + c] = val; });
    }
  }
}

__device__ __forceinline__ void ph_posb(const P& p) {
  const int lane = opq(threadIdx.x) & 63, wv = opq(threadIdx.x) >> 6;
  for (int o = blockIdx.x * 4 + wv; o < 256; o += gridDim.x * 4) {
    const int which = o >> 7, n = o & 127;
    const float* pos = which ? p.pos_v : p.pos_k;
    const float* w1 = which ? p.w1_v : p.w1_k;
    float acc = 0.f;
    for (int k = lane; k < 4096; k += 64) acc += pos[k] * w1[(size_t)k * 128 + n];
    acc = wave_sum(acc);
    if (lane == 0) p.posb[o] = acc;
  }
}

__device__ __forceinline__ void ph_compress2(const P& p, char* lds) {
  for (int item = blockIdx.x; item < 16; item += gridDim.x) {
    const int which = item >> 3, bg = item & 7;
    const bf16_t* src = (which ? p.vcin : p.kcin) + (size_t)bg * SEQ * 128;
    const bf16_t* w1t = p.w1T + (size_t)which * 128 * 4096;
    const bf16_t* w2t = p.w2T + (size_t)which * 128 * 128;
    const float* posb = p.posb + which * 128;
    bf16_t* c1 = p.c1 + (size_t)item * 128 * 128;
    gemm_tile_bf16<false>(src, 2048, w1t, 4096, 4096, lds, [&](int r, int c, float val) {
      c1[r * 128 + c] = f2bf(gelu_fast(val + posb[c])); });
    __threadfence_block();
    __syncthreads();
    if (which == 0) {
      bf16_t* kd = p.kcb + (size_t)bg * 128 * 128;
      gemm_tile_bf16<false>(c1, 128, w2t, 128, 128, lds, [&](int r, int c, float val) { kd[r * 128 + c] = f2bf(val); });
    } else {
      bf16_t* vd = p.vcT + (size_t)bg * 128 * 128;
      gemm_tile_bf16<true>(c1, 128, w2t, 128, 128, lds, [&](int r, int c, float val) { vd[r * 128 + perm16(c)] = f2bf(val); });
    }
  }
}

#define NEG_BIG (-1e30f)

struct KVRegs { u32x4 k0, k1, k2, k3, v0, v1, v2, v3; };

__device__ __forceinline__ int koff(int row, int chunk) { return row * 256 + ((chunk ^ (row & 15)) << 4); }

__device__ __forceinline__ void kv_load(KVRegs& r, const bf16_t* kp, int ldk, const bf16_t* vp, int ldv) {
  const int tid = opq(threadIdx.x);
  const bf16_t* kg = kp + (size_t)(tid >> 4) * ldk + (tid & 15) * 8;
  r.k0 = *(const u32x4*)kg;
  r.k1 = *(const u32x4*)(kg + (size_t)16 * ldk);
  r.k2 = *(const u32x4*)(kg + (size_t)32 * ldk);
  r.k3 = *(const u32x4*)(kg + (size_t)48 * ldk);
  const bf16_t* vg = vp + (size_t)(tid >> 3) * ldv + (tid & 7) * 8;
  r.v0 = *(const u32x4*)vg;
  r.v1 = *(const u32x4*)(vg + (size_t)32 * ldv);
  r.v2 = *(const u32x4*)(vg + (size_t)64 * ldv);
  r.v3 = *(const u32x4*)(vg + (size_t)96 * ldv);
}
__device__ __forceinline__ void kv_store(const KVRegs& r, char* lk, char* lv) {
  const int tid = opq(threadIdx.x);
  const int row = tid >> 4, ch = tid & 15;
  *(u32x4*)(lk + koff(row, ch)) = r.k0;
  *(u32x4*)(lk + koff(row + 16, ch)) = r.k1;
  *(u32x4*)(lk + koff(row + 32, ch)) = r.k2;
  *(u32x4*)(lk + koff(row + 48, ch)) = r.k3;
  const int vr = tid >> 3, vc = tid & 7;
  *(u32x4*)(lv + lds_off(vr, vc)) = r.v0;
  *(u32x4*)(lv + lds_off(vr + 32, vc)) = r.v1;
  *(u32x4*)(lv + lds_off(vr + 64, vc)) = r.v2;
  *(u32x4*)(lv + lds_off(vr + 96, vc)) = r.v3;
}

struct QFrag { bf16x8 f0, f1, f2, f3, f4, f5, f6, f7; };
__device__ __forceinline__ void q_load(QFrag& q, const bf16_t* qrow) {
  const int h = (opq(threadIdx.x) & 63) >> 5;
  const bf16x8* p8 = (const bf16x8*)(qrow + 8 * h);
  q.f0 = p8[0]; q.f1 = p8[2]; q.f2 = p8[4]; q.f3 = p8[6]; q.f4 = p8[8]; q.f5 = p8[10]; q.f6 = p8[12]; q.f7 = p8[14];
}

__device__ __forceinline__ void qk_tile(const QFrag& q, const char* lk, f32x16& s0, f32x16& s1) {
  const int lane = opq(threadIdx.x) & 63, row = lane & 31, h = lane >> 5;
#pragma unroll
  for (int r = 0; r < 16; ++r) { s0[r] = 0.f; s1[r] = 0.f; }
#define QK_STEP(kk, qf)                                                                  \
  {                                                                                      \
    bf16x8 a0 = *(const bf16x8*)(lk + koff(row, 2 * (kk) + h));                          \
    bf16x8 a1 = *(const bf16x8*)(lk + koff(row + 32, 2 * (kk) + h));                     \
    s0 = __builtin_amdgcn_mfma_f32_32x32x16_bf16(a0, qf, s0, 0, 0, 0);                   \
    s1 = __builtin_amdgcn_mfma_f32_32x32x16_bf16(a1, qf, s1, 0, 0, 0);                   \
  }
  QK_STEP(0, q.f0) QK_STEP(1, q.f1) QK_STEP(2, q.f2) QK_STEP(3, q.f3)
  QK_STEP(4, q.f4) QK_STEP(5, q.f5) QK_STEP(6, q.f6) QK_STEP(7, q.f7)
#undef QK_STEP
}

__device__ __forceinline__ bf16x8 pack8(const f32x16& p, const int base) {
  u32x4 u;
  u[0] = pack2(p[base + 0], p[base + 1]);
  u[1] = pack2(p[base + 2], p[base + 3]);
  u[2] = pack2(p[base + 4], p[base + 5]);
  u[3] = pack2(p[base + 6], p[base + 7]);
  return __builtin_bit_cast(bf16x8, u);
}

struct OAcc { f32x16 o0, o1, o2, o3; };
__device__ __forceinline__ void oacc_zero(OAcc& o) {
#pragma unroll
  for (int r = 0; r < 16; ++r) { o.o0[r] = 0.f; o.o1[r] = 0.f; o.o2[r] = 0.f; o.o3[r] = 0.f; }
}
__device__ __forceinline__ void oacc_scale(OAcc& o, float a) {
#pragma unroll
  for (int r = 0; r < 16; ++r) { o.o0[r] *= a; o.o1[r] *= a; o.o2[r] *= a; o.o3[r] *= a; }
}

__device__ __forceinline__ void pv_tile(OAcc& o, const char* lv, const f32x16& p0, const f32x16& p1) {
  const int lane = opq(threadIdx.x) & 63, row = lane & 31, h = lane >> 5;
  const bf16x8 pf0 = pack8(p0, 0), pf1 = pack8(p0, 8), pf2 = pack8(p1, 0), pf3 = pack8(p1, 8);
#define PV_ROW(dd, acc)                                                                                      \
  {                                                                                                          \
    acc = __builtin_amdgcn_mfma_f32_32x32x16_bf16(*(const bf16x8*)(lv + lds_off(32 * (dd) + row, 0 + h)), pf0, acc, 0, 0, 0); \
    acc = __builtin_amdgcn_mfma_f32_32x32x16_bf16(*(const bf16x8*)(lv + lds_off(32 * (dd) + row, 2 + h)), pf1, acc, 0, 0, 0); \
    acc = __builtin_amdgcn_mfma_f32_32x32x16_bf16(*(const bf16x8*)(lv + lds_off(32 * (dd) + row, 4 + h)), pf2, acc, 0, 0, 0); \
    acc = __builtin_amdgcn_mfma_f32_32x32x16_bf16(*(const bf16x8*)(lv + lds_off(32 * (dd) + row, 6 + h)), pf3, acc, 0, 0, 0); \
  }
  PV_ROW(0, o.o0) PV_ROW(1, o.o1) PV_ROW(2, o.o2) PV_ROW(3, o.o3)
#undef PV_ROW
}

__device__ __forceinline__ void softmax_tile(f32x16& s0, f32x16& s1, float& m, float& l, OAcc& o) {
  float mx = NEG_BIG;
#pragma unroll
  for (int r = 0; r < 16; ++r) mx = fmaxf(mx, fmaxf(s0[r], s1[r]));
  mx = fmaxf(mx, __shfl_xor(mx, 32));
  const float mn = fmaxf(m, mx);
  const float alpha = __expf(m - mn);
  float ls = 0.f;
#pragma unroll
  for (int r = 0; r < 16; ++r) {
    float a = (s0[r] > -1e29f) ? __expf(s0[r] - mn) : 0.f;
    float b = (s1[r] > -1e29f) ? __expf(s1[r] - mn) : 0.f;
    s0[r] = a; s1[r] = b;
    ls += a + b;
  }
  ls += __shfl_xor(ls, 32);
  l = l * alpha + ls;
  m = mn;
  if (__any(alpha != 1.f)) oacc_scale(o, alpha);
}

template <class F>
__device__ __forceinline__ void oacc_foreach(const OAcc& o, F f) {
  const int h = (opq(threadIdx.x) & 63) >> 5;
#pragma unroll
  for (int rho = 0; rho < 4; ++rho) {
    f(0 + 8 * rho + 4 * h, o.o0[4 * rho], o.o0[4 * rho + 1], o.o0[4 * rho + 2], o.o0[4 * rho + 3]);
    f(32 + 8 * rho + 4 * h, o.o1[4 * rho], o.o1[4 * rho + 1], o.o1[4 * rho + 2], o.o1[4 * rho + 3]);
    f(64 + 8 * rho + 4 * h, o.o2[4 * rho], o.o2[4 * rho + 1], o.o2[4 * rho + 2], o.o2[4 * rho + 3]);
    f(96 + 8 * rho + 4 * h, o.o3[4 * rho], o.o3[4 * rho + 1], o.o3[4 * rho + 2], o.o3[4 * rho + 3]);
  }
}

__device__ __forceinline__ void ph_memattn2(const P& p, char* lds) {
  char* lk = lds;
  char* lv = lds + 16384;
  const int lane = opq(threadIdx.x) & 63, wv = opq(threadIdx.x) >> 6;
  for (int item = blockIdx.x; item < NBATCH * 4 * (SEQ / 128); item += gridDim.x) {
    const int tb = item % (SEQ / 128);
    const int bh = item / (SEQ / 128);
    const int b = bh >> 2, hd = bh & 3;
    const int t = tb * 128 + wv * 32 + (lane & 31);
    QFrag q;
    q_load(q, p.qmemb + (size_t)(b * SEQ + t) * 512 + hd * 128);
    const bf16_t* kb = p.kmemb + (size_t)bh * 256 * 128;
    const bf16_t* vb = p.vmemT + (size_t)bh * 128 * 256;
    OAcc o;
    oacc_zero(o);
    float m = NEG_BIG, l = 0.f;
    KVRegs kv;
    kv_load(kv, kb, 128, vb, 256);
#pragma unroll 1
    for (int ti = 0; ti < 4; ++ti) {
      __syncthreads();
      kv_store(kv, lk, lv);
      __syncthreads();
      {
        const int tn = (ti + 1 < 4) ? ti + 1 : 3;
        kv_load(kv, kb + (size_t)tn * 64 * 128, 128, vb + tn * 64, 256);
      }
      f32x16 s0, s1;
      qk_tile(q, lk, s0, s1);
#pragma unroll
      for (int r = 0; r < 16; ++r) { s0[r] *= ATT_SCALE; s1[r] *= ATT_SCALE; }
      softmax_tile(s0, s1, m, l, o);
      pv_tile(o, lv, s0, s1);
    }
    const float il = 1.f / l;
    const int t2 = tb * 128 + (opq(threadIdx.x) >> 6) * 32 + (opq(threadIdx.x) & 31);
    bf16_t* orow = p.omem + (size_t)(b * SEQ + t2) * 512 + hd * 128;
    oacc_foreach(o, [&](int d, float v0, float v1, float v2, float v3) {
      uint2 u;
      u.x = pack2(v0 * il, v1 * il);
      u.y = pack2(v2 * il, v3 * il);
      *(uint2*)(orow + d) = u;
    });
  }
}

__device__ __forceinline__ void ph_sb2(const P& p, char* lds) {
  char* lk = lds;
  char* lv = lds + 16384;
  const int lane = opq(threadIdx.x) & 63, wv = opq(threadIdx.x) >> 6, hh = lane >> 5;
  for (int item = blockIdx.x; item < NBATCH * 8 * (SEQ / 128); item += gridDim.x) {
    const int tb = (SEQ / 128 - 1) - (item % (SEQ / 128));
    const int bh = item / (SEQ / 128);
    const int b = bh >> 3, hd = bh & 7;
    const int t0 = tb * 128;
    const int t = t0 + wv * 32 + (lane & 31);
    QFrag q;
    q_load(q, p.qsb + (size_t)(b * SEQ + t) * 1024 + hd * 128);
    const bf16_t* kb = p.ksb + (size_t)bh * SEQ * 128;
    const bf16_t* vb = p.vsbT + (size_t)bh * 128 * SEQ;
    OAcc o;
    oacc_zero(o);
    float carry = 0.f;
    const int jhi = (t0 >> 6) + 1;
    const int jw = (t0 + wv * 32 + 30) >> 6;
    KVRegs kv;
    kv_load(kv, kb + (size_t)jhi * 64 * 128, 128, vb + jhi * 64, SEQ);
    volatile unsigned* dflag = (volatile unsigned*)(lds + 32768);
    __syncthreads();
    if (opq(threadIdx.x) < 4) dflag[opq(threadIdx.x)] = 0u;
    for (int j = jhi; j >= 0; --j) {
      __syncthreads();
      if ((dflag[0] & dflag[1] & dflag[2] & dflag[3]) != 0u) break;
      kv_store(kv, lk, lv);
      __syncthreads();
      const int jn = (j > 0) ? j - 1 : 0;
      if (j > jw) kv_load(kv, kb + (size_t)jn * 64 * 128, 128, vb + jn * 64, SEQ);
      if (j <= jw) {
        f32x16 z0, z1;
        qk_tile(q, lk, z0, z1);
        const int sbase = j * 64 + 4 * hh;
        float gt[8];
        f32x16 l0, l1;
#pragma unroll
        for (int r = 0; r < 16; ++r) {
          const int so = sbase + 8 * (r >> 2) + (r & 3);
          {
            const float z = z0[r] * ATT_SCALE;
            const bool valid = so < t;
            const float lsp = fminf(z, 0.f) - __logf(1.f + __expf(-fabsf(z)));
            l0[r] = valid ? (lsp - z) : 0.f;
            z0[r] = valid ? z : NEG_BIG;
          }
          {
            const float z = z1[r] * ATT_SCALE;
            const bool valid = so + 32 < t;
            const float lsp = fminf(z, 0.f) - __logf(1.f + __expf(-fabsf(z)));
            l1[r] = valid ? (lsp - z) : 0.f;
            z1[r] = valid ? z : NEG_BIG;
          }
        }
#pragma unroll
        for (int rho = 0; rho < 4; ++rho) {
          gt[rho] = (l0[4 * rho] + l0[4 * rho + 1]) + (l0[4 * rho + 2] + l0[4 * rho + 3]);
          gt[4 + rho] = (l1[4 * rho] + l1[4 * rho + 1]) + (l1[4 * rho + 2] + l1[4 * rho + 3]);
        }
        float ag[8];
        float run = 0.f;
#pragma unroll
        for (int k = 7; k >= 0; --k) {
          const float pg = __shfl_xor(gt[k], 32);
          ag[k] = carry + run + (hh == 0 ? pg : 0.f);
          run += gt[k] + pg;
        }
        carry += run;
#pragma unroll
        for (int rho = 0; rho < 4; ++rho) {
          {
            const float x3 = l0[4 * rho + 3], x23 = x3 + l0[4 * rho + 2], x123 = x23 + l0[4 * rho + 1];
            const float g = ag[rho];
            z0[4 * rho + 0] = __expf((l0[4 * rho + 0] + z0[4 * rho + 0]) + (g + x123));
            z0[4 * rho + 1] = __expf((l0[4 * rho + 1] + z0[4 * rho + 1]) + (g + x23));
            z0[4 * rho + 2] = __expf((l0[4 * rho + 2] + z0[4 * rho + 2]) + (g + x3));
            z0[4 * rho + 3] = __expf((l0[4 * rho + 3] + z0[4 * rho + 3]) + g);
          }
          {
            const float x3 = l1[4 * rho + 3], x23 = x3 + l1[4 * rho + 2], x123 = x23 + l1[4 * rho + 1];
            const float g = ag[4 + rho];
            z1[4 * rho + 0] = __expf((l1[4 * rho + 0] + z1[4 * rho + 0]) + (g + x123));
            z1[4 * rho + 1] = __expf((l1[4 * rho + 1] + z1[4 * rho + 1]) + (g + x23));
            z1[4 * rho + 2] = __expf((l1[4 * rho + 2] + z1[4 * rho + 2]) + (g + x3));
            z1[4 * rho + 3] = __expf((l1[4 * rho + 3] + z1[4 * rho + 3]) + g);
          }
        }
        kv_load(kv, kb + (size_t)jn * 64 * 128, 128, vb + jn * 64, SEQ);
        pv_tile(o, lv, z0, z1);
        if (__all(carry < -104.f) && (opq(threadIdx.x) & 63) == 0) dflag[wv] = 1u;
      }
    }
    int t2 = t;
    asm volatile("" : "+v"(t2));
    bf16_t* orow = p.omix + (size_t)(b * SEQ + t2) * DM + 1024 + hd * 128;
    oacc_foreach(o, [&](int d, float v0, float v1, float v2, float v3) {
      uint2 u;
      u.x = pack2(v0, v1);
      u.y = pack2(v2, v3);
      *(uint2*)(orow + d) = u;
    });
  }
}

#define NSA_IMP 32768
#define NSA_KEYS 49152
#define NSA_SELM 53504
#define NSA_LUT 53632
__device__ __forceinline__ void ph_nsa2(const P& p, char* lds) {
  typedef __attribute__((ext_vector_type(4))) float f32x4;
  char* lk = lds;
  char* lv = lds + 16384;
  float* imp = (float*)(lds + NSA_IMP);
  float* keys = (float*)(lds + NSA_KEYS);
  unsigned* selm = (unsigned*)(lds + NSA_SELM);
  const int tid = opq(threadIdx.x), lane = tid & 63, wv = tid >> 6, hh = lane >> 5, ql = lane & 31;
  float* lut = (float*)(lds + NSA_LUT) + wv * 128;
  for (int item = blockIdx.x; item < NBATCH * 2 * (SEQ / 32); item += gridDim.x) {
    const int tt = (item < 256) ? (SEQ / 32 - 1) - (item % (SEQ / 32)) : (item % (SEQ / 32));
    const int bg = item / (SEQ / 32);
    const int b = bg >> 1, g = bg & 1;
    const int h = g * 4 + wv;
    const int t0 = tt * 32, tq = t0 + ql, cur = t0 >> 6;
    __syncthreads();
    QFrag q;
    q_load(q, p.qn + (size_t)(b * SEQ + tq) * 1024 + h * 128);
    {
      const int lo = opq(lane);
      lut[lo] = p.t5[t5_bucket(lo) * 8 + h];
      lut[lo + 64] = p.t5[t5_bucket(lo + 64) * 8 + h];
    }
#pragma unroll
    for (int i = 0; i < 16; ++i) imp[i * 256 + tid] = 0.f;
    if (tid < 32) selm[tid] = 0u;
    const float* grow = p.gates + (size_t)(b * SEQ + tq) * 24 + h * 3;
    float* prow = p.part + (size_t)(b * SEQ + tq) * 1024 + h * 128;
    OAcc o;
    float m, l;
    KVRegs kv;
    {
      const bf16_t* kb = p.kcb + (size_t)bg * 128 * 128;
      const bf16_t* vb = p.vcT + (size_t)bg * 128 * 128;
      oacc_zero(o);
      m = NEG_BIG; l = 0.f;
      kv_load(kv, kb, 128, vb, 128);
      __syncthreads();
      kv_store(kv, lk, lv);
      __syncthreads();
      f32x16 x0, x1;
      qk_tile(q, lk, x0, x1);
      int tqv = tq;
      asm volatile("" : "+v"(tqv));
      tqv -= 64 * hh;
      if (t0 >= 1152) {
        const float b31 = lut[127];
#pragma unroll
        for (int r = 0; r < 16; ++r) { x0[r] = x0[r] * ATT_SCALE + b31; x1[r] = x1[r] * ATT_SCALE + b31; }
      } else {
#pragma unroll
        for (int r = 0; r < 16; ++r) {
          const int c = 8 * (r >> 2) + (r & 3);
          const int d0 = tqv - 16 * c - 31, d1 = d0 - 512;
          x0[r] = (d0 >= 0) ? x0[r] * ATT_SCALE + lut[min(d0, 127)] : NEG_BIG;
          x1[r] = (d1 >= 0) ? x1[r] * ATT_SCALE + lut[min(d1, 127)] : NEG_BIG;
        }
      }
      softmax_tile(x0, x1, m, l, o);
      const float m0 = m;
      pv_tile(o, lv, x0, x1);
      f32x16 z0, z1;
#pragma unroll
      for (int r = 0; r < 16; ++r) { z0[r] = 0.f; z1[r] = 0.f; }
      if (t0 >= 1024) {
        kv_load(kv, kb + 64 * 128, 128, vb + 64, 128);
        __syncthreads();
        kv_store(kv, lk, lv);
        __syncthreads();
        qk_tile(q, lk, z0, z1);
        asm volatile("" : "+v"(tqv));
#pragma unroll
        for (int r = 0; r < 16; ++r) {
          const int c = 64 + 8 * (r >> 2) + (r & 3);
          const int d0 = tqv - 16 * c - 31, d1 = d0 - 512;
          z0[r] = (d0 >= 0) ? z0[r] * ATT_SCALE + lut[min(d0, 127)] : NEG_BIG;
          z1[r] = (d1 >= 0) ? z1[r] * ATT_SCALE + lut[min(d1, 127)] : NEG_BIG;
        }
        softmax_tile(z0, z1, m, l, o);
        pv_tile(o, lv, z0, z1);
      }
      const float inv = 1.f / fmaxf(l, 1e-20f);
      const float c0 = __expf(m0 - m) * inv;
#pragma unroll
      for (int r = 0; r < 16; ++r) {
        const int c = 8 * (r >> 2) + (r & 3) + 4 * hh;
        if (x0[r] != 0.f) atomicAdd(&imp[(c) * 32 + ql], x0[r] * c0);
        if (x1[r] != 0.f) atomicAdd(&imp[(c + 32) * 32 + ql], x1[r] * c0);
        if (z0[r] != 0.f) atomicAdd(&imp[(c + 64) * 32 + ql], z0[r] * inv);
        if (z1[r] != 0.f) atomicAdd(&imp[(c + 96) * 32 + ql], z1[r] * inv);
      }
      const float gs = inv / (1.f + __expf(-grow[0]));
      oacc_foreach(o, [&](int d, float v0, float v1, float v2, float v3) {
        f32x4 u = {v0 * gs, v1 * gs, v2 * gs, v3 * gs};
        *(f32x4*)(prow + d) = u;
      });
    }
    __syncthreads();
    {
      const int tido = opq(tid);
      const int qq = tido & 31, jg = tido >> 5;
#pragma unroll
      for (int jj = 0; jj < 4; ++jj) {
        const int j = jg * 4 + jj;
        float v = imp[(4 * j) * 32 + qq] + imp[(4 * j + 1) * 32 + qq] + imp[(4 * j + 2) * 32 + qq] + 0.5f * imp[(4 * j + 3) * 32 + qq];
        if (j > 0) v += 0.5f * imp[(4 * j - 1) * 32 + qq];
        const bool forced = (j == 0) || (j == cur) || (j == cur - 1);
        keys[qq * 33 + j] = forced ? 1e9f : ((j <= cur) ? v : -1e9f);
      }
      __syncthreads();
      unsigned bits = 0u;
#pragma unroll
      for (int jj = 0; jj < 4; ++jj) {
        const int j = jg * 4 + jj;
        const float kj = keys[qq * 33 + j];
        int rank = 0;
        for (int i = 0; i < 32; ++i) {
          const float ki = keys[qq * 33 + i];
          rank += (ki > kj || (ki == kj && i < j)) ? 1 : 0;
        }
        if (rank < 16 && j <= cur) bits |= 1u << j;
      }
      atomicOr(&selm[qq], bits);
      __syncthreads();
    }
    const unsigned mysel = selm[ql];
    unsigned um = mysel;
#pragma unroll
    for (int o2 = 16; o2 > 0; o2 >>= 1) um |= (unsigned)__shfl_xor((int)um, o2);
    um = (unsigned)__builtin_amdgcn_readfirstlane((int)um);
    {
      const bf16_t* kb = p.ks + (size_t)bg * SEQ * 128;
      const bf16_t* vb = p.vsT + (size_t)bg * 128 * SEQ;
      oacc_zero(o);
      m = NEG_BIG; l = 0.f;
      unsigned rem = um;
      int j = __builtin_ctz(rem);
      kv_load(kv, kb + (size_t)j * 64 * 128, 128, vb + j * 64, SEQ);
      while (rem) {
        j = __builtin_ctz(rem);
        rem &= rem - 1;
        const int jn = rem ? __builtin_ctz(rem) : j;
        __syncthreads();
        kv_store(kv, lk, lv);
        __syncthreads();
        f32x16 s0, s1;
        qk_tile(q, lk, s0, s1);
        const bool selq = (mysel >> j) & 1u;
        int tqv = tq;
        asm volatile("" : "+v"(tqv));
        if (j * 64 + 63 + 113 <= t0) {
          const float sc = selq ? ATT_SCALE : 0.f, bb = selq ? lut[127] : NEG_BIG;
#pragma unroll
          for (int r = 0; r < 16; ++r) { s0[r] = s0[r] * sc + bb; s1[r] = s1[r] * sc + bb; }
        } else {
#pragma unroll
          for (int r = 0; r < 16; ++r) {
            const int d0 = tqv - (j * 64 + 8 * (r >> 2) + (r & 3) + 4 * hh), d1 = d0 - 32;
            s0[r] = (selq && d0 >= 0) ? s0[r] * ATT_SCALE + lut[min(d0, 127)] : NEG_BIG;
            s1[r] = (selq && d1 >= 0) ? s1[r] * ATT_SCALE + lut[min(d1, 127)] : NEG_BIG;
          }
        }
        kv_load(kv, kb + (size_t)jn * 64 * 128, 128, vb + jn * 64, SEQ);
        softmax_tile(s0, s1, m, l, o);
        pv_tile(o, lv, s0, s1);
      }
      const float gs = 1.f / (fmaxf(l, 1e-20f) * (1.f + __expf(-grow[1])));
      int qo = ql;
      asm volatile("" : "+v"(qo));
      float* pr2 = p.part + (size_t)(b * SEQ + t0 + qo) * 1024 + h * 128;
      oacc_foreach(o, [&](int d, float v0, float v1, float v2, float v3) {
        f32x4 u = *(f32x4*)(pr2 + d);
        u[0] += v0 * gs; u[1] += v1 * gs; u[2] += v2 * gs; u[3] += v3 * gs;
        *(f32x4*)(pr2 + d) = u;
      });
    }
    {
      const bf16_t* kb = p.kw + (size_t)bg * SEQ * 128;
      const bf16_t* vb = p.vwT + (size_t)bg * 128 * SEQ;
      oacc_zero(o);
      m = NEG_BIG; l = 0.f;
      int jlo = (t0 - 511) >> 6;
      if (jlo < 0) jlo = 0;
      kv_load(kv, kb + (size_t)jlo * 64 * 128, 128, vb + jlo * 64, SEQ);
      for (int j = jlo; j <= cur; ++j) {
        const int jn = (j < cur) ? j + 1 : j;
        __syncthreads();
        kv_store(kv, lk, lv);
        __syncthreads();
        f32x16 s0, s1;
        qk_tile(q, lk, s0, s1);
        int tqv = tq;
        asm volatile("" : "+v"(tqv));
        if (j * 64 + 63 + 113 <= t0 && t0 + 31 - j * 64 < 512) {
          const float b31 = lut[127];
#pragma unroll
          for (int r = 0; r < 16; ++r) { s0[r] = s0[r] * ATT_SCALE + b31; s1[r] = s1[r] * ATT_SCALE + b31; }
        } else {
#pragma unroll
          for (int r = 0; r < 16; ++r) {
            const int d0 = tqv - (j * 64 + 8 * (r >> 2) + (r & 3) + 4 * hh), d1 = d0 - 32;
            s0[r] = (d0 >= 0 && d0 < 512) ? s0[r] * ATT_SCALE + lut[min(d0, 127)] : NEG_BIG;
            s1[r] = (d1 >= 0 && d1 < 512) ? s1[r] * ATT_SCALE + lut[min(d1, 127)] : NEG_BIG;
          }
        }
        kv_load(kv, kb + (size_t)jn * 64 * 128, 128, vb + jn * 64, SEQ);
        softmax_tile(s0, s1, m, l, o);
        pv_tile(o, lv, s0, s1);
      }
      const float gs = 1.f / (fmaxf(l, 1e-20f) * (1.f + __expf(-grow[2])));
      int qo = ql;
      asm volatile("" : "+v"(qo));
      const float* pr2 = p.part + (size_t)(b * SEQ + t0 + qo) * 1024 + h * 128;
      bf16_t* orow = p.omix + (size_t)(b * SEQ + t0 + qo) * DM + h * 128;
      oacc_foreach(o, [&](int d, float v0, float v1, float v2, float v3) {
        const f32x4 u = *(const f32x4*)(pr2 + d);
        uint2 w;
        w.x = pack2(u[0] + v0 * gs, u[1] + v1 * gs);
        w.y = pack2(u[2] + v2 * gs, u[3] + v3 * gs);
        *(uint2*)(orow + d) = w;
      });
    }
  }
}

__device__ __forceinline__ void ph_cvt(const float* src, bf16_t* dst, size_t n) {
  typedef __attribute__((ext_vector_type(4))) float f32x4;
  const size_t nv = n / 8;
  for (size_t i = (size_t)blockIdx.x * 256 + opq(threadIdx.x); i < nv; i += (size_t)gridDim.x * 256) {
    const f32x4 a = ((const f32x4*)src)[2 * i], b = ((const f32x4*)src)[2 * i + 1];
    u32x4 o;
    o[0] = pack2(a[0], a[1]); o[1] = pack2(a[2], a[3]); o[2] = pack2(b[0], b[1]); o[3] = pack2(b[2], b[3]);
    ((u32x4*)dst)[i] = o;
  }
}

__device__ __forceinline__ void ph_scores(const P& p, char* lds) {
  for (int u = blockIdx.x; u < 64 * 16; u += gridDim.x) {
    const int tm = u & 63, hp = u >> 6;
    const int m0 = tm * 128;
    float* sc = p.scores + (size_t)m0 * DM + hp * 128;
    gemm_tile_bf16<false>(p.omix + (size_t)m0 * DM + hp * 128, DM, p.subkb + (size_t)hp * 128 * 128, 128, 128, lds,
                          [&](int r, int c, float val) { sc[(size_t)r * DM + c] = val; });
  }
}

__device__ __forceinline__ void ph_cvt8(const float* src, unsigned char* dst, float* scales, int nrows, int wid0, int nw) {
  typedef __attribute__((ext_vector_type(4))) float f32x4;
  const int lane = opq(threadIdx.x) & 63;
  for (int row = wid0; row < nrows; row += nw) {
    const f32x4* s4 = (const f32x4*)(src + (size_t)row * DM);
    f32x4 v[8];
    float amax = 0.f;
#pragma unroll
    for (int c = 0; c < 2; ++c)
#pragma unroll
      for (int i = 0; i < 4; ++i) {
        v[c * 4 + i] = s4[c * 256 + lane * 4 + i];
#pragma unroll
        for (int k = 0; k < 4; ++k) amax = fmaxf(amax, fabsf(v[c * 4 + i][k]));
      }
    amax = wave_max(amax);
    const float sc = (amax > 0.f) ? 440.f / amax : 1.f;
#pragma unroll
    for (int c = 0; c < 2; ++c) {
      u32x4 o;
#pragma unroll
      for (int i = 0; i < 4; ++i) {
        int pk = 0;
        pk = __builtin_amdgcn_cvt_pk_fp8_f32(v[c * 4 + i][0] * sc, v[c * 4 + i][1] * sc, pk, false);
        pk = __builtin_amdgcn_cvt_pk_fp8_f32(v[c * 4 + i][2] * sc, v[c * 4 + i][3] * sc, pk, true);
        o[i] = (unsigned)pk;
      }
      *(u32x4*)(dst + (size_t)row * DM + c * 1024 + lane * 16) = o;
    }
    if (lane == 0) scales[row] = (amax > 0.f) ? amax / 440.f : 1.f;
  }
}

struct R8 { u32x4 r0, r1; };
__device__ __forceinline__ void r8_load(R8& r, const unsigned char* tab, int eid, int lane) {
  const u32x4* ur = (const u32x4*)(tab + (size_t)eid * DM) + lane;
  r.r0 = ur[0]; r.r1 = ur[64];
}
__device__ __forceinline__ float dot2q(unsigned w8, bool hi, unsigned xb, float c) {
  return __builtin_amdgcn_fdot2_f32_bf16(hi ? __builtin_amdgcn_cvt_scalef32_pk_bf16_fp8(w8, 1.0f, true)
                                            : __builtin_amdgcn_cvt_scalef32_pk_bf16_fp8(w8, 1.0f, false),
                                         __builtin_bit_cast(bf16v2, xb), c, false);
}
struct XPk { u32x4 a0, a1, b0, b1; };
struct Acc32 { f32x16 a, b; };

__device__ __forceinline__ float r8_dot(const R8& e, const XPk& x) {
  float pa = 0.f, pb = 0.f;
#pragma unroll
  for (int w = 0; w < 4; ++w) {
    const unsigned xa0 = (w < 2) ? x.a0[2 * w] : x.a1[2 * w - 4], xa1 = (w < 2) ? x.a0[2 * w + 1] : x.a1[2 * w - 3];
    const unsigned xb0 = (w < 2) ? x.b0[2 * w] : x.b1[2 * w - 4], xb1 = (w < 2) ? x.b0[2 * w + 1] : x.b1[2 * w - 3];
    pa = dot2q(e.r0[w], false, xa0, pa);
    pb = dot2q(e.r0[w], true, xa1, pb);
    pa = dot2q(e.r1[w], false, xb0, pa);
    pb = dot2q(e.r1[w], true, xb1, pb);
  }
  return pa + pb;
}
__device__ __forceinline__ void r8_axpy(const R8& e, float hid, Acc32& acc) {
  typedef __attribute__((ext_vector_type(2))) float f32x2;
#pragma unroll
  for (int w = 0; w < 4; ++w) {
    const f32x2 l0 = __builtin_amdgcn_cvt_pk_f32_fp8((int)e.r0[w], false), h0 = __builtin_amdgcn_cvt_pk_f32_fp8((int)e.r0[w], true);
    const f32x2 l1 = __builtin_amdgcn_cvt_pk_f32_fp8((int)e.r1[w], false), h1 = __builtin_amdgcn_cvt_pk_f32_fp8((int)e.r1[w], true);
    acc.a[4 * w + 0] += hid * l0[0]; acc.a[4 * w + 1] += hid * l0[1]; acc.a[4 * w + 2] += hid * h0[0]; acc.a[4 * w + 3] += hid * h0[1];
    acc.b[4 * w + 0] += hid * l1[0]; acc.b[4 * w + 1] += hid * l1[1]; acc.b[4 * w + 2] += hid * h1[0]; acc.b[4 * w + 3] += hid * h1[1];
  }
}

#define INS16(K, x)                                                                                      \
  K##15 = __builtin_amdgcn_fmed3f(K##15, K##14, x); K##14 = __builtin_amdgcn_fmed3f(K##14, K##13, x);   \
  K##13 = __builtin_amdgcn_fmed3f(K##13, K##12, x); K##12 = __builtin_amdgcn_fmed3f(K##12, K##11, x);   \
  K##11 = __builtin_amdgcn_fmed3f(K##11, K##10, x); K##10 = __builtin_amdgcn_fmed3f(K##10, K##9, x);    \
  K##9 = __builtin_amdgcn_fmed3f(K##9, K##8, x); K##8 = __builtin_amdgcn_fmed3f(K##8, K##7, x);         \
  K##7 = __builtin_amdgcn_fmed3f(K##7, K##6, x); K##6 = __builtin_amdgcn_fmed3f(K##6, K##5, x);         \
  K##5 = __builtin_amdgcn_fmed3f(K##5, K##4, x); K##4 = __builtin_amdgcn_fmed3f(K##4, K##3, x);         \
  K##3 = __builtin_amdgcn_fmed3f(K##3, K##2, x); K##2 = __builtin_amdgcn_fmed3f(K##2, K##1, x);         \
  K##1 = __builtin_amdgcn_fmed3f(K##1, K##0, x); K##0 = fmaxf(K##0, x);
#define DECL16(K) float K##0 = -INFINITY, K##1 = -INFINITY, K##2 = -INFINITY, K##3 = -INFINITY, K##4 = -INFINITY, \
  K##5 = -INFINITY, K##6 = -INFINITY, K##7 = -INFINITY, K##8 = -INFINITY, K##9 = -INFINITY, K##10 = -INFINITY,   \
  K##11 = -INFINITY, K##12 = -INFINITY, K##13 = -INFINITY, K##14 = -INFINITY, K##15 = -INFINITY;
__device__ __forceinline__ float mkkey(float v, unsigned tag, unsigned mask) {
  return __uint_as_float((__float_as_uint(v) & ~mask) | tag);
}

__device__ __forceinline__ void ph_peer(const P& p, float* smem) {
  typedef __attribute__((ext_vector_type(4))) float f32x4;
  const int tid = opq(threadIdx.x), lane = tid & 63, wv = tid >> 6;
  float* lists = smem;
  int* bexA = (int*)(smem + 4096);
  float* bgtA = smem + 6144;
  float* bsuA = smem + 8192;
  for (int item = blockIdx.x; item < T_TOK / 16; item += gridDim.x) {
    const int t0 = item * 16;
    __syncthreads();
    {
      const int tl = tid >> 4, hp = tid & 15;
      const f32x4* sp = (const f32x4*)(p.scores + (size_t)(t0 + tl) * DM + hp * 128);
      DECL16(k)
#pragma unroll 4
      for (int c4 = 0; c4 < 32; ++c4) {
        const f32x4 v = sp[c4];
#pragma unroll
        for (int e = 0; e < 4; ++e) {
          const float x = mkkey(v[e], 127u - (unsigned)(c4 * 4 + e), 127u);
          INS16(k, x)
        }
      }
      f32x4* lp = (f32x4*)(lists + (size_t)tid * 16);
      f32x4 o0 = {k0, k1, k2, k3}, o1 = {k4, k5, k6, k7}, o2 = {k8, k9, k10, k11}, o3 = {k12, k13, k14, k15};
      lp[0] = o0; lp[1] = o1; lp[2] = o2; lp[3] = o3;
    }
    __syncthreads();
    if (tid < 128) {
      const int tl = tid >> 3, h = tid & 7;
      const float* la = lists + (size_t)(tl * 16 + 2 * h) * 16;
      const float* lb = la + 16;
      float av[16], bv[16];
#pragma unroll
      for (int i = 0; i < 16; ++i) {
        av[i] = __uint_as_float(__float_as_uint(la[i]) & ~127u);
        bv[i] = __uint_as_float(__float_as_uint(lb[i]) & ~127u);
      }
      DECL16(c)
#pragma unroll
      for (int i = 0; i < 16; ++i) {
#pragma unroll
        for (int j = 0; j < 16; ++j) {
          if ((i + 1) * (j + 1) <= 16) {
            const float x = mkkey(av[i] + bv[j], 255u - (unsigned)(i * 16 + j), 255u);
            INS16(c, x)
          }
        }
      }
      float cs[16] = {c0, c1, c2, c3, c4, c5, c6, c7, c8, c9, c10, c11, c12, c13, c14, c15};
      float ev[16];
      float sum = 0.f;
      const float mx = __uint_as_float(__float_as_uint(cs[0]) & ~255u);
#pragma unroll
      for (int n = 0; n < 16; ++n) {
        ev[n] = __expf(__uint_as_float(__float_as_uint(cs[n]) & ~255u) - mx);
        sum += ev[n];
      }
      const float isum = 1.f / sum;
#pragma unroll
      for (int n = 0; n < 16; ++n) {
        const unsigned cc = 255u - (__float_as_uint(cs[n]) & 255u);
        const unsigned ka = 127u - (__float_as_uint(la[cc >> 4]) & 127u);
        const unsigned kb = 127u - (__float_as_uint(lb[cc & 15u]) & 127u);
        const int eid = (int)(ka * 128u + kb);
        bexA[tl * 128 + h * 16 + n] = eid;
        bgtA[tl * 128 + h * 16 + n] = ev[n] * isum * p.sv8[eid];
        bsuA[tl * 128 + h * 16 + n] = p.su8[eid];
      }
    }
    __syncthreads();
#pragma unroll 1
    for (int ti4 = 0; ti4 < 4; ++ti4) {
    const int tl = wv * 4 + ti4;
    const int t = t0 + tl;
    const int* bex = bexA + tl * 128;
    const float* bgt = bgtA + tl * 128;
    const float* bsu = bsuA + tl * 128;
    XPk x;
    {
      const f32x4* s4 = (const f32x4*)(p.out + (size_t)t * DM);
      const f32x4* g4 = (const f32x4*)p.norm_ffn;
      f32x4 a0 = s4[lane * 4], a1 = s4[lane * 4 + 1], a2 = s4[lane * 4 + 2], a3 = s4[lane * 4 + 3];
      f32x4 a4 = s4[256 + lane * 4], a5 = s4[256 + lane * 4 + 1], a6 = s4[256 + lane * 4 + 2], a7 = s4[256 + lane * 4 + 3];
      float ss = 0.f;
#define SSQ(v) ss += v[0] * v[0] + v[1] * v[1] + v[2] * v[2] + v[3] * v[3];
      SSQ(a0) SSQ(a1) SSQ(a2) SSQ(a3) SSQ(a4) SSQ(a5) SSQ(a6) SSQ(a7)
#undef SSQ
      ss = wave_sum(ss);
      const float rs = rsqrtf(ss * (1.f / DM) + RMS_EPS);
#define XPK(dst, va, vb, gi)                                                          \
  {                                                                                   \
    const f32x4 ga = g4[gi], gb = g4[gi + 1];                                         \
    dst[0] = pack2(va[0] * rs * ga[0], va[1] * rs * ga[1]);                           \
    dst[1] = pack2(va[2] * rs * ga[2], va[3] * rs * ga[3]);                           \
    dst[2] = pack2(vb[0] * rs * gb[0], vb[1] * rs * gb[1]);                           \
    dst[3] = pack2(vb[2] * rs * gb[2], vb[3] * rs * gb[3]);                           \
  }
      XPK(x.a0, a0, a1, lane * 4) XPK(x.a1, a2, a3, lane * 4 + 2) XPK(x.b0, a4, a5, 256 + lane * 4) XPK(x.b1, a6, a7, 256 + lane * 4 + 2)
#undef XPK
    }
    Acc32 acc;
#pragma unroll
    for (int r = 0; r < 16; ++r) { acc.a[r] = 0.f; acc.b[r] = 0.f; }
    R8 u0, u1, u2, u3, v0, v1, v2, v3;
    r8_load(u0, p.pu8, bex[0], lane); r8_load(u1, p.pu8, bex[1], lane); r8_load(u2, p.pu8, bex[2], lane); r8_load(u3, p.pu8, bex[3], lane);
    r8_load(v0, p.pv8, bex[0], lane); r8_load(v1, p.pv8, bex[1], lane); r8_load(v2, p.pv8, bex[2], lane); r8_load(v3, p.pv8, bex[3], lane);
#pragma unroll 1
    for (int e0 = 0; e0 < 128; e0 += 4) {
      float d0 = r8_dot(u0, x), d1 = r8_dot(u1, x), d2 = r8_dot(u2, x), d3 = r8_dot(u3, x);
      const int en = (e0 + 4 < 128) ? e0 + 4 : 124;
      const int i0 = bex[en], i1 = bex[en + 1], i2 = bex[en + 2], i3 = bex[en + 3];
      r8_load(u0, p.pu8, i0, lane); r8_load(u1, p.pu8, i1, lane); r8_load(u2, p.pu8, i2, lane); r8_load(u3, p.pu8, i3, lane);
#pragma unroll
      for (int o = 32; o > 0; o >>= 1) {
        d0 += __shfl_xor(d0, o); d1 += __shfl_xor(d1, o); d2 += __shfl_xor(d2, o); d3 += __shfl_xor(d3, o);
      }
      r8_axpy(v0, bgt[e0 + 0] * gelu_fast(d0 * bsu[e0 + 0]), acc);
      r8_axpy(v1, bgt[e0 + 1] * gelu_fast(d1 * bsu[e0 + 1]), acc);
      r8_axpy(v2, bgt[e0 + 2] * gelu_fast(d2 * bsu[e0 + 2]), acc);
      r8_axpy(v3, bgt[e0 + 3] * gelu_fast(d3 * bsu[e0 + 3]), acc);
      r8_load(v0, p.pv8, i0, lane); r8_load(v1, p.pv8, i1, lane); r8_load(v2, p.pv8, i2, lane); r8_load(v3, p.pv8, i3, lane);
    }
    const int lane2 = opq(lane);
    f32x4* o4 = (f32x4*)(p.out + (size_t)t * DM);
    const f32x4* g4 = (const f32x4*)p.norm_final;
    f32x4 hv[8];
    float ss = 0.f;
#pragma unroll
    for (int c = 0; c < 2; ++c)
#pragma unroll
      for (int i = 0; i < 4; ++i) {
        hv[c * 4 + i] = o4[c * 256 + lane2 * 4 + i];
#pragma unroll
        for (int k = 0; k < 4; ++k) {
          hv[c * 4 + i][k] += c ? acc.b[4 * i + k] : acc.a[4 * i + k];
          ss += hv[c * 4 + i][k] * hv[c * 4 + i][k];
        }
      }
    ss = wave_sum(ss);
    const float rs = rsqrtf(ss * (1.f / DM) + RMS_EPS);
#pragma unroll
    for (int c = 0; c < 2; ++c)
#pragma unroll
      for (int i = 0; i < 4; ++i) {
        const f32x4 g = g4[c * 256 + lane2 * 4 + i];
        f32x4 o;
#pragma unroll
        for (int k = 0; k < 4; ++k) o[k] = hv[c * 4 + i][k] * rs * g[k];
        o4[c * 256 + lane2 * 4 + i] = o;
      }
    }
  }
}

#define XB_TMO      128
#define XB_XCNT(j)  (256  + 64 * (j))
#define XB_XSUB(j)  (1280 + 64 * (j))
#define XB_XGEN(j)  (2304 + 64 * (j))
#define XB_TOP      3328
#define XB_TOPGEN   3392
#define XCD_BAR_WORDS 3456
#define XB_SPIN_CAP (1u << 22)
#define LAS __attribute__((address_space(3)))
__device__ __forceinline__ unsigned xb_ld(unsigned* p) { return __hip_atomic_load(p, __ATOMIC_RELAXED, __HIP_MEMORY_SCOPE_AGENT); }
__device__ __forceinline__ unsigned xb_add(unsigned* p, unsigned v) { return __hip_atomic_fetch_add(p, v, __ATOMIC_RELAXED, __HIP_MEMORY_SCOPE_AGENT); }
__device__ __forceinline__ unsigned xb_xcc_id() { return (unsigned)__builtin_amdgcn_s_getreg((3 << 11) | 20) & 0xFu; }
#define XB_SPIN(cond, bar) do { unsigned _sp = 0; while (cond) { __builtin_amdgcn_s_sleep(1); \
    if ((++_sp & 255u) == 0u) { if (xb_ld(&(bar)[XB_TMO])) break; if (_sp > XB_SPIN_CAP) { atomicAdd(&(bar)[XB_TMO], 1u); break; } } } } while (0)
struct XcdBarrier { unsigned* bar; unsigned x; volatile LAS unsigned* st; };
__device__ __forceinline__ XcdBarrier xcd_barrier_post(unsigned* bar, volatile LAS unsigned* st) {
  XcdBarrier b; b.bar = bar; b.x = xb_xcc_id(); b.st = st;
  if (threadIdx.x == 0) (void)xb_add(&bar[XB_XCNT(b.x)], 1u);
  return b;
}
__device__ __forceinline__ void xcd_barrier_complete(unsigned* bar, unsigned x, unsigned& nloc, unsigned& nx) {
  const unsigned G = gridDim.x * gridDim.y * gridDim.z;
  unsigned sum, cnt, mine, sp = 0u;
  for (;;) {
    sum = 0u; cnt = 0u; mine = 0u;
#pragma unroll
    for (unsigned j = 0; j < 16; ++j) { const unsigned c = xb_ld(&bar[XB_XCNT(j)]); sum += c; cnt += (c > 0u) ? 1u : 0u; mine = (j == x) ? c : mine; }
    if (sum == G) break;
    __builtin_amdgcn_s_sleep(1);
    if ((++sp & 255u) == 0u) { if (xb_ld(&bar[XB_TMO])) break; if (sp > XB_SPIN_CAP) { atomicAdd(&bar[XB_TMO], 1u); break; } }
  }
  nloc = mine > 0u ? mine : 1u; nx = cnt > 0u ? cnt : 1u;
}
__device__ __forceinline__ void xcd_barrier(const XcdBarrier& b) {
  asm volatile("s_waitcnt vmcnt(0)" ::: "memory");
  __syncthreads();
  if (threadIdx.x == 0) {
    unsigned* bar = b.bar;
    __builtin_amdgcn_s_waitcnt(0);
    unsigned nloc = b.st[0], nx = b.st[1];
    if (nloc == 0u) { xcd_barrier_complete(bar, b.x, nloc, nx); b.st[0] = nloc; b.st[1] = nx; }
    const unsigned old = xb_add(&bar[XB_XSUB(b.x)], 1u);
    const unsigned gen = old / nloc;
    if (old + 1u == (gen + 1u) * nloc) {
      __builtin_amdgcn_fence(__ATOMIC_RELEASE, "agent");
      asm volatile("s_waitcnt vmcnt(0)" ::: "memory");
      const unsigned og = xb_add(&bar[XB_TOP], 1u);
      const unsigned tg = og / nx;
      if (og + 1u == (tg + 1u) * nx) xb_add(&bar[XB_TOPGEN], 1u);
      else XB_SPIN(xb_ld(&bar[XB_TOPGEN]) == tg, bar);
      __builtin_amdgcn_fence(__ATOMIC_ACQUIRE, "agent");
      xb_add(&bar[XB_XGEN(b.x)], 1u);
      asm volatile("s_waitcnt vmcnt(0)" ::: "memory");
    } else {
      XB_SPIN(xb_ld(&bar[XB_XGEN(b.x)]) == gen, bar);
      __builtin_amdgcn_fence(__ATOMIC_ACQUIRE, "agent");
      asm volatile("s_waitcnt vmcnt(0)" ::: "memory");
    }
  }
  __syncthreads();
}

typedef const __attribute__((address_space(4))) P* KP;
__device__ __forceinline__ P loadP() {
#if defined(__HIP_DEVICE_COMPILE__)
  KP k = (KP)__builtin_amdgcn_kernarg_segment_ptr();
  asm volatile("" : "+s"(k));
  P p = *k;
  return p;
#else
  return P{};
#endif
}

__global__ void __launch_bounds__(256, 2) mega(P p_arg) {
  cg::grid_group grid = cg::this_grid();
  __shared__ __attribute__((aligned(16))) float smem[14336];
  char* lds = (char*)smem;
  __shared__ uint4 xb_words;
  if (threadIdx.x == 0) xb_words = make_uint4(0u, 0u, 0u, 0u);
  if (blockIdx.x == 0) {
    P p = loadP();
    for (int i = threadIdx.x; i < XCD_BAR_WORDS; i += 256) p.bar[i] = 0u;
  }
  { P p = loadP(); ph_rmsnorm(p.x, p.norm_mix, p.hn, T_TOK); ph_rmsnorm(p.mem, p.norm_mkv, p.memn, 1024); }
  { P p = loadP(); ph_transpose<true>(smem, p.w_in, DM, INC, 5760, p.WinT); }
  { P p = loadP(); ph_transpose<false>(smem, p.w_out, DM, DM, DM, p.WoutT); }
  { P p = loadP(); ph_transpose<false>(smem, p.w_pq, DM, DM, DM, p.WpqT); }
  { P p = loadP(); ph_transpose<false>(smem, p.w_mq, DM, 512, 512, p.WmqT); }
  { P p = loadP(); ph_transpose<false>(smem, p.w_mk, DM, 512, 512, p.WmkT); }
  { P p = loadP(); ph_transpose<false>(smem, p.w_mv, DM, 512, 512, p.WmvT); }
  { P p = loadP(); ph_transpose<false>(smem, p.w_mo, 512, DM, DM, p.WmoT); }
  { P p = loadP(); ph_cvt(p.subk, p.subkb, (size_t)16 * 128 * 128); }
  { P p = loadP(); ph_transpose<false>(smem, p.w1_k, 4096, 128, 128, p.w1T); }
  { P p = loadP(); ph_transpose<false>(smem, p.w1_v, 4096, 128, 128, p.w1T + 128 * 4096); }
  { P p = loadP(); ph_transpose<false>(smem, p.w2_k, 128, 128, 128, p.w2T); }
  { P p = loadP(); ph_transpose<false>(smem, p.w2_v, 128, 128, 128, p.w2T + 128 * 128); }
  { P p = loadP(); ph_posb(p); }
  grid.sync();
  XcdBarrier xb;
  { P p = loadP(); xb = xcd_barrier_post(p.bar, (volatile LAS unsigned*)&xb_words); }
  { P p = loadP(); ph_proj(p, lds); }
  { P p = loadP(); bf16_t* kmem = p.kmemb;
    ph_gemm_bf16(p.memn, DM, p.WmkT, DM, 1024, 512, DM, lds, [=](int m, int n, float v) {
      kmem[((size_t)((m >> 8) * 4 + (n >> 7)) * 256 + (m & 255)) * 128 + (n & 127)] = f2bf(v); }); }
  { P p = loadP(); bf16_t* vmem = p.vmemT;
    ph_gemm_bf16(p.memn, DM, p.WmvT, DM, 1024, 512, DM, lds, [=](int m, int n, float v) {
      vmem[((size_t)((m >> 8) * 4 + (n >> 7)) * 128 + (n & 127)) * 256 + perm16(m & 255)] = f2bf(v); }); }
  xcd_barrier(xb);
  { P p = loadP(); ph_compress2(p, lds); }
  { P p = loadP(); ph_sb2(p, lds); }
  xcd_barrier(xb);
  { P p = loadP(); ph_nsa2(p, lds); }
  xcd_barrier(xb);
  { P p = loadP(); float* out = p.out; const float* x = p.x;
    ph_gemm_bf16(p.omix, DM, p.WoutT, DM, T_TOK, DM, DM, lds, [=](int m, int n, float v) { out[(size_t)m * DM + n] = x[(size_t)m * DM + n] + v; }); }
  xcd_barrier(xb);
  { P p = loadP(); ph_rmsnorm(p.out, p.norm_mq, p.hn, T_TOK); }
  xcd_barrier(xb);
  if (blockIdx.x < 256 || gridDim.x < 512) {
    P p = loadP(); bf16_t* qmem = p.qmemb;
    ph_gemm_bf16(p.hn, DM, p.WmqT, DM, T_TOK, 512, DM, lds, [=](int m, int n, float v) { qmem[(size_t)m * 512 + n] = f2bf(v); });
  }
  {
    const int half = (gridDim.x >= 512) ? 256 : 0;
    if ((int)blockIdx.x >= half) {
      const int nwv = ((int)gridDim.x - half) * 4, wid = ((int)blockIdx.x - half) * 4 + (opq(threadIdx.x) >> 6);
      { P p = loadP(); ph_cvt8(p.pu, p.pu8, p.su8, 16384, wid, nwv); }
      { P p = loadP(); ph_cvt8(p.pv, p.pv8, p.sv8, 16384, wid, nwv); }
    }
  }
  xcd_barrier(xb);
  { P p = loadP(); ph_memattn2(p, lds); }
  xcd_barrier(xb);
  { P p = loadP(); float* out = p.out;
    ph_gemm_bf16(p.omem, 512, p.WmoT, 512, T_TOK, DM, 512, lds, [=](int m, int n, float v) { out[(size_t)m * DM + n] += v; }); }
  xcd_barrier(xb);
  { P p = loadP(); ph_rmsnorm(p.out, p.norm_ffn, p.hn, T_TOK); }
  xcd_barrier(xb);
  { P p = loadP(); bf16_t* qp = p.omix;
    ph_gemm_bf16(p.hn, DM, p.WpqT, DM, T_TOK, DM, DM, lds, [=](int m, int n, float v) { qp[(size_t)m * DM + n] = f2bf(v); }); }
  xcd_barrier(xb);
  { P p = loadP(); ph_scores(p, lds); }
  xcd_barrier(xb);
  { P p = loadP(); ph_peer(p, smem); }
}

extern "C" void kernel_launch(void* const* d_in, const int* in_sizes, int n_in, void* d_out, int out_size, void* d_ws,
                              size_t ws_size, hipStream_t stream) {
  P p{};
  p.x = (const float*)d_in[0]; p.mem = (const float*)d_in[1]; p.t5 = (const float*)d_in[2];
  p.norm_mix = (const float*)d_in[3]; p.w_in = (const float*)d_in[4]; p.pos_k = (const float*)d_in[5];
  p.w1_k = (const float*)d_in[6]; p.w2_k = (const float*)d_in[7]; p.pos_v = (const float*)d_in[8];
  p.w1_v = (const float*)d_in[9]; p.w2_v = (const float*)d_in[10]; p.w_out = (const float*)d_in[11];
  p.norm_mq = (const float*)d_in[12]; p.norm_mkv = (const float*)d_in[13]; p.w_mq = (const float*)d_in[14];
  p.w_mk = (const float*)d_in[15]; p.w_mv = (const float*)d_in[16]; p.w_mo = (const float*)d_in[17];
  p.norm_ffn = (const float*)d_in[18]; p.w_pq = (const float*)d_in[19]; p.subk = (const float*)d_in[20];
  p.pu = (const float*)d_in[21]; p.pv = (const float*)d_in[22]; p.norm_final = (const float*)d_in[23];
  p.out = (float*)d_out;
  char* w = (char*)d_ws;
  size_t off = 0;
  auto take = [&](size_t bytes) { char* r = w + off; off += (bytes + 255) & ~(size_t)255; return r; };
  p.bar = (unsigned*)take(XCD_BAR_WORDS * 4);
  p.scores = (float*)take((size_t)T_TOK * DM * 4);
  p.gates = (float*)take((size_t)T_TOK * 24 * 4);
  p.part = (float*)take((size_t)T_TOK * 1024 * 4);
  p.posb = (float*)take(256 * 4);
  p.qn = (bf16_t*)take((size_t)T_TOK * 1024 * 2);
  p.kcin = (bf16_t*)take((size_t)T_TOK * 256 * 2 + 65536);
  p.vcin = (bf16_t*)take((size_t)T_TOK * 256 * 2 + 65536);
  p.ks = (bf16_t*)take((size_t)T_TOK * 256 * 2);
  p.vsT = (bf16_t*)take((size_t)T_TOK * 256 * 2);
  p.kw = (bf16_t*)take((size_t)T_TOK * 256 * 2);
  p.vwT = (bf16_t*)take((size_t)T_TOK * 256 * 2);
  p.kcb = (bf16_t*)take((size_t)8 * 128 * 128 * 2);
  p.vcT = (bf16_t*)take((size_t)8 * 128 * 128 * 2);
  p.c1 = (bf16_t*)take((size_t)16 * 128 * 128 * 2);
  p.w1T = (bf16_t*)take((size_t)2 * 128 * 4096 * 2);
  p.w2T = (bf16_t*)take((size_t)2 * 128 * 128 * 2);
  p.hn = (bf16_t*)take((size_t)T_TOK * DM * 2);
  p.omix = (bf16_t*)take((size_t)T_TOK * DM * 2);
  p.memn = (bf16_t*)take((size_t)1024 * DM * 2);
  p.omem = (bf16_t*)take((size_t)T_TOK * 512 * 2);
  p.WinT = (bf16_t*)take((size_t)5760 * DM * 2);
  p.WoutT = (bf16_t*)take((size_t)DM * DM * 2);
  p.WpqT = (bf16_t*)take((size_t)DM * DM * 2);
  p.WmqT = (bf16_t*)take((size_t)512 * DM * 2);
  p.WmkT = (bf16_t*)take((size_t)512 * DM * 2);
  p.WmvT = (bf16_t*)take((size_t)512 * DM * 2);
  p.WmoT = (bf16_t*)take((size_t)DM * 512 * 2);
  p.qmemb = (bf16_t*)take((size_t)T_TOK * 512 * 2);
  p.kmemb = (bf16_t*)take((size_t)1024 * 512 * 2);
  p.vmemT = (bf16_t*)take((size_t)1024 * 512 * 2);
  p.qsb = (bf16_t*)take((size_t)T_TOK * 1024 * 2);
  p.ksb = (bf16_t*)take((size_t)T_TOK * 1024 * 2);
  p.vsbT = (bf16_t*)take((size_t)T_TOK * 1024 * 2);
  p.pu8 = (unsigned char*)take((size_t)16384 * DM);
  p.pv8 = (unsigned char*)take((size_t)16384 * DM);
  p.su8 = (float*)take(16384 * 4);
  p.sv8 = (float*)take(16384 * 4);
  p.subkb = (bf16_t*)take((size_t)16 * 128 * 128 * 2);
  static int grid_blocks = 0;
  if (!grid_blocks) {
    int dev = 0, cus = 0, per_cu = 0;
    (void)hipGetDevice(&dev);
    (void)hipDeviceGetAttribute(&cus, hipDeviceAttributeMultiprocessorCount, dev);
    (void)hipOccupancyMaxActiveBlocksPerMultiprocessor(&per_cu, mega, 256, 0);
    if (per_cu > 2) per_cu = 2;
    if (per_cu < 1) per_cu = 1;
    grid_blocks = cus * per_cu;
  }
  void* args[] = {&p};
  hipError_t e = hipLaunchCooperativeKernel((void*)mega, dim3(grid_blocks), dim3(256), args, 0, stream);
  if (e != hipSuccess) fprintf(stderr, "cooperative launch failed: %s (grid %d)\n", hipGetErrorString(e), grid_blocks);
}
```

```cpp
#include <hip/hip_runtime.h>
#include <hip/hip_cooperative_groups.h>
#include <cstdio>
namespace cg = cooperative_groups;
#include <stdint.h>

#define SEQ 2048
#define NBATCH 4
#define T_TOK 8192
#define DM 2048
#define INC 5656
#define C_QN 0
#define C_KC 1024
#define C_VC 1280
#define C_KS 1536
#define C_VS 1792
#define C_KW 2048
#define C_VW 2304
#define C_GT 2560
#define C_QSB 2584
#define C_KSB 3608
#define C_VSB 4632
#define ATT_SCALE 0.08838834764831845f
#define RMS_EPS 1e-6f

typedef unsigned short bf16_t;
typedef __attribute__((ext_vector_type(8))) short bf16x8;
typedef __attribute__((ext_vector_type(16))) float f32x16;
typedef __attribute__((ext_vector_type(2))) __bf16 bf16v2;
typedef __attribute__((ext_vector_type(4))) unsigned u32x4;

struct P {
  const float *x, *mem, *t5, *norm_mix, *w_in, *pos_k, *w1_k, *w2_k, *pos_v, *w1_v, *w2_v, *w_out,
      *norm_mq, *norm_mkv, *w_mq, *w_mk, *w_mv, *w_mo, *norm_ffn, *w_pq, *subk, *pu, *pv, *norm_final;
  float* out;
  float *scores, *gates, *part, *posb;
  unsigned* bar;
  bf16_t *hn, *omix, *memn, *omem;
  bf16_t *WinT, *WoutT, *WpqT, *WmqT, *WmkT, *WmvT, *WmoT;
  bf16_t *qmemb, *kmemb, *vmemT;
  bf16_t *qsb, *ksb, *vsbT;
  bf16_t* subkb;
  unsigned char *pu8, *pv8;
  float *su8, *sv8;
  bf16_t *qn, *kcin, *vcin, *ks, *vsT, *kw, *vwT, *kcb, *vcT, *c1, *w1T, *w2T;
};

__device__ __forceinline__ int opq(int v) { asm volatile("" : "+v"(v)); return v; }
__device__ __forceinline__ unsigned pack2(float a, float b) {
  bf16v2 r = {(__bf16)a, (__bf16)b};
  return *(unsigned*)&r;
}
__device__ __forceinline__ bf16_t f2bf(float a) {
  __bf16 r = (__bf16)a;
  return *(bf16_t*)&r;
}
__device__ __forceinline__ int perm16(int s) { return (s & ~12) | ((s & 4) << 1) | ((s & 8) >> 1); }
__device__ __forceinline__ float bf2f(bf16_t u) { return __uint_as_float((unsigned)u << 16); }

__device__ __forceinline__ float wave_max(float v) {
  for (int o = 32; o > 0; o >>= 1) v = fmaxf(v, __shfl_xor(v, o));
  return v;
}
__device__ __forceinline__ float wave_sum(float v) {
  for (int o = 32; o > 0; o >>= 1) v += __shfl_xor(v, o);
  return v;
}
__device__ __forceinline__ void wave_argmax(float& v, int& i) {
  for (int o = 32; o > 0; o >>= 1) {
    float ov = __shfl_xor(v, o);
    int oi = __shfl_xor(i, o);
    if (ov > v || (ov == v && oi < i)) { v = ov; i = oi; }
  }
}
__device__ __forceinline__ float gelu_tanh(float x) {
  return 0.5f * x * (1.f + tanhf(0.7978845608028654f * (x + 0.044715f * x * x * x)));
}
__device__ __forceinline__ float gelu_fast(float x) {
  const float y = 1.5957691216057308f * (x + 0.044715f * x * x * x);
  return x / (1.f + __expf(-y));
}
__device__ __forceinline__ int t5_bucket(int n) {
  if (n < 16) return n < 0 ? 0 : n;
  int b = 16;
  b += (n >= 19); b += (n >= 21); b += (n >= 24); b += (n >= 27); b += (n >= 31); b += (n >= 35);
  b += (n >= 40); b += (n >= 46); b += (n >= 52); b += (n >= 59); b += (n >= 67); b += (n >= 77);
  b += (n >= 87); b += (n >= 99); b += (n >= 113);
  return b;
}
__device__ __forceinline__ float log_sigmoid(float x) {
  return fminf(x, 0.f) - log1pf(expf(-fabsf(x)));
}

__device__ __forceinline__ void ph_rmsnorm(const float* src, const float* gain, bf16_t* dst, int rows) {
  int lane = opq(threadIdx.x) & 63, wv = opq(threadIdx.x) >> 6;
  for (int r = blockIdx.x * 4 + wv; r < rows; r += gridDim.x * 4) {
    const float4* s4 = (const float4*)(src + (size_t)r * DM);
    float4 v[8];
    float ss = 0.f;
#pragma unroll
    for (int i = 0; i < 8; ++i) {
      v[i] = s4[i * 64 + lane];
      ss += v[i].x * v[i].x + v[i].y * v[i].y + v[i].z * v[i].z + v[i].w * v[i].w;
    }
    ss = wave_sum(ss);
    float rs = rsqrtf(ss * (1.f / DM) + RMS_EPS);
    uint2* d2 = (uint2*)(dst + (size_t)r * DM);
    const float4* g4 = (const float4*)gain;
#pragma unroll
    for (int i = 0; i < 8; ++i) {
      float4 g = g4[i * 64 + lane];
      uint2 o;
      o.x = pack2(v[i].x * rs * g.x, v[i].y * rs * g.y);
      o.y = pack2(v[i].z * rs * g.z, v[i].w * rs * g.w);
      d2[i * 64 + lane] = o;
    }
  }
}

template <bool CMAP>
__device__ __forceinline__ void ph_transpose(float* smem, const float* W, int K, int N, int Npad, bf16_t* Wt) {
  float (*tl)[65] = (float (*)[65])smem;
  int tid = opq(threadIdx.x);
  int nk = K / 64, nn = Npad / 64;
  for (int tile = blockIdx.x; tile < nk * nn; tile += gridDim.x) {
    int k0 = (tile % nk) * 64, n0 = (tile / nk) * 64;
    int col = tid & 63, rb = tid >> 6;
#pragma unroll 4
    for (int pp = 0; pp < 16; ++pp) {
      int k = pp * 4 + rb;
      float v = 0.f;
      int sc = n0 + col;
      if (CMAP) sc = (sc < 2560) ? sc : (sc < 5632) ? sc + 24 : (sc < 5656) ? sc - 5632 + 2560 : N;
      if (sc < N) v = W[(size_t)(k0 + k) * N + sc];
      tl[k][col] = v;
    }
    __syncthreads();
    int n = tid >> 2, kc = (tid & 3) * 16;
    unsigned w[8];
#pragma unroll
    for (int i = 0; i < 8; ++i) w[i] = pack2(tl[kc + 2 * i][n], tl[kc + 2 * i + 1][n]);
    uint4* dst = (uint4*)(Wt + (size_t)(n0 + n) * K + k0 + kc);
    dst[0] = make_uint4(w[0], w[1], w[2], w[3]);
    dst[1] = make_uint4(w[4], w[5], w[6], w[7]);
    __syncthreads();
  }
}

__device__ __forceinline__ int lds_off(int row, int chunk) { return row * 128 + ((chunk ^ ((row >> 1) & 7)) << 4); }

template <bool TR, class Epi>
__device__ __forceinline__ void gemm_tile_bf16(const bf16_t* xp, int ldx, const bf16_t* yp, int ldy, int K, char* lds,
                                               Epi epi) {
  const int tid = opq(threadIdx.x), lane = tid & 63, wv = tid >> 6;
  const int wr = wv >> 1, wc = wv & 1;
  char* lx = lds;
  char* ly = lds + 16384;
  f32x16 acc[2][2];
#pragma unroll
  for (int i = 0; i < 2; ++i)
#pragma unroll
    for (int j = 0; j < 2; ++j)
#pragma unroll
      for (int r = 0; r < 16; ++r) acc[i][j][r] = 0.f;
  const int srow = tid >> 3, sch = tid & 7;
  const bf16_t* xg = xp + (size_t)srow * ldx + sch * 8;
  const bf16_t* yg = yp + (size_t)srow * ldy + sch * 8;
  const size_t x32 = (size_t)32 * ldx, y32 = (size_t)32 * ldy;
  uint4 sx0 = *(const uint4*)(xg), sx1 = *(const uint4*)(xg + x32), sx2 = *(const uint4*)(xg + 2 * x32),
        sx3 = *(const uint4*)(xg + 3 * x32);
  uint4 sy0 = *(const uint4*)(yg), sy1 = *(const uint4*)(yg + y32), sy2 = *(const uint4*)(yg + 2 * y32),
        sy3 = *(const uint4*)(yg + 3 * y32);
  const int so0 = lds_off(srow, sch), so1 = lds_off(32 + srow, sch), so2 = lds_off(64 + srow, sch),
            so3 = lds_off(96 + srow, sch);
  for (int k0 = 0; k0 < K; k0 += 64) {
    __syncthreads();
    *(uint4*)(lx + so0) = sx0; *(uint4*)(lx + so1) = sx1; *(uint4*)(lx + so2) = sx2; *(uint4*)(lx + so3) = sx3;
    *(uint4*)(ly + so0) = sy0; *(uint4*)(ly + so1) = sy1; *(uint4*)(ly + so2) = sy2; *(uint4*)(ly + so3) = sy3;
    __syncthreads();
    if (k0 + 64 < K) {
      const bf16_t* xn = xg + k0 + 64;
      const bf16_t* yn = yg + k0 + 64;
      sx0 = *(const uint4*)(xn); sx1 = *(const uint4*)(xn + x32); sx2 = *(const uint4*)(xn + 2 * x32);
      sx3 = *(const uint4*)(xn + 3 * x32);
      sy0 = *(const uint4*)(yn); sy1 = *(const uint4*)(yn + y32); sy2 = *(const uint4*)(yn + 2 * y32);
      sy3 = *(const uint4*)(yn + 3 * y32);
    }
#pragma unroll
    for (int kk = 0; kk < 4; ++kk) {
      bf16x8 a[2], b[2];
      const int ch = kk * 2 + (lane >> 5);
#pragma unroll
      for (int i = 0; i < 2; ++i) {
        a[i] = *(const bf16x8*)((TR ? ly : lx) + lds_off(wr * 64 + i * 32 + (lane & 31), ch));
        b[i] = *(const bf16x8*)((TR ? lx : ly) + lds_off(wc * 64 + i * 32 + (lane & 31), ch));
      }
#pragma unroll
      for (int i = 0; i < 2; ++i)
#pragma unroll
        for (int j = 0; j < 2; ++j) acc[i][j] = __builtin_amdgcn_mfma_f32_32x32x16_bf16(a[i], b[j], acc[i][j], 0, 0, 0);
    }
  }
  int lane2 = lane;
  asm volatile("" : "+v"(lane2));
#pragma unroll
  for (int i = 0; i < 2; ++i)
#pragma unroll
    for (int j = 0; j < 2; ++j)
#pragma unroll
      for (int r = 0; r < 16; ++r) {
        int rr = wr * 64 + i * 32 + (r & 3) + 8 * (r >> 2) + 4 * (lane2 >> 5);
        int cc = wc * 64 + j * 32 + (lane2 & 31);
        epi(rr, cc, acc[i][j][r]);
      }
}

template <class Epi>
__device__ __forceinline__ void ph_gemm_bf16(const bf16_t* A, int lda, const bf16_t* Wt, int ldw, int M, int N, int K,
                                             char* lds, Epi epi) {
  const int ntm = M / 128, ntn = N / 128;
  const int npm = (ntm + 7) / 8, npn = (ntn + 7) / 8;
  const int nslots = ((npm * npn * 64 + 511) / 512) * 512;
  for (int u = blockIdx.x; u < nslots; u += gridDim.x) {
    int v = (u & 7) * 64 + ((u >> 3) & 63) + (u & ~511);
    int patch = v >> 6, w = v & 63;
    int tm = (patch % npm) * 8 + (w & 7);
    int tn = (patch / npm) * 8 + (w >> 3);
    if (tm >= ntm || tn >= ntn) continue;
    const int m0 = tm * 128, n0 = tn * 128;
    gemm_tile_bf16<false>(A + (size_t)m0 * lda, lda, Wt + (size_t)n0 * ldw, ldw, K, lds,
                          [&](int r, int c, float val) { epi(m0 + r, n0 + c, val); });
  }
}

__device__ __forceinline__ void ph_proj(const P& p, char* lds) {
  const int ntm = T_TOK / 128, ntn = 5760 / 128;
  const int npm = (ntm + 7) / 8, npn = (ntn + 7) / 8;
  const int nslots = ((npm * npn * 64 + 511) / 512) * 512;
  for (int u = blockIdx.x; u < nslots; u += gridDim.x) {
    int v = (u & 7) * 64 + ((u >> 3) & 63) + (u & ~511);
    int patch = v >> 6, w = v & 63;
    int tm = (patch % npm) * 8 + (w & 7);
    int tn = (patch / npm) * 8 + (w >> 3);
    if (tm >= ntm || tn >= ntn) continue;
    const int m0 = tm * 128, n0 = tn * 128;
    const int b = m0 >> 11, sl = m0 & 2047;
    const bf16_t* A = p.hn + (size_t)m0 * DM;
    const bf16_t* W = p.WinT + (size_t)n0 * DM;
    if (n0 < 1024) {
      bf16_t* q = p.qn + (size_t)m0 * 1024 + n0;
      gemm_tile_bf16<false>(A, DM, W, DM, DM, lds, [&](int r, int c, float val) { q[(size_t)r * 1024 + c] = f2bf(val); });
    } else if (n0 < 2560) {
      const int seg = (n0 - 1024) >> 8, g = ((n0 - 1024) >> 7) & 1;
      if (seg == 3 || seg == 5) {
        bf16_t* vd = (seg == 3 ? p.vsT : p.vwT) + ((size_t)(b * 2 + g) * 128) * SEQ + sl;
        gemm_tile_bf16<true>(A, DM, W, DM, DM, lds, [&](int r, int c, float val) { vd[(size_t)r * SEQ + perm16(c)] = f2bf(val); });
      } else {
        bf16_t* base = (seg == 0) ? p.kcin : (seg == 1) ? p.vcin : (seg == 2) ? p.ks : p.kw;
        bf16_t* kd = base + ((size_t)(b * 2 + g) * SEQ + sl) * 128;
        gemm_tile_bf16<false>(A, DM, W, DM, DM, lds, [&](int r, int c, float val) { kd[(size_t)r * 128 + c] = f2bf(val); });
      }
    } else if (n0 < 3584) {
      bf16_t* q = p.qsb + (size_t)m0 * 1024 + (n0 - 2560);
      gemm_tile_bf16<false>(A, DM, W, DM, DM, lds, [&](int r, int c, float val) { q[(size_t)r * 1024 + c] = f2bf(val); });
    } else if (n0 < 4608) {
      bf16_t* kd = p.ksb + ((size_t)(b * 8 + ((n0 - 3584) >> 7)) * SEQ + sl) * 128;
      gemm_tile_bf16<false>(A, DM, W, DM, DM, lds, [&](int r, int c, float val) { kd[(size_t)r * 128 + c] = f2bf(val); });
    } else if (n0 < 5632) {
      bf16_t* vd = p.vsbT + ((size_t)(b * 8 + ((n0 - 4608) >> 7)) * 128) * SEQ + sl;
      gemm_tile_bf16<true>(A, DM, W, DM, DM, lds, [&](int r, int c, float val) { vd[(size_t)r * SEQ + perm16(c)] = f2bf(val); });
    } else {
      float* gd = p.gates + (size_t)m0 * 24;
      gemm_tile_bf16<false>(A, DM, W, DM, DM, lds, [&](int r, int c, float val) { if (c < 24) gd[(size_t)r * 24 + c] = val; });
    }
  }
}

__device__ __forceinline__ void ph_posb(const P& p) {
  const int lane = opq(threadIdx.x) & 63, wv = opq(threadIdx.x) >> 6;
  for (int o = blockIdx.x * 4 + wv; o < 256; o += gridDim.x * 4) {
    const int which = o >> 7, n = o & 127;
    const float* pos = which ? p.pos_v : p.pos_k;
    const float* w1 = which ? p.w1_v : p.w1_k;
    float acc = 0.f;
    for (int k = lane; k < 4096; k += 64) acc += pos[k] * w1[(size_t)k * 128 + n];
    acc = wave_sum(acc);
    if (lane == 0) p.posb[o] = acc;
  }
}

__device__ __forceinline__ void ph_compress2(const P& p, char* lds) {
  for (int item = blockIdx.x; item < 16; item += gridDim.x) {
    const int which = item >> 3, bg = item & 7;
    const bf16_t* src = (which ? p.vcin : p.kcin) + (size_t)bg * SEQ * 128;
    const bf16_t* w1t = p.w1T + (size_t)which * 128 * 4096;
    const bf16_t* w2t = p.w2T + (size_t)which * 128 * 128;
    const float* posb = p.posb + which * 128;
    bf16_t* c1 = p.c1 + (size_t)item * 128 * 128;
    gemm_tile_bf16<false>(src, 2048, w1t, 4096, 4096, lds, [&](int r, int c, float val) {
      c1[r * 128 + c] = f2bf(gelu_fast(val + posb[c])); });
    __threadfence_block();
    __syncthreads();
    if (which == 0) {
      bf16_t* kd = p.kcb + (size_t)bg * 128 * 128;
      gemm_tile_bf16<false>(c1, 128, w2t, 128, 128, lds, [&](int r, int c, float val) { kd[r * 128 + c] = f2bf(val); });
    } else {
      bf16_t* vd = p.vcT + (size_t)bg * 128 * 128;
      gemm_tile_bf16<true>(c1, 128, w2t, 128, 128, lds, [&](int r, int c, float val) { vd[r * 128 + perm16(c)] = f2bf(val); });
    }
  }
}

#define NEG_BIG (-1e30f)

struct KVRegs { u32x4 k0, k1, k2, k3, v0, v1, v2, v3; };

__device__ __forceinline__ int koff(int row, int chunk) { return row * 256 + ((chunk ^ (row & 15)) << 4); }

__device__ __forceinline__ void kv_load(KVRegs& r, const bf16_t* kp, int ldk, const bf16_t* vp, int ldv) {
  const int tid = opq(threadIdx.x);
  const bf16_t* kg = kp + (size_t)(tid >> 4) * ldk + (tid & 15) * 8;
  r.k0 = *(const u32x4*)kg;
  r.k1 = *(const u32x4*)(kg + (size_t)16 * ldk);
  r.k2 = *(const u32x4*)(kg + (size_t)32 * ldk);
  r.k3 = *(const u32x4*)(kg + (size_t)48 * ldk);
  const bf16_t* vg = vp + (size_t)(tid >> 3) * ldv + (tid & 7) * 8;
  r.v0 = *(const u32x4*)vg;
  r.v1 = *(const u32x4*)(vg + (size_t)32 * ldv);
  r.v2 = *(const u32x4*)(vg + (size_t)64 * ldv);
  r.v3 = *(const u32x4*)(vg + (size_t)96 * ldv);
}
__device__ __forceinline__ void kv_store(const KVRegs& r, char* lk, char* lv) {
  const int tid = opq(threadIdx.x);
  const int row = tid >> 4, ch = tid & 15;
  *(u32x4*)(lk + koff(row, ch)) = r.k0;
  *(u32x4*)(lk + koff(row + 16, ch)) = r.k1;
  *(u32x4*)(lk + koff(row + 32, ch)) = r.k2;
  *(u32x4*)(lk + koff(row + 48, ch)) = r.k3;
  const int vr = tid >> 3, vc = tid & 7;
  *(u32x4*)(lv + lds_off(vr, vc)) = r.v0;
  *(u32x4*)(lv + lds_off(vr + 32, vc)) = r.v1;
  *(u32x4*)(lv + lds_off(vr + 64, vc)) = r.v2;
  *(u32x4*)(lv + lds_off(vr + 96, vc)) = r.v3;
}

struct QFrag { bf16x8 f0, f1, f2, f3, f4, f5, f6, f7; };
__device__ __forceinline__ void q_load(QFrag& q, const bf16_t* qrow) {
  const int h = (opq(threadIdx.x) & 63) >> 5;
  const bf16x8* p8 = (const bf16x8*)(qrow + 8 * h);
  q.f0 = p8[0]; q.f1 = p8[2]; q.f2 = p8[4]; q.f3 = p8[6]; q.f4 = p8[8]; q.f5 = p8[10]; q.f6 = p8[12]; q.f7 = p8[14];
}

__device__ __forceinline__ void qk_tile(const QFrag& q, const char* lk, f32x16& s0, f32x16& s1) {
  const int lane = opq(threadIdx.x) & 63, row = lane & 31, h = lane >> 5;
#pragma unroll
  for (int r = 0; r < 16; ++r) { s0[r] = 0.f; s1[r] = 0.f; }
#define QK_STEP(kk, qf)                                                                  \
  {                                                                                      \
    bf16x8 a0 = *(const bf16x8*)(lk + koff(row, 2 * (kk) + h));                          \
    bf16x8 a1 = *(const bf16x8*)(lk + koff(row + 32, 2 * (kk) + h));                     \
    s0 = __builtin_amdgcn_mfma_f32_32x32x16_bf16(a0, qf, s0, 0, 0, 0);                   \
    s1 = __builtin_amdgcn_mfma_f32_32x32x16_bf16(a1, qf, s1, 0, 0, 0);                   \
  }
  QK_STEP(0, q.f0) QK_STEP(1, q.f1) QK_STEP(2, q.f2) QK_STEP(3, q.f3)
  QK_STEP(4, q.f4) QK_STEP(5, q.f5) QK_STEP(6, q.f6) QK_STEP(7, q.f7)
#undef QK_STEP
}

__device__ __forceinline__ bf16x8 pack8(const f32x16& p, const int base) {
  u32x4 u;
  u[0] = pack2(p[base + 0], p[base + 1]);
  u[1] = pack2(p[base + 2], p[base + 3]);
  u[2] = pack2(p[base + 4], p[base + 5]);
  u[3] = pack2(p[base + 6], p[base + 7]);
  return __builtin_bit_cast(bf16x8, u);
}

struct OAcc { f32x16 o0, o1, o2, o3; };
__device__ __forceinline__ void oacc_zero(OAcc& o) {
#pragma unroll
  for (int r = 0; r < 16; ++r) { o.o0[r] = 0.f; o.o1[r] = 0.f; o.o2[r] = 0.f; o.o3[r] = 0.f; }
}
__device__ __forceinline__ void oacc_scale(OAcc& o, float a) {
#pragma unroll
  for (int r = 0; r < 16; ++r) { o.o0[r] *= a; o.o1[r] *= a; o.o2[r] *= a; o.o3[r] *= a; }
}

__device__ __forceinline__ void pv_tile(OAcc& o, const char* lv, const f32x16& p0, const f32x16& p1) {
  const int lane = opq(threadIdx.x) & 63, row = lane & 31, h = lane >> 5;
  const bf16x8 pf0 = pack8(p0, 0), pf1 = pack8(p0, 8), pf2 = pack8(p1, 0), pf3 = pack8(p1, 8);
#define PV_ROW(dd, acc)                                                                                      \
  {                                                                                                          \
    acc = __builtin_amdgcn_mfma_f32_32x32x16_bf16(*(const bf16x8*)(lv + lds_off(32 * (dd) + row, 0 + h)), pf0, acc, 0, 0, 0); \
    acc = __builtin_amdgcn_mfma_f32_32x32x16_bf16(*(const bf16x8*)(lv + lds_off(32 * (dd) + row, 2 + h)), pf1, acc, 0, 0, 0); \
    acc = __builtin_amdgcn_mfma_f32_32x32x16_bf16(*(const bf16x8*)(lv + lds_off(32 * (dd) + row, 4 + h)), pf2, acc, 0, 0, 0); \
    acc = __builtin_amdgcn_mfma_f32_32x32x16_bf16(*(const bf16x8*)(lv + lds_off(32 * (dd) + row, 6 + h)), pf3, acc, 0, 0, 0); \
  }
  PV_ROW(0, o.o0) PV_ROW(1, o.o1) PV_ROW(2, o.o2) PV_ROW(3, o.o3)
#undef PV_ROW
}

__device__ __forceinline__ void softmax_tile(f32x16& s0, f32x16& s1, float& m, float& l, OAcc& o) {
  float mx = NEG_BIG;
#pragma unroll
  for (int r = 0; r < 16; ++r) mx = fmaxf(mx, fmaxf(s0[r], s1[r]));
  mx = fmaxf(mx, __shfl_xor(mx, 32));
  const float mn = fmaxf(m, mx);
  const float alpha = __expf(m - mn);
  float ls = 0.f;
#pragma unroll
  for (int r = 0; r < 16; ++r) {
    float a = (s0[r] > -1e29f) ? __expf(s0[r] - mn) : 0.f;
    float b = (s1[r] > -1e29f) ? __expf(s1[r] - mn) : 0.f;
    s0[r] = a; s1[r] = b;
    ls += a + b;
  }
  ls += __shfl_xor(ls, 32);
  l = l * alpha + ls;
  m = mn;
  if (__any(alpha != 1.f)) oacc_scale(o, alpha);
}

template <class F>
__device__ __forceinline__ void oacc_foreach(const OAcc& o, F f) {
  const int h = (opq(threadIdx.x) & 63) >> 5;
#pragma unroll
  for (int rho = 0; rho < 4; ++rho) {
    f(0 + 8 * rho + 4 * h, o.o0[4 * rho], o.o0[4 * rho + 1], o.o0[4 * rho + 2], o.o0[4 * rho + 3]);
    f(32 + 8 * rho + 4 * h, o.o1[4 * rho], o.o1[4 * rho + 1], o.o1[4 * rho + 2], o.o1[4 * rho + 3]);
    f(64 + 8 * rho + 4 * h, o.o2[4 * rho], o.o2[4 * rho + 1], o.o2[4 * rho + 2], o.o2[4 * rho + 3]);
    f(96 + 8 * rho + 4 * h, o.o3[4 * rho], o.o3[4 * rho + 1], o.o3[4 * rho + 2], o.o3[4 * rho + 3]);
  }
}

__device__ __forceinline__ void ph_memattn2(const P& p, char* lds) {
  char* lk = lds;
  char* lv = lds + 16384;
  const int lane = opq(threadIdx.x) & 63, wv = opq(threadIdx.x) >> 6;
  for (int item = blockIdx.x; item < NBATCH * 4 * (SEQ / 128); item += gridDim.x) {
    const int tb = item % (SEQ / 128);
    const int bh = item / (SEQ / 128);
    const int b = bh >> 2, hd = bh & 3;
    const int t = tb * 128 + wv * 32 + (lane & 31);
    QFrag q;
    q_load(q, p.qmemb + (size_t)(b * SEQ + t) * 512 + hd * 128);
    const bf16_t* kb = p.kmemb + (size_t)bh * 256 * 128;
    const bf16_t* vb = p.vmemT + (size_t)bh * 128 * 256;
    OAcc o;
    oacc_zero(o);
    float m = NEG_BIG, l = 0.f;
    KVRegs kv;
    kv_load(kv, kb, 128, vb, 256);
#pragma unroll 1
    for (int ti = 0; ti < 4; ++ti) {
      __syncthreads();
      kv_store(kv, lk, lv);
      __syncthreads();
      {
        const int tn = (ti + 1 < 4) ? ti + 1 : 3;
        kv_load(kv, kb + (size_t)tn * 64 * 128, 128, vb + tn * 64, 256);
      }
      f32x16 s0, s1;
      qk_tile(q, lk, s0, s1);
#pragma unroll
      for (int r = 0; r < 16; ++r) { s0[r] *= ATT_SCALE; s1[r] *= ATT_SCALE; }
      softmax_tile(s0, s1, m, l, o);
      pv_tile(o, lv, s0, s1);
    }
    const float il = 1.f / l;
    const int t2 = tb * 128 + (opq(threadIdx.x) >> 6) * 32 + (opq(threadIdx.x) & 31);
    bf16_t* orow = p.omem + (size_t)(b * SEQ + t2) * 512 + hd * 128;
    oacc_foreach(o, [&](int d, float v0, float v1, float v2, float v3) {
      uint2 u;
      u.x = pack2(v0 * il, v1 * il);
      u.y = pack2(v2 * il, v3 * il);
      *(uint2*)(orow + d) = u;
    });
  }
}

__device__ __forceinline__ void ph_sb2(const P& p, char* lds) {
  char* lk = lds;
  char* lv = lds + 16384;
  const int lane = opq(threadIdx.x) & 63, wv = opq(threadIdx.x) >> 6, hh = lane >> 5;
  const int sb_skip = (gridDim.x > 32) ? 16 : 0;
  if ((int)blockIdx.x < sb_skip) return;
  for (int item = (int)blockIdx.x - sb_skip; item < NBATCH * 8 * (SEQ / 128); item += (int)gridDim.x - sb_skip) {
    const int tb = (SEQ / 128 - 1) - (item % (SEQ / 128));
    const int bh = item / (SEQ / 128);
    const int b = bh >> 3, hd = bh & 7;
    const int t0 = tb * 128;
    const int t = t0 + wv * 32 + (lane & 31);
    QFrag q;
    q_load(q, p.qsb + (size_t)(b * SEQ + t) * 1024 + hd * 128);
    const bf16_t* kb = p.ksb + (size_t)bh * SEQ * 128;
    const bf16_t* vb = p.vsbT + (size_t)bh * 128 * SEQ;
    OAcc o;
    oacc_zero(o);
    float carry = 0.f;
    const int jhi = (t0 >> 6) + 1;
    const int jw = (t0 + wv * 32 + 30) >> 6;
    KVRegs kv;
    kv_load(kv, kb + (size_t)jhi * 64 * 128, 128, vb + jhi * 64, SEQ);
    volatile unsigned* dflag = (volatile unsigned*)(lds + 32768);
    __syncthreads();
    if (opq(threadIdx.x) < 4) dflag[opq(threadIdx.x)] = 0u;
    for (int j = jhi; j >= 0; --j) {
      __syncthreads();
      if ((dflag[0] & dflag[1] & dflag[2] & dflag[3]) != 0u) break;
      kv_store(kv, lk, lv);
      __syncthreads();
      const int jn = (j > 0) ? j - 1 : 0;
      if (j > jw) kv_load(kv, kb + (size_t)jn * 64 * 128, 128, vb + jn * 64, SEQ);
      if (j <= jw) {
        f32x16 z0, z1;
        qk_tile(q, lk, z0, z1);
        const int sbase = j * 64 + 4 * hh;
        float gt[8];
        f32x16 l0, l1;
#pragma unroll
        for (int r = 0; r < 16; ++r) {
          const int so = sbase + 8 * (r >> 2) + (r & 3);
          {
            const float z = z0[r] * ATT_SCALE;
            const bool valid = so < t;
            const float lsp = fminf(z, 0.f) - __logf(1.f + __expf(-fabsf(z)));
            l0[r] = valid ? (lsp - z) : 0.f;
            z0[r] = valid ? z : NEG_BIG;
          }
          {
            const float z = z1[r] * ATT_SCALE;
            const bool valid = so + 32 < t;
            const float lsp = fminf(z, 0.f) - __logf(1.f + __expf(-fabsf(z)));
            l1[r] = valid ? (lsp - z) : 0.f;
            z1[r] = valid ? z : NEG_BIG;
          }
        }
#pragma unroll
        for (int rho = 0; rho < 4; ++rho) {
          gt[rho] = (l0[4 * rho] + l0[4 * rho + 1]) + (l0[4 * rho + 2] + l0[4 * rho + 3]);
          gt[4 + rho] = (l1[4 * rho] + l1[4 * rho + 1]) + (l1[4 * rho + 2] + l1[4 * rho + 3]);
        }
        float ag[8];
        float run = 0.f;
#pragma unroll
        for (int k = 7; k >= 0; --k) {
          const float pg = __shfl_xor(gt[k], 32);
          ag[k] = carry + run + (hh == 0 ? pg : 0.f);
          run += gt[k] + pg;
        }
        carry += run;
#pragma unroll
        for (int rho = 0; rho < 4; ++rho) {
          {
            const float x3 = l0[4 * rho + 3], x23 = x3 + l0[4 * rho + 2], x123 = x23 + l0[4 * rho + 1];
            const float g = ag[rho];
            z0[4 * rho + 0] = __expf((l0[4 * rho + 0] + z0[4 * rho + 0]) + (g + x123));
            z0[4 * rho + 1] = __expf((l0[4 * rho + 1] + z0[4 * rho + 1]) + (g + x23));
            z0[4 * rho + 2] = __expf((l0[4 * rho + 2] + z0[4 * rho + 2]) + (g + x3));
            z0[4 * rho + 3] = __expf((l0[4 * rho + 3] + z0[4 * rho + 3]) + g);
          }
          {
            const float x3 = l1[4 * rho + 3], x23 = x3 + l1[4 * rho + 2], x123 = x23 + l1[4 * rho + 1];
            const float g = ag[4 + rho];
            z1[4 * rho + 0] = __expf((l1[4 * rho + 0] + z1[4 * rho + 0]) + (g + x123));
            z1[4 * rho + 1] = __expf((l1[4 * rho + 1] + z1[4 * rho + 1]) + (g + x23));
            z1[4 * rho + 2] = __expf((l1[4 * rho + 2] + z1[4 * rho + 2]) + (g + x3));
            z1[4 * rho + 3] = __expf((l1[4 * rho + 3] + z1[4 * rho + 3]) + g);
          }
        }
        kv_load(kv, kb + (size_t)jn * 64 * 128, 128, vb + jn * 64, SEQ);
        pv_tile(o, lv, z0, z1);
        if (__all(carry < -104.f) && (opq(threadIdx.x) & 63) == 0) dflag[wv] = 1u;
      }
    }
    int t2 = t;
    asm volatile("" : "+v"(t2));
    bf16_t* orow = p.omix + (size_t)(b * SEQ + t2) * DM + 1024 + hd * 128;
    oacc_foreach(o, [&](int d, float v0, float v1, float v2, float v3) {
      uint2 u;
      u.x = pack2(v0, v1);
      u.y = pack2(v2, v3);
      *(uint2*)(orow + d) = u;
    });
  }
}

#define NSA_IMP 32768
#define NSA_KEYS 49152
#define NSA_SELM 53504
#define NSA_LUT 53632
__device__ __forceinline__ void ph_nsa2(const P& p, char* lds) {
  typedef __attribute__((ext_vector_type(4))) float f32x4;
  char* lk = lds;
  char* lv = lds + 16384;
  float* imp = (float*)(lds + NSA_IMP);
  float* keys = (float*)(lds + NSA_KEYS);
  unsigned* selm = (unsigned*)(lds + NSA_SELM);
  const int tid = opq(threadIdx.x), lane = tid & 63, wv = tid >> 6, hh = lane >> 5, ql = lane & 31;
  float* lut = (float*)(lds + NSA_LUT) + wv * 128;
  for (int item = blockIdx.x; item < NBATCH * 2 * (SEQ / 32); item += gridDim.x) {
    const int tt = (item < 256) ? (SEQ / 32 - 1) - (item % (SEQ / 32)) : (item % (SEQ / 32));
    const int bg = item / (SEQ / 32);
    const int b = bg >> 1, g = bg & 1;
    const int h = g * 4 + wv;
    const int t0 = tt * 32, tq = t0 + ql, cur = t0 >> 6;
    __syncthreads();
    QFrag q;
    q_load(q, p.qn + (size_t)(b * SEQ + tq) * 1024 + h * 128);
    {
      const int lo = opq(lane);
      lut[lo] = p.t5[t5_bucket(lo) * 8 + h];
      lut[lo + 64] = p.t5[t5_bucket(lo + 64) * 8 + h];
    }
#pragma unroll
    for (int i = 0; i < 16; ++i) imp[i * 256 + tid] = 0.f;
    if (tid < 32) selm[tid] = 0u;
    const float* grow = p.gates + (size_t)(b * SEQ + tq) * 24 + h * 3;
    float* prow = p.part + (size_t)(b * SEQ + tq) * 1024 + h * 128;
    OAcc o;
    float m, l;
    KVRegs kv;
    {
      const bf16_t* kb = p.kcb + (size_t)bg * 128 * 128;
      const bf16_t* vb = p.vcT + (size_t)bg * 128 * 128;
      oacc_zero(o);
      m = NEG_BIG; l = 0.f;
      kv_load(kv, kb, 128, vb, 128);
      __syncthreads();
      kv_store(kv, lk, lv);
      __syncthreads();
      f32x16 x0, x1;
      qk_tile(q, lk, x0, x1);
      int tqv = tq;
      asm volatile("" : "+v"(tqv));
      tqv -= 64 * hh;
      if (t0 >= 1152) {
        const float b31 = lut[127];
#pragma unroll
        for (int r = 0; r < 16; ++r) { x0[r] = x0[r] * ATT_SCALE + b31; x1[r] = x1[r] * ATT_SCALE + b31; }
      } else {
#pragma unroll
        for (int r = 0; r < 16; ++r) {
          const int c = 8 * (r >> 2) + (r & 3);
          const int d0 = tqv - 16 * c - 31, d1 = d0 - 512;
          x0[r] = (d0 >= 0) ? x0[r] * ATT_SCALE + lut[min(d0, 127)] : NEG_BIG;
          x1[r] = (d1 >= 0) ? x1[r] * ATT_SCALE + lut[min(d1, 127)] : NEG_BIG;
        }
      }
      softmax_tile(x0, x1, m, l, o);
      const float m0 = m;
      pv_tile(o, lv, x0, x1);
      f32x16 z0, z1;
#pragma unroll
      for (int r = 0; r < 16; ++r) { z0[r] = 0.f; z1[r] = 0.f; }
      if (t0 >= 1024) {
        kv_load(kv, kb + 64 * 128, 128, vb + 64, 128);
        __syncthreads();
        kv_store(kv, lk, lv);
        __syncthreads();
        qk_tile(q, lk, z0, z1);
        asm volatile("" : "+v"(tqv));
#pragma unroll
        for (int r = 0; r < 16; ++r) {
          const int c = 64 + 8 * (r >> 2) + (r & 3);
          const int d0 = tqv - 16 * c - 31, d1 = d0 - 512;
          z0[r] = (d0 >= 0) ? z0[r] * ATT_SCALE + lut[min(d0, 127)] : NEG_BIG;
          z1[r] = (d1 >= 0) ? z1[r] * ATT_SCALE + lut[min(d1, 127)] : NEG_BIG;
        }
        softmax_tile(z0, z1, m, l, o);
        pv_tile(o, lv, z0, z1);
      }
      const float inv = 1.f / fmaxf(l, 1e-20f);
      const float c0 = __expf(m0 - m) * inv;
#pragma unroll
      for (int r = 0; r < 16; ++r) {
        const int c = 8 * (r >> 2) + (r & 3) + 4 * hh;
        if (x0[r] != 0.f) atomicAdd(&imp[(c) * 32 + ql], x0[r] * c0);
        if (x1[r] != 0.f) atomicAdd(&imp[(c + 32) * 32 + ql], x1[r] * c0);
        if (z0[r] != 0.f) atomicAdd(&imp[(c + 64) * 32 + ql], z0[r] * inv);
        if (z1[r] != 0.f) atomicAdd(&imp[(c + 96) * 32 + ql], z1[r] * inv);
      }
      const float gs = inv / (1.f + __expf(-grow[0]));
      oacc_foreach(o, [&](int d, float v0, float v1, float v2, float v3) {
        f32x4 u = {v0 * gs, v1 * gs, v2 * gs, v3 * gs};
        *(f32x4*)(prow + d) = u;
      });
    }
    __syncthreads();
    {
      const int tido = opq(tid);
      const int qq = tido & 31, jg = tido >> 5;
#pragma unroll
      for (int jj = 0; jj < 4; ++jj) {
        const int j = jg * 4 + jj;
        float v = imp[(4 * j) * 32 + qq] + imp[(4 * j + 1) * 32 + qq] + imp[(4 * j + 2) * 32 + qq] + 0.5f * imp[(4 * j + 3) * 32 + qq];
        if (j > 0) v += 0.5f * imp[(4 * j - 1) * 32 + qq];
        const bool forced = (j == 0) || (j == cur) || (j == cur - 1);
        keys[qq * 33 + j] = forced ? 1e9f : ((j <= cur) ? v : -1e9f);
      }
      __syncthreads();
      unsigned bits = 0u;
#pragma unroll
      for (int jj = 0; jj < 4; ++jj) {
        const int j = jg * 4 + jj;
        const float kj = keys[qq * 33 + j];
        int rank = 0;
        for (int i = 0; i < 32; ++i) {
          const float ki = keys[qq * 33 + i];
          rank += (ki > kj || (ki == kj && i < j)) ? 1 : 0;
        }
        if (rank < 16 && j <= cur) bits |= 1u << j;
      }
      atomicOr(&selm[qq], bits);
      __syncthreads();
    }
    const unsigned mysel = selm[ql];
    unsigned um = mysel;
#pragma unroll
    for (int o2 = 16; o2 > 0; o2 >>= 1) um |= (unsigned)__shfl_xor((int)um, o2);
    um = (unsigned)__builtin_amdgcn_readfirstlane((int)um);
    {
      const bf16_t* kb = p.ks + (size_t)bg * SEQ * 128;
      const bf16_t* vb = p.vsT + (size_t)bg * 128 * SEQ;
      oacc_zero(o);
      m = NEG_BIG; l = 0.f;
      unsigned rem = um;
      int j = __builtin_ctz(rem);
      kv_load(kv, kb + (size_t)j * 64 * 128, 128, vb + j * 64, SEQ);
      while (rem) {
        j = __builtin_ctz(rem);
        rem &= rem - 1;
        const int jn = rem ? __builtin_ctz(rem) : j;
        __syncthreads();
        kv_store(kv, lk, lv);
        __syncthreads();
        f32x16 s0, s1;
        qk_tile(q, lk, s0, s1);
        const bool selq = (mysel >> j) & 1u;
        int tqv = tq;
        asm volatile("" : "+v"(tqv));
        if (j * 64 + 63 + 113 <= t0) {
          const float sc = selq ? ATT_SCALE : 0.f, bb = selq ? lut[127] : NEG_BIG;
#pragma unroll
          for (int r = 0; r < 16; ++r) { s0[r] = s0[r] * sc + bb; s1[r] = s1[r] * sc + bb; }
        } else {
#pragma unroll
          for (int r = 0; r < 16; ++r) {
            const int d0 = tqv - (j * 64 + 8 * (r >> 2) + (r & 3) + 4 * hh), d1 = d0 - 32;
            s0[r] = (selq && d0 >= 0) ? s0[r] * ATT_SCALE + lut[min(d0, 127)] : NEG_BIG;
            s1[r] = (selq && d1 >= 0) ? s1[r] * ATT_SCALE + lut[min(d1, 127)] : NEG_BIG;
          }
        }
        kv_load(kv, kb + (size_t)jn * 64 * 128, 128, vb + jn * 64, SEQ);
        softmax_tile(s0, s1, m, l, o);
        pv_tile(o, lv, s0, s1);
      }
      const float gs = 1.f / (fmaxf(l, 1e-20f) * (1.f + __expf(-grow[1])));
      int qo = ql;
      asm volatile("" : "+v"(qo));
      float* pr2 = p.part + (size_t)(b * SEQ + t0 + qo) * 1024 + h * 128;
      oacc_foreach(o, [&](int d, float v0, float v1, float v2, float v3) {
        f32x4 u = *(f32x4*)(pr2 + d);
        u[0] += v0 * gs; u[1] += v1 * gs; u[2] += v2 * gs; u[3] += v3 * gs;
        *(f32x4*)(pr2 + d) = u;
      });
    }
    {
      const bf16_t* kb = p.kw + (size_t)bg * SEQ * 128;
      const bf16_t* vb = p.vwT + (size_t)bg * 128 * SEQ;
      oacc_zero(o);
      m = NEG_BIG; l = 0.f;
      int jlo = (t0 - 511) >> 6;
      if (jlo < 0) jlo = 0;
      kv_load(kv, kb + (size_t)jlo * 64 * 128, 128, vb + jlo * 64, SEQ);
      for (int j = jlo; j <= cur; ++j) {
        const int jn = (j < cur) ? j + 1 : j;
        __syncthreads();
        kv_store(kv, lk, lv);
        __syncthreads();
        f32x16 s0, s1;
        qk_tile(q, lk, s0, s1);
        int tqv = tq;
        asm volatile("" : "+v"(tqv));
        if (j * 64 + 63 + 113 <= t0 && t0 + 31 - j * 64 < 512) {
          const float b31 = lut[127];
#pragma unroll
          for (int r = 0; r < 16; ++r) { s0[r] = s0[r] * ATT_SCALE + b31; s1[r] = s1[r] * ATT_SCALE + b31; }
        } else {
#pragma unroll
          for (int r = 0; r < 16; ++r) {
            const int d0 = tqv - (j * 64 + 8 * (r >> 2) + (r & 3) + 4 * hh), d1 = d0 - 32;
            s0[r] = (d0 >= 0 && d0 < 512) ? s0[r] * ATT_SCALE + lut[min(d0, 127)] : NEG_BIG;
            s1[r] = (d1 >= 0 && d1 < 512) ? s1[r] * ATT_SCALE + lut[min(d1, 127)] : NEG_BIG;
          }
        }
        kv_load(kv, kb + (size_t)jn * 64 * 128, 128, vb + jn * 64, SEQ);
        softmax_tile(s0, s1, m, l, o);
        pv_tile(o, lv, s0, s1);
      }
      const float gs = 1.f / (fmaxf(l, 1e-20f) * (1.f + __expf(-grow[2])));
      int qo = ql;
      asm volatile("" : "+v"(qo));
      const float* pr2 = p.part + (size_t)(b * SEQ + t0 + qo) * 1024 + h * 128;
      bf16_t* orow = p.omix + (size_t)(b * SEQ + t0 + qo) * DM + h * 128;
      oacc_foreach(o, [&](int d, float v0, float v1, float v2, float v3) {
        const f32x4 u = *(const f32x4*)(pr2 + d);
        uint2 w;
        w.x = pack2(u[0] + v0 * gs, u[1] + v1 * gs);
        w.y = pack2(u[2] + v2 * gs, u[3] + v3 * gs);
        *(uint2*)(orow + d) = w;
      });
    }
  }
}

__device__ __forceinline__ void ph_cvt(const float* src, bf16_t* dst, size_t n) {
  typedef __attribute__((ext_vector_type(4))) float f32x4;
  const size_t nv = n / 8;
  for (size_t i = (size_t)blockIdx.x * 256 + opq(threadIdx.x); i < nv; i += (size_t)gridDim.x * 256) {
    const f32x4 a = ((const f32x4*)src)[2 * i], b = ((const f32x4*)src)[2 * i + 1];
    u32x4 o;
    o[0] = pack2(a[0], a[1]); o[1] = pack2(a[2], a[3]); o[2] = pack2(b[0], b[1]); o[3] = pack2(b[2], b[3]);
    ((u32x4*)dst)[i] = o;
  }
}

__device__ __forceinline__ void ph_scores(const P& p, char* lds) {
  for (int u = blockIdx.x; u < 64 * 16; u += gridDim.x) {
    const int tm = u & 63, hp = u >> 6;
    const int m0 = tm * 128;
    float* sc = p.scores + (size_t)m0 * DM + hp * 128;
    gemm_tile_bf16<false>(p.omix + (size_t)m0 * DM + hp * 128, DM, p.subkb + (size_t)hp * 128 * 128, 128, 128, lds,
                          [&](int r, int c, float val) { sc[(size_t)r * DM + c] = val; });
  }
}

__device__ __forceinline__ void ph_qp_scores(const P& p, char* lds) {
  const int ntm = T_TOK / 128, ntn = DM / 128;
  const int npm = (ntm + 7) / 8, npn = (ntn + 7) / 8;
  const int nslots = ((npm * npn * 64 + 511) / 512) * 512;
  for (int u = blockIdx.x; u < nslots; u += gridDim.x) {
    int v = (u & 7) * 64 + ((u >> 3) & 63) + (u & ~511);
    int patch = v >> 6, w = v & 63;
    int tm = (patch % npm) * 8 + (w & 7);
    int tn = (patch / npm) * 8 + (w >> 3);
    if (tm >= ntm || tn >= ntn) continue;
    const int m0 = tm * 128, n0 = tn * 128;
    bf16_t* qp = p.omix + (size_t)m0 * DM + n0;
    gemm_tile_bf16<false>(p.hn + (size_t)m0 * DM, DM, p.WpqT + (size_t)n0 * DM, DM, DM, lds,
                          [&](int r, int c, float val) { qp[(size_t)r * DM + c] = f2bf(val); });
    __threadfence_block();
    __syncthreads();
    float* sc = p.scores + (size_t)m0 * DM + n0;
    gemm_tile_bf16<false>(qp, DM, p.subkb + (size_t)tn * 128 * 128, 128, 128, lds,
                          [&](int r, int c, float val) { sc[(size_t)r * DM + c] = val; });
  }
}

__device__ __forceinline__ void ph_cvt8(const float* src, unsigned char* dst, float* scales, int nrows, int wid0, int nw) {
  typedef __attribute__((ext_vector_type(4))) float f32x4;
  const int lane = opq(threadIdx.x) & 63;
  for (int row = wid0; row < nrows; row += nw) {
    const f32x4* s4 = (const f32x4*)(src + (size_t)row * DM);
    f32x4 v[8];
    float amax = 0.f;
#pragma unroll
    for (int c = 0; c < 2; ++c)
#pragma unroll
      for (int i = 0; i < 4; ++i) {
        v[c * 4 + i] = s4[c * 256 + lane * 4 + i];
#pragma unroll
        for (int k = 0; k < 4; ++k) amax = fmaxf(amax, fabsf(v[c * 4 + i][k]));
      }
    amax = wave_max(amax);
    const float sc = (amax > 0.f) ? 440.f / amax : 1.f;
#pragma unroll
    for (int c = 0; c < 2; ++c) {
      u32x4 o;
#pragma unroll
      for (int i = 0; i < 4; ++i) {
        int pk = 0;
        pk = __builtin_amdgcn_cvt_pk_fp8_f32(v[c * 4 + i][0] * sc, v[c * 4 + i][1] * sc, pk, false);
        pk = __builtin_amdgcn_cvt_pk_fp8_f32(v[c * 4 + i][2] * sc, v[c * 4 + i][3] * sc, pk, true);
        o[i] = (unsigned)pk;
      }
      *(u32x4*)(dst + (size_t)row * DM + c * 1024 + lane * 16) = o;
    }
    if (lane == 0) scales[row] = (amax > 0.f) ? amax / 440.f : 1.f;
  }
}

struct R8 { u32x4 r0, r1; };
__device__ __forceinline__ void r8_load(R8& r, const unsigned char* tab, int eid, int lane) {
  const u32x4* ur = (const u32x4*)(tab + (size_t)eid * DM) + lane;
  r.r0 = ur[0]; r.r1 = ur[64];
}
__device__ __forceinline__ float dot2q(unsigned w8, bool hi, unsigned xb, float c) {
  return __builtin_amdgcn_fdot2_f32_bf16(hi ? __builtin_amdgcn_cvt_scalef32_pk_bf16_fp8(w8, 1.0f, true)
                                            : __builtin_amdgcn_cvt_scalef32_pk_bf16_fp8(w8, 1.0f, false),
                                         __builtin_bit_cast(bf16v2, xb), c, false);
}
struct XPk { u32x4 a0, a1, b0, b1; };
struct Acc32 { f32x16 a, b; };

__device__ __forceinline__ float r8_dot(const R8& e, const XPk& x) {
  float pa = 0.f, pb = 0.f;
#pragma unroll
  for (int w = 0; w < 4; ++w) {
    const unsigned xa0 = (w < 2) ? x.a0[2 * w] : x.a1[2 * w - 4], xa1 = (w < 2) ? x.a0[2 * w + 1] : x.a1[2 * w - 3];
    const unsigned xb0 = (w < 2) ? x.b0[2 * w] : x.b1[2 * w - 4], xb1 = (w < 2) ? x.b0[2 * w + 1] : x.b1[2 * w - 3];
    pa = dot2q(e.r0[w], false, xa0, pa);
    pb = dot2q(e.r0[w], true, xa1, pb);
    pa = dot2q(e.r1[w], false, xb0, pa);
    pb = dot2q(e.r1[w], true, xb1, pb);
  }
  return pa + pb;
}
__device__ __forceinline__ void r8_axpy(const R8& e, float hid, Acc32& acc) {
  typedef __attribute__((ext_vector_type(2))) float f32x2;
#pragma unroll
  for (int w = 0; w < 4; ++w) {
    const f32x2 l0 = __builtin_amdgcn_cvt_pk_f32_fp8((int)e.r0[w], false), h0 = __builtin_amdgcn_cvt_pk_f32_fp8((int)e.r0[w], true);
    const f32x2 l1 = __builtin_amdgcn_cvt_pk_f32_fp8((int)e.r1[w], false), h1 = __builtin_amdgcn_cvt_pk_f32_fp8((int)e.r1[w], true);
    acc.a[4 * w + 0] += hid * l0[0]; acc.a[4 * w + 1] += hid * l0[1]; acc.a[4 * w + 2] += hid * h0[0]; acc.a[4 * w + 3] += hid * h0[1];
    acc.b[4 * w + 0] += hid * l1[0]; acc.b[4 * w + 1] += hid * l1[1]; acc.b[4 * w + 2] += hid * h1[0]; acc.b[4 * w + 3] += hid * h1[1];
  }
}

#define INS16(K, x)                                                                                      \
  K##15 = __builtin_amdgcn_fmed3f(K##15, K##14, x); K##14 = __builtin_amdgcn_fmed3f(K##14, K##13, x);   \
  K##13 = __builtin_amdgcn_fmed3f(K##13, K##12, x); K##12 = __builtin_amdgcn_fmed3f(K##12, K##11, x);   \
  K##11 = __builtin_amdgcn_fmed3f(K##11, K##10, x); K##10 = __builtin_amdgcn_fmed3f(K##10, K##9, x);    \
  K##9 = __builtin_amdgcn_fmed3f(K##9, K##8, x); K##8 = __builtin_amdgcn_fmed3f(K##8, K##7, x);         \
  K##7 = __builtin_amdgcn_fmed3f(K##7, K##6, x); K##6 = __builtin_amdgcn_fmed3f(K##6, K##5, x);         \
  K##5 = __builtin_amdgcn_fmed3f(K##5, K##4, x); K##4 = __builtin_amdgcn_fmed3f(K##4, K##3, x);         \
  K##3 = __builtin_amdgcn_fmed3f(K##3, K##2, x); K##2 = __builtin_amdgcn_fmed3f(K##2, K##1, x);         \
  K##1 = __builtin_amdgcn_fmed3f(K##1, K##0, x); K##0 = fmaxf(K##0, x);
#define DECL16(K) float K##0 = -INFINITY, K##1 = -INFINITY, K##2 = -INFINITY, K##3 = -INFINITY, K##4 = -INFINITY, \
  K##5 = -INFINITY, K##6 = -INFINITY, K##7 = -INFINITY, K##8 = -INFINITY, K##9 = -INFINITY, K##10 = -INFINITY,   \
  K##11 = -INFINITY, K##12 = -INFINITY, K##13 = -INFINITY, K##14 = -INFINITY, K##15 = -INFINITY;
__device__ __forceinline__ float mkkey(float v, unsigned tag, unsigned mask) {
  return __uint_as_float((__float_as_uint(v) & ~mask) | tag);
}

__device__ __forceinline__ void ph_peer(const P& p, float* smem) {
  typedef __attribute__((ext_vector_type(4))) float f32x4;
  const int tid = opq(threadIdx.x), lane = tid & 63, wv = tid >> 6;
  float* lists = smem;
  int* bexA = (int*)(smem + 4096);
  float* bgtA = smem + 6144;
  float* bsuA = smem + 8192;
  for (int item = blockIdx.x; item < T_TOK / 16; item += gridDim.x) {
    const int t0 = item * 16;
    __syncthreads();
    {
      const int tl = tid >> 4, hp = tid & 15;
      const f32x4* sp = (const f32x4*)(p.scores + (size_t)(t0 + tl) * DM + hp * 128);
      DECL16(k)
#pragma unroll 4
      for (int c4 = 0; c4 < 32; ++c4) {
        const f32x4 v = sp[c4];
#pragma unroll
        for (int e = 0; e < 4; ++e) {
          const float x = mkkey(v[e], 127u - (unsigned)(c4 * 4 + e), 127u);
          INS16(k, x)
        }
      }
      f32x4* lp = (f32x4*)(lists + (size_t)tid * 16);
      f32x4 o0 = {k0, k1, k2, k3}, o1 = {k4, k5, k6, k7}, o2 = {k8, k9, k10, k11}, o3 = {k12, k13, k14, k15};
      lp[0] = o0; lp[1] = o1; lp[2] = o2; lp[3] = o3;
    }
    __syncthreads();
    if (tid < 128) {
      const int tl = tid >> 3, h = tid & 7;
      const float* la = lists + (size_t)(tl * 16 + 2 * h) * 16;
      const float* lb = la + 16;
      float av[16], bv[16];
#pragma unroll
      for (int i = 0; i < 16; ++i) {
        av[i] = __uint_as_float(__float_as_uint(la[i]) & ~127u);
        bv[i] = __uint_as_float(__float_as_uint(lb[i]) & ~127u);
      }
      DECL16(c)
#pragma unroll
      for (int i = 0; i < 16; ++i) {
#pragma unroll
        for (int j = 0; j < 16; ++j) {
          if ((i + 1) * (j + 1) <= 16) {
            const float x = mkkey(av[i] + bv[j], 255u - (unsigned)(i * 16 + j), 255u);
            INS16(c, x)
          }
        }
      }
      float cs[16] = {c0, c1, c2, c3, c4, c5, c6, c7, c8, c9, c10, c11, c12, c13, c14, c15};
      float ev[16];
      float sum = 0.f;
      const float mx = __uint_as_float(__float_as_uint(cs[0]) & ~255u);
#pragma unroll
      for (int n = 0; n < 16; ++n) {
        ev[n] = __expf(__uint_as_float(__float_as_uint(cs[n]) & ~255u) - mx);
        sum += ev[n];
      }
      const float isum = 1.f / sum;
#pragma unroll
      for (int n = 0; n < 16; ++n) {
        const unsigned cc = 255u - (__float_as_uint(cs[n]) & 255u);
        const unsigned ka = 127u - (__float_as_uint(la[cc >> 4]) & 127u);
        const unsigned kb = 127u - (__float_as_uint(lb[cc & 15u]) & 127u);
        const int eid = (int)(ka * 128u + kb);
        bexA[tl * 128 + h * 16 + n] = eid;
        bgtA[tl * 128 + h * 16 + n] = ev[n] * isum * p.sv8[eid];
        bsuA[tl * 128 + h * 16 + n] = p.su8[eid];
      }
    }
    __syncthreads();
#pragma unroll 1
    for (int ti4 = 0; ti4 < 4; ++ti4) {
    const int tl = wv * 4 + ti4;
    const int t = t0 + tl;
    const int* bex = bexA + tl * 128;
    const float* bgt = bgtA + tl * 128;
    const float* bsu = bsuA + tl * 128;
    XPk x;
    {
      const f32x4* s4 = (const f32x4*)(p.out + (size_t)t * DM);
      const f32x4* g4 = (const f32x4*)p.norm_ffn;
      f32x4 a0 = s4[lane * 4], a1 = s4[lane * 4 + 1], a2 = s4[lane * 4 + 2], a3 = s4[lane * 4 + 3];
      f32x4 a4 = s4[256 + lane * 4], a5 = s4[256 + lane * 4 + 1], a6 = s4[256 + lane * 4 + 2], a7 = s4[256 + lane * 4 + 3];
      float ss = 0.f;
#define SSQ(v) ss += v[0] * v[0] + v[1] * v[1] + v[2] * v[2] + v[3] * v[3];
      SSQ(a0) SSQ(a1) SSQ(a2) SSQ(a3) SSQ(a4) SSQ(a5) SSQ(a6) SSQ(a7)
#undef SSQ
      ss = wave_sum(ss);
      const float rs = rsqrtf(ss * (1.f / DM) + RMS_EPS);
#define XPK(dst, va, vb, gi)                                                          \
  {                                                                                   \
    const f32x4 ga = g4[gi], gb = g4[gi + 1];                                         \
    dst[0] = pack2(va[0] * rs * ga[0], va[1] * rs * ga[1]);                           \
    dst[1] = pack2(va[2] * rs * ga[2], va[3] * rs * ga[3]);                           \
    dst[2] = pack2(vb[0] * rs * gb[0], vb[1] * rs * gb[1]);                           \
    dst[3] = pack2(vb[2] * rs * gb[2], vb[3] * rs * gb[3]);                           \
  }
      XPK(x.a0, a0, a1, lane * 4) XPK(x.a1, a2, a3, lane * 4 + 2) XPK(x.b0, a4, a5, 256 + lane * 4) XPK(x.b1, a6, a7, 256 + lane * 4 + 2)
#undef XPK
    }
    Acc32 acc;
#pragma unroll
    for (int r = 0; r < 16; ++r) { acc.a[r] = 0.f; acc.b[r] = 0.f; }
    R8 u0, u1, u2, u3, v0, v1, v2, v3;
    r8_load(u0, p.pu8, bex[0], lane); r8_load(u1, p.pu8, bex[1], lane); r8_load(u2, p.pu8, bex[2], lane); r8_load(u3, p.pu8, bex[3], lane);
    r8_load(v0, p.pv8, bex[0], lane); r8_load(v1, p.pv8, bex[1], lane); r8_load(v2, p.pv8, bex[2], lane); r8_load(v3, p.pv8, bex[3], lane);
#pragma unroll 1
    for (int e0 = 0; e0 < 128; e0 += 4) {
      float d0 = r8_dot(u0, x), d1 = r8_dot(u1, x), d2 = r8_dot(u2, x), d3 = r8_dot(u3, x);
      const int en = (e0 + 4 < 128) ? e0 + 4 : 124;
      const int i0 = bex[en], i1 = bex[en + 1], i2 = bex[en + 2], i3 = bex[en + 3];
      r8_load(u0, p.pu8, i0, lane); r8_load(u1, p.pu8, i1, lane); r8_load(u2, p.pu8, i2, lane); r8_load(u3, p.pu8, i3, lane);
#pragma unroll
      for (int o = 32; o > 0; o >>= 1) {
        d0 += __shfl_xor(d0, o); d1 += __shfl_xor(d1, o); d2 += __shfl_xor(d2, o); d3 += __shfl_xor(d3, o);
      }
      r8_axpy(v0, bgt[e0 + 0] * gelu_fast(d0 * bsu[e0 + 0]), acc);
      r8_axpy(v1, bgt[e0 + 1] * gelu_fast(d1 * bsu[e0 + 1]), acc);
      r8_axpy(v2, bgt[e0 + 2] * gelu_fast(d2 * bsu[e0 + 2]), acc);
      r8_axpy(v3, bgt[e0 + 3] * gelu_fast(d3 * bsu[e0 + 3]), acc);
      r8_load(v0, p.pv8, i0, lane); r8_load(v1, p.pv8, i1, lane); r8_load(v2, p.pv8, i2, lane); r8_load(v3, p.pv8, i3, lane);
    }
    const int lane2 = opq(lane);
    f32x4* o4 = (f32x4*)(p.out + (size_t)t * DM);
    const f32x4* g4 = (const f32x4*)p.norm_final;
    f32x4 hv[8];
    float ss = 0.f;
#pragma unroll
    for (int c = 0; c < 2; ++c)
#pragma unroll
      for (int i = 0; i < 4; ++i) {
        hv[c * 4 + i] = o4[c * 256 + lane2 * 4 + i];
#pragma unroll
        for (int k = 0; k < 4; ++k) {
          hv[c * 4 + i][k] += c ? acc.b[4 * i + k] : acc.a[4 * i + k];
          ss += hv[c * 4 + i][k] * hv[c * 4 + i][k];
        }
      }
    ss = wave_sum(ss);
    const float rs = rsqrtf(ss * (1.f / DM) + RMS_EPS);
#pragma unroll
    for (int c = 0; c < 2; ++c)
#pragma unroll
      for (int i = 0; i < 4; ++i) {
        const f32x4 g = g4[c * 256 + lane2 * 4 + i];
        f32x4 o;
#pragma unroll
        for (int k = 0; k < 4; ++k) o[k] = hv[c * 4 + i][k] * rs * g[k];
        o4[c * 256 + lane2 * 4 + i] = o;
      }
    }
  }
}

#define XB_TMO      128
#define XB_XCNT(j)  (256  + 64 * (j))
#define XB_XSUB(j)  (1280 + 64 * (j))
#define XB_XGEN(j)  (2304 + 64 * (j))
#define XB_TOP      3328
#define XB_TOPGEN   3392
#define XCD_BAR_WORDS 3456
#define XB_SPIN_CAP (1u << 22)
#define LAS __attribute__((address_space(3)))
__device__ __forceinline__ unsigned xb_ld(unsigned* p) { return __hip_atomic_load(p, __ATOMIC_RELAXED, __HIP_MEMORY_SCOPE_AGENT); }
__device__ __forceinline__ unsigned xb_add(unsigned* p, unsigned v) { return __hip_atomic_fetch_add(p, v, __ATOMIC_RELAXED, __HIP_MEMORY_SCOPE_AGENT); }
__device__ __forceinline__ unsigned xb_xcc_id() { return (unsigned)__builtin_amdgcn_s_getreg((3 << 11) | 20) & 0xFu; }
#define XB_SPIN(cond, bar) do { unsigned _sp = 0; while (cond) { __builtin_amdgcn_s_sleep(1); \
    if ((++_sp & 255u) == 0u) { if (xb_ld(&(bar)[XB_TMO])) break; if (_sp > XB_SPIN_CAP) { atomicAdd(&(bar)[XB_TMO], 1u); break; } } } } while (0)
struct XcdBarrier { unsigned* bar; unsigned x; volatile LAS unsigned* st; };
__device__ __forceinline__ XcdBarrier xcd_barrier_post(unsigned* bar, volatile LAS unsigned* st) {
  XcdBarrier b; b.bar = bar; b.x = xb_xcc_id(); b.st = st;
  if (threadIdx.x == 0) (void)xb_add(&bar[XB_XCNT(b.x)], 1u);
  return b;
}
__device__ __forceinline__ void xcd_barrier_complete(unsigned* bar, unsigned x, unsigned& nloc, unsigned& nx) {
  const unsigned G = gridDim.x * gridDim.y * gridDim.z;
  unsigned sum, cnt, mine, sp = 0u;
  for (;;) {
    sum = 0u; cnt = 0u; mine = 0u;
#pragma unroll
    for (unsigned j = 0; j < 16; ++j) { const unsigned c = xb_ld(&bar[XB_XCNT(j)]); sum += c; cnt += (c > 0u) ? 1u : 0u; mine = (j == x) ? c : mine; }
    if (sum == G) break;
    __builtin_amdgcn_s_sleep(1);
    if ((++sp & 255u) == 0u) { if (xb_ld(&bar[XB_TMO])) break; if (sp > XB_SPIN_CAP) { atomicAdd(&bar[XB_TMO], 1u); break; } }
  }
  nloc = mine > 0u ? mine : 1u; nx = cnt > 0u ? cnt : 1u;
}
__device__ __forceinline__ void xcd_barrier(const XcdBarrier& b) {
  asm volatile("s_waitcnt vmcnt(0)" ::: "memory");
  __syncthreads();
  if (threadIdx.x == 0) {
    unsigned* bar = b.bar;
    __builtin_amdgcn_s_waitcnt(0);
    unsigned nloc = b.st[0], nx = b.st[1];
    if (nloc == 0u) { xcd_barrier_complete(bar, b.x, nloc, nx); b.st[0] = nloc; b.st[1] = nx; }
    const unsigned old = xb_add(&bar[XB_XSUB(b.x)], 1u);
    const unsigned gen = old / nloc;
    if (old + 1u == (gen + 1u) * nloc) {
      __builtin_amdgcn_fence(__ATOMIC_RELEASE, "agent");
      asm volatile("s_waitcnt vmcnt(0)" ::: "memory");
      const unsigned og = xb_add(&bar[XB_TOP], 1u);
      const unsigned tg = og / nx;
      if (og + 1u == (tg + 1u) * nx) xb_add(&bar[XB_TOPGEN], 1u);
      else XB_SPIN(xb_ld(&bar[XB_TOPGEN]) == tg, bar);
      __builtin_amdgcn_fence(__ATOMIC_ACQUIRE, "agent");
      xb_add(&bar[XB_XGEN(b.x)], 1u);
      asm volatile("s_waitcnt vmcnt(0)" ::: "memory");
    } else {
      XB_SPIN(xb_ld(&bar[XB_XGEN(b.x)]) == gen, bar);
      __builtin_amdgcn_fence(__ATOMIC_ACQUIRE, "agent");
      asm volatile("s_waitcnt vmcnt(0)" ::: "memory");
    }
  }
  __syncthreads();
}

typedef const __attribute__((address_space(4))) P* KP;
__device__ __forceinline__ P loadP() {
#if defined(__HIP_DEVICE_COMPILE__)
  KP k = (KP)__builtin_amdgcn_kernarg_segment_ptr();
  asm volatile("" : "+s"(k));
  P p = *k;
  return p;
#else
  return P{};
#endif
}

__global__ void __launch_bounds__(256, 2) mega(P p_arg) {
  cg::grid_group grid = cg::this_grid();
  __shared__ __attribute__((aligned(16))) float smem[14336];
  char* lds = (char*)smem;
  __shared__ uint4 xb_words;
  if (threadIdx.x == 0) xb_words = make_uint4(0u, 0u, 0u, 0u);
  if (blockIdx.x == 0) {
    P p = loadP();
    for (int i = threadIdx.x; i < XCD_BAR_WORDS; i += 256) p.bar[i] = 0u;
  }
  { P p = loadP(); ph_rmsnorm(p.x, p.norm_mix, p.hn, T_TOK); ph_rmsnorm(p.mem, p.norm_mkv, p.memn, 1024); }
  { P p = loadP(); ph_transpose<true>(smem, p.w_in, DM, INC, 5760, p.WinT); }
  { P p = loadP(); ph_transpose<false>(smem, p.w_out, DM, DM, DM, p.WoutT); }
  { P p = loadP(); ph_transpose<false>(smem, p.w_pq, DM, DM, DM, p.WpqT); }
  { P p = loadP(); ph_transpose<false>(smem, p.w_mq, DM, 512, 512, p.WmqT); }
  { P p = loadP(); ph_transpose<false>(smem, p.w_mk, DM, 512, 512, p.WmkT); }
  { P p = loadP(); ph_transpose<false>(smem, p.w_mv, DM, 512, 512, p.WmvT); }
  { P p = loadP(); ph_transpose<false>(smem, p.w_mo, 512, DM, DM, p.WmoT); }
  { P p = loadP(); ph_cvt(p.subk, p.subkb, (size_t)16 * 128 * 128); }
  { P p = loadP(); ph_transpose<false>(smem, p.w1_k, 4096, 128, 128, p.w1T); }
  { P p = loadP(); ph_transpose<false>(smem, p.w1_v, 4096, 128, 128, p.w1T + 128 * 4096); }
  { P p = loadP(); ph_transpose<false>(smem, p.w2_k, 128, 128, 128, p.w2T); }
  { P p = loadP(); ph_transpose<false>(smem, p.w2_v, 128, 128, 128, p.w2T + 128 * 128); }
  { P p = loadP(); ph_posb(p); }
  grid.sync();
  XcdBarrier xb;
  { P p = loadP(); xb = xcd_barrier_post(p.bar, (volatile LAS unsigned*)&xb_words); }
  { P p = loadP(); ph_proj(p, lds); }
  { P p = loadP(); bf16_t* kmem = p.kmemb;
    ph_gemm_bf16(p.memn, DM, p.WmkT, DM, 1024, 512, DM, lds, [=](int m, int n, float v) {
      kmem[((size_t)((m >> 8) * 4 + (n >> 7)) * 256 + (m & 255)) * 128 + (n & 127)] = f2bf(v); }); }
  { P p = loadP(); bf16_t* vmem = p.vmemT;
    ph_gemm_bf16(p.memn, DM, p.WmvT, DM, 1024, 512, DM, lds, [=](int m, int n, float v) {
      vmem[((size_t)((m >> 8) * 4 + (n >> 7)) * 128 + (n & 127)) * 256 + perm16(m & 255)] = f2bf(v); }); }
  xcd_barrier(xb);
  { P p = loadP(); ph_compress2(p, lds); }
  { P p = loadP(); ph_sb2(p, lds); }
  xcd_barrier(xb);
  { P p = loadP(); ph_nsa2(p, lds); }
  xcd_barrier(xb);
  { P p = loadP(); float* out = p.out; const float* x = p.x;
    ph_gemm_bf16(p.omix, DM, p.WoutT, DM, T_TOK, DM, DM, lds, [=](int m, int n, float v) { out[(size_t)m * DM + n] = x[(size_t)m * DM + n] + v; }); }
  xcd_barrier(xb);
  { P p = loadP(); ph_rmsnorm(p.out, p.norm_mq, p.hn, T_TOK); }
  xcd_barrier(xb);
  if (blockIdx.x < 256 || gridDim.x < 512) {
    P p = loadP(); bf16_t* qmem = p.qmemb;
    ph_gemm_bf16(p.hn, DM, p.WmqT, DM, T_TOK, 512, DM, lds, [=](int m, int n, float v) { qmem[(size_t)m * 512 + n] = f2bf(v); });
  }
  {
    const int half = (gridDim.x >= 512) ? 256 : 0;
    if ((int)blockIdx.x >= half) {
      const int nwv = ((int)gridDim.x - half) * 4, wid = ((int)blockIdx.x - half) * 4 + (opq(threadIdx.x) >> 6);
      { P p = loadP(); ph_cvt8(p.pu, p.pu8, p.su8, 16384, wid, nwv); }
      { P p = loadP(); ph_cvt8(p.pv, p.pv8, p.sv8, 16384, wid, nwv); }
    }
  }
  xcd_barrier(xb);
  { P p = loadP(); ph_memattn2(p, lds); }
  xcd_barrier(xb);
  { P p = loadP(); float* out = p.out;
    ph_gemm_bf16(p.omem, 512, p.WmoT, 512, T_TOK, DM, 512, lds, [=](int m, int n, float v) { out[(size_t)m * DM + n] += v; }); }
  xcd_barrier(xb);
  { P p = loadP(); ph_rmsnorm(p.out, p.norm_ffn, p.hn, T_TOK); }
  xcd_barrier(xb);
  { P p = loadP(); ph_qp_scores(p, lds); }
  xcd_barrier(xb);
  { P p = loadP(); ph_peer(p, smem); }
}

extern "C" void kernel_launch(void* const* d_in, const int* in_sizes, int n_in, void* d_out, int out_size, void* d_ws,
                              size_t ws_size, hipStream_t stream) {
  P p{};
  p.x = (const float*)d_in[0]; p.mem = (const float*)d_in[1]; p.t5 = (const float*)d_in[2];
  p.norm_mix = (const float*)d_in[3]; p.w_in = (const float*)d_in[4]; p.pos_k = (const float*)d_in[5];
  p.w1_k = (const float*)d_in[6]; p.w2_k = (const float*)d_in[7]; p.pos_v = (const float*)d_in[8];
  p.w1_v = (const float*)d_in[9]; p.w2_v = (const float*)d_in[10]; p.w_out = (const float*)d_in[11];
  p.norm_mq = (const float*)d_in[12]; p.norm_mkv = (const float*)d_in[13]; p.w_mq = (const float*)d_in[14];
  p.w_mk = (const float*)d_in[15]; p.w_mv = (const float*)d_in[16]; p.w_mo = (const float*)d_in[17];
  p.norm_ffn = (const float*)d_in[18]; p.w_pq = (const float*)d_in[19]; p.subk = (const float*)d_in[20];
  p.pu = (const float*)d_in[21]; p.pv = (const float*)d_in[22]; p.norm_final = (const float*)d_in[23];
  p.out = (float*)d_out;
  char* w = (char*)d_ws;
  size_t off = 0;
  auto take = [&](size_t bytes) { char* r = w + off; off += (bytes + 255) & ~(size_t)255; return r; };
  p.bar = (unsigned*)take(XCD_BAR_WORDS * 4);
  p.scores = (float*)take((size_t)T_TOK * DM * 4);
  p.gates = (float*)take((size_t)T_TOK * 24 * 4);
  p.part = (float*)take((size_t)T_TOK * 1024 * 4);
  p.posb = (float*)take(256 * 4);
  p.qn = (bf16_t*)take((size_t)T_TOK * 1024 * 2);
  p.kcin = (bf16_t*)take((size_t)T_TOK * 256 * 2 + 65536);
  p.vcin = (bf16_t*)take((size_t)T_TOK * 256 * 2 + 65536);
  p.ks = (bf16_t*)take((size_t)T_TOK * 256 * 2);
  p.vsT = (bf16_t*)take((size_t)T_TOK * 256 * 2);
  p.kw = (bf16_t*)take((size_t)T_TOK * 256 * 2);
  p.vwT = (bf16_t*)take((size_t)T_TOK * 256 * 2);
  p.kcb = (bf16_t*)take((size_t)8 * 128 * 128 * 2);
  p.vcT = (bf16_t*)take((size_t)8 * 128 * 128 * 2);
  p.c1 = (bf16_t*)take((size_t)16 * 128 * 128 * 2);
  p.w1T = (bf16_t*)take((size_t)2 * 128 * 4096 * 2);
  p.w2T = (bf16_t*)take((size_t)2 * 128 * 128 * 2);
  p.hn = (bf16_t*)take((size_t)T_TOK * DM * 2);
  p.omix = (bf16_t*)take((size_t)T_TOK * DM * 2);
  p.memn = (bf16_t*)take((size_t)1024 * DM * 2);
  p.omem = (bf16_t*)take((size_t)T_TOK * 512 * 2);
  p.WinT = (bf16_t*)take((size_t)5760 * DM * 2);
  p.WoutT = (bf16_t*)take((size_t)DM * DM * 2);
  p.WpqT = (bf16_t*)take((size_t)DM * DM * 2);
  p.WmqT = (bf16_t*)take((size_t)512 * DM * 2);
  p.WmkT = (bf16_t*)take((size_t)512 * DM * 2);
  p.WmvT = (bf16_t*)take((size_t)512 * DM * 2);
  p.WmoT = (bf16_t*)take((size_t)DM * 512 * 2);
  p.qmemb = (bf16_t*)take((size_t)T_TOK * 512 * 2);
  p.kmemb = (bf16_t*)take((size_t)1024 * 512 * 2);
  p.vmemT = (bf16_t*)take((size_t)1024 * 512 * 2);
  p.qsb = (bf16_t*)take((size_t)T_TOK * 1024 * 2);
  p.ksb = (bf16_t*)take((size_t)T_TOK * 1024 * 2);
  p.vsbT = (bf16_t*)take((size_t)T_TOK * 1024 * 2);
  p.pu8 = (unsigned char*)take((size_t)16384 * DM);
  p.pv8 = (unsigned char*)take((size_t)16384 * DM);
  p.su8 = (float*)take(16384 * 4);
  p.sv8 = (float*)take(16384 * 4);
  p.subkb = (bf16_t*)take((size_t)16 * 128 * 128 * 2);
  static int grid_blocks = 0;
  if (!grid_blocks) {
    int dev = 0, cus = 0, per_cu = 0;
    (void)hipGetDevice(&dev);
    (void)hipDeviceGetAttribute(&cus, hipDeviceAttributeMultiprocessorCount, dev);
    (void)hipOccupancyMaxActiveBlocksPerMultiprocessor(&per_cu, mega, 256, 0);
    if (per_cu > 2) per_cu = 2;
    if (per_cu < 1) per_cu = 1;
    grid_blocks = cus * per_cu;
  }
  void* args[] = {&p};
  hipError_t e = hipLaunchCooperativeKernel((void*)mega, dim3(grid_blocks), dim3(256), args, 0, stream);
  if (e != hipSuccess) fprintf(stderr, "cooperative launch failed: %s (grid %d)\n", hipGetErrorString(e), grid_blocks);
}
```

```cpp
#include <hip/hip_runtime.h>
#include <hip/hip_cooperative_groups.h>
#include <cstdio>
namespace cg = cooperative_groups;
#include <stdint.h>

#define SEQ 2048
#define NBATCH 4
#define T_TOK 8192
#define DM 2048
#define INC 5656
#define C_QN 0
#define C_KC 1024
#define C_VC 1280
#define C_KS 1536
#define C_VS 1792
#define C_KW 2048
#define C_VW 2304
#define C_GT 2560
#define C_QSB 2584
#define C_KSB 3608
#define C_VSB 4632
#define ATT_SCALE 0.08838834764831845f
#define RMS_EPS 1e-6f

typedef unsigned short bf16_t;
typedef __attribute__((ext_vector_type(8))) short bf16x8;
typedef __attribute__((ext_vector_type(16))) float f32x16;
typedef __attribute__((ext_vector_type(2))) __bf16 bf16v2;
typedef __attribute__((ext_vector_type(4))) unsigned u32x4;

struct P {
  const float *x, *mem, *t5, *norm_mix, *w_in, *pos_k, *w1_k, *w2_k, *pos_v, *w1_v, *w2_v, *w_out,
      *norm_mq, *norm_mkv, *w_mq, *w_mk, *w_mv, *w_mo, *norm_ffn, *w_pq, *subk, *pu, *pv, *norm_final;
  float* out;
  float *scores, *gates, *part, *posb;
  unsigned* bar;
  bf16_t *hn, *omix, *memn, *omem;
  bf16_t *WinT, *WoutT, *WpqT, *WmqT, *WmkT, *WmvT, *WmoT;
  bf16_t *qmemb, *kmemb, *vmemT;
  bf16_t *qsb, *ksb, *vsbT;
  bf16_t* subkb;
  unsigned char *pu8, *pv8;
  float *su8, *sv8;
  bf16_t *qn, *kcin, *vcin, *ks, *vsT, *kw, *vwT, *kcb, *vcT, *c1, *w1T, *w2T;
};

__device__ __forceinline__ int opq(int v) { asm volatile("" : "+v"(v)); return v; }
__device__ __forceinline__ unsigned pack2(float a, float b) {
  bf16v2 r = {(__bf16)a, (__bf16)b};
  return *(unsigned*)&r;
}
__device__ __forceinline__ bf16_t f2bf(float a) {
  __bf16 r = (__bf16)a;
  return *(bf16_t*)&r;
}
__device__ __forceinline__ int perm16(int s) { return (s & ~12) | ((s & 4) << 1) | ((s & 8) >> 1); }
__device__ __forceinline__ float bf2f(bf16_t u) { return __uint_as_float((unsigned)u << 16); }

__device__ __forceinline__ float wave_max(float v) {
  for (int o = 32; o > 0; o >>= 1) v = fmaxf(v, __shfl_xor(v, o));
  return v;
}
__device__ __forceinline__ float wave_sum(float v) {
  for (int o = 32; o > 0; o >>= 1) v += __shfl_xor(v, o);
  return v;
}
__device__ __forceinline__ void wave_argmax(float& v, int& i) {
  for (int o = 32; o > 0; o >>= 1) {
    float ov = __shfl_xor(v, o);
    int oi = __shfl_xor(i, o);
    if (ov > v || (ov == v && oi < i)) { v = ov; i = oi; }
  }
}
__device__ __forceinline__ float gelu_tanh(float x) {
  return 0.5f * x * (1.f + tanhf(0.7978845608028654f * (x + 0.044715f * x * x * x)));
}
__device__ __forceinline__ float gelu_fast(float x) {
  const float y = 1.5957691216057308f * (x + 0.044715f * x * x * x);
  return x / (1.f + __expf(-y));
}
__device__ __forceinline__ int t5_bucket(int n) {
  if (n < 16) return n < 0 ? 0 : n;
  int b = 16;
  b += (n >= 19); b += (n >= 21); b += (n >= 24); b += (n >= 27); b += (n >= 31); b += (n >= 35);
  b += (n >= 40); b += (n >= 46); b += (n >= 52); b += (n >= 59); b += (n >= 67); b += (n >= 77);
  b += (n >= 87); b += (n >= 99); b += (n >= 113);
  return b;
}
__device__ __forceinline__ float log_sigmoid(float x) {
  return fminf(x, 0.f) - log1pf(expf(-fabsf(x)));
}

__device__ __forceinline__ void ph_rmsnorm(const float* src, const float* gain, bf16_t* dst, int rows) {
  int lane = opq(threadIdx.x) & 63, wv = opq(threadIdx.x) >> 6;
  for (int r = blockIdx.x * 4 + wv; r < rows; r += gridDim.x * 4) {
    const float4* s4 = (const float4*)(src + (size_t)r * DM);
    float4 v[8];
    float ss = 0.f;
#pragma unroll
    for (int i = 0; i < 8; ++i) {
      v[i] = s4[i * 64 + lane];
      ss += v[i].x * v[i].x + v[i].y * v[i].y + v[i].z * v[i].z + v[i].w * v[i].w;
    }
    ss = wave_sum(ss);
    float rs = rsqrtf(ss * (1.f / DM) + RMS_EPS);
    uint2* d2 = (uint2*)(dst + (size_t)r * DM);
    const float4* g4 = (const float4*)gain;
#pragma unroll
    for (int i = 0; i < 8; ++i) {
      float4 g = g4[i * 64 + lane];
      uint2 o;
      o.x = pack2(v[i].x * rs * g.x, v[i].y * rs * g.y);
      o.y = pack2(v[i].z * rs * g.z, v[i].w * rs * g.w);
      d2[i * 64 + lane] = o;
    }
  }
}

template <bool CMAP>
__device__ __forceinline__ void ph_transpose(float* smem, const float* W, int K, int N, int Npad, bf16_t* Wt) {
  float (*tl)[65] = (float (*)[65])smem;
  int tid = opq(threadIdx.x);
  int nk = K / 64, nn = Npad / 64;
  for (int tile = blockIdx.x; tile < nk * nn; tile += gridDim.x) {
    int k0 = (tile % nk) * 64, n0 = (tile / nk) * 64;
    int col = tid & 63, rb = tid >> 6;
#pragma unroll 4
    for (int pp = 0; pp < 16; ++pp) {
      int k = pp * 4 + rb;
      float v = 0.f;
      int sc = n0 + col;
      if (CMAP) sc = (sc < 2560) ? sc : (sc < 5632) ? sc + 24 : (sc < 5656) ? sc - 5632 + 2560 : N;
      if (sc < N) v = W[(size_t)(k0 + k) * N + sc];
      tl[k][col] = v;
    }
    __syncthreads();
    int n = tid >> 2, kc = (tid & 3) * 16;
    unsigned w[8];
#pragma unroll
    for (int i = 0; i < 8; ++i) w[i] = pack2(tl[kc + 2 * i][n], tl[kc + 2 * i + 1][n]);
    uint4* dst = (uint4*)(Wt + (size_t)(n0 + n) * K + k0 + kc);
    dst[0] = make_uint4(w[0], w[1], w[2], w[3]);
    dst[1] = make_uint4(w[4], w[5], w[6], w[7]);
    __syncthreads();
  }
}

__device__ __forceinline__ int lds_off(int row, int chunk) { return row * 128 + ((chunk ^ ((row >> 1) & 7)) << 4); }

template <bool TR, class Epi>
__device__ __forceinline__ void gemm_tile_bf16(const bf16_t* xp, int ldx, const bf16_t* yp, int ldy, int K, char* lds,
                                               Epi epi) {
  const int tid = opq(threadIdx.x), lane = tid & 63, wv = tid >> 6;
  const int wr = wv >> 1, wc = wv & 1;
  char* lx = lds;
  char* ly = lds + 16384;
  f32x16 acc[2][2];
#pragma unroll
  for (int i = 0; i < 2; ++i)
#pragma unroll
    for (int j = 0; j < 2; ++j)
#pragma unroll
      for (int r = 0; r < 16; ++r) acc[i][j][r] = 0.f;
  const int srow = tid >> 3, sch = tid & 7;
  const bf16_t* xg = xp + (size_t)srow * ldx + sch * 8;
  const bf16_t* yg = yp + (size_t)srow * ldy + sch * 8;
  const size_t x32 = (size_t)32 * ldx, y32 = (size_t)32 * ldy;
  uint4 sx0 = *(const uint4*)(xg), sx1 = *(const uint4*)(xg + x32), sx2 = *(const uint4*)(xg + 2 * x32),
        sx3 = *(const uint4*)(xg + 3 * x32);
  uint4 sy0 = *(const uint4*)(yg), sy1 = *(const uint4*)(yg + y32), sy2 = *(const uint4*)(yg + 2 * y32),
        sy3 = *(const uint4*)(yg + 3 * y32);
  const int so0 = lds_off(srow, sch), so1 = lds_off(32 + srow, sch), so2 = lds_off(64 + srow, sch),
            so3 = lds_off(96 + srow, sch);
  for (int k0 = 0; k0 < K; k0 += 64) {
    __syncthreads();
    *(uint4*)(lx + so0) = sx0; *(uint4*)(lx + so1) = sx1; *(uint4*)(lx + so2) = sx2; *(uint4*)(lx + so3) = sx3;
    *(uint4*)(ly + so0) = sy0; *(uint4*)(ly + so1) = sy1; *(uint4*)(ly + so2) = sy2; *(uint4*)(ly + so3) = sy3;
    __syncthreads();
    if (k0 + 64 < K) {
      const bf16_t* xn = xg + k0 + 64;
      const bf16_t* yn = yg + k0 + 64;
      sx0 = *(const uint4*)(xn); sx1 = *(const uint4*)(xn + x32); sx2 = *(const uint4*)(xn + 2 * x32);
      sx3 = *(const uint4*)(xn + 3 * x32);
      sy0 = *(const uint4*)(yn); sy1 = *(const uint4*)(yn + y32); sy2 = *(const uint4*)(yn + 2 * y32);
      sy3 = *(const uint4*)(yn + 3 * y32);
    }
#pragma unroll
    for (int kk = 0; kk < 4; ++kk) {
      bf16x8 a[2], b[2];
      const int ch = kk * 2 + (lane >> 5);
#pragma unroll
      for (int i = 0; i < 2; ++i) {
        a[i] = *(const bf16x8*)((TR ? ly : lx) + lds_off(wr * 64 + i * 32 + (lane & 31), ch));
        b[i] = *(const bf16x8*)((TR ? lx : ly) + lds_off(wc * 64 + i * 32 + (lane & 31), ch));
      }
#pragma unroll
      for (int i = 0; i < 2; ++i)
#pragma unroll
        for (int j = 0; j < 2; ++j) acc[i][j] = __builtin_amdgcn_mfma_f32_32x32x16_bf16(a[i], b[j], acc[i][j], 0, 0, 0);
    }
  }
  int lane2 = lane;
  asm volatile("" : "+v"(lane2));
#pragma unroll
  for (int i = 0; i < 2; ++i)
#pragma unroll
    for (int j = 0; j < 2; ++j)
#pragma unroll
      for (int r = 0; r < 16; ++r) {
        int rr = wr * 64 + i * 32 + (r & 3) + 8 * (r >> 2) + 4 * (lane2 >> 5);
        int cc = wc * 64 + j * 32 + (lane2 & 31);
        epi(rr, cc, acc[i][j][r]);
      }
}

template <class Epi>
__device__ __forceinline__ void ph_gemm_bf16(const bf16_t* A, int lda, const bf16_t* Wt, int ldw, int M, int N, int K,
                                             char* lds, Epi epi) {
  const int ntm = M / 128, ntn = N / 128;
  const int npm = (ntm + 7) / 8, npn = (ntn + 7) / 8;
  const int nslots = ((npm * npn * 64 + 511) / 512) * 512;
  for (int u = blockIdx.x; u < nslots; u += gridDim.x) {
    int v = (u & 7) * 64 + ((u >> 3) & 63) + (u & ~511);
    int patch = v >> 6, w = v & 63;
    int tm = (patch % npm) * 8 + (w & 7);
    int tn = (patch / npm) * 8 + (w >> 3);
    if (tm >= ntm || tn >= ntn) continue;
    const int m0 = tm * 128, n0 = tn * 128;
    gemm_tile_bf16<false>(A + (size_t)m0 * lda, lda, Wt + (size_t)n0 * ldw, ldw, K, lds,
                          [&](int r, int c, float val) { epi(m0 + r, n0 + c, val); });
  }
}

__device__ __forceinline__ void ph_proj(const P& p, char* lds) {
  const int ntm = T_TOK / 128, ntn = 5760 / 128;
  const int npm = (ntm + 7) / 8, npn = (ntn + 7) / 8;
  const int nslots = ((npm * npn * 64 + 511) / 512) * 512;
  for (int u = blockIdx.x; u < nslots; u += gridDim.x) {
    int v = (u & 7) * 64 + ((u >> 3) & 63) + (u & ~511);
    int patch = v >> 6, w = v & 63;
    int tm = (patch % npm) * 8 + (w & 7);
    int tn = (patch / npm) * 8 + (w >> 3);
    if (tm >= ntm || tn >= ntn) continue;
    const int m0 = tm * 128, n0 = tn * 128;
    const int b = m0 >> 11, sl = m0 & 2047;
    const bf16_t* A = p.hn + (size_t)m0 * DM;
    const bf16_t* W = p.WinT + (size_t)n0 * DM;
    if (n0 < 1024) {
      bf16_t* q = p.qn + (size_t)m0 * 1024 + n0;
      gemm_tile_bf16<false>(A, DM, W, DM, DM, lds, [&](int r, int c, float val) { q[(size_t)r * 1024 + c] = f2bf(val); });
    } else if (n0 < 2560) {
      const int seg = (n0 - 1024) >> 8, g = ((n0 - 1024) >> 7) & 1;
      if (seg == 3 || seg == 5) {
        bf16_t* vd = (seg == 3 ? p.vsT : p.vwT) + ((size_t)(b * 2 + g) * 128) * SEQ + sl;
        gemm_tile_bf16<true>(A, DM, W, DM, DM, lds, [&](int r, int c, float val) { vd[(size_t)r * SEQ + perm16(c)] = f2bf(val); });
      } else {
        bf16_t* base = (seg == 0) ? p.kcin : (seg == 1) ? p.vcin : (seg == 2) ? p.ks : p.kw;
        bf16_t* kd = base + ((size_t)(b * 2 + g) * SEQ + sl) * 128;
        gemm_tile_bf16<false>(A, DM, W, DM, DM, lds, [&](int r, int c, float val) { kd[(size_t)r * 128 + c] = f2bf(val); });
      }
    } else if (n0 < 3584) {
      bf16_t* q = p.qsb + (size_t)m0 * 1024 + (n0 - 2560);
      gemm_tile_bf16<false>(A, DM, W, DM, DM, lds, [&](int r, int c, float val) { q[(size_t)r * 1024 + c] = f2bf(val); });
    } else if (n0 < 4608) {
      bf16_t* kd = p.ksb + ((size_t)(b * 8 + ((n0 - 3584) >> 7)) * SEQ + sl) * 128;
      gemm_tile_bf16<false>(A, DM, W, DM, DM, lds, [&](int r, int c, float val) { kd[(size_t)r * 128 + c] = f2bf(val); });
    } else if (n0 < 5632) {
      bf16_t* vd = p.vsbT + ((size_t)(b * 8 + ((n0 - 4608) >> 7)) * 128) * SEQ + sl;
      gemm_tile_bf16<true>(A, DM, W, DM, DM, lds, [&](int r, int c, float val) { vd[(size_t)r * SEQ + perm16(c)] = f2bf(val); });
    } else {
      float* gd = p.gates + (size_t)m0 * 24;
      gemm_tile_bf16<false>(A, DM, W, DM, DM, lds, [&](int r, int c, float val) { if (c < 24) gd[(size_t)r * 24 + c] = val; });
    }
  }
}

__device__ __forceinline__ void ph_posb(const P& p) {
  const int lane = opq(threadIdx.x) & 63, wv = opq(threadIdx.x) >> 6;
  for (int o = blockIdx.x * 4 + wv; o < 256; o += gridDim.x * 4) {
    const int which = o >> 7, n = o & 127;
    const float* pos = which ? p.pos_v : p.pos_k;
    const float* w1 = which ? p.w1_v : p.w1_k;
    float acc = 0.f;
    for (int k = lane; k < 4096; k += 64) acc += pos[k] * w1[(size_t)k * 128 + n];
    acc = wave_sum(acc);
    if (lane == 0) p.posb[o] = acc;
  }
}

__device__ __forceinline__ void ph_compress2(const P& p, char* lds) {
  for (int item = blockIdx.x; item < 16; item += gridDim.x) {
    const int which = item >> 3, bg = item & 7;
    const bf16_t* src = (which ? p.vcin : p.kcin) + (size_t)bg * SEQ * 128;
    const bf16_t* w1t = p.w1T + (size_t)which * 128 * 4096;
    const bf16_t* w2t = p.w2T + (size_t)which * 128 * 128;
    const float* posb = p.posb + which * 128;
    bf16_t* c1 = p.c1 + (size_t)item * 128 * 128;
    gemm_tile_bf16<false>(src, 2048, w1t, 4096, 4096, lds, [&](int r, int c, float val) {
      c1[r * 128 + c] = f2bf(gelu_fast(val + posb[c])); });
    __threadfence_block();
    __syncthreads();
    if (which == 0) {
      bf16_t* kd = p.kcb + (size_t)bg * 128 * 128;
      gemm_tile_bf16<false>(c1, 128, w2t, 128, 128, lds, [&](int r, int c, float val) { kd[r * 128 + c] = f2bf(val); });
    } else {
      bf16_t* vd = p.vcT + (size_t)bg * 128 * 128;
      gemm_tile_bf16<true>(c1, 128, w2t, 128, 128, lds, [&](int r, int c, float val) { vd[r * 128 + perm16(c)] = f2bf(val); });
    }
  }
}

#define NEG_BIG (-1e30f)

struct KVRegs { u32x4 k0, k1, k2, k3, v0, v1, v2, v3; };

__device__ __forceinline__ int koff(int row, int chunk) { return row * 256 + ((chunk ^ (row & 15)) << 4); }

__device__ __forceinline__ void kv_load(KVRegs& r, const bf16_t* kp, int ldk, const bf16_t* vp, int ldv) {
  const int tid = opq(threadIdx.x);
  const bf16_t* kg = kp + (size_t)(tid >> 4) * ldk + (tid & 15) * 8;
  r.k0 = *(const u32x4*)kg;
  r.k1 = *(const u32x4*)(kg + (size_t)16 * ldk);
  r.k2 = *(const u32x4*)(kg + (size_t)32 * ldk);
  r.k3 = *(const u32x4*)(kg + (size_t)48 * ldk);
  const bf16_t* vg = vp + (size_t)(tid >> 3) * ldv + (tid & 7) * 8;
  r.v0 = *(const u32x4*)vg;
  r.v1 = *(const u32x4*)(vg + (size_t)32 * ldv);
  r.v2 = *(const u32x4*)(vg + (size_t)64 * ldv);
  r.v3 = *(const u32x4*)(vg + (size_t)96 * ldv);
}
__device__ __forceinline__ void kv_store(const KVRegs& r, char* lk, char* lv) {
  const int tid = opq(threadIdx.x);
  const int row = tid >> 4, ch = tid & 15;
  *(u32x4*)(lk + koff(row, ch)) = r.k0;
  *(u32x4*)(lk + koff(row + 16, ch)) = r.k1;
  *(u32x4*)(lk + koff(row + 32, ch)) = r.k2;
  *(u32x4*)(lk + koff(row + 48, ch)) = r.k3;
  const int vr = tid >> 3, vc = tid & 7;
  *(u32x4*)(lv + lds_off(vr, vc)) = r.v0;
  *(u32x4*)(lv + lds_off(vr + 32, vc)) = r.v1;
  *(u32x4*)(lv + lds_off(vr + 64, vc)) = r.v2;
  *(u32x4*)(lv + lds_off(vr + 96, vc)) = r.v3;
}

struct QFrag { bf16x8 f0, f1, f2, f3, f4, f5, f6, f7; };
__device__ __forceinline__ void q_load(QFrag& q, const bf16_t* qrow) {
  const int h = (opq(threadIdx.x) & 63) >> 5;
  const bf16x8* p8 = (const bf16x8*)(qrow + 8 * h);
  q.f0 = p8[0]; q.f1 = p8[2]; q.f2 = p8[4]; q.f3 = p8[6]; q.f4 = p8[8]; q.f5 = p8[10]; q.f6 = p8[12]; q.f7 = p8[14];
}

__device__ __forceinline__ void qk_tile(const QFrag& q, const char* lk, f32x16& s0, f32x16& s1) {
  const int lane = opq(threadIdx.x) & 63, row = lane & 31, h = lane >> 5;
#pragma unroll
  for (int r = 0; r < 16; ++r) { s0[r] = 0.f; s1[r] = 0.f; }
#define QK_STEP(kk, qf)                                                                  \
  {                                                                                      \
    bf16x8 a0 = *(const bf16x8*)(lk + koff(row, 2 * (kk) + h));                          \
    bf16x8 a1 = *(const bf16x8*)(lk + koff(row + 32, 2 * (kk) + h));                     \
    s0 = __builtin_amdgcn_mfma_f32_32x32x16_bf16(a0, qf, s0, 0, 0, 0);                   \
    s1 = __builtin_amdgcn_mfma_f32_32x32x16_bf16(a1, qf, s1, 0, 0, 0);                   \
  }
  QK_STEP(0, q.f0) QK_STEP(1, q.f1) QK_STEP(2, q.f2) QK_STEP(3, q.f3)
  QK_STEP(4, q.f4) QK_STEP(5, q.f5) QK_STEP(6, q.f6) QK_STEP(7, q.f7)
#undef QK_STEP
}

__device__ __forceinline__ bf16x8 pack8(const f32x16& p, const int base) {
  u32x4 u;
  u[0] = pack2(p[base + 0], p[base + 1]);
  u[1] = pack2(p[base + 2], p[base + 3]);
  u[2] = pack2(p[base + 4], p[base + 5]);
  u[3] = pack2(p[base + 6], p[base + 7]);
  return __builtin_bit_cast(bf16x8, u);
}

struct OAcc { f32x16 o0, o1, o2, o3; };
__device__ __forceinline__ void oacc_zero(OAcc& o) {
#pragma unroll
  for (int r = 0; r < 16; ++r) { o.o0[r] = 0.f; o.o1[r] = 0.f; o.o2[r] = 0.f; o.o3[r] = 0.f; }
}
__device__ __forceinline__ void oacc_scale(OAcc& o, float a) {
#pragma unroll
  for (int r = 0; r < 16; ++r) { o.o0[r] *= a; o.o1[r] *= a; o.o2[r] *= a; o.o3[r] *= a; }
}

__device__ __forceinline__ void pv_tile(OAcc& o, const char* lv, const f32x16& p0, const f32x16& p1) {
  const int lane = opq(threadIdx.x) & 63, row = lane & 31, h = lane >> 5;
  const bf16x8 pf0 = pack8(p0, 0), pf1 = pack8(p0, 8), pf2 = pack8(p1, 0), pf3 = pack8(p1, 8);
#define PV_ROW(dd, acc)                                                                                      \
  {                                                                                                          \
    acc = __builtin_amdgcn_mfma_f32_32x32x16_bf16(*(const bf16x8*)(lv + lds_off(32 * (dd) + row, 0 + h)), pf0, acc, 0, 0, 0); \
    acc = __builtin_amdgcn_mfma_f32_32x32x16_bf16(*(const bf16x8*)(lv + lds_off(32 * (dd) + row, 2 + h)), pf1, acc, 0, 0, 0); \
    acc = __builtin_amdgcn_mfma_f32_32x32x16_bf16(*(const bf16x8*)(lv + lds_off(32 * (dd) + row, 4 + h)), pf2, acc, 0, 0, 0); \
    acc = __builtin_amdgcn_mfma_f32_32x32x16_bf16(*(const bf16x8*)(lv + lds_off(32 * (dd) + row, 6 + h)), pf3, acc, 0, 0, 0); \
  }
  PV_ROW(0, o.o0) PV_ROW(1, o.o1) PV_ROW(2, o.o2) PV_ROW(3, o.o3)
#undef PV_ROW
}

__device__ __forceinline__ void softmax_tile(f32x16& s0, f32x16& s1, float& m, float& l, OAcc& o) {
  float mx = NEG_BIG;
#pragma unroll
  for (int r = 0; r < 16; ++r) mx = fmaxf(mx, fmaxf(s0[r], s1[r]));
  mx = fmaxf(mx, __shfl_xor(mx, 32));
  const float mn = fmaxf(m, mx);
  const float alpha = __expf(m - mn);
  float ls = 0.f;
#pragma unroll
  for (int r = 0; r < 16; ++r) {
    float a = (s0[r] > -1e29f) ? __expf(s0[r] - mn) : 0.f;
    float b = (s1[r] > -1e29f) ? __expf(s1[r] - mn) : 0.f;
    s0[r] = a; s1[r] = b;
    ls += a + b;
  }
  ls += __shfl_xor(ls, 32);
  l = l * alpha + ls;
  m = mn;
  if (__any(alpha != 1.f)) oacc_scale(o, alpha);
}

template <class F>
__device__ __forceinline__ void oacc_foreach(const OAcc& o, F f) {
  const int h = (opq(threadIdx.x) & 63) >> 5;
#pragma unroll
  for (int rho = 0; rho < 4; ++rho) {
    f(0 + 8 * rho + 4 * h, o.o0[4 * rho], o.o0[4 * rho + 1], o.o0[4 * rho + 2], o.o0[4 * rho + 3]);
    f(32 + 8 * rho + 4 * h, o.o1[4 * rho], o.o1[4 * rho + 1], o.o1[4 * rho + 2], o.o1[4 * rho + 3]);
    f(64 + 8 * rho + 4 * h, o.o2[4 * rho], o.o2[4 * rho + 1], o.o2[4 * rho + 2], o.o2[4 * rho + 3]);
    f(96 + 8 * rho + 4 * h, o.o3[4 * rho], o.o3[4 * rho + 1], o.o3[4 * rho + 2], o.o3[4 * rho + 3]);
  }
}

__device__ __forceinline__ void ph_memattn2(const P& p, char* lds) {
  char* lk = lds;
  char* lv = lds + 16384;
  const int lane = opq(threadIdx.x) & 63, wv = opq(threadIdx.x) >> 6;
  for (int item = blockIdx.x; item < NBATCH * 4 * (SEQ / 128); item += gridDim.x) {
    const int tb = item % (SEQ / 128);
    const int bh = item / (SEQ / 128);
    const int b = bh >> 2, hd = bh & 3;
    const int t = tb * 128 + wv * 32 + (lane & 31);
    QFrag q;
    q_load(q, p.qmemb + (size_t)(b * SEQ + t) * 512 + hd * 128);
    const bf16_t* kb = p.kmemb + (size_t)bh * 256 * 128;
    const bf16_t* vb = p.vmemT + (size_t)bh * 128 * 256;
    OAcc o;
    oacc_zero(o);
    float m = NEG_BIG, l = 0.f;
    KVRegs kv;
    kv_load(kv, kb, 128, vb, 256);
#pragma unroll 1
    for (int ti = 0; ti < 4; ++ti) {
      __syncthreads();
      kv_store(kv, lk, lv);
      __syncthreads();
      {
        const int tn = (ti + 1 < 4) ? ti + 1 : 3;
        kv_load(kv, kb + (size_t)tn * 64 * 128, 128, vb + tn * 64, 256);
      }
      f32x16 s0, s1;
      qk_tile(q, lk, s0, s1);
#pragma unroll
      for (int r = 0; r < 16; ++r) { s0[r] *= ATT_SCALE; s1[r] *= ATT_SCALE; }
      softmax_tile(s0, s1, m, l, o);
      pv_tile(o, lv, s0, s1);
    }
    const float il = 1.f / l;
    const int t2 = tb * 128 + (opq(threadIdx.x) >> 6) * 32 + (opq(threadIdx.x) & 31);
    bf16_t* orow = p.omem + (size_t)(b * SEQ + t2) * 512 + hd * 128;
    oacc_foreach(o, [&](int d, float v0, float v1, float v2, float v3) {
      uint2 u;
      u.x = pack2(v0 * il, v1 * il);
      u.y = pack2(v2 * il, v3 * il);
      *(uint2*)(orow + d) = u;
    });
  }
}

__device__ __forceinline__ void ph_sb2(const P& p, char* lds) {
  char* lk = lds;
  char* lv = lds + 16384;
  const int lane = opq(threadIdx.x) & 63, wv = opq(threadIdx.x) >> 6, hh = lane >> 5;
  const int sb_skip = (gridDim.x > 32) ? 16 : 0;
  if ((int)blockIdx.x < sb_skip) return;
  for (int item = (int)blockIdx.x - sb_skip; item < NBATCH * 8 * (SEQ / 128); item += (int)gridDim.x - sb_skip) {
    const int tb = (SEQ / 128 - 1) - (item % (SEQ / 128));
    const int bh = item / (SEQ / 128);
    const int b = bh >> 3, hd = bh & 7;
    const int t0 = tb * 128;
    const int t = t0 + wv * 32 + (lane & 31);
    QFrag q;
    q_load(q, p.qsb + (size_t)(b * SEQ + t) * 1024 + hd * 128);
    const bf16_t* kb = p.ksb + (size_t)bh * SEQ * 128;
    const bf16_t* vb = p.vsbT + (size_t)bh * 128 * SEQ;
    OAcc o;
    oacc_zero(o);
    float carry = 0.f;
    const int jhi = (t0 >> 6) + 1;
    const int jw = (t0 + wv * 32 + 30) >> 6;
    KVRegs kv;
    kv_load(kv, kb + (size_t)jhi * 64 * 128, 128, vb + jhi * 64, SEQ);
    volatile unsigned* dflag = (volatile unsigned*)(lds + 32768);
    __syncthreads();
    if (opq(threadIdx.x) < 4) dflag[opq(threadIdx.x)] = 0u;
    for (int j = jhi; j >= 0; --j) {
      __syncthreads();
      if ((dflag[0] & dflag[1] & dflag[2] & dflag[3]) != 0u) break;
      kv_store(kv, lk, lv);
      __syncthreads();
      const int jn = (j > 0) ? j - 1 : 0;
      if (j > jw) kv_load(kv, kb + (size_t)jn * 64 * 128, 128, vb + jn * 64, SEQ);
      if (j <= jw) {
        f32x16 z0, z1;
        qk_tile(q, lk, z0, z1);
        const int sbase = j * 64 + 4 * hh;
        float gt[8];
        f32x16 l0, l1;
#pragma unroll
        for (int r = 0; r < 16; ++r) {
          const int so = sbase + 8 * (r >> 2) + (r & 3);
          {
            const float z = z0[r] * ATT_SCALE;
            const bool valid = so < t;
            const float lsp = fminf(z, 0.f) - __logf(1.f + __expf(-fabsf(z)));
            l0[r] = valid ? (lsp - z) : 0.f;
            z0[r] = valid ? z : NEG_BIG;
          }
          {
            const float z = z1[r] * ATT_SCALE;
            const bool valid = so + 32 < t;
            const float lsp = fminf(z, 0.f) - __logf(1.f + __expf(-fabsf(z)));
            l1[r] = valid ? (lsp - z) : 0.f;
            z1[r] = valid ? z : NEG_BIG;
          }
        }
#pragma unroll
        for (int rho = 0; rho < 4; ++rho) {
          gt[rho] = (l0[4 * rho] + l0[4 * rho + 1]) + (l0[4 * rho + 2] + l0[4 * rho + 3]);
          gt[4 + rho] = (l1[4 * rho] + l1[4 * rho + 1]) + (l1[4 * rho + 2] + l1[4 * rho + 3]);
        }
        float ag[8];
        float run = 0.f;
#pragma unroll
        for (int k = 7; k >= 0; --k) {
          const float pg = __shfl_xor(gt[k], 32);
          ag[k] = carry + run + (hh == 0 ? pg : 0.f);
          run += gt[k] + pg;
        }
        carry += run;
#pragma unroll
        for (int rho = 0; rho < 4; ++rho) {
          {
            const float x3 = l0[4 * rho + 3], x23 = x3 + l0[4 * rho + 2], x123 = x23 + l0[4 * rho + 1];
            const float g = ag[rho];
            z0[4 * rho + 0] = __expf((l0[4 * rho + 0] + z0[4 * rho + 0]) + (g + x123));
            z0[4 * rho + 1] = __expf((l0[4 * rho + 1] + z0[4 * rho + 1]) + (g + x23));
            z0[4 * rho + 2] = __expf((l0[4 * rho + 2] + z0[4 * rho + 2]) + (g + x3));
            z0[4 * rho + 3] = __expf((l0[4 * rho + 3] + z0[4 * rho + 3]) + g);
          }
          {
            const float x3 = l1[4 * rho + 3], x23 = x3 + l1[4 * rho + 2], x123 = x23 + l1[4 * rho + 1];
            const float g = ag[4 + rho];
            z1[4 * rho + 0] = __expf((l1[4 * rho + 0] + z1[4 * rho + 0]) + (g + x123));
            z1[4 * rho + 1] = __expf((l1[4 * rho + 1] + z1[4 * rho + 1]) + (g + x23));
            z1[4 * rho + 2] = __expf((l1[4 * rho + 2] + z1[4 * rho + 2]) + (g + x3));
            z1[4 * rho + 3] = __expf((l1[4 * rho + 3] + z1[4 * rho + 3]) + g);
          }
        }
        kv_load(kv, kb + (size_t)jn * 64 * 128, 128, vb + jn * 64, SEQ);
        pv_tile(o, lv, z0, z1);
        if (__all(carry < -104.f) && (opq(threadIdx.x) & 63) == 0) dflag[wv] = 1u;
      }
    }
    int t2 = t;
    asm volatile("" : "+v"(t2));
    bf16_t* orow = p.omix + (size_t)(b * SEQ + t2) * DM + 1024 + hd * 128;
    oacc_foreach(o, [&](int d, float v0, float v1, float v2, float v3) {
      uint2 u;
      u.x = pack2(v0, v1);
      u.y = pack2(v2, v3);
      *(uint2*)(orow + d) = u;
    });
  }
}

#define NSA_IMP 32768
#define NSA_KEYS 49152
#define NSA_SELM 53504
#define NSA_LUT 53632
__device__ __forceinline__ void ph_nsa2(const P& p, char* lds) {
  typedef __attribute__((ext_vector_type(4))) float f32x4;
  char* lk = lds;
  char* lv = lds + 16384;
  float* imp = (float*)(lds + NSA_IMP);
  float* keys = (float*)(lds + NSA_KEYS);
  unsigned* selm = (unsigned*)(lds + NSA_SELM);
  const int tid = opq(threadIdx.x), lane = tid & 63, wv = tid >> 6, hh = lane >> 5, ql = lane & 31;
  float* lut = (float*)(lds + NSA_LUT) + wv * 128;
  for (int item = blockIdx.x; item < NBATCH * 2 * (SEQ / 32); item += gridDim.x) {
    const int tt = (item < 256) ? (SEQ / 32 - 1) - (item % (SEQ / 32)) : (item % (SEQ / 32));
    const int bg = item / (SEQ / 32);
    const int b = bg >> 1, g = bg & 1;
    const int h = g * 4 + wv;
    const int t0 = tt * 32, tq = t0 + ql, cur = t0 >> 6;
    __syncthreads();
    QFrag q;
    q_load(q, p.qn + (size_t)(b * SEQ + tq) * 1024 + h * 128);
    {
      const int lo = opq(lane);
      lut[lo] = p.t5[t5_bucket(lo) * 8 + h];
      lut[lo + 64] = p.t5[t5_bucket(lo + 64) * 8 + h];
    }
#pragma unroll
    for (int i = 0; i < 16; ++i) imp[i * 256 + tid] = 0.f;
    if (tid < 32) selm[tid] = 0u;
    const float* grow = p.gates + (size_t)(b * SEQ + tq) * 24 + h * 3;
    float* prow = p.part + (size_t)(b * SEQ + tq) * 1024 + h * 128;
    OAcc o;
    float m, l;
    KVRegs kv;
    {
      const bf16_t* kb = p.kcb + (size_t)bg * 128 * 128;
      const bf16_t* vb = p.vcT + (size_t)bg * 128 * 128;
      oacc_zero(o);
      m = NEG_BIG; l = 0.f;
      kv_load(kv, kb, 128, vb, 128);
      __syncthreads();
      kv_store(kv, lk, lv);
      __syncthreads();
      f32x16 x0, x1;
      qk_tile(q, lk, x0, x1);
      int tqv = tq;
      asm volatile("" : "+v"(tqv));
      tqv -= 64 * hh;
      if (t0 >= 1152) {
        const float b31 = lut[127];
#pragma unroll
        for (int r = 0; r < 16; ++r) { x0[r] = x0[r] * ATT_SCALE + b31; x1[r] = x1[r] * ATT_SCALE + b31; }
      } else {
#pragma unroll
        for (int r = 0; r < 16; ++r) {
          const int c = 8 * (r >> 2) + (r & 3);
          const int d0 = tqv - 16 * c - 31, d1 = d0 - 512;
          x0[r] = (d0 >= 0) ? x0[r] * ATT_SCALE + lut[min(d0, 127)] : NEG_BIG;
          x1[r] = (d1 >= 0) ? x1[r] * ATT_SCALE + lut[min(d1, 127)] : NEG_BIG;
        }
      }
      softmax_tile(x0, x1, m, l, o);
      const float m0 = m;
      pv_tile(o, lv, x0, x1);
      f32x16 z0, z1;
#pragma unroll
      for (int r = 0; r < 16; ++r) { z0[r] = 0.f; z1[r] = 0.f; }
      if (t0 >= 1024) {
        kv_load(kv, kb + 64 * 128, 128, vb + 64, 128);
        __syncthreads();
        kv_store(kv, lk, lv);
        __syncthreads();
        qk_tile(q, lk, z0, z1);
        asm volatile("" : "+v"(tqv));
#pragma unroll
        for (int r = 0; r < 16; ++r) {
          const int c = 64 + 8 * (r >> 2) + (r & 3);
          const int d0 = tqv - 16 * c - 31, d1 = d0 - 512;
          z0[r] = (d0 >= 0) ? z0[r] * ATT_SCALE + lut[min(d0, 127)] : NEG_BIG;
          z1[r] = (d1 >= 0) ? z1[r] * ATT_SCALE + lut[min(d1, 127)] : NEG_BIG;
        }
        softmax_tile(z0, z1, m, l, o);
        pv_tile(o, lv, z0, z1);
      }
      const float inv = 1.f / fmaxf(l, 1e-20f);
      const float c0 = __expf(m0 - m) * inv;
#pragma unroll
      for (int r = 0; r < 16; ++r) {
        const int c = 8 * (r >> 2) + (r & 3) + 4 * hh;
        if (x0[r] != 0.f) atomicAdd(&imp[(c) * 32 + ql], x0[r] * c0);
        if (x1[r] != 0.f) atomicAdd(&imp[(c + 32) * 32 + ql], x1[r] * c0);
        if (z0[r] != 0.f) atomicAdd(&imp[(c + 64) * 32 + ql], z0[r] * inv);
        if (z1[r] != 0.f) atomicAdd(&imp[(c + 96) * 32 + ql], z1[r] * inv);
      }
      const float gs = inv / (1.f + __expf(-grow[0]));
      oacc_foreach(o, [&](int d, float v0, float v1, float v2, float v3) {
        f32x4 u = {v0 * gs, v1 * gs, v2 * gs, v3 * gs};
        *(f32x4*)(prow + d) = u;
      });
    }
    __syncthreads();
    {
      const int tido = opq(tid);
      const int qq = tido & 31, jg = tido >> 5;
#pragma unroll
      for (int jj = 0; jj < 4; ++jj) {
        const int j = jg * 4 + jj;
        float v = imp[(4 * j) * 32 + qq] + imp[(4 * j + 1) * 32 + qq] + imp[(4 * j + 2) * 32 + qq] + 0.5f * imp[(4 * j + 3) * 32 + qq];
        if (j > 0) v += 0.5f * imp[(4 * j - 1) * 32 + qq];
        const bool forced = (j == 0) || (j == cur) || (j == cur - 1);
        keys[qq * 33 + j] = forced ? 1e9f : ((j <= cur) ? v : -1e9f);
      }
      __syncthreads();
      unsigned bits = 0u;
#pragma unroll
      for (int jj = 0; jj < 4; ++jj) {
        const int j = jg * 4 + jj;
        const float kj = keys[qq * 33 + j];
        int rank = 0;
        for (int i = 0; i < 32; ++i) {
          const float ki = keys[qq * 33 + i];
          rank += (ki > kj || (ki == kj && i < j)) ? 1 : 0;
        }
        if (rank < 16 && j <= cur) bits |= 1u << j;
      }
      atomicOr(&selm[qq], bits);
      __syncthreads();
    }
    const unsigned mysel = selm[ql];
    unsigned um = mysel;
#pragma unroll
    for (int o2 = 16; o2 > 0; o2 >>= 1) um |= (unsigned)__shfl_xor((int)um, o2);
    um = (unsigned)__builtin_amdgcn_readfirstlane((int)um);
    {
      const bf16_t* kb = p.ks + (size_t)bg * SEQ * 128;
      const bf16_t* vb = p.vsT + (size_t)bg * 128 * SEQ;
      oacc_zero(o);
      m = NEG_BIG; l = 0.f;
      unsigned rem = um;
      int j = __builtin_ctz(rem);
      kv_load(kv, kb + (size_t)j * 64 * 128, 128, vb + j * 64, SEQ);
      while (rem) {
        j = __builtin_ctz(rem);
        rem &= rem - 1;
        const int jn = rem ? __builtin_ctz(rem) : j;
        __syncthreads();
        kv_store(kv, lk, lv);
        __syncthreads();
        f32x16 s0, s1;
        qk_tile(q, lk, s0, s1);
        const bool selq = (mysel >> j) & 1u;
        int tqv = tq;
        asm volatile("" : "+v"(tqv));
        if (j * 64 + 63 + 113 <= t0) {
          const float sc = selq ? ATT_SCALE : 0.f, bb = selq ? lut[127] : NEG_BIG;
#pragma unroll
          for (int r = 0; r < 16; ++r) { s0[r] = s0[r] * sc + bb; s1[r] = s1[r] * sc + bb; }
        } else {
#pragma unroll
          for (int r = 0; r < 16; ++r) {
            const int d0 = tqv - (j * 64 + 8 * (r >> 2) + (r & 3) + 4 * hh), d1 = d0 - 32;
            s0[r] = (selq && d0 >= 0) ? s0[r] * ATT_SCALE + lut[min(d0, 127)] : NEG_BIG;
            s1[r] = (selq && d1 >= 0) ? s1[r] * ATT_SCALE + lut[min(d1, 127)] : NEG_BIG;
          }
        }
        kv_load(kv, kb + (size_t)jn * 64 * 128, 128, vb + jn * 64, SEQ);
        softmax_tile(s0, s1, m, l, o);
        pv_tile(o, lv, s0, s1);
      }
      const float gs = 1.f / (fmaxf(l, 1e-20f) * (1.f + __expf(-grow[1])));
      int qo = ql;
      asm volatile("" : "+v"(qo));
      float* pr2 = p.part + (size_t)(b * SEQ + t0 + qo) * 1024 + h * 128;
      oacc_foreach(o, [&](int d, float v0, float v1, float v2, float v3) {
        f32x4 u = *(f32x4*)(pr2 + d);
        u[0] += v0 * gs; u[1] += v1 * gs; u[2] += v2 * gs; u[3] += v3 * gs;
        *(f32x4*)(pr2 + d) = u;
      });
    }
    {
      const bf16_t* kb = p.kw + (size_t)bg * SEQ * 128;
      const bf16_t* vb = p.vwT + (size_t)bg * 128 * SEQ;
      oacc_zero(o);
      m = NEG_BIG; l = 0.f;
      int jlo = (t0 - 511) >> 6;
      if (jlo < 0) jlo = 0;
      kv_load(kv, kb + (size_t)jlo * 64 * 128, 128, vb + jlo * 64, SEQ);
      for (int j = jlo; j <= cur; ++j) {
        const int jn = (j < cur) ? j + 1 : j;
        __syncthreads();
        kv_store(kv, lk, lv);
        __syncthreads();
        f32x16 s0, s1;
        qk_tile(q, lk, s0, s1);
        int tqv = tq;
        asm volatile("" : "+v"(tqv));
        if (j * 64 + 63 + 113 <= t0 && t0 + 31 - j * 64 < 512) {
          const float b31 = lut[127];
#pragma unroll
          for (int r = 0; r < 16; ++r) { s0[r] = s0[r] * ATT_SCALE + b31; s1[r] = s1[r] * ATT_SCALE + b31; }
        } else {
#pragma unroll
          for (int r = 0; r < 16; ++r) {
            const int d0 = tqv - (j * 64 + 8 * (r >> 2) + (r & 3) + 4 * hh), d1 = d0 - 32;
            s0[r] = (d0 >= 0 && d0 < 512) ? s0[r] * ATT_SCALE + lut[min(d0, 127)] : NEG_BIG;
            s1[r] = (d1 >= 0 && d1 < 512) ? s1[r] * ATT_SCALE + lut[min(d1, 127)] : NEG_BIG;
          }
        }
        kv_load(kv, kb + (size_t)jn * 64 * 128, 128, vb + jn * 64, SEQ);
        softmax_tile(s0, s1, m, l, o);
        pv_tile(o, lv, s0, s1);
      }
      const float gs = 1.f / (fmaxf(l, 1e-20f) * (1.f + __expf(-grow[2])));
      int qo = ql;
      asm volatile("" : "+v"(qo));
      const float* pr2 = p.part + (size_t)(b * SEQ + t0 + qo) * 1024 + h * 128;
      bf16_t* orow = p.omix + (size_t)(b * SEQ + t0 + qo) * DM + h * 128;
      oacc_foreach(o, [&](int d, float v0, float v1, float v2, float v3) {
        const f32x4 u = *(const f32x4*)(pr2 + d);
        uint2 w;
        w.x = pack2(u[0] + v0 * gs, u[1] + v1 * gs);
        w.y = pack2(u[2] + v2 * gs, u[3] + v3 * gs);
        *(uint2*)(orow + d) = w;
      });
    }
  }
}

__device__ __forceinline__ void ph_cvt(const float* src, bf16_t* dst, size_t n) {
  typedef __attribute__((ext_vector_type(4))) float f32x4;
  const size_t nv = n / 8;
  for (size_t i = (size_t)blockIdx.x * 256 + opq(threadIdx.x); i < nv; i += (size_t)gridDim.x * 256) {
    const f32x4 a = ((const f32x4*)src)[2 * i], b = ((const f32x4*)src)[2 * i + 1];
    u32x4 o;
    o[0] = pack2(a[0], a[1]); o[1] = pack2(a[2], a[3]); o[2] = pack2(b[0], b[1]); o[3] = pack2(b[2], b[3]);
    ((u32x4*)dst)[i] = o;
  }
}

__device__ __forceinline__ void ph_scores(const P& p, char* lds) {
  for (int u = blockIdx.x; u < 64 * 16; u += gridDim.x) {
    const int tm = u & 63, hp = u >> 6;
    const int m0 = tm * 128;
    float* sc = p.scores + (size_t)m0 * DM + hp * 128;
    gemm_tile_bf16<false>(p.omix + (size_t)m0 * DM + hp * 128, DM, p.subkb + (size_t)hp * 128 * 128, 128, 128, lds,
                          [&](int r, int c, float val) { sc[(size_t)r * DM + c] = val; });
  }
}

__device__ __forceinline__ void ph_qp_scores(const P& p, char* lds) {
  const int ntm = T_TOK / 128, ntn = DM / 128;
  const int npm = (ntm + 7) / 8, npn = (ntn + 7) / 8;
  const int nslots = ((npm * npn * 64 + 511) / 512) * 512;
  for (int u = blockIdx.x; u < nslots; u += gridDim.x) {
    int v = (u & 7) * 64 + ((u >> 3) & 63) + (u & ~511);
    int patch = v >> 6, w = v & 63;
    int tm = (patch % npm) * 8 + (w & 7);
    int tn = (patch / npm) * 8 + (w >> 3);
    if (tm >= ntm || tn >= ntn) continue;
    const int m0 = tm * 128, n0 = tn * 128;
    bf16_t* qp = p.omix + (size_t)m0 * DM + n0;
    gemm_tile_bf16<false>(p.hn + (size_t)m0 * DM, DM, p.WpqT + (size_t)n0 * DM, DM, DM, lds,
                          [&](int r, int c, float val) { qp[(size_t)r * DM + c] = f2bf(val); });
    __threadfence_block();
    __syncthreads();
    float* sc = p.scores + (size_t)m0 * DM + n0;
    gemm_tile_bf16<false>(qp, DM, p.subkb + (size_t)tn * 128 * 128, 128, 128, lds,
                          [&](int r, int c, float val) { sc[(size_t)r * DM + c] = val; });
  }
}

__device__ __forceinline__ void ph_cvt4(const float* src, unsigned char* dst, float* scales, int nrows, int wid0, int nw) {
  typedef __attribute__((ext_vector_type(4))) float f32x4;
  typedef __attribute__((ext_vector_type(2))) float f32x2;
  const int lane = opq(threadIdx.x) & 63;
  const float one = __uint_as_float((unsigned)opq(0x3F800000));
  float lev[8];
#pragma unroll
  for (int c = 0; c < 8; ++c) {
    const f32x2 q = __builtin_amdgcn_cvt_scalef32_pk_f32_fp4((unsigned)opq(c * 0x11111111), one, 0);
    lev[c] = fabsf(q[0]);
  }
  float thr[7];
#pragma unroll
  for (int c = 0; c < 7; ++c) thr[c] = 0.5f * (lev[c] + lev[c + 1]);
  const float maxlev = lev[7];
  for (int row = wid0; row < nrows; row += nw) {
    const f32x4* s4 = (const f32x4*)(src + (size_t)row * DM) + lane * 8;
    f32x4 v[8];
    float amax = 0.f;
#pragma unroll
    for (int i = 0; i < 8; ++i) {
      v[i] = s4[i];
#pragma unroll
      for (int k = 0; k < 4; ++k) amax = fmaxf(amax, fabsf(v[i][k]));
    }
    amax = wave_max(amax);
    const float sc = (amax > 0.f) ? maxlev / amax : 1.f;
    u32x4 o;
#pragma unroll
    for (int w = 0; w < 4; ++w) {
      unsigned pk = 0u;
#pragma unroll
      for (int e = 0; e < 8; ++e) {
        const float xv = v[2 * w + (e >> 2)][e & 3] * sc;
        const float a = fabsf(xv);
        unsigned code = (a > thr[0]) + (a > thr[1]) + (a > thr[2]) + (a > thr[3]) + (a > thr[4]) + (a > thr[5]) + (a > thr[6]);
        code |= (xv < 0.f) ? 8u : 0u;
        pk |= code << (4 * e);
      }
      o[w] = pk;
    }
    *(u32x4*)(dst + (size_t)row * 1024 + lane * 16) = o;
    if (lane == 0) scales[row] = (amax > 0.f) ? amax / maxlev : 1.f;
  }
}

__device__ __forceinline__ u32x4 r4_load(const unsigned char* tab, int eid, int lane) {
  return *((const u32x4*)(tab + (size_t)eid * 1024) + lane);
}
struct XPk { f32x16 a, b; };
struct Acc32 { f32x16 a, b; };

#define R4_DOT_W(word, xv, base, pa, pb)                                                             \
  {                                                                                                  \
    typedef __attribute__((ext_vector_type(2))) float f32x2;                                         \
    const f32x2 q0 = __builtin_amdgcn_cvt_scalef32_pk_f32_fp4(word, one, 0), q1 = __builtin_amdgcn_cvt_scalef32_pk_f32_fp4(word, one, 1); \
    const f32x2 q2 = __builtin_amdgcn_cvt_scalef32_pk_f32_fp4(word, one, 2), q3 = __builtin_amdgcn_cvt_scalef32_pk_f32_fp4(word, one, 3); \
    pa += q0[0] * xv[base + 0] + q0[1] * xv[base + 1]; pb += q1[0] * xv[base + 2] + q1[1] * xv[base + 3]; \
    pa += q2[0] * xv[base + 4] + q2[1] * xv[base + 5]; pb += q3[0] * xv[base + 6] + q3[1] * xv[base + 7]; \
  }
__device__ __forceinline__ float r4_dot(const u32x4& e, const XPk& x) {
  const float one = __uint_as_float((unsigned)opq(0x3F800000));
  float pa = 0.f, pb = 0.f;
  R4_DOT_W(e[0], x.a, 0, pa, pb) R4_DOT_W(e[1], x.a, 8, pa, pb) R4_DOT_W(e[2], x.b, 0, pa, pb) R4_DOT_W(e[3], x.b, 8, pa, pb)
  return pa + pb;
}
#define R4_AXPY_W(word, accv, base)                                                                  \
  {                                                                                                  \
    typedef __attribute__((ext_vector_type(2))) float f32x2;                                         \
    const f32x2 q0 = __builtin_amdgcn_cvt_scalef32_pk_f32_fp4(word, one, 0), q1 = __builtin_amdgcn_cvt_scalef32_pk_f32_fp4(word, one, 1); \
    const f32x2 q2 = __builtin_amdgcn_cvt_scalef32_pk_f32_fp4(word, one, 2), q3 = __builtin_amdgcn_cvt_scalef32_pk_f32_fp4(word, one, 3); \
    accv[base + 0] += hid * q0[0]; accv[base + 1] += hid * q0[1]; accv[base + 2] += hid * q1[0]; accv[base + 3] += hid * q1[1]; \
    accv[base + 4] += hid * q2[0]; accv[base + 5] += hid * q2[1]; accv[base + 6] += hid * q3[0]; accv[base + 7] += hid * q3[1]; \
  }
__device__ __forceinline__ void r4_axpy(const u32x4& e, float hid, Acc32& acc) {
  const float one = __uint_as_float((unsigned)opq(0x3F800000));
  R4_AXPY_W(e[0], acc.a, 0) R4_AXPY_W(e[1], acc.a, 8) R4_AXPY_W(e[2], acc.b, 0) R4_AXPY_W(e[3], acc.b, 8)
}

#define INS16(K, x)                                                                                      \
  K##15 = __builtin_amdgcn_fmed3f(K##15, K##14, x); K##14 = __builtin_amdgcn_fmed3f(K##14, K##13, x);   \
  K##13 = __builtin_amdgcn_fmed3f(K##13, K##12, x); K##12 = __builtin_amdgcn_fmed3f(K##12, K##11, x);   \
  K##11 = __builtin_amdgcn_fmed3f(K##11, K##10, x); K##10 = __builtin_amdgcn_fmed3f(K##10, K##9, x);    \
  K##9 = __builtin_amdgcn_fmed3f(K##9, K##8, x); K##8 = __builtin_amdgcn_fmed3f(K##8, K##7, x);         \
  K##7 = __builtin_amdgcn_fmed3f(K##7, K##6, x); K##6 = __builtin_amdgcn_fmed3f(K##6, K##5, x);         \
  K##5 = __builtin_amdgcn_fmed3f(K##5, K##4, x); K##4 = __builtin_amdgcn_fmed3f(K##4, K##3, x);         \
  K##3 = __builtin_amdgcn_fmed3f(K##3, K##2, x); K##2 = __builtin_amdgcn_fmed3f(K##2, K##1, x);         \
  K##1 = __builtin_amdgcn_fmed3f(K##1, K##0, x); K##0 = fmaxf(K##0, x);
#define DECL16(K) float K##0 = -INFINITY, K##1 = -INFINITY, K##2 = -INFINITY, K##3 = -INFINITY, K##4 = -INFINITY, \
  K##5 = -INFINITY, K##6 = -INFINITY, K##7 = -INFINITY, K##8 = -INFINITY, K##9 = -INFINITY, K##10 = -INFINITY,   \
  K##11 = -INFINITY, K##12 = -INFINITY, K##13 = -INFINITY, K##14 = -INFINITY, K##15 = -INFINITY;
__device__ __forceinline__ float mkkey(float v, unsigned tag, unsigned mask) {
  return __uint_as_float((__float_as_uint(v) & ~mask) | tag);
}

__device__ __forceinline__ void ph_peer(const P& p, float* smem) {
  typedef __attribute__((ext_vector_type(4))) float f32x4;
  float* lists = smem;
  int* bexA = (int*)(smem + 4096);
  float* bgtA = smem + 6144;
  float* bsuA = smem + 8192;
  for (int item = blockIdx.x; item < T_TOK / 16; item += gridDim.x) {
    const int t0 = item * 16;
    __syncthreads();
    {
      const int tid = opq(threadIdx.x);
      const int tl = tid >> 4, hp = tid & 15;
      const f32x4* sp = (const f32x4*)(p.scores + (size_t)(t0 + tl) * DM + hp * 128);
      DECL16(k)
#pragma unroll 4
      for (int c4 = 0; c4 < 32; ++c4) {
        const f32x4 v = sp[c4];
#pragma unroll
        for (int e = 0; e < 4; ++e) {
          const float x = mkkey(v[e], 127u - (unsigned)(c4 * 4 + e), 127u);
          INS16(k, x)
        }
      }
      f32x4* lp = (f32x4*)(lists + (size_t)opq(threadIdx.x) * 16);
      f32x4 o0 = {k0, k1, k2, k3}, o1 = {k4, k5, k6, k7}, o2 = {k8, k9, k10, k11}, o3 = {k12, k13, k14, k15};
      lp[0] = o0; lp[1] = o1; lp[2] = o2; lp[3] = o3;
    }
    __syncthreads();
    if (opq(threadIdx.x) < 128) {
      const int tid = opq(threadIdx.x);
      const int tl = tid >> 3, h = tid & 7;
      const float* la = lists + (size_t)(tl * 16 + 2 * h) * 16;
      const float* lb = la + 16;
      float av[16], bv[16];
#pragma unroll
      for (int i = 0; i < 16; ++i) {
        av[i] = __uint_as_float(__float_as_uint(la[i]) & ~127u);
        bv[i] = __uint_as_float(__float_as_uint(lb[i]) & ~127u);
      }
      DECL16(c)
#pragma unroll
      for (int i = 0; i < 16; ++i) {
#pragma unroll
        for (int j = 0; j < 16; ++j) {
          if ((i + 1) * (j + 1) <= 16) {
            const float x = mkkey(av[i] + bv[j], 255u - (unsigned)(i * 16 + j), 255u);
            INS16(c, x)
          }
        }
      }
      float cs[16] = {c0, c1, c2, c3, c4, c5, c6, c7, c8, c9, c10, c11, c12, c13, c14, c15};
      float ev[16];
      float sum = 0.f;
      const float mx = __uint_as_float(__float_as_uint(cs[0]) & ~255u);
#pragma unroll
      for (int n = 0; n < 16; ++n) {
        ev[n] = __expf(__uint_as_float(__float_as_uint(cs[n]) & ~255u) - mx);
        sum += ev[n];
      }
      const float isum = 1.f / sum;
#pragma unroll
      for (int n = 0; n < 16; ++n) {
        const unsigned cc = 255u - (__float_as_uint(cs[n]) & 255u);
        const unsigned ka = 127u - (__float_as_uint(la[cc >> 4]) & 127u);
        const unsigned kb = 127u - (__float_as_uint(lb[cc & 15u]) & 127u);
        const int eid = (int)(ka * 128u + kb);
        bexA[tl * 128 + h * 16 + n] = eid;
        bgtA[tl * 128 + h * 16 + n] = ev[n] * isum * p.sv8[eid];
        bsuA[tl * 128 + h * 16 + n] = p.su8[eid];
      }
    }
    __syncthreads();
#pragma unroll 1
    for (int ti4 = 0; ti4 < 4; ++ti4) {
    const int lane = opq(threadIdx.x) & 63, wv = opq(threadIdx.x) >> 6;
    const int tl = wv * 4 + ti4;
    const int t = t0 + tl;
    const int* bex = bexA + tl * 128;
    const float* bgt = bgtA + tl * 128;
    const float* bsu = bsuA + tl * 128;
    XPk x;
    {
      const f32x4* s4 = (const f32x4*)(p.out + (size_t)t * DM) + lane * 8;
      const f32x4* g4 = (const f32x4*)p.norm_ffn + lane * 8;
      f32x4 a0 = s4[0], a1 = s4[1], a2 = s4[2], a3 = s4[3], a4 = s4[4], a5 = s4[5], a6 = s4[6], a7 = s4[7];
      float ss = 0.f;
#define SSQ(v) ss += v[0] * v[0] + v[1] * v[1] + v[2] * v[2] + v[3] * v[3];
      SSQ(a0) SSQ(a1) SSQ(a2) SSQ(a3) SSQ(a4) SSQ(a5) SSQ(a6) SSQ(a7)
#undef SSQ
      ss = wave_sum(ss);
      const float rs = rsqrtf(ss * (1.f / DM) + RMS_EPS);
#define XPK(dst, base, va, vb, gi)                                                    \
  {                                                                                   \
    const f32x4 ga = g4[gi], gb = g4[gi + 1];                                         \
    dst[base + 0] = bf2f(f2bf(va[0] * rs * ga[0])); dst[base + 1] = bf2f(f2bf(va[1] * rs * ga[1]));   \
    dst[base + 2] = bf2f(f2bf(va[2] * rs * ga[2])); dst[base + 3] = bf2f(f2bf(va[3] * rs * ga[3]));   \
    dst[base + 4] = bf2f(f2bf(vb[0] * rs * gb[0])); dst[base + 5] = bf2f(f2bf(vb[1] * rs * gb[1]));   \
    dst[base + 6] = bf2f(f2bf(vb[2] * rs * gb[2])); dst[base + 7] = bf2f(f2bf(vb[3] * rs * gb[3]));   \
  }
      XPK(x.a, 0, a0, a1, 0) XPK(x.a, 8, a2, a3, 2) XPK(x.b, 0, a4, a5, 4) XPK(x.b, 8, a6, a7, 6)
#undef XPK
    }
    Acc32 acc;
#pragma unroll
    for (int r = 0; r < 16; ++r) { acc.a[r] = 0.f; acc.b[r] = 0.f; }
    u32x4 u0 = r4_load(p.pu8, bex[0], lane), u1 = r4_load(p.pu8, bex[1], lane), u2 = r4_load(p.pu8, bex[2], lane), u3 = r4_load(p.pu8, bex[3], lane);
    u32x4 v0 = r4_load(p.pv8, bex[0], lane), v1 = r4_load(p.pv8, bex[1], lane), v2 = r4_load(p.pv8, bex[2], lane), v3 = r4_load(p.pv8, bex[3], lane);
#pragma unroll 1
    for (int e0 = 0; e0 < 128; e0 += 4) {
      float d0 = r4_dot(u0, x), d1 = r4_dot(u1, x), d2 = r4_dot(u2, x), d3 = r4_dot(u3, x);
      const int en = (e0 + 4 < 128) ? e0 + 4 : 124;
      const int i0 = bex[en], i1 = bex[en + 1], i2 = bex[en + 2], i3 = bex[en + 3];
      u0 = r4_load(p.pu8, i0, lane); u1 = r4_load(p.pu8, i1, lane); u2 = r4_load(p.pu8, i2, lane); u3 = r4_load(p.pu8, i3, lane);
#pragma unroll
      for (int o = 32; o > 0; o >>= 1) {
        d0 += __shfl_xor(d0, o); d1 += __shfl_xor(d1, o); d2 += __shfl_xor(d2, o); d3 += __shfl_xor(d3, o);
      }
      { const float hid = bgt[e0 + 0] * gelu_fast(d0 * bsu[e0 + 0]); r4_axpy(v0, hid, acc); }
      { const float hid = bgt[e0 + 1] * gelu_fast(d1 * bsu[e0 + 1]); r4_axpy(v1, hid, acc); }
      { const float hid = bgt[e0 + 2] * gelu_fast(d2 * bsu[e0 + 2]); r4_axpy(v2, hid, acc); }
      { const float hid = bgt[e0 + 3] * gelu_fast(d3 * bsu[e0 + 3]); r4_axpy(v3, hid, acc); }
      v0 = r4_load(p.pv8, i0, lane); v1 = r4_load(p.pv8, i1, lane); v2 = r4_load(p.pv8, i2, lane); v3 = r4_load(p.pv8, i3, lane);
    }
    const int lane2 = opq(lane);
    f32x4* o4 = (f32x4*)(p.out + (size_t)t * DM) + lane2 * 8;
    const f32x4* g4 = (const f32x4*)p.norm_final + lane2 * 8;
    f32x4 hv[8];
    float ss = 0.f;
#pragma unroll
    for (int i = 0; i < 8; ++i) {
      hv[i] = o4[i];
#pragma unroll
      for (int k = 0; k < 4; ++k) {
        hv[i][k] += (i < 4) ? acc.a[4 * i + k] : acc.b[4 * (i - 4) + k];
        ss += hv[i][k] * hv[i][k];
      }
    }
    ss = wave_sum(ss);
    const float rs = rsqrtf(ss * (1.f / DM) + RMS_EPS);
#pragma unroll
    for (int i = 0; i < 8; ++i) {
      const f32x4 g = g4[i];
      f32x4 o;
#pragma unroll
      for (int k = 0; k < 4; ++k) o[k] = hv[i][k] * rs * g[k];
      o4[i] = o;
    }
    }
  }
}

#define XB_TMO      128
#define XB_XCNT(j)  (256  + 64 * (j))
#define XB_XSUB(j)  (1280 + 64 * (j))
#define XB_XGEN(j)  (2304 + 64 * (j))
#define XB_TOP      3328
#define XB_TOPGEN   3392
#define XCD_BAR_WORDS 3456
#define XB_SPIN_CAP (1u << 22)
#define LAS __attribute__((address_space(3)))
__device__ __forceinline__ unsigned xb_ld(unsigned* p) { return __hip_atomic_load(p, __ATOMIC_RELAXED, __HIP_MEMORY_SCOPE_AGENT); }
__device__ __forceinline__ unsigned xb_add(unsigned* p, unsigned v) { return __hip_atomic_fetch_add(p, v, __ATOMIC_RELAXED, __HIP_MEMORY_SCOPE_AGENT); }
__device__ __forceinline__ unsigned xb_xcc_id() { return (unsigned)__builtin_amdgcn_s_getreg((3 << 11) | 20) & 0xFu; }
#define XB_SPIN(cond, bar) do { unsigned _sp = 0; while (cond) { __builtin_amdgcn_s_sleep(1); \
    if ((++_sp & 255u) == 0u) { if (xb_ld(&(bar)[XB_TMO])) break; if (_sp > XB_SPIN_CAP) { atomicAdd(&(bar)[XB_TMO], 1u); break; } } } } while (0)
struct XcdBarrier { unsigned* bar; unsigned x; volatile LAS unsigned* st; };
__device__ __forceinline__ XcdBarrier xcd_barrier_post(unsigned* bar, volatile LAS unsigned* st) {
  XcdBarrier b; b.bar = bar; b.x = xb_xcc_id(); b.st = st;
  if (threadIdx.x == 0) (void)xb_add(&bar[XB_XCNT(b.x)], 1u);
  return b;
}
__device__ __forceinline__ void xcd_barrier_complete(unsigned* bar, unsigned x, unsigned& nloc, unsigned& nx) {
  const unsigned G = gridDim.x * gridDim.y * gridDim.z;
  unsigned sum, cnt, mine, sp = 0u;
  for (;;) {
    sum = 0u; cnt = 0u; mine = 0u;
#pragma unroll
    for (unsigned j = 0; j < 16; ++j) { const unsigned c = xb_ld(&bar[XB_XCNT(j)]); sum += c; cnt += (c > 0u) ? 1u : 0u; mine = (j == x) ? c : mine; }
    if (sum == G) break;
    __builtin_amdgcn_s_sleep(1);
    if ((++sp & 255u) == 0u) { if (xb_ld(&bar[XB_TMO])) break; if (sp > XB_SPIN_CAP) { atomicAdd(&bar[XB_TMO], 1u); break; } }
  }
  nloc = mine > 0u ? mine : 1u; nx = cnt > 0u ? cnt : 1u;
}
__device__ __forceinline__ void xcd_barrier(const XcdBarrier& b) {
  asm volatile("s_waitcnt vmcnt(0)" ::: "memory");
  __syncthreads();
  if (threadIdx.x == 0) {
    unsigned* bar = b.bar;
    __builtin_amdgcn_s_waitcnt(0);
    unsigned nloc = b.st[0], nx = b.st[1];
    if (nloc == 0u) { xcd_barrier_complete(bar, b.x, nloc, nx); b.st[0] = nloc; b.st[1] = nx; }
    const unsigned old = xb_add(&bar[XB_XSUB(b.x)], 1u);
    const unsigned gen = old / nloc;
    if (old + 1u == (gen + 1u) * nloc) {
      __builtin_amdgcn_fence(__ATOMIC_RELEASE, "agent");
      asm volatile("s_waitcnt vmcnt(0)" ::: "memory");
      const unsigned og = xb_add(&bar[XB_TOP], 1u);
      const unsigned tg = og / nx;
      if (og + 1u == (tg + 1u) * nx) xb_add(&bar[XB_TOPGEN], 1u);
      else XB_SPIN(xb_ld(&bar[XB_TOPGEN]) == tg, bar);
      __builtin_amdgcn_fence(__ATOMIC_ACQUIRE, "agent");
      xb_add(&bar[XB_XGEN(b.x)], 1u);
      asm volatile("s_waitcnt vmcnt(0)" ::: "memory");
    } else {
      XB_SPIN(xb_ld(&bar[XB_XGEN(b.x)]) == gen, bar);
      __builtin_amdgcn_fence(__ATOMIC_ACQUIRE, "agent");
      asm volatile("s_waitcnt vmcnt(0)" ::: "memory");
    }
  }
  __syncthreads();
}

typedef const __attribute__((address_space(4))) P* KP;
__device__ __forceinline__ P loadP() {
#if defined(__HIP_DEVICE_COMPILE__)
  KP k = (KP)__builtin_amdgcn_kernarg_segment_ptr();
  asm volatile("" : "+s"(k));
  P p = *k;
  return p;
#else
  return P{};
#endif
}

__global__ void __launch_bounds__(256, 2) mega(P p_arg) {
  cg::grid_group grid = cg::this_grid();
  __shared__ __attribute__((aligned(16))) float smem[14336];
  char* lds = (char*)smem;
  __shared__ uint4 xb_words;
  if (threadIdx.x == 0) xb_words = make_uint4(0u, 0u, 0u, 0u);
  if (blockIdx.x == 0) {
    P p = loadP();
    for (int i = threadIdx.x; i < XCD_BAR_WORDS; i += 256) p.bar[i] = 0u;
  }
  { P p = loadP(); ph_rmsnorm(p.x, p.norm_mix, p.hn, T_TOK); ph_rmsnorm(p.mem, p.norm_mkv, p.memn, 1024); }
  { P p = loadP(); ph_transpose<true>(smem, p.w_in, DM, INC, 5760, p.WinT); }
  { P p = loadP(); ph_transpose<false>(smem, p.w_out, DM, DM, DM, p.WoutT); }
  { P p = loadP(); ph_transpose<false>(smem, p.w_pq, DM, DM, DM, p.WpqT); }
  { P p = loadP(); ph_transpose<false>(smem, p.w_mq, DM, 512, 512, p.WmqT); }
  { P p = loadP(); ph_transpose<false>(smem, p.w_mk, DM, 512, 512, p.WmkT); }
  { P p = loadP(); ph_transpose<false>(smem, p.w_mv, DM, 512, 512, p.WmvT); }
  { P p = loadP(); ph_transpose<false>(smem, p.w_mo, 512, DM, DM, p.WmoT); }
  { P p = loadP(); ph_cvt(p.subk, p.subkb, (size_t)16 * 128 * 128); }
  { P p = loadP(); ph_transpose<false>(smem, p.w1_k, 4096, 128, 128, p.w1T); }
  { P p = loadP(); ph_transpose<false>(smem, p.w1_v, 4096, 128, 128, p.w1T + 128 * 4096); }
  { P p = loadP(); ph_transpose<false>(smem, p.w2_k, 128, 128, 128, p.w2T); }
  { P p = loadP(); ph_transpose<false>(smem, p.w2_v, 128, 128, 128, p.w2T + 128 * 128); }
  { P p = loadP(); ph_posb(p); }
  grid.sync();
  XcdBarrier xb;
  { P p = loadP(); xb = xcd_barrier_post(p.bar, (volatile LAS unsigned*)&xb_words); }
  { P p = loadP(); ph_proj(p, lds); }
  { P p = loadP(); bf16_t* kmem = p.kmemb;
    ph_gemm_bf16(p.memn, DM, p.WmkT, DM, 1024, 512, DM, lds, [=](int m, int n, float v) {
      kmem[((size_t)((m >> 8) * 4 + (n >> 7)) * 256 + (m & 255)) * 128 + (n & 127)] = f2bf(v); }); }
  { P p = loadP(); bf16_t* vmem = p.vmemT;
    ph_gemm_bf16(p.memn, DM, p.WmvT, DM, 1024, 512, DM, lds, [=](int m, int n, float v) {
      vmem[((size_t)((m >> 8) * 4 + (n >> 7)) * 128 + (n & 127)) * 256 + perm16(m & 255)] = f2bf(v); }); }
  xcd_barrier(xb);
  { P p = loadP(); ph_compress2(p, lds); }
  { P p = loadP(); ph_sb2(p, lds); }
  xcd_barrier(xb);
  { P p = loadP(); ph_nsa2(p, lds); }
  xcd_barrier(xb);
  { P p = loadP(); float* out = p.out; const float* x = p.x;
    ph_gemm_bf16(p.omix, DM, p.WoutT, DM, T_TOK, DM, DM, lds, [=](int m, int n, float v) { out[(size_t)m * DM + n] = x[(size_t)m * DM + n] + v; }); }
  xcd_barrier(xb);
  { P p = loadP(); ph_rmsnorm(p.out, p.norm_mq, p.hn, T_TOK); }
  xcd_barrier(xb);
  if (blockIdx.x < 256 || gridDim.x < 512) {
    P p = loadP(); bf16_t* qmem = p.qmemb;
    ph_gemm_bf16(p.hn, DM, p.WmqT, DM, T_TOK, 512, DM, lds, [=](int m, int n, float v) { qmem[(size_t)m * 512 + n] = f2bf(v); });
  }
  {
    const int half = (gridDim.x >= 512) ? 256 : 0;
    if ((int)blockIdx.x >= half) {
      const int nwv = ((int)gridDim.x - half) * 4, wid = ((int)blockIdx.x - half) * 4 + (opq(threadIdx.x) >> 6);
      { P p = loadP(); ph_cvt4(p.pu, p.pu8, p.su8, 16384, wid, nwv); }
      { P p = loadP(); ph_cvt4(p.pv, p.pv8, p.sv8, 16384, wid, nwv); }
    }
  }
  xcd_barrier(xb);
  { P p = loadP(); ph_memattn2(p, lds); }
  xcd_barrier(xb);
  { P p = loadP(); float* out = p.out;
    ph_gemm_bf16(p.omem, 512, p.WmoT, 512, T_TOK, DM, 512, lds, [=](int m, int n, float v) { out[(size_t)m * DM + n] += v; }); }
  xcd_barrier(xb);
  { P p = loadP(); ph_rmsnorm(p.out, p.norm_ffn, p.hn, T_TOK); }
  xcd_barrier(xb);
  { P p = loadP(); ph_qp_scores(p, lds); }
  xcd_barrier(xb);
  { P p = loadP(); ph_peer(p, smem); }
}

extern "C" void kernel_launch(void* const* d_in, const int* in_sizes, int n_in, void* d_out, int out_size, void* d_ws,
                              size_t ws_size, hipStream_t stream) {
  P p{};
  p.x = (const float*)d_in[0]; p.mem = (const float*)d_in[1]; p.t5 = (const float*)d_in[2];
  p.norm_mix = (const float*)d_in[3]; p.w_in = (const float*)d_in[4]; p.pos_k = (const float*)d_in[5];
  p.w1_k = (const float*)d_in[6]; p.w2_k = (const float*)d_in[7]; p.pos_v = (const float*)d_in[8];
  p.w1_v = (const float*)d_in[9]; p.w2_v = (const float*)d_in[10]; p.w_out = (const float*)d_in[11];
  p.norm_mq = (const float*)d_in[12]; p.norm_mkv = (const float*)d_in[13]; p.w_mq = (const float*)d_in[14];
  p.w_mk = (const float*)d_in[15]; p.w_mv = (const float*)d_in[16]; p.w_mo = (const float*)d_in[17];
  p.norm_ffn = (const float*)d_in[18]; p.w_pq = (const float*)d_in[19]; p.subk = (const float*)d_in[20];
  p.pu = (const float*)d_in[21]; p.pv = (const float*)d_in[22]; p.norm_final = (const float*)d_in[23];
  p.out = (float*)d_out;
  char* w = (char*)d_ws;
  size_t off = 0;
  auto take = [&](size_t bytes) { char* r = w + off; off += (bytes + 255) & ~(size_t)255; return r; };
  p.bar = (unsigned*)take(XCD_BAR_WORDS * 4);
  p.scores = (float*)take((size_t)T_TOK * DM * 4);
  p.gates = (float*)take((size_t)T_TOK * 24 * 4);
  p.part = (float*)take((size_t)T_TOK * 1024 * 4);
  p.posb = (float*)take(256 * 4);
  p.qn = (bf16_t*)take((size_t)T_TOK * 1024 * 2);
  p.kcin = (bf16_t*)take((size_t)T_TOK * 256 * 2 + 65536);
  p.vcin = (bf16_t*)take((size_t)T_TOK * 256 * 2 + 65536);
  p.ks = (bf16_t*)take((size_t)T_TOK * 256 * 2);
  p.vsT = (bf16_t*)take((size_t)T_TOK * 256 * 2);
  p.kw = (bf16_t*)take((size_t)T_TOK * 256 * 2);
  p.vwT = (bf16_t*)take((size_t)T_TOK * 256 * 2);
  p.kcb = (bf16_t*)take((size_t)8 * 128 * 128 * 2);
  p.vcT = (bf16_t*)take((size_t)8 * 128 * 128 * 2);
  p.c1 = (bf16_t*)take((size_t)16 * 128 * 128 * 2);
  p.w1T = (bf16_t*)take((size_t)2 * 128 * 4096 * 2);
  p.w2T = (bf16_t*)take((size_t)2 * 128 * 128 * 2);
  p.hn = (bf16_t*)take((size_t)T_TOK * DM * 2);
  p.omix = (bf16_t*)take((size_t)T_TOK * DM * 2);
  p.memn = (bf16_t*)take((size_t)1024 * DM * 2);
  p.omem = (bf16_t*)take((size_t)T_TOK * 512 * 2);
  p.WinT = (bf16_t*)take((size_t)5760 * DM * 2);
  p.WoutT = (bf16_t*)take((size_t)DM * DM * 2);
  p.WpqT = (bf16_t*)take((size_t)DM * DM * 2);
  p.WmqT = (bf16_t*)take((size_t)512 * DM * 2);
  p.WmkT = (bf16_t*)take((size_t)512 * DM * 2);
  p.WmvT = (bf16_t*)take((size_t)512 * DM * 2);
  p.WmoT = (bf16_t*)take((size_t)DM * 512 * 2);
  p.qmemb = (bf16_t*)take((size_t)T_TOK * 512 * 2);
  p.kmemb = (bf16_t*)take((size_t)1024 * 512 * 2);
  p.vmemT = (bf16_t*)take((size_t)1024 * 512 * 2);
  p.qsb = (bf16_t*)take((size_t)T_TOK * 1024 * 2);
  p.ksb = (bf16_t*)take((size_t)T_TOK * 1024 * 2);
  p.vsbT = (bf16_t*)take((size_t)T_TOK * 1024 * 2);
  p.pu8 = (unsigned char*)take((size_t)16384 * 1024);
  p.pv8 = (unsigned char*)take((size_t)16384 * 1024);
  p.su8 = (float*)take(16384 * 4);
  p.sv8 = (float*)take(16384 * 4);
  p.subkb = (bf16_t*)take((size_t)16 * 128 * 128 * 2);
  static int grid_blocks = 0;
  if (!grid_blocks) {
    int dev = 0, cus = 0, per_cu = 0;
    (void)hipGetDevice(&dev);
    (void)hipDeviceGetAttribute(&cus, hipDeviceAttributeMultiprocessorCount, dev);
    (void)hipOccupancyMaxActiveBlocksPerMultiprocessor(&per_cu, mega, 256, 0);
    if (per_cu > 2) per_cu = 2;
    if (per_cu < 1) per_cu = 1;
    grid_blocks = cus * per_cu;
  }
  void* args[] = {&p};
  hipError_t e = hipLaunchCooperativeKernel((void*)mega, dim3(grid_blocks), dim3(256), args, 0, stream);
  if (e != hipSuccess) fprintf(stderr, "cooperative launch failed: %s (grid %d)\n", hipGetErrorString(e), grid_blocks);
}
```

```cpp
#include <hip/hip_runtime.h>
#include <hip/hip_cooperative_groups.h>
#include <cstdio>
namespace cg = cooperative_groups;
#include <stdint.h>

#define SEQ 2048
#define NBATCH 4
#define T_TOK 8192
#define DM 2048
#define INC 5656
#define C_QN 0
#define C_KC 1024
#define C_VC 1280
#define C_KS 1536
#define C_VS 1792
#define C_KW 2048
#define C_VW 2304
#define C_GT 2560
#define C_QSB 2584
#define C_KSB 3608
#define C_VSB 4632
#define ATT_SCALE 0.08838834764831845f
#define RMS_EPS 1e-6f

typedef unsigned short bf16_t;
typedef __attribute__((ext_vector_type(8))) short bf16x8;
typedef __attribute__((ext_vector_type(16))) float f32x16;
typedef __attribute__((ext_vector_type(2))) __bf16 bf16v2;
typedef __attribute__((ext_vector_type(4))) unsigned u32x4;

struct P {
  const float *x, *mem, *t5, *norm_mix, *w_in, *pos_k, *w1_k, *w2_k, *pos_v, *w1_v, *w2_v, *w_out,
      *norm_mq, *norm_mkv, *w_mq, *w_mk, *w_mv, *w_mo, *norm_ffn, *w_pq, *subk, *pu, *pv, *norm_final;
  float* out;
  float *scores, *gates, *part, *posb;
  unsigned* bar;
  bf16_t *hn, *omix, *memn, *omem;
  bf16_t *WinT, *WoutT, *WpqT, *WmqT, *WmkT, *WmvT, *WmoT;
  bf16_t *qmemb, *kmemb, *vmemT;
  bf16_t *qsb, *ksb, *vsbT;
  bf16_t* subkb;
  unsigned char *pu8, *pv8;
  float *su8, *sv8;
  bf16_t *qn, *kcin, *vcin, *ks, *vsT, *kw, *vwT, *kcb, *vcT, *c1, *w1T, *w2T;
};

__device__ __forceinline__ int opq(int v) { asm volatile("" : "+v"(v)); return v; }
__device__ __forceinline__ unsigned pack2(float a, float b) {
  bf16v2 r = {(__bf16)a, (__bf16)b};
  return *(unsigned*)&r;
}
__device__ __forceinline__ bf16_t f2bf(float a) {
  __bf16 r = (__bf16)a;
  return *(bf16_t*)&r;
}
__device__ __forceinline__ int perm16(int s) { return (s & ~12) | ((s & 4) << 1) | ((s & 8) >> 1); }
__device__ __forceinline__ float bf2f(bf16_t u) { return __uint_as_float((unsigned)u << 16); }

__device__ __forceinline__ float wave_max(float v) {
  for (int o = 32; o > 0; o >>= 1) v = fmaxf(v, __shfl_xor(v, o));
  return v;
}
__device__ __forceinline__ float wave_sum(float v) {
  for (int o = 32; o > 0; o >>= 1) v += __shfl_xor(v, o);
  return v;
}
__device__ __forceinline__ void wave_argmax(float& v, int& i) {
  for (int o = 32; o > 0; o >>= 1) {
    float ov = __shfl_xor(v, o);
    int oi = __shfl_xor(i, o);
    if (ov > v || (ov == v && oi < i)) { v = ov; i = oi; }
  }
}
__device__ __forceinline__ float gelu_tanh(float x) {
  return 0.5f * x * (1.f + tanhf(0.7978845608028654f * (x + 0.044715f * x * x * x)));
}
__device__ __forceinline__ float gelu_fast(float x) {
  const float y = 1.5957691216057308f * (x + 0.044715f * x * x * x);
  return x / (1.f + __expf(-y));
}
__device__ __forceinline__ int t5_bucket(int n) {
  if (n < 16) return n < 0 ? 0 : n;
  int b = 16;
  b += (n >= 19); b += (n >= 21); b += (n >= 24); b += (n >= 27); b += (n >= 31); b += (n >= 35);
  b += (n >= 40); b += (n >= 46); b += (n >= 52); b += (n >= 59); b += (n >= 67); b += (n >= 77);
  b += (n >= 87); b += (n >= 99); b += (n >= 113);
  return b;
}
__device__ __forceinline__ float log_sigmoid(float x) {
  return fminf(x, 0.f) - log1pf(expf(-fabsf(x)));
}

__device__ __forceinline__ void ph_rmsnorm(const float* src, const float* gain, bf16_t* dst, int rows) {
  int lane = opq(threadIdx.x) & 63, wv = opq(threadIdx.x) >> 6;
  for (int r = blockIdx.x * 4 + wv; r < rows; r += gridDim.x * 4) {
    const float4* s4 = (const float4*)(src + (size_t)r * DM);
    float4 v[8];
    float ss = 0.f;
#pragma unroll
    for (int i = 0; i < 8; ++i) {
      v[i] = s4[i * 64 + lane];
      ss += v[i].x * v[i].x + v[i].y * v[i].y + v[i].z * v[i].z + v[i].w * v[i].w;
    }
    ss = wave_sum(ss);
    float rs = rsqrtf(ss * (1.f / DM) + RMS_EPS);
    uint2* d2 = (uint2*)(dst + (size_t)r * DM);
    const float4* g4 = (const float4*)gain;
#pragma unroll
    for (int i = 0; i < 8; ++i) {
      float4 g = g4[i * 64 + lane];
      uint2 o;
      o.x = pack2(v[i].x * rs * g.x, v[i].y * rs * g.y);
      o.y = pack2(v[i].z * rs * g.z, v[i].w * rs * g.w);
      d2[i * 64 + lane] = o;
    }
  }
}

template <bool CMAP>
__device__ __forceinline__ void ph_transpose(float* smem, const float* W, int K, int N, int Npad, bf16_t* Wt) {
  float (*tl)[65] = (float (*)[65])smem;
  int tid = opq(threadIdx.x);
  int nk = K / 64, nn = Npad / 64;
  for (int tile = blockIdx.x; tile < nk * nn; tile += gridDim.x) {
    int k0 = (tile % nk) * 64, n0 = (tile / nk) * 64;
    int col = tid & 63, rb = tid >> 6;
#pragma unroll 4
    for (int pp = 0; pp < 16; ++pp) {
      int k = pp * 4 + rb;
      float v = 0.f;
      int sc = n0 + col;
      if (CMAP) sc = (sc < 2560) ? sc : (sc < 5632) ? sc + 24 : (sc < 5656) ? sc - 5632 + 2560 : N;
      if (sc < N) v = W[(size_t)(k0 + k) * N + sc];
      tl[k][col] = v;
    }
    __syncthreads();
    int n = tid >> 2, kc = (tid & 3) * 16;
    unsigned w[8];
#pragma unroll
    for (int i = 0; i < 8; ++i) w[i] = pack2(tl[kc + 2 * i][n], tl[kc + 2 * i + 1][n]);
    uint4* dst = (uint4*)(Wt + (size_t)(n0 + n) * K + k0 + kc);
    dst[0] = make_uint4(w[0], w[1], w[2], w[3]);
    dst[1] = make_uint4(w[4], w[5], w[6], w[7]);
    __syncthreads();
  }
}

__device__ __forceinline__ int lds_off(int row, int chunk) { return row * 128 + ((chunk ^ ((row >> 1) & 7)) << 4); }

template <bool TR, class Epi>
__device__ __forceinline__ void gemm_tile_bf16(const bf16_t* xp, int ldx, const bf16_t* yp, int ldy, int K, char* lds,
                                               Epi epi) {
  const int tid = opq(threadIdx.x), lane = tid & 63, wv = tid >> 6;
  const int wr = wv >> 1, wc = wv & 1;
  char* lx = lds;
  char* ly = lds + 16384;
  f32x16 acc[2][2];
#pragma unroll
  for (int i = 0; i < 2; ++i)
#pragma unroll
    for (int j = 0; j < 2; ++j)
#pragma unroll
      for (int r = 0; r < 16; ++r) acc[i][j][r] = 0.f;
  const int srow = tid >> 3, sch = tid & 7;
  const bf16_t* xg = xp + (size_t)srow * ldx + sch * 8;
  const bf16_t* yg = yp + (size_t)srow * ldy + sch * 8;
  const size_t x32 = (size_t)32 * ldx, y32 = (size_t)32 * ldy;
  uint4 sx0 = *(const uint4*)(xg), sx1 = *(const uint4*)(xg + x32), sx2 = *(const uint4*)(xg + 2 * x32),
        sx3 = *(const uint4*)(xg + 3 * x32);
  uint4 sy0 = *(const uint4*)(yg), sy1 = *(const uint4*)(yg + y32), sy2 = *(const uint4*)(yg + 2 * y32),
        sy3 = *(const uint4*)(yg + 3 * y32);
  const int so0 = lds_off(srow, sch), so1 = lds_off(32 + srow, sch), so2 = lds_off(64 + srow, sch),
            so3 = lds_off(96 + srow, sch);
  for (int k0 = 0; k0 < K; k0 += 64) {
    __syncthreads();
    *(uint4*)(lx + so0) = sx0; *(uint4*)(lx + so1) = sx1; *(uint4*)(lx + so2) = sx2; *(uint4*)(lx + so3) = sx3;
    *(uint4*)(ly + so0) = sy0; *(uint4*)(ly + so1) = sy1; *(uint4*)(ly + so2) = sy2; *(uint4*)(ly + so3) = sy3;
    __syncthreads();
    if (k0 + 64 < K) {
      const bf16_t* xn = xg + k0 + 64;
      const bf16_t* yn = yg + k0 + 64;
      sx0 = *(const uint4*)(xn); sx1 = *(const uint4*)(xn + x32); sx2 = *(const uint4*)(xn + 2 * x32);
      sx3 = *(const uint4*)(xn + 3 * x32);
      sy0 = *(const uint4*)(yn); sy1 = *(const uint4*)(yn + y32); sy2 = *(const uint4*)(yn + 2 * y32);
      sy3 = *(const uint4*)(yn + 3 * y32);
    }
#pragma unroll
    for (int kk = 0; kk < 4; ++kk) {
      bf16x8 a[2], b[2];
      const int ch = kk * 2 + (lane >> 5);
#pragma unroll
      for (int i = 0; i < 2; ++i) {
        a[i] = *(const bf16x8*)((TR ? ly : lx) + lds_off(wr * 64 + i * 32 + (lane & 31), ch));
        b[i] = *(const bf16x8*)((TR ? lx : ly) + lds_off(wc * 64 + i * 32 + (lane & 31), ch));
      }
#pragma unroll
      for (int i = 0; i < 2; ++i)
#pragma unroll
        for (int j = 0; j < 2; ++j) acc[i][j] = __builtin_amdgcn_mfma_f32_32x32x16_bf16(a[i], b[j], acc[i][j], 0, 0, 0);
    }
  }
  int lane2 = lane;
  asm volatile("" : "+v"(lane2));
#pragma unroll
  for (int i = 0; i < 2; ++i)
#pragma unroll
    for (int j = 0; j < 2; ++j)
#pragma unroll
      for (int r = 0; r < 16; ++r) {
        int rr = wr * 64 + i * 32 + (r & 3) + 8 * (r >> 2) + 4 * (lane2 >> 5);
        int cc = wc * 64 + j * 32 + (lane2 & 31);
        epi(rr, cc, acc[i][j][r]);
      }
}

template <class Epi>
__device__ __forceinline__ void ph_gemm_bf16(const bf16_t* A, int lda, const bf16_t* Wt, int ldw, int M, int N, int K,
                                             char* lds, Epi epi, int vblock = -2) {
  const int ntm = M / 128, ntn = N / 128;
  const int npm = (ntm + 7) / 8, npn = (ntn + 7) / 8;
  const int nslots = ((npm * npn * 64 + 511) / 512) * 512;
  if (vblock == -1) return;
  for (int u = (vblock >= 0 ? vblock : (int)blockIdx.x); u < nslots; u += gridDim.x) {
    int v = (u & 7) * 64 + ((u >> 3) & 63) + (u & ~511);
    int patch = v >> 6, w = v & 63;
    int tm = (patch % npm) * 8 + (w & 7);
    int tn = (patch / npm) * 8 + (w >> 3);
    if (tm >= ntm || tn >= ntn) continue;
    const int m0 = tm * 128, n0 = tn * 128;
    gemm_tile_bf16<false>(A + (size_t)m0 * lda, lda, Wt + (size_t)n0 * ldw, ldw, K, lds,
                          [&](int r, int c, float val) { epi(m0 + r, n0 + c, val); });
  }
}

__device__ __forceinline__ void ph_proj(const P& p, char* lds) {
  const int ntm = T_TOK / 128, ntn = 5760 / 128;
  const int npm = (ntm + 7) / 8, npn = (ntn + 7) / 8;
  const int nslots = ((npm * npn * 64 + 511) / 512) * 512;
  for (int u = blockIdx.x; u < nslots; u += gridDim.x) {
    int v = (u & 7) * 64 + ((u >> 3) & 63) + (u & ~511);
    int patch = v >> 6, w = v & 63;
    int tm = (patch % npm) * 8 + (w & 7);
    int tn = (patch / npm) * 8 + (w >> 3);
    if (tm >= ntm || tn >= ntn) continue;
    const int m0 = tm * 128, n0 = tn * 128;
    const int b = m0 >> 11, sl = m0 & 2047;
    const bf16_t* A = p.hn + (size_t)m0 * DM;
    const bf16_t* W = p.WinT + (size_t)n0 * DM;
    if (n0 < 1024) {
      bf16_t* q = p.qn + (size_t)m0 * 1024 + n0;
      gemm_tile_bf16<false>(A, DM, W, DM, DM, lds, [&](int r, int c, float val) { q[(size_t)r * 1024 + c] = f2bf(val); });
    } else if (n0 < 2560) {
      const int seg = (n0 - 1024) >> 8, g = ((n0 - 1024) >> 7) & 1;
      if (seg == 3 || seg == 5) {
        bf16_t* vd = (seg == 3 ? p.vsT : p.vwT) + ((size_t)(b * 2 + g) * 128) * SEQ + sl;
        gemm_tile_bf16<true>(A, DM, W, DM, DM, lds, [&](int r, int c, float val) { vd[(size_t)r * SEQ + perm16(c)] = f2bf(val); });
      } else {
        bf16_t* base = (seg == 0) ? p.kcin : (seg == 1) ? p.vcin : (seg == 2) ? p.ks : p.kw;
        bf16_t* kd = base + ((size_t)(b * 2 + g) * SEQ + sl) * 128;
        gemm_tile_bf16<false>(A, DM, W, DM, DM, lds, [&](int r, int c, float val) { kd[(size_t)r * 128 + c] = f2bf(val); });
      }
    } else if (n0 < 3584) {
      bf16_t* q = p.qsb + (size_t)m0 * 1024 + (n0 - 2560);
      gemm_tile_bf16<false>(A, DM, W, DM, DM, lds, [&](int r, int c, float val) { q[(size_t)r * 1024 + c] = f2bf(val); });
    } else if (n0 < 4608) {
      bf16_t* kd = p.ksb + ((size_t)(b * 8 + ((n0 - 3584) >> 7)) * SEQ + sl) * 128;
      gemm_tile_bf16<false>(A, DM, W, DM, DM, lds, [&](int r, int c, float val) { kd[(size_t)r * 128 + c] = f2bf(val); });
    } else if (n0 < 5632) {
      bf16_t* vd = p.vsbT + ((size_t)(b * 8 + ((n0 - 4608) >> 7)) * 128) * SEQ + sl;
      gemm_tile_bf16<true>(A, DM, W, DM, DM, lds, [&](int r, int c, float val) { vd[(size_t)r * SEQ + perm16(c)] = f2bf(val); });
    } else {
      float* gd = p.gates + (size_t)m0 * 24;
      gemm_tile_bf16<false>(A, DM, W, DM, DM, lds, [&](int r, int c, float val) { if (c < 24) gd[(size_t)r * 24 + c] = val; });
    }
  }
}

__device__ __forceinline__ void ph_posb(const P& p) {
  const int lane = opq(threadIdx.x) & 63, wv = opq(threadIdx.x) >> 6;
  for (int o = blockIdx.x * 4 + wv; o < 256; o += gridDim.x * 4) {
    const int which = o >> 7, n = o & 127;
    const float* pos = which ? p.pos_v : p.pos_k;
    const float* w1 = which ? p.w1_v : p.w1_k;
    float acc = 0.f;
    for (int k = lane; k < 4096; k += 64) acc += pos[k] * w1[(size_t)k * 128 + n];
    acc = wave_sum(acc);
    if (lane == 0) p.posb[o] = acc;
  }
}

__device__ __forceinline__ void ph_compress2(const P& p, char* lds) {
  for (int item = blockIdx.x; item < 16; item += gridDim.x) {
    const int which = item >> 3, bg = item & 7;
    const bf16_t* src = (which ? p.vcin : p.kcin) + (size_t)bg * SEQ * 128;
    const bf16_t* w1t = p.w1T + (size_t)which * 128 * 4096;
    const bf16_t* w2t = p.w2T + (size_t)which * 128 * 128;
    const float* posb = p.posb + which * 128;
    bf16_t* c1 = p.c1 + (size_t)item * 128 * 128;
    gemm_tile_bf16<false>(src, 2048, w1t, 4096, 4096, lds, [&](int r, int c, float val) {
      c1[r * 128 + c] = f2bf(gelu_fast(val + posb[c])); });
    __threadfence_block();
    __syncthreads();
    if (which == 0) {
      bf16_t* kd = p.kcb + (size_t)bg * 128 * 128;
      gemm_tile_bf16<false>(c1, 128, w2t, 128, 128, lds, [&](int r, int c, float val) { kd[r * 128 + c] = f2bf(val); });
    } else {
      bf16_t* vd = p.vcT + (size_t)bg * 128 * 128;
      gemm_tile_bf16<true>(c1, 128, w2t, 128, 128, lds, [&](int r, int c, float val) { vd[r * 128 + perm16(c)] = f2bf(val); });
    }
  }
}

#define NEG_BIG (-1e30f)

struct KVRegs { u32x4 k0, k1, k2, k3, v0, v1, v2, v3; };

__device__ __forceinline__ int koff(int row, int chunk) { return row * 256 + ((chunk ^ (row & 15)) << 4); }

__device__ __forceinline__ void kv_load(KVRegs& r, const bf16_t* kp, int ldk, const bf16_t* vp, int ldv) {
  const int tid = opq(threadIdx.x);
  const bf16_t* kg = kp + (size_t)(tid >> 4) * ldk + (tid & 15) * 8;
  r.k0 = *(const u32x4*)kg;
  r.k1 = *(const u32x4*)(kg + (size_t)16 * ldk);
  r.k2 = *(const u32x4*)(kg + (size_t)32 * ldk);
  r.k3 = *(const u32x4*)(kg + (size_t)48 * ldk);
  const bf16_t* vg = vp + (size_t)(tid >> 3) * ldv + (tid & 7) * 8;
  r.v0 = *(const u32x4*)vg;
  r.v1 = *(const u32x4*)(vg + (size_t)32 * ldv);
  r.v2 = *(const u32x4*)(vg + (size_t)64 * ldv);
  r.v3 = *(const u32x4*)(vg + (size_t)96 * ldv);
}
__device__ __forceinline__ void kv_store(const KVRegs& r, char* lk, char* lv) {
  const int tid = opq(threadIdx.x);
  const int row = tid >> 4, ch = tid & 15;
  *(u32x4*)(lk + koff(row, ch)) = r.k0;
  *(u32x4*)(lk + koff(row + 16, ch)) = r.k1;
  *(u32x4*)(lk + koff(row + 32, ch)) = r.k2;
  *(u32x4*)(lk + koff(row + 48, ch)) = r.k3;
  const int vr = tid >> 3, vc = tid & 7;
  *(u32x4*)(lv + lds_off(vr, vc)) = r.v0;
  *(u32x4*)(lv + lds_off(vr + 32, vc)) = r.v1;
  *(u32x4*)(lv + lds_off(vr + 64, vc)) = r.v2;
  *(u32x4*)(lv + lds_off(vr + 96, vc)) = r.v3;
}

struct QFrag { bf16x8 f0, f1, f2, f3, f4, f5, f6, f7; };
__device__ __forceinline__ void q_load(QFrag& q, const bf16_t* qrow) {
  const int h = (opq(threadIdx.x) & 63) >> 5;
  const bf16x8* p8 = (const bf16x8*)(qrow + 8 * h);
  q.f0 = p8[0]; q.f1 = p8[2]; q.f2 = p8[4]; q.f3 = p8[6]; q.f4 = p8[8]; q.f5 = p8[10]; q.f6 = p8[12]; q.f7 = p8[14];
}

__device__ __forceinline__ void qk_tile(const QFrag& q, const char* lk, f32x16& s0, f32x16& s1) {
  const int lane = opq(threadIdx.x) & 63, row = lane & 31, h = lane >> 5;
#pragma unroll
  for (int r = 0; r < 16; ++r) { s0[r] = 0.f; s1[r] = 0.f; }
#define QK_STEP(kk, qf)                                                                  \
  {                                                                                      \
    bf16x8 a0 = *(const bf16x8*)(lk + koff(row, 2 * (kk) + h));                          \
    bf16x8 a1 = *(const bf16x8*)(lk + koff(row + 32, 2 * (kk) + h));                     \
    s0 = __builtin_amdgcn_mfma_f32_32x32x16_bf16(a0, qf, s0, 0, 0, 0);                   \
    s1 = __builtin_amdgcn_mfma_f32_32x32x16_bf16(a1, qf, s1, 0, 0, 0);                   \
  }
  QK_STEP(0, q.f0) QK_STEP(1, q.f1) QK_STEP(2, q.f2) QK_STEP(3, q.f3)
  QK_STEP(4, q.f4) QK_STEP(5, q.f5) QK_STEP(6, q.f6) QK_STEP(7, q.f7)
#undef QK_STEP
}

__device__ __forceinline__ bf16x8 pack8(const f32x16& p, const int base) {
  u32x4 u;
  u[0] = pack2(p[base + 0], p[base + 1]);
  u[1] = pack2(p[base + 2], p[base + 3]);
  u[2] = pack2(p[base + 4], p[base + 5]);
  u[3] = pack2(p[base + 6], p[base + 7]);
  return __builtin_bit_cast(bf16x8, u);
}

struct OAcc { f32x16 o0, o1, o2, o3; };
__device__ __forceinline__ void oacc_zero(OAcc& o) {
#pragma unroll
  for (int r = 0; r < 16; ++r) { o.o0[r] = 0.f; o.o1[r] = 0.f; o.o2[r] = 0.f; o.o3[r] = 0.f; }
}
__device__ __forceinline__ void oacc_scale(OAcc& o, float a) {
#pragma unroll
  for (int r = 0; r < 16; ++r) { o.o0[r] *= a; o.o1[r] *= a; o.o2[r] *= a; o.o3[r] *= a; }
}

__device__ __forceinline__ void pv_tile(OAcc& o, const char* lv, const f32x16& p0, const f32x16& p1) {
  const int lane = opq(threadIdx.x) & 63, row = lane & 31, h = lane >> 5;
  const bf16x8 pf0 = pack8(p0, 0), pf1 = pack8(p0, 8), pf2 = pack8(p1, 0), pf3 = pack8(p1, 8);
#define PV_ROW(dd, acc)                                                                                      \
  {                                                                                                          \
    acc = __builtin_amdgcn_mfma_f32_32x32x16_bf16(*(const bf16x8*)(lv + lds_off(32 * (dd) + row, 0 + h)), pf0, acc, 0, 0, 0); \
    acc = __builtin_amdgcn_mfma_f32_32x32x16_bf16(*(const bf16x8*)(lv + lds_off(32 * (dd) + row, 2 + h)), pf1, acc, 0, 0, 0); \
    acc = __builtin_amdgcn_mfma_f32_32x32x16_bf16(*(const bf16x8*)(lv + lds_off(32 * (dd) + row, 4 + h)), pf2, acc, 0, 0, 0); \
    acc = __builtin_amdgcn_mfma_f32_32x32x16_bf16(*(const bf16x8*)(lv + lds_off(32 * (dd) + row, 6 + h)), pf3, acc, 0, 0, 0); \
  }
  PV_ROW(0, o.o0) PV_ROW(1, o.o1) PV_ROW(2, o.o2) PV_ROW(3, o.o3)
#undef PV_ROW
}

__device__ __forceinline__ void softmax_tile(f32x16& s0, f32x16& s1, float& m, float& l, OAcc& o) {
  float mx = NEG_BIG;
#pragma unroll
  for (int r = 0; r < 16; ++r) mx = fmaxf(mx, fmaxf(s0[r], s1[r]));
  mx = fmaxf(mx, __shfl_xor(mx, 32));
  const float mn = fmaxf(m, mx);
  const float alpha = __expf(m - mn);
  float ls = 0.f;
#pragma unroll
  for (int r = 0; r < 16; ++r) {
    float a = (s0[r] > -1e29f) ? __expf(s0[r] - mn) : 0.f;
    float b = (s1[r] > -1e29f) ? __expf(s1[r] - mn) : 0.f;
    s0[r] = a; s1[r] = b;
    ls += a + b;
  }
  ls += __shfl_xor(ls, 32);
  l = l * alpha + ls;
  m = mn;
  if (__any(alpha != 1.f)) oacc_scale(o, alpha);
}

template <class F>
__device__ __forceinline__ void oacc_foreach(const OAcc& o, F f) {
  const int h = (opq(threadIdx.x) & 63) >> 5;
#pragma unroll
  for (int rho = 0; rho < 4; ++rho) {
    f(0 + 8 * rho + 4 * h, o.o0[4 * rho], o.o0[4 * rho + 1], o.o0[4 * rho + 2], o.o0[4 * rho + 3]);
    f(32 + 8 * rho + 4 * h, o.o1[4 * rho], o.o1[4 * rho + 1], o.o1[4 * rho + 2], o.o1[4 * rho + 3]);
    f(64 + 8 * rho + 4 * h, o.o2[4 * rho], o.o2[4 * rho + 1], o.o2[4 * rho + 2], o.o2[4 * rho + 3]);
    f(96 + 8 * rho + 4 * h, o.o3[4 * rho], o.o3[4 * rho + 1], o.o3[4 * rho + 2], o.o3[4 * rho + 3]);
  }
}

__device__ __forceinline__ void ph_memattn2(const P& p, char* lds) {
  char* lk = lds;
  char* lv = lds + 16384;
  const int lane = opq(threadIdx.x) & 63, wv = opq(threadIdx.x) >> 6;
  for (int item = blockIdx.x; item < NBATCH * 4 * (SEQ / 128); item += gridDim.x) {
    const int tb = item % (SEQ / 128);
    const int bh = item / (SEQ / 128);
    const int b = bh >> 2, hd = bh & 3;
    const int t = tb * 128 + wv * 32 + (lane & 31);
    QFrag q;
    q_load(q, p.qmemb + (size_t)(b * SEQ + t) * 512 + hd * 128);
    const bf16_t* kb = p.kmemb + (size_t)bh * 256 * 128;
    const bf16_t* vb = p.vmemT + (size_t)bh * 128 * 256;
    OAcc o;
    oacc_zero(o);
    float m = NEG_BIG, l = 0.f;
    KVRegs kv;
    kv_load(kv, kb, 128, vb, 256);
#pragma unroll 1
    for (int ti = 0; ti < 4; ++ti) {
      __syncthreads();
      kv_store(kv, lk, lv);
      __syncthreads();
      {
        const int tn = (ti + 1 < 4) ? ti + 1 : 3;
        kv_load(kv, kb + (size_t)tn * 64 * 128, 128, vb + tn * 64, 256);
      }
      f32x16 s0, s1;
      qk_tile(q, lk, s0, s1);
#pragma unroll
      for (int r = 0; r < 16; ++r) { s0[r] *= ATT_SCALE; s1[r] *= ATT_SCALE; }
      softmax_tile(s0, s1, m, l, o);
      pv_tile(o, lv, s0, s1);
    }
    const float il = 1.f / l;
    const int t2 = tb * 128 + (opq(threadIdx.x) >> 6) * 32 + (opq(threadIdx.x) & 31);
    bf16_t* orow = p.omem + (size_t)(b * SEQ + t2) * 512 + hd * 128;
    oacc_foreach(o, [&](int d, float v0, float v1, float v2, float v3) {
      uint2 u;
      u.x = pack2(v0 * il, v1 * il);
      u.y = pack2(v2 * il, v3 * il);
      *(uint2*)(orow + d) = u;
    });
  }
}

__device__ __forceinline__ void ph_sb2(const P& p, char* lds) {
  char* lk = lds;
  char* lv = lds + 16384;
  const int lane = opq(threadIdx.x) & 63, wv = opq(threadIdx.x) >> 6, hh = lane >> 5;
  const int sb_skip = (gridDim.x > 32) ? 16 : 0;
  if ((int)blockIdx.x < sb_skip) return;
  for (int item = (int)blockIdx.x - sb_skip; item < NBATCH * 8 * (SEQ / 128); item += (int)gridDim.x - sb_skip) {
    const int tb = (SEQ / 128 - 1) - (item % (SEQ / 128));
    const int bh = item / (SEQ / 128);
    const int b = bh >> 3, hd = bh & 7;
    const int t0 = tb * 128;
    const int t = t0 + wv * 32 + (lane & 31);
    QFrag q;
    q_load(q, p.qsb + (size_t)(b * SEQ + t) * 1024 + hd * 128);
    const bf16_t* kb = p.ksb + (size_t)bh * SEQ * 128;
    const bf16_t* vb = p.vsbT + (size_t)bh * 128 * SEQ;
    OAcc o;
    oacc_zero(o);
    float carry = 0.f;
    const int jhi = (t0 >> 6) + 1;
    const int jw = (t0 + wv * 32 + 30) >> 6;
    KVRegs kv;
    kv_load(kv, kb + (size_t)jhi * 64 * 128, 128, vb + jhi * 64, SEQ);
    volatile unsigned* dflag = (volatile unsigned*)(lds + 32768);
    __syncthreads();
    if (opq(threadIdx.x) < 4) dflag[opq(threadIdx.x)] = 0u;
    for (int j = jhi; j >= 0; --j) {
      __syncthreads();
      if ((dflag[0] & dflag[1] & dflag[2] & dflag[3]) != 0u) break;
      kv_store(kv, lk, lv);
      __syncthreads();
      const int jn = (j > 0) ? j - 1 : 0;
      if (j > jw) kv_load(kv, kb + (size_t)jn * 64 * 128, 128, vb + jn * 64, SEQ);
      if (j <= jw) {
        f32x16 z0, z1;
        qk_tile(q, lk, z0, z1);
        const int sbase = j * 64 + 4 * hh;
        float gt[8];
        f32x16 l0, l1;
#pragma unroll
        for (int r = 0; r < 16; ++r) {
          const int so = sbase + 8 * (r >> 2) + (r & 3);
          {
            const float z = z0[r] * ATT_SCALE;
            const bool valid = so < t;
            const float lsp = fminf(z, 0.f) - __logf(1.f + __expf(-fabsf(z)));
            l0[r] = valid ? (lsp - z) : 0.f;
            z0[r] = valid ? z : NEG_BIG;
          }
          {
            const float z = z1[r] * ATT_SCALE;
            const bool valid = so + 32 < t;
            const float lsp = fminf(z, 0.f) - __logf(1.f + __expf(-fabsf(z)));
            l1[r] = valid ? (lsp - z) : 0.f;
            z1[r] = valid ? z : NEG_BIG;
          }
        }
#pragma unroll
        for (int rho = 0; rho < 4; ++rho) {
          gt[rho] = (l0[4 * rho] + l0[4 * rho + 1]) + (l0[4 * rho + 2] + l0[4 * rho + 3]);
          gt[4 + rho] = (l1[4 * rho] + l1[4 * rho + 1]) + (l1[4 * rho + 2] + l1[4 * rho + 3]);
        }
        float ag[8];
        float run = 0.f;
#pragma unroll
        for (int k = 7; k >= 0; --k) {
          const float pg = __shfl_xor(gt[k], 32);
          ag[k] = carry + run + (hh == 0 ? pg : 0.f);
          run += gt[k] + pg;
        }
        carry += run;
#pragma unroll
        for (int rho = 0; rho < 4; ++rho) {
          {
            const float x3 = l0[4 * rho + 3], x23 = x3 + l0[4 * rho + 2], x123 = x23 + l0[4 * rho + 1];
            const float g = ag[rho];
            z0[4 * rho + 0] = __expf((l0[4 * rho + 0] + z0[4 * rho + 0]) + (g + x123));
            z0[4 * rho + 1] = __expf((l0[4 * rho + 1] + z0[4 * rho + 1]) + (g + x23));
            z0[4 * rho + 2] = __expf((l0[4 * rho + 2] + z0[4 * rho + 2]) + (g + x3));
            z0[4 * rho + 3] = __expf((l0[4 * rho + 3] + z0[4 * rho + 3]) + g);
          }
          {
            const float x3 = l1[4 * rho + 3], x23 = x3 + l1[4 * rho + 2], x123 = x23 + l1[4 * rho + 1];
            const float g = ag[4 + rho];
            z1[4 * rho + 0] = __expf((l1[4 * rho + 0] + z1[4 * rho + 0]) + (g + x123));
            z1[4 * rho + 1] = __expf((l1[4 * rho + 1] + z1[4 * rho + 1]) + (g + x23));
            z1[4 * rho + 2] = __expf((l1[4 * rho + 2] + z1[4 * rho + 2]) + (g + x3));
            z1[4 * rho + 3] = __expf((l1[4 * rho + 3] + z1[4 * rho + 3]) + g);
          }
        }
        kv_load(kv, kb + (size_t)jn * 64 * 128, 128, vb + jn * 64, SEQ);
        pv_tile(o, lv, z0, z1);
        if (__all(carry < -104.f) && (opq(threadIdx.x) & 63) == 0) dflag[wv] = 1u;
      }
    }
    int t2 = t;
    asm volatile("" : "+v"(t2));
    bf16_t* orow = p.omix + (size_t)(b * SEQ + t2) * DM + 1024 + hd * 128;
    oacc_foreach(o, [&](int d, float v0, float v1, float v2, float v3) {
      uint2 u;
      u.x = pack2(v0, v1);
      u.y = pack2(v2, v3);
      *(uint2*)(orow + d) = u;
    });
  }
}

#define NSA_IMP 32768
#define NSA_KEYS 49152
#define NSA_SELM 53504
#define NSA_LUT 53632
__device__ __forceinline__ void ph_nsa2(const P& p, char* lds) {
  typedef __attribute__((ext_vector_type(4))) float f32x4;
  char* lk = lds;
  char* lv = lds + 16384;
  float* imp = (float*)(lds + NSA_IMP);
  float* keys = (float*)(lds + NSA_KEYS);
  unsigned* selm = (unsigned*)(lds + NSA_SELM);
  const int tid = opq(threadIdx.x), lane = tid & 63, wv = tid >> 6, hh = lane >> 5, ql = lane & 31;
  float* lut = (float*)(lds + NSA_LUT) + wv * 128;
  for (int item = blockIdx.x; item < NBATCH * 2 * (SEQ / 32); item += gridDim.x) {
    const int tt = (item < 256) ? (SEQ / 32 - 1) - (item % (SEQ / 32)) : (item % (SEQ / 32));
    const int bg = item / (SEQ / 32);
    const int b = bg >> 1, g = bg & 1;
    const int h = g * 4 + wv;
    const int t0 = tt * 32, tq = t0 + ql, cur = t0 >> 6;
    __syncthreads();
    QFrag q;
    q_load(q, p.qn + (size_t)(b * SEQ + tq) * 1024 + h * 128);
    {
      const int lo = opq(lane);
      lut[lo] = p.t5[t5_bucket(lo) * 8 + h];
      lut[lo + 64] = p.t5[t5_bucket(lo + 64) * 8 + h];
    }
#pragma unroll
    for (int i = 0; i < 16; ++i) imp[i * 256 + tid] = 0.f;
    if (tid < 32) selm[tid] = 0u;
    const float* grow = p.gates + (size_t)(b * SEQ + tq) * 24 + h * 3;
    float* prow = p.part + (size_t)(b * SEQ + tq) * 1024 + h * 128;
    OAcc o;
    float m, l;
    KVRegs kv;
    {
      const bf16_t* kb = p.kcb + (size_t)bg * 128 * 128;
      const bf16_t* vb = p.vcT + (size_t)bg * 128 * 128;
      oacc_zero(o);
      m = NEG_BIG; l = 0.f;
      kv_load(kv, kb, 128, vb, 128);
      __syncthreads();
      kv_store(kv, lk, lv);
      __syncthreads();
      f32x16 x0, x1;
      qk_tile(q, lk, x0, x1);
      int tqv = tq;
      asm volatile("" : "+v"(tqv));
      tqv -= 64 * hh;
      if (t0 >= 1152) {
        const float b31 = lut[127];
#pragma unroll
        for (int r = 0; r < 16; ++r) { x0[r] = x0[r] * ATT_SCALE + b31; x1[r] = x1[r] * ATT_SCALE + b31; }
      } else {
#pragma unroll
        for (int r = 0; r < 16; ++r) {
          const int c = 8 * (r >> 2) + (r & 3);
          const int d0 = tqv - 16 * c - 31, d1 = d0 - 512;
          x0[r] = (d0 >= 0) ? x0[r] * ATT_SCALE + lut[min(d0, 127)] : NEG_BIG;
          x1[r] = (d1 >= 0) ? x1[r] * ATT_SCALE + lut[min(d1, 127)] : NEG_BIG;
        }
      }
      softmax_tile(x0, x1, m, l, o);
      const float m0 = m;
      pv_tile(o, lv, x0, x1);
      f32x16 z0, z1;
#pragma unroll
      for (int r = 0; r < 16; ++r) { z0[r] = 0.f; z1[r] = 0.f; }
      if (t0 >= 1024) {
        kv_load(kv, kb + 64 * 128, 128, vb + 64, 128);
        __syncthreads();
        kv_store(kv, lk, lv);
        __syncthreads();
        qk_tile(q, lk, z0, z1);
        asm volatile("" : "+v"(tqv));
#pragma unroll
        for (int r = 0; r < 16; ++r) {
          const int c = 64 + 8 * (r >> 2) + (r & 3);
          const int d0 = tqv - 16 * c - 31, d1 = d0 - 512;
          z0[r] = (d0 >= 0) ? z0[r] * ATT_SCALE + lut[min(d0, 127)] : NEG_BIG;
          z1[r] = (d1 >= 0) ? z1[r] * ATT_SCALE + lut[min(d1, 127)] : NEG_BIG;
        }
        softmax_tile(z0, z1, m, l, o);
        pv_tile(o, lv, z0, z1);
      }
      const float inv = 1.f / fmaxf(l, 1e-20f);
      const float c0 = __expf(m0 - m) * inv;
#pragma unroll
      for (int r = 0; r < 16; ++r) {
        const int c = 8 * (r >> 2) + (r & 3) + 4 * hh;
        if (x0[r] != 0.f) atomicAdd(&imp[(c) * 32 + ql], x0[r] * c0);
        if (x1[r] != 0.f) atomicAdd(&imp[(c + 32) * 32 + ql], x1[r] * c0);
        if (z0[r] != 0.f) atomicAdd(&imp[(c + 64) * 32 + ql], z0[r] * inv);
        if (z1[r] != 0.f) atomicAdd(&imp[(c + 96) * 32 + ql], z1[r] * inv);
      }
      const float gs = inv / (1.f + __expf(-grow[0]));
      oacc_foreach(o, [&](int d, float v0, float v1, float v2, float v3) {
        f32x4 u = {v0 * gs, v1 * gs, v2 * gs, v3 * gs};
        *(f32x4*)(prow + d) = u;
      });
    }
    __syncthreads();
    {
      const int tido = opq(tid);
      const int qq = tido & 31, jg = tido >> 5;
#pragma unroll
      for (int jj = 0; jj < 4; ++jj) {
        const int j = jg * 4 + jj;
        float v = imp[(4 * j) * 32 + qq] + imp[(4 * j + 1) * 32 + qq] + imp[(4 * j + 2) * 32 + qq] + 0.5f * imp[(4 * j + 3) * 32 + qq];
        if (j > 0) v += 0.5f * imp[(4 * j - 1) * 32 + qq];
        const bool forced = (j == 0) || (j == cur) || (j == cur - 1);
        keys[qq * 33 + j] = forced ? 1e9f : ((j <= cur) ? v : -1e9f);
      }
      __syncthreads();
      unsigned bits = 0u;
#pragma unroll
      for (int jj = 0; jj < 4; ++jj) {
        const int j = jg * 4 + jj;
        const float kj = keys[qq * 33 + j];
        int rank = 0;
        for (int i = 0; i < 32; ++i) {
          const float ki = keys[qq * 33 + i];
          rank += (ki > kj || (ki == kj && i < j)) ? 1 : 0;
        }
        if (rank < 16 && j <= cur) bits |= 1u << j;
      }
      atomicOr(&selm[qq], bits);
      __syncthreads();
    }
    const unsigned mysel = selm[ql];
    unsigned um = mysel;
#pragma unroll
    for (int o2 = 16; o2 > 0; o2 >>= 1) um |= (unsigned)__shfl_xor((int)um, o2);
    um = (unsigned)__builtin_amdgcn_readfirstlane((int)um);
    {
      const bf16_t* kb = p.ks + (size_t)bg * SEQ * 128;
      const bf16_t* vb = p.vsT + (size_t)bg * 128 * SEQ;
      oacc_zero(o);
      m = NEG_BIG; l = 0.f;
      unsigned rem = um;
      int j = __builtin_ctz(rem);
      kv_load(kv, kb + (size_t)j * 64 * 128, 128, vb + j * 64, SEQ);
      while (rem) {
        j = __builtin_ctz(rem);
        rem &= rem - 1;
        const int jn = rem ? __builtin_ctz(rem) : j;
        __syncthreads();
        kv_store(kv, lk, lv);
        __syncthreads();
        f32x16 s0, s1;
        qk_tile(q, lk, s0, s1);
        const bool selq = (mysel >> j) & 1u;
        int tqv = tq;
        asm volatile("" : "+v"(tqv));
        if (j * 64 + 63 + 113 <= t0) {
          const float sc = selq ? ATT_SCALE : 0.f, bb = selq ? lut[127] : NEG_BIG;
#pragma unroll
          for (int r = 0; r < 16; ++r) { s0[r] = s0[r] * sc + bb; s1[r] = s1[r] * sc + bb; }
        } else {
#pragma unroll
          for (int r = 0; r < 16; ++r) {
            const int d0 = tqv - (j * 64 + 8 * (r >> 2) + (r & 3) + 4 * hh), d1 = d0 - 32;
            s0[r] = (selq && d0 >= 0) ? s0[r] * ATT_SCALE + lut[min(d0, 127)] : NEG_BIG;
            s1[r] = (selq && d1 >= 0) ? s1[r] * ATT_SCALE + lut[min(d1, 127)] : NEG_BIG;
          }
        }
        kv_load(kv, kb + (size_t)jn * 64 * 128, 128, vb + jn * 64, SEQ);
        softmax_tile(s0, s1, m, l, o);
        pv_tile(o, lv, s0, s1);
      }
      const float gs = 1.f / (fmaxf(l, 1e-20f) * (1.f + __expf(-grow[1])));
      int qo = ql;
      asm volatile("" : "+v"(qo));
      float* pr2 = p.part + (size_t)(b * SEQ + t0 + qo) * 1024 + h * 128;
      oacc_foreach(o, [&](int d, float v0, float v1, float v2, float v3) {
        f32x4 u = *(f32x4*)(pr2 + d);
        u[0] += v0 * gs; u[1] += v1 * gs; u[2] += v2 * gs; u[3] += v3 * gs;
        *(f32x4*)(pr2 + d) = u;
      });
    }
    {
      const bf16_t* kb = p.kw + (size_t)bg * SEQ * 128;
      const bf16_t* vb = p.vwT + (size_t)bg * 128 * SEQ;
      oacc_zero(o);
      m = NEG_BIG; l = 0.f;
      int jlo = (t0 - 511) >> 6;
      if (jlo < 0) jlo = 0;
      kv_load(kv, kb + (size_t)jlo * 64 * 128, 128, vb + jlo * 64, SEQ);
      for (int j = jlo; j <= cur; ++j) {
        const int jn = (j < cur) ? j + 1 : j;
        __syncthreads();
        kv_store(kv, lk, lv);
        __syncthreads();
        f32x16 s0, s1;
        qk_tile(q, lk, s0, s1);
        int tqv = tq;
        asm volatile("" : "+v"(tqv));
        if (j * 64 + 63 + 113 <= t0 && t0 + 31 - j * 64 < 512) {
          const float b31 = lut[127];
#pragma unroll
          for (int r = 0; r < 16; ++r) { s0[r] = s0[r] * ATT_SCALE + b31; s1[r] = s1[r] * ATT_SCALE + b31; }
        } else {
#pragma unroll
          for (int r = 0; r < 16; ++r) {
            const int d0 = tqv - (j * 64 + 8 * (r >> 2) + (r & 3) + 4 * hh), d1 = d0 - 32;
            s0[r] = (d0 >= 0 && d0 < 512) ? s0[r] * ATT_SCALE + lut[min(d0, 127)] : NEG_BIG;
            s1[r] = (d1 >= 0 && d1 < 512) ? s1[r] * ATT_SCALE + lut[min(d1, 127)] : NEG_BIG;
          }
        }
        kv_load(kv, kb + (size_t)jn * 64 * 128, 128, vb + jn * 64, SEQ);
        softmax_tile(s0, s1, m, l, o);
        pv_tile(o, lv, s0, s1);
      }
      const float gs = 1.f / (fmaxf(l, 1e-20f) * (1.f + __expf(-grow[2])));
      int qo = ql;
      asm volatile("" : "+v"(qo));
      const float* pr2 = p.part + (size_t)(b * SEQ + t0 + qo) * 1024 + h * 128;
      bf16_t* orow = p.omix + (size_t)(b * SEQ + t0 + qo) * DM + h * 128;
      oacc_foreach(o, [&](int d, float v0, float v1, float v2, float v3) {
        const f32x4 u = *(const f32x4*)(pr2 + d);
        uint2 w;
        w.x = pack2(u[0] + v0 * gs, u[1] + v1 * gs);
        w.y = pack2(u[2] + v2 * gs, u[3] + v3 * gs);
        *(uint2*)(orow + d) = w;
      });
    }
  }
}

__device__ __forceinline__ void ph_cvt(const float* src, bf16_t* dst, size_t n) {
  typedef __attribute__((ext_vector_type(4))) float f32x4;
  const size_t nv = n / 8;
  for (size_t i = (size_t)blockIdx.x * 256 + opq(threadIdx.x); i < nv; i += (size_t)gridDim.x * 256) {
    const f32x4 a = ((const f32x4*)src)[2 * i], b = ((const f32x4*)src)[2 * i + 1];
    u32x4 o;
    o[0] = pack2(a[0], a[1]); o[1] = pack2(a[2], a[3]); o[2] = pack2(b[0], b[1]); o[3] = pack2(b[2], b[3]);
    ((u32x4*)dst)[i] = o;
  }
}

__device__ __forceinline__ void ph_scores(const P& p, char* lds) {
  for (int u = blockIdx.x; u < 64 * 16; u += gridDim.x) {
    const int tm = u & 63, hp = u >> 6;
    const int m0 = tm * 128;
    float* sc = p.scores + (size_t)m0 * DM + hp * 128;
    gemm_tile_bf16<false>(p.omix + (size_t)m0 * DM + hp * 128, DM, p.subkb + (size_t)hp * 128 * 128, 128, 128, lds,
                          [&](int r, int c, float val) { sc[(size_t)r * DM + c] = val; });
  }
}

__device__ __forceinline__ void ph_qp_scores(const P& p, char* lds) {
  const int ntm = T_TOK / 128, ntn = DM / 128;
  const int npm = (ntm + 7) / 8, npn = (ntn + 7) / 8;
  const int nslots = ((npm * npn * 64 + 511) / 512) * 512;
  for (int u = blockIdx.x; u < nslots; u += gridDim.x) {
    int v = (u & 7) * 64 + ((u >> 3) & 63) + (u & ~511);
    int patch = v >> 6, w = v & 63;
    int tm = (patch % npm) * 8 + (w & 7);
    int tn = (patch / npm) * 8 + (w >> 3);
    if (tm >= ntm || tn >= ntn) continue;
    const int m0 = tm * 128, n0 = tn * 128;
    bf16_t* qp = p.omix + (size_t)m0 * DM + n0;
    gemm_tile_bf16<false>(p.hn + (size_t)m0 * DM, DM, p.WpqT + (size_t)n0 * DM, DM, DM, lds,
                          [&](int r, int c, float val) { qp[(size_t)r * DM + c] = f2bf(val); });
    __threadfence_block();
    __syncthreads();
    float* sc = p.scores + (size_t)m0 * DM + n0;
    gemm_tile_bf16<false>(qp, DM, p.subkb + (size_t)tn * 128 * 128, 128, 128, lds,
                          [&](int r, int c, float val) { sc[(size_t)r * DM + c] = val; });
  }
}

__device__ __forceinline__ void ph_cvt4(const float* src, unsigned char* dst, float* scales, int nrows, int wid0, int nw) {
  typedef __attribute__((ext_vector_type(4))) float f32x4;
  typedef __attribute__((ext_vector_type(2))) float f32x2;
  const int lane = opq(threadIdx.x) & 63;
  const float one = __uint_as_float((unsigned)opq(0x3F800000));
  float lev[8];
#pragma unroll
  for (int c = 0; c < 8; ++c) {
    const f32x2 q = __builtin_amdgcn_cvt_scalef32_pk_f32_fp4((unsigned)opq(c * 0x11111111), one, 0);
    lev[c] = fabsf(q[0]);
  }
  float thr[7];
#pragma unroll
  for (int c = 0; c < 7; ++c) thr[c] = 0.5f * (lev[c] + lev[c + 1]);
  const float maxlev = lev[7];
  for (int row = wid0; row < nrows; row += nw) {
    const f32x4* s4 = (const f32x4*)(src + (size_t)row * DM) + lane * 8;
    f32x4 v[8];
    float amax = 0.f;
#pragma unroll
    for (int i = 0; i < 8; ++i) {
      v[i] = s4[i];
#pragma unroll
      for (int k = 0; k < 4; ++k) amax = fmaxf(amax, fabsf(v[i][k]));
    }
    amax = wave_max(amax);
    const float sc = (amax > 0.f) ? maxlev / amax : 1.f;
    u32x4 o;
#pragma unroll
    for (int w = 0; w < 4; ++w) {
      unsigned pk = 0u;
#pragma unroll
      for (int e = 0; e < 8; ++e) {
        const float xv = v[2 * w + (e >> 2)][e & 3] * sc;
        const float a = fabsf(xv);
        unsigned code = (a > thr[0]) + (a > thr[1]) + (a > thr[2]) + (a > thr[3]) + (a > thr[4]) + (a > thr[5]) + (a > thr[6]);
        code |= (xv < 0.f) ? 8u : 0u;
        pk |= code << (4 * e);
      }
      o[w] = pk;
    }
    *(u32x4*)(dst + (size_t)row * 1024 + lane * 16) = o;
    if (lane == 0) scales[row] = (amax > 0.f) ? amax / maxlev : 1.f;
  }
}

__device__ __forceinline__ u32x4 r4_load(const unsigned char* tab, int eid, int lane) {
  return *((const u32x4*)(tab + (size_t)eid * 1024) + lane);
}
struct XPk { f32x16 a, b; };
struct Acc32 { f32x16 a, b; };

#define R4_DOT_W(word, xv, base, pa, pb)                                                             \
  {                                                                                                  \
    typedef __attribute__((ext_vector_type(2))) float f32x2;                                         \
    const f32x2 q0 = __builtin_amdgcn_cvt_scalef32_pk_f32_fp4(word, one, 0), q1 = __builtin_amdgcn_cvt_scalef32_pk_f32_fp4(word, one, 1); \
    const f32x2 q2 = __builtin_amdgcn_cvt_scalef32_pk_f32_fp4(word, one, 2), q3 = __builtin_amdgcn_cvt_scalef32_pk_f32_fp4(word, one, 3); \
    pa += q0[0] * xv[base + 0] + q0[1] * xv[base + 1]; pb += q1[0] * xv[base + 2] + q1[1] * xv[base + 3]; \
    pa += q2[0] * xv[base + 4] + q2[1] * xv[base + 5]; pb += q3[0] * xv[base + 6] + q3[1] * xv[base + 7]; \
  }
__device__ __forceinline__ float r4_dot(const u32x4& e, const XPk& x) {
  const float one = __uint_as_float((unsigned)opq(0x3F800000));
  float pa = 0.f, pb = 0.f;
  R4_DOT_W(e[0], x.a, 0, pa, pb) R4_DOT_W(e[1], x.a, 8, pa, pb) R4_DOT_W(e[2], x.b, 0, pa, pb) R4_DOT_W(e[3], x.b, 8, pa, pb)
  return pa + pb;
}
#define R4_AXPY_W(word, accv, base)                                                                  \
  {                                                                                                  \
    typedef __attribute__((ext_vector_type(2))) float f32x2;                                         \
    const f32x2 q0 = __builtin_amdgcn_cvt_scalef32_pk_f32_fp4(word, one, 0), q1 = __builtin_amdgcn_cvt_scalef32_pk_f32_fp4(word, one, 1); \
    const f32x2 q2 = __builtin_amdgcn_cvt_scalef32_pk_f32_fp4(word, one, 2), q3 = __builtin_amdgcn_cvt_scalef32_pk_f32_fp4(word, one, 3); \
    accv[base + 0] += hid * q0[0]; accv[base + 1] += hid * q0[1]; accv[base + 2] += hid * q1[0]; accv[base + 3] += hid * q1[1]; \
    accv[base + 4] += hid * q2[0]; accv[base + 5] += hid * q2[1]; accv[base + 6] += hid * q3[0]; accv[base + 7] += hid * q3[1]; \
  }
__device__ __forceinline__ void r4_axpy(const u32x4& e, float hid, Acc32& acc) {
  const float one = __uint_as_float((unsigned)opq(0x3F800000));
  R4_AXPY_W(e[0], acc.a, 0) R4_AXPY_W(e[1], acc.a, 8) R4_AXPY_W(e[2], acc.b, 0) R4_AXPY_W(e[3], acc.b, 8)
}

#define INS16(K, x)                                                                                      \
  K##15 = __builtin_amdgcn_fmed3f(K##15, K##14, x); K##14 = __builtin_amdgcn_fmed3f(K##14, K##13, x);   \
  K##13 = __builtin_amdgcn_fmed3f(K##13, K##12, x); K##12 = __builtin_amdgcn_fmed3f(K##12, K##11, x);   \
  K##11 = __builtin_amdgcn_fmed3f(K##11, K##10, x); K##10 = __builtin_amdgcn_fmed3f(K##10, K##9, x);    \
  K##9 = __builtin_amdgcn_fmed3f(K##9, K##8, x); K##8 = __builtin_amdgcn_fmed3f(K##8, K##7, x);         \
  K##7 = __builtin_amdgcn_fmed3f(K##7, K##6, x); K##6 = __builtin_amdgcn_fmed3f(K##6, K##5, x);         \
  K##5 = __builtin_amdgcn_fmed3f(K##5, K##4, x); K##4 = __builtin_amdgcn_fmed3f(K##4, K##3, x);         \
  K##3 = __builtin_amdgcn_fmed3f(K##3, K##2, x); K##2 = __builtin_amdgcn_fmed3f(K##2, K##1, x);         \
  K##1 = __builtin_amdgcn_fmed3f(K##1, K##0, x); K##0 = fmaxf(K##0, x);
#define DECL16(K) float K##0 = -INFINITY, K##1 = -INFINITY, K##2 = -INFINITY, K##3 = -INFINITY, K##4 = -INFINITY, \
  K##5 = -INFINITY, K##6 = -INFINITY, K##7 = -INFINITY, K##8 = -INFINITY, K##9 = -INFINITY, K##10 = -INFINITY,   \
  K##11 = -INFINITY, K##12 = -INFINITY, K##13 = -INFINITY, K##14 = -INFINITY, K##15 = -INFINITY;
__device__ __forceinline__ float mkkey(float v, unsigned tag, unsigned mask) {
  return __uint_as_float((__float_as_uint(v) & ~mask) | tag);
}

__device__ __forceinline__ void ph_peer(const P& p, float* smem) {
  typedef __attribute__((ext_vector_type(4))) float f32x4;
  float* lists = smem;
  int* bexA = (int*)(smem + 4096);
  float* bgtA = smem + 6144;
  float* bsuA = smem + 8192;
  for (int item = blockIdx.x; item < T_TOK / 16; item += gridDim.x) {
    const int t0 = item * 16;
    __syncthreads();
    {
      const int tid = opq(threadIdx.x);
      const int tl = tid >> 4, hp = tid & 15;
      const f32x4* sp = (const f32x4*)(p.scores + (size_t)(t0 + tl) * DM + hp * 128);
      DECL16(k)
#pragma unroll 4
      for (int c4 = 0; c4 < 32; ++c4) {
        const f32x4 v = sp[c4];
#pragma unroll
        for (int e = 0; e < 4; ++e) {
          const float x = mkkey(v[e], 127u - (unsigned)(c4 * 4 + e), 127u);
          INS16(k, x)
        }
      }
      f32x4* lp = (f32x4*)(lists + (size_t)opq(threadIdx.x) * 16);
      f32x4 o0 = {k0, k1, k2, k3}, o1 = {k4, k5, k6, k7}, o2 = {k8, k9, k10, k11}, o3 = {k12, k13, k14, k15};
      lp[0] = o0; lp[1] = o1; lp[2] = o2; lp[3] = o3;
    }
    __syncthreads();
    if (opq(threadIdx.x) < 128) {
      const int tid = opq(threadIdx.x);
      const int tl = tid >> 3, h = tid & 7;
      const float* la = lists + (size_t)(tl * 16 + 2 * h) * 16;
      const float* lb = la + 16;
      float av[16], bv[16];
#pragma unroll
      for (int i = 0; i < 16; ++i) {
        av[i] = __uint_as_float(__float_as_uint(la[i]) & ~127u);
        bv[i] = __uint_as_float(__float_as_uint(lb[i]) & ~127u);
      }
      DECL16(c)
#pragma unroll
      for (int i = 0; i < 16; ++i) {
#pragma unroll
        for (int j = 0; j < 16; ++j) {
          if ((i + 1) * (j + 1) <= 16) {
            const float x = mkkey(av[i] + bv[j], 255u - (unsigned)(i * 16 + j), 255u);
            INS16(c, x)
          }
        }
      }
      float cs[16] = {c0, c1, c2, c3, c4, c5, c6, c7, c8, c9, c10, c11, c12, c13, c14, c15};
      float ev[16];
      float sum = 0.f;
      const float mx = __uint_as_float(__float_as_uint(cs[0]) & ~255u);
#pragma unroll
      for (int n = 0; n < 16; ++n) {
        ev[n] = __expf(__uint_as_float(__float_as_uint(cs[n]) & ~255u) - mx);
        sum += ev[n];
      }
      const float isum = 1.f / sum;
#pragma unroll
      for (int n = 0; n < 16; ++n) {
        const unsigned cc = 255u - (__float_as_uint(cs[n]) & 255u);
        const unsigned ka = 127u - (__float_as_uint(la[cc >> 4]) & 127u);
        const unsigned kb = 127u - (__float_as_uint(lb[cc & 15u]) & 127u);
        const int eid = (int)(ka * 128u + kb);
        bexA[tl * 128 + h * 16 + n] = eid;
        bgtA[tl * 128 + h * 16 + n] = ev[n] * isum * p.sv8[eid];
        bsuA[tl * 128 + h * 16 + n] = p.su8[eid];
      }
    }
    __syncthreads();
#pragma unroll 1
    for (int ti4 = 0; ti4 < 4; ++ti4) {
    const int lane = opq(threadIdx.x) & 63, wv = opq(threadIdx.x) >> 6;
    const int tl = wv * 4 + ti4;
    const int t = t0 + tl;
    const int* bex = bexA + tl * 128;
    const float* bgt = bgtA + tl * 128;
    const float* bsu = bsuA + tl * 128;
    XPk x;
    {
      const f32x4* s4 = (const f32x4*)(p.out + (size_t)t * DM) + lane * 8;
      const f32x4* g4 = (const f32x4*)p.norm_ffn + lane * 8;
      f32x4 a0 = s4[0], a1 = s4[1], a2 = s4[2], a3 = s4[3], a4 = s4[4], a5 = s4[5], a6 = s4[6], a7 = s4[7];
      float ss = 0.f;
#define SSQ(v) ss += v[0] * v[0] + v[1] * v[1] + v[2] * v[2] + v[3] * v[3];
      SSQ(a0) SSQ(a1) SSQ(a2) SSQ(a3) SSQ(a4) SSQ(a5) SSQ(a6) SSQ(a7)
#undef SSQ
      ss = wave_sum(ss);
      const float rs = rsqrtf(ss * (1.f / DM) + RMS_EPS);
#define XPK(dst, base, va, vb, gi)                                                    \
  {                                                                                   \
    const f32x4 ga = g4[gi], gb = g4[gi + 1];                                         \
    dst[base + 0] = bf2f(f2bf(va[0] * rs * ga[0])); dst[base + 1] = bf2f(f2bf(va[1] * rs * ga[1]));   \
    dst[base + 2] = bf2f(f2bf(va[2] * rs * ga[2])); dst[base + 3] = bf2f(f2bf(va[3] * rs * ga[3]));   \
    dst[base + 4] = bf2f(f2bf(vb[0] * rs * gb[0])); dst[base + 5] = bf2f(f2bf(vb[1] * rs * gb[1]));   \
    dst[base + 6] = bf2f(f2bf(vb[2] * rs * gb[2])); dst[base + 7] = bf2f(f2bf(vb[3] * rs * gb[3]));   \
  }
      XPK(x.a, 0, a0, a1, 0) XPK(x.a, 8, a2, a3, 2) XPK(x.b, 0, a4, a5, 4) XPK(x.b, 8, a6, a7, 6)
#undef XPK
    }
    Acc32 acc;
#pragma unroll
    for (int r = 0; r < 16; ++r) { acc.a[r] = 0.f; acc.b[r] = 0.f; }
    u32x4 u0 = r4_load(p.pu8, bex[0], lane), u1 = r4_load(p.pu8, bex[1], lane), u2 = r4_load(p.pu8, bex[2], lane), u3 = r4_load(p.pu8, bex[3], lane);
    u32x4 v0 = r4_load(p.pv8, bex[0], lane), v1 = r4_load(p.pv8, bex[1], lane), v2 = r4_load(p.pv8, bex[2], lane), v3 = r4_load(p.pv8, bex[3], lane);
#pragma unroll 1
    for (int e0 = 0; e0 < 128; e0 += 4) {
      float d0 = r4_dot(u0, x), d1 = r4_dot(u1, x), d2 = r4_dot(u2, x), d3 = r4_dot(u3, x);
      const int en = (e0 + 4 < 128) ? e0 + 4 : 124;
      const int i0 = bex[en], i1 = bex[en + 1], i2 = bex[en + 2], i3 = bex[en + 3];
      u0 = r4_load(p.pu8, i0, lane); u1 = r4_load(p.pu8, i1, lane); u2 = r4_load(p.pu8, i2, lane); u3 = r4_load(p.pu8, i3, lane);
#pragma unroll
      for (int o = 32; o > 0; o >>= 1) {
        d0 += __shfl_xor(d0, o); d1 += __shfl_xor(d1, o); d2 += __shfl_xor(d2, o); d3 += __shfl_xor(d3, o);
      }
      { const float hid = bgt[e0 + 0] * gelu_fast(d0 * bsu[e0 + 0]); r4_axpy(v0, hid, acc); }
      { const float hid = bgt[e0 + 1] * gelu_fast(d1 * bsu[e0 + 1]); r4_axpy(v1, hid, acc); }
      { const float hid = bgt[e0 + 2] * gelu_fast(d2 * bsu[e0 + 2]); r4_axpy(v2, hid, acc); }
      { const float hid = bgt[e0 + 3] * gelu_fast(d3 * bsu[e0 + 3]); r4_axpy(v3, hid, acc); }
      v0 = r4_load(p.pv8, i0, lane); v1 = r4_load(p.pv8, i1, lane); v2 = r4_load(p.pv8, i2, lane); v3 = r4_load(p.pv8, i3, lane);
    }
    const int lane2 = opq(lane);
    f32x4* o4 = (f32x4*)(p.out + (size_t)t * DM) + lane2 * 8;
    const f32x4* g4 = (const f32x4*)p.norm_final + lane2 * 8;
    f32x4 hv[8];
    float ss = 0.f;
#pragma unroll
    for (int i = 0; i < 8; ++i) {
      hv[i] = o4[i];
#pragma unroll
      for (int k = 0; k < 4; ++k) {
        hv[i][k] += (i < 4) ? acc.a[4 * i + k] : acc.b[4 * (i - 4) + k];
        ss += hv[i][k] * hv[i][k];
      }
    }
    ss = wave_sum(ss);
    const float rs = rsqrtf(ss * (1.f / DM) + RMS_EPS);
#pragma unroll
    for (int i = 0; i < 8; ++i) {
      const f32x4 g = g4[i];
      f32x4 o;
#pragma unroll
      for (int k = 0; k < 4; ++k) o[k] = hv[i][k] * rs * g[k];
      o4[i] = o;
    }
    }
  }
}

#define XB_TMO      128
#define XB_XCNT(j)  (256  + 64 * (j))
#define XB_XSUB(j)  (1280 + 64 * (j))
#define XB_XGEN(j)  (2304 + 64 * (j))
#define XB_TOP      3328
#define XB_TOPGEN   3392
#define XCD_BAR_WORDS 3456
#define XB_SPIN_CAP (1u << 22)
#define LAS __attribute__((address_space(3)))
__device__ __forceinline__ unsigned xb_ld(unsigned* p) { return __hip_atomic_load(p, __ATOMIC_RELAXED, __HIP_MEMORY_SCOPE_AGENT); }
__device__ __forceinline__ unsigned xb_add(unsigned* p, unsigned v) { return __hip_atomic_fetch_add(p, v, __ATOMIC_RELAXED, __HIP_MEMORY_SCOPE_AGENT); }
__device__ __forceinline__ unsigned xb_xcc_id() { return (unsigned)__builtin_amdgcn_s_getreg((3 << 11) | 20) & 0xFu; }
#define XB_SPIN(cond, bar) do { unsigned _sp = 0; while (cond) { __builtin_amdgcn_s_sleep(1); \
    if ((++_sp & 255u) == 0u) { if (xb_ld(&(bar)[XB_TMO])) break; if (_sp > XB_SPIN_CAP) { atomicAdd(&(bar)[XB_TMO], 1u); break; } } } } while (0)
struct XcdBarrier { unsigned* bar; unsigned x; volatile LAS unsigned* st; };
__device__ __forceinline__ XcdBarrier xcd_barrier_post(unsigned* bar, volatile LAS unsigned* st) {
  XcdBarrier b; b.bar = bar; b.x = xb_xcc_id(); b.st = st;
  if (threadIdx.x == 0) (void)xb_add(&bar[XB_XCNT(b.x)], 1u);
  return b;
}
__device__ __forceinline__ void xcd_barrier_complete(unsigned* bar, unsigned x, unsigned& nloc, unsigned& nx) {
  const unsigned G = gridDim.x * gridDim.y * gridDim.z;
  unsigned sum, cnt, mine, sp = 0u;
  for (;;) {
    sum = 0u; cnt = 0u; mine = 0u;
#pragma unroll
    for (unsigned j = 0; j < 16; ++j) { const unsigned c = xb_ld(&bar[XB_XCNT(j)]); sum += c; cnt += (c > 0u) ? 1u : 0u; mine = (j == x) ? c : mine; }
    if (sum == G) break;
    __builtin_amdgcn_s_sleep(1);
    if ((++sp & 255u) == 0u) { if (xb_ld(&bar[XB_TMO])) break; if (sp > XB_SPIN_CAP) { atomicAdd(&bar[XB_TMO], 1u); break; } }
  }
  nloc = mine > 0u ? mine : 1u; nx = cnt > 0u ? cnt : 1u;
}
__device__ __forceinline__ void xcd_barrier(const XcdBarrier& b) {
  asm volatile("s_waitcnt vmcnt(0)" ::: "memory");
  __syncthreads();
  if (threadIdx.x == 0) {
    unsigned* bar = b.bar;
    __builtin_amdgcn_s_waitcnt(0);
    unsigned nloc = b.st[0], nx = b.st[1];
    if (nloc == 0u) { xcd_barrier_complete(bar, b.x, nloc, nx); b.st[0] = nloc; b.st[1] = nx; }
    const unsigned old = xb_add(&bar[XB_XSUB(b.x)], 1u);
    const unsigned gen = old / nloc;
    if (old + 1u == (gen + 1u) * nloc) {
      __builtin_amdgcn_fence(__ATOMIC_RELEASE, "agent");
      asm volatile("s_waitcnt vmcnt(0)" ::: "memory");
      const unsigned og = xb_add(&bar[XB_TOP], 1u);
      const unsigned tg = og / nx;
      if (og + 1u == (tg + 1u) * nx) xb_add(&bar[XB_TOPGEN], 1u);
      else XB_SPIN(xb_ld(&bar[XB_TOPGEN]) == tg, bar);
      __builtin_amdgcn_fence(__ATOMIC_ACQUIRE, "agent");
      xb_add(&bar[XB_XGEN(b.x)], 1u);
      asm volatile("s_waitcnt vmcnt(0)" ::: "memory");
    } else {
      XB_SPIN(xb_ld(&bar[XB_XGEN(b.x)]) == gen, bar);
      __builtin_amdgcn_fence(__ATOMIC_ACQUIRE, "agent");
      asm volatile("s_waitcnt vmcnt(0)" ::: "memory");
    }
  }
  __syncthreads();
}

typedef const __attribute__((address_space(4))) P* KP;
__device__ __forceinline__ P loadP() {
#if defined(__HIP_DEVICE_COMPILE__)
  KP k = (KP)__builtin_amdgcn_kernarg_segment_ptr();
  asm volatile("" : "+s"(k));
  P p = *k;
  return p;
#else
  return P{};
#endif
}

__global__ void __launch_bounds__(256, 2) mega(P p_arg) {
  cg::grid_group grid = cg::this_grid();
  __shared__ __attribute__((aligned(16))) float smem[14336];
  char* lds = (char*)smem;
  __shared__ uint4 xb_words;
  if (threadIdx.x == 0) xb_words = make_uint4(0u, 0u, 0u, 0u);
  if (blockIdx.x == 0) {
    P p = loadP();
    for (int i = threadIdx.x; i < XCD_BAR_WORDS; i += 256) p.bar[i] = 0u;
  }
  { P p = loadP(); ph_rmsnorm(p.x, p.norm_mix, p.hn, T_TOK); ph_rmsnorm(p.mem, p.norm_mkv, p.memn, 1024); }
  { P p = loadP(); ph_transpose<true>(smem, p.w_in, DM, INC, 5760, p.WinT); }
  { P p = loadP(); ph_transpose<false>(smem, p.w_out, DM, DM, DM, p.WoutT); }
  { P p = loadP(); ph_transpose<false>(smem, p.w_pq, DM, DM, DM, p.WpqT); }
  { P p = loadP(); ph_transpose<false>(smem, p.w_mq, DM, 512, 512, p.WmqT); }
  { P p = loadP(); ph_transpose<false>(smem, p.w_mk, DM, 512, 512, p.WmkT); }
  { P p = loadP(); ph_transpose<false>(smem, p.w_mv, DM, 512, 512, p.WmvT); }
  { P p = loadP(); ph_transpose<false>(smem, p.w_mo, 512, DM, DM, p.WmoT); }
  { P p = loadP(); ph_cvt(p.subk, p.subkb, (size_t)16 * 128 * 128); }
  { P p = loadP(); ph_transpose<false>(smem, p.w1_k, 4096, 128, 128, p.w1T); }
  { P p = loadP(); ph_transpose<false>(smem, p.w1_v, 4096, 128, 128, p.w1T + 128 * 4096); }
  { P p = loadP(); ph_transpose<false>(smem, p.w2_k, 128, 128, 128, p.w2T); }
  { P p = loadP(); ph_transpose<false>(smem, p.w2_v, 128, 128, 128, p.w2T + 128 * 128); }
  { P p = loadP(); ph_posb(p); }
  grid.sync();
  XcdBarrier xb;
  { P p = loadP(); xb = xcd_barrier_post(p.bar, (volatile LAS unsigned*)&xb_words); }
  { P p = loadP(); ph_proj(p, lds); }
  const int kvb = (gridDim.x == 512) ? (((int)blockIdx.x >= 320 && (int)blockIdx.x < 352) ? ((int)blockIdx.x - 320) * 8 : -1) : -2;
  const int vvb = (gridDim.x == 512) ? (((int)blockIdx.x >= 352 && (int)blockIdx.x < 384) ? ((int)blockIdx.x - 352) * 8 : -1) : -2;
  { P p = loadP(); bf16_t* kmem = p.kmemb;
    ph_gemm_bf16(p.memn, DM, p.WmkT, DM, 1024, 512, DM, lds, [=](int m, int n, float v) {
      kmem[((size_t)((m >> 8) * 4 + (n >> 7)) * 256 + (m & 255)) * 128 + (n & 127)] = f2bf(v); }, kvb); }
  { P p = loadP(); bf16_t* vmem = p.vmemT;
    ph_gemm_bf16(p.memn, DM, p.WmvT, DM, 1024, 512, DM, lds, [=](int m, int n, float v) {
      vmem[((size_t)((m >> 8) * 4 + (n >> 7)) * 128 + (n & 127)) * 256 + perm16(m & 255)] = f2bf(v); }, vvb); }
  xcd_barrier(xb);
  { P p = loadP(); ph_compress2(p, lds); }
  { P p = loadP(); ph_sb2(p, lds); }
  xcd_barrier(xb);
  { P p = loadP(); ph_nsa2(p, lds); }
  xcd_barrier(xb);
  { P p = loadP(); float* out = p.out; const float* x = p.x;
    ph_gemm_bf16(p.omix, DM, p.WoutT, DM, T_TOK, DM, DM, lds, [=](int m, int n, float v) { out[(size_t)m * DM + n] = x[(size_t)m * DM + n] + v; }); }
  xcd_barrier(xb);
  { P p = loadP(); ph_rmsnorm(p.out, p.norm_mq, p.hn, T_TOK); }
  xcd_barrier(xb);
  if (blockIdx.x < 256 || gridDim.x < 512) {
    P p = loadP(); bf16_t* qmem = p.qmemb;
    ph_gemm_bf16(p.hn, DM, p.WmqT, DM, T_TOK, 512, DM, lds, [=](int m, int n, float v) { qmem[(size_t)m * 512 + n] = f2bf(v); });
  }
  {
    const int half = (gridDim.x >= 512) ? 256 : 0;
    if ((int)blockIdx.x >= half) {
      const int nwv = ((int)gridDim.x - half) * 4, wid = ((int)blockIdx.x - half) * 4 + (opq(threadIdx.x) >> 6);
      { P p = loadP(); ph_cvt4(p.pu, p.pu8, p.su8, 16384, wid, nwv); }
      { P p = loadP(); ph_cvt4(p.pv, p.pv8, p.sv8, 16384, wid, nwv); }
    }
  }
  xcd_barrier(xb);
  { P p = loadP(); ph_memattn2(p, lds); }
  xcd_barrier(xb);
  { P p = loadP(); float* out = p.out;
    ph_gemm_bf16(p.omem, 512, p.WmoT, 512, T_TOK, DM, 512, lds, [=](int m, int n, float v) { out[(size_t)m * DM + n] += v; }); }
  xcd_barrier(xb);
  { P p = loadP(); ph_rmsnorm(p.out, p.norm_ffn, p.hn, T_TOK); }
  xcd_barrier(xb);
  { P p = loadP(); ph_qp_scores(p, lds); }
  xcd_barrier(xb);
  { P p = loadP(); ph_peer(p, smem); }
}

extern "C" void kernel_launch(void* const* d_in, const int* in_sizes, int n_in, void* d_out, int out_size, void* d_ws,
                              size_t ws_size, hipStream_t stream) {
  P p{};
  p.x = (const float*)d_in[0]; p.mem = (const float*)d_in[1]; p.t5 = (const float*)d_in[2];
  p.norm_mix = (const float*)d_in[3]; p.w_in = (const float*)d_in[4]; p.pos_k = (const float*)d_in[5];
  p.w1_k = (const float*)d_in[6]; p.w2_k = (const float*)d_in[7]; p.pos_v = (const float*)d_in[8];
  p.w1_v = (const float*)d_in[9]; p.w2_v = (const float*)d_in[10]; p.w_out = (const float*)d_in[11];
  p.norm_mq = (const float*)d_in[12]; p.norm_mkv = (const float*)d_in[13]; p.w_mq = (const float*)d_in[14];
  p.w_mk = (const float*)d_in[15]; p.w_mv = (const float*)d_in[16]; p.w_mo = (const float*)d_in[17];
  p.norm_ffn = (const float*)d_in[18]; p.w_pq = (const float*)d_in[19]; p.subk = (const float*)d_in[20];
  p.pu = (const float*)d_in[21]; p.pv = (const float*)d_in[22]; p.norm_final = (const float*)d_in[23];
  p.out = (float*)d_out;
  char* w = (char*)d_ws;
  size_t off = 0;
  auto take = [&](size_t bytes) { char* r = w + off; off += (bytes + 255) & ~(size_t)255; return r; };
  p.bar = (unsigned*)take(XCD_BAR_WORDS * 4);
  p.scores = (float*)take((size_t)T_TOK * DM * 4);
  p.gates = (float*)take((size_t)T_TOK * 24 * 4);
  p.part = (float*)take((size_t)T_TOK * 1024 * 4);
  p.posb = (float*)take(256 * 4);
  p.qn = (bf16_t*)take((size_t)T_TOK * 1024 * 2);
  p.kcin = (bf16_t*)take((size_t)T_TOK * 256 * 2 + 65536);
  p.vcin = (bf16_t*)take((size_t)T_TOK * 256 * 2 + 65536);
  p.ks = (bf16_t*)take((size_t)T_TOK * 256 * 2);
  p.vsT = (bf16_t*)take((size_t)T_TOK * 256 * 2);
  p.kw = (bf16_t*)take((size_t)T_TOK * 256 * 2);
  p.vwT = (bf16_t*)take((size_t)T_TOK * 256 * 2);
  p.kcb = (bf16_t*)take((size_t)8 * 128 * 128 * 2);
  p.vcT = (bf16_t*)take((size_t)8 * 128 * 128 * 2);
  p.c1 = (bf16_t*)take((size_t)16 * 128 * 128 * 2);
  p.w1T = (bf16_t*)take((size_t)2 * 128 * 4096 * 2);
  p.w2T = (bf16_t*)take((size_t)2 * 128 * 128 * 2);
  p.hn = (bf16_t*)take((size_t)T_TOK * DM * 2);
  p.omix = (bf16_t*)take((size_t)T_TOK * DM * 2);
  p.memn = (bf16_t*)take((size_t)1024 * DM * 2);
  p.omem = (bf16_t*)take((size_t)T_TOK * 512 * 2);
  p.WinT = (bf16_t*)take((size_t)5760 * DM * 2);
  p.WoutT = (bf16_t*)take((size_t)DM * DM * 2);
  p.WpqT = (bf16_t*)take((size_t)DM * DM * 2);
  p.WmqT = (bf16_t*)take((size_t)512 * DM * 2);
  p.WmkT = (bf16_t*)take((size_t)512 * DM * 2);
  p.WmvT = (bf16_t*)take((size_t)512 * DM * 2);
  p.WmoT = (bf16_t*)take((size_t)DM * 512 * 2);
  p.qmemb = (bf16_t*)take((size_t)T_TOK * 512 * 2);
  p.kmemb = (bf16_t*)take((size_t)1024 * 512 * 2);
  p.vmemT = (bf16_t*)take((size_t)1024 * 512 * 2);
  p.qsb = (bf16_t*)take((size_t)T_TOK * 1024 * 2);
  p.ksb = (bf16_t*)take((size_t)T_TOK * 1024 * 2);
  p.vsbT = (bf16_t*)take((size_t)T_TOK * 1024 * 2);
  p.pu8 = (unsigned char*)take((size_t)16384 * 1024);
  p.pv8 = (unsigned char*)take((size_t)16384 * 1024);
  p.su8 = (float*)take(16384 * 4);
  p.sv8 = (float*)take(16384 * 4);
  p.subkb = (bf16_t*)take((size_t)16 * 128 * 128 * 2);
  static int grid_blocks = 0;
  if (!grid_blocks) {
    int dev = 0, cus = 0, per_cu = 0;
    (void)hipGetDevice(&dev);
    (void)hipDeviceGetAttribute(&cus, hipDeviceAttributeMultiprocessorCount, dev);
    (void)hipOccupancyMaxActiveBlocksPerMultiprocessor(&per_cu, mega, 256, 0);
    if (per_cu > 2) per_cu = 2;
    if (per_cu < 1) per_cu = 1;
    grid_blocks = cus * per_cu;
  }
  void* args[] = {&p};
  hipError_t e = hipLaunchCooperativeKernel((void*)mega, dim3(grid_blocks), dim3(256), args, 0, stream);
  if (e != hipSuccess) fprintf(stderr, "cooperative launch failed: %s (grid %d)\n", hipGetErrorString(e), grid_blocks);
}
```

```cpp
#include <hip/hip_runtime.h>
#include <hip/hip_cooperative_groups.h>
#include <cstdio>
namespace cg = cooperative_groups;
#include <stdint.h>

#define SEQ 2048
#define NBATCH 4
#define T_TOK 8192
#define DM 2048
#define INC 5656
#define C_QN 0
#define C_KC 1024
#define C_VC 1280
#define C_KS 1536
#define C_VS 1792
#define C_KW 2048
#define C_VW 2304
#define C_GT 2560
#define C_QSB 2584
#define C_KSB 3608
#define C_VSB 4632
#define ATT_SCALE 0.08838834764831845f
#define RMS_EPS 1e-6f

typedef unsigned short bf16_t;
typedef __attribute__((ext_vector_type(8))) short bf16x8;
typedef __attribute__((ext_vector_type(16))) float f32x16;
typedef __attribute__((ext_vector_type(2))) __bf16 bf16v2;
typedef __attribute__((ext_vector_type(4))) unsigned u32x4;

struct P {
  const float *x, *mem, *t5, *norm_mix, *w_in, *pos_k, *w1_k, *w2_k, *pos_v, *w1_v, *w2_v, *w_out,
      *norm_mq, *norm_mkv, *w_mq, *w_mk, *w_mv, *w_mo, *norm_ffn, *w_pq, *subk, *pu, *pv, *norm_final;
  float* out;
  float *scores, *gates, *part, *posb;
  unsigned* bar;
  bf16_t *hn, *omix, *memn, *omem;
  bf16_t *WinT, *WoutT, *WpqT, *WmqT, *WmkT, *WmvT, *WmoT;
  bf16_t *qmemb, *kmemb, *vmemT;
  bf16_t *qsb, *ksb, *vsbT;
  bf16_t* subkb;
  unsigned char *pu8, *pv8;
  float *su8, *sv8;
  bf16_t *qn, *kcin, *vcin, *ks, *vsT, *kw, *vwT, *kcb, *vcT, *c1, *w1T, *w2T;
};

__device__ __forceinline__ int opq(int v) { asm volatile("" : "+v"(v)); return v; }
__device__ __forceinline__ unsigned pack2(float a, float b) {
  bf16v2 r = {(__bf16)a, (__bf16)b};
  return *(unsigned*)&r;
}
__device__ __forceinline__ bf16_t f2bf(float a) {
  __bf16 r = (__bf16)a;
  return *(bf16_t*)&r;
}
__device__ __forceinline__ int perm16(int s) { return (s & ~12) | ((s & 4) << 1) | ((s & 8) >> 1); }
__device__ __forceinline__ float bf2f(bf16_t u) { return __uint_as_float((unsigned)u << 16); }

__device__ __forceinline__ float wave_max(float v) {
  for (int o = 32; o > 0; o >>= 1) v = fmaxf(v, __shfl_xor(v, o));
  return v;
}
__device__ __forceinline__ float wave_sum(float v) {
  for (int o = 32; o > 0; o >>= 1) v += __shfl_xor(v, o);
  return v;
}
__device__ __forceinline__ void wave_argmax(float& v, int& i) {
  for (int o = 32; o > 0; o >>= 1) {
    float ov = __shfl_xor(v, o);
    int oi = __shfl_xor(i, o);
    if (ov > v || (ov == v && oi < i)) { v = ov; i = oi; }
  }
}
__device__ __forceinline__ float gelu_tanh(float x) {
  return 0.5f * x * (1.f + tanhf(0.7978845608028654f * (x + 0.044715f * x * x * x)));
}
__device__ __forceinline__ float gelu_fast(float x) {
  const float y = 1.5957691216057308f * (x + 0.044715f * x * x * x);
  return x / (1.f + __expf(-y));
}
__device__ __forceinline__ int t5_bucket(int n) {
  if (n < 16) return n < 0 ? 0 : n;
  int b = 16;
  b += (n >= 19); b += (n >= 21); b += (n >= 24); b += (n >= 27); b += (n >= 31); b += (n >= 35);
  b += (n >= 40); b += (n >= 46); b += (n >= 52); b += (n >= 59); b += (n >= 67); b += (n >= 77);
  b += (n >= 87); b += (n >= 99); b += (n >= 113);
  return b;
}
__device__ __forceinline__ float log_sigmoid(float x) {
  return fminf(x, 0.f) - log1pf(expf(-fabsf(x)));
}

__device__ __forceinline__ void ph_rmsnorm(const float* src, const float* gain, bf16_t* dst, int rows) {
  int lane = opq(threadIdx.x) & 63, wv = opq(threadIdx.x) >> 6;
  for (int r = blockIdx.x * 4 + wv; r < rows; r += gridDim.x * 4) {
    const float4* s4 = (const float4*)(src + (size_t)r * DM);
    float4 v[8];
    float ss = 0.f;
#pragma unroll
    for (int i = 0; i < 8; ++i) {
      v[i] = s4[i * 64 + lane];
      ss += v[i].x * v[i].x + v[i].y * v[i].y + v[i].z * v[i].z + v[i].w * v[i].w;
    }
    ss = wave_sum(ss);
    float rs = rsqrtf(ss * (1.f / DM) + RMS_EPS);
    uint2* d2 = (uint2*)(dst + (size_t)r * DM);
    const float4* g4 = (const float4*)gain;
#pragma unroll
    for (int i = 0; i < 8; ++i) {
      float4 g = g4[i * 64 + lane];
      uint2 o;
      o.x = pack2(v[i].x * rs * g.x, v[i].y * rs * g.y);
      o.y = pack2(v[i].z * rs * g.z, v[i].w * rs * g.w);
      d2[i * 64 + lane] = o;
    }
  }
}

template <bool CMAP>
__device__ __forceinline__ void ph_transpose(float* smem, const float* W, int K, int N, int Npad, bf16_t* Wt) {
  float (*tl)[65] = (float (*)[65])smem;
  int tid = opq(threadIdx.x);
  int nk = K / 64, nn = Npad / 64;
  for (int tile = blockIdx.x; tile < nk * nn; tile += gridDim.x) {
    int k0 = (tile % nk) * 64, n0 = (tile / nk) * 64;
    int col = tid & 63, rb = tid >> 6;
#pragma unroll 4
    for (int pp = 0; pp < 16; ++pp) {
      int k = pp * 4 + rb;
      float v = 0.f;
      int sc = n0 + col;
      if (CMAP) sc = (sc < 2560) ? sc : (sc < 5632) ? sc + 24 : (sc < 5656) ? sc - 5632 + 2560 : N;
      if (sc < N) v = W[(size_t)(k0 + k) * N + sc];
      tl[k][col] = v;
    }
    __syncthreads();
    int n = tid >> 2, kc = (tid & 3) * 16;
    unsigned w[8];
#pragma unroll
    for (int i = 0; i < 8; ++i) w[i] = pack2(tl[kc + 2 * i][n], tl[kc + 2 * i + 1][n]);
    uint4* dst = (uint4*)(Wt + (size_t)(n0 + n) * K + k0 + kc);
    dst[0] = make_uint4(w[0], w[1], w[2], w[3]);
    dst[1] = make_uint4(w[4], w[5], w[6], w[7]);
    __syncthreads();
  }
}

__device__ __forceinline__ int lds_off(int row, int chunk) { return row * 128 + ((chunk ^ ((row >> 1) & 7)) << 4); }

template <bool TR, class Epi>
__device__ __forceinline__ void gemm_tile_bf16(const bf16_t* xp, int ldx, const bf16_t* yp, int ldy, int K, char* lds,
                                               Epi epi) {
  const int tid = opq(threadIdx.x), lane = tid & 63, wv = tid >> 6;
  const int wr = wv >> 1, wc = wv & 1;
  char* lx = lds;
  char* ly = lds + 16384;
  f32x16 acc[2][2];
#pragma unroll
  for (int i = 0; i < 2; ++i)
#pragma unroll
    for (int j = 0; j < 2; ++j)
#pragma unroll
      for (int r = 0; r < 16; ++r) acc[i][j][r] = 0.f;
  const int srow = tid >> 3, sch = tid & 7;
  const bf16_t* xg = xp + (size_t)srow * ldx + sch * 8;
  const bf16_t* yg = yp + (size_t)srow * ldy + sch * 8;
  const size_t x32 = (size_t)32 * ldx, y32 = (size_t)32 * ldy;
  uint4 sx0 = *(const uint4*)(xg), sx1 = *(const uint4*)(xg + x32), sx2 = *(const uint4*)(xg + 2 * x32),
        sx3 = *(const uint4*)(xg + 3 * x32);
  uint4 sy0 = *(const uint4*)(yg), sy1 = *(const uint4*)(yg + y32), sy2 = *(const uint4*)(yg + 2 * y32),
        sy3 = *(const uint4*)(yg + 3 * y32);
  const int so0 = lds_off(srow, sch), so1 = lds_off(32 + srow, sch), so2 = lds_off(64 + srow, sch),
            so3 = lds_off(96 + srow, sch);
  for (int k0 = 0; k0 < K; k0 += 64) {
    __syncthreads();
    *(uint4*)(lx + so0) = sx0; *(uint4*)(lx + so1) = sx1; *(uint4*)(lx + so2) = sx2; *(uint4*)(lx + so3) = sx3;
    *(uint4*)(ly + so0) = sy0; *(uint4*)(ly + so1) = sy1; *(uint4*)(ly + so2) = sy2; *(uint4*)(ly + so3) = sy3;
    __syncthreads();
    if (k0 + 64 < K) {
      const bf16_t* xn = xg + k0 + 64;
      const bf16_t* yn = yg + k0 + 64;
      sx0 = *(const uint4*)(xn); sx1 = *(const uint4*)(xn + x32); sx2 = *(const uint4*)(xn + 2 * x32);
      sx3 = *(const uint4*)(xn + 3 * x32);
      sy0 = *(const uint4*)(yn); sy1 = *(const uint4*)(yn + y32); sy2 = *(const uint4*)(yn + 2 * y32);
      sy3 = *(const uint4*)(yn + 3 * y32);
    }
#pragma unroll
    for (int kk = 0; kk < 4; ++kk) {
      bf16x8 a[2], b[2];
      const int ch = kk * 2 + (lane >> 5);
#pragma unroll
      for (int i = 0; i < 2; ++i) {
        a[i] = *(const bf16x8*)((TR ? ly : lx) + lds_off(wr * 64 + i * 32 + (lane & 31), ch));
        b[i] = *(const bf16x8*)((TR ? lx : ly) + lds_off(wc * 64 + i * 32 + (lane & 31), ch));
      }
#pragma unroll
      for (int i = 0; i < 2; ++i)
#pragma unroll
        for (int j = 0; j < 2; ++j) acc[i][j] = __builtin_amdgcn_mfma_f32_32x32x16_bf16(a[i], b[j], acc[i][j], 0, 0, 0);
    }
  }
  int lane2 = lane;
  asm volatile("" : "+v"(lane2));
#pragma unroll
  for (int i = 0; i < 2; ++i)
#pragma unroll
    for (int j = 0; j < 2; ++j)
#pragma unroll
      for (int r = 0; r < 16; ++r) {
        int rr = wr * 64 + i * 32 + (r & 3) + 8 * (r >> 2) + 4 * (lane2 >> 5);
        int cc = wc * 64 + j * 32 + (lane2 & 31);
        epi(rr, cc, acc[i][j][r]);
      }
}

template <class Epi>
__device__ __forceinline__ void ph_gemm_bf16(const bf16_t* A, int lda, const bf16_t* Wt, int ldw, int M, int N, int K,
                                             char* lds, Epi epi, int vblock = -2) {
  const int ntm = M / 128, ntn = N / 128;
  const int npm = (ntm + 7) / 8, npn = (ntn + 7) / 8;
  const int nslots = ((npm * npn * 64 + 511) / 512) * 512;
  if (vblock == -1) return;
  for (int u = (vblock >= 0 ? vblock : (int)blockIdx.x); u < nslots; u += gridDim.x) {
    int v = (u & 7) * 64 + ((u >> 3) & 63) + (u & ~511);
    int patch = v >> 6, w = v & 63;
    int tm = (patch % npm) * 8 + (w & 7);
    int tn = (patch / npm) * 8 + (w >> 3);
    if (tm >= ntm || tn >= ntn) continue;
    const int m0 = tm * 128, n0 = tn * 128;
    gemm_tile_bf16<false>(A + (size_t)m0 * lda, lda, Wt + (size_t)n0 * ldw, ldw, K, lds,
                          [&](int r, int c, float val) { epi(m0 + r, n0 + c, val); });
  }
}

__device__ __forceinline__ void ph_proj(const P& p, char* lds) {
  const int ntm = T_TOK / 128, ntn = 5760 / 128;
  const int npm = (ntm + 7) / 8, npn = (ntn + 7) / 8;
  const int nslots = ((npm * npn * 64 + 511) / 512) * 512;
  for (int u = blockIdx.x; u < nslots; u += gridDim.x) {
    int v = (u & 7) * 64 + ((u >> 3) & 63) + (u & ~511);
    int patch = v >> 6, w = v & 63;
    int tm = (patch % npm) * 8 + (w & 7);
    int tn = (patch / npm) * 8 + (w >> 3);
    if (tm >= ntm || tn >= ntn) continue;
    const int m0 = tm * 128, n0 = tn * 128;
    const int b = m0 >> 11, sl = m0 & 2047;
    const bf16_t* A = p.hn + (size_t)m0 * DM;
    const bf16_t* W = p.WinT + (size_t)n0 * DM;
    if (n0 < 1024) {
      bf16_t* q = p.qn + (size_t)m0 * 1024 + n0;
      gemm_tile_bf16<false>(A, DM, W, DM, DM, lds, [&](int r, int c, float val) { q[(size_t)r * 1024 + c] = f2bf(val); });
    } else if (n0 < 2560) {
      const int seg = (n0 - 1024) >> 8, g = ((n0 - 1024) >> 7) & 1;
      if (seg == 3 || seg == 5) {
        bf16_t* vd = (seg == 3 ? p.vsT : p.vwT) + ((size_t)(b * 2 + g) * 128) * SEQ + sl;
        gemm_tile_bf16<true>(A, DM, W, DM, DM, lds, [&](int r, int c, float val) { vd[(size_t)r * SEQ + perm16(c)] = f2bf(val); });
      } else {
        bf16_t* base = (seg == 0) ? p.kcin : (seg == 1) ? p.vcin : (seg == 2) ? p.ks : p.kw;
        bf16_t* kd = base + ((size_t)(b * 2 + g) * SEQ + sl) * 128;
        gemm_tile_bf16<false>(A, DM, W, DM, DM, lds, [&](int r, int c, float val) { kd[(size_t)r * 128 + c] = f2bf(val); });
      }
    } else if (n0 < 3584) {
      bf16_t* q = p.qsb + (size_t)m0 * 1024 + (n0 - 2560);
      gemm_tile_bf16<false>(A, DM, W, DM, DM, lds, [&](int r, int c, float val) { q[(size_t)r * 1024 + c] = f2bf(val); });
    } else if (n0 < 4608) {
      bf16_t* kd = p.ksb + ((size_t)(b * 8 + ((n0 - 3584) >> 7)) * SEQ + sl) * 128;
      gemm_tile_bf16<false>(A, DM, W, DM, DM, lds, [&](int r, int c, float val) { kd[(size_t)r * 128 + c] = f2bf(val); });
    } else if (n0 < 5632) {
      bf16_t* vd = p.vsbT + ((size_t)(b * 8 + ((n0 - 4608) >> 7)) * 128) * SEQ + sl;
      gemm_tile_bf16<true>(A, DM, W, DM, DM, lds, [&](int r, int c, float val) { vd[(size_t)r * SEQ + perm16(c)] = f2bf(val); });
    } else {
      float* gd = p.gates + (size_t)m0 * 24;
      gemm_tile_bf16<false>(A, DM, W, DM, DM, lds, [&](int r, int c, float val) { if (c < 24) gd[(size_t)r * 24 + c] = val; });
    }
  }
}

__device__ __forceinline__ void ph_posb(const P& p) {
  const int lane = opq(threadIdx.x) & 63, wv = opq(threadIdx.x) >> 6;
  for (int o = blockIdx.x * 4 + wv; o < 256; o += gridDim.x * 4) {
    const int which = o >> 7, n = o & 127;
    const float* pos = which ? p.pos_v : p.pos_k;
    const float* w1 = which ? p.w1_v : p.w1_k;
    float acc = 0.f;
    for (int k = lane; k < 4096; k += 64) acc += pos[k] * w1[(size_t)k * 128 + n];
    acc = wave_sum(acc);
    if (lane == 0) p.posb[o] = acc;
  }
}

__device__ __forceinline__ void ph_compress2(const P& p, char* lds) {
  for (int item = blockIdx.x; item < 16; item += gridDim.x) {
    const int which = item >> 3, bg = item & 7;
    const bf16_t* src = (which ? p.vcin : p.kcin) + (size_t)bg * SEQ * 128;
    const bf16_t* w1t = p.w1T + (size_t)which * 128 * 4096;
    const bf16_t* w2t = p.w2T + (size_t)which * 128 * 128;
    const float* posb = p.posb + which * 128;
    bf16_t* c1 = p.c1 + (size_t)item * 128 * 128;
    gemm_tile_bf16<false>(src, 2048, w1t, 4096, 4096, lds, [&](int r, int c, float val) {
      c1[r * 128 + c] = f2bf(gelu_fast(val + posb[c])); });
    __threadfence_block();
    __syncthreads();
    if (which == 0) {
      bf16_t* kd = p.kcb + (size_t)bg * 128 * 128;
      gemm_tile_bf16<false>(c1, 128, w2t, 128, 128, lds, [&](int r, int c, float val) { kd[r * 128 + c] = f2bf(val); });
    } else {
      bf16_t* vd = p.vcT + (size_t)bg * 128 * 128;
      gemm_tile_bf16<true>(c1, 128, w2t, 128, 128, lds, [&](int r, int c, float val) { vd[r * 128 + perm16(c)] = f2bf(val); });
    }
  }
}

#define NEG_BIG (-1e30f)

struct KVRegs { u32x4 k0, k1, k2, k3, v0, v1, v2, v3; };

__device__ __forceinline__ int koff(int row, int chunk) { return row * 256 + ((chunk ^ (row & 15)) << 4); }

__device__ __forceinline__ void kv_load(KVRegs& r, const bf16_t* kp, int ldk, const bf16_t* vp, int ldv) {
  const int tid = opq(threadIdx.x);
  const bf16_t* kg = kp + (size_t)(tid >> 4) * ldk + (tid & 15) * 8;
  r.k0 = *(const u32x4*)kg;
  r.k1 = *(const u32x4*)(kg + (size_t)16 * ldk);
  r.k2 = *(const u32x4*)(kg + (size_t)32 * ldk);
  r.k3 = *(const u32x4*)(kg + (size_t)48 * ldk);
  const bf16_t* vg = vp + (size_t)(tid >> 3) * ldv + (tid & 7) * 8;
  r.v0 = *(const u32x4*)vg;
  r.v1 = *(const u32x4*)(vg + (size_t)32 * ldv);
  r.v2 = *(const u32x4*)(vg + (size_t)64 * ldv);
  r.v3 = *(const u32x4*)(vg + (size_t)96 * ldv);
}
__device__ __forceinline__ void kv_store(const KVRegs& r, char* lk, char* lv) {
  const int tid = opq(threadIdx.x);
  const int row = tid >> 4, ch = tid & 15;
  *(u32x4*)(lk + koff(row, ch)) = r.k0;
  *(u32x4*)(lk + koff(row + 16, ch)) = r.k1;
  *(u32x4*)(lk + koff(row + 32, ch)) = r.k2;
  *(u32x4*)(lk + koff(row + 48, ch)) = r.k3;
  const int vr = tid >> 3, vc = tid & 7;
  *(u32x4*)(lv + lds_off(vr, vc)) = r.v0;
  *(u32x4*)(lv + lds_off(vr + 32, vc)) = r.v1;
  *(u32x4*)(lv + lds_off(vr + 64, vc)) = r.v2;
  *(u32x4*)(lv + lds_off(vr + 96, vc)) = r.v3;
}

struct QFrag { bf16x8 f0, f1, f2, f3, f4, f5, f6, f7; };
__device__ __forceinline__ void q_load(QFrag& q, const bf16_t* qrow) {
  const int h = (opq(threadIdx.x) & 63) >> 5;
  const bf16x8* p8 = (const bf16x8*)(qrow + 8 * h);
  q.f0 = p8[0]; q.f1 = p8[2]; q.f2 = p8[4]; q.f3 = p8[6]; q.f4 = p8[8]; q.f5 = p8[10]; q.f6 = p8[12]; q.f7 = p8[14];
}

__device__ __forceinline__ void qk_tile(const QFrag& q, const char* lk, f32x16& s0, f32x16& s1) {
  const int lane = opq(threadIdx.x) & 63, row = lane & 31, h = lane >> 5;
#pragma unroll
  for (int r = 0; r < 16; ++r) { s0[r] = 0.f; s1[r] = 0.f; }
#define QK_STEP(kk, qf)                                                                  \
  {                                                                                      \
    bf16x8 a0 = *(const bf16x8*)(lk + koff(row, 2 * (kk) + h));                          \
    bf16x8 a1 = *(const bf16x8*)(lk + koff(row + 32, 2 * (kk) + h));                     \
    s0 = __builtin_amdgcn_mfma_f32_32x32x16_bf16(a0, qf, s0, 0, 0, 0);                   \
    s1 = __builtin_amdgcn_mfma_f32_32x32x16_bf16(a1, qf, s1, 0, 0, 0);                   \
  }
  QK_STEP(0, q.f0) QK_STEP(1, q.f1) QK_STEP(2, q.f2) QK_STEP(3, q.f3)
  QK_STEP(4, q.f4) QK_STEP(5, q.f5) QK_STEP(6, q.f6) QK_STEP(7, q.f7)
#undef QK_STEP
}

__device__ __forceinline__ bf16x8 pack8(const f32x16& p, const int base) {
  u32x4 u;
  u[0] = pack2(p[base + 0], p[base + 1]);
  u[1] = pack2(p[base + 2], p[base + 3]);
  u[2] = pack2(p[base + 4], p[base + 5]);
  u[3] = pack2(p[base + 6], p[base + 7]);
  return __builtin_bit_cast(bf16x8, u);
}

struct OAcc { f32x16 o0, o1, o2, o3; };
__device__ __forceinline__ void oacc_zero(OAcc& o) {
#pragma unroll
  for (int r = 0; r < 16; ++r) { o.o0[r] = 0.f; o.o1[r] = 0.f; o.o2[r] = 0.f; o.o3[r] = 0.f; }
}
__device__ __forceinline__ void oacc_scale(OAcc& o, float a) {
#pragma unroll
  for (int r = 0; r < 16; ++r) { o.o0[r] *= a; o.o1[r] *= a; o.o2[r] *= a; o.o3[r] *= a; }
}

__device__ __forceinline__ void pv_tile(OAcc& o, const char* lv, const f32x16& p0, const f32x16& p1) {
  const int lane = opq(threadIdx.x) & 63, row = lane & 31, h = lane >> 5;
  const bf16x8 pf0 = pack8(p0, 0), pf1 = pack8(p0, 8), pf2 = pack8(p1, 0), pf3 = pack8(p1, 8);
#define PV_ROW(dd, acc)                                                                                      \
  {                                                                                                          \
    acc = __builtin_amdgcn_mfma_f32_32x32x16_bf16(*(const bf16x8*)(lv + lds_off(32 * (dd) + row, 0 + h)), pf0, acc, 0, 0, 0); \
    acc = __builtin_amdgcn_mfma_f32_32x32x16_bf16(*(const bf16x8*)(lv + lds_off(32 * (dd) + row, 2 + h)), pf1, acc, 0, 0, 0); \
    acc = __builtin_amdgcn_mfma_f32_32x32x16_bf16(*(const bf16x8*)(lv + lds_off(32 * (dd) + row, 4 + h)), pf2, acc, 0, 0, 0); \
    acc = __builtin_amdgcn_mfma_f32_32x32x16_bf16(*(const bf16x8*)(lv + lds_off(32 * (dd) + row, 6 + h)), pf3, acc, 0, 0, 0); \
  }
  PV_ROW(0, o.o0) PV_ROW(1, o.o1) PV_ROW(2, o.o2) PV_ROW(3, o.o3)
#undef PV_ROW
}

__device__ __forceinline__ void softmax_tile(f32x16& s0, f32x16& s1, float& m, float& l, OAcc& o) {
  float mx = NEG_BIG;
#pragma unroll
  for (int r = 0; r < 16; ++r) mx = fmaxf(mx, fmaxf(s0[r], s1[r]));
  mx = fmaxf(mx, __shfl_xor(mx, 32));
  const float mn = fmaxf(m, mx);
  const float alpha = __expf(m - mn);
  float ls = 0.f;
#pragma unroll
  for (int r = 0; r < 16; ++r) {
    float a = (s0[r] > -1e29f) ? __expf(s0[r] - mn) : 0.f;
    float b = (s1[r] > -1e29f) ? __expf(s1[r] - mn) : 0.f;
    s0[r] = a; s1[r] = b;
    ls += a + b;
  }
  ls += __shfl_xor(ls, 32);
  l = l * alpha + ls;
  m = mn;
  if (__any(alpha != 1.f)) oacc_scale(o, alpha);
}

template <class F>
__device__ __forceinline__ void oacc_foreach(const OAcc& o, F f) {
  const int h = (opq(threadIdx.x) & 63) >> 5;
#pragma unroll
  for (int rho = 0; rho < 4; ++rho) {
    f(0 + 8 * rho + 4 * h, o.o0[4 * rho], o.o0[4 * rho + 1], o.o0[4 * rho + 2], o.o0[4 * rho + 3]);
    f(32 + 8 * rho + 4 * h, o.o1[4 * rho], o.o1[4 * rho + 1], o.o1[4 * rho + 2], o.o1[4 * rho + 3]);
    f(64 + 8 * rho + 4 * h, o.o2[4 * rho], o.o2[4 * rho + 1], o.o2[4 * rho + 2], o.o2[4 * rho + 3]);
    f(96 + 8 * rho + 4 * h, o.o3[4 * rho], o.o3[4 * rho + 1], o.o3[4 * rho + 2], o.o3[4 * rho + 3]);
  }
}

__device__ __forceinline__ void ph_memattn2(const P& p, char* lds) {
  char* lk = lds;
  char* lv = lds + 16384;
  const int lane = opq(threadIdx.x) & 63, wv = opq(threadIdx.x) >> 6;
  for (int item = blockIdx.x; item < NBATCH * 4 * (SEQ / 128); item += gridDim.x) {
    const int tb = item % (SEQ / 128);
    const int bh = item / (SEQ / 128);
    const int b = bh >> 2, hd = bh & 3;
    const int t = tb * 128 + wv * 32 + (lane & 31);
    QFrag q;
    q_load(q, p.qmemb + (size_t)(b * SEQ + t) * 512 + hd * 128);
    const bf16_t* kb = p.kmemb + (size_t)bh * 256 * 128;
    const bf16_t* vb = p.vmemT + (size_t)bh * 128 * 256;
    OAcc o;
    oacc_zero(o);
    float m = NEG_BIG, l = 0.f;
    KVRegs kv;
    kv_load(kv, kb, 128, vb, 256);
#pragma unroll 1
    for (int ti = 0; ti < 4; ++ti) {
      __syncthreads();
      kv_store(kv, lk, lv);
      __syncthreads();
      {
        const int tn = (ti + 1 < 4) ? ti + 1 : 3;
        kv_load(kv, kb + (size_t)tn * 64 * 128, 128, vb + tn * 64, 256);
      }
      f32x16 s0, s1;
      qk_tile(q, lk, s0, s1);
#pragma unroll
      for (int r = 0; r < 16; ++r) { s0[r] *= ATT_SCALE; s1[r] *= ATT_SCALE; }
      softmax_tile(s0, s1, m, l, o);
      pv_tile(o, lv, s0, s1);
    }
    const float il = 1.f / l;
    const int t2 = tb * 128 + (opq(threadIdx.x) >> 6) * 32 + (opq(threadIdx.x) & 31);
    bf16_t* orow = p.omem + (size_t)(b * SEQ + t2) * 512 + hd * 128;
    oacc_foreach(o, [&](int d, float v0, float v1, float v2, float v3) {
      uint2 u;
      u.x = pack2(v0 * il, v1 * il);
      u.y = pack2(v2 * il, v3 * il);
      *(uint2*)(orow + d) = u;
    });
  }
}

__device__ __forceinline__ void ph_sb2(const P& p, char* lds) {
  char* lk = lds;
  char* lv = lds + 16384;
  const int lane = opq(threadIdx.x) & 63, wv = opq(threadIdx.x) >> 6, hh = lane >> 5;
  const int sb_skip = (gridDim.x > 32) ? 16 : 0;
  if ((int)blockIdx.x < sb_skip) return;
  for (int item = (int)blockIdx.x - sb_skip; item < NBATCH * 8 * (SEQ / 128); item += (int)gridDim.x - sb_skip) {
    const int tb = (SEQ / 128 - 1) - (item % (SEQ / 128));
    const int bh = item / (SEQ / 128);
    const int b = bh >> 3, hd = bh & 7;
    const int t0 = tb * 128;
    const int t = t0 + wv * 32 + (lane & 31);
    QFrag q;
    q_load(q, p.qsb + (size_t)(b * SEQ + t) * 1024 + hd * 128);
    const bf16_t* kb = p.ksb + (size_t)bh * SEQ * 128;
    const bf16_t* vb = p.vsbT + (size_t)bh * 128 * SEQ;
    OAcc o;
    oacc_zero(o);
    float carry = 0.f;
    const int jhi = (t0 >> 6) + 1;
    const int jw = (t0 + wv * 32 + 30) >> 6;
    KVRegs kv;
    kv_load(kv, kb + (size_t)jhi * 64 * 128, 128, vb + jhi * 64, SEQ);
    volatile unsigned* dflag = (volatile unsigned*)(lds + 32768);
    __syncthreads();
    if (opq(threadIdx.x) < 4) dflag[opq(threadIdx.x)] = 0u;
    for (int j = jhi; j >= 0; --j) {
      __syncthreads();
      if ((dflag[0] & dflag[1] & dflag[2] & dflag[3]) != 0u) break;
      kv_store(kv, lk, lv);
      __syncthreads();
      const int jn = (j > 0) ? j - 1 : 0;
      if (j > jw) kv_load(kv, kb + (size_t)jn * 64 * 128, 128, vb + jn * 64, SEQ);
      if (j <= jw) {
        f32x16 z0, z1;
        qk_tile(q, lk, z0, z1);
        const int sbase = j * 64 + 4 * hh;
        float gt[8];
        f32x16 l0, l1;
#pragma unroll
        for (int r = 0; r < 16; ++r) {
          const int so = sbase + 8 * (r >> 2) + (r & 3);
          {
            const float z = z0[r] * ATT_SCALE;
            const bool valid = so < t;
            const float lsp = fminf(z, 0.f) - __logf(1.f + __expf(-fabsf(z)));
            l0[r] = valid ? (lsp - z) : 0.f;
            z0[r] = valid ? z : NEG_BIG;
          }
          {
            const float z = z1[r] * ATT_SCALE;
            const bool valid = so + 32 < t;
            const float lsp = fminf(z, 0.f) - __logf(1.f + __expf(-fabsf(z)));
            l1[r] = valid ? (lsp - z) : 0.f;
            z1[r] = valid ? z : NEG_BIG;
          }
        }
#pragma unroll
        for (int rho = 0; rho < 4; ++rho) {
          gt[rho] = (l0[4 * rho] + l0[4 * rho + 1]) + (l0[4 * rho + 2] + l0[4 * rho + 3]);
          gt[4 + rho] = (l1[4 * rho] + l1[4 * rho + 1]) + (l1[4 * rho + 2] + l1[4 * rho + 3]);
        }
        float ag[8];
        float run = 0.f;
#pragma unroll
        for (int k = 7; k >= 0; --k) {
          const float pg = __shfl_xor(gt[k], 32);
          ag[k] = carry + run + (hh == 0 ? pg : 0.f);
          run += gt[k] + pg;
        }
        carry += run;
#pragma unroll
        for (int rho = 0; rho < 4; ++rho) {
          {
            const float x3 = l0[4 * rho + 3], x23 = x3 + l0[4 * rho + 2], x123 = x23 + l0[4 * rho + 1];
            const float g = ag[rho];
            z0[4 * rho + 0] = __expf((l0[4 * rho + 0] + z0[4 * rho + 0]) + (g + x123));
            z0[4 * rho + 1] = __expf((l0[4 * rho + 1] + z0[4 * rho + 1]) + (g + x23));
            z0[4 * rho + 2] = __expf((l0[4 * rho + 2] + z0[4 * rho + 2]) + (g + x3));
            z0[4 * rho + 3] = __expf((l0[4 * rho + 3] + z0[4 * rho + 3]) + g);
          }
          {
            const float x3 = l1[4 * rho + 3], x23 = x3 + l1[4 * rho + 2], x123 = x23 + l1[4 * rho + 1];
            const float g = ag[4 + rho];
            z1[4 * rho + 0] = __expf((l1[4 * rho + 0] + z1[4 * rho + 0]) + (g + x123));
            z1[4 * rho + 1] = __expf((l1[4 * rho + 1] + z1[4 * rho + 1]) + (g + x23));
            z1[4 * rho + 2] = __expf((l1[4 * rho + 2] + z1[4 * rho + 2]) + (g + x3));
            z1[4 * rho + 3] = __expf((l1[4 * rho + 3] + z1[4 * rho + 3]) + g);
          }
        }
        kv_load(kv, kb + (size_t)jn * 64 * 128, 128, vb + jn * 64, SEQ);
        pv_tile(o, lv, z0, z1);
        if (__all(carry < -104.f) && (opq(threadIdx.x) & 63) == 0) dflag[wv] = 1u;
      }
    }
    int t2 = t;
    asm volatile("" : "+v"(t2));
    bf16_t* orow = p.omix + (size_t)(b * SEQ + t2) * DM + 1024 + hd * 128;
    oacc_foreach(o, [&](int d, float v0, float v1, float v2, float v3) {
      uint2 u;
      u.x = pack2(v0, v1);
      u.y = pack2(v2, v3);
      *(uint2*)(orow + d) = u;
    });
  }
}

#define NSA_IMP 32768
#define NSA_KEYS 49152
#define NSA_SELM 53504
#define NSA_LUT 53632
__device__ __forceinline__ void ph_nsa2(const P& p, char* lds) {
  typedef __attribute__((ext_vector_type(4))) float f32x4;
  char* lk = lds;
  char* lv = lds + 16384;
  float* imp = (float*)(lds + NSA_IMP);
  float* keys = (float*)(lds + NSA_KEYS);
  unsigned* selm = (unsigned*)(lds + NSA_SELM);
  const int tid = opq(threadIdx.x), lane = tid & 63, wv = tid >> 6, hh = lane >> 5, ql = lane & 31;
  float* lut = (float*)(lds + NSA_LUT) + wv * 128;
  for (int item = blockIdx.x; item < NBATCH * 2 * (SEQ / 32); item += gridDim.x) {
    const int tt = (item < 256) ? (SEQ / 32 - 1) - (item % (SEQ / 32)) : (item % (SEQ / 32));
    const int bg = item / (SEQ / 32);
    const int b = bg >> 1, g = bg & 1;
    const int h = g * 4 + wv;
    const int t0 = tt * 32, tq = t0 + ql, cur = t0 >> 6;
    __syncthreads();
    QFrag q;
    q_load(q, p.qn + (size_t)(b * SEQ + tq) * 1024 + h * 128);
    {
      const int lo = opq(lane);
      lut[lo] = p.t5[t5_bucket(lo) * 8 + h];
      lut[lo + 64] = p.t5[t5_bucket(lo + 64) * 8 + h];
    }
#pragma unroll
    for (int i = 0; i < 16; ++i) imp[i * 256 + tid] = 0.f;
    if (tid < 32) selm[tid] = 0u;
    const float* grow = p.gates + (size_t)(b * SEQ + tq) * 24 + h * 3;
    float* prow = p.part + (size_t)(b * SEQ + tq) * 1024 + h * 128;
    OAcc o;
    float m, l;
    KVRegs kv;
    {
      const bf16_t* kb = p.kcb + (size_t)bg * 128 * 128;
      const bf16_t* vb = p.vcT + (size_t)bg * 128 * 128;
      oacc_zero(o);
      m = NEG_BIG; l = 0.f;
      kv_load(kv, kb, 128, vb, 128);
      __syncthreads();
      kv_store(kv, lk, lv);
      __syncthreads();
      f32x16 x0, x1;
      qk_tile(q, lk, x0, x1);
      int tqv = tq;
      asm volatile("" : "+v"(tqv));
      tqv -= 64 * hh;
      if (t0 >= 1152) {
        const float b31 = lut[127];
#pragma unroll
        for (int r = 0; r < 16; ++r) { x0[r] = x0[r] * ATT_SCALE + b31; x1[r] = x1[r] * ATT_SCALE + b31; }
      } else {
#pragma unroll
        for (int r = 0; r < 16; ++r) {
          const int c = 8 * (r >> 2) + (r & 3);
          const int d0 = tqv - 16 * c - 31, d1 = d0 - 512;
          x0[r] = (d0 >= 0) ? x0[r] * ATT_SCALE + lut[min(d0, 127)] : NEG_BIG;
          x1[r] = (d1 >= 0) ? x1[r] * ATT_SCALE + lut[min(d1, 127)] : NEG_BIG;
        }
      }
      softmax_tile(x0, x1, m, l, o);
      const float m0 = m;
      pv_tile(o, lv, x0, x1);
      f32x16 z0, z1;
#pragma unroll
      for (int r = 0; r < 16; ++r) { z0[r] = 0.f; z1[r] = 0.f; }
      if (t0 >= 1024) {
        kv_load(kv, kb + 64 * 128, 128, vb + 64, 128);
        __syncthreads();
        kv_store(kv, lk, lv);
        __syncthreads();
        qk_tile(q, lk, z0, z1);
        asm volatile("" : "+v"(tqv));
#pragma unroll
        for (int r = 0; r < 16; ++r) {
          const int c = 64 + 8 * (r >> 2) + (r & 3);
          const int d0 = tqv - 16 * c - 31, d1 = d0 - 512;
          z0[r] = (d0 >= 0) ? z0[r] * ATT_SCALE + lut[min(d0, 127)] : NEG_BIG;
          z1[r] = (d1 >= 0) ? z1[r] * ATT_SCALE + lut[min(d1, 127)] : NEG_BIG;
        }
        softmax_tile(z0, z1, m, l, o);
        pv_tile(o, lv, z0, z1);
      }
      const float inv = 1.f / fmaxf(l, 1e-20f);
      const float c0 = __expf(m0 - m) * inv;
#pragma unroll
      for (int r = 0; r < 16; ++r) {
        const int c = 8 * (r >> 2) + (r & 3) + 4 * hh;
        if (x0[r] != 0.f) atomicAdd(&imp[(c) * 32 + ql], x0[r] * c0);
        if (x1[r] != 0.f) atomicAdd(&imp[(c + 32) * 32 + ql], x1[r] * c0);
        if (z0[r] != 0.f) atomicAdd(&imp[(c + 64) * 32 + ql], z0[r] * inv);
        if (z1[r] != 0.f) atomicAdd(&imp[(c + 96) * 32 + ql], z1[r] * inv);
      }
      const float gs = inv / (1.f + __expf(-grow[0]));
      oacc_foreach(o, [&](int d, float v0, float v1, float v2, float v3) {
        f32x4 u = {v0 * gs, v1 * gs, v2 * gs, v3 * gs};
        *(f32x4*)(prow + d) = u;
      });
    }
    __syncthreads();
    {
      const int tido = opq(tid);
      const int qq = tido & 31, jg = tido >> 5;
#pragma unroll
      for (int jj = 0; jj < 4; ++jj) {
        const int j = jg * 4 + jj;
        float v = imp[(4 * j) * 32 + qq] + imp[(4 * j + 1) * 32 + qq] + imp[(4 * j + 2) * 32 + qq] + 0.5f * imp[(4 * j + 3) * 32 + qq];
        if (j > 0) v += 0.5f * imp[(4 * j - 1) * 32 + qq];
        const bool forced = (j == 0) || (j == cur) || (j == cur - 1);
        keys[qq * 33 + j] = forced ? 1e9f : ((j <= cur) ? v : -1e9f);
      }
      __syncthreads();
      unsigned bits = 0u;
#pragma unroll
      for (int jj = 0; jj < 4; ++jj) {
        const int j = jg * 4 + jj;
        const float kj = keys[qq * 33 + j];
        int rank = 0;
        for (int i = 0; i < 32; ++i) {
          const float ki = keys[qq * 33 + i];
          rank += (ki > kj || (ki == kj && i < j)) ? 1 : 0;
        }
        if (rank < 16 && j <= cur) bits |= 1u << j;
      }
      atomicOr(&selm[qq], bits);
      __syncthreads();
    }
    const unsigned mysel = selm[ql];
    unsigned um = mysel;
#pragma unroll
    for (int o2 = 16; o2 > 0; o2 >>= 1) um |= (unsigned)__shfl_xor((int)um, o2);
    um = (unsigned)__builtin_amdgcn_readfirstlane((int)um);
    {
      const bf16_t* kb = p.ks + (size_t)bg * SEQ * 128;
      const bf16_t* vb = p.vsT + (size_t)bg * 128 * SEQ;
      oacc_zero(o);
      m = NEG_BIG; l = 0.f;
      unsigned rem = um;
      int j = __builtin_ctz(rem);
      kv_load(kv, kb + (size_t)j * 64 * 128, 128, vb + j * 64, SEQ);
      while (rem) {
        j = __builtin_ctz(rem);
        rem &= rem - 1;
        const int jn = rem ? __builtin_ctz(rem) : j;
        __syncthreads();
        kv_store(kv, lk, lv);
        __syncthreads();
        f32x16 s0, s1;
        qk_tile(q, lk, s0, s1);
        const bool selq = (mysel >> j) & 1u;
        int tqv = tq;
        asm volatile("" : "+v"(tqv));
        if (j * 64 + 63 + 113 <= t0) {
          const float sc = selq ? ATT_SCALE : 0.f, bb = selq ? lut[127] : NEG_BIG;
#pragma unroll
          for (int r = 0; r < 16; ++r) { s0[r] = s0[r] * sc + bb; s1[r] = s1[r] * sc + bb; }
        } else {
#pragma unroll
          for (int r = 0; r < 16; ++r) {
            const int d0 = tqv - (j * 64 + 8 * (r >> 2) + (r & 3) + 4 * hh), d1 = d0 - 32;
            s0[r] = (selq && d0 >= 0) ? s0[r] * ATT_SCALE + lut[min(d0, 127)] : NEG_BIG;
            s1[r] = (selq && d1 >= 0) ? s1[r] * ATT_SCALE + lut[min(d1, 127)] : NEG_BIG;
          }
        }
        kv_load(kv, kb + (size_t)jn * 64 * 128, 128, vb + jn * 64, SEQ);
        softmax_tile(s0, s1, m, l, o);
        pv_tile(o, lv, s0, s1);
      }
      const float gs = 1.f / (fmaxf(l, 1e-20f) * (1.f + __expf(-grow[1])));
      int qo = ql;
      asm volatile("" : "+v"(qo));
      float* pr2 = p.part + (size_t)(b * SEQ + t0 + qo) * 1024 + h * 128;
      oacc_foreach(o, [&](int d, float v0, float v1, float v2, float v3) {
        f32x4 u = *(f32x4*)(pr2 + d);
        u[0] += v0 * gs; u[1] += v1 * gs; u[2] += v2 * gs; u[3] += v3 * gs;
        *(f32x4*)(pr2 + d) = u;
      });
    }
    {
      const bf16_t* kb = p.kw + (size_t)bg * SEQ * 128;
      const bf16_t* vb = p.vwT + (size_t)bg * 128 * SEQ;
      oacc_zero(o);
      m = NEG_BIG; l = 0.f;
      int jlo = (t0 - 511) >> 6;
      if (jlo < 0) jlo = 0;
      kv_load(kv, kb + (size_t)jlo * 64 * 128, 128, vb + jlo * 64, SEQ);
      for (int j = jlo; j <= cur; ++j) {
        const int jn = (j < cur) ? j + 1 : j;
        __syncthreads();
        kv_store(kv, lk, lv);
        __syncthreads();
        f32x16 s0, s1;
        qk_tile(q, lk, s0, s1);
        int tqv = tq;
        asm volatile("" : "+v"(tqv));
        if (j * 64 + 63 + 113 <= t0 && t0 + 31 - j * 64 < 512) {
          const float b31 = lut[127];
#pragma unroll
          for (int r = 0; r < 16; ++r) { s0[r] = s0[r] * ATT_SCALE + b31; s1[r] = s1[r] * ATT_SCALE + b31; }
        } else {
#pragma unroll
          for (int r = 0; r < 16; ++r) {
            const int d0 = tqv - (j * 64 + 8 * (r >> 2) + (r & 3) + 4 * hh), d1 = d0 - 32;
            s0[r] = (d0 >= 0 && d0 < 512) ? s0[r] * ATT_SCALE + lut[min(d0, 127)] : NEG_BIG;
            s1[r] = (d1 >= 0 && d1 < 512) ? s1[r] * ATT_SCALE + lut[min(d1, 127)] : NEG_BIG;
          }
        }
        kv_load(kv, kb + (size_t)jn * 64 * 128, 128, vb + jn * 64, SEQ);
        softmax_tile(s0, s1, m, l, o);
        pv_tile(o, lv, s0, s1);
      }
      const float gs = 1.f / (fmaxf(l, 1e-20f) * (1.f + __expf(-grow[2])));
      int qo = ql;
      asm volatile("" : "+v"(qo));
      const float* pr2 = p.part + (size_t)(b * SEQ + t0 + qo) * 1024 + h * 128;
      bf16_t* orow = p.omix + (size_t)(b * SEQ + t0 + qo) * DM + h * 128;
      oacc_foreach(o, [&](int d, float v0, float v1, float v2, float v3) {
        const f32x4 u = *(const f32x4*)(pr2 + d);
        uint2 w;
        w.x = pack2(u[0] + v0 * gs, u[1] + v1 * gs);
        w.y = pack2(u[2] + v2 * gs, u[3] + v3 * gs);
        *(uint2*)(orow + d) = w;
      });
    }
  }
}

__device__ __forceinline__ void ph_cvt(const float* src, bf16_t* dst, size_t n) {
  typedef __attribute__((ext_vector_type(4))) float f32x4;
  const size_t nv = n / 8;
  for (size_t i = (size_t)blockIdx.x * 256 + opq(threadIdx.x); i < nv; i += (size_t)gridDim.x * 256) {
    const f32x4 a = ((const f32x4*)src)[2 * i], b = ((const f32x4*)src)[2 * i + 1];
    u32x4 o;
    o[0] = pack2(a[0], a[1]); o[1] = pack2(a[2], a[3]); o[2] = pack2(b[0], b[1]); o[3] = pack2(b[2], b[3]);
    ((u32x4*)dst)[i] = o;
  }
}

__device__ __forceinline__ void ph_scores(const P& p, char* lds) {
  for (int u = blockIdx.x; u < 64 * 16; u += gridDim.x) {
    const int tm = u & 63, hp = u >> 6;
    const int m0 = tm * 128;
    float* sc = p.scores + (size_t)m0 * DM + hp * 128;
    gemm_tile_bf16<false>(p.omix + (size_t)m0 * DM + hp * 128, DM, p.subkb + (size_t)hp * 128 * 128, 128, 128, lds,
                          [&](int r, int c, float val) { sc[(size_t)r * DM + c] = val; });
  }
}

__device__ __forceinline__ void ph_qp_scores(const P& p, char* lds) {
  const int ntm = T_TOK / 128, ntn = DM / 128;
  const int npm = (ntm + 7) / 8, npn = (ntn + 7) / 8;
  const int nslots = ((npm * npn * 64 + 511) / 512) * 512;
  for (int u = blockIdx.x; u < nslots; u += gridDim.x) {
    int v = (u & 7) * 64 + ((u >> 3) & 63) + (u & ~511);
    int patch = v >> 6, w = v & 63;
    int tm = (patch % npm) * 8 + (w & 7);
    int tn = (patch / npm) * 8 + (w >> 3);
    if (tm >= ntm || tn >= ntn) continue;
    const int m0 = tm * 128, n0 = tn * 128;
    bf16_t* qp = p.omix + (size_t)m0 * DM + n0;
    gemm_tile_bf16<false>(p.hn + (size_t)m0 * DM, DM, p.WpqT + (size_t)n0 * DM, DM, DM, lds,
                          [&](int r, int c, float val) { qp[(size_t)r * DM + c] = f2bf(val); });
    __threadfence_block();
    __syncthreads();
    float* sc = p.scores + (size_t)m0 * DM + n0;
    gemm_tile_bf16<false>(qp, DM, p.subkb + (size_t)tn * 128 * 128, 128, 128, lds,
                          [&](int r, int c, float val) { sc[(size_t)r * DM + c] = val; });
  }
}

__device__ __forceinline__ void ph_cvt4(const float* src, unsigned char* dst, float* scales, int nrows, int wid0, int nw) {
  typedef __attribute__((ext_vector_type(4))) float f32x4;
  typedef __attribute__((ext_vector_type(2))) float f32x2;
  const int lane = opq(threadIdx.x) & 63;
  const float one = __uint_as_float((unsigned)opq(0x3F800000));
  float lev[8];
#pragma unroll
  for (int c = 0; c < 8; ++c) {
    const f32x2 q = __builtin_amdgcn_cvt_scalef32_pk_f32_fp4((unsigned)opq(c * 0x11111111), one, 0);
    lev[c] = fabsf(q[0]);
  }
  const float maxlev = lev[7];
  for (int row = wid0; row < nrows; row += nw) {
    const f32x4* s4 = (const f32x4*)(src + (size_t)row * DM) + lane * 8;
    f32x4 v[8];
    float amax = 0.f;
#pragma unroll
    for (int i = 0; i < 8; ++i) {
      v[i] = s4[i];
#pragma unroll
      for (int k = 0; k < 4; ++k) amax = fmaxf(amax, fabsf(v[i][k]));
    }
    amax = wave_max(amax);
    const float sc = (amax > 0.f) ? maxlev / amax : 1.f;
    u32x4 o;
#pragma unroll
    for (int w = 0; w < 4; ++w) {
      unsigned pk = 0u;
      pk = __builtin_amdgcn_cvt_scalef32_pk_fp4_f32(pk, v[2 * w][0] * sc, v[2 * w][1] * sc, 1.0f, 0);
      pk = __builtin_amdgcn_cvt_scalef32_pk_fp4_f32(pk, v[2 * w][2] * sc, v[2 * w][3] * sc, 1.0f, 1);
      pk = __builtin_amdgcn_cvt_scalef32_pk_fp4_f32(pk, v[2 * w + 1][0] * sc, v[2 * w + 1][1] * sc, 1.0f, 2);
      pk = __builtin_amdgcn_cvt_scalef32_pk_fp4_f32(pk, v[2 * w + 1][2] * sc, v[2 * w + 1][3] * sc, 1.0f, 3);
      o[w] = pk;
    }
    *(u32x4*)(dst + (size_t)row * 1024 + lane * 16) = o;
    if (lane == 0) scales[row] = (amax > 0.f) ? amax / maxlev : 1.f;
  }
}

__device__ __forceinline__ u32x4 r4_load(const unsigned char* tab, int eid, int lane) {
  return *((const u32x4*)(tab + (size_t)eid * 1024) + lane);
}
struct XPk { f32x16 a, b; };
struct Acc32 { f32x16 a, b; };

#define R4_DOT_W(word, xv, base, pa, pb)                                                             \
  {                                                                                                  \
    typedef __attribute__((ext_vector_type(2))) float f32x2;                                         \
    const f32x2 q0 = __builtin_amdgcn_cvt_scalef32_pk_f32_fp4(word, one, 0), q1 = __builtin_amdgcn_cvt_scalef32_pk_f32_fp4(word, one, 1); \
    const f32x2 q2 = __builtin_amdgcn_cvt_scalef32_pk_f32_fp4(word, one, 2), q3 = __builtin_amdgcn_cvt_scalef32_pk_f32_fp4(word, one, 3); \
    pa += q0[0] * xv[base + 0] + q0[1] * xv[base + 1]; pb += q1[0] * xv[base + 2] + q1[1] * xv[base + 3]; \
    pa += q2[0] * xv[base + 4] + q2[1] * xv[base + 5]; pb += q3[0] * xv[base + 6] + q3[1] * xv[base + 7]; \
  }
__device__ __forceinline__ float r4_dot(const u32x4& e, const XPk& x) {
  const float one = __uint_as_float((unsigned)opq(0x3F800000));
  float pa = 0.f, pb = 0.f;
  R4_DOT_W(e[0], x.a, 0, pa, pb) R4_DOT_W(e[1], x.a, 8, pa, pb) R4_DOT_W(e[2], x.b, 0, pa, pb) R4_DOT_W(e[3], x.b, 8, pa, pb)
  return pa + pb;
}
#define R4_AXPY_W(word, accv, base)                                                                  \
  {                                                                                                  \
    typedef __attribute__((ext_vector_type(2))) float f32x2;                                         \
    const f32x2 q0 = __builtin_amdgcn_cvt_scalef32_pk_f32_fp4(word, one, 0), q1 = __builtin_amdgcn_cvt_scalef32_pk_f32_fp4(word, one, 1); \
    const f32x2 q2 = __builtin_amdgcn_cvt_scalef32_pk_f32_fp4(word, one, 2), q3 = __builtin_amdgcn_cvt_scalef32_pk_f32_fp4(word, one, 3); \
    accv[base + 0] += hid * q0[0]; accv[base + 1] += hid * q0[1]; accv[base + 2] += hid * q1[0]; accv[base + 3] += hid * q1[1]; \
    accv[base + 4] += hid * q2[0]; accv[base + 5] += hid * q2[1]; accv[base + 6] += hid * q3[0]; accv[base + 7] += hid * q3[1]; \
  }
__device__ __forceinline__ void r4_axpy(const u32x4& e, float hid, Acc32& acc) {
  const float one = __uint_as_float((unsigned)opq(0x3F800000));
  R4_AXPY_W(e[0], acc.a, 0) R4_AXPY_W(e[1], acc.a, 8) R4_AXPY_W(e[2], acc.b, 0) R4_AXPY_W(e[3], acc.b, 8)
}

#define INS16(K, x)                                                                                      \
  K##15 = __builtin_amdgcn_fmed3f(K##15, K##14, x); K##14 = __builtin_amdgcn_fmed3f(K##14, K##13, x);   \
  K##13 = __builtin_amdgcn_fmed3f(K##13, K##12, x); K##12 = __builtin_amdgcn_fmed3f(K##12, K##11, x);   \
  K##11 = __builtin_amdgcn_fmed3f(K##11, K##10, x); K##10 = __builtin_amdgcn_fmed3f(K##10, K##9, x);    \
  K##9 = __builtin_amdgcn_fmed3f(K##9, K##8, x); K##8 = __builtin_amdgcn_fmed3f(K##8, K##7, x);         \
  K##7 = __builtin_amdgcn_fmed3f(K##7, K##6, x); K##6 = __builtin_amdgcn_fmed3f(K##6, K##5, x);         \
  K##5 = __builtin_amdgcn_fmed3f(K##5, K##4, x); K##4 = __builtin_amdgcn_fmed3f(K##4, K##3, x);         \
  K##3 = __builtin_amdgcn_fmed3f(K##3, K##2, x); K##2 = __builtin_amdgcn_fmed3f(K##2, K##1, x);         \
  K##1 = __builtin_amdgcn_fmed3f(K##1, K##0, x); K##0 = fmaxf(K##0, x);
#define DECL16(K) float K##0 = -INFINITY, K##1 = -INFINITY, K##2 = -INFINITY, K##3 = -INFINITY, K##4 = -INFINITY, \
  K##5 = -INFINITY, K##6 = -INFINITY, K##7 = -INFINITY, K##8 = -INFINITY, K##9 = -INFINITY, K##10 = -INFINITY,   \
  K##11 = -INFINITY, K##12 = -INFINITY, K##13 = -INFINITY, K##14 = -INFINITY, K##15 = -INFINITY;
__device__ __forceinline__ float mkkey(float v, unsigned tag, unsigned mask) {
  return __uint_as_float((__float_as_uint(v) & ~mask) | tag);
}

__device__ __forceinline__ void ph_peer(const P& p, float* smem) {
  typedef __attribute__((ext_vector_type(4))) float f32x4;
  float* lists = smem;
  int* bexA = (int*)(smem + 4096);
  float* bgtA = smem + 6144;
  float* bsuA = smem + 8192;
  for (int item = blockIdx.x; item < T_TOK / 16; item += gridDim.x) {
    const int t0 = item * 16;
    __syncthreads();
    {
      const int tid = opq(threadIdx.x);
      const int tl = tid >> 4, hp = tid & 15;
      const f32x4* sp = (const f32x4*)(p.scores + (size_t)(t0 + tl) * DM + hp * 128);
      DECL16(k)
#pragma unroll 4
      for (int c4 = 0; c4 < 32; ++c4) {
        const f32x4 v = sp[c4];
#pragma unroll
        for (int e = 0; e < 4; ++e) {
          const float x = mkkey(v[e], 127u - (unsigned)(c4 * 4 + e), 127u);
          INS16(k, x)
        }
      }
      f32x4* lp = (f32x4*)(lists + (size_t)opq(threadIdx.x) * 16);
      f32x4 o0 = {k0, k1, k2, k3}, o1 = {k4, k5, k6, k7}, o2 = {k8, k9, k10, k11}, o3 = {k12, k13, k14, k15};
      lp[0] = o0; lp[1] = o1; lp[2] = o2; lp[3] = o3;
    }
    __syncthreads();
    if (opq(threadIdx.x) < 128) {
      const int tid = opq(threadIdx.x);
      const int tl = tid >> 3, h = tid & 7;
      const float* la = lists + (size_t)(tl * 16 + 2 * h) * 16;
      const float* lb = la + 16;
      float av[16], bv[16];
#pragma unroll
      for (int i = 0; i < 16; ++i) {
        av[i] = __uint_as_float(__float_as_uint(la[i]) & ~127u);
        bv[i] = __uint_as_float(__float_as_uint(lb[i]) & ~127u);
      }
      DECL16(c)
#pragma unroll
      for (int i = 0; i < 16; ++i) {
#pragma unroll
        for (int j = 0; j < 16; ++j) {
          if ((i + 1) * (j + 1) <= 16) {
            const float x = mkkey(av[i] + bv[j], 255u - (unsigned)(i * 16 + j), 255u);
            INS16(c, x)
          }
        }
      }
      float cs[16] = {c0, c1, c2, c3, c4, c5, c6, c7, c8, c9, c10, c11, c12, c13, c14, c15};
      float ev[16];
      float sum = 0.f;
      const float mx = __uint_as_float(__float_as_uint(cs[0]) & ~255u);
#pragma unroll
      for (int n = 0; n < 16; ++n) {
        ev[n] = __expf(__uint_as_float(__float_as_uint(cs[n]) & ~255u) - mx);
        sum += ev[n];
      }
      const float isum = 1.f / sum;
#pragma unroll
      for (int n = 0; n < 16; ++n) {
        const unsigned cc = 255u - (__float_as_uint(cs[n]) & 255u);
        const unsigned ka = 127u - (__float_as_uint(la[cc >> 4]) & 127u);
        const unsigned kb = 127u - (__float_as_uint(lb[cc & 15u]) & 127u);
        const int eid = (int)(ka * 128u + kb);
        bexA[tl * 128 + h * 16 + n] = eid;
        bgtA[tl * 128 + h * 16 + n] = ev[n] * isum * p.sv8[eid];
        bsuA[tl * 128 + h * 16 + n] = p.su8[eid];
      }
    }
    __syncthreads();
#pragma unroll 1
    for (int ti4 = 0; ti4 < 4; ++ti4) {
    const int lane = opq(threadIdx.x) & 63, wv = opq(threadIdx.x) >> 6;
    const int tl = wv * 4 + ti4;
    const int t = t0 + tl;
    const int* bex = bexA + tl * 128;
    const float* bgt = bgtA + tl * 128;
    const float* bsu = bsuA + tl * 128;
    XPk x;
    {
      const f32x4* s4 = (const f32x4*)(p.out + (size_t)t * DM) + lane * 8;
      const f32x4* g4 = (const f32x4*)p.norm_ffn + lane * 8;
      f32x4 a0 = s4[0], a1 = s4[1], a2 = s4[2], a3 = s4[3], a4 = s4[4], a5 = s4[5], a6 = s4[6], a7 = s4[7];
      float ss = 0.f;
#define SSQ(v) ss += v[0] * v[0] + v[1] * v[1] + v[2] * v[2] + v[3] * v[3];
      SSQ(a0) SSQ(a1) SSQ(a2) SSQ(a3) SSQ(a4) SSQ(a5) SSQ(a6) SSQ(a7)
#undef SSQ
      ss = wave_sum(ss);
      const float rs = rsqrtf(ss * (1.f / DM) + RMS_EPS);
#define XPK(dst, base, va, vb, gi)                                                    \
  {                                                                                   \
    const f32x4 ga = g4[gi], gb = g4[gi + 1];                                         \
    dst[base + 0] = bf2f(f2bf(va[0] * rs * ga[0])); dst[base + 1] = bf2f(f2bf(va[1] * rs * ga[1]));   \
    dst[base + 2] = bf2f(f2bf(va[2] * rs * ga[2])); dst[base + 3] = bf2f(f2bf(va[3] * rs * ga[3]));   \
    dst[base + 4] = bf2f(f2bf(vb[0] * rs * gb[0])); dst[base + 5] = bf2f(f2bf(vb[1] * rs * gb[1]));   \
    dst[base + 6] = bf2f(f2bf(vb[2] * rs * gb[2])); dst[base + 7] = bf2f(f2bf(vb[3] * rs * gb[3]));   \
  }
      XPK(x.a, 0, a0, a1, 0) XPK(x.a, 8, a2, a3, 2) XPK(x.b, 0, a4, a5, 4) XPK(x.b, 8, a6, a7, 6)
#undef XPK
    }
    Acc32 acc;
#pragma unroll
    for (int r = 0; r < 16; ++r) { acc.a[r] = 0.f; acc.b[r] = 0.f; }
    u32x4 u0 = r4_load(p.pu8, bex[0], lane), u1 = r4_load(p.pu8, bex[1], lane), u2 = r4_load(p.pu8, bex[2], lane), u3 = r4_load(p.pu8, bex[3], lane);
    u32x4 v0 = r4_load(p.pv8, bex[0], lane), v1 = r4_load(p.pv8, bex[1], lane), v2 = r4_load(p.pv8, bex[2], lane), v3 = r4_load(p.pv8, bex[3], lane);
#pragma unroll 1
    for (int e0 = 0; e0 < 128; e0 += 4) {
      float d0 = r4_dot(u0, x), d1 = r4_dot(u1, x), d2 = r4_dot(u2, x), d3 = r4_dot(u3, x);
      const int en = (e0 + 4 < 128) ? e0 + 4 : 124;
      const int i0 = bex[en], i1 = bex[en + 1], i2 = bex[en + 2], i3 = bex[en + 3];
      u0 = r4_load(p.pu8, i0, lane); u1 = r4_load(p.pu8, i1, lane); u2 = r4_load(p.pu8, i2, lane); u3 = r4_load(p.pu8, i3, lane);
#pragma unroll
      for (int o = 32; o > 0; o >>= 1) {
        d0 += __shfl_xor(d0, o); d1 += __shfl_xor(d1, o); d2 += __shfl_xor(d2, o); d3 += __shfl_xor(d3, o);
      }
      { const float hid = bgt[e0 + 0] * gelu_fast(d0 * bsu[e0 + 0]); r4_axpy(v0, hid, acc); }
      { const float hid = bgt[e0 + 1] * gelu_fast(d1 * bsu[e0 + 1]); r4_axpy(v1, hid, acc); }
      { const float hid = bgt[e0 + 2] * gelu_fast(d2 * bsu[e0 + 2]); r4_axpy(v2, hid, acc); }
      { const float hid = bgt[e0 + 3] * gelu_fast(d3 * bsu[e0 + 3]); r4_axpy(v3, hid, acc); }
      v0 = r4_load(p.pv8, i0, lane); v1 = r4_load(p.pv8, i1, lane); v2 = r4_load(p.pv8, i2, lane); v3 = r4_load(p.pv8, i3, lane);
    }
    const int lane2 = opq(lane);
    f32x4* o4 = (f32x4*)(p.out + (size_t)t * DM) + lane2 * 8;
    const f32x4* g4 = (const f32x4*)p.norm_final + lane2 * 8;
    f32x4 hv[8];
    float ss = 0.f;
#pragma unroll
    for (int i = 0; i < 8; ++i) {
      hv[i] = o4[i];
#pragma unroll
      for (int k = 0; k < 4; ++k) {
        hv[i][k] += (i < 4) ? acc.a[4 * i + k] : acc.b[4 * (i - 4) + k];
        ss += hv[i][k] * hv[i][k];
      }
    }
    ss = wave_sum(ss);
    const float rs = rsqrtf(ss * (1.f / DM) + RMS_EPS);
#pragma unroll
    for (int i = 0; i < 8; ++i) {
      const f32x4 g = g4[i];
      f32x4 o;
#pragma unroll
      for (int k = 0; k < 4; ++k) o[k] = hv[i][k] * rs * g[k];
      o4[i] = o;
    }
    }
  }
}

#define XB_TMO      128
#define XB_XCNT(j)  (256  + 64 * (j))
#define XB_XSUB(j)  (1280 + 64 * (j))
#define XB_XGEN(j)  (2304 + 64 * (j))
#define XB_TOP      3328
#define XB_TOPGEN   3392
#define XCD_BAR_WORDS 3456
#define XB_SPIN_CAP (1u << 22)
#define LAS __attribute__((address_space(3)))
__device__ __forceinline__ unsigned xb_ld(unsigned* p) { return __hip_atomic_load(p, __ATOMIC_RELAXED, __HIP_MEMORY_SCOPE_AGENT); }
__device__ __forceinline__ unsigned xb_add(unsigned* p, unsigned v) { return __hip_atomic_fetch_add(p, v, __ATOMIC_RELAXED, __HIP_MEMORY_SCOPE_AGENT); }
__device__ __forceinline__ unsigned xb_xcc_id() { return (unsigned)__builtin_amdgcn_s_getreg((3 << 11) | 20) & 0xFu; }
#define XB_SPIN(cond, bar) do { unsigned _sp = 0; while (cond) { __builtin_amdgcn_s_sleep(1); \
    if ((++_sp & 255u) == 0u) { if (xb_ld(&(bar)[XB_TMO])) break; if (_sp > XB_SPIN_CAP) { atomicAdd(&(bar)[XB_TMO], 1u); break; } } } } while (0)
struct XcdBarrier { unsigned* bar; unsigned x; volatile LAS unsigned* st; };
__device__ __forceinline__ XcdBarrier xcd_barrier_post(unsigned* bar, volatile LAS unsigned* st) {
  XcdBarrier b; b.bar = bar; b.x = xb_xcc_id(); b.st = st;
  if (threadIdx.x == 0) (void)xb_add(&bar[XB_XCNT(b.x)], 1u);
  return b;
}
__device__ __forceinline__ void xcd_barrier_complete(unsigned* bar, unsigned x, unsigned& nloc, unsigned& nx) {
  const unsigned G = gridDim.x * gridDim.y * gridDim.z;
  unsigned sum, cnt, mine, sp = 0u;
  for (;;) {
    sum = 0u; cnt = 0u; mine = 0u;
#pragma unroll
    for (unsigned j = 0; j < 16; ++j) { const unsigned c = xb_ld(&bar[XB_XCNT(j)]); sum += c; cnt += (c > 0u) ? 1u : 0u; mine = (j == x) ? c : mine; }
    if (sum == G) break;
    __builtin_amdgcn_s_sleep(1);
    if ((++sp & 255u) == 0u) { if (xb_ld(&bar[XB_TMO])) break; if (sp > XB_SPIN_CAP) { atomicAdd(&bar[XB_TMO], 1u); break; } }
  }
  nloc = mine > 0u ? mine : 1u; nx = cnt > 0u ? cnt : 1u;
}
__device__ __forceinline__ void xcd_barrier(const XcdBarrier& b) {
  asm volatile("s_waitcnt vmcnt(0)" ::: "memory");
  __syncthreads();
  if (threadIdx.x == 0) {
    unsigned* bar = b.bar;
    __builtin_amdgcn_s_waitcnt(0);
    unsigned nloc = b.st[0], nx = b.st[1];
    if (nloc == 0u) { xcd_barrier_complete(bar, b.x, nloc, nx); b.st[0] = nloc; b.st[1] = nx; }
    const unsigned old = xb_add(&bar[XB_XSUB(b.x)], 1u);
    const unsigned gen = old / nloc;
    if (old + 1u == (gen + 1u) * nloc) {
      __builtin_amdgcn_fence(__ATOMIC_RELEASE, "agent");
      asm volatile("s_waitcnt vmcnt(0)" ::: "memory");
      const unsigned og = xb_add(&bar[XB_TOP], 1u);
      const unsigned tg = og / nx;
      if (og + 1u == (tg + 1u) * nx) xb_add(&bar[XB_TOPGEN], 1u);
      else XB_SPIN(xb_ld(&bar[XB_TOPGEN]) == tg, bar);
      __builtin_amdgcn_fence(__ATOMIC_ACQUIRE, "agent");
      xb_add(&bar[XB_XGEN(b.x)], 1u);
      asm volatile("s_waitcnt vmcnt(0)" ::: "memory");
    } else {
      XB_SPIN(xb_ld(&bar[XB_XGEN(b.x)]) == gen, bar);
      __builtin_amdgcn_fence(__ATOMIC_ACQUIRE, "agent");
      asm volatile("s_waitcnt vmcnt(0)" ::: "memory");
    }
  }
  __syncthreads();
}

typedef const __attribute__((address_space(4))) P* KP;
__device__ __forceinline__ P loadP() {
#if defined(__HIP_DEVICE_COMPILE__)
  KP k = (KP)__builtin_amdgcn_kernarg_segment_ptr();
  asm volatile("" : "+s"(k));
  P p = *k;
  return p;
#else
  return P{};
#endif
}

__global__ void __launch_bounds__(256, 2) mega(P p_arg) {
  cg::grid_group grid = cg::this_grid();
  __shared__ __attribute__((aligned(16))) float smem[14336];
  char* lds = (char*)smem;
  __shared__ uint4 xb_words;
  if (threadIdx.x == 0) xb_words = make_uint4(0u, 0u, 0u, 0u);
  if (blockIdx.x == 0) {
    P p = loadP();
    for (int i = threadIdx.x; i < XCD_BAR_WORDS; i += 256) p.bar[i] = 0u;
  }
  { P p = loadP(); ph_rmsnorm(p.x, p.norm_mix, p.hn, T_TOK); ph_rmsnorm(p.mem, p.norm_mkv, p.memn, 1024); }
  { P p = loadP(); ph_transpose<true>(smem, p.w_in, DM, INC, 5760, p.WinT); }
  { P p = loadP(); ph_transpose<false>(smem, p.w_out, DM, DM, DM, p.WoutT); }
  { P p = loadP(); ph_transpose<false>(smem, p.w_pq, DM, DM, DM, p.WpqT); }
  { P p = loadP(); ph_transpose<false>(smem, p.w_mq, DM, 512, 512, p.WmqT); }
  { P p = loadP(); ph_transpose<false>(smem, p.w_mk, DM, 512, 512, p.WmkT); }
  { P p = loadP(); ph_transpose<false>(smem, p.w_mv, DM, 512, 512, p.WmvT); }
  { P p = loadP(); ph_transpose<false>(smem, p.w_mo, 512, DM, DM, p.WmoT); }
  { P p = loadP(); ph_cvt(p.subk, p.subkb, (size_t)16 * 128 * 128); }
  { P p = loadP(); ph_transpose<false>(smem, p.w1_k, 4096, 128, 128, p.w1T); }
  { P p = loadP(); ph_transpose<false>(smem, p.w1_v, 4096, 128, 128, p.w1T + 128 * 4096); }
  { P p = loadP(); ph_transpose<false>(smem, p.w2_k, 128, 128, 128, p.w2T); }
  { P p = loadP(); ph_transpose<false>(smem, p.w2_v, 128, 128, 128, p.w2T + 128 * 128); }
  { P p = loadP(); ph_posb(p); }
  grid.sync();
  XcdBarrier xb;
  { P p = loadP(); xb = xcd_barrier_post(p.bar, (volatile LAS unsigned*)&xb_words); }
  { P p = loadP(); ph_proj(p, lds); }
  const int kvb = (gridDim.x == 512) ? (((int)blockIdx.x >= 320 && (int)blockIdx.x < 352) ? ((int)blockIdx.x - 320) * 8 : -1) : -2;
  const int vvb = (gridDim.x == 512) ? (((int)blockIdx.x >= 352 && (int)blockIdx.x < 384) ? ((int)blockIdx.x - 352) * 8 : -1) : -2;
  { P p = loadP(); bf16_t* kmem = p.kmemb;
    ph_gemm_bf16(p.memn, DM, p.WmkT, DM, 1024, 512, DM, lds, [=](int m, int n, float v) {
      kmem[((size_t)((m >> 8) * 4 + (n >> 7)) * 256 + (m & 255)) * 128 + (n & 127)] = f2bf(v); }, kvb); }
  { P p = loadP(); bf16_t* vmem = p.vmemT;
    ph_gemm_bf16(p.memn, DM, p.WmvT, DM, 1024, 512, DM, lds, [=](int m, int n, float v) {
      vmem[((size_t)((m >> 8) * 4 + (n >> 7)) * 128 + (n & 127)) * 256 + perm16(m & 255)] = f2bf(v); }, vvb); }
  xcd_barrier(xb);
  { P p = loadP(); ph_compress2(p, lds); }
  { P p = loadP(); ph_sb2(p, lds); }
  xcd_barrier(xb);
  { P p = loadP(); ph_nsa2(p, lds); }
  xcd_barrier(xb);
  { P p = loadP(); float* out = p.out; const float* x = p.x;
    ph_gemm_bf16(p.omix, DM, p.WoutT, DM, T_TOK, DM, DM, lds, [=](int m, int n, float v) { out[(size_t)m * DM + n] = x[(size_t)m * DM + n] + v; }); }
  xcd_barrier(xb);
  { P p = loadP(); ph_rmsnorm(p.out, p.norm_mq, p.hn, T_TOK); }
  xcd_barrier(xb);
  if (blockIdx.x < 256 || gridDim.x < 512) {
    P p = loadP(); bf16_t* qmem = p.qmemb;
    ph_gemm_bf16(p.hn, DM, p.WmqT, DM, T_TOK, 512, DM, lds, [=](int m, int n, float v) { qmem[(size_t)m * 512 + n] = f2bf(v); });
  }
  {
    const int half = (gridDim.x >= 512) ? 256 : 0;
    if ((int)blockIdx.x >= half) {
      const int nwv = ((int)gridDim.x - half) * 4, wid = ((int)blockIdx.x - half) * 4 + (opq(threadIdx.x) >> 6);
      { P p = loadP(); ph_cvt4(p.pu, p.pu8, p.su8, 16384, wid, nwv); }
      if (gridDim.x < 512) { P p = loadP(); ph_cvt4(p.pv, p.pv8, p.sv8, 16384, wid, nwv); }
    }
  }
  xcd_barrier(xb);
  { P p = loadP(); ph_memattn2(p, lds); }
  if (gridDim.x >= 512 && blockIdx.x >= 256) {
    const int nwv = ((int)gridDim.x - 256) * 4, wid = ((int)blockIdx.x - 256) * 4 + (opq(threadIdx.x) >> 6);
    P p = loadP(); ph_cvt4(p.pv, p.pv8, p.sv8, 16384, wid, nwv);
  }
  xcd_barrier(xb);
  { P p = loadP(); float* out = p.out;
    ph_gemm_bf16(p.omem, 512, p.WmoT, 512, T_TOK, DM, 512, lds, [=](int m, int n, float v) { out[(size_t)m * DM + n] += v; }); }
  xcd_barrier(xb);
  { P p = loadP(); ph_rmsnorm(p.out, p.norm_ffn, p.hn, T_TOK); }
  xcd_barrier(xb);
  { P p = loadP(); ph_qp_scores(p, lds); }
  xcd_barrier(xb);
  { P p = loadP(); ph_peer(p, smem); }
}

extern "C" void kernel_launch(void* const* d_in, const int* in_sizes, int n_in, void* d_out, int out_size, void* d_ws,
                              size_t ws_size, hipStream_t stream) {
  P p{};
  p.x = (const float*)d_in[0]; p.mem = (const float*)d_in[1]; p.t5 = (const float*)d_in[2];
  p.norm_mix = (const float*)d_in[3]; p.w_in = (const float*)d_in[4]; p.pos_k = (const float*)d_in[5];
  p.w1_k = (const float*)d_in[6]; p.w2_k = (const float*)d_in[7]; p.pos_v = (const float*)d_in[8];
  p.w1_v = (const float*)d_in[9]; p.w2_v = (const float*)d_in[10]; p.w_out = (const float*)d_in[11];
  p.norm_mq = (const float*)d_in[12]; p.norm_mkv = (const float*)d_in[13]; p.w_mq = (const float*)d_in[14];
  p.w_mk = (const float*)d_in[15]; p.w_mv = (const float*)d_in[16]; p.w_mo = (const float*)d_in[17];
  p.norm_ffn = (const float*)d_in[18]; p.w_pq = (const float*)d_in[19]; p.subk = (const float*)d_in[20];
  p.pu = (const float*)d_in[21]; p.pv = (const float*)d_in[22]; p.norm_final = (const float*)d_in[23];
  p.out = (float*)d_out;
  char* w = (char*)d_ws;
  size_t off = 0;
  auto take = [&](size_t bytes) { char* r = w + off; off += (bytes + 255) & ~(size_t)255; return r; };
  p.bar = (unsigned*)take(XCD_BAR_WORDS * 4);
  p.scores = (float*)take((size_t)T_TOK * DM * 4);
  p.gates = (float*)take((size_t)T_TOK * 24 * 4);
  p.part = (float*)take((size_t)T_TOK * 1024 * 4);
  p.posb = (float*)take(256 * 4);
  p.qn = (bf16_t*)take((size_t)T_TOK * 1024 * 2);
  p.kcin = (bf16_t*)take((size_t)T_TOK * 256 * 2 + 65536);
  p.vcin = (bf16_t*)take((size_t)T_TOK * 256 * 2 + 65536);
  p.ks = (bf16_t*)take((size_t)T_TOK * 256 * 2);
  p.vsT = (bf16_t*)take((size_t)T_TOK * 256 * 2);
  p.kw = (bf16_t*)take((size_t)T_TOK * 256 * 2);
  p.vwT = (bf16_t*)take((size_t)T_TOK * 256 * 2);
  p.kcb = (bf16_t*)take((size_t)8 * 128 * 128 * 2);
  p.vcT = (bf16_t*)take((size_t)8 * 128 * 128 * 2);
  p.c1 = (bf16_t*)take((size_t)16 * 128 * 128 * 2);
  p.w1T = (bf16_t*)take((size_t)2 * 128 * 4096 * 2);
  p.w2T = (bf16_t*)take((size_t)2 * 128 * 128 * 2);
  p.hn = (bf16_t*)take((size_t)T_TOK * DM * 2);
  p.omix = (bf16_t*)take((size_t)T_TOK * DM * 2);
  p.memn = (bf16_t*)take((size_t)1024 * DM * 2);
  p.omem = (bf16_t*)take((size_t)T_TOK * 512 * 2);
  p.WinT = (bf16_t*)take((size_t)5760 * DM * 2);
  p.WoutT = (bf16_t*)take((size_t)DM * DM * 2);
  p.WpqT = (bf16_t*)take((size_t)DM * DM * 2);
  p.WmqT = (bf16_t*)take((size_t)512 * DM * 2);
  p.WmkT = (bf16_t*)take((size_t)512 * DM * 2);
  p.WmvT = (bf16_t*)take((size_t)512 * DM * 2);
  p.WmoT = (bf16_t*)take((size_t)DM * 512 * 2);
  p.qmemb = (bf16_t*)take((size_t)T_TOK * 512 * 2);
  p.kmemb = (bf16_t*)take((size_t)1024 * 512 * 2);
  p.vmemT = (bf16_t*)take((size_t)1024 * 512 * 2);
  p.qsb = (bf16_t*)take((size_t)T_TOK * 1024 * 2);
  p.ksb = (bf16_t*)take((size_t)T_TOK * 1024 * 2);
  p.vsbT = (bf16_t*)take((size_t)T_TOK * 1024 * 2);
  p.pu8 = (unsigned char*)take((size_t)16384 * 1024);
  p.pv8 = (unsigned char*)take((size_t)16384 * 1024);
  p.su8 = (float*)take(16384 * 4);
  p.sv8 = (float*)take(16384 * 4);
  p.subkb = (bf16_t*)take((size_t)16 * 128 * 128 * 2);
  static int grid_blocks = 0;
  if (!grid_blocks) {
    int dev = 0, cus = 0, per_cu = 0;
    (void)hipGetDevice(&dev);
    (void)hipDeviceGetAttribute(&cus, hipDeviceAttributeMultiprocessorCount, dev);
    (void)hipOccupancyMaxActiveBlocksPerMultiprocessor(&per_cu, mega, 256, 0);
    if (per_cu > 2) per_cu = 2;
    if (per_cu < 1) per_cu = 1;
    grid_blocks = cus * per_cu;
  }
  void* args[] = {&p};
  hipError_t e = hipLaunchCooperativeKernel((void*)mega, dim3(grid_blocks), dim3(256), args, 0, stream);
  if (e != hipSuccess) fprintf(stderr, "cooperative launch failed: %s (grid %d)\n", hipGetErrorString(e), grid_blocks);
}
```

```cpp
#include <hip/hip_runtime.h>
#include <hip/hip_cooperative_groups.h>
#include <cstdio>
namespace cg = cooperative_groups;
#include <stdint.h>

#define SEQ 2048
#define NBATCH 4
#define T_TOK 8192
#define DM 2048
#define INC 5656
#define C_QN 0
#define C_KC 1024
#define C_VC 1280
#define C_KS 1536
#define C_VS 1792
#define C_KW 2048
#define C_VW 2304
#define C_GT 2560
#define C_QSB 2584
#define C_KSB 3608
#define C_VSB 4632
#define ATT_SCALE 0.08838834764831845f
#define RMS_EPS 1e-6f

typedef unsigned short bf16_t;
typedef __attribute__((ext_vector_type(8))) short bf16x8;
typedef __attribute__((ext_vector_type(16))) float f32x16;
typedef __attribute__((ext_vector_type(2))) __bf16 bf16v2;
typedef __attribute__((ext_vector_type(4))) unsigned u32x4;

struct P {
  const float *x, *mem, *t5, *norm_mix, *w_in, *pos_k, *w1_k, *w2_k, *pos_v, *w1_v, *w2_v, *w_out,
      *norm_mq, *norm_mkv, *w_mq, *w_mk, *w_mv, *w_mo, *norm_ffn, *w_pq, *subk, *pu, *pv, *norm_final;
  float* out;
  float *scores, *gates, *part, *posb;
  unsigned* bar;
  bf16_t *hn, *omix, *memn, *omem;
  bf16_t *WinT, *WoutT, *WpqT, *WmqT, *WmkT, *WmvT, *WmoT;
  bf16_t *qmemb, *kmemb, *vmemT;
  bf16_t *qsb, *ksb, *vsbT;
  bf16_t* subkb;
  unsigned char *pu8, *pv8;
  float *su8, *sv8;
  bf16_t *qn, *kcin, *vcin, *ks, *vsT, *kw, *vwT, *kcb, *vcT, *c1, *w1T, *w2T;
};

__device__ __forceinline__ int opq(int v) { asm volatile("" : "+v"(v)); return v; }
__device__ __forceinline__ unsigned pack2(float a, float b) {
  bf16v2 r = {(__bf16)a, (__bf16)b};
  return *(unsigned*)&r;
}
__device__ __forceinline__ bf16_t f2bf(float a) {
  __bf16 r = (__bf16)a;
  return *(bf16_t*)&r;
}
__device__ __forceinline__ int perm16(int s) { return (s & ~12) | ((s & 4) << 1) | ((s & 8) >> 1); }
__device__ __forceinline__ float bf2f(bf16_t u) { return __uint_as_float((unsigned)u << 16); }

__device__ __forceinline__ float wave_max(float v) {
  for (int o = 32; o > 0; o >>= 1) v = fmaxf(v, __shfl_xor(v, o));
  return v;
}
__device__ __forceinline__ float wave_sum(float v) {
  for (int o = 32; o > 0; o >>= 1) v += __shfl_xor(v, o);
  return v;
}
__device__ __forceinline__ void wave_argmax(float& v, int& i) {
  for (int o = 32; o > 0; o >>= 1) {
    float ov = __shfl_xor(v, o);
    int oi = __shfl_xor(i, o);
    if (ov > v || (ov == v && oi < i)) { v = ov; i = oi; }
  }
}
__device__ __forceinline__ float gelu_tanh(float x) {
  return 0.5f * x * (1.f + tanhf(0.7978845608028654f * (x + 0.044715f * x * x * x)));
}
__device__ __forceinline__ float gelu_fast(float x) {
  const float y = 1.5957691216057308f * (x + 0.044715f * x * x * x);
  return x / (1.f + __expf(-y));
}
__device__ __forceinline__ int t5_bucket(int n) {
  if (n < 16) return n < 0 ? 0 : n;
  int b = 16;
  b += (n >= 19); b += (n >= 21); b += (n >= 24); b += (n >= 27); b += (n >= 31); b += (n >= 35);
  b += (n >= 40); b += (n >= 46); b += (n >= 52); b += (n >= 59); b += (n >= 67); b += (n >= 77);
  b += (n >= 87); b += (n >= 99); b += (n >= 113);
  return b;
}
__device__ __forceinline__ float log_sigmoid(float x) {
  return fminf(x, 0.f) - log1pf(expf(-fabsf(x)));
}

__device__ __forceinline__ void ph_rmsnorm(const float* src, const float* gain, bf16_t* dst, int rows) {
  int lane = opq(threadIdx.x) & 63, wv = opq(threadIdx.x) >> 6;
  for (int r = blockIdx.x * 4 + wv; r < rows; r += gridDim.x * 4) {
    const float4* s4 = (const float4*)(src + (size_t)r * DM);
    float4 v[8];
    float ss = 0.f;
#pragma unroll
    for (int i = 0; i < 8; ++i) {
      v[i] = s4[i * 64 + lane];
      ss += v[i].x * v[i].x + v[i].y * v[i].y + v[i].z * v[i].z + v[i].w * v[i].w;
    }
    ss = wave_sum(ss);
    float rs = rsqrtf(ss * (1.f / DM) + RMS_EPS);
    uint2* d2 = (uint2*)(dst + (size_t)r * DM);
    const float4* g4 = (const float4*)gain;
#pragma unroll
    for (int i = 0; i < 8; ++i) {
      float4 g = g4[i * 64 + lane];
      uint2 o;
      o.x = pack2(v[i].x * rs * g.x, v[i].y * rs * g.y);
      o.y = pack2(v[i].z * rs * g.z, v[i].w * rs * g.w);
      d2[i * 64 + lane] = o;
    }
  }
}

template <bool CMAP>
__device__ __forceinline__ void ph_transpose(float* smem, const float* W, int K, int N, int Npad, bf16_t* Wt,
                                             int vblock = -2, int nvb = 0) {
  typedef __attribute__((ext_vector_type(4))) float f32x4;
  float (*tl)[65] = (float (*)[65])smem;
  if (vblock == -1) return;
  const int b0 = (vblock >= 0) ? vblock : (int)blockIdx.x, bstride = (vblock >= 0) ? nvb : (int)gridDim.x;
  const int tid = opq(threadIdx.x);
  const int nk = K / 64, nn = Npad / 64;
  for (int tile = b0; tile < nk * nn; tile += bstride) {
    const int k0 = (tile % nk) * 64, n0 = (tile / nk) * 64;
    const int kr = tid >> 4, n4 = (tid & 15) * 4;
    int sc = n0 + n4;
    if (CMAP) sc = (sc < 2560) ? sc : (sc < 5632) ? sc + 24 : (sc < 5656) ? sc - 5632 + 2560 : N;
#pragma unroll
    for (int i = 0; i < 4; ++i) {
      const int k = kr + 16 * i;
      f32x4 v = {0.f, 0.f, 0.f, 0.f};
      if (sc < N) v = *(const f32x4*)(W + (size_t)(k0 + k) * N + sc);
      tl[k][n4 + 0] = v[0]; tl[k][n4 + 1] = v[1]; tl[k][n4 + 2] = v[2]; tl[k][n4 + 3] = v[3];
    }
    __syncthreads();
    int n = tid >> 2, kc = (tid & 3) * 16;
    unsigned w[8];
#pragma unroll
    for (int i = 0; i < 8; ++i) w[i] = pack2(tl[kc + 2 * i][n], tl[kc + 2 * i + 1][n]);
    uint4* dst = (uint4*)(Wt + (size_t)(n0 + n) * K + k0 + kc);
    dst[0] = make_uint4(w[0], w[1], w[2], w[3]);
    dst[1] = make_uint4(w[4], w[5], w[6], w[7]);
    __syncthreads();
  }
}

__device__ __forceinline__ int lds_off(int row, int chunk) { return row * 128 + ((chunk ^ ((row >> 1) & 7)) << 4); }

template <bool TR, class Epi>
__device__ __forceinline__ void gemm_tile_bf16(const bf16_t* xp, int ldx, const bf16_t* yp, int ldy, int K, char* lds,
                                               Epi epi) {
  const int tid = opq(threadIdx.x), lane = tid & 63, wv = tid >> 6;
  const int wr = wv >> 1, wc = wv & 1;
  char* lx = lds;
  char* ly = lds + 16384;
  f32x16 acc[2][2];
#pragma unroll
  for (int i = 0; i < 2; ++i)
#pragma unroll
    for (int j = 0; j < 2; ++j)
#pragma unroll
      for (int r = 0; r < 16; ++r) acc[i][j][r] = 0.f;
  const int srow = tid >> 3, sch = tid & 7;
  const bf16_t* xg = xp + (size_t)srow * ldx + sch * 8;
  const bf16_t* yg = yp + (size_t)srow * ldy + sch * 8;
  const size_t x32 = (size_t)32 * ldx, y32 = (size_t)32 * ldy;
  uint4 sx0 = *(const uint4*)(xg), sx1 = *(const uint4*)(xg + x32), sx2 = *(const uint4*)(xg + 2 * x32),
        sx3 = *(const uint4*)(xg + 3 * x32);
  uint4 sy0 = *(const uint4*)(yg), sy1 = *(const uint4*)(yg + y32), sy2 = *(const uint4*)(yg + 2 * y32),
        sy3 = *(const uint4*)(yg + 3 * y32);
  const int so0 = lds_off(srow, sch), so1 = lds_off(32 + srow, sch), so2 = lds_off(64 + srow, sch),
            so3 = lds_off(96 + srow, sch);
  for (int k0 = 0; k0 < K; k0 += 64) {
    __syncthreads();
    *(uint4*)(lx + so0) = sx0; *(uint4*)(lx + so1) = sx1; *(uint4*)(lx + so2) = sx2; *(uint4*)(lx + so3) = sx3;
    *(uint4*)(ly + so0) = sy0; *(uint4*)(ly + so1) = sy1; *(uint4*)(ly + so2) = sy2; *(uint4*)(ly + so3) = sy3;
    __syncthreads();
    if (k0 + 64 < K) {
      const bf16_t* xn = xg + k0 + 64;
      const bf16_t* yn = yg + k0 + 64;
      sx0 = *(const uint4*)(xn); sx1 = *(const uint4*)(xn + x32); sx2 = *(const uint4*)(xn + 2 * x32);
      sx3 = *(const uint4*)(xn + 3 * x32);
      sy0 = *(const uint4*)(yn); sy1 = *(const uint4*)(yn + y32); sy2 = *(const uint4*)(yn + 2 * y32);
      sy3 = *(const uint4*)(yn + 3 * y32);
    }
#pragma unroll
    for (int kk = 0; kk < 4; ++kk) {
      bf16x8 a[2], b[2];
      const int ch = kk * 2 + (lane >> 5);
#pragma unroll
      for (int i = 0; i < 2; ++i) {
        a[i] = *(const bf16x8*)((TR ? ly : lx) + lds_off(wr * 64 + i * 32 + (lane & 31), ch));
        b[i] = *(const bf16x8*)((TR ? lx : ly) + lds_off(wc * 64 + i * 32 + (lane & 31), ch));
      }
#pragma unroll
      for (int i = 0; i < 2; ++i)
#pragma unroll
        for (int j = 0; j < 2; ++j) acc[i][j] = __builtin_amdgcn_mfma_f32_32x32x16_bf16(a[i], b[j], acc[i][j], 0, 0, 0);
    }
  }
  int lane2 = lane;
  asm volatile("" : "+v"(lane2));
#pragma unroll
  for (int i = 0; i < 2; ++i)
#pragma unroll
    for (int j = 0; j < 2; ++j)
#pragma unroll
      for (int r = 0; r < 16; ++r) {
        int rr = wr * 64 + i * 32 + (r & 3) + 8 * (r >> 2) + 4 * (lane2 >> 5);
        int cc = wc * 64 + j * 32 + (lane2 & 31);
        epi(rr, cc, acc[i][j][r]);
      }
}

template <class Epi>
__device__ __forceinline__ void ph_gemm_bf16(const bf16_t* A, int lda, const bf16_t* Wt, int ldw, int M, int N, int K,
                                             char* lds, Epi epi, int vblock = -2) {
  const int ntm = M / 128, ntn = N / 128;
  const int npm = (ntm + 7) / 8, npn = (ntn + 7) / 8;
  const int nslots = ((npm * npn * 64 + 511) / 512) * 512;
  if (vblock == -1) return;
  for (int u = (vblock >= 0 ? vblock : (int)blockIdx.x); u < nslots; u += gridDim.x) {
    int v = (u & 7) * 64 + ((u >> 3) & 63) + (u & ~511);
    int patch = v >> 6, w = v & 63;
    int tm = (patch % npm) * 8 + (w & 7);
    int tn = (patch / npm) * 8 + (w >> 3);
    if (tm >= ntm || tn >= ntn) continue;
    const int m0 = tm * 128, n0 = tn * 128;
    gemm_tile_bf16<false>(A + (size_t)m0 * lda, lda, Wt + (size_t)n0 * ldw, ldw, K, lds,
                          [&](int r, int c, float val) { epi(m0 + r, n0 + c, val); });
  }
}

__device__ __forceinline__ void ph_proj(const P& p, char* lds) {
  const int ntm = T_TOK / 128, ntn = 5760 / 128;
  const int npm = (ntm + 7) / 8, npn = (ntn + 7) / 8;
  const int nslots = ((npm * npn * 64 + 511) / 512) * 512;
  for (int u = blockIdx.x; u < nslots; u += gridDim.x) {
    int v = (u & 7) * 64 + ((u >> 3) & 63) + (u & ~511);
    int patch = v >> 6, w = v & 63;
    int tm = (patch % npm) * 8 + (w & 7);
    int tn = (patch / npm) * 8 + (w >> 3);
    if (tm >= ntm || tn >= ntn) continue;
    const int m0 = tm * 128, n0 = tn * 128;
    const int b = m0 >> 11, sl = m0 & 2047;
    const bf16_t* A = p.hn + (size_t)m0 * DM;
    const bf16_t* W = p.WinT + (size_t)n0 * DM;
    if (n0 < 1024) {
      bf16_t* q = p.qn + (size_t)m0 * 1024 + n0;
      gemm_tile_bf16<false>(A, DM, W, DM, DM, lds, [&](int r, int c, float val) { q[(size_t)r * 1024 + c] = f2bf(val); });
    } else if (n0 < 2560) {
      const int seg = (n0 - 1024) >> 8, g = ((n0 - 1024) >> 7) & 1;
      if (seg == 3 || seg == 5) {
        bf16_t* vd = (seg == 3 ? p.vsT : p.vwT) + ((size_t)(b * 2 + g) * 128) * SEQ + sl;
        gemm_tile_bf16<true>(A, DM, W, DM, DM, lds, [&](int r, int c, float val) { vd[(size_t)r * SEQ + perm16(c)] = f2bf(val); });
      } else {
        bf16_t* base = (seg == 0) ? p.kcin : (seg == 1) ? p.vcin : (seg == 2) ? p.ks : p.kw;
        bf16_t* kd = base + ((size_t)(b * 2 + g) * SEQ + sl) * 128;
        gemm_tile_bf16<false>(A, DM, W, DM, DM, lds, [&](int r, int c, float val) { kd[(size_t)r * 128 + c] = f2bf(val); });
      }
    } else if (n0 < 3584) {
      bf16_t* q = p.qsb + (size_t)m0 * 1024 + (n0 - 2560);
      gemm_tile_bf16<false>(A, DM, W, DM, DM, lds, [&](int r, int c, float val) { q[(size_t)r * 1024 + c] = f2bf(val); });
    } else if (n0 < 4608) {
      bf16_t* kd = p.ksb + ((size_t)(b * 8 + ((n0 - 3584) >> 7)) * SEQ + sl) * 128;
      gemm_tile_bf16<false>(A, DM, W, DM, DM, lds, [&](int r, int c, float val) { kd[(size_t)r * 128 + c] = f2bf(val); });
    } else if (n0 < 5632) {
      bf16_t* vd = p.vsbT + ((size_t)(b * 8 + ((n0 - 4608) >> 7)) * 128) * SEQ + sl;
      gemm_tile_bf16<true>(A, DM, W, DM, DM, lds, [&](int r, int c, float val) { vd[(size_t)r * SEQ + perm16(c)] = f2bf(val); });
    } else {
      float* gd = p.gates + (size_t)m0 * 24;
      gemm_tile_bf16<false>(A, DM, W, DM, DM, lds, [&](int r, int c, float val) { if (c < 24) gd[(size_t)r * 24 + c] = val; });
    }
  }
}

__device__ __forceinline__ void ph_posb(const P& p) {
  const int lane = opq(threadIdx.x) & 63, wv = opq(threadIdx.x) >> 6;
  for (int o = blockIdx.x * 4 + wv; o < 256; o += gridDim.x * 4) {
    const int which = o >> 7, n = o & 127;
    const float* pos = which ? p.pos_v : p.pos_k;
    const float* w1 = which ? p.w1_v : p.w1_k;
    float acc = 0.f;
    for (int k = lane; k < 4096; k += 64) acc += pos[k] * w1[(size_t)k * 128 + n];
    acc = wave_sum(acc);
    if (lane == 0) p.posb[o] = acc;
  }
}

__device__ __forceinline__ void ph_compress2(const P& p, char* lds) {
  for (int item = blockIdx.x; item < 16; item += gridDim.x) {
    const int which = item >> 3, bg = item & 7;
    const bf16_t* src = (which ? p.vcin : p.kcin) + (size_t)bg * SEQ * 128;
    const bf16_t* w1t = p.w1T + (size_t)which * 128 * 4096;
    const bf16_t* w2t = p.w2T + (size_t)which * 128 * 128;
    const float* posb = p.posb + which * 128;
    bf16_t* c1 = p.c1 + (size_t)item * 128 * 128;
    gemm_tile_bf16<false>(src, 2048, w1t, 4096, 4096, lds, [&](int r, int c, float val) {
      c1[r * 128 + c] = f2bf(gelu_fast(val + posb[c])); });
    __threadfence_block();
    __syncthreads();
    if (which == 0) {
      bf16_t* kd = p.kcb + (size_t)bg * 128 * 128;
      gemm_tile_bf16<false>(c1, 128, w2t, 128, 128, lds, [&](int r, int c, float val) { kd[r * 128 + c] = f2bf(val); });
    } else {
      bf16_t* vd = p.vcT + (size_t)bg * 128 * 128;
      gemm_tile_bf16<true>(c1, 128, w2t, 128, 128, lds, [&](int r, int c, float val) { vd[r * 128 + perm16(c)] = f2bf(val); });
    }
  }
}

#define NEG_BIG (-1e30f)

struct KVRegs { u32x4 k0, k1, k2, k3, v0, v1, v2, v3; };

__device__ __forceinline__ int koff(int row, int chunk) { return row * 256 + ((chunk ^ (row & 15)) << 4); }

__device__ __forceinline__ void kv_load(KVRegs& r, const bf16_t* kp, int ldk, const bf16_t* vp, int ldv) {
  const int tid = opq(threadIdx.x);
  const bf16_t* kg = kp + (size_t)(tid >> 4) * ldk + (tid & 15) * 8;
  r.k0 = *(const u32x4*)kg;
  r.k1 = *(const u32x4*)(kg + (size_t)16 * ldk);
  r.k2 = *(const u32x4*)(kg + (size_t)32 * ldk);
  r.k3 = *(const u32x4*)(kg + (size_t)48 * ldk);
  const bf16_t* vg = vp + (size_t)(tid >> 3) * ldv + (tid & 7) * 8;
  r.v0 = *(const u32x4*)vg;
  r.v1 = *(const u32x4*)(vg + (size_t)32 * ldv);
  r.v2 = *(const u32x4*)(vg + (size_t)64 * ldv);
  r.v3 = *(const u32x4*)(vg + (size_t)96 * ldv);
}
__device__ __forceinline__ void kv_store(const KVRegs& r, char* lk, char* lv) {
  const int tid = opq(threadIdx.x);
  const int row = tid >> 4, ch = tid & 15;
  *(u32x4*)(lk + koff(row, ch)) = r.k0;
  *(u32x4*)(lk + koff(row + 16, ch)) = r.k1;
  *(u32x4*)(lk + koff(row + 32, ch)) = r.k2;
  *(u32x4*)(lk + koff(row + 48, ch)) = r.k3;
  const int vr = tid >> 3, vc = tid & 7;
  *(u32x4*)(lv + lds_off(vr, vc)) = r.v0;
  *(u32x4*)(lv + lds_off(vr + 32, vc)) = r.v1;
  *(u32x4*)(lv + lds_off(vr + 64, vc)) = r.v2;
  *(u32x4*)(lv + lds_off(vr + 96, vc)) = r.v3;
}

struct QFrag { bf16x8 f0, f1, f2, f3, f4, f5, f6, f7; };
__device__ __forceinline__ void q_load(QFrag& q, const bf16_t* qrow) {
  const int h = (opq(threadIdx.x) & 63) >> 5;
  const bf16x8* p8 = (const bf16x8*)(qrow + 8 * h);
  q.f0 = p8[0]; q.f1 = p8[2]; q.f2 = p8[4]; q.f3 = p8[6]; q.f4 = p8[8]; q.f5 = p8[10]; q.f6 = p8[12]; q.f7 = p8[14];
}

__device__ __forceinline__ void qk_tile(const QFrag& q, const char* lk, f32x16& s0, f32x16& s1) {
  const int lane = opq(threadIdx.x) & 63, row = lane & 31, h = lane >> 5;
#pragma unroll
  for (int r = 0; r < 16; ++r) { s0[r] = 0.f; s1[r] = 0.f; }
#define QK_STEP(kk, qf)                                                                  \
  {                                                                                      \
    bf16x8 a0 = *(const bf16x8*)(lk + koff(row, 2 * (kk) + h));                          \
    bf16x8 a1 = *(const bf16x8*)(lk + koff(row + 32, 2 * (kk) + h));                     \
    s0 = __builtin_amdgcn_mfma_f32_32x32x16_bf16(a0, qf, s0, 0, 0, 0);                   \
    s1 = __builtin_amdgcn_mfma_f32_32x32x16_bf16(a1, qf, s1, 0, 0, 0);                   \
  }
  QK_STEP(0, q.f0) QK_STEP(1, q.f1) QK_STEP(2, q.f2) QK_STEP(3, q.f3)
  QK_STEP(4, q.f4) QK_STEP(5, q.f5) QK_STEP(6, q.f6) QK_STEP(7, q.f7)
#undef QK_STEP
}

__device__ __forceinline__ bf16x8 pack8(const f32x16& p, const int base) {
  u32x4 u;
  u[0] = pack2(p[base + 0], p[base + 1]);
  u[1] = pack2(p[base + 2], p[base + 3]);
  u[2] = pack2(p[base + 4], p[base + 5]);
  u[3] = pack2(p[base + 6], p[base + 7]);
  return __builtin_bit_cast(bf16x8, u);
}

struct OAcc { f32x16 o0, o1, o2, o3; };
__device__ __forceinline__ void oacc_zero(OAcc& o) {
#pragma unroll
  for (int r = 0; r < 16; ++r) { o.o0[r] = 0.f; o.o1[r] = 0.f; o.o2[r] = 0.f; o.o3[r] = 0.f; }
}
__device__ __forceinline__ void oacc_scale(OAcc& o, float a) {
#pragma unroll
  for (int r = 0; r < 16; ++r) { o.o0[r] *= a; o.o1[r] *= a; o.o2[r] *= a; o.o3[r] *= a; }
}

__device__ __forceinline__ void pv_tile(OAcc& o, const char* lv, const f32x16& p0, const f32x16& p1) {
  const int lane = opq(threadIdx.x) & 63, row = lane & 31, h = lane >> 5;
  const bf16x8 pf0 = pack8(p0, 0), pf1 = pack8(p0, 8), pf2 = pack8(p1, 0), pf3 = pack8(p1, 8);
#define PV_ROW(dd, acc)                                                                                      \
  {                                                                                                          \
    acc = __builtin_amdgcn_mfma_f32_32x32x16_bf16(*(const bf16x8*)(lv + lds_off(32 * (dd) + row, 0 + h)), pf0, acc, 0, 0, 0); \
    acc = __builtin_amdgcn_mfma_f32_32x32x16_bf16(*(const bf16x8*)(lv + lds_off(32 * (dd) + row, 2 + h)), pf1, acc, 0, 0, 0); \
    acc = __builtin_amdgcn_mfma_f32_32x32x16_bf16(*(const bf16x8*)(lv + lds_off(32 * (dd) + row, 4 + h)), pf2, acc, 0, 0, 0); \
    acc = __builtin_amdgcn_mfma_f32_32x32x16_bf16(*(const bf16x8*)(lv + lds_off(32 * (dd) + row, 6 + h)), pf3, acc, 0, 0, 0); \
  }
  PV_ROW(0, o.o0) PV_ROW(1, o.o1) PV_ROW(2, o.o2) PV_ROW(3, o.o3)
#undef PV_ROW
}

__device__ __forceinline__ void softmax_tile(f32x16& s0, f32x16& s1, float& m, float& l, OAcc& o) {
  float mx = NEG_BIG;
#pragma unroll
  for (int r = 0; r < 16; ++r) mx = fmaxf(mx, fmaxf(s0[r], s1[r]));
  mx = fmaxf(mx, __shfl_xor(mx, 32));
  const float mn = fmaxf(m, mx);
  const float alpha = __expf(m - mn);
  float ls = 0.f;
#pragma unroll
  for (int r = 0; r < 16; ++r) {
    float a = (s0[r] > -1e29f) ? __expf(s0[r] - mn) : 0.f;
    float b = (s1[r] > -1e29f) ? __expf(s1[r] - mn) : 0.f;
    s0[r] = a; s1[r] = b;
    ls += a + b;
  }
  ls += __shfl_xor(ls, 32);
  l = l * alpha + ls;
  m = mn;
  if (__any(alpha != 1.f)) oacc_scale(o, alpha);
}

template <class F>
__device__ __forceinline__ void oacc_foreach(const OAcc& o, F f) {
  const int h = (opq(threadIdx.x) & 63) >> 5;
#pragma unroll
  for (int rho = 0; rho < 4; ++rho) {
    f(0 + 8 * rho + 4 * h, o.o0[4 * rho], o.o0[4 * rho + 1], o.o0[4 * rho + 2], o.o0[4 * rho + 3]);
    f(32 + 8 * rho + 4 * h, o.o1[4 * rho], o.o1[4 * rho + 1], o.o1[4 * rho + 2], o.o1[4 * rho + 3]);
    f(64 + 8 * rho + 4 * h, o.o2[4 * rho], o.o2[4 * rho + 1], o.o2[4 * rho + 2], o.o2[4 * rho + 3]);
    f(96 + 8 * rho + 4 * h, o.o3[4 * rho], o.o3[4 * rho + 1], o.o3[4 * rho + 2], o.o3[4 * rho + 3]);
  }
}

__device__ __forceinline__ void ph_memattn2(const P& p, char* lds) {
  char* lk = lds;
  char* lv = lds + 16384;
  const int lane = opq(threadIdx.x) & 63, wv = opq(threadIdx.x) >> 6;
  for (int item = blockIdx.x; item < NBATCH * 4 * (SEQ / 128); item += gridDim.x) {
    const int tb = item % (SEQ / 128);
    const int bh = item / (SEQ / 128);
    const int b = bh >> 2, hd = bh & 3;
    const int t = tb * 128 + wv * 32 + (lane & 31);
    QFrag q;
    q_load(q, p.qmemb + (size_t)(b * SEQ + t) * 512 + hd * 128);
    const bf16_t* kb = p.kmemb + (size_t)bh * 256 * 128;
    const bf16_t* vb = p.vmemT + (size_t)bh * 128 * 256;
    OAcc o;
    oacc_zero(o);
    float m = NEG_BIG, l = 0.f;
    KVRegs kv;
    kv_load(kv, kb, 128, vb, 256);
#pragma unroll 1
    for (int ti = 0; ti < 4; ++ti) {
      __syncthreads();
      kv_store(kv, lk, lv);
      __syncthreads();
      {
        const int tn = (ti + 1 < 4) ? ti + 1 : 3;
        kv_load(kv, kb + (size_t)tn * 64 * 128, 128, vb + tn * 64, 256);
      }
      f32x16 s0, s1;
      qk_tile(q, lk, s0, s1);
#pragma unroll
      for (int r = 0; r < 16; ++r) { s0[r] *= ATT_SCALE; s1[r] *= ATT_SCALE; }
      softmax_tile(s0, s1, m, l, o);
      pv_tile(o, lv, s0, s1);
    }
    const float il = 1.f / l;
    const int t2 = tb * 128 + (opq(threadIdx.x) >> 6) * 32 + (opq(threadIdx.x) & 31);
    bf16_t* orow = p.omem + (size_t)(b * SEQ + t2) * 512 + hd * 128;
    oacc_foreach(o, [&](int d, float v0, float v1, float v2, float v3) {
      uint2 u;
      u.x = pack2(v0 * il, v1 * il);
      u.y = pack2(v2 * il, v3 * il);
      *(uint2*)(orow + d) = u;
    });
  }
}

__device__ __forceinline__ void ph_sb2(const P& p, char* lds) {
  char* lk = lds;
  char* lv = lds + 16384;
  const int lane = opq(threadIdx.x) & 63, wv = opq(threadIdx.x) >> 6, hh = lane >> 5;
  const int sb_skip = (gridDim.x > 32) ? 16 : 0;
  if ((int)blockIdx.x < sb_skip) return;
  for (int item = (int)blockIdx.x - sb_skip; item < NBATCH * 8 * (SEQ / 128); item += (int)gridDim.x - sb_skip) {
    const int tb = (SEQ / 128 - 1) - (item % (SEQ / 128));
    const int bh = item / (SEQ / 128);
    const int b = bh >> 3, hd = bh & 7;
    const int t0 = tb * 128;
    const int t = t0 + wv * 32 + (lane & 31);
    QFrag q;
    q_load(q, p.qsb + (size_t)(b * SEQ + t) * 1024 + hd * 128);
    const bf16_t* kb = p.ksb + (size_t)bh * SEQ * 128;
    const bf16_t* vb = p.vsbT + (size_t)bh * 128 * SEQ;
    OAcc o;
    oacc_zero(o);
    float carry = 0.f;
    const int jhi = (t0 >> 6) + 1;
    const int jw = (t0 + wv * 32 + 30) >> 6;
    KVRegs kv;
    kv_load(kv, kb + (size_t)jhi * 64 * 128, 128, vb + jhi * 64, SEQ);
    volatile unsigned* dflag = (volatile unsigned*)(lds + 32768);
    __syncthreads();
    if (opq(threadIdx.x) < 4) dflag[opq(threadIdx.x)] = 0u;
    for (int j = jhi; j >= 0; --j) {
      __syncthreads();
      if ((dflag[0] & dflag[1] & dflag[2] & dflag[3]) != 0u) break;
      kv_store(kv, lk, lv);
      __syncthreads();
      const int jn = (j > 0) ? j - 1 : 0;
      if (j > jw) kv_load(kv, kb + (size_t)jn * 64 * 128, 128, vb + jn * 64, SEQ);
      if (j <= jw) {
        f32x16 z0, z1;
        qk_tile(q, lk, z0, z1);
        const int sbase = j * 64 + 4 * hh;
        float gt[8];
        f32x16 l0, l1;
#pragma unroll
        for (int r = 0; r < 16; ++r) {
          const int so = sbase + 8 * (r >> 2) + (r & 3);
          {
            const float z = z0[r] * ATT_SCALE;
            const bool valid = so < t;
            const float lsp = fminf(z, 0.f) - __logf(1.f + __expf(-fabsf(z)));
            l0[r] = valid ? (lsp - z) : 0.f;
            z0[r] = valid ? z : NEG_BIG;
          }
          {
            const float z = z1[r] * ATT_SCALE;
            const bool valid = so + 32 < t;
            const float lsp = fminf(z, 0.f) - __logf(1.f + __expf(-fabsf(z)));
            l1[r] = valid ? (lsp - z) : 0.f;
            z1[r] = valid ? z : NEG_BIG;
          }
        }
#pragma unroll
        for (int rho = 0; rho < 4; ++rho) {
          gt[rho] = (l0[4 * rho] + l0[4 * rho + 1]) + (l0[4 * rho + 2] + l0[4 * rho + 3]);
          gt[4 + rho] = (l1[4 * rho] + l1[4 * rho + 1]) + (l1[4 * rho + 2] + l1[4 * rho + 3]);
        }
        float ag[8];
        float run = 0.f;
#pragma unroll
        for (int k = 7; k >= 0; --k) {
          const float pg = __shfl_xor(gt[k], 32);
          ag[k] = carry + run + (hh == 0 ? pg : 0.f);
          run += gt[k] + pg;
        }
        carry += run;
#pragma unroll
        for (int rho = 0; rho < 4; ++rho) {
          {
            const float x3 = l0[4 * rho + 3], x23 = x3 + l0[4 * rho + 2], x123 = x23 + l0[4 * rho + 1];
            const float g = ag[rho];
            z0[4 * rho + 0] = __expf((l0[4 * rho + 0] + z0[4 * rho + 0]) + (g + x123));
            z0[4 * rho + 1] = __expf((l0[4 * rho + 1] + z0[4 * rho + 1]) + (g + x23));
            z0[4 * rho + 2] = __expf((l0[4 * rho + 2] + z0[4 * rho + 2]) + (g + x3));
            z0[4 * rho + 3] = __expf((l0[4 * rho + 3] + z0[4 * rho + 3]) + g);
          }
          {
            const float x3 = l1[4 * rho + 3], x23 = x3 + l1[4 * rho + 2], x123 = x23 + l1[4 * rho + 1];
            const float g = ag[4 + rho];
            z1[4 * rho + 0] = __expf((l1[4 * rho + 0] + z1[4 * rho + 0]) + (g + x123));
            z1[4 * rho + 1] = __expf((l1[4 * rho + 1] + z1[4 * rho + 1]) + (g + x23));
            z1[4 * rho + 2] = __expf((l1[4 * rho + 2] + z1[4 * rho + 2]) + (g + x3));
            z1[4 * rho + 3] = __expf((l1[4 * rho + 3] + z1[4 * rho + 3]) + g);
          }
        }
        kv_load(kv, kb + (size_t)jn * 64 * 128, 128, vb + jn * 64, SEQ);
        pv_tile(o, lv, z0, z1);
        if (__all(carry < -104.f) && (opq(threadIdx.x) & 63) == 0) dflag[wv] = 1u;
      }
    }
    int t2 = t;
    asm volatile("" : "+v"(t2));
    bf16_t* orow = p.omix + (size_t)(b * SEQ + t2) * DM + 1024 + hd * 128;
    oacc_foreach(o, [&](int d, float v0, float v1, float v2, float v3) {
      uint2 u;
      u.x = pack2(v0, v1);
      u.y = pack2(v2, v3);
      *(uint2*)(orow + d) = u;
    });
  }
}

#define NSA_IMP 32768
#define NSA_KEYS 49152
#define NSA_SELM 53504
#define NSA_LUT 53632
__device__ __forceinline__ void ph_nsa2(const P& p, char* lds) {
  typedef __attribute__((ext_vector_type(4))) float f32x4;
  char* lk = lds;
  char* lv = lds + 16384;
  float* imp = (float*)(lds + NSA_IMP);
  float* keys = (float*)(lds + NSA_KEYS);
  unsigned* selm = (unsigned*)(lds + NSA_SELM);
  const int tid = opq(threadIdx.x), lane = tid & 63, wv = tid >> 6, hh = lane >> 5, ql = lane & 31;
  float* lut = (float*)(lds + NSA_LUT) + wv * 128;
  for (int item = blockIdx.x; item < NBATCH * 2 * (SEQ / 32); item += gridDim.x) {
    const int tt = (item < 256) ? (SEQ / 32 - 1) - (item % (SEQ / 32)) : (item % (SEQ / 32));
    const int bg = item / (SEQ / 32);
    const int b = bg >> 1, g = bg & 1;
    const int h = g * 4 + wv;
    const int t0 = tt * 32, tq = t0 + ql, cur = t0 >> 6;
    __syncthreads();
    QFrag q;
    q_load(q, p.qn + (size_t)(b * SEQ + tq) * 1024 + h * 128);
    {
      const int lo = opq(lane);
      lut[lo] = p.t5[t5_bucket(lo) * 8 + h];
      lut[lo + 64] = p.t5[t5_bucket(lo + 64) * 8 + h];
    }
#pragma unroll
    for (int i = 0; i < 16; ++i) imp[i * 256 + tid] = 0.f;
    if (tid < 32) selm[tid] = 0u;
    const float* grow = p.gates + (size_t)(b * SEQ + tq) * 24 + h * 3;
    float* prow = p.part + (size_t)(b * SEQ + tq) * 1024 + h * 128;
    OAcc o;
    float m, l;
    KVRegs kv;
    {
      const bf16_t* kb = p.kcb + (size_t)bg * 128 * 128;
      const bf16_t* vb = p.vcT + (size_t)bg * 128 * 128;
      oacc_zero(o);
      m = NEG_BIG; l = 0.f;
      kv_load(kv, kb, 128, vb, 128);
      __syncthreads();
      kv_store(kv, lk, lv);
      __syncthreads();
      f32x16 x0, x1;
      qk_tile(q, lk, x0, x1);
      int tqv = tq;
      asm volatile("" : "+v"(tqv));
      tqv -= 64 * hh;
      if (t0 >= 1152) {
        const float b31 = lut[127];
#pragma unroll
        for (int r = 0; r < 16; ++r) { x0[r] = x0[r] * ATT_SCALE + b31; x1[r] = x1[r] * ATT_SCALE + b31; }
      } else {
#pragma unroll
        for (int r = 0; r < 16; ++r) {
          const int c = 8 * (r >> 2) + (r & 3);
          const int d0 = tqv - 16 * c - 31, d1 = d0 - 512;
          x0[r] = (d0 >= 0) ? x0[r] * ATT_SCALE + lut[min(d0, 127)] : NEG_BIG;
          x1[r] = (d1 >= 0) ? x1[r] * ATT_SCALE + lut[min(d1, 127)] : NEG_BIG;
        }
      }
      softmax_tile(x0, x1, m, l, o);
      const float m0 = m;
      pv_tile(o, lv, x0, x1);
      f32x16 z0, z1;
#pragma unroll
      for (int r = 0; r < 16; ++r) { z0[r] = 0.f; z1[r] = 0.f; }
      if (t0 >= 1024) {
        kv_load(kv, kb + 64 * 128, 128, vb + 64, 128);
        __syncthreads();
        kv_store(kv, lk, lv);
        __syncthreads();
        qk_tile(q, lk, z0, z1);
        asm volatile("" : "+v"(tqv));
#pragma unroll
        for (int r = 0; r < 16; ++r) {
          const int c = 64 + 8 * (r >> 2) + (r & 3);
          const int d0 = tqv - 16 * c - 31, d1 = d0 - 512;
          z0[r] = (d0 >= 0) ? z0[r] * ATT_SCALE + lut[min(d0, 127)] : NEG_BIG;
          z1[r] = (d1 >= 0) ? z1[r] * ATT_SCALE + lut[min(d1, 127)] : NEG_BIG;
        }
        softmax_tile(z0, z1, m, l, o);
        pv_tile(o, lv, z0, z1);
      }
      const float inv = 1.f / fmaxf(l, 1e-20f);
      const float c0 = __expf(m0 - m) * inv;
#pragma unroll
      for (int r = 0; r < 16; ++r) {
        const int c = 8 * (r >> 2) + (r & 3) + 4 * hh;
        if (x0[r] != 0.f) atomicAdd(&imp[(c) * 32 + ql], x0[r] * c0);
        if (x1[r] != 0.f) atomicAdd(&imp[(c + 32) * 32 + ql], x1[r] * c0);
        if (z0[r] != 0.f) atomicAdd(&imp[(c + 64) * 32 + ql], z0[r] * inv);
        if (z1[r] != 0.f) atomicAdd(&imp[(c + 96) * 32 + ql], z1[r] * inv);
      }
      const float gs = inv / (1.f + __expf(-grow[0]));
      oacc_foreach(o, [&](int d, float v0, float v1, float v2, float v3) {
        f32x4 u = {v0 * gs, v1 * gs, v2 * gs, v3 * gs};
        *(f32x4*)(prow + d) = u;
      });
    }
    __syncthreads();
    {
      const int tido = opq(tid);
      const int qq = tido & 31, jg = tido >> 5;
#pragma unroll
      for (int jj = 0; jj < 4; ++jj) {
        const int j = jg * 4 + jj;
        float v = imp[(4 * j) * 32 + qq] + imp[(4 * j + 1) * 32 + qq] + imp[(4 * j + 2) * 32 + qq] + 0.5f * imp[(4 * j + 3) * 32 + qq];
        if (j > 0) v += 0.5f * imp[(4 * j - 1) * 32 + qq];
        const bool forced = (j == 0) || (j == cur) || (j == cur - 1);
        keys[qq * 33 + j] = forced ? 1e9f : ((j <= cur) ? v : -1e9f);
      }
      __syncthreads();
      unsigned bits = 0u;
#pragma unroll
      for (int jj = 0; jj < 4; ++jj) {
        const int j = jg * 4 + jj;
        const float kj = keys[qq * 33 + j];
        int rank = 0;
        for (int i = 0; i < 32; ++i) {
          const float ki = keys[qq * 33 + i];
          rank += (ki > kj || (ki == kj && i < j)) ? 1 : 0;
        }
        if (rank < 16 && j <= cur) bits |= 1u << j;
      }
      atomicOr(&selm[qq], bits);
      __syncthreads();
    }
    const unsigned mysel = selm[ql];
    unsigned um = mysel;
#pragma unroll
    for (int o2 = 16; o2 > 0; o2 >>= 1) um |= (unsigned)__shfl_xor((int)um, o2);
    um = (unsigned)__builtin_amdgcn_readfirstlane((int)um);
    {
      const bf16_t* kb = p.ks + (size_t)bg * SEQ * 128;
      const bf16_t* vb = p.vsT + (size_t)bg * 128 * SEQ;
      oacc_zero(o);
      m = NEG_BIG; l = 0.f;
      unsigned rem = um;
      int j = __builtin_ctz(rem);
      kv_load(kv, kb + (size_t)j * 64 * 128, 128, vb + j * 64, SEQ);
      while (rem) {
        j = __builtin_ctz(rem);
        rem &= rem - 1;
        const int jn = rem ? __builtin_ctz(rem) : j;
        __syncthreads();
        kv_store(kv, lk, lv);
        __syncthreads();
        f32x16 s0, s1;
        qk_tile(q, lk, s0, s1);
        const bool selq = (mysel >> j) & 1u;
        int tqv = tq;
        asm volatile("" : "+v"(tqv));
        if (j * 64 + 63 + 113 <= t0) {
          const float sc = selq ? ATT_SCALE : 0.f, bb = selq ? lut[127] : NEG_BIG;
#pragma unroll
          for (int r = 0; r < 16; ++r) { s0[r] = s0[r] * sc + bb; s1[r] = s1[r] * sc + bb; }
        } else {
#pragma unroll
          for (int r = 0; r < 16; ++r) {
            const int d0 = tqv - (j * 64 + 8 * (r >> 2) + (r & 3) + 4 * hh), d1 = d0 - 32;
            s0[r] = (selq && d0 >= 0) ? s0[r] * ATT_SCALE + lut[min(d0, 127)] : NEG_BIG;
            s1[r] = (selq && d1 >= 0) ? s1[r] * ATT_SCALE + lut[min(d1, 127)] : NEG_BIG;
          }
        }
        kv_load(kv, kb + (size_t)jn * 64 * 128, 128, vb + jn * 64, SEQ);
        softmax_tile(s0, s1, m, l, o);
        pv_tile(o, lv, s0, s1);
      }
      const float gs = 1.f / (fmaxf(l, 1e-20f) * (1.f + __expf(-grow[1])));
      int qo = ql;
      asm volatile("" : "+v"(qo));
      float* pr2 = p.part + (size_t)(b * SEQ + t0 + qo) * 1024 + h * 128;
      oacc_foreach(o, [&](int d, float v0, float v1, float v2, float v3) {
        f32x4 u = *(f32x4*)(pr2 + d);
        u[0] += v0 * gs; u[1] += v1 * gs; u[2] += v2 * gs; u[3] += v3 * gs;
        *(f32x4*)(pr2 + d) = u;
      });
    }
    {
      const bf16_t* kb = p.kw + (size_t)bg * SEQ * 128;
      const bf16_t* vb = p.vwT + (size_t)bg * 128 * SEQ;
      oacc_zero(o);
      m = NEG_BIG; l = 0.f;
      int jlo = (t0 - 511) >> 6;
      if (jlo < 0) jlo = 0;
      kv_load(kv, kb + (size_t)jlo * 64 * 128, 128, vb + jlo * 64, SEQ);
      for (int j = jlo; j <= cur; ++j) {
        const int jn = (j < cur) ? j + 1 : j;
        __syncthreads();
        kv_store(kv, lk, lv);
        __syncthreads();
        f32x16 s0, s1;
        qk_tile(q, lk, s0, s1);
        int tqv = tq;
        asm volatile("" : "+v"(tqv));
        if (j * 64 + 63 + 113 <= t0 && t0 + 31 - j * 64 < 512) {
          const float b31 = lut[127];
#pragma unroll
          for (int r = 0; r < 16; ++r) { s0[r] = s0[r] * ATT_SCALE + b31; s1[r] = s1[r] * ATT_SCALE + b31; }
        } else {
#pragma unroll
          for (int r = 0; r < 16; ++r) {
            const int d0 = tqv - (j * 64 + 8 * (r >> 2) + (r & 3) + 4 * hh), d1 = d0 - 32;
            s0[r] = (d0 >= 0 && d0 < 512) ? s0[r] * ATT_SCALE + lut[min(d0, 127)] : NEG_BIG;
            s1[r] = (d1 >= 0 && d1 < 512) ? s1[r] * ATT_SCALE + lut[min(d1, 127)] : NEG_BIG;
          }
        }
        kv_load(kv, kb + (size_t)jn * 64 * 128, 128, vb + jn * 64, SEQ);
        softmax_tile(s0, s1, m, l, o);
        pv_tile(o, lv, s0, s1);
      }
      const float gs = 1.f / (fmaxf(l, 1e-20f) * (1.f + __expf(-grow[2])));
      int qo = ql;
      asm volatile("" : "+v"(qo));
      const float* pr2 = p.part + (size_t)(b * SEQ + t0 + qo) * 1024 + h * 128;
      bf16_t* orow = p.omix + (size_t)(b * SEQ + t0 + qo) * DM + h * 128;
      oacc_foreach(o, [&](int d, float v0, float v1, float v2, float v3) {
        const f32x4 u = *(const f32x4*)(pr2 + d);
        uint2 w;
        w.x = pack2(u[0] + v0 * gs, u[1] + v1 * gs);
        w.y = pack2(u[2] + v2 * gs, u[3] + v3 * gs);
        *(uint2*)(orow + d) = w;
      });
    }
  }
}

__device__ __forceinline__ void ph_cvt(const float* src, bf16_t* dst, size_t n) {
  typedef __attribute__((ext_vector_type(4))) float f32x4;
  const size_t nv = n / 8;
  for (size_t i = (size_t)blockIdx.x * 256 + opq(threadIdx.x); i < nv; i += (size_t)gridDim.x * 256) {
    const f32x4 a = ((const f32x4*)src)[2 * i], b = ((const f32x4*)src)[2 * i + 1];
    u32x4 o;
    o[0] = pack2(a[0], a[1]); o[1] = pack2(a[2], a[3]); o[2] = pack2(b[0], b[1]); o[3] = pack2(b[2], b[3]);
    ((u32x4*)dst)[i] = o;
  }
}

__device__ __forceinline__ void ph_scores(const P& p, char* lds) {
  for (int u = blockIdx.x; u < 64 * 16; u += gridDim.x) {
    const int tm = u & 63, hp = u >> 6;
    const int m0 = tm * 128;
    float* sc = p.scores + (size_t)m0 * DM + hp * 128;
    gemm_tile_bf16<false>(p.omix + (size_t)m0 * DM + hp * 128, DM, p.subkb + (size_t)hp * 128 * 128, 128, 128, lds,
                          [&](int r, int c, float val) { sc[(size_t)r * DM + c] = val; });
  }
}

__device__ __forceinline__ void ph_qp_scores(const P& p, char* lds) {
  const int ntm = T_TOK / 128, ntn = DM / 128;
  const int npm = (ntm + 7) / 8, npn = (ntn + 7) / 8;
  const int nslots = ((npm * npn * 64 + 511) / 512) * 512;
  for (int u = blockIdx.x; u < nslots; u += gridDim.x) {
    int v = (u & 7) * 64 + ((u >> 3) & 63) + (u & ~511);
    int patch = v >> 6, w = v & 63;
    int tm = (patch % npm) * 8 + (w & 7);
    int tn = (patch / npm) * 8 + (w >> 3);
    if (tm >= ntm || tn >= ntn) continue;
    const int m0 = tm * 128, n0 = tn * 128;
    bf16_t* qp = p.omix + (size_t)m0 * DM + n0;
    gemm_tile_bf16<false>(p.hn + (size_t)m0 * DM, DM, p.WpqT + (size_t)n0 * DM, DM, DM, lds,
                          [&](int r, int c, float val) { qp[(size_t)r * DM + c] = f2bf(val); });
    __threadfence_block();
    __syncthreads();
    float* sc = p.scores + (size_t)m0 * DM + n0;
    gemm_tile_bf16<false>(qp, DM, p.subkb + (size_t)tn * 128 * 128, 128, 128, lds,
                          [&](int r, int c, float val) { sc[(size_t)r * DM + c] = val; });
  }
}

__device__ __forceinline__ void ph_cvt4(const float* src, unsigned char* dst, float* scales, int nrows, int wid0, int nw) {
  typedef __attribute__((ext_vector_type(4))) float f32x4;
  typedef __attribute__((ext_vector_type(2))) float f32x2;
  const int lane = opq(threadIdx.x) & 63;
  const float one = __uint_as_float((unsigned)opq(0x3F800000));
  float lev[8];
#pragma unroll
  for (int c = 0; c < 8; ++c) {
    const f32x2 q = __builtin_amdgcn_cvt_scalef32_pk_f32_fp4((unsigned)opq(c * 0x11111111), one, 0);
    lev[c] = fabsf(q[0]);
  }
  const float maxlev = lev[7];
  for (int row = wid0; row < nrows; row += nw) {
    const f32x4* s4 = (const f32x4*)(src + (size_t)row * DM) + lane * 8;
    f32x4 v[8];
    float amax = 0.f;
#pragma unroll
    for (int i = 0; i < 8; ++i) {
      v[i] = s4[i];
#pragma unroll
      for (int k = 0; k < 4; ++k) amax = fmaxf(amax, fabsf(v[i][k]));
    }
    amax = wave_max(amax);
    const float sc = (amax > 0.f) ? maxlev / amax : 1.f;
    u32x4 o;
#pragma unroll
    for (int w = 0; w < 4; ++w) {
      unsigned pk = 0u;
      pk = __builtin_amdgcn_cvt_scalef32_pk_fp4_f32(pk, v[2 * w][0] * sc, v[2 * w][1] * sc, 1.0f, 0);
      pk = __builtin_amdgcn_cvt_scalef32_pk_fp4_f32(pk, v[2 * w][2] * sc, v[2 * w][3] * sc, 1.0f, 1);
      pk = __builtin_amdgcn_cvt_scalef32_pk_fp4_f32(pk, v[2 * w + 1][0] * sc, v[2 * w + 1][1] * sc, 1.0f, 2);
      pk = __builtin_amdgcn_cvt_scalef32_pk_fp4_f32(pk, v[2 * w + 1][2] * sc, v[2 * w + 1][3] * sc, 1.0f, 3);
      o[w] = pk;
    }
    *(u32x4*)(dst + (size_t)row * 1024 + lane * 16) = o;
    if (lane == 0) scales[row] = (amax > 0.f) ? amax / maxlev : 1.f;
  }
}

__device__ __forceinline__ u32x4 r4_load(const unsigned char* tab, int eid, int lane) {
  return *((const u32x4*)(tab + (size_t)eid * 1024) + lane);
}
struct XPk { f32x16 a, b; };
struct Acc32 { f32x16 a, b; };

#define R4_DOT_W(word, xv, base, pa, pb)                                                             \
  {                                                                                                  \
    typedef __attribute__((ext_vector_type(2))) float f32x2;                                         \
    const f32x2 q0 = __builtin_amdgcn_cvt_scalef32_pk_f32_fp4(word, one, 0), q1 = __builtin_amdgcn_cvt_scalef32_pk_f32_fp4(word, one, 1); \
    const f32x2 q2 = __builtin_amdgcn_cvt_scalef32_pk_f32_fp4(word, one, 2), q3 = __builtin_amdgcn_cvt_scalef32_pk_f32_fp4(word, one, 3); \
    pa += q0[0] * xv[base + 0] + q0[1] * xv[base + 1]; pb += q1[0] * xv[base + 2] + q1[1] * xv[base + 3]; \
    pa += q2[0] * xv[base + 4] + q2[1] * xv[base + 5]; pb += q3[0] * xv[base + 6] + q3[1] * xv[base + 7]; \
  }
__device__ __forceinline__ float r4_dot(const u32x4& e, const XPk& x) {
  const float one = __uint_as_float((unsigned)opq(0x3F800000));
  float pa = 0.f, pb = 0.f;
  R4_DOT_W(e[0], x.a, 0, pa, pb) R4_DOT_W(e[1], x.a, 8, pa, pb) R4_DOT_W(e[2], x.b, 0, pa, pb) R4_DOT_W(e[3], x.b, 8, pa, pb)
  return pa + pb;
}
#define R4_AXPY_W(word, accv, base)                                                                  \
  {                                                                                                  \
    typedef __attribute__((ext_vector_type(2))) float f32x2;                                         \
    const f32x2 q0 = __builtin_amdgcn_cvt_scalef32_pk_f32_fp4(word, one, 0), q1 = __builtin_amdgcn_cvt_scalef32_pk_f32_fp4(word, one, 1); \
    const f32x2 q2 = __builtin_amdgcn_cvt_scalef32_pk_f32_fp4(word, one, 2), q3 = __builtin_amdgcn_cvt_scalef32_pk_f32_fp4(word, one, 3); \
    accv[base + 0] += hid * q0[0]; accv[base + 1] += hid * q0[1]; accv[base + 2] += hid * q1[0]; accv[base + 3] += hid * q1[1]; \
    accv[base + 4] += hid * q2[0]; accv[base + 5] += hid * q2[1]; accv[base + 6] += hid * q3[0]; accv[base + 7] += hid * q3[1]; \
  }
__device__ __forceinline__ void r4_axpy(const u32x4& e, float hid, Acc32& acc) {
  const float one = __uint_as_float((unsigned)opq(0x3F800000));
  R4_AXPY_W(e[0], acc.a, 0) R4_AXPY_W(e[1], acc.a, 8) R4_AXPY_W(e[2], acc.b, 0) R4_AXPY_W(e[3], acc.b, 8)
}

#define INS16(K, x)                                                                                      \
  K##15 = __builtin_amdgcn_fmed3f(K##15, K##14, x); K##14 = __builtin_amdgcn_fmed3f(K##14, K##13, x);   \
  K##13 = __builtin_amdgcn_fmed3f(K##13, K##12, x); K##12 = __builtin_amdgcn_fmed3f(K##12, K##11, x);   \
  K##11 = __builtin_amdgcn_fmed3f(K##11, K##10, x); K##10 = __builtin_amdgcn_fmed3f(K##10, K##9, x);    \
  K##9 = __builtin_amdgcn_fmed3f(K##9, K##8, x); K##8 = __builtin_amdgcn_fmed3f(K##8, K##7, x);         \
  K##7 = __builtin_amdgcn_fmed3f(K##7, K##6, x); K##6 = __builtin_amdgcn_fmed3f(K##6, K##5, x);         \
  K##5 = __builtin_amdgcn_fmed3f(K##5, K##4, x); K##4 = __builtin_amdgcn_fmed3f(K##4, K##3, x);         \
  K##3 = __builtin_amdgcn_fmed3f(K##3, K##2, x); K##2 = __builtin_amdgcn_fmed3f(K##2, K##1, x);         \
  K##1 = __builtin_amdgcn_fmed3f(K##1, K##0, x); K##0 = fmaxf(K##0, x);
#define DECL16(K) float K##0 = -INFINITY, K##1 = -INFINITY, K##2 = -INFINITY, K##3 = -INFINITY, K##4 = -INFINITY, \
  K##5 = -INFINITY, K##6 = -INFINITY, K##7 = -INFINITY, K##8 = -INFINITY, K##9 = -INFINITY, K##10 = -INFINITY,   \
  K##11 = -INFINITY, K##12 = -INFINITY, K##13 = -INFINITY, K##14 = -INFINITY, K##15 = -INFINITY;
__device__ __forceinline__ float mkkey(float v, unsigned tag, unsigned mask) {
  return __uint_as_float((__float_as_uint(v) & ~mask) | tag);
}

__device__ __forceinline__ void ph_peer(const P& p, float* smem) {
  typedef __attribute__((ext_vector_type(4))) float f32x4;
  float* lists = smem;
  int* bexA = (int*)(smem + 4096);
  float* bgtA = smem + 6144;
  float* bsuA = smem + 8192;
  for (int item = blockIdx.x; item < T_TOK / 16; item += gridDim.x) {
    const int t0 = item * 16;
    __syncthreads();
    {
      const int tid = opq(threadIdx.x);
      const int tl = tid >> 4, hp = tid & 15;
      const f32x4* sp = (const f32x4*)(p.scores + (size_t)(t0 + tl) * DM + hp * 128);
      DECL16(k)
#pragma unroll 4
      for (int c4 = 0; c4 < 32; ++c4) {
        const f32x4 v = sp[c4];
#pragma unroll
        for (int e = 0; e < 4; ++e) {
          const float x = mkkey(v[e], 127u - (unsigned)(c4 * 4 + e), 127u);
          INS16(k, x)
        }
      }
      f32x4* lp = (f32x4*)(lists + (size_t)opq(threadIdx.x) * 16);
      f32x4 o0 = {k0, k1, k2, k3}, o1 = {k4, k5, k6, k7}, o2 = {k8, k9, k10, k11}, o3 = {k12, k13, k14, k15};
      lp[0] = o0; lp[1] = o1; lp[2] = o2; lp[3] = o3;
    }
    __syncthreads();
    if (opq(threadIdx.x) < 128) {
      const int tid = opq(threadIdx.x);
      const int tl = tid >> 3, h = tid & 7;
      const float* la = lists + (size_t)(tl * 16 + 2 * h) * 16;
      const float* lb = la + 16;
      float av[16], bv[16];
#pragma unroll
      for (int i = 0; i < 16; ++i) {
        av[i] = __uint_as_float(__float_as_uint(la[i]) & ~127u);
        bv[i] = __uint_as_float(__float_as_uint(lb[i]) & ~127u);
      }
      DECL16(c)
#pragma unroll
      for (int i = 0; i < 16; ++i) {
#pragma unroll
        for (int j = 0; j < 16; ++j) {
          if ((i + 1) * (j + 1) <= 16) {
            const float x = mkkey(av[i] + bv[j], 255u - (unsigned)(i * 16 + j), 255u);
            INS16(c, x)
          }
        }
      }
      float cs[16] = {c0, c1, c2, c3, c4, c5, c6, c7, c8, c9, c10, c11, c12, c13, c14, c15};
      float ev[16];
      float sum = 0.f;
      const float mx = __uint_as_float(__float_as_uint(cs[0]) & ~255u);
#pragma unroll
      for (int n = 0; n < 16; ++n) {
        ev[n] = __expf(__uint_as_float(__float_as_uint(cs[n]) & ~255u) - mx);
        sum += ev[n];
      }
      const float isum = 1.f / sum;
#pragma unroll
      for (int n = 0; n < 16; ++n) {
        const unsigned cc = 255u - (__float_as_uint(cs[n]) & 255u);
        const unsigned ka = 127u - (__float_as_uint(la[cc >> 4]) & 127u);
        const unsigned kb = 127u - (__float_as_uint(lb[cc & 15u]) & 127u);
        const int eid = (int)(ka * 128u + kb);
        bexA[tl * 128 + h * 16 + n] = eid;
        bgtA[tl * 128 + h * 16 + n] = ev[n] * isum * p.sv8[eid];
        bsuA[tl * 128 + h * 16 + n] = p.su8[eid];
      }
    }
    __syncthreads();
#pragma unroll 1
    for (int ti4 = 0; ti4 < 4; ++ti4) {
    const int lane = opq(threadIdx.x) & 63, wv = opq(threadIdx.x) >> 6;
    const int tl = wv * 4 + ti4;
    const int t = t0 + tl;
    const int* bex = bexA + tl * 128;
    const float* bgt = bgtA + tl * 128;
    const float* bsu = bsuA + tl * 128;
    XPk x;
    {
      const f32x4* s4 = (const f32x4*)(p.out + (size_t)t * DM) + lane * 8;
      const f32x4* g4 = (const f32x4*)p.norm_ffn + lane * 8;
      f32x4 a0 = s4[0], a1 = s4[1], a2 = s4[2], a3 = s4[3], a4 = s4[4], a5 = s4[5], a6 = s4[6], a7 = s4[7];
      float ss = 0.f;
#define SSQ(v) ss += v[0] * v[0] + v[1] * v[1] + v[2] * v[2] + v[3] * v[3];
      SSQ(a0) SSQ(a1) SSQ(a2) SSQ(a3) SSQ(a4) SSQ(a5) SSQ(a6) SSQ(a7)
#undef SSQ
      ss = wave_sum(ss);
      const float rs = rsqrtf(ss * (1.f / DM) + RMS_EPS);
#define XPK(dst, base, va, vb, gi)                                                    \
  {                                                                                   \
    const f32x4 ga = g4[gi], gb = g4[gi + 1];                                         \
    dst[base + 0] = bf2f(f2bf(va[0] * rs * ga[0])); dst[base + 1] = bf2f(f2bf(va[1] * rs * ga[1]));   \
    dst[base + 2] = bf2f(f2bf(va[2] * rs * ga[2])); dst[base + 3] = bf2f(f2bf(va[3] * rs * ga[3]));   \
    dst[base + 4] = bf2f(f2bf(vb[0] * rs * gb[0])); dst[base + 5] = bf2f(f2bf(vb[1] * rs * gb[1]));   \
    dst[base + 6] = bf2f(f2bf(vb[2] * rs * gb[2])); dst[base + 7] = bf2f(f2bf(vb[3] * rs * gb[3]));   \
  }
      XPK(x.a, 0, a0, a1, 0) XPK(x.a, 8, a2, a3, 2) XPK(x.b, 0, a4, a5, 4) XPK(x.b, 8, a6, a7, 6)
#undef XPK
    }
    Acc32 acc;
#pragma unroll
    for (int r = 0; r < 16; ++r) { acc.a[r] = 0.f; acc.b[r] = 0.f; }
    u32x4 u0 = r4_load(p.pu8, bex[0], lane), u1 = r4_load(p.pu8, bex[1], lane), u2 = r4_load(p.pu8, bex[2], lane), u3 = r4_load(p.pu8, bex[3], lane);
    u32x4 v0 = r4_load(p.pv8, bex[0], lane), v1 = r4_load(p.pv8, bex[1], lane), v2 = r4_load(p.pv8, bex[2], lane), v3 = r4_load(p.pv8, bex[3], lane);
#pragma unroll 1
    for (int e0 = 0; e0 < 128; e0 += 4) {
      float d0 = r4_dot(u0, x), d1 = r4_dot(u1, x), d2 = r4_dot(u2, x), d3 = r4_dot(u3, x);
      const int en = (e0 + 4 < 128) ? e0 + 4 : 124;
      const int i0 = bex[en], i1 = bex[en + 1], i2 = bex[en + 2], i3 = bex[en + 3];
      u0 = r4_load(p.pu8, i0, lane); u1 = r4_load(p.pu8, i1, lane); u2 = r4_load(p.pu8, i2, lane); u3 = r4_load(p.pu8, i3, lane);
#pragma unroll
      for (int o = 32; o > 0; o >>= 1) {
        d0 += __shfl_xor(d0, o); d1 += __shfl_xor(d1, o); d2 += __shfl_xor(d2, o); d3 += __shfl_xor(d3, o);
      }
      { const float hid = bgt[e0 + 0] * gelu_fast(d0 * bsu[e0 + 0]); r4_axpy(v0, hid, acc); }
      { const float hid = bgt[e0 + 1] * gelu_fast(d1 * bsu[e0 + 1]); r4_axpy(v1, hid, acc); }
      { const float hid = bgt[e0 + 2] * gelu_fast(d2 * bsu[e0 + 2]); r4_axpy(v2, hid, acc); }
      { const float hid = bgt[e0 + 3] * gelu_fast(d3 * bsu[e0 + 3]); r4_axpy(v3, hid, acc); }
      v0 = r4_load(p.pv8, i0, lane); v1 = r4_load(p.pv8, i1, lane); v2 = r4_load(p.pv8, i2, lane); v3 = r4_load(p.pv8, i3, lane);
    }
    const int lane2 = opq(lane);
    f32x4* o4 = (f32x4*)(p.out + (size_t)t * DM) + lane2 * 8;
    const f32x4* g4 = (const f32x4*)p.norm_final + lane2 * 8;
    f32x4 hv[8];
    float ss = 0.f;
#pragma unroll
    for (int i = 0; i < 8; ++i) {
      hv[i] = o4[i];
#pragma unroll
      for (int k = 0; k < 4; ++k) {
        hv[i][k] += (i < 4) ? acc.a[4 * i + k] : acc.b[4 * (i - 4) + k];
        ss += hv[i][k] * hv[i][k];
      }
    }
    ss = wave_sum(ss);
    const float rs = rsqrtf(ss * (1.f / DM) + RMS_EPS);
#pragma unroll
    for (int i = 0; i < 8; ++i) {
      const f32x4 g = g4[i];
      f32x4 o;
#pragma unroll
      for (int k = 0; k < 4; ++k) o[k] = hv[i][k] * rs * g[k];
      o4[i] = o;
    }
    }
  }
}

#define XB_TMO      128
#define XB_XCNT(j)  (256  + 64 * (j))
#define XB_XSUB(j)  (1280 + 64 * (j))
#define XB_XGEN(j)  (2304 + 64 * (j))
#define XB_TOP      3328
#define XB_TOPGEN   3392
#define XCD_BAR_WORDS 3456
#define XB_SPIN_CAP (1u << 22)
#define LAS __attribute__((address_space(3)))
__device__ __forceinline__ unsigned xb_ld(unsigned* p) { return __hip_atomic_load(p, __ATOMIC_RELAXED, __HIP_MEMORY_SCOPE_AGENT); }
__device__ __forceinline__ unsigned xb_add(unsigned* p, unsigned v) { return __hip_atomic_fetch_add(p, v, __ATOMIC_RELAXED, __HIP_MEMORY_SCOPE_AGENT); }
__device__ __forceinline__ unsigned xb_xcc_id() { return (unsigned)__builtin_amdgcn_s_getreg((3 << 11) | 20) & 0xFu; }
#define XB_SPIN(cond, bar) do { unsigned _sp = 0; while (cond) { __builtin_amdgcn_s_sleep(1); \
    if ((++_sp & 255u) == 0u) { if (xb_ld(&(bar)[XB_TMO])) break; if (_sp > XB_SPIN_CAP) { atomicAdd(&(bar)[XB_TMO], 1u); break; } } } } while (0)
struct XcdBarrier { unsigned* bar; unsigned x; volatile LAS unsigned* st; };
__device__ __forceinline__ XcdBarrier xcd_barrier_post(unsigned* bar, volatile LAS unsigned* st) {
  XcdBarrier b; b.bar = bar; b.x = xb_xcc_id(); b.st = st;
  if (threadIdx.x == 0) (void)xb_add(&bar[XB_XCNT(b.x)], 1u);
  return b;
}
__device__ __forceinline__ void xcd_barrier_complete(unsigned* bar, unsigned x, unsigned& nloc, unsigned& nx) {
  const unsigned G = gridDim.x * gridDim.y * gridDim.z;
  unsigned sum, cnt, mine, sp = 0u;
  for (;;) {
    sum = 0u; cnt = 0u; mine = 0u;
#pragma unroll
    for (unsigned j = 0; j < 16; ++j) { const unsigned c = xb_ld(&bar[XB_XCNT(j)]); sum += c; cnt += (c > 0u) ? 1u : 0u; mine = (j == x) ? c : mine; }
    if (sum == G) break;
    __builtin_amdgcn_s_sleep(1);
    if ((++sp & 255u) == 0u) { if (xb_ld(&bar[XB_TMO])) break; if (sp > XB_SPIN_CAP) { atomicAdd(&bar[XB_TMO], 1u); break; } }
  }
  nloc = mine > 0u ? mine : 1u; nx = cnt > 0u ? cnt : 1u;
}
__device__ __forceinline__ void xcd_barrier(const XcdBarrier& b) {
  asm volatile("s_waitcnt vmcnt(0)" ::: "memory");
  __syncthreads();
  if (threadIdx.x == 0) {
    unsigned* bar = b.bar;
    __builtin_amdgcn_s_waitcnt(0);
    unsigned nloc = b.st[0], nx = b.st[1];
    if (nloc == 0u) { xcd_barrier_complete(bar, b.x, nloc, nx); b.st[0] = nloc; b.st[1] = nx; }
    const unsigned old = xb_add(&bar[XB_XSUB(b.x)], 1u);
    const unsigned gen = old / nloc;
    if (old + 1u == (gen + 1u) * nloc) {
      __builtin_amdgcn_fence(__ATOMIC_RELEASE, "agent");
      asm volatile("s_waitcnt vmcnt(0)" ::: "memory");
      const unsigned og = xb_add(&bar[XB_TOP], 1u);
      const unsigned tg = og / nx;
      if (og + 1u == (tg + 1u) * nx) xb_add(&bar[XB_TOPGEN], 1u);
      else XB_SPIN(xb_ld(&bar[XB_TOPGEN]) == tg, bar);
      __builtin_amdgcn_fence(__ATOMIC_ACQUIRE, "agent");
      xb_add(&bar[XB_XGEN(b.x)], 1u);
      asm volatile("s_waitcnt vmcnt(0)" ::: "memory");
    } else {
      XB_SPIN(xb_ld(&bar[XB_XGEN(b.x)]) == gen, bar);
      __builtin_amdgcn_fence(__ATOMIC_ACQUIRE, "agent");
      asm volatile("s_waitcnt vmcnt(0)" ::: "memory");
    }
  }
  __syncthreads();
}

typedef const __attribute__((address_space(4))) P* KP;
__device__ __forceinline__ P loadP() {
#if defined(__HIP_DEVICE_COMPILE__)
  KP k = (KP)__builtin_amdgcn_kernarg_segment_ptr();
  asm volatile("" : "+s"(k));
  P p = *k;
  return p;
#else
  return P{};
#endif
}

__global__ void __launch_bounds__(256, 2) mega(P p_arg) {
  cg::grid_group grid = cg::this_grid();
  __shared__ __attribute__((aligned(16))) float smem[14336];
  char* lds = (char*)smem;
  __shared__ uint4 xb_words;
  if (threadIdx.x == 0) xb_words = make_uint4(0u, 0u, 0u, 0u);
  if (blockIdx.x == 0) {
    P p = loadP();
    for (int i = threadIdx.x; i < XCD_BAR_WORDS; i += 256) p.bar[i] = 0u;
  }
  { P p = loadP(); ph_rmsnorm(p.x, p.norm_mix, p.hn, T_TOK); ph_rmsnorm(p.mem, p.norm_mkv, p.memn, 1024); }
  { P p = loadP(); ph_transpose<true>(smem, p.w_in, DM, INC, 5760, p.WinT); }
  { P p = loadP(); ph_transpose<false>(smem, p.w_mk, DM, 512, 512, p.WmkT); }
  { P p = loadP(); ph_transpose<false>(smem, p.w_mv, DM, 512, 512, p.WmvT); }
  { P p = loadP(); ph_cvt(p.subk, p.subkb, (size_t)16 * 128 * 128); }
  { P p = loadP(); ph_transpose<false>(smem, p.w1_k, 4096, 128, 128, p.w1T); }
  { P p = loadP(); ph_transpose<false>(smem, p.w1_v, 4096, 128, 128, p.w1T + 128 * 4096); }
  { P p = loadP(); ph_transpose<false>(smem, p.w2_k, 128, 128, 128, p.w2T); }
  { P p = loadP(); ph_transpose<false>(smem, p.w2_v, 128, 128, 128, p.w2T + 128 * 128); }
  { P p = loadP(); ph_posb(p); }
  grid.sync();
  XcdBarrier xb;
  { P p = loadP(); xb = xcd_barrier_post(p.bar, (volatile LAS unsigned*)&xb_words); }
  { P p = loadP(); ph_proj(p, lds); }
  const int kvb = (gridDim.x == 512) ? (((int)blockIdx.x >= 320 && (int)blockIdx.x < 352) ? ((int)blockIdx.x - 320) * 8 : -1) : -2;
  const int vvb = (gridDim.x == 512) ? (((int)blockIdx.x >= 352 && (int)blockIdx.x < 384) ? ((int)blockIdx.x - 352) * 8 : -1) : -2;
  { P p = loadP(); bf16_t* kmem = p.kmemb;
    ph_gemm_bf16(p.memn, DM, p.WmkT, DM, 1024, 512, DM, lds, [=](int m, int n, float v) {
      kmem[((size_t)((m >> 8) * 4 + (n >> 7)) * 256 + (m & 255)) * 128 + (n & 127)] = f2bf(v); }, kvb); }
  { P p = loadP(); bf16_t* vmem = p.vmemT;
    ph_gemm_bf16(p.memn, DM, p.WmvT, DM, 1024, 512, DM, lds, [=](int m, int n, float v) {
      vmem[((size_t)((m >> 8) * 4 + (n >> 7)) * 128 + (n & 127)) * 256 + perm16(m & 255)] = f2bf(v); }, vvb); }
  xcd_barrier(xb);
  { P p = loadP(); ph_compress2(p, lds); }
  { P p = loadP(); ph_sb2(p, lds); }
  {
    const int skip = (gridDim.x > 32) ? 16 : 0;
    const int vb = ((int)blockIdx.x >= skip) ? (int)blockIdx.x - skip : -1, nvb = (int)gridDim.x - skip;
    __syncthreads();
    { P p = loadP(); ph_transpose<false>(smem, p.w_out, DM, DM, DM, p.WoutT, vb, nvb); }
    { P p = loadP(); ph_transpose<false>(smem, p.w_mq, DM, 512, 512, p.WmqT, vb, nvb); }
  }
  xcd_barrier(xb);
  { P p = loadP(); ph_nsa2(p, lds); }
  xcd_barrier(xb);
  { P p = loadP(); float* out = p.out; const float* x = p.x;
    ph_gemm_bf16(p.omix, DM, p.WoutT, DM, T_TOK, DM, DM, lds, [=](int m, int n, float v) { out[(size_t)m * DM + n] = x[(size_t)m * DM + n] + v; }); }
  xcd_barrier(xb);
  { P p = loadP(); ph_rmsnorm(p.out, p.norm_mq, p.hn, T_TOK); }
  xcd_barrier(xb);
  if (blockIdx.x < 256 || gridDim.x < 512) {
    P p = loadP(); bf16_t* qmem = p.qmemb;
    ph_gemm_bf16(p.hn, DM, p.WmqT, DM, T_TOK, 512, DM, lds, [=](int m, int n, float v) { qmem[(size_t)m * 512 + n] = f2bf(v); });
  }
  {
    const int half = (gridDim.x >= 512) ? 256 : 0;
    if ((int)blockIdx.x >= half) {
      const int nwv = ((int)gridDim.x - half) * 4, wid = ((int)blockIdx.x - half) * 4 + (opq(threadIdx.x) >> 6);
      { P p = loadP(); ph_cvt4(p.pu, p.pu8, p.su8, 16384, wid, nwv); }
      if (gridDim.x < 512) { P p = loadP(); ph_cvt4(p.pv, p.pv8, p.sv8, 16384, wid, nwv); }
      __syncthreads();
      { P p = loadP(); ph_transpose<false>(smem, p.w_mo, 512, DM, DM, p.WmoT, (int)blockIdx.x - half, (int)gridDim.x - half); }
    }
  }
  xcd_barrier(xb);
  { P p = loadP(); ph_memattn2(p, lds); }
  if (gridDim.x >= 512 && blockIdx.x >= 256) {
    const int nwv = ((int)gridDim.x - 256) * 4, wid = ((int)blockIdx.x - 256) * 4 + (opq(threadIdx.x) >> 6);
    { P p = loadP(); ph_cvt4(p.pv, p.pv8, p.sv8, 16384, wid, nwv); }
  }
  {
    const int half = (gridDim.x >= 512) ? 256 : 0;
    __syncthreads();
    P p = loadP(); ph_transpose<false>(smem, p.w_pq, DM, DM, DM, p.WpqT, ((int)blockIdx.x >= half) ? (int)blockIdx.x - half : -1, (int)gridDim.x - half);
  }
  xcd_barrier(xb);
  { P p = loadP(); float* out = p.out;
    ph_gemm_bf16(p.omem, 512, p.WmoT, 512, T_TOK, DM, 512, lds, [=](int m, int n, float v) { out[(size_t)m * DM + n] += v; }); }
  xcd_barrier(xb);
  { P p = loadP(); ph_rmsnorm(p.out, p.norm_ffn, p.hn, T_TOK); }
  xcd_barrier(xb);
  { P p = loadP(); ph_qp_scores(p, lds); }
  xcd_barrier(xb);
  { P p = loadP(); ph_peer(p, smem); }
}

extern "C" void kernel_launch(void* const* d_in, const int* in_sizes, int n_in, void* d_out, int out_size, void* d_ws,
                              size_t ws_size, hipStream_t stream) {
  P p{};
  p.x = (const float*)d_in[0]; p.mem = (const float*)d_in[1]; p.t5 = (const float*)d_in[2];
  p.norm_mix = (const float*)d_in[3]; p.w_in = (const float*)d_in[4]; p.pos_k = (const float*)d_in[5];
  p.w1_k = (const float*)d_in[6]; p.w2_k = (const float*)d_in[7]; p.pos_v = (const float*)d_in[8];
  p.w1_v = (const float*)d_in[9]; p.w2_v = (const float*)d_in[10]; p.w_out = (const float*)d_in[11];
  p.norm_mq = (const float*)d_in[12]; p.norm_mkv = (const float*)d_in[13]; p.w_mq = (const float*)d_in[14];
  p.w_mk = (const float*)d_in[15]; p.w_mv = (const float*)d_in[16]; p.w_mo = (const float*)d_in[17];
  p.norm_ffn = (const float*)d_in[18]; p.w_pq = (const float*)d_in[19]; p.subk = (const float*)d_in[20];
  p.pu = (const float*)d_in[21]; p.pv = (const float*)d_in[22]; p.norm_final = (const float*)d_in[23];
  p.out = (float*)d_out;
  char* w = (char*)d_ws;
  size_t off = 0;
  auto take = [&](size_t bytes) { char* r = w + off; off += (bytes + 255) & ~(size_t)255; return r; };
  p.bar = (unsigned*)take(XCD_BAR_WORDS * 4);
  p.scores = (float*)take((size_t)T_TOK * DM * 4);
  p.gates = (float*)take((size_t)T_TOK * 24 * 4);
  p.part = (float*)take((size_t)T_TOK * 1024 * 4);
  p.posb = (float*)take(256 * 4);
  p.qn = (bf16_t*)take((size_t)T_TOK * 1024 * 2);
  p.kcin = (bf16_t*)take((size_t)T_TOK * 256 * 2 + 65536);
  p.vcin = (bf16_t*)take((size_t)T_TOK * 256 * 2 + 65536);
  p.ks = (bf16_t*)take((size_t)T_TOK * 256 * 2);
  p.vsT = (bf16_t*)take((size_t)T_TOK * 256 * 2);
  p.kw = (bf16_t*)take((size_t)T_TOK * 256 * 2);
  p.vwT = (bf16_t*)take((size_t)T_TOK * 256 * 2);
  p.kcb = (bf16_t*)take((size_t)8 * 128 * 128 * 2);
  p.vcT = (bf16_t*)take((size_t)8 * 128 * 128 * 2);
  p.c1 = (bf16_t*)take((size_t)16 * 128 * 128 * 2);
  p.w1T = (bf16_t*)take((size_t)2 * 128 * 4096 * 2);
  p.w2T = (bf16_t*)take((size_t)2 * 128 * 128 * 2);
  p.hn = (bf16_t*)take((size_t)T_TOK * DM * 2);
  p.omix = (bf16_t*)take((size_t)T_TOK * DM * 2);
  p.memn = (bf16_t*)take((size_t)1024 * DM * 2);
  p.omem = (bf16_t*)take((size_t)T_TOK * 512 * 2);
  p.WinT = (bf16_t*)take((size_t)5760 * DM * 2);
  p.WoutT = (bf16_t*)take((size_t)DM * DM * 2);
  p.WpqT = (bf16_t*)take((size_t)DM * DM * 2);
  p.WmqT = (bf16_t*)take((size_t)512 * DM * 2);
  p.WmkT = (bf16_t*)take((size_t)512 * DM * 2);
  p.WmvT = (bf16_t*)take((size_t)512 * DM * 2);
  p.WmoT = (bf16_t*)take((size_t)DM * 512 * 2);
  p.qmemb = (bf16_t*)take((size_t)T_TOK * 512 * 2);
  p.kmemb = (bf16_t*)take((size_t)1024 * 512 * 2);
  p.vmemT = (bf16_t*)take((size_t)1024 * 512 * 2);
  p.qsb = (bf16_t*)take((size_t)T_TOK * 1024 * 2);
  p.ksb = (bf16_t*)take((size_t)T_TOK * 1024 * 2);
  p.vsbT = (bf16_t*)take((size_t)T_TOK * 1024 * 2);
  p.pu8 = (unsigned char*)take((size_t)16384 * 1024);
  p.pv8 = (unsigned char*)take((size_t)16384 * 1024);
  p.su8 = (float*)take(16384 * 4);
  p.sv8 = (float*)take(16384 * 4);
  p.subkb = (bf16_t*)take((size_t)16 * 128 * 128 * 2);
  static int grid_blocks = 0;
  if (!grid_blocks) {
    int dev = 0, cus = 0, per_cu = 0;
    (void)hipGetDevice(&dev);
    (void)hipDeviceGetAttribute(&cus, hipDeviceAttributeMultiprocessorCount, dev);
    (void)hipOccupancyMaxActiveBlocksPerMultiprocessor(&per_cu, mega, 256, 0);
    if (per_cu > 2) per_cu = 2;
    if (per_cu < 1) per_cu = 1;
    grid_blocks = cus * per_cu;
  }
  void* args[] = {&p};
  hipError_t e = hipLaunchCooperativeKernel((void*)mega, dim3(grid_blocks), dim3(256), args, 0, stream);
  if (e != hipSuccess) fprintf(stderr, "cooperative launch failed: %s (grid %d)\n", hipGetErrorString(e), grid_blocks);
}
```

```cpp
#include <hip/hip_runtime.h>
#include <hip/hip_cooperative_groups.h>
#include <cstdio>
namespace cg = cooperative_groups;
#include <stdint.h>

#define SEQ 2048
#define NBATCH 4
#define T_TOK 8192
#define DM 2048
#define INC 5656
#define C_QN 0
#define C_KC 1024
#define C_VC 1280
#define C_KS 1536
#define C_VS 1792
#define C_KW 2048
#define C_VW 2304
#define C_GT 2560
#define C_QSB 2584
#define C_KSB 3608
#define C_VSB 4632
#define ATT_SCALE 0.08838834764831845f
#define RMS_EPS 1e-6f

typedef unsigned short bf16_t;
typedef __attribute__((ext_vector_type(8))) short bf16x8;
typedef __attribute__((ext_vector_type(16))) float f32x16;
typedef __attribute__((ext_vector_type(2))) __bf16 bf16v2;
typedef __attribute__((ext_vector_type(4))) unsigned u32x4;

struct P {
  const float *x, *mem, *t5, *norm_mix, *w_in, *pos_k, *w1_k, *w2_k, *pos_v, *w1_v, *w2_v, *w_out,
      *norm_mq, *norm_mkv, *w_mq, *w_mk, *w_mv, *w_mo, *norm_ffn, *w_pq, *subk, *pu, *pv, *norm_final;
  float* out;
  float *scores, *gates, *part, *posb;
  unsigned* bar;
  bf16_t *hn, *omix, *memn, *omem;
  bf16_t *WinT, *WoutT, *WpqT, *WmqT, *WmkT, *WmvT, *WmoT;
  bf16_t *qmemb, *kmemb, *vmemT;
  bf16_t *qsb, *ksb, *vsbT;
  bf16_t* subkb;
  unsigned char *pu8, *pv8;
  float *su8, *sv8;
  bf16_t *qn, *kcin, *vcin, *ks, *vsT, *kw, *vwT, *kcb, *vcT, *c1, *w1T, *w2T;
};

__device__ __forceinline__ int opq(int v) { asm volatile("" : "+v"(v)); return v; }
__device__ __forceinline__ unsigned pack2(float a, float b) {
  bf16v2 r = {(__bf16)a, (__bf16)b};
  return *(unsigned*)&r;
}
__device__ __forceinline__ bf16_t f2bf(float a) {
  __bf16 r = (__bf16)a;
  return *(bf16_t*)&r;
}
__device__ __forceinline__ int perm16(int s) { return (s & ~12) | ((s & 4) << 1) | ((s & 8) >> 1); }
__device__ __forceinline__ float bf2f(bf16_t u) { return __uint_as_float((unsigned)u << 16); }

__device__ __forceinline__ float wave_max(float v) {
  for (int o = 32; o > 0; o >>= 1) v = fmaxf(v, __shfl_xor(v, o));
  return v;
}
__device__ __forceinline__ float wave_sum(float v) {
  for (int o = 32; o > 0; o >>= 1) v += __shfl_xor(v, o);
  return v;
}
__device__ __forceinline__ void wave_argmax(float& v, int& i) {
  for (int o = 32; o > 0; o >>= 1) {
    float ov = __shfl_xor(v, o);
    int oi = __shfl_xor(i, o);
    if (ov > v || (ov == v && oi < i)) { v = ov; i = oi; }
  }
}
__device__ __forceinline__ float gelu_tanh(float x) {
  return 0.5f * x * (1.f + tanhf(0.7978845608028654f * (x + 0.044715f * x * x * x)));
}
__device__ __forceinline__ float gelu_fast(float x) {
  const float y = 1.5957691216057308f * (x + 0.044715f * x * x * x);
  return x / (1.f + __expf(-y));
}
__device__ __forceinline__ int t5_bucket(int n) {
  if (n < 16) return n < 0 ? 0 : n;
  int b = 16;
  b += (n >= 19); b += (n >= 21); b += (n >= 24); b += (n >= 27); b += (n >= 31); b += (n >= 35);
  b += (n >= 40); b += (n >= 46); b += (n >= 52); b += (n >= 59); b += (n >= 67); b += (n >= 77);
  b += (n >= 87); b += (n >= 99); b += (n >= 113);
  return b;
}
__device__ __forceinline__ float log_sigmoid(float x) {
  return fminf(x, 0.f) - log1pf(expf(-fabsf(x)));
}

__device__ __forceinline__ void ph_rmsnorm(const float* src, const float* gain, bf16_t* dst, int rows) {
  int lane = opq(threadIdx.x) & 63, wv = opq(threadIdx.x) >> 6;
  for (int r = blockIdx.x * 4 + wv; r < rows; r += gridDim.x * 4) {
    const float4* s4 = (const float4*)(src + (size_t)r * DM);
    float4 v[8];
    float ss = 0.f;
#pragma unroll
    for (int i = 0; i < 8; ++i) {
      v[i] = s4[i * 64 + lane];
      ss += v[i].x * v[i].x + v[i].y * v[i].y + v[i].z * v[i].z + v[i].w * v[i].w;
    }
    ss = wave_sum(ss);
    float rs = rsqrtf(ss * (1.f / DM) + RMS_EPS);
    uint2* d2 = (uint2*)(dst + (size_t)r * DM);
    const float4* g4 = (const float4*)gain;
#pragma unroll
    for (int i = 0; i < 8; ++i) {
      float4 g = g4[i * 64 + lane];
      uint2 o;
      o.x = pack2(v[i].x * rs * g.x, v[i].y * rs * g.y);
      o.y = pack2(v[i].z * rs * g.z, v[i].w * rs * g.w);
      d2[i * 64 + lane] = o;
    }
  }
}

template <bool CMAP>
__device__ __forceinline__ void ph_transpose(float* smem, const float* W, int K, int N, int Npad, bf16_t* Wt,
                                             int vblock = -2, int nvb = 0) {
  typedef __attribute__((ext_vector_type(4))) float f32x4;
  float (*tl)[65] = (float (*)[65])smem;
  if (vblock == -1) return;
  const int b0 = (vblock >= 0) ? vblock : (int)blockIdx.x, bstride = (vblock >= 0) ? nvb : (int)gridDim.x;
  const int tid = opq(threadIdx.x);
  const int nk = K / 64, nn = Npad / 64;
  for (int tile = b0; tile < nk * nn; tile += bstride) {
    const int k0 = (tile % nk) * 64, n0 = (tile / nk) * 64;
    const int kr = tid >> 4, n4 = (tid & 15) * 4;
    int sc = n0 + n4;
    if (CMAP) sc = (sc < 2560) ? sc : (sc < 5632) ? sc + 24 : (sc < 5656) ? sc - 5632 + 2560 : N;
#pragma unroll
    for (int i = 0; i < 4; ++i) {
      const int k = kr + 16 * i;
      f32x4 v = {0.f, 0.f, 0.f, 0.f};
      if (sc < N) v = *(const f32x4*)(W + (size_t)(k0 + k) * N + sc);
      tl[k][n4 + 0] = v[0]; tl[k][n4 + 1] = v[1]; tl[k][n4 + 2] = v[2]; tl[k][n4 + 3] = v[3];
    }
    __syncthreads();
    int n = tid >> 2, kc = (tid & 3) * 16;
    unsigned w[8];
#pragma unroll
    for (int i = 0; i < 8; ++i) w[i] = pack2(tl[kc + 2 * i][n], tl[kc + 2 * i + 1][n]);
    uint4* dst = (uint4*)(Wt + (size_t)(n0 + n) * K + k0 + kc);
    dst[0] = make_uint4(w[0], w[1], w[2], w[3]);
    dst[1] = make_uint4(w[4], w[5], w[6], w[7]);
    __syncthreads();
  }
}

__device__ __forceinline__ int lds_off(int row, int chunk) { return row * 128 + ((chunk ^ ((row >> 1) & 7)) << 4); }

template <bool TR, bool VEC = false, class Epi>
__device__ __forceinline__ void gemm_tile_bf16(const bf16_t* xp, int ldx, const bf16_t* yp, int ldy, int K, char* lds,
                                               Epi epi) {
  const int tid = opq(threadIdx.x), lane = tid & 63, wv = tid >> 6;
  const int wr = wv >> 1, wc = wv & 1;
  char* lx = lds;
  char* ly = lds + 16384;
  f32x16 acc[2][2];
#pragma unroll
  for (int i = 0; i < 2; ++i)
#pragma unroll
    for (int j = 0; j < 2; ++j)
#pragma unroll
      for (int r = 0; r < 16; ++r) acc[i][j][r] = 0.f;
  const int srow = tid >> 3, sch = tid & 7;
  const bf16_t* xg = xp + (size_t)srow * ldx + sch * 8;
  const bf16_t* yg = yp + (size_t)srow * ldy + sch * 8;
  const size_t x32 = (size_t)32 * ldx, y32 = (size_t)32 * ldy;
  uint4 sx0 = *(const uint4*)(xg), sx1 = *(const uint4*)(xg + x32), sx2 = *(const uint4*)(xg + 2 * x32),
        sx3 = *(const uint4*)(xg + 3 * x32);
  uint4 sy0 = *(const uint4*)(yg), sy1 = *(const uint4*)(yg + y32), sy2 = *(const uint4*)(yg + 2 * y32),
        sy3 = *(const uint4*)(yg + 3 * y32);
  const int so0 = lds_off(srow, sch), so1 = lds_off(32 + srow, sch), so2 = lds_off(64 + srow, sch),
            so3 = lds_off(96 + srow, sch);
  for (int k0 = 0; k0 < K; k0 += 64) {
    __syncthreads();
    *(uint4*)(lx + so0) = sx0; *(uint4*)(lx + so1) = sx1; *(uint4*)(lx + so2) = sx2; *(uint4*)(lx + so3) = sx3;
    *(uint4*)(ly + so0) = sy0; *(uint4*)(ly + so1) = sy1; *(uint4*)(ly + so2) = sy2; *(uint4*)(ly + so3) = sy3;
    __syncthreads();
    if (k0 + 64 < K) {
      const bf16_t* xn = xg + k0 + 64;
      const bf16_t* yn = yg + k0 + 64;
      sx0 = *(const uint4*)(xn); sx1 = *(const uint4*)(xn + x32); sx2 = *(const uint4*)(xn + 2 * x32);
      sx3 = *(const uint4*)(xn + 3 * x32);
      sy0 = *(const uint4*)(yn); sy1 = *(const uint4*)(yn + y32); sy2 = *(const uint4*)(yn + 2 * y32);
      sy3 = *(const uint4*)(yn + 3 * y32);
    }
#pragma unroll
    for (int kk = 0; kk < 4; ++kk) {
      bf16x8 a[2], b[2];
      const int ch = kk * 2 + (lane >> 5);
#pragma unroll
      for (int i = 0; i < 2; ++i) {
        a[i] = *(const bf16x8*)((TR ? ly : lx) + lds_off(wr * 64 + i * 32 + (lane & 31), ch));
        b[i] = *(const bf16x8*)((TR ? lx : ly) + lds_off(wc * 64 + i * 32 + (lane & 31), ch));
      }
#pragma unroll
      for (int i = 0; i < 2; ++i)
#pragma unroll
        for (int j = 0; j < 2; ++j) acc[i][j] = __builtin_amdgcn_mfma_f32_32x32x16_bf16(a[i], b[j], acc[i][j], 0, 0, 0);
    }
  }
  int lane2 = lane;
  asm volatile("" : "+v"(lane2));
  if constexpr (VEC) {
    typedef __attribute__((ext_vector_type(4))) float f32x4;
    __syncthreads();
    float* wl = (float*)lds + wv * (32 * 68);
    const int hh2 = lane2 >> 5, cl = lane2 & 31;
#pragma unroll
    for (int i = 0; i < 2; ++i) {
#pragma unroll
      for (int j = 0; j < 2; ++j)
#pragma unroll
        for (int r = 0; r < 16; ++r) wl[((r & 3) + 8 * (r >> 2) + 4 * hh2) * 68 + j * 32 + cl] = acc[i][j][r];
      __builtin_amdgcn_wave_barrier();
#pragma unroll
      for (int k = 0; k < 4; ++k) {
        const int row = (lane2 >> 3) + 8 * k, c8 = (lane2 & 7) * 8;
        const f32x4 lo = *(const f32x4*)&wl[row * 68 + c8];
        const f32x4 hi = *(const f32x4*)&wl[row * 68 + c8 + 4];
        epi(wr * 64 + i * 32 + row, wc * 64 + c8, lo, hi);
      }
      __builtin_amdgcn_wave_barrier();
    }
  } else {
#pragma unroll
    for (int i = 0; i < 2; ++i)
#pragma unroll
      for (int j = 0; j < 2; ++j)
#pragma unroll
        for (int r = 0; r < 16; ++r) {
          int rr = wr * 64 + i * 32 + (r & 3) + 8 * (r >> 2) + 4 * (lane2 >> 5);
          int cc = wc * 64 + j * 32 + (lane2 & 31);
          epi(rr, cc, acc[i][j][r]);
        }
  }
}

typedef __attribute__((ext_vector_type(4))) float f32x4_e;
__device__ __forceinline__ void st_bf16x8(bf16_t* dst, f32x4_e lo, f32x4_e hi) {
  u32x4 o;
  o[0] = pack2(lo[0], lo[1]); o[1] = pack2(lo[2], lo[3]); o[2] = pack2(hi[0], hi[1]); o[3] = pack2(hi[2], hi[3]);
  *(u32x4*)dst = o;
}

template <bool VEC = false, class Epi>
__device__ __forceinline__ void ph_gemm_bf16(const bf16_t* A, int lda, const bf16_t* Wt, int ldw, int M, int N, int K,
                                             char* lds, Epi epi, int vblock = -2) {
  const int ntm = M / 128, ntn = N / 128;
  const int npm = (ntm + 7) / 8, npn = (ntn + 7) / 8;
  const int nslots = ((npm * npn * 64 + 511) / 512) * 512;
  if (vblock == -1) return;
  for (int u = (vblock >= 0 ? vblock : (int)blockIdx.x); u < nslots; u += gridDim.x) {
    int v = (u & 7) * 64 + ((u >> 3) & 63) + (u & ~511);
    int patch = v >> 6, w = v & 63;
    int tm = (patch % npm) * 8 + (w & 7);
    int tn = (patch / npm) * 8 + (w >> 3);
    if (tm >= ntm || tn >= ntn) continue;
    const int m0 = tm * 128, n0 = tn * 128;
    if constexpr (VEC)
      gemm_tile_bf16<false, true>(A + (size_t)m0 * lda, lda, Wt + (size_t)n0 * ldw, ldw, K, lds,
                                  [&](int r, int c, f32x4_e lo, f32x4_e hi) { epi(m0 + r, n0 + c, lo, hi); });
    else
      gemm_tile_bf16<false>(A + (size_t)m0 * lda, lda, Wt + (size_t)n0 * ldw, ldw, K, lds,
                            [&](int r, int c, float val) { epi(m0 + r, n0 + c, val); });
  }
}

__device__ __forceinline__ void ph_proj(const P& p, char* lds) {
  const int ntm = T_TOK / 128, ntn = 5760 / 128;
  const int npm = (ntm + 7) / 8, npn = (ntn + 7) / 8;
  const int nslots = ((npm * npn * 64 + 511) / 512) * 512;
  for (int u = blockIdx.x; u < nslots; u += gridDim.x) {
    int v = (u & 7) * 64 + ((u >> 3) & 63) + (u & ~511);
    int patch = v >> 6, w = v & 63;
    int tm = (patch % npm) * 8 + (w & 7);
    int tn = (patch / npm) * 8 + (w >> 3);
    if (tm >= ntm || tn >= ntn) continue;
    const int m0 = tm * 128, n0 = tn * 128;
    const int b = m0 >> 11, sl = m0 & 2047;
    const bf16_t* A = p.hn + (size_t)m0 * DM;
    const bf16_t* W = p.WinT + (size_t)n0 * DM;
    if (n0 < 1024) {
      bf16_t* q = p.qn + (size_t)m0 * 1024 + n0;
      gemm_tile_bf16<false, true>(A, DM, W, DM, DM, lds, [&](int r, int c, f32x4_e lo, f32x4_e hi) { st_bf16x8(q + (size_t)r * 1024 + c, lo, hi); });
    } else if (n0 < 2560) {
      const int seg = (n0 - 1024) >> 8, g = ((n0 - 1024) >> 7) & 1;
      if (seg == 3 || seg == 5) {
        bf16_t* vd = (seg == 3 ? p.vsT : p.vwT) + ((size_t)(b * 2 + g) * 128) * SEQ + sl;
        gemm_tile_bf16<true>(A, DM, W, DM, DM, lds, [&](int r, int c, float val) { vd[(size_t)r * SEQ + perm16(c)] = f2bf(val); });
      } else {
        bf16_t* base = (seg == 0) ? p.kcin : (seg == 1) ? p.vcin : (seg == 2) ? p.ks : p.kw;
        bf16_t* kd = base + ((size_t)(b * 2 + g) * SEQ + sl) * 128;
        gemm_tile_bf16<false, true>(A, DM, W, DM, DM, lds, [&](int r, int c, f32x4_e lo, f32x4_e hi) { st_bf16x8(kd + (size_t)r * 128 + c, lo, hi); });
      }
    } else if (n0 < 3584) {
      bf16_t* q = p.qsb + (size_t)m0 * 1024 + (n0 - 2560);
      gemm_tile_bf16<false, true>(A, DM, W, DM, DM, lds, [&](int r, int c, f32x4_e lo, f32x4_e hi) { st_bf16x8(q + (size_t)r * 1024 + c, lo, hi); });
    } else if (n0 < 4608) {
      bf16_t* kd = p.ksb + ((size_t)(b * 8 + ((n0 - 3584) >> 7)) * SEQ + sl) * 128;
      gemm_tile_bf16<false, true>(A, DM, W, DM, DM, lds, [&](int r, int c, f32x4_e lo, f32x4_e hi) { st_bf16x8(kd + (size_t)r * 128 + c, lo, hi); });
    } else if (n0 < 5632) {
      bf16_t* vd = p.vsbT + ((size_t)(b * 8 + ((n0 - 4608) >> 7)) * 128) * SEQ + sl;
      gemm_tile_bf16<true>(A, DM, W, DM, DM, lds, [&](int r, int c, float val) { vd[(size_t)r * SEQ + perm16(c)] = f2bf(val); });
    } else {
      float* gd = p.gates + (size_t)m0 * 24;
      gemm_tile_bf16<false>(A, DM, W, DM, DM, lds, [&](int r, int c, float val) { if (c < 24) gd[(size_t)r * 24 + c] = val; });
    }
  }
}

__device__ __forceinline__ void ph_posb(const P& p) {
  const int lane = opq(threadIdx.x) & 63, wv = opq(threadIdx.x) >> 6;
  for (int o = blockIdx.x * 4 + wv; o < 256; o += gridDim.x * 4) {
    const int which = o >> 7, n = o & 127;
    const float* pos = which ? p.pos_v : p.pos_k;
    const float* w1 = which ? p.w1_v : p.w1_k;
    float acc = 0.f;
    for (int k = lane; k < 4096; k += 64) acc += pos[k] * w1[(size_t)k * 128 + n];
    acc = wave_sum(acc);
    if (lane == 0) p.posb[o] = acc;
  }
}

__device__ __forceinline__ void ph_compress2(const P& p, char* lds) {
  for (int item = blockIdx.x; item < 16; item += gridDim.x) {
    const int which = item >> 3, bg = item & 7;
    const bf16_t* src = (which ? p.vcin : p.kcin) + (size_t)bg * SEQ * 128;
    const bf16_t* w1t = p.w1T + (size_t)which * 128 * 4096;
    const bf16_t* w2t = p.w2T + (size_t)which * 128 * 128;
    const float* posb = p.posb + which * 128;
    bf16_t* c1 = p.c1 + (size_t)item * 128 * 128;
    gemm_tile_bf16<false>(src, 2048, w1t, 4096, 4096, lds, [&](int r, int c, float val) {
      c1[r * 128 + c] = f2bf(gelu_fast(val + posb[c])); });
    __threadfence_block();
    __syncthreads();
    if (which == 0) {
      bf16_t* kd = p.kcb + (size_t)bg * 128 * 128;
      gemm_tile_bf16<false>(c1, 128, w2t, 128, 128, lds, [&](int r, int c, float val) { kd[r * 128 + c] = f2bf(val); });
    } else {
      bf16_t* vd = p.vcT + (size_t)bg * 128 * 128;
      gemm_tile_bf16<true>(c1, 128, w2t, 128, 128, lds, [&](int r, int c, float val) { vd[r * 128 + perm16(c)] = f2bf(val); });
    }
  }
}

#define NEG_BIG (-1e30f)

struct KVRegs { u32x4 k0, k1, k2, k3, v0, v1, v2, v3; };

__device__ __forceinline__ int koff(int row, int chunk) { return row * 256 + ((chunk ^ (row & 15)) << 4); }

__device__ __forceinline__ void kv_load(KVRegs& r, const bf16_t* kp, int ldk, const bf16_t* vp, int ldv) {
  const int tid = opq(threadIdx.x);
  const bf16_t* kg = kp + (size_t)(tid >> 4) * ldk + (tid & 15) * 8;
  r.k0 = *(const u32x4*)kg;
  r.k1 = *(const u32x4*)(kg + (size_t)16 * ldk);
  r.k2 = *(const u32x4*)(kg + (size_t)32 * ldk);
  r.k3 = *(const u32x4*)(kg + (size_t)48 * ldk);
  const bf16_t* vg = vp + (size_t)(tid >> 3) * ldv + (tid & 7) * 8;
  r.v0 = *(const u32x4*)vg;
  r.v1 = *(const u32x4*)(vg + (size_t)32 * ldv);
  r.v2 = *(const u32x4*)(vg + (size_t)64 * ldv);
  r.v3 = *(const u32x4*)(vg + (size_t)96 * ldv);
}
__device__ __forceinline__ void kv_store(const KVRegs& r, char* lk, char* lv) {
  const int tid = opq(threadIdx.x);
  const int row = tid >> 4, ch = tid & 15;
  *(u32x4*)(lk + koff(row, ch)) = r.k0;
  *(u32x4*)(lk + koff(row + 16, ch)) = r.k1;
  *(u32x4*)(lk + koff(row + 32, ch)) = r.k2;
  *(u32x4*)(lk + koff(row + 48, ch)) = r.k3;
  const int vr = tid >> 3, vc = tid & 7;
  *(u32x4*)(lv + lds_off(vr, vc)) = r.v0;
  *(u32x4*)(lv + lds_off(vr + 32, vc)) = r.v1;
  *(u32x4*)(lv + lds_off(vr + 64, vc)) = r.v2;
  *(u32x4*)(lv + lds_off(vr + 96, vc)) = r.v3;
}

struct QFrag { bf16x8 f0, f1, f2, f3, f4, f5, f6, f7; };
__device__ __forceinline__ void q_load(QFrag& q, const bf16_t* qrow) {
  const int h = (opq(threadIdx.x) & 63) >> 5;
  const bf16x8* p8 = (const bf16x8*)(qrow + 8 * h);
  q.f0 = p8[0]; q.f1 = p8[2]; q.f2 = p8[4]; q.f3 = p8[6]; q.f4 = p8[8]; q.f5 = p8[10]; q.f6 = p8[12]; q.f7 = p8[14];
}

__device__ __forceinline__ void qk_tile(const QFrag& q, const char* lk, f32x16& s0, f32x16& s1) {
  const int lane = opq(threadIdx.x) & 63, row = lane & 31, h = lane >> 5;
#pragma unroll
  for (int r = 0; r < 16; ++r) { s0[r] = 0.f; s1[r] = 0.f; }
#define QK_STEP(kk, qf)                                                                  \
  {                                                                                      \
    bf16x8 a0 = *(const bf16x8*)(lk + koff(row, 2 * (kk) + h));                          \
    bf16x8 a1 = *(const bf16x8*)(lk + koff(row + 32, 2 * (kk) + h));                     \
    s0 = __builtin_amdgcn_mfma_f32_32x32x16_bf16(a0, qf, s0, 0, 0, 0);                   \
    s1 = __builtin_amdgcn_mfma_f32_32x32x16_bf16(a1, qf, s1, 0, 0, 0);                   \
  }
  QK_STEP(0, q.f0) QK_STEP(1, q.f1) QK_STEP(2, q.f2) QK_STEP(3, q.f3)
  QK_STEP(4, q.f4) QK_STEP(5, q.f5) QK_STEP(6, q.f6) QK_STEP(7, q.f7)
#undef QK_STEP
}

__device__ __forceinline__ bf16x8 pack8(const f32x16& p, const int base) {
  u32x4 u;
  u[0] = pack2(p[base + 0], p[base + 1]);
  u[1] = pack2(p[base + 2], p[base + 3]);
  u[2] = pack2(p[base + 4], p[base + 5]);
  u[3] = pack2(p[base + 6], p[base + 7]);
  return __builtin_bit_cast(bf16x8, u);
}

struct OAcc { f32x16 o0, o1, o2, o3; };
__device__ __forceinline__ void oacc_zero(OAcc& o) {
#pragma unroll
  for (int r = 0; r < 16; ++r) { o.o0[r] = 0.f; o.o1[r] = 0.f; o.o2[r] = 0.f; o.o3[r] = 0.f; }
}
__device__ __forceinline__ void oacc_scale(OAcc& o, float a) {
#pragma unroll
  for (int r = 0; r < 16; ++r) { o.o0[r] *= a; o.o1[r] *= a; o.o2[r] *= a; o.o3[r] *= a; }
}

__device__ __forceinline__ void pv_tile(OAcc& o, const char* lv, const f32x16& p0, const f32x16& p1) {
  const int lane = opq(threadIdx.x) & 63, row = lane & 31, h = lane >> 5;
  const bf16x8 pf0 = pack8(p0, 0), pf1 = pack8(p0, 8), pf2 = pack8(p1, 0), pf3 = pack8(p1, 8);
#define PV_ROW(dd, acc)                                                                                      \
  {                                                                                                          \
    acc = __builtin_amdgcn_mfma_f32_32x32x16_bf16(*(const bf16x8*)(lv + lds_off(32 * (dd) + row, 0 + h)), pf0, acc, 0, 0, 0); \
    acc = __builtin_amdgcn_mfma_f32_32x32x16_bf16(*(const bf16x8*)(lv + lds_off(32 * (dd) + row, 2 + h)), pf1, acc, 0, 0, 0); \
    acc = __builtin_amdgcn_mfma_f32_32x32x16_bf16(*(const bf16x8*)(lv + lds_off(32 * (dd) + row, 4 + h)), pf2, acc, 0, 0, 0); \
    acc = __builtin_amdgcn_mfma_f32_32x32x16_bf16(*(const bf16x8*)(lv + lds_off(32 * (dd) + row, 6 + h)), pf3, acc, 0, 0, 0); \
  }
  PV_ROW(0, o.o0) PV_ROW(1, o.o1) PV_ROW(2, o.o2) PV_ROW(3, o.o3)
#undef PV_ROW
}

__device__ __forceinline__ void softmax_tile(f32x16& s0, f32x16& s1, float& m, float& l, OAcc& o) {
  float mx = NEG_BIG;
#pragma unroll
  for (int r = 0; r < 16; ++r) mx = fmaxf(mx, fmaxf(s0[r], s1[r]));
  mx = fmaxf(mx, __shfl_xor(mx, 32));
  const float mn = fmaxf(m, mx);
  const float alpha = __expf(m - mn);
  float ls = 0.f;
#pragma unroll
  for (int r = 0; r < 16; ++r) {
    float a = (s0[r] > -1e29f) ? __expf(s0[r] - mn) : 0.f;
    float b = (s1[r] > -1e29f) ? __expf(s1[r] - mn) : 0.f;
    s0[r] = a; s1[r] = b;
    ls += a + b;
  }
  ls += __shfl_xor(ls, 32);
  l = l * alpha + ls;
  m = mn;
  if (__any(alpha != 1.f)) oacc_scale(o, alpha);
}

template <class F>
__device__ __forceinline__ void oacc_foreach(const OAcc& o, F f) {
  const int h = (opq(threadIdx.x) & 63) >> 5;
#pragma unroll
  for (int rho = 0; rho < 4; ++rho) {
    f(0 + 8 * rho + 4 * h, o.o0[4 * rho], o.o0[4 * rho + 1], o.o0[4 * rho + 2], o.o0[4 * rho + 3]);
    f(32 + 8 * rho + 4 * h, o.o1[4 * rho], o.o1[4 * rho + 1], o.o1[4 * rho + 2], o.o1[4 * rho + 3]);
    f(64 + 8 * rho + 4 * h, o.o2[4 * rho], o.o2[4 * rho + 1], o.o2[4 * rho + 2], o.o2[4 * rho + 3]);
    f(96 + 8 * rho + 4 * h, o.o3[4 * rho], o.o3[4 * rho + 1], o.o3[4 * rho + 2], o.o3[4 * rho + 3]);
  }
}

__device__ __forceinline__ void ph_memattn2(const P& p, char* lds) {
  char* lk = lds;
  char* lv = lds + 16384;
  const int lane = opq(threadIdx.x) & 63, wv = opq(threadIdx.x) >> 6;
  for (int item = blockIdx.x; item < NBATCH * 4 * (SEQ / 128); item += gridDim.x) {
    const int tb = item % (SEQ / 128);
    const int bh = item / (SEQ / 128);
    const int b = bh >> 2, hd = bh & 3;
    const int t = tb * 128 + wv * 32 + (lane & 31);
    QFrag q;
    q_load(q, p.qmemb + (size_t)(b * SEQ + t) * 512 + hd * 128);
    const bf16_t* kb = p.kmemb + (size_t)bh * 256 * 128;
    const bf16_t* vb = p.vmemT + (size_t)bh * 128 * 256;
    OAcc o;
    oacc_zero(o);
    float m = NEG_BIG, l = 0.f;
    KVRegs kv;
    kv_load(kv, kb, 128, vb, 256);
#pragma unroll 1
    for (int ti = 0; ti < 4; ++ti) {
      __syncthreads();
      kv_store(kv, lk, lv);
      __syncthreads();
      {
        const int tn = (ti + 1 < 4) ? ti + 1 : 3;
        kv_load(kv, kb + (size_t)tn * 64 * 128, 128, vb + tn * 64, 256);
      }
      f32x16 s0, s1;
      qk_tile(q, lk, s0, s1);
#pragma unroll
      for (int r = 0; r < 16; ++r) { s0[r] *= ATT_SCALE; s1[r] *= ATT_SCALE; }
      softmax_tile(s0, s1, m, l, o);
      pv_tile(o, lv, s0, s1);
    }
    const float il = 1.f / l;
    const int t2 = tb * 128 + (opq(threadIdx.x) >> 6) * 32 + (opq(threadIdx.x) & 31);
    bf16_t* orow = p.omem + (size_t)(b * SEQ + t2) * 512 + hd * 128;
    oacc_foreach(o, [&](int d, float v0, float v1, float v2, float v3) {
      uint2 u;
      u.x = pack2(v0 * il, v1 * il);
      u.y = pack2(v2 * il, v3 * il);
      *(uint2*)(orow + d) = u;
    });
  }
}

__device__ __forceinline__ void ph_sb2(const P& p, char* lds) {
  char* lk = lds;
  char* lv = lds + 16384;
  const int lane = opq(threadIdx.x) & 63, wv = opq(threadIdx.x) >> 6, hh = lane >> 5;
  const int sb_skip = (gridDim.x > 32) ? 16 : 0;
  if ((int)blockIdx.x < sb_skip) return;
  for (int item = (int)blockIdx.x - sb_skip; item < NBATCH * 8 * (SEQ / 128); item += (int)gridDim.x - sb_skip) {
    const int tb = (SEQ / 128 - 1) - (item % (SEQ / 128));
    const int bh = item / (SEQ / 128);
    const int b = bh >> 3, hd = bh & 7;
    const int t0 = tb * 128;
    const int t = t0 + wv * 32 + (lane & 31);
    QFrag q;
    q_load(q, p.qsb + (size_t)(b * SEQ + t) * 1024 + hd * 128);
    const bf16_t* kb = p.ksb + (size_t)bh * SEQ * 128;
    const bf16_t* vb = p.vsbT + (size_t)bh * 128 * SEQ;
    OAcc o;
    oacc_zero(o);
    float carry = 0.f;
    const int jhi = (t0 >> 6) + 1;
    const int jw = (t0 + wv * 32 + 30) >> 6;
    KVRegs kv;
    kv_load(kv, kb + (size_t)jhi * 64 * 128, 128, vb + jhi * 64, SEQ);
    volatile unsigned* dflag = (volatile unsigned*)(lds + 32768);
    __syncthreads();
    if (opq(threadIdx.x) < 4) dflag[opq(threadIdx.x)] = 0u;
    for (int j = jhi; j >= 0; --j) {
      __syncthreads();
      if ((dflag[0] & dflag[1] & dflag[2] & dflag[3]) != 0u) break;
      kv_store(kv, lk, lv);
      __syncthreads();
      const int jn = (j > 0) ? j - 1 : 0;
      if (j > jw) kv_load(kv, kb + (size_t)jn * 64 * 128, 128, vb + jn * 64, SEQ);
      if (j <= jw) {
        f32x16 z0, z1;
        qk_tile(q, lk, z0, z1);
        const int sbase = j * 64 + 4 * hh;
        float gt[8];
        f32x16 l0, l1;
#pragma unroll
        for (int r = 0; r < 16; ++r) {
          const int so = sbase + 8 * (r >> 2) + (r & 3);
          {
            const float z = z0[r] * ATT_SCALE;
            const bool valid = so < t;
            const float lsp = fminf(z, 0.f) - __logf(1.f + __expf(-fabsf(z)));
            l0[r] = valid ? (lsp - z) : 0.f;
            z0[r] = valid ? z : NEG_BIG;
          }
          {
            const float z = z1[r] * ATT_SCALE;
            const bool valid = so + 32 < t;
            const float lsp = fminf(z, 0.f) - __logf(1.f + __expf(-fabsf(z)));
            l1[r] = valid ? (lsp - z) : 0.f;
            z1[r] = valid ? z : NEG_BIG;
          }
        }
#pragma unroll
        for (int rho = 0; rho < 4; ++rho) {
          gt[rho] = (l0[4 * rho] + l0[4 * rho + 1]) + (l0[4 * rho + 2] + l0[4 * rho + 3]);
          gt[4 + rho] = (l1[4 * rho] + l1[4 * rho + 1]) + (l1[4 * rho + 2] + l1[4 * rho + 3]);
        }
        float ag[8];
        float run = 0.f;
#pragma unroll
        for (int k = 7; k >= 0; --k) {
          const float pg = __shfl_xor(gt[k], 32);
          ag[k] = carry + run + (hh == 0 ? pg : 0.f);
          run += gt[k] + pg;
        }
        carry += run;
#pragma unroll
        for (int rho = 0; rho < 4; ++rho) {
          {
            const float x3 = l0[4 * rho + 3], x23 = x3 + l0[4 * rho + 2], x123 = x23 + l0[4 * rho + 1];
            const float g = ag[rho];
            z0[4 * rho + 0] = __expf((l0[4 * rho + 0] + z0[4 * rho + 0]) + (g + x123));
            z0[4 * rho + 1] = __expf((l0[4 * rho + 1] + z0[4 * rho + 1]) + (g + x23));
            z0[4 * rho + 2] = __expf((l0[4 * rho + 2] + z0[4 * rho + 2]) + (g + x3));
            z0[4 * rho + 3] = __expf((l0[4 * rho + 3] + z0[4 * rho + 3]) + g);
          }
          {
            const float x3 = l1[4 * rho + 3], x23 = x3 + l1[4 * rho + 2], x123 = x23 + l1[4 * rho + 1];
            const float g = ag[4 + rho];
            z1[4 * rho + 0] = __expf((l1[4 * rho + 0] + z1[4 * rho + 0]) + (g + x123));
            z1[4 * rho + 1] = __expf((l1[4 * rho + 1] + z1[4 * rho + 1]) + (g + x23));
            z1[4 * rho + 2] = __expf((l1[4 * rho + 2] + z1[4 * rho + 2]) + (g + x3));
            z1[4 * rho + 3] = __expf((l1[4 * rho + 3] + z1[4 * rho + 3]) + g);
          }
        }
        kv_load(kv, kb + (size_t)jn * 64 * 128, 128, vb + jn * 64, SEQ);
        pv_tile(o, lv, z0, z1);
        if (__all(carry < -104.f) && (opq(threadIdx.x) & 63) == 0) dflag[wv] = 1u;
      }
    }
    int t2 = t;
    asm volatile("" : "+v"(t2));
    bf16_t* orow = p.omix + (size_t)(b * SEQ + t2) * DM + 1024 + hd * 128;
    oacc_foreach(o, [&](int d, float v0, float v1, float v2, float v3) {
      uint2 u;
      u.x = pack2(v0, v1);
      u.y = pack2(v2, v3);
      *(uint2*)(orow + d) = u;
    });
  }
}

#define NSA_IMP 32768
#define NSA_KEYS 49152
#define NSA_SELM 53504
#define NSA_LUT 53632
__device__ __forceinline__ void ph_nsa2(const P& p, char* lds) {
  typedef __attribute__((ext_vector_type(4))) float f32x4;
  char* lk = lds;
  char* lv = lds + 16384;
  float* imp = (float*)(lds + NSA_IMP);
  float* keys = (float*)(lds + NSA_KEYS);
  unsigned* selm = (unsigned*)(lds + NSA_SELM);
  const int tid = opq(threadIdx.x), lane = tid & 63, wv = tid >> 6, hh = lane >> 5, ql = lane & 31;
  float* lut = (float*)(lds + NSA_LUT) + wv * 128;
  for (int item = blockIdx.x; item < NBATCH * 2 * (SEQ / 32); item += gridDim.x) {
    const int tt = (item < 256) ? (SEQ / 32 - 1) - (item % (SEQ / 32)) : (item % (SEQ / 32));
    const int bg = item / (SEQ / 32);
    const int b = bg >> 1, g = bg & 1;
    const int h = g * 4 + wv;
    const int t0 = tt * 32, tq = t0 + ql, cur = t0 >> 6;
    __syncthreads();
    QFrag q;
    q_load(q, p.qn + (size_t)(b * SEQ + tq) * 1024 + h * 128);
    {
      const int lo = opq(lane);
      lut[lo] = p.t5[t5_bucket(lo) * 8 + h];
      lut[lo + 64] = p.t5[t5_bucket(lo + 64) * 8 + h];
    }
#pragma unroll
    for (int i = 0; i < 16; ++i) imp[i * 256 + tid] = 0.f;
    if (tid < 32) selm[tid] = 0u;
    const float* grow = p.gates + (size_t)(b * SEQ + tq) * 24 + h * 3;
    float* prow = p.part + (size_t)(b * SEQ + tq) * 1024 + h * 128;
    OAcc o;
    float m, l;
    KVRegs kv;
    {
      const bf16_t* kb = p.kcb + (size_t)bg * 128 * 128;
      const bf16_t* vb = p.vcT + (size_t)bg * 128 * 128;
      oacc_zero(o);
      m = NEG_BIG; l = 0.f;
      kv_load(kv, kb, 128, vb, 128);
      __syncthreads();
      kv_store(kv, lk, lv);
      __syncthreads();
      f32x16 x0, x1;
      qk_tile(q, lk, x0, x1);
      int tqv = tq;
      asm volatile("" : "+v"(tqv));
      tqv -= 64 * hh;
      if (t0 >= 1152) {
        const float b31 = lut[127];
#pragma unroll
        for (int r = 0; r < 16; ++r) { x0[r] = x0[r] * ATT_SCALE + b31; x1[r] = x1[r] * ATT_SCALE + b31; }
      } else {
#pragma unroll
        for (int r = 0; r < 16; ++r) {
          const int c = 8 * (r >> 2) + (r & 3);
          const int d0 = tqv - 16 * c - 31, d1 = d0 - 512;
          x0[r] = (d0 >= 0) ? x0[r] * ATT_SCALE + lut[min(d0, 127)] : NEG_BIG;
          x1[r] = (d1 >= 0) ? x1[r] * ATT_SCALE + lut[min(d1, 127)] : NEG_BIG;
        }
      }
      softmax_tile(x0, x1, m, l, o);
      const float m0 = m;
      pv_tile(o, lv, x0, x1);
      f32x16 z0, z1;
#pragma unroll
      for (int r = 0; r < 16; ++r) { z0[r] = 0.f; z1[r] = 0.f; }
      if (t0 >= 1024) {
        kv_load(kv, kb + 64 * 128, 128, vb + 64, 128);
        __syncthreads();
        kv_store(kv, lk, lv);
        __syncthreads();
        qk_tile(q, lk, z0, z1);
        asm volatile("" : "+v"(tqv));
#pragma unroll
        for (int r = 0; r < 16; ++r) {
          const int c = 64 + 8 * (r >> 2) + (r & 3);
          const int d0 = tqv - 16 * c - 31, d1 = d0 - 512;
          z0[r] = (d0 >= 0) ? z0[r] * ATT_SCALE + lut[min(d0, 127)] : NEG_BIG;
          z1[r] = (d1 >= 0) ? z1[r] * ATT_SCALE + lut[min(d1, 127)] : NEG_BIG;
        }
        softmax_tile(z0, z1, m, l, o);
        pv_tile(o, lv, z0, z1);
      }
      const float inv = 1.f / fmaxf(l, 1e-20f);
      const float c0 = __expf(m0 - m) * inv;
#pragma unroll
      for (int r = 0; r < 16; ++r) {
        const int c = 8 * (r >> 2) + (r & 3) + 4 * hh;
        if (x0[r] != 0.f) atomicAdd(&imp[(c) * 32 + ql], x0[r] * c0);
        if (x1[r] != 0.f) atomicAdd(&imp[(c + 32) * 32 + ql], x1[r] * c0);
        if (z0[r] != 0.f) atomicAdd(&imp[(c + 64) * 32 + ql], z0[r] * inv);
        if (z1[r] != 0.f) atomicAdd(&imp[(c + 96) * 32 + ql], z1[r] * inv);
      }
      const float gs = inv / (1.f + __expf(-grow[0]));
      oacc_foreach(o, [&](int d, float v0, float v1, float v2, float v3) {
        f32x4 u = {v0 * gs, v1 * gs, v2 * gs, v3 * gs};
        *(f32x4*)(prow + d) = u;
      });
    }
    __syncthreads();
    {
      const int tido = opq(tid);
      const int qq = tido & 31, jg = tido >> 5;
#pragma unroll
      for (int jj = 0; jj < 4; ++jj) {
        const int j = jg * 4 + jj;
        float v = imp[(4 * j) * 32 + qq] + imp[(4 * j + 1) * 32 + qq] + imp[(4 * j + 2) * 32 + qq] + 0.5f * imp[(4 * j + 3) * 32 + qq];
        if (j > 0) v += 0.5f * imp[(4 * j - 1) * 32 + qq];
        const bool forced = (j == 0) || (j == cur) || (j == cur - 1);
        keys[qq * 33 + j] = forced ? 1e9f : ((j <= cur) ? v : -1e9f);
      }
      __syncthreads();
      unsigned bits = 0u;
#pragma unroll
      for (int jj = 0; jj < 4; ++jj) {
        const int j = jg * 4 + jj;
        const float kj = keys[qq * 33 + j];
        int rank = 0;
        for (int i = 0; i < 32; ++i) {
          const float ki = keys[qq * 33 + i];
          rank += (ki > kj || (ki == kj && i < j)) ? 1 : 0;
        }
        if (rank < 16 && j <= cur) bits |= 1u << j;
      }
      atomicOr(&selm[qq], bits);
      __syncthreads();
    }
    const unsigned mysel = selm[ql];
    unsigned um = mysel;
#pragma unroll
    for (int o2 = 16; o2 > 0; o2 >>= 1) um |= (unsigned)__shfl_xor((int)um, o2);
    um = (unsigned)__builtin_amdgcn_readfirstlane((int)um);
    {
      const bf16_t* kb = p.ks + (size_t)bg * SEQ * 128;
      const bf16_t* vb = p.vsT + (size_t)bg * 128 * SEQ;
      oacc_zero(o);
      m = NEG_BIG; l = 0.f;
      unsigned rem = um;
      int j = __builtin_ctz(rem);
      kv_load(kv, kb + (size_t)j * 64 * 128, 128, vb + j * 64, SEQ);
      while (rem) {
        j = __builtin_ctz(rem);
        rem &= rem - 1;
        const int jn = rem ? __builtin_ctz(rem) : j;
        __syncthreads();
        kv_store(kv, lk, lv);
        __syncthreads();
        f32x16 s0, s1;
        qk_tile(q, lk, s0, s1);
        const bool selq = (mysel >> j) & 1u;
        int tqv = tq;
        asm volatile("" : "+v"(tqv));
        if (j * 64 + 63 + 113 <= t0) {
          const float sc = selq ? ATT_SCALE : 0.f, bb = selq ? lut[127] : NEG_BIG;
#pragma unroll
          for (int r = 0; r < 16; ++r) { s0[r] = s0[r] * sc + bb; s1[r] = s1[r] * sc + bb; }
        } else {
#pragma unroll
          for (int r = 0; r < 16; ++r) {
            const int d0 = tqv - (j * 64 + 8 * (r >> 2) + (r & 3) + 4 * hh), d1 = d0 - 32;
            s0[r] = (selq && d0 >= 0) ? s0[r] * ATT_SCALE + lut[min(d0, 127)] : NEG_BIG;
            s1[r] = (selq && d1 >= 0) ? s1[r] * ATT_SCALE + lut[min(d1, 127)] : NEG_BIG;
          }
        }
        kv_load(kv, kb + (size_t)jn * 64 * 128, 128, vb + jn * 64, SEQ);
        softmax_tile(s0, s1, m, l, o);
        pv_tile(o, lv, s0, s1);
      }
      const float gs = 1.f / (fmaxf(l, 1e-20f) * (1.f + __expf(-grow[1])));
      int qo = ql;
      asm volatile("" : "+v"(qo));
      float* pr2 = p.part + (size_t)(b * SEQ + t0 + qo) * 1024 + h * 128;
      oacc_foreach(o, [&](int d, float v0, float v1, float v2, float v3) {
        f32x4 u = *(f32x4*)(pr2 + d);
        u[0] += v0 * gs; u[1] += v1 * gs; u[2] += v2 * gs; u[3] += v3 * gs;
        *(f32x4*)(pr2 + d) = u;
      });
    }
    {
      const bf16_t* kb = p.kw + (size_t)bg * SEQ * 128;
      const bf16_t* vb = p.vwT + (size_t)bg * 128 * SEQ;
      oacc_zero(o);
      m = NEG_BIG; l = 0.f;
      int jlo = (t0 - 511) >> 6;
      if (jlo < 0) jlo = 0;
      kv_load(kv, kb + (size_t)jlo * 64 * 128, 128, vb + jlo * 64, SEQ);
      for (int j = jlo; j <= cur; ++j) {
        const int jn = (j < cur) ? j + 1 : j;
        __syncthreads();
        kv_store(kv, lk, lv);
        __syncthreads();
        f32x16 s0, s1;
        qk_tile(q, lk, s0, s1);
        int tqv = tq;
        asm volatile("" : "+v"(tqv));
        if (j * 64 + 63 + 113 <= t0 && t0 + 31 - j * 64 < 512) {
          const float b31 = lut[127];
#pragma unroll
          for (int r = 0; r < 16; ++r) { s0[r] = s0[r] * ATT_SCALE + b31; s1[r] = s1[r] * ATT_SCALE + b31; }
        } else {
#pragma unroll
          for (int r = 0; r < 16; ++r) {
            const int d0 = tqv - (j * 64 + 8 * (r >> 2) + (r & 3) + 4 * hh), d1 = d0 - 32;
            s0[r] = (d0 >= 0 && d0 < 512) ? s0[r] * ATT_SCALE + lut[min(d0, 127)] : NEG_BIG;
            s1[r] = (d1 >= 0 && d1 < 512) ? s1[r] * ATT_SCALE + lut[min(d1, 127)] : NEG_BIG;
          }
        }
        kv_load(kv, kb + (size_t)jn * 64 * 128, 128, vb + jn * 64, SEQ);
        softmax_tile(s0, s1, m, l, o);
        pv_tile(o, lv, s0, s1);
      }
      const float gs = 1.f / (fmaxf(l, 1e-20f) * (1.f + __expf(-grow[2])));
      int qo = ql;
      asm volatile("" : "+v"(qo));
      const float* pr2 = p.part + (size_t)(b * SEQ + t0 + qo) * 1024 + h * 128;
      bf16_t* orow = p.omix + (size_t)(b * SEQ + t0 + qo) * DM + h * 128;
      oacc_foreach(o, [&](int d, float v0, float v1, float v2, float v3) {
        const f32x4 u = *(const f32x4*)(pr2 + d);
        uint2 w;
        w.x = pack2(u[0] + v0 * gs, u[1] + v1 * gs);
        w.y = pack2(u[2] + v2 * gs, u[3] + v3 * gs);
        *(uint2*)(orow + d) = w;
      });
    }
  }
}

__device__ __forceinline__ void ph_cvt(const float* src, bf16_t* dst, size_t n) {
  typedef __attribute__((ext_vector_type(4))) float f32x4;
  const size_t nv = n / 8;
  for (size_t i = (size_t)blockIdx.x * 256 + opq(threadIdx.x); i < nv; i += (size_t)gridDim.x * 256) {
    const f32x4 a = ((const f32x4*)src)[2 * i], b = ((const f32x4*)src)[2 * i + 1];
    u32x4 o;
    o[0] = pack2(a[0], a[1]); o[1] = pack2(a[2], a[3]); o[2] = pack2(b[0], b[1]); o[3] = pack2(b[2], b[3]);
    ((u32x4*)dst)[i] = o;
  }
}

__device__ __forceinline__ void ph_scores(const P& p, char* lds) {
  for (int u = blockIdx.x; u < 64 * 16; u += gridDim.x) {
    const int tm = u & 63, hp = u >> 6;
    const int m0 = tm * 128;
    float* sc = p.scores + (size_t)m0 * DM + hp * 128;
    gemm_tile_bf16<false>(p.omix + (size_t)m0 * DM + hp * 128, DM, p.subkb + (size_t)hp * 128 * 128, 128, 128, lds,
                          [&](int r, int c, float val) { sc[(size_t)r * DM + c] = val; });
  }
}

__device__ __forceinline__ void ph_qp_scores(const P& p, char* lds) {
  const int ntm = T_TOK / 128, ntn = DM / 128;
  const int npm = (ntm + 7) / 8, npn = (ntn + 7) / 8;
  const int nslots = ((npm * npn * 64 + 511) / 512) * 512;
  for (int u = blockIdx.x; u < nslots; u += gridDim.x) {
    int v = (u & 7) * 64 + ((u >> 3) & 63) + (u & ~511);
    int patch = v >> 6, w = v & 63;
    int tm = (patch % npm) * 8 + (w & 7);
    int tn = (patch / npm) * 8 + (w >> 3);
    if (tm >= ntm || tn >= ntn) continue;
    const int m0 = tm * 128, n0 = tn * 128;
    bf16_t* qp = p.omix + (size_t)m0 * DM + n0;
    gemm_tile_bf16<false, true>(p.hn + (size_t)m0 * DM, DM, p.WpqT + (size_t)n0 * DM, DM, DM, lds,
                                [&](int r, int c, f32x4_e lo, f32x4_e hi) { st_bf16x8(qp + (size_t)r * DM + c, lo, hi); });
    __threadfence_block();
    __syncthreads();
    float* sc = p.scores + (size_t)m0 * DM + n0;
    gemm_tile_bf16<false, true>(qp, DM, p.subkb + (size_t)tn * 128 * 128, 128, 128, lds,
                                [&](int r, int c, f32x4_e lo, f32x4_e hi) {
                                  *(f32x4_e*)(sc + (size_t)r * DM + c) = lo; *(f32x4_e*)(sc + (size_t)r * DM + c + 4) = hi; });
  }
}

__device__ __forceinline__ void ph_cvt4(const float* src, unsigned char* dst, float* scales, int nrows, int wid0, int nw) {
  typedef __attribute__((ext_vector_type(4))) float f32x4;
  typedef __attribute__((ext_vector_type(2))) float f32x2;
  const int lane = opq(threadIdx.x) & 63;
  const float one = __uint_as_float((unsigned)opq(0x3F800000));
  float lev[8];
#pragma unroll
  for (int c = 0; c < 8; ++c) {
    const f32x2 q = __builtin_amdgcn_cvt_scalef32_pk_f32_fp4((unsigned)opq(c * 0x11111111), one, 0);
    lev[c] = fabsf(q[0]);
  }
  const float maxlev = lev[7];
  for (int row = wid0; row < nrows; row += nw) {
    const f32x4* s4 = (const f32x4*)(src + (size_t)row * DM) + lane * 8;
    f32x4 v[8];
    float amax = 0.f;
#pragma unroll
    for (int i = 0; i < 8; ++i) {
      v[i] = s4[i];
#pragma unroll
      for (int k = 0; k < 4; ++k) amax = fmaxf(amax, fabsf(v[i][k]));
    }
    amax = wave_max(amax);
    const float sc = (amax > 0.f) ? maxlev / amax : 1.f;
    u32x4 o;
#pragma unroll
    for (int w = 0; w < 4; ++w) {
      unsigned pk = 0u;
      pk = __builtin_amdgcn_cvt_scalef32_pk_fp4_f32(pk, v[2 * w][0] * sc, v[2 * w][1] * sc, 1.0f, 0);
      pk = __builtin_amdgcn_cvt_scalef32_pk_fp4_f32(pk, v[2 * w][2] * sc, v[2 * w][3] * sc, 1.0f, 1);
      pk = __builtin_amdgcn_cvt_scalef32_pk_fp4_f32(pk, v[2 * w + 1][0] * sc, v[2 * w + 1][1] * sc, 1.0f, 2);
      pk = __builtin_amdgcn_cvt_scalef32_pk_fp4_f32(pk, v[2 * w + 1][2] * sc, v[2 * w + 1][3] * sc, 1.0f, 3);
      o[w] = pk;
    }
    *(u32x4*)(dst + (size_t)row * 1024 + lane * 16) = o;
    if (lane == 0) scales[row] = (amax > 0.f) ? amax / maxlev : 1.f;
  }
}

__device__ __forceinline__ u32x4 r4_load(const unsigned char* tab, int eid, int lane) {
  return *((const u32x4*)(tab + (size_t)eid * 1024) + lane);
}
struct XPk { f32x16 a, b; };
struct Acc32 { f32x16 a, b; };

#define R4_DOT_W(word, xv, base, pa, pb)                                                             \
  {                                                                                                  \
    typedef __attribute__((ext_vector_type(2))) float f32x2;                                         \
    const f32x2 q0 = __builtin_amdgcn_cvt_scalef32_pk_f32_fp4(word, one, 0), q1 = __builtin_amdgcn_cvt_scalef32_pk_f32_fp4(word, one, 1); \
    const f32x2 q2 = __builtin_amdgcn_cvt_scalef32_pk_f32_fp4(word, one, 2), q3 = __builtin_amdgcn_cvt_scalef32_pk_f32_fp4(word, one, 3); \
    pa += q0[0] * xv[base + 0] + q0[1] * xv[base + 1]; pb += q1[0] * xv[base + 2] + q1[1] * xv[base + 3]; \
    pa += q2[0] * xv[base + 4] + q2[1] * xv[base + 5]; pb += q3[0] * xv[base + 6] + q3[1] * xv[base + 7]; \
  }
__device__ __forceinline__ float r4_dot(const u32x4& e, const XPk& x) {
  const float one = __uint_as_float((unsigned)opq(0x3F800000));
  float pa = 0.f, pb = 0.f;
  R4_DOT_W(e[0], x.a, 0, pa, pb) R4_DOT_W(e[1], x.a, 8, pa, pb) R4_DOT_W(e[2], x.b, 0, pa, pb) R4_DOT_W(e[3], x.b, 8, pa, pb)
  return pa + pb;
}
#define R4_AXPY_W(word, accv, base)                                                                  \
  {                                                                                                  \
    typedef __attribute__((ext_vector_type(2))) float f32x2;                                         \
    const f32x2 q0 = __builtin_amdgcn_cvt_scalef32_pk_f32_fp4(word, one, 0), q1 = __builtin_amdgcn_cvt_scalef32_pk_f32_fp4(word, one, 1); \
    const f32x2 q2 = __builtin_amdgcn_cvt_scalef32_pk_f32_fp4(word, one, 2), q3 = __builtin_amdgcn_cvt_scalef32_pk_f32_fp4(word, one, 3); \
    accv[base + 0] += hid * q0[0]; accv[base + 1] += hid * q0[1]; accv[base + 2] += hid * q1[0]; accv[base + 3] += hid * q1[1]; \
    accv[base + 4] += hid * q2[0]; accv[base + 5] += hid * q2[1]; accv[base + 6] += hid * q3[0]; accv[base + 7] += hid * q3[1]; \
  }
__device__ __forceinline__ void r4_axpy(const u32x4& e, float hid, Acc32& acc) {
  const float one = __uint_as_float((unsigned)opq(0x3F800000));
  R4_AXPY_W(e[0], acc.a, 0) R4_AXPY_W(e[1], acc.a, 8) R4_AXPY_W(e[2], acc.b, 0) R4_AXPY_W(e[3], acc.b, 8)
}

#define INS16(K, x)                                                                                      \
  K##15 = __builtin_amdgcn_fmed3f(K##15, K##14, x); K##14 = __builtin_amdgcn_fmed3f(K##14, K##13, x);   \
  K##13 = __builtin_amdgcn_fmed3f(K##13, K##12, x); K##12 = __builtin_amdgcn_fmed3f(K##12, K##11, x);   \
  K##11 = __builtin_amdgcn_fmed3f(K##11, K##10, x); K##10 = __builtin_amdgcn_fmed3f(K##10, K##9, x);    \
  K##9 = __builtin_amdgcn_fmed3f(K##9, K##8, x); K##8 = __builtin_amdgcn_fmed3f(K##8, K##7, x);         \
  K##7 = __builtin_amdgcn_fmed3f(K##7, K##6, x); K##6 = __builtin_amdgcn_fmed3f(K##6, K##5, x);         \
  K##5 = __builtin_amdgcn_fmed3f(K##5, K##4, x); K##4 = __builtin_amdgcn_fmed3f(K##4, K##3, x);         \
  K##3 = __builtin_amdgcn_fmed3f(K##3, K##2, x); K##2 = __builtin_amdgcn_fmed3f(K##2, K##1, x);         \
  K##1 = __builtin_amdgcn_fmed3f(K##1, K##0, x); K##0 = fmaxf(K##0, x);
#define DECL16(K) float K##0 = -INFINITY, K##1 = -INFINITY, K##2 = -INFINITY, K##3 = -INFINITY, K##4 = -INFINITY, \
  K##5 = -INFINITY, K##6 = -INFINITY, K##7 = -INFINITY, K##8 = -INFINITY, K##9 = -INFINITY, K##10 = -INFINITY,   \
  K##11 = -INFINITY, K##12 = -INFINITY, K##13 = -INFINITY, K##14 = -INFINITY, K##15 = -INFINITY;
__device__ __forceinline__ float mkkey(float v, unsigned tag, unsigned mask) {
  return __uint_as_float((__float_as_uint(v) & ~mask) | tag);
}

__device__ __forceinline__ void ph_peer(const P& p, float* smem) {
  typedef __attribute__((ext_vector_type(4))) float f32x4;
  float* lists = smem;
  int* bexA = (int*)(smem + 4096);
  float* bgtA = smem + 6144;
  float* bsuA = smem + 8192;
  for (int item = blockIdx.x; item < T_TOK / 16; item += gridDim.x) {
    const int t0 = item * 16;
    __syncthreads();
    {
      const int tid = opq(threadIdx.x);
      const int tl = tid >> 4, hp = tid & 15;
      const f32x4* sp = (const f32x4*)(p.scores + (size_t)(t0 + tl) * DM + hp * 128);
      DECL16(k)
#pragma unroll 4
      for (int c4 = 0; c4 < 32; ++c4) {
        const f32x4 v = sp[c4];
#pragma unroll
        for (int e = 0; e < 4; ++e) {
          const float x = mkkey(v[e], 127u - (unsigned)(c4 * 4 + e), 127u);
          INS16(k, x)
        }
      }
      f32x4* lp = (f32x4*)(lists + (size_t)opq(threadIdx.x) * 16);
      f32x4 o0 = {k0, k1, k2, k3}, o1 = {k4, k5, k6, k7}, o2 = {k8, k9, k10, k11}, o3 = {k12, k13, k14, k15};
      lp[0] = o0; lp[1] = o1; lp[2] = o2; lp[3] = o3;
    }
    __syncthreads();
    if (opq(threadIdx.x) < 128) {
      const int tid = opq(threadIdx.x);
      const int tl = tid >> 3, h = tid & 7;
      const float* la = lists + (size_t)(tl * 16 + 2 * h) * 16;
      const float* lb = la + 16;
      float av[16], bv[16];
#pragma unroll
      for (int i = 0; i < 16; ++i) {
        av[i] = __uint_as_float(__float_as_uint(la[i]) & ~127u);
        bv[i] = __uint_as_float(__float_as_uint(lb[i]) & ~127u);
      }
      DECL16(c)
#pragma unroll
      for (int i = 0; i < 16; ++i) {
#pragma unroll
        for (int j = 0; j < 16; ++j) {
          if ((i + 1) * (j + 1) <= 16) {
            const float x = mkkey(av[i] + bv[j], 255u - (unsigned)(i * 16 + j), 255u);
            INS16(c, x)
          }
        }
      }
      float cs[16] = {c0, c1, c2, c3, c4, c5, c6, c7, c8, c9, c10, c11, c12, c13, c14, c15};
      float ev[16];
      float sum = 0.f;
      const float mx = __uint_as_float(__float_as_uint(cs[0]) & ~255u);
#pragma unroll
      for (int n = 0; n < 16; ++n) {
        ev[n] = __expf(__uint_as_float(__float_as_uint(cs[n]) & ~255u) - mx);
        sum += ev[n];
      }
      const float isum = 1.f / sum;
#pragma unroll
      for (int n = 0; n < 16; ++n) {
        const unsigned cc = 255u - (__float_as_uint(cs[n]) & 255u);
        const unsigned ka = 127u - (__float_as_uint(la[cc >> 4]) & 127u);
        const unsigned kb = 127u - (__float_as_uint(lb[cc & 15u]) & 127u);
        const int eid = (int)(ka * 128u + kb);
        bexA[tl * 128 + h * 16 + n] = eid;
        bgtA[tl * 128 + h * 16 + n] = ev[n] * isum * p.sv8[eid];
        bsuA[tl * 128 + h * 16 + n] = p.su8[eid];
      }
    }
    __syncthreads();
#pragma unroll 1
    for (int ti4 = 0; ti4 < 4; ++ti4) {
    const int lane = opq(threadIdx.x) & 63, wv = opq(threadIdx.x) >> 6;
    const int tl = wv * 4 + ti4;
    const int t = t0 + tl;
    const int* bex = bexA + tl * 128;
    const float* bgt = bgtA + tl * 128;
    const float* bsu = bsuA + tl * 128;
    XPk x;
    {
      const f32x4* s4 = (const f32x4*)(p.out + (size_t)t * DM) + lane * 8;
      const f32x4* g4 = (const f32x4*)p.norm_ffn + lane * 8;
      f32x4 a0 = s4[0], a1 = s4[1], a2 = s4[2], a3 = s4[3], a4 = s4[4], a5 = s4[5], a6 = s4[6], a7 = s4[7];
      float ss = 0.f;
#define SSQ(v) ss += v[0] * v[0] + v[1] * v[1] + v[2] * v[2] + v[3] * v[3];
      SSQ(a0) SSQ(a1) SSQ(a2) SSQ(a3) SSQ(a4) SSQ(a5) SSQ(a6) SSQ(a7)
#undef SSQ
      ss = wave_sum(ss);
      const float rs = rsqrtf(ss * (1.f / DM) + RMS_EPS);
#define XPK(dst, base, va, vb, gi)                                                    \
  {                                                                                   \
    const f32x4 ga = g4[gi], gb = g4[gi + 1];                                         \
    dst[base + 0] = bf2f(f2bf(va[0] * rs * ga[0])); dst[base + 1] = bf2f(f2bf(va[1] * rs * ga[1]));   \
    dst[base + 2] = bf2f(f2bf(va[2] * rs * ga[2])); dst[base + 3] = bf2f(f2bf(va[3] * rs * ga[3]));   \
    dst[base + 4] = bf2f(f2bf(vb[0] * rs * gb[0])); dst[base + 5] = bf2f(f2bf(vb[1] * rs * gb[1]));   \
    dst[base + 6] = bf2f(f2bf(vb[2] * rs * gb[2])); dst[base + 7] = bf2f(f2bf(vb[3] * rs * gb[3]));   \
  }
      XPK(x.a, 0, a0, a1, 0) XPK(x.a, 8, a2, a3, 2) XPK(x.b, 0, a4, a5, 4) XPK(x.b, 8, a6, a7, 6)
#undef XPK
    }
    Acc32 acc;
#pragma unroll
    for (int r = 0; r < 16; ++r) { acc.a[r] = 0.f; acc.b[r] = 0.f; }
    u32x4 u0 = r4_load(p.pu8, bex[0], lane), u1 = r4_load(p.pu8, bex[1], lane), u2 = r4_load(p.pu8, bex[2], lane), u3 = r4_load(p.pu8, bex[3], lane);
    u32x4 v0 = r4_load(p.pv8, bex[0], lane), v1 = r4_load(p.pv8, bex[1], lane), v2 = r4_load(p.pv8, bex[2], lane), v3 = r4_load(p.pv8, bex[3], lane);
#pragma unroll 1
    for (int e0 = 0; e0 < 128; e0 += 4) {
      float d0 = r4_dot(u0, x), d1 = r4_dot(u1, x), d2 = r4_dot(u2, x), d3 = r4_dot(u3, x);
      const int en = (e0 + 4 < 128) ? e0 + 4 : 124;
      const int i0 = bex[en], i1 = bex[en + 1], i2 = bex[en + 2], i3 = bex[en + 3];
      u0 = r4_load(p.pu8, i0, lane); u1 = r4_load(p.pu8, i1, lane); u2 = r4_load(p.pu8, i2, lane); u3 = r4_load(p.pu8, i3, lane);
#pragma unroll
      for (int o = 32; o > 0; o >>= 1) {
        d0 += __shfl_xor(d0, o); d1 += __shfl_xor(d1, o); d2 += __shfl_xor(d2, o); d3 += __shfl_xor(d3, o);
      }
      { const float hid = bgt[e0 + 0] * gelu_fast(d0 * bsu[e0 + 0]); r4_axpy(v0, hid, acc); }
      { const float hid = bgt[e0 + 1] * gelu_fast(d1 * bsu[e0 + 1]); r4_axpy(v1, hid, acc); }
      { const float hid = bgt[e0 + 2] * gelu_fast(d2 * bsu[e0 + 2]); r4_axpy(v2, hid, acc); }
      { const float hid = bgt[e0 + 3] * gelu_fast(d3 * bsu[e0 + 3]); r4_axpy(v3, hid, acc); }
      v0 = r4_load(p.pv8, i0, lane); v1 = r4_load(p.pv8, i1, lane); v2 = r4_load(p.pv8, i2, lane); v3 = r4_load(p.pv8, i3, lane);
    }
    const int lane2 = opq(lane);
    f32x4* o4 = (f32x4*)(p.out + (size_t)t * DM) + lane2 * 8;
    const f32x4* g4 = (const f32x4*)p.norm_final + lane2 * 8;
    f32x4 hv[8];
    float ss = 0.f;
#pragma unroll
    for (int i = 0; i < 8; ++i) {
      hv[i] = o4[i];
#pragma unroll
      for (int k = 0; k < 4; ++k) {
        hv[i][k] += (i < 4) ? acc.a[4 * i + k] : acc.b[4 * (i - 4) + k];
        ss += hv[i][k] * hv[i][k];
      }
    }
    ss = wave_sum(ss);
    const float rs = rsqrtf(ss * (1.f / DM) + RMS_EPS);
#pragma unroll
    for (int i = 0; i < 8; ++i) {
      const f32x4 g = g4[i];
      f32x4 o;
#pragma unroll
      for (int k = 0; k < 4; ++k) o[k] = hv[i][k] * rs * g[k];
      o4[i] = o;
    }
    }
  }
}

#define XB_TMO      128
#define XB_XCNT(j)  (256  + 64 * (j))
#define XB_XSUB(j)  (1280 + 64 * (j))
#define XB_XGEN(j)  (2304 + 64 * (j))
#define XB_TOP      3328
#define XB_TOPGEN   3392
#define XCD_BAR_WORDS 3456
#define XB_SPIN_CAP (1u << 22)
#define LAS __attribute__((address_space(3)))
__device__ __forceinline__ unsigned xb_ld(unsigned* p) { return __hip_atomic_load(p, __ATOMIC_RELAXED, __HIP_MEMORY_SCOPE_AGENT); }
__device__ __forceinline__ unsigned xb_add(unsigned* p, unsigned v) { return __hip_atomic_fetch_add(p, v, __ATOMIC_RELAXED, __HIP_MEMORY_SCOPE_AGENT); }
__device__ __forceinline__ unsigned xb_xcc_id() { return (unsigned)__builtin_amdgcn_s_getreg((3 << 11) | 20) & 0xFu; }
#define XB_SPIN(cond, bar) do { unsigned _sp = 0; while (cond) { __builtin_amdgcn_s_sleep(1); \
    if ((++_sp & 255u) == 0u) { if (xb_ld(&(bar)[XB_TMO])) break; if (_sp > XB_SPIN_CAP) { atomicAdd(&(bar)[XB_TMO], 1u); break; } } } } while (0)
struct XcdBarrier { unsigned* bar; unsigned x; volatile LAS unsigned* st; };
__device__ __forceinline__ XcdBarrier xcd_barrier_post(unsigned* bar, volatile LAS unsigned* st) {
  XcdBarrier b; b.bar = bar; b.x = xb_xcc_id(); b.st = st;
  if (threadIdx.x == 0) (void)xb_add(&bar[XB_XCNT(b.x)], 1u);
  return b;
}
__device__ __forceinline__ void xcd_barrier_complete(unsigned* bar, unsigned x, unsigned& nloc, unsigned& nx) {
  const unsigned G = gridDim.x * gridDim.y * gridDim.z;
  unsigned sum, cnt, mine, sp = 0u;
  for (;;) {
    sum = 0u; cnt = 0u; mine = 0u;
#pragma unroll
    for (unsigned j = 0; j < 16; ++j) { const unsigned c = xb_ld(&bar[XB_XCNT(j)]); sum += c; cnt += (c > 0u) ? 1u : 0u; mine = (j == x) ? c : mine; }
    if (sum == G) break;
    __builtin_amdgcn_s_sleep(1);
    if ((++sp & 255u) == 0u) { if (xb_ld(&bar[XB_TMO])) break; if (sp > XB_SPIN_CAP) { atomicAdd(&bar[XB_TMO], 1u); break; } }
  }
  nloc = mine > 0u ? mine : 1u; nx = cnt > 0u ? cnt : 1u;
}
__device__ __forceinline__ void xcd_barrier(const XcdBarrier& b) {
  asm volatile("s_waitcnt vmcnt(0)" ::: "memory");
  __syncthreads();
  if (threadIdx.x == 0) {
    unsigned* bar = b.bar;
    __builtin_amdgcn_s_waitcnt(0);
    unsigned nloc = b.st[0], nx = b.st[1];
    if (nloc == 0u) { xcd_barrier_complete(bar, b.x, nloc, nx); b.st[0] = nloc; b.st[1] = nx; }
    const unsigned old = xb_add(&bar[XB_XSUB(b.x)], 1u);
    const unsigned gen = old / nloc;
    if (old + 1u == (gen + 1u) * nloc) {
      __builtin_amdgcn_fence(__ATOMIC_RELEASE, "agent");
      asm volatile("s_waitcnt vmcnt(0)" ::: "memory");
      const unsigned og = xb_add(&bar[XB_TOP], 1u);
      const unsigned tg = og / nx;
      if (og + 1u == (tg + 1u) * nx) xb_add(&bar[XB_TOPGEN], 1u);
      else XB_SPIN(xb_ld(&bar[XB_TOPGEN]) == tg, bar);
      __builtin_amdgcn_fence(__ATOMIC_ACQUIRE, "agent");
      xb_add(&bar[XB_XGEN(b.x)], 1u);
      asm volatile("s_waitcnt vmcnt(0)" ::: "memory");
    } else {
      XB_SPIN(xb_ld(&bar[XB_XGEN(b.x)]) == gen, bar);
      __builtin_amdgcn_fence(__ATOMIC_ACQUIRE, "agent");
      asm volatile("s_waitcnt vmcnt(0)" ::: "memory");
    }
  }
  __syncthreads();
}

typedef const __attribute__((address_space(4))) P* KP;
__device__ __forceinline__ P loadP() {
#if defined(__HIP_DEVICE_COMPILE__)
  KP k = (KP)__builtin_amdgcn_kernarg_segment_ptr();
  asm volatile("" : "+s"(k));
  P p = *k;
  return p;
#else
  return P{};
#endif
}

__global__ void __launch_bounds__(256, 2) mega(P p_arg) {
  cg::grid_group grid = cg::this_grid();
  __shared__ __attribute__((aligned(16))) float smem[14336];
  char* lds = (char*)smem;
  __shared__ uint4 xb_words;
  if (threadIdx.x == 0) xb_words = make_uint4(0u, 0u, 0u, 0u);
  if (blockIdx.x == 0) {
    P p = loadP();
    for (int i = threadIdx.x; i < XCD_BAR_WORDS; i += 256) p.bar[i] = 0u;
  }
  { P p = loadP(); ph_rmsnorm(p.x, p.norm_mix, p.hn, T_TOK); ph_rmsnorm(p.mem, p.norm_mkv, p.memn, 1024); }
  { P p = loadP(); ph_transpose<true>(smem, p.w_in, DM, INC, 5760, p.WinT); }
  { P p = loadP(); ph_transpose<false>(smem, p.w_mk, DM, 512, 512, p.WmkT); }
  { P p = loadP(); ph_transpose<false>(smem, p.w_mv, DM, 512, 512, p.WmvT); }
  { P p = loadP(); ph_cvt(p.subk, p.subkb, (size_t)16 * 128 * 128); }
  { P p = loadP(); ph_transpose<false>(smem, p.w1_k, 4096, 128, 128, p.w1T); }
  { P p = loadP(); ph_transpose<false>(smem, p.w1_v, 4096, 128, 128, p.w1T + 128 * 4096); }
  { P p = loadP(); ph_transpose<false>(smem, p.w2_k, 128, 128, 128, p.w2T); }
  { P p = loadP(); ph_transpose<false>(smem, p.w2_v, 128, 128, 128, p.w2T + 128 * 128); }
  { P p = loadP(); ph_posb(p); }
  grid.sync();
  XcdBarrier xb;
  { P p = loadP(); xb = xcd_barrier_post(p.bar, (volatile LAS unsigned*)&xb_words); }
  { P p = loadP(); ph_proj(p, lds); }
  const int kvb = (gridDim.x == 512) ? (((int)blockIdx.x >= 320 && (int)blockIdx.x < 352) ? ((int)blockIdx.x - 320) * 8 : -1) : -2;
  const int vvb = (gridDim.x == 512) ? (((int)blockIdx.x >= 352 && (int)blockIdx.x < 384) ? ((int)blockIdx.x - 352) * 8 : -1) : -2;
  { P p = loadP(); bf16_t* kmem = p.kmemb;
    ph_gemm_bf16(p.memn, DM, p.WmkT, DM, 1024, 512, DM, lds, [=](int m, int n, float v) {
      kmem[((size_t)((m >> 8) * 4 + (n >> 7)) * 256 + (m & 255)) * 128 + (n & 127)] = f2bf(v); }, kvb); }
  { P p = loadP(); bf16_t* vmem = p.vmemT;
    ph_gemm_bf16(p.memn, DM, p.WmvT, DM, 1024, 512, DM, lds, [=](int m, int n, float v) {
      vmem[((size_t)((m >> 8) * 4 + (n >> 7)) * 128 + (n & 127)) * 256 + perm16(m & 255)] = f2bf(v); }, vvb); }
  xcd_barrier(xb);
  { P p = loadP(); ph_compress2(p, lds); }
  { P p = loadP(); ph_sb2(p, lds); }
  {
    const int skip = (gridDim.x > 32) ? 16 : 0;
    const int vb = ((int)blockIdx.x >= skip) ? (int)blockIdx.x - skip : -1, nvb = (int)gridDim.x - skip;
    __syncthreads();
    { P p = loadP(); ph_transpose<false>(smem, p.w_out, DM, DM, DM, p.WoutT, vb, nvb); }
    { P p = loadP(); ph_transpose<false>(smem, p.w_mq, DM, 512, 512, p.WmqT, vb, nvb); }
  }
  xcd_barrier(xb);
  { P p = loadP(); ph_nsa2(p, lds); }
  xcd_barrier(xb);
  { P p = loadP(); float* out = p.out; const float* x = p.x;
    ph_gemm_bf16<true>(p.omix, DM, p.WoutT, DM, T_TOK, DM, DM, lds, [=](int m, int n, f32x4_e lo, f32x4_e hi) {
      const f32x4_e x0 = *(const f32x4_e*)(x + (size_t)m * DM + n), x1 = *(const f32x4_e*)(x + (size_t)m * DM + n + 4);
      *(f32x4_e*)(out + (size_t)m * DM + n) = x0 + lo; *(f32x4_e*)(out + (size_t)m * DM + n + 4) = x1 + hi; }); }
  xcd_barrier(xb);
  { P p = loadP(); ph_rmsnorm(p.out, p.norm_mq, p.hn, T_TOK); }
  xcd_barrier(xb);
  if (blockIdx.x < 256 || gridDim.x < 512) {
    P p = loadP(); bf16_t* qmem = p.qmemb;
    ph_gemm_bf16<true>(p.hn, DM, p.WmqT, DM, T_TOK, 512, DM, lds, [=](int m, int n, f32x4_e lo, f32x4_e hi) { st_bf16x8(qmem + (size_t)m * 512 + n, lo, hi); });
  }
  {
    const int half = (gridDim.x >= 512) ? 256 : 0;
    if ((int)blockIdx.x >= half) {
      const int nwv = ((int)gridDim.x - half) * 4, wid = ((int)blockIdx.x - half) * 4 + (opq(threadIdx.x) >> 6);
      { P p = loadP(); ph_cvt4(p.pu, p.pu8, p.su8, 16384, wid, nwv); }
      if (gridDim.x < 512) { P p = loadP(); ph_cvt4(p.pv, p.pv8, p.sv8, 16384, wid, nwv); }
      __syncthreads();
      { P p = loadP(); ph_transpose<false>(smem, p.w_mo, 512, DM, DM, p.WmoT, (int)blockIdx.x - half, (int)gridDim.x - half); }
    }
  }
  xcd_barrier(xb);
  { P p = loadP(); ph_memattn2(p, lds); }
  if (gridDim.x >= 512 && blockIdx.x >= 256) {
    const int nwv = ((int)gridDim.x - 256) * 4, wid = ((int)blockIdx.x - 256) * 4 + (opq(threadIdx.x) >> 6);
    { P p = loadP(); ph_cvt4(p.pv, p.pv8, p.sv8, 16384, wid, nwv); }
  }
  {
    const int half = (gridDim.x >= 512) ? 256 : 0;
    __syncthreads();
    P p = loadP(); ph_transpose<false>(smem, p.w_pq, DM, DM, DM, p.WpqT, ((int)blockIdx.x >= half) ? (int)blockIdx.x - half : -1, (int)gridDim.x - half);
  }
  xcd_barrier(xb);
  { P p = loadP(); float* out = p.out;
    ph_gemm_bf16<true>(p.omem, 512, p.WmoT, 512, T_TOK, DM, 512, lds, [=](int m, int n, f32x4_e lo, f32x4_e hi) {
      f32x4_e* o0 = (f32x4_e*)(out + (size_t)m * DM + n);
      o0[0] = o0[0] + lo; o0[1] = o0[1] + hi; }); }
  xcd_barrier(xb);
  { P p = loadP(); ph_rmsnorm(p.out, p.norm_ffn, p.hn, T_TOK); }
  xcd_barrier(xb);
  { P p = loadP(); ph_qp_scores(p, lds); }
  xcd_barrier(xb);
  { P p = loadP(); ph_peer(p, smem); }
}

extern "C" void kernel_launch(void* const* d_in, const int* in_sizes, int n_in, void* d_out, int out_size, void* d_ws,
                              size_t ws_size, hipStream_t stream) {
  P p{};
  p.x = (const float*)d_in[0]; p.mem = (const float*)d_in[1]; p.t5 = (const float*)d_in[2];
  p.norm_mix = (const float*)d_in[3]; p.w_in = (const float*)d_in[4]; p.pos_k = (const float*)d_in[5];
  p.w1_k = (const float*)d_in[6]; p.w2_k = (const float*)d_in[7]; p.pos_v = (const float*)d_in[8];
  p.w1_v = (const float*)d_in[9]; p.w2_v = (const float*)d_in[10]; p.w_out = (const float*)d_in[11];
  p.norm_mq = (const float*)d_in[12]; p.norm_mkv = (const float*)d_in[13]; p.w_mq = (const float*)d_in[14];
  p.w_mk = (const float*)d_in[15]; p.w_mv = (const float*)d_in[16]; p.w_mo = (const float*)d_in[17];
  p.norm_ffn = (const float*)d_in[18]; p.w_pq = (const float*)d_in[19]; p.subk = (const float*)d_in[20];
  p.pu = (const float*)d_in[21]; p.pv = (const float*)d_in[22]; p.norm_final = (const float*)d_in[23];
  p.out = (float*)d_out;
  char* w = (char*)d_ws;
  size_t off = 0;
  auto take = [&](size_t bytes) { char* r = w + off; off += (bytes + 255) & ~(size_t)255; return r; };
  p.bar = (unsigned*)take(XCD_BAR_WORDS * 4);
  p.scores = (float*)take((size_t)T_TOK * DM * 4);
  p.gates = (float*)take((size_t)T_TOK * 24 * 4);
  p.part = (float*)take((size_t)T_TOK * 1024 * 4);
  p.posb = (float*)take(256 * 4);
  p.qn = (bf16_t*)take((size_t)T_TOK * 1024 * 2);
  p.kcin = (bf16_t*)take((size_t)T_TOK * 256 * 2 + 65536);
  p.vcin = (bf16_t*)take((size_t)T_TOK * 256 * 2 + 65536);
  p.ks = (bf16_t*)take((size_t)T_TOK * 256 * 2);
  p.vsT = (bf16_t*)take((size_t)T_TOK * 256 * 2);
  p.kw = (bf16_t*)take((size_t)T_TOK * 256 * 2);
  p.vwT = (bf16_t*)take((size_t)T_TOK * 256 * 2);
  p.kcb = (bf16_t*)take((size_t)8 * 128 * 128 * 2);
  p.vcT = (bf16_t*)take((size_t)8 * 128 * 128 * 2);
  p.c1 = (bf16_t*)take((size_t)16 * 128 * 128 * 2);
  p.w1T = (bf16_t*)take((size_t)2 * 128 * 4096 * 2);
  p.w2T = (bf16_t*)take((size_t)2 * 128 * 128 * 2);
  p.hn = (bf16_t*)take((size_t)T_TOK * DM * 2);
  p.omix = (bf16_t*)take((size_t)T_TOK * DM * 2);
  p.memn = (bf16_t*)take((size_t)1024 * DM * 2);
  p.omem = (bf16_t*)take((size_t)T_TOK * 512 * 2);
  p.WinT = (bf16_t*)take((size_t)5760 * DM * 2);
  p.WoutT = (bf16_t*)take((size_t)DM * DM * 2);
  p.WpqT = (bf16_t*)take((size_t)DM * DM * 2);
  p.WmqT = (bf16_t*)take((size_t)512 * DM * 2);
  p.WmkT = (bf16_t*)take((size_t)512 * DM * 2);
  p.WmvT = (bf16_t*)take((size_t)512 * DM * 2);
  p.WmoT = (bf16_t*)take((size_t)DM * 512 * 2);
  p.qmemb = (bf16_t*)take((size_t)T_TOK * 512 * 2);
  p.kmemb = (bf16_t*)take((size_t)1024 * 512 * 2);
  p.vmemT = (bf16_t*)take((size_t)1024 * 512 * 2);
  p.qsb = (bf16_t*)take((size_t)T_TOK * 1024 * 2);
  p.ksb = (bf16_t*)take((size_t)T_TOK * 1024 * 2);
  p.vsbT = (bf16_t*)take((size_t)T_TOK * 1024 * 2);
  p.pu8 = (unsigned char*)take((size_t)16384 * 1024);
  p.pv8 = (unsigned char*)take((size_t)16384 * 1024);
  p.su8 = (float*)take(16384 * 4);
  p.sv8 = (float*)take(16384 * 4);
  p.subkb = (bf16_t*)take((size_t)16 * 128 * 128 * 2);
  static int grid_blocks = 0;
  if (!grid_blocks) {
    int dev = 0, cus = 0, per_cu = 0;
    (void)hipGetDevice(&dev);
    (void)hipDeviceGetAttribute(&cus, hipDeviceAttributeMultiprocessorCount, dev);
    (void)hipOccupancyMaxActiveBlocksPerMultiprocessor(&per_cu, mega, 256, 0);
    if (per_cu > 2) per_cu = 2;
    if (per_cu < 1) per_cu = 1;
    grid_blocks = cus * per_cu;
  }
  void* args[] = {&p};
  hipError_t e = hipLaunchCooperativeKernel((void*)mega, dim3(grid_blocks), dim3(256), args, 0, stream);
  if (e != hipSuccess) fprintf(stderr, "cooperative launch failed: %s (grid %d)\n", hipGetErrorString(e), grid_blocks);
}
```

```cpp
#include <hip/hip_runtime.h>
#include <hip/hip_cooperative_groups.h>
#include <cstdio>
namespace cg = cooperative_groups;
#include <stdint.h>

#define SEQ 2048
#define NBATCH 4
#define T_TOK 8192
#define DM 2048
#define INC 5656
#define C_QN 0
#define C_KC 1024
#define C_VC 1280
#define C_KS 1536
#define C_VS 1792
#define C_KW 2048
#define C_VW 2304
#define C_GT 2560
#define C_QSB 2584
#define C_KSB 3608
#define C_VSB 4632
#define ATT_SCALE 0.08838834764831845f
#define RMS_EPS 1e-6f

typedef unsigned short bf16_t;
typedef __attribute__((ext_vector_type(8))) short bf16x8;
typedef __attribute__((ext_vector_type(16))) float f32x16;
typedef __attribute__((ext_vector_type(2))) __bf16 bf16v2;
typedef __attribute__((ext_vector_type(4))) unsigned u32x4;

struct P {
  const float *x, *mem, *t5, *norm_mix, *w_in, *pos_k, *w1_k, *w2_k, *pos_v, *w1_v, *w2_v, *w_out,
      *norm_mq, *norm_mkv, *w_mq, *w_mk, *w_mv, *w_mo, *norm_ffn, *w_pq, *subk, *pu, *pv, *norm_final;
  float* out;
  float *scores, *gates, *part, *posb;
  unsigned* bar;
  bf16_t *hn, *omix, *memn, *omem;
  bf16_t *WinT, *WoutT, *WpqT, *WmqT, *WmkT, *WmvT, *WmoT;
  bf16_t *qmemb, *kmemb, *vmemT;
  bf16_t *qsb, *ksb, *vsbT;
  bf16_t* subkb;
  unsigned char *pu8, *pv8;
  float *su8, *sv8;
  bf16_t *qn, *kcin, *vcin, *ks, *vsT, *kw, *vwT, *kcb, *vcT, *c1, *w1T, *w2T;
};

__device__ __forceinline__ int opq(int v) { asm volatile("" : "+v"(v)); return v; }
__device__ __forceinline__ unsigned pack2(float a, float b) {
  bf16v2 r = {(__bf16)a, (__bf16)b};
  return *(unsigned*)&r;
}
__device__ __forceinline__ bf16_t f2bf(float a) {
  __bf16 r = (__bf16)a;
  return *(bf16_t*)&r;
}
__device__ __forceinline__ int perm16(int s) { return (s & ~12) | ((s & 4) << 1) | ((s & 8) >> 1); }
__device__ __forceinline__ float bf2f(bf16_t u) { return __uint_as_float((unsigned)u << 16); }

__device__ __forceinline__ float wave_max(float v) {
  for (int o = 32; o > 0; o >>= 1) v = fmaxf(v, __shfl_xor(v, o));
  return v;
}
__device__ __forceinline__ float wave_sum(float v) {
  for (int o = 32; o > 0; o >>= 1) v += __shfl_xor(v, o);
  return v;
}
__device__ __forceinline__ void wave_argmax(float& v, int& i) {
  for (int o = 32; o > 0; o >>= 1) {
    float ov = __shfl_xor(v, o);
    int oi = __shfl_xor(i, o);
    if (ov > v || (ov == v && oi < i)) { v = ov; i = oi; }
  }
}
__device__ __forceinline__ float gelu_tanh(float x) {
  return 0.5f * x * (1.f + tanhf(0.7978845608028654f * (x + 0.044715f * x * x * x)));
}
__device__ __forceinline__ float gelu_fast(float x) {
  const float y = 1.5957691216057308f * (x + 0.044715f * x * x * x);
  return x / (1.f + __expf(-y));
}
__device__ __forceinline__ int t5_bucket(int n) {
  if (n < 16) return n < 0 ? 0 : n;
  int b = 16;
  b += (n >= 19); b += (n >= 21); b += (n >= 24); b += (n >= 27); b += (n >= 31); b += (n >= 35);
  b += (n >= 40); b += (n >= 46); b += (n >= 52); b += (n >= 59); b += (n >= 67); b += (n >= 77);
  b += (n >= 87); b += (n >= 99); b += (n >= 113);
  return b;
}
__device__ __forceinline__ float log_sigmoid(float x) {
  return fminf(x, 0.f) - log1pf(expf(-fabsf(x)));
}

__device__ __forceinline__ void ph_rmsnorm(const float* src, const float* gain, bf16_t* dst, int rows) {
  int lane = opq(threadIdx.x) & 63, wv = opq(threadIdx.x) >> 6;
  for (int r = blockIdx.x * 4 + wv; r < rows; r += gridDim.x * 4) {
    const float4* s4 = (const float4*)(src + (size_t)r * DM);
    float4 v[8];
    float ss = 0.f;
#pragma unroll
    for (int i = 0; i < 8; ++i) {
      v[i] = s4[i * 64 + lane];
      ss += v[i].x * v[i].x + v[i].y * v[i].y + v[i].z * v[i].z + v[i].w * v[i].w;
    }
    ss = wave_sum(ss);
    float rs = rsqrtf(ss * (1.f / DM) + RMS_EPS);
    uint2* d2 = (uint2*)(dst + (size_t)r * DM);
    const float4* g4 = (const float4*)gain;
#pragma unroll
    for (int i = 0; i < 8; ++i) {
      float4 g = g4[i * 64 + lane];
      uint2 o;
      o.x = pack2(v[i].x * rs * g.x, v[i].y * rs * g.y);
      o.y = pack2(v[i].z * rs * g.z, v[i].w * rs * g.w);
      d2[i * 64 + lane] = o;
    }
  }
}

template <bool CMAP>
__device__ __forceinline__ void ph_transpose(float* smem, const float* W, int K, int N, int Npad, bf16_t* Wt,
                                             int vblock = -2, int nvb = 0) {
  typedef __attribute__((ext_vector_type(4))) float f32x4;
  float (*tl)[65] = (float (*)[65])smem;
  if (vblock == -1) return;
  const int b0 = (vblock >= 0) ? vblock : (int)blockIdx.x, bstride = (vblock >= 0) ? nvb : (int)gridDim.x;
  const int tid = opq(threadIdx.x);
  const int nk = K / 64, nn = Npad / 64;
  for (int tile = b0; tile < nk * nn; tile += bstride) {
    const int k0 = (tile % nk) * 64, n0 = (tile / nk) * 64;
    const int kr = tid >> 4, n4 = (tid & 15) * 4;
    int sc = n0 + n4;
    if (CMAP) sc = (sc < 2560) ? sc : (sc < 5632) ? sc + 24 : (sc < 5656) ? sc - 5632 + 2560 : N;
#pragma unroll
    for (int i = 0; i < 4; ++i) {
      const int k = kr + 16 * i;
      f32x4 v = {0.f, 0.f, 0.f, 0.f};
      if (sc < N) v = *(const f32x4*)(W + (size_t)(k0 + k) * N + sc);
      tl[k][n4 + 0] = v[0]; tl[k][n4 + 1] = v[1]; tl[k][n4 + 2] = v[2]; tl[k][n4 + 3] = v[3];
    }
    __syncthreads();
    int n = tid >> 2, kc = (tid & 3) * 16;
    unsigned w[8];
#pragma unroll
    for (int i = 0; i < 8; ++i) w[i] = pack2(tl[kc + 2 * i][n], tl[kc + 2 * i + 1][n]);
    uint4* dst = (uint4*)(Wt + (size_t)(n0 + n) * K + k0 + kc);
    dst[0] = make_uint4(w[0], w[1], w[2], w[3]);
    dst[1] = make_uint4(w[4], w[5], w[6], w[7]);
    __syncthreads();
  }
}

__device__ __forceinline__ int lds_off(int row, int chunk) { return row * 128 + ((chunk ^ ((row >> 1) & 7)) << 4); }

template <bool TR, bool VEC = false, class Epi>
__device__ __forceinline__ void gemm_tile_bf16(const bf16_t* xp, int ldx, const bf16_t* yp, int ldy, int K, char* lds,
                                               Epi epi) {
  const int tid = opq(threadIdx.x), lane = tid & 63, wv = tid >> 6;
  const int wr = wv >> 1, wc = wv & 1;
  f32x16 acc[2][2];
#pragma unroll
  for (int i = 0; i < 2; ++i)
#pragma unroll
    for (int j = 0; j < 2; ++j)
#pragma unroll
      for (int r = 0; r < 16; ++r) acc[i][j][r] = 0.f;
  const int prow = lane >> 3, pch = lane & 7;
  const bf16_t* xs[4];
  const bf16_t* ys[4];
#pragma unroll
  for (int ps = 0; ps < 4; ++ps) {
    const int row = (wv * 4 + ps) * 8 + prow;
    const int c = pch ^ ((row >> 1) & 7);
    xs[ps] = xp + (size_t)row * ldx + c * 8;
    ys[ps] = yp + (size_t)row * ldy + c * 8;
  }
  char* const mydst = lds + wv * 4096 + lane * 16;
#define GEMM_ISSUE(k0, bufoff)                                                                                              \
  _Pragma("unroll") for (int ps = 0; ps < 4; ++ps) {                                                                        \
    __builtin_amdgcn_global_load_lds((const unsigned*)(xs[ps] + (k0)), (unsigned*)(mydst + (bufoff) + ps * 1024), 16, 0, 0);         \
    __builtin_amdgcn_global_load_lds((const unsigned*)(ys[ps] + (k0)), (unsigned*)(mydst + (bufoff) + 16384 + ps * 1024), 16, 0, 0); \
  }
#define GEMM_COMPUTE(bufoff)                                                                                     \
  _Pragma("unroll") for (int kk = 0; kk < 4; ++kk) {                                                             \
    bf16x8 a[2], b[2];                                                                                           \
    const int ch = kk * 2 + (lane >> 5);                                                                         \
    _Pragma("unroll") for (int i = 0; i < 2; ++i) {                                                              \
      a[i] = *(const bf16x8*)(lds + (bufoff) + (TR ? 16384 : 0) + lds_off(wr * 64 + i * 32 + (lane & 31), ch)); \
      b[i] = *(const bf16x8*)(lds + (bufoff) + (TR ? 0 : 16384) + lds_off(wc * 64 + i * 32 + (lane & 31), ch)); \
    }                                                                                                            \
    _Pragma("unroll") for (int i = 0; i < 2; ++i)                                                                \
      _Pragma("unroll") for (int j = 0; j < 2; ++j)                                                              \
        acc[i][j] = __builtin_amdgcn_mfma_f32_32x32x16_bf16(a[i], b[j], acc[i][j], 0, 0, 0);                    \
  }
  __syncthreads();
  GEMM_ISSUE(0, 0)
  for (int k0 = 0; k0 < K; k0 += 128) {
    asm volatile("s_waitcnt vmcnt(0)" ::: "memory");
    __syncthreads();
    GEMM_ISSUE(k0 + 64, 32768)
    GEMM_COMPUTE(0)
    asm volatile("s_waitcnt vmcnt(0)" ::: "memory");
    __syncthreads();
    if (k0 + 128 < K) { GEMM_ISSUE(k0 + 128, 0) }
    GEMM_COMPUTE(32768)
  }
#undef GEMM_ISSUE
#undef GEMM_COMPUTE
  int lane2 = lane;
  asm volatile("" : "+v"(lane2));
  if constexpr (VEC) {
    typedef __attribute__((ext_vector_type(4))) float f32x4;
    __syncthreads();
    float* wl = (float*)lds + wv * (32 * 68);
    const int hh2 = lane2 >> 5, cl = lane2 & 31;
#pragma unroll
    for (int i = 0; i < 2; ++i) {
#pragma unroll
      for (int j = 0; j < 2; ++j)
#pragma unroll
        for (int r = 0; r < 16; ++r) wl[((r & 3) + 8 * (r >> 2) + 4 * hh2) * 68 + j * 32 + cl] = acc[i][j][r];
      __builtin_amdgcn_wave_barrier();
#pragma unroll
      for (int k = 0; k < 4; ++k) {
        const int row = (lane2 >> 3) + 8 * k, c8 = (lane2 & 7) * 8;
        const f32x4 lo = *(const f32x4*)&wl[row * 68 + c8];
        const f32x4 hi = *(const f32x4*)&wl[row * 68 + c8 + 4];
        epi(wr * 64 + i * 32 + row, wc * 64 + c8, lo, hi);
      }
      __builtin_amdgcn_wave_barrier();
    }
  } else {
#pragma unroll
    for (int i = 0; i < 2; ++i)
#pragma unroll
      for (int j = 0; j < 2; ++j)
#pragma unroll
        for (int r = 0; r < 16; ++r) {
          int rr = wr * 64 + i * 32 + (r & 3) + 8 * (r >> 2) + 4 * (lane2 >> 5);
          int cc = wc * 64 + j * 32 + (lane2 & 31);
          epi(rr, cc, acc[i][j][r]);
        }
  }
}

typedef __attribute__((ext_vector_type(4))) float f32x4_e;
__device__ __forceinline__ void st_bf16x8(bf16_t* dst, f32x4_e lo, f32x4_e hi) {
  u32x4 o;
  o[0] = pack2(lo[0], lo[1]); o[1] = pack2(lo[2], lo[3]); o[2] = pack2(hi[0], hi[1]); o[3] = pack2(hi[2], hi[3]);
  *(u32x4*)dst = o;
}

template <bool VEC = false, class Epi>
__device__ __forceinline__ void ph_gemm_bf16(const bf16_t* A, int lda, const bf16_t* Wt, int ldw, int M, int N, int K,
                                             char* lds, Epi epi, int vblock = -2) {
  const int ntm = M / 128, ntn = N / 128;
  const int npm = (ntm + 7) / 8, npn = (ntn + 7) / 8;
  const int nslots = ((npm * npn * 64 + 511) / 512) * 512;
  if (vblock == -1) return;
  for (int u = (vblock >= 0 ? vblock : (int)blockIdx.x); u < nslots; u += gridDim.x) {
    int v = (u & 7) * 64 + ((u >> 3) & 63) + (u & ~511);
    int patch = v >> 6, w = v & 63;
    int tm = (patch % npm) * 8 + (w & 7);
    int tn = (patch / npm) * 8 + (w >> 3);
    if (tm >= ntm || tn >= ntn) continue;
    const int m0 = tm * 128, n0 = tn * 128;
    if constexpr (VEC)
      gemm_tile_bf16<false, true>(A + (size_t)m0 * lda, lda, Wt + (size_t)n0 * ldw, ldw, K, lds,
                                  [&](int r, int c, f32x4_e lo, f32x4_e hi) { epi(m0 + r, n0 + c, lo, hi); });
    else
      gemm_tile_bf16<false>(A + (size_t)m0 * lda, lda, Wt + (size_t)n0 * ldw, ldw, K, lds,
                            [&](int r, int c, float val) { epi(m0 + r, n0 + c, val); });
  }
}

__device__ __forceinline__ void ph_proj(const P& p, char* lds) {
  const int ntm = T_TOK / 128, ntn = 5760 / 128;
  const int npm = (ntm + 7) / 8, npn = (ntn + 7) / 8;
  const int nslots = ((npm * npn * 64 + 511) / 512) * 512;
  for (int u = blockIdx.x; u < nslots; u += gridDim.x) {
    int v = (u & 7) * 64 + ((u >> 3) & 63) + (u & ~511);
    int patch = v >> 6, w = v & 63;
    int tm = (patch % npm) * 8 + (w & 7);
    int tn = (patch / npm) * 8 + (w >> 3);
    if (tm >= ntm || tn >= ntn) continue;
    const int m0 = tm * 128, n0 = tn * 128;
    const int b = m0 >> 11, sl = m0 & 2047;
    const bf16_t* A = p.hn + (size_t)m0 * DM;
    const bf16_t* W = p.WinT + (size_t)n0 * DM;
    if (n0 < 1024) {
      bf16_t* q = p.qn + (size_t)m0 * 1024 + n0;
      gemm_tile_bf16<false, true>(A, DM, W, DM, DM, lds, [&](int r, int c, f32x4_e lo, f32x4_e hi) { st_bf16x8(q + (size_t)r * 1024 + c, lo, hi); });
    } else if (n0 < 2560) {
      const int seg = (n0 - 1024) >> 8, g = ((n0 - 1024) >> 7) & 1;
      if (seg == 3 || seg == 5) {
        bf16_t* vd = (seg == 3 ? p.vsT : p.vwT) + ((size_t)(b * 2 + g) * 128) * SEQ + sl;
        gemm_tile_bf16<true>(A, DM, W, DM, DM, lds, [&](int r, int c, float val) { vd[(size_t)r * SEQ + perm16(c)] = f2bf(val); });
      } else {
        bf16_t* base = (seg == 0) ? p.kcin : (seg == 1) ? p.vcin : (seg == 2) ? p.ks : p.kw;
        bf16_t* kd = base + ((size_t)(b * 2 + g) * SEQ + sl) * 128;
        gemm_tile_bf16<false, true>(A, DM, W, DM, DM, lds, [&](int r, int c, f32x4_e lo, f32x4_e hi) { st_bf16x8(kd + (size_t)r * 128 + c, lo, hi); });
      }
    } else if (n0 < 3584) {
      bf16_t* q = p.qsb + (size_t)m0 * 1024 + (n0 - 2560);
      gemm_tile_bf16<false, true>(A, DM, W, DM, DM, lds, [&](int r, int c, f32x4_e lo, f32x4_e hi) { st_bf16x8(q + (size_t)r * 1024 + c, lo, hi); });
    } else if (n0 < 4608) {
      bf16_t* kd = p.ksb + ((size_t)(b * 8 + ((n0 - 3584) >> 7)) * SEQ + sl) * 128;
      gemm_tile_bf16<false, true>(A, DM, W, DM, DM, lds, [&](int r, int c, f32x4_e lo, f32x4_e hi) { st_bf16x8(kd + (size_t)r * 128 + c, lo, hi); });
    } else if (n0 < 5632) {
      bf16_t* vd = p.vsbT + ((size_t)(b * 8 + ((n0 - 4608) >> 7)) * 128) * SEQ + sl;
      gemm_tile_bf16<true>(A, DM, W, DM, DM, lds, [&](int r, int c, float val) { vd[(size_t)r * SEQ + perm16(c)] = f2bf(val); });
    } else {
      float* gd = p.gates + (size_t)m0 * 24;
      gemm_tile_bf16<false>(A, DM, W, DM, DM, lds, [&](int r, int c, float val) { if (c < 24) gd[(size_t)r * 24 + c] = val; });
    }
  }
}

__device__ __forceinline__ void ph_posb(const P& p) {
  const int lane = opq(threadIdx.x) & 63, wv = opq(threadIdx.x) >> 6;
  for (int o = blockIdx.x * 4 + wv; o < 256; o += gridDim.x * 4) {
    const int which = o >> 7, n = o & 127;
    const float* pos = which ? p.pos_v : p.pos_k;
    const float* w1 = which ? p.w1_v : p.w1_k;
    float acc = 0.f;
    for (int k = lane; k < 4096; k += 64) acc += pos[k] * w1[(size_t)k * 128 + n];
    acc = wave_sum(acc);
    if (lane == 0) p.posb[o] = acc;
  }
}

__device__ __forceinline__ void ph_compress2(const P& p, char* lds) {
  for (int item = blockIdx.x; item < 16; item += gridDim.x) {
    const int which = item >> 3, bg = item & 7;
    const bf16_t* src = (which ? p.vcin : p.kcin) + (size_t)bg * SEQ * 128;
    const bf16_t* w1t = p.w1T + (size_t)which * 128 * 4096;
    const bf16_t* w2t = p.w2T + (size_t)which * 128 * 128;
    const float* posb = p.posb + which * 128;
    bf16_t* c1 = p.c1 + (size_t)item * 128 * 128;
    gemm_tile_bf16<false>(src, 2048, w1t, 4096, 4096, lds, [&](int r, int c, float val) {
      c1[r * 128 + c] = f2bf(gelu_fast(val + posb[c])); });
    __threadfence_block();
    __syncthreads();
    if (which == 0) {
      bf16_t* kd = p.kcb + (size_t)bg * 128 * 128;
      gemm_tile_bf16<false>(c1, 128, w2t, 128, 128, lds, [&](int r, int c, float val) { kd[r * 128 + c] = f2bf(val); });
    } else {
      bf16_t* vd = p.vcT + (size_t)bg * 128 * 128;
      gemm_tile_bf16<true>(c1, 128, w2t, 128, 128, lds, [&](int r, int c, float val) { vd[r * 128 + perm16(c)] = f2bf(val); });
    }
  }
}

#define NEG_BIG (-1e30f)

struct KVRegs { u32x4 k0, k1, k2, k3, v0, v1, v2, v3; };

__device__ __forceinline__ int koff(int row, int chunk) { return row * 256 + ((chunk ^ (row & 15)) << 4); }

__device__ __forceinline__ void kv_load(KVRegs& r, const bf16_t* kp, int ldk, const bf16_t* vp, int ldv) {
  const int tid = opq(threadIdx.x);
  const bf16_t* kg = kp + (size_t)(tid >> 4) * ldk + (tid & 15) * 8;
  r.k0 = *(const u32x4*)kg;
  r.k1 = *(const u32x4*)(kg + (size_t)16 * ldk);
  r.k2 = *(const u32x4*)(kg + (size_t)32 * ldk);
  r.k3 = *(const u32x4*)(kg + (size_t)48 * ldk);
  const bf16_t* vg = vp + (size_t)(tid >> 3) * ldv + (tid & 7) * 8;
  r.v0 = *(const u32x4*)vg;
  r.v1 = *(const u32x4*)(vg + (size_t)32 * ldv);
  r.v2 = *(const u32x4*)(vg + (size_t)64 * ldv);
  r.v3 = *(const u32x4*)(vg + (size_t)96 * ldv);
}
__device__ __forceinline__ void kv_store(const KVRegs& r, char* lk, char* lv) {
  const int tid = opq(threadIdx.x);
  const int row = tid >> 4, ch = tid & 15;
  *(u32x4*)(lk + koff(row, ch)) = r.k0;
  *(u32x4*)(lk + koff(row + 16, ch)) = r.k1;
  *(u32x4*)(lk + koff(row + 32, ch)) = r.k2;
  *(u32x4*)(lk + koff(row + 48, ch)) = r.k3;
  const int vr = tid >> 3, vc = tid & 7;
  *(u32x4*)(lv + lds_off(vr, vc)) = r.v0;
  *(u32x4*)(lv + lds_off(vr + 32, vc)) = r.v1;
  *(u32x4*)(lv + lds_off(vr + 64, vc)) = r.v2;
  *(u32x4*)(lv + lds_off(vr + 96, vc)) = r.v3;
}

struct QFrag { bf16x8 f0, f1, f2, f3, f4, f5, f6, f7; };
__device__ __forceinline__ void q_load(QFrag& q, const bf16_t* qrow) {
  const int h = (opq(threadIdx.x) & 63) >> 5;
  const bf16x8* p8 = (const bf16x8*)(qrow + 8 * h);
  q.f0 = p8[0]; q.f1 = p8[2]; q.f2 = p8[4]; q.f3 = p8[6]; q.f4 = p8[8]; q.f5 = p8[10]; q.f6 = p8[12]; q.f7 = p8[14];
}

__device__ __forceinline__ void qk_tile(const QFrag& q, const char* lk, f32x16& s0, f32x16& s1) {
  const int lane = opq(threadIdx.x) & 63, row = lane & 31, h = lane >> 5;
#pragma unroll
  for (int r = 0; r < 16; ++r) { s0[r] = 0.f; s1[r] = 0.f; }
#define QK_STEP(kk, qf)                                                                  \
  {                                                                                      \
    bf16x8 a0 = *(const bf16x8*)(lk + koff(row, 2 * (kk) + h));                          \
    bf16x8 a1 = *(const bf16x8*)(lk + koff(row + 32, 2 * (kk) + h));                     \
    s0 = __builtin_amdgcn_mfma_f32_32x32x16_bf16(a0, qf, s0, 0, 0, 0);                   \
    s1 = __builtin_amdgcn_mfma_f32_32x32x16_bf16(a1, qf, s1, 0, 0, 0);                   \
  }
  QK_STEP(0, q.f0) QK_STEP(1, q.f1) QK_STEP(2, q.f2) QK_STEP(3, q.f3)
  QK_STEP(4, q.f4) QK_STEP(5, q.f5) QK_STEP(6, q.f6) QK_STEP(7, q.f7)
#undef QK_STEP
}

__device__ __forceinline__ bf16x8 pack8(const f32x16& p, const int base) {
  u32x4 u;
  u[0] = pack2(p[base + 0], p[base + 1]);
  u[1] = pack2(p[base + 2], p[base + 3]);
  u[2] = pack2(p[base + 4], p[base + 5]);
  u[3] = pack2(p[base + 6], p[base + 7]);
  return __builtin_bit_cast(bf16x8, u);
}

struct OAcc { f32x16 o0, o1, o2, o3; };
__device__ __forceinline__ void oacc_zero(OAcc& o) {
#pragma unroll
  for (int r = 0; r < 16; ++r) { o.o0[r] = 0.f; o.o1[r] = 0.f; o.o2[r] = 0.f; o.o3[r] = 0.f; }
}
__device__ __forceinline__ void oacc_scale(OAcc& o, float a) {
#pragma unroll
  for (int r = 0; r < 16; ++r) { o.o0[r] *= a; o.o1[r] *= a; o.o2[r] *= a; o.o3[r] *= a; }
}

__device__ __forceinline__ void pv_tile(OAcc& o, const char* lv, const f32x16& p0, const f32x16& p1) {
  const int lane = opq(threadIdx.x) & 63, row = lane & 31, h = lane >> 5;
  const bf16x8 pf0 = pack8(p0, 0), pf1 = pack8(p0, 8), pf2 = pack8(p1, 0), pf3 = pack8(p1, 8);
#define PV_ROW(dd, acc)                                                                                      \
  {                                                                                                          \
    acc = __builtin_amdgcn_mfma_f32_32x32x16_bf16(*(const bf16x8*)(lv + lds_off(32 * (dd) + row, 0 + h)), pf0, acc, 0, 0, 0); \
    acc = __builtin_amdgcn_mfma_f32_32x32x16_bf16(*(const bf16x8*)(lv + lds_off(32 * (dd) + row, 2 + h)), pf1, acc, 0, 0, 0); \
    acc = __builtin_amdgcn_mfma_f32_32x32x16_bf16(*(const bf16x8*)(lv + lds_off(32 * (dd) + row, 4 + h)), pf2, acc, 0, 0, 0); \
    acc = __builtin_amdgcn_mfma_f32_32x32x16_bf16(*(const bf16x8*)(lv + lds_off(32 * (dd) + row, 6 + h)), pf3, acc, 0, 0, 0); \
  }
  PV_ROW(0, o.o0) PV_ROW(1, o.o1) PV_ROW(2, o.o2) PV_ROW(3, o.o3)
#undef PV_ROW
}

__device__ __forceinline__ void softmax_tile(f32x16& s0, f32x16& s1, float& m, float& l, OAcc& o) {
  float mx = NEG_BIG;
#pragma unroll
  for (int r = 0; r < 16; ++r) mx = fmaxf(mx, fmaxf(s0[r], s1[r]));
  mx = fmaxf(mx, __shfl_xor(mx, 32));
  const float mn = fmaxf(m, mx);
  const float alpha = __expf(m - mn);
  float ls = 0.f;
#pragma unroll
  for (int r = 0; r < 16; ++r) {
    float a = (s0[r] > -1e29f) ? __expf(s0[r] - mn) : 0.f;
    float b = (s1[r] > -1e29f) ? __expf(s1[r] - mn) : 0.f;
    s0[r] = a; s1[r] = b;
    ls += a + b;
  }
  ls += __shfl_xor(ls, 32);
  l = l * alpha + ls;
  m = mn;
  if (__any(alpha != 1.f)) oacc_scale(o, alpha);
}

template <class F>
__device__ __forceinline__ void oacc_foreach(const OAcc& o, F f) {
  const int h = (opq(threadIdx.x) & 63) >> 5;
#pragma unroll
  for (int rho = 0; rho < 4; ++rho) {
    f(0 + 8 * rho + 4 * h, o.o0[4 * rho], o.o0[4 * rho + 1], o.o0[4 * rho + 2], o.o0[4 * rho + 3]);
    f(32 + 8 * rho + 4 * h, o.o1[4 * rho], o.o1[4 * rho + 1], o.o1[4 * rho + 2], o.o1[4 * rho + 3]);
    f(64 + 8 * rho + 4 * h, o.o2[4 * rho], o.o2[4 * rho + 1], o.o2[4 * rho + 2], o.o2[4 * rho + 3]);
    f(96 + 8 * rho + 4 * h, o.o3[4 * rho], o.o3[4 * rho + 1], o.o3[4 * rho + 2], o.o3[4 * rho + 3]);
  }
}

__device__ __forceinline__ void ph_memattn2(const P& p, char* lds) {
  char* lk = lds;
  char* lv = lds + 16384;
  const int lane = opq(threadIdx.x) & 63, wv = opq(threadIdx.x) >> 6;
  for (int item = blockIdx.x; item < NBATCH * 4 * (SEQ / 128); item += gridDim.x) {
    const int tb = item % (SEQ / 128);
    const int bh = item / (SEQ / 128);
    const int b = bh >> 2, hd = bh & 3;
    const int t = tb * 128 + wv * 32 + (lane & 31);
    QFrag q;
    q_load(q, p.qmemb + (size_t)(b * SEQ + t) * 512 + hd * 128);
    const bf16_t* kb = p.kmemb + (size_t)bh * 256 * 128;
    const bf16_t* vb = p.vmemT + (size_t)bh * 128 * 256;
    OAcc o;
    oacc_zero(o);
    float m = NEG_BIG, l = 0.f;
    KVRegs kv;
    kv_load(kv, kb, 128, vb, 256);
#pragma unroll 1
    for (int ti = 0; ti < 4; ++ti) {
      __syncthreads();
      kv_store(kv, lk, lv);
      __syncthreads();
      {
        const int tn = (ti + 1 < 4) ? ti + 1 : 3;
        kv_load(kv, kb + (size_t)tn * 64 * 128, 128, vb + tn * 64, 256);
      }
      f32x16 s0, s1;
      qk_tile(q, lk, s0, s1);
#pragma unroll
      for (int r = 0; r < 16; ++r) { s0[r] *= ATT_SCALE; s1[r] *= ATT_SCALE; }
      softmax_tile(s0, s1, m, l, o);
      pv_tile(o, lv, s0, s1);
    }
    const float il = 1.f / l;
    const int t2 = tb * 128 + (opq(threadIdx.x) >> 6) * 32 + (opq(threadIdx.x) & 31);
    bf16_t* orow = p.omem + (size_t)(b * SEQ + t2) * 512 + hd * 128;
    oacc_foreach(o, [&](int d, float v0, float v1, float v2, float v3) {
      uint2 u;
      u.x = pack2(v0 * il, v1 * il);
      u.y = pack2(v2 * il, v3 * il);
      *(uint2*)(orow + d) = u;
    });
  }
}

__device__ __forceinline__ void ph_sb2(const P& p, char* lds) {
  char* lk = lds;
  char* lv = lds + 16384;
  const int lane = opq(threadIdx.x) & 63, wv = opq(threadIdx.x) >> 6, hh = lane >> 5;
  const int sb_skip = (gridDim.x > 32) ? 16 : 0;
  if ((int)blockIdx.x < sb_skip) return;
  for (int item = (int)blockIdx.x - sb_skip; item < NBATCH * 8 * (SEQ / 128); item += (int)gridDim.x - sb_skip) {
    const int tb = (SEQ / 128 - 1) - (item % (SEQ / 128));
    const int bh = item / (SEQ / 128);
    const int b = bh >> 3, hd = bh & 7;
    const int t0 = tb * 128;
    const int t = t0 + wv * 32 + (lane & 31);
    QFrag q;
    q_load(q, p.qsb + (size_t)(b * SEQ + t) * 1024 + hd * 128);
    const bf16_t* kb = p.ksb + (size_t)bh * SEQ * 128;
    const bf16_t* vb = p.vsbT + (size_t)bh * 128 * SEQ;
    OAcc o;
    oacc_zero(o);
    float carry = 0.f;
    const int jhi = (t0 >> 6) + 1;
    const int jw = (t0 + wv * 32 + 30) >> 6;
    KVRegs kv;
    kv_load(kv, kb + (size_t)jhi * 64 * 128, 128, vb + jhi * 64, SEQ);
    volatile unsigned* dflag = (volatile unsigned*)(lds + 32768);
    __syncthreads();
    if (opq(threadIdx.x) < 4) dflag[opq(threadIdx.x)] = 0u;
    for (int j = jhi; j >= 0; --j) {
      __syncthreads();
      if ((dflag[0] & dflag[1] & dflag[2] & dflag[3]) != 0u) break;
      kv_store(kv, lk, lv);
      __syncthreads();
      const int jn = (j > 0) ? j - 1 : 0;
      if (j > jw) kv_load(kv, kb + (size_t)jn * 64 * 128, 128, vb + jn * 64, SEQ);
      if (j <= jw) {
        f32x16 z0, z1;
        qk_tile(q, lk, z0, z1);
        const int sbase = j * 64 + 4 * hh;
        float gt[8];
        f32x16 l0, l1;
#pragma unroll
        for (int r = 0; r < 16; ++r) {
          const int so = sbase + 8 * (r >> 2) + (r & 3);
          {
            const float z = z0[r] * ATT_SCALE;
            const bool valid = so < t;
            const float lsp = fminf(z, 0.f) - __logf(1.f + __expf(-fabsf(z)));
            l0[r] = valid ? (lsp - z) : 0.f;
            z0[r] = valid ? z : NEG_BIG;
          }
          {
            const float z = z1[r] * ATT_SCALE;
            const bool valid = so + 32 < t;
            const float lsp = fminf(z, 0.f) - __logf(1.f + __expf(-fabsf(z)));
            l1[r] = valid ? (lsp - z) : 0.f;
            z1[r] = valid ? z : NEG_BIG;
          }
        }
#pragma unroll
        for (int rho = 0; rho < 4; ++rho) {
          gt[rho] = (l0[4 * rho] + l0[4 * rho + 1]) + (l0[4 * rho + 2] + l0[4 * rho + 3]);
          gt[4 + rho] = (l1[4 * rho] + l1[4 * rho + 1]) + (l1[4 * rho + 2] + l1[4 * rho + 3]);
        }
        float ag[8];
        float run = 0.f;
#pragma unroll
        for (int k = 7; k >= 0; --k) {
          const float pg = __shfl_xor(gt[k], 32);
          ag[k] = carry + run + (hh == 0 ? pg : 0.f);
          run += gt[k] + pg;
        }
        carry += run;
#pragma unroll
        for (int rho = 0; rho < 4; ++rho) {
          {
            const float x3 = l0[4 * rho + 3], x23 = x3 + l0[4 * rho + 2], x123 = x23 + l0[4 * rho + 1];
            const float g = ag[rho];
            z0[4 * rho + 0] = __expf((l0[4 * rho + 0] + z0[4 * rho + 0]) + (g + x123));
            z0[4 * rho + 1] = __expf((l0[4 * rho + 1] + z0[4 * rho + 1]) + (g + x23));
            z0[4 * rho + 2] = __expf((l0[4 * rho + 2] + z0[4 * rho + 2]) + (g + x3));
            z0[4 * rho + 3] = __expf((l0[4 * rho + 3] + z0[4 * rho + 3]) + g);
          }
          {
            const float x3 = l1[4 * rho + 3], x23 = x3 + l1[4 * rho + 2], x123 = x23 + l1[4 * rho + 1];
            const float g = ag[4 + rho];
            z1[4 * rho + 0] = __expf((l1[4 * rho + 0] + z1[4 * rho + 0]) + (g + x123));
            z1[4 * rho + 1] = __expf((l1[4 * rho + 1] + z1[4 * rho + 1]) + (g + x23));
            z1[4 * rho + 2] = __expf((l1[4 * rho + 2] + z1[4 * rho + 2]) + (g + x3));
            z1[4 * rho + 3] = __expf((l1[4 * rho + 3] + z1[4 * rho + 3]) + g);
          }
        }
        kv_load(kv, kb + (size_t)jn * 64 * 128, 128, vb + jn * 64, SEQ);
        pv_tile(o, lv, z0, z1);
        if (__all(carry < -104.f) && (opq(threadIdx.x) & 63) == 0) dflag[wv] = 1u;
      }
    }
    int t2 = t;
    asm volatile("" : "+v"(t2));
    bf16_t* orow = p.omix + (size_t)(b * SEQ + t2) * DM + 1024 + hd * 128;
    oacc_foreach(o, [&](int d, float v0, float v1, float v2, float v3) {
      uint2 u;
      u.x = pack2(v0, v1);
      u.y = pack2(v2, v3);
      *(uint2*)(orow + d) = u;
    });
  }
}

#define NSA_IMP 32768
#define NSA_KEYS 49152
#define NSA_SELM 53504
#define NSA_LUT 53632
__device__ __forceinline__ void ph_nsa2(const P& p, char* lds) {
  typedef __attribute__((ext_vector_type(4))) float f32x4;
  char* lk = lds;
  char* lv = lds + 16384;
  float* imp = (float*)(lds + NSA_IMP);
  float* keys = (float*)(lds + NSA_KEYS);
  unsigned* selm = (unsigned*)(lds + NSA_SELM);
  const int tid = opq(threadIdx.x), lane = tid & 63, wv = tid >> 6, hh = lane >> 5, ql = lane & 31;
  float* lut = (float*)(lds + NSA_LUT) + wv * 128;
  for (int item = blockIdx.x; item < NBATCH * 2 * (SEQ / 32); item += gridDim.x) {
    const int tt = (item < 256) ? (SEQ / 32 - 1) - (item % (SEQ / 32)) : (item % (SEQ / 32));
    const int bg = item / (SEQ / 32);
    const int b = bg >> 1, g = bg & 1;
    const int h = g * 4 + wv;
    const int t0 = tt * 32, tq = t0 + ql, cur = t0 >> 6;
    __syncthreads();
    QFrag q;
    q_load(q, p.qn + (size_t)(b * SEQ + tq) * 1024 + h * 128);
    {
      const int lo = opq(lane);
      lut[lo] = p.t5[t5_bucket(lo) * 8 + h];
      lut[lo + 64] = p.t5[t5_bucket(lo + 64) * 8 + h];
    }
#pragma unroll
    for (int i = 0; i < 16; ++i) imp[i * 256 + tid] = 0.f;
    if (tid < 32) selm[tid] = 0u;
    const float* grow = p.gates + (size_t)(b * SEQ + tq) * 24 + h * 3;
    float* prow = p.part + (size_t)(b * SEQ + tq) * 1024 + h * 128;
    OAcc o;
    float m, l;
    KVRegs kv;
    {
      const bf16_t* kb = p.kcb + (size_t)bg * 128 * 128;
      const bf16_t* vb = p.vcT + (size_t)bg * 128 * 128;
      oacc_zero(o);
      m = NEG_BIG; l = 0.f;
      kv_load(kv, kb, 128, vb, 128);
      __syncthreads();
      kv_store(kv, lk, lv);
      __syncthreads();
      f32x16 x0, x1;
      qk_tile(q, lk, x0, x1);
      int tqv = tq;
      asm volatile("" : "+v"(tqv));
      tqv -= 64 * hh;
      if (t0 >= 1152) {
        const float b31 = lut[127];
#pragma unroll
        for (int r = 0; r < 16; ++r) { x0[r] = x0[r] * ATT_SCALE + b31; x1[r] = x1[r] * ATT_SCALE + b31; }
      } else {
#pragma unroll
        for (int r = 0; r < 16; ++r) {
          const int c = 8 * (r >> 2) + (r & 3);
          const int d0 = tqv - 16 * c - 31, d1 = d0 - 512;
          x0[r] = (d0 >= 0) ? x0[r] * ATT_SCALE + lut[min(d0, 127)] : NEG_BIG;
          x1[r] = (d1 >= 0) ? x1[r] * ATT_SCALE + lut[min(d1, 127)] : NEG_BIG;
        }
      }
      softmax_tile(x0, x1, m, l, o);
      const float m0 = m;
      pv_tile(o, lv, x0, x1);
      f32x16 z0, z1;
#pragma unroll
      for (int r = 0; r < 16; ++r) { z0[r] = 0.f; z1[r] = 0.f; }
      if (t0 >= 1024) {
        kv_load(kv, kb + 64 * 128, 128, vb + 64, 128);
        __syncthreads();
        kv_store(kv, lk, lv);
        __syncthreads();
        qk_tile(q, lk, z0, z1);
        asm volatile("" : "+v"(tqv));
#pragma unroll
        for (int r = 0; r < 16; ++r) {
          const int c = 64 + 8 * (r >> 2) + (r & 3);
          const int d0 = tqv - 16 * c - 31, d1 = d0 - 512;
          z0[r] = (d0 >= 0) ? z0[r] * ATT_SCALE + lut[min(d0, 127)] : NEG_BIG;
          z1[r] = (d1 >= 0) ? z1[r] * ATT_SCALE + lut[min(d1, 127)] : NEG_BIG;
        }
        softmax_tile(z0, z1, m, l, o);
        pv_tile(o, lv, z0, z1);
      }
      const float inv = 1.f / fmaxf(l, 1e-20f);
      const float c0 = __expf(m0 - m) * inv;
#pragma unroll
      for (int r = 0; r < 16; ++r) {
        const int c = 8 * (r >> 2) + (r & 3) + 4 * hh;
        if (x0[r] != 0.f) atomicAdd(&imp[(c) * 32 + ql], x0[r] * c0);
        if (x1[r] != 0.f) atomicAdd(&imp[(c + 32) * 32 + ql], x1[r] * c0);
        if (z0[r] != 0.f) atomicAdd(&imp[(c + 64) * 32 + ql], z0[r] * inv);
        if (z1[r] != 0.f) atomicAdd(&imp[(c + 96) * 32 + ql], z1[r] * inv);
      }
      const float gs = inv / (1.f + __expf(-grow[0]));
      oacc_foreach(o, [&](int d, float v0, float v1, float v2, float v3) {
        f32x4 u = {v0 * gs, v1 * gs, v2 * gs, v3 * gs};
        *(f32x4*)(prow + d) = u;
      });
    }
    __syncthreads();
    {
      const int tido = opq(tid);
      const int qq = tido & 31, jg = tido >> 5;
#pragma unroll
      for (int jj = 0; jj < 4; ++jj) {
        const int j = jg * 4 + jj;
        float v = imp[(4 * j) * 32 + qq] + imp[(4 * j + 1) * 32 + qq] + imp[(4 * j + 2) * 32 + qq] + 0.5f * imp[(4 * j + 3) * 32 + qq];
        if (j > 0) v += 0.5f * imp[(4 * j - 1) * 32 + qq];
        const bool forced = (j == 0) || (j == cur) || (j == cur - 1);
        keys[qq * 33 + j] = forced ? 1e9f : ((j <= cur) ? v : -1e9f);
      }
      __syncthreads();
      unsigned bits = 0u;
#pragma unroll
      for (int jj = 0; jj < 4; ++jj) {
        const int j = jg * 4 + jj;
        const float kj = keys[qq * 33 + j];
        int rank = 0;
        for (int i = 0; i < 32; ++i) {
          const float ki = keys[qq * 33 + i];
          rank += (ki > kj || (ki == kj && i < j)) ? 1 : 0;
        }
        if (rank < 16 && j <= cur) bits |= 1u << j;
      }
      atomicOr(&selm[qq], bits);
      __syncthreads();
    }
    const unsigned mysel = selm[ql];
    unsigned um = mysel;
#pragma unroll
    for (int o2 = 16; o2 > 0; o2 >>= 1) um |= (unsigned)__shfl_xor((int)um, o2);
    um = (unsigned)__builtin_amdgcn_readfirstlane((int)um);
    {
      const bf16_t* kb = p.ks + (size_t)bg * SEQ * 128;
      const bf16_t* vb = p.vsT + (size_t)bg * 128 * SEQ;
      oacc_zero(o);
      m = NEG_BIG; l = 0.f;
      unsigned rem = um;
      int j = __builtin_ctz(rem);
      kv_load(kv, kb + (size_t)j * 64 * 128, 128, vb + j * 64, SEQ);
      while (rem) {
        j = __builtin_ctz(rem);
        rem &= rem - 1;
        const int jn = rem ? __builtin_ctz(rem) : j;
        __syncthreads();
        kv_store(kv, lk, lv);
        __syncthreads();
        f32x16 s0, s1;
        qk_tile(q, lk, s0, s1);
        const bool selq = (mysel >> j) & 1u;
        int tqv = tq;
        asm volatile("" : "+v"(tqv));
        if (j * 64 + 63 + 113 <= t0) {
          const float sc = selq ? ATT_SCALE : 0.f, bb = selq ? lut[127] : NEG_BIG;
#pragma unroll
          for (int r = 0; r < 16; ++r) { s0[r] = s0[r] * sc + bb; s1[r] = s1[r] * sc + bb; }
        } else {
#pragma unroll
          for (int r = 0; r < 16; ++r) {
            const int d0 = tqv - (j * 64 + 8 * (r >> 2) + (r & 3) + 4 * hh), d1 = d0 - 32;
            s0[r] = (selq && d0 >= 0) ? s0[r] * ATT_SCALE + lut[min(d0, 127)] : NEG_BIG;
            s1[r] = (selq && d1 >= 0) ? s1[r] * ATT_SCALE + lut[min(d1, 127)] : NEG_BIG;
          }
        }
        kv_load(kv, kb + (size_t)jn * 64 * 128, 128, vb + jn * 64, SEQ);
        softmax_tile(s0, s1, m, l, o);
        pv_tile(o, lv, s0, s1);
      }
      const float gs = 1.f / (fmaxf(l, 1e-20f) * (1.f + __expf(-grow[1])));
      int qo = ql;
      asm volatile("" : "+v"(qo));
      float* pr2 = p.part + (size_t)(b * SEQ + t0 + qo) * 1024 + h * 128;
      oacc_foreach(o, [&](int d, float v0, float v1, float v2, float v3) {
        f32x4 u = *(f32x4*)(pr2 + d);
        u[0] += v0 * gs; u[1] += v1 * gs; u[2] += v2 * gs; u[3] += v3 * gs;
        *(f32x4*)(pr2 + d) = u;
      });
    }
    {
      const bf16_t* kb = p.kw + (size_t)bg * SEQ * 128;
      const bf16_t* vb = p.vwT + (size_t)bg * 128 * SEQ;
      oacc_zero(o);
      m = NEG_BIG; l = 0.f;
      int jlo = (t0 - 511) >> 6;
      if (jlo < 0) jlo = 0;
      kv_load(kv, kb + (size_t)jlo * 64 * 128, 128, vb + jlo * 64, SEQ);
      for (int j = jlo; j <= cur; ++j) {
        const int jn = (j < cur) ? j + 1 : j;
        __syncthreads();
        kv_store(kv, lk, lv);
        __syncthreads();
        f32x16 s0, s1;
        qk_tile(q, lk, s0, s1);
        int tqv = tq;
        asm volatile("" : "+v"(tqv));
        if (j * 64 + 63 + 113 <= t0 && t0 + 31 - j * 64 < 512) {
          const float b31 = lut[127];
#pragma unroll
          for (int r = 0; r < 16; ++r) { s0[r] = s0[r] * ATT_SCALE + b31; s1[r] = s1[r] * ATT_SCALE + b31; }
        } else {
#pragma unroll
          for (int r = 0; r < 16; ++r) {
            const int d0 = tqv - (j * 64 + 8 * (r >> 2) + (r & 3) + 4 * hh), d1 = d0 - 32;
            s0[r] = (d0 >= 0 && d0 < 512) ? s0[r] * ATT_SCALE + lut[min(d0, 127)] : NEG_BIG;
            s1[r] = (d1 >= 0 && d1 < 512) ? s1[r] * ATT_SCALE + lut[min(d1, 127)] : NEG_BIG;
          }
        }
        kv_load(kv, kb + (size_t)jn * 64 * 128, 128, vb + jn * 64, SEQ);
        softmax_tile(s0, s1, m, l, o);
        pv_tile(o, lv, s0, s1);
      }
      const float gs = 1.f / (fmaxf(l, 1e-20f) * (1.f + __expf(-grow[2])));
      int qo = ql;
      asm volatile("" : "+v"(qo));
      const float* pr2 = p.part + (size_t)(b * SEQ + t0 + qo) * 1024 + h * 128;
      bf16_t* orow = p.omix + (size_t)(b * SEQ + t0 + qo) * DM + h * 128;
      oacc_foreach(o, [&](int d, float v0, float v1, float v2, float v3) {
        const f32x4 u = *(const f32x4*)(pr2 + d);
        uint2 w;
        w.x = pack2(u[0] + v0 * gs, u[1] + v1 * gs);
        w.y = pack2(u[2] + v2 * gs, u[3] + v3 * gs);
        *(uint2*)(orow + d) = w;
      });
    }
  }
}

__device__ __forceinline__ void ph_cvt(const float* src, bf16_t* dst, size_t n) {
  typedef __attribute__((ext_vector_type(4))) float f32x4;
  const size_t nv = n / 8;
  for (size_t i = (size_t)blockIdx.x * 256 + opq(threadIdx.x); i < nv; i += (size_t)gridDim.x * 256) {
    const f32x4 a = ((const f32x4*)src)[2 * i], b = ((const f32x4*)src)[2 * i + 1];
    u32x4 o;
    o[0] = pack2(a[0], a[1]); o[1] = pack2(a[2], a[3]); o[2] = pack2(b[0], b[1]); o[3] = pack2(b[2], b[3]);
    ((u32x4*)dst)[i] = o;
  }
}

__device__ __forceinline__ void ph_scores(const P& p, char* lds) {
  for (int u = blockIdx.x; u < 64 * 16; u += gridDim.x) {
    const int tm = u & 63, hp = u >> 6;
    const int m0 = tm * 128;
    float* sc = p.scores + (size_t)m0 * DM + hp * 128;
    gemm_tile_bf16<false>(p.omix + (size_t)m0 * DM + hp * 128, DM, p.subkb + (size_t)hp * 128 * 128, 128, 128, lds,
                          [&](int r, int c, float val) { sc[(size_t)r * DM + c] = val; });
  }
}

__device__ __forceinline__ void ph_qp_scores(const P& p, char* lds) {
  const int ntm = T_TOK / 128, ntn = DM / 128;
  const int npm = (ntm + 7) / 8, npn = (ntn + 7) / 8;
  const int nslots = ((npm * npn * 64 + 511) / 512) * 512;
  for (int u = blockIdx.x; u < nslots; u += gridDim.x) {
    int v = (u & 7) * 64 + ((u >> 3) & 63) + (u & ~511);
    int patch = v >> 6, w = v & 63;
    int tm = (patch % npm) * 8 + (w & 7);
    int tn = (patch / npm) * 8 + (w >> 3);
    if (tm >= ntm || tn >= ntn) continue;
    const int m0 = tm * 128, n0 = tn * 128;
    bf16_t* qp = p.omix + (size_t)m0 * DM + n0;
    gemm_tile_bf16<false, true>(p.hn + (size_t)m0 * DM, DM, p.WpqT + (size_t)n0 * DM, DM, DM, lds,
                                [&](int r, int c, f32x4_e lo, f32x4_e hi) { st_bf16x8(qp + (size_t)r * DM + c, lo, hi); });
    __threadfence_block();
    __syncthreads();
    float* sc = p.scores + (size_t)m0 * DM + n0;
    gemm_tile_bf16<false, true>(qp, DM, p.subkb + (size_t)tn * 128 * 128, 128, 128, lds,
                                [&](int r, int c, f32x4_e lo, f32x4_e hi) {
                                  *(f32x4_e*)(sc + (size_t)r * DM + c) = lo; *(f32x4_e*)(sc + (size_t)r * DM + c + 4) = hi; });
  }
}

__device__ __forceinline__ void ph_cvt4(const float* src, unsigned char* dst, float* scales, int nrows, int wid0, int nw) {
  typedef __attribute__((ext_vector_type(4))) float f32x4;
  typedef __attribute__((ext_vector_type(2))) float f32x2;
  const int lane = opq(threadIdx.x) & 63;
  const float one = __uint_as_float((unsigned)opq(0x3F800000));
  float lev[8];
#pragma unroll
  for (int c = 0; c < 8; ++c) {
    const f32x2 q = __builtin_amdgcn_cvt_scalef32_pk_f32_fp4((unsigned)opq(c * 0x11111111), one, 0);
    lev[c] = fabsf(q[0]);
  }
  const float maxlev = lev[7];
  for (int row = wid0; row < nrows; row += nw) {
    const f32x4* s4 = (const f32x4*)(src + (size_t)row * DM) + lane * 8;
    f32x4 v[8];
    float amax = 0.f;
#pragma unroll
    for (int i = 0; i < 8; ++i) {
      v[i] = s4[i];
#pragma unroll
      for (int k = 0; k < 4; ++k) amax = fmaxf(amax, fabsf(v[i][k]));
    }
    amax = wave_max(amax);
    const float sc = (amax > 0.f) ? maxlev / amax : 1.f;
    u32x4 o;
#pragma unroll
    for (int w = 0; w < 4; ++w) {
      unsigned pk = 0u;
      pk = __builtin_amdgcn_cvt_scalef32_pk_fp4_f32(pk, v[2 * w][0] * sc, v[2 * w][1] * sc, 1.0f, 0);
      pk = __builtin_amdgcn_cvt_scalef32_pk_fp4_f32(pk, v[2 * w][2] * sc, v[2 * w][3] * sc, 1.0f, 1);
      pk = __builtin_amdgcn_cvt_scalef32_pk_fp4_f32(pk, v[2 * w + 1][0] * sc, v[2 * w + 1][1] * sc, 1.0f, 2);
      pk = __builtin_amdgcn_cvt_scalef32_pk_fp4_f32(pk, v[2 * w + 1][2] * sc, v[2 * w + 1][3] * sc, 1.0f, 3);
      o[w] = pk;
    }
    *(u32x4*)(dst + (size_t)row * 1024 + lane * 16) = o;
    if (lane == 0) scales[row] = (amax > 0.f) ? amax / maxlev : 1.f;
  }
}

__device__ __forceinline__ u32x4 r4_load(const unsigned char* tab, int eid, int lane) {
  return *((const u32x4*)(tab + (size_t)eid * 1024) + lane);
}
struct XPk { f32x16 a, b; };
struct Acc32 { f32x16 a, b; };

#define R4_DOT_W(word, xv, base, pa, pb)                                                             \
  {                                                                                                  \
    typedef __attribute__((ext_vector_type(2))) float f32x2;                                         \
    const f32x2 q0 = __builtin_amdgcn_cvt_scalef32_pk_f32_fp4(word, one, 0), q1 = __builtin_amdgcn_cvt_scalef32_pk_f32_fp4(word, one, 1); \
    const f32x2 q2 = __builtin_amdgcn_cvt_scalef32_pk_f32_fp4(word, one, 2), q3 = __builtin_amdgcn_cvt_scalef32_pk_f32_fp4(word, one, 3); \
    pa += q0[0] * xv[base + 0] + q0[1] * xv[base + 1]; pb += q1[0] * xv[base + 2] + q1[1] * xv[base + 3]; \
    pa += q2[0] * xv[base + 4] + q2[1] * xv[base + 5]; pb += q3[0] * xv[base + 6] + q3[1] * xv[base + 7]; \
  }
__device__ __forceinline__ float r4_dot(const u32x4& e, const XPk& x) {
  const float one = __uint_as_float((unsigned)opq(0x3F800000));
  float pa = 0.f, pb = 0.f;
  R4_DOT_W(e[0], x.a, 0, pa, pb) R4_DOT_W(e[1], x.a, 8, pa, pb) R4_DOT_W(e[2], x.b, 0, pa, pb) R4_DOT_W(e[3], x.b, 8, pa, pb)
  return pa + pb;
}
#define R4_AXPY_W(word, accv, base)                                                                  \
  {                                                                                                  \
    typedef __attribute__((ext_vector_type(2))) float f32x2;                                         \
    const f32x2 q0 = __builtin_amdgcn_cvt_scalef32_pk_f32_fp4(word, one, 0), q1 = __builtin_amdgcn_cvt_scalef32_pk_f32_fp4(word, one, 1); \
    const f32x2 q2 = __builtin_amdgcn_cvt_scalef32_pk_f32_fp4(word, one, 2), q3 = __builtin_amdgcn_cvt_scalef32_pk_f32_fp4(word, one, 3); \
    accv[base + 0] += hid * q0[0]; accv[base + 1] += hid * q0[1]; accv[base + 2] += hid * q1[0]; accv[base + 3] += hid * q1[1]; \
    accv[base + 4] += hid * q2[0]; accv[base + 5] += hid * q2[1]; accv[base + 6] += hid * q3[0]; accv[base + 7] += hid * q3[1]; \
  }
__device__ __forceinline__ void r4_axpy(const u32x4& e, float hid, Acc32& acc) {
  const float one = __uint_as_float((unsigned)opq(0x3F800000));
  R4_AXPY_W(e[0], acc.a, 0) R4_AXPY_W(e[1], acc.a, 8) R4_AXPY_W(e[2], acc.b, 0) R4_AXPY_W(e[3], acc.b, 8)
}

#define INS16(K, x)                                                                                      \
  K##15 = __builtin_amdgcn_fmed3f(K##15, K##14, x); K##14 = __builtin_amdgcn_fmed3f(K##14, K##13, x);   \
  K##13 = __builtin_amdgcn_fmed3f(K##13, K##12, x); K##12 = __builtin_amdgcn_fmed3f(K##12, K##11, x);   \
  K##11 = __builtin_amdgcn_fmed3f(K##11, K##10, x); K##10 = __builtin_amdgcn_fmed3f(K##10, K##9, x);    \
  K##9 = __builtin_amdgcn_fmed3f(K##9, K##8, x); K##8 = __builtin_amdgcn_fmed3f(K##8, K##7, x);         \
  K##7 = __builtin_amdgcn_fmed3f(K##7, K##6, x); K##6 = __builtin_amdgcn_fmed3f(K##6, K##5, x);         \
  K##5 = __builtin_amdgcn_fmed3f(K##5, K##4, x); K##4 = __builtin_amdgcn_fmed3f(K##4, K##3, x);         \
  K##3 = __builtin_amdgcn_fmed3f(K##3, K##2, x); K##2 = __builtin_amdgcn_fmed3f(K##2, K##1, x);         \
  K##1 = __builtin_amdgcn_fmed3f(K##1, K##0, x); K##0 = fmaxf(K##0, x);
#define DECL16(K) float K##0 = -INFINITY, K##1 = -INFINITY, K##2 = -INFINITY, K##3 = -INFINITY, K##4 = -INFINITY, \
  K##5 = -INFINITY, K##6 = -INFINITY, K##7 = -INFINITY, K##8 = -INFINITY, K##9 = -INFINITY, K##10 = -INFINITY,   \
  K##11 = -INFINITY, K##12 = -INFINITY, K##13 = -INFINITY, K##14 = -INFINITY, K##15 = -INFINITY;
__device__ __forceinline__ float mkkey(float v, unsigned tag, unsigned mask) {
  return __uint_as_float((__float_as_uint(v) & ~mask) | tag);
}

__device__ __forceinline__ void ph_peer(const P& p, float* smem) {
  typedef __attribute__((ext_vector_type(4))) float f32x4;
  float* lists = smem;
  int* bexA = (int*)(smem + 4096);
  float* bgtA = smem + 6144;
  float* bsuA = smem + 8192;
  for (int item = blockIdx.x; item < T_TOK / 16; item += gridDim.x) {
    const int t0 = item * 16;
    __syncthreads();
    {
      const int tid = opq(threadIdx.x);
      const int tl = tid >> 4, hp = tid & 15;
      const f32x4* sp = (const f32x4*)(p.scores + (size_t)(t0 + tl) * DM + hp * 128);
      DECL16(k)
#pragma unroll 4
      for (int c4 = 0; c4 < 32; ++c4) {
        const f32x4 v = sp[c4];
#pragma unroll
        for (int e = 0; e < 4; ++e) {
          const float x = mkkey(v[e], 127u - (unsigned)(c4 * 4 + e), 127u);
          INS16(k, x)
        }
      }
      f32x4* lp = (f32x4*)(lists + (size_t)opq(threadIdx.x) * 16);
      f32x4 o0 = {k0, k1, k2, k3}, o1 = {k4, k5, k6, k7}, o2 = {k8, k9, k10, k11}, o3 = {k12, k13, k14, k15};
      lp[0] = o0; lp[1] = o1; lp[2] = o2; lp[3] = o3;
    }
    __syncthreads();
    if (opq(threadIdx.x) < 128) {
      const int tid = opq(threadIdx.x);
      const int tl = tid >> 3, h = tid & 7;
      const float* la = lists + (size_t)(tl * 16 + 2 * h) * 16;
      const float* lb = la + 16;
      float av[16], bv[16];
#pragma unroll
      for (int i = 0; i < 16; ++i) {
        av[i] = __uint_as_float(__float_as_uint(la[i]) & ~127u);
        bv[i] = __uint_as_float(__float_as_uint(lb[i]) & ~127u);
      }
      DECL16(c)
#pragma unroll
      for (int i = 0; i < 16; ++i) {
#pragma unroll
        for (int j = 0; j < 16; ++j) {
          if ((i + 1) * (j + 1) <= 16) {
            const float x = mkkey(av[i] + bv[j], 255u - (unsigned)(i * 16 + j), 255u);
            INS16(c, x)
          }
        }
      }
      float cs[16] = {c0, c1, c2, c3, c4, c5, c6, c7, c8, c9, c10, c11, c12, c13, c14, c15};
      float ev[16];
      float sum = 0.f;
      const float mx = __uint_as_float(__float_as_uint(cs[0]) & ~255u);
#pragma unroll
      for (int n = 0; n < 16; ++n) {
        ev[n] = __expf(__uint_as_float(__float_as_uint(cs[n]) & ~255u) - mx);
        sum += ev[n];
      }
      const float isum = 1.f / sum;
#pragma unroll
      for (int n = 0; n < 16; ++n) {
        const unsigned cc = 255u - (__float_as_uint(cs[n]) & 255u);
        const unsigned ka = 127u - (__float_as_uint(la[cc >> 4]) & 127u);
        const unsigned kb = 127u - (__float_as_uint(lb[cc & 15u]) & 127u);
        const int eid = (int)(ka * 128u + kb);
        bexA[tl * 128 + h * 16 + n] = eid;
        bgtA[tl * 128 + h * 16 + n] = ev[n] * isum * p.sv8[eid];
        bsuA[tl * 128 + h * 16 + n] = p.su8[eid];
      }
    }
    __syncthreads();
#pragma unroll 1
    for (int ti4 = 0; ti4 < 4; ++ti4) {
    const int lane = opq(threadIdx.x) & 63, wv = opq(threadIdx.x) >> 6;
    const int tl = wv * 4 + ti4;
    const int t = t0 + tl;
    const int* bex = bexA + tl * 128;
    const float* bgt = bgtA + tl * 128;
    const float* bsu = bsuA + tl * 128;
    XPk x;
    {
      const f32x4* s4 = (const f32x4*)(p.out + (size_t)t * DM) + lane * 8;
      const f32x4* g4 = (const f32x4*)p.norm_ffn + lane * 8;
      f32x4 a0 = s4[0], a1 = s4[1], a2 = s4[2], a3 = s4[3], a4 = s4[4], a5 = s4[5], a6 = s4[6], a7 = s4[7];
      float ss = 0.f;
#define SSQ(v) ss += v[0] * v[0] + v[1] * v[1] + v[2] * v[2] + v[3] * v[3];
      SSQ(a0) SSQ(a1) SSQ(a2) SSQ(a3) SSQ(a4) SSQ(a5) SSQ(a6) SSQ(a7)
#undef SSQ
      ss = wave_sum(ss);
      const float rs = rsqrtf(ss * (1.f / DM) + RMS_EPS);
#define XPK(dst, base, va, vb, gi)                                                    \
  {                                                                                   \
    const f32x4 ga = g4[gi], gb = g4[gi + 1];                                         \
    dst[base + 0] = bf2f(f2bf(va[0] * rs * ga[0])); dst[base + 1] = bf2f(f2bf(va[1] * rs * ga[1]));   \
    dst[base + 2] = bf2f(f2bf(va[2] * rs * ga[2])); dst[base + 3] = bf2f(f2bf(va[3] * rs * ga[3]));   \
    dst[base + 4] = bf2f(f2bf(vb[0] * rs * gb[0])); dst[base + 5] = bf2f(f2bf(vb[1] * rs * gb[1]));   \
    dst[base + 6] = bf2f(f2bf(vb[2] * rs * gb[2])); dst[base + 7] = bf2f(f2bf(vb[3] * rs * gb[3]));   \
  }
      XPK(x.a, 0, a0, a1, 0) XPK(x.a, 8, a2, a3, 2) XPK(x.b, 0, a4, a5, 4) XPK(x.b, 8, a6, a7, 6)
#undef XPK
    }
    Acc32 acc;
#pragma unroll
    for (int r = 0; r < 16; ++r) { acc.a[r] = 0.f; acc.b[r] = 0.f; }
    u32x4 u0 = r4_load(p.pu8, bex[0], lane), u1 = r4_load(p.pu8, bex[1], lane), u2 = r4_load(p.pu8, bex[2], lane), u3 = r4_load(p.pu8, bex[3], lane);
    u32x4 v0 = r4_load(p.pv8, bex[0], lane), v1 = r4_load(p.pv8, bex[1], lane), v2 = r4_load(p.pv8, bex[2], lane), v3 = r4_load(p.pv8, bex[3], lane);
#pragma unroll 1
    for (int e0 = 0; e0 < 128; e0 += 4) {
      float d0 = r4_dot(u0, x), d1 = r4_dot(u1, x), d2 = r4_dot(u2, x), d3 = r4_dot(u3, x);
      const int en = (e0 + 4 < 128) ? e0 + 4 : 124;
      const int i0 = bex[en], i1 = bex[en + 1], i2 = bex[en + 2], i3 = bex[en + 3];
      u0 = r4_load(p.pu8, i0, lane); u1 = r4_load(p.pu8, i1, lane); u2 = r4_load(p.pu8, i2, lane); u3 = r4_load(p.pu8, i3, lane);
#pragma unroll
      for (int o = 32; o > 0; o >>= 1) {
        d0 += __shfl_xor(d0, o); d1 += __shfl_xor(d1, o); d2 += __shfl_xor(d2, o); d3 += __shfl_xor(d3, o);
      }
      { const float hid = bgt[e0 + 0] * gelu_fast(d0 * bsu[e0 + 0]); r4_axpy(v0, hid, acc); }
      { const float hid = bgt[e0 + 1] * gelu_fast(d1 * bsu[e0 + 1]); r4_axpy(v1, hid, acc); }
      { const float hid = bgt[e0 + 2] * gelu_fast(d2 * bsu[e0 + 2]); r4_axpy(v2, hid, acc); }
      { const float hid = bgt[e0 + 3] * gelu_fast(d3 * bsu[e0 + 3]); r4_axpy(v3, hid, acc); }
      v0 = r4_load(p.pv8, i0, lane); v1 = r4_load(p.pv8, i1, lane); v2 = r4_load(p.pv8, i2, lane); v3 = r4_load(p.pv8, i3, lane);
    }
    const int lane2 = opq(lane);
    f32x4* o4 = (f32x4*)(p.out + (size_t)t * DM) + lane2 * 8;
    const f32x4* g4 = (const f32x4*)p.norm_final + lane2 * 8;
    f32x4 hv[8];
    float ss = 0.f;
#pragma unroll
    for (int i = 0; i < 8; ++i) {
      hv[i] = o4[i];
#pragma unroll
      for (int k = 0; k < 4; ++k) {
        hv[i][k] += (i < 4) ? acc.a[4 * i + k] : acc.b[4 * (i - 4) + k];
        ss += hv[i][k] * hv[i][k];
      }
    }
    ss = wave_sum(ss);
    const float rs = rsqrtf(ss * (1.f / DM) + RMS_EPS);
#pragma unroll
    for (int i = 0; i < 8; ++i) {
      const f32x4 g = g4[i];
      f32x4 o;
#pragma unroll
      for (int k = 0; k < 4; ++k) o[k] = hv[i][k] * rs * g[k];
      o4[i] = o;
    }
    }
  }
}

#define XB_TMO      128
#define XB_XCNT(j)  (256  + 64 * (j))
#define XB_XSUB(j)  (1280 + 64 * (j))
#define XB_XGEN(j)  (2304 + 64 * (j))
#define XB_TOP      3328
#define XB_TOPGEN   3392
#define XCD_BAR_WORDS 3456
#define XB_SPIN_CAP (1u << 22)
#define LAS __attribute__((address_space(3)))
__device__ __forceinline__ unsigned xb_ld(unsigned* p) { return __hip_atomic_load(p, __ATOMIC_RELAXED, __HIP_MEMORY_SCOPE_AGENT); }
__device__ __forceinline__ unsigned xb_add(unsigned* p, unsigned v) { return __hip_atomic_fetch_add(p, v, __ATOMIC_RELAXED, __HIP_MEMORY_SCOPE_AGENT); }
__device__ __forceinline__ unsigned xb_xcc_id() { return (unsigned)__builtin_amdgcn_s_getreg((3 << 11) | 20) & 0xFu; }
#define XB_SPIN(cond, bar) do { unsigned _sp = 0; while (cond) { __builtin_amdgcn_s_sleep(1); \
    if ((++_sp & 255u) == 0u) { if (xb_ld(&(bar)[XB_TMO])) break; if (_sp > XB_SPIN_CAP) { atomicAdd(&(bar)[XB_TMO], 1u); break; } } } } while (0)
struct XcdBarrier { unsigned* bar; unsigned x; volatile LAS unsigned* st; };
__device__ __forceinline__ XcdBarrier xcd_barrier_post(unsigned* bar, volatile LAS unsigned* st) {
  XcdBarrier b; b.bar = bar; b.x = xb_xcc_id(); b.st = st;
  if (threadIdx.x == 0) (void)xb_add(&bar[XB_XCNT(b.x)], 1u);
  return b;
}
__device__ __forceinline__ void xcd_barrier_complete(unsigned* bar, unsigned x, unsigned& nloc, unsigned& nx) {
  const unsigned G = gridDim.x * gridDim.y * gridDim.z;
  unsigned sum, cnt, mine, sp = 0u;
  for (;;) {
    sum = 0u; cnt = 0u; mine = 0u;
#pragma unroll
    for (unsigned j = 0; j < 16; ++j) { const unsigned c = xb_ld(&bar[XB_XCNT(j)]); sum += c; cnt += (c > 0u) ? 1u : 0u; mine = (j == x) ? c : mine; }
    if (sum == G) break;
    __builtin_amdgcn_s_sleep(1);
    if ((++sp & 255u) == 0u) { if (xb_ld(&bar[XB_TMO])) break; if (sp > XB_SPIN_CAP) { atomicAdd(&bar[XB_TMO], 1u); break; } }
  }
  nloc = mine > 0u ? mine : 1u; nx = cnt > 0u ? cnt : 1u;
}
__device__ __forceinline__ void xcd_barrier(const XcdBarrier& b) {
  asm volatile("s_waitcnt vmcnt(0)" ::: "memory");
  __syncthreads();
  if (threadIdx.x == 0) {
    unsigned* bar = b.bar;
    __builtin_amdgcn_s_waitcnt(0);
    unsigned nloc = b.st[0], nx = b.st[1];
    if (nloc == 0u) { xcd_barrier_complete(bar, b.x, nloc, nx); b.st[0] = nloc; b.st[1] = nx; }
    const unsigned old = xb_add(&bar[XB_XSUB(b.x)], 1u);
    const unsigned gen = old / nloc;
    if (old + 1u == (gen + 1u) * nloc) {
      __builtin_amdgcn_fence(__ATOMIC_RELEASE, "agent");
      asm volatile("s_waitcnt vmcnt(0)" ::: "memory");
      const unsigned og = xb_add(&bar[XB_TOP], 1u);
      const unsigned tg = og / nx;
      if (og + 1u == (tg + 1u) * nx) xb_add(&bar[XB_TOPGEN], 1u);
      else XB_SPIN(xb_ld(&bar[XB_TOPGEN]) == tg, bar);
      __builtin_amdgcn_fence(__ATOMIC_ACQUIRE, "agent");
      xb_add(&bar[XB_XGEN(b.x)], 1u);
      asm volatile("s_waitcnt vmcnt(0)" ::: "memory");
    } else {
      XB_SPIN(xb_ld(&bar[XB_XGEN(b.x)]) == gen, bar);
      __builtin_amdgcn_fence(__ATOMIC_ACQUIRE, "agent");
      asm volatile("s_waitcnt vmcnt(0)" ::: "memory");
    }
  }
  __syncthreads();
}

typedef const __attribute__((address_space(4))) P* KP;
__device__ __forceinline__ P loadP() {
#if defined(__HIP_DEVICE_COMPILE__)
  KP k = (KP)__builtin_amdgcn_kernarg_segment_ptr();
  asm volatile("" : "+s"(k));
  P p = *k;
  return p;
#else
  return P{};
#endif
}

__global__ void __launch_bounds__(256, 2) mega(P p_arg) {
  cg::grid_group grid = cg::this_grid();
  __shared__ __attribute__((aligned(16))) float smem[16384];
  char* lds = (char*)smem;
  __shared__ uint4 xb_words;
  if (threadIdx.x == 0) xb_words = make_uint4(0u, 0u, 0u, 0u);
  if (blockIdx.x == 0) {
    P p = loadP();
    for (int i = threadIdx.x; i < XCD_BAR_WORDS; i += 256) p.bar[i] = 0u;
  }
  { P p = loadP(); ph_rmsnorm(p.x, p.norm_mix, p.hn, T_TOK); ph_rmsnorm(p.mem, p.norm_mkv, p.memn, 1024); }
  { P p = loadP(); ph_transpose<true>(smem, p.w_in, DM, INC, 5760, p.WinT); }
  { P p = loadP(); ph_transpose<false>(smem, p.w_mk, DM, 512, 512, p.WmkT); }
  { P p = loadP(); ph_transpose<false>(smem, p.w_mv, DM, 512, 512, p.WmvT); }
  { P p = loadP(); ph_cvt(p.subk, p.subkb, (size_t)16 * 128 * 128); }
  { P p = loadP(); ph_transpose<false>(smem, p.w1_k, 4096, 128, 128, p.w1T); }
  { P p = loadP(); ph_transpose<false>(smem, p.w1_v, 4096, 128, 128, p.w1T + 128 * 4096); }
  { P p = loadP(); ph_transpose<false>(smem, p.w2_k, 128, 128, 128, p.w2T); }
  { P p = loadP(); ph_transpose<false>(smem, p.w2_v, 128, 128, 128, p.w2T + 128 * 128); }
  { P p = loadP(); ph_posb(p); }
  grid.sync();
  XcdBarrier xb;
  { P p = loadP(); xb = xcd_barrier_post(p.bar, (volatile LAS unsigned*)&xb_words); }
  { P p = loadP(); ph_proj(p, lds); }
  const int kvb = (gridDim.x == 512) ? (((int)blockIdx.x >= 320 && (int)blockIdx.x < 352) ? ((int)blockIdx.x - 320) * 8 : -1) : -2;
  const int vvb = (gridDim.x == 512) ? (((int)blockIdx.x >= 352 && (int)blockIdx.x < 384) ? ((int)blockIdx.x - 352) * 8 : -1) : -2;
  { P p = loadP(); bf16_t* kmem = p.kmemb;
    ph_gemm_bf16(p.memn, DM, p.WmkT, DM, 1024, 512, DM, lds, [=](int m, int n, float v) {
      kmem[((size_t)((m >> 8) * 4 + (n >> 7)) * 256 + (m & 255)) * 128 + (n & 127)] = f2bf(v); }, kvb); }
  { P p = loadP(); bf16_t* vmem = p.vmemT;
    ph_gemm_bf16(p.memn, DM, p.WmvT, DM, 1024, 512, DM, lds, [=](int m, int n, float v) {
      vmem[((size_t)((m >> 8) * 4 + (n >> 7)) * 128 + (n & 127)) * 256 + perm16(m & 255)] = f2bf(v); }, vvb); }
  xcd_barrier(xb);
  { P p = loadP(); ph_compress2(p, lds); }
  { P p = loadP(); ph_sb2(p, lds); }
  {
    const int skip = (gridDim.x > 32) ? 16 : 0;
    const int vb = ((int)blockIdx.x >= skip) ? (int)blockIdx.x - skip : -1, nvb = (int)gridDim.x - skip;
    __syncthreads();
    { P p = loadP(); ph_transpose<false>(smem, p.w_out, DM, DM, DM, p.WoutT, vb, nvb); }
    { P p = loadP(); ph_transpose<false>(smem, p.w_mq, DM, 512, 512, p.WmqT, vb, nvb); }
  }
  xcd_barrier(xb);
  { P p = loadP(); ph_nsa2(p, lds); }
  xcd_barrier(xb);
  { P p = loadP(); float* out = p.out; const float* x = p.x;
    ph_gemm_bf16<true>(p.omix, DM, p.WoutT, DM, T_TOK, DM, DM, lds, [=](int m, int n, f32x4_e lo, f32x4_e hi) {
      const f32x4_e x0 = *(const f32x4_e*)(x + (size_t)m * DM + n), x1 = *(const f32x4_e*)(x + (size_t)m * DM + n + 4);
      *(f32x4_e*)(out + (size_t)m * DM + n) = x0 + lo; *(f32x4_e*)(out + (size_t)m * DM + n + 4) = x1 + hi; }); }
  xcd_barrier(xb);
  { P p = loadP(); ph_rmsnorm(p.out, p.norm_mq, p.hn, T_TOK); }
  xcd_barrier(xb);
  if (blockIdx.x < 256 || gridDim.x < 512) {
    P p = loadP(); bf16_t* qmem = p.qmemb;
    ph_gemm_bf16<true>(p.hn, DM, p.WmqT, DM, T_TOK, 512, DM, lds, [=](int m, int n, f32x4_e lo, f32x4_e hi) { st_bf16x8(qmem + (size_t)m * 512 + n, lo, hi); });
  }
  {
    const int half = (gridDim.x >= 512) ? 256 : 0;
    if ((int)blockIdx.x >= half) {
      const int nwv = ((int)gridDim.x - half) * 4, wid = ((int)blockIdx.x - half) * 4 + (opq(threadIdx.x) >> 6);
      { P p = loadP(); ph_cvt4(p.pu, p.pu8, p.su8, 16384, wid, nwv); }
      if (gridDim.x < 512) { P p = loadP(); ph_cvt4(p.pv, p.pv8, p.sv8, 16384, wid, nwv); }
      __syncthreads();
      { P p = loadP(); ph_transpose<false>(smem, p.w_mo, 512, DM, DM, p.WmoT, (int)blockIdx.x - half, (int)gridDim.x - half); }
    }
  }
  xcd_barrier(xb);
  { P p = loadP(); ph_memattn2(p, lds); }
  if (gridDim.x >= 512 && blockIdx.x >= 256) {
    const int nwv = ((int)gridDim.x - 256) * 4, wid = ((int)blockIdx.x - 256) * 4 + (opq(threadIdx.x) >> 6);
    { P p = loadP(); ph_cvt4(p.pv, p.pv8, p.sv8, 16384, wid, nwv); }
  }
  {
    const int half = (gridDim.x >= 512) ? 256 : 0;
    __syncthreads();
    P p = loadP(); ph_transpose<false>(smem, p.w_pq, DM, DM, DM, p.WpqT, ((int)blockIdx.x >= half) ? (int)blockIdx.x - half : -1, (int)gridDim.x - half);
  }
  xcd_barrier(xb);
  { P p = loadP(); float* out = p.out;
    ph_gemm_bf16<true>(p.omem, 512, p.WmoT, 512, T_TOK, DM, 512, lds, [=](int m, int n, f32x4_e lo, f32x4_e hi) {
      f32x4_e* o0 = (f32x4_e*)(out + (size_t)m * DM + n);
      o0[0] = o0[0] + lo; o0[1] = o0[1] + hi; }); }
  xcd_barrier(xb);
  { P p = loadP(); ph_rmsnorm(p.out, p.norm_ffn, p.hn, T_TOK); }
  xcd_barrier(xb);
  { P p = loadP(); ph_qp_scores(p, lds); }
  xcd_barrier(xb);
  { P p = loadP(); ph_peer(p, smem); }
}

extern "C" void kernel_launch(void* const* d_in, const int* in_sizes, int n_in, void* d_out, int out_size, void* d_ws,
                              size_t ws_size, hipStream_t stream) {
  P p{};
  p.x = (const float*)d_in[0]; p.mem = (const float*)d_in[1]; p.t5 = (const float*)d_in[2];
  p.norm_mix = (const float*)d_in[3]; p.w_in = (const float*)d_in[4]; p.pos_k = (const float*)d_in[5];
  p.w1_k = (const float*)d_in[6]; p.w2_k = (const float*)d_in[7]; p.pos_v = (const float*)d_in[8];
  p.w1_v = (const float*)d_in[9]; p.w2_v = (const float*)d_in[10]; p.w_out = (const float*)d_in[11];
  p.norm_mq = (const float*)d_in[12]; p.norm_mkv = (const float*)d_in[13]; p.w_mq = (const float*)d_in[14];
  p.w_mk = (const float*)d_in[15]; p.w_mv = (const float*)d_in[16]; p.w_mo = (const float*)d_in[17];
  p.norm_ffn = (const float*)d_in[18]; p.w_pq = (const float*)d_in[19]; p.subk = (const float*)d_in[20];
  p.pu = (const float*)d_in[21]; p.pv = (const float*)d_in[22]; p.norm_final = (const float*)d_in[23];
  p.out = (float*)d_out;
  char* w = (char*)d_ws;
  size_t off = 0;
  auto take = [&](size_t bytes) { char* r = w + off; off += (bytes + 255) & ~(size_t)255; return r; };
  p.bar = (unsigned*)take(XCD_BAR_WORDS * 4);
  p.scores = (float*)take((size_t)T_TOK * DM * 4);
  p.gates = (float*)take((size_t)T_TOK * 24 * 4);
  p.part = (float*)take((size_t)T_TOK * 1024 * 4);
  p.posb = (float*)take(256 * 4);
  p.qn = (bf16_t*)take((size_t)T_TOK * 1024 * 2);
  p.kcin = (bf16_t*)take((size_t)T_TOK * 256 * 2 + 65536);
  p.vcin = (bf16_t*)take((size_t)T_TOK * 256 * 2 + 65536);
  p.ks = (bf16_t*)take((size_t)T_TOK * 256 * 2);
  p.vsT = (bf16_t*)take((size_t)T_TOK * 256 * 2);
  p.kw = (bf16_t*)take((size_t)T_TOK * 256 * 2);
  p.vwT = (bf16_t*)take((size_t)T_TOK * 256 * 2);
  p.kcb = (bf16_t*)take((size_t)8 * 128 * 128 * 2);
  p.vcT = (bf16_t*)take((size_t)8 * 128 * 128 * 2);
  p.c1 = (bf16_t*)take((size_t)16 * 128 * 128 * 2);
  p.w1T = (bf16_t*)take((size_t)2 * 128 * 4096 * 2);
  p.w2T = (bf16_t*)take((size_t)2 * 128 * 128 * 2);
  p.hn = (bf16_t*)take((size_t)T_TOK * DM * 2);
  p.omix = (bf16_t*)take((size_t)T_TOK * DM * 2);
  p.memn = (bf16_t*)take((size_t)1024 * DM * 2);
  p.omem = (bf16_t*)take((size_t)T_TOK * 512 * 2);
  p.WinT = (bf16_t*)take((size_t)5760 * DM * 2);
  p.WoutT = (bf16_t*)take((size_t)DM * DM * 2);
  p.WpqT = (bf16_t*)take((size_t)DM * DM * 2);
  p.WmqT = (bf16_t*)take((size_t)512 * DM * 2);
  p.WmkT = (bf16_t*)take((size_t)512 * DM * 2);
  p.WmvT = (bf16_t*)take((size_t)512 * DM * 2);
  p.WmoT = (bf16_t*)take((size_t)DM * 512 * 2);
  p.qmemb = (bf16_t*)take((size_t)T_TOK * 512 * 2);
  p.kmemb = (bf16_t*)take((size_t)1024 * 512 * 2);
  p.vmemT = (bf16_t*)take((size_t)1024 * 512 * 2);
  p.qsb = (bf16_t*)take((size_t)T_TOK * 1024 * 2);
  p.ksb = (bf16_t*)take((size_t)T_TOK * 1024 * 2);
  p.vsbT = (bf16_t*)take((size_t)T_TOK * 1024 * 2);
  p.pu8 = (unsigned char*)take((size_t)16384 * 1024);
  p.pv8 = (unsigned char*)take((size_t)16384 * 1024);
  p.su8 = (float*)take(16384 * 4);
  p.sv8 = (float*)take(16384 * 4);
  p.subkb = (bf16_t*)take((size_t)16 * 128 * 128 * 2);
  static int grid_blocks = 0;
  if (!grid_blocks) {
    int dev = 0, cus = 0, per_cu = 0;
    (void)hipGetDevice(&dev);
    (void)hipDeviceGetAttribute(&cus, hipDeviceAttributeMultiprocessorCount, dev);
    (void)hipOccupancyMaxActiveBlocksPerMultiprocessor(&per_cu, mega, 256, 0);
    if (per_cu > 2) per_cu = 2;
    if (per_cu < 1) per_cu = 1;
    grid_blocks = cus * per_cu;
  }
  void* args[] = {&p};
  hipError_t e = hipLaunchCooperativeKernel((void*)mega, dim3(grid_blocks), dim3(256), args, 0, stream);
  if (e != hipSuccess) fprintf(stderr, "cooperative launch failed: %s (grid %d)\n", hipGetErrorString(e), grid_blocks);
}
```

```cpp
#include <hip/hip_runtime.h>
#include <hip/hip_cooperative_groups.h>
#include <cstdio>
namespace cg = cooperative_groups;
#include <stdint.h>

#define SEQ 2048
#define NBATCH 4
#define T_TOK 8192
#define DM 2048
#define INC 5656
#define C_QN 0
#define C_KC 1024
#define C_VC 1280
#define C_KS 1536
#define C_VS 1792
#define C_KW 2048
#define C_VW 2304
#define C_GT 2560
#define C_QSB 2584
#define C_KSB 3608
#define C_VSB 4632
#define ATT_SCALE 0.08838834764831845f
#define RMS_EPS 1e-6f

typedef unsigned short bf16_t;
typedef __attribute__((ext_vector_type(8))) short bf16x8;
typedef __attribute__((ext_vector_type(16))) float f32x16;
typedef __attribute__((ext_vector_type(2))) __bf16 bf16v2;
typedef __attribute__((ext_vector_type(4))) unsigned u32x4;

struct P {
  const float *x, *mem, *t5, *norm_mix, *w_in, *pos_k, *w1_k, *w2_k, *pos_v, *w1_v, *w2_v, *w_out,
      *norm_mq, *norm_mkv, *w_mq, *w_mk, *w_mv, *w_mo, *norm_ffn, *w_pq, *subk, *pu, *pv, *norm_final;
  float* out;
  float *scores, *gates, *part, *posb, *rowss;
  unsigned* bar;
  bf16_t *hn, *omix, *memn, *omem;
  bf16_t *WinT, *WoutT, *WpqT, *WmqT, *WmkT, *WmvT, *WmoT;
  bf16_t *qmemb, *kmemb, *vmemT;
  bf16_t *qsb, *ksb, *vsbT;
  bf16_t* subkb;
  unsigned char *pu8, *pv8;
  float *su8, *sv8;
  bf16_t *qn, *kcin, *vcin, *ks, *vsT, *kw, *vwT, *kcb, *vcT, *c1, *w1T, *w2T;
};

__device__ __forceinline__ int opq(int v) { asm volatile("" : "+v"(v)); return v; }
__device__ __forceinline__ unsigned pack2(float a, float b) {
  bf16v2 r = {(__bf16)a, (__bf16)b};
  return *(unsigned*)&r;
}
__device__ __forceinline__ bf16_t f2bf(float a) {
  __bf16 r = (__bf16)a;
  return *(bf16_t*)&r;
}
__device__ __forceinline__ int perm16(int s) { return (s & ~12) | ((s & 4) << 1) | ((s & 8) >> 1); }
__device__ __forceinline__ float bf2f(bf16_t u) { return __uint_as_float((unsigned)u << 16); }

__device__ __forceinline__ float wave_max(float v) {
  for (int o = 32; o > 0; o >>= 1) v = fmaxf(v, __shfl_xor(v, o));
  return v;
}
__device__ __forceinline__ float wave_sum(float v) {
  for (int o = 32; o > 0; o >>= 1) v += __shfl_xor(v, o);
  return v;
}
__device__ __forceinline__ void wave_argmax(float& v, int& i) {
  for (int o = 32; o > 0; o >>= 1) {
    float ov = __shfl_xor(v, o);
    int oi = __shfl_xor(i, o);
    if (ov > v || (ov == v && oi < i)) { v = ov; i = oi; }
  }
}
__device__ __forceinline__ float gelu_tanh(float x) {
  return 0.5f * x * (1.f + tanhf(0.7978845608028654f * (x + 0.044715f * x * x * x)));
}
__device__ __forceinline__ float gelu_fast(float x) {
  const float y = 1.5957691216057308f * (x + 0.044715f * x * x * x);
  return x / (1.f + __expf(-y));
}
__device__ __forceinline__ int t5_bucket(int n) {
  if (n < 16) return n < 0 ? 0 : n;
  int b = 16;
  b += (n >= 19); b += (n >= 21); b += (n >= 24); b += (n >= 27); b += (n >= 31); b += (n >= 35);
  b += (n >= 40); b += (n >= 46); b += (n >= 52); b += (n >= 59); b += (n >= 67); b += (n >= 77);
  b += (n >= 87); b += (n >= 99); b += (n >= 113);
  return b;
}
__device__ __forceinline__ float log_sigmoid(float x) {
  return fminf(x, 0.f) - log1pf(expf(-fabsf(x)));
}

__device__ __forceinline__ void ph_rmsnorm(const float* src, const float* gain, bf16_t* dst, int rows) {
  int lane = opq(threadIdx.x) & 63, wv = opq(threadIdx.x) >> 6;
  for (int r = blockIdx.x * 4 + wv; r < rows; r += gridDim.x * 4) {
    const float4* s4 = (const float4*)(src + (size_t)r * DM);
    float4 v[8];
    float ss = 0.f;
#pragma unroll
    for (int i = 0; i < 8; ++i) {
      v[i] = s4[i * 64 + lane];
      ss += v[i].x * v[i].x + v[i].y * v[i].y + v[i].z * v[i].z + v[i].w * v[i].w;
    }
    ss = wave_sum(ss);
    float rs = rsqrtf(ss * (1.f / DM) + RMS_EPS);
    uint2* d2 = (uint2*)(dst + (size_t)r * DM);
    const float4* g4 = (const float4*)gain;
#pragma unroll
    for (int i = 0; i < 8; ++i) {
      float4 g = g4[i * 64 + lane];
      uint2 o;
      o.x = pack2(v[i].x * rs * g.x, v[i].y * rs * g.y);
      o.y = pack2(v[i].z * rs * g.z, v[i].w * rs * g.w);
      d2[i * 64 + lane] = o;
    }
  }
}

template <bool CMAP>
__device__ __forceinline__ void ph_transpose(float* smem, const float* W, int K, int N, int Npad, bf16_t* Wt,
                                             int vblock = -2, int nvb = 0) {
  typedef __attribute__((ext_vector_type(4))) float f32x4;
  float (*tl)[65] = (float (*)[65])smem;
  if (vblock == -1) return;
  const int b0 = (vblock >= 0) ? vblock : (int)blockIdx.x, bstride = (vblock >= 0) ? nvb : (int)gridDim.x;
  const int tid = opq(threadIdx.x);
  const int nk = K / 64, nn = Npad / 64;
  for (int tile = b0; tile < nk * nn; tile += bstride) {
    const int k0 = (tile % nk) * 64, n0 = (tile / nk) * 64;
    const int kr = tid >> 4, n4 = (tid & 15) * 4;
    int sc = n0 + n4;
    if (CMAP) sc = (sc < 2560) ? sc : (sc < 5632) ? sc + 24 : (sc < 5656) ? sc - 5632 + 2560 : N;
#pragma unroll
    for (int i = 0; i < 4; ++i) {
      const int k = kr + 16 * i;
      f32x4 v = {0.f, 0.f, 0.f, 0.f};
      if (sc < N) v = *(const f32x4*)(W + (size_t)(k0 + k) * N + sc);
      tl[k][n4 + 0] = v[0]; tl[k][n4 + 1] = v[1]; tl[k][n4 + 2] = v[2]; tl[k][n4 + 3] = v[3];
    }
    __syncthreads();
    int n = tid >> 2, kc = (tid & 3) * 16;
    unsigned w[8];
#pragma unroll
    for (int i = 0; i < 8; ++i) w[i] = pack2(tl[kc + 2 * i][n], tl[kc + 2 * i + 1][n]);
    uint4* dst = (uint4*)(Wt + (size_t)(n0 + n) * K + k0 + kc);
    dst[0] = make_uint4(w[0], w[1], w[2], w[3]);
    dst[1] = make_uint4(w[4], w[5], w[6], w[7]);
    __syncthreads();
  }
}

__device__ __forceinline__ int lds_off(int row, int chunk) { return row * 128 + ((chunk ^ ((row >> 1) & 7)) << 4); }

template <bool TR, bool VEC = false, class Epi>
__device__ __forceinline__ void gemm_tile_bf16(const bf16_t* xp, int ldx, const bf16_t* yp, int ldy, int K, char* lds,
                                               Epi epi) {
  const int tid = opq(threadIdx.x), lane = tid & 63, wv = tid >> 6;
  const int wr = wv >> 1, wc = wv & 1;
  f32x16 acc[2][2];
#pragma unroll
  for (int i = 0; i < 2; ++i)
#pragma unroll
    for (int j = 0; j < 2; ++j)
#pragma unroll
      for (int r = 0; r < 16; ++r) acc[i][j][r] = 0.f;
  const int prow = lane >> 3, pch = lane & 7;
  const bf16_t* xs[4];
  const bf16_t* ys[4];
#pragma unroll
  for (int ps = 0; ps < 4; ++ps) {
    const int row = (wv * 4 + ps) * 8 + prow;
    const int c = pch ^ ((row >> 1) & 7);
    xs[ps] = xp + (size_t)row * ldx + c * 8;
    ys[ps] = yp + (size_t)row * ldy + c * 8;
  }
  char* const mydst = lds + wv * 4096 + lane * 16;
#define GEMM_ISSUE(k0, bufoff)                                                                                              \
  _Pragma("unroll") for (int ps = 0; ps < 4; ++ps) {                                                                        \
    __builtin_amdgcn_global_load_lds((const unsigned*)(xs[ps] + (k0)), (unsigned*)(mydst + (bufoff) + ps * 1024), 16, 0, 0);         \
    __builtin_amdgcn_global_load_lds((const unsigned*)(ys[ps] + (k0)), (unsigned*)(mydst + (bufoff) + 16384 + ps * 1024), 16, 0, 0); \
  }
#define GEMM_COMPUTE(bufoff)                                                                                     \
  _Pragma("unroll") for (int kk = 0; kk < 4; ++kk) {                                                             \
    bf16x8 a[2], b[2];                                                                                           \
    const int ch = kk * 2 + (lane >> 5);                                                                         \
    _Pragma("unroll") for (int i = 0; i < 2; ++i) {                                                              \
      a[i] = *(const bf16x8*)(lds + (bufoff) + (TR ? 16384 : 0) + lds_off(wr * 64 + i * 32 + (lane & 31), ch)); \
      b[i] = *(const bf16x8*)(lds + (bufoff) + (TR ? 0 : 16384) + lds_off(wc * 64 + i * 32 + (lane & 31), ch)); \
    }                                                                                                            \
    _Pragma("unroll") for (int i = 0; i < 2; ++i)                                                                \
      _Pragma("unroll") for (int j = 0; j < 2; ++j)                                                              \
        acc[i][j] = __builtin_amdgcn_mfma_f32_32x32x16_bf16(a[i], b[j], acc[i][j], 0, 0, 0);                    \
  }
  __syncthreads();
  GEMM_ISSUE(0, 0)
  for (int k0 = 0; k0 < K; k0 += 128) {
    asm volatile("s_waitcnt vmcnt(0)" ::: "memory");
    __syncthreads();
    GEMM_ISSUE(k0 + 64, 32768)
    GEMM_COMPUTE(0)
    asm volatile("s_waitcnt vmcnt(0)" ::: "memory");
    __syncthreads();
    if (k0 + 128 < K) { GEMM_ISSUE(k0 + 128, 0) }
    GEMM_COMPUTE(32768)
  }
#undef GEMM_ISSUE
#undef GEMM_COMPUTE
  int lane2 = lane;
  asm volatile("" : "+v"(lane2));
  if constexpr (VEC) {
    typedef __attribute__((ext_vector_type(4))) float f32x4;
    __syncthreads();
    float* wl = (float*)lds + wv * (32 * 68);
    const int hh2 = lane2 >> 5, cl = lane2 & 31;
#pragma unroll
    for (int i = 0; i < 2; ++i) {
#pragma unroll
      for (int j = 0; j < 2; ++j)
#pragma unroll
        for (int r = 0; r < 16; ++r) wl[((r & 3) + 8 * (r >> 2) + 4 * hh2) * 68 + j * 32 + cl] = acc[i][j][r];
      __builtin_amdgcn_wave_barrier();
#pragma unroll
      for (int k = 0; k < 4; ++k) {
        const int row = (lane2 >> 3) + 8 * k, c8 = (lane2 & 7) * 8;
        const f32x4 lo = *(const f32x4*)&wl[row * 68 + c8];
        const f32x4 hi = *(const f32x4*)&wl[row * 68 + c8 + 4];
        epi(wr * 64 + i * 32 + row, wc * 64 + c8, lo, hi);
      }
      __builtin_amdgcn_wave_barrier();
    }
  } else {
#pragma unroll
    for (int i = 0; i < 2; ++i)
#pragma unroll
      for (int j = 0; j < 2; ++j)
#pragma unroll
        for (int r = 0; r < 16; ++r) {
          int rr = wr * 64 + i * 32 + (r & 3) + 8 * (r >> 2) + 4 * (lane2 >> 5);
          int cc = wc * 64 + j * 32 + (lane2 & 31);
          epi(rr, cc, acc[i][j][r]);
        }
  }
}

typedef __attribute__((ext_vector_type(4))) float f32x4_e;
__device__ __forceinline__ void st_bf16x8(bf16_t* dst, f32x4_e lo, f32x4_e hi) {
  u32x4 o;
  o[0] = pack2(lo[0], lo[1]); o[1] = pack2(lo[2], lo[3]); o[2] = pack2(hi[0], hi[1]); o[3] = pack2(hi[2], hi[3]);
  *(u32x4*)dst = o;
}

__device__ __forceinline__ void norm_feed(const f32x4_e h0, const f32x4_e h1, const float* gain, int n, bf16_t* hn_row,
                                          float* rowss_m) {
  const f32x4_e g0 = *(const f32x4_e*)(gain + n), g1 = *(const f32x4_e*)(gain + n + 4);
  st_bf16x8(hn_row + n, h0 * g0, h1 * g1);
  float ss = h0[0] * h0[0] + h0[1] * h0[1] + h0[2] * h0[2] + h0[3] * h0[3] + h1[0] * h1[0] + h1[1] * h1[1] + h1[2] * h1[2] + h1[3] * h1[3];
  ss += __shfl_xor(ss, 1);
  ss += __shfl_xor(ss, 2);
  ss += __shfl_xor(ss, 4);
  if (((opq(threadIdx.x)) & 7) == 0) atomicAdd(rowss_m, ss);
}

template <bool VEC = false, class Epi>
__device__ __forceinline__ void ph_gemm_bf16(const bf16_t* A, int lda, const bf16_t* Wt, int ldw, int M, int N, int K,
                                             char* lds, Epi epi, int vblock = -2) {
  const int ntm = M / 128, ntn = N / 128;
  const int npm = (ntm + 7) / 8, npn = (ntn + 7) / 8;
  const int nslots = ((npm * npn * 64 + 511) / 512) * 512;
  if (vblock == -1) return;
  for (int u = (vblock >= 0 ? vblock : (int)blockIdx.x); u < nslots; u += gridDim.x) {
    int v = (u & 7) * 64 + ((u >> 3) & 63) + (u & ~511);
    int patch = v >> 6, w = v & 63;
    int tm = (patch % npm) * 8 + (w & 7);
    int tn = (patch / npm) * 8 + (w >> 3);
    if (tm >= ntm || tn >= ntn) continue;
    const int m0 = tm * 128, n0 = tn * 128;
    if constexpr (VEC)
      gemm_tile_bf16<false, true>(A + (size_t)m0 * lda, lda, Wt + (size_t)n0 * ldw, ldw, K, lds,
                                  [&](int r, int c, f32x4_e lo, f32x4_e hi) { epi(m0 + r, n0 + c, lo, hi); });
    else
      gemm_tile_bf16<false>(A + (size_t)m0 * lda, lda, Wt + (size_t)n0 * ldw, ldw, K, lds,
                            [&](int r, int c, float val) { epi(m0 + r, n0 + c, val); });
  }
}

__device__ __forceinline__ void ph_proj(const P& p, char* lds) {
  const int ntm = T_TOK / 128, ntn = 5760 / 128;
  const int npm = (ntm + 7) / 8, npn = (ntn + 7) / 8;
  const int nslots = ((npm * npn * 64 + 511) / 512) * 512;
  for (int u = blockIdx.x; u < nslots; u += gridDim.x) {
    int v = (u & 7) * 64 + ((u >> 3) & 63) + (u & ~511);
    int patch = v >> 6, w = v & 63;
    int tm = (patch % npm) * 8 + (w & 7);
    int tn = (patch / npm) * 8 + (w >> 3);
    if (tm >= ntm || tn >= ntn) continue;
    const int m0 = tm * 128, n0 = tn * 128;
    const int b = m0 >> 11, sl = m0 & 2047;
    const bf16_t* A = p.hn + (size_t)m0 * DM;
    const bf16_t* W = p.WinT + (size_t)n0 * DM;
    if (n0 < 1024) {
      bf16_t* q = p.qn + (size_t)m0 * 1024 + n0;
      gemm_tile_bf16<false, true>(A, DM, W, DM, DM, lds, [&](int r, int c, f32x4_e lo, f32x4_e hi) { st_bf16x8(q + (size_t)r * 1024 + c, lo, hi); });
    } else if (n0 < 2560) {
      const int seg = (n0 - 1024) >> 8, g = ((n0 - 1024) >> 7) & 1;
      if (seg == 3 || seg == 5) {
        bf16_t* vd = (seg == 3 ? p.vsT : p.vwT) + ((size_t)(b * 2 + g) * 128) * SEQ + sl;
        gemm_tile_bf16<true>(A, DM, W, DM, DM, lds, [&](int r, int c, float val) { vd[(size_t)r * SEQ + perm16(c)] = f2bf(val); });
      } else {
        bf16_t* base = (seg == 0) ? p.kcin : (seg == 1) ? p.vcin : (seg == 2) ? p.ks : p.kw;
        bf16_t* kd = base + ((size_t)(b * 2 + g) * SEQ + sl) * 128;
        gemm_tile_bf16<false, true>(A, DM, W, DM, DM, lds, [&](int r, int c, f32x4_e lo, f32x4_e hi) { st_bf16x8(kd + (size_t)r * 128 + c, lo, hi); });
      }
    } else if (n0 < 3584) {
      bf16_t* q = p.qsb + (size_t)m0 * 1024 + (n0 - 2560);
      gemm_tile_bf16<false, true>(A, DM, W, DM, DM, lds, [&](int r, int c, f32x4_e lo, f32x4_e hi) { st_bf16x8(q + (size_t)r * 1024 + c, lo, hi); });
    } else if (n0 < 4608) {
      bf16_t* kd = p.ksb + ((size_t)(b * 8 + ((n0 - 3584) >> 7)) * SEQ + sl) * 128;
      gemm_tile_bf16<false, true>(A, DM, W, DM, DM, lds, [&](int r, int c, f32x4_e lo, f32x4_e hi) { st_bf16x8(kd + (size_t)r * 128 + c, lo, hi); });
    } else if (n0 < 5632) {
      bf16_t* vd = p.vsbT + ((size_t)(b * 8 + ((n0 - 4608) >> 7)) * 128) * SEQ + sl;
      gemm_tile_bf16<true>(A, DM, W, DM, DM, lds, [&](int r, int c, float val) { vd[(size_t)r * SEQ + perm16(c)] = f2bf(val); });
    } else {
      float* gd = p.gates + (size_t)m0 * 24;
      gemm_tile_bf16<false>(A, DM, W, DM, DM, lds, [&](int r, int c, float val) { if (c < 24) gd[(size_t)r * 24 + c] = val; });
    }
  }
}

__device__ __forceinline__ void ph_posb(const P& p) {
  const int lane = opq(threadIdx.x) & 63, wv = opq(threadIdx.x) >> 6;
  for (int o = blockIdx.x * 4 + wv; o < 256; o += gridDim.x * 4) {
    const int which = o >> 7, n = o & 127;
    const float* pos = which ? p.pos_v : p.pos_k;
    const float* w1 = which ? p.w1_v : p.w1_k;
    float acc = 0.f;
    for (int k = lane; k < 4096; k += 64) acc += pos[k] * w1[(size_t)k * 128 + n];
    acc = wave_sum(acc);
    if (lane == 0) p.posb[o] = acc;
  }
}

__device__ __forceinline__ void ph_compress2(const P& p, char* lds) {
  for (int item = blockIdx.x; item < 16; item += gridDim.x) {
    const int which = item >> 3, bg = item & 7;
    const bf16_t* src = (which ? p.vcin : p.kcin) + (size_t)bg * SEQ * 128;
    const bf16_t* w1t = p.w1T + (size_t)which * 128 * 4096;
    const bf16_t* w2t = p.w2T + (size_t)which * 128 * 128;
    const float* posb = p.posb + which * 128;
    bf16_t* c1 = p.c1 + (size_t)item * 128 * 128;
    gemm_tile_bf16<false>(src, 2048, w1t, 4096, 4096, lds, [&](int r, int c, float val) {
      c1[r * 128 + c] = f2bf(gelu_fast(val + posb[c])); });
    __threadfence_block();
    __syncthreads();
    if (which == 0) {
      bf16_t* kd = p.kcb + (size_t)bg * 128 * 128;
      gemm_tile_bf16<false>(c1, 128, w2t, 128, 128, lds, [&](int r, int c, float val) { kd[r * 128 + c] = f2bf(val); });
    } else {
      bf16_t* vd = p.vcT + (size_t)bg * 128 * 128;
      gemm_tile_bf16<true>(c1, 128, w2t, 128, 128, lds, [&](int r, int c, float val) { vd[r * 128 + perm16(c)] = f2bf(val); });
    }
  }
}

#define NEG_BIG (-1e30f)

struct KVRegs { u32x4 k0, k1, k2, k3, v0, v1, v2, v3; };

__device__ __forceinline__ int koff(int row, int chunk) { return row * 256 + ((chunk ^ (row & 15)) << 4); }

__device__ __forceinline__ void kv_load(KVRegs& r, const bf16_t* kp, int ldk, const bf16_t* vp, int ldv) {
  const int tid = opq(threadIdx.x);
  const bf16_t* kg = kp + (size_t)(tid >> 4) * ldk + (tid & 15) * 8;
  r.k0 = *(const u32x4*)kg;
  r.k1 = *(const u32x4*)(kg + (size_t)16 * ldk);
  r.k2 = *(const u32x4*)(kg + (size_t)32 * ldk);
  r.k3 = *(const u32x4*)(kg + (size_t)48 * ldk);
  const bf16_t* vg = vp + (size_t)(tid >> 3) * ldv + (tid & 7) * 8;
  r.v0 = *(const u32x4*)vg;
  r.v1 = *(const u32x4*)(vg + (size_t)32 * ldv);
  r.v2 = *(const u32x4*)(vg + (size_t)64 * ldv);
  r.v3 = *(const u32x4*)(vg + (size_t)96 * ldv);
}
__device__ __forceinline__ void kv_store(const KVRegs& r, char* lk, char* lv) {
  const int tid = opq(threadIdx.x);
  const int row = tid >> 4, ch = tid & 15;
  *(u32x4*)(lk + koff(row, ch)) = r.k0;
  *(u32x4*)(lk + koff(row + 16, ch)) = r.k1;
  *(u32x4*)(lk + koff(row + 32, ch)) = r.k2;
  *(u32x4*)(lk + koff(row + 48, ch)) = r.k3;
  const int vr = tid >> 3, vc = tid & 7;
  *(u32x4*)(lv + lds_off(vr, vc)) = r.v0;
  *(u32x4*)(lv + lds_off(vr + 32, vc)) = r.v1;
  *(u32x4*)(lv + lds_off(vr + 64, vc)) = r.v2;
  *(u32x4*)(lv + lds_off(vr + 96, vc)) = r.v3;
}

struct QFrag { bf16x8 f0, f1, f2, f3, f4, f5, f6, f7; };
__device__ __forceinline__ void q_load(QFrag& q, const bf16_t* qrow) {
  const int h = (opq(threadIdx.x) & 63) >> 5;
  const bf16x8* p8 = (const bf16x8*)(qrow + 8 * h);
  q.f0 = p8[0]; q.f1 = p8[2]; q.f2 = p8[4]; q.f3 = p8[6]; q.f4 = p8[8]; q.f5 = p8[10]; q.f6 = p8[12]; q.f7 = p8[14];
}

__device__ __forceinline__ void qk_tile(const QFrag& q, const char* lk, f32x16& s0, f32x16& s1) {
  const int lane = opq(threadIdx.x) & 63, row = lane & 31, h = lane >> 5;
#pragma unroll
  for (int r = 0; r < 16; ++r) { s0[r] = 0.f; s1[r] = 0.f; }
#define QK_STEP(kk, qf)                                                                  \
  {                                                                                      \
    bf16x8 a0 = *(const bf16x8*)(lk + koff(row, 2 * (kk) + h));                          \
    bf16x8 a1 = *(const bf16x8*)(lk + koff(row + 32, 2 * (kk) + h));                     \
    s0 = __builtin_amdgcn_mfma_f32_32x32x16_bf16(a0, qf, s0, 0, 0, 0);                   \
    s1 = __builtin_amdgcn_mfma_f32_32x32x16_bf16(a1, qf, s1, 0, 0, 0);                   \
  }
  QK_STEP(0, q.f0) QK_STEP(1, q.f1) QK_STEP(2, q.f2) QK_STEP(3, q.f3)
  QK_STEP(4, q.f4) QK_STEP(5, q.f5) QK_STEP(6, q.f6) QK_STEP(7, q.f7)
#undef QK_STEP
}

__device__ __forceinline__ bf16x8 pack8(const f32x16& p, const int base) {
  u32x4 u;
  u[0] = pack2(p[base + 0], p[base + 1]);
  u[1] = pack2(p[base + 2], p[base + 3]);
  u[2] = pack2(p[base + 4], p[base + 5]);
  u[3] = pack2(p[base + 6], p[base + 7]);
  return __builtin_bit_cast(bf16x8, u);
}

struct OAcc { f32x16 o0, o1, o2, o3; };
__device__ __forceinline__ void oacc_zero(OAcc& o) {
#pragma unroll
  for (int r = 0; r < 16; ++r) { o.o0[r] = 0.f; o.o1[r] = 0.f; o.o2[r] = 0.f; o.o3[r] = 0.f; }
}
__device__ __forceinline__ void oacc_scale(OAcc& o, float a) {
#pragma unroll
  for (int r = 0; r < 16; ++r) { o.o0[r] *= a; o.o1[r] *= a; o.o2[r] *= a; o.o3[r] *= a; }
}

__device__ __forceinline__ void pv_tile(OAcc& o, const char* lv, const f32x16& p0, const f32x16& p1) {
  const int lane = opq(threadIdx.x) & 63, row = lane & 31, h = lane >> 5;
  const bf16x8 pf0 = pack8(p0, 0), pf1 = pack8(p0, 8), pf2 = pack8(p1, 0), pf3 = pack8(p1, 8);
#define PV_ROW(dd, acc)                                                                                      \
  {                                                                                                          \
    acc = __builtin_amdgcn_mfma_f32_32x32x16_bf16(*(const bf16x8*)(lv + lds_off(32 * (dd) + row, 0 + h)), pf0, acc, 0, 0, 0); \
    acc = __builtin_amdgcn_mfma_f32_32x32x16_bf16(*(const bf16x8*)(lv + lds_off(32 * (dd) + row, 2 + h)), pf1, acc, 0, 0, 0); \
    acc = __builtin_amdgcn_mfma_f32_32x32x16_bf16(*(const bf16x8*)(lv + lds_off(32 * (dd) + row, 4 + h)), pf2, acc, 0, 0, 0); \
    acc = __builtin_amdgcn_mfma_f32_32x32x16_bf16(*(const bf16x8*)(lv + lds_off(32 * (dd) + row, 6 + h)), pf3, acc, 0, 0, 0); \
  }
  PV_ROW(0, o.o0) PV_ROW(1, o.o1) PV_ROW(2, o.o2) PV_ROW(3, o.o3)
#undef PV_ROW
}

__device__ __forceinline__ void softmax_tile(f32x16& s0, f32x16& s1, float& m, float& l, OAcc& o) {
  float mx = NEG_BIG;
#pragma unroll
  for (int r = 0; r < 16; ++r) mx = fmaxf(mx, fmaxf(s0[r], s1[r]));
  mx = fmaxf(mx, __shfl_xor(mx, 32));
  const float mn = fmaxf(m, mx);
  const float alpha = __expf(m - mn);
  float ls = 0.f;
#pragma unroll
  for (int r = 0; r < 16; ++r) {
    float a = (s0[r] > -1e29f) ? __expf(s0[r] - mn) : 0.f;
    float b = (s1[r] > -1e29f) ? __expf(s1[r] - mn) : 0.f;
    s0[r] = a; s1[r] = b;
    ls += a + b;
  }
  ls += __shfl_xor(ls, 32);
  l = l * alpha + ls;
  m = mn;
  if (__any(alpha != 1.f)) oacc_scale(o, alpha);
}

template <class F>
__device__ __forceinline__ void oacc_foreach(const OAcc& o, F f) {
  const int h = (opq(threadIdx.x) & 63) >> 5;
#pragma unroll
  for (int rho = 0; rho < 4; ++rho) {
    f(0 + 8 * rho + 4 * h, o.o0[4 * rho], o.o0[4 * rho + 1], o.o0[4 * rho + 2], o.o0[4 * rho + 3]);
    f(32 + 8 * rho + 4 * h, o.o1[4 * rho], o.o1[4 * rho + 1], o.o1[4 * rho + 2], o.o1[4 * rho + 3]);
    f(64 + 8 * rho + 4 * h, o.o2[4 * rho], o.o2[4 * rho + 1], o.o2[4 * rho + 2], o.o2[4 * rho + 3]);
    f(96 + 8 * rho + 4 * h, o.o3[4 * rho], o.o3[4 * rho + 1], o.o3[4 * rho + 2], o.o3[4 * rho + 3]);
  }
}

__device__ __forceinline__ void ph_memattn2(const P& p, char* lds) {
  char* lk = lds;
  char* lv = lds + 16384;
  const int lane = opq(threadIdx.x) & 63, wv = opq(threadIdx.x) >> 6;
  for (int item = blockIdx.x; item < NBATCH * 4 * (SEQ / 128); item += gridDim.x) {
    const int tb = item % (SEQ / 128);
    const int bh = item / (SEQ / 128);
    const int b = bh >> 2, hd = bh & 3;
    const int t = tb * 128 + wv * 32 + (lane & 31);
    QFrag q;
    q_load(q, p.qmemb + (size_t)(b * SEQ + t) * 512 + hd * 128);
    const bf16_t* kb = p.kmemb + (size_t)bh * 256 * 128;
    const bf16_t* vb = p.vmemT + (size_t)bh * 128 * 256;
    OAcc o;
    oacc_zero(o);
    float m = NEG_BIG, l = 0.f;
    KVRegs kv;
    kv_load(kv, kb, 128, vb, 256);
#pragma unroll 1
    for (int ti = 0; ti < 4; ++ti) {
      __syncthreads();
      kv_store(kv, lk, lv);
      __syncthreads();
      {
        const int tn = (ti + 1 < 4) ? ti + 1 : 3;
        kv_load(kv, kb + (size_t)tn * 64 * 128, 128, vb + tn * 64, 256);
      }
      f32x16 s0, s1;
      qk_tile(q, lk, s0, s1);
#pragma unroll
      for (int r = 0; r < 16; ++r) { s0[r] *= ATT_SCALE; s1[r] *= ATT_SCALE; }
      softmax_tile(s0, s1, m, l, o);
      pv_tile(o, lv, s0, s1);
    }
    const float il = 1.f / l;
    const int t2 = tb * 128 + (opq(threadIdx.x) >> 6) * 32 + (opq(threadIdx.x) & 31);
    bf16_t* orow = p.omem + (size_t)(b * SEQ + t2) * 512 + hd * 128;
    oacc_foreach(o, [&](int d, float v0, float v1, float v2, float v3) {
      uint2 u;
      u.x = pack2(v0 * il, v1 * il);
      u.y = pack2(v2 * il, v3 * il);
      *(uint2*)(orow + d) = u;
    });
  }
}

__device__ __forceinline__ void ph_sb2(const P& p, char* lds) {
  char* lk = lds;
  char* lv = lds + 16384;
  const int lane = opq(threadIdx.x) & 63, wv = opq(threadIdx.x) >> 6, hh = lane >> 5;
  const int sb_skip = (gridDim.x > 32) ? 16 : 0;
  if ((int)blockIdx.x < sb_skip) return;
  for (int item = (int)blockIdx.x - sb_skip; item < NBATCH * 8 * (SEQ / 128); item += (int)gridDim.x - sb_skip) {
    const int tb = (SEQ / 128 - 1) - (item % (SEQ / 128));
    const int bh = item / (SEQ / 128);
    const int b = bh >> 3, hd = bh & 7;
    const int t0 = tb * 128;
    const int t = t0 + wv * 32 + (lane & 31);
    QFrag q;
    q_load(q, p.qsb + (size_t)(b * SEQ + t) * 1024 + hd * 128);
    const bf16_t* kb = p.ksb + (size_t)bh * SEQ * 128;
    const bf16_t* vb = p.vsbT + (size_t)bh * 128 * SEQ;
    OAcc o;
    oacc_zero(o);
    float carry = 0.f;
    const int jhi = (t0 >> 6) + 1;
    const int jw = (t0 + wv * 32 + 30) >> 6;
    KVRegs kv;
    kv_load(kv, kb + (size_t)jhi * 64 * 128, 128, vb + jhi * 64, SEQ);
    volatile unsigned* dflag = (volatile unsigned*)(lds + 32768);
    __syncthreads();
    if (opq(threadIdx.x) < 4) dflag[opq(threadIdx.x)] = 0u;
    for (int j = jhi; j >= 0; --j) {
      __syncthreads();
      if ((dflag[0] & dflag[1] & dflag[2] & dflag[3]) != 0u) break;
      kv_store(kv, lk, lv);
      __syncthreads();
      const int jn = (j > 0) ? j - 1 : 0;
      if (j > jw) kv_load(kv, kb + (size_t)jn * 64 * 128, 128, vb + jn * 64, SEQ);
      if (j <= jw) {
        f32x16 z0, z1;
        qk_tile(q, lk, z0, z1);
        const int sbase = j * 64 + 4 * hh;
        float gt[8];
        f32x16 l0, l1;
#pragma unroll
        for (int r = 0; r < 16; ++r) {
          const int so = sbase + 8 * (r >> 2) + (r & 3);
          {
            const float z = z0[r] * ATT_SCALE;
            const bool valid = so < t;
            const float lsp = fminf(z, 0.f) - __logf(1.f + __expf(-fabsf(z)));
            l0[r] = valid ? (lsp - z) : 0.f;
            z0[r] = valid ? z : NEG_BIG;
          }
          {
            const float z = z1[r] * ATT_SCALE;
            const bool valid = so + 32 < t;
            const float lsp = fminf(z, 0.f) - __logf(1.f + __expf(-fabsf(z)));
            l1[r] = valid ? (lsp - z) : 0.f;
            z1[r] = valid ? z : NEG_BIG;
          }
        }
#pragma unroll
        for (int rho = 0; rho < 4; ++rho) {
          gt[rho] = (l0[4 * rho] + l0[4 * rho + 1]) + (l0[4 * rho + 2] + l0[4 * rho + 3]);
          gt[4 + rho] = (l1[4 * rho] + l1[4 * rho + 1]) + (l1[4 * rho + 2] + l1[4 * rho + 3]);
        }
        float ag[8];
        float run = 0.f;
#pragma unroll
        for (int k = 7; k >= 0; --k) {
          const float pg = __shfl_xor(gt[k], 32);
          ag[k] = carry + run + (hh == 0 ? pg : 0.f);
          run += gt[k] + pg;
        }
        carry += run;
#pragma unroll
        for (int rho = 0; rho < 4; ++rho) {
          {
            const float x3 = l0[4 * rho + 3], x23 = x3 + l0[4 * rho + 2], x123 = x23 + l0[4 * rho + 1];
            const float g = ag[rho];
            z0[4 * rho + 0] = __expf((l0[4 * rho + 0] + z0[4 * rho + 0]) + (g + x123));
            z0[4 * rho + 1] = __expf((l0[4 * rho + 1] + z0[4 * rho + 1]) + (g + x23));
            z0[4 * rho + 2] = __expf((l0[4 * rho + 2] + z0[4 * rho + 2]) + (g + x3));
            z0[4 * rho + 3] = __expf((l0[4 * rho + 3] + z0[4 * rho + 3]) + g);
          }
          {
            const float x3 = l1[4 * rho + 3], x23 = x3 + l1[4 * rho + 2], x123 = x23 + l1[4 * rho + 1];
            const float g = ag[4 + rho];
            z1[4 * rho + 0] = __expf((l1[4 * rho + 0] + z1[4 * rho + 0]) + (g + x123));
            z1[4 * rho + 1] = __expf((l1[4 * rho + 1] + z1[4 * rho + 1]) + (g + x23));
            z1[4 * rho + 2] = __expf((l1[4 * rho + 2] + z1[4 * rho + 2]) + (g + x3));
            z1[4 * rho + 3] = __expf((l1[4 * rho + 3] + z1[4 * rho + 3]) + g);
          }
        }
        kv_load(kv, kb + (size_t)jn * 64 * 128, 128, vb + jn * 64, SEQ);
        pv_tile(o, lv, z0, z1);
        if (__all(carry < -104.f) && (opq(threadIdx.x) & 63) == 0) dflag[wv] = 1u;
      }
    }
    int t2 = t;
    asm volatile("" : "+v"(t2));
    bf16_t* orow = p.omix + (size_t)(b * SEQ + t2) * DM + 1024 + hd * 128;
    oacc_foreach(o, [&](int d, float v0, float v1, float v2, float v3) {
      uint2 u;
      u.x = pack2(v0, v1);
      u.y = pack2(v2, v3);
      *(uint2*)(orow + d) = u;
    });
  }
}

#define NSA_IMP 32768
#define NSA_KEYS 49152
#define NSA_SELM 53504
#define NSA_LUT 53632
__device__ __forceinline__ void ph_nsa2(const P& p, char* lds) {
  typedef __attribute__((ext_vector_type(4))) float f32x4;
  char* lk = lds;
  char* lv = lds + 16384;
  float* imp = (float*)(lds + NSA_IMP);
  float* keys = (float*)(lds + NSA_KEYS);
  unsigned* selm = (unsigned*)(lds + NSA_SELM);
  const int tid = opq(threadIdx.x), lane = tid & 63, wv = tid >> 6, hh = lane >> 5, ql = lane & 31;
  float* lut = (float*)(lds + NSA_LUT) + wv * 128;
  for (int item = blockIdx.x; item < NBATCH * 2 * (SEQ / 32); item += gridDim.x) {
    const int tt = (item < 256) ? (SEQ / 32 - 1) - (item % (SEQ / 32)) : (item % (SEQ / 32));
    const int bg = item / (SEQ / 32);
    const int b = bg >> 1, g = bg & 1;
    const int h = g * 4 + wv;
    const int t0 = tt * 32, tq = t0 + ql, cur = t0 >> 6;
    __syncthreads();
    QFrag q;
    q_load(q, p.qn + (size_t)(b * SEQ + tq) * 1024 + h * 128);
    {
      const int lo = opq(lane);
      lut[lo] = p.t5[t5_bucket(lo) * 8 + h];
      lut[lo + 64] = p.t5[t5_bucket(lo + 64) * 8 + h];
    }
#pragma unroll
    for (int i = 0; i < 16; ++i) imp[i * 256 + tid] = 0.f;
    if (tid < 32) selm[tid] = 0u;
    const float* grow = p.gates + (size_t)(b * SEQ + tq) * 24 + h * 3;
    float* prow = p.part + (size_t)(b * SEQ + tq) * 1024 + h * 128;
    OAcc o;
    float m, l;
    KVRegs kv;
    {
      const bf16_t* kb = p.kcb + (size_t)bg * 128 * 128;
      const bf16_t* vb = p.vcT + (size_t)bg * 128 * 128;
      oacc_zero(o);
      m = NEG_BIG; l = 0.f;
      kv_load(kv, kb, 128, vb, 128);
      __syncthreads();
      kv_store(kv, lk, lv);
      __syncthreads();
      f32x16 x0, x1;
      qk_tile(q, lk, x0, x1);
      int tqv = tq;
      asm volatile("" : "+v"(tqv));
      tqv -= 64 * hh;
      if (t0 >= 1152) {
        const float b31 = lut[127];
#pragma unroll
        for (int r = 0; r < 16; ++r) { x0[r] = x0[r] * ATT_SCALE + b31; x1[r] = x1[r] * ATT_SCALE + b31; }
      } else {
#pragma unroll
        for (int r = 0; r < 16; ++r) {
          const int c = 8 * (r >> 2) + (r & 3);
          const int d0 = tqv - 16 * c - 31, d1 = d0 - 512;
          x0[r] = (d0 >= 0) ? x0[r] * ATT_SCALE + lut[min(d0, 127)] : NEG_BIG;
          x1[r] = (d1 >= 0) ? x1[r] * ATT_SCALE + lut[min(d1, 127)] : NEG_BIG;
        }
      }
      softmax_tile(x0, x1, m, l, o);
      const float m0 = m;
      pv_tile(o, lv, x0, x1);
      f32x16 z0, z1;
#pragma unroll
      for (int r = 0; r < 16; ++r) { z0[r] = 0.f; z1[r] = 0.f; }
      if (t0 >= 1024) {
        kv_load(kv, kb + 64 * 128, 128, vb + 64, 128);
        __syncthreads();
        kv_store(kv, lk, lv);
        __syncthreads();
        qk_tile(q, lk, z0, z1);
        asm volatile("" : "+v"(tqv));
#pragma unroll
        for (int r = 0; r < 16; ++r) {
          const int c = 64 + 8 * (r >> 2) + (r & 3);
          const int d0 = tqv - 16 * c - 31, d1 = d0 - 512;
          z0[r] = (d0 >= 0) ? z0[r] * ATT_SCALE + lut[min(d0, 127)] : NEG_BIG;
          z1[r] = (d1 >= 0) ? z1[r] * ATT_SCALE + lut[min(d1, 127)] : NEG_BIG;
        }
        softmax_tile(z0, z1, m, l, o);
        pv_tile(o, lv, z0, z1);
      }
      const float inv = 1.f / fmaxf(l, 1e-20f);
      const float c0 = __expf(m0 - m) * inv;
#pragma unroll
      for (int r = 0; r < 16; ++r) {
        const int c = 8 * (r >> 2) + (r & 3) + 4 * hh;
        if (x0[r] != 0.f) atomicAdd(&imp[(c) * 32 + ql], x0[r] * c0);
        if (x1[r] != 0.f) atomicAdd(&imp[(c + 32) * 32 + ql], x1[r] * c0);
        if (z0[r] != 0.f) atomicAdd(&imp[(c + 64) * 32 + ql], z0[r] * inv);
        if (z1[r] != 0.f) atomicAdd(&imp[(c + 96) * 32 + ql], z1[r] * inv);
      }
      const float gs = inv / (1.f + __expf(-grow[0]));
      oacc_foreach(o, [&](int d, float v0, float v1, float v2, float v3) {
        f32x4 u = {v0 * gs, v1 * gs, v2 * gs, v3 * gs};
        *(f32x4*)(prow + d) = u;
      });
    }
    __syncthreads();
    {
      const int tido = opq(tid);
      const int qq = tido & 31, jg = tido >> 5;
#pragma unroll
      for (int jj = 0; jj < 4; ++jj) {
        const int j = jg * 4 + jj;
        float v = imp[(4 * j) * 32 + qq] + imp[(4 * j + 1) * 32 + qq] + imp[(4 * j + 2) * 32 + qq] + 0.5f * imp[(4 * j + 3) * 32 + qq];
        if (j > 0) v += 0.5f * imp[(4 * j - 1) * 32 + qq];
        const bool forced = (j == 0) || (j == cur) || (j == cur - 1);
        keys[qq * 33 + j] = forced ? 1e9f : ((j <= cur) ? v : -1e9f);
      }
      __syncthreads();
      unsigned bits = 0u;
#pragma unroll
      for (int jj = 0; jj < 4; ++jj) {
        const int j = jg * 4 + jj;
        const float kj = keys[qq * 33 + j];
        int rank = 0;
        for (int i = 0; i < 32; ++i) {
          const float ki = keys[qq * 33 + i];
          rank += (ki > kj || (ki == kj && i < j)) ? 1 : 0;
        }
        if (rank < 16 && j <= cur) bits |= 1u << j;
      }
      atomicOr(&selm[qq], bits);
      __syncthreads();
    }
    const unsigned mysel = selm[ql];
    unsigned um = mysel;
#pragma unroll
    for (int o2 = 16; o2 > 0; o2 >>= 1) um |= (unsigned)__shfl_xor((int)um, o2);
    um = (unsigned)__builtin_amdgcn_readfirstlane((int)um);
    {
      const bf16_t* kb = p.ks + (size_t)bg * SEQ * 128;
      const bf16_t* vb = p.vsT + (size_t)bg * 128 * SEQ;
      oacc_zero(o);
      m = NEG_BIG; l = 0.f;
      unsigned rem = um;
      int j = __builtin_ctz(rem);
      kv_load(kv, kb + (size_t)j * 64 * 128, 128, vb + j * 64, SEQ);
      while (rem) {
        j = __builtin_ctz(rem);
        rem &= rem - 1;
        const int jn = rem ? __builtin_ctz(rem) : j;
        __syncthreads();
        kv_store(kv, lk, lv);
        __syncthreads();
        f32x16 s0, s1;
        qk_tile(q, lk, s0, s1);
        const bool selq = (mysel >> j) & 1u;
        int tqv = tq;
        asm volatile("" : "+v"(tqv));
        if (j * 64 + 63 + 113 <= t0) {
          const float sc = selq ? ATT_SCALE : 0.f, bb = selq ? lut[127] : NEG_BIG;
#pragma unroll
          for (int r = 0; r < 16; ++r) { s0[r] = s0[r] * sc + bb; s1[r] = s1[r] * sc + bb; }
        } else {
#pragma unroll
          for (int r = 0; r < 16; ++r) {
            const int d0 = tqv - (j * 64 + 8 * (r >> 2) + (r & 3) + 4 * hh), d1 = d0 - 32;
            s0[r] = (selq && d0 >= 0) ? s0[r] * ATT_SCALE + lut[min(d0, 127)] : NEG_BIG;
            s1[r] = (selq && d1 >= 0) ? s1[r] * ATT_SCALE + lut[min(d1, 127)] : NEG_BIG;
          }
        }
        kv_load(kv, kb + (size_t)jn * 64 * 128, 128, vb + jn * 64, SEQ);
        softmax_tile(s0, s1, m, l, o);
        pv_tile(o, lv, s0, s1);
      }
      const float gs = 1.f / (fmaxf(l, 1e-20f) * (1.f + __expf(-grow[1])));
      int qo = ql;
      asm volatile("" : "+v"(qo));
      float* pr2 = p.part + (size_t)(b * SEQ + t0 + qo) * 1024 + h * 128;
      oacc_foreach(o, [&](int d, float v0, float v1, float v2, float v3) {
        f32x4 u = *(f32x4*)(pr2 + d);
        u[0] += v0 * gs; u[1] += v1 * gs; u[2] += v2 * gs; u[3] += v3 * gs;
        *(f32x4*)(pr2 + d) = u;
      });
    }
    {
      const bf16_t* kb = p.kw + (size_t)bg * SEQ * 128;
      const bf16_t* vb = p.vwT + (size_t)bg * 128 * SEQ;
      oacc_zero(o);
      m = NEG_BIG; l = 0.f;
      int jlo = (t0 - 511) >> 6;
      if (jlo < 0) jlo = 0;
      kv_load(kv, kb + (size_t)jlo * 64 * 128, 128, vb + jlo * 64, SEQ);
      for (int j = jlo; j <= cur; ++j) {
        const int jn = (j < cur) ? j + 1 : j;
        __syncthreads();
        kv_store(kv, lk, lv);
        __syncthreads();
        f32x16 s0, s1;
        qk_tile(q, lk, s0, s1);
        int tqv = tq;
        asm volatile("" : "+v"(tqv));
        if (j * 64 + 63 + 113 <= t0 && t0 + 31 - j * 64 < 512) {
          const float b31 = lut[127];
#pragma unroll
          for (int r = 0; r < 16; ++r) { s0[r] = s0[r] * ATT_SCALE + b31; s1[r] = s1[r] * ATT_SCALE + b31; }
        } else {
#pragma unroll
          for (int r = 0; r < 16; ++r) {
            const int d0 = tqv - (j * 64 + 8 * (r >> 2) + (r & 3) + 4 * hh), d1 = d0 - 32;
            s0[r] = (d0 >= 0 && d0 < 512) ? s0[r] * ATT_SCALE + lut[min(d0, 127)] : NEG_BIG;
            s1[r] = (d1 >= 0 && d1 < 512) ? s1[r] * ATT_SCALE + lut[min(d1, 127)] : NEG_BIG;
          }
        }
        kv_load(kv, kb + (size_t)jn * 64 * 128, 128, vb + jn * 64, SEQ);
        softmax_tile(s0, s1, m, l, o);
        pv_tile(o, lv, s0, s1);
      }
      const float gs = 1.f / (fmaxf(l, 1e-20f) * (1.f + __expf(-grow[2])));
      int qo = ql;
      asm volatile("" : "+v"(qo));
      const float* pr2 = p.part + (size_t)(b * SEQ + t0 + qo) * 1024 + h * 128;
      bf16_t* orow = p.omix + (size_t)(b * SEQ + t0 + qo) * DM + h * 128;
      oacc_foreach(o, [&](int d, float v0, float v1, float v2, float v3) {
        const f32x4 u = *(const f32x4*)(pr2 + d);
        uint2 w;
        w.x = pack2(u[0] + v0 * gs, u[1] + v1 * gs);
        w.y = pack2(u[2] + v2 * gs, u[3] + v3 * gs);
        *(uint2*)(orow + d) = w;
      });
    }
  }
}

__device__ __forceinline__ void ph_cvt(const float* src, bf16_t* dst, size_t n) {
  typedef __attribute__((ext_vector_type(4))) float f32x4;
  const size_t nv = n / 8;
  for (size_t i = (size_t)blockIdx.x * 256 + opq(threadIdx.x); i < nv; i += (size_t)gridDim.x * 256) {
    const f32x4 a = ((const f32x4*)src)[2 * i], b = ((const f32x4*)src)[2 * i + 1];
    u32x4 o;
    o[0] = pack2(a[0], a[1]); o[1] = pack2(a[2], a[3]); o[2] = pack2(b[0], b[1]); o[3] = pack2(b[2], b[3]);
    ((u32x4*)dst)[i] = o;
  }
}

__device__ __forceinline__ void ph_scores(const P& p, char* lds) {
  for (int u = blockIdx.x; u < 64 * 16; u += gridDim.x) {
    const int tm = u & 63, hp = u >> 6;
    const int m0 = tm * 128;
    float* sc = p.scores + (size_t)m0 * DM + hp * 128;
    gemm_tile_bf16<false>(p.omix + (size_t)m0 * DM + hp * 128, DM, p.subkb + (size_t)hp * 128 * 128, 128, 128, lds,
                          [&](int r, int c, float val) { sc[(size_t)r * DM + c] = val; });
  }
}

__device__ __forceinline__ void ph_qp_scores(const P& p, char* lds) {
  const int ntm = T_TOK / 128, ntn = DM / 128;
  const int npm = (ntm + 7) / 8, npn = (ntn + 7) / 8;
  const int nslots = ((npm * npn * 64 + 511) / 512) * 512;
  for (int u = blockIdx.x; u < nslots; u += gridDim.x) {
    int v = (u & 7) * 64 + ((u >> 3) & 63) + (u & ~511);
    int patch = v >> 6, w = v & 63;
    int tm = (patch % npm) * 8 + (w & 7);
    int tn = (patch / npm) * 8 + (w >> 3);
    if (tm >= ntm || tn >= ntn) continue;
    const int m0 = tm * 128, n0 = tn * 128;
    bf16_t* qp = p.omix + (size_t)m0 * DM + n0;
    const float* rss = p.rowss + T_TOK + m0;
    gemm_tile_bf16<false, true>(p.hn + (size_t)m0 * DM, DM, p.WpqT + (size_t)n0 * DM, DM, DM, lds,
                                [&](int r, int c, f32x4_e lo, f32x4_e hi) {
                                  const float rs = rsqrtf(rss[r] * (1.f / DM) + RMS_EPS);
                                  st_bf16x8(qp + (size_t)r * DM + c, lo * rs, hi * rs); });
    __threadfence_block();
    __syncthreads();
    float* sc = p.scores + (size_t)m0 * DM + n0;
    gemm_tile_bf16<false, true>(qp, DM, p.subkb + (size_t)tn * 128 * 128, 128, 128, lds,
                                [&](int r, int c, f32x4_e lo, f32x4_e hi) {
                                  *(f32x4_e*)(sc + (size_t)r * DM + c) = lo; *(f32x4_e*)(sc + (size_t)r * DM + c + 4) = hi; });
  }
}

__device__ __forceinline__ void ph_cvt4(const float* src, unsigned char* dst, float* scales, int nrows, int wid0, int nw) {
  typedef __attribute__((ext_vector_type(4))) float f32x4;
  typedef __attribute__((ext_vector_type(2))) float f32x2;
  const int lane = opq(threadIdx.x) & 63;
  const float one = __uint_as_float((unsigned)opq(0x3F800000));
  float lev[8];
#pragma unroll
  for (int c = 0; c < 8; ++c) {
    const f32x2 q = __builtin_amdgcn_cvt_scalef32_pk_f32_fp4((unsigned)opq(c * 0x11111111), one, 0);
    lev[c] = fabsf(q[0]);
  }
  const float maxlev = lev[7];
  for (int row = wid0; row < nrows; row += nw) {
    const f32x4* s4 = (const f32x4*)(src + (size_t)row * DM) + lane * 8;
    f32x4 v[8];
    float amax = 0.f;
#pragma unroll
    for (int i = 0; i < 8; ++i) {
      v[i] = s4[i];
#pragma unroll
      for (int k = 0; k < 4; ++k) amax = fmaxf(amax, fabsf(v[i][k]));
    }
    amax = wave_max(amax);
    const float sc = (amax > 0.f) ? maxlev / amax : 1.f;
    u32x4 o;
#pragma unroll
    for (int w = 0; w < 4; ++w) {
      unsigned pk = 0u;
      pk = __builtin_amdgcn_cvt_scalef32_pk_fp4_f32(pk, v[2 * w][0] * sc, v[2 * w][1] * sc, 1.0f, 0);
      pk = __builtin_amdgcn_cvt_scalef32_pk_fp4_f32(pk, v[2 * w][2] * sc, v[2 * w][3] * sc, 1.0f, 1);
      pk = __builtin_amdgcn_cvt_scalef32_pk_fp4_f32(pk, v[2 * w + 1][0] * sc, v[2 * w + 1][1] * sc, 1.0f, 2);
      pk = __builtin_amdgcn_cvt_scalef32_pk_fp4_f32(pk, v[2 * w + 1][2] * sc, v[2 * w + 1][3] * sc, 1.0f, 3);
      o[w] = pk;
    }
    *(u32x4*)(dst + (size_t)row * 1024 + lane * 16) = o;
    if (lane == 0) scales[row] = (amax > 0.f) ? amax / maxlev : 1.f;
  }
}

__device__ __forceinline__ u32x4 r4_load(const unsigned char* tab, int eid, int lane) {
  return *((const u32x4*)(tab + (size_t)eid * 1024) + lane);
}
struct XPk { f32x16 a, b; };
struct Acc32 { f32x16 a, b; };

#define R4_DOT_W(word, xv, base, pa, pb)                                                             \
  {                                                                                                  \
    typedef __attribute__((ext_vector_type(2))) float f32x2;                                         \
    const f32x2 q0 = __builtin_amdgcn_cvt_scalef32_pk_f32_fp4(word, one, 0), q1 = __builtin_amdgcn_cvt_scalef32_pk_f32_fp4(word, one, 1); \
    const f32x2 q2 = __builtin_amdgcn_cvt_scalef32_pk_f32_fp4(word, one, 2), q3 = __builtin_amdgcn_cvt_scalef32_pk_f32_fp4(word, one, 3); \
    pa += q0[0] * xv[base + 0] + q0[1] * xv[base + 1]; pb += q1[0] * xv[base + 2] + q1[1] * xv[base + 3]; \
    pa += q2[0] * xv[base + 4] + q2[1] * xv[base + 5]; pb += q3[0] * xv[base + 6] + q3[1] * xv[base + 7]; \
  }
__device__ __forceinline__ float r4_dot(const u32x4& e, const XPk& x) {
  const float one = __uint_as_float((unsigned)opq(0x3F800000));
  float pa = 0.f, pb = 0.f;
  R4_DOT_W(e[0], x.a, 0, pa, pb) R4_DOT_W(e[1], x.a, 8, pa, pb) R4_DOT_W(e[2], x.b, 0, pa, pb) R4_DOT_W(e[3], x.b, 8, pa, pb)
  return pa + pb;
}
#define R4_AXPY_W(word, accv, base)                                                                  \
  {                                                                                                  \
    typedef __attribute__((ext_vector_type(2))) float f32x2;                                         \
    const f32x2 q0 = __builtin_amdgcn_cvt_scalef32_pk_f32_fp4(word, one, 0), q1 = __builtin_amdgcn_cvt_scalef32_pk_f32_fp4(word, one, 1); \
    const f32x2 q2 = __builtin_amdgcn_cvt_scalef32_pk_f32_fp4(word, one, 2), q3 = __builtin_amdgcn_cvt_scalef32_pk_f32_fp4(word, one, 3); \
    accv[base + 0] += hid * q0[0]; accv[base + 1] += hid * q0[1]; accv[base + 2] += hid * q1[0]; accv[base + 3] += hid * q1[1]; \
    accv[base + 4] += hid * q2[0]; accv[base + 5] += hid * q2[1]; accv[base + 6] += hid * q3[0]; accv[base + 7] += hid * q3[1]; \
  }
__device__ __forceinline__ void r4_axpy(const u32x4& e, float hid, Acc32& acc) {
  const float one = __uint_as_float((unsigned)opq(0x3F800000));
  R4_AXPY_W(e[0], acc.a, 0) R4_AXPY_W(e[1], acc.a, 8) R4_AXPY_W(e[2], acc.b, 0) R4_AXPY_W(e[3], acc.b, 8)
}

#define INS16(K, x)                                                                                      \
  K##15 = __builtin_amdgcn_fmed3f(K##15, K##14, x); K##14 = __builtin_amdgcn_fmed3f(K##14, K##13, x);   \
  K##13 = __builtin_amdgcn_fmed3f(K##13, K##12, x); K##12 = __builtin_amdgcn_fmed3f(K##12, K##11, x);   \
  K##11 = __builtin_amdgcn_fmed3f(K##11, K##10, x); K##10 = __builtin_amdgcn_fmed3f(K##10, K##9, x);    \
  K##9 = __builtin_amdgcn_fmed3f(K##9, K##8, x); K##8 = __builtin_amdgcn_fmed3f(K##8, K##7, x);         \
  K##7 = __builtin_amdgcn_fmed3f(K##7, K##6, x); K##6 = __builtin_amdgcn_fmed3f(K##6, K##5, x);         \
  K##5 = __builtin_amdgcn_fmed3f(K##5, K##4, x); K##4 = __builtin_amdgcn_fmed3f(K##4, K##3, x);         \
  K##3 = __builtin_amdgcn_fmed3f(K##3, K##2, x); K##2 = __builtin_amdgcn_fmed3f(K##2, K##1, x);         \
  K##1 = __builtin_amdgcn_fmed3f(K##1, K##0, x); K##0 = fmaxf(K##0, x);
#define DECL16(K) float K##0 = -INFINITY, K##1 = -INFINITY, K##2 = -INFINITY, K##3 = -INFINITY, K##4 = -INFINITY, \
  K##5 = -INFINITY, K##6 = -INFINITY, K##7 = -INFINITY, K##8 = -INFINITY, K##9 = -INFINITY, K##10 = -INFINITY,   \
  K##11 = -INFINITY, K##12 = -INFINITY, K##13 = -INFINITY, K##14 = -INFINITY, K##15 = -INFINITY;
__device__ __forceinline__ float mkkey(float v, unsigned tag, unsigned mask) {
  return __uint_as_float((__float_as_uint(v) & ~mask) | tag);
}

__device__ __forceinline__ void ph_peer(const P& p, float* smem) {
  typedef __attribute__((ext_vector_type(4))) float f32x4;
  float* lists = smem;
  int* bexA = (int*)(smem + 4096);
  float* bgtA = smem + 6144;
  float* bsuA = smem + 8192;
  for (int item = blockIdx.x; item < T_TOK / 16; item += gridDim.x) {
    const int t0 = item * 16;
    __syncthreads();
    {
      const int tid = opq(threadIdx.x);
      const int tl = tid >> 4, hp = tid & 15;
      const f32x4* sp = (const f32x4*)(p.scores + (size_t)(t0 + tl) * DM + hp * 128);
      DECL16(k)
#pragma unroll 4
      for (int c4 = 0; c4 < 32; ++c4) {
        const f32x4 v = sp[c4];
#pragma unroll
        for (int e = 0; e < 4; ++e) {
          const float x = mkkey(v[e], 127u - (unsigned)(c4 * 4 + e), 127u);
          INS16(k, x)
        }
      }
      f32x4* lp = (f32x4*)(lists + (size_t)opq(threadIdx.x) * 16);
      f32x4 o0 = {k0, k1, k2, k3}, o1 = {k4, k5, k6, k7}, o2 = {k8, k9, k10, k11}, o3 = {k12, k13, k14, k15};
      lp[0] = o0; lp[1] = o1; lp[2] = o2; lp[3] = o3;
    }
    __syncthreads();
    if (opq(threadIdx.x) < 128) {
      const int tid = opq(threadIdx.x);
      const int tl = tid >> 3, h = tid & 7;
      const float* la = lists + (size_t)(tl * 16 + 2 * h) * 16;
      const float* lb = la + 16;
      float av[16], bv[16];
#pragma unroll
      for (int i = 0; i < 16; ++i) {
        av[i] = __uint_as_float(__float_as_uint(la[i]) & ~127u);
        bv[i] = __uint_as_float(__float_as_uint(lb[i]) & ~127u);
      }
      DECL16(c)
#pragma unroll
      for (int i = 0; i < 16; ++i) {
#pragma unroll
        for (int j = 0; j < 16; ++j) {
          if ((i + 1) * (j + 1) <= 16) {
            const float x = mkkey(av[i] + bv[j], 255u - (unsigned)(i * 16 + j), 255u);
            INS16(c, x)
          }
        }
      }
      float cs[16] = {c0, c1, c2, c3, c4, c5, c6, c7, c8, c9, c10, c11, c12, c13, c14, c15};
      float ev[16];
      float sum = 0.f;
      const float mx = __uint_as_float(__float_as_uint(cs[0]) & ~255u);
#pragma unroll
      for (int n = 0; n < 16; ++n) {
        ev[n] = __expf(__uint_as_float(__float_as_uint(cs[n]) & ~255u) - mx);
        sum += ev[n];
      }
      const float isum = 1.f / sum;
#pragma unroll
      for (int n = 0; n < 16; ++n) {
        const unsigned cc = 255u - (__float_as_uint(cs[n]) & 255u);
        const unsigned ka = 127u - (__float_as_uint(la[cc >> 4]) & 127u);
        const unsigned kb = 127u - (__float_as_uint(lb[cc & 15u]) & 127u);
        const int eid = (int)(ka * 128u + kb);
        bexA[tl * 128 + h * 16 + n] = eid;
        bgtA[tl * 128 + h * 16 + n] = ev[n] * isum * p.sv8[eid];
        bsuA[tl * 128 + h * 16 + n] = p.su8[eid];
      }
    }
    __syncthreads();
#pragma unroll 1
    for (int ti4 = 0; ti4 < 4; ++ti4) {
    const int lane = opq(threadIdx.x) & 63, wv = opq(threadIdx.x) >> 6;
    const int tl = wv * 4 + ti4;
    const int t = t0 + tl;
    const int* bex = bexA + tl * 128;
    const float* bgt = bgtA + tl * 128;
    const float* bsu = bsuA + tl * 128;
    XPk x;
    {
      const f32x4* s4 = (const f32x4*)(p.out + (size_t)t * DM) + lane * 8;
      const f32x4* g4 = (const f32x4*)p.norm_ffn + lane * 8;
      f32x4 a0 = s4[0], a1 = s4[1], a2 = s4[2], a3 = s4[3], a4 = s4[4], a5 = s4[5], a6 = s4[6], a7 = s4[7];
      float ss = 0.f;
#define SSQ(v) ss += v[0] * v[0] + v[1] * v[1] + v[2] * v[2] + v[3] * v[3];
      SSQ(a0) SSQ(a1) SSQ(a2) SSQ(a3) SSQ(a4) SSQ(a5) SSQ(a6) SSQ(a7)
#undef SSQ
      ss = wave_sum(ss);
      const float rs = rsqrtf(ss * (1.f / DM) + RMS_EPS);
#define XPK(dst, base, va, vb, gi)                                                    \
  {                                                                                   \
    const f32x4 ga = g4[gi], gb = g4[gi + 1];                                         \
    dst[base + 0] = bf2f(f2bf(va[0] * rs * ga[0])); dst[base + 1] = bf2f(f2bf(va[1] * rs * ga[1]));   \
    dst[base + 2] = bf2f(f2bf(va[2] * rs * ga[2])); dst[base + 3] = bf2f(f2bf(va[3] * rs * ga[3]));   \
    dst[base + 4] = bf2f(f2bf(vb[0] * rs * gb[0])); dst[base + 5] = bf2f(f2bf(vb[1] * rs * gb[1]));   \
    dst[base + 6] = bf2f(f2bf(vb[2] * rs * gb[2])); dst[base + 7] = bf2f(f2bf(vb[3] * rs * gb[3]));   \
  }
      XPK(x.a, 0, a0, a1, 0) XPK(x.a, 8, a2, a3, 2) XPK(x.b, 0, a4, a5, 4) XPK(x.b, 8, a6, a7, 6)
#undef XPK
    }
    Acc32 acc;
#pragma unroll
    for (int r = 0; r < 16; ++r) { acc.a[r] = 0.f; acc.b[r] = 0.f; }
    u32x4 u0 = r4_load(p.pu8, bex[0], lane), u1 = r4_load(p.pu8, bex[1], lane), u2 = r4_load(p.pu8, bex[2], lane), u3 = r4_load(p.pu8, bex[3], lane);
    u32x4 v0 = r4_load(p.pv8, bex[0], lane), v1 = r4_load(p.pv8, bex[1], lane), v2 = r4_load(p.pv8, bex[2], lane), v3 = r4_load(p.pv8, bex[3], lane);
#pragma unroll 1
    for (int e0 = 0; e0 < 128; e0 += 4) {
      float d0 = r4_dot(u0, x), d1 = r4_dot(u1, x), d2 = r4_dot(u2, x), d3 = r4_dot(u3, x);
      const int en = (e0 + 4 < 128) ? e0 + 4 : 124;
      const int i0 = bex[en], i1 = bex[en + 1], i2 = bex[en + 2], i3 = bex[en + 3];
      u0 = r4_load(p.pu8, i0, lane); u1 = r4_load(p.pu8, i1, lane); u2 = r4_load(p.pu8, i2, lane); u3 = r4_load(p.pu8, i3, lane);
#pragma unroll
      for (int o = 32; o > 0; o >>= 1) {
        d0 += __shfl_xor(d0, o); d1 += __shfl_xor(d1, o); d2 += __shfl_xor(d2, o); d3 += __shfl_xor(d3, o);
      }
      { const float hid = bgt[e0 + 0] * gelu_fast(d0 * bsu[e0 + 0]); r4_axpy(v0, hid, acc); }
      { const float hid = bgt[e0 + 1] * gelu_fast(d1 * bsu[e0 + 1]); r4_axpy(v1, hid, acc); }
      { const float hid = bgt[e0 + 2] * gelu_fast(d2 * bsu[e0 + 2]); r4_axpy(v2, hid, acc); }
      { const float hid = bgt[e0 + 3] * gelu_fast(d3 * bsu[e0 + 3]); r4_axpy(v3, hid, acc); }
      v0 = r4_load(p.pv8, i0, lane); v1 = r4_load(p.pv8, i1, lane); v2 = r4_load(p.pv8, i2, lane); v3 = r4_load(p.pv8, i3, lane);
    }
    const int lane2 = opq(lane);
    f32x4* o4 = (f32x4*)(p.out + (size_t)t * DM) + lane2 * 8;
    const f32x4* g4 = (const f32x4*)p.norm_final + lane2 * 8;
    f32x4 hv[8];
    float ss = 0.f;
#pragma unroll
    for (int i = 0; i < 8; ++i) {
      hv[i] = o4[i];
#pragma unroll
      for (int k = 0; k < 4; ++k) {
        hv[i][k] += (i < 4) ? acc.a[4 * i + k] : acc.b[4 * (i - 4) + k];
        ss += hv[i][k] * hv[i][k];
      }
    }
    ss = wave_sum(ss);
    const float rs = rsqrtf(ss * (1.f / DM) + RMS_EPS);
#pragma unroll
    for (int i = 0; i < 8; ++i) {
      const f32x4 g = g4[i];
      f32x4 o;
#pragma unroll
      for (int k = 0; k < 4; ++k) o[k] = hv[i][k] * rs * g[k];
      o4[i] = o;
    }
    }
  }
}

#define XB_TMO      128
#define XB_XCNT(j)  (256  + 64 * (j))
#define XB_XSUB(j)  (1280 + 64 * (j))
#define XB_XGEN(j)  (2304 + 64 * (j))
#define XB_TOP      3328
#define XB_TOPGEN   3392
#define XCD_BAR_WORDS 3456
#define XB_SPIN_CAP (1u << 22)
#define LAS __attribute__((address_space(3)))
__device__ __forceinline__ unsigned xb_ld(unsigned* p) { return __hip_atomic_load(p, __ATOMIC_RELAXED, __HIP_MEMORY_SCOPE_AGENT); }
__device__ __forceinline__ unsigned xb_add(unsigned* p, unsigned v) { return __hip_atomic_fetch_add(p, v, __ATOMIC_RELAXED, __HIP_MEMORY_SCOPE_AGENT); }
__device__ __forceinline__ unsigned xb_xcc_id() { return (unsigned)__builtin_amdgcn_s_getreg((3 << 11) | 20) & 0xFu; }
#define XB_SPIN(cond, bar) do { unsigned _sp = 0; while (cond) { __builtin_amdgcn_s_sleep(1); \
    if ((++_sp & 255u) == 0u) { if (xb_ld(&(bar)[XB_TMO])) break; if (_sp > XB_SPIN_CAP) { atomicAdd(&(bar)[XB_TMO], 1u); break; } } } } while (0)
struct XcdBarrier { unsigned* bar; unsigned x; volatile LAS unsigned* st; };
__device__ __forceinline__ XcdBarrier xcd_barrier_post(unsigned* bar, volatile LAS unsigned* st) {
  XcdBarrier b; b.bar = bar; b.x = xb_xcc_id(); b.st = st;
  if (threadIdx.x == 0) (void)xb_add(&bar[XB_XCNT(b.x)], 1u);
  return b;
}
__device__ __forceinline__ void xcd_barrier_complete(unsigned* bar, unsigned x, unsigned& nloc, unsigned& nx) {
  const unsigned G = gridDim.x * gridDim.y * gridDim.z;
  unsigned sum, cnt, mine, sp = 0u;
  for (;;) {
    sum = 0u; cnt = 0u; mine = 0u;
#pragma unroll
    for (unsigned j = 0; j < 16; ++j) { const unsigned c = xb_ld(&bar[XB_XCNT(j)]); sum += c; cnt += (c > 0u) ? 1u : 0u; mine = (j == x) ? c : mine; }
    if (sum == G) break;
    __builtin_amdgcn_s_sleep(1);
    if ((++sp & 255u) == 0u) { if (xb_ld(&bar[XB_TMO])) break; if (sp > XB_SPIN_CAP) { atomicAdd(&bar[XB_TMO], 1u); break; } }
  }
  nloc = mine > 0u ? mine : 1u; nx = cnt > 0u ? cnt : 1u;
}
__device__ __forceinline__ void xcd_barrier(const XcdBarrier& b) {
  asm volatile("s_waitcnt vmcnt(0)" ::: "memory");
  __syncthreads();
  if (threadIdx.x == 0) {
    unsigned* bar = b.bar;
    __builtin_amdgcn_s_waitcnt(0);
    unsigned nloc = b.st[0], nx = b.st[1];
    if (nloc == 0u) { xcd_barrier_complete(bar, b.x, nloc, nx); b.st[0] = nloc; b.st[1] = nx; }
    const unsigned old = xb_add(&bar[XB_XSUB(b.x)], 1u);
    const unsigned gen = old / nloc;
    if (old + 1u == (gen + 1u) * nloc) {
      __builtin_amdgcn_fence(__ATOMIC_RELEASE, "agent");
      asm volatile("s_waitcnt vmcnt(0)" ::: "memory");
      const unsigned og = xb_add(&bar[XB_TOP], 1u);
      const unsigned tg = og / nx;
      if (og + 1u == (tg + 1u) * nx) xb_add(&bar[XB_TOPGEN], 1u);
      else XB_SPIN(xb_ld(&bar[XB_TOPGEN]) == tg, bar);
      __builtin_amdgcn_fence(__ATOMIC_ACQUIRE, "agent");
      xb_add(&bar[XB_XGEN(b.x)], 1u);
      asm volatile("s_waitcnt vmcnt(0)" ::: "memory");
    } else {
      XB_SPIN(xb_ld(&bar[XB_XGEN(b.x)]) == gen, bar);
      __builtin_amdgcn_fence(__ATOMIC_ACQUIRE, "agent");
      asm volatile("s_waitcnt vmcnt(0)" ::: "memory");
    }
  }
  __syncthreads();
}

typedef const __attribute__((address_space(4))) P* KP;
__device__ __forceinline__ P loadP() {
#if defined(__HIP_DEVICE_COMPILE__)
  KP k = (KP)__builtin_amdgcn_kernarg_segment_ptr();
  asm volatile("" : "+s"(k));
  P p = *k;
  return p;
#else
  return P{};
#endif
}

__global__ void __launch_bounds__(256, 2) mega(P p_arg) {
  cg::grid_group grid = cg::this_grid();
  __shared__ __attribute__((aligned(16))) float smem[16384];
  char* lds = (char*)smem;
  __shared__ uint4 xb_words;
  if (threadIdx.x == 0) xb_words = make_uint4(0u, 0u, 0u, 0u);
  if (blockIdx.x == 0) {
    P p = loadP();
    for (int i = threadIdx.x; i < XCD_BAR_WORDS; i += 256) p.bar[i] = 0u;
  }
  { P p = loadP(); ph_rmsnorm(p.x, p.norm_mix, p.hn, T_TOK); ph_rmsnorm(p.mem, p.norm_mkv, p.memn, 1024); }
  { P p = loadP(); ph_transpose<true>(smem, p.w_in, DM, INC, 5760, p.WinT); }
  { P p = loadP(); ph_transpose<false>(smem, p.w_mk, DM, 512, 512, p.WmkT); }
  { P p = loadP(); ph_transpose<false>(smem, p.w_mv, DM, 512, 512, p.WmvT); }
  { P p = loadP(); ph_cvt(p.subk, p.subkb, (size_t)16 * 128 * 128); }
  { P p = loadP(); ph_transpose<false>(smem, p.w1_k, 4096, 128, 128, p.w1T); }
  { P p = loadP(); ph_transpose<false>(smem, p.w1_v, 4096, 128, 128, p.w1T + 128 * 4096); }
  { P p = loadP(); ph_transpose<false>(smem, p.w2_k, 128, 128, 128, p.w2T); }
  { P p = loadP(); ph_transpose<false>(smem, p.w2_v, 128, 128, 128, p.w2T + 128 * 128); }
  { P p = loadP(); ph_posb(p); }
  { P p = loadP(); for (int i = blockIdx.x * 256 + opq(threadIdx.x); i < 2 * T_TOK; i += gridDim.x * 256) p.rowss[i] = 0.f; }
  grid.sync();
  XcdBarrier xb;
  { P p = loadP(); xb = xcd_barrier_post(p.bar, (volatile LAS unsigned*)&xb_words); }
  { P p = loadP(); ph_proj(p, lds); }
  const int kvb = (gridDim.x == 512) ? (((int)blockIdx.x >= 320 && (int)blockIdx.x < 352) ? ((int)blockIdx.x - 320) * 8 : -1) : -2;
  const int vvb = (gridDim.x == 512) ? (((int)blockIdx.x >= 352 && (int)blockIdx.x < 384) ? ((int)blockIdx.x - 352) * 8 : -1) : -2;
  { P p = loadP(); bf16_t* kmem = p.kmemb;
    ph_gemm_bf16(p.memn, DM, p.WmkT, DM, 1024, 512, DM, lds, [=](int m, int n, float v) {
      kmem[((size_t)((m >> 8) * 4 + (n >> 7)) * 256 + (m & 255)) * 128 + (n & 127)] = f2bf(v); }, kvb); }
  { P p = loadP(); bf16_t* vmem = p.vmemT;
    ph_gemm_bf16(p.memn, DM, p.WmvT, DM, 1024, 512, DM, lds, [=](int m, int n, float v) {
      vmem[((size_t)((m >> 8) * 4 + (n >> 7)) * 128 + (n & 127)) * 256 + perm16(m & 255)] = f2bf(v); }, vvb); }
  xcd_barrier(xb);
  { P p = loadP(); ph_compress2(p, lds); }
  { P p = loadP(); ph_sb2(p, lds); }
  {
    const int skip = (gridDim.x > 32) ? 16 : 0;
    const int vb = ((int)blockIdx.x >= skip) ? (int)blockIdx.x - skip : -1, nvb = (int)gridDim.x - skip;
    __syncthreads();
    { P p = loadP(); ph_transpose<false>(smem, p.w_out, DM, DM, DM, p.WoutT, vb, nvb); }
    { P p = loadP(); ph_transpose<false>(smem, p.w_mq, DM, 512, 512, p.WmqT, vb, nvb); }
  }
  xcd_barrier(xb);
  { P p = loadP(); ph_nsa2(p, lds); }
  xcd_barrier(xb);
  { P p = loadP(); float* out = p.out; const float* x = p.x; const float* gmq = p.norm_mq; bf16_t* hn = p.hn; float* rss = p.rowss;
    ph_gemm_bf16<true>(p.omix, DM, p.WoutT, DM, T_TOK, DM, DM, lds, [=](int m, int n, f32x4_e lo, f32x4_e hi) {
      const f32x4_e x0 = *(const f32x4_e*)(x + (size_t)m * DM + n), x1 = *(const f32x4_e*)(x + (size_t)m * DM + n + 4);
      const f32x4_e h0 = x0 + lo, h1 = x1 + hi;
      *(f32x4_e*)(out + (size_t)m * DM + n) = h0; *(f32x4_e*)(out + (size_t)m * DM + n + 4) = h1;
      norm_feed(h0, h1, gmq, n, hn + (size_t)m * DM, rss + m); }); }
  xcd_barrier(xb);
  if (blockIdx.x < 256 || gridDim.x < 512) {
    P p = loadP(); bf16_t* qmem = p.qmemb; const float* rss = p.rowss;
    ph_gemm_bf16<true>(p.hn, DM, p.WmqT, DM, T_TOK, 512, DM, lds, [=](int m, int n, f32x4_e lo, f32x4_e hi) {
      const float rs = rsqrtf(rss[m] * (1.f / DM) + RMS_EPS);
      st_bf16x8(qmem + (size_t)m * 512 + n, lo * rs, hi * rs); });
  }
  {
    const int half = (gridDim.x >= 512) ? 256 : 0;
    if ((int)blockIdx.x >= half) {
      const int nwv = ((int)gridDim.x - half) * 4, wid = ((int)blockIdx.x - half) * 4 + (opq(threadIdx.x) >> 6);
      { P p = loadP(); ph_cvt4(p.pu, p.pu8, p.su8, 16384, wid, nwv); }
      if (gridDim.x < 512) { P p = loadP(); ph_cvt4(p.pv, p.pv8, p.sv8, 16384, wid, nwv); }
      __syncthreads();
      { P p = loadP(); ph_transpose<false>(smem, p.w_mo, 512, DM, DM, p.WmoT, (int)blockIdx.x - half, (int)gridDim.x - half); }
    }
  }
  xcd_barrier(xb);
  { P p = loadP(); ph_memattn2(p, lds); }
  if (gridDim.x >= 512 && blockIdx.x >= 256) {
    const int nwv = ((int)gridDim.x - 256) * 4, wid = ((int)blockIdx.x - 256) * 4 + (opq(threadIdx.x) >> 6);
    { P p = loadP(); ph_cvt4(p.pv, p.pv8, p.sv8, 16384, wid, nwv); }
  }
  {
    const int half = (gridDim.x >= 512) ? 256 : 0;
    __syncthreads();
    P p = loadP(); ph_transpose<false>(smem, p.w_pq, DM, DM, DM, p.WpqT, ((int)blockIdx.x >= half) ? (int)blockIdx.x - half : -1, (int)gridDim.x - half);
  }
  xcd_barrier(xb);
  { P p = loadP(); float* out = p.out; const float* gffn = p.norm_ffn; bf16_t* hn = p.hn; float* rss = p.rowss + T_TOK;
    ph_gemm_bf16<true>(p.omem, 512, p.WmoT, 512, T_TOK, DM, 512, lds, [=](int m, int n, f32x4_e lo, f32x4_e hi) {
      f32x4_e* o0 = (f32x4_e*)(out + (size_t)m * DM + n);
      const f32x4_e h0 = o0[0] + lo, h1 = o0[1] + hi;
      o0[0] = h0; o0[1] = h1;
      norm_feed(h0, h1, gffn, n, hn + (size_t)m * DM, rss + m); }); }
  xcd_barrier(xb);
  { P p = loadP(); ph_qp_scores(p, lds); }
  xcd_barrier(xb);
  { P p = loadP(); ph_peer(p, smem); }
}

extern "C" void kernel_launch(void* const* d_in, const int* in_sizes, int n_in, void* d_out, int out_size, void* d_ws,
                              size_t ws_size, hipStream_t stream) {
  P p{};
  p.x = (const float*)d_in[0]; p.mem = (const float*)d_in[1]; p.t5 = (const float*)d_in[2];
  p.norm_mix = (const float*)d_in[3]; p.w_in = (const float*)d_in[4]; p.pos_k = (const float*)d_in[5];
  p.w1_k = (const float*)d_in[6]; p.w2_k = (const float*)d_in[7]; p.pos_v = (const float*)d_in[8];
  p.w1_v = (const float*)d_in[9]; p.w2_v = (const float*)d_in[10]; p.w_out = (const float*)d_in[11];
  p.norm_mq = (const float*)d_in[12]; p.norm_mkv = (const float*)d_in[13]; p.w_mq = (const float*)d_in[14];
  p.w_mk = (const float*)d_in[15]; p.w_mv = (const float*)d_in[16]; p.w_mo = (const float*)d_in[17];
  p.norm_ffn = (const float*)d_in[18]; p.w_pq = (const float*)d_in[19]; p.subk = (const float*)d_in[20];
  p.pu = (const float*)d_in[21]; p.pv = (const float*)d_in[22]; p.norm_final = (const float*)d_in[23];
  p.out = (float*)d_out;
  char* w = (char*)d_ws;
  size_t off = 0;
  auto take = [&](size_t bytes) { char* r = w + off; off += (bytes + 255) & ~(size_t)255; return r; };
  p.bar = (unsigned*)take(XCD_BAR_WORDS * 4);
  p.scores = (float*)take((size_t)T_TOK * DM * 4);
  p.gates = (float*)take((size_t)T_TOK * 24 * 4);
  p.part = (float*)take((size_t)T_TOK * 1024 * 4);
  p.posb = (float*)take(256 * 4);
  p.rowss = (float*)take((size_t)2 * T_TOK * 4);
  p.qn = (bf16_t*)take((size_t)T_TOK * 1024 * 2);
  p.kcin = (bf16_t*)take((size_t)T_TOK * 256 * 2 + 65536);
  p.vcin = (bf16_t*)take((size_t)T_TOK * 256 * 2 + 65536);
  p.ks = (bf16_t*)take((size_t)T_TOK * 256 * 2);
  p.vsT = (bf16_t*)take((size_t)T_TOK * 256 * 2);
  p.kw = (bf16_t*)take((size_t)T_TOK * 256 * 2);
  p.vwT = (bf16_t*)take((size_t)T_TOK * 256 * 2);
  p.kcb = (bf16_t*)take((size_t)8 * 128 * 128 * 2);
  p.vcT = (bf16_t*)take((size_t)8 * 128 * 128 * 2);
  p.c1 = (bf16_t*)take((size_t)16 * 128 * 128 * 2);
  p.w1T = (bf16_t*)take((size_t)2 * 128 * 4096 * 2);
  p.w2T = (bf16_t*)take((size_t)2 * 128 * 128 * 2);
  p.hn = (bf16_t*)take((size_t)T_TOK * DM * 2);
  p.omix = (bf16_t*)take((size_t)T_TOK * DM * 2);
  p.memn = (bf16_t*)take((size_t)1024 * DM * 2);
  p.omem = (bf16_t*)take((size_t)T_TOK * 512 * 2);
  p.WinT = (bf16_t*)take((size_t)5760 * DM * 2);
  p.WoutT = (bf16_t*)take((size_t)DM * DM * 2);
  p.WpqT = (bf16_t*)take((size_t)DM * DM * 2);
  p.WmqT = (bf16_t*)take((size_t)512 * DM * 2);
  p.WmkT = (bf16_t*)take((size_t)512 * DM * 2);
  p.WmvT = (bf16_t*)take((size_t)512 * DM * 2);
  p.WmoT = (bf16_t*)take((size_t)DM * 512 * 2);
  p.qmemb = (bf16_t*)take((size_t)T_TOK * 512 * 2);
  p.kmemb = (bf16_t*)take((size_t)1024 * 512 * 2);
  p.vmemT = (bf16_t*)take((size_t)1024 * 512 * 2);
  p.qsb = (bf16_t*)take((size_t)T_TOK * 1024 * 2);
  p.ksb = (bf16_t*)take((size_t)T_TOK * 1024 * 2);
  p.vsbT = (bf16_t*)take((size_t)T_TOK * 1024 * 2);
  p.pu8 = (unsigned char*)take((size_t)16384 * 1024);
  p.pv8 = (unsigned char*)take((size_t)16384 * 1024);
  p.su8 = (float*)take(16384 * 4);
  p.sv8 = (float*)take(16384 * 4);
  p.subkb = (bf16_t*)take((size_t)16 * 128 * 128 * 2);
  static int grid_blocks = 0;
  if (!grid_blocks) {
    int dev = 0, cus = 0, per_cu = 0;
    (void)hipGetDevice(&dev);
    (void)hipDeviceGetAttribute(&cus, hipDeviceAttributeMultiprocessorCount, dev);
    (void)hipOccupancyMaxActiveBlocksPerMultiprocessor(&per_cu, mega, 256, 0);
    if (per_cu > 2) per_cu = 2;
    if (per_cu < 1) per_cu = 1;
    grid_blocks = cus * per_cu;
  }
  void* args[] = {&p};
  hipError_t e = hipLaunchCooperativeKernel((void*)mega, dim3(grid_blocks), dim3(256), args, 0, stream);
  if (e != hipSuccess) fprintf(stderr, "cooperative launch failed: %s (grid %d)\n", hipGetErrorString(e), grid_blocks);
}
```

```cpp
#include <hip/hip_runtime.h>
#include <hip/hip_cooperative_groups.h>
#include <cstdio>
namespace cg = cooperative_groups;
#include <stdint.h>

#define SEQ 2048
#define NBATCH 4
#define T_TOK 8192
#define DM 2048
#define INC 5656
#define C_QN 0
#define C_KC 1024
#define C_VC 1280
#define C_KS 1536
#define C_VS 1792
#define C_KW 2048
#define C_VW 2304
#define C_GT 2560
#define C_QSB 2584
#define C_KSB 3608
#define C_VSB 4632
#define ATT_SCALE 0.08838834764831845f
#define LOG2E 1.4426950408889634f
#define ATT_SCALE2 (ATT_SCALE * LOG2E)
#define RMS_EPS 1e-6f

typedef unsigned short bf16_t;
typedef __attribute__((ext_vector_type(8))) short bf16x8;
typedef __attribute__((ext_vector_type(16))) float f32x16;
typedef __attribute__((ext_vector_type(2))) __bf16 bf16v2;
typedef __attribute__((ext_vector_type(4))) unsigned u32x4;

struct P {
  const float *x, *mem, *t5, *norm_mix, *w_in, *pos_k, *w1_k, *w2_k, *pos_v, *w1_v, *w2_v, *w_out,
      *norm_mq, *norm_mkv, *w_mq, *w_mk, *w_mv, *w_mo, *norm_ffn, *w_pq, *subk, *pu, *pv, *norm_final;
  float* out;
  float *scores, *gates, *part, *posb, *rowss;
  unsigned* bar;
  bf16_t *hn, *omix, *memn, *omem;
  bf16_t *WinT, *WoutT, *WpqT, *WmqT, *WmkT, *WmvT, *WmoT;
  bf16_t *qmemb, *kmemb, *vmemT;
  bf16_t *qsb, *ksb, *vsbT;
  bf16_t* subkb;
  unsigned char *pu8, *pv8;
  float *su8, *sv8;
  bf16_t *qn, *kcin, *vcin, *ks, *vsT, *kw, *vwT, *kcb, *vcT, *c1, *w1T, *w2T;
};

__device__ __forceinline__ int opq(int v) { asm volatile("" : "+v"(v)); return v; }
__device__ __forceinline__ unsigned pack2(float a, float b) {
  bf16v2 r = {(__bf16)a, (__bf16)b};
  return *(unsigned*)&r;
}
__device__ __forceinline__ bf16_t f2bf(float a) {
  __bf16 r = (__bf16)a;
  return *(bf16_t*)&r;
}
__device__ __forceinline__ int perm16(int s) { return (s & ~12) | ((s & 4) << 1) | ((s & 8) >> 1); }
__device__ __forceinline__ float bf2f(bf16_t u) { return __uint_as_float((unsigned)u << 16); }

__device__ __forceinline__ float wave_max(float v) {
  for (int o = 32; o > 0; o >>= 1) v = fmaxf(v, __shfl_xor(v, o));
  return v;
}
__device__ __forceinline__ float wave_sum(float v) {
  for (int o = 32; o > 0; o >>= 1) v += __shfl_xor(v, o);
  return v;
}
__device__ __forceinline__ void wave_argmax(float& v, int& i) {
  for (int o = 32; o > 0; o >>= 1) {
    float ov = __shfl_xor(v, o);
    int oi = __shfl_xor(i, o);
    if (ov > v || (ov == v && oi < i)) { v = ov; i = oi; }
  }
}
__device__ __forceinline__ float gelu_tanh(float x) {
  return 0.5f * x * (1.f + tanhf(0.7978845608028654f * (x + 0.044715f * x * x * x)));
}
__device__ __forceinline__ float gelu_fast(float x) {
  const float y = 1.5957691216057308f * (x + 0.044715f * x * x * x);
  return x / (1.f + __expf(-y));
}
__device__ __forceinline__ int t5_bucket(int n) {
  if (n < 16) return n < 0 ? 0 : n;
  int b = 16;
  b += (n >= 19); b += (n >= 21); b += (n >= 24); b += (n >= 27); b += (n >= 31); b += (n >= 35);
  b += (n >= 40); b += (n >= 46); b += (n >= 52); b += (n >= 59); b += (n >= 67); b += (n >= 77);
  b += (n >= 87); b += (n >= 99); b += (n >= 113);
  return b;
}
__device__ __forceinline__ float log_sigmoid(float x) {
  return fminf(x, 0.f) - log1pf(expf(-fabsf(x)));
}

__device__ __forceinline__ void ph_rmsnorm(const float* src, const float* gain, bf16_t* dst, int rows) {
  int lane = opq(threadIdx.x) & 63, wv = opq(threadIdx.x) >> 6;
  for (int r = blockIdx.x * 4 + wv; r < rows; r += gridDim.x * 4) {
    const float4* s4 = (const float4*)(src + (size_t)r * DM);
    float4 v[8];
    float ss = 0.f;
#pragma unroll
    for (int i = 0; i < 8; ++i) {
      v[i] = s4[i * 64 + lane];
      ss += v[i].x * v[i].x + v[i].y * v[i].y + v[i].z * v[i].z + v[i].w * v[i].w;
    }
    ss = wave_sum(ss);
    float rs = rsqrtf(ss * (1.f / DM) + RMS_EPS);
    uint2* d2 = (uint2*)(dst + (size_t)r * DM);
    const float4* g4 = (const float4*)gain;
#pragma unroll
    for (int i = 0; i < 8; ++i) {
      float4 g = g4[i * 64 + lane];
      uint2 o;
      o.x = pack2(v[i].x * rs * g.x, v[i].y * rs * g.y);
      o.y = pack2(v[i].z * rs * g.z, v[i].w * rs * g.w);
      d2[i * 64 + lane] = o;
    }
  }
}

template <bool CMAP>
__device__ __forceinline__ void ph_transpose(float* smem, const float* W, int K, int N, int Npad, bf16_t* Wt,
                                             int vblock = -2, int nvb = 0) {
  typedef __attribute__((ext_vector_type(4))) float f32x4;
  float (*tl)[65] = (float (*)[65])smem;
  if (vblock == -1) return;
  const int b0 = (vblock >= 0) ? vblock : (int)blockIdx.x, bstride = (vblock >= 0) ? nvb : (int)gridDim.x;
  const int tid = opq(threadIdx.x);
  const int nk = K / 64, nn = Npad / 64;
  for (int tile = b0; tile < nk * nn; tile += bstride) {
    const int k0 = (tile % nk) * 64, n0 = (tile / nk) * 64;
    const int kr = tid >> 4, n4 = (tid & 15) * 4;
    int sc = n0 + n4;
    if (CMAP) sc = (sc < 2560) ? sc : (sc < 5632) ? sc + 24 : (sc < 5656) ? sc - 5632 + 2560 : N;
#pragma unroll
    for (int i = 0; i < 4; ++i) {
      const int k = kr + 16 * i;
      f32x4 v = {0.f, 0.f, 0.f, 0.f};
      if (sc < N) v = *(const f32x4*)(W + (size_t)(k0 + k) * N + sc);
      tl[k][n4 + 0] = v[0]; tl[k][n4 + 1] = v[1]; tl[k][n4 + 2] = v[2]; tl[k][n4 + 3] = v[3];
    }
    __syncthreads();
    int n = tid >> 2, kc = (tid & 3) * 16;
    unsigned w[8];
#pragma unroll
    for (int i = 0; i < 8; ++i) w[i] = pack2(tl[kc + 2 * i][n], tl[kc + 2 * i + 1][n]);
    uint4* dst = (uint4*)(Wt + (size_t)(n0 + n) * K + k0 + kc);
    dst[0] = make_uint4(w[0], w[1], w[2], w[3]);
    dst[1] = make_uint4(w[4], w[5], w[6], w[7]);
    __syncthreads();
  }
}

__device__ __forceinline__ int lds_off(int row, int chunk) { return row * 128 + ((chunk ^ ((row >> 1) & 7)) << 4); }

template <bool TR, bool VEC = false, class Epi>
__device__ __forceinline__ void gemm_tile_bf16(const bf16_t* xp, int ldx, const bf16_t* yp, int ldy, int K, char* lds,
                                               Epi epi) {
  const int tid = opq(threadIdx.x), lane = tid & 63, wv = tid >> 6;
  const int wr = wv >> 1, wc = wv & 1;
  f32x16 acc[2][2];
#pragma unroll
  for (int i = 0; i < 2; ++i)
#pragma unroll
    for (int j = 0; j < 2; ++j)
#pragma unroll
      for (int r = 0; r < 16; ++r) acc[i][j][r] = 0.f;
  const int prow = lane >> 3, pch = lane & 7;
  const bf16_t* xs[4];
  const bf16_t* ys[4];
#pragma unroll
  for (int ps = 0; ps < 4; ++ps) {
    const int row = (wv * 4 + ps) * 8 + prow;
    const int c = pch ^ ((row >> 1) & 7);
    xs[ps] = xp + (size_t)row * ldx + c * 8;
    ys[ps] = yp + (size_t)row * ldy + c * 8;
  }
  char* const mydst = lds + wv * 4096 + lane * 16;
#define GEMM_ISSUE(k0, bufoff)                                                                                              \
  _Pragma("unroll") for (int ps = 0; ps < 4; ++ps) {                                                                        \
    __builtin_amdgcn_global_load_lds((const unsigned*)(xs[ps] + (k0)), (unsigned*)(mydst + (bufoff) + ps * 1024), 16, 0, 0);         \
    __builtin_amdgcn_global_load_lds((const unsigned*)(ys[ps] + (k0)), (unsigned*)(mydst + (bufoff) + 16384 + ps * 1024), 16, 0, 0); \
  }
#define GEMM_COMPUTE(bufoff)                                                                                     \
  _Pragma("unroll") for (int kk = 0; kk < 4; ++kk) {                                                             \
    bf16x8 a[2], b[2];                                                                                           \
    const int ch = kk * 2 + (lane >> 5);                                                                         \
    _Pragma("unroll") for (int i = 0; i < 2; ++i) {                                                              \
      a[i] = *(const bf16x8*)(lds + (bufoff) + (TR ? 16384 : 0) + lds_off(wr * 64 + i * 32 + (lane & 31), ch)); \
      b[i] = *(const bf16x8*)(lds + (bufoff) + (TR ? 0 : 16384) + lds_off(wc * 64 + i * 32 + (lane & 31), ch)); \
    }                                                                                                            \
    _Pragma("unroll") for (int i = 0; i < 2; ++i)                                                                \
      _Pragma("unroll") for (int j = 0; j < 2; ++j)                                                              \
        acc[i][j] = __builtin_amdgcn_mfma_f32_32x32x16_bf16(a[i], b[j], acc[i][j], 0, 0, 0);                    \
  }
  __syncthreads();
  GEMM_ISSUE(0, 0)
  for (int k0 = 0; k0 < K; k0 += 128) {
    asm volatile("s_waitcnt vmcnt(0)" ::: "memory");
    __syncthreads();
    GEMM_ISSUE(k0 + 64, 32768)
    GEMM_COMPUTE(0)
    asm volatile("s_waitcnt vmcnt(0)" ::: "memory");
    __syncthreads();
    if (k0 + 128 < K) { GEMM_ISSUE(k0 + 128, 0) }
    GEMM_COMPUTE(32768)
  }
#undef GEMM_ISSUE
#undef GEMM_COMPUTE
  int lane2 = lane;
  asm volatile("" : "+v"(lane2));
  if constexpr (VEC) {
    typedef __attribute__((ext_vector_type(4))) float f32x4;
    __syncthreads();
    float* wl = (float*)lds + wv * (32 * 68);
    const int hh2 = lane2 >> 5, cl = lane2 & 31;
#pragma unroll
    for (int i = 0; i < 2; ++i) {
#pragma unroll
      for (int j = 0; j < 2; ++j)
#pragma unroll
        for (int r = 0; r < 16; ++r) wl[((r & 3) + 8 * (r >> 2) + 4 * hh2) * 68 + j * 32 + cl] = acc[i][j][r];
      __builtin_amdgcn_wave_barrier();
#pragma unroll
      for (int k = 0; k < 4; ++k) {
        const int row = (lane2 >> 3) + 8 * k, c8 = (lane2 & 7) * 8;
        const f32x4 lo = *(const f32x4*)&wl[row * 68 + c8];
        const f32x4 hi = *(const f32x4*)&wl[row * 68 + c8 + 4];
        epi(wr * 64 + i * 32 + row, wc * 64 + c8, lo, hi);
      }
      __builtin_amdgcn_wave_barrier();
    }
  } else {
#pragma unroll
    for (int i = 0; i < 2; ++i)
#pragma unroll
      for (int j = 0; j < 2; ++j)
#pragma unroll
        for (int r = 0; r < 16; ++r) {
          int rr = wr * 64 + i * 32 + (r & 3) + 8 * (r >> 2) + 4 * (lane2 >> 5);
          int cc = wc * 64 + j * 32 + (lane2 & 31);
          epi(rr, cc, acc[i][j][r]);
        }
  }
}

typedef __attribute__((ext_vector_type(4))) float f32x4_e;
__device__ __forceinline__ void st_bf16x8(bf16_t* dst, f32x4_e lo, f32x4_e hi) {
  u32x4 o;
  o[0] = pack2(lo[0], lo[1]); o[1] = pack2(lo[2], lo[3]); o[2] = pack2(hi[0], hi[1]); o[3] = pack2(hi[2], hi[3]);
  *(u32x4*)dst = o;
}

__device__ __forceinline__ void norm_feed(const f32x4_e h0, const f32x4_e h1, const float* gain, int n, bf16_t* hn_row,
                                          float* rowss_m) {
  const f32x4_e g0 = *(const f32x4_e*)(gain + n), g1 = *(const f32x4_e*)(gain + n + 4);
  st_bf16x8(hn_row + n, h0 * g0, h1 * g1);
  float ss = h0[0] * h0[0] + h0[1] * h0[1] + h0[2] * h0[2] + h0[3] * h0[3] + h1[0] * h1[0] + h1[1] * h1[1] + h1[2] * h1[2] + h1[3] * h1[3];
  ss += __shfl_xor(ss, 1);
  ss += __shfl_xor(ss, 2);
  ss += __shfl_xor(ss, 4);
  if (((opq(threadIdx.x)) & 7) == 0) atomicAdd(rowss_m, ss);
}

template <bool VEC = false, class Epi>
__device__ __forceinline__ void ph_gemm_bf16(const bf16_t* A, int lda, const bf16_t* Wt, int ldw, int M, int N, int K,
                                             char* lds, Epi epi, int vblock = -2) {
  const int ntm = M / 128, ntn = N / 128;
  const int npm = (ntm + 7) / 8, npn = (ntn + 7) / 8;
  const int nslots = ((npm * npn * 64 + 511) / 512) * 512;
  if (vblock == -1) return;
  for (int u = (vblock >= 0 ? vblock : (int)blockIdx.x); u < nslots; u += gridDim.x) {
    int v = (u & 7) * 64 + ((u >> 3) & 63) + (u & ~511);
    int patch = v >> 6, w = v & 63;
    int tm = (patch % npm) * 8 + (w & 7);
    int tn = (patch / npm) * 8 + (w >> 3);
    if (tm >= ntm || tn >= ntn) continue;
    const int m0 = tm * 128, n0 = tn * 128;
    if constexpr (VEC)
      gemm_tile_bf16<false, true>(A + (size_t)m0 * lda, lda, Wt + (size_t)n0 * ldw, ldw, K, lds,
                                  [&](int r, int c, f32x4_e lo, f32x4_e hi) { epi(m0 + r, n0 + c, lo, hi); });
    else
      gemm_tile_bf16<false>(A + (size_t)m0 * lda, lda, Wt + (size_t)n0 * ldw, ldw, K, lds,
                            [&](int r, int c, float val) { epi(m0 + r, n0 + c, val); });
  }
}

__device__ __forceinline__ void ph_proj(const P& p, char* lds) {
  const int ntm = T_TOK / 128, ntn = 5760 / 128;
  const int npm = (ntm + 7) / 8, npn = (ntn + 7) / 8;
  const int nslots = ((npm * npn * 64 + 511) / 512) * 512;
  for (int u = blockIdx.x; u < nslots; u += gridDim.x) {
    int v = (u & 7) * 64 + ((u >> 3) & 63) + (u & ~511);
    int patch = v >> 6, w = v & 63;
    int tm = (patch % npm) * 8 + (w & 7);
    int tn = (patch / npm) * 8 + (w >> 3);
    if (tm >= ntm || tn >= ntn) continue;
    const int m0 = tm * 128, n0 = tn * 128;
    const int b = m0 >> 11, sl = m0 & 2047;
    const bf16_t* A = p.hn + (size_t)m0 * DM;
    const bf16_t* W = p.WinT + (size_t)n0 * DM;
    if (n0 < 1024) {
      bf16_t* q = p.qn + (size_t)m0 * 1024 + n0;
      gemm_tile_bf16<false, true>(A, DM, W, DM, DM, lds, [&](int r, int c, f32x4_e lo, f32x4_e hi) { st_bf16x8(q + (size_t)r * 1024 + c, lo, hi); });
    } else if (n0 < 2560) {
      const int seg = (n0 - 1024) >> 8, g = ((n0 - 1024) >> 7) & 1;
      if (seg == 3 || seg == 5) {
        bf16_t* vd = (seg == 3 ? p.vsT : p.vwT) + ((size_t)(b * 2 + g) * 128) * SEQ + sl;
        gemm_tile_bf16<true>(A, DM, W, DM, DM, lds, [&](int r, int c, float val) { vd[(size_t)r * SEQ + perm16(c)] = f2bf(val); });
      } else {
        bf16_t* base = (seg == 0) ? p.kcin : (seg == 1) ? p.vcin : (seg == 2) ? p.ks : p.kw;
        bf16_t* kd = base + ((size_t)(b * 2 + g) * SEQ + sl) * 128;
        gemm_tile_bf16<false, true>(A, DM, W, DM, DM, lds, [&](int r, int c, f32x4_e lo, f32x4_e hi) { st_bf16x8(kd + (size_t)r * 128 + c, lo, hi); });
      }
    } else if (n0 < 3584) {
      bf16_t* q = p.qsb + (size_t)m0 * 1024 + (n0 - 2560);
      gemm_tile_bf16<false, true>(A, DM, W, DM, DM, lds, [&](int r, int c, f32x4_e lo, f32x4_e hi) { st_bf16x8(q + (size_t)r * 1024 + c, lo, hi); });
    } else if (n0 < 4608) {
      bf16_t* kd = p.ksb + ((size_t)(b * 8 + ((n0 - 3584) >> 7)) * SEQ + sl) * 128;
      gemm_tile_bf16<false, true>(A, DM, W, DM, DM, lds, [&](int r, int c, f32x4_e lo, f32x4_e hi) { st_bf16x8(kd + (size_t)r * 128 + c, lo, hi); });
    } else if (n0 < 5632) {
      bf16_t* vd = p.vsbT + ((size_t)(b * 8 + ((n0 - 4608) >> 7)) * 128) * SEQ + sl;
      gemm_tile_bf16<true>(A, DM, W, DM, DM, lds, [&](int r, int c, float val) { vd[(size_t)r * SEQ + perm16(c)] = f2bf(val); });
    } else {
      float* gd = p.gates + (size_t)m0 * 24;
      gemm_tile_bf16<false>(A, DM, W, DM, DM, lds, [&](int r, int c, float val) { if (c < 24) gd[(size_t)r * 24 + c] = val; });
    }
  }
}

__device__ __forceinline__ void ph_posb(const P& p) {
  const int lane = opq(threadIdx.x) & 63, wv = opq(threadIdx.x) >> 6;
  for (int o = blockIdx.x * 4 + wv; o < 256; o += gridDim.x * 4) {
    const int which = o >> 7, n = o & 127;
    const float* pos = which ? p.pos_v : p.pos_k;
    const float* w1 = which ? p.w1_v : p.w1_k;
    float acc = 0.f;
    for (int k = lane; k < 4096; k += 64) acc += pos[k] * w1[(size_t)k * 128 + n];
    acc = wave_sum(acc);
    if (lane == 0) p.posb[o] = acc;
  }
}

__device__ __forceinline__ void ph_compress2(const P& p, char* lds) {
  for (int item = blockIdx.x; item < 16; item += gridDim.x) {
    const int which = item >> 3, bg = item & 7;
    const bf16_t* src = (which ? p.vcin : p.kcin) + (size_t)bg * SEQ * 128;
    const bf16_t* w1t = p.w1T + (size_t)which * 128 * 4096;
    const bf16_t* w2t = p.w2T + (size_t)which * 128 * 128;
    const float* posb = p.posb + which * 128;
    bf16_t* c1 = p.c1 + (size_t)item * 128 * 128;
    gemm_tile_bf16<false>(src, 2048, w1t, 4096, 4096, lds, [&](int r, int c, float val) {
      c1[r * 128 + c] = f2bf(gelu_fast(val + posb[c])); });
    __threadfence_block();
    __syncthreads();
    if (which == 0) {
      bf16_t* kd = p.kcb + (size_t)bg * 128 * 128;
      gemm_tile_bf16<false>(c1, 128, w2t, 128, 128, lds, [&](int r, int c, float val) { kd[r * 128 + c] = f2bf(val); });
    } else {
      bf16_t* vd = p.vcT + (size_t)bg * 128 * 128;
      gemm_tile_bf16<true>(c1, 128, w2t, 128, 128, lds, [&](int r, int c, float val) { vd[r * 128 + perm16(c)] = f2bf(val); });
    }
  }
}

#define NEG_BIG (-1e30f)

struct KVRegs { u32x4 k0, k1, k2, k3, v0, v1, v2, v3; };

__device__ __forceinline__ int koff(int row, int chunk) { return row * 256 + ((chunk ^ (row & 15)) << 4); }

__device__ __forceinline__ void kv_load(KVRegs& r, const bf16_t* kp, int ldk, const bf16_t* vp, int ldv) {
  const int tid = opq(threadIdx.x);
  const bf16_t* kg = kp + (size_t)(tid >> 4) * ldk + (tid & 15) * 8;
  r.k0 = *(const u32x4*)kg;
  r.k1 = *(const u32x4*)(kg + (size_t)16 * ldk);
  r.k2 = *(const u32x4*)(kg + (size_t)32 * ldk);
  r.k3 = *(const u32x4*)(kg + (size_t)48 * ldk);
  const bf16_t* vg = vp + (size_t)(tid >> 3) * ldv + (tid & 7) * 8;
  r.v0 = *(const u32x4*)vg;
  r.v1 = *(const u32x4*)(vg + (size_t)32 * ldv);
  r.v2 = *(const u32x4*)(vg + (size_t)64 * ldv);
  r.v3 = *(const u32x4*)(vg + (size_t)96 * ldv);
}
__device__ __forceinline__ void kv_store(const KVRegs& r, char* lk, char* lv) {
  const int tid = opq(threadIdx.x);
  const int row = tid >> 4, ch = tid & 15;
  *(u32x4*)(lk + koff(row, ch)) = r.k0;
  *(u32x4*)(lk + koff(row + 16, ch)) = r.k1;
  *(u32x4*)(lk + koff(row + 32, ch)) = r.k2;
  *(u32x4*)(lk + koff(row + 48, ch)) = r.k3;
  const int vr = tid >> 3, vc = tid & 7;
  *(u32x4*)(lv + lds_off(vr, vc)) = r.v0;
  *(u32x4*)(lv + lds_off(vr + 32, vc)) = r.v1;
  *(u32x4*)(lv + lds_off(vr + 64, vc)) = r.v2;
  *(u32x4*)(lv + lds_off(vr + 96, vc)) = r.v3;
}

struct QFrag { bf16x8 f0, f1, f2, f3, f4, f5, f6, f7; };
__device__ __forceinline__ void q_load(QFrag& q, const bf16_t* qrow) {
  const int h = (opq(threadIdx.x) & 63) >> 5;
  const bf16x8* p8 = (const bf16x8*)(qrow + 8 * h);
  q.f0 = p8[0]; q.f1 = p8[2]; q.f2 = p8[4]; q.f3 = p8[6]; q.f4 = p8[8]; q.f5 = p8[10]; q.f6 = p8[12]; q.f7 = p8[14];
}

__device__ __forceinline__ void qk_tile(const QFrag& q, const char* lk, f32x16& s0, f32x16& s1) {
  const int lane = opq(threadIdx.x) & 63, row = lane & 31, h = lane >> 5;
#pragma unroll
  for (int r = 0; r < 16; ++r) { s0[r] = 0.f; s1[r] = 0.f; }
#define QK_STEP(kk, qf)                                                                  \
  {                                                                                      \
    bf16x8 a0 = *(const bf16x8*)(lk + koff(row, 2 * (kk) + h));                          \
    bf16x8 a1 = *(const bf16x8*)(lk + koff(row + 32, 2 * (kk) + h));                     \
    s0 = __builtin_amdgcn_mfma_f32_32x32x16_bf16(a0, qf, s0, 0, 0, 0);                   \
    s1 = __builtin_amdgcn_mfma_f32_32x32x16_bf16(a1, qf, s1, 0, 0, 0);                   \
  }
  QK_STEP(0, q.f0) QK_STEP(1, q.f1) QK_STEP(2, q.f2) QK_STEP(3, q.f3)
  QK_STEP(4, q.f4) QK_STEP(5, q.f5) QK_STEP(6, q.f6) QK_STEP(7, q.f7)
#undef QK_STEP
}

__device__ __forceinline__ bf16x8 pack8(const f32x16& p, const int base) {
  u32x4 u;
  u[0] = pack2(p[base + 0], p[base + 1]);
  u[1] = pack2(p[base + 2], p[base + 3]);
  u[2] = pack2(p[base + 4], p[base + 5]);
  u[3] = pack2(p[base + 6], p[base + 7]);
  return __builtin_bit_cast(bf16x8, u);
}

typedef __attribute__((ext_vector_type(2))) unsigned u32x2_t;
__device__ __forceinline__ float xhalf_max(float v) {
  const u32x2_t r = __builtin_amdgcn_permlane32_swap(__float_as_uint(v), __float_as_uint(v), false, false);
  return fmaxf(__uint_as_float(r[0]), __uint_as_float(r[1]));
}
__device__ __forceinline__ float xhalf_sum(float v) {
  const u32x2_t r = __builtin_amdgcn_permlane32_swap(__float_as_uint(v), __float_as_uint(v), false, false);
  return __uint_as_float(r[0]) + __uint_as_float(r[1]);
}
__device__ __forceinline__ float xhalf_get(float v, int hh) {
  const u32x2_t r = __builtin_amdgcn_permlane32_swap(__float_as_uint(v), __float_as_uint(v), false, false);
  return hh ? __uint_as_float(r[0]) : __uint_as_float(r[1]);
}
struct OAcc { f32x16 o0, o1, o2, o3; };
__device__ __forceinline__ void oacc_zero(OAcc& o) {
#pragma unroll
  for (int r = 0; r < 16; ++r) { o.o0[r] = 0.f; o.o1[r] = 0.f; o.o2[r] = 0.f; o.o3[r] = 0.f; }
}
__device__ __forceinline__ void oacc_scale(OAcc& o, float a) {
#pragma unroll
  for (int r = 0; r < 16; ++r) { o.o0[r] *= a; o.o1[r] *= a; o.o2[r] *= a; o.o3[r] *= a; }
}

__device__ __forceinline__ void pv_tile(OAcc& o, const char* lv, const f32x16& p0, const f32x16& p1) {
  const int lane = opq(threadIdx.x) & 63, row = lane & 31, h = lane >> 5;
  const bf16x8 pf0 = pack8(p0, 0), pf1 = pack8(p0, 8), pf2 = pack8(p1, 0), pf3 = pack8(p1, 8);
#define PV_ROW(dd, acc)                                                                                      \
  {                                                                                                          \
    acc = __builtin_amdgcn_mfma_f32_32x32x16_bf16(*(const bf16x8*)(lv + lds_off(32 * (dd) + row, 0 + h)), pf0, acc, 0, 0, 0); \
    acc = __builtin_amdgcn_mfma_f32_32x32x16_bf16(*(const bf16x8*)(lv + lds_off(32 * (dd) + row, 2 + h)), pf1, acc, 0, 0, 0); \
    acc = __builtin_amdgcn_mfma_f32_32x32x16_bf16(*(const bf16x8*)(lv + lds_off(32 * (dd) + row, 4 + h)), pf2, acc, 0, 0, 0); \
    acc = __builtin_amdgcn_mfma_f32_32x32x16_bf16(*(const bf16x8*)(lv + lds_off(32 * (dd) + row, 6 + h)), pf3, acc, 0, 0, 0); \
  }
  PV_ROW(0, o.o0) PV_ROW(1, o.o1) PV_ROW(2, o.o2) PV_ROW(3, o.o3)
#undef PV_ROW
}

__device__ __forceinline__ void softmax_tile(f32x16& s0, f32x16& s1, float& m, float& l, OAcc& o) {
  float mx = NEG_BIG;
#pragma unroll
  for (int r = 0; r < 16; ++r) mx = fmaxf(mx, fmaxf(s0[r], s1[r]));
  mx = xhalf_max(mx);
  const float mn = fmaxf(m, mx);
  const float alpha = __builtin_amdgcn_exp2f(m - mn);
  float ls = 0.f;
#pragma unroll
  for (int r = 0; r < 16; ++r) {
    const float a = __builtin_amdgcn_exp2f(s0[r] - mn);
    const float b = __builtin_amdgcn_exp2f(s1[r] - mn);
    s0[r] = a; s1[r] = b;
    ls += a + b;
  }
  ls = xhalf_sum(ls);
  l = l * alpha + ls;
  m = mn;
  if (__any(alpha != 1.f)) oacc_scale(o, alpha);
}

template <class F>
__device__ __forceinline__ void oacc_foreach(const OAcc& o, F f) {
  const int h = (opq(threadIdx.x) & 63) >> 5;
#pragma unroll
  for (int rho = 0; rho < 4; ++rho) {
    f(0 + 8 * rho + 4 * h, o.o0[4 * rho], o.o0[4 * rho + 1], o.o0[4 * rho + 2], o.o0[4 * rho + 3]);
    f(32 + 8 * rho + 4 * h, o.o1[4 * rho], o.o1[4 * rho + 1], o.o1[4 * rho + 2], o.o1[4 * rho + 3]);
    f(64 + 8 * rho + 4 * h, o.o2[4 * rho], o.o2[4 * rho + 1], o.o2[4 * rho + 2], o.o2[4 * rho + 3]);
    f(96 + 8 * rho + 4 * h, o.o3[4 * rho], o.o3[4 * rho + 1], o.o3[4 * rho + 2], o.o3[4 * rho + 3]);
  }
}

__device__ __forceinline__ void ph_memattn2(const P& p, char* lds) {
  char* lk = lds;
  char* lv = lds + 16384;
  const int lane = opq(threadIdx.x) & 63, wv = opq(threadIdx.x) >> 6;
  for (int item = blockIdx.x; item < NBATCH * 4 * (SEQ / 128); item += gridDim.x) {
    const int tb = item % (SEQ / 128);
    const int bh = item / (SEQ / 128);
    const int b = bh >> 2, hd = bh & 3;
    const int t = tb * 128 + wv * 32 + (lane & 31);
    QFrag q;
    q_load(q, p.qmemb + (size_t)(b * SEQ + t) * 512 + hd * 128);
    const bf16_t* kb = p.kmemb + (size_t)bh * 256 * 128;
    const bf16_t* vb = p.vmemT + (size_t)bh * 128 * 256;
    OAcc o;
    oacc_zero(o);
    float m = NEG_BIG, l = 0.f;
    KVRegs kv;
    kv_load(kv, kb, 128, vb, 256);
#pragma unroll 1
    for (int ti = 0; ti < 4; ++ti) {
      __syncthreads();
      kv_store(kv, lk, lv);
      __syncthreads();
      {
        const int tn = (ti + 1 < 4) ? ti + 1 : 3;
        kv_load(kv, kb + (size_t)tn * 64 * 128, 128, vb + tn * 64, 256);
      }
      f32x16 s0, s1;
      qk_tile(q, lk, s0, s1);
#pragma unroll
      for (int r = 0; r < 16; ++r) { s0[r] *= ATT_SCALE2; s1[r] *= ATT_SCALE2; }
      softmax_tile(s0, s1, m, l, o);
      pv_tile(o, lv, s0, s1);
    }
    const float il = 1.f / l;
    const int t2 = tb * 128 + (opq(threadIdx.x) >> 6) * 32 + (opq(threadIdx.x) & 31);
    bf16_t* orow = p.omem + (size_t)(b * SEQ + t2) * 512 + hd * 128;
    oacc_foreach(o, [&](int d, float v0, float v1, float v2, float v3) {
      uint2 u;
      u.x = pack2(v0 * il, v1 * il);
      u.y = pack2(v2 * il, v3 * il);
      *(uint2*)(orow + d) = u;
    });
  }
}

__device__ __forceinline__ void ph_sb2(const P& p, char* lds) {
  char* lk = lds;
  char* lv = lds + 16384;
  const int lane = opq(threadIdx.x) & 63, wv = opq(threadIdx.x) >> 6, hh = lane >> 5;
  const int sb_skip = (gridDim.x > 32) ? 16 : 0;
  if ((int)blockIdx.x < sb_skip) return;
  for (int item = (int)blockIdx.x - sb_skip; item < NBATCH * 8 * (SEQ / 128); item += (int)gridDim.x - sb_skip) {
    const int tb = (SEQ / 128 - 1) - (item % (SEQ / 128));
    const int bh = item / (SEQ / 128);
    const int b = bh >> 3, hd = bh & 7;
    const int t0 = tb * 128;
    const int t = t0 + wv * 32 + (lane & 31);
    QFrag q;
    q_load(q, p.qsb + (size_t)(b * SEQ + t) * 1024 + hd * 128);
    const bf16_t* kb = p.ksb + (size_t)bh * SEQ * 128;
    const bf16_t* vb = p.vsbT + (size_t)bh * 128 * SEQ;
    OAcc o;
    oacc_zero(o);
    float carry = 0.f;
    const int jhi = (t0 >> 6) + 1;
    const int jw = (t0 + wv * 32 + 30) >> 6;
    KVRegs kv;
    kv_load(kv, kb + (size_t)jhi * 64 * 128, 128, vb + jhi * 64, SEQ);
    volatile unsigned* dflag = (volatile unsigned*)(lds + 32768);
    __syncthreads();
    if (opq(threadIdx.x) < 4) dflag[opq(threadIdx.x)] = 0u;
    for (int j = jhi; j >= 0; --j) {
      __syncthreads();
      if ((dflag[0] & dflag[1] & dflag[2] & dflag[3]) != 0u) break;
      kv_store(kv, lk, lv);
      __syncthreads();
      const int jn = (j > 0) ? j - 1 : 0;
      if (j > jw) kv_load(kv, kb + (size_t)jn * 64 * 128, 128, vb + jn * 64, SEQ);
      if (j <= jw) {
        f32x16 z0, z1;
        qk_tile(q, lk, z0, z1);
        const int sbase = j * 64 + 4 * hh;
        float gt[8];
        f32x16 l0, l1;
#pragma unroll
        for (int r = 0; r < 16; ++r) {
          const int so = sbase + 8 * (r >> 2) + (r & 3);
          {
            const float z = z0[r] * ATT_SCALE2;
            const bool valid = so < t;
            const float lsp = fminf(z, 0.f) - __builtin_amdgcn_logf(1.f + __builtin_amdgcn_exp2f(-fabsf(z)));
            l0[r] = valid ? (lsp - z) : 0.f;
            z0[r] = valid ? z : NEG_BIG;
          }
          {
            const float z = z1[r] * ATT_SCALE2;
            const bool valid = so + 32 < t;
            const float lsp = fminf(z, 0.f) - __builtin_amdgcn_logf(1.f + __builtin_amdgcn_exp2f(-fabsf(z)));
            l1[r] = valid ? (lsp - z) : 0.f;
            z1[r] = valid ? z : NEG_BIG;
          }
        }
#pragma unroll
        for (int rho = 0; rho < 4; ++rho) {
          gt[rho] = (l0[4 * rho] + l0[4 * rho + 1]) + (l0[4 * rho + 2] + l0[4 * rho + 3]);
          gt[4 + rho] = (l1[4 * rho] + l1[4 * rho + 1]) + (l1[4 * rho + 2] + l1[4 * rho + 3]);
        }
        float ag[8];
        float run = 0.f;
#pragma unroll
        for (int k = 7; k >= 0; --k) {
          const float pg = xhalf_get(gt[k], hh);
          ag[k] = carry + run + (hh == 0 ? pg : 0.f);
          run += gt[k] + pg;
        }
        carry += run;
#pragma unroll
        for (int rho = 0; rho < 4; ++rho) {
          {
            const float x3 = l0[4 * rho + 3], x23 = x3 + l0[4 * rho + 2], x123 = x23 + l0[4 * rho + 1];
            const float g = ag[rho];
            z0[4 * rho + 0] = __builtin_amdgcn_exp2f((l0[4 * rho + 0] + z0[4 * rho + 0]) + (g + x123));
            z0[4 * rho + 1] = __builtin_amdgcn_exp2f((l0[4 * rho + 1] + z0[4 * rho + 1]) + (g + x23));
            z0[4 * rho + 2] = __builtin_amdgcn_exp2f((l0[4 * rho + 2] + z0[4 * rho + 2]) + (g + x3));
            z0[4 * rho + 3] = __builtin_amdgcn_exp2f((l0[4 * rho + 3] + z0[4 * rho + 3]) + g);
          }
          {
            const float x3 = l1[4 * rho + 3], x23 = x3 + l1[4 * rho + 2], x123 = x23 + l1[4 * rho + 1];
            const float g = ag[4 + rho];
            z1[4 * rho + 0] = __builtin_amdgcn_exp2f((l1[4 * rho + 0] + z1[4 * rho + 0]) + (g + x123));
            z1[4 * rho + 1] = __builtin_amdgcn_exp2f((l1[4 * rho + 1] + z1[4 * rho + 1]) + (g + x23));
            z1[4 * rho + 2] = __builtin_amdgcn_exp2f((l1[4 * rho + 2] + z1[4 * rho + 2]) + (g + x3));
            z1[4 * rho + 3] = __builtin_amdgcn_exp2f((l1[4 * rho + 3] + z1[4 * rho + 3]) + g);
          }
        }
        kv_load(kv, kb + (size_t)jn * 64 * 128, 128, vb + jn * 64, SEQ);
        pv_tile(o, lv, z0, z1);
        if (__all(carry < -104.f * LOG2E) && (opq(threadIdx.x) & 63) == 0) dflag[wv] = 1u;
      }
    }
    int t2 = t;
    asm volatile("" : "+v"(t2));
    bf16_t* orow = p.omix + (size_t)(b * SEQ + t2) * DM + 1024 + hd * 128;
    oacc_foreach(o, [&](int d, float v0, float v1, float v2, float v3) {
      uint2 u;
      u.x = pack2(v0, v1);
      u.y = pack2(v2, v3);
      *(uint2*)(orow + d) = u;
    });
  }
}

#define NSA_IMP 32768
#define NSA_KEYS 49152
#define NSA_SELM 53504
#define NSA_LUT 53632
__device__ __forceinline__ void ph_nsa2(const P& p, char* lds) {
  typedef __attribute__((ext_vector_type(4))) float f32x4;
  char* lk = lds;
  char* lv = lds + 16384;
  float* imp = (float*)(lds + NSA_IMP);
  float* keys = (float*)(lds + NSA_KEYS);
  unsigned* selm = (unsigned*)(lds + NSA_SELM);
  const int tid = opq(threadIdx.x), lane = tid & 63, wv = tid >> 6, hh = lane >> 5, ql = lane & 31;
  float* lut = (float*)(lds + NSA_LUT) + wv * 128;
  for (int item = blockIdx.x; item < NBATCH * 2 * (SEQ / 32); item += gridDim.x) {
    const int tt = (item < 256) ? (SEQ / 32 - 1) - (item % (SEQ / 32)) : (item % (SEQ / 32));
    const int bg = item / (SEQ / 32);
    const int b = bg >> 1, g = bg & 1;
    const int h = g * 4 + wv;
    const int t0 = tt * 32, tq = t0 + ql, cur = t0 >> 6;
    __syncthreads();
    QFrag q;
    q_load(q, p.qn + (size_t)(b * SEQ + tq) * 1024 + h * 128);
    {
      const int lo = opq(lane);
      lut[lo] = p.t5[t5_bucket(lo) * 8 + h] * LOG2E;
      lut[lo + 64] = p.t5[t5_bucket(lo + 64) * 8 + h] * LOG2E;
    }
#pragma unroll
    for (int i = 0; i < 16; ++i) imp[i * 256 + tid] = 0.f;
    if (tid < 32) selm[tid] = 0u;
    const float* grow = p.gates + (size_t)(b * SEQ + tq) * 24 + h * 3;
    float* prow = p.part + (size_t)(b * SEQ + tq) * 1024 + h * 128;
    OAcc o;
    float m, l;
    KVRegs kv;
    {
      const bf16_t* kb = p.kcb + (size_t)bg * 128 * 128;
      const bf16_t* vb = p.vcT + (size_t)bg * 128 * 128;
      oacc_zero(o);
      m = NEG_BIG; l = 0.f;
      kv_load(kv, kb, 128, vb, 128);
      __syncthreads();
      kv_store(kv, lk, lv);
      __syncthreads();
      f32x16 x0, x1;
      qk_tile(q, lk, x0, x1);
      int tqv = tq;
      asm volatile("" : "+v"(tqv));
      tqv -= 64 * hh;
      if (t0 >= 1152) {
        const float b31 = lut[127];
#pragma unroll
        for (int r = 0; r < 16; ++r) { x0[r] = x0[r] * ATT_SCALE2 + b31; x1[r] = x1[r] * ATT_SCALE2 + b31; }
      } else {
#pragma unroll
        for (int r = 0; r < 16; ++r) {
          const int c = 8 * (r >> 2) + (r & 3);
          const int d0 = tqv - 16 * c - 31, d1 = d0 - 512;
          x0[r] = (d0 >= 0) ? x0[r] * ATT_SCALE2 + lut[min(d0, 127)] : -INFINITY;
          x1[r] = (d1 >= 0) ? x1[r] * ATT_SCALE2 + lut[min(d1, 127)] : -INFINITY;
        }
      }
      softmax_tile(x0, x1, m, l, o);
      const float m0 = m;
      pv_tile(o, lv, x0, x1);
      f32x16 z0, z1;
#pragma unroll
      for (int r = 0; r < 16; ++r) { z0[r] = 0.f; z1[r] = 0.f; }
      if (t0 >= 1024) {
        kv_load(kv, kb + 64 * 128, 128, vb + 64, 128);
        __syncthreads();
        kv_store(kv, lk, lv);
        __syncthreads();
        qk_tile(q, lk, z0, z1);
        asm volatile("" : "+v"(tqv));
#pragma unroll
        for (int r = 0; r < 16; ++r) {
          const int c = 64 + 8 * (r >> 2) + (r & 3);
          const int d0 = tqv - 16 * c - 31, d1 = d0 - 512;
          z0[r] = (d0 >= 0) ? z0[r] * ATT_SCALE2 + lut[min(d0, 127)] : -INFINITY;
          z1[r] = (d1 >= 0) ? z1[r] * ATT_SCALE2 + lut[min(d1, 127)] : -INFINITY;
        }
        softmax_tile(z0, z1, m, l, o);
        pv_tile(o, lv, z0, z1);
      }
      const float inv = 1.f / fmaxf(l, 1e-20f);
      const float c0 = __builtin_amdgcn_exp2f(m0 - m) * inv;
#pragma unroll
      for (int r = 0; r < 16; ++r) {
        const int c = 8 * (r >> 2) + (r & 3) + 4 * hh;
        if (x0[r] != 0.f) atomicAdd(&imp[(c) * 32 + ql], x0[r] * c0);
        if (x1[r] != 0.f) atomicAdd(&imp[(c + 32) * 32 + ql], x1[r] * c0);
        if (z0[r] != 0.f) atomicAdd(&imp[(c + 64) * 32 + ql], z0[r] * inv);
        if (z1[r] != 0.f) atomicAdd(&imp[(c + 96) * 32 + ql], z1[r] * inv);
      }
      const float gs = inv / (1.f + __expf(-grow[0]));
      oacc_foreach(o, [&](int d, float v0, float v1, float v2, float v3) {
        f32x4 u = {v0 * gs, v1 * gs, v2 * gs, v3 * gs};
        *(f32x4*)(prow + d) = u;
      });
    }
    __syncthreads();
    {
      const int tido = opq(tid);
      const int qq = tido & 31, jg = tido >> 5;
#pragma unroll
      for (int jj = 0; jj < 4; ++jj) {
        const int j = jg * 4 + jj;
        float v = imp[(4 * j) * 32 + qq] + imp[(4 * j + 1) * 32 + qq] + imp[(4 * j + 2) * 32 + qq] + 0.5f * imp[(4 * j + 3) * 32 + qq];
        if (j > 0) v += 0.5f * imp[(4 * j - 1) * 32 + qq];
        const bool forced = (j == 0) || (j == cur) || (j == cur - 1);
        keys[qq * 33 + j] = forced ? 1e9f : ((j <= cur) ? v : -1e9f);
      }
      __syncthreads();
      unsigned bits = 0u;
#pragma unroll
      for (int jj = 0; jj < 4; ++jj) {
        const int j = jg * 4 + jj;
        const float kj = keys[qq * 33 + j];
        int rank = 0;
        for (int i = 0; i < 32; ++i) {
          const float ki = keys[qq * 33 + i];
          rank += (ki > kj || (ki == kj && i < j)) ? 1 : 0;
        }
        if (rank < 16 && j <= cur) bits |= 1u << j;
      }
      atomicOr(&selm[qq], bits);
      __syncthreads();
    }
    const unsigned mysel = selm[ql];
    unsigned um = mysel;
#pragma unroll
    for (int o2 = 16; o2 > 0; o2 >>= 1) um |= (unsigned)__shfl_xor((int)um, o2);
    um = (unsigned)__builtin_amdgcn_readfirstlane((int)um);
    {
      const bf16_t* kb = p.ks + (size_t)bg * SEQ * 128;
      const bf16_t* vb = p.vsT + (size_t)bg * 128 * SEQ;
      oacc_zero(o);
      m = NEG_BIG; l = 0.f;
      unsigned rem = um;
      int j = __builtin_ctz(rem);
      kv_load(kv, kb + (size_t)j * 64 * 128, 128, vb + j * 64, SEQ);
      while (rem) {
        j = __builtin_ctz(rem);
        rem &= rem - 1;
        const int jn = rem ? __builtin_ctz(rem) : j;
        __syncthreads();
        kv_store(kv, lk, lv);
        __syncthreads();
        f32x16 s0, s1;
        qk_tile(q, lk, s0, s1);
        const bool selq = (mysel >> j) & 1u;
        int tqv = tq;
        asm volatile("" : "+v"(tqv));
        if (j * 64 + 63 + 113 <= t0) {
          const float sc = selq ? ATT_SCALE2 : 0.f, bb = selq ? lut[127] : -INFINITY;
#pragma unroll
          for (int r = 0; r < 16; ++r) { s0[r] = s0[r] * sc + bb; s1[r] = s1[r] * sc + bb; }
        } else {
#pragma unroll
          for (int r = 0; r < 16; ++r) {
            const int d0 = tqv - (j * 64 + 8 * (r >> 2) + (r & 3) + 4 * hh), d1 = d0 - 32;
            s0[r] = (selq && d0 >= 0) ? s0[r] * ATT_SCALE2 + lut[min(d0, 127)] : -INFINITY;
            s1[r] = (selq && d1 >= 0) ? s1[r] * ATT_SCALE2 + lut[min(d1, 127)] : -INFINITY;
          }
        }
        kv_load(kv, kb + (size_t)jn * 64 * 128, 128, vb + jn * 64, SEQ);
        softmax_tile(s0, s1, m, l, o);
        pv_tile(o, lv, s0, s1);
      }
      const float gs = 1.f / (fmaxf(l, 1e-20f) * (1.f + __expf(-grow[1])));
      int qo = ql;
      asm volatile("" : "+v"(qo));
      float* pr2 = p.part + (size_t)(b * SEQ + t0 + qo) * 1024 + h * 128;
      oacc_foreach(o, [&](int d, float v0, float v1, float v2, float v3) {
        f32x4 u = *(f32x4*)(pr2 + d);
        u[0] += v0 * gs; u[1] += v1 * gs; u[2] += v2 * gs; u[3] += v3 * gs;
        *(f32x4*)(pr2 + d) = u;
      });
    }
    {
      const bf16_t* kb = p.kw + (size_t)bg * SEQ * 128;
      const bf16_t* vb = p.vwT + (size_t)bg * 128 * SEQ;
      oacc_zero(o);
      m = NEG_BIG; l = 0.f;
      int jlo = (t0 - 511) >> 6;
      if (jlo < 0) jlo = 0;
      kv_load(kv, kb + (size_t)jlo * 64 * 128, 128, vb + jlo * 64, SEQ);
      for (int j = jlo; j <= cur; ++j) {
        const int jn = (j < cur) ? j + 1 : j;
        __syncthreads();
        kv_store(kv, lk, lv);
        __syncthreads();
        f32x16 s0, s1;
        qk_tile(q, lk, s0, s1);
        int tqv = tq;
        asm volatile("" : "+v"(tqv));
        if (j * 64 + 63 + 113 <= t0 && t0 + 31 - j * 64 < 512) {
          const float b31 = lut[127];
#pragma unroll
          for (int r = 0; r < 16; ++r) { s0[r] = s0[r] * ATT_SCALE2 + b31; s1[r] = s1[r] * ATT_SCALE2 + b31; }
        } else {
#pragma unroll
          for (int r = 0; r < 16; ++r) {
            const int d0 = tqv - (j * 64 + 8 * (r >> 2) + (r & 3) + 4 * hh), d1 = d0 - 32;
            s0[r] = (d0 >= 0 && d0 < 512) ? s0[r] * ATT_SCALE2 + lut[min(d0, 127)] : -INFINITY;
            s1[r] = (d1 >= 0 && d1 < 512) ? s1[r] * ATT_SCALE2 + lut[min(d1, 127)] : -INFINITY;
          }
        }
        kv_load(kv, kb + (size_t)jn * 64 * 128, 128, vb + jn * 64, SEQ);
        softmax_tile(s0, s1, m, l, o);
        pv_tile(o, lv, s0, s1);
      }
      const float gs = 1.f / (fmaxf(l, 1e-20f) * (1.f + __expf(-grow[2])));
      int qo = ql;
      asm volatile("" : "+v"(qo));
      const float* pr2 = p.part + (size_t)(b * SEQ + t0 + qo) * 1024 + h * 128;
      bf16_t* orow = p.omix + (size_t)(b * SEQ + t0 + qo) * DM + h * 128;
      oacc_foreach(o, [&](int d, float v0, float v1, float v2, float v3) {
        const f32x4 u = *(const f32x4*)(pr2 + d);
        uint2 w;
        w.x = pack2(u[0] + v0 * gs, u[1] + v1 * gs);
        w.y = pack2(u[2] + v2 * gs, u[3] + v3 * gs);
        *(uint2*)(orow + d) = w;
      });
    }
  }
}

__device__ __forceinline__ void ph_cvt(const float* src, bf16_t* dst, size_t n) {
  typedef __attribute__((ext_vector_type(4))) float f32x4;
  const size_t nv = n / 8;
  for (size_t i = (size_t)blockIdx.x * 256 + opq(threadIdx.x); i < nv; i += (size_t)gridDim.x * 256) {
    const f32x4 a = ((const f32x4*)src)[2 * i], b = ((const f32x4*)src)[2 * i + 1];
    u32x4 o;
    o[0] = pack2(a[0], a[1]); o[1] = pack2(a[2], a[3]); o[2] = pack2(b[0], b[1]); o[3] = pack2(b[2], b[3]);
    ((u32x4*)dst)[i] = o;
  }
}

__device__ __forceinline__ void ph_scores(const P& p, char* lds) {
  for (int u = blockIdx.x; u < 64 * 16; u += gridDim.x) {
    const int tm = u & 63, hp = u >> 6;
    const int m0 = tm * 128;
    float* sc = p.scores + (size_t)m0 * DM + hp * 128;
    gemm_tile_bf16<false>(p.omix + (size_t)m0 * DM + hp * 128, DM, p.subkb + (size_t)hp * 128 * 128, 128, 128, lds,
                          [&](int r, int c, float val) { sc[(size_t)r * DM + c] = val; });
  }
}

__device__ __forceinline__ void ph_qp_scores(const P& p, char* lds) {
  const int ntm = T_TOK / 128, ntn = DM / 128;
  const int npm = (ntm + 7) / 8, npn = (ntn + 7) / 8;
  const int nslots = ((npm * npn * 64 + 511) / 512) * 512;
  for (int u = blockIdx.x; u < nslots; u += gridDim.x) {
    int v = (u & 7) * 64 + ((u >> 3) & 63) + (u & ~511);
    int patch = v >> 6, w = v & 63;
    int tm = (patch % npm) * 8 + (w & 7);
    int tn = (patch / npm) * 8 + (w >> 3);
    if (tm >= ntm || tn >= ntn) continue;
    const int m0 = tm * 128, n0 = tn * 128;
    bf16_t* qp = p.omix + (size_t)m0 * DM + n0;
    const float* rss = p.rowss + T_TOK + m0;
    gemm_tile_bf16<false, true>(p.hn + (size_t)m0 * DM, DM, p.WpqT + (size_t)n0 * DM, DM, DM, lds,
                                [&](int r, int c, f32x4_e lo, f32x4_e hi) {
                                  const float rs = rsqrtf(rss[r] * (1.f / DM) + RMS_EPS);
                                  st_bf16x8(qp + (size_t)r * DM + c, lo * rs, hi * rs); });
    __threadfence_block();
    __syncthreads();
    float* sc = p.scores + (size_t)m0 * DM + n0;
    gemm_tile_bf16<false, true>(qp, DM, p.subkb + (size_t)tn * 128 * 128, 128, 128, lds,
                                [&](int r, int c, f32x4_e lo, f32x4_e hi) {
                                  *(f32x4_e*)(sc + (size_t)r * DM + c) = lo; *(f32x4_e*)(sc + (size_t)r * DM + c + 4) = hi; });
  }
}

__device__ __forceinline__ void ph_cvt4(const float* src, unsigned char* dst, float* scales, int nrows, int wid0, int nw) {
  typedef __attribute__((ext_vector_type(4))) float f32x4;
  typedef __attribute__((ext_vector_type(2))) float f32x2;
  const int lane = opq(threadIdx.x) & 63;
  const float one = __uint_as_float((unsigned)opq(0x3F800000));
  float lev[8];
#pragma unroll
  for (int c = 0; c < 8; ++c) {
    const f32x2 q = __builtin_amdgcn_cvt_scalef32_pk_f32_fp4((unsigned)opq(c * 0x11111111), one, 0);
    lev[c] = fabsf(q[0]);
  }
  const float maxlev = lev[7];
  for (int row = wid0; row < nrows; row += nw) {
    const f32x4* s4 = (const f32x4*)(src + (size_t)row * DM) + lane * 8;
    f32x4 v[8];
    float amax = 0.f;
#pragma unroll
    for (int i = 0; i < 8; ++i) {
      v[i] = s4[i];
#pragma unroll
      for (int k = 0; k < 4; ++k) amax = fmaxf(amax, fabsf(v[i][k]));
    }
    amax = wave_max(amax);
    const float sc = (amax > 0.f) ? maxlev / amax : 1.f;
    u32x4 o;
#pragma unroll
    for (int w = 0; w < 4; ++w) {
      unsigned pk = 0u;
      pk = __builtin_amdgcn_cvt_scalef32_pk_fp4_f32(pk, v[2 * w][0] * sc, v[2 * w][1] * sc, 1.0f, 0);
      pk = __builtin_amdgcn_cvt_scalef32_pk_fp4_f32(pk, v[2 * w][2] * sc, v[2 * w][3] * sc, 1.0f, 1);
      pk = __builtin_amdgcn_cvt_scalef32_pk_fp4_f32(pk, v[2 * w + 1][0] * sc, v[2 * w + 1][1] * sc, 1.0f, 2);
      pk = __builtin_amdgcn_cvt_scalef32_pk_fp4_f32(pk, v[2 * w + 1][2] * sc, v[2 * w + 1][3] * sc, 1.0f, 3);
      o[w] = pk;
    }
    *(u32x4*)(dst + (size_t)row * 1024 + lane * 16) = o;
    if (lane == 0) scales[row] = (amax > 0.f) ? amax / maxlev : 1.f;
  }
}

__device__ __forceinline__ u32x4 r4_load(const unsigned char* tab, int eid, int lane) {
  return *((const u32x4*)(tab + (size_t)eid * 1024) + lane);
}
struct XPk { f32x16 a, b; };
struct Acc32 { f32x16 a, b; };

#define R4_DOT_W(word, xv, base, pa, pb)                                                             \
  {                                                                                                  \
    typedef __attribute__((ext_vector_type(2))) float f32x2;                                         \
    const f32x2 q0 = __builtin_amdgcn_cvt_scalef32_pk_f32_fp4(word, one, 0), q1 = __builtin_amdgcn_cvt_scalef32_pk_f32_fp4(word, one, 1); \
    const f32x2 q2 = __builtin_amdgcn_cvt_scalef32_pk_f32_fp4(word, one, 2), q3 = __builtin_amdgcn_cvt_scalef32_pk_f32_fp4(word, one, 3); \
    pa += q0[0] * xv[base + 0] + q0[1] * xv[base + 1]; pb += q1[0] * xv[base + 2] + q1[1] * xv[base + 3]; \
    pa += q2[0] * xv[base + 4] + q2[1] * xv[base + 5]; pb += q3[0] * xv[base + 6] + q3[1] * xv[base + 7]; \
  }
__device__ __forceinline__ float r4_dot(const u32x4& e, const XPk& x) {
  const float one = __uint_as_float((unsigned)opq(0x3F800000));
  float pa = 0.f, pb = 0.f;
  R4_DOT_W(e[0], x.a, 0, pa, pb) R4_DOT_W(e[1], x.a, 8, pa, pb) R4_DOT_W(e[2], x.b, 0, pa, pb) R4_DOT_W(e[3], x.b, 8, pa, pb)
  return pa + pb;
}
#define R4_AXPY_W(word, accv, base)                                                                  \
  {                                                                                                  \
    typedef __attribute__((ext_vector_type(2))) float f32x2;                                         \
    const f32x2 q0 = __builtin_amdgcn_cvt_scalef32_pk_f32_fp4(word, one, 0), q1 = __builtin_amdgcn_cvt_scalef32_pk_f32_fp4(word, one, 1); \
    const f32x2 q2 = __builtin_amdgcn_cvt_scalef32_pk_f32_fp4(word, one, 2), q3 = __builtin_amdgcn_cvt_scalef32_pk_f32_fp4(word, one, 3); \
    accv[base + 0] += hid * q0[0]; accv[base + 1] += hid * q0[1]; accv[base + 2] += hid * q1[0]; accv[base + 3] += hid * q1[1]; \
    accv[base + 4] += hid * q2[0]; accv[base + 5] += hid * q2[1]; accv[base + 6] += hid * q3[0]; accv[base + 7] += hid * q3[1]; \
  }
__device__ __forceinline__ void r4_axpy(const u32x4& e, float hid, Acc32& acc) {
  const float one = __uint_as_float((unsigned)opq(0x3F800000));
  R4_AXPY_W(e[0], acc.a, 0) R4_AXPY_W(e[1], acc.a, 8) R4_AXPY_W(e[2], acc.b, 0) R4_AXPY_W(e[3], acc.b, 8)
}

#define INS16(K, x)                                                                                      \
  K##15 = __builtin_amdgcn_fmed3f(K##15, K##14, x); K##14 = __builtin_amdgcn_fmed3f(K##14, K##13, x);   \
  K##13 = __builtin_amdgcn_fmed3f(K##13, K##12, x); K##12 = __builtin_amdgcn_fmed3f(K##12, K##11, x);   \
  K##11 = __builtin_amdgcn_fmed3f(K##11, K##10, x); K##10 = __builtin_amdgcn_fmed3f(K##10, K##9, x);    \
  K##9 = __builtin_amdgcn_fmed3f(K##9, K##8, x); K##8 = __builtin_amdgcn_fmed3f(K##8, K##7, x);         \
  K##7 = __builtin_amdgcn_fmed3f(K##7, K##6, x); K##6 = __builtin_amdgcn_fmed3f(K##6, K##5, x);         \
  K##5 = __builtin_amdgcn_fmed3f(K##5, K##4, x); K##4 = __builtin_amdgcn_fmed3f(K##4, K##3, x);         \
  K##3 = __builtin_amdgcn_fmed3f(K##3, K##2, x); K##2 = __builtin_amdgcn_fmed3f(K##2, K##1, x);         \
  K##1 = __builtin_amdgcn_fmed3f(K##1, K##0, x); K##0 = fmaxf(K##0, x);
#define DECL16(K) float K##0 = -INFINITY, K##1 = -INFINITY, K##2 = -INFINITY, K##3 = -INFINITY, K##4 = -INFINITY, \
  K##5 = -INFINITY, K##6 = -INFINITY, K##7 = -INFINITY, K##8 = -INFINITY, K##9 = -INFINITY, K##10 = -INFINITY,   \
  K##11 = -INFINITY, K##12 = -INFINITY, K##13 = -INFINITY, K##14 = -INFINITY, K##15 = -INFINITY;
__device__ __forceinline__ float mkkey(float v, unsigned tag, unsigned mask) {
  return __uint_as_float((__float_as_uint(v) & ~mask) | tag);
}

__device__ __forceinline__ void ph_peer(const P& p, float* smem) {
  typedef __attribute__((ext_vector_type(4))) float f32x4;
  float* lists = smem;
  int* bexA = (int*)(smem + 4096);
  float* bgtA = smem + 6144;
  float* bsuA = smem + 8192;
  for (int item = blockIdx.x; item < T_TOK / 16; item += gridDim.x) {
    const int t0 = item * 16;
    __syncthreads();
    {
      const int tid = opq(threadIdx.x);
      const int tl = tid >> 4, hp = tid & 15;
      const f32x4* sp = (const f32x4*)(p.scores + (size_t)(t0 + tl) * DM + hp * 128);
      DECL16(k)
#pragma unroll 4
      for (int c4 = 0; c4 < 32; ++c4) {
        const f32x4 v = sp[c4];
#pragma unroll
        for (int e = 0; e < 4; ++e) {
          const float x = mkkey(v[e], 127u - (unsigned)(c4 * 4 + e), 127u);
          INS16(k, x)
        }
      }
      f32x4* lp = (f32x4*)(lists + (size_t)opq(threadIdx.x) * 16);
      f32x4 o0 = {k0, k1, k2, k3}, o1 = {k4, k5, k6, k7}, o2 = {k8, k9, k10, k11}, o3 = {k12, k13, k14, k15};
      lp[0] = o0; lp[1] = o1; lp[2] = o2; lp[3] = o3;
    }
    __syncthreads();
    if (opq(threadIdx.x) < 128) {
      const int tid = opq(threadIdx.x);
      const int tl = tid >> 3, h = tid & 7;
      const float* la = lists + (size_t)(tl * 16 + 2 * h) * 16;
      const float* lb = la + 16;
      float av[16], bv[16];
#pragma unroll
      for (int i = 0; i < 16; ++i) {
        av[i] = __uint_as_float(__float_as_uint(la[i]) & ~127u);
        bv[i] = __uint_as_float(__float_as_uint(lb[i]) & ~127u);
      }
      DECL16(c)
#pragma unroll
      for (int i = 0; i < 16; ++i) {
#pragma unroll
        for (int j = 0; j < 16; ++j) {
          if ((i + 1) * (j + 1) <= 16) {
            const float x = mkkey(av[i] + bv[j], 255u - (unsigned)(i * 16 + j), 255u);
            INS16(c, x)
          }
        }
      }
      float cs[16] = {c0, c1, c2, c3, c4, c5, c6, c7, c8, c9, c10, c11, c12, c13, c14, c15};
      float ev[16];
      float sum = 0.f;
      const float mx = __uint_as_float(__float_as_uint(cs[0]) & ~255u);
#pragma unroll
      for (int n = 0; n < 16; ++n) {
        ev[n] = __expf(__uint_as_float(__float_as_uint(cs[n]) & ~255u) - mx);
        sum += ev[n];
      }
      const float isum = 1.f / sum;
#pragma unroll
      for (int n = 0; n < 16; ++n) {
        const unsigned cc = 255u - (__float_as_uint(cs[n]) & 255u);
        const unsigned ka = 127u - (__float_as_uint(la[cc >> 4]) & 127u);
        const unsigned kb = 127u - (__float_as_uint(lb[cc & 15u]) & 127u);
        const int eid = (int)(ka * 128u + kb);
        bexA[tl * 128 + h * 16 + n] = eid;
        bgtA[tl * 128 + h * 16 + n] = ev[n] * isum * p.sv8[eid];
        bsuA[tl * 128 + h * 16 + n] = p.su8[eid];
      }
    }
    __syncthreads();
#pragma unroll 1
    for (int ti4 = 0; ti4 < 4; ++ti4) {
    const int lane = opq(threadIdx.x) & 63, wv = opq(threadIdx.x) >> 6;
    const int tl = wv * 4 + ti4;
    const int t = t0 + tl;
    const int* bex = bexA + tl * 128;
    const float* bgt = bgtA + tl * 128;
    const float* bsu = bsuA + tl * 128;
    XPk x;
    {
      const f32x4* s4 = (const f32x4*)(p.out + (size_t)t * DM) + lane * 8;
      const f32x4* g4 = (const f32x4*)p.norm_ffn + lane * 8;
      f32x4 a0 = s4[0], a1 = s4[1], a2 = s4[2], a3 = s4[3], a4 = s4[4], a5 = s4[5], a6 = s4[6], a7 = s4[7];
      float ss = 0.f;
#define SSQ(v) ss += v[0] * v[0] + v[1] * v[1] + v[2] * v[2] + v[3] * v[3];
      SSQ(a0) SSQ(a1) SSQ(a2) SSQ(a3) SSQ(a4) SSQ(a5) SSQ(a6) SSQ(a7)
#undef SSQ
      ss = wave_sum(ss);
      const float rs = rsqrtf(ss * (1.f / DM) + RMS_EPS);
#define XPK(dst, base, va, vb, gi)                                                    \
  {                                                                                   \
    const f32x4 ga = g4[gi], gb = g4[gi + 1];                                         \
    dst[base + 0] = bf2f(f2bf(va[0] * rs * ga[0])); dst[base + 1] = bf2f(f2bf(va[1] * rs * ga[1]));   \
    dst[base + 2] = bf2f(f2bf(va[2] * rs * ga[2])); dst[base + 3] = bf2f(f2bf(va[3] * rs * ga[3]));   \
    dst[base + 4] = bf2f(f2bf(vb[0] * rs * gb[0])); dst[base + 5] = bf2f(f2bf(vb[1] * rs * gb[1]));   \
    dst[base + 6] = bf2f(f2bf(vb[2] * rs * gb[2])); dst[base + 7] = bf2f(f2bf(vb[3] * rs * gb[3]));   \
  }
      XPK(x.a, 0, a0, a1, 0) XPK(x.a, 8, a2, a3, 2) XPK(x.b, 0, a4, a5, 4) XPK(x.b, 8, a6, a7, 6)
#undef XPK
    }
    Acc32 acc;
#pragma unroll
    for (int r = 0; r < 16; ++r) { acc.a[r] = 0.f; acc.b[r] = 0.f; }
    u32x4 u0 = r4_load(p.pu8, bex[0], lane), u1 = r4_load(p.pu8, bex[1], lane), u2 = r4_load(p.pu8, bex[2], lane), u3 = r4_load(p.pu8, bex[3], lane);
    u32x4 v0 = r4_load(p.pv8, bex[0], lane), v1 = r4_load(p.pv8, bex[1], lane), v2 = r4_load(p.pv8, bex[2], lane), v3 = r4_load(p.pv8, bex[3], lane);
#pragma unroll 1
    for (int e0 = 0; e0 < 128; e0 += 4) {
      float d0 = r4_dot(u0, x), d1 = r4_dot(u1, x), d2 = r4_dot(u2, x), d3 = r4_dot(u3, x);
      const int en = (e0 + 4 < 128) ? e0 + 4 : 124;
      const int i0 = bex[en], i1 = bex[en + 1], i2 = bex[en + 2], i3 = bex[en + 3];
      u0 = r4_load(p.pu8, i0, lane); u1 = r4_load(p.pu8, i1, lane); u2 = r4_load(p.pu8, i2, lane); u3 = r4_load(p.pu8, i3, lane);
#pragma unroll
      for (int o = 32; o > 0; o >>= 1) {
        d0 += __shfl_xor(d0, o); d1 += __shfl_xor(d1, o); d2 += __shfl_xor(d2, o); d3 += __shfl_xor(d3, o);
      }
      { const float hid = bgt[e0 + 0] * gelu_fast(d0 * bsu[e0 + 0]); r4_axpy(v0, hid, acc); }
      { const float hid = bgt[e0 + 1] * gelu_fast(d1 * bsu[e0 + 1]); r4_axpy(v1, hid, acc); }
      { const float hid = bgt[e0 + 2] * gelu_fast(d2 * bsu[e0 + 2]); r4_axpy(v2, hid, acc); }
      { const float hid = bgt[e0 + 3] * gelu_fast(d3 * bsu[e0 + 3]); r4_axpy(v3, hid, acc); }
      v0 = r4_load(p.pv8, i0, lane); v1 = r4_load(p.pv8, i1, lane); v2 = r4_load(p.pv8, i2, lane); v3 = r4_load(p.pv8, i3, lane);
    }
    const int lane2 = opq(lane);
    f32x4* o4 = (f32x4*)(p.out + (size_t)t * DM) + lane2 * 8;
    const f32x4* g4 = (const f32x4*)p.norm_final + lane2 * 8;
    f32x4 hv[8];
    float ss = 0.f;
#pragma unroll
    for (int i = 0; i < 8; ++i) {
      hv[i] = o4[i];
#pragma unroll
      for (int k = 0; k < 4; ++k) {
        hv[i][k] += (i < 4) ? acc.a[4 * i + k] : acc.b[4 * (i - 4) + k];
        ss += hv[i][k] * hv[i][k];
      }
    }
    ss = wave_sum(ss);
    const float rs = rsqrtf(ss * (1.f / DM) + RMS_EPS);
#pragma unroll
    for (int i = 0; i < 8; ++i) {
      const f32x4 g = g4[i];
      f32x4 o;
#pragma unroll
      for (int k = 0; k < 4; ++k) o[k] = hv[i][k] * rs * g[k];
      o4[i] = o;
    }
    }
  }
}

#define XB_TMO      128
#define XB_XCNT(j)  (256  + 64 * (j))
#define XB_XSUB(j)  (1280 + 64 * (j))
#define XB_XGEN(j)  (2304 + 64 * (j))
#define XB_TOP      3328
#define XB_TOPGEN   3392
#define XCD_BAR_WORDS 3456
#define XB_SPIN_CAP (1u << 22)
#define LAS __attribute__((address_space(3)))
__device__ __forceinline__ unsigned xb_ld(unsigned* p) { return __hip_atomic_load(p, __ATOMIC_RELAXED, __HIP_MEMORY_SCOPE_AGENT); }
__device__ __forceinline__ unsigned xb_add(unsigned* p, unsigned v) { return __hip_atomic_fetch_add(p, v, __ATOMIC_RELAXED, __HIP_MEMORY_SCOPE_AGENT); }
__device__ __forceinline__ unsigned xb_xcc_id() { return (unsigned)__builtin_amdgcn_s_getreg((3 << 11) | 20) & 0xFu; }
#define XB_SPIN(cond, bar) do { unsigned _sp = 0; while (cond) { __builtin_amdgcn_s_sleep(1); \
    if ((++_sp & 255u) == 0u) { if (xb_ld(&(bar)[XB_TMO])) break; if (_sp > XB_SPIN_CAP) { atomicAdd(&(bar)[XB_TMO], 1u); break; } } } } while (0)
struct XcdBarrier { unsigned* bar; unsigned x; volatile LAS unsigned* st; };
__device__ __forceinline__ XcdBarrier xcd_barrier_post(unsigned* bar, volatile LAS unsigned* st) {
  XcdBarrier b; b.bar = bar; b.x = xb_xcc_id(); b.st = st;
  if (threadIdx.x == 0) (void)xb_add(&bar[XB_XCNT(b.x)], 1u);
  return b;
}
__device__ __forceinline__ void xcd_barrier_complete(unsigned* bar, unsigned x, unsigned& nloc, unsigned& nx) {
  const unsigned G = gridDim.x * gridDim.y * gridDim.z;
  unsigned sum, cnt, mine, sp = 0u;
  for (;;) {
    sum = 0u; cnt = 0u; mine = 0u;
#pragma unroll
    for (unsigned j = 0; j < 16; ++j) { const unsigned c = xb_ld(&bar[XB_XCNT(j)]); sum += c; cnt += (c > 0u) ? 1u : 0u; mine = (j == x) ? c : mine; }
    if (sum == G) break;
    __builtin_amdgcn_s_sleep(1);
    if ((++sp & 255u) == 0u) { if (xb_ld(&bar[XB_TMO])) break; if (sp > XB_SPIN_CAP) { atomicAdd(&bar[XB_TMO], 1u); break; } }
  }
  nloc = mine > 0u ? mine : 1u; nx = cnt > 0u ? cnt : 1u;
}
__device__ __forceinline__ void xcd_barrier(const XcdBarrier& b) {
  asm volatile("s_waitcnt vmcnt(0)" ::: "memory");
  __syncthreads();
  if (threadIdx.x == 0) {
    unsigned* bar = b.bar;
    __builtin_amdgcn_s_waitcnt(0);
    unsigned nloc = b.st[0], nx = b.st[1];
    if (nloc == 0u) { xcd_barrier_complete(bar, b.x, nloc, nx); b.st[0] = nloc; b.st[1] = nx; }
    const unsigned old = xb_add(&bar[XB_XSUB(b.x)], 1u);
    const unsigned gen = old / nloc;
    if (old + 1u == (gen + 1u) * nloc) {
      __builtin_amdgcn_fence(__ATOMIC_RELEASE, "agent");
      asm volatile("s_waitcnt vmcnt(0)" ::: "memory");
      const unsigned og = xb_add(&bar[XB_TOP], 1u);
      const unsigned tg = og / nx;
      if (og + 1u == (tg + 1u) * nx) xb_add(&bar[XB_TOPGEN], 1u);
      else XB_SPIN(xb_ld(&bar[XB_TOPGEN]) == tg, bar);
      __builtin_amdgcn_fence(__ATOMIC_ACQUIRE, "agent");
      xb_add(&bar[XB_XGEN(b.x)], 1u);
      asm volatile("s_waitcnt vmcnt(0)" ::: "memory");
    } else {
      XB_SPIN(xb_ld(&bar[XB_XGEN(b.x)]) == gen, bar);
      __builtin_amdgcn_fence(__ATOMIC_ACQUIRE, "agent");
      asm volatile("s_waitcnt vmcnt(0)" ::: "memory");
    }
  }
  __syncthreads();
}

typedef const __attribute__((address_space(4))) P* KP;
__device__ __forceinline__ P loadP() {
#if defined(__HIP_DEVICE_COMPILE__)
  KP k = (KP)__builtin_amdgcn_kernarg_segment_ptr();
  asm volatile("" : "+s"(k));
  P p = *k;
  return p;
#else
  return P{};
#endif
}

__global__ void __launch_bounds__(256, 2) mega(P p_arg) {
  cg::grid_group grid = cg::this_grid();
  __shared__ __attribute__((aligned(16))) float smem[16384];
  char* lds = (char*)smem;
  __shared__ uint4 xb_words;
  if (threadIdx.x == 0) xb_words = make_uint4(0u, 0u, 0u, 0u);
  if (blockIdx.x == 0) {
    P p = loadP();
    for (int i = threadIdx.x; i < XCD_BAR_WORDS; i += 256) p.bar[i] = 0u;
  }
  { P p = loadP(); ph_rmsnorm(p.x, p.norm_mix, p.hn, T_TOK); ph_rmsnorm(p.mem, p.norm_mkv, p.memn, 1024); }
  { P p = loadP(); ph_transpose<true>(smem, p.w_in, DM, INC, 5760, p.WinT); }
  { P p = loadP(); ph_transpose<false>(smem, p.w_mk, DM, 512, 512, p.WmkT); }
  { P p = loadP(); ph_transpose<false>(smem, p.w_mv, DM, 512, 512, p.WmvT); }
  { P p = loadP(); ph_cvt(p.subk, p.subkb, (size_t)16 * 128 * 128); }
  { P p = loadP(); ph_transpose<false>(smem, p.w1_k, 4096, 128, 128, p.w1T); }
  { P p = loadP(); ph_transpose<false>(smem, p.w1_v, 4096, 128, 128, p.w1T + 128 * 4096); }
  { P p = loadP(); ph_transpose<false>(smem, p.w2_k, 128, 128, 128, p.w2T); }
  { P p = loadP(); ph_transpose<false>(smem, p.w2_v, 128, 128, 128, p.w2T + 128 * 128); }
  { P p = loadP(); ph_posb(p); }
  { P p = loadP(); for (int i = blockIdx.x * 256 + opq(threadIdx.x); i < 2 * T_TOK; i += gridDim.x * 256) p.rowss[i] = 0.f; }
  grid.sync();
  XcdBarrier xb;
  { P p = loadP(); xb = xcd_barrier_post(p.bar, (volatile LAS unsigned*)&xb_words); }
  { P p = loadP(); ph_proj(p, lds); }
  const int kvb = (gridDim.x == 512) ? (((int)blockIdx.x >= 320 && (int)blockIdx.x < 352) ? ((int)blockIdx.x - 320) * 8 : -1) : -2;
  const int vvb = (gridDim.x == 512) ? (((int)blockIdx.x >= 352 && (int)blockIdx.x < 384) ? ((int)blockIdx.x - 352) * 8 : -1) : -2;
  { P p = loadP(); bf16_t* kmem = p.kmemb;
    ph_gemm_bf16(p.memn, DM, p.WmkT, DM, 1024, 512, DM, lds, [=](int m, int n, float v) {
      kmem[((size_t)((m >> 8) * 4 + (n >> 7)) * 256 + (m & 255)) * 128 + (n & 127)] = f2bf(v); }, kvb); }
  { P p = loadP(); bf16_t* vmem = p.vmemT;
    ph_gemm_bf16(p.memn, DM, p.WmvT, DM, 1024, 512, DM, lds, [=](int m, int n, float v) {
      vmem[((size_t)((m >> 8) * 4 + (n >> 7)) * 128 + (n & 127)) * 256 + perm16(m & 255)] = f2bf(v); }, vvb); }
  xcd_barrier(xb);
  { P p = loadP(); ph_compress2(p, lds); }
  { P p = loadP(); ph_sb2(p, lds); }
  {
    const int skip = (gridDim.x > 32) ? 16 : 0;
    const int vb = ((int)blockIdx.x >= skip) ? (int)blockIdx.x - skip : -1, nvb = (int)gridDim.x - skip;
    __syncthreads();
    { P p = loadP(); ph_transpose<false>(smem, p.w_out, DM, DM, DM, p.WoutT, vb, nvb); }
    { P p = loadP(); ph_transpose<false>(smem, p.w_mq, DM, 512, 512, p.WmqT, vb, nvb); }
  }
  xcd_barrier(xb);
  { P p = loadP(); ph_nsa2(p, lds); }
  xcd_barrier(xb);
  { P p = loadP(); float* out = p.out; const float* x = p.x; const float* gmq = p.norm_mq; bf16_t* hn = p.hn; float* rss = p.rowss;
    ph_gemm_bf16<true>(p.omix, DM, p.WoutT, DM, T_TOK, DM, DM, lds, [=](int m, int n, f32x4_e lo, f32x4_e hi) {
      const f32x4_e x0 = *(const f32x4_e*)(x + (size_t)m * DM + n), x1 = *(const f32x4_e*)(x + (size_t)m * DM + n + 4);
      const f32x4_e h0 = x0 + lo, h1 = x1 + hi;
      *(f32x4_e*)(out + (size_t)m * DM + n) = h0; *(f32x4_e*)(out + (size_t)m * DM + n + 4) = h1;
      norm_feed(h0, h1, gmq, n, hn + (size_t)m * DM, rss + m); }); }
  xcd_barrier(xb);
  if (blockIdx.x < 256 || gridDim.x < 512) {
    P p = loadP(); bf16_t* qmem = p.qmemb; const float* rss = p.rowss;
    ph_gemm_bf16<true>(p.hn, DM, p.WmqT, DM, T_TOK, 512, DM, lds, [=](int m, int n, f32x4_e lo, f32x4_e hi) {
      const float rs = rsqrtf(rss[m] * (1.f / DM) + RMS_EPS);
      st_bf16x8(qmem + (size_t)m * 512 + n, lo * rs, hi * rs); });
  }
  {
    const int half = (gridDim.x >= 512) ? 256 : 0;
    if ((int)blockIdx.x >= half) {
      const int nwv = ((int)gridDim.x - half) * 4, wid = ((int)blockIdx.x - half) * 4 + (opq(threadIdx.x) >> 6);
      { P p = loadP(); ph_cvt4(p.pu, p.pu8, p.su8, 16384, wid, nwv); }
      if (gridDim.x < 512) { P p = loadP(); ph_cvt4(p.pv, p.pv8, p.sv8, 16384, wid, nwv); }
      __syncthreads();
      { P p = loadP(); ph_transpose<false>(smem, p.w_mo, 512, DM, DM, p.WmoT, (int)blockIdx.x - half, (int)gridDim.x - half); }
    }
  }
  xcd_barrier(xb);
  { P p = loadP(); ph_memattn2(p, lds); }
  if (gridDim.x >= 512 && blockIdx.x >= 256) {
    const int nwv = ((int)gridDim.x - 256) * 4, wid = ((int)blockIdx.x - 256) * 4 + (opq(threadIdx.x) >> 6);
    { P p = loadP(); ph_cvt4(p.pv, p.pv8, p.sv8, 16384, wid, nwv); }
  }
  {
    const int half = (gridDim.x >= 512) ? 256 : 0;
    __syncthreads();
    P p = loadP(); ph_transpose<false>(smem, p.w_pq, DM, DM, DM, p.WpqT, ((int)blockIdx.x >= half) ? (int)blockIdx.x - half : -1, (int)gridDim.x - half);
  }
  xcd_barrier(xb);
  { P p = loadP(); float* out = p.out; const float* gffn = p.norm_ffn; bf16_t* hn = p.hn; float* rss = p.rowss + T_TOK;
    ph_gemm_bf16<true>(p.omem, 512, p.WmoT, 512, T_TOK, DM, 512, lds, [=](int m, int n, f32x4_e lo, f32x4_e hi) {
      f32x4_e* o0 = (f32x4_e*)(out + (size_t)m * DM + n);
      const f32x4_e h0 = o0[0] + lo, h1 = o0[1] + hi;
      o0[0] = h0; o0[1] = h1;
      norm_feed(h0, h1, gffn, n, hn + (size_t)m * DM, rss + m); }); }
  xcd_barrier(xb);
  { P p = loadP(); ph_qp_scores(p, lds); }
  xcd_barrier(xb);
  { P p = loadP(); ph_peer(p, smem); }
}

extern "C" void kernel_launch(void* const* d_in, const int* in_sizes, int n_in, void* d_out, int out_size, void* d_ws,
                              size_t ws_size, hipStream_t stream) {
  P p{};
  p.x = (const float*)d_in[0]; p.mem = (const float*)d_in[1]; p.t5 = (const float*)d_in[2];
  p.norm_mix = (const float*)d_in[3]; p.w_in = (const float*)d_in[4]; p.pos_k = (const float*)d_in[5];
  p.w1_k = (const float*)d_in[6]; p.w2_k = (const float*)d_in[7]; p.pos_v = (const float*)d_in[8];
  p.w1_v = (const float*)d_in[9]; p.w2_v = (const float*)d_in[10]; p.w_out = (const float*)d_in[11];
  p.norm_mq = (const float*)d_in[12]; p.norm_mkv = (const float*)d_in[13]; p.w_mq = (const float*)d_in[14];
  p.w_mk = (const float*)d_in[15]; p.w_mv = (const float*)d_in[16]; p.w_mo = (const float*)d_in[17];
  p.norm_ffn = (const float*)d_in[18]; p.w_pq = (const float*)d_in[19]; p.subk = (const float*)d_in[20];
  p.pu = (const float*)d_in[21]; p.pv = (const float*)d_in[22]; p.norm_final = (const float*)d_in[23];
  p.out = (float*)d_out;
  char* w = (char*)d_ws;
  size_t off = 0;
  auto take = [&](size_t bytes) { char* r = w + off; off += (bytes + 255) & ~(size_t)255; return r; };
  p.bar = (unsigned*)take(XCD_BAR_WORDS * 4);
  p.scores = (float*)take((size_t)T_TOK * DM * 4);
  p.gates = (float*)take((size_t)T_TOK * 24 * 4);
  p.part = (float*)take((size_t)T_TOK * 1024 * 4);
  p.posb = (float*)take(256 * 4);
  p.rowss = (float*)take((size_t)2 * T_TOK * 4);
  p.qn = (bf16_t*)take((size_t)T_TOK * 1024 * 2);
  p.kcin = (bf16_t*)take((size_t)T_TOK * 256 * 2 + 65536);
  p.vcin = (bf16_t*)take((size_t)T_TOK * 256 * 2 + 65536);
  p.ks = (bf16_t*)take((size_t)T_TOK * 256 * 2);
  p.vsT = (bf16_t*)take((size_t)T_TOK * 256 * 2);
  p.kw = (bf16_t*)take((size_t)T_TOK * 256 * 2);
  p.vwT = (bf16_t*)take((size_t)T_TOK * 256 * 2);
  p.kcb = (bf16_t*)take((size_t)8 * 128 * 128 * 2);
  p.vcT = (bf16_t*)take((size_t)8 * 128 * 128 * 2);
  p.c1 = (bf16_t*)take((size_t)16 * 128 * 128 * 2);
  p.w1T = (bf16_t*)take((size_t)2 * 128 * 4096 * 2);
  p.w2T = (bf16_t*)take((size_t)2 * 128 * 128 * 2);
  p.hn = (bf16_t*)take((size_t)T_TOK * DM * 2);
  p.omix = (bf16_t*)take((size_t)T_TOK * DM * 2);
  p.memn = (bf16_t*)take((size_t)1024 * DM * 2);
  p.omem = (bf16_t*)take((size_t)T_TOK * 512 * 2);
  p.WinT = (bf16_t*)take((size_t)5760 * DM * 2);
  p.WoutT = (bf16_t*)take((size_t)DM * DM * 2);
  p.WpqT = (bf16_t*)take((size_t)DM * DM * 2);
  p.WmqT = (bf16_t*)take((size_t)512 * DM * 2);
  p.WmkT = (bf16_t*)take((size_t)512 * DM * 2);
  p.WmvT = (bf16_t*)take((size_t)512 * DM * 2);
  p.WmoT = (bf16_t*)take((size_t)DM * 512 * 2);
  p.qmemb = (bf16_t*)take((size_t)T_TOK * 512 * 2);
  p.kmemb = (bf16_t*)take((size_t)1024 * 512 * 2);
  p.vmemT = (bf16_t*)take((size_t)1024 * 512 * 2);
  p.qsb = (bf16_t*)take((size_t)T_TOK * 1024 * 2);
  p.ksb = (bf16_t*)take((size_t)T_TOK * 1024 * 2);
  p.vsbT = (bf16_t*)take((size_t)T_TOK * 1024 * 2);
  p.pu8 = (unsigned char*)take((size_t)16384 * 1024);
  p.pv8 = (unsigned char*)take((size_t)16384 * 1024);
  p.su8 = (float*)take(16384 * 4);
  p.sv8 = (float*)take(16384 * 4);
  p.subkb = (bf16_t*)take((size_t)16 * 128 * 128 * 2);
  static int grid_blocks = 0;
  if (!grid_blocks) {
    int dev = 0, cus = 0, per_cu = 0;
    (void)hipGetDevice(&dev);
    (void)hipDeviceGetAttribute(&cus, hipDeviceAttributeMultiprocessorCount, dev);
    (void)hipOccupancyMaxActiveBlocksPerMultiprocessor(&per_cu, mega, 256, 0);
    if (per_cu > 2) per_cu = 2;
    if (per_cu < 1) per_cu = 1;
    grid_blocks = cus * per_cu;
  }
  void* args[] = {&p};
  hipError_t e = hipLaunchCooperativeKernel((void*)mega, dim3(grid_blocks), dim3(256), args, 0, stream);
  if (e != hipSuccess) fprintf(stderr, "cooperative launch failed: %s (grid %d)\n", hipGetErrorString(e), grid_blocks);
}
```

```cpp
#include <hip/hip_runtime.h>
#include <hip/hip_cooperative_groups.h>
#include <cstdio>
namespace cg = cooperative_groups;
#include <stdint.h>

#define SEQ 2048
#define NBATCH 4
#define T_TOK 8192
#define DM 2048
#define INC 5656
#define C_QN 0
#define C_KC 1024
#define C_VC 1280
#define C_KS 1536
#define C_VS 1792
#define C_KW 2048
#define C_VW 2304
#define C_GT 2560
#define C_QSB 2584
#define C_KSB 3608
#define C_VSB 4632
#define ATT_SCALE 0.08838834764831845f
#define LOG2E 1.4426950408889634f
#define ATT_SCALE2 (ATT_SCALE * LOG2E)
#define RMS_EPS 1e-6f

typedef unsigned short bf16_t;
typedef __attribute__((ext_vector_type(8))) short bf16x8;
typedef __attribute__((ext_vector_type(16))) float f32x16;
typedef __attribute__((ext_vector_type(2))) __bf16 bf16v2;
typedef __attribute__((ext_vector_type(4))) unsigned u32x4;

struct P {
  const float *x, *mem, *t5, *norm_mix, *w_in, *pos_k, *w1_k, *w2_k, *pos_v, *w1_v, *w2_v, *w_out,
      *norm_mq, *norm_mkv, *w_mq, *w_mk, *w_mv, *w_mo, *norm_ffn, *w_pq, *subk, *pu, *pv, *norm_final;
  float* out;
  float *scores, *gates, *part, *posb, *rowss;
  unsigned* bar;
  bf16_t *hn, *omix, *memn, *omem;
  bf16_t *WinT, *WoutT, *WpqT, *WmqT, *WmkT, *WmvT, *WmoT;
  bf16_t *qmemb, *kmemb, *vmemT;
  bf16_t *qsb, *ksb, *vsbT;
  bf16_t* subkb;
  unsigned char *pu8, *pv8;
  float *su8, *sv8;
  bf16_t *qn, *kcin, *vcin, *ks, *vsT, *kw, *vwT, *kcb, *vcT, *c1, *w1T, *w2T;
};

__device__ __forceinline__ int opq(int v) { asm volatile("" : "+v"(v)); return v; }
__device__ __forceinline__ unsigned pack2(float a, float b) {
  bf16v2 r = {(__bf16)a, (__bf16)b};
  return *(unsigned*)&r;
}
__device__ __forceinline__ bf16_t f2bf(float a) {
  __bf16 r = (__bf16)a;
  return *(bf16_t*)&r;
}
__device__ __forceinline__ int perm16(int s) { return (s & ~12) | ((s & 4) << 1) | ((s & 8) >> 1); }
__device__ __forceinline__ float bf2f(bf16_t u) { return __uint_as_float((unsigned)u << 16); }

__device__ __forceinline__ float wave_max(float v) {
  for (int o = 32; o > 0; o >>= 1) v = fmaxf(v, __shfl_xor(v, o));
  return v;
}
__device__ __forceinline__ float wave_sum(float v) {
  for (int o = 32; o > 0; o >>= 1) v += __shfl_xor(v, o);
  return v;
}
__device__ __forceinline__ void wave_argmax(float& v, int& i) {
  for (int o = 32; o > 0; o >>= 1) {
    float ov = __shfl_xor(v, o);
    int oi = __shfl_xor(i, o);
    if (ov > v || (ov == v && oi < i)) { v = ov; i = oi; }
  }
}
__device__ __forceinline__ float gelu_tanh(float x) {
  return 0.5f * x * (1.f + tanhf(0.7978845608028654f * (x + 0.044715f * x * x * x)));
}
__device__ __forceinline__ float gelu_fast(float x) {
  const float y = 1.5957691216057308f * (x + 0.044715f * x * x * x);
  return x / (1.f + __expf(-y));
}
__device__ __forceinline__ int t5_bucket(int n) {
  if (n < 16) return n < 0 ? 0 : n;
  int b = 16;
  b += (n >= 19); b += (n >= 21); b += (n >= 24); b += (n >= 27); b += (n >= 31); b += (n >= 35);
  b += (n >= 40); b += (n >= 46); b += (n >= 52); b += (n >= 59); b += (n >= 67); b += (n >= 77);
  b += (n >= 87); b += (n >= 99); b += (n >= 113);
  return b;
}
__device__ __forceinline__ float log_sigmoid(float x) {
  return fminf(x, 0.f) - log1pf(expf(-fabsf(x)));
}

__device__ __forceinline__ void ph_rmsnorm(const float* src, const float* gain, bf16_t* dst, int rows) {
  int lane = opq(threadIdx.x) & 63, wv = opq(threadIdx.x) >> 6;
  for (int r = blockIdx.x * 4 + wv; r < rows; r += gridDim.x * 4) {
    const float4* s4 = (const float4*)(src + (size_t)r * DM);
    float4 v[8];
    float ss = 0.f;
#pragma unroll
    for (int i = 0; i < 8; ++i) {
      v[i] = s4[i * 64 + lane];
      ss += v[i].x * v[i].x + v[i].y * v[i].y + v[i].z * v[i].z + v[i].w * v[i].w;
    }
    ss = wave_sum(ss);
    float rs = rsqrtf(ss * (1.f / DM) + RMS_EPS);
    uint2* d2 = (uint2*)(dst + (size_t)r * DM);
    const float4* g4 = (const float4*)gain;
#pragma unroll
    for (int i = 0; i < 8; ++i) {
      float4 g = g4[i * 64 + lane];
      uint2 o;
      o.x = pack2(v[i].x * rs * g.x, v[i].y * rs * g.y);
      o.y = pack2(v[i].z * rs * g.z, v[i].w * rs * g.w);
      d2[i * 64 + lane] = o;
    }
  }
}

template <bool CMAP>
__device__ __forceinline__ void ph_transpose(float* smem, const float* W, int K, int N, int Npad, bf16_t* Wt,
                                             int vblock = -2, int nvb = 0) {
  typedef __attribute__((ext_vector_type(4))) float f32x4;
  float (*tl)[65] = (float (*)[65])smem;
  if (vblock == -1) return;
  const int b0 = (vblock >= 0) ? vblock : (int)blockIdx.x, bstride = (vblock >= 0) ? nvb : (int)gridDim.x;
  const int tid = opq(threadIdx.x);
  const int nk = K / 64, nn = Npad / 64;
  for (int tile = b0; tile < nk * nn; tile += bstride) {
    const int k0 = (tile % nk) * 64, n0 = (tile / nk) * 64;
    const int kr = tid >> 4, n4 = (tid & 15) * 4;
    int sc = n0 + n4;
    if (CMAP) sc = (sc < 2560) ? sc : (sc < 5632) ? sc + 24 : (sc < 5656) ? sc - 5632 + 2560 : N;
#pragma unroll
    for (int i = 0; i < 4; ++i) {
      const int k = kr + 16 * i;
      f32x4 v = {0.f, 0.f, 0.f, 0.f};
      if (sc < N) v = *(const f32x4*)(W + (size_t)(k0 + k) * N + sc);
      tl[k][n4 + 0] = v[0]; tl[k][n4 + 1] = v[1]; tl[k][n4 + 2] = v[2]; tl[k][n4 + 3] = v[3];
    }
    __syncthreads();
    int n = tid >> 2, kc = (tid & 3) * 16;
    unsigned w[8];
#pragma unroll
    for (int i = 0; i < 8; ++i) w[i] = pack2(tl[kc + 2 * i][n], tl[kc + 2 * i + 1][n]);
    uint4* dst = (uint4*)(Wt + (size_t)(n0 + n) * K + k0 + kc);
    dst[0] = make_uint4(w[0], w[1], w[2], w[3]);
    dst[1] = make_uint4(w[4], w[5], w[6], w[7]);
    __syncthreads();
  }
}

__device__ __forceinline__ int lds_off(int row, int chunk) { return row * 128 + ((chunk ^ ((row >> 1) & 7)) << 4); }

template <bool TR, bool VEC = false, class Epi>
__device__ __forceinline__ void gemm_tile_bf16(const bf16_t* xp, int ldx, const bf16_t* yp, int ldy, int K, char* lds,
                                               Epi epi) {
  const int tid = opq(threadIdx.x), lane = tid & 63, wv = tid >> 6;
  const int wr = wv >> 1, wc = wv & 1;
  f32x16 acc[2][2];
#pragma unroll
  for (int i = 0; i < 2; ++i)
#pragma unroll
    for (int j = 0; j < 2; ++j)
#pragma unroll
      for (int r = 0; r < 16; ++r) acc[i][j][r] = 0.f;
  const int prow = lane >> 3, pch = lane & 7;
  const bf16_t* xs[4];
  const bf16_t* ys[4];
#pragma unroll
  for (int ps = 0; ps < 4; ++ps) {
    const int row = (wv * 4 + ps) * 8 + prow;
    const int c = pch ^ ((row >> 1) & 7);
    xs[ps] = xp + (size_t)row * ldx + c * 8;
    ys[ps] = yp + (size_t)row * ldy + c * 8;
  }
  char* const mydst = lds + wv * 4096 + lane * 16;
#define GEMM_ISSUE(k0, bufoff)                                                                                              \
  _Pragma("unroll") for (int ps = 0; ps < 4; ++ps) {                                                                        \
    __builtin_amdgcn_global_load_lds((const unsigned*)(xs[ps] + (k0)), (unsigned*)(mydst + (bufoff) + ps * 1024), 16, 0, 0);         \
    __builtin_amdgcn_global_load_lds((const unsigned*)(ys[ps] + (k0)), (unsigned*)(mydst + (bufoff) + 16384 + ps * 1024), 16, 0, 0); \
  }
#define GEMM_COMPUTE(bufoff)                                                                                     \
  _Pragma("unroll") for (int kk = 0; kk < 4; ++kk) {                                                             \
    bf16x8 a[2], b[2];                                                                                           \
    const int ch = kk * 2 + (lane >> 5);                                                                         \
    _Pragma("unroll") for (int i = 0; i < 2; ++i) {                                                              \
      a[i] = *(const bf16x8*)(lds + (bufoff) + (TR ? 16384 : 0) + lds_off(wr * 64 + i * 32 + (lane & 31), ch)); \
      b[i] = *(const bf16x8*)(lds + (bufoff) + (TR ? 0 : 16384) + lds_off(wc * 64 + i * 32 + (lane & 31), ch)); \
    }                                                                                                            \
    _Pragma("unroll") for (int i = 0; i < 2; ++i)                                                                \
      _Pragma("unroll") for (int j = 0; j < 2; ++j)                                                              \
        acc[i][j] = __builtin_amdgcn_mfma_f32_32x32x16_bf16(a[i], b[j], acc[i][j], 0, 0, 0);                    \
  }
  __syncthreads();
  GEMM_ISSUE(0, 0)
  for (int k0 = 0; k0 < K; k0 += 128) {
    asm volatile("s_waitcnt vmcnt(0)" ::: "memory");
    __syncthreads();
    GEMM_ISSUE(k0 + 64, 32768)
    GEMM_COMPUTE(0)
    asm volatile("s_waitcnt vmcnt(0)" ::: "memory");
    __syncthreads();
    if (k0 + 128 < K) { GEMM_ISSUE(k0 + 128, 0) }
    GEMM_COMPUTE(32768)
  }
#undef GEMM_ISSUE
#undef GEMM_COMPUTE
  int lane2 = lane;
  asm volatile("" : "+v"(lane2));
  if constexpr (VEC) {
    typedef __attribute__((ext_vector_type(4))) float f32x4;
    __syncthreads();
    float* wl = (float*)lds + wv * (32 * 68);
    const int hh2 = lane2 >> 5, cl = lane2 & 31;
#pragma unroll
    for (int i = 0; i < 2; ++i) {
#pragma unroll
      for (int j = 0; j < 2; ++j)
#pragma unroll
        for (int r = 0; r < 16; ++r) wl[((r & 3) + 8 * (r >> 2) + 4 * hh2) * 68 + j * 32 + cl] = acc[i][j][r];
      __builtin_amdgcn_wave_barrier();
#pragma unroll
      for (int k = 0; k < 4; ++k) {
        const int row = (lane2 >> 3) + 8 * k, c8 = (lane2 & 7) * 8;
        const f32x4 lo = *(const f32x4*)&wl[row * 68 + c8];
        const f32x4 hi = *(const f32x4*)&wl[row * 68 + c8 + 4];
        epi(wr * 64 + i * 32 + row, wc * 64 + c8, lo, hi);
      }
      __builtin_amdgcn_wave_barrier();
    }
  } else {
#pragma unroll
    for (int i = 0; i < 2; ++i)
#pragma unroll
      for (int j = 0; j < 2; ++j)
#pragma unroll
        for (int r = 0; r < 16; ++r) {
          int rr = wr * 64 + i * 32 + (r & 3) + 8 * (r >> 2) + 4 * (lane2 >> 5);
          int cc = wc * 64 + j * 32 + (lane2 & 31);
          epi(rr, cc, acc[i][j][r]);
        }
  }
}

typedef __attribute__((ext_vector_type(4))) float f32x4_e;
__device__ __forceinline__ void st_bf16x8(bf16_t* dst, f32x4_e lo, f32x4_e hi) {
  u32x4 o;
  o[0] = pack2(lo[0], lo[1]); o[1] = pack2(lo[2], lo[3]); o[2] = pack2(hi[0], hi[1]); o[3] = pack2(hi[2], hi[3]);
  *(u32x4*)dst = o;
}

__device__ __forceinline__ int lds_off32(int row, int chunk) { return row * 64 + ((chunk ^ ((row >> 2) & 3)) << 4); }

template <class Epi>
__device__ __forceinline__ void gemm_tile_big(const bf16_t* xp, int ldx, const bf16_t* yp, int ldy, int K, char* lds,
                                              Epi epi) {
  const int tid = opq(threadIdx.x), lane = tid & 63, wv = tid >> 6;
  f32x16 acc[2][4];
#pragma unroll
  for (int i = 0; i < 2; ++i)
#pragma unroll
    for (int j = 0; j < 4; ++j)
#pragma unroll
      for (int r = 0; r < 16; ++r) acc[i][j][r] = 0.f;
  const int prow = lane >> 2, pch = lane & 3;
  const bf16_t* xs[4];
  const bf16_t* ys[2];
#pragma unroll
  for (int ps = 0; ps < 4; ++ps) {
    const int row = (wv * 4 + ps) * 16 + prow;
    xs[ps] = xp + (size_t)row * ldx + (pch ^ ((row >> 2) & 3)) * 8;
  }
#pragma unroll
  for (int ps = 0; ps < 2; ++ps) {
    const int row = (wv * 2 + ps) * 16 + prow;
    ys[ps] = yp + (size_t)row * ldy + (pch ^ ((row >> 2) & 3)) * 8;
  }
  char* const xdst = lds + wv * 4096 + lane * 16;
  char* const ydst = lds + 16384 + wv * 2048 + lane * 16;
#define BIG_ISSUE(k0, st)                                                                                                      \
  _Pragma("unroll") for (int ps = 0; ps < 4; ++ps)                                                                             \
    __builtin_amdgcn_global_load_lds((const unsigned*)(xs[ps] + (k0)), (unsigned*)(xdst + (st) + ps * 1024), 16, 0, 0);        \
  _Pragma("unroll") for (int ps = 0; ps < 2; ++ps)                                                                             \
    __builtin_amdgcn_global_load_lds((const unsigned*)(ys[ps] + (k0)), (unsigned*)(ydst + (st) + ps * 1024), 16, 0, 0);
#define BIG_COMPUTE(st)                                                                                   \
  _Pragma("unroll") for (int kk = 0; kk < 2; ++kk) {                                                      \
    bf16x8 a[2], b[4];                                                                                    \
    const int ch = kk * 2 + (lane >> 5);                                                                  \
    _Pragma("unroll") for (int i = 0; i < 2; ++i)                                                         \
      a[i] = *(const bf16x8*)(lds + (st) + lds_off32(wv * 64 + i * 32 + (lane & 31), ch));                \
    _Pragma("unroll") for (int j = 0; j < 4; ++j)                                                         \
      b[j] = *(const bf16x8*)(lds + (st) + 16384 + lds_off32(j * 32 + (lane & 31), ch));                  \
    _Pragma("unroll") for (int i = 0; i < 2; ++i)                                                         \
      _Pragma("unroll") for (int j = 0; j < 4; ++j)                                                       \
        acc[i][j] = __builtin_amdgcn_mfma_f32_32x32x16_bf16(a[i], b[j], acc[i][j], 0, 0, 0);             \
  }
  __syncthreads();
  BIG_ISSUE(0, 0)
  for (int k0 = 0; k0 < K; k0 += 64) {
    asm volatile("s_waitcnt vmcnt(0)" ::: "memory");
    __syncthreads();
    BIG_ISSUE(k0 + 32, 24576)
    BIG_COMPUTE(0)
    asm volatile("s_waitcnt vmcnt(0)" ::: "memory");
    __syncthreads();
    if (k0 + 64 < K) { BIG_ISSUE(k0 + 64, 0) }
    BIG_COMPUTE(24576)
  }
#undef BIG_ISSUE
#undef BIG_COMPUTE
  const int lane2 = opq(lane);
  typedef __attribute__((ext_vector_type(4))) float f32x4;
  __syncthreads();
  float* wl = (float*)lds + wv * (32 * 68);
  const int hh2 = lane2 >> 5, cl = lane2 & 31;
#pragma unroll
  for (int i = 0; i < 2; ++i)
#pragma unroll
    for (int jh = 0; jh < 2; ++jh) {
#pragma unroll
      for (int j = 0; j < 2; ++j)
#pragma unroll
        for (int r = 0; r < 16; ++r) wl[((r & 3) + 8 * (r >> 2) + 4 * hh2) * 68 + j * 32 + cl] = acc[i][jh * 2 + j][r];
      __builtin_amdgcn_wave_barrier();
#pragma unroll
      for (int k = 0; k < 4; ++k) {
        const int row = (lane2 >> 3) + 8 * k, c8 = (lane2 & 7) * 8;
        const f32x4 lo = *(const f32x4*)&wl[row * 68 + c8];
        const f32x4 hi = *(const f32x4*)&wl[row * 68 + c8 + 4];
        epi(wv * 64 + i * 32 + row, jh * 64 + c8, lo, hi);
      }
      __builtin_amdgcn_wave_barrier();
    }
}

template <class Epi>
__device__ __forceinline__ void ph_gemm_big(const bf16_t* A, int lda, const bf16_t* Wt, int ldw, int M, int N, int K,
                                            char* lds, Epi epi) {
  const int ntm = M / 256, ntn = N / 128;
  const int npm = (ntm + 7) / 8, npn = (ntn + 7) / 8;
  const int nslots = ((npm * npn * 64 + 511) / 512) * 512;
  for (int u = blockIdx.x; u < nslots; u += gridDim.x) {
    int v = (u & 7) * 64 + ((u >> 3) & 63) + (u & ~511);
    int patch = v >> 6, w = v & 63;
    int tm = (patch % npm) * 8 + (w & 7);
    int tn = (patch / npm) * 8 + (w >> 3);
    if (tm >= ntm || tn >= ntn) continue;
    const int m0 = tm * 256, n0 = tn * 128;
    gemm_tile_big(A + (size_t)m0 * lda, lda, Wt + (size_t)n0 * ldw, ldw, K, lds,
                  [&](int r, int c, f32x4_e lo, f32x4_e hi) { epi(m0 + r, n0 + c, lo, hi); });
  }
}

__device__ __forceinline__ void norm_feed(const f32x4_e h0, const f32x4_e h1, const float* gain, int n, bf16_t* hn_row,
                                          float* rowss_m) {
  const f32x4_e g0 = *(const f32x4_e*)(gain + n), g1 = *(const f32x4_e*)(gain + n + 4);
  st_bf16x8(hn_row + n, h0 * g0, h1 * g1);
  float ss = h0[0] * h0[0] + h0[1] * h0[1] + h0[2] * h0[2] + h0[3] * h0[3] + h1[0] * h1[0] + h1[1] * h1[1] + h1[2] * h1[2] + h1[3] * h1[3];
  ss += __shfl_xor(ss, 1);
  ss += __shfl_xor(ss, 2);
  ss += __shfl_xor(ss, 4);
  if (((opq(threadIdx.x)) & 7) == 0) atomicAdd(rowss_m, ss);
}

template <bool VEC = false, class Epi>
__device__ __forceinline__ void ph_gemm_bf16(const bf16_t* A, int lda, const bf16_t* Wt, int ldw, int M, int N, int K,
                                             char* lds, Epi epi, int vblock = -2) {
  const int ntm = M / 128, ntn = N / 128;
  const int npm = (ntm + 7) / 8, npn = (ntn + 7) / 8;
  const int nslots = ((npm * npn * 64 + 511) / 512) * 512;
  if (vblock == -1) return;
  for (int u = (vblock >= 0 ? vblock : (int)blockIdx.x); u < nslots; u += gridDim.x) {
    int v = (u & 7) * 64 + ((u >> 3) & 63) + (u & ~511);
    int patch = v >> 6, w = v & 63;
    int tm = (patch % npm) * 8 + (w & 7);
    int tn = (patch / npm) * 8 + (w >> 3);
    if (tm >= ntm || tn >= ntn) continue;
    const int m0 = tm * 128, n0 = tn * 128;
    if constexpr (VEC)
      gemm_tile_bf16<false, true>(A + (size_t)m0 * lda, lda, Wt + (size_t)n0 * ldw, ldw, K, lds,
                                  [&](int r, int c, f32x4_e lo, f32x4_e hi) { epi(m0 + r, n0 + c, lo, hi); });
    else
      gemm_tile_bf16<false>(A + (size_t)m0 * lda, lda, Wt + (size_t)n0 * ldw, ldw, K, lds,
                            [&](int r, int c, float val) { epi(m0 + r, n0 + c, val); });
  }
}

__device__ __forceinline__ void ph_proj(const P& p, char* lds) {
  for (int u = blockIdx.x; u < 1024; u += gridDim.x) {
    int v = (u & 7) * 64 + ((u >> 3) & 63) + (u & ~511);
    int patch = v >> 6, w = v & 63;
    const int tm = (patch & 3) * 8 + (w & 7), tb = (patch >> 2) * 8 + (w >> 3);
    const int tn = (tb < 14) ? tb : (tb < 16) ? tb + 2 : tb + 4;
    const int m0 = tm * 256, n0 = tn * 128;
    const int b = m0 >> 11, sl = m0 & 2047;
    const bf16_t* A = p.hn + (size_t)m0 * DM;
    const bf16_t* W = p.WinT + (size_t)n0 * DM;
    bf16_t* dst;
    int ldd;
    if (n0 < 1024) { dst = p.qn + (size_t)m0 * 1024 + n0; ldd = 1024; }
    else if (n0 < 2560) {
      const int seg = (n0 - 1024) >> 8, g = ((n0 - 1024) >> 7) & 1;
      bf16_t* base = (seg == 0) ? p.kcin : (seg == 1) ? p.vcin : (seg == 2) ? p.ks : p.kw;
      dst = base + ((size_t)(b * 2 + g) * SEQ + sl) * 128; ldd = 128;
    } else if (n0 < 3584) { dst = p.qsb + (size_t)m0 * 1024 + (n0 - 2560); ldd = 1024; }
    else { dst = p.ksb + ((size_t)(b * 8 + ((n0 - 3584) >> 7)) * SEQ + sl) * 128; ldd = 128; }
    gemm_tile_big(A, DM, W, DM, DM, lds, [&](int r, int c, f32x4_e lo, f32x4_e hi) { st_bf16x8(dst + (size_t)r * ldd + c, lo, hi); });
  }
  for (int u = blockIdx.x; u < 64 * 13; u += gridDim.x) {
    const int tm = u & 63, ts = u >> 6;
    const int tn = (ts < 2) ? 14 + ts : (ts < 4) ? 16 + ts : (ts < 12) ? 32 + ts : 44;
    const int m0 = tm * 128, n0 = tn * 128;
    const int b = m0 >> 11, sl = m0 & 2047;
    const bf16_t* A = p.hn + (size_t)m0 * DM;
    const bf16_t* W = p.WinT + (size_t)n0 * DM;
    if (n0 < 2560) {
      const int seg = (n0 - 1024) >> 8, g = ((n0 - 1024) >> 7) & 1;
      bf16_t* vd = (seg == 3 ? p.vsT : p.vwT) + ((size_t)(b * 2 + g) * 128) * SEQ + sl;
      gemm_tile_bf16<true>(A, DM, W, DM, DM, lds, [&](int r, int c, float val) { vd[(size_t)r * SEQ + perm16(c)] = f2bf(val); });
    } else if (n0 < 5632) {
      bf16_t* vd = p.vsbT + ((size_t)(b * 8 + ((n0 - 4608) >> 7)) * 128) * SEQ + sl;
      gemm_tile_bf16<true>(A, DM, W, DM, DM, lds, [&](int r, int c, float val) { vd[(size_t)r * SEQ + perm16(c)] = f2bf(val); });
    } else {
      float* gd = p.gates + (size_t)m0 * 24;
      gemm_tile_bf16<false>(A, DM, W, DM, DM, lds, [&](int r, int c, float val) { if (c < 24) gd[(size_t)r * 24 + c] = val; });
    }
  }
}

__device__ __forceinline__ void ph_posb(const P& p) {
  const int lane = opq(threadIdx.x) & 63, wv = opq(threadIdx.x) >> 6;
  for (int o = blockIdx.x * 4 + wv; o < 256; o += gridDim.x * 4) {
    const int which = o >> 7, n = o & 127;
    const float* pos = which ? p.pos_v : p.pos_k;
    const float* w1 = which ? p.w1_v : p.w1_k;
    float acc = 0.f;
    for (int k = lane; k < 4096; k += 64) acc += pos[k] * w1[(size_t)k * 128 + n];
    acc = wave_sum(acc);
    if (lane == 0) p.posb[o] = acc;
  }
}

__device__ __forceinline__ void ph_compress2(const P& p, char* lds) {
  for (int item = blockIdx.x; item < 16; item += gridDim.x) {
    const int which = item >> 3, bg = item & 7;
    const bf16_t* src = (which ? p.vcin : p.kcin) + (size_t)bg * SEQ * 128;
    const bf16_t* w1t = p.w1T + (size_t)which * 128 * 4096;
    const bf16_t* w2t = p.w2T + (size_t)which * 128 * 128;
    const float* posb = p.posb + which * 128;
    bf16_t* c1 = p.c1 + (size_t)item * 128 * 128;
    gemm_tile_bf16<false>(src, 2048, w1t, 4096, 4096, lds, [&](int r, int c, float val) {
      c1[r * 128 + c] = f2bf(gelu_fast(val + posb[c])); });
    __threadfence_block();
    __syncthreads();
    if (which == 0) {
      bf16_t* kd = p.kcb + (size_t)bg * 128 * 128;
      gemm_tile_bf16<false>(c1, 128, w2t, 128, 128, lds, [&](int r, int c, float val) { kd[r * 128 + c] = f2bf(val); });
    } else {
      bf16_t* vd = p.vcT + (size_t)bg * 128 * 128;
      gemm_tile_bf16<true>(c1, 128, w2t, 128, 128, lds, [&](int r, int c, float val) { vd[r * 128 + perm16(c)] = f2bf(val); });
    }
  }
}

#define NEG_BIG (-1e30f)

struct KVRegs { u32x4 k0, k1, k2, k3, v0, v1, v2, v3; };

__device__ __forceinline__ int koff(int row, int chunk) { return row * 256 + ((chunk ^ (row & 15)) << 4); }

__device__ __forceinline__ void kv_load(KVRegs& r, const bf16_t* kp, int ldk, const bf16_t* vp, int ldv) {
  const int tid = opq(threadIdx.x);
  const bf16_t* kg = kp + (size_t)(tid >> 4) * ldk + (tid & 15) * 8;
  r.k0 = *(const u32x4*)kg;
  r.k1 = *(const u32x4*)(kg + (size_t)16 * ldk);
  r.k2 = *(const u32x4*)(kg + (size_t)32 * ldk);
  r.k3 = *(const u32x4*)(kg + (size_t)48 * ldk);
  const bf16_t* vg = vp + (size_t)(tid >> 3) * ldv + (tid & 7) * 8;
  r.v0 = *(const u32x4*)vg;
  r.v1 = *(const u32x4*)(vg + (size_t)32 * ldv);
  r.v2 = *(const u32x4*)(vg + (size_t)64 * ldv);
  r.v3 = *(const u32x4*)(vg + (size_t)96 * ldv);
}
__device__ __forceinline__ void kv_store(const KVRegs& r, char* lk, char* lv) {
  const int tid = opq(threadIdx.x);
  const int row = tid >> 4, ch = tid & 15;
  *(u32x4*)(lk + koff(row, ch)) = r.k0;
  *(u32x4*)(lk + koff(row + 16, ch)) = r.k1;
  *(u32x4*)(lk + koff(row + 32, ch)) = r.k2;
  *(u32x4*)(lk + koff(row + 48, ch)) = r.k3;
  const int vr = tid >> 3, vc = tid & 7;
  *(u32x4*)(lv + lds_off(vr, vc)) = r.v0;
  *(u32x4*)(lv + lds_off(vr + 32, vc)) = r.v1;
  *(u32x4*)(lv + lds_off(vr + 64, vc)) = r.v2;
  *(u32x4*)(lv + lds_off(vr + 96, vc)) = r.v3;
}

struct QFrag { bf16x8 f0, f1, f2, f3, f4, f5, f6, f7; };
__device__ __forceinline__ void q_load(QFrag& q, const bf16_t* qrow) {
  const int h = (opq(threadIdx.x) & 63) >> 5;
  const bf16x8* p8 = (const bf16x8*)(qrow + 8 * h);
  q.f0 = p8[0]; q.f1 = p8[2]; q.f2 = p8[4]; q.f3 = p8[6]; q.f4 = p8[8]; q.f5 = p8[10]; q.f6 = p8[12]; q.f7 = p8[14];
}

__device__ __forceinline__ void qk_tile(const QFrag& q, const char* lk, f32x16& s0, f32x16& s1) {
  const int lane = opq(threadIdx.x) & 63, row = lane & 31, h = lane >> 5;
#pragma unroll
  for (int r = 0; r < 16; ++r) { s0[r] = 0.f; s1[r] = 0.f; }
#define QK_STEP(kk, qf)                                                                  \
  {                                                                                      \
    bf16x8 a0 = *(const bf16x8*)(lk + koff(row, 2 * (kk) + h));                          \
    bf16x8 a1 = *(const bf16x8*)(lk + koff(row + 32, 2 * (kk) + h));                     \
    s0 = __builtin_amdgcn_mfma_f32_32x32x16_bf16(a0, qf, s0, 0, 0, 0);                   \
    s1 = __builtin_amdgcn_mfma_f32_32x32x16_bf16(a1, qf, s1, 0, 0, 0);                   \
  }
  QK_STEP(0, q.f0) QK_STEP(1, q.f1) QK_STEP(2, q.f2) QK_STEP(3, q.f3)
  QK_STEP(4, q.f4) QK_STEP(5, q.f5) QK_STEP(6, q.f6) QK_STEP(7, q.f7)
#undef QK_STEP
}

__device__ __forceinline__ bf16x8 pack8(const f32x16& p, const int base) {
  u32x4 u;
  u[0] = pack2(p[base + 0], p[base + 1]);
  u[1] = pack2(p[base + 2], p[base + 3]);
  u[2] = pack2(p[base + 4], p[base + 5]);
  u[3] = pack2(p[base + 6], p[base + 7]);
  return __builtin_bit_cast(bf16x8, u);
}

typedef __attribute__((ext_vector_type(2))) unsigned u32x2_t;
__device__ __forceinline__ float xhalf_max(float v) {
  const u32x2_t r = __builtin_amdgcn_permlane32_swap(__float_as_uint(v), __float_as_uint(v), false, false);
  return fmaxf(__uint_as_float(r[0]), __uint_as_float(r[1]));
}
__device__ __forceinline__ float xhalf_sum(float v) {
  const u32x2_t r = __builtin_amdgcn_permlane32_swap(__float_as_uint(v), __float_as_uint(v), false, false);
  return __uint_as_float(r[0]) + __uint_as_float(r[1]);
}
__device__ __forceinline__ float xhalf_get(float v, int hh) {
  const u32x2_t r = __builtin_amdgcn_permlane32_swap(__float_as_uint(v), __float_as_uint(v), false, false);
  return hh ? __uint_as_float(r[0]) : __uint_as_float(r[1]);
}
struct OAcc { f32x16 o0, o1, o2, o3; };
__device__ __forceinline__ void oacc_zero(OAcc& o) {
#pragma unroll
  for (int r = 0; r < 16; ++r) { o.o0[r] = 0.f; o.o1[r] = 0.f; o.o2[r] = 0.f; o.o3[r] = 0.f; }
}
__device__ __forceinline__ void oacc_scale(OAcc& o, float a) {
#pragma unroll
  for (int r = 0; r < 16; ++r) { o.o0[r] *= a; o.o1[r] *= a; o.o2[r] *= a; o.o3[r] *= a; }
}

__device__ __forceinline__ void pv_tile(OAcc& o, const char* lv, const f32x16& p0, const f32x16& p1) {
  const int lane = opq(threadIdx.x) & 63, row = lane & 31, h = lane >> 5;
  const bf16x8 pf0 = pack8(p0, 0), pf1 = pack8(p0, 8), pf2 = pack8(p1, 0), pf3 = pack8(p1, 8);
#define PV_ROW(dd, acc)                                                                                      \
  {                                                                                                          \
    acc = __builtin_amdgcn_mfma_f32_32x32x16_bf16(*(const bf16x8*)(lv + lds_off(32 * (dd) + row, 0 + h)), pf0, acc, 0, 0, 0); \
    acc = __builtin_amdgcn_mfma_f32_32x32x16_bf16(*(const bf16x8*)(lv + lds_off(32 * (dd) + row, 2 + h)), pf1, acc, 0, 0, 0); \
    acc = __builtin_amdgcn_mfma_f32_32x32x16_bf16(*(const bf16x8*)(lv + lds_off(32 * (dd) + row, 4 + h)), pf2, acc, 0, 0, 0); \
    acc = __builtin_amdgcn_mfma_f32_32x32x16_bf16(*(const bf16x8*)(lv + lds_off(32 * (dd) + row, 6 + h)), pf3, acc, 0, 0, 0); \
  }
  PV_ROW(0, o.o0) PV_ROW(1, o.o1) PV_ROW(2, o.o2) PV_ROW(3, o.o3)
#undef PV_ROW
}

__device__ __forceinline__ void softmax_tile(f32x16& s0, f32x16& s1, float& m, float& l, OAcc& o) {
  float mx = NEG_BIG;
#pragma unroll
  for (int r = 0; r < 16; ++r) mx = fmaxf(mx, fmaxf(s0[r], s1[r]));
  mx = xhalf_max(mx);
  const float mn = fmaxf(m, mx);
  const float alpha = __builtin_amdgcn_exp2f(m - mn);
  float ls = 0.f;
#pragma unroll
  for (int r = 0; r < 16; ++r) {
    const float a = __builtin_amdgcn_exp2f(s0[r] - mn);
    const float b = __builtin_amdgcn_exp2f(s1[r] - mn);
    s0[r] = a; s1[r] = b;
    ls += a + b;
  }
  ls = xhalf_sum(ls);
  l = l * alpha + ls;
  m = mn;
  if (__any(alpha != 1.f)) oacc_scale(o, alpha);
}

template <class F>
__device__ __forceinline__ void oacc_foreach(const OAcc& o, F f) {
  const int h = (opq(threadIdx.x) & 63) >> 5;
#pragma unroll
  for (int rho = 0; rho < 4; ++rho) {
    f(0 + 8 * rho + 4 * h, o.o0[4 * rho], o.o0[4 * rho + 1], o.o0[4 * rho + 2], o.o0[4 * rho + 3]);
    f(32 + 8 * rho + 4 * h, o.o1[4 * rho], o.o1[4 * rho + 1], o.o1[4 * rho + 2], o.o1[4 * rho + 3]);
    f(64 + 8 * rho + 4 * h, o.o2[4 * rho], o.o2[4 * rho + 1], o.o2[4 * rho + 2], o.o2[4 * rho + 3]);
    f(96 + 8 * rho + 4 * h, o.o3[4 * rho], o.o3[4 * rho + 1], o.o3[4 * rho + 2], o.o3[4 * rho + 3]);
  }
}

__device__ __forceinline__ void ph_memattn2(const P& p, char* lds) {
  char* lk = lds;
  char* lv = lds + 16384;
  const int lane = opq(threadIdx.x) & 63, wv = opq(threadIdx.x) >> 6;
  for (int item = blockIdx.x; item < NBATCH * 4 * (SEQ / 128); item += gridDim.x) {
    const int tb = item % (SEQ / 128);
    const int bh = item / (SEQ / 128);
    const int b = bh >> 2, hd = bh & 3;
    const int t = tb * 128 + wv * 32 + (lane & 31);
    QFrag q;
    q_load(q, p.qmemb + (size_t)(b * SEQ + t) * 512 + hd * 128);
    const bf16_t* kb = p.kmemb + (size_t)bh * 256 * 128;
    const bf16_t* vb = p.vmemT + (size_t)bh * 128 * 256;
    OAcc o;
    oacc_zero(o);
    float m = NEG_BIG, l = 0.f;
    KVRegs kv;
    kv_load(kv, kb, 128, vb, 256);
#pragma unroll 1
    for (int ti = 0; ti < 4; ++ti) {
      __syncthreads();
      kv_store(kv, lk, lv);
      __syncthreads();
      {
        const int tn = (ti + 1 < 4) ? ti + 1 : 3;
        kv_load(kv, kb + (size_t)tn * 64 * 128, 128, vb + tn * 64, 256);
      }
      f32x16 s0, s1;
      qk_tile(q, lk, s0, s1);
#pragma unroll
      for (int r = 0; r < 16; ++r) { s0[r] *= ATT_SCALE2; s1[r] *= ATT_SCALE2; }
      softmax_tile(s0, s1, m, l, o);
      pv_tile(o, lv, s0, s1);
    }
    const float il = 1.f / l;
    const int t2 = tb * 128 + (opq(threadIdx.x) >> 6) * 32 + (opq(threadIdx.x) & 31);
    bf16_t* orow = p.omem + (size_t)(b * SEQ + t2) * 512 + hd * 128;
    oacc_foreach(o, [&](int d, float v0, float v1, float v2, float v3) {
      uint2 u;
      u.x = pack2(v0 * il, v1 * il);
      u.y = pack2(v2 * il, v3 * il);
      *(uint2*)(orow + d) = u;
    });
  }
}

__device__ __forceinline__ void ph_sb2(const P& p, char* lds) {
  char* lk = lds;
  char* lv = lds + 16384;
  const int lane = opq(threadIdx.x) & 63, wv = opq(threadIdx.x) >> 6, hh = lane >> 5;
  const int sb_skip = (gridDim.x > 32) ? 16 : 0;
  if ((int)blockIdx.x < sb_skip) return;
  for (int item = (int)blockIdx.x - sb_skip; item < NBATCH * 8 * (SEQ / 128); item += (int)gridDim.x - sb_skip) {
    const int tb = (SEQ / 128 - 1) - (item % (SEQ / 128));
    const int bh = item / (SEQ / 128);
    const int b = bh >> 3, hd = bh & 7;
    const int t0 = tb * 128;
    const int t = t0 + wv * 32 + (lane & 31);
    QFrag q;
    q_load(q, p.qsb + (size_t)(b * SEQ + t) * 1024 + hd * 128);
    const bf16_t* kb = p.ksb + (size_t)bh * SEQ * 128;
    const bf16_t* vb = p.vsbT + (size_t)bh * 128 * SEQ;
    OAcc o;
    oacc_zero(o);
    float carry = 0.f;
    const int jhi = (t0 >> 6) + 1;
    const int jw = (t0 + wv * 32 + 30) >> 6;
    KVRegs kv;
    kv_load(kv, kb + (size_t)jhi * 64 * 128, 128, vb + jhi * 64, SEQ);
    volatile unsigned* dflag = (volatile unsigned*)(lds + 32768);
    __syncthreads();
    if (opq(threadIdx.x) < 4) dflag[opq(threadIdx.x)] = 0u;
    for (int j = jhi; j >= 0; --j) {
      __syncthreads();
      if ((dflag[0] & dflag[1] & dflag[2] & dflag[3]) != 0u) break;
      kv_store(kv, lk, lv);
      __syncthreads();
      const int jn = (j > 0) ? j - 1 : 0;
      if (j > jw) kv_load(kv, kb + (size_t)jn * 64 * 128, 128, vb + jn * 64, SEQ);
      if (j <= jw) {
        f32x16 z0, z1;
        qk_tile(q, lk, z0, z1);
        const int sbase = j * 64 + 4 * hh;
        float gt[8];
        f32x16 l0, l1;
#pragma unroll
        for (int r = 0; r < 16; ++r) {
          const int so = sbase + 8 * (r >> 2) + (r & 3);
          {
            const float z = z0[r] * ATT_SCALE2;
            const bool valid = so < t;
            const float lsp = fminf(z, 0.f) - __builtin_amdgcn_logf(1.f + __builtin_amdgcn_exp2f(-fabsf(z)));
            l0[r] = valid ? (lsp - z) : 0.f;
            z0[r] = valid ? z : NEG_BIG;
          }
          {
            const float z = z1[r] * ATT_SCALE2;
            const bool valid = so + 32 < t;
            const float lsp = fminf(z, 0.f) - __builtin_amdgcn_logf(1.f + __builtin_amdgcn_exp2f(-fabsf(z)));
            l1[r] = valid ? (lsp - z) : 0.f;
            z1[r] = valid ? z : NEG_BIG;
          }
        }
#pragma unroll
        for (int rho = 0; rho < 4; ++rho) {
          gt[rho] = (l0[4 * rho] + l0[4 * rho + 1]) + (l0[4 * rho + 2] + l0[4 * rho + 3]);
          gt[4 + rho] = (l1[4 * rho] + l1[4 * rho + 1]) + (l1[4 * rho + 2] + l1[4 * rho + 3]);
        }
        float ag[8];
        float run = 0.f;
#pragma unroll
        for (int k = 7; k >= 0; --k) {
          const float pg = xhalf_get(gt[k], hh);
          ag[k] = carry + run + (hh == 0 ? pg : 0.f);
          run += gt[k] + pg;
        }
        carry += run;
#pragma unroll
        for (int rho = 0; rho < 4; ++rho) {
          {
            const float x3 = l0[4 * rho + 3], x23 = x3 + l0[4 * rho + 2], x123 = x23 + l0[4 * rho + 1];
            const float g = ag[rho];
            z0[4 * rho + 0] = __builtin_amdgcn_exp2f((l0[4 * rho + 0] + z0[4 * rho + 0]) + (g + x123));
            z0[4 * rho + 1] = __builtin_amdgcn_exp2f((l0[4 * rho + 1] + z0[4 * rho + 1]) + (g + x23));
            z0[4 * rho + 2] = __builtin_amdgcn_exp2f((l0[4 * rho + 2] + z0[4 * rho + 2]) + (g + x3));
            z0[4 * rho + 3] = __builtin_amdgcn_exp2f((l0[4 * rho + 3] + z0[4 * rho + 3]) + g);
          }
          {
            const float x3 = l1[4 * rho + 3], x23 = x3 + l1[4 * rho + 2], x123 = x23 + l1[4 * rho + 1];
            const float g = ag[4 + rho];
            z1[4 * rho + 0] = __builtin_amdgcn_exp2f((l1[4 * rho + 0] + z1[4 * rho + 0]) + (g + x123));
            z1[4 * rho + 1] = __builtin_amdgcn_exp2f((l1[4 * rho + 1] + z1[4 * rho + 1]) + (g + x23));
            z1[4 * rho + 2] = __builtin_amdgcn_exp2f((l1[4 * rho + 2] + z1[4 * rho + 2]) + (g + x3));
            z1[4 * rho + 3] = __builtin_amdgcn_exp2f((l1[4 * rho + 3] + z1[4 * rho + 3]) + g);
          }
        }
        kv_load(kv, kb + (size_t)jn * 64 * 128, 128, vb + jn * 64, SEQ);
        pv_tile(o, lv, z0, z1);
        if (__all(carry < -104.f * LOG2E) && (opq(threadIdx.x) & 63) == 0) dflag[wv] = 1u;
      }
    }
    int t2 = t;
    asm volatile("" : "+v"(t2));
    bf16_t* orow = p.omix + (size_t)(b * SEQ + t2) * DM + 1024 + hd * 128;
    oacc_foreach(o, [&](int d, float v0, float v1, float v2, float v3) {
      uint2 u;
      u.x = pack2(v0, v1);
      u.y = pack2(v2, v3);
      *(uint2*)(orow + d) = u;
    });
  }
}

#define NSA_IMP 32768
#define NSA_KEYS 49152
#define NSA_SELM 53504
#define NSA_LUT 53632
__device__ __forceinline__ void ph_nsa2(const P& p, char* lds) {
  typedef __attribute__((ext_vector_type(4))) float f32x4;
  char* lk = lds;
  char* lv = lds + 16384;
  float* imp = (float*)(lds + NSA_IMP);
  float* keys = (float*)(lds + NSA_KEYS);
  unsigned* selm = (unsigned*)(lds + NSA_SELM);
  const int tid = opq(threadIdx.x), lane = tid & 63, wv = tid >> 6, hh = lane >> 5, ql = lane & 31;
  float* lut = (float*)(lds + NSA_LUT) + wv * 128;
  for (int item = blockIdx.x; item < NBATCH * 2 * (SEQ / 32); item += gridDim.x) {
    const int tt = (item < 256) ? (SEQ / 32 - 1) - (item % (SEQ / 32)) : (item % (SEQ / 32));
    const int bg = item / (SEQ / 32);
    const int b = bg >> 1, g = bg & 1;
    const int h = g * 4 + wv;
    const int t0 = tt * 32, tq = t0 + ql, cur = t0 >> 6;
    __syncthreads();
    QFrag q;
    q_load(q, p.qn + (size_t)(b * SEQ + tq) * 1024 + h * 128);
    {
      const int lo = opq(lane);
      lut[lo] = p.t5[t5_bucket(lo) * 8 + h] * LOG2E;
      lut[lo + 64] = p.t5[t5_bucket(lo + 64) * 8 + h] * LOG2E;
    }
#pragma unroll
    for (int i = 0; i < 16; ++i) imp[i * 256 + tid] = 0.f;
    if (tid < 32) selm[tid] = 0u;
    const float* grow = p.gates + (size_t)(b * SEQ + tq) * 24 + h * 3;
    float* prow = p.part + (size_t)(b * SEQ + tq) * 1024 + h * 128;
    OAcc o;
    float m, l;
    KVRegs kv;
    {
      const bf16_t* kb = p.kcb + (size_t)bg * 128 * 128;
      const bf16_t* vb = p.vcT + (size_t)bg * 128 * 128;
      oacc_zero(o);
      m = NEG_BIG; l = 0.f;
      kv_load(kv, kb, 128, vb, 128);
      __syncthreads();
      kv_store(kv, lk, lv);
      __syncthreads();
      f32x16 x0, x1;
      qk_tile(q, lk, x0, x1);
      int tqv = tq;
      asm volatile("" : "+v"(tqv));
      tqv -= 64 * hh;
      if (t0 >= 1152) {
        const float b31 = lut[127];
#pragma unroll
        for (int r = 0; r < 16; ++r) { x0[r] = x0[r] * ATT_SCALE2 + b31; x1[r] = x1[r] * ATT_SCALE2 + b31; }
      } else {
#pragma unroll
        for (int r = 0; r < 16; ++r) {
          const int c = 8 * (r >> 2) + (r & 3);
          const int d0 = tqv - 16 * c - 31, d1 = d0 - 512;
          x0[r] = (d0 >= 0) ? x0[r] * ATT_SCALE2 + lut[min(d0, 127)] : -INFINITY;
          x1[r] = (d1 >= 0) ? x1[r] * ATT_SCALE2 + lut[min(d1, 127)] : -INFINITY;
        }
      }
      softmax_tile(x0, x1, m, l, o);
      const float m0 = m;
      pv_tile(o, lv, x0, x1);
      f32x16 z0, z1;
#pragma unroll
      for (int r = 0; r < 16; ++r) { z0[r] = 0.f; z1[r] = 0.f; }
      if (t0 >= 1024) {
        kv_load(kv, kb + 64 * 128, 128, vb + 64, 128);
        __syncthreads();
        kv_store(kv, lk, lv);
        __syncthreads();
        qk_tile(q, lk, z0, z1);
        asm volatile("" : "+v"(tqv));
#pragma unroll
        for (int r = 0; r < 16; ++r) {
          const int c = 64 + 8 * (r >> 2) + (r & 3);
          const int d0 = tqv - 16 * c - 31, d1 = d0 - 512;
          z0[r] = (d0 >= 0) ? z0[r] * ATT_SCALE2 + lut[min(d0, 127)] : -INFINITY;
          z1[r] = (d1 >= 0) ? z1[r] * ATT_SCALE2 + lut[min(d1, 127)] : -INFINITY;
        }
        softmax_tile(z0, z1, m, l, o);
        pv_tile(o, lv, z0, z1);
      }
      const float inv = 1.f / fmaxf(l, 1e-20f);
      const float c0 = __builtin_amdgcn_exp2f(m0 - m) * inv;
#pragma unroll
      for (int r = 0; r < 16; ++r) {
        const int c = 8 * (r >> 2) + (r & 3) + 4 * hh;
        if (x0[r] != 0.f) atomicAdd(&imp[(c) * 32 + ql], x0[r] * c0);
        if (x1[r] != 0.f) atomicAdd(&imp[(c + 32) * 32 + ql], x1[r] * c0);
        if (z0[r] != 0.f) atomicAdd(&imp[(c + 64) * 32 + ql], z0[r] * inv);
        if (z1[r] != 0.f) atomicAdd(&imp[(c + 96) * 32 + ql], z1[r] * inv);
      }
      const float gs = inv / (1.f + __expf(-grow[0]));
      oacc_foreach(o, [&](int d, float v0, float v1, float v2, float v3) {
        f32x4 u = {v0 * gs, v1 * gs, v2 * gs, v3 * gs};
        *(f32x4*)(prow + d) = u;
      });
    }
    __syncthreads();
    {
      const int tido = opq(tid);
      const int qq = tido & 31, jg = tido >> 5;
#pragma unroll
      for (int jj = 0; jj < 4; ++jj) {
        const int j = jg * 4 + jj;
        float v = imp[(4 * j) * 32 + qq] + imp[(4 * j + 1) * 32 + qq] + imp[(4 * j + 2) * 32 + qq] + 0.5f * imp[(4 * j + 3) * 32 + qq];
        if (j > 0) v += 0.5f * imp[(4 * j - 1) * 32 + qq];
        const bool forced = (j == 0) || (j == cur) || (j == cur - 1);
        keys[qq * 33 + j] = forced ? 1e9f : ((j <= cur) ? v : -1e9f);
      }
      __syncthreads();
      unsigned bits = 0u;
#pragma unroll
      for (int jj = 0; jj < 4; ++jj) {
        const int j = jg * 4 + jj;
        const float kj = keys[qq * 33 + j];
        int rank = 0;
        for (int i = 0; i < 32; ++i) {
          const float ki = keys[qq * 33 + i];
          rank += (ki > kj || (ki == kj && i < j)) ? 1 : 0;
        }
        if (rank < 16 && j <= cur) bits |= 1u << j;
      }
      atomicOr(&selm[qq], bits);
      __syncthreads();
    }
    const unsigned mysel = selm[ql];
    unsigned um = mysel;
#pragma unroll
    for (int o2 = 16; o2 > 0; o2 >>= 1) um |= (unsigned)__shfl_xor((int)um, o2);
    um = (unsigned)__builtin_amdgcn_readfirstlane((int)um);
    {
      const bf16_t* kb = p.ks + (size_t)bg * SEQ * 128;
      const bf16_t* vb = p.vsT + (size_t)bg * 128 * SEQ;
      oacc_zero(o);
      m = NEG_BIG; l = 0.f;
      unsigned rem = um;
      int j = __builtin_ctz(rem);
      kv_load(kv, kb + (size_t)j * 64 * 128, 128, vb + j * 64, SEQ);
      while (rem) {
        j = __builtin_ctz(rem);
        rem &= rem - 1;
        const int jn = rem ? __builtin_ctz(rem) : j;
        __syncthreads();
        kv_store(kv, lk, lv);
        __syncthreads();
        f32x16 s0, s1;
        qk_tile(q, lk, s0, s1);
        const bool selq = (mysel >> j) & 1u;
        int tqv = tq;
        asm volatile("" : "+v"(tqv));
        if (j * 64 + 63 + 113 <= t0) {
          const float sc = selq ? ATT_SCALE2 : 0.f, bb = selq ? lut[127] : -INFINITY;
#pragma unroll
          for (int r = 0; r < 16; ++r) { s0[r] = s0[r] * sc + bb; s1[r] = s1[r] * sc + bb; }
        } else {
#pragma unroll
          for (int r = 0; r < 16; ++r) {
            const int d0 = tqv - (j * 64 + 8 * (r >> 2) + (r & 3) + 4 * hh), d1 = d0 - 32;
            s0[r] = (selq && d0 >= 0) ? s0[r] * ATT_SCALE2 + lut[min(d0, 127)] : -INFINITY;
            s1[r] = (selq && d1 >= 0) ? s1[r] * ATT_SCALE2 + lut[min(d1, 127)] : -INFINITY;
          }
        }
        kv_load(kv, kb + (size_t)jn * 64 * 128, 128, vb + jn * 64, SEQ);
        softmax_tile(s0, s1, m, l, o);
        pv_tile(o, lv, s0, s1);
      }
      const float gs = 1.f / (fmaxf(l, 1e-20f) * (1.f + __expf(-grow[1])));
      int qo = ql;
      asm volatile("" : "+v"(qo));
      float* pr2 = p.part + (size_t)(b * SEQ + t0 + qo) * 1024 + h * 128;
      oacc_foreach(o, [&](int d, float v0, float v1, float v2, float v3) {
        f32x4 u = *(f32x4*)(pr2 + d);
        u[0] += v0 * gs; u[1] += v1 * gs; u[2] += v2 * gs; u[3] += v3 * gs;
        *(f32x4*)(pr2 + d) = u;
      });
    }
    {
      const bf16_t* kb = p.kw + (size_t)bg * SEQ * 128;
      const bf16_t* vb = p.vwT + (size_t)bg * 128 * SEQ;
      oacc_zero(o);
      m = NEG_BIG; l = 0.f;
      int jlo = (t0 - 511) >> 6;
      if (jlo < 0) jlo = 0;
      kv_load(kv, kb + (size_t)jlo * 64 * 128, 128, vb + jlo * 64, SEQ);
      for (int j = jlo; j <= cur; ++j) {
        const int jn = (j < cur) ? j + 1 : j;
        __syncthreads();
        kv_store(kv, lk, lv);
        __syncthreads();
        f32x16 s0, s1;
        qk_tile(q, lk, s0, s1);
        int tqv = tq;
        asm volatile("" : "+v"(tqv));
        if (j * 64 + 63 + 113 <= t0 && t0 + 31 - j * 64 < 512) {
          const float b31 = lut[127];
#pragma unroll
          for (int r = 0; r < 16; ++r) { s0[r] = s0[r] * ATT_SCALE2 + b31; s1[r] = s1[r] * ATT_SCALE2 + b31; }
        } else {
#pragma unroll
          for (int r = 0; r < 16; ++r) {
            const int d0 = tqv - (j * 64 + 8 * (r >> 2) + (r & 3) + 4 * hh), d1 = d0 - 32;
            s0[r] = (d0 >= 0 && d0 < 512) ? s0[r] * ATT_SCALE2 + lut[min(d0, 127)] : -INFINITY;
            s1[r] = (d1 >= 0 && d1 < 512) ? s1[r] * ATT_SCALE2 + lut[min(d1, 127)] : -INFINITY;
          }
        }
        kv_load(kv, kb + (size_t)jn * 64 * 128, 128, vb + jn * 64, SEQ);
        softmax_tile(s0, s1, m, l, o);
        pv_tile(o, lv, s0, s1);
      }
      const float gs = 1.f / (fmaxf(l, 1e-20f) * (1.f + __expf(-grow[2])));
      int qo = ql;
      asm volatile("" : "+v"(qo));
      const float* pr2 = p.part + (size_t)(b * SEQ + t0 + qo) * 1024 + h * 128;
      bf16_t* orow = p.omix + (size_t)(b * SEQ + t0 + qo) * DM + h * 128;
      oacc_foreach(o, [&](int d, float v0, float v1, float v2, float v3) {
        const f32x4 u = *(const f32x4*)(pr2 + d);
        uint2 w;
        w.x = pack2(u[0] + v0 * gs, u[1] + v1 * gs);
        w.y = pack2(u[2] + v2 * gs, u[3] + v3 * gs);
        *(uint2*)(orow + d) = w;
      });
    }
  }
}

__device__ __forceinline__ void ph_cvt(const float* src, bf16_t* dst, size_t n) {
  typedef __attribute__((ext_vector_type(4))) float f32x4;
  const size_t nv = n / 8;
  for (size_t i = (size_t)blockIdx.x * 256 + opq(threadIdx.x); i < nv; i += (size_t)gridDim.x * 256) {
    const f32x4 a = ((const f32x4*)src)[2 * i], b = ((const f32x4*)src)[2 * i + 1];
    u32x4 o;
    o[0] = pack2(a[0], a[1]); o[1] = pack2(a[2], a[3]); o[2] = pack2(b[0], b[1]); o[3] = pack2(b[2], b[3]);
    ((u32x4*)dst)[i] = o;
  }
}

__device__ __forceinline__ void ph_scores(const P& p, char* lds) {
  for (int u = blockIdx.x; u < 64 * 16; u += gridDim.x) {
    const int tm = u & 63, hp = u >> 6;
    const int m0 = tm * 128;
    float* sc = p.scores + (size_t)m0 * DM + hp * 128;
    gemm_tile_bf16<false>(p.omix + (size_t)m0 * DM + hp * 128, DM, p.subkb + (size_t)hp * 128 * 128, 128, 128, lds,
                          [&](int r, int c, float val) { sc[(size_t)r * DM + c] = val; });
  }
}

__device__ __forceinline__ void ph_qp_scores(const P& p, char* lds) {
  const int ntm = T_TOK / 256, ntn = DM / 128;
  const int npm = (ntm + 7) / 8, npn = (ntn + 7) / 8;
  const int nslots = ((npm * npn * 64 + 511) / 512) * 512;
  for (int u = blockIdx.x; u < nslots; u += gridDim.x) {
    int v = (u & 7) * 64 + ((u >> 3) & 63) + (u & ~511);
    int patch = v >> 6, w = v & 63;
    int tm = (patch % npm) * 8 + (w & 7);
    int tn = (patch / npm) * 8 + (w >> 3);
    if (tm >= ntm || tn >= ntn) continue;
    const int m0 = tm * 256, n0 = tn * 128;
    bf16_t* qp = p.omix + (size_t)m0 * DM + n0;
    const float* rss = p.rowss + T_TOK + m0;
    gemm_tile_big(p.hn + (size_t)m0 * DM, DM, p.WpqT + (size_t)n0 * DM, DM, DM, lds,
                  [&](int r, int c, f32x4_e lo, f32x4_e hi) {
                    const float rs = rsqrtf(rss[r] * (1.f / DM) + RMS_EPS);
                    st_bf16x8(qp + (size_t)r * DM + c, lo * rs, hi * rs); });
    __threadfence_block();
    __syncthreads();
    float* sc = p.scores + (size_t)m0 * DM + n0;
    gemm_tile_big(qp, DM, p.subkb + (size_t)tn * 128 * 128, 128, 128, lds,
                  [&](int r, int c, f32x4_e lo, f32x4_e hi) {
                    *(f32x4_e*)(sc + (size_t)r * DM + c) = lo; *(f32x4_e*)(sc + (size_t)r * DM + c + 4) = hi; });
  }
}

__device__ __forceinline__ void ph_cvt4(const float* src, unsigned char* dst, float* scales, int nrows, int wid0, int nw) {
  typedef __attribute__((ext_vector_type(4))) float f32x4;
  typedef __attribute__((ext_vector_type(2))) float f32x2;
  const int lane = opq(threadIdx.x) & 63;
  const float one = __uint_as_float((unsigned)opq(0x3F800000));
  float lev[8];
#pragma unroll
  for (int c = 0; c < 8; ++c) {
    const f32x2 q = __builtin_amdgcn_cvt_scalef32_pk_f32_fp4((unsigned)opq(c * 0x11111111), one, 0);
    lev[c] = fabsf(q[0]);
  }
  const float maxlev = lev[7];
  for (int row = wid0; row < nrows; row += nw) {
    const f32x4* s4 = (const f32x4*)(src + (size_t)row * DM) + lane * 8;
    f32x4 v[8];
    float amax = 0.f;
#pragma unroll
    for (int i = 0; i < 8; ++i) {
      v[i] = s4[i];
#pragma unroll
      for (int k = 0; k < 4; ++k) amax = fmaxf(amax, fabsf(v[i][k]));
    }
    amax = wave_max(amax);
    const float sc = (amax > 0.f) ? maxlev / amax : 1.f;
    u32x4 o;
#pragma unroll
    for (int w = 0; w < 4; ++w) {
      unsigned pk = 0u;
      pk = __builtin_amdgcn_cvt_scalef32_pk_fp4_f32(pk, v[2 * w][0] * sc, v[2 * w][1] * sc, 1.0f, 0);
      pk = __builtin_amdgcn_cvt_scalef32_pk_fp4_f32(pk, v[2 * w][2] * sc, v[2 * w][3] * sc, 1.0f, 1);
      pk = __builtin_amdgcn_cvt_scalef32_pk_fp4_f32(pk, v[2 * w + 1][0] * sc, v[2 * w + 1][1] * sc, 1.0f, 2);
      pk = __builtin_amdgcn_cvt_scalef32_pk_fp4_f32(pk, v[2 * w + 1][2] * sc, v[2 * w + 1][3] * sc, 1.0f, 3);
      o[w] = pk;
    }
    *(u32x4*)(dst + (size_t)row * 1024 + lane * 16) = o;
    if (lane == 0) scales[row] = (amax > 0.f) ? amax / maxlev : 1.f;
  }
}

__device__ __forceinline__ u32x4 r4_load(const unsigned char* tab, int eid, int lane) {
  return *((const u32x4*)(tab + (size_t)eid * 1024) + lane);
}
struct XPk { f32x16 a, b; };
struct Acc32 { f32x16 a, b; };

#define R4_DOT_W(word, xv, base, pa, pb)                                                             \
  {                                                                                                  \
    typedef __attribute__((ext_vector_type(2))) float f32x2;                                         \
    const f32x2 q0 = __builtin_amdgcn_cvt_scalef32_pk_f32_fp4(word, one, 0), q1 = __builtin_amdgcn_cvt_scalef32_pk_f32_fp4(word, one, 1); \
    const f32x2 q2 = __builtin_amdgcn_cvt_scalef32_pk_f32_fp4(word, one, 2), q3 = __builtin_amdgcn_cvt_scalef32_pk_f32_fp4(word, one, 3); \
    pa += q0[0] * xv[base + 0] + q0[1] * xv[base + 1]; pb += q1[0] * xv[base + 2] + q1[1] * xv[base + 3]; \
    pa += q2[0] * xv[base + 4] + q2[1] * xv[base + 5]; pb += q3[0] * xv[base + 6] + q3[1] * xv[base + 7]; \
  }
__device__ __forceinline__ float r4_dot(const u32x4& e, const XPk& x) {
  const float one = __uint_as_float((unsigned)opq(0x3F800000));
  float pa = 0.f, pb = 0.f;
  R4_DOT_W(e[0], x.a, 0, pa, pb) R4_DOT_W(e[1], x.a, 8, pa, pb) R4_DOT_W(e[2], x.b, 0, pa, pb) R4_DOT_W(e[3], x.b, 8, pa, pb)
  return pa + pb;
}
#define R4_AXPY_W(word, accv, base)                                                                  \
  {                                                                                                  \
    typedef __attribute__((ext_vector_type(2))) float f32x2;                                         \
    const f32x2 q0 = __builtin_amdgcn_cvt_scalef32_pk_f32_fp4(word, one, 0), q1 = __builtin_amdgcn_cvt_scalef32_pk_f32_fp4(word, one, 1); \
    const f32x2 q2 = __builtin_amdgcn_cvt_scalef32_pk_f32_fp4(word, one, 2), q3 = __builtin_amdgcn_cvt_scalef32_pk_f32_fp4(word, one, 3); \
    accv[base + 0] += hid * q0[0]; accv[base + 1] += hid * q0[1]; accv[base + 2] += hid * q1[0]; accv[base + 3] += hid * q1[1]; \
    accv[base + 4] += hid * q2[0]; accv[base + 5] += hid * q2[1]; accv[base + 6] += hid * q3[0]; accv[base + 7] += hid * q3[1]; \
  }
__device__ __forceinline__ void r4_axpy(const u32x4& e, float hid, Acc32& acc) {
  const float one = __uint_as_float((unsigned)opq(0x3F800000));
  R4_AXPY_W(e[0], acc.a, 0) R4_AXPY_W(e[1], acc.a, 8) R4_AXPY_W(e[2], acc.b, 0) R4_AXPY_W(e[3], acc.b, 8)
}

#define INS16(K, x)                                                                                      \
  K##15 = __builtin_amdgcn_fmed3f(K##15, K##14, x); K##14 = __builtin_amdgcn_fmed3f(K##14, K##13, x);   \
  K##13 = __builtin_amdgcn_fmed3f(K##13, K##12, x); K##12 = __builtin_amdgcn_fmed3f(K##12, K##11, x);   \
  K##11 = __builtin_amdgcn_fmed3f(K##11, K##10, x); K##10 = __builtin_amdgcn_fmed3f(K##10, K##9, x);    \
  K##9 = __builtin_amdgcn_fmed3f(K##9, K##8, x); K##8 = __builtin_amdgcn_fmed3f(K##8, K##7, x);         \
  K##7 = __builtin_amdgcn_fmed3f(K##7, K##6, x); K##6 = __builtin_amdgcn_fmed3f(K##6, K##5, x);         \
  K##5 = __builtin_amdgcn_fmed3f(K##5, K##4, x); K##4 = __builtin_amdgcn_fmed3f(K##4, K##3, x);         \
  K##3 = __builtin_amdgcn_fmed3f(K##3, K##2, x); K##2 = __builtin_amdgcn_fmed3f(K##2, K##1, x);         \
  K##1 = __builtin_amdgcn_fmed3f(K##1, K##0, x); K##0 = fmaxf(K##0, x);
#define DECL16(K) float K##0 = -INFINITY, K##1 = -INFINITY, K##2 = -INFINITY, K##3 = -INFINITY, K##4 = -INFINITY, \
  K##5 = -INFINITY, K##6 = -INFINITY, K##7 = -INFINITY, K##8 = -INFINITY, K##9 = -INFINITY, K##10 = -INFINITY,   \
  K##11 = -INFINITY, K##12 = -INFINITY, K##13 = -INFINITY, K##14 = -INFINITY, K##15 = -INFINITY;
__device__ __forceinline__ float mkkey(float v, unsigned tag, unsigned mask) {
  return __uint_as_float((__float_as_uint(v) & ~mask) | tag);
}

__device__ __forceinline__ void ph_peer(const P& p, float* smem) {
  typedef __attribute__((ext_vector_type(4))) float f32x4;
  float* lists = smem;
  int* bexA = (int*)(smem + 4096);
  float* bgtA = smem + 6144;
  float* bsuA = smem + 8192;
  for (int item = blockIdx.x; item < T_TOK / 16; item += gridDim.x) {
    const int t0 = item * 16;
    __syncthreads();
    {
      const int tid = opq(threadIdx.x);
      const int tl = tid >> 4, hp = tid & 15;
      const f32x4* sp = (const f32x4*)(p.scores + (size_t)(t0 + tl) * DM + hp * 128);
      DECL16(k)
#pragma unroll 4
      for (int c4 = 0; c4 < 32; ++c4) {
        const f32x4 v = sp[c4];
#pragma unroll
        for (int e = 0; e < 4; ++e) {
          const float x = mkkey(v[e], 127u - (unsigned)(c4 * 4 + e), 127u);
          INS16(k, x)
        }
      }
      f32x4* lp = (f32x4*)(lists + (size_t)opq(threadIdx.x) * 16);
      f32x4 o0 = {k0, k1, k2, k3}, o1 = {k4, k5, k6, k7}, o2 = {k8, k9, k10, k11}, o3 = {k12, k13, k14, k15};
      lp[0] = o0; lp[1] = o1; lp[2] = o2; lp[3] = o3;
    }
    __syncthreads();
    if (opq(threadIdx.x) < 128) {
      const int tid = opq(threadIdx.x);
      const int tl = tid >> 3, h = tid & 7;
      const float* la = lists + (size_t)(tl * 16 + 2 * h) * 16;
      const float* lb = la + 16;
      float av[16], bv[16];
#pragma unroll
      for (int i = 0; i < 16; ++i) {
        av[i] = __uint_as_float(__float_as_uint(la[i]) & ~127u);
        bv[i] = __uint_as_float(__float_as_uint(lb[i]) & ~127u);
      }
      DECL16(c)
#pragma unroll
      for (int i = 0; i < 16; ++i) {
#pragma unroll
        for (int j = 0; j < 16; ++j) {
          if ((i + 1) * (j + 1) <= 16) {
            const float x = mkkey(av[i] + bv[j], 255u - (unsigned)(i * 16 + j), 255u);
            INS16(c, x)
          }
        }
      }
      float cs[16] = {c0, c1, c2, c3, c4, c5, c6, c7, c8, c9, c10, c11, c12, c13, c14, c15};
      float ev[16];
      float sum = 0.f;
      const float mx = __uint_as_float(__float_as_uint(cs[0]) & ~255u);
#pragma unroll
      for (int n = 0; n < 16; ++n) {
        ev[n] = __expf(__uint_as_float(__float_as_uint(cs[n]) & ~255u) - mx);
        sum += ev[n];
      }
      const float isum = 1.f / sum;
#pragma unroll
      for (int n = 0; n < 16; ++n) {
        const unsigned cc = 255u - (__float_as_uint(cs[n]) & 255u);
        const unsigned ka = 127u - (__float_as_uint(la[cc >> 4]) & 127u);
        const unsigned kb = 127u - (__float_as_uint(lb[cc & 15u]) & 127u);
        const int eid = (int)(ka * 128u + kb);
        bexA[tl * 128 + h * 16 + n] = eid;
        bgtA[tl * 128 + h * 16 + n] = ev[n] * isum * p.sv8[eid];
        bsuA[tl * 128 + h * 16 + n] = p.su8[eid];
      }
    }
    __syncthreads();
#pragma unroll 1
    for (int ti4 = 0; ti4 < 4; ++ti4) {
    const int lane = opq(threadIdx.x) & 63, wv = opq(threadIdx.x) >> 6;
    const int tl = wv * 4 + ti4;
    const int t = t0 + tl;
    const int* bex = bexA + tl * 128;
    const float* bgt = bgtA + tl * 128;
    const float* bsu = bsuA + tl * 128;
    XPk x;
    {
      const f32x4* s4 = (const f32x4*)(p.out + (size_t)t * DM) + lane * 8;
      const f32x4* g4 = (const f32x4*)p.norm_ffn + lane * 8;
      f32x4 a0 = s4[0], a1 = s4[1], a2 = s4[2], a3 = s4[3], a4 = s4[4], a5 = s4[5], a6 = s4[6], a7 = s4[7];
      float ss = 0.f;
#define SSQ(v) ss += v[0] * v[0] + v[1] * v[1] + v[2] * v[2] + v[3] * v[3];
      SSQ(a0) SSQ(a1) SSQ(a2) SSQ(a3) SSQ(a4) SSQ(a5) SSQ(a6) SSQ(a7)
#undef SSQ
      ss = wave_sum(ss);
      const float rs = rsqrtf(ss * (1.f / DM) + RMS_EPS);
#define XPK(dst, base, va, vb, gi)                                                    \
  {                                                                                   \
    const f32x4 ga = g4[gi], gb = g4[gi + 1];                                         \
    dst[base + 0] = bf2f(f2bf(va[0] * rs * ga[0])); dst[base + 1] = bf2f(f2bf(va[1] * rs * ga[1]));   \
    dst[base + 2] = bf2f(f2bf(va[2] * rs * ga[2])); dst[base + 3] = bf2f(f2bf(va[3] * rs * ga[3]));   \
    dst[base + 4] = bf2f(f2bf(vb[0] * rs * gb[0])); dst[base + 5] = bf2f(f2bf(vb[1] * rs * gb[1]));   \
    dst[base + 6] = bf2f(f2bf(vb[2] * rs * gb[2])); dst[base + 7] = bf2f(f2bf(vb[3] * rs * gb[3]));   \
  }
      XPK(x.a, 0, a0, a1, 0) XPK(x.a, 8, a2, a3, 2) XPK(x.b, 0, a4, a5, 4) XPK(x.b, 8, a6, a7, 6)
#undef XPK
    }
    Acc32 acc;
#pragma unroll
    for (int r = 0; r < 16; ++r) { acc.a[r] = 0.f; acc.b[r] = 0.f; }
    u32x4 u0 = r4_load(p.pu8, bex[0], lane), u1 = r4_load(p.pu8, bex[1], lane), u2 = r4_load(p.pu8, bex[2], lane), u3 = r4_load(p.pu8, bex[3], lane);
    u32x4 v0 = r4_load(p.pv8, bex[0], lane), v1 = r4_load(p.pv8, bex[1], lane), v2 = r4_load(p.pv8, bex[2], lane), v3 = r4_load(p.pv8, bex[3], lane);
#pragma unroll 1
    for (int e0 = 0; e0 < 128; e0 += 4) {
      float d0 = r4_dot(u0, x), d1 = r4_dot(u1, x), d2 = r4_dot(u2, x), d3 = r4_dot(u3, x);
      const int en = (e0 + 4 < 128) ? e0 + 4 : 124;
      const int i0 = bex[en], i1 = bex[en + 1], i2 = bex[en + 2], i3 = bex[en + 3];
      u0 = r4_load(p.pu8, i0, lane); u1 = r4_load(p.pu8, i1, lane); u2 = r4_load(p.pu8, i2, lane); u3 = r4_load(p.pu8, i3, lane);
#pragma unroll
      for (int o = 32; o > 0; o >>= 1) {
        d0 += __shfl_xor(d0, o); d1 += __shfl_xor(d1, o); d2 += __shfl_xor(d2, o); d3 += __shfl_xor(d3, o);
      }
      { const float hid = bgt[e0 + 0] * gelu_fast(d0 * bsu[e0 + 0]); r4_axpy(v0, hid, acc); }
      { const float hid = bgt[e0 + 1] * gelu_fast(d1 * bsu[e0 + 1]); r4_axpy(v1, hid, acc); }
      { const float hid = bgt[e0 + 2] * gelu_fast(d2 * bsu[e0 + 2]); r4_axpy(v2, hid, acc); }
      { const float hid = bgt[e0 + 3] * gelu_fast(d3 * bsu[e0 + 3]); r4_axpy(v3, hid, acc); }
      v0 = r4_load(p.pv8, i0, lane); v1 = r4_load(p.pv8, i1, lane); v2 = r4_load(p.pv8, i2, lane); v3 = r4_load(p.pv8, i3, lane);
    }
    const int lane2 = opq(lane);
    f32x4* o4 = (f32x4*)(p.out + (size_t)t * DM) + lane2 * 8;
    const f32x4* g4 = (const f32x4*)p.norm_final + lane2 * 8;
    f32x4 hv[8];
    float ss = 0.f;
#pragma unroll
    for (int i = 0; i < 8; ++i) {
      hv[i] = o4[i];
#pragma unroll
      for (int k = 0; k < 4; ++k) {
        hv[i][k] += (i < 4) ? acc.a[4 * i + k] : acc.b[4 * (i - 4) + k];
        ss += hv[i][k] * hv[i][k];
      }
    }
    ss = wave_sum(ss);
    const float rs = rsqrtf(ss * (1.f / DM) + RMS_EPS);
#pragma unroll
    for (int i = 0; i < 8; ++i) {
      const f32x4 g = g4[i];
      f32x4 o;
#pragma unroll
      for (int k = 0; k < 4; ++k) o[k] = hv[i][k] * rs * g[k];
      o4[i] = o;
    }
    }
  }
}

#define XB_TMO      128
#define XB_XCNT(j)  (256  + 64 * (j))
#define XB_XSUB(j)  (1280 + 64 * (j))
#define XB_XGEN(j)  (2304 + 64 * (j))
#define XB_TOP      3328
#define XB_TOPGEN   3392
#define XCD_BAR_WORDS 3456
#define XB_SPIN_CAP (1u << 22)
#define LAS __attribute__((address_space(3)))
__device__ __forceinline__ unsigned xb_ld(unsigned* p) { return __hip_atomic_load(p, __ATOMIC_RELAXED, __HIP_MEMORY_SCOPE_AGENT); }
__device__ __forceinline__ unsigned xb_add(unsigned* p, unsigned v) { return __hip_atomic_fetch_add(p, v, __ATOMIC_RELAXED, __HIP_MEMORY_SCOPE_AGENT); }
__device__ __forceinline__ unsigned xb_xcc_id() { return (unsigned)__builtin_amdgcn_s_getreg((3 << 11) | 20) & 0xFu; }
#define XB_SPIN(cond, bar) do { unsigned _sp = 0; while (cond) { __builtin_amdgcn_s_sleep(1); \
    if ((++_sp & 255u) == 0u) { if (xb_ld(&(bar)[XB_TMO])) break; if (_sp > XB_SPIN_CAP) { atomicAdd(&(bar)[XB_TMO], 1u); break; } } } } while (0)
struct XcdBarrier { unsigned* bar; unsigned x; volatile LAS unsigned* st; };
__device__ __forceinline__ XcdBarrier xcd_barrier_post(unsigned* bar, volatile LAS unsigned* st) {
  XcdBarrier b; b.bar = bar; b.x = xb_xcc_id(); b.st = st;
  if (threadIdx.x == 0) (void)xb_add(&bar[XB_XCNT(b.x)], 1u);
  return b;
}
__device__ __forceinline__ void xcd_barrier_complete(unsigned* bar, unsigned x, unsigned& nloc, unsigned& nx) {
  const unsigned G = gridDim.x * gridDim.y * gridDim.z;
  unsigned sum, cnt, mine, sp = 0u;
  for (;;) {
    sum = 0u; cnt = 0u; mine = 0u;
#pragma unroll
    for (unsigned j = 0; j < 16; ++j) { const unsigned c = xb_ld(&bar[XB_XCNT(j)]); sum += c; cnt += (c > 0u) ? 1u : 0u; mine = (j == x) ? c : mine; }
    if (sum == G) break;
    __builtin_amdgcn_s_sleep(1);
    if ((++sp & 255u) == 0u) { if (xb_ld(&bar[XB_TMO])) break; if (sp > XB_SPIN_CAP) { atomicAdd(&bar[XB_TMO], 1u); break; } }
  }
  nloc = mine > 0u ? mine : 1u; nx = cnt > 0u ? cnt : 1u;
}
__device__ __forceinline__ void xcd_barrier(const XcdBarrier& b) {
  asm volatile("s_waitcnt vmcnt(0)" ::: "memory");
  __syncthreads();
  if (threadIdx.x == 0) {
    unsigned* bar = b.bar;
    __builtin_amdgcn_s_waitcnt(0);
    unsigned nloc = b.st[0], nx = b.st[1];
    if (nloc == 0u) { xcd_barrier_complete(bar, b.x, nloc, nx); b.st[0] = nloc; b.st[1] = nx; }
    const unsigned old = xb_add(&bar[XB_XSUB(b.x)], 1u);
    const unsigned gen = old / nloc;
    if (old + 1u == (gen + 1u) * nloc) {
      __builtin_amdgcn_fence(__ATOMIC_RELEASE, "agent");
      asm volatile("s_waitcnt vmcnt(0)" ::: "memory");
      const unsigned og = xb_add(&bar[XB_TOP], 1u);
      const unsigned tg = og / nx;
      if (og + 1u == (tg + 1u) * nx) xb_add(&bar[XB_TOPGEN], 1u);
      else XB_SPIN(xb_ld(&bar[XB_TOPGEN]) == tg, bar);
      __builtin_amdgcn_fence(__ATOMIC_ACQUIRE, "agent");
      xb_add(&bar[XB_XGEN(b.x)], 1u);
      asm volatile("s_waitcnt vmcnt(0)" ::: "memory");
    } else {
      XB_SPIN(xb_ld(&bar[XB_XGEN(b.x)]) == gen, bar);
      __builtin_amdgcn_fence(__ATOMIC_ACQUIRE, "agent");
      asm volatile("s_waitcnt vmcnt(0)" ::: "memory");
    }
  }
  __syncthreads();
}

typedef const __attribute__((address_space(4))) P* KP;
__device__ __forceinline__ P loadP() {
#if defined(__HIP_DEVICE_COMPILE__)
  KP k = (KP)__builtin_amdgcn_kernarg_segment_ptr();
  asm volatile("" : "+s"(k));
  P p = *k;
  return p;
#else
  return P{};
#endif
}

__global__ void __launch_bounds__(256, 2) mega(P p_arg) {
  cg::grid_group grid = cg::this_grid();
  __shared__ __attribute__((aligned(16))) float smem[16384];
  char* lds = (char*)smem;
  __shared__ uint4 xb_words;
  if (threadIdx.x == 0) xb_words = make_uint4(0u, 0u, 0u, 0u);
  if (blockIdx.x == 0) {
    P p = loadP();
    for (int i = threadIdx.x; i < XCD_BAR_WORDS; i += 256) p.bar[i] = 0u;
  }
  { P p = loadP(); ph_rmsnorm(p.x, p.norm_mix, p.hn, T_TOK); ph_rmsnorm(p.mem, p.norm_mkv, p.memn, 1024); }
  { P p = loadP(); ph_transpose<true>(smem, p.w_in, DM, INC, 5760, p.WinT); }
  { P p = loadP(); ph_transpose<false>(smem, p.w_mk, DM, 512, 512, p.WmkT); }
  { P p = loadP(); ph_transpose<false>(smem, p.w_mv, DM, 512, 512, p.WmvT); }
  { P p = loadP(); ph_cvt(p.subk, p.subkb, (size_t)16 * 128 * 128); }
  { P p = loadP(); ph_transpose<false>(smem, p.w1_k, 4096, 128, 128, p.w1T); }
  { P p = loadP(); ph_transpose<false>(smem, p.w1_v, 4096, 128, 128, p.w1T + 128 * 4096); }
  { P p = loadP(); ph_transpose<false>(smem, p.w2_k, 128, 128, 128, p.w2T); }
  { P p = loadP(); ph_transpose<false>(smem, p.w2_v, 128, 128, 128, p.w2T + 128 * 128); }
  { P p = loadP(); ph_posb(p); }
  { P p = loadP(); for (int i = blockIdx.x * 256 + opq(threadIdx.x); i < 2 * T_TOK; i += gridDim.x * 256) p.rowss[i] = 0.f; }
  grid.sync();
  XcdBarrier xb;
  { P p = loadP(); xb = xcd_barrier_post(p.bar, (volatile LAS unsigned*)&xb_words); }
  { P p = loadP(); ph_proj(p, lds); }
  const int kvb = (gridDim.x == 512) ? (((int)blockIdx.x >= 320 && (int)blockIdx.x < 352) ? ((int)blockIdx.x - 320) * 8 : -1) : -2;
  const int vvb = (gridDim.x == 512) ? (((int)blockIdx.x >= 352 && (int)blockIdx.x < 384) ? ((int)blockIdx.x - 352) * 8 : -1) : -2;
  { P p = loadP(); bf16_t* kmem = p.kmemb;
    ph_gemm_bf16(p.memn, DM, p.WmkT, DM, 1024, 512, DM, lds, [=](int m, int n, float v) {
      kmem[((size_t)((m >> 8) * 4 + (n >> 7)) * 256 + (m & 255)) * 128 + (n & 127)] = f2bf(v); }, kvb); }
  { P p = loadP(); bf16_t* vmem = p.vmemT;
    ph_gemm_bf16(p.memn, DM, p.WmvT, DM, 1024, 512, DM, lds, [=](int m, int n, float v) {
      vmem[((size_t)((m >> 8) * 4 + (n >> 7)) * 128 + (n & 127)) * 256 + perm16(m & 255)] = f2bf(v); }, vvb); }
  xcd_barrier(xb);
  { P p = loadP(); ph_compress2(p, lds); }
  { P p = loadP(); ph_sb2(p, lds); }
  {
    const int skip = (gridDim.x > 32) ? 16 : 0;
    const int vb = ((int)blockIdx.x >= skip) ? (int)blockIdx.x - skip : -1, nvb = (int)gridDim.x - skip;
    __syncthreads();
    { P p = loadP(); ph_transpose<false>(smem, p.w_out, DM, DM, DM, p.WoutT, vb, nvb); }
    { P p = loadP(); ph_transpose<false>(smem, p.w_mq, DM, 512, 512, p.WmqT, vb, nvb); }
  }
  xcd_barrier(xb);
  { P p = loadP(); ph_nsa2(p, lds); }
  xcd_barrier(xb);
  { P p = loadP(); float* out = p.out; const float* x = p.x; const float* gmq = p.norm_mq; bf16_t* hn = p.hn; float* rss = p.rowss;
    ph_gemm_big(p.omix, DM, p.WoutT, DM, T_TOK, DM, DM, lds, [=](int m, int n, f32x4_e lo, f32x4_e hi) {
      const f32x4_e x0 = *(const f32x4_e*)(x + (size_t)m * DM + n), x1 = *(const f32x4_e*)(x + (size_t)m * DM + n + 4);
      const f32x4_e h0 = x0 + lo, h1 = x1 + hi;
      *(f32x4_e*)(out + (size_t)m * DM + n) = h0; *(f32x4_e*)(out + (size_t)m * DM + n + 4) = h1;
      norm_feed(h0, h1, gmq, n, hn + (size_t)m * DM, rss + m); }); }
  xcd_barrier(xb);
  if (blockIdx.x < 256 || gridDim.x < 512) {
    P p = loadP(); bf16_t* qmem = p.qmemb; const float* rss = p.rowss;
    ph_gemm_bf16<true>(p.hn, DM, p.WmqT, DM, T_TOK, 512, DM, lds, [=](int m, int n, f32x4_e lo, f32x4_e hi) {
      const float rs = rsqrtf(rss[m] * (1.f / DM) + RMS_EPS);
      st_bf16x8(qmem + (size_t)m * 512 + n, lo * rs, hi * rs); });
  }
  {
    const int half = (gridDim.x >= 512) ? 256 : 0;
    if ((int)blockIdx.x >= half) {
      const int nwv = ((int)gridDim.x - half) * 4, wid = ((int)blockIdx.x - half) * 4 + (opq(threadIdx.x) >> 6);
      { P p = loadP(); ph_cvt4(p.pu, p.pu8, p.su8, 16384, wid, nwv); }
      if (gridDim.x < 512) { P p = loadP(); ph_cvt4(p.pv, p.pv8, p.sv8, 16384, wid, nwv); }
      __syncthreads();
      { P p = loadP(); ph_transpose<false>(smem, p.w_mo, 512, DM, DM, p.WmoT, (int)blockIdx.x - half, (int)gridDim.x - half); }
    }
  }
  xcd_barrier(xb);
  { P p = loadP(); ph_memattn2(p, lds); }
  if (gridDim.x >= 512 && blockIdx.x >= 256) {
    const int nwv = ((int)gridDim.x - 256) * 4, wid = ((int)blockIdx.x - 256) * 4 + (opq(threadIdx.x) >> 6);
    { P p = loadP(); ph_cvt4(p.pv, p.pv8, p.sv8, 16384, wid, nwv); }
  }
  {
    const int half = (gridDim.x >= 512) ? 256 : 0;
    __syncthreads();
    P p = loadP(); ph_transpose<false>(smem, p.w_pq, DM, DM, DM, p.WpqT, ((int)blockIdx.x >= half) ? (int)blockIdx.x - half : -1, (int)gridDim.x - half);
  }
  xcd_barrier(xb);
  { P p = loadP(); float* out = p.out; const float* gffn = p.norm_ffn; bf16_t* hn = p.hn; float* rss = p.rowss + T_TOK;
    ph_gemm_big(p.omem, 512, p.WmoT, 512, T_TOK, DM, 512, lds, [=](int m, int n, f32x4_e lo, f32x4_e hi) {
      f32x4_e* o0 = (f32x4_e*)(out + (size_t)m * DM + n);
      const f32x4_e h0 = o0[0] + lo, h1 = o0[1] + hi;
      o0[0] = h0; o0[1] = h1;
      norm_feed(h0, h1, gffn, n, hn + (size_t)m * DM, rss + m); }); }
  xcd_barrier(xb);
  { P p = loadP(); ph_qp_scores(p, lds); }
  xcd_barrier(xb);
  { P p = loadP(); ph_peer(p, smem); }
}

extern "C" void kernel_launch(void* const* d_in, const int* in_sizes, int n_in, void* d_out, int out_size, void* d_ws,
                              size_t ws_size, hipStream_t stream) {
  P p{};
  p.x = (const float*)d_in[0]; p.mem = (const float*)d_in[1]; p.t5 = (const float*)d_in[2];
  p.norm_mix = (const float*)d_in[3]; p.w_in = (const float*)d_in[4]; p.pos_k = (const float*)d_in[5];
  p.w1_k = (const float*)d_in[6]; p.w2_k = (const float*)d_in[7]; p.pos_v = (const float*)d_in[8];
  p.w1_v = (const float*)d_in[9]; p.w2_v = (const float*)d_in[10]; p.w_out = (const float*)d_in[11];
  p.norm_mq = (const float*)d_in[12]; p.norm_mkv = (const float*)d_in[13]; p.w_mq = (const float*)d_in[14];
  p.w_mk = (const float*)d_in[15]; p.w_mv = (const float*)d_in[16]; p.w_mo = (const float*)d_in[17];
  p.norm_ffn = (const float*)d_in[18]; p.w_pq = (const float*)d_in[19]; p.subk = (const float*)d_in[20];
  p.pu = (const float*)d_in[21]; p.pv = (const float*)d_in[22]; p.norm_final = (const float*)d_in[23];
  p.out = (float*)d_out;
  char* w = (char*)d_ws;
  size_t off = 0;
  auto take = [&](size_t bytes) { char* r = w + off; off += (bytes + 255) & ~(size_t)255; return r; };
  p.bar = (unsigned*)take(XCD_BAR_WORDS * 4);
  p.scores = (float*)take((size_t)T_TOK * DM * 4);
  p.gates = (float*)take((size_t)T_TOK * 24 * 4);
  p.part = (float*)take((size_t)T_TOK * 1024 * 4);
  p.posb = (float*)take(256 * 4);
  p.rowss = (float*)take((size_t)2 * T_TOK * 4);
  p.qn = (bf16_t*)take((size_t)T_TOK * 1024 * 2);
  p.kcin = (bf16_t*)take((size_t)T_TOK * 256 * 2 + 65536);
  p.vcin = (bf16_t*)take((size_t)T_TOK * 256 * 2 + 65536);
  p.ks = (bf16_t*)take((size_t)T_TOK * 256 * 2);
  p.vsT = (bf16_t*)take((size_t)T_TOK * 256 * 2);
  p.kw = (bf16_t*)take((size_t)T_TOK * 256 * 2);
  p.vwT = (bf16_t*)take((size_t)T_TOK * 256 * 2);
  p.kcb = (bf16_t*)take((size_t)8 * 128 * 128 * 2);
  p.vcT = (bf16_t*)take((size_t)8 * 128 * 128 * 2);
  p.c1 = (bf16_t*)take((size_t)16 * 128 * 128 * 2);
  p.w1T = (bf16_t*)take((size_t)2 * 128 * 4096 * 2);
  p.w2T = (bf16_t*)take((size_t)2 * 128 * 128 * 2);
  p.hn = (bf16_t*)take((size_t)T_TOK * DM * 2);
  p.omix = (bf16_t*)take((size_t)T_TOK * DM * 2);
  p.memn = (bf16_t*)take((size_t)1024 * DM * 2);
  p.omem = (bf16_t*)take((size_t)T_TOK * 512 * 2);
  p.WinT = (bf16_t*)take((size_t)5760 * DM * 2);
  p.WoutT = (bf16_t*)take((size_t)DM * DM * 2);
  p.WpqT = (bf16_t*)take((size_t)DM * DM * 2);
  p.WmqT = (bf16_t*)take((size_t)512 * DM * 2);
  p.WmkT = (bf16_t*)take((size_t)512 * DM * 2);
  p.WmvT = (bf16_t*)take((size_t)512 * DM * 2);
  p.WmoT = (bf16_t*)take((size_t)DM * 512 * 2);
  p.qmemb = (bf16_t*)take((size_t)T_TOK * 512 * 2);
  p.kmemb = (bf16_t*)take((size_t)1024 * 512 * 2);
  p.vmemT = (bf16_t*)take((size_t)1024 * 512 * 2);
  p.qsb = (bf16_t*)take((size_t)T_TOK * 1024 * 2);
  p.ksb = (bf16_t*)take((size_t)T_TOK * 1024 * 2);
  p.vsbT = (bf16_t*)take((size_t)T_TOK * 1024 * 2);
  p.pu8 = (unsigned char*)take((size_t)16384 * 1024);
  p.pv8 = (unsigned char*)take((size_t)16384 * 1024);
  p.su8 = (float*)take(16384 * 4);
  p.sv8 = (float*)take(16384 * 4);
  p.subkb = (bf16_t*)take((size_t)16 * 128 * 128 * 2);
  static int grid_blocks = 0;
  if (!grid_blocks) {
    int dev = 0, cus = 0, per_cu = 0;
    (void)hipGetDevice(&dev);
    (void)hipDeviceGetAttribute(&cus, hipDeviceAttributeMultiprocessorCount, dev);
    (void)hipOccupancyMaxActiveBlocksPerMultiprocessor(&per_cu, mega, 256, 0);
    if (per_cu > 2) per_cu = 2;
    if (per_cu < 1) per_cu = 1;
    grid_blocks = cus * per_cu;
  }
  void* args[] = {&p};
  hipError_t e = hipLaunchCooperativeKernel((void*)mega, dim3(grid_blocks), dim3(256), args, 0, stream);
  if (e != hipSuccess) fprintf(stderr, "cooperative launch failed: %s (grid %d)\n", hipGetErrorString(e), grid_blocks);
}
```

```cpp
#include <hip/hip_runtime.h>
#include <hip/hip_cooperative_groups.h>
#include <cstdio>
namespace cg = cooperative_groups;
#include <stdint.h>

#define SEQ 2048
#define NBATCH 4
#define T_TOK 8192
#define DM 2048
#define INC 5656
#define C_QN 0
#define C_KC 1024
#define C_VC 1280
#define C_KS 1536
#define C_VS 1792
#define C_KW 2048
#define C_VW 2304
#define C_GT 2560
#define C_QSB 2584
#define C_KSB 3608
#define C_VSB 4632
#define ATT_SCALE 0.08838834764831845f
#define LOG2E 1.4426950408889634f
#define ATT_SCALE2 (ATT_SCALE * LOG2E)
#define RMS_EPS 1e-6f

typedef unsigned short bf16_t;
typedef __attribute__((ext_vector_type(8))) short bf16x8;
typedef __attribute__((ext_vector_type(16))) float f32x16;
typedef __attribute__((ext_vector_type(2))) __bf16 bf16v2;
typedef __attribute__((ext_vector_type(4))) unsigned u32x4;

struct P {
  const float *x, *mem, *t5, *norm_mix, *w_in, *pos_k, *w1_k, *w2_k, *pos_v, *w1_v, *w2_v, *w_out,
      *norm_mq, *norm_mkv, *w_mq, *w_mk, *w_mv, *w_mo, *norm_ffn, *w_pq, *subk, *pu, *pv, *norm_final;
  float* out;
  float *scores, *gates, *part, *posb, *rowss;
  unsigned* bar;
  bf16_t *hn, *omix, *memn, *omem;
  bf16_t *WinT, *WoutT, *WpqT, *WmqT, *WmkT, *WmvT, *WmoT;
  bf16_t *qmemb, *kmemb, *vmemT;
  bf16_t *qsb, *ksb, *vsbT;
  bf16_t* subkb;
  unsigned char *pu8, *pv8;
  float *su8, *sv8;
  bf16_t *qn, *kcin, *vcin, *ks, *vsT, *kw, *vwT, *kcb, *vcT, *c1, *w1T, *w2T;
};

__device__ __forceinline__ int opq(int v) { asm volatile("" : "+v"(v)); return v; }
__device__ __forceinline__ unsigned pack2(float a, float b) {
  bf16v2 r = {(__bf16)a, (__bf16)b};
  return *(unsigned*)&r;
}
__device__ __forceinline__ bf16_t f2bf(float a) {
  __bf16 r = (__bf16)a;
  return *(bf16_t*)&r;
}
__device__ __forceinline__ int perm16(int s) { return (s & ~12) | ((s & 4) << 1) | ((s & 8) >> 1); }
__device__ __forceinline__ float bf2f(bf16_t u) { return __uint_as_float((unsigned)u << 16); }

__device__ __forceinline__ float wave_max(float v) {
  for (int o = 32; o > 0; o >>= 1) v = fmaxf(v, __shfl_xor(v, o));
  return v;
}
__device__ __forceinline__ float wave_sum(float v) {
  for (int o = 32; o > 0; o >>= 1) v += __shfl_xor(v, o);
  return v;
}
__device__ __forceinline__ void wave_argmax(float& v, int& i) {
  for (int o = 32; o > 0; o >>= 1) {
    float ov = __shfl_xor(v, o);
    int oi = __shfl_xor(i, o);
    if (ov > v || (ov == v && oi < i)) { v = ov; i = oi; }
  }
}
__device__ __forceinline__ float gelu_tanh(float x) {
  return 0.5f * x * (1.f + tanhf(0.7978845608028654f * (x + 0.044715f * x * x * x)));
}
__device__ __forceinline__ float gelu_fast(float x) {
  const float y = 1.5957691216057308f * (x + 0.044715f * x * x * x);
  return x / (1.f + __expf(-y));
}
__device__ __forceinline__ int t5_bucket(int n) {
  if (n < 16) return n < 0 ? 0 : n;
  int b = 16;
  b += (n >= 19); b += (n >= 21); b += (n >= 24); b += (n >= 27); b += (n >= 31); b += (n >= 35);
  b += (n >= 40); b += (n >= 46); b += (n >= 52); b += (n >= 59); b += (n >= 67); b += (n >= 77);
  b += (n >= 87); b += (n >= 99); b += (n >= 113);
  return b;
}
__device__ __forceinline__ float log_sigmoid(float x) {
  return fminf(x, 0.f) - log1pf(expf(-fabsf(x)));
}

__device__ __forceinline__ void ph_rmsnorm(const float* src, const float* gain, bf16_t* dst, int rows) {
  int lane = opq(threadIdx.x) & 63, wv = opq(threadIdx.x) >> 6;
  for (int r = blockIdx.x * 4 + wv; r < rows; r += gridDim.x * 4) {
    const float4* s4 = (const float4*)(src + (size_t)r * DM);
    float4 v[8];
    float ss = 0.f;
#pragma unroll
    for (int i = 0; i < 8; ++i) {
      v[i] = s4[i * 64 + lane];
      ss += v[i].x * v[i].x + v[i].y * v[i].y + v[i].z * v[i].z + v[i].w * v[i].w;
    }
    ss = wave_sum(ss);
    float rs = rsqrtf(ss * (1.f / DM) + RMS_EPS);
    uint2* d2 = (uint2*)(dst + (size_t)r * DM);
    const float4* g4 = (const float4*)gain;
#pragma unroll
    for (int i = 0; i < 8; ++i) {
      float4 g = g4[i * 64 + lane];
      uint2 o;
      o.x = pack2(v[i].x * rs * g.x, v[i].y * rs * g.y);
      o.y = pack2(v[i].z * rs * g.z, v[i].w * rs * g.w);
      d2[i * 64 + lane] = o;
    }
  }
}

template <bool CMAP>
__device__ __forceinline__ void ph_transpose(float* smem, const float* W, int K, int N, int Npad, bf16_t* Wt,
                                             int vblock = -2, int nvb = 0) {
  typedef __attribute__((ext_vector_type(4))) float f32x4;
  float (*tl)[65] = (float (*)[65])smem;
  if (vblock == -1) return;
  const int b0 = (vblock >= 0) ? vblock : (int)blockIdx.x, bstride = (vblock >= 0) ? nvb : (int)gridDim.x;
  const int tid = opq(threadIdx.x);
  const int nk = K / 64, nn = Npad / 64;
  for (int tile = b0; tile < nk * nn; tile += bstride) {
    const int k0 = (tile % nk) * 64, n0 = (tile / nk) * 64;
    const int kr = tid >> 4, n4 = (tid & 15) * 4;
    int sc = n0 + n4;
    if (CMAP) sc = (sc < 2560) ? sc : (sc < 5632) ? sc + 24 : (sc < 5656) ? sc - 5632 + 2560 : N;
#pragma unroll
    for (int i = 0; i < 4; ++i) {
      const int k = kr + 16 * i;
      f32x4 v = {0.f, 0.f, 0.f, 0.f};
      if (sc < N) v = *(const f32x4*)(W + (size_t)(k0 + k) * N + sc);
      tl[k][n4 + 0] = v[0]; tl[k][n4 + 1] = v[1]; tl[k][n4 + 2] = v[2]; tl[k][n4 + 3] = v[3];
    }
    __syncthreads();
    int n = tid >> 2, kc = (tid & 3) * 16;
    unsigned w[8];
#pragma unroll
    for (int i = 0; i < 8; ++i) w[i] = pack2(tl[kc + 2 * i][n], tl[kc + 2 * i + 1][n]);
    uint4* dst = (uint4*)(Wt + (size_t)(n0 + n) * K + k0 + kc);
    dst[0] = make_uint4(w[0], w[1], w[2], w[3]);
    dst[1] = make_uint4(w[4], w[5], w[6], w[7]);
    __syncthreads();
  }
}

__device__ __forceinline__ int lds_off(int row, int chunk) { return row * 128 + ((chunk ^ ((row >> 1) & 7)) << 4); }

template <bool TR, bool VEC = false, class Epi>
__device__ __forceinline__ void gemm_tile_bf16(const bf16_t* xp, int ldx, const bf16_t* yp, int ldy, int K, char* lds,
                                               Epi epi) {
  const int tid = opq(threadIdx.x), lane = tid & 63, wv = tid >> 6;
  const int wr = wv >> 1, wc = wv & 1;
  f32x16 acc[2][2];
#pragma unroll
  for (int i = 0; i < 2; ++i)
#pragma unroll
    for (int j = 0; j < 2; ++j)
#pragma unroll
      for (int r = 0; r < 16; ++r) acc[i][j][r] = 0.f;
  const int prow = lane >> 3, pch = lane & 7;
  const bf16_t* xs[4];
  const bf16_t* ys[4];
#pragma unroll
  for (int ps = 0; ps < 4; ++ps) {
    const int row = (wv * 4 + ps) * 8 + prow;
    const int c = pch ^ ((row >> 1) & 7);
    xs[ps] = xp + (size_t)row * ldx + c * 8;
    ys[ps] = yp + (size_t)row * ldy + c * 8;
  }
  char* const mydst = lds + wv * 4096 + lane * 16;
#define GEMM_ISSUE(k0, bufoff)                                                                                              \
  _Pragma("unroll") for (int ps = 0; ps < 4; ++ps) {                                                                        \
    __builtin_amdgcn_global_load_lds((const unsigned*)(xs[ps] + (k0)), (unsigned*)(mydst + (bufoff) + ps * 1024), 16, 0, 0);         \
    __builtin_amdgcn_global_load_lds((const unsigned*)(ys[ps] + (k0)), (unsigned*)(mydst + (bufoff) + 16384 + ps * 1024), 16, 0, 0); \
  }
#define GEMM_COMPUTE(bufoff)                                                                                     \
  _Pragma("unroll") for (int kk = 0; kk < 4; ++kk) {                                                             \
    bf16x8 a[2], b[2];                                                                                           \
    const int ch = kk * 2 + (lane >> 5);                                                                         \
    _Pragma("unroll") for (int i = 0; i < 2; ++i) {                                                              \
      a[i] = *(const bf16x8*)(lds + (bufoff) + (TR ? 16384 : 0) + lds_off(wr * 64 + i * 32 + (lane & 31), ch)); \
      b[i] = *(const bf16x8*)(lds + (bufoff) + (TR ? 0 : 16384) + lds_off(wc * 64 + i * 32 + (lane & 31), ch)); \
    }                                                                                                            \
    _Pragma("unroll") for (int i = 0; i < 2; ++i)                                                                \
      _Pragma("unroll") for (int j = 0; j < 2; ++j)                                                              \
        acc[i][j] = __builtin_amdgcn_mfma_f32_32x32x16_bf16(a[i], b[j], acc[i][j], 0, 0, 0);                    \
  }
  __syncthreads();
  GEMM_ISSUE(0, 0)
  for (int k0 = 0; k0 < K; k0 += 128) {
    asm volatile("s_waitcnt vmcnt(0)" ::: "memory");
    __syncthreads();
    GEMM_ISSUE(k0 + 64, 32768)
    GEMM_COMPUTE(0)
    asm volatile("s_waitcnt vmcnt(0)" ::: "memory");
    __syncthreads();
    if (k0 + 128 < K) { GEMM_ISSUE(k0 + 128, 0) }
    GEMM_COMPUTE(32768)
  }
#undef GEMM_ISSUE
#undef GEMM_COMPUTE
  int lane2 = lane;
  asm volatile("" : "+v"(lane2));
  if constexpr (VEC) {
    typedef __attribute__((ext_vector_type(4))) float f32x4;
    __syncthreads();
    float* wl = (float*)lds + wv * (32 * 68);
    const int hh2 = lane2 >> 5, cl = lane2 & 31;
#pragma unroll
    for (int i = 0; i < 2; ++i) {
#pragma unroll
      for (int j = 0; j < 2; ++j)
#pragma unroll
        for (int r = 0; r < 16; ++r) wl[((r & 3) + 8 * (r >> 2) + 4 * hh2) * 68 + j * 32 + cl] = acc[i][j][r];
      __builtin_amdgcn_wave_barrier();
#pragma unroll
      for (int k = 0; k < 4; ++k) {
        const int row = (lane2 >> 3) + 8 * k, c8 = (lane2 & 7) * 8;
        const f32x4 lo = *(const f32x4*)&wl[row * 68 + c8];
        const f32x4 hi = *(const f32x4*)&wl[row * 68 + c8 + 4];
        epi(wr * 64 + i * 32 + row, wc * 64 + c8, lo, hi);
      }
      __builtin_amdgcn_wave_barrier();
    }
  } else {
#pragma unroll
    for (int i = 0; i < 2; ++i)
#pragma unroll
      for (int j = 0; j < 2; ++j)
#pragma unroll
        for (int r = 0; r < 16; ++r) {
          int rr = wr * 64 + i * 32 + (r & 3) + 8 * (r >> 2) + 4 * (lane2 >> 5);
          int cc = wc * 64 + j * 32 + (lane2 & 31);
          epi(rr, cc, acc[i][j][r]);
        }
  }
}

typedef __attribute__((ext_vector_type(4))) float f32x4_e;
__device__ __forceinline__ void st_bf16x8(bf16_t* dst, f32x4_e lo, f32x4_e hi) {
  u32x4 o;
  o[0] = pack2(lo[0], lo[1]); o[1] = pack2(lo[2], lo[3]); o[2] = pack2(hi[0], hi[1]); o[3] = pack2(hi[2], hi[3]);
  *(u32x4*)dst = o;
}

__device__ __forceinline__ int lds_off32(int row, int chunk) { return row * 64 + ((chunk ^ ((row >> 2) & 3)) << 4); }

template <class Epi>
__device__ __forceinline__ void gemm_tile_big(const bf16_t* xp, int ldx, const bf16_t* yp, int ldy, int K, char* lds,
                                              Epi epi) {
  const int tid = opq(threadIdx.x), lane = tid & 63, wv = tid >> 6;
  f32x16 acc[2][4];
#pragma unroll
  for (int i = 0; i < 2; ++i)
#pragma unroll
    for (int j = 0; j < 4; ++j)
#pragma unroll
      for (int r = 0; r < 16; ++r) acc[i][j][r] = 0.f;
  const int prow = lane >> 2, pch = lane & 3;
  const bf16_t* xs[4];
  const bf16_t* ys[2];
#pragma unroll
  for (int ps = 0; ps < 4; ++ps) {
    const int row = (wv * 4 + ps) * 16 + prow;
    xs[ps] = xp + (size_t)row * ldx + (pch ^ ((row >> 2) & 3)) * 8;
  }
#pragma unroll
  for (int ps = 0; ps < 2; ++ps) {
    const int row = (wv * 2 + ps) * 16 + prow;
    ys[ps] = yp + (size_t)row * ldy + (pch ^ ((row >> 2) & 3)) * 8;
  }
  char* const xdst = lds + wv * 4096 + lane * 16;
  char* const ydst = lds + 16384 + wv * 2048 + lane * 16;
#define BIG_ISSUE(k0, st)                                                                                                      \
  _Pragma("unroll") for (int ps = 0; ps < 4; ++ps)                                                                             \
    __builtin_amdgcn_global_load_lds((const unsigned*)(xs[ps] + (k0)), (unsigned*)(xdst + (st) + ps * 1024), 16, 0, 0);        \
  _Pragma("unroll") for (int ps = 0; ps < 2; ++ps)                                                                             \
    __builtin_amdgcn_global_load_lds((const unsigned*)(ys[ps] + (k0)), (unsigned*)(ydst + (st) + ps * 1024), 16, 0, 0);
#define BIG_COMPUTE(st)                                                                                   \
  _Pragma("unroll") for (int kk = 0; kk < 2; ++kk) {                                                      \
    bf16x8 a[2], b[4];                                                                                    \
    const int ch = kk * 2 + (lane >> 5);                                                                  \
    _Pragma("unroll") for (int i = 0; i < 2; ++i)                                                         \
      a[i] = *(const bf16x8*)(lds + (st) + lds_off32(wv * 64 + i * 32 + (lane & 31), ch));                \
    _Pragma("unroll") for (int j = 0; j < 4; ++j)                                                         \
      b[j] = *(const bf16x8*)(lds + (st) + 16384 + lds_off32(j * 32 + (lane & 31), ch));                  \
    _Pragma("unroll") for (int i = 0; i < 2; ++i)                                                         \
      _Pragma("unroll") for (int j = 0; j < 4; ++j)                                                       \
        acc[i][j] = __builtin_amdgcn_mfma_f32_32x32x16_bf16(a[i], b[j], acc[i][j], 0, 0, 0);             \
  }
  __syncthreads();
  BIG_ISSUE(0, 0)
  for (int k0 = 0; k0 < K; k0 += 64) {
    asm volatile("s_waitcnt vmcnt(0)" ::: "memory");
    __syncthreads();
    BIG_ISSUE(k0 + 32, 24576)
    BIG_COMPUTE(0)
    asm volatile("s_waitcnt vmcnt(0)" ::: "memory");
    __syncthreads();
    if (k0 + 64 < K) { BIG_ISSUE(k0 + 64, 0) }
    BIG_COMPUTE(24576)
  }
#undef BIG_ISSUE
#undef BIG_COMPUTE
  const int lane2 = opq(lane);
  typedef __attribute__((ext_vector_type(4))) float f32x4;
  __syncthreads();
  float* wl = (float*)lds + wv * (32 * 68);
  const int hh2 = lane2 >> 5, cl = lane2 & 31;
#pragma unroll
  for (int i = 0; i < 2; ++i)
#pragma unroll
    for (int jh = 0; jh < 2; ++jh) {
#pragma unroll
      for (int j = 0; j < 2; ++j)
#pragma unroll
        for (int r = 0; r < 16; ++r) wl[((r & 3) + 8 * (r >> 2) + 4 * hh2) * 68 + j * 32 + cl] = acc[i][jh * 2 + j][r];
      __builtin_amdgcn_wave_barrier();
#pragma unroll
      for (int k = 0; k < 4; ++k) {
        const int row = (lane2 >> 3) + 8 * k, c8 = (lane2 & 7) * 8;
        const f32x4 lo = *(const f32x4*)&wl[row * 68 + c8];
        const f32x4 hi = *(const f32x4*)&wl[row * 68 + c8 + 4];
        epi(wv * 64 + i * 32 + row, jh * 64 + c8, lo, hi);
      }
      __builtin_amdgcn_wave_barrier();
    }
}

template <class Epi>
__device__ __forceinline__ void ph_gemm_big(const bf16_t* A, int lda, const bf16_t* Wt, int ldw, int M, int N, int K,
                                            char* lds, Epi epi) {
  const int ntm = M / 256, ntn = N / 128;
  const int npm = (ntm + 7) / 8, npn = (ntn + 7) / 8;
  const int nslots = ((npm * npn * 64 + 511) / 512) * 512;
  for (int u = blockIdx.x; u < nslots; u += gridDim.x) {
    int v = (u & 7) * 64 + ((u >> 3) & 63) + (u & ~511);
    int patch = v >> 6, w = v & 63;
    int tm = (patch % npm) * 8 + (w & 7);
    int tn = (patch / npm) * 8 + (w >> 3);
    if (tm >= ntm || tn >= ntn) continue;
    const int m0 = tm * 256, n0 = tn * 128;
    gemm_tile_big(A + (size_t)m0 * lda, lda, Wt + (size_t)n0 * ldw, ldw, K, lds,
                  [&](int r, int c, f32x4_e lo, f32x4_e hi) { epi(m0 + r, n0 + c, lo, hi); });
  }
}

__device__ __forceinline__ void norm_feed(const f32x4_e h0, const f32x4_e h1, const float* gain, int n, bf16_t* hn_row,
                                          float* rowss_m) {
  const f32x4_e g0 = *(const f32x4_e*)(gain + n), g1 = *(const f32x4_e*)(gain + n + 4);
  st_bf16x8(hn_row + n, h0 * g0, h1 * g1);
  float ss = h0[0] * h0[0] + h0[1] * h0[1] + h0[2] * h0[2] + h0[3] * h0[3] + h1[0] * h1[0] + h1[1] * h1[1] + h1[2] * h1[2] + h1[3] * h1[3];
  ss += __shfl_xor(ss, 1);
  ss += __shfl_xor(ss, 2);
  ss += __shfl_xor(ss, 4);
  if (((opq(threadIdx.x)) & 7) == 0) atomicAdd(rowss_m, ss);
}

template <bool VEC = false, class Epi>
__device__ __forceinline__ void ph_gemm_bf16(const bf16_t* A, int lda, const bf16_t* Wt, int ldw, int M, int N, int K,
                                             char* lds, Epi epi, int vblock = -2) {
  const int ntm = M / 128, ntn = N / 128;
  const int npm = (ntm + 7) / 8, npn = (ntn + 7) / 8;
  const int nslots = ((npm * npn * 64 + 511) / 512) * 512;
  if (vblock == -1) return;
  for (int u = (vblock >= 0 ? vblock : (int)blockIdx.x); u < nslots; u += gridDim.x) {
    int v = (u & 7) * 64 + ((u >> 3) & 63) + (u & ~511);
    int patch = v >> 6, w = v & 63;
    int tm = (patch % npm) * 8 + (w & 7);
    int tn = (patch / npm) * 8 + (w >> 3);
    if (tm >= ntm || tn >= ntn) continue;
    const int m0 = tm * 128, n0 = tn * 128;
    if constexpr (VEC)
      gemm_tile_bf16<false, true>(A + (size_t)m0 * lda, lda, Wt + (size_t)n0 * ldw, ldw, K, lds,
                                  [&](int r, int c, f32x4_e lo, f32x4_e hi) { epi(m0 + r, n0 + c, lo, hi); });
    else
      gemm_tile_bf16<false>(A + (size_t)m0 * lda, lda, Wt + (size_t)n0 * ldw, ldw, K, lds,
                            [&](int r, int c, float val) { epi(m0 + r, n0 + c, val); });
  }
}

__device__ __forceinline__ void ph_proj(const P& p, char* lds) {
  for (int u = blockIdx.x; u < 1024; u += gridDim.x) {
    int v = (u & 7) * 64 + ((u >> 3) & 63) + (u & ~511);
    int patch = v >> 6, w = v & 63;
    const int tm = (patch & 3) * 8 + (w & 7), tb = (patch >> 2) * 8 + (w >> 3);
    const int tn = (tb < 14) ? tb : (tb < 16) ? tb + 2 : tb + 4;
    const int m0 = tm * 256, n0 = tn * 128;
    const int b = m0 >> 11, sl = m0 & 2047;
    const bf16_t* A = p.hn + (size_t)m0 * DM;
    const bf16_t* W = p.WinT + (size_t)n0 * DM;
    bf16_t* dst;
    int ldd;
    if (n0 < 1024) { dst = p.qn + (size_t)m0 * 1024 + n0; ldd = 1024; }
    else if (n0 < 2560) {
      const int seg = (n0 - 1024) >> 8, g = ((n0 - 1024) >> 7) & 1;
      bf16_t* base = (seg == 0) ? p.kcin : (seg == 1) ? p.vcin : (seg == 2) ? p.ks : p.kw;
      dst = base + ((size_t)(b * 2 + g) * SEQ + sl) * 128; ldd = 128;
    } else if (n0 < 3584) { dst = p.qsb + (size_t)m0 * 1024 + (n0 - 2560); ldd = 1024; }
    else { dst = p.ksb + ((size_t)(b * 8 + ((n0 - 3584) >> 7)) * SEQ + sl) * 128; ldd = 128; }
    gemm_tile_big(A, DM, W, DM, DM, lds, [&](int r, int c, f32x4_e lo, f32x4_e hi) { st_bf16x8(dst + (size_t)r * ldd + c, lo, hi); });
  }
  for (int u = blockIdx.x; u < 64 * 13; u += gridDim.x) {
    const int tm = u & 63, ts = u >> 6;
    const int tn = (ts < 2) ? 14 + ts : (ts < 4) ? 16 + ts : (ts < 12) ? 32 + ts : 44;
    const int m0 = tm * 128, n0 = tn * 128;
    const int b = m0 >> 11, sl = m0 & 2047;
    const bf16_t* A = p.hn + (size_t)m0 * DM;
    const bf16_t* W = p.WinT + (size_t)n0 * DM;
    if (n0 < 2560) {
      const int seg = (n0 - 1024) >> 8, g = ((n0 - 1024) >> 7) & 1;
      bf16_t* vd = (seg == 3 ? p.vsT : p.vwT) + ((size_t)(b * 2 + g) * 128) * SEQ + sl;
      gemm_tile_bf16<true>(A, DM, W, DM, DM, lds, [&](int r, int c, float val) { vd[(size_t)r * SEQ + perm16(c)] = f2bf(val); });
    } else if (n0 < 5632) {
      bf16_t* vd = p.vsbT + ((size_t)(b * 8 + ((n0 - 4608) >> 7)) * 128) * SEQ + sl;
      gemm_tile_bf16<true>(A, DM, W, DM, DM, lds, [&](int r, int c, float val) { vd[(size_t)r * SEQ + perm16(c)] = f2bf(val); });
    } else {
      float* gd = p.gates + (size_t)m0 * 24;
      gemm_tile_bf16<false>(A, DM, W, DM, DM, lds, [&](int r, int c, float val) { if (c < 24) gd[(size_t)r * 24 + c] = val; });
    }
  }
}

__device__ __forceinline__ void ph_posb(const P& p) {
  const int lane = opq(threadIdx.x) & 63, wv = opq(threadIdx.x) >> 6;
  for (int o = blockIdx.x * 4 + wv; o < 256; o += gridDim.x * 4) {
    const int which = o >> 7, n = o & 127;
    const float* pos = which ? p.pos_v : p.pos_k;
    const float* w1 = which ? p.w1_v : p.w1_k;
    float acc = 0.f;
    for (int k = lane; k < 4096; k += 64) acc += pos[k] * w1[(size_t)k * 128 + n];
    acc = wave_sum(acc);
    if (lane == 0) p.posb[o] = acc;
  }
}

__device__ __forceinline__ void ph_compress2(const P& p, char* lds) {
  for (int item = blockIdx.x; item < 16; item += gridDim.x) {
    const int which = item >> 3, bg = item & 7;
    const bf16_t* src = (which ? p.vcin : p.kcin) + (size_t)bg * SEQ * 128;
    const bf16_t* w1t = p.w1T + (size_t)which * 128 * 4096;
    const bf16_t* w2t = p.w2T + (size_t)which * 128 * 128;
    const float* posb = p.posb + which * 128;
    bf16_t* c1 = p.c1 + (size_t)item * 128 * 128;
    gemm_tile_bf16<false>(src, 2048, w1t, 4096, 4096, lds, [&](int r, int c, float val) {
      c1[r * 128 + c] = f2bf(gelu_fast(val + posb[c])); });
    __threadfence_block();
    __syncthreads();
    if (which == 0) {
      bf16_t* kd = p.kcb + (size_t)bg * 128 * 128;
      gemm_tile_bf16<false>(c1, 128, w2t, 128, 128, lds, [&](int r, int c, float val) { kd[r * 128 + c] = f2bf(val); });
    } else {
      bf16_t* vd = p.vcT + (size_t)bg * 128 * 128;
      gemm_tile_bf16<true>(c1, 128, w2t, 128, 128, lds, [&](int r, int c, float val) { vd[r * 128 + perm16(c)] = f2bf(val); });
    }
  }
}

#define NEG_BIG (-1e30f)

struct KVRegs { u32x4 k0, k1, k2, k3, v0, v1, v2, v3; };

__device__ __forceinline__ int koff(int row, int chunk) { return row * 256 + ((chunk ^ (row & 15)) << 4); }

__device__ __forceinline__ void kv_load(KVRegs& r, const bf16_t* kp, int ldk, const bf16_t* vp, int ldv) {
  const int tid = opq(threadIdx.x);
  const bf16_t* kg = kp + (size_t)(tid >> 4) * ldk + (tid & 15) * 8;
  r.k0 = *(const u32x4*)kg;
  r.k1 = *(const u32x4*)(kg + (size_t)16 * ldk);
  r.k2 = *(const u32x4*)(kg + (size_t)32 * ldk);
  r.k3 = *(const u32x4*)(kg + (size_t)48 * ldk);
  const bf16_t* vg = vp + (size_t)(tid >> 3) * ldv + (tid & 7) * 8;
  r.v0 = *(const u32x4*)vg;
  r.v1 = *(const u32x4*)(vg + (size_t)32 * ldv);
  r.v2 = *(const u32x4*)(vg + (size_t)64 * ldv);
  r.v3 = *(const u32x4*)(vg + (size_t)96 * ldv);
}
__device__ __forceinline__ void kv_store(const KVRegs& r, char* lk, char* lv) {
  const int tid = opq(threadIdx.x);
  const int row = tid >> 4, ch = tid & 15;
  *(u32x4*)(lk + koff(row, ch)) = r.k0;
  *(u32x4*)(lk + koff(row + 16, ch)) = r.k1;
  *(u32x4*)(lk + koff(row + 32, ch)) = r.k2;
  *(u32x4*)(lk + koff(row + 48, ch)) = r.k3;
  const int vr = tid >> 3, vc = tid & 7;
  *(u32x4*)(lv + lds_off(vr, vc)) = r.v0;
  *(u32x4*)(lv + lds_off(vr + 32, vc)) = r.v1;
  *(u32x4*)(lv + lds_off(vr + 64, vc)) = r.v2;
  *(u32x4*)(lv + lds_off(vr + 96, vc)) = r.v3;
}

struct QFrag { bf16x8 f0, f1, f2, f3, f4, f5, f6, f7; };
__device__ __forceinline__ void q_load(QFrag& q, const bf16_t* qrow) {
  const int h = (opq(threadIdx.x) & 63) >> 5;
  const bf16x8* p8 = (const bf16x8*)(qrow + 8 * h);
  q.f0 = p8[0]; q.f1 = p8[2]; q.f2 = p8[4]; q.f3 = p8[6]; q.f4 = p8[8]; q.f5 = p8[10]; q.f6 = p8[12]; q.f7 = p8[14];
}

__device__ __forceinline__ void qk_tile(const QFrag& q, const char* lk, f32x16& s0, f32x16& s1) {
  const int lane = opq(threadIdx.x) & 63, row = lane & 31, h = lane >> 5;
#pragma unroll
  for (int r = 0; r < 16; ++r) { s0[r] = 0.f; s1[r] = 0.f; }
#define QK_STEP(kk, qf)                                                                  \
  {                                                                                      \
    bf16x8 a0 = *(const bf16x8*)(lk + koff(row, 2 * (kk) + h));                          \
    bf16x8 a1 = *(const bf16x8*)(lk + koff(row + 32, 2 * (kk) + h));                     \
    s0 = __builtin_amdgcn_mfma_f32_32x32x16_bf16(a0, qf, s0, 0, 0, 0);                   \
    s1 = __builtin_amdgcn_mfma_f32_32x32x16_bf16(a1, qf, s1, 0, 0, 0);                   \
  }
  QK_STEP(0, q.f0) QK_STEP(1, q.f1) QK_STEP(2, q.f2) QK_STEP(3, q.f3)
  QK_STEP(4, q.f4) QK_STEP(5, q.f5) QK_STEP(6, q.f6) QK_STEP(7, q.f7)
#undef QK_STEP
}

__device__ __forceinline__ bf16x8 pack8(const f32x16& p, const int base) {
  u32x4 u;
  u[0] = pack2(p[base + 0], p[base + 1]);
  u[1] = pack2(p[base + 2], p[base + 3]);
  u[2] = pack2(p[base + 4], p[base + 5]);
  u[3] = pack2(p[base + 6], p[base + 7]);
  return __builtin_bit_cast(bf16x8, u);
}

typedef __attribute__((ext_vector_type(2))) unsigned u32x2_t;
__device__ __forceinline__ float xhalf_max(float v) {
  const u32x2_t r = __builtin_amdgcn_permlane32_swap(__float_as_uint(v), __float_as_uint(v), false, false);
  return fmaxf(__uint_as_float(r[0]), __uint_as_float(r[1]));
}
__device__ __forceinline__ float xhalf_sum(float v) {
  const u32x2_t r = __builtin_amdgcn_permlane32_swap(__float_as_uint(v), __float_as_uint(v), false, false);
  return __uint_as_float(r[0]) + __uint_as_float(r[1]);
}
__device__ __forceinline__ float xhalf_get(float v, int hh) {
  const u32x2_t r = __builtin_amdgcn_permlane32_swap(__float_as_uint(v), __float_as_uint(v), false, false);
  return hh ? __uint_as_float(r[0]) : __uint_as_float(r[1]);
}
struct OAcc { f32x16 o0, o1, o2, o3; };
__device__ __forceinline__ void oacc_zero(OAcc& o) {
#pragma unroll
  for (int r = 0; r < 16; ++r) { o.o0[r] = 0.f; o.o1[r] = 0.f; o.o2[r] = 0.f; o.o3[r] = 0.f; }
}
__device__ __forceinline__ void oacc_scale(OAcc& o, float a) {
#pragma unroll
  for (int r = 0; r < 16; ++r) { o.o0[r] *= a; o.o1[r] *= a; o.o2[r] *= a; o.o3[r] *= a; }
}

__device__ __forceinline__ void pv_tile(OAcc& o, const char* lv, const f32x16& p0, const f32x16& p1) {
  const int lane = opq(threadIdx.x) & 63, row = lane & 31, h = lane >> 5;
  const bf16x8 pf0 = pack8(p0, 0), pf1 = pack8(p0, 8), pf2 = pack8(p1, 0), pf3 = pack8(p1, 8);
#define PV_ROW(dd, acc)                                                                                      \
  {                                                                                                          \
    acc = __builtin_amdgcn_mfma_f32_32x32x16_bf16(*(const bf16x8*)(lv + lds_off(32 * (dd) + row, 0 + h)), pf0, acc, 0, 0, 0); \
    acc = __builtin_amdgcn_mfma_f32_32x32x16_bf16(*(const bf16x8*)(lv + lds_off(32 * (dd) + row, 2 + h)), pf1, acc, 0, 0, 0); \
    acc = __builtin_amdgcn_mfma_f32_32x32x16_bf16(*(const bf16x8*)(lv + lds_off(32 * (dd) + row, 4 + h)), pf2, acc, 0, 0, 0); \
    acc = __builtin_amdgcn_mfma_f32_32x32x16_bf16(*(const bf16x8*)(lv + lds_off(32 * (dd) + row, 6 + h)), pf3, acc, 0, 0, 0); \
  }
  PV_ROW(0, o.o0) PV_ROW(1, o.o1) PV_ROW(2, o.o2) PV_ROW(3, o.o3)
#undef PV_ROW
}

__device__ __forceinline__ void softmax_tile(f32x16& s0, f32x16& s1, float& m, float& l, OAcc& o) {
  float mx = NEG_BIG;
#pragma unroll
  for (int r = 0; r < 16; ++r) mx = fmaxf(mx, fmaxf(s0[r], s1[r]));
  mx = xhalf_max(mx);
  const float mn = fmaxf(m, mx);
  const float alpha = __builtin_amdgcn_exp2f(m - mn);
  float ls = 0.f;
#pragma unroll
  for (int r = 0; r < 16; ++r) {
    const float a = __builtin_amdgcn_exp2f(s0[r] - mn);
    const float b = __builtin_amdgcn_exp2f(s1[r] - mn);
    s0[r] = a; s1[r] = b;
    ls += a + b;
  }
  ls = xhalf_sum(ls);
  l = l * alpha + ls;
  m = mn;
  if (__any(alpha != 1.f)) oacc_scale(o, alpha);
}

template <class F>
__device__ __forceinline__ void oacc_foreach(const OAcc& o, F f) {
  const int h = (opq(threadIdx.x) & 63) >> 5;
#pragma unroll
  for (int rho = 0; rho < 4; ++rho) {
    f(0 + 8 * rho + 4 * h, o.o0[4 * rho], o.o0[4 * rho + 1], o.o0[4 * rho + 2], o.o0[4 * rho + 3]);
    f(32 + 8 * rho + 4 * h, o.o1[4 * rho], o.o1[4 * rho + 1], o.o1[4 * rho + 2], o.o1[4 * rho + 3]);
    f(64 + 8 * rho + 4 * h, o.o2[4 * rho], o.o2[4 * rho + 1], o.o2[4 * rho + 2], o.o2[4 * rho + 3]);
    f(96 + 8 * rho + 4 * h, o.o3[4 * rho], o.o3[4 * rho + 1], o.o3[4 * rho + 2], o.o3[4 * rho + 3]);
  }
}

__device__ __forceinline__ void memattn_item(const P& p, char* lds, int item) {
  char* lk = lds;
  char* lv = lds + 16384;
  const int lane = opq(threadIdx.x) & 63, wv = opq(threadIdx.x) >> 6;
  {
    const int tb = item % (SEQ / 128);
    const int bh = item / (SEQ / 128);
    const int b = bh >> 2, hd = bh & 3;
    const int t = tb * 128 + wv * 32 + (lane & 31);
    QFrag q;
    q_load(q, p.qmemb + (size_t)(b * SEQ + t) * 512 + hd * 128);
    const bf16_t* kb = p.kmemb + (size_t)bh * 256 * 128;
    const bf16_t* vb = p.vmemT + (size_t)bh * 128 * 256;
    OAcc o;
    oacc_zero(o);
    float m = NEG_BIG, l = 0.f;
    KVRegs kv;
    kv_load(kv, kb, 128, vb, 256);
#pragma unroll 1
    for (int ti = 0; ti < 4; ++ti) {
      __syncthreads();
      kv_store(kv, lk, lv);
      __syncthreads();
      {
        const int tn = (ti + 1 < 4) ? ti + 1 : 3;
        kv_load(kv, kb + (size_t)tn * 64 * 128, 128, vb + tn * 64, 256);
      }
      f32x16 s0, s1;
      qk_tile(q, lk, s0, s1);
#pragma unroll
      for (int r = 0; r < 16; ++r) { s0[r] *= ATT_SCALE2; s1[r] *= ATT_SCALE2; }
      softmax_tile(s0, s1, m, l, o);
      pv_tile(o, lv, s0, s1);
    }
    const float il = 1.f / l;
    const int t2 = tb * 128 + (opq(threadIdx.x) >> 6) * 32 + (opq(threadIdx.x) & 31);
    bf16_t* orow = p.omem + (size_t)(b * SEQ + t2) * 512 + hd * 128;
    oacc_foreach(o, [&](int d, float v0, float v1, float v2, float v3) {
      uint2 u;
      u.x = pack2(v0 * il, v1 * il);
      u.y = pack2(v2 * il, v3 * il);
      *(uint2*)(orow + d) = u;
    });
  }
}

__device__ __forceinline__ void ph_memq_attn(const P& p, char* lds, int vblock, int nvb) {
  if (vblock < 0) return;
  const float* rss = p.rowss;
  for (int u = vblock; u < 64 * 4; u += nvb) {
    const int tm = u & 63, hd = u >> 6;
    const int m0 = tm * 128;
    bf16_t* qd = p.qmemb + (size_t)m0 * 512 + hd * 128;
    gemm_tile_bf16<false, true>(p.hn + (size_t)m0 * DM, DM, p.WmqT + (size_t)hd * 128 * DM, DM, DM, lds,
                                [&](int r, int c, f32x4_e lo, f32x4_e hi) {
                                  const float rs = rsqrtf(rss[m0 + r] * (1.f / DM) + RMS_EPS);
                                  st_bf16x8(qd + (size_t)r * 512 + c, lo * rs, hi * rs); });
    __threadfence_block();
    __syncthreads();
    memattn_item(p, lds, ((m0 >> 11) * 4 + hd) * (SEQ / 128) + ((m0 & 2047) >> 7));
  }
}

__device__ __forceinline__ void ph_sb2(const P& p, char* lds) {
  char* lk = lds;
  char* lv = lds + 16384;
  const int lane = opq(threadIdx.x) & 63, wv = opq(threadIdx.x) >> 6, hh = lane >> 5;
  const int sb_skip = (gridDim.x > 32) ? 16 : 0;
  if ((int)blockIdx.x < sb_skip) return;
  for (int item = (int)blockIdx.x - sb_skip; item < NBATCH * 8 * (SEQ / 128); item += (int)gridDim.x - sb_skip) {
    const int tb = (SEQ / 128 - 1) - (item % (SEQ / 128));
    const int bh = item / (SEQ / 128);
    const int b = bh >> 3, hd = bh & 7;
    const int t0 = tb * 128;
    const int t = t0 + wv * 32 + (lane & 31);
    QFrag q;
    q_load(q, p.qsb + (size_t)(b * SEQ + t) * 1024 + hd * 128);
    const bf16_t* kb = p.ksb + (size_t)bh * SEQ * 128;
    const bf16_t* vb = p.vsbT + (size_t)bh * 128 * SEQ;
    OAcc o;
    oacc_zero(o);
    float carry = 0.f;
    const int jhi = (t0 >> 6) + 1;
    const int jw = (t0 + wv * 32 + 30) >> 6;
    KVRegs kv;
    kv_load(kv, kb + (size_t)jhi * 64 * 128, 128, vb + jhi * 64, SEQ);
    volatile unsigned* dflag = (volatile unsigned*)(lds + 32768);
    __syncthreads();
    if (opq(threadIdx.x) < 4) dflag[opq(threadIdx.x)] = 0u;
    for (int j = jhi; j >= 0; --j) {
      __syncthreads();
      if ((dflag[0] & dflag[1] & dflag[2] & dflag[3]) != 0u) break;
      kv_store(kv, lk, lv);
      __syncthreads();
      const int jn = (j > 0) ? j - 1 : 0;
      if (j > jw) kv_load(kv, kb + (size_t)jn * 64 * 128, 128, vb + jn * 64, SEQ);
      if (j <= jw) {
        f32x16 z0, z1;
        qk_tile(q, lk, z0, z1);
        const int sbase = j * 64 + 4 * hh;
        float gt[8];
        f32x16 l0, l1;
#pragma unroll
        for (int r = 0; r < 16; ++r) {
          const int so = sbase + 8 * (r >> 2) + (r & 3);
          {
            const float z = z0[r] * ATT_SCALE2;
            const bool valid = so < t;
            const float lsp = fminf(z, 0.f) - __builtin_amdgcn_logf(1.f + __builtin_amdgcn_exp2f(-fabsf(z)));
            l0[r] = valid ? (lsp - z) : 0.f;
            z0[r] = valid ? z : NEG_BIG;
          }
          {
            const float z = z1[r] * ATT_SCALE2;
            const bool valid = so + 32 < t;
            const float lsp = fminf(z, 0.f) - __builtin_amdgcn_logf(1.f + __builtin_amdgcn_exp2f(-fabsf(z)));
            l1[r] = valid ? (lsp - z) : 0.f;
            z1[r] = valid ? z : NEG_BIG;
          }
        }
#pragma unroll
        for (int rho = 0; rho < 4; ++rho) {
          gt[rho] = (l0[4 * rho] + l0[4 * rho + 1]) + (l0[4 * rho + 2] + l0[4 * rho + 3]);
          gt[4 + rho] = (l1[4 * rho] + l1[4 * rho + 1]) + (l1[4 * rho + 2] + l1[4 * rho + 3]);
        }
        float ag[8];
        float run = 0.f;
#pragma unroll
        for (int k = 7; k >= 0; --k) {
          const float pg = xhalf_get(gt[k], hh);
          ag[k] = carry + run + (hh == 0 ? pg : 0.f);
          run += gt[k] + pg;
        }
        carry += run;
#pragma unroll
        for (int rho = 0; rho < 4; ++rho) {
          {
            const float x3 = l0[4 * rho + 3], x23 = x3 + l0[4 * rho + 2], x123 = x23 + l0[4 * rho + 1];
            const float g = ag[rho];
            z0[4 * rho + 0] = __builtin_amdgcn_exp2f((l0[4 * rho + 0] + z0[4 * rho + 0]) + (g + x123));
            z0[4 * rho + 1] = __builtin_amdgcn_exp2f((l0[4 * rho + 1] + z0[4 * rho + 1]) + (g + x23));
            z0[4 * rho + 2] = __builtin_amdgcn_exp2f((l0[4 * rho + 2] + z0[4 * rho + 2]) + (g + x3));
            z0[4 * rho + 3] = __builtin_amdgcn_exp2f((l0[4 * rho + 3] + z0[4 * rho + 3]) + g);
          }
          {
            const float x3 = l1[4 * rho + 3], x23 = x3 + l1[4 * rho + 2], x123 = x23 + l1[4 * rho + 1];
            const float g = ag[4 + rho];
            z1[4 * rho + 0] = __builtin_amdgcn_exp2f((l1[4 * rho + 0] + z1[4 * rho + 0]) + (g + x123));
            z1[4 * rho + 1] = __builtin_amdgcn_exp2f((l1[4 * rho + 1] + z1[4 * rho + 1]) + (g + x23));
            z1[4 * rho + 2] = __builtin_amdgcn_exp2f((l1[4 * rho + 2] + z1[4 * rho + 2]) + (g + x3));
            z1[4 * rho + 3] = __builtin_amdgcn_exp2f((l1[4 * rho + 3] + z1[4 * rho + 3]) + g);
          }
        }
        kv_load(kv, kb + (size_t)jn * 64 * 128, 128, vb + jn * 64, SEQ);
        pv_tile(o, lv, z0, z1);
        if (__all(carry < -104.f * LOG2E) && (opq(threadIdx.x) & 63) == 0) dflag[wv] = 1u;
      }
    }
    int t2 = t;
    asm volatile("" : "+v"(t2));
    bf16_t* orow = p.omix + (size_t)(b * SEQ + t2) * DM + 1024 + hd * 128;
    oacc_foreach(o, [&](int d, float v0, float v1, float v2, float v3) {
      uint2 u;
      u.x = pack2(v0, v1);
      u.y = pack2(v2, v3);
      *(uint2*)(orow + d) = u;
    });
  }
}

#define NSA_IMP 32768
#define NSA_KEYS 49152
#define NSA_SELM 53504
#define NSA_LUT 53632
__device__ __forceinline__ void ph_nsa2(const P& p, char* lds) {
  typedef __attribute__((ext_vector_type(4))) float f32x4;
  char* lk = lds;
  char* lv = lds + 16384;
  float* imp = (float*)(lds + NSA_IMP);
  float* keys = (float*)(lds + NSA_KEYS);
  unsigned* selm = (unsigned*)(lds + NSA_SELM);
  const int tid = opq(threadIdx.x), lane = tid & 63, wv = tid >> 6, hh = lane >> 5, ql = lane & 31;
  float* lut = (float*)(lds + NSA_LUT) + wv * 128;
  for (int item = blockIdx.x; item < NBATCH * 2 * (SEQ / 32); item += gridDim.x) {
    const int tt = (item < 256) ? (SEQ / 32 - 1) - (item % (SEQ / 32)) : (item % (SEQ / 32));
    const int bg = item / (SEQ / 32);
    const int b = bg >> 1, g = bg & 1;
    const int h = g * 4 + wv;
    const int t0 = tt * 32, tq = t0 + ql, cur = t0 >> 6;
    __syncthreads();
    QFrag q;
    q_load(q, p.qn + (size_t)(b * SEQ + tq) * 1024 + h * 128);
    {
      const int lo = opq(lane);
      lut[lo] = p.t5[t5_bucket(lo) * 8 + h] * LOG2E;
      lut[lo + 64] = p.t5[t5_bucket(lo + 64) * 8 + h] * LOG2E;
    }
#pragma unroll
    for (int i = 0; i < 16; ++i) imp[i * 256 + tid] = 0.f;
    if (tid < 32) selm[tid] = 0u;
    const float* grow = p.gates + (size_t)(b * SEQ + tq) * 24 + h * 3;
    float* prow = p.part + (size_t)(b * SEQ + tq) * 1024 + h * 128;
    OAcc o;
    float m, l;
    KVRegs kv;
    {
      const bf16_t* kb = p.kcb + (size_t)bg * 128 * 128;
      const bf16_t* vb = p.vcT + (size_t)bg * 128 * 128;
      oacc_zero(o);
      m = NEG_BIG; l = 0.f;
      kv_load(kv, kb, 128, vb, 128);
      __syncthreads();
      kv_store(kv, lk, lv);
      __syncthreads();
      f32x16 x0, x1;
      qk_tile(q, lk, x0, x1);
      int tqv = tq;
      asm volatile("" : "+v"(tqv));
      tqv -= 64 * hh;
      if (t0 >= 1152) {
        const float b31 = lut[127];
#pragma unroll
        for (int r = 0; r < 16; ++r) { x0[r] = x0[r] * ATT_SCALE2 + b31; x1[r] = x1[r] * ATT_SCALE2 + b31; }
      } else {
#pragma unroll
        for (int r = 0; r < 16; ++r) {
          const int c = 8 * (r >> 2) + (r & 3);
          const int d0 = tqv - 16 * c - 31, d1 = d0 - 512;
          x0[r] = (d0 >= 0) ? x0[r] * ATT_SCALE2 + lut[min(d0, 127)] : -INFINITY;
          x1[r] = (d1 >= 0) ? x1[r] * ATT_SCALE2 + lut[min(d1, 127)] : -INFINITY;
        }
      }
      softmax_tile(x0, x1, m, l, o);
      const float m0 = m;
      pv_tile(o, lv, x0, x1);
      f32x16 z0, z1;
#pragma unroll
      for (int r = 0; r < 16; ++r) { z0[r] = 0.f; z1[r] = 0.f; }
      if (t0 >= 1024) {
        kv_load(kv, kb + 64 * 128, 128, vb + 64, 128);
        __syncthreads();
        kv_store(kv, lk, lv);
        __syncthreads();
        qk_tile(q, lk, z0, z1);
        asm volatile("" : "+v"(tqv));
#pragma unroll
        for (int r = 0; r < 16; ++r) {
          const int c = 64 + 8 * (r >> 2) + (r & 3);
          const int d0 = tqv - 16 * c - 31, d1 = d0 - 512;
          z0[r] = (d0 >= 0) ? z0[r] * ATT_SCALE2 + lut[min(d0, 127)] : -INFINITY;
          z1[r] = (d1 >= 0) ? z1[r] * ATT_SCALE2 + lut[min(d1, 127)] : -INFINITY;
        }
        softmax_tile(z0, z1, m, l, o);
        pv_tile(o, lv, z0, z1);
      }
      const float inv = 1.f / fmaxf(l, 1e-20f);
      const float c0 = __builtin_amdgcn_exp2f(m0 - m) * inv;
#pragma unroll
      for (int r = 0; r < 16; ++r) {
        const int c = 8 * (r >> 2) + (r & 3) + 4 * hh;
        if (x0[r] != 0.f) atomicAdd(&imp[(c) * 32 + ql], x0[r] * c0);
        if (x1[r] != 0.f) atomicAdd(&imp[(c + 32) * 32 + ql], x1[r] * c0);
        if (z0[r] != 0.f) atomicAdd(&imp[(c + 64) * 32 + ql], z0[r] * inv);
        if (z1[r] != 0.f) atomicAdd(&imp[(c + 96) * 32 + ql], z1[r] * inv);
      }
      const float gs = inv / (1.f + __expf(-grow[0]));
      oacc_foreach(o, [&](int d, float v0, float v1, float v2, float v3) {
        f32x4 u = {v0 * gs, v1 * gs, v2 * gs, v3 * gs};
        *(f32x4*)(prow + d) = u;
      });
    }
    __syncthreads();
    {
      const int tido = opq(tid);
      const int qq = tido & 31, jg = tido >> 5;
#pragma unroll
      for (int jj = 0; jj < 4; ++jj) {
        const int j = jg * 4 + jj;
        float v = imp[(4 * j) * 32 + qq] + imp[(4 * j + 1) * 32 + qq] + imp[(4 * j + 2) * 32 + qq] + 0.5f * imp[(4 * j + 3) * 32 + qq];
        if (j > 0) v += 0.5f * imp[(4 * j - 1) * 32 + qq];
        const bool forced = (j == 0) || (j == cur) || (j == cur - 1);
        keys[qq * 33 + j] = forced ? 1e9f : ((j <= cur) ? v : -1e9f);
      }
      __syncthreads();
      unsigned bits = 0u;
#pragma unroll
      for (int jj = 0; jj < 4; ++jj) {
        const int j = jg * 4 + jj;
        const float kj = keys[qq * 33 + j];
        int rank = 0;
        for (int i = 0; i < 32; ++i) {
          const float ki = keys[qq * 33 + i];
          rank += (ki > kj || (ki == kj && i < j)) ? 1 : 0;
        }
        if (rank < 16 && j <= cur) bits |= 1u << j;
      }
      atomicOr(&selm[qq], bits);
      __syncthreads();
    }
    const unsigned mysel = selm[ql];
    unsigned um = mysel;
#pragma unroll
    for (int o2 = 16; o2 > 0; o2 >>= 1) um |= (unsigned)__shfl_xor((int)um, o2);
    um = (unsigned)__builtin_amdgcn_readfirstlane((int)um);
    {
      const bf16_t* kb = p.ks + (size_t)bg * SEQ * 128;
      const bf16_t* vb = p.vsT + (size_t)bg * 128 * SEQ;
      oacc_zero(o);
      m = NEG_BIG; l = 0.f;
      unsigned rem = um;
      int j = __builtin_ctz(rem);
      kv_load(kv, kb + (size_t)j * 64 * 128, 128, vb + j * 64, SEQ);
      while (rem) {
        j = __builtin_ctz(rem);
        rem &= rem - 1;
        const int jn = rem ? __builtin_ctz(rem) : j;
        __syncthreads();
        kv_store(kv, lk, lv);
        __syncthreads();
        f32x16 s0, s1;
        qk_tile(q, lk, s0, s1);
        const bool selq = (mysel >> j) & 1u;
        int tqv = tq;
        asm volatile("" : "+v"(tqv));
        if (j * 64 + 63 + 113 <= t0) {
          const float sc = selq ? ATT_SCALE2 : 0.f, bb = selq ? lut[127] : -INFINITY;
#pragma unroll
          for (int r = 0; r < 16; ++r) { s0[r] = s0[r] * sc + bb; s1[r] = s1[r] * sc + bb; }
        } else {
#pragma unroll
          for (int r = 0; r < 16; ++r) {
            const int d0 = tqv - (j * 64 + 8 * (r >> 2) + (r & 3) + 4 * hh), d1 = d0 - 32;
            s0[r] = (selq && d0 >= 0) ? s0[r] * ATT_SCALE2 + lut[min(d0, 127)] : -INFINITY;
            s1[r] = (selq && d1 >= 0) ? s1[r] * ATT_SCALE2 + lut[min(d1, 127)] : -INFINITY;
          }
        }
        kv_load(kv, kb + (size_t)jn * 64 * 128, 128, vb + jn * 64, SEQ);
        softmax_tile(s0, s1, m, l, o);
        pv_tile(o, lv, s0, s1);
      }
      const float gs = 1.f / (fmaxf(l, 1e-20f) * (1.f + __expf(-grow[1])));
      int qo = ql;
      asm volatile("" : "+v"(qo));
      float* pr2 = p.part + (size_t)(b * SEQ + t0 + qo) * 1024 + h * 128;
      oacc_foreach(o, [&](int d, float v0, float v1, float v2, float v3) {
        f32x4 u = *(f32x4*)(pr2 + d);
        u[0] += v0 * gs; u[1] += v1 * gs; u[2] += v2 * gs; u[3] += v3 * gs;
        *(f32x4*)(pr2 + d) = u;
      });
    }
    {
      const bf16_t* kb = p.kw + (size_t)bg * SEQ * 128;
      const bf16_t* vb = p.vwT + (size_t)bg * 128 * SEQ;
      oacc_zero(o);
      m = NEG_BIG; l = 0.f;
      int jlo = (t0 - 511) >> 6;
      if (jlo < 0) jlo = 0;
      kv_load(kv, kb + (size_t)jlo * 64 * 128, 128, vb + jlo * 64, SEQ);
      for (int j = jlo; j <= cur; ++j) {
        const int jn = (j < cur) ? j + 1 : j;
        __syncthreads();
        kv_store(kv, lk, lv);
        __syncthreads();
        f32x16 s0, s1;
        qk_tile(q, lk, s0, s1);
        int tqv = tq;
        asm volatile("" : "+v"(tqv));
        if (j * 64 + 63 + 113 <= t0 && t0 + 31 - j * 64 < 512) {
          const float b31 = lut[127];
#pragma unroll
          for (int r = 0; r < 16; ++r) { s0[r] = s0[r] * ATT_SCALE2 + b31; s1[r] = s1[r] * ATT_SCALE2 + b31; }
        } else {
#pragma unroll
          for (int r = 0; r < 16; ++r) {
            const int d0 = tqv - (j * 64 + 8 * (r >> 2) + (r & 3) + 4 * hh), d1 = d0 - 32;
            s0[r] = (d0 >= 0 && d0 < 512) ? s0[r] * ATT_SCALE2 + lut[min(d0, 127)] : -INFINITY;
            s1[r] = (d1 >= 0 && d1 < 512) ? s1[r] * ATT_SCALE2 + lut[min(d1, 127)] : -INFINITY;
          }
        }
        kv_load(kv, kb + (size_t)jn * 64 * 128, 128, vb + jn * 64, SEQ);
        softmax_tile(s0, s1, m, l, o);
        pv_tile(o, lv, s0, s1);
      }
      const float gs = 1.f / (fmaxf(l, 1e-20f) * (1.f + __expf(-grow[2])));
      int qo = ql;
      asm volatile("" : "+v"(qo));
      const float* pr2 = p.part + (size_t)(b * SEQ + t0 + qo) * 1024 + h * 128;
      bf16_t* orow = p.omix + (size_t)(b * SEQ + t0 + qo) * DM + h * 128;
      oacc_foreach(o, [&](int d, float v0, float v1, float v2, float v3) {
        const f32x4 u = *(const f32x4*)(pr2 + d);
        uint2 w;
        w.x = pack2(u[0] + v0 * gs, u[1] + v1 * gs);
        w.y = pack2(u[2] + v2 * gs, u[3] + v3 * gs);
        *(uint2*)(orow + d) = w;
      });
    }
  }
}

__device__ __forceinline__ void ph_cvt(const float* src, bf16_t* dst, size_t n) {
  typedef __attribute__((ext_vector_type(4))) float f32x4;
  const size_t nv = n / 8;
  for (size_t i = (size_t)blockIdx.x * 256 + opq(threadIdx.x); i < nv; i += (size_t)gridDim.x * 256) {
    const f32x4 a = ((const f32x4*)src)[2 * i], b = ((const f32x4*)src)[2 * i + 1];
    u32x4 o;
    o[0] = pack2(a[0], a[1]); o[1] = pack2(a[2], a[3]); o[2] = pack2(b[0], b[1]); o[3] = pack2(b[2], b[3]);
    ((u32x4*)dst)[i] = o;
  }
}

__device__ __forceinline__ void ph_scores(const P& p, char* lds) {
  for (int u = blockIdx.x; u < 64 * 16; u += gridDim.x) {
    const int tm = u & 63, hp = u >> 6;
    const int m0 = tm * 128;
    float* sc = p.scores + (size_t)m0 * DM + hp * 128;
    gemm_tile_bf16<false>(p.omix + (size_t)m0 * DM + hp * 128, DM, p.subkb + (size_t)hp * 128 * 128, 128, 128, lds,
                          [&](int r, int c, float val) { sc[(size_t)r * DM + c] = val; });
  }
}

__device__ __forceinline__ void ph_qp_scores(const P& p, char* lds) {
  const int ntm = T_TOK / 256, ntn = DM / 128;
  const int npm = (ntm + 7) / 8, npn = (ntn + 7) / 8;
  const int nslots = ((npm * npn * 64 + 511) / 512) * 512;
  for (int u = blockIdx.x; u < nslots; u += gridDim.x) {
    int v = (u & 7) * 64 + ((u >> 3) & 63) + (u & ~511);
    int patch = v >> 6, w = v & 63;
    int tm = (patch % npm) * 8 + (w & 7);
    int tn = (patch / npm) * 8 + (w >> 3);
    if (tm >= ntm || tn >= ntn) continue;
    const int m0 = tm * 256, n0 = tn * 128;
    bf16_t* qp = p.omix + (size_t)m0 * DM + n0;
    const float* rss = p.rowss + T_TOK + m0;
    gemm_tile_big(p.hn + (size_t)m0 * DM, DM, p.WpqT + (size_t)n0 * DM, DM, DM, lds,
                  [&](int r, int c, f32x4_e lo, f32x4_e hi) {
                    const float rs = rsqrtf(rss[r] * (1.f / DM) + RMS_EPS);
                    st_bf16x8(qp + (size_t)r * DM + c, lo * rs, hi * rs); });
    __threadfence_block();
    __syncthreads();
    float* sc = p.scores + (size_t)m0 * DM + n0;
    gemm_tile_big(qp, DM, p.subkb + (size_t)tn * 128 * 128, 128, 128, lds,
                  [&](int r, int c, f32x4_e lo, f32x4_e hi) {
                    *(f32x4_e*)(sc + (size_t)r * DM + c) = lo; *(f32x4_e*)(sc + (size_t)r * DM + c + 4) = hi; });
  }
}

__device__ __forceinline__ void ph_cvt4(const float* src, unsigned char* dst, float* scales, int nrows, int wid0, int nw) {
  typedef __attribute__((ext_vector_type(4))) float f32x4;
  typedef __attribute__((ext_vector_type(2))) float f32x2;
  const int lane = opq(threadIdx.x) & 63;
  const float one = __uint_as_float((unsigned)opq(0x3F800000));
  float lev[8];
#pragma unroll
  for (int c = 0; c < 8; ++c) {
    const f32x2 q = __builtin_amdgcn_cvt_scalef32_pk_f32_fp4((unsigned)opq(c * 0x11111111), one, 0);
    lev[c] = fabsf(q[0]);
  }
  const float maxlev = lev[7];
  for (int row = wid0; row < nrows; row += nw) {
    const f32x4* s4 = (const f32x4*)(src + (size_t)row * DM) + lane * 8;
    f32x4 v[8];
    float amax = 0.f;
#pragma unroll
    for (int i = 0; i < 8; ++i) {
      v[i] = s4[i];
#pragma unroll
      for (int k = 0; k < 4; ++k) amax = fmaxf(amax, fabsf(v[i][k]));
    }
    amax = wave_max(amax);
    const float sc = (amax > 0.f) ? maxlev / amax : 1.f;
    u32x4 o;
#pragma unroll
    for (int w = 0; w < 4; ++w) {
      unsigned pk = 0u;
      pk = __builtin_amdgcn_cvt_scalef32_pk_fp4_f32(pk, v[2 * w][0] * sc, v[2 * w][1] * sc, 1.0f, 0);
      pk = __builtin_amdgcn_cvt_scalef32_pk_fp4_f32(pk, v[2 * w][2] * sc, v[2 * w][3] * sc, 1.0f, 1);
      pk = __builtin_amdgcn_cvt_scalef32_pk_fp4_f32(pk, v[2 * w + 1][0] * sc, v[2 * w + 1][1] * sc, 1.0f, 2);
      pk = __builtin_amdgcn_cvt_scalef32_pk_fp4_f32(pk, v[2 * w + 1][2] * sc, v[2 * w + 1][3] * sc, 1.0f, 3);
      o[w] = pk;
    }
    *(u32x4*)(dst + (size_t)row * 1024 + lane * 16) = o;
    if (lane == 0) scales[row] = (amax > 0.f) ? amax / maxlev : 1.f;
  }
}

__device__ __forceinline__ u32x4 r4_load(const unsigned char* tab, int eid, int lane) {
  return *((const u32x4*)(tab + (size_t)eid * 1024) + lane);
}
struct XPk { f32x16 a, b; };
struct Acc32 { f32x16 a, b; };

#define R4_DOT_W(word, xv, base, pa, pb)                                                             \
  {                                                                                                  \
    typedef __attribute__((ext_vector_type(2))) float f32x2;                                         \
    const f32x2 q0 = __builtin_amdgcn_cvt_scalef32_pk_f32_fp4(word, one, 0), q1 = __builtin_amdgcn_cvt_scalef32_pk_f32_fp4(word, one, 1); \
    const f32x2 q2 = __builtin_amdgcn_cvt_scalef32_pk_f32_fp4(word, one, 2), q3 = __builtin_amdgcn_cvt_scalef32_pk_f32_fp4(word, one, 3); \
    pa += q0[0] * xv[base + 0] + q0[1] * xv[base + 1]; pb += q1[0] * xv[base + 2] + q1[1] * xv[base + 3]; \
    pa += q2[0] * xv[base + 4] + q2[1] * xv[base + 5]; pb += q3[0] * xv[base + 6] + q3[1] * xv[base + 7]; \
  }
__device__ __forceinline__ float r4_dot(const u32x4& e, const XPk& x) {
  const float one = __uint_as_float((unsigned)opq(0x3F800000));
  float pa = 0.f, pb = 0.f;
  R4_DOT_W(e[0], x.a, 0, pa, pb) R4_DOT_W(e[1], x.a, 8, pa, pb) R4_DOT_W(e[2], x.b, 0, pa, pb) R4_DOT_W(e[3], x.b, 8, pa, pb)
  return pa + pb;
}
#define R4_AXPY_W(word, accv, base)                                                                  \
  {                                                                                                  \
    typedef __attribute__((ext_vector_type(2))) float f32x2;                                         \
    const f32x2 q0 = __builtin_amdgcn_cvt_scalef32_pk_f32_fp4(word, one, 0), q1 = __builtin_amdgcn_cvt_scalef32_pk_f32_fp4(word, one, 1); \
    const f32x2 q2 = __builtin_amdgcn_cvt_scalef32_pk_f32_fp4(word, one, 2), q3 = __builtin_amdgcn_cvt_scalef32_pk_f32_fp4(word, one, 3); \
    accv[base + 0] += hid * q0[0]; accv[base + 1] += hid * q0[1]; accv[base + 2] += hid * q1[0]; accv[base + 3] += hid * q1[1]; \
    accv[base + 4] += hid * q2[0]; accv[base + 5] += hid * q2[1]; accv[base + 6] += hid * q3[0]; accv[base + 7] += hid * q3[1]; \
  }
__device__ __forceinline__ void r4_axpy(const u32x4& e, float hid, Acc32& acc) {
  const float one = __uint_as_float((unsigned)opq(0x3F800000));
  R4_AXPY_W(e[0], acc.a, 0) R4_AXPY_W(e[1], acc.a, 8) R4_AXPY_W(e[2], acc.b, 0) R4_AXPY_W(e[3], acc.b, 8)
}

#define INS16(K, x)                                                                                      \
  K##15 = __builtin_amdgcn_fmed3f(K##15, K##14, x); K##14 = __builtin_amdgcn_fmed3f(K##14, K##13, x);   \
  K##13 = __builtin_amdgcn_fmed3f(K##13, K##12, x); K##12 = __builtin_amdgcn_fmed3f(K##12, K##11, x);   \
  K##11 = __builtin_amdgcn_fmed3f(K##11, K##10, x); K##10 = __builtin_amdgcn_fmed3f(K##10, K##9, x);    \
  K##9 = __builtin_amdgcn_fmed3f(K##9, K##8, x); K##8 = __builtin_amdgcn_fmed3f(K##8, K##7, x);         \
  K##7 = __builtin_amdgcn_fmed3f(K##7, K##6, x); K##6 = __builtin_amdgcn_fmed3f(K##6, K##5, x);         \
  K##5 = __builtin_amdgcn_fmed3f(K##5, K##4, x); K##4 = __builtin_amdgcn_fmed3f(K##4, K##3, x);         \
  K##3 = __builtin_amdgcn_fmed3f(K##3, K##2, x); K##2 = __builtin_amdgcn_fmed3f(K##2, K##1, x);         \
  K##1 = __builtin_amdgcn_fmed3f(K##1, K##0, x); K##0 = fmaxf(K##0, x);
#define DECL16(K) float K##0 = -INFINITY, K##1 = -INFINITY, K##2 = -INFINITY, K##3 = -INFINITY, K##4 = -INFINITY, \
  K##5 = -INFINITY, K##6 = -INFINITY, K##7 = -INFINITY, K##8 = -INFINITY, K##9 = -INFINITY, K##10 = -INFINITY,   \
  K##11 = -INFINITY, K##12 = -INFINITY, K##13 = -INFINITY, K##14 = -INFINITY, K##15 = -INFINITY;
__device__ __forceinline__ float mkkey(float v, unsigned tag, unsigned mask) {
  return __uint_as_float((__float_as_uint(v) & ~mask) | tag);
}

__device__ __forceinline__ void ph_peer(const P& p, float* smem) {
  typedef __attribute__((ext_vector_type(4))) float f32x4;
  float* lists = smem;
  int* bexA = (int*)(smem + 4096);
  float* bgtA = smem + 6144;
  float* bsuA = smem + 8192;
  for (int item = blockIdx.x; item < T_TOK / 16; item += gridDim.x) {
    const int t0 = item * 16;
    __syncthreads();
    {
      const int tid = opq(threadIdx.x);
      const int tl = tid >> 4, hp = tid & 15;
      const f32x4* sp = (const f32x4*)(p.scores + (size_t)(t0 + tl) * DM + hp * 128);
      DECL16(k)
#pragma unroll 4
      for (int c4 = 0; c4 < 32; ++c4) {
        const f32x4 v = sp[c4];
#pragma unroll
        for (int e = 0; e < 4; ++e) {
          const float x = mkkey(v[e], 127u - (unsigned)(c4 * 4 + e), 127u);
          INS16(k, x)
        }
      }
      f32x4* lp = (f32x4*)(lists + (size_t)opq(threadIdx.x) * 16);
      f32x4 o0 = {k0, k1, k2, k3}, o1 = {k4, k5, k6, k7}, o2 = {k8, k9, k10, k11}, o3 = {k12, k13, k14, k15};
      lp[0] = o0; lp[1] = o1; lp[2] = o2; lp[3] = o3;
    }
    __syncthreads();
    if (opq(threadIdx.x) < 128) {
      const int tid = opq(threadIdx.x);
      const int tl = tid >> 3, h = tid & 7;
      const float* la = lists + (size_t)(tl * 16 + 2 * h) * 16;
      const float* lb = la + 16;
      float av[16], bv[16];
#pragma unroll
      for (int i = 0; i < 16; ++i) {
        av[i] = __uint_as_float(__float_as_uint(la[i]) & ~127u);
        bv[i] = __uint_as_float(__float_as_uint(lb[i]) & ~127u);
      }
      DECL16(c)
#pragma unroll
      for (int i = 0; i < 16; ++i) {
#pragma unroll
        for (int j = 0; j < 16; ++j) {
          if ((i + 1) * (j + 1) <= 16) {
            const float x = mkkey(av[i] + bv[j], 255u - (unsigned)(i * 16 + j), 255u);
            INS16(c, x)
          }
        }
      }
      float cs[16] = {c0, c1, c2, c3, c4, c5, c6, c7, c8, c9, c10, c11, c12, c13, c14, c15};
      float ev[16];
      float sum = 0.f;
      const float mx = __uint_as_float(__float_as_uint(cs[0]) & ~255u);
#pragma unroll
      for (int n = 0; n < 16; ++n) {
        ev[n] = __expf(__uint_as_float(__float_as_uint(cs[n]) & ~255u) - mx);
        sum += ev[n];
      }
      const float isum = 1.f / sum;
#pragma unroll
      for (int n = 0; n < 16; ++n) {
        const unsigned cc = 255u - (__float_as_uint(cs[n]) & 255u);
        const unsigned ka = 127u - (__float_as_uint(la[cc >> 4]) & 127u);
        const unsigned kb = 127u - (__float_as_uint(lb[cc & 15u]) & 127u);
        const int eid = (int)(ka * 128u + kb);
        bexA[tl * 128 + h * 16 + n] = eid;
        bgtA[tl * 128 + h * 16 + n] = ev[n] * isum * p.sv8[eid];
        bsuA[tl * 128 + h * 16 + n] = p.su8[eid];
      }
    }
    __syncthreads();
#pragma unroll 1
    for (int ti4 = 0; ti4 < 4; ++ti4) {
    const int lane = opq(threadIdx.x) & 63, wv = opq(threadIdx.x) >> 6;
    const int tl = wv * 4 + ti4;
    const int t = t0 + tl;
    const int* bex = bexA + tl * 128;
    const float* bgt = bgtA + tl * 128;
    const float* bsu = bsuA + tl * 128;
    XPk x;
    {
      const f32x4* s4 = (const f32x4*)(p.out + (size_t)t * DM) + lane * 8;
      const f32x4* g4 = (const f32x4*)p.norm_ffn + lane * 8;
      f32x4 a0 = s4[0], a1 = s4[1], a2 = s4[2], a3 = s4[3], a4 = s4[4], a5 = s4[5], a6 = s4[6], a7 = s4[7];
      float ss = 0.f;
#define SSQ(v) ss += v[0] * v[0] + v[1] * v[1] + v[2] * v[2] + v[3] * v[3];
      SSQ(a0) SSQ(a1) SSQ(a2) SSQ(a3) SSQ(a4) SSQ(a5) SSQ(a6) SSQ(a7)
#undef SSQ
      ss = wave_sum(ss);
      const float rs = rsqrtf(ss * (1.f / DM) + RMS_EPS);
#define XPK(dst, base, va, vb, gi)                                                    \
  {                                                                                   \
    const f32x4 ga = g4[gi], gb = g4[gi + 1];                                         \
    dst[base + 0] = bf2f(f2bf(va[0] * rs * ga[0])); dst[base + 1] = bf2f(f2bf(va[1] * rs * ga[1]));   \
    dst[base + 2] = bf2f(f2bf(va[2] * rs * ga[2])); dst[base + 3] = bf2f(f2bf(va[3] * rs * ga[3]));   \
    dst[base + 4] = bf2f(f2bf(vb[0] * rs * gb[0])); dst[base + 5] = bf2f(f2bf(vb[1] * rs * gb[1]));   \
    dst[base + 6] = bf2f(f2bf(vb[2] * rs * gb[2])); dst[base + 7] = bf2f(f2bf(vb[3] * rs * gb[3]));   \
  }
      XPK(x.a, 0, a0, a1, 0) XPK(x.a, 8, a2, a3, 2) XPK(x.b, 0, a4, a5, 4) XPK(x.b, 8, a6, a7, 6)
#undef XPK
    }
    Acc32 acc;
#pragma unroll
    for (int r = 0; r < 16; ++r) { acc.a[r] = 0.f; acc.b[r] = 0.f; }
    u32x4 u0 = r4_load(p.pu8, bex[0], lane), u1 = r4_load(p.pu8, bex[1], lane), u2 = r4_load(p.pu8, bex[2], lane), u3 = r4_load(p.pu8, bex[3], lane);
    u32x4 v0 = r4_load(p.pv8, bex[0], lane), v1 = r4_load(p.pv8, bex[1], lane), v2 = r4_load(p.pv8, bex[2], lane), v3 = r4_load(p.pv8, bex[3], lane);
#pragma unroll 1
    for (int e0 = 0; e0 < 128; e0 += 4) {
      float d0 = r4_dot(u0, x), d1 = r4_dot(u1, x), d2 = r4_dot(u2, x), d3 = r4_dot(u3, x);
      const int en = (e0 + 4 < 128) ? e0 + 4 : 124;
      const int i0 = bex[en], i1 = bex[en + 1], i2 = bex[en + 2], i3 = bex[en + 3];
      u0 = r4_load(p.pu8, i0, lane); u1 = r4_load(p.pu8, i1, lane); u2 = r4_load(p.pu8, i2, lane); u3 = r4_load(p.pu8, i3, lane);
#pragma unroll
      for (int o = 32; o > 0; o >>= 1) {
        d0 += __shfl_xor(d0, o); d1 += __shfl_xor(d1, o); d2 += __shfl_xor(d2, o); d3 += __shfl_xor(d3, o);
      }
      { const float hid = bgt[e0 + 0] * gelu_fast(d0 * bsu[e0 + 0]); r4_axpy(v0, hid, acc); }
      { const float hid = bgt[e0 + 1] * gelu_fast(d1 * bsu[e0 + 1]); r4_axpy(v1, hid, acc); }
      { const float hid = bgt[e0 + 2] * gelu_fast(d2 * bsu[e0 + 2]); r4_axpy(v2, hid, acc); }
      { const float hid = bgt[e0 + 3] * gelu_fast(d3 * bsu[e0 + 3]); r4_axpy(v3, hid, acc); }
      v0 = r4_load(p.pv8, i0, lane); v1 = r4_load(p.pv8, i1, lane); v2 = r4_load(p.pv8, i2, lane); v3 = r4_load(p.pv8, i3, lane);
    }
    const int lane2 = opq(lane);
    f32x4* o4 = (f32x4*)(p.out + (size_t)t * DM) + lane2 * 8;
    const f32x4* g4 = (const f32x4*)p.norm_final + lane2 * 8;
    f32x4 hv[8];
    float ss = 0.f;
#pragma unroll
    for (int i = 0; i < 8; ++i) {
      hv[i] = o4[i];
#pragma unroll
      for (int k = 0; k < 4; ++k) {
        hv[i][k] += (i < 4) ? acc.a[4 * i + k] : acc.b[4 * (i - 4) + k];
        ss += hv[i][k] * hv[i][k];
      }
    }
    ss = wave_sum(ss);
    const float rs = rsqrtf(ss * (1.f / DM) + RMS_EPS);
#pragma unroll
    for (int i = 0; i < 8; ++i) {
      const f32x4 g = g4[i];
      f32x4 o;
#pragma unroll
      for (int k = 0; k < 4; ++k) o[k] = hv[i][k] * rs * g[k];
      o4[i] = o;
    }
    }
  }
}

#define XB_TMO      128
#define XB_XCNT(j)  (256  + 64 * (j))
#define XB_XSUB(j)  (1280 + 64 * (j))
#define XB_XGEN(j)  (2304 + 64 * (j))
#define XB_TOP      3328
#define XB_TOPGEN   3392
#define XCD_BAR_WORDS 3456
#define XB_SPIN_CAP (1u << 22)
#define LAS __attribute__((address_space(3)))
__device__ __forceinline__ unsigned xb_ld(unsigned* p) { return __hip_atomic_load(p, __ATOMIC_RELAXED, __HIP_MEMORY_SCOPE_AGENT); }
__device__ __forceinline__ unsigned xb_add(unsigned* p, unsigned v) { return __hip_atomic_fetch_add(p, v, __ATOMIC_RELAXED, __HIP_MEMORY_SCOPE_AGENT); }
__device__ __forceinline__ unsigned xb_xcc_id() { return (unsigned)__builtin_amdgcn_s_getreg((3 << 11) | 20) & 0xFu; }
#define XB_SPIN(cond, bar) do { unsigned _sp = 0; while (cond) { __builtin_amdgcn_s_sleep(1); \
    if ((++_sp & 255u) == 0u) { if (xb_ld(&(bar)[XB_TMO])) break; if (_sp > XB_SPIN_CAP) { atomicAdd(&(bar)[XB_TMO], 1u); break; } } } } while (0)
struct XcdBarrier { unsigned* bar; unsigned x; volatile LAS unsigned* st; };
__device__ __forceinline__ XcdBarrier xcd_barrier_post(unsigned* bar, volatile LAS unsigned* st) {
  XcdBarrier b; b.bar = bar; b.x = xb_xcc_id(); b.st = st;
  if (threadIdx.x == 0) (void)xb_add(&bar[XB_XCNT(b.x)], 1u);
  return b;
}
__device__ __forceinline__ void xcd_barrier_complete(unsigned* bar, unsigned x, unsigned& nloc, unsigned& nx) {
  const unsigned G = gridDim.x * gridDim.y * gridDim.z;
  unsigned sum, cnt, mine, sp = 0u;
  for (;;) {
    sum = 0u; cnt = 0u; mine = 0u;
#pragma unroll
    for (unsigned j = 0; j < 16; ++j) { const unsigned c = xb_ld(&bar[XB_XCNT(j)]); sum += c; cnt += (c > 0u) ? 1u : 0u; mine = (j == x) ? c : mine; }
    if (sum == G) break;
    __builtin_amdgcn_s_sleep(1);
    if ((++sp & 255u) == 0u) { if (xb_ld(&bar[XB_TMO])) break; if (sp > XB_SPIN_CAP) { atomicAdd(&bar[XB_TMO], 1u); break; } }
  }
  nloc = mine > 0u ? mine : 1u; nx = cnt > 0u ? cnt : 1u;
}
__device__ __forceinline__ void xcd_barrier(const XcdBarrier& b) {
  asm volatile("s_waitcnt vmcnt(0)" ::: "memory");
  __syncthreads();
  if (threadIdx.x == 0) {
    unsigned* bar = b.bar;
    __builtin_amdgcn_s_waitcnt(0);
    unsigned nloc = b.st[0], nx = b.st[1];
    if (nloc == 0u) { xcd_barrier_complete(bar, b.x, nloc, nx); b.st[0] = nloc; b.st[1] = nx; }
    const unsigned old = xb_add(&bar[XB_XSUB(b.x)], 1u);
    const unsigned gen = old / nloc;
    if (old + 1u == (gen + 1u) * nloc) {
      __builtin_amdgcn_fence(__ATOMIC_RELEASE, "agent");
      asm volatile("s_waitcnt vmcnt(0)" ::: "memory");
      const unsigned og = xb_add(&bar[XB_TOP], 1u);
      const unsigned tg = og / nx;
      if (og + 1u == (tg + 1u) * nx) xb_add(&bar[XB_TOPGEN], 1u);
      else XB_SPIN(xb_ld(&bar[XB_TOPGEN]) == tg, bar);
      __builtin_amdgcn_fence(__ATOMIC_ACQUIRE, "agent");
      xb_add(&bar[XB_XGEN(b.x)], 1u);
      asm volatile("s_waitcnt vmcnt(0)" ::: "memory");
    } else {
      XB_SPIN(xb_ld(&bar[XB_XGEN(b.x)]) == gen, bar);
      __builtin_amdgcn_fence(__ATOMIC_ACQUIRE, "agent");
      asm volatile("s_waitcnt vmcnt(0)" ::: "memory");
    }
  }
  __syncthreads();
}

typedef const __attribute__((address_space(4))) P* KP;
__device__ __forceinline__ P loadP() {
#if defined(__HIP_DEVICE_COMPILE__)
  KP k = (KP)__builtin_amdgcn_kernarg_segment_ptr();
  asm volatile("" : "+s"(k));
  P p = *k;
  return p;
#else
  return P{};
#endif
}

__global__ void __launch_bounds__(256, 2) mega(P p_arg) {
  cg::grid_group grid = cg::this_grid();
  __shared__ __attribute__((aligned(16))) float smem[16384];
  char* lds = (char*)smem;
  __shared__ uint4 xb_words;
  if (threadIdx.x == 0) xb_words = make_uint4(0u, 0u, 0u, 0u);
  if (blockIdx.x == 0) {
    P p = loadP();
    for (int i = threadIdx.x; i < XCD_BAR_WORDS; i += 256) p.bar[i] = 0u;
  }
  { P p = loadP(); ph_rmsnorm(p.x, p.norm_mix, p.hn, T_TOK); ph_rmsnorm(p.mem, p.norm_mkv, p.memn, 1024); }
  { P p = loadP(); ph_transpose<true>(smem, p.w_in, DM, INC, 5760, p.WinT); }
  { P p = loadP(); ph_transpose<false>(smem, p.w_mk, DM, 512, 512, p.WmkT); }
  { P p = loadP(); ph_transpose<false>(smem, p.w_mv, DM, 512, 512, p.WmvT); }
  { P p = loadP(); ph_cvt(p.subk, p.subkb, (size_t)16 * 128 * 128); }
  { P p = loadP(); ph_transpose<false>(smem, p.w1_k, 4096, 128, 128, p.w1T); }
  { P p = loadP(); ph_transpose<false>(smem, p.w1_v, 4096, 128, 128, p.w1T + 128 * 4096); }
  { P p = loadP(); ph_transpose<false>(smem, p.w2_k, 128, 128, 128, p.w2T); }
  { P p = loadP(); ph_transpose<false>(smem, p.w2_v, 128, 128, 128, p.w2T + 128 * 128); }
  { P p = loadP(); ph_posb(p); }
  { P p = loadP(); for (int i = blockIdx.x * 256 + opq(threadIdx.x); i < 2 * T_TOK; i += gridDim.x * 256) p.rowss[i] = 0.f; }
  grid.sync();
  XcdBarrier xb;
  { P p = loadP(); xb = xcd_barrier_post(p.bar, (volatile LAS unsigned*)&xb_words); }
  { P p = loadP(); ph_proj(p, lds); }
  const int kvb = (gridDim.x == 512) ? (((int)blockIdx.x >= 320 && (int)blockIdx.x < 352) ? ((int)blockIdx.x - 320) * 8 : -1) : -2;
  const int vvb = (gridDim.x == 512) ? (((int)blockIdx.x >= 352 && (int)blockIdx.x < 384) ? ((int)blockIdx.x - 352) * 8 : -1) : -2;
  { P p = loadP(); bf16_t* kmem = p.kmemb;
    ph_gemm_bf16(p.memn, DM, p.WmkT, DM, 1024, 512, DM, lds, [=](int m, int n, float v) {
      kmem[((size_t)((m >> 8) * 4 + (n >> 7)) * 256 + (m & 255)) * 128 + (n & 127)] = f2bf(v); }, kvb); }
  { P p = loadP(); bf16_t* vmem = p.vmemT;
    ph_gemm_bf16(p.memn, DM, p.WmvT, DM, 1024, 512, DM, lds, [=](int m, int n, float v) {
      vmem[((size_t)((m >> 8) * 4 + (n >> 7)) * 128 + (n & 127)) * 256 + perm16(m & 255)] = f2bf(v); }, vvb); }
  xcd_barrier(xb);
  { P p = loadP(); ph_compress2(p, lds); }
  { P p = loadP(); ph_sb2(p, lds); }
  {
    const int skip = (gridDim.x > 32) ? 16 : 0;
    const int vb = ((int)blockIdx.x >= skip) ? (int)blockIdx.x - skip : -1, nvb = (int)gridDim.x - skip;
    __syncthreads();
    { P p = loadP(); ph_transpose<false>(smem, p.w_out, DM, DM, DM, p.WoutT, vb, nvb); }
    { P p = loadP(); ph_transpose<false>(smem, p.w_mq, DM, 512, 512, p.WmqT, vb, nvb); }
  }
  xcd_barrier(xb);
  { P p = loadP(); ph_nsa2(p, lds); }
  xcd_barrier(xb);
  { P p = loadP(); float* out = p.out; const float* x = p.x; const float* gmq = p.norm_mq; bf16_t* hn = p.hn; float* rss = p.rowss;
    ph_gemm_big(p.omix, DM, p.WoutT, DM, T_TOK, DM, DM, lds, [=](int m, int n, f32x4_e lo, f32x4_e hi) {
      const f32x4_e x0 = *(const f32x4_e*)(x + (size_t)m * DM + n), x1 = *(const f32x4_e*)(x + (size_t)m * DM + n + 4);
      const f32x4_e h0 = x0 + lo, h1 = x1 + hi;
      *(f32x4_e*)(out + (size_t)m * DM + n) = h0; *(f32x4_e*)(out + (size_t)m * DM + n + 4) = h1;
      norm_feed(h0, h1, gmq, n, hn + (size_t)m * DM, rss + m); }); }
  xcd_barrier(xb);
  {
    const int half = (gridDim.x >= 512) ? 256 : 0;
    if (half == 0 || (int)blockIdx.x < half) { P p = loadP(); ph_memq_attn(p, lds, (int)blockIdx.x, half ? half : (int)gridDim.x); }
    if ((int)blockIdx.x >= half) {
      const int nwv = ((int)gridDim.x - half) * 4, wid = ((int)blockIdx.x - half) * 4 + (opq(threadIdx.x) >> 6);
      __syncthreads();
      { P p = loadP(); ph_transpose<false>(smem, p.w_mo, 512, DM, DM, p.WmoT, (int)blockIdx.x - half, (int)gridDim.x - half); }
      { P p = loadP(); ph_cvt4(p.pu, p.pu8, p.su8, 16384, wid, nwv); }
      { P p = loadP(); ph_cvt4(p.pv, p.pv8, p.sv8, 16384, wid, nwv); }
      __syncthreads();
      { P p = loadP(); ph_transpose<false>(smem, p.w_pq, DM, DM, DM, p.WpqT, (int)blockIdx.x - half, (int)gridDim.x - half); }
    }
  }
  xcd_barrier(xb);
  { P p = loadP(); float* out = p.out; const float* gffn = p.norm_ffn; bf16_t* hn = p.hn; float* rss = p.rowss + T_TOK;
    ph_gemm_big(p.omem, 512, p.WmoT, 512, T_TOK, DM, 512, lds, [=](int m, int n, f32x4_e lo, f32x4_e hi) {
      f32x4_e* o0 = (f32x4_e*)(out + (size_t)m * DM + n);
      const f32x4_e h0 = o0[0] + lo, h1 = o0[1] + hi;
      o0[0] = h0; o0[1] = h1;
      norm_feed(h0, h1, gffn, n, hn + (size_t)m * DM, rss + m); }); }
  xcd_barrier(xb);
  { P p = loadP(); ph_qp_scores(p, lds); }
  xcd_barrier(xb);
  { P p = loadP(); ph_peer(p, smem); }
}

extern "C" void kernel_launch(void* const* d_in, const int* in_sizes, int n_in, void* d_out, int out_size, void* d_ws,
                              size_t ws_size, hipStream_t stream) {
  P p{};
  p.x = (const float*)d_in[0]; p.mem = (const float*)d_in[1]; p.t5 = (const float*)d_in[2];
  p.norm_mix = (const float*)d_in[3]; p.w_in = (const float*)d_in[4]; p.pos_k = (const float*)d_in[5];
  p.w1_k = (const float*)d_in[6]; p.w2_k = (const float*)d_in[7]; p.pos_v = (const float*)d_in[8];
  p.w1_v = (const float*)d_in[9]; p.w2_v = (const float*)d_in[10]; p.w_out = (const float*)d_in[11];
  p.norm_mq = (const float*)d_in[12]; p.norm_mkv = (const float*)d_in[13]; p.w_mq = (const float*)d_in[14];
  p.w_mk = (const float*)d_in[15]; p.w_mv = (const float*)d_in[16]; p.w_mo = (const float*)d_in[17];
  p.norm_ffn = (const float*)d_in[18]; p.w_pq = (const float*)d_in[19]; p.subk = (const float*)d_in[20];
  p.pu = (const float*)d_in[21]; p.pv = (const float*)d_in[22]; p.norm_final = (const float*)d_in[23];
  p.out = (float*)d_out;
  char* w = (char*)d_ws;
  size_t off = 0;
  auto take = [&](size_t bytes) { char* r = w + off; off += (bytes + 255) & ~(size_t)255; return r; };
  p.bar = (unsigned*)take(XCD_BAR_WORDS * 4);
  p.scores = (float*)take((size_t)T_TOK * DM * 4);
  p.gates = (float*)take((size_t)T_TOK * 24 * 4);
  p.part = (float*)take((size_t)T_TOK * 1024 * 4);
  p.posb = (float*)take(256 * 4);
  p.rowss = (float*)take((size_t)2 * T_TOK * 4);
  p.qn = (bf16_t*)take((size_t)T_TOK * 1024 * 2);
  p.kcin = (bf16_t*)take((size_t)T_TOK * 256 * 2 + 65536);
  p.vcin = (bf16_t*)take((size_t)T_TOK * 256 * 2 + 65536);
  p.ks = (bf16_t*)take((size_t)T_TOK * 256 * 2);
  p.vsT = (bf16_t*)take((size_t)T_TOK * 256 * 2);
  p.kw = (bf16_t*)take((size_t)T_TOK * 256 * 2);
  p.vwT = (bf16_t*)take((size_t)T_TOK * 256 * 2);
  p.kcb = (bf16_t*)take((size_t)8 * 128 * 128 * 2);
  p.vcT = (bf16_t*)take((size_t)8 * 128 * 128 * 2);
  p.c1 = (bf16_t*)take((size_t)16 * 128 * 128 * 2);
  p.w1T = (bf16_t*)take((size_t)2 * 128 * 4096 * 2);
  p.w2T = (bf16_t*)take((size_t)2 * 128 * 128 * 2);
  p.hn = (bf16_t*)take((size_t)T_TOK * DM * 2);
  p.omix = (bf16_t*)take((size_t)T_TOK * DM * 2);
  p.memn = (bf16_t*)take((size_t)1024 * DM * 2);
  p.omem = (bf16_t*)take((size_t)T_TOK * 512 * 2);
  p.WinT = (bf16_t*)take((size_t)5760 * DM * 2);
  p.WoutT = (bf16_t*)take((size_t)DM * DM * 2);
  p.WpqT = (bf16_t*)take((size_t)DM * DM * 2);
  p.WmqT = (bf16_t*)take((size_t)512 * DM * 2);
  p.WmkT = (bf16_t*)take((size_t)512 * DM * 2);
  p.WmvT = (bf16_t*)take((size_t)512 * DM * 2);
  p.WmoT = (bf16_t*)take((size_t)DM * 512 * 2);
  p.qmemb = (bf16_t*)take((size_t)T_TOK * 512 * 2);
  p.kmemb = (bf16_t*)take((size_t)1024 * 512 * 2);
  p.vmemT = (bf16_t*)take((size_t)1024 * 512 * 2);
  p.qsb = (bf16_t*)take((size_t)T_TOK * 1024 * 2);
  p.ksb = (bf16_t*)take((size_t)T_TOK * 1024 * 2);
  p.vsbT = (bf16_t*)take((size_t)T_TOK * 1024 * 2);
  p.pu8 = (unsigned char*)take((size_t)16384 * 1024);
  p.pv8 = (unsigned char*)take((size_t)16384 * 1024);
  p.su8 = (float*)take(16384 * 4);
  p.sv8 = (float*)take(16384 * 4);
  p.subkb = (bf16_t*)take((size_t)16 * 128 * 128 * 2);
  static int grid_blocks = 0;
  if (!grid_blocks) {
    int dev = 0, cus = 0, per_cu = 0;
    (void)hipGetDevice(&dev);
    (void)hipDeviceGetAttribute(&cus, hipDeviceAttributeMultiprocessorCount, dev);
    (void)hipOccupancyMaxActiveBlocksPerMultiprocessor(&per_cu, mega, 256, 0);
    if (per_cu > 2) per_cu = 2;
    if (per_cu < 1) per_cu = 1;
    grid_blocks = cus * per_cu;
  }
  void* args[] = {&p};
  hipError_t e = hipLaunchCooperativeKernel((void*)mega, dim3(grid_blocks), dim3(256), args, 0, stream);
  if (e != hipSuccess) fprintf(stderr, "cooperative launch failed: %s (grid %d)\n", hipGetErrorString(e), grid_blocks);
}
```

```cpp
#include <hip/hip_runtime.h>
#include <hip/hip_cooperative_groups.h>
#include <cstdio>
namespace cg = cooperative_groups;
#include <stdint.h>

#define SEQ 2048
#define NBATCH 4
#define T_TOK 8192
#define DM 2048
#define INC 5656
#define C_QN 0
#define C_KC 1024
#define C_VC 1280
#define C_KS 1536
#define C_VS 1792
#define C_KW 2048
#define C_VW 2304
#define C_GT 2560
#define C_QSB 2584
#define C_KSB 3608
#define C_VSB 4632
#define ATT_SCALE 0.08838834764831845f
#define LOG2E 1.4426950408889634f
#define ATT_SCALE2 (ATT_SCALE * LOG2E)
#define RMS_EPS 1e-6f

typedef unsigned short bf16_t;
typedef __attribute__((ext_vector_type(8))) short bf16x8;
typedef __attribute__((ext_vector_type(16))) float f32x16;
typedef __attribute__((ext_vector_type(2))) __bf16 bf16v2;
typedef __attribute__((ext_vector_type(4))) unsigned u32x4;

struct P {
  const float *x, *mem, *t5, *norm_mix, *w_in, *pos_k, *w1_k, *w2_k, *pos_v, *w1_v, *w2_v, *w_out,
      *norm_mq, *norm_mkv, *w_mq, *w_mk, *w_mv, *w_mo, *norm_ffn, *w_pq, *subk, *pu, *pv, *norm_final;
  float* out;
  float *scores, *gates, *part, *posb, *rowss;
  unsigned* bar;
  bf16_t *hn, *omix, *memn, *omem;
  bf16_t *WinT, *WoutT, *WpqT, *WmqT, *WmkT, *WmvT, *WmoT;
  bf16_t *qmemb, *kmemb, *vmemT;
  bf16_t *qsb, *ksb, *vsbT;
  bf16_t* subkb;
  unsigned char *pu8, *pv8;
  float *su8, *sv8;
  bf16_t *qn, *kcin, *vcin, *ks, *vsT, *kw, *vwT, *kcb, *vcT, *c1, *w1T, *w2T;
};

__device__ __forceinline__ int opq(int v) { asm volatile("" : "+v"(v)); return v; }
__device__ __forceinline__ unsigned pack2(float a, float b) {
  bf16v2 r = {(__bf16)a, (__bf16)b};
  return *(unsigned*)&r;
}
__device__ __forceinline__ bf16_t f2bf(float a) {
  __bf16 r = (__bf16)a;
  return *(bf16_t*)&r;
}
__device__ __forceinline__ int perm16(int s) { return (s & ~12) | ((s & 4) << 1) | ((s & 8) >> 1); }
__device__ __forceinline__ float bf2f(bf16_t u) { return __uint_as_float((unsigned)u << 16); }

__device__ __forceinline__ float wave_max(float v) {
  for (int o = 32; o > 0; o >>= 1) v = fmaxf(v, __shfl_xor(v, o));
  return v;
}
__device__ __forceinline__ float wave_sum(float v) {
  for (int o = 32; o > 0; o >>= 1) v += __shfl_xor(v, o);
  return v;
}
__device__ __forceinline__ void wave_argmax(float& v, int& i) {
  for (int o = 32; o > 0; o >>= 1) {
    float ov = __shfl_xor(v, o);
    int oi = __shfl_xor(i, o);
    if (ov > v || (ov == v && oi < i)) { v = ov; i = oi; }
  }
}
__device__ __forceinline__ float gelu_tanh(float x) {
  return 0.5f * x * (1.f + tanhf(0.7978845608028654f * (x + 0.044715f * x * x * x)));
}
__device__ __forceinline__ float gelu_fast(float x) {
  const float y = 1.5957691216057308f * (x + 0.044715f * x * x * x);
  return x / (1.f + __expf(-y));
}
__device__ __forceinline__ int t5_bucket(int n) {
  if (n < 16) return n < 0 ? 0 : n;
  int b = 16;
  b += (n >= 19); b += (n >= 21); b += (n >= 24); b += (n >= 27); b += (n >= 31); b += (n >= 35);
  b += (n >= 40); b += (n >= 46); b += (n >= 52); b += (n >= 59); b += (n >= 67); b += (n >= 77);
  b += (n >= 87); b += (n >= 99); b += (n >= 113);
  return b;
}
__device__ __forceinline__ float log_sigmoid(float x) {
  return fminf(x, 0.f) - log1pf(expf(-fabsf(x)));
}

__device__ __forceinline__ void ph_rmsnorm(const float* src, const float* gain, bf16_t* dst, int rows) {
  int lane = opq(threadIdx.x) & 63, wv = opq(threadIdx.x) >> 6;
  for (int r = blockIdx.x * 4 + wv; r < rows; r += gridDim.x * 4) {
    const float4* s4 = (const float4*)(src + (size_t)r * DM);
    float4 v[8];
    float ss = 0.f;
#pragma unroll
    for (int i = 0; i < 8; ++i) {
      v[i] = s4[i * 64 + lane];
      ss += v[i].x * v[i].x + v[i].y * v[i].y + v[i].z * v[i].z + v[i].w * v[i].w;
    }
    ss = wave_sum(ss);
    float rs = rsqrtf(ss * (1.f / DM) + RMS_EPS);
    uint2* d2 = (uint2*)(dst + (size_t)r * DM);
    const float4* g4 = (const float4*)gain;
#pragma unroll
    for (int i = 0; i < 8; ++i) {
      float4 g = g4[i * 64 + lane];
      uint2 o;
      o.x = pack2(v[i].x * rs * g.x, v[i].y * rs * g.y);
      o.y = pack2(v[i].z * rs * g.z, v[i].w * rs * g.w);
      d2[i * 64 + lane] = o;
    }
  }
}

template <bool CMAP>
__device__ __forceinline__ void ph_transpose(float* smem, const float* W, int K, int N, int Npad, bf16_t* Wt,
                                             int vblock = -2, int nvb = 0) {
  typedef __attribute__((ext_vector_type(4))) float f32x4;
  float (*tl)[65] = (float (*)[65])smem;
  if (vblock == -1) return;
  const int b0 = (vblock >= 0) ? vblock : (int)blockIdx.x, bstride = (vblock >= 0) ? nvb : (int)gridDim.x;
  const int tid = opq(threadIdx.x);
  const int nk = K / 64, nn = Npad / 64;
  for (int tile = b0; tile < nk * nn; tile += bstride) {
    const int k0 = (tile % nk) * 64, n0 = (tile / nk) * 64;
    const int kr = tid >> 4, n4 = (tid & 15) * 4;
    int sc = n0 + n4;
    if (CMAP) sc = (sc < 2560) ? sc : (sc < 5632) ? sc + 24 : (sc < 5656) ? sc - 5632 + 2560 : N;
#pragma unroll
    for (int i = 0; i < 4; ++i) {
      const int k = kr + 16 * i;
      f32x4 v = {0.f, 0.f, 0.f, 0.f};
      if (sc < N) v = *(const f32x4*)(W + (size_t)(k0 + k) * N + sc);
      tl[k][n4 + 0] = v[0]; tl[k][n4 + 1] = v[1]; tl[k][n4 + 2] = v[2]; tl[k][n4 + 3] = v[3];
    }
    __syncthreads();
    int n = tid >> 2, kc = (tid & 3) * 16;
    unsigned w[8];
#pragma unroll
    for (int i = 0; i < 8; ++i) w[i] = pack2(tl[kc + 2 * i][n], tl[kc + 2 * i + 1][n]);
    uint4* dst = (uint4*)(Wt + (size_t)(n0 + n) * K + k0 + kc);
    dst[0] = make_uint4(w[0], w[1], w[2], w[3]);
    dst[1] = make_uint4(w[4], w[5], w[6], w[7]);
    __syncthreads();
  }
}

__device__ __forceinline__ int lds_off(int row, int chunk) { return row * 128 + ((chunk ^ ((row >> 1) & 7)) << 4); }

template <bool TR, bool VEC = false, class Epi>
__device__ __forceinline__ void gemm_tile_bf16(const bf16_t* xp, int ldx, const bf16_t* yp, int ldy, int K, char* lds,
                                               Epi epi) {
  const int tid = opq(threadIdx.x), lane = tid & 63, wv = tid >> 6;
  const int wr = wv >> 1, wc = wv & 1;
  f32x16 acc[2][2];
#pragma unroll
  for (int i = 0; i < 2; ++i)
#pragma unroll
    for (int j = 0; j < 2; ++j)
#pragma unroll
      for (int r = 0; r < 16; ++r) acc[i][j][r] = 0.f;
  const int prow = lane >> 3, pch = lane & 7;
  const bf16_t* xs[4];
  const bf16_t* ys[4];
#pragma unroll
  for (int ps = 0; ps < 4; ++ps) {
    const int row = (wv * 4 + ps) * 8 + prow;
    const int c = pch ^ ((row >> 1) & 7);
    xs[ps] = xp + (size_t)row * ldx + c * 8;
    ys[ps] = yp + (size_t)row * ldy + c * 8;
  }
  char* const mydst = lds + wv * 4096 + lane * 16;
#define GEMM_ISSUE(k0, bufoff)                                                                                              \
  _Pragma("unroll") for (int ps = 0; ps < 4; ++ps) {                                                                        \
    __builtin_amdgcn_global_load_lds((const unsigned*)(xs[ps] + (k0)), (unsigned*)(mydst + (bufoff) + ps * 1024), 16, 0, 0);         \
    __builtin_amdgcn_global_load_lds((const unsigned*)(ys[ps] + (k0)), (unsigned*)(mydst + (bufoff) + 16384 + ps * 1024), 16, 0, 0); \
  }
#define GEMM_COMPUTE(bufoff)                                                                                     \
  _Pragma("unroll") for (int kk = 0; kk < 4; ++kk) {                                                             \
    bf16x8 a[2], b[2];                                                                                           \
    const int ch = kk * 2 + (lane >> 5);                                                                         \
    _Pragma("unroll") for (int i = 0; i < 2; ++i) {                                                              \
      a[i] = *(const bf16x8*)(lds + (bufoff) + (TR ? 16384 : 0) + lds_off(wr * 64 + i * 32 + (lane & 31), ch)); \
      b[i] = *(const bf16x8*)(lds + (bufoff) + (TR ? 0 : 16384) + lds_off(wc * 64 + i * 32 + (lane & 31), ch)); \
    }                                                                                                            \
    _Pragma("unroll") for (int i = 0; i < 2; ++i)                                                                \
      _Pragma("unroll") for (int j = 0; j < 2; ++j)                                                              \
        acc[i][j] = __builtin_amdgcn_mfma_f32_32x32x16_bf16(a[i], b[j], acc[i][j], 0, 0, 0);                    \
  }
  __syncthreads();
  GEMM_ISSUE(0, 0)
  for (int k0 = 0; k0 < K; k0 += 128) {
    asm volatile("s_waitcnt vmcnt(0)" ::: "memory");
    __syncthreads();
    GEMM_ISSUE(k0 + 64, 32768)
    GEMM_COMPUTE(0)
    asm volatile("s_waitcnt vmcnt(0)" ::: "memory");
    __syncthreads();
    if (k0 + 128 < K) { GEMM_ISSUE(k0 + 128, 0) }
    GEMM_COMPUTE(32768)
  }
#undef GEMM_ISSUE
#undef GEMM_COMPUTE
  int lane2 = lane;
  asm volatile("" : "+v"(lane2));
  if constexpr (VEC) {
    typedef __attribute__((ext_vector_type(4))) float f32x4;
    __syncthreads();
    float* wl = (float*)lds + wv * (32 * 68);
    const int hh2 = lane2 >> 5, cl = lane2 & 31;
#pragma unroll
    for (int i = 0; i < 2; ++i) {
#pragma unroll
      for (int j = 0; j < 2; ++j)
#pragma unroll
        for (int r = 0; r < 16; ++r) wl[((r & 3) + 8 * (r >> 2) + 4 * hh2) * 68 + j * 32 + cl] = acc[i][j][r];
      __builtin_amdgcn_wave_barrier();
#pragma unroll
      for (int k = 0; k < 4; ++k) {
        const int row = (lane2 >> 3) + 8 * k, c8 = (lane2 & 7) * 8;
        const f32x4 lo = *(const f32x4*)&wl[row * 68 + c8];
        const f32x4 hi = *(const f32x4*)&wl[row * 68 + c8 + 4];
        epi(wr * 64 + i * 32 + row, wc * 64 + c8, lo, hi);
      }
      __builtin_amdgcn_wave_barrier();
    }
  } else {
#pragma unroll
    for (int i = 0; i < 2; ++i)
#pragma unroll
      for (int j = 0; j < 2; ++j)
#pragma unroll
        for (int r = 0; r < 16; ++r) {
          int rr = wr * 64 + i * 32 + (r & 3) + 8 * (r >> 2) + 4 * (lane2 >> 5);
          int cc = wc * 64 + j * 32 + (lane2 & 31);
          epi(rr, cc, acc[i][j][r]);
        }
  }
}

typedef __attribute__((ext_vector_type(4))) float f32x4_e;
__device__ __forceinline__ void st_bf16x8(bf16_t* dst, f32x4_e lo, f32x4_e hi) {
  u32x4 o;
  o[0] = pack2(lo[0], lo[1]); o[1] = pack2(lo[2], lo[3]); o[2] = pack2(hi[0], hi[1]); o[3] = pack2(hi[2], hi[3]);
  *(u32x4*)dst = o;
}

__device__ __forceinline__ int lds_off32(int row, int chunk) { return row * 64 + ((chunk ^ ((row >> 2) & 3)) << 4); }

template <class Epi>
__device__ __forceinline__ void gemm_tile_big(const bf16_t* xp, int ldx, const bf16_t* yp, int ldy, int K, char* lds,
                                              Epi epi) {
  const int tid = opq(threadIdx.x), lane = tid & 63, wv = tid >> 6;
  f32x16 acc[2][4];
#pragma unroll
  for (int i = 0; i < 2; ++i)
#pragma unroll
    for (int j = 0; j < 4; ++j)
#pragma unroll
      for (int r = 0; r < 16; ++r) acc[i][j][r] = 0.f;
  const int prow = lane >> 2, pch = lane & 3;
  const bf16_t* xs[4];
  const bf16_t* ys[2];
#pragma unroll
  for (int ps = 0; ps < 4; ++ps) {
    const int row = (wv * 4 + ps) * 16 + prow;
    xs[ps] = xp + (size_t)row * ldx + (pch ^ ((row >> 2) & 3)) * 8;
  }
#pragma unroll
  for (int ps = 0; ps < 2; ++ps) {
    const int row = (wv * 2 + ps) * 16 + prow;
    ys[ps] = yp + (size_t)row * ldy + (pch ^ ((row >> 2) & 3)) * 8;
  }
  char* const xdst = lds + wv * 4096 + lane * 16;
  char* const ydst = lds + 16384 + wv * 2048 + lane * 16;
#define BIG_ISSUE(k0, st)                                                                                                      \
  _Pragma("unroll") for (int ps = 0; ps < 4; ++ps)                                                                             \
    __builtin_amdgcn_global_load_lds((const unsigned*)(xs[ps] + (k0)), (unsigned*)(xdst + (st) + ps * 1024), 16, 0, 0);        \
  _Pragma("unroll") for (int ps = 0; ps < 2; ++ps)                                                                             \
    __builtin_amdgcn_global_load_lds((const unsigned*)(ys[ps] + (k0)), (unsigned*)(ydst + (st) + ps * 1024), 16, 0, 0);
#define DSR(dst, addr, off) asm volatile("ds_read_b128 %0, %1 offset:%2" : "=v"(dst) : "v"(addr), "i"(off) : "memory")
#define WAIT1(n, x) asm volatile("s_waitcnt lgkmcnt(" #n ")" : "+v"(x))
#define WAIT2(n, x, y) asm volatile("s_waitcnt lgkmcnt(" #n ")" : "+v"(x), "+v"(y))
#define MF(acc_, a_, b_) acc_ = __builtin_amdgcn_mfma_f32_32x32x16_bf16(a_, b_, acc_, 0, 0, 0)
#define BIG_COMPUTE(st)                                                                                   \
  {                                                                                                       \
    bf16x8 a00, a01, a10, a11, b00, b01, b02, b03, b10, b11, b12, b13;                                    \
    const unsigned aa0 = abase0 + (st), aa1 = abase1 + (st), bb0 = bbase0 + (st), bb1 = bbase1 + (st);    \
    DSR(a00, aa0, 0); DSR(b00, bb0, 0); DSR(b01, bb0, 2048); DSR(b02, bb0, 4096); DSR(b03, bb0, 6144);    \
    DSR(a01, aa0, 2048);                                                                                  \
    DSR(a10, aa1, 0); DSR(b10, bb1, 0); DSR(b11, bb1, 2048); DSR(b12, bb1, 4096); DSR(b13, bb1, 6144);    \
    DSR(a11, aa1, 2048);                                                                                  \
    WAIT2(10, a00, b00); MF(acc[0][0], a00, b00);                                                         \
    WAIT1(9, b01); MF(acc[0][1], a00, b01);                                                               \
    WAIT1(8, b02); MF(acc[0][2], a00, b02);                                                               \
    WAIT1(7, b03); MF(acc[0][3], a00, b03);                                                               \
    WAIT1(6, a01); MF(acc[1][0], a01, b00); MF(acc[1][1], a01, b01); MF(acc[1][2], a01, b02); MF(acc[1][3], a01, b03); \
    WAIT2(4, a10, b10); MF(acc[0][0], a10, b10);                                                          \
    WAIT1(3, b11); MF(acc[0][1], a10, b11);                                                               \
    WAIT1(2, b12); MF(acc[0][2], a10, b12);                                                               \
    WAIT1(1, b13); MF(acc[0][3], a10, b13);                                                               \
    WAIT1(0, a11); MF(acc[1][0], a11, b10); MF(acc[1][1], a11, b11); MF(acc[1][2], a11, b12); MF(acc[1][3], a11, b13); \
  }
  const unsigned ldsb = (unsigned)(size_t)(__attribute__((address_space(3))) char*)lds;
  const unsigned abase0 = ldsb + lds_off32(wv * 64 + (lane & 31), 0 + (lane >> 5));
  const unsigned abase1 = ldsb + lds_off32(wv * 64 + (lane & 31), 2 + (lane >> 5));
  const unsigned bbase0 = ldsb + 16384 + lds_off32((lane & 31), 0 + (lane >> 5));
  const unsigned bbase1 = ldsb + 16384 + lds_off32((lane & 31), 2 + (lane >> 5));
  const int nsteps = K >> 5;
  __syncthreads();
  BIG_ISSUE(0, 0)
  BIG_ISSUE(32, 24576)
  int cur = 0, nx2 = 49152;
  for (int t = 0; t < nsteps - 2; ++t) {
    asm volatile("s_waitcnt vmcnt(6)" ::: "memory");
    __builtin_amdgcn_s_barrier();
    BIG_ISSUE((t + 2) * 32, nx2)
    BIG_COMPUTE(cur)
    cur = (cur == 49152) ? 0 : cur + 24576;
    nx2 = (nx2 == 49152) ? 0 : nx2 + 24576;
  }
  asm volatile("s_waitcnt vmcnt(6)" ::: "memory");
  __builtin_amdgcn_s_barrier();
  BIG_COMPUTE(cur)
  cur = (cur == 49152) ? 0 : cur + 24576;
  asm volatile("s_waitcnt vmcnt(0)" ::: "memory");
  __builtin_amdgcn_s_barrier();
  BIG_COMPUTE(cur)
#undef BIG_ISSUE
#undef BIG_COMPUTE
#undef DSR
#undef WAIT1
#undef WAIT2
#undef MF
  const int lane2 = opq(lane);
  typedef __attribute__((ext_vector_type(4))) float f32x4;
  __syncthreads();
  float* wl = (float*)lds + wv * (32 * 68);
  const int hh2 = lane2 >> 5, cl = lane2 & 31;
#pragma unroll
  for (int i = 0; i < 2; ++i)
#pragma unroll
    for (int jh = 0; jh < 2; ++jh) {
#pragma unroll
      for (int j = 0; j < 2; ++j)
#pragma unroll
        for (int r = 0; r < 16; ++r) wl[((r & 3) + 8 * (r >> 2) + 4 * hh2) * 68 + j * 32 + cl] = acc[i][jh * 2 + j][r];
      __builtin_amdgcn_wave_barrier();
#pragma unroll
      for (int k = 0; k < 4; ++k) {
        const int row = (lane2 >> 3) + 8 * k, c8 = (lane2 & 7) * 8;
        const f32x4 lo = *(const f32x4*)&wl[row * 68 + c8];
        const f32x4 hi = *(const f32x4*)&wl[row * 68 + c8 + 4];
        epi(wv * 64 + i * 32 + row, jh * 64 + c8, lo, hi);
      }
      __builtin_amdgcn_wave_barrier();
    }
}

template <class Epi>
__device__ __forceinline__ void ph_gemm_big(const bf16_t* A, int lda, const bf16_t* Wt, int ldw, int M, int N, int K,
                                            char* lds, Epi epi) {
  const int ntm = M / 256, ntn = N / 128;
  const int npm = (ntm + 7) / 8, npn = (ntn + 7) / 8;
  const int nslots = ((npm * npn * 64 + 511) / 512) * 512;
  for (int u = blockIdx.x; u < nslots; u += gridDim.x) {
    int v = (u & 7) * 64 + ((u >> 3) & 63) + (u & ~511);
    int patch = v >> 6, w = v & 63;
    int tm = (patch % npm) * 8 + (w & 7);
    int tn = (patch / npm) * 8 + (w >> 3);
    if (tm >= ntm || tn >= ntn) continue;
    const int m0 = tm * 256, n0 = tn * 128;
    gemm_tile_big(A + (size_t)m0 * lda, lda, Wt + (size_t)n0 * ldw, ldw, K, lds,
                  [&](int r, int c, f32x4_e lo, f32x4_e hi) { epi(m0 + r, n0 + c, lo, hi); });
  }
}

__device__ __forceinline__ void norm_feed(const f32x4_e h0, const f32x4_e h1, const float* gain, int n, bf16_t* hn_row,
                                          float* rowss_m) {
  const f32x4_e g0 = *(const f32x4_e*)(gain + n), g1 = *(const f32x4_e*)(gain + n + 4);
  st_bf16x8(hn_row + n, h0 * g0, h1 * g1);
  float ss = h0[0] * h0[0] + h0[1] * h0[1] + h0[2] * h0[2] + h0[3] * h0[3] + h1[0] * h1[0] + h1[1] * h1[1] + h1[2] * h1[2] + h1[3] * h1[3];
  ss += __shfl_xor(ss, 1);
  ss += __shfl_xor(ss, 2);
  ss += __shfl_xor(ss, 4);
  if (((opq(threadIdx.x)) & 7) == 0) atomicAdd(rowss_m, ss);
}

template <bool VEC = false, class Epi>
__device__ __forceinline__ void ph_gemm_bf16(const bf16_t* A, int lda, const bf16_t* Wt, int ldw, int M, int N, int K,
                                             char* lds, Epi epi, int vblock = -2) {
  const int ntm = M / 128, ntn = N / 128;
  const int npm = (ntm + 7) / 8, npn = (ntn + 7) / 8;
  const int nslots = ((npm * npn * 64 + 511) / 512) * 512;
  if (vblock == -1) return;
  for (int u = (vblock >= 0 ? vblock : (int)blockIdx.x); u < nslots; u += gridDim.x) {
    int v = (u & 7) * 64 + ((u >> 3) & 63) + (u & ~511);
    int patch = v >> 6, w = v & 63;
    int tm = (patch % npm) * 8 + (w & 7);
    int tn = (patch / npm) * 8 + (w >> 3);
    if (tm >= ntm || tn >= ntn) continue;
    const int m0 = tm * 128, n0 = tn * 128;
    if constexpr (VEC)
      gemm_tile_bf16<false, true>(A + (size_t)m0 * lda, lda, Wt + (size_t)n0 * ldw, ldw, K, lds,
                                  [&](int r, int c, f32x4_e lo, f32x4_e hi) { epi(m0 + r, n0 + c, lo, hi); });
    else
      gemm_tile_bf16<false>(A + (size_t)m0 * lda, lda, Wt + (size_t)n0 * ldw, ldw, K, lds,
                            [&](int r, int c, float val) { epi(m0 + r, n0 + c, val); });
  }
}

__device__ __forceinline__ void ph_proj(const P& p, char* lds) {
  for (int u = blockIdx.x; u < 1024; u += gridDim.x) {
    int v = (u & 7) * 64 + ((u >> 3) & 63) + (u & ~511);
    int patch = v >> 6, w = v & 63;
    const int tm = (patch & 3) * 8 + (w & 7), tb = (patch >> 2) * 8 + (w >> 3);
    const int tn = (tb < 14) ? tb : (tb < 16) ? tb + 2 : tb + 4;
    const int m0 = tm * 256, n0 = tn * 128;
    const int b = m0 >> 11, sl = m0 & 2047;
    const bf16_t* A = p.hn + (size_t)m0 * DM;
    const bf16_t* W = p.WinT + (size_t)n0 * DM;
    bf16_t* dst;
    int ldd;
    if (n0 < 1024) { dst = p.qn + (size_t)m0 * 1024 + n0; ldd = 1024; }
    else if (n0 < 2560) {
      const int seg = (n0 - 1024) >> 8, g = ((n0 - 1024) >> 7) & 1;
      bf16_t* base = (seg == 0) ? p.kcin : (seg == 1) ? p.vcin : (seg == 2) ? p.ks : p.kw;
      dst = base + ((size_t)(b * 2 + g) * SEQ + sl) * 128; ldd = 128;
    } else if (n0 < 3584) { dst = p.qsb + (size_t)m0 * 1024 + (n0 - 2560); ldd = 1024; }
    else { dst = p.ksb + ((size_t)(b * 8 + ((n0 - 3584) >> 7)) * SEQ + sl) * 128; ldd = 128; }
    gemm_tile_big(A, DM, W, DM, DM, lds, [&](int r, int c, f32x4_e lo, f32x4_e hi) { st_bf16x8(dst + (size_t)r * ldd + c, lo, hi); });
  }
  for (int u = blockIdx.x; u < 64 * 13; u += gridDim.x) {
    const int tm = u & 63, ts = u >> 6;
    const int tn = (ts < 2) ? 14 + ts : (ts < 4) ? 16 + ts : (ts < 12) ? 32 + ts : 44;
    const int m0 = tm * 128, n0 = tn * 128;
    const int b = m0 >> 11, sl = m0 & 2047;
    const bf16_t* A = p.hn + (size_t)m0 * DM;
    const bf16_t* W = p.WinT + (size_t)n0 * DM;
    if (n0 < 2560) {
      const int seg = (n0 - 1024) >> 8, g = ((n0 - 1024) >> 7) & 1;
      bf16_t* vd = (seg == 3 ? p.vsT : p.vwT) + ((size_t)(b * 2 + g) * 128) * SEQ + sl;
      gemm_tile_bf16<true>(A, DM, W, DM, DM, lds, [&](int r, int c, float val) { vd[(size_t)r * SEQ + perm16(c)] = f2bf(val); });
    } else if (n0 < 5632) {
      bf16_t* vd = p.vsbT + ((size_t)(b * 8 + ((n0 - 4608) >> 7)) * 128) * SEQ + sl;
      gemm_tile_bf16<true>(A, DM, W, DM, DM, lds, [&](int r, int c, float val) { vd[(size_t)r * SEQ + perm16(c)] = f2bf(val); });
    } else {
      float* gd = p.gates + (size_t)m0 * 24;
      gemm_tile_bf16<false>(A, DM, W, DM, DM, lds, [&](int r, int c, float val) { if (c < 24) gd[(size_t)r * 24 + c] = val; });
    }
  }
}

__device__ __forceinline__ void ph_posb(const P& p) {
  const int lane = opq(threadIdx.x) & 63, wv = opq(threadIdx.x) >> 6;
  for (int o = blockIdx.x * 4 + wv; o < 256; o += gridDim.x * 4) {
    const int which = o >> 7, n = o & 127;
    const float* pos = which ? p.pos_v : p.pos_k;
    const float* w1 = which ? p.w1_v : p.w1_k;
    float acc = 0.f;
    for (int k = lane; k < 4096; k += 64) acc += pos[k] * w1[(size_t)k * 128 + n];
    acc = wave_sum(acc);
    if (lane == 0) p.posb[o] = acc;
  }
}

__device__ __forceinline__ void ph_compress2(const P& p, char* lds) {
  for (int item = blockIdx.x; item < 16; item += gridDim.x) {
    const int which = item >> 3, bg = item & 7;
    const bf16_t* src = (which ? p.vcin : p.kcin) + (size_t)bg * SEQ * 128;
    const bf16_t* w1t = p.w1T + (size_t)which * 128 * 4096;
    const bf16_t* w2t = p.w2T + (size_t)which * 128 * 128;
    const float* posb = p.posb + which * 128;
    bf16_t* c1 = p.c1 + (size_t)item * 128 * 128;
    gemm_tile_bf16<false>(src, 2048, w1t, 4096, 4096, lds, [&](int r, int c, float val) {
      c1[r * 128 + c] = f2bf(gelu_fast(val + posb[c])); });
    __threadfence_block();
    __syncthreads();
    if (which == 0) {
      bf16_t* kd = p.kcb + (size_t)bg * 128 * 128;
      gemm_tile_bf16<false>(c1, 128, w2t, 128, 128, lds, [&](int r, int c, float val) { kd[r * 128 + c] = f2bf(val); });
    } else {
      bf16_t* vd = p.vcT + (size_t)bg * 128 * 128;
      gemm_tile_bf16<true>(c1, 128, w2t, 128, 128, lds, [&](int r, int c, float val) { vd[r * 128 + perm16(c)] = f2bf(val); });
    }
  }
}

#define NEG_BIG (-1e30f)

struct KVRegs { u32x4 k0, k1, k2, k3, v0, v1, v2, v3; };

__device__ __forceinline__ int koff(int row, int chunk) { return row * 256 + ((chunk ^ (row & 15)) << 4); }

__device__ __forceinline__ void kv_load(KVRegs& r, const bf16_t* kp, int ldk, const bf16_t* vp, int ldv) {
  const int tid = opq(threadIdx.x);
  const bf16_t* kg = kp + (size_t)(tid >> 4) * ldk + (tid & 15) * 8;
  r.k0 = *(const u32x4*)kg;
  r.k1 = *(const u32x4*)(kg + (size_t)16 * ldk);
  r.k2 = *(const u32x4*)(kg + (size_t)32 * ldk);
  r.k3 = *(const u32x4*)(kg + (size_t)48 * ldk);
  const bf16_t* vg = vp + (size_t)(tid >> 3) * ldv + (tid & 7) * 8;
  r.v0 = *(const u32x4*)vg;
  r.v1 = *(const u32x4*)(vg + (size_t)32 * ldv);
  r.v2 = *(const u32x4*)(vg + (size_t)64 * ldv);
  r.v3 = *(const u32x4*)(vg + (size_t)96 * ldv);
}
__device__ __forceinline__ void kv_store(const KVRegs& r, char* lk, char* lv) {
  const int tid = opq(threadIdx.x);
  const int row = tid >> 4, ch = tid & 15;
  *(u32x4*)(lk + koff(row, ch)) = r.k0;
  *(u32x4*)(lk + koff(row + 16, ch)) = r.k1;
  *(u32x4*)(lk + koff(row + 32, ch)) = r.k2;
  *(u32x4*)(lk + koff(row + 48, ch)) = r.k3;
  const int vr = tid >> 3, vc = tid & 7;
  *(u32x4*)(lv + lds_off(vr, vc)) = r.v0;
  *(u32x4*)(lv + lds_off(vr + 32, vc)) = r.v1;
  *(u32x4*)(lv + lds_off(vr + 64, vc)) = r.v2;
  *(u32x4*)(lv + lds_off(vr + 96, vc)) = r.v3;
}

struct QFrag { bf16x8 f0, f1, f2, f3, f4, f5, f6, f7; };
__device__ __forceinline__ void q_load(QFrag& q, const bf16_t* qrow) {
  const int h = (opq(threadIdx.x) & 63) >> 5;
  const bf16x8* p8 = (const bf16x8*)(qrow + 8 * h);
  q.f0 = p8[0]; q.f1 = p8[2]; q.f2 = p8[4]; q.f3 = p8[6]; q.f4 = p8[8]; q.f5 = p8[10]; q.f6 = p8[12]; q.f7 = p8[14];
}

__device__ __forceinline__ void qk_tile(const QFrag& q, const char* lk, f32x16& s0, f32x16& s1) {
  const int lane = opq(threadIdx.x) & 63, row = lane & 31, h = lane >> 5;
#pragma unroll
  for (int r = 0; r < 16; ++r) { s0[r] = 0.f; s1[r] = 0.f; }
#define QK_STEP(kk, qf)                                                                  \
  {                                                                                      \
    bf16x8 a0 = *(const bf16x8*)(lk + koff(row, 2 * (kk) + h));                          \
    bf16x8 a1 = *(const bf16x8*)(lk + koff(row + 32, 2 * (kk) + h));                     \
    s0 = __builtin_amdgcn_mfma_f32_32x32x16_bf16(a0, qf, s0, 0, 0, 0);                   \
    s1 = __builtin_amdgcn_mfma_f32_32x32x16_bf16(a1, qf, s1, 0, 0, 0);                   \
  }
  QK_STEP(0, q.f0) QK_STEP(1, q.f1) QK_STEP(2, q.f2) QK_STEP(3, q.f3)
  QK_STEP(4, q.f4) QK_STEP(5, q.f5) QK_STEP(6, q.f6) QK_STEP(7, q.f7)
#undef QK_STEP
}

__device__ __forceinline__ bf16x8 pack8(const f32x16& p, const int base) {
  u32x4 u;
  u[0] = pack2(p[base + 0], p[base + 1]);
  u[1] = pack2(p[base + 2], p[base + 3]);
  u[2] = pack2(p[base + 4], p[base + 5]);
  u[3] = pack2(p[base + 6], p[base + 7]);
  return __builtin_bit_cast(bf16x8, u);
}

typedef __attribute__((ext_vector_type(2))) unsigned u32x2_t;
__device__ __forceinline__ float xhalf_max(float v) {
  const u32x2_t r = __builtin_amdgcn_permlane32_swap(__float_as_uint(v), __float_as_uint(v), false, false);
  return fmaxf(__uint_as_float(r[0]), __uint_as_float(r[1]));
}
__device__ __forceinline__ float xhalf_sum(float v) {
  const u32x2_t r = __builtin_amdgcn_permlane32_swap(__float_as_uint(v), __float_as_uint(v), false, false);
  return __uint_as_float(r[0]) + __uint_as_float(r[1]);
}
__device__ __forceinline__ float xhalf_get(float v, int hh) {
  const u32x2_t r = __builtin_amdgcn_permlane32_swap(__float_as_uint(v), __float_as_uint(v), false, false);
  return hh ? __uint_as_float(r[0]) : __uint_as_float(r[1]);
}
struct OAcc { f32x16 o0, o1, o2, o3; };
__device__ __forceinline__ void oacc_zero(OAcc& o) {
#pragma unroll
  for (int r = 0; r < 16; ++r) { o.o0[r] = 0.f; o.o1[r] = 0.f; o.o2[r] = 0.f; o.o3[r] = 0.f; }
}
__device__ __forceinline__ void oacc_scale(OAcc& o, float a) {
#pragma unroll
  for (int r = 0; r < 16; ++r) { o.o0[r] *= a; o.o1[r] *= a; o.o2[r] *= a; o.o3[r] *= a; }
}

__device__ __forceinline__ void pv_tile(OAcc& o, const char* lv, const f32x16& p0, const f32x16& p1) {
  const int lane = opq(threadIdx.x) & 63, row = lane & 31, h = lane >> 5;
  const bf16x8 pf0 = pack8(p0, 0), pf1 = pack8(p0, 8), pf2 = pack8(p1, 0), pf3 = pack8(p1, 8);
#define PV_ROW(dd, acc)                                                                                      \
  {                                                                                                          \
    acc = __builtin_amdgcn_mfma_f32_32x32x16_bf16(*(const bf16x8*)(lv + lds_off(32 * (dd) + row, 0 + h)), pf0, acc, 0, 0, 0); \
    acc = __builtin_amdgcn_mfma_f32_32x32x16_bf16(*(const bf16x8*)(lv + lds_off(32 * (dd) + row, 2 + h)), pf1, acc, 0, 0, 0); \
    acc = __builtin_amdgcn_mfma_f32_32x32x16_bf16(*(const bf16x8*)(lv + lds_off(32 * (dd) + row, 4 + h)), pf2, acc, 0, 0, 0); \
    acc = __builtin_amdgcn_mfma_f32_32x32x16_bf16(*(const bf16x8*)(lv + lds_off(32 * (dd) + row, 6 + h)), pf3, acc, 0, 0, 0); \
  }
  PV_ROW(0, o.o0) PV_ROW(1, o.o1) PV_ROW(2, o.o2) PV_ROW(3, o.o3)
#undef PV_ROW
}

__device__ __forceinline__ void softmax_tile(f32x16& s0, f32x16& s1, float& m, float& l, OAcc& o) {
  float mx = NEG_BIG;
#pragma unroll
  for (int r = 0; r < 16; ++r) mx = fmaxf(mx, fmaxf(s0[r], s1[r]));
  mx = xhalf_max(mx);
  const float mn = fmaxf(m, mx);
  const float alpha = __builtin_amdgcn_exp2f(m - mn);
  float ls = 0.f;
#pragma unroll
  for (int r = 0; r < 16; ++r) {
    const float a = __builtin_amdgcn_exp2f(s0[r] - mn);
    const float b = __builtin_amdgcn_exp2f(s1[r] - mn);
    s0[r] = a; s1[r] = b;
    ls += a + b;
  }
  ls = xhalf_sum(ls);
  l = l * alpha + ls;
  m = mn;
  if (__any(alpha != 1.f)) oacc_scale(o, alpha);
}

template <class F>
__device__ __forceinline__ void oacc_foreach(const OAcc& o, F f) {
  const int h = (opq(threadIdx.x) & 63) >> 5;
#pragma unroll
  for (int rho = 0; rho < 4; ++rho) {
    f(0 + 8 * rho + 4 * h, o.o0[4 * rho], o.o0[4 * rho + 1], o.o0[4 * rho + 2], o.o0[4 * rho + 3]);
    f(32 + 8 * rho + 4 * h, o.o1[4 * rho], o.o1[4 * rho + 1], o.o1[4 * rho + 2], o.o1[4 * rho + 3]);
    f(64 + 8 * rho + 4 * h, o.o2[4 * rho], o.o2[4 * rho + 1], o.o2[4 * rho + 2], o.o2[4 * rho + 3]);
    f(96 + 8 * rho + 4 * h, o.o3[4 * rho], o.o3[4 * rho + 1], o.o3[4 * rho + 2], o.o3[4 * rho + 3]);
  }
}

__device__ __forceinline__ void memattn_item(const P& p, char* lds, int item) {
  char* lk = lds;
  char* lv = lds + 16384;
  const int lane = opq(threadIdx.x) & 63, wv = opq(threadIdx.x) >> 6;
  {
    const int tb = item % (SEQ / 128);
    const int bh = item / (SEQ / 128);
    const int b = bh >> 2, hd = bh & 3;
    const int t = tb * 128 + wv * 32 + (lane & 31);
    QFrag q;
    q_load(q, p.qmemb + (size_t)(b * SEQ + t) * 512 + hd * 128);
    const bf16_t* kb = p.kmemb + (size_t)bh * 256 * 128;
    const bf16_t* vb = p.vmemT + (size_t)bh * 128 * 256;
    OAcc o;
    oacc_zero(o);
    float m = NEG_BIG, l = 0.f;
    KVRegs kv;
    kv_load(kv, kb, 128, vb, 256);
#pragma unroll 1
    for (int ti = 0; ti < 4; ++ti) {
      __syncthreads();
      kv_store(kv, lk, lv);
      __syncthreads();
      {
        const int tn = (ti + 1 < 4) ? ti + 1 : 3;
        kv_load(kv, kb + (size_t)tn * 64 * 128, 128, vb + tn * 64, 256);
      }
      f32x16 s0, s1;
      qk_tile(q, lk, s0, s1);
#pragma unroll
      for (int r = 0; r < 16; ++r) { s0[r] *= ATT_SCALE2; s1[r] *= ATT_SCALE2; }
      softmax_tile(s0, s1, m, l, o);
      pv_tile(o, lv, s0, s1);
    }
    const float il = 1.f / l;
    const int t2 = tb * 128 + (opq(threadIdx.x) >> 6) * 32 + (opq(threadIdx.x) & 31);
    bf16_t* orow = p.omem + (size_t)(b * SEQ + t2) * 512 + hd * 128;
    oacc_foreach(o, [&](int d, float v0, float v1, float v2, float v3) {
      uint2 u;
      u.x = pack2(v0 * il, v1 * il);
      u.y = pack2(v2 * il, v3 * il);
      *(uint2*)(orow + d) = u;
    });
  }
}

__device__ __forceinline__ void ph_memq_attn(const P& p, char* lds, int vblock, int nvb) {
  if (vblock < 0) return;
  const float* rss = p.rowss;
  for (int u = vblock; u < 64 * 4; u += nvb) {
    const int tm = u & 63, hd = u >> 6;
    const int m0 = tm * 128;
    bf16_t* qd = p.qmemb + (size_t)m0 * 512 + hd * 128;
    gemm_tile_bf16<false, true>(p.hn + (size_t)m0 * DM, DM, p.WmqT + (size_t)hd * 128 * DM, DM, DM, lds,
                                [&](int r, int c, f32x4_e lo, f32x4_e hi) {
                                  const float rs = rsqrtf(rss[m0 + r] * (1.f / DM) + RMS_EPS);
                                  st_bf16x8(qd + (size_t)r * 512 + c, lo * rs, hi * rs); });
    __threadfence_block();
    __syncthreads();
    memattn_item(p, lds, ((m0 >> 11) * 4 + hd) * (SEQ / 128) + ((m0 & 2047) >> 7));
  }
}

__device__ __forceinline__ void ph_sb2(const P& p, char* lds) {
  char* lk = lds;
  char* lv = lds + 16384;
  const int lane = opq(threadIdx.x) & 63, wv = opq(threadIdx.x) >> 6, hh = lane >> 5;
  const int sb_skip = (gridDim.x > 32) ? 16 : 0;
  if ((int)blockIdx.x < sb_skip) return;
  for (int item = (int)blockIdx.x - sb_skip; item < NBATCH * 8 * (SEQ / 128); item += (int)gridDim.x - sb_skip) {
    const int tb = (SEQ / 128 - 1) - (item % (SEQ / 128));
    const int bh = item / (SEQ / 128);
    const int b = bh >> 3, hd = bh & 7;
    const int t0 = tb * 128;
    const int t = t0 + wv * 32 + (lane & 31);
    QFrag q;
    q_load(q, p.qsb + (size_t)(b * SEQ + t) * 1024 + hd * 128);
    const bf16_t* kb = p.ksb + (size_t)bh * SEQ * 128;
    const bf16_t* vb = p.vsbT + (size_t)bh * 128 * SEQ;
    OAcc o;
    oacc_zero(o);
    float carry = 0.f;
    const int jhi = (t0 >> 6) + 1;
    const int jw = (t0 + wv * 32 + 30) >> 6;
    KVRegs kv;
    kv_load(kv, kb + (size_t)jhi * 64 * 128, 128, vb + jhi * 64, SEQ);
    volatile unsigned* dflag = (volatile unsigned*)(lds + 32768);
    __syncthreads();
    if (opq(threadIdx.x) < 4) dflag[opq(threadIdx.x)] = 0u;
    for (int j = jhi; j >= 0; --j) {
      __syncthreads();
      if ((dflag[0] & dflag[1] & dflag[2] & dflag[3]) != 0u) break;
      kv_store(kv, lk, lv);
      __syncthreads();
      const int jn = (j > 0) ? j - 1 : 0;
      if (j > jw) kv_load(kv, kb + (size_t)jn * 64 * 128, 128, vb + jn * 64, SEQ);
      if (j <= jw) {
        f32x16 z0, z1;
        qk_tile(q, lk, z0, z1);
        const int sbase = j * 64 + 4 * hh;
        float gt[8];
        f32x16 l0, l1;
#pragma unroll
        for (int r = 0; r < 16; ++r) {
          const int so = sbase + 8 * (r >> 2) + (r & 3);
          {
            const float z = z0[r] * ATT_SCALE2;
            const bool valid = so < t;
            const float lsp = fminf(z, 0.f) - __builtin_amdgcn_logf(1.f + __builtin_amdgcn_exp2f(-fabsf(z)));
            l0[r] = valid ? (lsp - z) : 0.f;
            z0[r] = valid ? z : NEG_BIG;
          }
          {
            const float z = z1[r] * ATT_SCALE2;
            const bool valid = so + 32 < t;
            const float lsp = fminf(z, 0.f) - __builtin_amdgcn_logf(1.f + __builtin_amdgcn_exp2f(-fabsf(z)));
            l1[r] = valid ? (lsp - z) : 0.f;
            z1[r] = valid ? z : NEG_BIG;
          }
        }
#pragma unroll
        for (int rho = 0; rho < 4; ++rho) {
          gt[rho] = (l0[4 * rho] + l0[4 * rho + 1]) + (l0[4 * rho + 2] + l0[4 * rho + 3]);
          gt[4 + rho] = (l1[4 * rho] + l1[4 * rho + 1]) + (l1[4 * rho + 2] + l1[4 * rho + 3]);
        }
        float ag[8];
        float run = 0.f;
#pragma unroll
        for (int k = 7; k >= 0; --k) {
          const float pg = xhalf_get(gt[k], hh);
          ag[k] = carry + run + (hh == 0 ? pg : 0.f);
          run += gt[k] + pg;
        }
        carry += run;
#pragma unroll
        for (int rho = 0; rho < 4; ++rho) {
          {
            const float x3 = l0[4 * rho + 3], x23 = x3 + l0[4 * rho + 2], x123 = x23 + l0[4 * rho + 1];
            const float g = ag[rho];
            z0[4 * rho + 0] = __builtin_amdgcn_exp2f((l0[4 * rho + 0] + z0[4 * rho + 0]) + (g + x123));
            z0[4 * rho + 1] = __builtin_amdgcn_exp2f((l0[4 * rho + 1] + z0[4 * rho + 1]) + (g + x23));
            z0[4 * rho + 2] = __builtin_amdgcn_exp2f((l0[4 * rho + 2] + z0[4 * rho + 2]) + (g + x3));
            z0[4 * rho + 3] = __builtin_amdgcn_exp2f((l0[4 * rho + 3] + z0[4 * rho + 3]) + g);
          }
          {
            const float x3 = l1[4 * rho + 3], x23 = x3 + l1[4 * rho + 2], x123 = x23 + l1[4 * rho + 1];
            const float g = ag[4 + rho];
            z1[4 * rho + 0] = __builtin_amdgcn_exp2f((l1[4 * rho + 0] + z1[4 * rho + 0]) + (g + x123));
            z1[4 * rho + 1] = __builtin_amdgcn_exp2f((l1[4 * rho + 1] + z1[4 * rho + 1]) + (g + x23));
            z1[4 * rho + 2] = __builtin_amdgcn_exp2f((l1[4 * rho + 2] + z1[4 * rho + 2]) + (g + x3));
            z1[4 * rho + 3] = __builtin_amdgcn_exp2f((l1[4 * rho + 3] + z1[4 * rho + 3]) + g);
          }
        }
        kv_load(kv, kb + (size_t)jn * 64 * 128, 128, vb + jn * 64, SEQ);
        pv_tile(o, lv, z0, z1);
        if (__all(carry < -104.f * LOG2E) && (opq(threadIdx.x) & 63) == 0) dflag[wv] = 1u;
      }
    }
    int t2 = t;
    asm volatile("" : "+v"(t2));
    bf16_t* orow = p.omix + (size_t)(b * SEQ + t2) * DM + 1024 + hd * 128;
    oacc_foreach(o, [&](int d, float v0, float v1, float v2, float v3) {
      uint2 u;
      u.x = pack2(v0, v1);
      u.y = pack2(v2, v3);
      *(uint2*)(orow + d) = u;
    });
  }
}

#define NSA_IMP 32768
#define NSA_KEYS 49152
#define NSA_SELM 53504
#define NSA_LUT 53632
__device__ __forceinline__ void ph_nsa2(const P& p, char* lds) {
  typedef __attribute__((ext_vector_type(4))) float f32x4;
  char* lk = lds;
  char* lv = lds + 16384;
  float* imp = (float*)(lds + NSA_IMP);
  float* keys = (float*)(lds + NSA_KEYS);
  unsigned* selm = (unsigned*)(lds + NSA_SELM);
  const int tid = opq(threadIdx.x), lane = tid & 63, wv = tid >> 6, hh = lane >> 5, ql = lane & 31;
  float* lut = (float*)(lds + NSA_LUT) + wv * 128;
  for (int item = blockIdx.x; item < NBATCH * 2 * (SEQ / 32); item += gridDim.x) {
    const int tt = (item < 256) ? (SEQ / 32 - 1) - (item % (SEQ / 32)) : (item % (SEQ / 32));
    const int bg = item / (SEQ / 32);
    const int b = bg >> 1, g = bg & 1;
    const int h = g * 4 + wv;
    const int t0 = tt * 32, tq = t0 + ql, cur = t0 >> 6;
    __syncthreads();
    QFrag q;
    q_load(q, p.qn + (size_t)(b * SEQ + tq) * 1024 + h * 128);
    {
      const int lo = opq(lane);
      lut[lo] = p.t5[t5_bucket(lo) * 8 + h] * LOG2E;
      lut[lo + 64] = p.t5[t5_bucket(lo + 64) * 8 + h] * LOG2E;
    }
#pragma unroll
    for (int i = 0; i < 16; ++i) imp[i * 256 + tid] = 0.f;
    if (tid < 32) selm[tid] = 0u;
    const float* grow = p.gates + (size_t)(b * SEQ + tq) * 24 + h * 3;
    float* prow = p.part + (size_t)(b * SEQ + tq) * 1024 + h * 128;
    OAcc o;
    float m, l;
    KVRegs kv;
    {
      const bf16_t* kb = p.kcb + (size_t)bg * 128 * 128;
      const bf16_t* vb = p.vcT + (size_t)bg * 128 * 128;
      oacc_zero(o);
      m = NEG_BIG; l = 0.f;
      kv_load(kv, kb, 128, vb, 128);
      __syncthreads();
      kv_store(kv, lk, lv);
      __syncthreads();
      f32x16 x0, x1;
      qk_tile(q, lk, x0, x1);
      int tqv = tq;
      asm volatile("" : "+v"(tqv));
      tqv -= 64 * hh;
      if (t0 >= 1152) {
        const float b31 = lut[127];
#pragma unroll
        for (int r = 0; r < 16; ++r) { x0[r] = x0[r] * ATT_SCALE2 + b31; x1[r] = x1[r] * ATT_SCALE2 + b31; }
      } else {
#pragma unroll
        for (int r = 0; r < 16; ++r) {
          const int c = 8 * (r >> 2) + (r & 3);
          const int d0 = tqv - 16 * c - 31, d1 = d0 - 512;
          x0[r] = (d0 >= 0) ? x0[r] * ATT_SCALE2 + lut[min(d0, 127)] : -INFINITY;
          x1[r] = (d1 >= 0) ? x1[r] * ATT_SCALE2 + lut[min(d1, 127)] : -INFINITY;
        }
      }
      softmax_tile(x0, x1, m, l, o);
      const float m0 = m;
      pv_tile(o, lv, x0, x1);
      f32x16 z0, z1;
#pragma unroll
      for (int r = 0; r < 16; ++r) { z0[r] = 0.f; z1[r] = 0.f; }
      if (t0 >= 1024) {
        kv_load(kv, kb + 64 * 128, 128, vb + 64, 128);
        __syncthreads();
        kv_store(kv, lk, lv);
        __syncthreads();
        qk_tile(q, lk, z0, z1);
        asm volatile("" : "+v"(tqv));
#pragma unroll
        for (int r = 0; r < 16; ++r) {
          const int c = 64 + 8 * (r >> 2) + (r & 3);
          const int d0 = tqv - 16 * c - 31, d1 = d0 - 512;
          z0[r] = (d0 >= 0) ? z0[r] * ATT_SCALE2 + lut[min(d0, 127)] : -INFINITY;
          z1[r] = (d1 >= 0) ? z1[r] * ATT_SCALE2 + lut[min(d1, 127)] : -INFINITY;
        }
        softmax_tile(z0, z1, m, l, o);
        pv_tile(o, lv, z0, z1);
      }
      const float inv = 1.f / fmaxf(l, 1e-20f);
      const float c0 = __builtin_amdgcn_exp2f(m0 - m) * inv;
#pragma unroll
      for (int r = 0; r < 16; ++r) {
        const int c = 8 * (r >> 2) + (r & 3) + 4 * hh;
        if (x0[r] != 0.f) atomicAdd(&imp[(c) * 32 + ql], x0[r] * c0);
        if (x1[r] != 0.f) atomicAdd(&imp[(c + 32) * 32 + ql], x1[r] * c0);
        if (z0[r] != 0.f) atomicAdd(&imp[(c + 64) * 32 + ql], z0[r] * inv);
        if (z1[r] != 0.f) atomicAdd(&imp[(c + 96) * 32 + ql], z1[r] * inv);
      }
      const float gs = inv / (1.f + __expf(-grow[0]));
      oacc_foreach(o, [&](int d, float v0, float v1, float v2, float v3) {
        f32x4 u = {v0 * gs, v1 * gs, v2 * gs, v3 * gs};
        *(f32x4*)(prow + d) = u;
      });
    }
    __syncthreads();
    {
      const int tido = opq(tid);
      const int qq = tido & 31, jg = tido >> 5;
#pragma unroll
      for (int jj = 0; jj < 4; ++jj) {
        const int j = jg * 4 + jj;
        float v = imp[(4 * j) * 32 + qq] + imp[(4 * j + 1) * 32 + qq] + imp[(4 * j + 2) * 32 + qq] + 0.5f * imp[(4 * j + 3) * 32 + qq];
        if (j > 0) v += 0.5f * imp[(4 * j - 1) * 32 + qq];
        const bool forced = (j == 0) || (j == cur) || (j == cur - 1);
        keys[qq * 33 + j] = forced ? 1e9f : ((j <= cur) ? v : -1e9f);
      }
      __syncthreads();
      unsigned bits = 0u;
#pragma unroll
      for (int jj = 0; jj < 4; ++jj) {
        const int j = jg * 4 + jj;
        const float kj = keys[qq * 33 + j];
        int rank = 0;
        for (int i = 0; i < 32; ++i) {
          const float ki = keys[qq * 33 + i];
          rank += (ki > kj || (ki == kj && i < j)) ? 1 : 0;
        }
        if (rank < 16 && j <= cur) bits |= 1u << j;
      }
      atomicOr(&selm[qq], bits);
      __syncthreads();
    }
    const unsigned mysel = selm[ql];
    unsigned um = mysel;
#pragma unroll
    for (int o2 = 16; o2 > 0; o2 >>= 1) um |= (unsigned)__shfl_xor((int)um, o2);
    um = (unsigned)__builtin_amdgcn_readfirstlane((int)um);
    {
      const bf16_t* kb = p.ks + (size_t)bg * SEQ * 128;
      const bf16_t* vb = p.vsT + (size_t)bg * 128 * SEQ;
      oacc_zero(o);
      m = NEG_BIG; l = 0.f;
      unsigned rem = um;
      int j = __builtin_ctz(rem);
      kv_load(kv, kb + (size_t)j * 64 * 128, 128, vb + j * 64, SEQ);
      while (rem) {
        j = __builtin_ctz(rem);
        rem &= rem - 1;
        const int jn = rem ? __builtin_ctz(rem) : j;
        __syncthreads();
        kv_store(kv, lk, lv);
        __syncthreads();
        f32x16 s0, s1;
        qk_tile(q, lk, s0, s1);
        const bool selq = (mysel >> j) & 1u;
        int tqv = tq;
        asm volatile("" : "+v"(tqv));
        if (j * 64 + 63 + 113 <= t0) {
          const float sc = selq ? ATT_SCALE2 : 0.f, bb = selq ? lut[127] : -INFINITY;
#pragma unroll
          for (int r = 0; r < 16; ++r) { s0[r] = s0[r] * sc + bb; s1[r] = s1[r] * sc + bb; }
        } else {
#pragma unroll
          for (int r = 0; r < 16; ++r) {
            const int d0 = tqv - (j * 64 + 8 * (r >> 2) + (r & 3) + 4 * hh), d1 = d0 - 32;
            s0[r] = (selq && d0 >= 0) ? s0[r] * ATT_SCALE2 + lut[min(d0, 127)] : -INFINITY;
            s1[r] = (selq && d1 >= 0) ? s1[r] * ATT_SCALE2 + lut[min(d1, 127)] : -INFINITY;
          }
        }
        kv_load(kv, kb + (size_t)jn * 64 * 128, 128, vb + jn * 64, SEQ);
        softmax_tile(s0, s1, m, l, o);
        pv_tile(o, lv, s0, s1);
      }
      const float gs = 1.f / (fmaxf(l, 1e-20f) * (1.f + __expf(-grow[1])));
      int qo = ql;
      asm volatile("" : "+v"(qo));
      float* pr2 = p.part + (size_t)(b * SEQ + t0 + qo) * 1024 + h * 128;
      oacc_foreach(o, [&](int d, float v0, float v1, float v2, float v3) {
        f32x4 u = *(f32x4*)(pr2 + d);
        u[0] += v0 * gs; u[1] += v1 * gs; u[2] += v2 * gs; u[3] += v3 * gs;
        *(f32x4*)(pr2 + d) = u;
      });
    }
    {
      const bf16_t* kb = p.kw + (size_t)bg * SEQ * 128;
      const bf16_t* vb = p.vwT + (size_t)bg * 128 * SEQ;
      oacc_zero(o);
      m = NEG_BIG; l = 0.f;
      int jlo = (t0 - 511) >> 6;
      if (jlo < 0) jlo = 0;
      kv_load(kv, kb + (size_t)jlo * 64 * 128, 128, vb + jlo * 64, SEQ);
      for (int j = jlo; j <= cur; ++j) {
        const int jn = (j < cur) ? j + 1 : j;
        __syncthreads();
        kv_store(kv, lk, lv);
        __syncthreads();
        f32x16 s0, s1;
        qk_tile(q, lk, s0, s1);
        int tqv = tq;
        asm volatile("" : "+v"(tqv));
        if (j * 64 + 63 + 113 <= t0 && t0 + 31 - j * 64 < 512) {
          const float b31 = lut[127];
#pragma unroll
          for (int r = 0; r < 16; ++r) { s0[r] = s0[r] * ATT_SCALE2 + b31; s1[r] = s1[r] * ATT_SCALE2 + b31; }
        } else {
#pragma unroll
          for (int r = 0; r < 16; ++r) {
            const int d0 = tqv - (j * 64 + 8 * (r >> 2) + (r & 3) + 4 * hh), d1 = d0 - 32;
            s0[r] = (d0 >= 0 && d0 < 512) ? s0[r] * ATT_SCALE2 + lut[min(d0, 127)] : -INFINITY;
            s1[r] = (d1 >= 0 && d1 < 512) ? s1[r] * ATT_SCALE2 + lut[min(d1, 127)] : -INFINITY;
          }
        }
        kv_load(kv, kb + (size_t)jn * 64 * 128, 128, vb + jn * 64, SEQ);
        softmax_tile(s0, s1, m, l, o);
        pv_tile(o, lv, s0, s1);
      }
      const float gs = 1.f / (fmaxf(l, 1e-20f) * (1.f + __expf(-grow[2])));
      int qo = ql;
      asm volatile("" : "+v"(qo));
      const float* pr2 = p.part + (size_t)(b * SEQ + t0 + qo) * 1024 + h * 128;
      bf16_t* orow = p.omix + (size_t)(b * SEQ + t0 + qo) * DM + h * 128;
      oacc_foreach(o, [&](int d, float v0, float v1, float v2, float v3) {
        const f32x4 u = *(const f32x4*)(pr2 + d);
        uint2 w;
        w.x = pack2(u[0] + v0 * gs, u[1] + v1 * gs);
        w.y = pack2(u[2] + v2 * gs, u[3] + v3 * gs);
        *(uint2*)(orow + d) = w;
      });
    }
  }
}

__device__ __forceinline__ void ph_cvt(const float* src, bf16_t* dst, size_t n) {
  typedef __attribute__((ext_vector_type(4))) float f32x4;
  const size_t nv = n / 8;
  for (size_t i = (size_t)blockIdx.x * 256 + opq(threadIdx.x); i < nv; i += (size_t)gridDim.x * 256) {
    const f32x4 a = ((const f32x4*)src)[2 * i], b = ((const f32x4*)src)[2 * i + 1];
    u32x4 o;
    o[0] = pack2(a[0], a[1]); o[1] = pack2(a[2], a[3]); o[2] = pack2(b[0], b[1]); o[3] = pack2(b[2], b[3]);
    ((u32x4*)dst)[i] = o;
  }
}

__device__ __forceinline__ void ph_scores(const P& p, char* lds) {
  for (int u = blockIdx.x; u < 64 * 16; u += gridDim.x) {
    const int tm = u & 63, hp = u >> 6;
    const int m0 = tm * 128;
    float* sc = p.scores + (size_t)m0 * DM + hp * 128;
    gemm_tile_bf16<false>(p.omix + (size_t)m0 * DM + hp * 128, DM, p.subkb + (size_t)hp * 128 * 128, 128, 128, lds,
                          [&](int r, int c, float val) { sc[(size_t)r * DM + c] = val; });
  }
}

__device__ __forceinline__ void ph_qp_scores(const P& p, char* lds) {
  const int ntm = T_TOK / 256, ntn = DM / 128;
  const int npm = (ntm + 7) / 8, npn = (ntn + 7) / 8;
  const int nslots = ((npm * npn * 64 + 511) / 512) * 512;
  for (int u = blockIdx.x; u < nslots; u += gridDim.x) {
    int v = (u & 7) * 64 + ((u >> 3) & 63) + (u & ~511);
    int patch = v >> 6, w = v & 63;
    int tm = (patch % npm) * 8 + (w & 7);
    int tn = (patch / npm) * 8 + (w >> 3);
    if (tm >= ntm || tn >= ntn) continue;
    const int m0 = tm * 256, n0 = tn * 128;
    bf16_t* qp = p.omix + (size_t)m0 * DM + n0;
    const float* rss = p.rowss + T_TOK + m0;
    gemm_tile_big(p.hn + (size_t)m0 * DM, DM, p.WpqT + (size_t)n0 * DM, DM, DM, lds,
                  [&](int r, int c, f32x4_e lo, f32x4_e hi) {
                    const float rs = rsqrtf(rss[r] * (1.f / DM) + RMS_EPS);
                    st_bf16x8(qp + (size_t)r * DM + c, lo * rs, hi * rs); });
    __threadfence_block();
    __syncthreads();
    float* sc = p.scores + (size_t)m0 * DM + n0;
    gemm_tile_big(qp, DM, p.subkb + (size_t)tn * 128 * 128, 128, 128, lds,
                  [&](int r, int c, f32x4_e lo, f32x4_e hi) {
                    *(f32x4_e*)(sc + (size_t)r * DM + c) = lo; *(f32x4_e*)(sc + (size_t)r * DM + c + 4) = hi; });
  }
}

__device__ __forceinline__ void ph_cvt4(const float* src, unsigned char* dst, float* scales, int nrows, int wid0, int nw) {
  typedef __attribute__((ext_vector_type(4))) float f32x4;
  typedef __attribute__((ext_vector_type(2))) float f32x2;
  const int lane = opq(threadIdx.x) & 63;
  const float one = __uint_as_float((unsigned)opq(0x3F800000));
  float lev[8];
#pragma unroll
  for (int c = 0; c < 8; ++c) {
    const f32x2 q = __builtin_amdgcn_cvt_scalef32_pk_f32_fp4((unsigned)opq(c * 0x11111111), one, 0);
    lev[c] = fabsf(q[0]);
  }
  const float maxlev = lev[7];
  for (int row = wid0; row < nrows; row += nw) {
    const f32x4* s4 = (const f32x4*)(src + (size_t)row * DM) + lane * 8;
    f32x4 v[8];
    float amax = 0.f;
#pragma unroll
    for (int i = 0; i < 8; ++i) {
      v[i] = s4[i];
#pragma unroll
      for (int k = 0; k < 4; ++k) amax = fmaxf(amax, fabsf(v[i][k]));
    }
    amax = wave_max(amax);
    const float sc = (amax > 0.f) ? maxlev / amax : 1.f;
    u32x4 o;
#pragma unroll
    for (int w = 0; w < 4; ++w) {
      unsigned pk = 0u;
      pk = __builtin_amdgcn_cvt_scalef32_pk_fp4_f32(pk, v[2 * w][0] * sc, v[2 * w][1] * sc, 1.0f, 0);
      pk = __builtin_amdgcn_cvt_scalef32_pk_fp4_f32(pk, v[2 * w][2] * sc, v[2 * w][3] * sc, 1.0f, 1);
      pk = __builtin_amdgcn_cvt_scalef32_pk_fp4_f32(pk, v[2 * w + 1][0] * sc, v[2 * w + 1][1] * sc, 1.0f, 2);
      pk = __builtin_amdgcn_cvt_scalef32_pk_fp4_f32(pk, v[2 * w + 1][2] * sc, v[2 * w + 1][3] * sc, 1.0f, 3);
      o[w] = pk;
    }
    *(u32x4*)(dst + (size_t)row * 1024 + lane * 16) = o;
    if (lane == 0) scales[row] = (amax > 0.f) ? amax / maxlev : 1.f;
  }
}

__device__ __forceinline__ u32x4 r4_load(const unsigned char* tab, int eid, int lane) {
  return *((const u32x4*)(tab + (size_t)eid * 1024) + lane);
}
struct XPk { f32x16 a, b; };
struct Acc32 { f32x16 a, b; };

#define R4_DOT_W(word, xv, base, pa, pb)                                                             \
  {                                                                                                  \
    typedef __attribute__((ext_vector_type(2))) float f32x2;                                         \
    const f32x2 q0 = __builtin_amdgcn_cvt_scalef32_pk_f32_fp4(word, one, 0), q1 = __builtin_amdgcn_cvt_scalef32_pk_f32_fp4(word, one, 1); \
    const f32x2 q2 = __builtin_amdgcn_cvt_scalef32_pk_f32_fp4(word, one, 2), q3 = __builtin_amdgcn_cvt_scalef32_pk_f32_fp4(word, one, 3); \
    pa += q0[0] * xv[base + 0] + q0[1] * xv[base + 1]; pb += q1[0] * xv[base + 2] + q1[1] * xv[base + 3]; \
    pa += q2[0] * xv[base + 4] + q2[1] * xv[base + 5]; pb += q3[0] * xv[base + 6] + q3[1] * xv[base + 7]; \
  }
__device__ __forceinline__ float r4_dot(const u32x4& e, const XPk& x) {
  const float one = __uint_as_float((unsigned)opq(0x3F800000));
  float pa = 0.f, pb = 0.f;
  R4_DOT_W(e[0], x.a, 0, pa, pb) R4_DOT_W(e[1], x.a, 8, pa, pb) R4_DOT_W(e[2], x.b, 0, pa, pb) R4_DOT_W(e[3], x.b, 8, pa, pb)
  return pa + pb;
}
#define R4_AXPY_W(word, accv, base)                                                                  \
  {                                                                                                  \
    typedef __attribute__((ext_vector_type(2))) float f32x2;                                         \
    const f32x2 q0 = __builtin_amdgcn_cvt_scalef32_pk_f32_fp4(word, one, 0), q1 = __builtin_amdgcn_cvt_scalef32_pk_f32_fp4(word, one, 1); \
    const f32x2 q2 = __builtin_amdgcn_cvt_scalef32_pk_f32_fp4(word, one, 2), q3 = __builtin_amdgcn_cvt_scalef32_pk_f32_fp4(word, one, 3); \
    accv[base + 0] += hid * q0[0]; accv[base + 1] += hid * q0[1]; accv[base + 2] += hid * q1[0]; accv[base + 3] += hid * q1[1]; \
    accv[base + 4] += hid * q2[0]; accv[base + 5] += hid * q2[1]; accv[base + 6] += hid * q3[0]; accv[base + 7] += hid * q3[1]; \
  }
__device__ __forceinline__ void r4_axpy(const u32x4& e, float hid, Acc32& acc) {
  const float one = __uint_as_float((unsigned)opq(0x3F800000));
  R4_AXPY_W(e[0], acc.a, 0) R4_AXPY_W(e[1], acc.a, 8) R4_AXPY_W(e[2], acc.b, 0) R4_AXPY_W(e[3], acc.b, 8)
}

#define INS16(K, x)                                                                                      \
  K##15 = __builtin_amdgcn_fmed3f(K##15, K##14, x); K##14 = __builtin_amdgcn_fmed3f(K##14, K##13, x);   \
  K##13 = __builtin_amdgcn_fmed3f(K##13, K##12, x); K##12 = __builtin_amdgcn_fmed3f(K##12, K##11, x);   \
  K##11 = __builtin_amdgcn_fmed3f(K##11, K##10, x); K##10 = __builtin_amdgcn_fmed3f(K##10, K##9, x);    \
  K##9 = __builtin_amdgcn_fmed3f(K##9, K##8, x); K##8 = __builtin_amdgcn_fmed3f(K##8, K##7, x);         \
  K##7 = __builtin_amdgcn_fmed3f(K##7, K##6, x); K##6 = __builtin_amdgcn_fmed3f(K##6, K##5, x);         \
  K##5 = __builtin_amdgcn_fmed3f(K##5, K##4, x); K##4 = __builtin_amdgcn_fmed3f(K##4, K##3, x);         \
  K##3 = __builtin_amdgcn_fmed3f(K##3, K##2, x); K##2 = __builtin_amdgcn_fmed3f(K##2, K##1, x);         \
  K##1 = __builtin_amdgcn_fmed3f(K##1, K##0, x); K##0 = fmaxf(K##0, x);
#define DECL16(K) float K##0 = -INFINITY, K##1 = -INFINITY, K##2 = -INFINITY, K##3 = -INFINITY, K##4 = -INFINITY, \
  K##5 = -INFINITY, K##6 = -INFINITY, K##7 = -INFINITY, K##8 = -INFINITY, K##9 = -INFINITY, K##10 = -INFINITY,   \
  K##11 = -INFINITY, K##12 = -INFINITY, K##13 = -INFINITY, K##14 = -INFINITY, K##15 = -INFINITY;
__device__ __forceinline__ float mkkey(float v, unsigned tag, unsigned mask) {
  return __uint_as_float((__float_as_uint(v) & ~mask) | tag);
}

__device__ __forceinline__ void ph_peer(const P& p, float* smem) {
  typedef __attribute__((ext_vector_type(4))) float f32x4;
  float* lists = smem;
  int* bexA = (int*)(smem + 4096);
  float* bgtA = smem + 6144;
  float* bsuA = smem + 8192;
  for (int item = blockIdx.x; item < T_TOK / 16; item += gridDim.x) {
    const int t0 = item * 16;
    __syncthreads();
    {
      const int tid = opq(threadIdx.x);
      const int tl = tid >> 4, hp = tid & 15;
      const f32x4* sp = (const f32x4*)(p.scores + (size_t)(t0 + tl) * DM + hp * 128);
      DECL16(k)
#pragma unroll 4
      for (int c4 = 0; c4 < 32; ++c4) {
        const f32x4 v = sp[c4];
#pragma unroll
        for (int e = 0; e < 4; ++e) {
          const float x = mkkey(v[e], 127u - (unsigned)(c4 * 4 + e), 127u);
          INS16(k, x)
        }
      }
      f32x4* lp = (f32x4*)(lists + (size_t)opq(threadIdx.x) * 16);
      f32x4 o0 = {k0, k1, k2, k3}, o1 = {k4, k5, k6, k7}, o2 = {k8, k9, k10, k11}, o3 = {k12, k13, k14, k15};
      lp[0] = o0; lp[1] = o1; lp[2] = o2; lp[3] = o3;
    }
    __syncthreads();
    if (opq(threadIdx.x) < 128) {
      const int tid = opq(threadIdx.x);
      const int tl = tid >> 3, h = tid & 7;
      const float* la = lists + (size_t)(tl * 16 + 2 * h) * 16;
      const float* lb = la + 16;
      float av[16], bv[16];
#pragma unroll
      for (int i = 0; i < 16; ++i) {
        av[i] = __uint_as_float(__float_as_uint(la[i]) & ~127u);
        bv[i] = __uint_as_float(__float_as_uint(lb[i]) & ~127u);
      }
      DECL16(c)
#pragma unroll
      for (int i = 0; i < 16; ++i) {
#pragma unroll
        for (int j = 0; j < 16; ++j) {
          if ((i + 1) * (j + 1) <= 16) {
            const float x = mkkey(av[i] + bv[j], 255u - (unsigned)(i * 16 + j), 255u);
            INS16(c, x)
          }
        }
      }
      float cs[16] = {c0, c1, c2, c3, c4, c5, c6, c7, c8, c9, c10, c11, c12, c13, c14, c15};
      float ev[16];
      float sum = 0.f;
      const float mx = __uint_as_float(__float_as_uint(cs[0]) & ~255u);
#pragma unroll
      for (int n = 0; n < 16; ++n) {
        ev[n] = __expf(__uint_as_float(__float_as_uint(cs[n]) & ~255u) - mx);
        sum += ev[n];
      }
      const float isum = 1.f / sum;
#pragma unroll
      for (int n = 0; n < 16; ++n) {
        const unsigned cc = 255u - (__float_as_uint(cs[n]) & 255u);
        const unsigned ka = 127u - (__float_as_uint(la[cc >> 4]) & 127u);
        const unsigned kb = 127u - (__float_as_uint(lb[cc & 15u]) & 127u);
        const int eid = (int)(ka * 128u + kb);
        bexA[tl * 128 + h * 16 + n] = eid;
        bgtA[tl * 128 + h * 16 + n] = ev[n] * isum * p.sv8[eid];
        bsuA[tl * 128 + h * 16 + n] = p.su8[eid];
      }
    }
    __syncthreads();
#pragma unroll 1
    for (int ti4 = 0; ti4 < 4; ++ti4) {
    const int lane = opq(threadIdx.x) & 63, wv = opq(threadIdx.x) >> 6;
    const int tl = wv * 4 + ti4;
    const int t = t0 + tl;
    const int* bex = bexA + tl * 128;
    const float* bgt = bgtA + tl * 128;
    const float* bsu = bsuA + tl * 128;
    XPk x;
    {
      const f32x4* s4 = (const f32x4*)(p.out + (size_t)t * DM) + lane * 8;
      const f32x4* g4 = (const f32x4*)p.norm_ffn + lane * 8;
      f32x4 a0 = s4[0], a1 = s4[1], a2 = s4[2], a3 = s4[3], a4 = s4[4], a5 = s4[5], a6 = s4[6], a7 = s4[7];
      float ss = 0.f;
#define SSQ(v) ss += v[0] * v[0] + v[1] * v[1] + v[2] * v[2] + v[3] * v[3];
      SSQ(a0) SSQ(a1) SSQ(a2) SSQ(a3) SSQ(a4) SSQ(a5) SSQ(a6) SSQ(a7)
#undef SSQ
      ss = wave_sum(ss);
      const float rs = rsqrtf(ss * (1.f / DM) + RMS_EPS);
#define XPK(dst, base, va, vb, gi)                                                    \
  {                                                                                   \
    const f32x4 ga = g4[gi], gb = g4[gi + 1];                                         \
    dst[base + 0] = bf2f(f2bf(va[0] * rs * ga[0])); dst[base + 1] = bf2f(f2bf(va[1] * rs * ga[1]));   \
    dst[base + 2] = bf2f(f2bf(va[2] * rs * ga[2])); dst[base + 3] = bf2f(f2bf(va[3] * rs * ga[3]));   \
    dst[base + 4] = bf2f(f2bf(vb[0] * rs * gb[0])); dst[base + 5] = bf2f(f2bf(vb[1] * rs * gb[1]));   \
    dst[base + 6] = bf2f(f2bf(vb[2] * rs * gb[2])); dst[base + 7] = bf2f(f2bf(vb[3] * rs * gb[3]));   \
  }
      XPK(x.a, 0, a0, a1, 0) XPK(x.a, 8, a2, a3, 2) XPK(x.b, 0, a4, a5, 4) XPK(x.b, 8, a6, a7, 6)
#undef XPK
    }
    Acc32 acc;
#pragma unroll
    for (int r = 0; r < 16; ++r) { acc.a[r] = 0.f; acc.b[r] = 0.f; }
    u32x4 u0 = r4_load(p.pu8, bex[0], lane), u1 = r4_load(p.pu8, bex[1], lane), u2 = r4_load(p.pu8, bex[2], lane), u3 = r4_load(p.pu8, bex[3], lane);
    u32x4 v0 = r4_load(p.pv8, bex[0], lane), v1 = r4_load(p.pv8, bex[1], lane), v2 = r4_load(p.pv8, bex[2], lane), v3 = r4_load(p.pv8, bex[3], lane);
#pragma unroll 1
    for (int e0 = 0; e0 < 128; e0 += 4) {
      float d0 = r4_dot(u0, x), d1 = r4_dot(u1, x), d2 = r4_dot(u2, x), d3 = r4_dot(u3, x);
      const int en = (e0 + 4 < 128) ? e0 + 4 : 124;
      const int i0 = bex[en], i1 = bex[en + 1], i2 = bex[en + 2], i3 = bex[en + 3];
      u0 = r4_load(p.pu8, i0, lane); u1 = r4_load(p.pu8, i1, lane); u2 = r4_load(p.pu8, i2, lane); u3 = r4_load(p.pu8, i3, lane);
#pragma unroll
      for (int o = 32; o > 0; o >>= 1) {
        d0 += __shfl_xor(d0, o); d1 += __shfl_xor(d1, o); d2 += __shfl_xor(d2, o); d3 += __shfl_xor(d3, o);
      }
      { const float hid = bgt[e0 + 0] * gelu_fast(d0 * bsu[e0 + 0]); r4_axpy(v0, hid, acc); }
      { const float hid = bgt[e0 + 1] * gelu_fast(d1 * bsu[e0 + 1]); r4_axpy(v1, hid, acc); }
      { const float hid = bgt[e0 + 2] * gelu_fast(d2 * bsu[e0 + 2]); r4_axpy(v2, hid, acc); }
      { const float hid = bgt[e0 + 3] * gelu_fast(d3 * bsu[e0 + 3]); r4_axpy(v3, hid, acc); }
      v0 = r4_load(p.pv8, i0, lane); v1 = r4_load(p.pv8, i1, lane); v2 = r4_load(p.pv8, i2, lane); v3 = r4_load(p.pv8, i3, lane);
    }
    const int lane2 = opq(lane);
    f32x4* o4 = (f32x4*)(p.out + (size_t)t * DM) + lane2 * 8;
    const f32x4* g4 = (const f32x4*)p.norm_final + lane2 * 8;
    f32x4 hv[8];
    float ss = 0.f;
#pragma unroll
    for (int i = 0; i < 8; ++i) {
      hv[i] = o4[i];
#pragma unroll
      for (int k = 0; k < 4; ++k) {
        hv[i][k] += (i < 4) ? acc.a[4 * i + k] : acc.b[4 * (i - 4) + k];
        ss += hv[i][k] * hv[i][k];
      }
    }
    ss = wave_sum(ss);
    const float rs = rsqrtf(ss * (1.f / DM) + RMS_EPS);
#pragma unroll
    for (int i = 0; i < 8; ++i) {
      const f32x4 g = g4[i];
      f32x4 o;
#pragma unroll
      for (int k = 0; k < 4; ++k) o[k] = hv[i][k] * rs * g[k];
      o4[i] = o;
    }
    }
  }
}

#define XB_TMO      128
#define XB_XCNT(j)  (256  + 64 * (j))
#define XB_XSUB(j)  (1280 + 64 * (j))
#define XB_XGEN(j)  (2304 + 64 * (j))
#define XB_TOP      3328
#define XB_TOPGEN   3392
#define XCD_BAR_WORDS 3456
#define XB_SPIN_CAP (1u << 22)
#define LAS __attribute__((address_space(3)))
__device__ __forceinline__ unsigned xb_ld(unsigned* p) { return __hip_atomic_load(p, __ATOMIC_RELAXED, __HIP_MEMORY_SCOPE_AGENT); }
__device__ __forceinline__ unsigned xb_add(unsigned* p, unsigned v) { return __hip_atomic_fetch_add(p, v, __ATOMIC_RELAXED, __HIP_MEMORY_SCOPE_AGENT); }
__device__ __forceinline__ unsigned xb_xcc_id() { return (unsigned)__builtin_amdgcn_s_getreg((3 << 11) | 20) & 0xFu; }
#define XB_SPIN(cond, bar) do { unsigned _sp = 0; while (cond) { __builtin_amdgcn_s_sleep(1); \
    if ((++_sp & 255u) == 0u) { if (xb_ld(&(bar)[XB_TMO])) break; if (_sp > XB_SPIN_CAP) { atomicAdd(&(bar)[XB_TMO], 1u); break; } } } } while (0)
struct XcdBarrier { unsigned* bar; unsigned x; volatile LAS unsigned* st; };
__device__ __forceinline__ XcdBarrier xcd_barrier_post(unsigned* bar, volatile LAS unsigned* st) {
  XcdBarrier b; b.bar = bar; b.x = xb_xcc_id(); b.st = st;
  if (threadIdx.x == 0) (void)xb_add(&bar[XB_XCNT(b.x)], 1u);
  return b;
}
__device__ __forceinline__ void xcd_barrier_complete(unsigned* bar, unsigned x, unsigned& nloc, unsigned& nx) {
  const unsigned G = gridDim.x * gridDim.y * gridDim.z;
  unsigned sum, cnt, mine, sp = 0u;
  for (;;) {
    sum = 0u; cnt = 0u; mine = 0u;
#pragma unroll
    for (unsigned j = 0; j < 16; ++j) { const unsigned c = xb_ld(&bar[XB_XCNT(j)]); sum += c; cnt += (c > 0u) ? 1u : 0u; mine = (j == x) ? c : mine; }
    if (sum == G) break;
    __builtin_amdgcn_s_sleep(1);
    if ((++sp & 255u) == 0u) { if (xb_ld(&bar[XB_TMO])) break; if (sp > XB_SPIN_CAP) { atomicAdd(&bar[XB_TMO], 1u); break; } }
  }
  nloc = mine > 0u ? mine : 1u; nx = cnt > 0u ? cnt : 1u;
}
__device__ __forceinline__ void xcd_barrier(const XcdBarrier& b) {
  asm volatile("s_waitcnt vmcnt(0)" ::: "memory");
  __syncthreads();
  if (threadIdx.x == 0) {
    unsigned* bar = b.bar;
    __builtin_amdgcn_s_waitcnt(0);
    unsigned nloc = b.st[0], nx = b.st[1];
    if (nloc == 0u) { xcd_barrier_complete(bar, b.x, nloc, nx); b.st[0] = nloc; b.st[1] = nx; }
    const unsigned old = xb_add(&bar[XB_XSUB(b.x)], 1u);
    const unsigned gen = old / nloc;
    if (old + 1u == (gen + 1u) * nloc) {
      __builtin_amdgcn_fence(__ATOMIC_RELEASE, "agent");
      asm volatile("s_waitcnt vmcnt(0)" ::: "memory");
      const unsigned og = xb_add(&bar[XB_TOP], 1u);
      const unsigned tg = og / nx;
      if (og + 1u == (tg + 1u) * nx) xb_add(&bar[XB_TOPGEN], 1u);
      else XB_SPIN(xb_ld(&bar[XB_TOPGEN]) == tg, bar);
      __builtin_amdgcn_fence(__ATOMIC_ACQUIRE, "agent");
      xb_add(&bar[XB_XGEN(b.x)], 1u);
      asm volatile("s_waitcnt vmcnt(0)" ::: "memory");
    } else {
      XB_SPIN(xb_ld(&bar[XB_XGEN(b.x)]) == gen, bar);
      __builtin_amdgcn_fence(__ATOMIC_ACQUIRE, "agent");
      asm volatile("s_waitcnt vmcnt(0)" ::: "memory");
    }
  }
  __syncthreads();
}

typedef const __attribute__((address_space(4))) P* KP;
__device__ __forceinline__ P loadP() {
#if defined(__HIP_DEVICE_COMPILE__)
  KP k = (KP)__builtin_amdgcn_kernarg_segment_ptr();
  asm volatile("" : "+s"(k));
  P p = *k;
  return p;
#else
  return P{};
#endif
}

__global__ void __launch_bounds__(256, 2) mega(P p_arg) {
  cg::grid_group grid = cg::this_grid();
  __shared__ __attribute__((aligned(16))) float smem[18432];
  char* lds = (char*)smem;
  __shared__ uint4 xb_words;
  if (threadIdx.x == 0) xb_words = make_uint4(0u, 0u, 0u, 0u);
  if (blockIdx.x == 0) {
    P p = loadP();
    for (int i = threadIdx.x; i < XCD_BAR_WORDS; i += 256) p.bar[i] = 0u;
  }
  { P p = loadP(); ph_rmsnorm(p.x, p.norm_mix, p.hn, T_TOK); ph_rmsnorm(p.mem, p.norm_mkv, p.memn, 1024); }
  { P p = loadP(); ph_transpose<true>(smem, p.w_in, DM, INC, 5760, p.WinT); }
  { P p = loadP(); ph_transpose<false>(smem, p.w_mk, DM, 512, 512, p.WmkT); }
  { P p = loadP(); ph_transpose<false>(smem, p.w_mv, DM, 512, 512, p.WmvT); }
  { P p = loadP(); ph_cvt(p.subk, p.subkb, (size_t)16 * 128 * 128); }
  { P p = loadP(); ph_transpose<false>(smem, p.w1_k, 4096, 128, 128, p.w1T); }
  { P p = loadP(); ph_transpose<false>(smem, p.w1_v, 4096, 128, 128, p.w1T + 128 * 4096); }
  { P p = loadP(); ph_transpose<false>(smem, p.w2_k, 128, 128, 128, p.w2T); }
  { P p = loadP(); ph_transpose<false>(smem, p.w2_v, 128, 128, 128, p.w2T + 128 * 128); }
  { P p = loadP(); ph_posb(p); }
  { P p = loadP(); for (int i = blockIdx.x * 256 + opq(threadIdx.x); i < 2 * T_TOK; i += gridDim.x * 256) p.rowss[i] = 0.f; }
  grid.sync();
  XcdBarrier xb;
  { P p = loadP(); xb = xcd_barrier_post(p.bar, (volatile LAS unsigned*)&xb_words); }
  { P p = loadP(); ph_proj(p, lds); }
  const int kvb = (gridDim.x == 512) ? (((int)blockIdx.x >= 320 && (int)blockIdx.x < 352) ? ((int)blockIdx.x - 320) * 8 : -1) : -2;
  const int vvb = (gridDim.x == 512) ? (((int)blockIdx.x >= 352 && (int)blockIdx.x < 384) ? ((int)blockIdx.x - 352) * 8 : -1) : -2;
  { P p = loadP(); bf16_t* kmem = p.kmemb;
    ph_gemm_bf16(p.memn, DM, p.WmkT, DM, 1024, 512, DM, lds, [=](int m, int n, float v) {
      kmem[((size_t)((m >> 8) * 4 + (n >> 7)) * 256 + (m & 255)) * 128 + (n & 127)] = f2bf(v); }, kvb); }
  { P p = loadP(); bf16_t* vmem = p.vmemT;
    ph_gemm_bf16(p.memn, DM, p.WmvT, DM, 1024, 512, DM, lds, [=](int m, int n, float v) {
      vmem[((size_t)((m >> 8) * 4 + (n >> 7)) * 128 + (n & 127)) * 256 + perm16(m & 255)] = f2bf(v); }, vvb); }
  xcd_barrier(xb);
  { P p = loadP(); ph_compress2(p, lds); }
  { P p = loadP(); ph_sb2(p, lds); }
  {
    const int skip = (gridDim.x > 32) ? 16 : 0;
    const int vb = ((int)blockIdx.x >= skip) ? (int)blockIdx.x - skip : -1, nvb = (int)gridDim.x - skip;
    __syncthreads();
    { P p = loadP(); ph_transpose<false>(smem, p.w_out, DM, DM, DM, p.WoutT, vb, nvb); }
    { P p = loadP(); ph_transpose<false>(smem, p.w_mq, DM, 512, 512, p.WmqT, vb, nvb); }
  }
  xcd_barrier(xb);
  { P p = loadP(); ph_nsa2(p, lds); }
  xcd_barrier(xb);
  { P p = loadP(); float* out = p.out; const float* x = p.x; const float* gmq = p.norm_mq; bf16_t* hn = p.hn; float* rss = p.rowss;
    ph_gemm_big(p.omix, DM, p.WoutT, DM, T_TOK, DM, DM, lds, [=](int m, int n, f32x4_e lo, f32x4_e hi) {
      const f32x4_e x0 = *(const f32x4_e*)(x + (size_t)m * DM + n), x1 = *(const f32x4_e*)(x + (size_t)m * DM + n + 4);
      const f32x4_e h0 = x0 + lo, h1 = x1 + hi;
      *(f32x4_e*)(out + (size_t)m * DM + n) = h0; *(f32x4_e*)(out + (size_t)m * DM + n + 4) = h1;
      norm_feed(h0, h1, gmq, n, hn + (size_t)m * DM, rss + m); }); }
  xcd_barrier(xb);
  {
    const int half = (gridDim.x >= 512) ? 256 : 0;
    if (half == 0 || (int)blockIdx.x < half) { P p = loadP(); ph_memq_attn(p, lds, (int)blockIdx.x, half ? half : (int)gridDim.x); }
    if ((int)blockIdx.x >= half) {
      const int nwv = ((int)gridDim.x - half) * 4, wid = ((int)blockIdx.x - half) * 4 + (opq(threadIdx.x) >> 6);
      __syncthreads();
      { P p = loadP(); ph_transpose<false>(smem, p.w_mo, 512, DM, DM, p.WmoT, (int)blockIdx.x - half, (int)gridDim.x - half); }
      { P p = loadP(); ph_cvt4(p.pu, p.pu8, p.su8, 16384, wid, nwv); }
      { P p = loadP(); ph_cvt4(p.pv, p.pv8, p.sv8, 16384, wid, nwv); }
      __syncthreads();
      { P p = loadP(); ph_transpose<false>(smem, p.w_pq, DM, DM, DM, p.WpqT, (int)blockIdx.x - half, (int)gridDim.x - half); }
    }
  }
  xcd_barrier(xb);
  { P p = loadP(); float* out = p.out; const float* gffn = p.norm_ffn; bf16_t* hn = p.hn; float* rss = p.rowss + T_TOK;
    ph_gemm_big(p.omem, 512, p.WmoT, 512, T_TOK, DM, 512, lds, [=](int m, int n, f32x4_e lo, f32x4_e hi) {
      f32x4_e* o0 = (f32x4_e*)(out + (size_t)m * DM + n);
      const f32x4_e h0 = o0[0] + lo, h1 = o0[1] + hi;
      o0[0] = h0; o0[1] = h1;
      norm_feed(h0, h1, gffn, n, hn + (size_t)m * DM, rss + m); }); }
  xcd_barrier(xb);
  { P p = loadP(); ph_qp_scores(p, lds); }
  xcd_barrier(xb);
  { P p = loadP(); ph_peer(p, smem); }
}

extern "C" void kernel_launch(void* const* d_in, const int* in_sizes, int n_in, void* d_out, int out_size, void* d_ws,
                              size_t ws_size, hipStream_t stream) {
  P p{};
  p.x = (const float*)d_in[0]; p.mem = (const float*)d_in[1]; p.t5 = (const float*)d_in[2];
  p.norm_mix = (const float*)d_in[3]; p.w_in = (const float*)d_in[4]; p.pos_k = (const float*)d_in[5];
  p.w1_k = (const float*)d_in[6]; p.w2_k = (const float*)d_in[7]; p.pos_v = (const float*)d_in[8];
  p.w1_v = (const float*)d_in[9]; p.w2_v = (const float*)d_in[10]; p.w_out = (const float*)d_in[11];
  p.norm_mq = (const float*)d_in[12]; p.norm_mkv = (const float*)d_in[13]; p.w_mq = (const float*)d_in[14];
  p.w_mk = (const float*)d_in[15]; p.w_mv = (const float*)d_in[16]; p.w_mo = (const float*)d_in[17];
  p.norm_ffn = (const float*)d_in[18]; p.w_pq = (const float*)d_in[19]; p.subk = (const float*)d_in[20];
  p.pu = (const float*)d_in[21]; p.pv = (const float*)d_in[22]; p.norm_final = (const float*)d_in[23];
  p.out = (float*)d_out;
  char* w = (char*)d_ws;
  size_t off = 0;
  auto take = [&](size_t bytes) { char* r = w + off; off += (bytes + 255) & ~(size_t)255; return r; };
  p.bar = (unsigned*)take(XCD_BAR_WORDS * 4);
  p.scores = (float*)take((size_t)T_TOK * DM * 4);
  p.gates = (float*)take((size_t)T_TOK * 24 * 4);
  p.part = (float*)take((size_t)T_TOK * 1024 * 4);
  p.posb = (float*)take(256 * 4);
  p.rowss = (float*)take((size_t)2 * T_TOK * 4);
  p.qn = (bf16_t*)take((size_t)T_TOK * 1024 * 2);
  p.kcin = (bf16_t*)take((size_t)T_TOK * 256 * 2 + 65536);
  p.vcin = (bf16_t*)take((size_t)T_TOK * 256 * 2 + 65536);
  p.ks = (bf16_t*)take((size_t)T_TOK * 256 * 2);
  p.vsT = (bf16_t*)take((size_t)T_TOK * 256 * 2);
  p.kw = (bf16_t*)take((size_t)T_TOK * 256 * 2);
  p.vwT = (bf16_t*)take((size_t)T_TOK * 256 * 2);
  p.kcb = (bf16_t*)take((size_t)8 * 128 * 128 * 2);
  p.vcT = (bf16_t*)take((size_t)8 * 128 * 128 * 2);
  p.c1 = (bf16_t*)take((size_t)16 * 128 * 128 * 2);
  p.w1T = (bf16_t*)take((size_t)2 * 128 * 4096 * 2);
  p.w2T = (bf16_t*)take((size_t)2 * 128 * 128 * 2);
  p.hn = (bf16_t*)take((size_t)T_TOK * DM * 2);
  p.omix = (bf16_t*)take((size_t)T_TOK * DM * 2);
  p.memn = (bf16_t*)take((size_t)1024 * DM * 2);
  p.omem = (bf16_t*)take((size_t)T_TOK * 512 * 2);
  p.WinT = (bf16_t*)take((size_t)5760 * DM * 2);
  p.WoutT = (bf16_t*)take((size_t)DM * DM * 2);
  p.WpqT = (bf16_t*)take((size_t)DM * DM * 2);
  p.WmqT = (bf16_t*)take((size_t)512 * DM * 2);
  p.WmkT = (bf16_t*)take((size_t)512 * DM * 2);
  p.WmvT = (bf16_t*)take((size_t)512 * DM * 2);
  p.WmoT = (bf16_t*)take((size_t)DM * 512 * 2);
  p.qmemb = (bf16_t*)take((size_t)T_TOK * 512 * 2);
  p.kmemb = (bf16_t*)take((size_t)1024 * 512 * 2);
  p.vmemT = (bf16_t*)take((size_t)1024 * 512 * 2);
  p.qsb = (bf16_t*)take((size_t)T_TOK * 1024 * 2);
  p.ksb = (bf16_t*)take((size_t)T_TOK * 1024 * 2);
  p.vsbT = (bf16_t*)take((size_t)T_TOK * 1024 * 2);
  p.pu8 = (unsigned char*)take((size_t)16384 * 1024);
  p.pv8 = (unsigned char*)take((size_t)16384 * 1024);
  p.su8 = (float*)take(16384 * 4);
  p.sv8 = (float*)take(16384 * 4);
  p.subkb = (bf16_t*)take((size_t)16 * 128 * 128 * 2);
  static int grid_blocks = 0;
  if (!grid_blocks) {
    int dev = 0, cus = 0, per_cu = 0;
    (void)hipGetDevice(&dev);
    (void)hipDeviceGetAttribute(&cus, hipDeviceAttributeMultiprocessorCount, dev);
    (void)hipOccupancyMaxActiveBlocksPerMultiprocessor(&per_cu, mega, 256, 0);
    if (per_cu > 2) per_cu = 2;
    if (per_cu < 1) per_cu = 1;
    grid_blocks = cus * per_cu;
  }
  void* args[] = {&p};
  hipError_t e = hipLaunchCooperativeKernel((void*)mega, dim3(grid_blocks), dim3(256), args, 0, stream);
  if (e != hipSuccess) fprintf(stderr, "cooperative launch failed: %s (grid %d)\n", hipGetErrorString(e), grid_blocks);
}
```

```cpp
#include <hip/hip_runtime.h>
#include <hip/hip_cooperative_groups.h>
#include <cstdio>
namespace cg = cooperative_groups;
#include <stdint.h>

#define SEQ 2048
#define NBATCH 4
#define T_TOK 8192
#define DM 2048
#define INC 5656
#define C_QN 0
#define C_KC 1024
#define C_VC 1280
#define C_KS 1536
#define C_VS 1792
#define C_KW 2048
#define C_VW 2304
#define C_GT 2560
#define C_QSB 2584
#define C_KSB 3608
#define C_VSB 4632
#define ATT_SCALE 0.08838834764831845f
#define LOG2E 1.4426950408889634f
#define ATT_SCALE2 (ATT_SCALE * LOG2E)
#define RMS_EPS 1e-6f

typedef unsigned short bf16_t;
typedef __attribute__((ext_vector_type(8))) short bf16x8;
typedef __attribute__((ext_vector_type(16))) float f32x16;
typedef __attribute__((ext_vector_type(2))) __bf16 bf16v2;
typedef __attribute__((ext_vector_type(4))) unsigned u32x4;

struct P {
  const float *x, *mem, *t5, *norm_mix, *w_in, *pos_k, *w1_k, *w2_k, *pos_v, *w1_v, *w2_v, *w_out,
      *norm_mq, *norm_mkv, *w_mq, *w_mk, *w_mv, *w_mo, *norm_ffn, *w_pq, *subk, *pu, *pv, *norm_final;
  float* out;
  float *scores, *gates, *part, *posb, *rowss;
  unsigned* bar;
  bf16_t *hn, *omix, *memn, *omem;
  bf16_t *WinT, *WoutT, *WpqT, *WmqT, *WmkT, *WmvT, *WmoT;
  bf16_t *qmemb, *kmemb, *vmemT;
  bf16_t *qsb, *ksb, *vsbT;
  bf16_t* subkb;
  unsigned char *pu8, *pv8;
  float *su8, *sv8;
  bf16_t *qn, *kcin, *vcin, *ks, *vsT, *kw, *vwT, *kcb, *vcT, *c1, *w1T, *w2T;
};

__device__ __forceinline__ int opq(int v) { asm volatile("" : "+v"(v)); return v; }
__device__ __forceinline__ unsigned pack2(float a, float b) {
  bf16v2 r = {(__bf16)a, (__bf16)b};
  return *(unsigned*)&r;
}
__device__ __forceinline__ bf16_t f2bf(float a) {
  __bf16 r = (__bf16)a;
  return *(bf16_t*)&r;
}
__device__ __forceinline__ int perm16(int s) { return (s & ~12) | ((s & 4) << 1) | ((s & 8) >> 1); }
__device__ __forceinline__ float bf2f(bf16_t u) { return __uint_as_float((unsigned)u << 16); }

__device__ __forceinline__ float wave_max(float v) {
  for (int o = 32; o > 0; o >>= 1) v = fmaxf(v, __shfl_xor(v, o));
  return v;
}
__device__ __forceinline__ float wave_sum(float v) {
  for (int o = 32; o > 0; o >>= 1) v += __shfl_xor(v, o);
  return v;
}
__device__ __forceinline__ void wave_argmax(float& v, int& i) {
  for (int o = 32; o > 0; o >>= 1) {
    float ov = __shfl_xor(v, o);
    int oi = __shfl_xor(i, o);
    if (ov > v || (ov == v && oi < i)) { v = ov; i = oi; }
  }
}
__device__ __forceinline__ float gelu_tanh(float x) {
  return 0.5f * x * (1.f + tanhf(0.7978845608028654f * (x + 0.044715f * x * x * x)));
}
__device__ __forceinline__ float gelu_fast(float x) {
  const float y = 1.5957691216057308f * (x + 0.044715f * x * x * x);
  return x / (1.f + __expf(-y));
}
__device__ __forceinline__ int t5_bucket(int n) {
  if (n < 16) return n < 0 ? 0 : n;
  int b = 16;
  b += (n >= 19); b += (n >= 21); b += (n >= 24); b += (n >= 27); b += (n >= 31); b += (n >= 35);
  b += (n >= 40); b += (n >= 46); b += (n >= 52); b += (n >= 59); b += (n >= 67); b += (n >= 77);
  b += (n >= 87); b += (n >= 99); b += (n >= 113);
  return b;
}
__device__ __forceinline__ float log_sigmoid(float x) {
  return fminf(x, 0.f) - log1pf(expf(-fabsf(x)));
}

__device__ __forceinline__ void ph_rmsnorm(const float* src, const float* gain, bf16_t* dst, int rows) {
  int lane = opq(threadIdx.x) & 63, wv = opq(threadIdx.x) >> 6;
  for (int r = blockIdx.x * 4 + wv; r < rows; r += gridDim.x * 4) {
    const float4* s4 = (const float4*)(src + (size_t)r * DM);
    float4 v[8];
    float ss = 0.f;
#pragma unroll
    for (int i = 0; i < 8; ++i) {
      v[i] = s4[i * 64 + lane];
      ss += v[i].x * v[i].x + v[i].y * v[i].y + v[i].z * v[i].z + v[i].w * v[i].w;
    }
    ss = wave_sum(ss);
    float rs = rsqrtf(ss * (1.f / DM) + RMS_EPS);
    uint2* d2 = (uint2*)(dst + (size_t)r * DM);
    const float4* g4 = (const float4*)gain;
#pragma unroll
    for (int i = 0; i < 8; ++i) {
      float4 g = g4[i * 64 + lane];
      uint2 o;
      o.x = pack2(v[i].x * rs * g.x, v[i].y * rs * g.y);
      o.y = pack2(v[i].z * rs * g.z, v[i].w * rs * g.w);
      d2[i * 64 + lane] = o;
    }
  }
}

template <bool CMAP>
__device__ __forceinline__ void ph_transpose(float* smem, const float* W, int K, int N, int Npad, bf16_t* Wt,
                                             int vblock = -2, int nvb = 0) {
  typedef __attribute__((ext_vector_type(4))) float f32x4;
  float (*tl)[65] = (float (*)[65])smem;
  if (vblock == -1) return;
  const int b0 = (vblock >= 0) ? vblock : (int)blockIdx.x, bstride = (vblock >= 0) ? nvb : (int)gridDim.x;
  const int tid = opq(threadIdx.x);
  const int nk = K / 64, nn = Npad / 64;
  for (int tile = b0; tile < nk * nn; tile += bstride) {
    const int k0 = (tile % nk) * 64, n0 = (tile / nk) * 64;
    const int kr = tid >> 4, n4 = (tid & 15) * 4;
    int sc = n0 + n4;
    if (CMAP) sc = (sc < 2560) ? sc : (sc < 5632) ? sc + 24 : (sc < 5656) ? sc - 5632 + 2560 : N;
#pragma unroll
    for (int i = 0; i < 4; ++i) {
      const int k = kr + 16 * i;
      f32x4 v = {0.f, 0.f, 0.f, 0.f};
      if (sc < N) v = *(const f32x4*)(W + (size_t)(k0 + k) * N + sc);
      tl[k][n4 + 0] = v[0]; tl[k][n4 + 1] = v[1]; tl[k][n4 + 2] = v[2]; tl[k][n4 + 3] = v[3];
    }
    __syncthreads();
    int n = tid >> 2, kc = (tid & 3) * 16;
    unsigned w[8];
#pragma unroll
    for (int i = 0; i < 8; ++i) w[i] = pack2(tl[kc + 2 * i][n], tl[kc + 2 * i + 1][n]);
    uint4* dst = (uint4*)(Wt + (size_t)(n0 + n) * K + k0 + kc);
    dst[0] = make_uint4(w[0], w[1], w[2], w[3]);
    dst[1] = make_uint4(w[4], w[5], w[6], w[7]);
    __syncthreads();
  }
}

__device__ __forceinline__ int lds_off(int row, int chunk) { return row * 128 + ((chunk ^ ((row >> 1) & 7)) << 4); }

template <bool TR, bool VEC = false, class Epi>
__device__ __forceinline__ void gemm_tile_bf16(const bf16_t* xp, int ldx, const bf16_t* yp, int ldy, int K, char* lds,
                                               Epi epi) {
  const int tid = opq(threadIdx.x), lane = tid & 63, wv = tid >> 6;
  const int wr = wv >> 1, wc = wv & 1;
  f32x16 acc[2][2];
#pragma unroll
  for (int i = 0; i < 2; ++i)
#pragma unroll
    for (int j = 0; j < 2; ++j)
#pragma unroll
      for (int r = 0; r < 16; ++r) acc[i][j][r] = 0.f;
  const int prow = lane >> 3, pch = lane & 7;
  const bf16_t* xs[4];
  const bf16_t* ys[4];
#pragma unroll
  for (int ps = 0; ps < 4; ++ps) {
    const int row = (wv * 4 + ps) * 8 + prow;
    const int c = pch ^ ((row >> 1) & 7);
    xs[ps] = xp + (size_t)row * ldx + c * 8;
    ys[ps] = yp + (size_t)row * ldy + c * 8;
  }
  char* const mydst = lds + wv * 4096 + lane * 16;
#define GEMM_ISSUE(k0, bufoff)                                                                                              \
  _Pragma("unroll") for (int ps = 0; ps < 4; ++ps) {                                                                        \
    __builtin_amdgcn_global_load_lds((const unsigned*)(xs[ps] + (k0)), (unsigned*)(mydst + (bufoff) + ps * 1024), 16, 0, 0);         \
    __builtin_amdgcn_global_load_lds((const unsigned*)(ys[ps] + (k0)), (unsigned*)(mydst + (bufoff) + 16384 + ps * 1024), 16, 0, 0); \
  }
#define GEMM_COMPUTE(bufoff)                                                                                     \
  _Pragma("unroll") for (int kk = 0; kk < 4; ++kk) {                                                             \
    bf16x8 a[2], b[2];                                                                                           \
    const int ch = kk * 2 + (lane >> 5);                                                                         \
    _Pragma("unroll") for (int i = 0; i < 2; ++i) {                                                              \
      a[i] = *(const bf16x8*)(lds + (bufoff) + (TR ? 16384 : 0) + lds_off(wr * 64 + i * 32 + (lane & 31), ch)); \
      b[i] = *(const bf16x8*)(lds + (bufoff) + (TR ? 0 : 16384) + lds_off(wc * 64 + i * 32 + (lane & 31), ch)); \
    }                                                                                                            \
    _Pragma("unroll") for (int i = 0; i < 2; ++i)                                                                \
      _Pragma("unroll") for (int j = 0; j < 2; ++j)                                                              \
        acc[i][j] = __builtin_amdgcn_mfma_f32_32x32x16_bf16(a[i], b[j], acc[i][j], 0, 0, 0);                    \
  }
  __syncthreads();
  GEMM_ISSUE(0, 0)
  for (int k0 = 0; k0 < K; k0 += 128) {
    asm volatile("s_waitcnt vmcnt(0)" ::: "memory");
    __syncthreads();
    GEMM_ISSUE(k0 + 64, 32768)
    GEMM_COMPUTE(0)
    asm volatile("s_waitcnt vmcnt(0)" ::: "memory");
    __syncthreads();
    if (k0 + 128 < K) { GEMM_ISSUE(k0 + 128, 0) }
    GEMM_COMPUTE(32768)
  }
#undef GEMM_ISSUE
#undef GEMM_COMPUTE
  int lane2 = lane;
  asm volatile("" : "+v"(lane2));
  if constexpr (VEC) {
    typedef __attribute__((ext_vector_type(4))) float f32x4;
    __syncthreads();
    float* wl = (float*)lds + wv * (32 * 68);
    const int hh2 = lane2 >> 5, cl = lane2 & 31;
#pragma unroll
    for (int i = 0; i < 2; ++i) {
#pragma unroll
      for (int j = 0; j < 2; ++j)
#pragma unroll
        for (int r = 0; r < 16; ++r) wl[((r & 3) + 8 * (r >> 2) + 4 * hh2) * 68 + j * 32 + cl] = acc[i][j][r];
      __builtin_amdgcn_wave_barrier();
#pragma unroll
      for (int k = 0; k < 4; ++k) {
        const int row = (lane2 >> 3) + 8 * k, c8 = (lane2 & 7) * 8;
        const f32x4 lo = *(const f32x4*)&wl[row * 68 + c8];
        const f32x4 hi = *(const f32x4*)&wl[row * 68 + c8 + 4];
        epi(wr * 64 + i * 32 + row, wc * 64 + c8, lo, hi);
      }
      __builtin_amdgcn_wave_barrier();
    }
  } else {
#pragma unroll
    for (int i = 0; i < 2; ++i)
#pragma unroll
      for (int j = 0; j < 2; ++j)
#pragma unroll
        for (int r = 0; r < 16; ++r) {
          int rr = wr * 64 + i * 32 + (r & 3) + 8 * (r >> 2) + 4 * (lane2 >> 5);
          int cc = wc * 64 + j * 32 + (lane2 & 31);
          epi(rr, cc, acc[i][j][r]);
        }
  }
}

typedef __attribute__((ext_vector_type(4))) float f32x4_e;
__device__ __forceinline__ void st_bf16x8(bf16_t* dst, f32x4_e lo, f32x4_e hi) {
  u32x4 o;
  o[0] = pack2(lo[0], lo[1]); o[1] = pack2(lo[2], lo[3]); o[2] = pack2(hi[0], hi[1]); o[3] = pack2(hi[2], hi[3]);
  *(u32x4*)dst = o;
}

__device__ __forceinline__ int lds_off32(int row, int chunk) { return row * 64 + ((chunk ^ ((row >> 2) & 3)) << 4); }

template <class Epi>
__device__ __forceinline__ void gemm_tile_big(const bf16_t* xp, int ldx, const bf16_t* yp, int ldy, int K, char* lds,
                                              Epi epi) {
  const int tid = opq(threadIdx.x), lane = tid & 63, wv = tid >> 6;
  f32x16 acc[2][4];
#pragma unroll
  for (int i = 0; i < 2; ++i)
#pragma unroll
    for (int j = 0; j < 4; ++j)
#pragma unroll
      for (int r = 0; r < 16; ++r) acc[i][j][r] = 0.f;
  const int prow = lane >> 2, pch = lane & 3;
  const bf16_t* xs[4];
  const bf16_t* ys[2];
#pragma unroll
  for (int ps = 0; ps < 4; ++ps) {
    const int row = (wv * 4 + ps) * 16 + prow;
    xs[ps] = xp + (size_t)row * ldx + (pch ^ ((row >> 2) & 3)) * 8;
  }
#pragma unroll
  for (int ps = 0; ps < 2; ++ps) {
    const int row = (wv * 2 + ps) * 16 + prow;
    ys[ps] = yp + (size_t)row * ldy + (pch ^ ((row >> 2) & 3)) * 8;
  }
  char* const xdst = lds + wv * 4096 + lane * 16;
  char* const ydst = lds + 16384 + wv * 2048 + lane * 16;
#define BIG_ISSUE(k0, st)                                                                                                      \
  _Pragma("unroll") for (int ps = 0; ps < 4; ++ps)                                                                             \
    __builtin_amdgcn_global_load_lds((const unsigned*)(xs[ps] + (k0)), (unsigned*)(xdst + (st) + ps * 1024), 16, 0, 0);        \
  _Pragma("unroll") for (int ps = 0; ps < 2; ++ps)                                                                             \
    __builtin_amdgcn_global_load_lds((const unsigned*)(ys[ps] + (k0)), (unsigned*)(ydst + (st) + ps * 1024), 16, 0, 0);
#define DSR(dst, addr, off) asm volatile("ds_read_b128 %0, %1 offset:%2" : "=v"(dst) : "v"(addr), "i"(off) : "memory")
#define WAIT1(n, x) asm volatile("s_waitcnt lgkmcnt(" #n ")" : "+v"(x))
#define WAIT2(n, x, y) asm volatile("s_waitcnt lgkmcnt(" #n ")" : "+v"(x), "+v"(y))
#define MF(acc_, a_, b_) acc_ = __builtin_amdgcn_mfma_f32_32x32x16_bf16(a_, b_, acc_, 0, 0, 0)
#define BIG_COMPUTE(st)                                                                                   \
  {                                                                                                       \
    bf16x8 a00, a01, a10, a11, b00, b01, b02, b03, b10, b11, b12, b13;                                    \
    const unsigned aa0 = abase0 + (st), aa1 = abase1 + (st), bb0 = bbase0 + (st), bb1 = bbase1 + (st);    \
    DSR(a00, aa0, 0); DSR(b00, bb0, 0); DSR(b01, bb0, 2048); DSR(b02, bb0, 4096); DSR(b03, bb0, 6144);    \
    DSR(a01, aa0, 2048);                                                                                  \
    DSR(a10, aa1, 0); DSR(b10, bb1, 0); DSR(b11, bb1, 2048); DSR(b12, bb1, 4096); DSR(b13, bb1, 6144);    \
    DSR(a11, aa1, 2048);                                                                                  \
    WAIT2(10, a00, b00); MF(acc[0][0], a00, b00);                                                         \
    WAIT1(9, b01); MF(acc[0][1], a00, b01);                                                               \
    WAIT1(8, b02); MF(acc[0][2], a00, b02);                                                               \
    WAIT1(7, b03); MF(acc[0][3], a00, b03);                                                               \
    WAIT1(6, a01); MF(acc[1][0], a01, b00); MF(acc[1][1], a01, b01); MF(acc[1][2], a01, b02); MF(acc[1][3], a01, b03); \
    WAIT2(4, a10, b10); MF(acc[0][0], a10, b10);                                                          \
    WAIT1(3, b11); MF(acc[0][1], a10, b11);                                                               \
    WAIT1(2, b12); MF(acc[0][2], a10, b12);                                                               \
    WAIT1(1, b13); MF(acc[0][3], a10, b13);                                                               \
    WAIT1(0, a11); MF(acc[1][0], a11, b10); MF(acc[1][1], a11, b11); MF(acc[1][2], a11, b12); MF(acc[1][3], a11, b13); \
  }
  const unsigned ldsb = (unsigned)(size_t)(__attribute__((address_space(3))) char*)lds;
  const unsigned abase0 = ldsb + lds_off32(wv * 64 + (lane & 31), 0 + (lane >> 5));
  const unsigned abase1 = ldsb + lds_off32(wv * 64 + (lane & 31), 2 + (lane >> 5));
  const unsigned bbase0 = ldsb + 16384 + lds_off32((lane & 31), 0 + (lane >> 5));
  const unsigned bbase1 = ldsb + 16384 + lds_off32((lane & 31), 2 + (lane >> 5));
  const int nsteps = K >> 5;
  __syncthreads();
  BIG_ISSUE(0, 0)
  BIG_ISSUE(32, 24576)
  int cur = 0, nx2 = 49152;
  for (int t = 0; t < nsteps - 2; ++t) {
    asm volatile("s_waitcnt vmcnt(6)" ::: "memory");
    __builtin_amdgcn_s_barrier();
    BIG_ISSUE((t + 2) * 32, nx2)
    BIG_COMPUTE(cur)
    cur = (cur == 49152) ? 0 : cur + 24576;
    nx2 = (nx2 == 49152) ? 0 : nx2 + 24576;
  }
  asm volatile("s_waitcnt vmcnt(6)" ::: "memory");
  __builtin_amdgcn_s_barrier();
  BIG_COMPUTE(cur)
  cur = (cur == 49152) ? 0 : cur + 24576;
  asm volatile("s_waitcnt vmcnt(0)" ::: "memory");
  __builtin_amdgcn_s_barrier();
  BIG_COMPUTE(cur)
#undef BIG_ISSUE
#undef BIG_COMPUTE
#undef DSR
#undef WAIT1
#undef WAIT2
#undef MF
  const int lane2 = opq(lane);
  typedef __attribute__((ext_vector_type(4))) float f32x4;
  __syncthreads();
  float* wl = (float*)lds + wv * (32 * 68);
  const int hh2 = lane2 >> 5, cl = lane2 & 31;
#pragma unroll
  for (int i = 0; i < 2; ++i)
#pragma unroll
    for (int jh = 0; jh < 2; ++jh) {
#pragma unroll
      for (int j = 0; j < 2; ++j)
#pragma unroll
        for (int r = 0; r < 16; ++r) wl[((r & 3) + 8 * (r >> 2) + 4 * hh2) * 68 + j * 32 + cl] = acc[i][jh * 2 + j][r];
      __builtin_amdgcn_wave_barrier();
#pragma unroll
      for (int k = 0; k < 4; ++k) {
        const int row = (lane2 >> 3) + 8 * k, c8 = (lane2 & 7) * 8;
        const f32x4 lo = *(const f32x4*)&wl[row * 68 + c8];
        const f32x4 hi = *(const f32x4*)&wl[row * 68 + c8 + 4];
        epi(wv * 64 + i * 32 + row, jh * 64 + c8, lo, hi);
      }
      __builtin_amdgcn_wave_barrier();
    }
}

template <class Epi>
__device__ __forceinline__ void ph_gemm_big(const bf16_t* A, int lda, const bf16_t* Wt, int ldw, int M, int N, int K,
                                            char* lds, Epi epi) {
  const int ntm = M / 256, ntn = N / 128;
  const int npm = (ntm + 7) / 8, npn = (ntn + 7) / 8;
  const int nslots = ((npm * npn * 64 + 511) / 512) * 512;
  for (int u = blockIdx.x; u < nslots; u += gridDim.x) {
    int v = (u & 7) * 64 + ((u >> 3) & 63) + (u & ~511);
    int patch = v >> 6, w = v & 63;
    int tm = (patch % npm) * 8 + (w & 7);
    int tn = (patch / npm) * 8 + (w >> 3);
    if (tm >= ntm || tn >= ntn) continue;
    const int m0 = tm * 256, n0 = tn * 128;
    gemm_tile_big(A + (size_t)m0 * lda, lda, Wt + (size_t)n0 * ldw, ldw, K, lds,
                  [&](int r, int c, f32x4_e lo, f32x4_e hi) { epi(m0 + r, n0 + c, lo, hi); });
  }
}

__device__ __forceinline__ void norm_feed(const f32x4_e h0, const f32x4_e h1, const float* gain, int n, bf16_t* hn_row,
                                          float* rowss_m) {
  const f32x4_e g0 = *(const f32x4_e*)(gain + n), g1 = *(const f32x4_e*)(gain + n + 4);
  st_bf16x8(hn_row + n, h0 * g0, h1 * g1);
  float ss = h0[0] * h0[0] + h0[1] * h0[1] + h0[2] * h0[2] + h0[3] * h0[3] + h1[0] * h1[0] + h1[1] * h1[1] + h1[2] * h1[2] + h1[3] * h1[3];
  ss += __shfl_xor(ss, 1);
  ss += __shfl_xor(ss, 2);
  ss += __shfl_xor(ss, 4);
  if (((opq(threadIdx.x)) & 7) == 0) atomicAdd(rowss_m, ss);
}

template <bool VEC = false, class Epi>
__device__ __forceinline__ void ph_gemm_bf16(const bf16_t* A, int lda, const bf16_t* Wt, int ldw, int M, int N, int K,
                                             char* lds, Epi epi, int vblock = -2) {
  const int ntm = M / 128, ntn = N / 128;
  const int npm = (ntm + 7) / 8, npn = (ntn + 7) / 8;
  const int nslots = ((npm * npn * 64 + 511) / 512) * 512;
  if (vblock == -1) return;
  for (int u = (vblock >= 0 ? vblock : (int)blockIdx.x); u < nslots; u += gridDim.x) {
    int v = (u & 7) * 64 + ((u >> 3) & 63) + (u & ~511);
    int patch = v >> 6, w = v & 63;
    int tm = (patch % npm) * 8 + (w & 7);
    int tn = (patch / npm) * 8 + (w >> 3);
    if (tm >= ntm || tn >= ntn) continue;
    const int m0 = tm * 128, n0 = tn * 128;
    if constexpr (VEC)
      gemm_tile_bf16<false, true>(A + (size_t)m0 * lda, lda, Wt + (size_t)n0 * ldw, ldw, K, lds,
                                  [&](int r, int c, f32x4_e lo, f32x4_e hi) { epi(m0 + r, n0 + c, lo, hi); });
    else
      gemm_tile_bf16<false>(A + (size_t)m0 * lda, lda, Wt + (size_t)n0 * ldw, ldw, K, lds,
                            [&](int r, int c, float val) { epi(m0 + r, n0 + c, val); });
  }
}

__device__ __forceinline__ void ph_proj(const P& p, char* lds) {
  for (int u = blockIdx.x; u < 1024; u += gridDim.x) {
    int v = (u & 7) * 64 + ((u >> 3) & 63) + (u & ~511);
    int patch = v >> 6, w = v & 63;
    const int tm = (patch & 3) * 8 + (w & 7), tb = (patch >> 2) * 8 + (w >> 3);
    const int tn = (tb < 14) ? tb : (tb < 16) ? tb + 2 : tb + 4;
    const int m0 = tm * 256, n0 = tn * 128;
    const int b = m0 >> 11, sl = m0 & 2047;
    const bf16_t* A = p.hn + (size_t)m0 * DM;
    const bf16_t* W = p.WinT + (size_t)n0 * DM;
    bf16_t* dst;
    int ldd;
    if (n0 < 1024) { dst = p.qn + (size_t)m0 * 1024 + n0; ldd = 1024; }
    else if (n0 < 2560) {
      const int seg = (n0 - 1024) >> 8, g = ((n0 - 1024) >> 7) & 1;
      bf16_t* base = (seg == 0) ? p.kcin : (seg == 1) ? p.vcin : (seg == 2) ? p.ks : p.kw;
      dst = base + ((size_t)(b * 2 + g) * SEQ + sl) * 128; ldd = 128;
    } else if (n0 < 3584) { dst = p.qsb + (size_t)m0 * 1024 + (n0 - 2560); ldd = 1024; }
    else { dst = p.ksb + ((size_t)(b * 8 + ((n0 - 3584) >> 7)) * SEQ + sl) * 128; ldd = 128; }
    gemm_tile_big(A, DM, W, DM, DM, lds, [&](int r, int c, f32x4_e lo, f32x4_e hi) { st_bf16x8(dst + (size_t)r * ldd + c, lo, hi); });
  }
  for (int u = blockIdx.x; u < 64 * 13; u += gridDim.x) {
    const int tm = u & 63, ts = u >> 6;
    const int tn = (ts < 2) ? 14 + ts : (ts < 4) ? 16 + ts : (ts < 12) ? 32 + ts : 44;
    const int m0 = tm * 128, n0 = tn * 128;
    const int b = m0 >> 11, sl = m0 & 2047;
    const bf16_t* A = p.hn + (size_t)m0 * DM;
    const bf16_t* W = p.WinT + (size_t)n0 * DM;
    if (n0 < 2560) {
      const int seg = (n0 - 1024) >> 8, g = ((n0 - 1024) >> 7) & 1;
      bf16_t* vd = (seg == 3 ? p.vsT : p.vwT) + ((size_t)(b * 2 + g) * 128) * SEQ + sl;
      gemm_tile_bf16<true>(A, DM, W, DM, DM, lds, [&](int r, int c, float val) { vd[(size_t)r * SEQ + perm16(c)] = f2bf(val); });
    } else if (n0 < 5632) {
      bf16_t* vd = p.vsbT + ((size_t)(b * 8 + ((n0 - 4608) >> 7)) * 128) * SEQ + sl;
      gemm_tile_bf16<true>(A, DM, W, DM, DM, lds, [&](int r, int c, float val) { vd[(size_t)r * SEQ + perm16(c)] = f2bf(val); });
    } else {
      float* gd = p.gates + (size_t)m0 * 24;
      gemm_tile_bf16<false>(A, DM, W, DM, DM, lds, [&](int r, int c, float val) { if (c < 24) gd[(size_t)r * 24 + c] = val; });
    }
  }
}

__device__ __forceinline__ void ph_posb(const P& p) {
  const int lane = opq(threadIdx.x) & 63, wv = opq(threadIdx.x) >> 6;
  for (int o = blockIdx.x * 4 + wv; o < 256; o += gridDim.x * 4) {
    const int which = o >> 7, n = o & 127;
    const float* pos = which ? p.pos_v : p.pos_k;
    const float* w1 = which ? p.w1_v : p.w1_k;
    float acc = 0.f;
    for (int k = lane; k < 4096; k += 64) acc += pos[k] * w1[(size_t)k * 128 + n];
    acc = wave_sum(acc);
    if (lane == 0) p.posb[o] = acc;
  }
}

__device__ __forceinline__ void ph_compress2(const P& p, char* lds) {
  for (int item = blockIdx.x; item < 16; item += gridDim.x) {
    const int which = item >> 3, bg = item & 7;
    const bf16_t* src = (which ? p.vcin : p.kcin) + (size_t)bg * SEQ * 128;
    const bf16_t* w1t = p.w1T + (size_t)which * 128 * 4096;
    const bf16_t* w2t = p.w2T + (size_t)which * 128 * 128;
    const float* posb = p.posb + which * 128;
    bf16_t* c1 = p.c1 + (size_t)item * 128 * 128;
    gemm_tile_bf16<false>(src, 2048, w1t, 4096, 4096, lds, [&](int r, int c, float val) {
      c1[r * 128 + c] = f2bf(gelu_fast(val + posb[c])); });
    __threadfence_block();
    __syncthreads();
    if (which == 0) {
      bf16_t* kd = p.kcb + (size_t)bg * 128 * 128;
      gemm_tile_bf16<false>(c1, 128, w2t, 128, 128, lds, [&](int r, int c, float val) { kd[r * 128 + c] = f2bf(val); });
    } else {
      bf16_t* vd = p.vcT + (size_t)bg * 128 * 128;
      gemm_tile_bf16<true>(c1, 128, w2t, 128, 128, lds, [&](int r, int c, float val) { vd[r * 128 + perm16(c)] = f2bf(val); });
    }
  }
}

#define NEG_BIG (-1e30f)

struct KVRegs { u32x4 k0, k1, k2, k3, v0, v1, v2, v3; };

__device__ __forceinline__ int koff(int row, int chunk) { return row * 256 + ((chunk ^ (row & 15)) << 4); }

__device__ __forceinline__ void kv_load(KVRegs& r, const bf16_t* kp, int ldk, const bf16_t* vp, int ldv) {
  const int tid = opq(threadIdx.x);
  const bf16_t* kg = kp + (size_t)(tid >> 4) * ldk + (tid & 15) * 8;
  r.k0 = *(const u32x4*)kg;
  r.k1 = *(const u32x4*)(kg + (size_t)16 * ldk);
  r.k2 = *(const u32x4*)(kg + (size_t)32 * ldk);
  r.k3 = *(const u32x4*)(kg + (size_t)48 * ldk);
  const bf16_t* vg = vp + (size_t)(tid >> 3) * ldv + (tid & 7) * 8;
  r.v0 = *(const u32x4*)vg;
  r.v1 = *(const u32x4*)(vg + (size_t)32 * ldv);
  r.v2 = *(const u32x4*)(vg + (size_t)64 * ldv);
  r.v3 = *(const u32x4*)(vg + (size_t)96 * ldv);
}
__device__ __forceinline__ void kv_store(const KVRegs& r, char* lk, char* lv) {
  const int tid = opq(threadIdx.x);
  const int row = tid >> 4, ch = tid & 15;
  *(u32x4*)(lk + koff(row, ch)) = r.k0;
  *(u32x4*)(lk + koff(row + 16, ch)) = r.k1;
  *(u32x4*)(lk + koff(row + 32, ch)) = r.k2;
  *(u32x4*)(lk + koff(row + 48, ch)) = r.k3;
  const int vr = tid >> 3, vc = tid & 7;
  *(u32x4*)(lv + lds_off(vr, vc)) = r.v0;
  *(u32x4*)(lv + lds_off(vr + 32, vc)) = r.v1;
  *(u32x4*)(lv + lds_off(vr + 64, vc)) = r.v2;
  *(u32x4*)(lv + lds_off(vr + 96, vc)) = r.v3;
}

struct QFrag { bf16x8 f0, f1, f2, f3, f4, f5, f6, f7; };
__device__ __forceinline__ void q_load(QFrag& q, const bf16_t* qrow) {
  const int h = (opq(threadIdx.x) & 63) >> 5;
  const bf16x8* p8 = (const bf16x8*)(qrow + 8 * h);
  q.f0 = p8[0]; q.f1 = p8[2]; q.f2 = p8[4]; q.f3 = p8[6]; q.f4 = p8[8]; q.f5 = p8[10]; q.f6 = p8[12]; q.f7 = p8[14];
}

__device__ __forceinline__ void qk_tile(const QFrag& q, const char* lk, f32x16& s0, f32x16& s1) {
  const int lane = opq(threadIdx.x) & 63, row = lane & 31, h = lane >> 5;
#pragma unroll
  for (int r = 0; r < 16; ++r) { s0[r] = 0.f; s1[r] = 0.f; }
#define QK_STEP(kk, qf)                                                                  \
  {                                                                                      \
    bf16x8 a0 = *(const bf16x8*)(lk + koff(row, 2 * (kk) + h));                          \
    bf16x8 a1 = *(const bf16x8*)(lk + koff(row + 32, 2 * (kk) + h));                     \
    s0 = __builtin_amdgcn_mfma_f32_32x32x16_bf16(a0, qf, s0, 0, 0, 0);                   \
    s1 = __builtin_amdgcn_mfma_f32_32x32x16_bf16(a1, qf, s1, 0, 0, 0);                   \
  }
  QK_STEP(0, q.f0) QK_STEP(1, q.f1) QK_STEP(2, q.f2) QK_STEP(3, q.f3)
  QK_STEP(4, q.f4) QK_STEP(5, q.f5) QK_STEP(6, q.f6) QK_STEP(7, q.f7)
#undef QK_STEP
}

__device__ __forceinline__ bf16x8 pack8(const f32x16& p, const int base) {
  u32x4 u;
  u[0] = pack2(p[base + 0], p[base + 1]);
  u[1] = pack2(p[base + 2], p[base + 3]);
  u[2] = pack2(p[base + 4], p[base + 5]);
  u[3] = pack2(p[base + 6], p[base + 7]);
  return __builtin_bit_cast(bf16x8, u);
}

typedef __attribute__((ext_vector_type(2))) unsigned u32x2_t;
__device__ __forceinline__ float xhalf_max(float v) {
  const u32x2_t r = __builtin_amdgcn_permlane32_swap(__float_as_uint(v), __float_as_uint(v), false, false);
  return fmaxf(__uint_as_float(r[0]), __uint_as_float(r[1]));
}
__device__ __forceinline__ float xhalf_sum(float v) {
  const u32x2_t r = __builtin_amdgcn_permlane32_swap(__float_as_uint(v), __float_as_uint(v), false, false);
  return __uint_as_float(r[0]) + __uint_as_float(r[1]);
}
__device__ __forceinline__ float xhalf_get(float v, int hh) {
  const u32x2_t r = __builtin_amdgcn_permlane32_swap(__float_as_uint(v), __float_as_uint(v), false, false);
  return hh ? __uint_as_float(r[0]) : __uint_as_float(r[1]);
}
struct OAcc { f32x16 o0, o1, o2, o3; };
__device__ __forceinline__ void oacc_zero(OAcc& o) {
#pragma unroll
  for (int r = 0; r < 16; ++r) { o.o0[r] = 0.f; o.o1[r] = 0.f; o.o2[r] = 0.f; o.o3[r] = 0.f; }
}
__device__ __forceinline__ void oacc_scale(OAcc& o, float a) {
#pragma unroll
  for (int r = 0; r < 16; ++r) { o.o0[r] *= a; o.o1[r] *= a; o.o2[r] *= a; o.o3[r] *= a; }
}

__device__ __forceinline__ void pv_tile(OAcc& o, const char* lv, const f32x16& p0, const f32x16& p1) {
  const int lane = opq(threadIdx.x) & 63, row = lane & 31, h = lane >> 5;
  const bf16x8 pf0 = pack8(p0, 0), pf1 = pack8(p0, 8), pf2 = pack8(p1, 0), pf3 = pack8(p1, 8);
#define PV_ROW(dd, acc)                                                                                      \
  {                                                                                                          \
    acc = __builtin_amdgcn_mfma_f32_32x32x16_bf16(*(const bf16x8*)(lv + lds_off(32 * (dd) + row, 0 + h)), pf0, acc, 0, 0, 0); \
    acc = __builtin_amdgcn_mfma_f32_32x32x16_bf16(*(const bf16x8*)(lv + lds_off(32 * (dd) + row, 2 + h)), pf1, acc, 0, 0, 0); \
    acc = __builtin_amdgcn_mfma_f32_32x32x16_bf16(*(const bf16x8*)(lv + lds_off(32 * (dd) + row, 4 + h)), pf2, acc, 0, 0, 0); \
    acc = __builtin_amdgcn_mfma_f32_32x32x16_bf16(*(const bf16x8*)(lv + lds_off(32 * (dd) + row, 6 + h)), pf3, acc, 0, 0, 0); \
  }
  PV_ROW(0, o.o0) PV_ROW(1, o.o1) PV_ROW(2, o.o2) PV_ROW(3, o.o3)
#undef PV_ROW
}

__device__ __forceinline__ void softmax_tile(f32x16& s0, f32x16& s1, float& m, float& l, OAcc& o) {
  float mx = NEG_BIG;
#pragma unroll
  for (int r = 0; r < 16; ++r) mx = fmaxf(mx, fmaxf(s0[r], s1[r]));
  mx = xhalf_max(mx);
  const float mn = fmaxf(m, mx);
  const float alpha = __builtin_amdgcn_exp2f(m - mn);
  float ls = 0.f;
#pragma unroll
  for (int r = 0; r < 16; ++r) {
    const float a = __builtin_amdgcn_exp2f(s0[r] - mn);
    const float b = __builtin_amdgcn_exp2f(s1[r] - mn);
    s0[r] = a; s1[r] = b;
    ls += a + b;
  }
  ls = xhalf_sum(ls);
  l = l * alpha + ls;
  m = mn;
  if (__any(alpha != 1.f)) oacc_scale(o, alpha);
}

template <class F>
__device__ __forceinline__ void oacc_foreach(const OAcc& o, F f) {
  const int h = (opq(threadIdx.x) & 63) >> 5;
#pragma unroll
  for (int rho = 0; rho < 4; ++rho) {
    f(0 + 8 * rho + 4 * h, o.o0[4 * rho], o.o0[4 * rho + 1], o.o0[4 * rho + 2], o.o0[4 * rho + 3]);
    f(32 + 8 * rho + 4 * h, o.o1[4 * rho], o.o1[4 * rho + 1], o.o1[4 * rho + 2], o.o1[4 * rho + 3]);
    f(64 + 8 * rho + 4 * h, o.o2[4 * rho], o.o2[4 * rho + 1], o.o2[4 * rho + 2], o.o2[4 * rho + 3]);
    f(96 + 8 * rho + 4 * h, o.o3[4 * rho], o.o3[4 * rho + 1], o.o3[4 * rho + 2], o.o3[4 * rho + 3]);
  }
}

__device__ __forceinline__ void memattn_item(const P& p, char* lds, int item) {
  char* lk = lds;
  char* lv = lds + 16384;
  const int lane = opq(threadIdx.x) & 63, wv = opq(threadIdx.x) >> 6;
  {
    const int tb = item % (SEQ / 128);
    const int bh = item / (SEQ / 128);
    const int b = bh >> 2, hd = bh & 3;
    const int t = tb * 128 + wv * 32 + (lane & 31);
    QFrag q;
    q_load(q, p.qmemb + (size_t)(b * SEQ + t) * 512 + hd * 128);
    const bf16_t* kb = p.kmemb + (size_t)bh * 256 * 128;
    const bf16_t* vb = p.vmemT + (size_t)bh * 128 * 256;
    OAcc o;
    oacc_zero(o);
    float m = NEG_BIG, l = 0.f;
    KVRegs kv;
    kv_load(kv, kb, 128, vb, 256);
#pragma unroll 1
    for (int ti = 0; ti < 4; ++ti) {
      __syncthreads();
      kv_store(kv, lk, lv);
      __syncthreads();
      {
        const int tn = (ti + 1 < 4) ? ti + 1 : 3;
        kv_load(kv, kb + (size_t)tn * 64 * 128, 128, vb + tn * 64, 256);
      }
      f32x16 s0, s1;
      qk_tile(q, lk, s0, s1);
#pragma unroll
      for (int r = 0; r < 16; ++r) { s0[r] *= ATT_SCALE2; s1[r] *= ATT_SCALE2; }
      softmax_tile(s0, s1, m, l, o);
      pv_tile(o, lv, s0, s1);
    }
    const float il = 1.f / l;
    const int t2 = tb * 128 + (opq(threadIdx.x) >> 6) * 32 + (opq(threadIdx.x) & 31);
    bf16_t* orow = p.omem + (size_t)(b * SEQ + t2) * 512 + hd * 128;
    oacc_foreach(o, [&](int d, float v0, float v1, float v2, float v3) {
      uint2 u;
      u.x = pack2(v0 * il, v1 * il);
      u.y = pack2(v2 * il, v3 * il);
      *(uint2*)(orow + d) = u;
    });
  }
}

__device__ __forceinline__ void ph_memq_attn(const P& p, char* lds, int vblock, int nvb) {
  if (vblock < 0) return;
  const float* rss = p.rowss;
  for (int u = vblock; u < 64 * 4; u += nvb) {
    const int tm = u & 63, hd = u >> 6;
    const int m0 = tm * 128;
    bf16_t* qd = p.qmemb + (size_t)m0 * 512 + hd * 128;
    gemm_tile_bf16<false, true>(p.hn + (size_t)m0 * DM, DM, p.WmqT + (size_t)hd * 128 * DM, DM, DM, lds,
                                [&](int r, int c, f32x4_e lo, f32x4_e hi) {
                                  const float rs = rsqrtf(rss[m0 + r] * (1.f / DM) + RMS_EPS);
                                  st_bf16x8(qd + (size_t)r * 512 + c, lo * rs, hi * rs); });
    __threadfence_block();
    __syncthreads();
    memattn_item(p, lds, ((m0 >> 11) * 4 + hd) * (SEQ / 128) + ((m0 & 2047) >> 7));
  }
}

__device__ __forceinline__ void ph_sb2(const P& p, char* lds) {
  char* lk = lds;
  char* lv = lds + 16384;
  const int lane = opq(threadIdx.x) & 63, wv = opq(threadIdx.x) >> 6, hh = lane >> 5;
  const int sb_skip = (gridDim.x > 32) ? 16 : 0;
  if ((int)blockIdx.x < sb_skip) return;
  for (int item = (int)blockIdx.x - sb_skip; item < NBATCH * 8 * (SEQ / 128); item += (int)gridDim.x - sb_skip) {
    const int tb = (SEQ / 128 - 1) - (item % (SEQ / 128));
    const int bh = item / (SEQ / 128);
    const int b = bh >> 3, hd = bh & 7;
    const int t0 = tb * 128;
    const int t = t0 + wv * 32 + (lane & 31);
    QFrag q;
    q_load(q, p.qsb + (size_t)(b * SEQ + t) * 1024 + hd * 128);
    const bf16_t* kb = p.ksb + (size_t)bh * SEQ * 128;
    const bf16_t* vb = p.vsbT + (size_t)bh * 128 * SEQ;
    OAcc o;
    oacc_zero(o);
    float carry = 0.f;
    const int jhi = (t0 >> 6) + 1;
    const int jw = (t0 + wv * 32 + 30) >> 6;
    KVRegs kv;
    kv_load(kv, kb + (size_t)jhi * 64 * 128, 128, vb + jhi * 64, SEQ);
    volatile unsigned* dflag = (volatile unsigned*)(lds + 32768);
    __syncthreads();
    if (opq(threadIdx.x) < 4) dflag[opq(threadIdx.x)] = 0u;
    for (int j = jhi; j >= 0; --j) {
      __syncthreads();
      if ((dflag[0] & dflag[1] & dflag[2] & dflag[3]) != 0u) break;
      kv_store(kv, lk, lv);
      __syncthreads();
      const int jn = (j > 0) ? j - 1 : 0;
      if (j > jw) kv_load(kv, kb + (size_t)jn * 64 * 128, 128, vb + jn * 64, SEQ);
      if (j <= jw) {
        f32x16 z0, z1;
        qk_tile(q, lk, z0, z1);
        const int sbase = j * 64 + 4 * hh;
        float gt[8];
        f32x16 l0, l1;
#pragma unroll
        for (int r = 0; r < 16; ++r) {
          const int so = sbase + 8 * (r >> 2) + (r & 3);
          {
            const float z = z0[r] * ATT_SCALE2;
            const bool valid = so < t;
            const float lsp = fminf(z, 0.f) - __builtin_amdgcn_logf(1.f + __builtin_amdgcn_exp2f(-fabsf(z)));
            l0[r] = valid ? (lsp - z) : 0.f;
            z0[r] = valid ? z : NEG_BIG;
          }
          {
            const float z = z1[r] * ATT_SCALE2;
            const bool valid = so + 32 < t;
            const float lsp = fminf(z, 0.f) - __builtin_amdgcn_logf(1.f + __builtin_amdgcn_exp2f(-fabsf(z)));
            l1[r] = valid ? (lsp - z) : 0.f;
            z1[r] = valid ? z : NEG_BIG;
          }
        }
#pragma unroll
        for (int rho = 0; rho < 4; ++rho) {
          gt[rho] = (l0[4 * rho] + l0[4 * rho + 1]) + (l0[4 * rho + 2] + l0[4 * rho + 3]);
          gt[4 + rho] = (l1[4 * rho] + l1[4 * rho + 1]) + (l1[4 * rho + 2] + l1[4 * rho + 3]);
        }
        float ag[8];
        float run = 0.f;
#pragma unroll
        for (int k = 7; k >= 0; --k) {
          const float pg = xhalf_get(gt[k], hh);
          ag[k] = carry + run + (hh == 0 ? pg : 0.f);
          run += gt[k] + pg;
        }
        carry += run;
#pragma unroll
        for (int rho = 0; rho < 4; ++rho) {
          {
            const float x3 = l0[4 * rho + 3], x23 = x3 + l0[4 * rho + 2], x123 = x23 + l0[4 * rho + 1];
            const float g = ag[rho];
            z0[4 * rho + 0] = __builtin_amdgcn_exp2f((l0[4 * rho + 0] + z0[4 * rho + 0]) + (g + x123));
            z0[4 * rho + 1] = __builtin_amdgcn_exp2f((l0[4 * rho + 1] + z0[4 * rho + 1]) + (g + x23));
            z0[4 * rho + 2] = __builtin_amdgcn_exp2f((l0[4 * rho + 2] + z0[4 * rho + 2]) + (g + x3));
            z0[4 * rho + 3] = __builtin_amdgcn_exp2f((l0[4 * rho + 3] + z0[4 * rho + 3]) + g);
          }
          {
            const float x3 = l1[4 * rho + 3], x23 = x3 + l1[4 * rho + 2], x123 = x23 + l1[4 * rho + 1];
            const float g = ag[4 + rho];
            z1[4 * rho + 0] = __builtin_amdgcn_exp2f((l1[4 * rho + 0] + z1[4 * rho + 0]) + (g + x123));
            z1[4 * rho + 1] = __builtin_amdgcn_exp2f((l1[4 * rho + 1] + z1[4 * rho + 1]) + (g + x23));
            z1[4 * rho + 2] = __builtin_amdgcn_exp2f((l1[4 * rho + 2] + z1[4 * rho + 2]) + (g + x3));
            z1[4 * rho + 3] = __builtin_amdgcn_exp2f((l1[4 * rho + 3] + z1[4 * rho + 3]) + g);
          }
        }
        kv_load(kv, kb + (size_t)jn * 64 * 128, 128, vb + jn * 64, SEQ);
        pv_tile(o, lv, z0, z1);
        if (__all(carry < -104.f * LOG2E) && (opq(threadIdx.x) & 63) == 0) dflag[wv] = 1u;
      }
    }
    int t2 = t;
    asm volatile("" : "+v"(t2));
    bf16_t* orow = p.omix + (size_t)(b * SEQ + t2) * DM + 1024 + hd * 128;
    oacc_foreach(o, [&](int d, float v0, float v1, float v2, float v3) {
      uint2 u;
      u.x = pack2(v0, v1);
      u.y = pack2(v2, v3);
      *(uint2*)(orow + d) = u;
    });
  }
}

#define NSA_IMP 32768
#define NSA_KEYS 49152
#define NSA_SELM 53504
#define NSA_LUT 53632
__device__ __forceinline__ void ph_nsa2(const P& p, char* lds) {
  typedef __attribute__((ext_vector_type(4))) float f32x4;
  char* lk = lds;
  char* lv = lds + 16384;
  float* imp = (float*)(lds + NSA_IMP);
  float* keys = (float*)(lds + NSA_KEYS);
  unsigned* selm = (unsigned*)(lds + NSA_SELM);
  const int tid = opq(threadIdx.x), lane = tid & 63, wv = tid >> 6, hh = lane >> 5, ql = lane & 31;
  float* lut = (float*)(lds + NSA_LUT) + wv * 128;
  for (int item = blockIdx.x; item < NBATCH * 2 * (SEQ / 32); item += gridDim.x) {
    const int tt = (item < 256) ? (SEQ / 32 - 1) - (item % (SEQ / 32)) : (item % (SEQ / 32));
    const int bg = item / (SEQ / 32);
    const int b = bg >> 1, g = bg & 1;
    const int h = g * 4 + wv;
    const int t0 = tt * 32, tq = t0 + ql, cur = t0 >> 6;
    __syncthreads();
    QFrag q;
    q_load(q, p.qn + (size_t)(b * SEQ + tq) * 1024 + h * 128);
    {
      const int lo = opq(lane);
      lut[lo] = p.t5[t5_bucket(lo) * 8 + h] * LOG2E;
      lut[lo + 64] = p.t5[t5_bucket(lo + 64) * 8 + h] * LOG2E;
    }
#pragma unroll
    for (int i = 0; i < 16; ++i) imp[i * 256 + tid] = 0.f;
    if (tid < 32) selm[tid] = 0u;
    const float* grow = p.gates + (size_t)(b * SEQ + tq) * 24 + h * 3;
    float* prow = p.part + (size_t)(b * SEQ + tq) * 1024 + h * 128;
    OAcc o;
    float m, l;
    KVRegs kv;
    {
      const bf16_t* kb = p.kcb + (size_t)bg * 128 * 128;
      const bf16_t* vb = p.vcT + (size_t)bg * 128 * 128;
      oacc_zero(o);
      m = NEG_BIG; l = 0.f;
      kv_load(kv, kb, 128, vb, 128);
      __syncthreads();
      kv_store(kv, lk, lv);
      __syncthreads();
      f32x16 x0, x1;
      qk_tile(q, lk, x0, x1);
      int tqv = tq;
      asm volatile("" : "+v"(tqv));
      tqv -= 64 * hh;
      if (t0 >= 1152) {
        const float b31 = lut[127];
#pragma unroll
        for (int r = 0; r < 16; ++r) { x0[r] = x0[r] * ATT_SCALE2 + b31; x1[r] = x1[r] * ATT_SCALE2 + b31; }
      } else {
#pragma unroll
        for (int r = 0; r < 16; ++r) {
          const int c = 8 * (r >> 2) + (r & 3);
          const int d0 = tqv - 16 * c - 31, d1 = d0 - 512;
          x0[r] = (d0 >= 0) ? x0[r] * ATT_SCALE2 + lut[min(d0, 127)] : -INFINITY;
          x1[r] = (d1 >= 0) ? x1[r] * ATT_SCALE2 + lut[min(d1, 127)] : -INFINITY;
        }
      }
      softmax_tile(x0, x1, m, l, o);
      const float m0 = m;
      pv_tile(o, lv, x0, x1);
      f32x16 z0, z1;
#pragma unroll
      for (int r = 0; r < 16; ++r) { z0[r] = 0.f; z1[r] = 0.f; }
      if (t0 >= 1024) {
        kv_load(kv, kb + 64 * 128, 128, vb + 64, 128);
        __syncthreads();
        kv_store(kv, lk, lv);
        __syncthreads();
        qk_tile(q, lk, z0, z1);
        asm volatile("" : "+v"(tqv));
#pragma unroll
        for (int r = 0; r < 16; ++r) {
          const int c = 64 + 8 * (r >> 2) + (r & 3);
          const int d0 = tqv - 16 * c - 31, d1 = d0 - 512;
          z0[r] = (d0 >= 0) ? z0[r] * ATT_SCALE2 + lut[min(d0, 127)] : -INFINITY;
          z1[r] = (d1 >= 0) ? z1[r] * ATT_SCALE2 + lut[min(d1, 127)] : -INFINITY;
        }
        softmax_tile(z0, z1, m, l, o);
        pv_tile(o, lv, z0, z1);
      }
      const float inv = 1.f / fmaxf(l, 1e-20f);
      const float c0 = __builtin_amdgcn_exp2f(m0 - m) * inv;
#pragma unroll
      for (int r = 0; r < 16; ++r) {
        const int c = 8 * (r >> 2) + (r & 3) + 4 * hh;
        if (x0[r] != 0.f) atomicAdd(&imp[(c) * 32 + ql], x0[r] * c0);
        if (x1[r] != 0.f) atomicAdd(&imp[(c + 32) * 32 + ql], x1[r] * c0);
        if (z0[r] != 0.f) atomicAdd(&imp[(c + 64) * 32 + ql], z0[r] * inv);
        if (z1[r] != 0.f) atomicAdd(&imp[(c + 96) * 32 + ql], z1[r] * inv);
      }
      const float gs = inv / (1.f + __expf(-grow[0]));
      oacc_foreach(o, [&](int d, float v0, float v1, float v2, float v3) {
        f32x4 u = {v0 * gs, v1 * gs, v2 * gs, v3 * gs};
        *(f32x4*)(prow + d) = u;
      });
    }
    __syncthreads();
    {
      const int tido = opq(tid);
      const int qq = tido & 31, jg = tido >> 5;
#pragma unroll
      for (int jj = 0; jj < 4; ++jj) {
        const int j = jg * 4 + jj;
        float v = imp[(4 * j) * 32 + qq] + imp[(4 * j + 1) * 32 + qq] + imp[(4 * j + 2) * 32 + qq] + 0.5f * imp[(4 * j + 3) * 32 + qq];
        if (j > 0) v += 0.5f * imp[(4 * j - 1) * 32 + qq];
        const bool forced = (j == 0) || (j == cur) || (j == cur - 1);
        keys[qq * 33 + j] = forced ? 1e9f : ((j <= cur) ? v : -1e9f);
      }
      __syncthreads();
      unsigned bits = 0u;
#pragma unroll
      for (int jj = 0; jj < 4; ++jj) {
        const int j = jg * 4 + jj;
        const float kj = keys[qq * 33 + j];
        int rank = 0;
        for (int i = 0; i < 32; ++i) {
          const float ki = keys[qq * 33 + i];
          rank += (ki > kj || (ki == kj && i < j)) ? 1 : 0;
        }
        if (rank < 16 && j <= cur) bits |= 1u << j;
      }
      atomicOr(&selm[qq], bits);
      __syncthreads();
    }
    const unsigned mysel = selm[ql];
    unsigned um = mysel;
#pragma unroll
    for (int o2 = 16; o2 > 0; o2 >>= 1) um |= (unsigned)__shfl_xor((int)um, o2);
    um = (unsigned)__builtin_amdgcn_readfirstlane((int)um);
    {
      const bf16_t* kb = p.ks + (size_t)bg * SEQ * 128;
      const bf16_t* vb = p.vsT + (size_t)bg * 128 * SEQ;
      oacc_zero(o);
      m = NEG_BIG; l = 0.f;
      unsigned rem = um;
      int j = __builtin_ctz(rem);
      kv_load(kv, kb + (size_t)j * 64 * 128, 128, vb + j * 64, SEQ);
      while (rem) {
        j = __builtin_ctz(rem);
        rem &= rem - 1;
        const int jn = rem ? __builtin_ctz(rem) : j;
        __syncthreads();
        kv_store(kv, lk, lv);
        __syncthreads();
        f32x16 s0, s1;
        qk_tile(q, lk, s0, s1);
        const bool selq = (mysel >> j) & 1u;
        int tqv = tq;
        asm volatile("" : "+v"(tqv));
        if (j * 64 + 63 + 113 <= t0) {
          const float sc = selq ? ATT_SCALE2 : 0.f, bb = selq ? lut[127] : -INFINITY;
#pragma unroll
          for (int r = 0; r < 16; ++r) { s0[r] = s0[r] * sc + bb; s1[r] = s1[r] * sc + bb; }
        } else {
#pragma unroll
          for (int r = 0; r < 16; ++r) {
            const int d0 = tqv - (j * 64 + 8 * (r >> 2) + (r & 3) + 4 * hh), d1 = d0 - 32;
            s0[r] = (selq && d0 >= 0) ? s0[r] * ATT_SCALE2 + lut[min(d0, 127)] : -INFINITY;
            s1[r] = (selq && d1 >= 0) ? s1[r] * ATT_SCALE2 + lut[min(d1, 127)] : -INFINITY;
          }
        }
        kv_load(kv, kb + (size_t)jn * 64 * 128, 128, vb + jn * 64, SEQ);
        softmax_tile(s0, s1, m, l, o);
        pv_tile(o, lv, s0, s1);
      }
      const float gs = 1.f / (fmaxf(l, 1e-20f) * (1.f + __expf(-grow[1])));
      int qo = ql;
      asm volatile("" : "+v"(qo));
      float* pr2 = p.part + (size_t)(b * SEQ + t0 + qo) * 1024 + h * 128;
      oacc_foreach(o, [&](int d, float v0, float v1, float v2, float v3) {
        f32x4 u = *(f32x4*)(pr2 + d);
        u[0] += v0 * gs; u[1] += v1 * gs; u[2] += v2 * gs; u[3] += v3 * gs;
        *(f32x4*)(pr2 + d) = u;
      });
    }
    {
      const bf16_t* kb = p.kw + (size_t)bg * SEQ * 128;
      const bf16_t* vb = p.vwT + (size_t)bg * 128 * SEQ;
      oacc_zero(o);
      m = NEG_BIG; l = 0.f;
      int jlo = (t0 - 511) >> 6;
      if (jlo < 0) jlo = 0;
      kv_load(kv, kb + (size_t)jlo * 64 * 128, 128, vb + jlo * 64, SEQ);
      for (int j = jlo; j <= cur; ++j) {
        const int jn = (j < cur) ? j + 1 : j;
        __syncthreads();
        kv_store(kv, lk, lv);
        __syncthreads();
        f32x16 s0, s1;
        qk_tile(q, lk, s0, s1);
        int tqv = tq;
        asm volatile("" : "+v"(tqv));
        if (j * 64 + 63 + 113 <= t0 && t0 + 31 - j * 64 < 512) {
          const float b31 = lut[127];
#pragma unroll
          for (int r = 0; r < 16; ++r) { s0[r] = s0[r] * ATT_SCALE2 + b31; s1[r] = s1[r] * ATT_SCALE2 + b31; }
        } else {
#pragma unroll
          for (int r = 0; r < 16; ++r) {
            const int d0 = tqv - (j * 64 + 8 * (r >> 2) + (r & 3) + 4 * hh), d1 = d0 - 32;
            s0[r] = (d0 >= 0 && d0 < 512) ? s0[r] * ATT_SCALE2 + lut[min(d0, 127)] : -INFINITY;
            s1[r] = (d1 >= 0 && d1 < 512) ? s1[r] * ATT_SCALE2 + lut[min(d1, 127)] : -INFINITY;
          }
        }
        kv_load(kv, kb + (size_t)jn * 64 * 128, 128, vb + jn * 64, SEQ);
        softmax_tile(s0, s1, m, l, o);
        pv_tile(o, lv, s0, s1);
      }
      const float gs = 1.f / (fmaxf(l, 1e-20f) * (1.f + __expf(-grow[2])));
      int qo = ql;
      asm volatile("" : "+v"(qo));
      const float* pr2 = p.part + (size_t)(b * SEQ + t0 + qo) * 1024 + h * 128;
      bf16_t* orow = p.omix + (size_t)(b * SEQ + t0 + qo) * DM + h * 128;
      oacc_foreach(o, [&](int d, float v0, float v1, float v2, float v3) {
        const f32x4 u = *(const f32x4*)(pr2 + d);
        uint2 w;
        w.x = pack2(u[0] + v0 * gs, u[1] + v1 * gs);
        w.y = pack2(u[2] + v2 * gs, u[3] + v3 * gs);
        *(uint2*)(orow + d) = w;
      });
    }
  }
}

__device__ __forceinline__ void ph_cvt(const float* src, bf16_t* dst, size_t n) {
  typedef __attribute__((ext_vector_type(4))) float f32x4;
  const size_t nv = n / 8;
  for (size_t i = (size_t)blockIdx.x * 256 + opq(threadIdx.x); i < nv; i += (size_t)gridDim.x * 256) {
    const f32x4 a = ((const f32x4*)src)[2 * i], b = ((const f32x4*)src)[2 * i + 1];
    u32x4 o;
    o[0] = pack2(a[0], a[1]); o[1] = pack2(a[2], a[3]); o[2] = pack2(b[0], b[1]); o[3] = pack2(b[2], b[3]);
    ((u32x4*)dst)[i] = o;
  }
}

__device__ __forceinline__ void ph_scores(const P& p, char* lds) {
  for (int u = blockIdx.x; u < 64 * 16; u += gridDim.x) {
    const int tm = u & 63, hp = u >> 6;
    const int m0 = tm * 128;
    float* sc = p.scores + (size_t)m0 * DM + hp * 128;
    gemm_tile_bf16<false>(p.omix + (size_t)m0 * DM + hp * 128, DM, p.subkb + (size_t)hp * 128 * 128, 128, 128, lds,
                          [&](int r, int c, float val) { sc[(size_t)r * DM + c] = val; });
  }
}

__device__ __forceinline__ void ph_qp_scores(const P& p, char* lds) {
  const int ntm = T_TOK / 256, ntn = DM / 128;
  const int npm = (ntm + 7) / 8, npn = (ntn + 7) / 8;
  const int nslots = ((npm * npn * 64 + 511) / 512) * 512;
  for (int u = blockIdx.x; u < nslots; u += gridDim.x) {
    int v = (u & 7) * 64 + ((u >> 3) & 63) + (u & ~511);
    int patch = v >> 6, w = v & 63;
    int tm = (patch % npm) * 8 + (w & 7);
    int tn = (patch / npm) * 8 + (w >> 3);
    if (tm >= ntm || tn >= ntn) continue;
    const int m0 = tm * 256, n0 = tn * 128;
    bf16_t* qp = p.omix + (size_t)m0 * DM + n0;
    const float* rss = p.rowss + T_TOK + m0;
    gemm_tile_big(p.hn + (size_t)m0 * DM, DM, p.WpqT + (size_t)n0 * DM, DM, DM, lds,
                  [&](int r, int c, f32x4_e lo, f32x4_e hi) {
                    const float rs = rsqrtf(rss[r] * (1.f / DM) + RMS_EPS);
                    st_bf16x8(qp + (size_t)r * DM + c, lo * rs, hi * rs); });
    __threadfence_block();
    __syncthreads();
    float* sc = p.scores + (size_t)m0 * DM + n0;
    gemm_tile_big(qp, DM, p.subkb + (size_t)tn * 128 * 128, 128, 128, lds,
                  [&](int r, int c, f32x4_e lo, f32x4_e hi) {
                    *(f32x4_e*)(sc + (size_t)r * DM + c) = lo; *(f32x4_e*)(sc + (size_t)r * DM + c + 4) = hi; });
  }
}

__device__ __forceinline__ void ph_cvt4(const float* src, unsigned char* dst, float* scales, int nrows, int wid0, int nw) {
  typedef __attribute__((ext_vector_type(4))) float f32x4;
  typedef __attribute__((ext_vector_type(2))) float f32x2;
  const int lane = opq(threadIdx.x) & 63;
  const float one = __uint_as_float((unsigned)opq(0x3F800000));
  float lev[8];
#pragma unroll
  for (int c = 0; c < 8; ++c) {
    const f32x2 q = __builtin_amdgcn_cvt_scalef32_pk_f32_fp4((unsigned)opq(c * 0x11111111), one, 0);
    lev[c] = fabsf(q[0]);
  }
  const float maxlev = lev[7];
  for (int row = wid0; row < nrows; row += nw) {
    const f32x4* s4 = (const f32x4*)(src + (size_t)row * DM) + lane * 8;
    f32x4 v[8];
    float amax = 0.f;
#pragma unroll
    for (int i = 0; i < 8; ++i) {
      v[i] = s4[i];
#pragma unroll
      for (int k = 0; k < 4; ++k) amax = fmaxf(amax, fabsf(v[i][k]));
    }
    amax = wave_max(amax);
    const float sc = (amax > 0.f) ? maxlev / amax : 1.f;
    u32x4 o;
#pragma unroll
    for (int w = 0; w < 4; ++w) {
      unsigned pk = 0u;
      pk = __builtin_amdgcn_cvt_scalef32_pk_fp4_f32(pk, v[2 * w][0] * sc, v[2 * w][1] * sc, 1.0f, 0);
      pk = __builtin_amdgcn_cvt_scalef32_pk_fp4_f32(pk, v[2 * w][2] * sc, v[2 * w][3] * sc, 1.0f, 1);
      pk = __builtin_amdgcn_cvt_scalef32_pk_fp4_f32(pk, v[2 * w + 1][0] * sc, v[2 * w + 1][1] * sc, 1.0f, 2);
      pk = __builtin_amdgcn_cvt_scalef32_pk_fp4_f32(pk, v[2 * w + 1][2] * sc, v[2 * w + 1][3] * sc, 1.0f, 3);
      o[w] = pk;
    }
    *(u32x4*)(dst + (size_t)row * 1024 + lane * 16) = o;
    if (lane == 0) scales[row] = (amax > 0.f) ? amax / maxlev : 1.f;
  }
}

__device__ __forceinline__ float wave_sum_dpp(float v) {
  typedef __attribute__((ext_vector_type(2))) unsigned u32x2_d;
  v += __builtin_bit_cast(float, __builtin_amdgcn_update_dpp(0, __builtin_bit_cast(int, v), 0xB1, 0xF, 0xF, true));
  v += __builtin_bit_cast(float, __builtin_amdgcn_update_dpp(0, __builtin_bit_cast(int, v), 0x4E, 0xF, 0xF, true));
  v += __builtin_bit_cast(float, __builtin_amdgcn_update_dpp(0, __builtin_bit_cast(int, v), 0x141, 0xF, 0xF, true));
  v += __builtin_bit_cast(float, __builtin_amdgcn_update_dpp(0, __builtin_bit_cast(int, v), 0x140, 0xF, 0xF, true));
  u32x2_d r = __builtin_amdgcn_permlane16_swap(__float_as_uint(v), __float_as_uint(v), false, false);
  v = __uint_as_float(r[0]) + __uint_as_float(r[1]);
  r = __builtin_amdgcn_permlane32_swap(__float_as_uint(v), __float_as_uint(v), false, false);
  return __uint_as_float(r[0]) + __uint_as_float(r[1]);
}
__device__ __forceinline__ float gelu_rcp(float x) {
  const float y2 = (1.5957691216057308f * LOG2E) * (x + 0.044715f * x * x * x);
  return x * __builtin_amdgcn_rcpf(1.f + __builtin_amdgcn_exp2f(-y2));
}
__device__ __forceinline__ u32x4 r4_load(const unsigned char* tab, int eid, int lane) {
  return *((const u32x4*)(tab + (size_t)eid * 1024) + lane);
}
struct XPk { f32x16 a, b; };
struct Acc32 { f32x16 a, b; };

typedef __attribute__((ext_vector_type(2))) float f32x2_t;
#define PAIR(v, i) __builtin_shufflevector(v, v, (i), (i) + 1)
#define R4_DOT_W(word, xv, base, sa, sb)                                                             \
  {                                                                                                  \
    const f32x2_t q0 = __builtin_amdgcn_cvt_scalef32_pk_f32_fp4(word, one, 0), q1 = __builtin_amdgcn_cvt_scalef32_pk_f32_fp4(word, one, 1); \
    const f32x2_t q2 = __builtin_amdgcn_cvt_scalef32_pk_f32_fp4(word, one, 2), q3 = __builtin_amdgcn_cvt_scalef32_pk_f32_fp4(word, one, 3); \
    sa = __builtin_elementwise_fma(q0, PAIR(xv, base + 0), sa); sb = __builtin_elementwise_fma(q1, PAIR(xv, base + 2), sb); \
    sa = __builtin_elementwise_fma(q2, PAIR(xv, base + 4), sa); sb = __builtin_elementwise_fma(q3, PAIR(xv, base + 6), sb); \
  }
__device__ __forceinline__ float r4_dot(const u32x4& e, const XPk& x) {
  const float one = __uint_as_float((unsigned)opq(0x3F800000));
  f32x2_t sa = {0.f, 0.f}, sb = {0.f, 0.f};
  R4_DOT_W(e[0], x.a, 0, sa, sb) R4_DOT_W(e[1], x.a, 8, sa, sb) R4_DOT_W(e[2], x.b, 0, sa, sb) R4_DOT_W(e[3], x.b, 8, sa, sb)
  sa = sa + sb;
  return sa[0] + sa[1];
}
#define R4_AXPY_P(accv, i, q)                                                                        \
  { const f32x2_t r_ = __builtin_elementwise_fma(h2, q, PAIR(accv, i)); accv[i] = r_[0]; accv[(i) + 1] = r_[1]; }
#define R4_AXPY_W(word, accv, base)                                                                  \
  {                                                                                                  \
    const f32x2_t q0 = __builtin_amdgcn_cvt_scalef32_pk_f32_fp4(word, one, 0), q1 = __builtin_amdgcn_cvt_scalef32_pk_f32_fp4(word, one, 1); \
    const f32x2_t q2 = __builtin_amdgcn_cvt_scalef32_pk_f32_fp4(word, one, 2), q3 = __builtin_amdgcn_cvt_scalef32_pk_f32_fp4(word, one, 3); \
    R4_AXPY_P(accv, base + 0, q0) R4_AXPY_P(accv, base + 2, q1) R4_AXPY_P(accv, base + 4, q2) R4_AXPY_P(accv, base + 6, q3) \
  }
__device__ __forceinline__ void r4_axpy(const u32x4& e, float hid, Acc32& acc) {
  const float one = __uint_as_float((unsigned)opq(0x3F800000));
  const f32x2_t h2 = {hid, hid};
  R4_AXPY_W(e[0], acc.a, 0) R4_AXPY_W(e[1], acc.a, 8) R4_AXPY_W(e[2], acc.b, 0) R4_AXPY_W(e[3], acc.b, 8)
}

#define INS16(K, x)                                                                                      \
  K##15 = __builtin_amdgcn_fmed3f(K##15, K##14, x); K##14 = __builtin_amdgcn_fmed3f(K##14, K##13, x);   \
  K##13 = __builtin_amdgcn_fmed3f(K##13, K##12, x); K##12 = __builtin_amdgcn_fmed3f(K##12, K##11, x);   \
  K##11 = __builtin_amdgcn_fmed3f(K##11, K##10, x); K##10 = __builtin_amdgcn_fmed3f(K##10, K##9, x);    \
  K##9 = __builtin_amdgcn_fmed3f(K##9, K##8, x); K##8 = __builtin_amdgcn_fmed3f(K##8, K##7, x);         \
  K##7 = __builtin_amdgcn_fmed3f(K##7, K##6, x); K##6 = __builtin_amdgcn_fmed3f(K##6, K##5, x);         \
  K##5 = __builtin_amdgcn_fmed3f(K##5, K##4, x); K##4 = __builtin_amdgcn_fmed3f(K##4, K##3, x);         \
  K##3 = __builtin_amdgcn_fmed3f(K##3, K##2, x); K##2 = __builtin_amdgcn_fmed3f(K##2, K##1, x);         \
  K##1 = __builtin_amdgcn_fmed3f(K##1, K##0, x); K##0 = fmaxf(K##0, x);
#define DECL16(K) float K##0 = -INFINITY, K##1 = -INFINITY, K##2 = -INFINITY, K##3 = -INFINITY, K##4 = -INFINITY, \
  K##5 = -INFINITY, K##6 = -INFINITY, K##7 = -INFINITY, K##8 = -INFINITY, K##9 = -INFINITY, K##10 = -INFINITY,   \
  K##11 = -INFINITY, K##12 = -INFINITY, K##13 = -INFINITY, K##14 = -INFINITY, K##15 = -INFINITY;
__device__ __forceinline__ float mkkey(float v, unsigned tag, unsigned mask) {
  return __uint_as_float((__float_as_uint(v) & ~mask) | tag);
}

__device__ __forceinline__ void ph_peer(const P& p, float* smem) {
  typedef __attribute__((ext_vector_type(4))) float f32x4;
  float* lists = smem;
  int* bexA = (int*)(smem + 4096);
  float* bgtA = smem + 6144;
  float* bsuA = smem + 8192;
  for (int item = blockIdx.x; item < T_TOK / 16; item += gridDim.x) {
    const int t0 = item * 16;
    __syncthreads();
    {
      const int tid = opq(threadIdx.x);
      const int tl = tid >> 4, hp = tid & 15;
      const f32x4* sp = (const f32x4*)(p.scores + (size_t)(t0 + tl) * DM + hp * 128);
      DECL16(k)
#pragma unroll 4
      for (int c4 = 0; c4 < 32; ++c4) {
        const f32x4 v = sp[c4];
#pragma unroll
        for (int e = 0; e < 4; ++e) {
          const float x = mkkey(v[e], 127u - (unsigned)(c4 * 4 + e), 127u);
          INS16(k, x)
        }
      }
      f32x4* lp = (f32x4*)(lists + (size_t)opq(threadIdx.x) * 16);
      f32x4 o0 = {k0, k1, k2, k3}, o1 = {k4, k5, k6, k7}, o2 = {k8, k9, k10, k11}, o3 = {k12, k13, k14, k15};
      lp[0] = o0; lp[1] = o1; lp[2] = o2; lp[3] = o3;
    }
    __syncthreads();
    if (opq(threadIdx.x) < 128) {
      const int tid = opq(threadIdx.x);
      const int tl = tid >> 3, h = tid & 7;
      const float* la = lists + (size_t)(tl * 16 + 2 * h) * 16;
      const float* lb = la + 16;
      float av[16], bv[16];
#pragma unroll
      for (int i = 0; i < 16; ++i) {
        av[i] = __uint_as_float(__float_as_uint(la[i]) & ~127u);
        bv[i] = __uint_as_float(__float_as_uint(lb[i]) & ~127u);
      }
      DECL16(c)
#pragma unroll
      for (int i = 0; i < 16; ++i) {
#pragma unroll
        for (int j = 0; j < 16; ++j) {
          if ((i + 1) * (j + 1) <= 16) {
            const float x = mkkey(av[i] + bv[j], 255u - (unsigned)(i * 16 + j), 255u);
            INS16(c, x)
          }
        }
      }
      float cs[16] = {c0, c1, c2, c3, c4, c5, c6, c7, c8, c9, c10, c11, c12, c13, c14, c15};
      float ev[16];
      float sum = 0.f;
      const float mx = __uint_as_float(__float_as_uint(cs[0]) & ~255u);
#pragma unroll
      for (int n = 0; n < 16; ++n) {
        ev[n] = __expf(__uint_as_float(__float_as_uint(cs[n]) & ~255u) - mx);
        sum += ev[n];
      }
      const float isum = 1.f / sum;
#pragma unroll
      for (int n = 0; n < 16; ++n) {
        const unsigned cc = 255u - (__float_as_uint(cs[n]) & 255u);
        const unsigned ka = 127u - (__float_as_uint(la[cc >> 4]) & 127u);
        const unsigned kb = 127u - (__float_as_uint(lb[cc & 15u]) & 127u);
        const int eid = (int)(ka * 128u + kb);
        bexA[tl * 128 + h * 16 + n] = eid;
        bgtA[tl * 128 + h * 16 + n] = ev[n] * isum * p.sv8[eid];
        bsuA[tl * 128 + h * 16 + n] = p.su8[eid];
      }
    }
    __syncthreads();
#pragma unroll 1
    for (int ti4 = 0; ti4 < 4; ++ti4) {
    const int lane = opq(threadIdx.x) & 63, wv = opq(threadIdx.x) >> 6;
    const int tl = wv * 4 + ti4;
    const int t = t0 + tl;
    const int* bex = bexA + tl * 128;
    const float* bgt = bgtA + tl * 128;
    const float* bsu = bsuA + tl * 128;
    XPk x;
    {
      const f32x4* s4 = (const f32x4*)(p.out + (size_t)t * DM) + lane * 8;
      const f32x4* g4 = (const f32x4*)p.norm_ffn + lane * 8;
      f32x4 a0 = s4[0], a1 = s4[1], a2 = s4[2], a3 = s4[3], a4 = s4[4], a5 = s4[5], a6 = s4[6], a7 = s4[7];
      float ss = 0.f;
#define SSQ(v) ss += v[0] * v[0] + v[1] * v[1] + v[2] * v[2] + v[3] * v[3];
      SSQ(a0) SSQ(a1) SSQ(a2) SSQ(a3) SSQ(a4) SSQ(a5) SSQ(a6) SSQ(a7)
#undef SSQ
      ss = wave_sum(ss);
      const float rs = rsqrtf(ss * (1.f / DM) + RMS_EPS);
#define XPK(dst, base, va, vb, gi)                                                    \
  {                                                                                   \
    const f32x4 ga = g4[gi], gb = g4[gi + 1];                                         \
    dst[base + 0] = bf2f(f2bf(va[0] * rs * ga[0])); dst[base + 1] = bf2f(f2bf(va[1] * rs * ga[1]));   \
    dst[base + 2] = bf2f(f2bf(va[2] * rs * ga[2])); dst[base + 3] = bf2f(f2bf(va[3] * rs * ga[3]));   \
    dst[base + 4] = bf2f(f2bf(vb[0] * rs * gb[0])); dst[base + 5] = bf2f(f2bf(vb[1] * rs * gb[1]));   \
    dst[base + 6] = bf2f(f2bf(vb[2] * rs * gb[2])); dst[base + 7] = bf2f(f2bf(vb[3] * rs * gb[3]));   \
  }
      XPK(x.a, 0, a0, a1, 0) XPK(x.a, 8, a2, a3, 2) XPK(x.b, 0, a4, a5, 4) XPK(x.b, 8, a6, a7, 6)
#undef XPK
    }
    Acc32 acc;
#pragma unroll
    for (int r = 0; r < 16; ++r) { acc.a[r] = 0.f; acc.b[r] = 0.f; }
    u32x4 u0 = r4_load(p.pu8, bex[0], lane), u1 = r4_load(p.pu8, bex[1], lane), u2 = r4_load(p.pu8, bex[2], lane), u3 = r4_load(p.pu8, bex[3], lane);
    u32x4 v0 = r4_load(p.pv8, bex[0], lane), v1 = r4_load(p.pv8, bex[1], lane), v2 = r4_load(p.pv8, bex[2], lane), v3 = r4_load(p.pv8, bex[3], lane);
#pragma unroll 1
    for (int e0 = 0; e0 < 128; e0 += 4) {
      float d0 = r4_dot(u0, x), d1 = r4_dot(u1, x), d2 = r4_dot(u2, x), d3 = r4_dot(u3, x);
      const int en = (e0 + 4 < 128) ? e0 + 4 : 124;
      const int i0 = bex[en], i1 = bex[en + 1], i2 = bex[en + 2], i3 = bex[en + 3];
      u0 = r4_load(p.pu8, i0, lane); u1 = r4_load(p.pu8, i1, lane); u2 = r4_load(p.pu8, i2, lane); u3 = r4_load(p.pu8, i3, lane);
      d0 = wave_sum_dpp(d0); d1 = wave_sum_dpp(d1); d2 = wave_sum_dpp(d2); d3 = wave_sum_dpp(d3);
      { const float hid = bgt[e0 + 0] * gelu_rcp(d0 * bsu[e0 + 0]); r4_axpy(v0, hid, acc); }
      { const float hid = bgt[e0 + 1] * gelu_rcp(d1 * bsu[e0 + 1]); r4_axpy(v1, hid, acc); }
      { const float hid = bgt[e0 + 2] * gelu_rcp(d2 * bsu[e0 + 2]); r4_axpy(v2, hid, acc); }
      { const float hid = bgt[e0 + 3] * gelu_rcp(d3 * bsu[e0 + 3]); r4_axpy(v3, hid, acc); }
      v0 = r4_load(p.pv8, i0, lane); v1 = r4_load(p.pv8, i1, lane); v2 = r4_load(p.pv8, i2, lane); v3 = r4_load(p.pv8, i3, lane);
    }
    const int lane2 = opq(lane);
    f32x4* o4 = (f32x4*)(p.out + (size_t)t * DM) + lane2 * 8;
    const f32x4* g4 = (const f32x4*)p.norm_final + lane2 * 8;
    f32x4 hv[8];
    float ss = 0.f;
#pragma unroll
    for (int i = 0; i < 8; ++i) {
      hv[i] = o4[i];
#pragma unroll
      for (int k = 0; k < 4; ++k) {
        hv[i][k] += (i < 4) ? acc.a[4 * i + k] : acc.b[4 * (i - 4) + k];
        ss += hv[i][k] * hv[i][k];
      }
    }
    ss = wave_sum(ss);
    const float rs = rsqrtf(ss * (1.f / DM) + RMS_EPS);
#pragma unroll
    for (int i = 0; i < 8; ++i) {
      const f32x4 g = g4[i];
      f32x4 o;
#pragma unroll
      for (int k = 0; k < 4; ++k) o[k] = hv[i][k] * rs * g[k];
      o4[i] = o;
    }
    }
  }
}

#define XB_TMO      128
#define XB_XCNT(j)  (256  + 64 * (j))
#define XB_XSUB(j)  (1280 + 64 * (j))
#define XB_XGEN(j)  (2304 + 64 * (j))
#define XB_TOP      3328
#define XB_TOPGEN   3392
#define XCD_BAR_WORDS 3456
#define XB_SPIN_CAP (1u << 22)
#define LAS __attribute__((address_space(3)))
__device__ __forceinline__ unsigned xb_ld(unsigned* p) { return __hip_atomic_load(p, __ATOMIC_RELAXED, __HIP_MEMORY_SCOPE_AGENT); }
__device__ __forceinline__ unsigned xb_add(unsigned* p, unsigned v) { return __hip_atomic_fetch_add(p, v, __ATOMIC_RELAXED, __HIP_MEMORY_SCOPE_AGENT); }
__device__ __forceinline__ unsigned xb_xcc_id() { return (unsigned)__builtin_amdgcn_s_getreg((3 << 11) | 20) & 0xFu; }
#define XB_SPIN(cond, bar) do { unsigned _sp = 0; while (cond) { __builtin_amdgcn_s_sleep(1); \
    if ((++_sp & 255u) == 0u) { if (xb_ld(&(bar)[XB_TMO])) break; if (_sp > XB_SPIN_CAP) { atomicAdd(&(bar)[XB_TMO], 1u); break; } } } } while (0)
struct XcdBarrier { unsigned* bar; unsigned x; volatile LAS unsigned* st; };
__device__ __forceinline__ XcdBarrier xcd_barrier_post(unsigned* bar, volatile LAS unsigned* st) {
  XcdBarrier b; b.bar = bar; b.x = xb_xcc_id(); b.st = st;
  if (threadIdx.x == 0) (void)xb_add(&bar[XB_XCNT(b.x)], 1u);
  return b;
}
__device__ __forceinline__ void xcd_barrier_complete(unsigned* bar, unsigned x, unsigned& nloc, unsigned& nx) {
  const unsigned G = gridDim.x * gridDim.y * gridDim.z;
  unsigned sum, cnt, mine, sp = 0u;
  for (;;) {
    sum = 0u; cnt = 0u; mine = 0u;
#pragma unroll
    for (unsigned j = 0; j < 16; ++j) { const unsigned c = xb_ld(&bar[XB_XCNT(j)]); sum += c; cnt += (c > 0u) ? 1u : 0u; mine = (j == x) ? c : mine; }
    if (sum == G) break;
    __builtin_amdgcn_s_sleep(1);
    if ((++sp & 255u) == 0u) { if (xb_ld(&bar[XB_TMO])) break; if (sp > XB_SPIN_CAP) { atomicAdd(&bar[XB_TMO], 1u); break; } }
  }
  nloc = mine > 0u ? mine : 1u; nx = cnt > 0u ? cnt : 1u;
}
__device__ __forceinline__ void xcd_barrier(const XcdBarrier& b) {
  asm volatile("s_waitcnt vmcnt(0)" ::: "memory");
  __syncthreads();
  if (threadIdx.x == 0) {
    unsigned* bar = b.bar;
    __builtin_amdgcn_s_waitcnt(0);
    unsigned nloc = b.st[0], nx = b.st[1];
    if (nloc == 0u) { xcd_barrier_complete(bar, b.x, nloc, nx); b.st[0] = nloc; b.st[1] = nx; }
    const unsigned old = xb_add(&bar[XB_XSUB(b.x)], 1u);
    const unsigned gen = old / nloc;
    if (old + 1u == (gen + 1u) * nloc) {
      __builtin_amdgcn_fence(__ATOMIC_RELEASE, "agent");
      asm volatile("s_waitcnt vmcnt(0)" ::: "memory");
      const unsigned og = xb_add(&bar[XB_TOP], 1u);
      const unsigned tg = og / nx;
      if (og + 1u == (tg + 1u) * nx) xb_add(&bar[XB_TOPGEN], 1u);
      else XB_SPIN(xb_ld(&bar[XB_TOPGEN]) == tg, bar);
      __builtin_amdgcn_fence(__ATOMIC_ACQUIRE, "agent");
      xb_add(&bar[XB_XGEN(b.x)], 1u);
      asm volatile("s_waitcnt vmcnt(0)" ::: "memory");
    } else {
      XB_SPIN(xb_ld(&bar[XB_XGEN(b.x)]) == gen, bar);
      __builtin_amdgcn_fence(__ATOMIC_ACQUIRE, "agent");
      asm volatile("s_waitcnt vmcnt(0)" ::: "memory");
    }
  }
  __syncthreads();
}

typedef const __attribute__((address_space(4))) P* KP;
__device__ __forceinline__ P loadP() {
#if defined(__HIP_DEVICE_COMPILE__)
  KP k = (KP)__builtin_amdgcn_kernarg_segment_ptr();
  asm volatile("" : "+s"(k));
  P p = *k;
  return p;
#else
  return P{};
#endif
}

__global__ void __launch_bounds__(256, 2) mega(P p_arg) {
  cg::grid_group grid = cg::this_grid();
  __shared__ __attribute__((aligned(16))) float smem[18432];
  char* lds = (char*)smem;
  __shared__ uint4 xb_words;
  if (threadIdx.x == 0) xb_words = make_uint4(0u, 0u, 0u, 0u);
  if (blockIdx.x == 0) {
    P p = loadP();
    for (int i = threadIdx.x; i < XCD_BAR_WORDS; i += 256) p.bar[i] = 0u;
  }
  { P p = loadP(); ph_rmsnorm(p.x, p.norm_mix, p.hn, T_TOK); ph_rmsnorm(p.mem, p.norm_mkv, p.memn, 1024); }
  { P p = loadP(); ph_transpose<true>(smem, p.w_in, DM, INC, 5760, p.WinT); }
  { P p = loadP(); ph_transpose<false>(smem, p.w_mk, DM, 512, 512, p.WmkT); }
  { P p = loadP(); ph_transpose<false>(smem, p.w_mv, DM, 512, 512, p.WmvT); }
  { P p = loadP(); ph_cvt(p.subk, p.subkb, (size_t)16 * 128 * 128); }
  { P p = loadP(); ph_transpose<false>(smem, p.w1_k, 4096, 128, 128, p.w1T); }
  { P p = loadP(); ph_transpose<false>(smem, p.w1_v, 4096, 128, 128, p.w1T + 128 * 4096); }
  { P p = loadP(); ph_transpose<false>(smem, p.w2_k, 128, 128, 128, p.w2T); }
  { P p = loadP(); ph_transpose<false>(smem, p.w2_v, 128, 128, 128, p.w2T + 128 * 128); }
  { P p = loadP(); ph_posb(p); }
  { P p = loadP(); for (int i = blockIdx.x * 256 + opq(threadIdx.x); i < 2 * T_TOK; i += gridDim.x * 256) p.rowss[i] = 0.f; }
  grid.sync();
  XcdBarrier xb;
  { P p = loadP(); xb = xcd_barrier_post(p.bar, (volatile LAS unsigned*)&xb_words); }
  { P p = loadP(); ph_proj(p, lds); }
  const int kvb = (gridDim.x == 512) ? (((int)blockIdx.x >= 320 && (int)blockIdx.x < 352) ? ((int)blockIdx.x - 320) * 8 : -1) : -2;
  const int vvb = (gridDim.x == 512) ? (((int)blockIdx.x >= 352 && (int)blockIdx.x < 384) ? ((int)blockIdx.x - 352) * 8 : -1) : -2;
  { P p = loadP(); bf16_t* kmem = p.kmemb;
    ph_gemm_bf16(p.memn, DM, p.WmkT, DM, 1024, 512, DM, lds, [=](int m, int n, float v) {
      kmem[((size_t)((m >> 8) * 4 + (n >> 7)) * 256 + (m & 255)) * 128 + (n & 127)] = f2bf(v); }, kvb); }
  { P p = loadP(); bf16_t* vmem = p.vmemT;
    ph_gemm_bf16(p.memn, DM, p.WmvT, DM, 1024, 512, DM, lds, [=](int m, int n, float v) {
      vmem[((size_t)((m >> 8) * 4 + (n >> 7)) * 128 + (n & 127)) * 256 + perm16(m & 255)] = f2bf(v); }, vvb); }
  xcd_barrier(xb);
  { P p = loadP(); ph_compress2(p, lds); }
  { P p = loadP(); ph_sb2(p, lds); }
  {
    const int skip = (gridDim.x > 32) ? 16 : 0;
    const int vb = ((int)blockIdx.x >= skip) ? (int)blockIdx.x - skip : -1, nvb = (int)gridDim.x - skip;
    __syncthreads();
    { P p = loadP(); ph_transpose<false>(smem, p.w_out, DM, DM, DM, p.WoutT, vb, nvb); }
    { P p = loadP(); ph_transpose<false>(smem, p.w_mq, DM, 512, 512, p.WmqT, vb, nvb); }
  }
  xcd_barrier(xb);
  { P p = loadP(); ph_nsa2(p, lds); }
  xcd_barrier(xb);
  { P p = loadP(); float* out = p.out; const float* x = p.x; const float* gmq = p.norm_mq; bf16_t* hn = p.hn; float* rss = p.rowss;
    ph_gemm_big(p.omix, DM, p.WoutT, DM, T_TOK, DM, DM, lds, [=](int m, int n, f32x4_e lo, f32x4_e hi) {
      const f32x4_e x0 = *(const f32x4_e*)(x + (size_t)m * DM + n), x1 = *(const f32x4_e*)(x + (size_t)m * DM + n + 4);
      const f32x4_e h0 = x0 + lo, h1 = x1 + hi;
      *(f32x4_e*)(out + (size_t)m * DM + n) = h0; *(f32x4_e*)(out + (size_t)m * DM + n + 4) = h1;
      norm_feed(h0, h1, gmq, n, hn + (size_t)m * DM, rss + m); }); }
  xcd_barrier(xb);
  {
    const int half = (gridDim.x >= 512) ? 256 : 0;
    if (half == 0 || (int)blockIdx.x < half) { P p = loadP(); ph_memq_attn(p, lds, (int)blockIdx.x, half ? half : (int)gridDim.x); }
    if ((int)blockIdx.x >= half) {
      const int nwv = ((int)gridDim.x - half) * 4, wid = ((int)blockIdx.x - half) * 4 + (opq(threadIdx.x) >> 6);
      __syncthreads();
      { P p = loadP(); ph_transpose<false>(smem, p.w_mo, 512, DM, DM, p.WmoT, (int)blockIdx.x - half, (int)gridDim.x - half); }
      { P p = loadP(); ph_cvt4(p.pu, p.pu8, p.su8, 16384, wid, nwv); }
      { P p = loadP(); ph_cvt4(p.pv, p.pv8, p.sv8, 16384, wid, nwv); }
      __syncthreads();
      { P p = loadP(); ph_transpose<false>(smem, p.w_pq, DM, DM, DM, p.WpqT, (int)blockIdx.x - half, (int)gridDim.x - half); }
    }
  }
  xcd_barrier(xb);
  { P p = loadP(); float* out = p.out; const float* gffn = p.norm_ffn; bf16_t* hn = p.hn; float* rss = p.rowss + T_TOK;
    ph_gemm_big(p.omem, 512, p.WmoT, 512, T_TOK, DM, 512, lds, [=](int m, int n, f32x4_e lo, f32x4_e hi) {
      f32x4_e* o0 = (f32x4_e*)(out + (size_t)m * DM + n);
      const f32x4_e h0 = o0[0] + lo, h1 = o0[1] + hi;
      o0[0] = h0; o0[1] = h1;
      norm_feed(h0, h1, gffn, n, hn + (size_t)m * DM, rss + m); }); }
  xcd_barrier(xb);
  { P p = loadP(); ph_qp_scores(p, lds); }
  xcd_barrier(xb);
  { P p = loadP(); ph_peer(p, smem); }
}

extern "C" void kernel_launch(void* const* d_in, const int* in_sizes, int n_in, void* d_out, int out_size, void* d_ws,
                              size_t ws_size, hipStream_t stream) {
  P p{};
  p.x = (const float*)d_in[0]; p.mem = (const float*)d_in[1]; p.t5 = (const float*)d_in[2];
  p.norm_mix = (const float*)d_in[3]; p.w_in = (const float*)d_in[4]; p.pos_k = (const float*)d_in[5];
  p.w1_k = (const float*)d_in[6]; p.w2_k = (const float*)d_in[7]; p.pos_v = (const float*)d_in[8];
  p.w1_v = (const float*)d_in[9]; p.w2_v = (const float*)d_in[10]; p.w_out = (const float*)d_in[11];
  p.norm_mq = (const float*)d_in[12]; p.norm_mkv = (const float*)d_in[13]; p.w_mq = (const float*)d_in[14];
  p.w_mk = (const float*)d_in[15]; p.w_mv = (const float*)d_in[16]; p.w_mo = (const float*)d_in[17];
  p.norm_ffn = (const float*)d_in[18]; p.w_pq = (const float*)d_in[19]; p.subk = (const float*)d_in[20];
  p.pu = (const float*)d_in[21]; p.pv = (const float*)d_in[22]; p.norm_final = (const float*)d_in[23];
  p.out = (float*)d_out;
  char* w = (char*)d_ws;
  size_t off = 0;
  auto take = [&](size_t bytes) { char* r = w + off; off += (bytes + 255) & ~(size_t)255; return r; };
  p.bar = (unsigned*)take(XCD_BAR_WORDS * 4);
  p.scores = (float*)take((size_t)T_TOK * DM * 4);
  p.gates = (float*)take((size_t)T_TOK * 24 * 4);
  p.part = (float*)take((size_t)T_TOK * 1024 * 4);
  p.posb = (float*)take(256 * 4);
  p.rowss = (float*)take((size_t)2 * T_TOK * 4);
  p.qn = (bf16_t*)take((size_t)T_TOK * 1024 * 2);
  p.kcin = (bf16_t*)take((size_t)T_TOK * 256 * 2 + 65536);
  p.vcin = (bf16_t*)take((size_t)T_TOK * 256 * 2 + 65536);
  p.ks = (bf16_t*)take((size_t)T_TOK * 256 * 2);
  p.vsT = (bf16_t*)take((size_t)T_TOK * 256 * 2);
  p.kw = (bf16_t*)take((size_t)T_TOK * 256 * 2);
  p.vwT = (bf16_t*)take((size_t)T_TOK * 256 * 2);
  p.kcb = (bf16_t*)take((size_t)8 * 128 * 128 * 2);
  p.vcT = (bf16_t*)take((size_t)8 * 128 * 128 * 2);
  p.c1 = (bf16_t*)take((size_t)16 * 128 * 128 * 2);
  p.w1T = (bf16_t*)take((size_t)2 * 128 * 4096 * 2);
  p.w2T = (bf16_t*)take((size_t)2 * 128 * 128 * 2);
  p.hn = (bf16_t*)take((size_t)T_TOK * DM * 2);
  p.omix = (bf16_t*)take((size_t)T_TOK * DM * 2);
  p.memn = (bf16_t*)take((size_t)1024 * DM * 2);
  p.omem = (bf16_t*)take((size_t)T_TOK * 512 * 2);
  p.WinT = (bf16_t*)take((size_t)5760 * DM * 2);
  p.WoutT = (bf16_t*)take((size_t)DM * DM * 2);
  p.WpqT = (bf16_t*)take((size_t)DM * DM * 2);
  p.WmqT = (bf16_t*)take((size_t)512 * DM * 2);
  p.WmkT = (bf16_t*)take((size_t)512 * DM * 2);
  p.WmvT = (bf16_t*)take((size_t)512 * DM * 2);
  p.WmoT = (bf16_t*)take((size_t)DM * 512 * 2);
  p.qmemb = (bf16_t*)take((size_t)T_TOK * 512 * 2);
  p.kmemb = (bf16_t*)take((size_t)1024 * 512 * 2);
  p.vmemT = (bf16_t*)take((size_t)1024 * 512 * 2);
  p.qsb = (bf16_t*)take((size_t)T_TOK * 1024 * 2);
  p.ksb = (bf16_t*)take((size_t)T_TOK * 1024 * 2);
  p.vsbT = (bf16_t*)take((size_t)T_TOK * 1024 * 2);
  p.pu8 = (unsigned char*)take((size_t)16384 * 1024);
  p.pv8 = (unsigned char*)take((size_t)16384 * 1024);
  p.su8 = (float*)take(16384 * 4);
  p.sv8 = (float*)take(16384 * 4);
  p.subkb = (bf16_t*)take((size_t)16 * 128 * 128 * 2);
  static int grid_blocks = 0;
  if (!grid_blocks) {
    int dev = 0, cus = 0, per_cu = 0;
    (void)hipGetDevice(&dev);
    (void)hipDeviceGetAttribute(&cus, hipDeviceAttributeMultiprocessorCount, dev);
    (void)hipOccupancyMaxActiveBlocksPerMultiprocessor(&per_cu, mega, 256, 0);
    if (per_cu > 2) per_cu = 2;
    if (per_cu < 1) per_cu = 1;
    grid_blocks = cus * per_cu;
  }
  void* args[] = {&p};
  hipError_t e = hipLaunchCooperativeKernel((void*)mega, dim3(grid_blocks), dim3(256), args, 0, stream);
  if (e != hipSuccess) fprintf(stderr, "cooperative launch failed: %s (grid %d)\n", hipGetErrorString(e), grid_blocks);
}
```

```cpp
#include <hip/hip_runtime.h>
#include <hip/hip_cooperative_groups.h>
#include <cstdio>
namespace cg = cooperative_groups;
#include <stdint.h>

#define SEQ 2048
#define NBATCH 4
#define T_TOK 8192
#define DM 2048
#define INC 5656
#define C_QN 0
#define C_KC 1024
#define C_VC 1280
#define C_KS 1536
#define C_VS 1792
#define C_KW 2048
#define C_VW 2304
#define C_GT 2560
#define C_QSB 2584
#define C_KSB 3608
#define C_VSB 4632
#define ATT_SCALE 0.08838834764831845f
#define LOG2E 1.4426950408889634f
#define ATT_SCALE2 (ATT_SCALE * LOG2E)
#define RMS_EPS 1e-6f

typedef unsigned short bf16_t;
typedef __attribute__((ext_vector_type(8))) short bf16x8;
typedef __attribute__((ext_vector_type(16))) float f32x16;
typedef __attribute__((ext_vector_type(2))) __bf16 bf16v2;
typedef __attribute__((ext_vector_type(4))) unsigned u32x4;

struct P {
  const float *x, *mem, *t5, *norm_mix, *w_in, *pos_k, *w1_k, *w2_k, *pos_v, *w1_v, *w2_v, *w_out,
      *norm_mq, *norm_mkv, *w_mq, *w_mk, *w_mv, *w_mo, *norm_ffn, *w_pq, *subk, *pu, *pv, *norm_final;
  float* out;
  float *scores, *gates, *part, *posb, *rowss;
  unsigned* bar;
  bf16_t *hn, *omix, *memn, *omem;
  bf16_t *WinT, *WoutT, *WpqT, *WmqT, *WmkT, *WmvT, *WmoT;
  bf16_t *qmemb, *kmemb, *vmemT;
  bf16_t *qsb, *ksb, *vsbT;
  bf16_t* subkb;
  unsigned char *pu8, *pv8;
  float *su8, *sv8;
  bf16_t *qn, *kcin, *vcin, *ks, *vsT, *kw, *vwT, *kcb, *vcT, *c1, *w1T, *w2T;
};

__device__ __forceinline__ int opq(int v) { asm volatile("" : "+v"(v)); return v; }
__device__ __forceinline__ unsigned pack2(float a, float b) {
  bf16v2 r = {(__bf16)a, (__bf16)b};
  return *(unsigned*)&r;
}
__device__ __forceinline__ bf16_t f2bf(float a) {
  __bf16 r = (__bf16)a;
  return *(bf16_t*)&r;
}
__device__ __forceinline__ int perm16(int s) { return (s & ~12) | ((s & 4) << 1) | ((s & 8) >> 1); }
__device__ __forceinline__ float bf2f(bf16_t u) { return __uint_as_float((unsigned)u << 16); }

__device__ __forceinline__ float wave_max(float v) {
  for (int o = 32; o > 0; o >>= 1) v = fmaxf(v, __shfl_xor(v, o));
  return v;
}
__device__ __forceinline__ float wave_sum(float v) {
  for (int o = 32; o > 0; o >>= 1) v += __shfl_xor(v, o);
  return v;
}
__device__ __forceinline__ void wave_argmax(float& v, int& i) {
  for (int o = 32; o > 0; o >>= 1) {
    float ov = __shfl_xor(v, o);
    int oi = __shfl_xor(i, o);
    if (ov > v || (ov == v && oi < i)) { v = ov; i = oi; }
  }
}
__device__ __forceinline__ float gelu_tanh(float x) {
  return 0.5f * x * (1.f + tanhf(0.7978845608028654f * (x + 0.044715f * x * x * x)));
}
__device__ __forceinline__ float gelu_fast(float x) {
  const float y = 1.5957691216057308f * (x + 0.044715f * x * x * x);
  return x / (1.f + __expf(-y));
}
__device__ __forceinline__ int t5_bucket(int n) {
  if (n < 16) return n < 0 ? 0 : n;
  int b = 16;
  b += (n >= 19); b += (n >= 21); b += (n >= 24); b += (n >= 27); b += (n >= 31); b += (n >= 35);
  b += (n >= 40); b += (n >= 46); b += (n >= 52); b += (n >= 59); b += (n >= 67); b += (n >= 77);
  b += (n >= 87); b += (n >= 99); b += (n >= 113);
  return b;
}
__device__ __forceinline__ float log_sigmoid(float x) {
  return fminf(x, 0.f) - log1pf(expf(-fabsf(x)));
}

__device__ __forceinline__ void ph_rmsnorm(const float* src, const float* gain, bf16_t* dst, int rows) {
  int lane = opq(threadIdx.x) & 63, wv = opq(threadIdx.x) >> 6;
  for (int r = blockIdx.x * 4 + wv; r < rows; r += gridDim.x * 4) {
    const float4* s4 = (const float4*)(src + (size_t)r * DM);
    float4 v[8];
    float ss = 0.f;
#pragma unroll
    for (int i = 0; i < 8; ++i) {
      v[i] = s4[i * 64 + lane];
      ss += v[i].x * v[i].x + v[i].y * v[i].y + v[i].z * v[i].z + v[i].w * v[i].w;
    }
    ss = wave_sum(ss);
    float rs = rsqrtf(ss * (1.f / DM) + RMS_EPS);
    uint2* d2 = (uint2*)(dst + (size_t)r * DM);
    const float4* g4 = (const float4*)gain;
#pragma unroll
    for (int i = 0; i < 8; ++i) {
      float4 g = g4[i * 64 + lane];
      uint2 o;
      o.x = pack2(v[i].x * rs * g.x, v[i].y * rs * g.y);
      o.y = pack2(v[i].z * rs * g.z, v[i].w * rs * g.w);
      d2[i * 64 + lane] = o;
    }
  }
}

template <bool CMAP>
__device__ __forceinline__ void ph_transpose(float* smem, const float* W, int K, int N, int Npad, bf16_t* Wt,
                                             int vblock = -2, int nvb = 0) {
  typedef __attribute__((ext_vector_type(4))) float f32x4;
  float (*tl)[65] = (float (*)[65])smem;
  if (vblock == -1) return;
  const int b0 = (vblock >= 0) ? vblock : (int)blockIdx.x, bstride = (vblock >= 0) ? nvb : (int)gridDim.x;
  const int tid = opq(threadIdx.x);
  const int nk = K / 64, nn = Npad / 64;
  for (int tile = b0; tile < nk * nn; tile += bstride) {
    const int k0 = (tile % nk) * 64, n0 = (tile / nk) * 64;
    const int kr = tid >> 4, n4 = (tid & 15) * 4;
    int sc = n0 + n4;
    if (CMAP) sc = (sc < 2560) ? sc : (sc < 5632) ? sc + 24 : (sc < 5656) ? sc - 5632 + 2560 : N;
#pragma unroll
    for (int i = 0; i < 4; ++i) {
      const int k = kr + 16 * i;
      f32x4 v = {0.f, 0.f, 0.f, 0.f};
      if (sc < N) v = *(const f32x4*)(W + (size_t)(k0 + k) * N + sc);
      tl[k][n4 + 0] = v[0]; tl[k][n4 + 1] = v[1]; tl[k][n4 + 2] = v[2]; tl[k][n4 + 3] = v[3];
    }
    __syncthreads();
    int n = tid >> 2, kc = (tid & 3) * 16;
    unsigned w[8];
#pragma unroll
    for (int i = 0; i < 8; ++i) w[i] = pack2(tl[kc + 2 * i][n], tl[kc + 2 * i + 1][n]);
    uint4* dst = (uint4*)(Wt + (size_t)(n0 + n) * K + k0 + kc);
    dst[0] = make_uint4(w[0], w[1], w[2], w[3]);
    dst[1] = make_uint4(w[4], w[5], w[6], w[7]);
    __syncthreads();
  }
}

__device__ __forceinline__ int lds_off(int row, int chunk) { return row * 128 + ((chunk ^ ((row >> 1) & 7)) << 4); }

template <bool TR, bool VEC = false, class Epi>
__device__ __forceinline__ void gemm_tile_bf16(const bf16_t* xp, int ldx, const bf16_t* yp, int ldy, int K, char* lds,
                                               Epi epi) {
  const int tid = opq(threadIdx.x), lane = tid & 63, wv = tid >> 6;
  const int wr = wv >> 1, wc = wv & 1;
  f32x16 acc[2][2];
#pragma unroll
  for (int i = 0; i < 2; ++i)
#pragma unroll
    for (int j = 0; j < 2; ++j)
#pragma unroll
      for (int r = 0; r < 16; ++r) acc[i][j][r] = 0.f;
  const int prow = lane >> 3, pch = lane & 7;
  const bf16_t* xs[4];
  const bf16_t* ys[4];
#pragma unroll
  for (int ps = 0; ps < 4; ++ps) {
    const int row = (wv * 4 + ps) * 8 + prow;
    const int c = pch ^ ((row >> 1) & 7);
    xs[ps] = xp + (size_t)row * ldx + c * 8;
    ys[ps] = yp + (size_t)row * ldy + c * 8;
  }
  char* const mydst = lds + wv * 4096 + lane * 16;
#define GEMM_ISSUE(k0, bufoff)                                                                                              \
  _Pragma("unroll") for (int ps = 0; ps < 4; ++ps) {                                                                        \
    __builtin_amdgcn_global_load_lds((const unsigned*)(xs[ps] + (k0)), (unsigned*)(mydst + (bufoff) + ps * 1024), 16, 0, 0);         \
    __builtin_amdgcn_global_load_lds((const unsigned*)(ys[ps] + (k0)), (unsigned*)(mydst + (bufoff) + 16384 + ps * 1024), 16, 0, 0); \
  }
#define GEMM_COMPUTE(bufoff)                                                                                     \
  _Pragma("unroll") for (int kk = 0; kk < 4; ++kk) {                                                             \
    bf16x8 a[2], b[2];                                                                                           \
    const int ch = kk * 2 + (lane >> 5);                                                                         \
    _Pragma("unroll") for (int i = 0; i < 2; ++i) {                                                              \
      a[i] = *(const bf16x8*)(lds + (bufoff) + (TR ? 16384 : 0) + lds_off(wr * 64 + i * 32 + (lane & 31), ch)); \
      b[i] = *(const bf16x8*)(lds + (bufoff) + (TR ? 0 : 16384) + lds_off(wc * 64 + i * 32 + (lane & 31), ch)); \
    }                                                                                                            \
    _Pragma("unroll") for (int i = 0; i < 2; ++i)                                                                \
      _Pragma("unroll") for (int j = 0; j < 2; ++j)                                                              \
        acc[i][j] = __builtin_amdgcn_mfma_f32_32x32x16_bf16(a[i], b[j], acc[i][j], 0, 0, 0);                    \
  }
  __syncthreads();
  GEMM_ISSUE(0, 0)
  for (int k0 = 0; k0 < K; k0 += 128) {
    asm volatile("s_waitcnt vmcnt(0)" ::: "memory");
    __syncthreads();
    GEMM_ISSUE(k0 + 64, 32768)
    GEMM_COMPUTE(0)
    asm volatile("s_waitcnt vmcnt(0)" ::: "memory");
    __syncthreads();
    if (k0 + 128 < K) { GEMM_ISSUE(k0 + 128, 0) }
    GEMM_COMPUTE(32768)
  }
#undef GEMM_ISSUE
#undef GEMM_COMPUTE
  int lane2 = lane;
  asm volatile("" : "+v"(lane2));
  if constexpr (VEC) {
    typedef __attribute__((ext_vector_type(4))) float f32x4;
    __syncthreads();
    float* wl = (float*)lds + wv * (32 * 68);
    const int hh2 = lane2 >> 5, cl = lane2 & 31;
#pragma unroll
    for (int i = 0; i < 2; ++i) {
#pragma unroll
      for (int j = 0; j < 2; ++j)
#pragma unroll
        for (int r = 0; r < 16; ++r) wl[((r & 3) + 8 * (r >> 2) + 4 * hh2) * 68 + j * 32 + cl] = acc[i][j][r];
      __builtin_amdgcn_wave_barrier();
#pragma unroll
      for (int k = 0; k < 4; ++k) {
        const int row = (lane2 >> 3) + 8 * k, c8 = (lane2 & 7) * 8;
        const f32x4 lo = *(const f32x4*)&wl[row * 68 + c8];
        const f32x4 hi = *(const f32x4*)&wl[row * 68 + c8 + 4];
        epi(wr * 64 + i * 32 + row, wc * 64 + c8, lo, hi);
      }
      __builtin_amdgcn_wave_barrier();
    }
  } else {
#pragma unroll
    for (int i = 0; i < 2; ++i)
#pragma unroll
      for (int j = 0; j < 2; ++j)
#pragma unroll
        for (int r = 0; r < 16; ++r) {
          int rr = wr * 64 + i * 32 + (r & 3) + 8 * (r >> 2) + 4 * (lane2 >> 5);
          int cc = wc * 64 + j * 32 + (lane2 & 31);
          epi(rr, cc, acc[i][j][r]);
        }
  }
}

typedef __attribute__((ext_vector_type(4))) float f32x4_e;
__device__ __forceinline__ void st_bf16x8(bf16_t* dst, f32x4_e lo, f32x4_e hi) {
  u32x4 o;
  o[0] = pack2(lo[0], lo[1]); o[1] = pack2(lo[2], lo[3]); o[2] = pack2(hi[0], hi[1]); o[3] = pack2(hi[2], hi[3]);
  *(u32x4*)dst = o;
}

__device__ __forceinline__ int lds_off32(int row, int chunk) { return row * 64 + ((chunk ^ ((row >> 2) & 3)) << 4); }

template <class Epi>
__device__ __forceinline__ void gemm_tile_big(const bf16_t* xp, int ldx, const bf16_t* yp, int ldy, int K, char* lds,
                                              Epi epi) {
  const int tid = opq(threadIdx.x), lane = tid & 63, wv = tid >> 6;
  f32x16 acc[2][4];
#pragma unroll
  for (int i = 0; i < 2; ++i)
#pragma unroll
    for (int j = 0; j < 4; ++j)
#pragma unroll
      for (int r = 0; r < 16; ++r) acc[i][j][r] = 0.f;
  const int prow = lane >> 2, pch = lane & 3;
  const bf16_t* xs[4];
  const bf16_t* ys[2];
#pragma unroll
  for (int ps = 0; ps < 4; ++ps) {
    const int row = (wv * 4 + ps) * 16 + prow;
    xs[ps] = xp + (size_t)row * ldx + (pch ^ ((row >> 2) & 3)) * 8;
  }
#pragma unroll
  for (int ps = 0; ps < 2; ++ps) {
    const int row = (wv * 2 + ps) * 16 + prow;
    ys[ps] = yp + (size_t)row * ldy + (pch ^ ((row >> 2) & 3)) * 8;
  }
  char* const xdst = lds + wv * 4096 + lane * 16;
  char* const ydst = lds + 16384 + wv * 2048 + lane * 16;
#define BIG_ISSUE(k0, st)                                                                                                      \
  _Pragma("unroll") for (int ps = 0; ps < 4; ++ps)                                                                             \
    __builtin_amdgcn_global_load_lds((const unsigned*)(xs[ps] + (k0)), (unsigned*)(xdst + (st) + ps * 1024), 16, 0, 0);        \
  _Pragma("unroll") for (int ps = 0; ps < 2; ++ps)                                                                             \
    __builtin_amdgcn_global_load_lds((const unsigned*)(ys[ps] + (k0)), (unsigned*)(ydst + (st) + ps * 1024), 16, 0, 0);
#define DSR(dst, addr, off) asm volatile("ds_read_b128 %0, %1 offset:%2" : "=v"(dst) : "v"(addr), "i"(off) : "memory")
#define WAIT1(n, x) asm volatile("s_waitcnt lgkmcnt(" #n ")" : "+v"(x))
#define WAIT2(n, x, y) asm volatile("s_waitcnt lgkmcnt(" #n ")" : "+v"(x), "+v"(y))
#define MF(acc_, a_, b_) acc_ = __builtin_amdgcn_mfma_f32_32x32x16_bf16(a_, b_, acc_, 0, 0, 0)
#define BIG_COMPUTE(st)                                                                                   \
  {                                                                                                       \
    bf16x8 a00, a01, a10, a11, b00, b01, b02, b03, b10, b11, b12, b13;                                    \
    const unsigned aa0 = abase0 + (st), aa1 = abase1 + (st), bb0 = bbase0 + (st), bb1 = bbase1 + (st);    \
    DSR(a00, aa0, 0); DSR(b00, bb0, 0); DSR(b01, bb0, 2048); DSR(b02, bb0, 4096); DSR(b03, bb0, 6144);    \
    DSR(a01, aa0, 2048);                                                                                  \
    DSR(a10, aa1, 0); DSR(b10, bb1, 0); DSR(b11, bb1, 2048); DSR(b12, bb1, 4096); DSR(b13, bb1, 6144);    \
    DSR(a11, aa1, 2048);                                                                                  \
    WAIT2(10, a00, b00); MF(acc[0][0], a00, b00);                                                         \
    WAIT1(9, b01); MF(acc[0][1], a00, b01);                                                               \
    WAIT1(8, b02); MF(acc[0][2], a00, b02);                                                               \
    WAIT1(7, b03); MF(acc[0][3], a00, b03);                                                               \
    WAIT1(6, a01); MF(acc[1][0], a01, b00); MF(acc[1][1], a01, b01); MF(acc[1][2], a01, b02); MF(acc[1][3], a01, b03); \
    WAIT2(4, a10, b10); MF(acc[0][0], a10, b10);                                                          \
    WAIT1(3, b11); MF(acc[0][1], a10, b11);                                                               \
    WAIT1(2, b12); MF(acc[0][2], a10, b12);                                                               \
    WAIT1(1, b13); MF(acc[0][3], a10, b13);                                                               \
    WAIT1(0, a11); MF(acc[1][0], a11, b10); MF(acc[1][1], a11, b11); MF(acc[1][2], a11, b12); MF(acc[1][3], a11, b13); \
  }
  const unsigned ldsb = (unsigned)(size_t)(__attribute__((address_space(3))) char*)lds;
  const unsigned abase0 = ldsb + lds_off32(wv * 64 + (lane & 31), 0 + (lane >> 5));
  const unsigned abase1 = ldsb + lds_off32(wv * 64 + (lane & 31), 2 + (lane >> 5));
  const unsigned bbase0 = ldsb + 16384 + lds_off32((lane & 31), 0 + (lane >> 5));
  const unsigned bbase1 = ldsb + 16384 + lds_off32((lane & 31), 2 + (lane >> 5));
  const int nsteps = K >> 5;
  __syncthreads();
  BIG_ISSUE(0, 0)
  BIG_ISSUE(32, 24576)
  int cur = 0, nx2 = 49152;
  for (int t = 0; t < nsteps - 2; ++t) {
    asm volatile("s_waitcnt vmcnt(6)" ::: "memory");
    __builtin_amdgcn_s_barrier();
    BIG_ISSUE((t + 2) * 32, nx2)
    BIG_COMPUTE(cur)
    cur = (cur == 49152) ? 0 : cur + 24576;
    nx2 = (nx2 == 49152) ? 0 : nx2 + 24576;
  }
  asm volatile("s_waitcnt vmcnt(6)" ::: "memory");
  __builtin_amdgcn_s_barrier();
  BIG_COMPUTE(cur)
  cur = (cur == 49152) ? 0 : cur + 24576;
  asm volatile("s_waitcnt vmcnt(0)" ::: "memory");
  __builtin_amdgcn_s_barrier();
  BIG_COMPUTE(cur)
#undef BIG_ISSUE
#undef BIG_COMPUTE
#undef DSR
#undef WAIT1
#undef WAIT2
#undef MF
  const int lane2 = opq(lane);
  typedef __attribute__((ext_vector_type(4))) float f32x4;
  __syncthreads();
  float* wl = (float*)lds + wv * (32 * 68);
  const int hh2 = lane2 >> 5, cl = lane2 & 31;
#pragma unroll
  for (int i = 0; i < 2; ++i)
#pragma unroll
    for (int jh = 0; jh < 2; ++jh) {
#pragma unroll
      for (int j = 0; j < 2; ++j)
#pragma unroll
        for (int r = 0; r < 16; ++r) wl[((r & 3) + 8 * (r >> 2) + 4 * hh2) * 68 + j * 32 + cl] = acc[i][jh * 2 + j][r];
      __builtin_amdgcn_wave_barrier();
#pragma unroll
      for (int k = 0; k < 4; ++k) {
        const int row = (lane2 >> 3) + 8 * k, c8 = (lane2 & 7) * 8;
        const f32x4 lo = *(const f32x4*)&wl[row * 68 + c8];
        const f32x4 hi = *(const f32x4*)&wl[row * 68 + c8 + 4];
        epi(wv * 64 + i * 32 + row, jh * 64 + c8, lo, hi);
      }
      __builtin_amdgcn_wave_barrier();
    }
}

template <class Epi>
__device__ __forceinline__ void ph_gemm_big(const bf16_t* A, int lda, const bf16_t* Wt, int ldw, int M, int N, int K,
                                            char* lds, Epi epi) {
  const int ntm = M / 256, ntn = N / 128;
  const int npm = (ntm + 7) / 8, npn = (ntn + 7) / 8;
  const int nslots = ((npm * npn * 64 + 511) / 512) * 512;
  for (int u = blockIdx.x; u < nslots; u += gridDim.x) {
    int v = (u & 7) * 64 + ((u >> 3) & 63) + (u & ~511);
    int patch = v >> 6, w = v & 63;
    int tm = (patch % npm) * 8 + (w & 7);
    int tn = (patch / npm) * 8 + (w >> 3);
    if (tm >= ntm || tn >= ntn) continue;
    const int m0 = tm * 256, n0 = tn * 128;
    gemm_tile_big(A + (size_t)m0 * lda, lda, Wt + (size_t)n0 * ldw, ldw, K, lds,
                  [&](int r, int c, f32x4_e lo, f32x4_e hi) { epi(m0 + r, n0 + c, lo, hi); });
  }
}

__device__ __forceinline__ void norm_feed(const f32x4_e h0, const f32x4_e h1, const float* gain, int n, bf16_t* hn_row,
                                          float* rowss_m) {
  const f32x4_e g0 = *(const f32x4_e*)(gain + n), g1 = *(const f32x4_e*)(gain + n + 4);
  st_bf16x8(hn_row + n, h0 * g0, h1 * g1);
  float ss = h0[0] * h0[0] + h0[1] * h0[1] + h0[2] * h0[2] + h0[3] * h0[3] + h1[0] * h1[0] + h1[1] * h1[1] + h1[2] * h1[2] + h1[3] * h1[3];
  ss += __shfl_xor(ss, 1);
  ss += __shfl_xor(ss, 2);
  ss += __shfl_xor(ss, 4);
  if (((opq(threadIdx.x)) & 7) == 0) atomicAdd(rowss_m, ss);
}

template <bool VEC = false, class Epi>
__device__ __forceinline__ void ph_gemm_bf16(const bf16_t* A, int lda, const bf16_t* Wt, int ldw, int M, int N, int K,
                                             char* lds, Epi epi, int vblock = -2) {
  const int ntm = M / 128, ntn = N / 128;
  const int npm = (ntm + 7) / 8, npn = (ntn + 7) / 8;
  const int nslots = ((npm * npn * 64 + 511) / 512) * 512;
  if (vblock == -1) return;
  for (int u = (vblock >= 0 ? vblock : (int)blockIdx.x); u < nslots; u += gridDim.x) {
    int v = (u & 7) * 64 + ((u >> 3) & 63) + (u & ~511);
    int patch = v >> 6, w = v & 63;
    int tm = (patch % npm) * 8 + (w & 7);
    int tn = (patch / npm) * 8 + (w >> 3);
    if (tm >= ntm || tn >= ntn) continue;
    const int m0 = tm * 128, n0 = tn * 128;
    if constexpr (VEC)
      gemm_tile_bf16<false, true>(A + (size_t)m0 * lda, lda, Wt + (size_t)n0 * ldw, ldw, K, lds,
                                  [&](int r, int c, f32x4_e lo, f32x4_e hi) { epi(m0 + r, n0 + c, lo, hi); });
    else
      gemm_tile_bf16<false>(A + (size_t)m0 * lda, lda, Wt + (size_t)n0 * ldw, ldw, K, lds,
                            [&](int r, int c, float val) { epi(m0 + r, n0 + c, val); });
  }
}

__device__ __forceinline__ void ph_proj(const P& p, char* lds) {
  for (int u = blockIdx.x; u < 1024; u += gridDim.x) {
    int v = (u & 7) * 64 + ((u >> 3) & 63) + (u & ~511);
    int patch = v >> 6, w = v & 63;
    const int tm = (patch & 3) * 8 + (w & 7), tb = (patch >> 2) * 8 + (w >> 3);
    const int tn = (tb < 14) ? tb : (tb < 16) ? tb + 2 : tb + 4;
    const int m0 = tm * 256, n0 = tn * 128;
    const int b = m0 >> 11, sl = m0 & 2047;
    const bf16_t* A = p.hn + (size_t)m0 * DM;
    const bf16_t* W = p.WinT + (size_t)n0 * DM;
    bf16_t* dst;
    int ldd;
    if (n0 < 1024) { dst = p.qn + (size_t)m0 * 1024 + n0; ldd = 1024; }
    else if (n0 < 2560) {
      const int seg = (n0 - 1024) >> 8, g = ((n0 - 1024) >> 7) & 1;
      bf16_t* base = (seg == 0) ? p.kcin : (seg == 1) ? p.vcin : (seg == 2) ? p.ks : p.kw;
      dst = base + ((size_t)(b * 2 + g) * SEQ + sl) * 128; ldd = 128;
    } else if (n0 < 3584) { dst = p.qsb + (size_t)m0 * 1024 + (n0 - 2560); ldd = 1024; }
    else { dst = p.ksb + ((size_t)(b * 8 + ((n0 - 3584) >> 7)) * SEQ + sl) * 128; ldd = 128; }
    gemm_tile_big(A, DM, W, DM, DM, lds, [&](int r, int c, f32x4_e lo, f32x4_e hi) { st_bf16x8(dst + (size_t)r * ldd + c, lo, hi); });
  }
  for (int u = blockIdx.x; u < 64 * 13; u += gridDim.x) {
    const int tm = u & 63, ts = u >> 6;
    const int tn = (ts < 2) ? 14 + ts : (ts < 4) ? 16 + ts : (ts < 12) ? 32 + ts : 44;
    const int m0 = tm * 128, n0 = tn * 128;
    const int b = m0 >> 11, sl = m0 & 2047;
    const bf16_t* A = p.hn + (size_t)m0 * DM;
    const bf16_t* W = p.WinT + (size_t)n0 * DM;
    if (n0 < 2560) {
      const int seg = (n0 - 1024) >> 8, g = ((n0 - 1024) >> 7) & 1;
      bf16_t* vd = (seg == 3 ? p.vsT : p.vwT) + ((size_t)(b * 2 + g) * 128) * SEQ + sl;
      gemm_tile_bf16<true>(A, DM, W, DM, DM, lds, [&](int r, int c, float val) { vd[(size_t)r * SEQ + perm16(c)] = f2bf(val); });
    } else if (n0 < 5632) {
      bf16_t* vd = p.vsbT + ((size_t)(b * 8 + ((n0 - 4608) >> 7)) * 128) * SEQ + sl;
      gemm_tile_bf16<true>(A, DM, W, DM, DM, lds, [&](int r, int c, float val) { vd[(size_t)r * SEQ + perm16(c)] = f2bf(val); });
    } else {
      float* gd = p.gates + (size_t)m0 * 24;
      gemm_tile_bf16<false>(A, DM, W, DM, DM, lds, [&](int r, int c, float val) { if (c < 24) gd[(size_t)r * 24 + c] = val; });
    }
  }
}

__device__ __forceinline__ void ph_posb(const P& p) {
  const int lane = opq(threadIdx.x) & 63, wv = opq(threadIdx.x) >> 6;
  for (int o = blockIdx.x * 4 + wv; o < 256; o += gridDim.x * 4) {
    const int which = o >> 7, n = o & 127;
    const float* pos = which ? p.pos_v : p.pos_k;
    const float* w1 = which ? p.w1_v : p.w1_k;
    float acc = 0.f;
    for (int k = lane; k < 4096; k += 64) acc += pos[k] * w1[(size_t)k * 128 + n];
    acc = wave_sum(acc);
    if (lane == 0) p.posb[o] = acc;
  }
}

__device__ __forceinline__ void ph_compress2(const P& p, char* lds) {
  for (int item = blockIdx.x; item < 16; item += gridDim.x) {
    const int which = item >> 3, bg = item & 7;
    const bf16_t* src = (which ? p.vcin : p.kcin) + (size_t)bg * SEQ * 128;
    const bf16_t* w1t = p.w1T + (size_t)which * 128 * 4096;
    const bf16_t* w2t = p.w2T + (size_t)which * 128 * 128;
    const float* posb = p.posb + which * 128;
    bf16_t* c1 = p.c1 + (size_t)item * 128 * 128;
    gemm_tile_bf16<false>(src, 2048, w1t, 4096, 4096, lds, [&](int r, int c, float val) {
      c1[r * 128 + c] = f2bf(gelu_fast(val + posb[c])); });
    __threadfence_block();
    __syncthreads();
    if (which == 0) {
      bf16_t* kd = p.kcb + (size_t)bg * 128 * 128;
      gemm_tile_bf16<false>(c1, 128, w2t, 128, 128, lds, [&](int r, int c, float val) { kd[r * 128 + c] = f2bf(val); });
    } else {
      bf16_t* vd = p.vcT + (size_t)bg * 128 * 128;
      gemm_tile_bf16<true>(c1, 128, w2t, 128, 128, lds, [&](int r, int c, float val) { vd[r * 128 + perm16(c)] = f2bf(val); });
    }
  }
}

#define NEG_BIG (-1e30f)

struct KVRegs { u32x4 k0, k1, k2, k3, v0, v1, v2, v3; };

__device__ __forceinline__ int koff(int row, int chunk) { return row * 256 + ((chunk ^ (row & 15)) << 4); }

__device__ __forceinline__ void kv_load(KVRegs& r, const bf16_t* kp, int ldk, const bf16_t* vp, int ldv) {
  const int tid = opq(threadIdx.x);
  const bf16_t* kg = kp + (size_t)(tid >> 4) * ldk + (tid & 15) * 8;
  r.k0 = *(const u32x4*)kg;
  r.k1 = *(const u32x4*)(kg + (size_t)16 * ldk);
  r.k2 = *(const u32x4*)(kg + (size_t)32 * ldk);
  r.k3 = *(const u32x4*)(kg + (size_t)48 * ldk);
  const bf16_t* vg = vp + (size_t)(tid >> 3) * ldv + (tid & 7) * 8;
  r.v0 = *(const u32x4*)vg;
  r.v1 = *(const u32x4*)(vg + (size_t)32 * ldv);
  r.v2 = *(const u32x4*)(vg + (size_t)64 * ldv);
  r.v3 = *(const u32x4*)(vg + (size_t)96 * ldv);
}
__device__ __forceinline__ void kv_store(const KVRegs& r, char* lk, char* lv) {
  const int tid = opq(threadIdx.x);
  const int row = tid >> 4, ch = tid & 15;
  *(u32x4*)(lk + koff(row, ch)) = r.k0;
  *(u32x4*)(lk + koff(row + 16, ch)) = r.k1;
  *(u32x4*)(lk + koff(row + 32, ch)) = r.k2;
  *(u32x4*)(lk + koff(row + 48, ch)) = r.k3;
  const int vr = tid >> 3, vc = tid & 7;
  *(u32x4*)(lv + lds_off(vr, vc)) = r.v0;
  *(u32x4*)(lv + lds_off(vr + 32, vc)) = r.v1;
  *(u32x4*)(lv + lds_off(vr + 64, vc)) = r.v2;
  *(u32x4*)(lv + lds_off(vr + 96, vc)) = r.v3;
}

struct QFrag { bf16x8 f0, f1, f2, f3, f4, f5, f6, f7; };
__device__ __forceinline__ void q_load(QFrag& q, const bf16_t* qrow) {
  const int h = (opq(threadIdx.x) & 63) >> 5;
  const bf16x8* p8 = (const bf16x8*)(qrow + 8 * h);
  q.f0 = p8[0]; q.f1 = p8[2]; q.f2 = p8[4]; q.f3 = p8[6]; q.f4 = p8[8]; q.f5 = p8[10]; q.f6 = p8[12]; q.f7 = p8[14];
}

__device__ __forceinline__ void qk_tile(const QFrag& q, const char* lk, f32x16& s0, f32x16& s1) {
  const int lane = opq(threadIdx.x) & 63, row = lane & 31, h = lane >> 5;
#pragma unroll
  for (int r = 0; r < 16; ++r) { s0[r] = 0.f; s1[r] = 0.f; }
#define QK_STEP(kk, qf)                                                                  \
  {                                                                                      \
    bf16x8 a0 = *(const bf16x8*)(lk + koff(row, 2 * (kk) + h));                          \
    bf16x8 a1 = *(const bf16x8*)(lk + koff(row + 32, 2 * (kk) + h));                     \
    s0 = __builtin_amdgcn_mfma_f32_32x32x16_bf16(a0, qf, s0, 0, 0, 0);                   \
    s1 = __builtin_amdgcn_mfma_f32_32x32x16_bf16(a1, qf, s1, 0, 0, 0);                   \
  }
  QK_STEP(0, q.f0) QK_STEP(1, q.f1) QK_STEP(2, q.f2) QK_STEP(3, q.f3)
  QK_STEP(4, q.f4) QK_STEP(5, q.f5) QK_STEP(6, q.f6) QK_STEP(7, q.f7)
#undef QK_STEP
}

__device__ __forceinline__ bf16x8 pack8(const f32x16& p, const int base) {
  u32x4 u;
  u[0] = pack2(p[base + 0], p[base + 1]);
  u[1] = pack2(p[base + 2], p[base + 3]);
  u[2] = pack2(p[base + 4], p[base + 5]);
  u[3] = pack2(p[base + 6], p[base + 7]);
  return __builtin_bit_cast(bf16x8, u);
}

typedef __attribute__((ext_vector_type(2))) unsigned u32x2_t;
__device__ __forceinline__ float xhalf_max(float v) {
  const u32x2_t r = __builtin_amdgcn_permlane32_swap(__float_as_uint(v), __float_as_uint(v), false, false);
  return fmaxf(__uint_as_float(r[0]), __uint_as_float(r[1]));
}
__device__ __forceinline__ float xhalf_sum(float v) {
  const u32x2_t r = __builtin_amdgcn_permlane32_swap(__float_as_uint(v), __float_as_uint(v), false, false);
  return __uint_as_float(r[0]) + __uint_as_float(r[1]);
}
__device__ __forceinline__ float xhalf_get(float v, int hh) {
  const u32x2_t r = __builtin_amdgcn_permlane32_swap(__float_as_uint(v), __float_as_uint(v), false, false);
  return hh ? __uint_as_float(r[0]) : __uint_as_float(r[1]);
}
struct OAcc { f32x16 o0, o1, o2, o3; };
__device__ __forceinline__ void oacc_zero(OAcc& o) {
#pragma unroll
  for (int r = 0; r < 16; ++r) { o.o0[r] = 0.f; o.o1[r] = 0.f; o.o2[r] = 0.f; o.o3[r] = 0.f; }
}
__device__ __forceinline__ void oacc_scale(OAcc& o, float a) {
#pragma unroll
  for (int r = 0; r < 16; ++r) { o.o0[r] *= a; o.o1[r] *= a; o.o2[r] *= a; o.o3[r] *= a; }
}

__device__ __forceinline__ void pv_tile(OAcc& o, const char* lv, const f32x16& p0, const f32x16& p1) {
  const int lane = opq(threadIdx.x) & 63, row = lane & 31, h = lane >> 5;
  const bf16x8 pf0 = pack8(p0, 0), pf1 = pack8(p0, 8), pf2 = pack8(p1, 0), pf3 = pack8(p1, 8);
#define PV_ROW(dd, acc)                                                                                      \
  {                                                                                                          \
    acc = __builtin_amdgcn_mfma_f32_32x32x16_bf16(*(const bf16x8*)(lv + lds_off(32 * (dd) + row, 0 + h)), pf0, acc, 0, 0, 0); \
    acc = __builtin_amdgcn_mfma_f32_32x32x16_bf16(*(const bf16x8*)(lv + lds_off(32 * (dd) + row, 2 + h)), pf1, acc, 0, 0, 0); \
    acc = __builtin_amdgcn_mfma_f32_32x32x16_bf16(*(const bf16x8*)(lv + lds_off(32 * (dd) + row, 4 + h)), pf2, acc, 0, 0, 0); \
    acc = __builtin_amdgcn_mfma_f32_32x32x16_bf16(*(const bf16x8*)(lv + lds_off(32 * (dd) + row, 6 + h)), pf3, acc, 0, 0, 0); \
  }
  PV_ROW(0, o.o0) PV_ROW(1, o.o1) PV_ROW(2, o.o2) PV_ROW(3, o.o3)
#undef PV_ROW
}

typedef __attribute__((ext_vector_type(2))) float f32x2_s;
#define SPAIR(v, i) __builtin_shufflevector(v, v, (i), (i) + 1)
__device__ __forceinline__ void softmax_tile(f32x16& s0, f32x16& s1, float& m, float& l, OAcc& o, const float sc = 1.f,
                                             const float bb = 0.f) {
  float mr = -INFINITY;
#pragma unroll
  for (int r = 0; r < 16; ++r) mr = fmaxf(mr, fmaxf(s0[r], s1[r]));
  float mx = fmaf(mr, sc, bb);
  mx = (mx != mx) ? -INFINITY : mx;
  mx = xhalf_max(fmaxf(mx, NEG_BIG));
  const float mn = fmaxf(m, mx);
  const float alpha = __builtin_amdgcn_exp2f(m - mn);
  const f32x2_s sc2 = {sc, sc}, c2 = {bb - mn, bb - mn};
  f32x2_s ls2 = {0.f, 0.f};
#pragma unroll
  for (int r = 0; r < 16; r += 2) {
    const f32x2_s pa_in = {s0[r], s0[r + 1]}, pb_in = {s1[r], s1[r + 1]};
    const f32x2_s a = __builtin_elementwise_fma(pa_in, sc2, c2);
    const f32x2_s b = __builtin_elementwise_fma(pb_in, sc2, c2);
    const float a0 = __builtin_amdgcn_exp2f(a[0]), a1 = __builtin_amdgcn_exp2f(a[1]);
    const float b0 = __builtin_amdgcn_exp2f(b[0]), b1 = __builtin_amdgcn_exp2f(b[1]);
    s0[r] = a0; s0[r + 1] = a1; s1[r] = b0; s1[r + 1] = b1;
    const f32x2_s pa = {a0, a1}, pb = {b0, b1};
    ls2 = ls2 + pa + pb;
  }
  const float ls = xhalf_sum(ls2[0] + ls2[1]);
  l = l * alpha + ls;
  m = mn;
  if (__any(alpha != 1.f)) oacc_scale(o, alpha);
}

template <class F>
__device__ __forceinline__ void oacc_foreach(const OAcc& o, F f) {
  const int h = (opq(threadIdx.x) & 63) >> 5;
#pragma unroll
  for (int rho = 0; rho < 4; ++rho) {
    f(0 + 8 * rho + 4 * h, o.o0[4 * rho], o.o0[4 * rho + 1], o.o0[4 * rho + 2], o.o0[4 * rho + 3]);
    f(32 + 8 * rho + 4 * h, o.o1[4 * rho], o.o1[4 * rho + 1], o.o1[4 * rho + 2], o.o1[4 * rho + 3]);
    f(64 + 8 * rho + 4 * h, o.o2[4 * rho], o.o2[4 * rho + 1], o.o2[4 * rho + 2], o.o2[4 * rho + 3]);
    f(96 + 8 * rho + 4 * h, o.o3[4 * rho], o.o3[4 * rho + 1], o.o3[4 * rho + 2], o.o3[4 * rho + 3]);
  }
}

__device__ __forceinline__ void memattn_item(const P& p, char* lds, int item) {
  char* lk = lds;
  char* lv = lds + 16384;
  const int lane = opq(threadIdx.x) & 63, wv = opq(threadIdx.x) >> 6;
  {
    const int tb = item % (SEQ / 128);
    const int bh = item / (SEQ / 128);
    const int b = bh >> 2, hd = bh & 3;
    const int t = tb * 128 + wv * 32 + (lane & 31);
    QFrag q;
    q_load(q, p.qmemb + (size_t)(b * SEQ + t) * 512 + hd * 128);
    const bf16_t* kb = p.kmemb + (size_t)bh * 256 * 128;
    const bf16_t* vb = p.vmemT + (size_t)bh * 128 * 256;
    OAcc o;
    oacc_zero(o);
    float m = NEG_BIG, l = 0.f;
    KVRegs kv;
    kv_load(kv, kb, 128, vb, 256);
#pragma unroll 1
    for (int ti = 0; ti < 4; ++ti) {
      __syncthreads();
      kv_store(kv, lk, lv);
      __syncthreads();
      {
        const int tn = (ti + 1 < 4) ? ti + 1 : 3;
        kv_load(kv, kb + (size_t)tn * 64 * 128, 128, vb + tn * 64, 256);
      }
      f32x16 s0, s1;
      qk_tile(q, lk, s0, s1);
      softmax_tile(s0, s1, m, l, o, ATT_SCALE2, 0.f);
      pv_tile(o, lv, s0, s1);
    }
    const float il = 1.f / l;
    const int t2 = tb * 128 + (opq(threadIdx.x) >> 6) * 32 + (opq(threadIdx.x) & 31);
    bf16_t* orow = p.omem + (size_t)(b * SEQ + t2) * 512 + hd * 128;
    oacc_foreach(o, [&](int d, float v0, float v1, float v2, float v3) {
      uint2 u;
      u.x = pack2(v0 * il, v1 * il);
      u.y = pack2(v2 * il, v3 * il);
      *(uint2*)(orow + d) = u;
    });
  }
}

__device__ __forceinline__ void ph_memq_attn(const P& p, char* lds, int vblock, int nvb) {
  if (vblock < 0) return;
  const float* rss = p.rowss;
  for (int u = vblock; u < 64 * 4; u += nvb) {
    const int tm = u & 63, hd = u >> 6;
    const int m0 = tm * 128;
    bf16_t* qd = p.qmemb + (size_t)m0 * 512 + hd * 128;
    gemm_tile_bf16<false, true>(p.hn + (size_t)m0 * DM, DM, p.WmqT + (size_t)hd * 128 * DM, DM, DM, lds,
                                [&](int r, int c, f32x4_e lo, f32x4_e hi) {
                                  const float rs = rsqrtf(rss[m0 + r] * (1.f / DM) + RMS_EPS);
                                  st_bf16x8(qd + (size_t)r * 512 + c, lo * rs, hi * rs); });
    __threadfence_block();
    __syncthreads();
    memattn_item(p, lds, ((m0 >> 11) * 4 + hd) * (SEQ / 128) + ((m0 & 2047) >> 7));
  }
}

template <bool CHK>
__device__ __forceinline__ void sb_pass1(f32x16& z, f32x16& l, const int s_first, const int t) {
  const f32x2_s sc2 = {ATT_SCALE2, ATT_SCALE2}, one2 = {1.f, 1.f};
#pragma unroll
  for (int r = 0; r < 16; r += 2) {
    const f32x2_s zin = {z[r], z[r + 1]};
    const f32x2_s zz = zin * sc2;
    const f32x2_s ee = {__builtin_amdgcn_exp2f(-fabsf(zz[0])), __builtin_amdgcn_exp2f(-fabsf(zz[1]))};
    const f32x2_s tt = ee + one2;
    const f32x2_s lg = {__builtin_amdgcn_logf(tt[0]), __builtin_amdgcn_logf(tt[1])};
    const f32x2_s mn = {fminf(zz[0], 0.f), fminf(zz[1], 0.f)};
    const f32x2_s lf = (mn - lg) - zz;
    if (CHK) {
      const int so = s_first + 8 * (r >> 2) + (r & 3);
      const bool v0 = so < t, v1 = so + 1 < t;
      l[r] = v0 ? lf[0] : 0.f; l[r + 1] = v1 ? lf[1] : 0.f;
      z[r] = v0 ? zz[0] : NEG_BIG; z[r + 1] = v1 ? zz[1] : NEG_BIG;
    } else {
      l[r] = lf[0]; l[r + 1] = lf[1];
      z[r] = zz[0]; z[r + 1] = zz[1];
    }
  }
}
__device__ __forceinline__ void sb_pass3(f32x16& z, const f32x16& l, const float* ag) {
#pragma unroll
  for (int rho = 0; rho < 4; ++rho) {
    const float x3 = l[4 * rho + 3], x23 = x3 + l[4 * rho + 2], x123 = x23 + l[4 * rho + 1];
    const float g = ag[rho];
    const f32x2_s g2 = {g, g};
    const f32x2_s la = {l[4 * rho + 0], l[4 * rho + 1]}, lb = {l[4 * rho + 2], l[4 * rho + 3]};
    const f32x2_s za = {z[4 * rho + 0], z[4 * rho + 1]}, zb = {z[4 * rho + 2], z[4 * rho + 3]};
    const f32x2_s xa = {x123, x23}, xb = {x3, 0.f};
    const f32x2_s aa = (la + za) + (g2 + xa), ab = (lb + zb) + (g2 + xb);
    z[4 * rho + 0] = __builtin_amdgcn_exp2f(aa[0]); z[4 * rho + 1] = __builtin_amdgcn_exp2f(aa[1]);
    z[4 * rho + 2] = __builtin_amdgcn_exp2f(ab[0]); z[4 * rho + 3] = __builtin_amdgcn_exp2f(ab[1]);
  }
}

__device__ __forceinline__ void ph_sb2(const P& p, char* lds) {
  char* lk = lds;
  char* lv = lds + 16384;
  const int lane = opq(threadIdx.x) & 63, wv = opq(threadIdx.x) >> 6, hh = lane >> 5;
  const int sb_skip = (gridDim.x > 32) ? 16 : 0;
  if ((int)blockIdx.x < sb_skip) return;
  for (int item = (int)blockIdx.x - sb_skip; item < NBATCH * 8 * (SEQ / 128); item += (int)gridDim.x - sb_skip) {
    const int tb = (SEQ / 128 - 1) - (item % (SEQ / 128));
    const int bh = item / (SEQ / 128);
    const int b = bh >> 3, hd = bh & 7;
    const int t0 = tb * 128;
    const int t = t0 + wv * 32 + (lane & 31);
    QFrag q;
    q_load(q, p.qsb + (size_t)(b * SEQ + t) * 1024 + hd * 128);
    const bf16_t* kb = p.ksb + (size_t)bh * SEQ * 128;
    const bf16_t* vb = p.vsbT + (size_t)bh * 128 * SEQ;
    OAcc o;
    oacc_zero(o);
    float carry = 0.f;
    const int jhi = (t0 >> 6) + 1;
    const int jw = (t0 + wv * 32 + 30) >> 6;
    KVRegs kv;
    kv_load(kv, kb + (size_t)jhi * 64 * 128, 128, vb + jhi * 64, SEQ);
    volatile unsigned* dflag = (volatile unsigned*)(lds + 32768);
    __syncthreads();
    if (opq(threadIdx.x) < 4) dflag[opq(threadIdx.x)] = 0u;
    for (int j = jhi; j >= 0; --j) {
      __syncthreads();
      if ((dflag[0] & dflag[1] & dflag[2] & dflag[3]) != 0u) break;
      kv_store(kv, lk, lv);
      __syncthreads();
      const int jn = (j > 0) ? j - 1 : 0;
      if (j > jw) kv_load(kv, kb + (size_t)jn * 64 * 128, 128, vb + jn * 64, SEQ);
      if (j <= jw) {
        f32x16 z0, z1;
        qk_tile(q, lk, z0, z1);
        const int sbase = j * 64 + 4 * hh;
        float gt[8];
        f32x16 l0, l1;
        if (j * 64 + 63 < t0 + wv * 32) {
          sb_pass1<false>(z0, l0, sbase, t);
          sb_pass1<false>(z1, l1, sbase + 32, t);
        } else {
          sb_pass1<true>(z0, l0, sbase, t);
          sb_pass1<true>(z1, l1, sbase + 32, t);
        }
#pragma unroll
        for (int rho = 0; rho < 4; ++rho) {
          gt[rho] = (l0[4 * rho] + l0[4 * rho + 1]) + (l0[4 * rho + 2] + l0[4 * rho + 3]);
          gt[4 + rho] = (l1[4 * rho] + l1[4 * rho + 1]) + (l1[4 * rho + 2] + l1[4 * rho + 3]);
        }
        float ag[8];
        float run = 0.f;
#pragma unroll
        for (int k = 7; k >= 0; --k) {
          const float pg = xhalf_get(gt[k], hh);
          ag[k] = carry + run + (hh == 0 ? pg : 0.f);
          run += gt[k] + pg;
        }
        carry += run;
        sb_pass3(z0, l0, ag);
        sb_pass3(z1, l1, ag + 4);
        kv_load(kv, kb + (size_t)jn * 64 * 128, 128, vb + jn * 64, SEQ);
        pv_tile(o, lv, z0, z1);
        if (__all(carry < -104.f * LOG2E) && (opq(threadIdx.x) & 63) == 0) dflag[wv] = 1u;
      }
    }
    int t2 = t;
    asm volatile("" : "+v"(t2));
    bf16_t* orow = p.omix + (size_t)(b * SEQ + t2) * DM + 1024 + hd * 128;
    oacc_foreach(o, [&](int d, float v0, float v1, float v2, float v3) {
      uint2 u;
      u.x = pack2(v0, v1);
      u.y = pack2(v2, v3);
      *(uint2*)(orow + d) = u;
    });
  }
}

#define NSA_IMP 32768
#define NSA_KEYS 49152
#define NSA_SELM 53504
#define NSA_LUT 53632
__device__ __forceinline__ void ph_nsa2(const P& p, char* lds) {
  typedef __attribute__((ext_vector_type(4))) float f32x4;
  char* lk = lds;
  char* lv = lds + 16384;
  float* imp = (float*)(lds + NSA_IMP);
  float* keys = (float*)(lds + NSA_KEYS);
  unsigned* selm = (unsigned*)(lds + NSA_SELM);
  const int tid = opq(threadIdx.x), lane = tid & 63, wv = tid >> 6, hh = lane >> 5, ql = lane & 31;
  float* lut = (float*)(lds + NSA_LUT) + wv * 128;
  for (int item = blockIdx.x; item < NBATCH * 2 * (SEQ / 32); item += gridDim.x) {
    const int tt = (item < 256) ? (SEQ / 32 - 1) - (item % (SEQ / 32)) : (item % (SEQ / 32));
    const int bg = item / (SEQ / 32);
    const int b = bg >> 1, g = bg & 1;
    const int h = g * 4 + wv;
    const int t0 = tt * 32, tq = t0 + ql, cur = t0 >> 6;
    __syncthreads();
    QFrag q;
    q_load(q, p.qn + (size_t)(b * SEQ + tq) * 1024 + h * 128);
    {
      const int lo = opq(lane);
      lut[lo] = p.t5[t5_bucket(lo) * 8 + h] * LOG2E;
      lut[lo + 64] = p.t5[t5_bucket(lo + 64) * 8 + h] * LOG2E;
    }
#pragma unroll
    for (int i = 0; i < 16; ++i) imp[i * 256 + tid] = 0.f;
    if (tid < 32) selm[tid] = 0u;
    const float* grow = p.gates + (size_t)(b * SEQ + tq) * 24 + h * 3;
    float* prow = p.part + (size_t)(b * SEQ + tq) * 1024 + h * 128;
    OAcc o;
    float m, l;
    KVRegs kv;
    {
      const bf16_t* kb = p.kcb + (size_t)bg * 128 * 128;
      const bf16_t* vb = p.vcT + (size_t)bg * 128 * 128;
      oacc_zero(o);
      m = NEG_BIG; l = 0.f;
      kv_load(kv, kb, 128, vb, 128);
      __syncthreads();
      kv_store(kv, lk, lv);
      __syncthreads();
      f32x16 x0, x1;
      qk_tile(q, lk, x0, x1);
      int tqv = tq;
      asm volatile("" : "+v"(tqv));
      tqv -= 64 * hh;
      float fsc = 1.f, fbb = 0.f;
      if (t0 >= 1152) {
        fsc = ATT_SCALE2; fbb = lut[127];
      } else {
#pragma unroll
        for (int r = 0; r < 16; ++r) {
          const int c = 8 * (r >> 2) + (r & 3);
          const int d0 = tqv - 16 * c - 31, d1 = d0 - 512;
          x0[r] = (d0 >= 0) ? x0[r] * ATT_SCALE2 + lut[min(d0, 127)] : -INFINITY;
          x1[r] = (d1 >= 0) ? x1[r] * ATT_SCALE2 + lut[min(d1, 127)] : -INFINITY;
        }
      }
      softmax_tile(x0, x1, m, l, o, fsc, fbb);
      const float m0 = m;
      pv_tile(o, lv, x0, x1);
      f32x16 z0, z1;
#pragma unroll
      for (int r = 0; r < 16; ++r) { z0[r] = 0.f; z1[r] = 0.f; }
      if (t0 >= 1024) {
        kv_load(kv, kb + 64 * 128, 128, vb + 64, 128);
        __syncthreads();
        kv_store(kv, lk, lv);
        __syncthreads();
        qk_tile(q, lk, z0, z1);
        asm volatile("" : "+v"(tqv));
#pragma unroll
        for (int r = 0; r < 16; ++r) {
          const int c = 64 + 8 * (r >> 2) + (r & 3);
          const int d0 = tqv - 16 * c - 31, d1 = d0 - 512;
          z0[r] = (d0 >= 0) ? z0[r] * ATT_SCALE2 + lut[min(d0, 127)] : -INFINITY;
          z1[r] = (d1 >= 0) ? z1[r] * ATT_SCALE2 + lut[min(d1, 127)] : -INFINITY;
        }
        softmax_tile(z0, z1, m, l, o);
        pv_tile(o, lv, z0, z1);
      }
      const float inv = 1.f / fmaxf(l, 1e-20f);
      const float c0 = __builtin_amdgcn_exp2f(m0 - m) * inv;
#pragma unroll
      for (int r = 0; r < 16; ++r) {
        const int c = 8 * (r >> 2) + (r & 3) + 4 * hh;
        if (x0[r] != 0.f) atomicAdd(&imp[(c) * 32 + ql], x0[r] * c0);
        if (x1[r] != 0.f) atomicAdd(&imp[(c + 32) * 32 + ql], x1[r] * c0);
        if (z0[r] != 0.f) atomicAdd(&imp[(c + 64) * 32 + ql], z0[r] * inv);
        if (z1[r] != 0.f) atomicAdd(&imp[(c + 96) * 32 + ql], z1[r] * inv);
      }
      const float gs = inv / (1.f + __expf(-grow[0]));
      oacc_foreach(o, [&](int d, float v0, float v1, float v2, float v3) {
        f32x4 u = {v0 * gs, v1 * gs, v2 * gs, v3 * gs};
        *(f32x4*)(prow + d) = u;
      });
    }
    __syncthreads();
    {
      const int tido = opq(tid);
      const int qq = tido & 31, jg = tido >> 5;
#pragma unroll
      for (int jj = 0; jj < 4; ++jj) {
        const int j = jg * 4 + jj;
        float v = imp[(4 * j) * 32 + qq] + imp[(4 * j + 1) * 32 + qq] + imp[(4 * j + 2) * 32 + qq] + 0.5f * imp[(4 * j + 3) * 32 + qq];
        if (j > 0) v += 0.5f * imp[(4 * j - 1) * 32 + qq];
        const bool forced = (j == 0) || (j == cur) || (j == cur - 1);
        keys[qq * 33 + j] = forced ? 1e9f : ((j <= cur) ? v : -1e9f);
      }
      __syncthreads();
      unsigned bits = 0u;
#pragma unroll
      for (int jj = 0; jj < 4; ++jj) {
        const int j = jg * 4 + jj;
        const float kj = keys[qq * 33 + j];
        int rank = 0;
        for (int i = 0; i < 32; ++i) {
          const float ki = keys[qq * 33 + i];
          rank += (ki > kj || (ki == kj && i < j)) ? 1 : 0;
        }
        if (rank < 16 && j <= cur) bits |= 1u << j;
      }
      atomicOr(&selm[qq], bits);
      __syncthreads();
    }
    const unsigned mysel = selm[ql];
    unsigned um = mysel;
#pragma unroll
    for (int o2 = 16; o2 > 0; o2 >>= 1) um |= (unsigned)__shfl_xor((int)um, o2);
    um = (unsigned)__builtin_amdgcn_readfirstlane((int)um);
    {
      const bf16_t* kb = p.ks + (size_t)bg * SEQ * 128;
      const bf16_t* vb = p.vsT + (size_t)bg * 128 * SEQ;
      oacc_zero(o);
      m = NEG_BIG; l = 0.f;
      unsigned rem = um;
      int j = __builtin_ctz(rem);
      kv_load(kv, kb + (size_t)j * 64 * 128, 128, vb + j * 64, SEQ);
      while (rem) {
        j = __builtin_ctz(rem);
        rem &= rem - 1;
        const int jn = rem ? __builtin_ctz(rem) : j;
        __syncthreads();
        kv_store(kv, lk, lv);
        __syncthreads();
        f32x16 s0, s1;
        qk_tile(q, lk, s0, s1);
        const bool selq = (mysel >> j) & 1u;
        int tqv = tq;
        asm volatile("" : "+v"(tqv));
        float fsc = 1.f, fbb = 0.f;
        if (j * 64 + 63 + 113 <= t0) {
          fsc = selq ? ATT_SCALE2 : 0.f; fbb = selq ? lut[127] : -INFINITY;
        } else {
#pragma unroll
          for (int r = 0; r < 16; ++r) {
            const int d0 = tqv - (j * 64 + 8 * (r >> 2) + (r & 3) + 4 * hh), d1 = d0 - 32;
            s0[r] = (selq && d0 >= 0) ? s0[r] * ATT_SCALE2 + lut[min(d0, 127)] : -INFINITY;
            s1[r] = (selq && d1 >= 0) ? s1[r] * ATT_SCALE2 + lut[min(d1, 127)] : -INFINITY;
          }
        }
        kv_load(kv, kb + (size_t)jn * 64 * 128, 128, vb + jn * 64, SEQ);
        softmax_tile(s0, s1, m, l, o, fsc, fbb);
        pv_tile(o, lv, s0, s1);
      }
      const float gs = 1.f / (fmaxf(l, 1e-20f) * (1.f + __expf(-grow[1])));
      int qo = ql;
      asm volatile("" : "+v"(qo));
      float* pr2 = p.part + (size_t)(b * SEQ + t0 + qo) * 1024 + h * 128;
      oacc_foreach(o, [&](int d, float v0, float v1, float v2, float v3) {
        f32x4 u = *(f32x4*)(pr2 + d);
        u[0] += v0 * gs; u[1] += v1 * gs; u[2] += v2 * gs; u[3] += v3 * gs;
        *(f32x4*)(pr2 + d) = u;
      });
    }
    {
      const bf16_t* kb = p.kw + (size_t)bg * SEQ * 128;
      const bf16_t* vb = p.vwT + (size_t)bg * 128 * SEQ;
      oacc_zero(o);
      m = NEG_BIG; l = 0.f;
      int jlo = (t0 - 511) >> 6;
      if (jlo < 0) jlo = 0;
      kv_load(kv, kb + (size_t)jlo * 64 * 128, 128, vb + jlo * 64, SEQ);
      for (int j = jlo; j <= cur; ++j) {
        const int jn = (j < cur) ? j + 1 : j;
        __syncthreads();
        kv_store(kv, lk, lv);
        __syncthreads();
        f32x16 s0, s1;
        qk_tile(q, lk, s0, s1);
        int tqv = tq;
        asm volatile("" : "+v"(tqv));
        float wsc = 1.f, wbb = 0.f;
        if (j * 64 + 63 + 113 <= t0 && t0 + 31 - j * 64 < 512) {
          wsc = ATT_SCALE2; wbb = lut[127];
        } else {
#pragma unroll
          for (int r = 0; r < 16; ++r) {
            const int d0 = tqv - (j * 64 + 8 * (r >> 2) + (r & 3) + 4 * hh), d1 = d0 - 32;
            s0[r] = (d0 >= 0 && d0 < 512) ? s0[r] * ATT_SCALE2 + lut[min(d0, 127)] : -INFINITY;
            s1[r] = (d1 >= 0 && d1 < 512) ? s1[r] * ATT_SCALE2 + lut[min(d1, 127)] : -INFINITY;
          }
        }
        kv_load(kv, kb + (size_t)jn * 64 * 128, 128, vb + jn * 64, SEQ);
        softmax_tile(s0, s1, m, l, o, wsc, wbb);
        pv_tile(o, lv, s0, s1);
      }
      const float gs = 1.f / (fmaxf(l, 1e-20f) * (1.f + __expf(-grow[2])));
      int qo = ql;
      asm volatile("" : "+v"(qo));
      const float* pr2 = p.part + (size_t)(b * SEQ + t0 + qo) * 1024 + h * 128;
      bf16_t* orow = p.omix + (size_t)(b * SEQ + t0 + qo) * DM + h * 128;
      oacc_foreach(o, [&](int d, float v0, float v1, float v2, float v3) {
        const f32x4 u = *(const f32x4*)(pr2 + d);
        uint2 w;
        w.x = pack2(u[0] + v0 * gs, u[1] + v1 * gs);
        w.y = pack2(u[2] + v2 * gs, u[3] + v3 * gs);
        *(uint2*)(orow + d) = w;
      });
    }
  }
}

__device__ __forceinline__ void ph_cvt(const float* src, bf16_t* dst, size_t n) {
  typedef __attribute__((ext_vector_type(4))) float f32x4;
  const size_t nv = n / 8;
  for (size_t i = (size_t)blockIdx.x * 256 + opq(threadIdx.x); i < nv; i += (size_t)gridDim.x * 256) {
    const f32x4 a = ((const f32x4*)src)[2 * i], b = ((const f32x4*)src)[2 * i + 1];
    u32x4 o;
    o[0] = pack2(a[0], a[1]); o[1] = pack2(a[2], a[3]); o[2] = pack2(b[0], b[1]); o[3] = pack2(b[2], b[3]);
    ((u32x4*)dst)[i] = o;
  }
}

__device__ __forceinline__ void ph_scores(const P& p, char* lds) {
  for (int u = blockIdx.x; u < 64 * 16; u += gridDim.x) {
    const int tm = u & 63, hp = u >> 6;
    const int m0 = tm * 128;
    float* sc = p.scores + (size_t)m0 * DM + hp * 128;
    gemm_tile_bf16<false>(p.omix + (size_t)m0 * DM + hp * 128, DM, p.subkb + (size_t)hp * 128 * 128, 128, 128, lds,
                          [&](int r, int c, float val) { sc[(size_t)r * DM + c] = val; });
  }
}

__device__ __forceinline__ void ph_qp_scores(const P& p, char* lds) {
  const int ntm = T_TOK / 256, ntn = DM / 128;
  const int npm = (ntm + 7) / 8, npn = (ntn + 7) / 8;
  const int nslots = ((npm * npn * 64 + 511) / 512) * 512;
  for (int u = blockIdx.x; u < nslots; u += gridDim.x) {
    int v = (u & 7) * 64 + ((u >> 3) & 63) + (u & ~511);
    int patch = v >> 6, w = v & 63;
    int tm = (patch % npm) * 8 + (w & 7);
    int tn = (patch / npm) * 8 + (w >> 3);
    if (tm >= ntm || tn >= ntn) continue;
    const int m0 = tm * 256, n0 = tn * 128;
    bf16_t* qp = p.omix + (size_t)m0 * DM + n0;
    const float* rss = p.rowss + T_TOK + m0;
    gemm_tile_big(p.hn + (size_t)m0 * DM, DM, p.WpqT + (size_t)n0 * DM, DM, DM, lds,
                  [&](int r, int c, f32x4_e lo, f32x4_e hi) {
                    const float rs = rsqrtf(rss[r] * (1.f / DM) + RMS_EPS);
                    st_bf16x8(qp + (size_t)r * DM + c, lo * rs, hi * rs); });
    __threadfence_block();
    __syncthreads();
    float* sc = p.scores + (size_t)m0 * DM + n0;
    gemm_tile_big(qp, DM, p.subkb + (size_t)tn * 128 * 128, 128, 128, lds,
                  [&](int r, int c, f32x4_e lo, f32x4_e hi) {
                    *(f32x4_e*)(sc + (size_t)r * DM + c) = lo; *(f32x4_e*)(sc + (size_t)r * DM + c + 4) = hi; });
  }
}

__device__ __forceinline__ void ph_cvt4(const float* src, unsigned char* dst, float* scales, int nrows, int wid0, int nw) {
  typedef __attribute__((ext_vector_type(4))) float f32x4;
  typedef __attribute__((ext_vector_type(2))) float f32x2;
  const int lane = opq(threadIdx.x) & 63;
  const float one = __uint_as_float((unsigned)opq(0x3F800000));
  float lev[8];
#pragma unroll
  for (int c = 0; c < 8; ++c) {
    const f32x2 q = __builtin_amdgcn_cvt_scalef32_pk_f32_fp4((unsigned)opq(c * 0x11111111), one, 0);
    lev[c] = fabsf(q[0]);
  }
  const float maxlev = lev[7];
  for (int row = wid0; row < nrows; row += nw) {
    const f32x4* s4 = (const f32x4*)(src + (size_t)row * DM) + lane * 8;
    f32x4 v[8];
    float amax = 0.f;
#pragma unroll
    for (int i = 0; i < 8; ++i) {
      v[i] = s4[i];
#pragma unroll
      for (int k = 0; k < 4; ++k) amax = fmaxf(amax, fabsf(v[i][k]));
    }
    amax = wave_max(amax);
    const float sc = (amax > 0.f) ? maxlev / amax : 1.f;
    u32x4 o;
#pragma unroll
    for (int w = 0; w < 4; ++w) {
      unsigned pk = 0u;
      pk = __builtin_amdgcn_cvt_scalef32_pk_fp4_f32(pk, v[2 * w][0] * sc, v[2 * w][1] * sc, 1.0f, 0);
      pk = __builtin_amdgcn_cvt_scalef32_pk_fp4_f32(pk, v[2 * w][2] * sc, v[2 * w][3] * sc, 1.0f, 1);
      pk = __builtin_amdgcn_cvt_scalef32_pk_fp4_f32(pk, v[2 * w + 1][0] * sc, v[2 * w + 1][1] * sc, 1.0f, 2);
      pk = __builtin_amdgcn_cvt_scalef32_pk_fp4_f32(pk, v[2 * w + 1][2] * sc, v[2 * w + 1][3] * sc, 1.0f, 3);
      o[w] = pk;
    }
    *(u32x4*)(dst + (size_t)row * 1024 + lane * 16) = o;
    if (lane == 0) scales[row] = (amax > 0.f) ? amax / maxlev : 1.f;
  }
}

__device__ __forceinline__ float wave_sum_dpp(float v) {
  typedef __attribute__((ext_vector_type(2))) unsigned u32x2_d;
  v += __builtin_bit_cast(float, __builtin_amdgcn_update_dpp(0, __builtin_bit_cast(int, v), 0xB1, 0xF, 0xF, true));
  v += __builtin_bit_cast(float, __builtin_amdgcn_update_dpp(0, __builtin_bit_cast(int, v), 0x4E, 0xF, 0xF, true));
  v += __builtin_bit_cast(float, __builtin_amdgcn_update_dpp(0, __builtin_bit_cast(int, v), 0x141, 0xF, 0xF, true));
  v += __builtin_bit_cast(float, __builtin_amdgcn_update_dpp(0, __builtin_bit_cast(int, v), 0x140, 0xF, 0xF, true));
  u32x2_d r = __builtin_amdgcn_permlane16_swap(__float_as_uint(v), __float_as_uint(v), false, false);
  v = __uint_as_float(r[0]) + __uint_as_float(r[1]);
  r = __builtin_amdgcn_permlane32_swap(__float_as_uint(v), __float_as_uint(v), false, false);
  return __uint_as_float(r[0]) + __uint_as_float(r[1]);
}
__device__ __forceinline__ float gelu_rcp(float x) {
  const float y2 = (1.5957691216057308f * LOG2E) * (x + 0.044715f * x * x * x);
  return x * __builtin_amdgcn_rcpf(1.f + __builtin_amdgcn_exp2f(-y2));
}
__device__ __forceinline__ u32x4 r4_load(const unsigned char* tab, int eid, int lane) {
  return *((const u32x4*)(tab + (size_t)eid * 1024) + lane);
}
struct XPk { f32x16 a, b; };
struct Acc32 { f32x16 a, b; };

typedef __attribute__((ext_vector_type(2))) float f32x2_t;
#define PAIR(v, i) __builtin_shufflevector(v, v, (i), (i) + 1)
#define R4_DOT_W(word, xv, base, sa, sb)                                                             \
  {                                                                                                  \
    const f32x2_t q0 = __builtin_amdgcn_cvt_scalef32_pk_f32_fp4(word, one, 0), q1 = __builtin_amdgcn_cvt_scalef32_pk_f32_fp4(word, one, 1); \
    const f32x2_t q2 = __builtin_amdgcn_cvt_scalef32_pk_f32_fp4(word, one, 2), q3 = __builtin_amdgcn_cvt_scalef32_pk_f32_fp4(word, one, 3); \
    sa = __builtin_elementwise_fma(q0, PAIR(xv, base + 0), sa); sb = __builtin_elementwise_fma(q1, PAIR(xv, base + 2), sb); \
    sa = __builtin_elementwise_fma(q2, PAIR(xv, base + 4), sa); sb = __builtin_elementwise_fma(q3, PAIR(xv, base + 6), sb); \
  }
__device__ __forceinline__ float r4_dot(const u32x4& e, const XPk& x) {
  const float one = __uint_as_float((unsigned)opq(0x3F800000));
  f32x2_t sa = {0.f, 0.f}, sb = {0.f, 0.f};
  R4_DOT_W(e[0], x.a, 0, sa, sb) R4_DOT_W(e[1], x.a, 8, sa, sb) R4_DOT_W(e[2], x.b, 0, sa, sb) R4_DOT_W(e[3], x.b, 8, sa, sb)
  sa = sa + sb;
  return sa[0] + sa[1];
}
#define R4_AXPY_P(accv, i, q)                                                                        \
  { const f32x2_t r_ = __builtin_elementwise_fma(h2, q, PAIR(accv, i)); accv[i] = r_[0]; accv[(i) + 1] = r_[1]; }
#define R4_AXPY_W(word, accv, base)                                                                  \
  {                                                                                                  \
    const f32x2_t q0 = __builtin_amdgcn_cvt_scalef32_pk_f32_fp4(word, one, 0), q1 = __builtin_amdgcn_cvt_scalef32_pk_f32_fp4(word, one, 1); \
    const f32x2_t q2 = __builtin_amdgcn_cvt_scalef32_pk_f32_fp4(word, one, 2), q3 = __builtin_amdgcn_cvt_scalef32_pk_f32_fp4(word, one, 3); \
    R4_AXPY_P(accv, base + 0, q0) R4_AXPY_P(accv, base + 2, q1) R4_AXPY_P(accv, base + 4, q2) R4_AXPY_P(accv, base + 6, q3) \
  }
__device__ __forceinline__ void r4_axpy(const u32x4& e, float hid, Acc32& acc) {
  const float one = __uint_as_float((unsigned)opq(0x3F800000));
  const f32x2_t h2 = {hid, hid};
  R4_AXPY_W(e[0], acc.a, 0) R4_AXPY_W(e[1], acc.a, 8) R4_AXPY_W(e[2], acc.b, 0) R4_AXPY_W(e[3], acc.b, 8)
}

#define INS16(K, x)                                                                                      \
  K##15 = __builtin_amdgcn_fmed3f(K##15, K##14, x); K##14 = __builtin_amdgcn_fmed3f(K##14, K##13, x);   \
  K##13 = __builtin_amdgcn_fmed3f(K##13, K##12, x); K##12 = __builtin_amdgcn_fmed3f(K##12, K##11, x);   \
  K##11 = __builtin_amdgcn_fmed3f(K##11, K##10, x); K##10 = __builtin_amdgcn_fmed3f(K##10, K##9, x);    \
  K##9 = __builtin_amdgcn_fmed3f(K##9, K##8, x); K##8 = __builtin_amdgcn_fmed3f(K##8, K##7, x);         \
  K##7 = __builtin_amdgcn_fmed3f(K##7, K##6, x); K##6 = __builtin_amdgcn_fmed3f(K##6, K##5, x);         \
  K##5 = __builtin_amdgcn_fmed3f(K##5, K##4, x); K##4 = __builtin_amdgcn_fmed3f(K##4, K##3, x);         \
  K##3 = __builtin_amdgcn_fmed3f(K##3, K##2, x); K##2 = __builtin_amdgcn_fmed3f(K##2, K##1, x);         \
  K##1 = __builtin_amdgcn_fmed3f(K##1, K##0, x); K##0 = fmaxf(K##0, x);
#define DECL16(K) float K##0 = -INFINITY, K##1 = -INFINITY, K##2 = -INFINITY, K##3 = -INFINITY, K##4 = -INFINITY, \
  K##5 = -INFINITY, K##6 = -INFINITY, K##7 = -INFINITY, K##8 = -INFINITY, K##9 = -INFINITY, K##10 = -INFINITY,   \
  K##11 = -INFINITY, K##12 = -INFINITY, K##13 = -INFINITY, K##14 = -INFINITY, K##15 = -INFINITY;
__device__ __forceinline__ float mkkey(float v, unsigned tag, unsigned mask) {
  return __uint_as_float((__float_as_uint(v) & ~mask) | tag);
}

__device__ __forceinline__ void ph_peer(const P& p, float* smem) {
  typedef __attribute__((ext_vector_type(4))) float f32x4;
  float* lists = smem;
  int* bexA = (int*)(smem + 4096);
  float* bgtA = smem + 6144;
  float* bsuA = smem + 8192;
  for (int item = blockIdx.x; item < T_TOK / 16; item += gridDim.x) {
    const int t0 = item * 16;
    __syncthreads();
    {
      const int tid = opq(threadIdx.x);
      const int tl = tid >> 4, hp = tid & 15;
      const f32x4* sp = (const f32x4*)(p.scores + (size_t)(t0 + tl) * DM + hp * 128);
      DECL16(k)
#pragma unroll 4
      for (int c4 = 0; c4 < 32; ++c4) {
        const f32x4 v = sp[c4];
#pragma unroll
        for (int e = 0; e < 4; ++e) {
          const float x = mkkey(v[e], 127u - (unsigned)(c4 * 4 + e), 127u);
          INS16(k, x)
        }
      }
      f32x4* lp = (f32x4*)(lists + (size_t)opq(threadIdx.x) * 16);
      f32x4 o0 = {k0, k1, k2, k3}, o1 = {k4, k5, k6, k7}, o2 = {k8, k9, k10, k11}, o3 = {k12, k13, k14, k15};
      lp[0] = o0; lp[1] = o1; lp[2] = o2; lp[3] = o3;
    }
    __syncthreads();
    if (opq(threadIdx.x) < 128) {
      const int tid = opq(threadIdx.x);
      const int tl = tid >> 3, h = tid & 7;
      const float* la = lists + (size_t)(tl * 16 + 2 * h) * 16;
      const float* lb = la + 16;
      float av[16], bv[16];
#pragma unroll
      for (int i = 0; i < 16; ++i) {
        av[i] = __uint_as_float(__float_as_uint(la[i]) & ~127u);
        bv[i] = __uint_as_float(__float_as_uint(lb[i]) & ~127u);
      }
      DECL16(c)
#pragma unroll
      for (int i = 0; i < 16; ++i) {
#pragma unroll
        for (int j = 0; j < 16; ++j) {
          if ((i + 1) * (j + 1) <= 16) {
            const float x = mkkey(av[i] + bv[j], 255u - (unsigned)(i * 16 + j), 255u);
            INS16(c, x)
          }
        }
      }
      float cs[16] = {c0, c1, c2, c3, c4, c5, c6, c7, c8, c9, c10, c11, c12, c13, c14, c15};
      float ev[16];
      float sum = 0.f;
      const float mx = __uint_as_float(__float_as_uint(cs[0]) & ~255u);
#pragma unroll
      for (int n = 0; n < 16; ++n) {
        ev[n] = __expf(__uint_as_float(__float_as_uint(cs[n]) & ~255u) - mx);
        sum += ev[n];
      }
      const float isum = 1.f / sum;
#pragma unroll
      for (int n = 0; n < 16; ++n) {
        const unsigned cc = 255u - (__float_as_uint(cs[n]) & 255u);
        const unsigned ka = 127u - (__float_as_uint(la[cc >> 4]) & 127u);
        const unsigned kb = 127u - (__float_as_uint(lb[cc & 15u]) & 127u);
        const int eid = (int)(ka * 128u + kb);
        bexA[tl * 128 + h * 16 + n] = eid;
        bgtA[tl * 128 + h * 16 + n] = ev[n] * isum * p.sv8[eid];
        bsuA[tl * 128 + h * 16 + n] = p.su8[eid];
      }
    }
    __syncthreads();
#pragma unroll 1
    for (int ti4 = 0; ti4 < 4; ++ti4) {
    const int lane = opq(threadIdx.x) & 63, wv = opq(threadIdx.x) >> 6;
    const int tl = wv * 4 + ti4;
    const int t = t0 + tl;
    const int* bex = bexA + tl * 128;
    const float* bgt = bgtA + tl * 128;
    const float* bsu = bsuA + tl * 128;
    XPk x;
    {
      const f32x4* s4 = (const f32x4*)(p.out + (size_t)t * DM) + lane * 8;
      const f32x4* g4 = (const f32x4*)p.norm_ffn + lane * 8;
      f32x4 a0 = s4[0], a1 = s4[1], a2 = s4[2], a3 = s4[3], a4 = s4[4], a5 = s4[5], a6 = s4[6], a7 = s4[7];
      float ss = 0.f;
#define SSQ(v) ss += v[0] * v[0] + v[1] * v[1] + v[2] * v[2] + v[3] * v[3];
      SSQ(a0) SSQ(a1) SSQ(a2) SSQ(a3) SSQ(a4) SSQ(a5) SSQ(a6) SSQ(a7)
#undef SSQ
      ss = wave_sum(ss);
      const float rs = rsqrtf(ss * (1.f / DM) + RMS_EPS);
#define XPK(dst, base, va, vb, gi)                                                    \
  {                                                                                   \
    const f32x4 ga = g4[gi], gb = g4[gi + 1];                                         \
    dst[base + 0] = bf2f(f2bf(va[0] * rs * ga[0])); dst[base + 1] = bf2f(f2bf(va[1] * rs * ga[1]));   \
    dst[base + 2] = bf2f(f2bf(va[2] * rs * ga[2])); dst[base + 3] = bf2f(f2bf(va[3] * rs * ga[3]));   \
    dst[base + 4] = bf2f(f2bf(vb[0] * rs * gb[0])); dst[base + 5] = bf2f(f2bf(vb[1] * rs * gb[1]));   \
    dst[base + 6] = bf2f(f2bf(vb[2] * rs * gb[2])); dst[base + 7] = bf2f(f2bf(vb[3] * rs * gb[3]));   \
  }
      XPK(x.a, 0, a0, a1, 0) XPK(x.a, 8, a2, a3, 2) XPK(x.b, 0, a4, a5, 4) XPK(x.b, 8, a6, a7, 6)
#undef XPK
    }
    Acc32 acc;
#pragma unroll
    for (int r = 0; r < 16; ++r) { acc.a[r] = 0.f; acc.b[r] = 0.f; }
    u32x4 u0 = r4_load(p.pu8, bex[0], lane), u1 = r4_load(p.pu8, bex[1], lane), u2 = r4_load(p.pu8, bex[2], lane), u3 = r4_load(p.pu8, bex[3], lane);
    u32x4 v0 = r4_load(p.pv8, bex[0], lane), v1 = r4_load(p.pv8, bex[1], lane), v2 = r4_load(p.pv8, bex[2], lane), v3 = r4_load(p.pv8, bex[3], lane);
#pragma unroll 1
    for (int e0 = 0; e0 < 128; e0 += 4) {
      float d0 = r4_dot(u0, x), d1 = r4_dot(u1, x), d2 = r4_dot(u2, x), d3 = r4_dot(u3, x);
      const int en = (e0 + 4 < 128) ? e0 + 4 : 124;
      const int i0 = bex[en], i1 = bex[en + 1], i2 = bex[en + 2], i3 = bex[en + 3];
      u0 = r4_load(p.pu8, i0, lane); u1 = r4_load(p.pu8, i1, lane); u2 = r4_load(p.pu8, i2, lane); u3 = r4_load(p.pu8, i3, lane);
      d0 = wave_sum_dpp(d0); d1 = wave_sum_dpp(d1); d2 = wave_sum_dpp(d2); d3 = wave_sum_dpp(d3);
      { const float hid = bgt[e0 + 0] * gelu_rcp(d0 * bsu[e0 + 0]); r4_axpy(v0, hid, acc); }
      { const float hid = bgt[e0 + 1] * gelu_rcp(d1 * bsu[e0 + 1]); r4_axpy(v1, hid, acc); }
      { const float hid = bgt[e0 + 2] * gelu_rcp(d2 * bsu[e0 + 2]); r4_axpy(v2, hid, acc); }
      { const float hid = bgt[e0 + 3] * gelu_rcp(d3 * bsu[e0 + 3]); r4_axpy(v3, hid, acc); }
      v0 = r4_load(p.pv8, i0, lane); v1 = r4_load(p.pv8, i1, lane); v2 = r4_load(p.pv8, i2, lane); v3 = r4_load(p.pv8, i3, lane);
    }
    const int lane2 = opq(lane);
    f32x4* o4 = (f32x4*)(p.out + (size_t)t * DM) + lane2 * 8;
    const f32x4* g4 = (const f32x4*)p.norm_final + lane2 * 8;
    f32x4 hv[8];
    float ss = 0.f;
#pragma unroll
    for (int i = 0; i < 8; ++i) {
      hv[i] = o4[i];
#pragma unroll
      for (int k = 0; k < 4; ++k) {
        hv[i][k] += (i < 4) ? acc.a[4 * i + k] : acc.b[4 * (i - 4) + k];
        ss += hv[i][k] * hv[i][k];
      }
    }
    ss = wave_sum(ss);
    const float rs = rsqrtf(ss * (1.f / DM) + RMS_EPS);
#pragma unroll
    for (int i = 0; i < 8; ++i) {
      const f32x4 g = g4[i];
      f32x4 o;
#pragma unroll
      for (int k = 0; k < 4; ++k) o[k] = hv[i][k] * rs * g[k];
      o4[i] = o;
    }
    }
  }
}

#define XB_TMO      128
#define XB_XCNT(j)  (256  + 64 * (j))
#define XB_XSUB(j)  (1280 + 64 * (j))
#define XB_XGEN(j)  (2304 + 64 * (j))
#define XB_TOP      3328
#define XB_TOPGEN   3392
#define XCD_BAR_WORDS 3456
#define XB_SPIN_CAP (1u << 22)
#define LAS __attribute__((address_space(3)))
__device__ __forceinline__ unsigned xb_ld(unsigned* p) { return __hip_atomic_load(p, __ATOMIC_RELAXED, __HIP_MEMORY_SCOPE_AGENT); }
__device__ __forceinline__ unsigned xb_add(unsigned* p, unsigned v) { return __hip_atomic_fetch_add(p, v, __ATOMIC_RELAXED, __HIP_MEMORY_SCOPE_AGENT); }
__device__ __forceinline__ unsigned xb_xcc_id() { return (unsigned)__builtin_amdgcn_s_getreg((3 << 11) | 20) & 0xFu; }
#define XB_SPIN(cond, bar) do { unsigned _sp = 0; while (cond) { __builtin_amdgcn_s_sleep(1); \
    if ((++_sp & 255u) == 0u) { if (xb_ld(&(bar)[XB_TMO])) break; if (_sp > XB_SPIN_CAP) { atomicAdd(&(bar)[XB_TMO], 1u); break; } } } } while (0)
struct XcdBarrier { unsigned* bar; unsigned x; volatile LAS unsigned* st; };
__device__ __forceinline__ XcdBarrier xcd_barrier_post(unsigned* bar, volatile LAS unsigned* st) {
  XcdBarrier b; b.bar = bar; b.x = xb_xcc_id(); b.st = st;
  if (threadIdx.x == 0) (void)xb_add(&bar[XB_XCNT(b.x)], 1u);
  return b;
}
__device__ __forceinline__ void xcd_barrier_complete(unsigned* bar, unsigned x, unsigned& nloc, unsigned& nx) {
  const unsigned G = gridDim.x * gridDim.y * gridDim.z;
  unsigned sum, cnt, mine, sp = 0u;
  for (;;) {
    sum = 0u; cnt = 0u; mine = 0u;
#pragma unroll
    for (unsigned j = 0; j < 16; ++j) { const unsigned c = xb_ld(&bar[XB_XCNT(j)]); sum += c; cnt += (c > 0u) ? 1u : 0u; mine = (j == x) ? c : mine; }
    if (sum == G) break;
    __builtin_amdgcn_s_sleep(1);
    if ((++sp & 255u) == 0u) { if (xb_ld(&bar[XB_TMO])) break; if (sp > XB_SPIN_CAP) { atomicAdd(&bar[XB_TMO], 1u); break; } }
  }
  nloc = mine > 0u ? mine : 1u; nx = cnt > 0u ? cnt : 1u;
}
__device__ __forceinline__ void xcd_barrier(const XcdBarrier& b) {
  asm volatile("s_waitcnt vmcnt(0)" ::: "memory");
  __syncthreads();
  if (threadIdx.x == 0) {
    unsigned* bar = b.bar;
    __builtin_amdgcn_s_waitcnt(0);
    unsigned nloc = b.st[0], nx = b.st[1];
    if (nloc == 0u) { xcd_barrier_complete(bar, b.x, nloc, nx); b.st[0] = nloc; b.st[1] = nx; }
    const unsigned old = xb_add(&bar[XB_XSUB(b.x)], 1u);
    const unsigned gen = old / nloc;
    if (old + 1u == (gen + 1u) * nloc) {
      __builtin_amdgcn_fence(__ATOMIC_RELEASE, "agent");
      asm volatile("s_waitcnt vmcnt(0)" ::: "memory");
      const unsigned og = xb_add(&bar[XB_TOP], 1u);
      const unsigned tg = og / nx;
      if (og + 1u == (tg + 1u) * nx) xb_add(&bar[XB_TOPGEN], 1u);
      else XB_SPIN(xb_ld(&bar[XB_TOPGEN]) == tg, bar);
      __builtin_amdgcn_fence(__ATOMIC_ACQUIRE, "agent");
      xb_add(&bar[XB_XGEN(b.x)], 1u);
      asm volatile("s_waitcnt vmcnt(0)" ::: "memory");
    } else {
      XB_SPIN(xb_ld(&bar[XB_XGEN(b.x)]) == gen, bar);
      __builtin_amdgcn_fence(__ATOMIC_ACQUIRE, "agent");
      asm volatile("s_waitcnt vmcnt(0)" ::: "memory");
    }
  }
  __syncthreads();
}

typedef const __attribute__((address_space(4))) P* KP;
__device__ __forceinline__ P loadP() {
#if defined(__HIP_DEVICE_COMPILE__)
  KP k = (KP)__builtin_amdgcn_kernarg_segment_ptr();
  asm volatile("" : "+s"(k));
  P p = *k;
  return p;
#else
  return P{};
#endif
}

__global__ void __launch_bounds__(256, 2) mega(P p_arg) {
  cg::grid_group grid = cg::this_grid();
  __shared__ __attribute__((aligned(16))) float smem[18432];
  char* lds = (char*)smem;
  __shared__ uint4 xb_words;
  if (threadIdx.x == 0) xb_words = make_uint4(0u, 0u, 0u, 0u);
  if (blockIdx.x == 0) {
    P p = loadP();
    for (int i = threadIdx.x; i < XCD_BAR_WORDS; i += 256) p.bar[i] = 0u;
  }
  { P p = loadP(); ph_rmsnorm(p.x, p.norm_mix, p.hn, T_TOK); ph_rmsnorm(p.mem, p.norm_mkv, p.memn, 1024); }
  { P p = loadP(); ph_transpose<true>(smem, p.w_in, DM, INC, 5760, p.WinT); }
  { P p = loadP(); ph_transpose<false>(smem, p.w_mk, DM, 512, 512, p.WmkT); }
  { P p = loadP(); ph_transpose<false>(smem, p.w_mv, DM, 512, 512, p.WmvT); }
  { P p = loadP(); ph_cvt(p.subk, p.subkb, (size_t)16 * 128 * 128); }
  { P p = loadP(); ph_transpose<false>(smem, p.w1_k, 4096, 128, 128, p.w1T); }
  { P p = loadP(); ph_transpose<false>(smem, p.w1_v, 4096, 128, 128, p.w1T + 128 * 4096); }
  { P p = loadP(); ph_transpose<false>(smem, p.w2_k, 128, 128, 128, p.w2T); }
  { P p = loadP(); ph_transpose<false>(smem, p.w2_v, 128, 128, 128, p.w2T + 128 * 128); }
  { P p = loadP(); ph_posb(p); }
  { P p = loadP(); for (int i = blockIdx.x * 256 + opq(threadIdx.x); i < 2 * T_TOK; i += gridDim.x * 256) p.rowss[i] = 0.f; }
  grid.sync();
  XcdBarrier xb;
  { P p = loadP(); xb = xcd_barrier_post(p.bar, (volatile LAS unsigned*)&xb_words); }
  { P p = loadP(); ph_proj(p, lds); }
  const int kvb = (gridDim.x == 512) ? (((int)blockIdx.x >= 320 && (int)blockIdx.x < 352) ? ((int)blockIdx.x - 320) * 8 : -1) : -2;
  const int vvb = (gridDim.x == 512) ? (((int)blockIdx.x >= 352 && (int)blockIdx.x < 384) ? ((int)blockIdx.x - 352) * 8 : -1) : -2;
  { P p = loadP(); bf16_t* kmem = p.kmemb;
    ph_gemm_bf16(p.memn, DM, p.WmkT, DM, 1024, 512, DM, lds, [=](int m, int n, float v) {
      kmem[((size_t)((m >> 8) * 4 + (n >> 7)) * 256 + (m & 255)) * 128 + (n & 127)] = f2bf(v); }, kvb); }
  { P p = loadP(); bf16_t* vmem = p.vmemT;
    ph_gemm_bf16(p.memn, DM, p.WmvT, DM, 1024, 512, DM, lds, [=](int m, int n, float v) {
      vmem[((size_t)((m >> 8) * 4 + (n >> 7)) * 128 + (n & 127)) * 256 + perm16(m & 255)] = f2bf(v); }, vvb); }
  xcd_barrier(xb);
  { P p = loadP(); ph_compress2(p, lds); }
  { P p = loadP(); ph_sb2(p, lds); }
  {
    const int skip = (gridDim.x > 32) ? 16 : 0;
    const int vb = ((int)blockIdx.x >= skip) ? (int)blockIdx.x - skip : -1, nvb = (int)gridDim.x - skip;
    __syncthreads();
    { P p = loadP(); ph_transpose<false>(smem, p.w_out, DM, DM, DM, p.WoutT, vb, nvb); }
    { P p = loadP(); ph_transpose<false>(smem, p.w_mq, DM, 512, 512, p.WmqT, vb, nvb); }
  }
  xcd_barrier(xb);
  { P p = loadP(); ph_nsa2(p, lds); }
  xcd_barrier(xb);
  { P p = loadP(); float* out = p.out; const float* x = p.x; const float* gmq = p.norm_mq; bf16_t* hn = p.hn; float* rss = p.rowss;
    ph_gemm_big(p.omix, DM, p.WoutT, DM, T_TOK, DM, DM, lds, [=](int m, int n, f32x4_e lo, f32x4_e hi) {
      const f32x4_e x0 = *(const f32x4_e*)(x + (size_t)m * DM + n), x1 = *(const f32x4_e*)(x + (size_t)m * DM + n + 4);
      const f32x4_e h0 = x0 + lo, h1 = x1 + hi;
      *(f32x4_e*)(out + (size_t)m * DM + n) = h0; *(f32x4_e*)(out + (size_t)m * DM + n + 4) = h1;
      norm_feed(h0, h1, gmq, n, hn + (size_t)m * DM, rss + m); }); }
  xcd_barrier(xb);
  {
    const int half = (gridDim.x >= 512) ? 256 : 0;
    if (half == 0 || (int)blockIdx.x < half) { P p = loadP(); ph_memq_attn(p, lds, (int)blockIdx.x, half ? half : (int)gridDim.x); }
    if ((int)blockIdx.x >= half) {
      const int nwv = ((int)gridDim.x - half) * 4, wid = ((int)blockIdx.x - half) * 4 + (opq(threadIdx.x) >> 6);
      __syncthreads();
      { P p = loadP(); ph_transpose<false>(smem, p.w_mo, 512, DM, DM, p.WmoT, (int)blockIdx.x - half, (int)gridDim.x - half); }
      { P p = loadP(); ph_cvt4(p.pu, p.pu8, p.su8, 16384, wid, nwv); }
      { P p = loadP(); ph_cvt4(p.pv, p.pv8, p.sv8, 16384, wid, nwv); }
      __syncthreads();
      { P p = loadP(); ph_transpose<false>(smem, p.w_pq, DM, DM, DM, p.WpqT, (int)blockIdx.x - half, (int)gridDim.x - half); }
    }
  }
  xcd_barrier(xb);
  { P p = loadP(); float* out = p.out; const float* gffn = p.norm_ffn; bf16_t* hn = p.hn; float* rss = p.rowss + T_TOK;
    ph_gemm_big(p.omem, 512, p.WmoT, 512, T_TOK, DM, 512, lds, [=](int m, int n, f32x4_e lo, f32x4_e hi) {
      f32x4_e* o0 = (f32x4_e*)(out + (size_t)m * DM + n);
      const f32x4_e h0 = o0[0] + lo, h1 = o0[1] + hi;
      o0[0] = h0; o0[1] = h1;
      norm_feed(h0, h1, gffn, n, hn + (size_t)m * DM, rss + m); }); }
  xcd_barrier(xb);
  { P p = loadP(); ph_qp_scores(p, lds); }
  xcd_barrier(xb);
  { P p = loadP(); ph_peer(p, smem); }
}

extern "C" void kernel_launch(void* const* d_in, const int* in_sizes, int n_in, void* d_out, int out_size, void* d_ws,
                              size_t ws_size, hipStream_t stream) {
  P p{};
  p.x = (const float*)d_in[0]; p.mem = (const float*)d_in[1]; p.t5 = (const float*)d_in[2];
  p.norm_mix = (const float*)d_in[3]; p.w_in = (const float*)d_in[4]; p.pos_k = (const float*)d_in[5];
  p.w1_k = (const float*)d_in[6]; p.w2_k = (const float*)d_in[7]; p.pos_v = (const float*)d_in[8];
  p.w1_v = (const float*)d_in[9]; p.w2_v = (const float*)d_in[10]; p.w_out = (const float*)d_in[11];
  p.norm_mq = (const float*)d_in[12]; p.norm_mkv = (const float*)d_in[13]; p.w_mq = (const float*)d_in[14];
  p.w_mk = (const float*)d_in[15]; p.w_mv = (const float*)d_in[16]; p.w_mo = (const float*)d_in[17];
  p.norm_ffn = (const float*)d_in[18]; p.w_pq = (const float*)d_in[19]; p.subk = (const float*)d_in[20];
  p.pu = (const float*)d_in[21]; p.pv = (const float*)d_in[22]; p.norm_final = (const float*)d_in[23];
  p.out = (float*)d_out;
  char* w = (char*)d_ws;
  size_t off = 0;
  auto take = [&](size_t bytes) { char* r = w + off; off += (bytes + 255) & ~(size_t)255; return r; };
  p.bar = (unsigned*)take(XCD_BAR_WORDS * 4);
  p.scores = (float*)take((size_t)T_TOK * DM * 4);
  p.gates = (float*)take((size_t)T_TOK * 24 * 4);
  p.part = (float*)take((size_t)T_TOK * 1024 * 4);
  p.posb = (float*)take(256 * 4);
  p.rowss = (float*)take((size_t)2 * T_TOK * 4);
  p.qn = (bf16_t*)take((size_t)T_TOK * 1024 * 2);
  p.kcin = (bf16_t*)take((size_t)T_TOK * 256 * 2 + 65536);
  p.vcin = (bf16_t*)take((size_t)T_TOK * 256 * 2 + 65536);
  p.ks = (bf16_t*)take((size_t)T_TOK * 256 * 2);
  p.vsT = (bf16_t*)take((size_t)T_TOK * 256 * 2);
  p.kw = (bf16_t*)take((size_t)T_TOK * 256 * 2);
  p.vwT = (bf16_t*)take((size_t)T_TOK * 256 * 2);
  p.kcb = (bf16_t*)take((size_t)8 * 128 * 128 * 2);
  p.vcT = (bf16_t*)take((size_t)8 * 128 * 128 * 2);
  p.c1 = (bf16_t*)take((size_t)16 * 128 * 128 * 2);
  p.w1T = (bf16_t*)take((size_t)2 * 128 * 4096 * 2);
  p.w2T = (bf16_t*)take((size_t)2 * 128 * 128 * 2);
  p.hn = (bf16_t*)take((size_t)T_TOK * DM * 2);
  p.omix = (bf16_t*)take((size_t)T_TOK * DM * 2);
  p.memn = (bf16_t*)take((size_t)1024 * DM * 2);
  p.omem = (bf16_t*)take((size_t)T_TOK * 512 * 2);
  p.WinT = (bf16_t*)take((size_t)5760 * DM * 2);
  p.WoutT = (bf16_t*)take((size_t)DM * DM * 2);
  p.WpqT = (bf16_t*)take((size_t)DM * DM * 2);
  p.WmqT = (bf16_t*)take((size_t)512 * DM * 2);
  p.WmkT = (bf16_t*)take((size_t)512 * DM * 2);
  p.WmvT = (bf16_t*)take((size_t)512 * DM * 2);
  p.WmoT = (bf16_t*)take((size_t)DM * 512 * 2);
  p.qmemb = (bf16_t*)take((size_t)T_TOK * 512 * 2);
  p.kmemb = (bf16_t*)take((size_t)1024 * 512 * 2);
  p.vmemT = (bf16_t*)take((size_t)1024 * 512 * 2);
  p.qsb = (bf16_t*)take((size_t)T_TOK * 1024 * 2);
  p.ksb = (bf16_t*)take((size_t)T_TOK * 1024 * 2);
  p.vsbT = (bf16_t*)take((size_t)T_TOK * 1024 * 2);
  p.pu8 = (unsigned char*)take((size_t)16384 * 1024);
  p.pv8 = (unsigned char*)take((size_t)16384 * 1024);
  p.su8 = (float*)take(16384 * 4);
  p.sv8 = (float*)take(16384 * 4);
  p.subkb = (bf16_t*)take((size_t)16 * 128 * 128 * 2);
  static int grid_blocks = 0;
  if (!grid_blocks) {
    int dev = 0, cus = 0, per_cu = 0;
    (void)hipGetDevice(&dev);
    (void)hipDeviceGetAttribute(&cus, hipDeviceAttributeMultiprocessorCount, dev);
    (void)hipOccupancyMaxActiveBlocksPerMultiprocessor(&per_cu, mega, 256, 0);
    if (per_cu > 2) per_cu = 2;
    if (per_cu < 1) per_cu = 1;
    grid_blocks = cus * per_cu;
  }
  void* args[] = {&p};
  hipError_t e = hipLaunchCooperativeKernel((void*)mega, dim3(grid_blocks), dim3(256), args, 0, stream);
  if (e != hipSuccess) fprintf(stderr, "cooperative launch failed: %s (grid %d)\n", hipGetErrorString(e), grid_blocks);
}
```

```cpp
#include <hip/hip_runtime.h>
#include <hip/hip_cooperative_groups.h>
#include <cstdio>
namespace cg = cooperative_groups;
#include <stdint.h>

#define SEQ 2048
#define NBATCH 4
#define T_TOK 8192
#define DM 2048
#define INC 5656
#define C_QN 0
#define C_KC 1024
#define C_VC 1280
#define C_KS 1536
#define C_VS 1792
#define C_KW 2048
#define C_VW 2304
#define C_GT 2560
#define C_QSB 2584
#define C_KSB 3608
#define C_VSB 4632
#define ATT_SCALE 0.08838834764831845f
#define LOG2E 1.4426950408889634f
#define ATT_SCALE2 (ATT_SCALE * LOG2E)
#define RMS_EPS 1e-6f

typedef unsigned short bf16_t;
typedef __attribute__((ext_vector_type(8))) short bf16x8;
typedef __attribute__((ext_vector_type(16))) float f32x16;
typedef __attribute__((ext_vector_type(2))) __bf16 bf16v2;
typedef __attribute__((ext_vector_type(4))) unsigned u32x4;

struct P {
  const float *x, *mem, *t5, *norm_mix, *w_in, *pos_k, *w1_k, *w2_k, *pos_v, *w1_v, *w2_v, *w_out,
      *norm_mq, *norm_mkv, *w_mq, *w_mk, *w_mv, *w_mo, *norm_ffn, *w_pq, *subk, *pu, *pv, *norm_final;
  float* out;
  float *scores, *gates, *part, *posb, *rowss;
  unsigned* bar;
  bf16_t *hn, *omix, *memn, *omem;
  bf16_t *WinT, *WoutT, *WpqT, *WmqT, *WmkT, *WmvT, *WmoT;
  bf16_t *qmemb, *kmemb, *vmemT;
  bf16_t *qsb, *ksb, *vsbT;
  bf16_t* subkb;
  unsigned char *pu8, *pv8;
  float *su8, *sv8;
  bf16_t *qn, *kcin, *vcin, *ks, *vsT, *kw, *vwT, *kcb, *vcT, *c1, *w1T, *w2T;
};

__device__ __forceinline__ int opq(int v) { asm volatile("" : "+v"(v)); return v; }
#define LAS __attribute__((address_space(3)))
#define VHALF_BYTES 73728
#define VCNT_OFF (2 * VHALF_BYTES)
__device__ __forceinline__ int VT() { return opq(threadIdx.x) & 255; }
__device__ __forceinline__ int VB() { return (int)blockIdx.x * 2 + (int)(threadIdx.x >> 8); }
__device__ __forceinline__ int VG() { return (int)gridDim.x * 2; }
__device__ __forceinline__ void vbar_wait() {
  if ((threadIdx.x & 63) == 0) {
    LAS unsigned* c = (LAS unsigned*)(unsigned)(VCNT_OFF + 64 * (int)(threadIdx.x >> 8));
    const unsigned old = __hip_atomic_fetch_add(c, 1u, __ATOMIC_RELAXED, __HIP_MEMORY_SCOPE_WORKGROUP);
    const unsigned target = (old & ~3u) + 4u;
    while (__hip_atomic_load(c, __ATOMIC_RELAXED, __HIP_MEMORY_SCOPE_WORKGROUP) < target) __builtin_amdgcn_s_sleep(0);
  }
}
__device__ __forceinline__ void vsync() {
  __builtin_amdgcn_fence(__ATOMIC_RELEASE, "workgroup");
  vbar_wait();
  __builtin_amdgcn_fence(__ATOMIC_ACQUIRE, "workgroup");
}
__device__ __forceinline__ void vsync_raw() {
  asm volatile("" ::: "memory");
  vbar_wait();
  asm volatile("" ::: "memory");
}

__device__ __forceinline__ unsigned pack2(float a, float b) {
  bf16v2 r = {(__bf16)a, (__bf16)b};
  return *(unsigned*)&r;
}
__device__ __forceinline__ bf16_t f2bf(float a) {
  __bf16 r = (__bf16)a;
  return *(bf16_t*)&r;
}
__device__ __forceinline__ int perm16(int s) { return (s & ~12) | ((s & 4) << 1) | ((s & 8) >> 1); }
__device__ __forceinline__ float bf2f(bf16_t u) { return __uint_as_float((unsigned)u << 16); }

__device__ __forceinline__ float wave_max(float v) {
  for (int o = 32; o > 0; o >>= 1) v = fmaxf(v, __shfl_xor(v, o));
  return v;
}
__device__ __forceinline__ float wave_sum(float v) {
  for (int o = 32; o > 0; o >>= 1) v += __shfl_xor(v, o);
  return v;
}
__device__ __forceinline__ void wave_argmax(float& v, int& i) {
  for (int o = 32; o > 0; o >>= 1) {
    float ov = __shfl_xor(v, o);
    int oi = __shfl_xor(i, o);
    if (ov > v || (ov == v && oi < i)) { v = ov; i = oi; }
  }
}
__device__ __forceinline__ float gelu_tanh(float x) {
  return 0.5f * x * (1.f + tanhf(0.7978845608028654f * (x + 0.044715f * x * x * x)));
}
__device__ __forceinline__ float gelu_fast(float x) {
  const float y = 1.5957691216057308f * (x + 0.044715f * x * x * x);
  return x / (1.f + __expf(-y));
}
__device__ __forceinline__ int t5_bucket(int n) {
  if (n < 16) return n < 0 ? 0 : n;
  int b = 16;
  b += (n >= 19); b += (n >= 21); b += (n >= 24); b += (n >= 27); b += (n >= 31); b += (n >= 35);
  b += (n >= 40); b += (n >= 46); b += (n >= 52); b += (n >= 59); b += (n >= 67); b += (n >= 77);
  b += (n >= 87); b += (n >= 99); b += (n >= 113);
  return b;
}
__device__ __forceinline__ float log_sigmoid(float x) {
  return fminf(x, 0.f) - log1pf(expf(-fabsf(x)));
}

__device__ __forceinline__ void ph_rmsnorm(const float* src, const float* gain, bf16_t* dst, int rows) {
  int lane = VT() & 63, wv = VT() >> 6;
  for (int r = VB() * 4 + wv; r < rows; r += VG() * 4) {
    const float4* s4 = (const float4*)(src + (size_t)r * DM);
    float4 v[8];
    float ss = 0.f;
#pragma unroll
    for (int i = 0; i < 8; ++i) {
      v[i] = s4[i * 64 + lane];
      ss += v[i].x * v[i].x + v[i].y * v[i].y + v[i].z * v[i].z + v[i].w * v[i].w;
    }
    ss = wave_sum(ss);
    float rs = rsqrtf(ss * (1.f / DM) + RMS_EPS);
    uint2* d2 = (uint2*)(dst + (size_t)r * DM);
    const float4* g4 = (const float4*)gain;
#pragma unroll
    for (int i = 0; i < 8; ++i) {
      float4 g = g4[i * 64 + lane];
      uint2 o;
      o.x = pack2(v[i].x * rs * g.x, v[i].y * rs * g.y);
      o.y = pack2(v[i].z * rs * g.z, v[i].w * rs * g.w);
      d2[i * 64 + lane] = o;
    }
  }
}

template <bool CMAP>
__device__ __forceinline__ void ph_transpose(float* smem, const float* W, int K, int N, int Npad, bf16_t* Wt,
                                             int vblock = -2, int nvb = 0) {
  typedef __attribute__((ext_vector_type(4))) float f32x4;
  float (*tl)[65] = (float (*)[65])smem;
  if (vblock == -1) return;
  const int b0 = (vblock >= 0) ? vblock : VB(), bstride = (vblock >= 0) ? nvb : VG();
  const int tid = VT();
  const int nk = K / 64, nn = Npad / 64;
  for (int tile = b0; tile < nk * nn; tile += bstride) {
    const int k0 = (tile % nk) * 64, n0 = (tile / nk) * 64;
    const int kr = tid >> 4, n4 = (tid & 15) * 4;
    int sc = n0 + n4;
    if (CMAP) sc = (sc < 2560) ? sc : (sc < 5632) ? sc + 24 : (sc < 5656) ? sc - 5632 + 2560 : N;
#pragma unroll
    for (int i = 0; i < 4; ++i) {
      const int k = kr + 16 * i;
      f32x4 v = {0.f, 0.f, 0.f, 0.f};
      if (sc < N) v = *(const f32x4*)(W + (size_t)(k0 + k) * N + sc);
      tl[k][n4 + 0] = v[0]; tl[k][n4 + 1] = v[1]; tl[k][n4 + 2] = v[2]; tl[k][n4 + 3] = v[3];
    }
    vsync();
    int n = tid >> 2, kc = (tid & 3) * 16;
    unsigned w[8];
#pragma unroll
    for (int i = 0; i < 8; ++i) w[i] = pack2(tl[kc + 2 * i][n], tl[kc + 2 * i + 1][n]);
    uint4* dst = (uint4*)(Wt + (size_t)(n0 + n) * K + k0 + kc);
    dst[0] = make_uint4(w[0], w[1], w[2], w[3]);
    dst[1] = make_uint4(w[4], w[5], w[6], w[7]);
    vsync();
  }
}

__device__ __forceinline__ int lds_off(int row, int chunk) { return row * 128 + ((chunk ^ ((row >> 1) & 7)) << 4); }

template <bool TR, bool VEC = false, class Epi>
__device__ __forceinline__ void gemm_tile_bf16(const bf16_t* xp, int ldx, const bf16_t* yp, int ldy, int K, char* lds,
                                               Epi epi) {
  const int tid = VT(), lane = tid & 63, wv = tid >> 6;
  const int wr = wv >> 1, wc = wv & 1;
  f32x16 acc[2][2];
#pragma unroll
  for (int i = 0; i < 2; ++i)
#pragma unroll
    for (int j = 0; j < 2; ++j)
#pragma unroll
      for (int r = 0; r < 16; ++r) acc[i][j][r] = 0.f;
  const int prow = lane >> 3, pch = lane & 7;
  const bf16_t* xs[4];
  const bf16_t* ys[4];
#pragma unroll
  for (int ps = 0; ps < 4; ++ps) {
    const int row = (wv * 4 + ps) * 8 + prow;
    const int c = pch ^ ((row >> 1) & 7);
    xs[ps] = xp + (size_t)row * ldx + c * 8;
    ys[ps] = yp + (size_t)row * ldy + c * 8;
  }
  char* const mydst = lds + wv * 4096 + lane * 16;
#define GEMM_ISSUE(k0, bufoff)                                                                                              \
  _Pragma("unroll") for (int ps = 0; ps < 4; ++ps) {                                                                        \
    __builtin_amdgcn_global_load_lds((const unsigned*)(xs[ps] + (k0)), (unsigned*)(mydst + (bufoff) + ps * 1024), 16, 0, 0);         \
    __builtin_amdgcn_global_load_lds((const unsigned*)(ys[ps] + (k0)), (unsigned*)(mydst + (bufoff) + 16384 + ps * 1024), 16, 0, 0); \
  }
#define GEMM_COMPUTE(bufoff)                                                                                     \
  _Pragma("unroll") for (int kk = 0; kk < 4; ++kk) {                                                             \
    bf16x8 a[2], b[2];                                                                                           \
    const int ch = kk * 2 + (lane >> 5);                                                                         \
    _Pragma("unroll") for (int i = 0; i < 2; ++i) {                                                              \
      a[i] = *(const bf16x8*)(lds + (bufoff) + (TR ? 16384 : 0) + lds_off(wr * 64 + i * 32 + (lane & 31), ch)); \
      b[i] = *(const bf16x8*)(lds + (bufoff) + (TR ? 0 : 16384) + lds_off(wc * 64 + i * 32 + (lane & 31), ch)); \
    }                                                                                                            \
    _Pragma("unroll") for (int i = 0; i < 2; ++i)                                                                \
      _Pragma("unroll") for (int j = 0; j < 2; ++j)                                                              \
        acc[i][j] = __builtin_amdgcn_mfma_f32_32x32x16_bf16(a[i], b[j], acc[i][j], 0, 0, 0);                    \
  }
  vsync();
  GEMM_ISSUE(0, 0)
  for (int k0 = 0; k0 < K; k0 += 128) {
    asm volatile("s_waitcnt vmcnt(0)" ::: "memory");
    vsync();
    GEMM_ISSUE(k0 + 64, 32768)
    GEMM_COMPUTE(0)
    asm volatile("s_waitcnt vmcnt(0)" ::: "memory");
    vsync();
    if (k0 + 128 < K) { GEMM_ISSUE(k0 + 128, 0) }
    GEMM_COMPUTE(32768)
  }
#undef GEMM_ISSUE
#undef GEMM_COMPUTE
  int lane2 = lane;
  asm volatile("" : "+v"(lane2));
  if constexpr (VEC) {
    typedef __attribute__((ext_vector_type(4))) float f32x4;
    vsync();
    float* wl = (float*)lds + wv * (32 * 68);
    const int hh2 = lane2 >> 5, cl = lane2 & 31;
#pragma unroll
    for (int i = 0; i < 2; ++i) {
#pragma unroll
      for (int j = 0; j < 2; ++j)
#pragma unroll
        for (int r = 0; r < 16; ++r) wl[((r & 3) + 8 * (r >> 2) + 4 * hh2) * 68 + j * 32 + cl] = acc[i][j][r];
      __builtin_amdgcn_wave_barrier();
#pragma unroll
      for (int k = 0; k < 4; ++k) {
        const int row = (lane2 >> 3) + 8 * k, c8 = (lane2 & 7) * 8;
        const f32x4 lo = *(const f32x4*)&wl[row * 68 + c8];
        const f32x4 hi = *(const f32x4*)&wl[row * 68 + c8 + 4];
        epi(wr * 64 + i * 32 + row, wc * 64 + c8, lo, hi);
      }
      __builtin_amdgcn_wave_barrier();
    }
  } else {
#pragma unroll
    for (int i = 0; i < 2; ++i)
#pragma unroll
      for (int j = 0; j < 2; ++j)
#pragma unroll
        for (int r = 0; r < 16; ++r) {
          int rr = wr * 64 + i * 32 + (r & 3) + 8 * (r >> 2) + 4 * (lane2 >> 5);
          int cc = wc * 64 + j * 32 + (lane2 & 31);
          epi(rr, cc, acc[i][j][r]);
        }
  }
}

typedef __attribute__((ext_vector_type(4))) float f32x4_e;
__device__ __forceinline__ void st_bf16x8(bf16_t* dst, f32x4_e lo, f32x4_e hi) {
  u32x4 o;
  o[0] = pack2(lo[0], lo[1]); o[1] = pack2(lo[2], lo[3]); o[2] = pack2(hi[0], hi[1]); o[3] = pack2(hi[2], hi[3]);
  *(u32x4*)dst = o;
}

__device__ __forceinline__ int lds_off32(int row, int chunk) { return row * 64 + ((chunk ^ ((row >> 2) & 3)) << 4); }

template <class Epi>
__device__ __forceinline__ void gemm_tile_big(const bf16_t* xp, int ldx, const bf16_t* yp, int ldy, int K, char* lds,
                                              Epi epi) {
  const int tid = VT(), lane = tid & 63, wv = tid >> 6;
  f32x16 acc[2][4];
#pragma unroll
  for (int i = 0; i < 2; ++i)
#pragma unroll
    for (int j = 0; j < 4; ++j)
#pragma unroll
      for (int r = 0; r < 16; ++r) acc[i][j][r] = 0.f;
  const int prow = lane >> 2, pch = lane & 3;
  const bf16_t* xs[4];
  const bf16_t* ys[2];
#pragma unroll
  for (int ps = 0; ps < 4; ++ps) {
    const int row = (wv * 4 + ps) * 16 + prow;
    xs[ps] = xp + (size_t)row * ldx + (pch ^ ((row >> 2) & 3)) * 8;
  }
#pragma unroll
  for (int ps = 0; ps < 2; ++ps) {
    const int row = (wv * 2 + ps) * 16 + prow;
    ys[ps] = yp + (size_t)row * ldy + (pch ^ ((row >> 2) & 3)) * 8;
  }
  char* const xdst = lds + wv * 4096 + lane * 16;
  char* const ydst = lds + 16384 + wv * 2048 + lane * 16;
#define BIG_ISSUE(k0, st)                                                                                                      \
  _Pragma("unroll") for (int ps = 0; ps < 4; ++ps)                                                                             \
    __builtin_amdgcn_global_load_lds((const unsigned*)(xs[ps] + (k0)), (unsigned*)(xdst + (st) + ps * 1024), 16, 0, 0);        \
  _Pragma("unroll") for (int ps = 0; ps < 2; ++ps)                                                                             \
    __builtin_amdgcn_global_load_lds((const unsigned*)(ys[ps] + (k0)), (unsigned*)(ydst + (st) + ps * 1024), 16, 0, 0);
#define DSR(dst, addr, off) asm volatile("ds_read_b128 %0, %1 offset:%2" : "=v"(dst) : "v"(addr), "i"(off) : "memory")
#define WAIT1(n, x) asm volatile("s_waitcnt lgkmcnt(" #n ")" : "+v"(x))
#define WAIT2(n, x, y) asm volatile("s_waitcnt lgkmcnt(" #n ")" : "+v"(x), "+v"(y))
#define MF(acc_, a_, b_) acc_ = __builtin_amdgcn_mfma_f32_32x32x16_bf16(a_, b_, acc_, 0, 0, 0)
#define BIG_COMPUTE(st)                                                                                   \
  {                                                                                                       \
    bf16x8 a00, a01, a10, a11, b00, b01, b02, b03, b10, b11, b12, b13;                                    \
    const unsigned aa0 = abase0 + (st), aa1 = abase1 + (st), bb0 = bbase0 + (st), bb1 = bbase1 + (st);    \
    DSR(a00, aa0, 0); DSR(b00, bb0, 0); DSR(b01, bb0, 2048); DSR(b02, bb0, 4096); DSR(b03, bb0, 6144);    \
    DSR(a01, aa0, 2048);                                                                                  \
    DSR(a10, aa1, 0); DSR(b10, bb1, 0); DSR(b11, bb1, 2048); DSR(b12, bb1, 4096); DSR(b13, bb1, 6144);    \
    DSR(a11, aa1, 2048);                                                                                  \
    WAIT2(10, a00, b00); MF(acc[0][0], a00, b00);                                                         \
    WAIT1(9, b01); MF(acc[0][1], a00, b01);                                                               \
    WAIT1(8, b02); MF(acc[0][2], a00, b02);                                                               \
    WAIT1(7, b03); MF(acc[0][3], a00, b03);                                                               \
    WAIT1(6, a01); MF(acc[1][0], a01, b00); MF(acc[1][1], a01, b01); MF(acc[1][2], a01, b02); MF(acc[1][3], a01, b03); \
    WAIT2(4, a10, b10); MF(acc[0][0], a10, b10);                                                          \
    WAIT1(3, b11); MF(acc[0][1], a10, b11);                                                               \
    WAIT1(2, b12); MF(acc[0][2], a10, b12);                                                               \
    WAIT1(1, b13); MF(acc[0][3], a10, b13);                                                               \
    WAIT1(0, a11); MF(acc[1][0], a11, b10); MF(acc[1][1], a11, b11); MF(acc[1][2], a11, b12); MF(acc[1][3], a11, b13); \
  }
  const unsigned ldsb = (unsigned)(size_t)(__attribute__((address_space(3))) char*)lds;
  const unsigned abase0 = ldsb + lds_off32(wv * 64 + (lane & 31), 0 + (lane >> 5));
  const unsigned abase1 = ldsb + lds_off32(wv * 64 + (lane & 31), 2 + (lane >> 5));
  const unsigned bbase0 = ldsb + 16384 + lds_off32((lane & 31), 0 + (lane >> 5));
  const unsigned bbase1 = ldsb + 16384 + lds_off32((lane & 31), 2 + (lane >> 5));
  const int nsteps = K >> 5;
  vsync();
  BIG_ISSUE(0, 0)
  BIG_ISSUE(32, 24576)
  int cur = 0, nx2 = 49152;
  for (int t = 0; t < nsteps - 2; ++t) {
    asm volatile("s_waitcnt vmcnt(6)" ::: "memory");
    vsync_raw();
    BIG_ISSUE((t + 2) * 32, nx2)
    BIG_COMPUTE(cur)
    cur = (cur == 49152) ? 0 : cur + 24576;
    nx2 = (nx2 == 49152) ? 0 : nx2 + 24576;
  }
  asm volatile("s_waitcnt vmcnt(6)" ::: "memory");
  vsync_raw();
  BIG_COMPUTE(cur)
  cur = (cur == 49152) ? 0 : cur + 24576;
  asm volatile("s_waitcnt vmcnt(0)" ::: "memory");
  vsync_raw();
  BIG_COMPUTE(cur)
#undef BIG_ISSUE
#undef BIG_COMPUTE
#undef DSR
#undef WAIT1
#undef WAIT2
#undef MF
  const int lane2 = opq(lane);
  typedef __attribute__((ext_vector_type(4))) float f32x4;
  vsync();
  float* wl = (float*)lds + wv * (32 * 68);
  const int hh2 = lane2 >> 5, cl = lane2 & 31;
#pragma unroll
  for (int i = 0; i < 2; ++i)
#pragma unroll
    for (int jh = 0; jh < 2; ++jh) {
#pragma unroll
      for (int j = 0; j < 2; ++j)
#pragma unroll
        for (int r = 0; r < 16; ++r) wl[((r & 3) + 8 * (r >> 2) + 4 * hh2) * 68 + j * 32 + cl] = acc[i][jh * 2 + j][r];
      __builtin_amdgcn_wave_barrier();
#pragma unroll
      for (int k = 0; k < 4; ++k) {
        const int row = (lane2 >> 3) + 8 * k, c8 = (lane2 & 7) * 8;
        const f32x4 lo = *(const f32x4*)&wl[row * 68 + c8];
        const f32x4 hi = *(const f32x4*)&wl[row * 68 + c8 + 4];
        epi(wv * 64 + i * 32 + row, jh * 64 + c8, lo, hi);
      }
      __builtin_amdgcn_wave_barrier();
    }
}

template <class Epi>
__device__ __forceinline__ void ph_gemm_big(const bf16_t* A, int lda, const bf16_t* Wt, int ldw, int M, int N, int K,
                                            char* lds, Epi epi) {
  const int ntm = M / 256, ntn = N / 128;
  const int npm = (ntm + 7) / 8, npn = (ntn + 7) / 8;
  const int nslots = ((npm * npn * 64 + 511) / 512) * 512;
  for (int u = VB(); u < nslots; u += VG()) {
    int v = (u & 7) * 64 + ((u >> 3) & 63) + (u & ~511);
    int patch = v >> 6, w = v & 63;
    int tm = (patch % npm) * 8 + (w & 7);
    int tn = (patch / npm) * 8 + (w >> 3);
    if (tm >= ntm || tn >= ntn) continue;
    const int m0 = tm * 256, n0 = tn * 128;
    gemm_tile_big(A + (size_t)m0 * lda, lda, Wt + (size_t)n0 * ldw, ldw, K, lds,
                  [&](int r, int c, f32x4_e lo, f32x4_e hi) { epi(m0 + r, n0 + c, lo, hi); });
  }
}

__device__ __forceinline__ void norm_feed(const f32x4_e h0, const f32x4_e h1, const float* gain, int n, bf16_t* hn_row,
                                          float* rowss_m) {
  const f32x4_e g0 = *(const f32x4_e*)(gain + n), g1 = *(const f32x4_e*)(gain + n + 4);
  st_bf16x8(hn_row + n, h0 * g0, h1 * g1);
  float ss = h0[0] * h0[0] + h0[1] * h0[1] + h0[2] * h0[2] + h0[3] * h0[3] + h1[0] * h1[0] + h1[1] * h1[1] + h1[2] * h1[2] + h1[3] * h1[3];
  ss += __shfl_xor(ss, 1);
  ss += __shfl_xor(ss, 2);
  ss += __shfl_xor(ss, 4);
  if (((VT()) & 7) == 0) atomicAdd(rowss_m, ss);
}

template <bool VEC = false, class Epi>
__device__ __forceinline__ void ph_gemm_bf16(const bf16_t* A, int lda, const bf16_t* Wt, int ldw, int M, int N, int K,
                                             char* lds, Epi epi, int vblock = -2) {
  const int ntm = M / 128, ntn = N / 128;
  const int npm = (ntm + 7) / 8, npn = (ntn + 7) / 8;
  const int nslots = ((npm * npn * 64 + 511) / 512) * 512;
  if (vblock == -1) return;
  for (int u = (vblock >= 0 ? vblock : VB()); u < nslots; u += VG()) {
    int v = (u & 7) * 64 + ((u >> 3) & 63) + (u & ~511);
    int patch = v >> 6, w = v & 63;
    int tm = (patch % npm) * 8 + (w & 7);
    int tn = (patch / npm) * 8 + (w >> 3);
    if (tm >= ntm || tn >= ntn) continue;
    const int m0 = tm * 128, n0 = tn * 128;
    if constexpr (VEC)
      gemm_tile_bf16<false, true>(A + (size_t)m0 * lda, lda, Wt + (size_t)n0 * ldw, ldw, K, lds,
                                  [&](int r, int c, f32x4_e lo, f32x4_e hi) { epi(m0 + r, n0 + c, lo, hi); });
    else
      gemm_tile_bf16<false>(A + (size_t)m0 * lda, lda, Wt + (size_t)n0 * ldw, ldw, K, lds,
                            [&](int r, int c, float val) { epi(m0 + r, n0 + c, val); });
  }
}

__device__ __forceinline__ void ph_proj(const P& p, char* lds) {
  for (int u = VB(); u < 1024; u += VG()) {
    int v = (u & 7) * 64 + ((u >> 3) & 63) + (u & ~511);
    int patch = v >> 6, w = v & 63;
    const int tm = (patch & 3) * 8 + (w & 7), tb = (patch >> 2) * 8 + (w >> 3);
    const int tn = (tb < 14) ? tb : (tb < 16) ? tb + 2 : tb + 4;
    const int m0 = tm * 256, n0 = tn * 128;
    const int b = m0 >> 11, sl = m0 & 2047;
    const bf16_t* A = p.hn + (size_t)m0 * DM;
    const bf16_t* W = p.WinT + (size_t)n0 * DM;
    bf16_t* dst;
    int ldd;
    if (n0 < 1024) { dst = p.qn + (size_t)m0 * 1024 + n0; ldd = 1024; }
    else if (n0 < 2560) {
      const int seg = (n0 - 1024) >> 8, g = ((n0 - 1024) >> 7) & 1;
      bf16_t* base = (seg == 0) ? p.kcin : (seg == 1) ? p.vcin : (seg == 2) ? p.ks : p.kw;
      dst = base + ((size_t)(b * 2 + g) * SEQ + sl) * 128; ldd = 128;
    } else if (n0 < 3584) { dst = p.qsb + (size_t)m0 * 1024 + (n0 - 2560); ldd = 1024; }
    else { dst = p.ksb + ((size_t)(b * 8 + ((n0 - 3584) >> 7)) * SEQ + sl) * 128; ldd = 128; }
    gemm_tile_big(A, DM, W, DM, DM, lds, [&](int r, int c, f32x4_e lo, f32x4_e hi) { st_bf16x8(dst + (size_t)r * ldd + c, lo, hi); });
  }
  for (int u = VB(); u < 64 * 13; u += VG()) {
    const int tm = u & 63, ts = u >> 6;
    const int tn = (ts < 2) ? 14 + ts : (ts < 4) ? 16 + ts : (ts < 12) ? 32 + ts : 44;
    const int m0 = tm * 128, n0 = tn * 128;
    const int b = m0 >> 11, sl = m0 & 2047;
    const bf16_t* A = p.hn + (size_t)m0 * DM;
    const bf16_t* W = p.WinT + (size_t)n0 * DM;
    if (n0 < 2560) {
      const int seg = (n0 - 1024) >> 8, g = ((n0 - 1024) >> 7) & 1;
      bf16_t* vd = (seg == 3 ? p.vsT : p.vwT) + ((size_t)(b * 2 + g) * 128) * SEQ + sl;
      gemm_tile_bf16<true>(A, DM, W, DM, DM, lds, [&](int r, int c, float val) { vd[(size_t)r * SEQ + perm16(c)] = f2bf(val); });
    } else if (n0 < 5632) {
      bf16_t* vd = p.vsbT + ((size_t)(b * 8 + ((n0 - 4608) >> 7)) * 128) * SEQ + sl;
      gemm_tile_bf16<true>(A, DM, W, DM, DM, lds, [&](int r, int c, float val) { vd[(size_t)r * SEQ + perm16(c)] = f2bf(val); });
    } else {
      float* gd = p.gates + (size_t)m0 * 24;
      gemm_tile_bf16<false>(A, DM, W, DM, DM, lds, [&](int r, int c, float val) { if (c < 24) gd[(size_t)r * 24 + c] = val; });
    }
  }
}

__device__ __forceinline__ void ph_posb(const P& p) {
  const int lane = VT() & 63, wv = VT() >> 6;
  for (int o = VB() * 4 + wv; o < 256; o += VG() * 4) {
    const int which = o >> 7, n = o & 127;
    const float* pos = which ? p.pos_v : p.pos_k;
    const float* w1 = which ? p.w1_v : p.w1_k;
    float acc = 0.f;
    for (int k = lane; k < 4096; k += 64) acc += pos[k] * w1[(size_t)k * 128 + n];
    acc = wave_sum(acc);
    if (lane == 0) p.posb[o] = acc;
  }
}

__device__ __forceinline__ void ph_compress2(const P& p, char* lds) {
  for (int item = VB(); item < 16; item += VG()) {
    const int which = item >> 3, bg = item & 7;
    const bf16_t* src = (which ? p.vcin : p.kcin) + (size_t)bg * SEQ * 128;
    const bf16_t* w1t = p.w1T + (size_t)which * 128 * 4096;
    const bf16_t* w2t = p.w2T + (size_t)which * 128 * 128;
    const float* posb = p.posb + which * 128;
    bf16_t* c1 = p.c1 + (size_t)item * 128 * 128;
    gemm_tile_bf16<false>(src, 2048, w1t, 4096, 4096, lds, [&](int r, int c, float val) {
      c1[r * 128 + c] = f2bf(gelu_fast(val + posb[c])); });
    __threadfence_block();
    vsync();
    if (which == 0) {
      bf16_t* kd = p.kcb + (size_t)bg * 128 * 128;
      gemm_tile_bf16<false>(c1, 128, w2t, 128, 128, lds, [&](int r, int c, float val) { kd[r * 128 + c] = f2bf(val); });
    } else {
      bf16_t* vd = p.vcT + (size_t)bg * 128 * 128;
      gemm_tile_bf16<true>(c1, 128, w2t, 128, 128, lds, [&](int r, int c, float val) { vd[r * 128 + perm16(c)] = f2bf(val); });
    }
  }
}

#define NEG_BIG (-1e30f)

struct KVRegs { u32x4 k0, k1, k2, k3, v0, v1, v2, v3; };

__device__ __forceinline__ int koff(int row, int chunk) { return row * 256 + ((chunk ^ (row & 15)) << 4); }

__device__ __forceinline__ void kv_load(KVRegs& r, const bf16_t* kp, int ldk, const bf16_t* vp, int ldv) {
  const int tid = VT();
  const bf16_t* kg = kp + (size_t)(tid >> 4) * ldk + (tid & 15) * 8;
  r.k0 = *(const u32x4*)kg;
  r.k1 = *(const u32x4*)(kg + (size_t)16 * ldk);
  r.k2 = *(const u32x4*)(kg + (size_t)32 * ldk);
  r.k3 = *(const u32x4*)(kg + (size_t)48 * ldk);
  const bf16_t* vg = vp + (size_t)(tid >> 3) * ldv + (tid & 7) * 8;
  r.v0 = *(const u32x4*)vg;
  r.v1 = *(const u32x4*)(vg + (size_t)32 * ldv);
  r.v2 = *(const u32x4*)(vg + (size_t)64 * ldv);
  r.v3 = *(const u32x4*)(vg + (size_t)96 * ldv);
}
__device__ __forceinline__ void kv_store(const KVRegs& r, char* lk, char* lv) {
  const int tid = VT();
  const int row = tid >> 4, ch = tid & 15;
  *(u32x4*)(lk + koff(row, ch)) = r.k0;
  *(u32x4*)(lk + koff(row + 16, ch)) = r.k1;
  *(u32x4*)(lk + koff(row + 32, ch)) = r.k2;
  *(u32x4*)(lk + koff(row + 48, ch)) = r.k3;
  const int vr = tid >> 3, vc = tid & 7;
  *(u32x4*)(lv + lds_off(vr, vc)) = r.v0;
  *(u32x4*)(lv + lds_off(vr + 32, vc)) = r.v1;
  *(u32x4*)(lv + lds_off(vr + 64, vc)) = r.v2;
  *(u32x4*)(lv + lds_off(vr + 96, vc)) = r.v3;
}

struct QFrag { bf16x8 f0, f1, f2, f3, f4, f5, f6, f7; };
__device__ __forceinline__ void q_load(QFrag& q, const bf16_t* qrow) {
  const int h = (VT() & 63) >> 5;
  const bf16x8* p8 = (const bf16x8*)(qrow + 8 * h);
  q.f0 = p8[0]; q.f1 = p8[2]; q.f2 = p8[4]; q.f3 = p8[6]; q.f4 = p8[8]; q.f5 = p8[10]; q.f6 = p8[12]; q.f7 = p8[14];
}

__device__ __forceinline__ void qk_tile(const QFrag& q, const char* lk, f32x16& s0, f32x16& s1) {
  const int lane = VT() & 63, row = lane & 31, h = lane >> 5;
#pragma unroll
  for (int r = 0; r < 16; ++r) { s0[r] = 0.f; s1[r] = 0.f; }
#define QK_STEP(kk, qf)                                                                  \
  {                                                                                      \
    bf16x8 a0 = *(const bf16x8*)(lk + koff(row, 2 * (kk) + h));                          \
    bf16x8 a1 = *(const bf16x8*)(lk + koff(row + 32, 2 * (kk) + h));                     \
    s0 = __builtin_amdgcn_mfma_f32_32x32x16_bf16(a0, qf, s0, 0, 0, 0);                   \
    s1 = __builtin_amdgcn_mfma_f32_32x32x16_bf16(a1, qf, s1, 0, 0, 0);                   \
  }
  QK_STEP(0, q.f0) QK_STEP(1, q.f1) QK_STEP(2, q.f2) QK_STEP(3, q.f3)
  QK_STEP(4, q.f4) QK_STEP(5, q.f5) QK_STEP(6, q.f6) QK_STEP(7, q.f7)
#undef QK_STEP
}

__device__ __forceinline__ bf16x8 pack8(const f32x16& p, const int base) {
  u32x4 u;
  u[0] = pack2(p[base + 0], p[base + 1]);
  u[1] = pack2(p[base + 2], p[base + 3]);
  u[2] = pack2(p[base + 4], p[base + 5]);
  u[3] = pack2(p[base + 6], p[base + 7]);
  return __builtin_bit_cast(bf16x8, u);
}

typedef __attribute__((ext_vector_type(2))) unsigned u32x2_t;
__device__ __forceinline__ float xhalf_max(float v) {
  const u32x2_t r = __builtin_amdgcn_permlane32_swap(__float_as_uint(v), __float_as_uint(v), false, false);
  return fmaxf(__uint_as_float(r[0]), __uint_as_float(r[1]));
}
__device__ __forceinline__ float xhalf_sum(float v) {
  const u32x2_t r = __builtin_amdgcn_permlane32_swap(__float_as_uint(v), __float_as_uint(v), false, false);
  return __uint_as_float(r[0]) + __uint_as_float(r[1]);
}
__device__ __forceinline__ float xhalf_get(float v, int hh) {
  const u32x2_t r = __builtin_amdgcn_permlane32_swap(__float_as_uint(v), __float_as_uint(v), false, false);
  return hh ? __uint_as_float(r[0]) : __uint_as_float(r[1]);
}
struct OAcc { f32x16 o0, o1, o2, o3; };
__device__ __forceinline__ void oacc_zero(OAcc& o) {
#pragma unroll
  for (int r = 0; r < 16; ++r) { o.o0[r] = 0.f; o.o1[r] = 0.f; o.o2[r] = 0.f; o.o3[r] = 0.f; }
}
__device__ __forceinline__ void oacc_scale(OAcc& o, float a) {
#pragma unroll
  for (int r = 0; r < 16; ++r) { o.o0[r] *= a; o.o1[r] *= a; o.o2[r] *= a; o.o3[r] *= a; }
}

__device__ __forceinline__ void pv_tile(OAcc& o, const char* lv, const f32x16& p0, const f32x16& p1) {
  const int lane = VT() & 63, row = lane & 31, h = lane >> 5;
  const bf16x8 pf0 = pack8(p0, 0), pf1 = pack8(p0, 8), pf2 = pack8(p1, 0), pf3 = pack8(p1, 8);
#define PV_ROW(dd, acc)                                                                                      \
  {                                                                                                          \
    acc = __builtin_amdgcn_mfma_f32_32x32x16_bf16(*(const bf16x8*)(lv + lds_off(32 * (dd) + row, 0 + h)), pf0, acc, 0, 0, 0); \
    acc = __builtin_amdgcn_mfma_f32_32x32x16_bf16(*(const bf16x8*)(lv + lds_off(32 * (dd) + row, 2 + h)), pf1, acc, 0, 0, 0); \
    acc = __builtin_amdgcn_mfma_f32_32x32x16_bf16(*(const bf16x8*)(lv + lds_off(32 * (dd) + row, 4 + h)), pf2, acc, 0, 0, 0); \
    acc = __builtin_amdgcn_mfma_f32_32x32x16_bf16(*(const bf16x8*)(lv + lds_off(32 * (dd) + row, 6 + h)), pf3, acc, 0, 0, 0); \
  }
  PV_ROW(0, o.o0) PV_ROW(1, o.o1) PV_ROW(2, o.o2) PV_ROW(3, o.o3)
#undef PV_ROW
}

typedef __attribute__((ext_vector_type(2))) float f32x2_s;
#define SPAIR(v, i) __builtin_shufflevector(v, v, (i), (i) + 1)
__device__ __forceinline__ void softmax_tile(f32x16& s0, f32x16& s1, float& m, float& l, OAcc& o, const float sc = 1.f,
                                             const float bb = 0.f) {
  float mr = -INFINITY;
#pragma unroll
  for (int r = 0; r < 16; ++r) mr = fmaxf(mr, fmaxf(s0[r], s1[r]));
  float mx = fmaf(mr, sc, bb);
  mx = (mx != mx) ? -INFINITY : mx;
  mx = xhalf_max(fmaxf(mx, NEG_BIG));
  const float mn = fmaxf(m, mx);
  const float alpha = __builtin_amdgcn_exp2f(m - mn);
  const f32x2_s sc2 = {sc, sc}, c2 = {bb - mn, bb - mn};
  f32x2_s ls2 = {0.f, 0.f};
#pragma unroll
  for (int r = 0; r < 16; r += 2) {
    const f32x2_s pa_in = {s0[r], s0[r + 1]}, pb_in = {s1[r], s1[r + 1]};
    const f32x2_s a = __builtin_elementwise_fma(pa_in, sc2, c2);
    const f32x2_s b = __builtin_elementwise_fma(pb_in, sc2, c2);
    const float a0 = __builtin_amdgcn_exp2f(a[0]), a1 = __builtin_amdgcn_exp2f(a[1]);
    const float b0 = __builtin_amdgcn_exp2f(b[0]), b1 = __builtin_amdgcn_exp2f(b[1]);
    s0[r] = a0; s0[r + 1] = a1; s1[r] = b0; s1[r + 1] = b1;
    const f32x2_s pa = {a0, a1}, pb = {b0, b1};
    ls2 = ls2 + pa + pb;
  }
  const float ls = xhalf_sum(ls2[0] + ls2[1]);
  l = l * alpha + ls;
  m = mn;
  if (__any(alpha != 1.f)) oacc_scale(o, alpha);
}

template <class F>
__device__ __forceinline__ void oacc_foreach(const OAcc& o, F f) {
  const int h = (VT() & 63) >> 5;
#pragma unroll
  for (int rho = 0; rho < 4; ++rho) {
    f(0 + 8 * rho + 4 * h, o.o0[4 * rho], o.o0[4 * rho + 1], o.o0[4 * rho + 2], o.o0[4 * rho + 3]);
    f(32 + 8 * rho + 4 * h, o.o1[4 * rho], o.o1[4 * rho + 1], o.o1[4 * rho + 2], o.o1[4 * rho + 3]);
    f(64 + 8 * rho + 4 * h, o.o2[4 * rho], o.o2[4 * rho + 1], o.o2[4 * rho + 2], o.o2[4 * rho + 3]);
    f(96 + 8 * rho + 4 * h, o.o3[4 * rho], o.o3[4 * rho + 1], o.o3[4 * rho + 2], o.o3[4 * rho + 3]);
  }
}

__device__ __forceinline__ void memattn_item(const P& p, char* lds, int item) {
  char* lk = lds;
  char* lv = lds + 16384;
  const int lane = VT() & 63, wv = VT() >> 6;
  {
    const int tb = item % (SEQ / 128);
    const int bh = item / (SEQ / 128);
    const int b = bh >> 2, hd = bh & 3;
    const int t = tb * 128 + wv * 32 + (lane & 31);
    QFrag q;
    q_load(q, p.qmemb + (size_t)(b * SEQ + t) * 512 + hd * 128);
    const bf16_t* kb = p.kmemb + (size_t)bh * 256 * 128;
    const bf16_t* vb = p.vmemT + (size_t)bh * 128 * 256;
    OAcc o;
    oacc_zero(o);
    float m = NEG_BIG, l = 0.f;
    KVRegs kv;
    kv_load(kv, kb, 128, vb, 256);
#pragma unroll 1
    for (int ti = 0; ti < 4; ++ti) {
      vsync();
      kv_store(kv, lk, lv);
      vsync();
      {
        const int tn = (ti + 1 < 4) ? ti + 1 : 3;
        kv_load(kv, kb + (size_t)tn * 64 * 128, 128, vb + tn * 64, 256);
      }
      f32x16 s0, s1;
      qk_tile(q, lk, s0, s1);
      softmax_tile(s0, s1, m, l, o, ATT_SCALE2, 0.f);
      pv_tile(o, lv, s0, s1);
    }
    const float il = 1.f / l;
    const int t2 = tb * 128 + (VT() >> 6) * 32 + (VT() & 31);
    bf16_t* orow = p.omem + (size_t)(b * SEQ + t2) * 512 + hd * 128;
    oacc_foreach(o, [&](int d, float v0, float v1, float v2, float v3) {
      uint2 u;
      u.x = pack2(v0 * il, v1 * il);
      u.y = pack2(v2 * il, v3 * il);
      *(uint2*)(orow + d) = u;
    });
  }
}

__device__ __forceinline__ void ph_memq_attn(const P& p, char* lds, int vblock, int nvb) {
  if (vblock < 0) return;
  const float* rss = p.rowss;
  for (int u = vblock; u < 64 * 4; u += nvb) {
    const int tm = u & 63, hd = u >> 6;
    const int m0 = tm * 128;
    bf16_t* qd = p.qmemb + (size_t)m0 * 512 + hd * 128;
    gemm_tile_bf16<false, true>(p.hn + (size_t)m0 * DM, DM, p.WmqT + (size_t)hd * 128 * DM, DM, DM, lds,
                                [&](int r, int c, f32x4_e lo, f32x4_e hi) {
                                  const float rs = rsqrtf(rss[m0 + r] * (1.f / DM) + RMS_EPS);
                                  st_bf16x8(qd + (size_t)r * 512 + c, lo * rs, hi * rs); });
    __threadfence_block();
    vsync();
    memattn_item(p, lds, ((m0 >> 11) * 4 + hd) * (SEQ / 128) + ((m0 & 2047) >> 7));
  }
}

template <bool CHK>
__device__ __forceinline__ void sb_pass1(f32x16& z, f32x16& l, const int s_first, const int t) {
  const f32x2_s sc2 = {ATT_SCALE2, ATT_SCALE2}, one2 = {1.f, 1.f};
#pragma unroll
  for (int r = 0; r < 16; r += 2) {
    const f32x2_s zin = {z[r], z[r + 1]};
    const f32x2_s zz = zin * sc2;
    const f32x2_s ee = {__builtin_amdgcn_exp2f(-fabsf(zz[0])), __builtin_amdgcn_exp2f(-fabsf(zz[1]))};
    const f32x2_s tt = ee + one2;
    const f32x2_s lg = {__builtin_amdgcn_logf(tt[0]), __builtin_amdgcn_logf(tt[1])};
    const f32x2_s mn = {fminf(zz[0], 0.f), fminf(zz[1], 0.f)};
    const f32x2_s lf = (mn - lg) - zz;
    if (CHK) {
      const int so = s_first + 8 * (r >> 2) + (r & 3);
      const bool v0 = so < t, v1 = so + 1 < t;
      l[r] = v0 ? lf[0] : 0.f; l[r + 1] = v1 ? lf[1] : 0.f;
      z[r] = v0 ? zz[0] : NEG_BIG; z[r + 1] = v1 ? zz[1] : NEG_BIG;
    } else {
      l[r] = lf[0]; l[r + 1] = lf[1];
      z[r] = zz[0]; z[r + 1] = zz[1];
    }
  }
}
__device__ __forceinline__ void sb_pass3(f32x16& z, const f32x16& l, const float* ag) {
#pragma unroll
  for (int rho = 0; rho < 4; ++rho) {
    const float x3 = l[4 * rho + 3], x23 = x3 + l[4 * rho + 2], x123 = x23 + l[4 * rho + 1];
    const float g = ag[rho];
    const f32x2_s g2 = {g, g};
    const f32x2_s la = {l[4 * rho + 0], l[4 * rho + 1]}, lb = {l[4 * rho + 2], l[4 * rho + 3]};
    const f32x2_s za = {z[4 * rho + 0], z[4 * rho + 1]}, zb = {z[4 * rho + 2], z[4 * rho + 3]};
    const f32x2_s xa = {x123, x23}, xb = {x3, 0.f};
    const f32x2_s aa = (la + za) + (g2 + xa), ab = (lb + zb) + (g2 + xb);
    z[4 * rho + 0] = __builtin_amdgcn_exp2f(aa[0]); z[4 * rho + 1] = __builtin_amdgcn_exp2f(aa[1]);
    z[4 * rho + 2] = __builtin_amdgcn_exp2f(ab[0]); z[4 * rho + 3] = __builtin_amdgcn_exp2f(ab[1]);
  }
}

__device__ __forceinline__ void ph_sb2(const P& p, char* lds) {
  char* lk = lds;
  char* lv = lds + 16384;
  const int lane = VT() & 63, wv = VT() >> 6, hh = lane >> 5;
  const int sb_skip = (VG() > 32) ? 16 : 0;
  if (VB() < sb_skip) return;
  for (int item = VB() - sb_skip; item < NBATCH * 8 * (SEQ / 128); item += VG() - sb_skip) {
    const int tb = (SEQ / 128 - 1) - (item % (SEQ / 128));
    const int bh = item / (SEQ / 128);
    const int b = bh >> 3, hd = bh & 7;
    const int t0 = tb * 128;
    const int t = t0 + wv * 32 + (lane & 31);
    QFrag q;
    q_load(q, p.qsb + (size_t)(b * SEQ + t) * 1024 + hd * 128);
    const bf16_t* kb = p.ksb + (size_t)bh * SEQ * 128;
    const bf16_t* vb = p.vsbT + (size_t)bh * 128 * SEQ;
    OAcc o;
    oacc_zero(o);
    float carry = 0.f;
    const int jhi = (t0 >> 6) + 1;
    const int jw = (t0 + wv * 32 + 30) >> 6;
    KVRegs kv;
    kv_load(kv, kb + (size_t)jhi * 64 * 128, 128, vb + jhi * 64, SEQ);
    volatile unsigned* dflag = (volatile unsigned*)(lds + 32768);
    vsync();
    if (VT() < 4) dflag[VT()] = 0u;
    for (int j = jhi; j >= 0; --j) {
      vsync();
      if ((dflag[0] & dflag[1] & dflag[2] & dflag[3]) != 0u) break;
      kv_store(kv, lk, lv);
      vsync();
      const int jn = (j > 0) ? j - 1 : 0;
      if (j > jw) kv_load(kv, kb + (size_t)jn * 64 * 128, 128, vb + jn * 64, SEQ);
      if (j <= jw) {
        f32x16 z0, z1;
        qk_tile(q, lk, z0, z1);
        const int sbase = j * 64 + 4 * hh;
        float gt[8];
        f32x16 l0, l1;
        if (j * 64 + 63 < t0 + wv * 32) {
          sb_pass1<false>(z0, l0, sbase, t);
          sb_pass1<false>(z1, l1, sbase + 32, t);
        } else {
          sb_pass1<true>(z0, l0, sbase, t);
          sb_pass1<true>(z1, l1, sbase + 32, t);
        }
#pragma unroll
        for (int rho = 0; rho < 4; ++rho) {
          gt[rho] = (l0[4 * rho] + l0[4 * rho + 1]) + (l0[4 * rho + 2] + l0[4 * rho + 3]);
          gt[4 + rho] = (l1[4 * rho] + l1[4 * rho + 1]) + (l1[4 * rho + 2] + l1[4 * rho + 3]);
        }
        float ag[8];
        float run = 0.f;
#pragma unroll
        for (int k = 7; k >= 0; --k) {
          const float pg = xhalf_get(gt[k], hh);
          ag[k] = carry + run + (hh == 0 ? pg : 0.f);
          run += gt[k] + pg;
        }
        carry += run;
        sb_pass3(z0, l0, ag);
        sb_pass3(z1, l1, ag + 4);
        kv_load(kv, kb + (size_t)jn * 64 * 128, 128, vb + jn * 64, SEQ);
        pv_tile(o, lv, z0, z1);
        if (__all(carry < -104.f * LOG2E) && (VT() & 63) == 0) dflag[wv] = 1u;
      }
    }
    int t2 = t;
    asm volatile("" : "+v"(t2));
    bf16_t* orow = p.omix + (size_t)(b * SEQ + t2) * DM + 1024 + hd * 128;
    oacc_foreach(o, [&](int d, float v0, float v1, float v2, float v3) {
      uint2 u;
      u.x = pack2(v0, v1);
      u.y = pack2(v2, v3);
      *(uint2*)(orow + d) = u;
    });
  }
}

#define NSA_IMP 32768
#define NSA_KEYS 49152
#define NSA_SELM 53504
#define NSA_LUT 53632
__device__ __forceinline__ void ph_nsa2(const P& p, char* lds) {
  typedef __attribute__((ext_vector_type(4))) float f32x4;
  char* lk = lds;
  char* lv = lds + 16384;
  float* imp = (float*)(lds + NSA_IMP);
  float* keys = (float*)(lds + NSA_KEYS);
  unsigned* selm = (unsigned*)(lds + NSA_SELM);
  const int tid = VT(), lane = tid & 63, wv = tid >> 6, hh = lane >> 5, ql = lane & 31;
  float* lut = (float*)(lds + NSA_LUT) + wv * 128;
  for (int item = VB(); item < NBATCH * 2 * (SEQ / 32); item += VG()) {
    const int tt = (item < 256) ? (SEQ / 32 - 1) - (item % (SEQ / 32)) : (item % (SEQ / 32));
    const int bg = item / (SEQ / 32);
    const int b = bg >> 1, g = bg & 1;
    const int h = g * 4 + wv;
    const int t0 = tt * 32, tq = t0 + ql, cur = t0 >> 6;
    vsync();
    QFrag q;
    q_load(q, p.qn + (size_t)(b * SEQ + tq) * 1024 + h * 128);
    {
      const int lo = opq(lane);
      lut[lo] = p.t5[t5_bucket(lo) * 8 + h] * LOG2E;
      lut[lo + 64] = p.t5[t5_bucket(lo + 64) * 8 + h] * LOG2E;
    }
#pragma unroll
    for (int i = 0; i < 16; ++i) imp[i * 256 + tid] = 0.f;
    if (tid < 32) selm[tid] = 0u;
    const float* grow = p.gates + (size_t)(b * SEQ + tq) * 24 + h * 3;
    float* prow = p.part + (size_t)(b * SEQ + tq) * 1024 + h * 128;
    OAcc o;
    float m, l;
    KVRegs kv;
    {
      const bf16_t* kb = p.kcb + (size_t)bg * 128 * 128;
      const bf16_t* vb = p.vcT + (size_t)bg * 128 * 128;
      oacc_zero(o);
      m = NEG_BIG; l = 0.f;
      kv_load(kv, kb, 128, vb, 128);
      vsync();
      kv_store(kv, lk, lv);
      vsync();
      f32x16 x0, x1;
      qk_tile(q, lk, x0, x1);
      int tqv = tq;
      asm volatile("" : "+v"(tqv));
      tqv -= 64 * hh;
      float fsc = 1.f, fbb = 0.f;
      if (t0 >= 1152) {
        fsc = ATT_SCALE2; fbb = lut[127];
      } else {
#pragma unroll
        for (int r = 0; r < 16; ++r) {
          const int c = 8 * (r >> 2) + (r & 3);
          const int d0 = tqv - 16 * c - 31, d1 = d0 - 512;
          x0[r] = (d0 >= 0) ? x0[r] * ATT_SCALE2 + lut[min(d0, 127)] : -INFINITY;
          x1[r] = (d1 >= 0) ? x1[r] * ATT_SCALE2 + lut[min(d1, 127)] : -INFINITY;
        }
      }
      softmax_tile(x0, x1, m, l, o, fsc, fbb);
      const float m0 = m;
      pv_tile(o, lv, x0, x1);
      f32x16 z0, z1;
#pragma unroll
      for (int r = 0; r < 16; ++r) { z0[r] = 0.f; z1[r] = 0.f; }
      if (t0 >= 1024) {
        kv_load(kv, kb + 64 * 128, 128, vb + 64, 128);
        vsync();
        kv_store(kv, lk, lv);
        vsync();
        qk_tile(q, lk, z0, z1);
        asm volatile("" : "+v"(tqv));
#pragma unroll
        for (int r = 0; r < 16; ++r) {
          const int c = 64 + 8 * (r >> 2) + (r & 3);
          const int d0 = tqv - 16 * c - 31, d1 = d0 - 512;
          z0[r] = (d0 >= 0) ? z0[r] * ATT_SCALE2 + lut[min(d0, 127)] : -INFINITY;
          z1[r] = (d1 >= 0) ? z1[r] * ATT_SCALE2 + lut[min(d1, 127)] : -INFINITY;
        }
        softmax_tile(z0, z1, m, l, o);
        pv_tile(o, lv, z0, z1);
      }
      const float inv = 1.f / fmaxf(l, 1e-20f);
      const float c0 = __builtin_amdgcn_exp2f(m0 - m) * inv;
#pragma unroll
      for (int r = 0; r < 16; ++r) {
        const int c = 8 * (r >> 2) + (r & 3) + 4 * hh;
        if (x0[r] != 0.f) atomicAdd(&imp[(c) * 32 + ql], x0[r] * c0);
        if (x1[r] != 0.f) atomicAdd(&imp[(c + 32) * 32 + ql], x1[r] * c0);
        if (z0[r] != 0.f) atomicAdd(&imp[(c + 64) * 32 + ql], z0[r] * inv);
        if (z1[r] != 0.f) atomicAdd(&imp[(c + 96) * 32 + ql], z1[r] * inv);
      }
      const float gs = inv / (1.f + __expf(-grow[0]));
      oacc_foreach(o, [&](int d, float v0, float v1, float v2, float v3) {
        f32x4 u = {v0 * gs, v1 * gs, v2 * gs, v3 * gs};
        *(f32x4*)(prow + d) = u;
      });
    }
    vsync();
    {
      const int tido = opq(tid);
      const int qq = tido & 31, jg = tido >> 5;
#pragma unroll
      for (int jj = 0; jj < 4; ++jj) {
        const int j = jg * 4 + jj;
        float v = imp[(4 * j) * 32 + qq] + imp[(4 * j + 1) * 32 + qq] + imp[(4 * j + 2) * 32 + qq] + 0.5f * imp[(4 * j + 3) * 32 + qq];
        if (j > 0) v += 0.5f * imp[(4 * j - 1) * 32 + qq];
        const bool forced = (j == 0) || (j == cur) || (j == cur - 1);
        keys[qq * 33 + j] = forced ? 1e9f : ((j <= cur) ? v : -1e9f);
      }
      vsync();
      unsigned bits = 0u;
#pragma unroll
      for (int jj = 0; jj < 4; ++jj) {
        const int j = jg * 4 + jj;
        const float kj = keys[qq * 33 + j];
        int rank = 0;
        for (int i = 0; i < 32; ++i) {
          const float ki = keys[qq * 33 + i];
          rank += (ki > kj || (ki == kj && i < j)) ? 1 : 0;
        }
        if (rank < 16 && j <= cur) bits |= 1u << j;
      }
      atomicOr(&selm[qq], bits);
      vsync();
    }
    const unsigned mysel = selm[ql];
    unsigned um = mysel;
#pragma unroll
    for (int o2 = 16; o2 > 0; o2 >>= 1) um |= (unsigned)__shfl_xor((int)um, o2);
    um = (unsigned)__builtin_amdgcn_readfirstlane((int)um);
    {
      const bf16_t* kb = p.ks + (size_t)bg * SEQ * 128;
      const bf16_t* vb = p.vsT + (size_t)bg * 128 * SEQ;
      oacc_zero(o);
      m = NEG_BIG; l = 0.f;
      unsigned rem = um;
      int j = __builtin_ctz(rem);
      kv_load(kv, kb + (size_t)j * 64 * 128, 128, vb + j * 64, SEQ);
      while (rem) {
        j = __builtin_ctz(rem);
        rem &= rem - 1;
        const int jn = rem ? __builtin_ctz(rem) : j;
        vsync();
        kv_store(kv, lk, lv);
        vsync();
        f32x16 s0, s1;
        qk_tile(q, lk, s0, s1);
        const bool selq = (mysel >> j) & 1u;
        int tqv = tq;
        asm volatile("" : "+v"(tqv));
        float fsc = 1.f, fbb = 0.f;
        if (j * 64 + 63 + 113 <= t0) {
          fsc = selq ? ATT_SCALE2 : 0.f; fbb = selq ? lut[127] : -INFINITY;
        } else {
#pragma unroll
          for (int r = 0; r < 16; ++r) {
            const int d0 = tqv - (j * 64 + 8 * (r >> 2) + (r & 3) + 4 * hh), d1 = d0 - 32;
            s0[r] = (selq && d0 >= 0) ? s0[r] * ATT_SCALE2 + lut[min(d0, 127)] : -INFINITY;
            s1[r] = (selq && d1 >= 0) ? s1[r] * ATT_SCALE2 + lut[min(d1, 127)] : -INFINITY;
          }
        }
        kv_load(kv, kb + (size_t)jn * 64 * 128, 128, vb + jn * 64, SEQ);
        softmax_tile(s0, s1, m, l, o, fsc, fbb);
        pv_tile(o, lv, s0, s1);
      }
      const float gs = 1.f / (fmaxf(l, 1e-20f) * (1.f + __expf(-grow[1])));
      int qo = ql;
      asm volatile("" : "+v"(qo));
      float* pr2 = p.part + (size_t)(b * SEQ + t0 + qo) * 1024 + h * 128;
      oacc_foreach(o, [&](int d, float v0, float v1, float v2, float v3) {
        f32x4 u = *(f32x4*)(pr2 + d);
        u[0] += v0 * gs; u[1] += v1 * gs; u[2] += v2 * gs; u[3] += v3 * gs;
        *(f32x4*)(pr2 + d) = u;
      });
    }
    {
      const bf16_t* kb = p.kw + (size_t)bg * SEQ * 128;
      const bf16_t* vb = p.vwT + (size_t)bg * 128 * SEQ;
      oacc_zero(o);
      m = NEG_BIG; l = 0.f;
      int jlo = (t0 - 511) >> 6;
      if (jlo < 0) jlo = 0;
      kv_load(kv, kb + (size_t)jlo * 64 * 128, 128, vb + jlo * 64, SEQ);
      for (int j = jlo; j <= cur; ++j) {
        const int jn = (j < cur) ? j + 1 : j;
        vsync();
        kv_store(kv, lk, lv);
        vsync();
        f32x16 s0, s1;
        qk_tile(q, lk, s0, s1);
        int tqv = tq;
        asm volatile("" : "+v"(tqv));
        float wsc = 1.f, wbb = 0.f;
        if (j * 64 + 63 + 113 <= t0 && t0 + 31 - j * 64 < 512) {
          wsc = ATT_SCALE2; wbb = lut[127];
        } else {
#pragma unroll
          for (int r = 0; r < 16; ++r) {
            const int d0 = tqv - (j * 64 + 8 * (r >> 2) + (r & 3) + 4 * hh), d1 = d0 - 32;
            s0[r] = (d0 >= 0 && d0 < 512) ? s0[r] * ATT_SCALE2 + lut[min(d0, 127)] : -INFINITY;
            s1[r] = (d1 >= 0 && d1 < 512) ? s1[r] * ATT_SCALE2 + lut[min(d1, 127)] : -INFINITY;
          }
        }
        kv_load(kv, kb + (size_t)jn * 64 * 128, 128, vb + jn * 64, SEQ);
        softmax_tile(s0, s1, m, l, o, wsc, wbb);
        pv_tile(o, lv, s0, s1);
      }
      const float gs = 1.f / (fmaxf(l, 1e-20f) * (1.f + __expf(-grow[2])));
      int qo = ql;
      asm volatile("" : "+v"(qo));
      const float* pr2 = p.part + (size_t)(b * SEQ + t0 + qo) * 1024 + h * 128;
      bf16_t* orow = p.omix + (size_t)(b * SEQ + t0 + qo) * DM + h * 128;
      oacc_foreach(o, [&](int d, float v0, float v1, float v2, float v3) {
        const f32x4 u = *(const f32x4*)(pr2 + d);
        uint2 w;
        w.x = pack2(u[0] + v0 * gs, u[1] + v1 * gs);
        w.y = pack2(u[2] + v2 * gs, u[3] + v3 * gs);
        *(uint2*)(orow + d) = w;
      });
    }
  }
}

__device__ __forceinline__ void ph_cvt(const float* src, bf16_t* dst, size_t n) {
  typedef __attribute__((ext_vector_type(4))) float f32x4;
  const size_t nv = n / 8;
  for (size_t i = (size_t)VB() * 256 + VT(); i < nv; i += (size_t)VG() * 256) {
    const f32x4 a = ((const f32x4*)src)[2 * i], b = ((const f32x4*)src)[2 * i + 1];
    u32x4 o;
    o[0] = pack2(a[0], a[1]); o[1] = pack2(a[2], a[3]); o[2] = pack2(b[0], b[1]); o[3] = pack2(b[2], b[3]);
    ((u32x4*)dst)[i] = o;
  }
}

__device__ __forceinline__ void ph_scores(const P& p, char* lds) {
  for (int u = VB(); u < 64 * 16; u += VG()) {
    const int tm = u & 63, hp = u >> 6;
    const int m0 = tm * 128;
    float* sc = p.scores + (size_t)m0 * DM + hp * 128;
    gemm_tile_bf16<false>(p.omix + (size_t)m0 * DM + hp * 128, DM, p.subkb + (size_t)hp * 128 * 128, 128, 128, lds,
                          [&](int r, int c, float val) { sc[(size_t)r * DM + c] = val; });
  }
}

__device__ __forceinline__ void ph_qp_scores(const P& p, char* lds) {
  const int ntm = T_TOK / 256, ntn = DM / 128;
  const int npm = (ntm + 7) / 8, npn = (ntn + 7) / 8;
  const int nslots = ((npm * npn * 64 + 511) / 512) * 512;
  for (int u = VB(); u < nslots; u += VG()) {
    int v = (u & 7) * 64 + ((u >> 3) & 63) + (u & ~511);
    int patch = v >> 6, w = v & 63;
    int tm = (patch % npm) * 8 + (w & 7);
    int tn = (patch / npm) * 8 + (w >> 3);
    if (tm >= ntm || tn >= ntn) continue;
    const int m0 = tm * 256, n0 = tn * 128;
    bf16_t* qp = p.omix + (size_t)m0 * DM + n0;
    const float* rss = p.rowss + T_TOK + m0;
    gemm_tile_big(p.hn + (size_t)m0 * DM, DM, p.WpqT + (size_t)n0 * DM, DM, DM, lds,
                  [&](int r, int c, f32x4_e lo, f32x4_e hi) {
                    const float rs = rsqrtf(rss[r] * (1.f / DM) + RMS_EPS);
                    st_bf16x8(qp + (size_t)r * DM + c, lo * rs, hi * rs); });
    __threadfence_block();
    vsync();
    float* sc = p.scores + (size_t)m0 * DM + n0;
    gemm_tile_big(qp, DM, p.subkb + (size_t)tn * 128 * 128, 128, 128, lds,
                  [&](int r, int c, f32x4_e lo, f32x4_e hi) {
                    *(f32x4_e*)(sc + (size_t)r * DM + c) = lo; *(f32x4_e*)(sc + (size_t)r * DM + c + 4) = hi; });
  }
}

__device__ __forceinline__ void ph_cvt4(const float* src, unsigned char* dst, float* scales, int nrows, int wid0, int nw) {
  typedef __attribute__((ext_vector_type(4))) float f32x4;
  typedef __attribute__((ext_vector_type(2))) float f32x2;
  const int lane = VT() & 63;
  const float one = __uint_as_float((unsigned)opq(0x3F800000));
  float lev[8];
#pragma unroll
  for (int c = 0; c < 8; ++c) {
    const f32x2 q = __builtin_amdgcn_cvt_scalef32_pk_f32_fp4((unsigned)opq(c * 0x11111111), one, 0);
    lev[c] = fabsf(q[0]);
  }
  const float maxlev = lev[7];
  for (int row = wid0; row < nrows; row += nw) {
    const f32x4* s4 = (const f32x4*)(src + (size_t)row * DM) + lane * 8;
    f32x4 v[8];
    float amax = 0.f;
#pragma unroll
    for (int i = 0; i < 8; ++i) {
      v[i] = s4[i];
#pragma unroll
      for (int k = 0; k < 4; ++k) amax = fmaxf(amax, fabsf(v[i][k]));
    }
    amax = wave_max(amax);
    const float sc = (amax > 0.f) ? maxlev / amax : 1.f;
    u32x4 o;
#pragma unroll
    for (int w = 0; w < 4; ++w) {
      unsigned pk = 0u;
      pk = __builtin_amdgcn_cvt_scalef32_pk_fp4_f32(pk, v[2 * w][0] * sc, v[2 * w][1] * sc, 1.0f, 0);
      pk = __builtin_amdgcn_cvt_scalef32_pk_fp4_f32(pk, v[2 * w][2] * sc, v[2 * w][3] * sc, 1.0f, 1);
      pk = __builtin_amdgcn_cvt_scalef32_pk_fp4_f32(pk, v[2 * w + 1][0] * sc, v[2 * w + 1][1] * sc, 1.0f, 2);
      pk = __builtin_amdgcn_cvt_scalef32_pk_fp4_f32(pk, v[2 * w + 1][2] * sc, v[2 * w + 1][3] * sc, 1.0f, 3);
      o[w] = pk;
    }
    *(u32x4*)(dst + (size_t)row * 1024 + lane * 16) = o;
    if (lane == 0) scales[row] = (amax > 0.f) ? amax / maxlev : 1.f;
  }
}

__device__ __forceinline__ float wave_sum_dpp(float v) {
  typedef __attribute__((ext_vector_type(2))) unsigned u32x2_d;
  v += __builtin_bit_cast(float, __builtin_amdgcn_update_dpp(0, __builtin_bit_cast(int, v), 0xB1, 0xF, 0xF, true));
  v += __builtin_bit_cast(float, __builtin_amdgcn_update_dpp(0, __builtin_bit_cast(int, v), 0x4E, 0xF, 0xF, true));
  v += __builtin_bit_cast(float, __builtin_amdgcn_update_dpp(0, __builtin_bit_cast(int, v), 0x141, 0xF, 0xF, true));
  v += __builtin_bit_cast(float, __builtin_amdgcn_update_dpp(0, __builtin_bit_cast(int, v), 0x140, 0xF, 0xF, true));
  u32x2_d r = __builtin_amdgcn_permlane16_swap(__float_as_uint(v), __float_as_uint(v), false, false);
  v = __uint_as_float(r[0]) + __uint_as_float(r[1]);
  r = __builtin_amdgcn_permlane32_swap(__float_as_uint(v), __float_as_uint(v), false, false);
  return __uint_as_float(r[0]) + __uint_as_float(r[1]);
}
__device__ __forceinline__ float gelu_rcp(float x) {
  const float y2 = (1.5957691216057308f * LOG2E) * (x + 0.044715f * x * x * x);
  return x * __builtin_amdgcn_rcpf(1.f + __builtin_amdgcn_exp2f(-y2));
}
__device__ __forceinline__ u32x4 r4_load(const unsigned char* tab, int eid, int lane) {
  return *((const u32x4*)(tab + (size_t)eid * 1024) + lane);
}
struct XPk { f32x16 a, b; };
struct Acc32 { f32x16 a, b; };

typedef __attribute__((ext_vector_type(2))) float f32x2_t;
#define PAIR(v, i) __builtin_shufflevector(v, v, (i), (i) + 1)
#define R4_DOT_W(word, xv, base, sa, sb)                                                             \
  {                                                                                                  \
    const f32x2_t q0 = __builtin_amdgcn_cvt_scalef32_pk_f32_fp4(word, one, 0), q1 = __builtin_amdgcn_cvt_scalef32_pk_f32_fp4(word, one, 1); \
    const f32x2_t q2 = __builtin_amdgcn_cvt_scalef32_pk_f32_fp4(word, one, 2), q3 = __builtin_amdgcn_cvt_scalef32_pk_f32_fp4(word, one, 3); \
    sa = __builtin_elementwise_fma(q0, PAIR(xv, base + 0), sa); sb = __builtin_elementwise_fma(q1, PAIR(xv, base + 2), sb); \
    sa = __builtin_elementwise_fma(q2, PAIR(xv, base + 4), sa); sb = __builtin_elementwise_fma(q3, PAIR(xv, base + 6), sb); \
  }
__device__ __forceinline__ float r4_dot(const u32x4& e, const XPk& x) {
  const float one = __uint_as_float((unsigned)opq(0x3F800000));
  f32x2_t sa = {0.f, 0.f}, sb = {0.f, 0.f};
  R4_DOT_W(e[0], x.a, 0, sa, sb) R4_DOT_W(e[1], x.a, 8, sa, sb) R4_DOT_W(e[2], x.b, 0, sa, sb) R4_DOT_W(e[3], x.b, 8, sa, sb)
  sa = sa + sb;
  return sa[0] + sa[1];
}
#define R4_AXPY_P(accv, i, q)                                                                        \
  { const f32x2_t r_ = __builtin_elementwise_fma(h2, q, PAIR(accv, i)); accv[i] = r_[0]; accv[(i) + 1] = r_[1]; }
#define R4_AXPY_W(word, accv, base)                                                                  \
  {                                                                                                  \
    const f32x2_t q0 = __builtin_amdgcn_cvt_scalef32_pk_f32_fp4(word, one, 0), q1 = __builtin_amdgcn_cvt_scalef32_pk_f32_fp4(word, one, 1); \
    const f32x2_t q2 = __builtin_amdgcn_cvt_scalef32_pk_f32_fp4(word, one, 2), q3 = __builtin_amdgcn_cvt_scalef32_pk_f32_fp4(word, one, 3); \
    R4_AXPY_P(accv, base + 0, q0) R4_AXPY_P(accv, base + 2, q1) R4_AXPY_P(accv, base + 4, q2) R4_AXPY_P(accv, base + 6, q3) \
  }
__device__ __forceinline__ void r4_axpy(const u32x4& e, float hid, Acc32& acc) {
  const float one = __uint_as_float((unsigned)opq(0x3F800000));
  const f32x2_t h2 = {hid, hid};
  R4_AXPY_W(e[0], acc.a, 0) R4_AXPY_W(e[1], acc.a, 8) R4_AXPY_W(e[2], acc.b, 0) R4_AXPY_W(e[3], acc.b, 8)
}

#define INS16(K, x)                                                                                      \
  K##15 = __builtin_amdgcn_fmed3f(K##15, K##14, x); K##14 = __builtin_amdgcn_fmed3f(K##14, K##13, x);   \
  K##13 = __builtin_amdgcn_fmed3f(K##13, K##12, x); K##12 = __builtin_amdgcn_fmed3f(K##12, K##11, x);   \
  K##11 = __builtin_amdgcn_fmed3f(K##11, K##10, x); K##10 = __builtin_amdgcn_fmed3f(K##10, K##9, x);    \
  K##9 = __builtin_amdgcn_fmed3f(K##9, K##8, x); K##8 = __builtin_amdgcn_fmed3f(K##8, K##7, x);         \
  K##7 = __builtin_amdgcn_fmed3f(K##7, K##6, x); K##6 = __builtin_amdgcn_fmed3f(K##6, K##5, x);         \
  K##5 = __builtin_amdgcn_fmed3f(K##5, K##4, x); K##4 = __builtin_amdgcn_fmed3f(K##4, K##3, x);         \
  K##3 = __builtin_amdgcn_fmed3f(K##3, K##2, x); K##2 = __builtin_amdgcn_fmed3f(K##2, K##1, x);         \
  K##1 = __builtin_amdgcn_fmed3f(K##1, K##0, x); K##0 = fmaxf(K##0, x);
#define DECL16(K) float K##0 = -INFINITY, K##1 = -INFINITY, K##2 = -INFINITY, K##3 = -INFINITY, K##4 = -INFINITY, \
  K##5 = -INFINITY, K##6 = -INFINITY, K##7 = -INFINITY, K##8 = -INFINITY, K##9 = -INFINITY, K##10 = -INFINITY,   \
  K##11 = -INFINITY, K##12 = -INFINITY, K##13 = -INFINITY, K##14 = -INFINITY, K##15 = -INFINITY;
__device__ __forceinline__ float mkkey(float v, unsigned tag, unsigned mask) {
  return __uint_as_float((__float_as_uint(v) & ~mask) | tag);
}

__device__ __forceinline__ void ph_peer(const P& p, float* smem) {
  typedef __attribute__((ext_vector_type(4))) float f32x4;
  float* lists = smem;
  int* bexA = (int*)(smem + 4096);
  float* bgtA = smem + 6144;
  float* bsuA = smem + 8192;
  for (int item = VB(); item < T_TOK / 16; item += VG()) {
    const int t0 = item * 16;
    vsync();
    {
      const int tid = VT();
      const int tl = tid >> 4, hp = tid & 15;
      const f32x4* sp = (const f32x4*)(p.scores + (size_t)(t0 + tl) * DM + hp * 128);
      DECL16(k)
#pragma unroll 4
      for (int c4 = 0; c4 < 32; ++c4) {
        const f32x4 v = sp[c4];
#pragma unroll
        for (int e = 0; e < 4; ++e) {
          const float x = mkkey(v[e], 127u - (unsigned)(c4 * 4 + e), 127u);
          INS16(k, x)
        }
      }
      f32x4* lp = (f32x4*)(lists + (size_t)VT() * 16);
      f32x4 o0 = {k0, k1, k2, k3}, o1 = {k4, k5, k6, k7}, o2 = {k8, k9, k10, k11}, o3 = {k12, k13, k14, k15};
      lp[0] = o0; lp[1] = o1; lp[2] = o2; lp[3] = o3;
    }
    vsync();
    if (VT() < 128) {
      const int tid = VT();
      const int tl = tid >> 3, h = tid & 7;
      const float* la = lists + (size_t)(tl * 16 + 2 * h) * 16;
      const float* lb = la + 16;
      float av[16], bv[16];
#pragma unroll
      for (int i = 0; i < 16; ++i) {
        av[i] = __uint_as_float(__float_as_uint(la[i]) & ~127u);
        bv[i] = __uint_as_float(__float_as_uint(lb[i]) & ~127u);
      }
      DECL16(c)
#pragma unroll
      for (int i = 0; i < 16; ++i) {
#pragma unroll
        for (int j = 0; j < 16; ++j) {
          if ((i + 1) * (j + 1) <= 16) {
            const float x = mkkey(av[i] + bv[j], 255u - (unsigned)(i * 16 + j), 255u);
            INS16(c, x)
          }
        }
      }
      float cs[16] = {c0, c1, c2, c3, c4, c5, c6, c7, c8, c9, c10, c11, c12, c13, c14, c15};
      float ev[16];
      float sum = 0.f;
      const float mx = __uint_as_float(__float_as_uint(cs[0]) & ~255u);
#pragma unroll
      for (int n = 0; n < 16; ++n) {
        ev[n] = __expf(__uint_as_float(__float_as_uint(cs[n]) & ~255u) - mx);
        sum += ev[n];
      }
      const float isum = 1.f / sum;
#pragma unroll
      for (int n = 0; n < 16; ++n) {
        const unsigned cc = 255u - (__float_as_uint(cs[n]) & 255u);
        const unsigned ka = 127u - (__float_as_uint(la[cc >> 4]) & 127u);
        const unsigned kb = 127u - (__float_as_uint(lb[cc & 15u]) & 127u);
        const int eid = (int)(ka * 128u + kb);
        bexA[tl * 128 + h * 16 + n] = eid;
        bgtA[tl * 128 + h * 16 + n] = ev[n] * isum * p.sv8[eid];
        bsuA[tl * 128 + h * 16 + n] = p.su8[eid];
      }
    }
    vsync();
#pragma unroll 1
    for (int ti4 = 0; ti4 < 4; ++ti4) {
    const int lane = VT() & 63, wv = VT() >> 6;
    const int tl = wv * 4 + ti4;
    const int t = t0 + tl;
    const int* bex = bexA + tl * 128;
    const float* bgt = bgtA + tl * 128;
    const float* bsu = bsuA + tl * 128;
    XPk x;
    {
      const f32x4* s4 = (const f32x4*)(p.out + (size_t)t * DM) + lane * 8;
      const f32x4* g4 = (const f32x4*)p.norm_ffn + lane * 8;
      f32x4 a0 = s4[0], a1 = s4[1], a2 = s4[2], a3 = s4[3], a4 = s4[4], a5 = s4[5], a6 = s4[6], a7 = s4[7];
      float ss = 0.f;
#define SSQ(v) ss += v[0] * v[0] + v[1] * v[1] + v[2] * v[2] + v[3] * v[3];
      SSQ(a0) SSQ(a1) SSQ(a2) SSQ(a3) SSQ(a4) SSQ(a5) SSQ(a6) SSQ(a7)
#undef SSQ
      ss = wave_sum(ss);
      const float rs = rsqrtf(ss * (1.f / DM) + RMS_EPS);
#define XPK(dst, base, va, vb, gi)                                                    \
  {                                                                                   \
    const f32x4 ga = g4[gi], gb = g4[gi + 1];                                         \
    dst[base + 0] = bf2f(f2bf(va[0] * rs * ga[0])); dst[base + 1] = bf2f(f2bf(va[1] * rs * ga[1]));   \
    dst[base + 2] = bf2f(f2bf(va[2] * rs * ga[2])); dst[base + 3] = bf2f(f2bf(va[3] * rs * ga[3]));   \
    dst[base + 4] = bf2f(f2bf(vb[0] * rs * gb[0])); dst[base + 5] = bf2f(f2bf(vb[1] * rs * gb[1]));   \
    dst[base + 6] = bf2f(f2bf(vb[2] * rs * gb[2])); dst[base + 7] = bf2f(f2bf(vb[3] * rs * gb[3]));   \
  }
      XPK(x.a, 0, a0, a1, 0) XPK(x.a, 8, a2, a3, 2) XPK(x.b, 0, a4, a5, 4) XPK(x.b, 8, a6, a7, 6)
#undef XPK
    }
    Acc32 acc;
#pragma unroll
    for (int r = 0; r < 16; ++r) { acc.a[r] = 0.f; acc.b[r] = 0.f; }
    u32x4 u0 = r4_load(p.pu8, bex[0], lane), u1 = r4_load(p.pu8, bex[1], lane), u2 = r4_load(p.pu8, bex[2], lane), u3 = r4_load(p.pu8, bex[3], lane);
    u32x4 v0 = r4_load(p.pv8, bex[0], lane), v1 = r4_load(p.pv8, bex[1], lane), v2 = r4_load(p.pv8, bex[2], lane), v3 = r4_load(p.pv8, bex[3], lane);
#pragma unroll 1
    for (int e0 = 0; e0 < 128; e0 += 4) {
      float d0 = r4_dot(u0, x), d1 = r4_dot(u1, x), d2 = r4_dot(u2, x), d3 = r4_dot(u3, x);
      const int en = (e0 + 4 < 128) ? e0 + 4 : 124;
      const int i0 = bex[en], i1 = bex[en + 1], i2 = bex[en + 2], i3 = bex[en + 3];
      u0 = r4_load(p.pu8, i0, lane); u1 = r4_load(p.pu8, i1, lane); u2 = r4_load(p.pu8, i2, lane); u3 = r4_load(p.pu8, i3, lane);
      d0 = wave_sum_dpp(d0); d1 = wave_sum_dpp(d1); d2 = wave_sum_dpp(d2); d3 = wave_sum_dpp(d3);
      { const float hid = bgt[e0 + 0] * gelu_rcp(d0 * bsu[e0 + 0]); r4_axpy(v0, hid, acc); }
      { const float hid = bgt[e0 + 1] * gelu_rcp(d1 * bsu[e0 + 1]); r4_axpy(v1, hid, acc); }
      { const float hid = bgt[e0 + 2] * gelu_rcp(d2 * bsu[e0 + 2]); r4_axpy(v2, hid, acc); }
      { const float hid = bgt[e0 + 3] * gelu_rcp(d3 * bsu[e0 + 3]); r4_axpy(v3, hid, acc); }
      v0 = r4_load(p.pv8, i0, lane); v1 = r4_load(p.pv8, i1, lane); v2 = r4_load(p.pv8, i2, lane); v3 = r4_load(p.pv8, i3, lane);
    }
    const int lane2 = opq(lane);
    f32x4* o4 = (f32x4*)(p.out + (size_t)t * DM) + lane2 * 8;
    const f32x4* g4 = (const f32x4*)p.norm_final + lane2 * 8;
    f32x4 hv[8];
    float ss = 0.f;
#pragma unroll
    for (int i = 0; i < 8; ++i) {
      hv[i] = o4[i];
#pragma unroll
      for (int k = 0; k < 4; ++k) {
        hv[i][k] += (i < 4) ? acc.a[4 * i + k] : acc.b[4 * (i - 4) + k];
        ss += hv[i][k] * hv[i][k];
      }
    }
    ss = wave_sum(ss);
    const float rs = rsqrtf(ss * (1.f / DM) + RMS_EPS);
#pragma unroll
    for (int i = 0; i < 8; ++i) {
      const f32x4 g = g4[i];
      f32x4 o;
#pragma unroll
      for (int k = 0; k < 4; ++k) o[k] = hv[i][k] * rs * g[k];
      o4[i] = o;
    }
    }
  }
}

#define XB_TMO      128
#define XB_XCNT(j)  (256  + 64 * (j))
#define XB_XSUB(j)  (1280 + 64 * (j))
#define XB_XGEN(j)  (2304 + 64 * (j))
#define XB_TOP      3328
#define XB_TOPGEN   3392
#define XCD_BAR_WORDS 3456
#define XB_SPIN_CAP (1u << 22)
__device__ __forceinline__ unsigned xb_ld(unsigned* p) { return __hip_atomic_load(p, __ATOMIC_RELAXED, __HIP_MEMORY_SCOPE_AGENT); }
__device__ __forceinline__ unsigned xb_add(unsigned* p, unsigned v) { return __hip_atomic_fetch_add(p, v, __ATOMIC_RELAXED, __HIP_MEMORY_SCOPE_AGENT); }
__device__ __forceinline__ unsigned xb_xcc_id() { return (unsigned)__builtin_amdgcn_s_getreg((3 << 11) | 20) & 0xFu; }
#define XB_SPIN(cond, bar) do { unsigned _sp = 0; while (cond) { __builtin_amdgcn_s_sleep(1); \
    if ((++_sp & 255u) == 0u) { if (xb_ld(&(bar)[XB_TMO])) break; if (_sp > XB_SPIN_CAP) { atomicAdd(&(bar)[XB_TMO], 1u); break; } } } } while (0)
struct XcdBarrier { unsigned* bar; unsigned x; volatile LAS unsigned* st; };
__device__ __forceinline__ XcdBarrier xcd_barrier_post(unsigned* bar, volatile LAS unsigned* st) {
  XcdBarrier b; b.bar = bar; b.x = xb_xcc_id(); b.st = st;
  if (threadIdx.x == 0) (void)xb_add(&bar[XB_XCNT(b.x)], 1u);
  return b;
}
__device__ __forceinline__ void xcd_barrier_complete(unsigned* bar, unsigned x, unsigned& nloc, unsigned& nx) {
  const unsigned G = gridDim.x * gridDim.y * gridDim.z;
  unsigned sum, cnt, mine, sp = 0u;
  for (;;) {
    sum = 0u; cnt = 0u; mine = 0u;
#pragma unroll
    for (unsigned j = 0; j < 16; ++j) { const unsigned c = xb_ld(&bar[XB_XCNT(j)]); sum += c; cnt += (c > 0u) ? 1u : 0u; mine = (j == x) ? c : mine; }
    if (sum == G) break;
    __builtin_amdgcn_s_sleep(1);
    if ((++sp & 255u) == 0u) { if (xb_ld(&bar[XB_TMO])) break; if (sp > XB_SPIN_CAP) { atomicAdd(&bar[XB_TMO], 1u); break; } }
  }
  nloc = mine > 0u ? mine : 1u; nx = cnt > 0u ? cnt : 1u;
}
__device__ __forceinline__ void xcd_barrier(const XcdBarrier& b) {
  asm volatile("s_waitcnt vmcnt(0)" ::: "memory");
  __syncthreads();
  if (threadIdx.x == 0) {
    unsigned* bar = b.bar;
    __builtin_amdgcn_s_waitcnt(0);
    unsigned nloc = b.st[0], nx = b.st[1];
    if (nloc == 0u) { xcd_barrier_complete(bar, b.x, nloc, nx); b.st[0] = nloc; b.st[1] = nx; }
    const unsigned old = xb_add(&bar[XB_XSUB(b.x)], 1u);
    const unsigned gen = old / nloc;
    if (old + 1u == (gen + 1u) * nloc) {
      __builtin_amdgcn_fence(__ATOMIC_RELEASE, "agent");
      asm volatile("s_waitcnt vmcnt(0)" ::: "memory");
      const unsigned og = xb_add(&bar[XB_TOP], 1u);
      const unsigned tg = og / nx;
      if (og + 1u == (tg + 1u) * nx) xb_add(&bar[XB_TOPGEN], 1u);
      else XB_SPIN(xb_ld(&bar[XB_TOPGEN]) == tg, bar);
      __builtin_amdgcn_fence(__ATOMIC_ACQUIRE, "agent");
      xb_add(&bar[XB_XGEN(b.x)], 1u);
      asm volatile("s_waitcnt vmcnt(0)" ::: "memory");
    } else {
      XB_SPIN(xb_ld(&bar[XB_XGEN(b.x)]) == gen, bar);
      __builtin_amdgcn_fence(__ATOMIC_ACQUIRE, "agent");
      asm volatile("s_waitcnt vmcnt(0)" ::: "memory");
    }
  }
  __syncthreads();
}

typedef const __attribute__((address_space(4))) P* KP;
__device__ __forceinline__ P loadP() {
#if defined(__HIP_DEVICE_COMPILE__)
  KP k = (KP)__builtin_amdgcn_kernarg_segment_ptr();
  asm volatile("" : "+s"(k));
  P p = *k;
  return p;
#else
  return P{};
#endif
}

__global__ void __launch_bounds__(512, 2) mega(P p_arg) {
  cg::grid_group grid = cg::this_grid();
  __shared__ __attribute__((aligned(16))) float smem_all[2 * 18432 + 64];
  float* smem = smem_all + (threadIdx.x >> 8) * 18432;
  char* lds = (char*)smem;
  unsigned* xbw = (unsigned*)(smem_all + 2 * 18432 + 32);
  if (threadIdx.x < 64) ((unsigned*)(smem_all + 2 * 18432))[threadIdx.x] = 0u;
  if (blockIdx.x == 0) {
    P p = loadP();
    for (int i = threadIdx.x; i < XCD_BAR_WORDS; i += 512) p.bar[i] = 0u;
  }
  __syncthreads();
  { P p = loadP(); ph_rmsnorm(p.x, p.norm_mix, p.hn, T_TOK); ph_rmsnorm(p.mem, p.norm_mkv, p.memn, 1024); }
  { P p = loadP(); ph_transpose<true>(smem, p.w_in, DM, INC, 5760, p.WinT); }
  { P p = loadP(); ph_transpose<false>(smem, p.w_mk, DM, 512, 512, p.WmkT); }
  { P p = loadP(); ph_transpose<false>(smem, p.w_mv, DM, 512, 512, p.WmvT); }
  { P p = loadP(); ph_cvt(p.subk, p.subkb, (size_t)16 * 128 * 128); }
  { P p = loadP(); ph_transpose<false>(smem, p.w1_k, 4096, 128, 128, p.w1T); }
  { P p = loadP(); ph_transpose<false>(smem, p.w1_v, 4096, 128, 128, p.w1T + 128 * 4096); }
  { P p = loadP(); ph_transpose<false>(smem, p.w2_k, 128, 128, 128, p.w2T); }
  { P p = loadP(); ph_transpose<false>(smem, p.w2_v, 128, 128, 128, p.w2T + 128 * 128); }
  { P p = loadP(); ph_posb(p); }
  { P p = loadP(); for (int i = VB() * 256 + VT(); i < 2 * T_TOK; i += VG() * 256) p.rowss[i] = 0.f; }
  grid.sync();
  XcdBarrier xb;
  { P p = loadP(); xb = xcd_barrier_post(p.bar, (volatile LAS unsigned*)xbw); }
  { P p = loadP(); ph_proj(p, lds); }
  const int kvb = (VG() == 512) ? ((VB() >= 320 && VB() < 352) ? (VB() - 320) * 8 : -1) : -2;
  const int vvb = (VG() == 512) ? ((VB() >= 352 && VB() < 384) ? (VB() - 352) * 8 : -1) : -2;
  { P p = loadP(); bf16_t* kmem = p.kmemb;
    ph_gemm_bf16(p.memn, DM, p.WmkT, DM, 1024, 512, DM, lds, [=](int m, int n, float v) {
      kmem[((size_t)((m >> 8) * 4 + (n >> 7)) * 256 + (m & 255)) * 128 + (n & 127)] = f2bf(v); }, kvb); }
  { P p = loadP(); bf16_t* vmem = p.vmemT;
    ph_gemm_bf16(p.memn, DM, p.WmvT, DM, 1024, 512, DM, lds, [=](int m, int n, float v) {
      vmem[((size_t)((m >> 8) * 4 + (n >> 7)) * 128 + (n & 127)) * 256 + perm16(m & 255)] = f2bf(v); }, vvb); }
  xcd_barrier(xb);
  { P p = loadP(); ph_compress2(p, lds); }
  { P p = loadP(); ph_sb2(p, lds); }
  {
    const int skip = (VG() > 32) ? 16 : 0;
    const int vb = (VB() >= skip) ? VB() - skip : -1, nvb = VG() - skip;
    vsync();
    { P p = loadP(); ph_transpose<false>(smem, p.w_out, DM, DM, DM, p.WoutT, vb, nvb); }
    { P p = loadP(); ph_transpose<false>(smem, p.w_mq, DM, 512, 512, p.WmqT, vb, nvb); }
  }
  xcd_barrier(xb);
  { P p = loadP(); ph_nsa2(p, lds); }
  xcd_barrier(xb);
  { P p = loadP(); float* out = p.out; const float* x = p.x; const float* gmq = p.norm_mq; bf16_t* hn = p.hn; float* rss = p.rowss;
    ph_gemm_big(p.omix, DM, p.WoutT, DM, T_TOK, DM, DM, lds, [=](int m, int n, f32x4_e lo, f32x4_e hi) {
      const f32x4_e x0 = *(const f32x4_e*)(x + (size_t)m * DM + n), x1 = *(const f32x4_e*)(x + (size_t)m * DM + n + 4);
      const f32x4_e h0 = x0 + lo, h1 = x1 + hi;
      *(f32x4_e*)(out + (size_t)m * DM + n) = h0; *(f32x4_e*)(out + (size_t)m * DM + n + 4) = h1;
      norm_feed(h0, h1, gmq, n, hn + (size_t)m * DM, rss + m); }); }
  xcd_barrier(xb);
  {
    const int half = (VG() >= 512) ? 256 : 0;
    if (half == 0 || VB() < half) { P p = loadP(); ph_memq_attn(p, lds, VB(), half ? half : VG()); }
    if (VB() >= half) {
      const int nwv = (VG() - half) * 4, wid = (VB() - half) * 4 + (VT() >> 6);
      vsync();
      { P p = loadP(); ph_transpose<false>(smem, p.w_mo, 512, DM, DM, p.WmoT, VB() - half, VG() - half); }
      { P p = loadP(); ph_cvt4(p.pu, p.pu8, p.su8, 16384, wid, nwv); }
      { P p = loadP(); ph_cvt4(p.pv, p.pv8, p.sv8, 16384, wid, nwv); }
      vsync();
      { P p = loadP(); ph_transpose<false>(smem, p.w_pq, DM, DM, DM, p.WpqT, VB() - half, VG() - half); }
    }
  }
  xcd_barrier(xb);
  { P p = loadP(); float* out = p.out; const float* gffn = p.norm_ffn; bf16_t* hn = p.hn; float* rss = p.rowss + T_TOK;
    ph_gemm_big(p.omem, 512, p.WmoT, 512, T_TOK, DM, 512, lds, [=](int m, int n, f32x4_e lo, f32x4_e hi) {
      f32x4_e* o0 = (f32x4_e*)(out + (size_t)m * DM + n);
      const f32x4_e h0 = o0[0] + lo, h1 = o0[1] + hi;
      o0[0] = h0; o0[1] = h1;
      norm_feed(h0, h1, gffn, n, hn + (size_t)m * DM, rss + m); }); }
  xcd_barrier(xb);
  { P p = loadP(); ph_qp_scores(p, lds); }
  xcd_barrier(xb);
  { P p = loadP(); ph_peer(p, smem); }
}

extern "C" void kernel_launch(void* const* d_in, const int* in_sizes, int n_in, void* d_out, int out_size, void* d_ws,
                              size_t ws_size, hipStream_t stream) {
  P p{};
  p.x = (const float*)d_in[0]; p.mem = (const float*)d_in[1]; p.t5 = (const float*)d_in[2];
  p.norm_mix = (const float*)d_in[3]; p.w_in = (const float*)d_in[4]; p.pos_k = (const float*)d_in[5];
  p.w1_k = (const float*)d_in[6]; p.w2_k = (const float*)d_in[7]; p.pos_v = (const float*)d_in[8];
  p.w1_v = (const float*)d_in[9]; p.w2_v = (const float*)d_in[10]; p.w_out = (const float*)d_in[11];
  p.norm_mq = (const float*)d_in[12]; p.norm_mkv = (const float*)d_in[13]; p.w_mq = (const float*)d_in[14];
  p.w_mk = (const float*)d_in[15]; p.w_mv = (const float*)d_in[16]; p.w_mo = (const float*)d_in[17];
  p.norm_ffn = (const float*)d_in[18]; p.w_pq = (const float*)d_in[19]; p.subk = (const float*)d_in[20];
  p.pu = (const float*)d_in[21]; p.pv = (const float*)d_in[22]; p.norm_final = (const float*)d_in[23];
  p.out = (float*)d_out;
  char* w = (char*)d_ws;
  size_t off = 0;
  auto take = [&](size_t bytes) { char* r = w + off; off += (bytes + 255) & ~(size_t)255; return r; };
  p.bar = (unsigned*)take(XCD_BAR_WORDS * 4);
  p.scores = (float*)take((size_t)T_TOK * DM * 4);
  p.gates = (float*)take((size_t)T_TOK * 24 * 4);
  p.part = (float*)take((size_t)T_TOK * 1024 * 4);
  p.posb = (float*)take(256 * 4);
  p.rowss = (float*)take((size_t)2 * T_TOK * 4);
  p.qn = (bf16_t*)take((size_t)T_TOK * 1024 * 2);
  p.kcin = (bf16_t*)take((size_t)T_TOK * 256 * 2 + 65536);
  p.vcin = (bf16_t*)take((size_t)T_TOK * 256 * 2 + 65536);
  p.ks = (bf16_t*)take((size_t)T_TOK * 256 * 2);
  p.vsT = (bf16_t*)take((size_t)T_TOK * 256 * 2);
  p.kw = (bf16_t*)take((size_t)T_TOK * 256 * 2);
  p.vwT = (bf16_t*)take((size_t)T_TOK * 256 * 2);
  p.kcb = (bf16_t*)take((size_t)8 * 128 * 128 * 2);
  p.vcT = (bf16_t*)take((size_t)8 * 128 * 128 * 2);
  p.c1 = (bf16_t*)take((size_t)16 * 128 * 128 * 2);
  p.w1T = (bf16_t*)take((size_t)2 * 128 * 4096 * 2);
  p.w2T = (bf16_t*)take((size_t)2 * 128 * 128 * 2);
  p.hn = (bf16_t*)take((size_t)T_TOK * DM * 2);
  p.omix = (bf16_t*)take((size_t)T_TOK * DM * 2);
  p.memn = (bf16_t*)take((size_t)1024 * DM * 2);
  p.omem = (bf16_t*)take((size_t)T_TOK * 512 * 2);
  p.WinT = (bf16_t*)take((size_t)5760 * DM * 2);
  p.WoutT = (bf16_t*)take((size_t)DM * DM * 2);
  p.WpqT = (bf16_t*)take((size_t)DM * DM * 2);
  p.WmqT = (bf16_t*)take((size_t)512 * DM * 2);
  p.WmkT = (bf16_t*)take((size_t)512 * DM * 2);
  p.WmvT = (bf16_t*)take((size_t)512 * DM * 2);
  p.WmoT = (bf16_t*)take((size_t)DM * 512 * 2);
  p.qmemb = (bf16_t*)take((size_t)T_TOK * 512 * 2);
  p.kmemb = (bf16_t*)take((size_t)1024 * 512 * 2);
  p.vmemT = (bf16_t*)take((size_t)1024 * 512 * 2);
  p.qsb = (bf16_t*)take((size_t)T_TOK * 1024 * 2);
  p.ksb = (bf16_t*)take((size_t)T_TOK * 1024 * 2);
  p.vsbT = (bf16_t*)take((size_t)T_TOK * 1024 * 2);
  p.pu8 = (unsigned char*)take((size_t)16384 * 1024);
  p.pv8 = (unsigned char*)take((size_t)16384 * 1024);
  p.su8 = (float*)take(16384 * 4);
  p.sv8 = (float*)take(16384 * 4);
  p.subkb = (bf16_t*)take((size_t)16 * 128 * 128 * 2);
  static int grid_blocks = 0;
  if (!grid_blocks) {
    int dev = 0, cus = 0, per_cu = 0;
    (void)hipGetDevice(&dev);
    (void)hipDeviceGetAttribute(&cus, hipDeviceAttributeMultiprocessorCount, dev);
    (void)hipOccupancyMaxActiveBlocksPerMultiprocessor(&per_cu, mega, 512, 0);
    if (per_cu > 1) per_cu = 1;
    if (per_cu < 1) per_cu = 1;
    grid_blocks = cus * per_cu;
  }
  void* args[] = {&p};
  hipError_t e = hipLaunchCooperativeKernel((void*)mega, dim3(grid_blocks), dim3(512), args, 0, stream);
  if (e != hipSuccess) fprintf(stderr, "cooperative launch failed: %s (grid %d)\n", hipGetErrorString(e), grid_blocks);
}
```

```cpp
#include <hip/hip_runtime.h>
#include <hip/hip_cooperative_groups.h>
#include <cstdio>
namespace cg = cooperative_groups;
#include <stdint.h>

#define SEQ 2048
#define NBATCH 4
#define T_TOK 8192
#define DM 2048
#define INC 5656
#define C_QN 0
#define C_KC 1024
#define C_VC 1280
#define C_KS 1536
#define C_VS 1792
#define C_KW 2048
#define C_VW 2304
#define C_GT 2560
#define C_QSB 2584
#define C_KSB 3608
#define C_VSB 4632
#define ATT_SCALE 0.08838834764831845f
#define LOG2E 1.4426950408889634f
#define ATT_SCALE2 (ATT_SCALE * LOG2E)
#define RMS_EPS 1e-6f

typedef unsigned short bf16_t;
typedef __attribute__((ext_vector_type(8))) short bf16x8;
typedef __attribute__((ext_vector_type(16))) float f32x16;
typedef __attribute__((ext_vector_type(2))) __bf16 bf16v2;
typedef __attribute__((ext_vector_type(4))) unsigned u32x4;

struct P {
  const float *x, *mem, *t5, *norm_mix, *w_in, *pos_k, *w1_k, *w2_k, *pos_v, *w1_v, *w2_v, *w_out,
      *norm_mq, *norm_mkv, *w_mq, *w_mk, *w_mv, *w_mo, *norm_ffn, *w_pq, *subk, *pu, *pv, *norm_final;
  float* out;
  float *scores, *gates, *part, *posb, *rowss;
  unsigned* bar;
  bf16_t *hn, *omix, *memn, *omem;
  bf16_t *WinT, *WoutT, *WpqT, *WmqT, *WmkT, *WmvT, *WmoT;
  bf16_t *qmemb, *kmemb, *vmemT;
  bf16_t *qsb, *ksb, *vsbT;
  bf16_t* subkb;
  unsigned char *pu8, *pv8;
  float *su8, *sv8;
  bf16_t *qn, *kcin, *vcin, *ks, *vsT, *kw, *vwT, *kcb, *vcT, *c1, *w1T, *w2T;
};

__device__ __forceinline__ int opq(int v) { asm volatile("" : "+v"(v)); return v; }
#define LAS __attribute__((address_space(3)))
#define VHALF_BYTES 73728
#define VCNT_OFF (2 * VHALF_BYTES)
__device__ __forceinline__ int VT() { return opq(threadIdx.x) & 255; }
__device__ __forceinline__ int VB() { return (int)blockIdx.x * 2 + (int)(threadIdx.x >> 8); }
__device__ __forceinline__ int VG() { return (int)gridDim.x * 2; }
__device__ __forceinline__ void vbar_wait() {
  if ((threadIdx.x & 63) == 0) {
    LAS unsigned* c = (LAS unsigned*)(unsigned)(VCNT_OFF + 64 * (int)(threadIdx.x >> 8));
    const unsigned old = __hip_atomic_fetch_add(c, 1u, __ATOMIC_RELAXED, __HIP_MEMORY_SCOPE_WORKGROUP);
    const unsigned target = (old & ~3u) + 4u;
    while (__hip_atomic_load(c, __ATOMIC_RELAXED, __HIP_MEMORY_SCOPE_WORKGROUP) < target) __builtin_amdgcn_s_sleep(0);
  }
}
__device__ __forceinline__ void vsync() {
  __builtin_amdgcn_fence(__ATOMIC_RELEASE, "workgroup");
  vbar_wait();
  __builtin_amdgcn_fence(__ATOMIC_ACQUIRE, "workgroup");
}
__device__ __forceinline__ void vsync_raw() {
  asm volatile("" ::: "memory");
  vbar_wait();
  asm volatile("" ::: "memory");
}

__device__ __forceinline__ unsigned pack2(float a, float b) {
  bf16v2 r = {(__bf16)a, (__bf16)b};
  return *(unsigned*)&r;
}
__device__ __forceinline__ bf16_t f2bf(float a) {
  __bf16 r = (__bf16)a;
  return *(bf16_t*)&r;
}
__device__ __forceinline__ int perm16(int s) { return (s & ~12) | ((s & 4) << 1) | ((s & 8) >> 1); }
__device__ __forceinline__ float bf2f(bf16_t u) { return __uint_as_float((unsigned)u << 16); }

__device__ __forceinline__ float wave_max(float v) {
  for (int o = 32; o > 0; o >>= 1) v = fmaxf(v, __shfl_xor(v, o));
  return v;
}
__device__ __forceinline__ float wave_sum(float v) {
  for (int o = 32; o > 0; o >>= 1) v += __shfl_xor(v, o);
  return v;
}
__device__ __forceinline__ void wave_argmax(float& v, int& i) {
  for (int o = 32; o > 0; o >>= 1) {
    float ov = __shfl_xor(v, o);
    int oi = __shfl_xor(i, o);
    if (ov > v || (ov == v && oi < i)) { v = ov; i = oi; }
  }
}
__device__ __forceinline__ float gelu_tanh(float x) {
  return 0.5f * x * (1.f + tanhf(0.7978845608028654f * (x + 0.044715f * x * x * x)));
}
__device__ __forceinline__ float gelu_fast(float x) {
  const float y = 1.5957691216057308f * (x + 0.044715f * x * x * x);
  return x / (1.f + __expf(-y));
}
__device__ __forceinline__ int t5_bucket(int n) {
  if (n < 16) return n < 0 ? 0 : n;
  int b = 16;
  b += (n >= 19); b += (n >= 21); b += (n >= 24); b += (n >= 27); b += (n >= 31); b += (n >= 35);
  b += (n >= 40); b += (n >= 46); b += (n >= 52); b += (n >= 59); b += (n >= 67); b += (n >= 77);
  b += (n >= 87); b += (n >= 99); b += (n >= 113);
  return b;
}
__device__ __forceinline__ float log_sigmoid(float x) {
  return fminf(x, 0.f) - log1pf(expf(-fabsf(x)));
}

__device__ __forceinline__ void ph_rmsnorm(const float* src, const float* gain, bf16_t* dst, int rows) {
  int lane = VT() & 63, wv = VT() >> 6;
  for (int r = VB() * 4 + wv; r < rows; r += VG() * 4) {
    const float4* s4 = (const float4*)(src + (size_t)r * DM);
    float4 v[8];
    float ss = 0.f;
#pragma unroll
    for (int i = 0; i < 8; ++i) {
      v[i] = s4[i * 64 + lane];
      ss += v[i].x * v[i].x + v[i].y * v[i].y + v[i].z * v[i].z + v[i].w * v[i].w;
    }
    ss = wave_sum(ss);
    float rs = rsqrtf(ss * (1.f / DM) + RMS_EPS);
    uint2* d2 = (uint2*)(dst + (size_t)r * DM);
    const float4* g4 = (const float4*)gain;
#pragma unroll
    for (int i = 0; i < 8; ++i) {
      float4 g = g4[i * 64 + lane];
      uint2 o;
      o.x = pack2(v[i].x * rs * g.x, v[i].y * rs * g.y);
      o.y = pack2(v[i].z * rs * g.z, v[i].w * rs * g.w);
      d2[i * 64 + lane] = o;
    }
  }
}

template <bool CMAP>
__device__ __forceinline__ void ph_transpose(float* smem, const float* W, int K, int N, int Npad, bf16_t* Wt,
                                             int vblock = -2, int nvb = 0) {
  typedef __attribute__((ext_vector_type(4))) float f32x4;
  float (*tl)[65] = (float (*)[65])smem;
  if (vblock == -1) return;
  const int b0 = (vblock >= 0) ? vblock : VB(), bstride = (vblock >= 0) ? nvb : VG();
  const int tid = VT();
  const int nk = K / 64, nn = Npad / 64;
  for (int tile = b0; tile < nk * nn; tile += bstride) {
    const int k0 = (tile % nk) * 64, n0 = (tile / nk) * 64;
    const int kr = tid >> 4, n4 = (tid & 15) * 4;
    int sc = n0 + n4;
    if (CMAP) sc = (sc < 2560) ? sc : (sc < 5632) ? sc + 24 : (sc < 5656) ? sc - 5632 + 2560 : N;
#pragma unroll
    for (int i = 0; i < 4; ++i) {
      const int k = kr + 16 * i;
      f32x4 v = {0.f, 0.f, 0.f, 0.f};
      if (sc < N) v = *(const f32x4*)(W + (size_t)(k0 + k) * N + sc);
      tl[k][n4 + 0] = v[0]; tl[k][n4 + 1] = v[1]; tl[k][n4 + 2] = v[2]; tl[k][n4 + 3] = v[3];
    }
    vsync();
    int n = tid >> 2, kc = (tid & 3) * 16;
    unsigned w[8];
#pragma unroll
    for (int i = 0; i < 8; ++i) w[i] = pack2(tl[kc + 2 * i][n], tl[kc + 2 * i + 1][n]);
    uint4* dst = (uint4*)(Wt + (size_t)(n0 + n) * K + k0 + kc);
    dst[0] = make_uint4(w[0], w[1], w[2], w[3]);
    dst[1] = make_uint4(w[4], w[5], w[6], w[7]);
    vsync();
  }
}

__device__ __forceinline__ int lds_off(int row, int chunk) { return row * 128 + ((chunk ^ ((row >> 1) & 7)) << 4); }

template <bool TR, bool VEC = false, class Epi>
__device__ __forceinline__ void gemm_tile_bf16(const bf16_t* xp, int ldx, const bf16_t* yp, int ldy, int K, char* lds,
                                               Epi epi) {
  const int tid = VT(), lane = tid & 63, wv = tid >> 6;
  const int wr = wv >> 1, wc = wv & 1;
  f32x16 acc[2][2];
#pragma unroll
  for (int i = 0; i < 2; ++i)
#pragma unroll
    for (int j = 0; j < 2; ++j)
#pragma unroll
      for (int r = 0; r < 16; ++r) acc[i][j][r] = 0.f;
  const int prow = lane >> 3, pch = lane & 7;
  const bf16_t* xs[4];
  const bf16_t* ys[4];
#pragma unroll
  for (int ps = 0; ps < 4; ++ps) {
    const int row = (wv * 4 + ps) * 8 + prow;
    const int c = pch ^ ((row >> 1) & 7);
    xs[ps] = xp + (size_t)row * ldx + c * 8;
    ys[ps] = yp + (size_t)row * ldy + c * 8;
  }
  char* const mydst = lds + wv * 4096 + lane * 16;
#define GEMM_ISSUE(k0, bufoff)                                                                                              \
  _Pragma("unroll") for (int ps = 0; ps < 4; ++ps) {                                                                        \
    __builtin_amdgcn_global_load_lds((const unsigned*)(xs[ps] + (k0)), (unsigned*)(mydst + (bufoff) + ps * 1024), 16, 0, 0);         \
    __builtin_amdgcn_global_load_lds((const unsigned*)(ys[ps] + (k0)), (unsigned*)(mydst + (bufoff) + 16384 + ps * 1024), 16, 0, 0); \
  }
#define GEMM_COMPUTE(bufoff)                                                                                     \
  _Pragma("unroll") for (int kk = 0; kk < 4; ++kk) {                                                             \
    bf16x8 a[2], b[2];                                                                                           \
    const int ch = kk * 2 + (lane >> 5);                                                                         \
    _Pragma("unroll") for (int i = 0; i < 2; ++i) {                                                              \
      a[i] = *(const bf16x8*)(lds + (bufoff) + (TR ? 16384 : 0) + lds_off(wr * 64 + i * 32 + (lane & 31), ch)); \
      b[i] = *(const bf16x8*)(lds + (bufoff) + (TR ? 0 : 16384) + lds_off(wc * 64 + i * 32 + (lane & 31), ch)); \
    }                                                                                                            \
    _Pragma("unroll") for (int i = 0; i < 2; ++i)                                                                \
      _Pragma("unroll") for (int j = 0; j < 2; ++j)                                                              \
        acc[i][j] = __builtin_amdgcn_mfma_f32_32x32x16_bf16(a[i], b[j], acc[i][j], 0, 0, 0);                    \
  }
  vsync();
  GEMM_ISSUE(0, 0)
  for (int k0 = 0; k0 < K; k0 += 128) {
    asm volatile("s_waitcnt vmcnt(0)" ::: "memory");
    vsync();
    GEMM_ISSUE(k0 + 64, 32768)
    GEMM_COMPUTE(0)
    asm volatile("s_waitcnt vmcnt(0)" ::: "memory");
    vsync();
    if (k0 + 128 < K) { GEMM_ISSUE(k0 + 128, 0) }
    GEMM_COMPUTE(32768)
  }
#undef GEMM_ISSUE
#undef GEMM_COMPUTE
  int lane2 = lane;
  asm volatile("" : "+v"(lane2));
  if constexpr (VEC) {
    typedef __attribute__((ext_vector_type(4))) float f32x4;
    vsync();
    float* wl = (float*)lds + wv * (32 * 68);
    const int hh2 = lane2 >> 5, cl = lane2 & 31;
#pragma unroll
    for (int i = 0; i < 2; ++i) {
#pragma unroll
      for (int j = 0; j < 2; ++j)
#pragma unroll
        for (int r = 0; r < 16; ++r) wl[((r & 3) + 8 * (r >> 2) + 4 * hh2) * 68 + j * 32 + cl] = acc[i][j][r];
      __builtin_amdgcn_wave_barrier();
#pragma unroll
      for (int k = 0; k < 4; ++k) {
        const int row = (lane2 >> 3) + 8 * k, c8 = (lane2 & 7) * 8;
        const f32x4 lo = *(const f32x4*)&wl[row * 68 + c8];
        const f32x4 hi = *(const f32x4*)&wl[row * 68 + c8 + 4];
        epi(wr * 64 + i * 32 + row, wc * 64 + c8, lo, hi);
      }
      __builtin_amdgcn_wave_barrier();
    }
  } else {
#pragma unroll
    for (int i = 0; i < 2; ++i)
#pragma unroll
      for (int j = 0; j < 2; ++j)
#pragma unroll
        for (int r = 0; r < 16; ++r) {
          int rr = wr * 64 + i * 32 + (r & 3) + 8 * (r >> 2) + 4 * (lane2 >> 5);
          int cc = wc * 64 + j * 32 + (lane2 & 31);
          epi(rr, cc, acc[i][j][r]);
        }
  }
}

typedef __attribute__((ext_vector_type(4))) float f32x4_e;
__device__ __forceinline__ void st_bf16x8(bf16_t* dst, f32x4_e lo, f32x4_e hi) {
  u32x4 o;
  o[0] = pack2(lo[0], lo[1]); o[1] = pack2(lo[2], lo[3]); o[2] = pack2(hi[0], hi[1]); o[3] = pack2(hi[2], hi[3]);
  *(u32x4*)dst = o;
}

__device__ __forceinline__ int lds_off32(int row, int chunk) { return row * 64 + ((chunk ^ ((row >> 2) & 3)) << 4); }

template <class Epi>
__device__ __forceinline__ void gemm_tile_big(const bf16_t* xp, int ldx, const bf16_t* yp, int ldy, int K, char* lds,
                                              Epi epi) {
  const int tid = VT(), lane = tid & 63, wv = tid >> 6;
  f32x16 acc[2][4];
#pragma unroll
  for (int i = 0; i < 2; ++i)
#pragma unroll
    for (int j = 0; j < 4; ++j)
#pragma unroll
      for (int r = 0; r < 16; ++r) acc[i][j][r] = 0.f;
  const int prow = lane >> 2, pch = lane & 3;
  const bf16_t* xs[4];
  const bf16_t* ys[2];
#pragma unroll
  for (int ps = 0; ps < 4; ++ps) {
    const int row = (wv * 4 + ps) * 16 + prow;
    xs[ps] = xp + (size_t)row * ldx + (pch ^ ((row >> 2) & 3)) * 8;
  }
#pragma unroll
  for (int ps = 0; ps < 2; ++ps) {
    const int row = (wv * 2 + ps) * 16 + prow;
    ys[ps] = yp + (size_t)row * ldy + (pch ^ ((row >> 2) & 3)) * 8;
  }
  char* const xdst = lds + wv * 4096 + lane * 16;
  char* const ydst = lds + 16384 + wv * 2048 + lane * 16;
#define BIG_ISSUE(k0, st)                                                                                                      \
  _Pragma("unroll") for (int ps = 0; ps < 4; ++ps)                                                                             \
    __builtin_amdgcn_global_load_lds((const unsigned*)(xs[ps] + (k0)), (unsigned*)(xdst + (st) + ps * 1024), 16, 0, 0);        \
  _Pragma("unroll") for (int ps = 0; ps < 2; ++ps)                                                                             \
    __builtin_amdgcn_global_load_lds((const unsigned*)(ys[ps] + (k0)), (unsigned*)(ydst + (st) + ps * 1024), 16, 0, 0);
#define DSR(dst, addr, off) asm volatile("ds_read_b128 %0, %1 offset:%2" : "=v"(dst) : "v"(addr), "i"(off) : "memory")
#define WAIT1(n, x) asm volatile("s_waitcnt lgkmcnt(" #n ")" : "+v"(x))
#define WAIT2(n, x, y) asm volatile("s_waitcnt lgkmcnt(" #n ")" : "+v"(x), "+v"(y))
#define MF(acc_, a_, b_) acc_ = __builtin_amdgcn_mfma_f32_32x32x16_bf16(a_, b_, acc_, 0, 0, 0)
#define BIG_COMPUTE(st)                                                                                   \
  {                                                                                                       \
    bf16x8 a00, a01, a10, a11, b00, b01, b02, b03, b10, b11, b12, b13;                                    \
    const unsigned aa0 = abase0 + (st), aa1 = abase1 + (st), bb0 = bbase0 + (st), bb1 = bbase1 + (st);    \
    DSR(a00, aa0, 0); DSR(b00, bb0, 0); DSR(b01, bb0, 2048); DSR(b02, bb0, 4096); DSR(b03, bb0, 6144);    \
    DSR(a01, aa0, 2048);                                                                                  \
    DSR(a10, aa1, 0); DSR(b10, bb1, 0); DSR(b11, bb1, 2048); DSR(b12, bb1, 4096); DSR(b13, bb1, 6144);    \
    DSR(a11, aa1, 2048);                                                                                  \
    WAIT2(10, a00, b00); MF(acc[0][0], a00, b00);                                                         \
    WAIT1(9, b01); MF(acc[0][1], a00, b01);                                                               \
    WAIT1(8, b02); MF(acc[0][2], a00, b02);                                                               \
    WAIT1(7, b03); MF(acc[0][3], a00, b03);                                                               \
    WAIT1(6, a01); MF(acc[1][0], a01, b00); MF(acc[1][1], a01, b01); MF(acc[1][2], a01, b02); MF(acc[1][3], a01, b03); \
    WAIT2(4, a10, b10); MF(acc[0][0], a10, b10);                                                          \
    WAIT1(3, b11); MF(acc[0][1], a10, b11);                                                               \
    WAIT1(2, b12); MF(acc[0][2], a10, b12);                                                               \
    WAIT1(1, b13); MF(acc[0][3], a10, b13);                                                               \
    WAIT1(0, a11); MF(acc[1][0], a11, b10); MF(acc[1][1], a11, b11); MF(acc[1][2], a11, b12); MF(acc[1][3], a11, b13); \
  }
  const unsigned ldsb = (unsigned)(size_t)(__attribute__((address_space(3))) char*)lds;
  const unsigned abase0 = ldsb + lds_off32(wv * 64 + (lane & 31), 0 + (lane >> 5));
  const unsigned abase1 = ldsb + lds_off32(wv * 64 + (lane & 31), 2 + (lane >> 5));
  const unsigned bbase0 = ldsb + 16384 + lds_off32((lane & 31), 0 + (lane >> 5));
  const unsigned bbase1 = ldsb + 16384 + lds_off32((lane & 31), 2 + (lane >> 5));
  const int nsteps = K >> 5;
  vsync();
  BIG_ISSUE(0, 0)
  BIG_ISSUE(32, 24576)
  int cur = 0, nx2 = 49152;
  for (int t = 0; t < nsteps - 2; ++t) {
    asm volatile("s_waitcnt vmcnt(6)" ::: "memory");
    vsync_raw();
    BIG_ISSUE((t + 2) * 32, nx2)
    BIG_COMPUTE(cur)
    cur = (cur == 49152) ? 0 : cur + 24576;
    nx2 = (nx2 == 49152) ? 0 : nx2 + 24576;
  }
  asm volatile("s_waitcnt vmcnt(6)" ::: "memory");
  vsync_raw();
  BIG_COMPUTE(cur)
  cur = (cur == 49152) ? 0 : cur + 24576;
  asm volatile("s_waitcnt vmcnt(0)" ::: "memory");
  vsync_raw();
  BIG_COMPUTE(cur)
#undef BIG_ISSUE
#undef BIG_COMPUTE
#undef DSR
#undef WAIT1
#undef WAIT2
#undef MF
  const int lane2 = opq(lane);
  typedef __attribute__((ext_vector_type(4))) float f32x4;
  vsync();
  float* wl = (float*)lds + wv * (32 * 68);
  const int hh2 = lane2 >> 5, cl = lane2 & 31;
#pragma unroll
  for (int i = 0; i < 2; ++i)
#pragma unroll
    for (int jh = 0; jh < 2; ++jh) {
#pragma unroll
      for (int j = 0; j < 2; ++j)
#pragma unroll
        for (int r = 0; r < 16; ++r) wl[((r & 3) + 8 * (r >> 2) + 4 * hh2) * 68 + j * 32 + cl] = acc[i][jh * 2 + j][r];
      __builtin_amdgcn_wave_barrier();
#pragma unroll
      for (int k = 0; k < 4; ++k) {
        const int row = (lane2 >> 3) + 8 * k, c8 = (lane2 & 7) * 8;
        const f32x4 lo = *(const f32x4*)&wl[row * 68 + c8];
        const f32x4 hi = *(const f32x4*)&wl[row * 68 + c8 + 4];
        epi(wv * 64 + i * 32 + row, jh * 64 + c8, lo, hi);
      }
      __builtin_amdgcn_wave_barrier();
    }
}

template <class Epi>
__device__ __forceinline__ void ph_gemm_big(const bf16_t* A, int lda, const bf16_t* Wt, int ldw, int M, int N, int K,
                                            char* lds, Epi epi) {
  const int ntm = M / 256, ntn = N / 128;
  const int npm = (ntm + 7) / 8, npn = (ntn + 7) / 8;
  const int nslots = ((npm * npn * 64 + 511) / 512) * 512;
  for (int u = VB(); u < nslots; u += VG()) {
    int v = (u & 7) * 64 + ((u >> 3) & 63) + (u & ~511);
    int patch = v >> 6, w = v & 63;
    int tm = (patch % npm) * 8 + (w & 7);
    int tn = (patch / npm) * 8 + (w >> 3);
    if (tm >= ntm || tn >= ntn) continue;
    const int m0 = tm * 256, n0 = tn * 128;
    gemm_tile_big(A + (size_t)m0 * lda, lda, Wt + (size_t)n0 * ldw, ldw, K, lds,
                  [&](int r, int c, f32x4_e lo, f32x4_e hi) { epi(m0 + r, n0 + c, lo, hi); });
  }
}

template <int PM = 0, class Epi>
__device__ __forceinline__ void gemm_tile_huge(const bf16_t* xp, int ldx, const bf16_t* yp, int ldy, int K, char* lds0,
                                               Epi epi) {
  const int tid = opq(threadIdx.x), lane = tid & 63, wv = tid >> 6;
  const int wr = wv >> 2, wc = wv & 3;
  f32x16 acc[4][2];
#pragma unroll
  for (int i = 0; i < 4; ++i)
#pragma unroll
    for (int j = 0; j < 2; ++j)
#pragma unroll
      for (int r = 0; r < 16; ++r) acc[i][j][r] = 0.f;
  const int prow = lane >> 3, pch = lane & 7;
  const bf16_t* xs[4];
  const bf16_t* ys[4];
#pragma unroll
  for (int ps = 0; ps < 4; ++ps) {
    const int row = (wv * 4 + ps) * 8 + prow;
    const int c = pch ^ ((row >> 1) & 7);
    xs[ps] = xp + (size_t)row * ldx + c * 8;
    ys[ps] = yp + (size_t)row * ldy + c * 8;
  }
  char* const xdst = lds0 + wv * 4096 + lane * 16;
#define HUGE_ISSUE(k0, st)                                                                                                          \
  _Pragma("unroll") for (int ps = 0; ps < 4; ++ps) {                                                                                \
    __builtin_amdgcn_global_load_lds((const unsigned*)(xs[ps] + (k0)), (unsigned*)(xdst + (st) + ps * 1024), 16, 0, 0);             \
    __builtin_amdgcn_global_load_lds((const unsigned*)(ys[ps] + (k0)), (unsigned*)(xdst + (st) + 32768 + ps * 1024), 16, 0, 0);     \
  }
#define HDSR(dst, addr, off) asm volatile("ds_read_b128 %0, %1 offset:%2" : "=v"(dst) : "v"(addr), "i"(off) : "memory")
#define HREAD(S, ab, bb)                                                                            \
  HDSR(S##a0, ab, 0); HDSR(S##b0, bb, 0); HDSR(S##b1, bb, 4096); HDSR(S##a1, ab, 4096);             \
  HDSR(S##a2, ab, 8192); HDSR(S##a3, ab, 12288);
#define HWAIT(n, S)                                                                                 \
  asm volatile("s_waitcnt lgkmcnt(" #n ")" : "+v"(S##a0), "+v"(S##a1), "+v"(S##a2), "+v"(S##a3), "+v"(S##b0), "+v"(S##b1))
#define HMF(i, j, S) acc[i][j] = __builtin_amdgcn_mfma_f32_32x32x16_bf16(S##a##i, S##b##j, acc[i][j], 0, 0, 0)
#define HMMA(S) HMF(0, 0, S); HMF(0, 1, S); HMF(1, 0, S); HMF(1, 1, S); HMF(2, 0, S); HMF(2, 1, S); HMF(3, 0, S); HMF(3, 1, S);
  const unsigned ldsb = (unsigned)(size_t)(LAS char*)lds0;
  const int frow = lane & 31, fh = lane >> 5;
  const unsigned ab0 = ldsb + lds_off(wr * 128 + frow, 0 + fh), ab1 = ldsb + lds_off(wr * 128 + frow, 2 + fh);
  const unsigned ab2 = ldsb + lds_off(wr * 128 + frow, 4 + fh), ab3 = ldsb + lds_off(wr * 128 + frow, 6 + fh);
  const unsigned bb0 = ldsb + 32768 + lds_off(wc * 64 + frow, 0 + fh), bb1 = ldsb + 32768 + lds_off(wc * 64 + frow, 2 + fh);
  const unsigned bb2 = ldsb + 32768 + lds_off(wc * 64 + frow, 4 + fh), bb3 = ldsb + 32768 + lds_off(wc * 64 + frow, 6 + fh);
  __syncthreads();
  if (PM != 1) { HUGE_ISSUE(0, 0) }
  unsigned st = 0;
  for (int k0 = 0; k0 < K; k0 += 64) {
    asm volatile("s_waitcnt vmcnt(0)" ::: "memory");
    __syncthreads();
    if (PM != 1 && k0 + 64 < K) { HUGE_ISSUE(k0 + 64, st ^ 65536u) }
    if (PM != 2) {
      bf16x8 Ea0, Ea1, Ea2, Ea3, Eb0, Eb1, Oa0, Oa1, Oa2, Oa3, Ob0, Ob1;
      const unsigned a0 = ab0 + st, a1 = ab1 + st, a2 = ab2 + st, a3 = ab3 + st;
      const unsigned b0 = bb0 + st, b1 = bb1 + st, b2 = bb2 + st, b3 = bb3 + st;
      HREAD(E, a0, b0)
      HREAD(O, a1, b1)
      HWAIT(6, E); HMMA(E)
      HREAD(E, a2, b2)
      HWAIT(6, O); HMMA(O)
      HREAD(O, a3, b3)
      HWAIT(6, E); HMMA(E)
      HWAIT(0, O); HMMA(O)
    }
    st ^= 65536u;
  }
#undef HUGE_ISSUE
#undef HDSR
#undef HREAD
#undef HWAIT
#undef HMF
#undef HMMA
  const int lane2 = opq(lane);
  typedef __attribute__((ext_vector_type(4))) float f32x4;
  __syncthreads();
  float* wl = (float*)lds0 + wv * (32 * 68);
  const int hh2 = lane2 >> 5, cl = lane2 & 31;
#pragma unroll
  for (int i = 0; i < 4; ++i) {
#pragma unroll
    for (int j = 0; j < 2; ++j)
#pragma unroll
      for (int r = 0; r < 16; ++r) wl[((r & 3) + 8 * (r >> 2) + 4 * hh2) * 68 + j * 32 + cl] = acc[i][j][r];
    __builtin_amdgcn_wave_barrier();
#pragma unroll
    for (int k = 0; k < 4; ++k) {
      const int row = (lane2 >> 3) + 8 * k, c8 = (lane2 & 7) * 8;
      const f32x4 lo = *(const f32x4*)&wl[row * 68 + c8];
      const f32x4 hi = *(const f32x4*)&wl[row * 68 + c8 + 4];
      if (PM != 3) epi(wr * 128 + i * 32 + row, wc * 64 + c8, lo, hi);
    }
    __builtin_amdgcn_wave_barrier();
  }
  __syncthreads();
}

template <class Epi>
__device__ __forceinline__ void ph_gemm_huge(const bf16_t* A, int lda, const bf16_t* Wt, int ldw, int M, int N, int K,
                                             char* lds0, Epi epi) {
  const int ntm = M / 256, ntn = N / 256;
  for (int u = (int)blockIdx.x; u < ntm * ntn; u += (int)gridDim.x) {
    const int x = u & 7, i = (u >> 3) & 31, rnd = u >> 8;
    const int tm = (x & 3) * 8 + (i & 7), tn = rnd * 8 + (x >> 2) * 4 + (i >> 3);
    if (tm >= ntm || tn >= ntn) continue;
    const int m0 = tm * 256, n0 = tn * 256;
    gemm_tile_huge(A + (size_t)m0 * lda, lda, Wt + (size_t)n0 * ldw, ldw, K, lds0,
                   [&](int r, int c, f32x4_e lo, f32x4_e hi) { epi(m0 + r, n0 + c, lo, hi); });
  }
}

__device__ __forceinline__ void norm_feed(const f32x4_e h0, const f32x4_e h1, const float* gain, int n, bf16_t* hn_row,
                                          float* rowss_m) {
  const f32x4_e g0 = *(const f32x4_e*)(gain + n), g1 = *(const f32x4_e*)(gain + n + 4);
  st_bf16x8(hn_row + n, h0 * g0, h1 * g1);
  float ss = h0[0] * h0[0] + h0[1] * h0[1] + h0[2] * h0[2] + h0[3] * h0[3] + h1[0] * h1[0] + h1[1] * h1[1] + h1[2] * h1[2] + h1[3] * h1[3];
  ss += __shfl_xor(ss, 1);
  ss += __shfl_xor(ss, 2);
  ss += __shfl_xor(ss, 4);
  if (((VT()) & 7) == 0) atomicAdd(rowss_m, ss);
}

template <bool VEC = false, class Epi>
__device__ __forceinline__ void ph_gemm_bf16(const bf16_t* A, int lda, const bf16_t* Wt, int ldw, int M, int N, int K,
                                             char* lds, Epi epi, int vblock = -2) {
  const int ntm = M / 128, ntn = N / 128;
  const int npm = (ntm + 7) / 8, npn = (ntn + 7) / 8;
  const int nslots = ((npm * npn * 64 + 511) / 512) * 512;
  if (vblock == -1) return;
  for (int u = (vblock >= 0 ? vblock : VB()); u < nslots; u += VG()) {
    int v = (u & 7) * 64 + ((u >> 3) & 63) + (u & ~511);
    int patch = v >> 6, w = v & 63;
    int tm = (patch % npm) * 8 + (w & 7);
    int tn = (patch / npm) * 8 + (w >> 3);
    if (tm >= ntm || tn >= ntn) continue;
    const int m0 = tm * 128, n0 = tn * 128;
    if constexpr (VEC)
      gemm_tile_bf16<false, true>(A + (size_t)m0 * lda, lda, Wt + (size_t)n0 * ldw, ldw, K, lds,
                                  [&](int r, int c, f32x4_e lo, f32x4_e hi) { epi(m0 + r, n0 + c, lo, hi); });
    else
      gemm_tile_bf16<false>(A + (size_t)m0 * lda, lda, Wt + (size_t)n0 * ldw, ldw, K, lds,
                            [&](int r, int c, float val) { epi(m0 + r, n0 + c, val); });
  }
}

__device__ __forceinline__ void ph_proj(const P& p, char* lds0, char* lds) {
  for (int u = (int)blockIdx.x; u < 512; u += (int)gridDim.x) {
    const int x = u & 7, i = (u >> 3) & 31, rnd = u >> 8;
    const int tm = (x & 3) * 8 + (i & 7), tp = rnd * 8 + (x >> 2) * 4 + (i >> 3);
    const int tb = tp * 2;
    const int tn = (tb < 14) ? tb : (tb < 16) ? tb + 2 : tb + 4;
    const int m0 = tm * 256, n0 = tn * 128;
    const int b = m0 >> 11, sl = m0 & 2047;
    const bf16_t* A = p.hn + (size_t)m0 * DM;
    const bf16_t* W = p.WinT + (size_t)n0 * DM;
    if (n0 < 1024 || (n0 >= 2560 && n0 < 3584)) {
      bf16_t* dst = (n0 < 1024) ? p.qn + (size_t)m0 * 1024 + n0 : p.qsb + (size_t)m0 * 1024 + (n0 - 2560);
      gemm_tile_huge(A, DM, W, DM, DM, lds0, [&](int r, int c, f32x4_e lo, f32x4_e hi) { st_bf16x8(dst + (size_t)r * 1024 + c, lo, hi); });
    } else if (n0 < 2560) {
      const int seg = (n0 - 1024) >> 8;
      bf16_t* base = (seg == 0) ? p.kcin : (seg == 1) ? p.vcin : (seg == 2) ? p.ks : p.kw;
      bf16_t* dst = base + ((size_t)(b * 2) * SEQ + sl) * 128;
      gemm_tile_huge(A, DM, W, DM, DM, lds0, [&](int r, int c, f32x4_e lo, f32x4_e hi) {
        st_bf16x8(dst + ((size_t)(c >> 7) * SEQ + r) * 128 + (c & 127), lo, hi); });
    } else {
      bf16_t* dst = p.ksb + ((size_t)(b * 8 + ((n0 - 3584) >> 7)) * SEQ + sl) * 128;
      gemm_tile_huge(A, DM, W, DM, DM, lds0, [&](int r, int c, f32x4_e lo, f32x4_e hi) {
        st_bf16x8(dst + ((size_t)(c >> 7) * SEQ + r) * 128 + (c & 127), lo, hi); });
    }
  }
  for (int u = VB(); u < 64 * 13; u += VG()) {
    const int tm = u & 63, ts = u >> 6;
    const int tn = (ts < 2) ? 14 + ts : (ts < 4) ? 16 + ts : (ts < 12) ? 32 + ts : 44;
    const int m0 = tm * 128, n0 = tn * 128;
    const int b = m0 >> 11, sl = m0 & 2047;
    const bf16_t* A = p.hn + (size_t)m0 * DM;
    const bf16_t* W = p.WinT + (size_t)n0 * DM;
    if (n0 < 2560) {
      const int seg = (n0 - 1024) >> 8, g = ((n0 - 1024) >> 7) & 1;
      bf16_t* vd = (seg == 3 ? p.vsT : p.vwT) + ((size_t)(b * 2 + g) * 128) * SEQ + sl;
      gemm_tile_bf16<true>(A, DM, W, DM, DM, lds, [&](int r, int c, float val) { vd[(size_t)r * SEQ + perm16(c)] = f2bf(val); });
    } else if (n0 < 5632) {
      bf16_t* vd = p.vsbT + ((size_t)(b * 8 + ((n0 - 4608) >> 7)) * 128) * SEQ + sl;
      gemm_tile_bf16<true>(A, DM, W, DM, DM, lds, [&](int r, int c, float val) { vd[(size_t)r * SEQ + perm16(c)] = f2bf(val); });
    } else {
      float* gd = p.gates + (size_t)m0 * 24;
      gemm_tile_bf16<false>(A, DM, W, DM, DM, lds, [&](int r, int c, float val) { if (c < 24) gd[(size_t)r * 24 + c] = val; });
    }
  }
}

__device__ __forceinline__ void ph_posb(const P& p) {
  const int lane = VT() & 63, wv = VT() >> 6;
  for (int o = VB() * 4 + wv; o < 256; o += VG() * 4) {
    const int which = o >> 7, n = o & 127;
    const float* pos = which ? p.pos_v : p.pos_k;
    const float* w1 = which ? p.w1_v : p.w1_k;
    float acc = 0.f;
    for (int k = lane; k < 4096; k += 64) acc += pos[k] * w1[(size_t)k * 128 + n];
    acc = wave_sum(acc);
    if (lane == 0) p.posb[o] = acc;
  }
}

__device__ __forceinline__ void ph_compress2(const P& p, char* lds) {
  for (int item = VB(); item < 16; item += VG()) {
    const int which = item >> 3, bg = item & 7;
    const bf16_t* src = (which ? p.vcin : p.kcin) + (size_t)bg * SEQ * 128;
    const bf16_t* w1t = p.w1T + (size_t)which * 128 * 4096;
    const bf16_t* w2t = p.w2T + (size_t)which * 128 * 128;
    const float* posb = p.posb + which * 128;
    bf16_t* c1 = p.c1 + (size_t)item * 128 * 128;
    gemm_tile_bf16<false>(src, 2048, w1t, 4096, 4096, lds, [&](int r, int c, float val) {
      c1[r * 128 + c] = f2bf(gelu_fast(val + posb[c])); });
    __threadfence_block();
    vsync();
    if (which == 0) {
      bf16_t* kd = p.kcb + (size_t)bg * 128 * 128;
      gemm_tile_bf16<false>(c1, 128, w2t, 128, 128, lds, [&](int r, int c, float val) { kd[r * 128 + c] = f2bf(val); });
    } else {
      bf16_t* vd = p.vcT + (size_t)bg * 128 * 128;
      gemm_tile_bf16<true>(c1, 128, w2t, 128, 128, lds, [&](int r, int c, float val) { vd[r * 128 + perm16(c)] = f2bf(val); });
    }
  }
}

#define NEG_BIG (-1e30f)

struct KVRegs { u32x4 k0, k1, k2, k3, v0, v1, v2, v3; };

__device__ __forceinline__ int koff(int row, int chunk) { return row * 256 + ((chunk ^ (row & 15)) << 4); }

__device__ __forceinline__ void kv_load(KVRegs& r, const bf16_t* kp, int ldk, const bf16_t* vp, int ldv) {
  const int tid = VT();
  const bf16_t* kg = kp + (size_t)(tid >> 4) * ldk + (tid & 15) * 8;
  r.k0 = *(const u32x4*)kg;
  r.k1 = *(const u32x4*)(kg + (size_t)16 * ldk);
  r.k2 = *(const u32x4*)(kg + (size_t)32 * ldk);
  r.k3 = *(const u32x4*)(kg + (size_t)48 * ldk);
  const bf16_t* vg = vp + (size_t)(tid >> 3) * ldv + (tid & 7) * 8;
  r.v0 = *(const u32x4*)vg;
  r.v1 = *(const u32x4*)(vg + (size_t)32 * ldv);
  r.v2 = *(const u32x4*)(vg + (size_t)64 * ldv);
  r.v3 = *(const u32x4*)(vg + (size_t)96 * ldv);
}
__device__ __forceinline__ void kv_store(const KVRegs& r, char* lk, char* lv) {
  const int tid = VT();
  const int row = tid >> 4, ch = tid & 15;
  *(u32x4*)(lk + koff(row, ch)) = r.k0;
  *(u32x4*)(lk + koff(row + 16, ch)) = r.k1;
  *(u32x4*)(lk + koff(row + 32, ch)) = r.k2;
  *(u32x4*)(lk + koff(row + 48, ch)) = r.k3;
  const int vr = tid >> 3, vc = tid & 7;
  *(u32x4*)(lv + lds_off(vr, vc)) = r.v0;
  *(u32x4*)(lv + lds_off(vr + 32, vc)) = r.v1;
  *(u32x4*)(lv + lds_off(vr + 64, vc)) = r.v2;
  *(u32x4*)(lv + lds_off(vr + 96, vc)) = r.v3;
}

struct QFrag { bf16x8 f0, f1, f2, f3, f4, f5, f6, f7; };
__device__ __forceinline__ void q_load(QFrag& q, const bf16_t* qrow) {
  const int h = (VT() & 63) >> 5;
  const bf16x8* p8 = (const bf16x8*)(qrow + 8 * h);
  q.f0 = p8[0]; q.f1 = p8[2]; q.f2 = p8[4]; q.f3 = p8[6]; q.f4 = p8[8]; q.f5 = p8[10]; q.f6 = p8[12]; q.f7 = p8[14];
}

__device__ __forceinline__ void qk_tile(const QFrag& q, const char* lk, f32x16& s0, f32x16& s1) {
  const int lane = VT() & 63, row = lane & 31, h = lane >> 5;
#pragma unroll
  for (int r = 0; r < 16; ++r) { s0[r] = 0.f; s1[r] = 0.f; }
#define QK_STEP(kk, qf)                                                                  \
  {                                                                                      \
    bf16x8 a0 = *(const bf16x8*)(lk + koff(row, 2 * (kk) + h));                          \
    bf16x8 a1 = *(const bf16x8*)(lk + koff(row + 32, 2 * (kk) + h));                     \
    s0 = __builtin_amdgcn_mfma_f32_32x32x16_bf16(a0, qf, s0, 0, 0, 0);                   \
    s1 = __builtin_amdgcn_mfma_f32_32x32x16_bf16(a1, qf, s1, 0, 0, 0);                   \
  }
  QK_STEP(0, q.f0) QK_STEP(1, q.f1) QK_STEP(2, q.f2) QK_STEP(3, q.f3)
  QK_STEP(4, q.f4) QK_STEP(5, q.f5) QK_STEP(6, q.f6) QK_STEP(7, q.f7)
#undef QK_STEP
}

__device__ __forceinline__ bf16x8 pack8(const f32x16& p, const int base) {
  u32x4 u;
  u[0] = pack2(p[base + 0], p[base + 1]);
  u[1] = pack2(p[base + 2], p[base + 3]);
  u[2] = pack2(p[base + 4], p[base + 5]);
  u[3] = pack2(p[base + 6], p[base + 7]);
  return __builtin_bit_cast(bf16x8, u);
}

typedef __attribute__((ext_vector_type(2))) unsigned u32x2_t;
__device__ __forceinline__ float xhalf_max(float v) {
  const u32x2_t r = __builtin_amdgcn_permlane32_swap(__float_as_uint(v), __float_as_uint(v), false, false);
  return fmaxf(__uint_as_float(r[0]), __uint_as_float(r[1]));
}
__device__ __forceinline__ float xhalf_sum(float v) {
  const u32x2_t r = __builtin_amdgcn_permlane32_swap(__float_as_uint(v), __float_as_uint(v), false, false);
  return __uint_as_float(r[0]) + __uint_as_float(r[1]);
}
__device__ __forceinline__ float xhalf_get(float v, int hh) {
  const u32x2_t r = __builtin_amdgcn_permlane32_swap(__float_as_uint(v), __float_as_uint(v), false, false);
  return hh ? __uint_as_float(r[0]) : __uint_as_float(r[1]);
}
struct OAcc { f32x16 o0, o1, o2, o3; };
__device__ __forceinline__ void oacc_zero(OAcc& o) {
#pragma unroll
  for (int r = 0; r < 16; ++r) { o.o0[r] = 0.f; o.o1[r] = 0.f; o.o2[r] = 0.f; o.o3[r] = 0.f; }
}
__device__ __forceinline__ void oacc_scale(OAcc& o, float a) {
#pragma unroll
  for (int r = 0; r < 16; ++r) { o.o0[r] *= a; o.o1[r] *= a; o.o2[r] *= a; o.o3[r] *= a; }
}

__device__ __forceinline__ void pv_tile(OAcc& o, const char* lv, const f32x16& p0, const f32x16& p1) {
  const int lane = VT() & 63, row = lane & 31, h = lane >> 5;
  const bf16x8 pf0 = pack8(p0, 0), pf1 = pack8(p0, 8), pf2 = pack8(p1, 0), pf3 = pack8(p1, 8);
#define PV_ROW(dd, acc)                                                                                      \
  {                                                                                                          \
    acc = __builtin_amdgcn_mfma_f32_32x32x16_bf16(*(const bf16x8*)(lv + lds_off(32 * (dd) + row, 0 + h)), pf0, acc, 0, 0, 0); \
    acc = __builtin_amdgcn_mfma_f32_32x32x16_bf16(*(const bf16x8*)(lv + lds_off(32 * (dd) + row, 2 + h)), pf1, acc, 0, 0, 0); \
    acc = __builtin_amdgcn_mfma_f32_32x32x16_bf16(*(const bf16x8*)(lv + lds_off(32 * (dd) + row, 4 + h)), pf2, acc, 0, 0, 0); \
    acc = __builtin_amdgcn_mfma_f32_32x32x16_bf16(*(const bf16x8*)(lv + lds_off(32 * (dd) + row, 6 + h)), pf3, acc, 0, 0, 0); \
  }
  PV_ROW(0, o.o0) PV_ROW(1, o.o1) PV_ROW(2, o.o2) PV_ROW(3, o.o3)
#undef PV_ROW
}

typedef __attribute__((ext_vector_type(2))) float f32x2_s;
#define SPAIR(v, i) __builtin_shufflevector(v, v, (i), (i) + 1)
__device__ __forceinline__ void softmax_tile(f32x16& s0, f32x16& s1, float& m, float& l, OAcc& o, const float sc = 1.f,
                                             const float bb = 0.f) {
  float mr = -INFINITY;
#pragma unroll
  for (int r = 0; r < 16; ++r) mr = fmaxf(mr, fmaxf(s0[r], s1[r]));
  float mx = fmaf(mr, sc, bb);
  mx = (mx != mx) ? -INFINITY : mx;
  mx = xhalf_max(fmaxf(mx, NEG_BIG));
  const float mn = fmaxf(m, mx);
  const float alpha = __builtin_amdgcn_exp2f(m - mn);
  const f32x2_s sc2 = {sc, sc}, c2 = {bb - mn, bb - mn};
  f32x2_s ls2 = {0.f, 0.f};
#pragma unroll
  for (int r = 0; r < 16; r += 2) {
    const f32x2_s pa_in = {s0[r], s0[r + 1]}, pb_in = {s1[r], s1[r + 1]};
    const f32x2_s a = __builtin_elementwise_fma(pa_in, sc2, c2);
    const f32x2_s b = __builtin_elementwise_fma(pb_in, sc2, c2);
    const float a0 = __builtin_amdgcn_exp2f(a[0]), a1 = __builtin_amdgcn_exp2f(a[1]);
    const float b0 = __builtin_amdgcn_exp2f(b[0]), b1 = __builtin_amdgcn_exp2f(b[1]);
    s0[r] = a0; s0[r + 1] = a1; s1[r] = b0; s1[r + 1] = b1;
    const f32x2_s pa = {a0, a1}, pb = {b0, b1};
    ls2 = ls2 + pa + pb;
  }
  const float ls = xhalf_sum(ls2[0] + ls2[1]);
  l = l * alpha + ls;
  m = mn;
  if (__any(alpha != 1.f)) oacc_scale(o, alpha);
}

template <class F>
__device__ __forceinline__ void oacc_foreach(const OAcc& o, F f) {
  const int h = (VT() & 63) >> 5;
#pragma unroll
  for (int rho = 0; rho < 4; ++rho) {
    f(0 + 8 * rho + 4 * h, o.o0[4 * rho], o.o0[4 * rho + 1], o.o0[4 * rho + 2], o.o0[4 * rho + 3]);
    f(32 + 8 * rho + 4 * h, o.o1[4 * rho], o.o1[4 * rho + 1], o.o1[4 * rho + 2], o.o1[4 * rho + 3]);
    f(64 + 8 * rho + 4 * h, o.o2[4 * rho], o.o2[4 * rho + 1], o.o2[4 * rho + 2], o.o2[4 * rho + 3]);
    f(96 + 8 * rho + 4 * h, o.o3[4 * rho], o.o3[4 * rho + 1], o.o3[4 * rho + 2], o.o3[4 * rho + 3]);
  }
}

__device__ __forceinline__ void memattn_item(const P& p, char* lds, int item) {
  char* lk = lds;
  char* lv = lds + 16384;
  const int lane = VT() & 63, wv = VT() >> 6;
  {
    const int tb = item % (SEQ / 128);
    const int bh = item / (SEQ / 128);
    const int b = bh >> 2, hd = bh & 3;
    const int t = tb * 128 + wv * 32 + (lane & 31);
    QFrag q;
    q_load(q, p.qmemb + (size_t)(b * SEQ + t) * 512 + hd * 128);
    const bf16_t* kb = p.kmemb + (size_t)bh * 256 * 128;
    const bf16_t* vb = p.vmemT + (size_t)bh * 128 * 256;
    OAcc o;
    oacc_zero(o);
    float m = NEG_BIG, l = 0.f;
    KVRegs kv;
    kv_load(kv, kb, 128, vb, 256);
#pragma unroll 1
    for (int ti = 0; ti < 4; ++ti) {
      vsync();
      kv_store(kv, lk, lv);
      vsync();
      {
        const int tn = (ti + 1 < 4) ? ti + 1 : 3;
        kv_load(kv, kb + (size_t)tn * 64 * 128, 128, vb + tn * 64, 256);
      }
      f32x16 s0, s1;
      qk_tile(q, lk, s0, s1);
      softmax_tile(s0, s1, m, l, o, ATT_SCALE2, 0.f);
      pv_tile(o, lv, s0, s1);
    }
    const float il = 1.f / l;
    const int t2 = tb * 128 + (VT() >> 6) * 32 + (VT() & 31);
    bf16_t* orow = p.omem + (size_t)(b * SEQ + t2) * 512 + hd * 128;
    oacc_foreach(o, [&](int d, float v0, float v1, float v2, float v3) {
      uint2 u;
      u.x = pack2(v0 * il, v1 * il);
      u.y = pack2(v2 * il, v3 * il);
      *(uint2*)(orow + d) = u;
    });
  }
}

__device__ __forceinline__ void ph_memq_attn(const P& p, char* lds, int vblock, int nvb) {
  if (vblock < 0) return;
  const float* rss = p.rowss;
  for (int u = vblock; u < 64 * 4; u += nvb) {
    const int tm = u & 63, hd = u >> 6;
    const int m0 = tm * 128;
    bf16_t* qd = p.qmemb + (size_t)m0 * 512 + hd * 128;
    gemm_tile_bf16<false, true>(p.hn + (size_t)m0 * DM, DM, p.WmqT + (size_t)hd * 128 * DM, DM, DM, lds,
                                [&](int r, int c, f32x4_e lo, f32x4_e hi) {
                                  const float rs = rsqrtf(rss[m0 + r] * (1.f / DM) + RMS_EPS);
                                  st_bf16x8(qd + (size_t)r * 512 + c, lo * rs, hi * rs); });
    __threadfence_block();
    vsync();
    memattn_item(p, lds, ((m0 >> 11) * 4 + hd) * (SEQ / 128) + ((m0 & 2047) >> 7));
  }
}

template <bool CHK>
__device__ __forceinline__ void sb_pass1(f32x16& z, f32x16& l, const int s_first, const int t) {
  const f32x2_s sc2 = {ATT_SCALE2, ATT_SCALE2}, one2 = {1.f, 1.f};
#pragma unroll
  for (int r = 0; r < 16; r += 2) {
    const f32x2_s zin = {z[r], z[r + 1]};
    const f32x2_s zz = zin * sc2;
    const f32x2_s ee = {__builtin_amdgcn_exp2f(-fabsf(zz[0])), __builtin_amdgcn_exp2f(-fabsf(zz[1]))};
    const f32x2_s tt = ee + one2;
    const f32x2_s lg = {__builtin_amdgcn_logf(tt[0]), __builtin_amdgcn_logf(tt[1])};
    const f32x2_s mn = {fminf(zz[0], 0.f), fminf(zz[1], 0.f)};
    const f32x2_s lf = (mn - lg) - zz;
    if (CHK) {
      const int so = s_first + 8 * (r >> 2) + (r & 3);
      const bool v0 = so < t, v1 = so + 1 < t;
      l[r] = v0 ? lf[0] : 0.f; l[r + 1] = v1 ? lf[1] : 0.f;
      z[r] = v0 ? zz[0] : NEG_BIG; z[r + 1] = v1 ? zz[1] : NEG_BIG;
    } else {
      l[r] = lf[0]; l[r + 1] = lf[1];
      z[r] = zz[0]; z[r + 1] = zz[1];
    }
  }
}
__device__ __forceinline__ void sb_pass3(f32x16& z, const f32x16& l, const float* ag) {
#pragma unroll
  for (int rho = 0; rho < 4; ++rho) {
    const float x3 = l[4 * rho + 3], x23 = x3 + l[4 * rho + 2], x123 = x23 + l[4 * rho + 1];
    const float g = ag[rho];
    const f32x2_s g2 = {g, g};
    const f32x2_s la = {l[4 * rho + 0], l[4 * rho + 1]}, lb = {l[4 * rho + 2], l[4 * rho + 3]};
    const f32x2_s za = {z[4 * rho + 0], z[4 * rho + 1]}, zb = {z[4 * rho + 2], z[4 * rho + 3]};
    const f32x2_s xa = {x123, x23}, xb = {x3, 0.f};
    const f32x2_s aa = (la + za) + (g2 + xa), ab = (lb + zb) + (g2 + xb);
    z[4 * rho + 0] = __builtin_amdgcn_exp2f(aa[0]); z[4 * rho + 1] = __builtin_amdgcn_exp2f(aa[1]);
    z[4 * rho + 2] = __builtin_amdgcn_exp2f(ab[0]); z[4 * rho + 3] = __builtin_amdgcn_exp2f(ab[1]);
  }
}

__device__ __forceinline__ void ph_sb2(const P& p, char* lds) {
  char* lk = lds;
  char* lv = lds + 16384;
  const int lane = VT() & 63, wv = VT() >> 6, hh = lane >> 5;
  const int sb_skip = (VG() > 32) ? 16 : 0;
  if (VB() < sb_skip) return;
  for (int item = VB() - sb_skip; item < NBATCH * 8 * (SEQ / 128); item += VG() - sb_skip) {
    const int tb = (SEQ / 128 - 1) - (item % (SEQ / 128));
    const int bh = item / (SEQ / 128);
    const int b = bh >> 3, hd = bh & 7;
    const int t0 = tb * 128;
    const int t = t0 + wv * 32 + (lane & 31);
    QFrag q;
    q_load(q, p.qsb + (size_t)(b * SEQ + t) * 1024 + hd * 128);
    const bf16_t* kb = p.ksb + (size_t)bh * SEQ * 128;
    const bf16_t* vb = p.vsbT + (size_t)bh * 128 * SEQ;
    OAcc o;
    oacc_zero(o);
    float carry = 0.f;
    const int jhi = (t0 >> 6) + 1;
    const int jw = (t0 + wv * 32 + 30) >> 6;
    KVRegs kv;
    kv_load(kv, kb + (size_t)jhi * 64 * 128, 128, vb + jhi * 64, SEQ);
    volatile unsigned* dflag = (volatile unsigned*)(lds + 32768);
    vsync();
    if (VT() < 4) dflag[VT()] = 0u;
    for (int j = jhi; j >= 0; --j) {
      vsync();
      if ((dflag[0] & dflag[1] & dflag[2] & dflag[3]) != 0u) break;
      kv_store(kv, lk, lv);
      vsync();
      const int jn = (j > 0) ? j - 1 : 0;
      if (j > jw) kv_load(kv, kb + (size_t)jn * 64 * 128, 128, vb + jn * 64, SEQ);
      if (j <= jw) {
        f32x16 z0, z1;
        qk_tile(q, lk, z0, z1);
        const int sbase = j * 64 + 4 * hh;
        float gt[8];
        f32x16 l0, l1;
        if (j * 64 + 63 < t0 + wv * 32) {
          sb_pass1<false>(z0, l0, sbase, t);
          sb_pass1<false>(z1, l1, sbase + 32, t);
        } else {
          sb_pass1<true>(z0, l0, sbase, t);
          sb_pass1<true>(z1, l1, sbase + 32, t);
        }
#pragma unroll
        for (int rho = 0; rho < 4; ++rho) {
          gt[rho] = (l0[4 * rho] + l0[4 * rho + 1]) + (l0[4 * rho + 2] + l0[4 * rho + 3]);
          gt[4 + rho] = (l1[4 * rho] + l1[4 * rho + 1]) + (l1[4 * rho + 2] + l1[4 * rho + 3]);
        }
        float ag[8];
        float run = 0.f;
#pragma unroll
        for (int k = 7; k >= 0; --k) {
          const float pg = xhalf_get(gt[k], hh);
          ag[k] = carry + run + (hh == 0 ? pg : 0.f);
          run += gt[k] + pg;
        }
        carry += run;
        sb_pass3(z0, l0, ag);
        sb_pass3(z1, l1, ag + 4);
        kv_load(kv, kb + (size_t)jn * 64 * 128, 128, vb + jn * 64, SEQ);
        pv_tile(o, lv, z0, z1);
        if (__all(carry < -104.f * LOG2E) && (VT() & 63) == 0) dflag[wv] = 1u;
      }
    }
    int t2 = t;
    asm volatile("" : "+v"(t2));
    bf16_t* orow = p.omix + (size_t)(b * SEQ + t2) * DM + 1024 + hd * 128;
    oacc_foreach(o, [&](int d, float v0, float v1, float v2, float v3) {
      uint2 u;
      u.x = pack2(v0, v1);
      u.y = pack2(v2, v3);
      *(uint2*)(orow + d) = u;
    });
  }
}

#define NSA_IMP 32768
#define NSA_KEYS 49152
#define NSA_SELM 53504
#define NSA_LUT 53632
__device__ __forceinline__ void ph_nsa2(const P& p, char* lds) {
  typedef __attribute__((ext_vector_type(4))) float f32x4;
  char* lk = lds;
  char* lv = lds + 16384;
  float* imp = (float*)(lds + NSA_IMP);
  float* keys = (float*)(lds + NSA_KEYS);
  unsigned* selm = (unsigned*)(lds + NSA_SELM);
  const int tid = VT(), lane = tid & 63, wv = tid >> 6, hh = lane >> 5, ql = lane & 31;
  float* lut = (float*)(lds + NSA_LUT) + wv * 128;
  for (int item = VB(); item < NBATCH * 2 * (SEQ / 32); item += VG()) {
    const int tt = (item < 256) ? (SEQ / 32 - 1) - (item % (SEQ / 32)) : (item % (SEQ / 32));
    const int bg = item / (SEQ / 32);
    const int b = bg >> 1, g = bg & 1;
    const int h = g * 4 + wv;
    const int t0 = tt * 32, tq = t0 + ql, cur = t0 >> 6;
    vsync();
    QFrag q;
    q_load(q, p.qn + (size_t)(b * SEQ + tq) * 1024 + h * 128);
    {
      const int lo = opq(lane);
      lut[lo] = p.t5[t5_bucket(lo) * 8 + h] * LOG2E;
      lut[lo + 64] = p.t5[t5_bucket(lo + 64) * 8 + h] * LOG2E;
    }
#pragma unroll
    for (int i = 0; i < 16; ++i) imp[i * 256 + tid] = 0.f;
    if (tid < 32) selm[tid] = 0u;
    const float* grow = p.gates + (size_t)(b * SEQ + tq) * 24 + h * 3;
    float* prow = p.part + (size_t)(b * SEQ + tq) * 1024 + h * 128;
    OAcc o;
    float m, l;
    KVRegs kv;
    {
      const bf16_t* kb = p.kcb + (size_t)bg * 128 * 128;
      const bf16_t* vb = p.vcT + (size_t)bg * 128 * 128;
      oacc_zero(o);
      m = NEG_BIG; l = 0.f;
      kv_load(kv, kb, 128, vb, 128);
      vsync();
      kv_store(kv, lk, lv);
      vsync();
      f32x16 x0, x1;
      qk_tile(q, lk, x0, x1);
      int tqv = tq;
      asm volatile("" : "+v"(tqv));
      tqv -= 64 * hh;
      float fsc = 1.f, fbb = 0.f;
      if (t0 >= 1152) {
        fsc = ATT_SCALE2; fbb = lut[127];
      } else {
#pragma unroll
        for (int r = 0; r < 16; ++r) {
          const int c = 8 * (r >> 2) + (r & 3);
          const int d0 = tqv - 16 * c - 31, d1 = d0 - 512;
          x0[r] = (d0 >= 0) ? x0[r] * ATT_SCALE2 + lut[min(d0, 127)] : -INFINITY;
          x1[r] = (d1 >= 0) ? x1[r] * ATT_SCALE2 + lut[min(d1, 127)] : -INFINITY;
        }
      }
      softmax_tile(x0, x1, m, l, o, fsc, fbb);
      const float m0 = m;
      pv_tile(o, lv, x0, x1);
      f32x16 z0, z1;
#pragma unroll
      for (int r = 0; r < 16; ++r) { z0[r] = 0.f; z1[r] = 0.f; }
      if (t0 >= 1024) {
        kv_load(kv, kb + 64 * 128, 128, vb + 64, 128);
        vsync();
        kv_store(kv, lk, lv);
        vsync();
        qk_tile(q, lk, z0, z1);
        asm volatile("" : "+v"(tqv));
#pragma unroll
        for (int r = 0; r < 16; ++r) {
          const int c = 64 + 8 * (r >> 2) + (r & 3);
          const int d0 = tqv - 16 * c - 31, d1 = d0 - 512;
          z0[r] = (d0 >= 0) ? z0[r] * ATT_SCALE2 + lut[min(d0, 127)] : -INFINITY;
          z1[r] = (d1 >= 0) ? z1[r] * ATT_SCALE2 + lut[min(d1, 127)] : -INFINITY;
        }
        softmax_tile(z0, z1, m, l, o);
        pv_tile(o, lv, z0, z1);
      }
      const float inv = 1.f / fmaxf(l, 1e-20f);
      const float c0 = __builtin_amdgcn_exp2f(m0 - m) * inv;
#pragma unroll
      for (int r = 0; r < 16; ++r) {
        const int c = 8 * (r >> 2) + (r & 3) + 4 * hh;
        if (x0[r] != 0.f) atomicAdd(&imp[(c) * 32 + ql], x0[r] * c0);
        if (x1[r] != 0.f) atomicAdd(&imp[(c + 32) * 32 + ql], x1[r] * c0);
        if (z0[r] != 0.f) atomicAdd(&imp[(c + 64) * 32 + ql], z0[r] * inv);
        if (z1[r] != 0.f) atomicAdd(&imp[(c + 96) * 32 + ql], z1[r] * inv);
      }
      const float gs = inv / (1.f + __expf(-grow[0]));
      oacc_foreach(o, [&](int d, float v0, float v1, float v2, float v3) {
        f32x4 u = {v0 * gs, v1 * gs, v2 * gs, v3 * gs};
        *(f32x4*)(prow + d) = u;
      });
    }
    vsync();
    {
      const int tido = opq(tid);
      const int qq = tido & 31, jg = tido >> 5;
#pragma unroll
      for (int jj = 0; jj < 4; ++jj) {
        const int j = jg * 4 + jj;
        float v = imp[(4 * j) * 32 + qq] + imp[(4 * j + 1) * 32 + qq] + imp[(4 * j + 2) * 32 + qq] + 0.5f * imp[(4 * j + 3) * 32 + qq];
        if (j > 0) v += 0.5f * imp[(4 * j - 1) * 32 + qq];
        const bool forced = (j == 0) || (j == cur) || (j == cur - 1);
        keys[qq * 33 + j] = forced ? 1e9f : ((j <= cur) ? v : -1e9f);
      }
      vsync();
      unsigned bits = 0u;
#pragma unroll
      for (int jj = 0; jj < 4; ++jj) {
        const int j = jg * 4 + jj;
        const float kj = keys[qq * 33 + j];
        int rank = 0;
        for (int i = 0; i < 32; ++i) {
          const float ki = keys[qq * 33 + i];
          rank += (ki > kj || (ki == kj && i < j)) ? 1 : 0;
        }
        if (rank < 16 && j <= cur) bits |= 1u << j;
      }
      atomicOr(&selm[qq], bits);
      vsync();
    }
    const unsigned mysel = selm[ql];
    unsigned um = mysel;
#pragma unroll
    for (int o2 = 16; o2 > 0; o2 >>= 1) um |= (unsigned)__shfl_xor((int)um, o2);
    um = (unsigned)__builtin_amdgcn_readfirstlane((int)um);
    {
      const bf16_t* kb = p.ks + (size_t)bg * SEQ * 128;
      const bf16_t* vb = p.vsT + (size_t)bg * 128 * SEQ;
      oacc_zero(o);
      m = NEG_BIG; l = 0.f;
      unsigned rem = um;
      int j = __builtin_ctz(rem);
      kv_load(kv, kb + (size_t)j * 64 * 128, 128, vb + j * 64, SEQ);
      while (rem) {
        j = __builtin_ctz(rem);
        rem &= rem - 1;
        const int jn = rem ? __builtin_ctz(rem) : j;
        vsync();
        kv_store(kv, lk, lv);
        vsync();
        f32x16 s0, s1;
        qk_tile(q, lk, s0, s1);
        const bool selq = (mysel >> j) & 1u;
        int tqv = tq;
        asm volatile("" : "+v"(tqv));
        float fsc = 1.f, fbb = 0.f;
        if (j * 64 + 63 + 113 <= t0) {
          fsc = selq ? ATT_SCALE2 : 0.f; fbb = selq ? lut[127] : -INFINITY;
        } else {
#pragma unroll
          for (int r = 0; r < 16; ++r) {
            const int d0 = tqv - (j * 64 + 8 * (r >> 2) + (r & 3) + 4 * hh), d1 = d0 - 32;
            s0[r] = (selq && d0 >= 0) ? s0[r] * ATT_SCALE2 + lut[min(d0, 127)] : -INFINITY;
            s1[r] = (selq && d1 >= 0) ? s1[r] * ATT_SCALE2 + lut[min(d1, 127)] : -INFINITY;
          }
        }
        kv_load(kv, kb + (size_t)jn * 64 * 128, 128, vb + jn * 64, SEQ);
        softmax_tile(s0, s1, m, l, o, fsc, fbb);
        pv_tile(o, lv, s0, s1);
      }
      const float gs = 1.f / (fmaxf(l, 1e-20f) * (1.f + __expf(-grow[1])));
      int qo = ql;
      asm volatile("" : "+v"(qo));
      float* pr2 = p.part + (size_t)(b * SEQ + t0 + qo) * 1024 + h * 128;
      oacc_foreach(o, [&](int d, float v0, float v1, float v2, float v3) {
        f32x4 u = *(f32x4*)(pr2 + d);
        u[0] += v0 * gs; u[1] += v1 * gs; u[2] += v2 * gs; u[3] += v3 * gs;
        *(f32x4*)(pr2 + d) = u;
      });
    }
    {
      const bf16_t* kb = p.kw + (size_t)bg * SEQ * 128;
      const bf16_t* vb = p.vwT + (size_t)bg * 128 * SEQ;
      oacc_zero(o);
      m = NEG_BIG; l = 0.f;
      int jlo = (t0 - 511) >> 6;
      if (jlo < 0) jlo = 0;
      kv_load(kv, kb + (size_t)jlo * 64 * 128, 128, vb + jlo * 64, SEQ);
      for (int j = jlo; j <= cur; ++j) {
        const int jn = (j < cur) ? j + 1 : j;
        vsync();
        kv_store(kv, lk, lv);
        vsync();
        f32x16 s0, s1;
        qk_tile(q, lk, s0, s1);
        int tqv = tq;
        asm volatile("" : "+v"(tqv));
        float wsc = 1.f, wbb = 0.f;
        if (j * 64 + 63 + 113 <= t0 && t0 + 31 - j * 64 < 512) {
          wsc = ATT_SCALE2; wbb = lut[127];
        } else {
#pragma unroll
          for (int r = 0; r < 16; ++r) {
            const int d0 = tqv - (j * 64 + 8 * (r >> 2) + (r & 3) + 4 * hh), d1 = d0 - 32;
            s0[r] = (d0 >= 0 && d0 < 512) ? s0[r] * ATT_SCALE2 + lut[min(d0, 127)] : -INFINITY;
            s1[r] = (d1 >= 0 && d1 < 512) ? s1[r] * ATT_SCALE2 + lut[min(d1, 127)] : -INFINITY;
          }
        }
        kv_load(kv, kb + (size_t)jn * 64 * 128, 128, vb + jn * 64, SEQ);
        softmax_tile(s0, s1, m, l, o, wsc, wbb);
        pv_tile(o, lv, s0, s1);
      }
      const float gs = 1.f / (fmaxf(l, 1e-20f) * (1.f + __expf(-grow[2])));
      int qo = ql;
      asm volatile("" : "+v"(qo));
      const float* pr2 = p.part + (size_t)(b * SEQ + t0 + qo) * 1024 + h * 128;
      bf16_t* orow = p.omix + (size_t)(b * SEQ + t0 + qo) * DM + h * 128;
      oacc_foreach(o, [&](int d, float v0, float v1, float v2, float v3) {
        const f32x4 u = *(const f32x4*)(pr2 + d);
        uint2 w;
        w.x = pack2(u[0] + v0 * gs, u[1] + v1 * gs);
        w.y = pack2(u[2] + v2 * gs, u[3] + v3 * gs);
        *(uint2*)(orow + d) = w;
      });
    }
  }
}

__device__ __forceinline__ void ph_cvt(const float* src, bf16_t* dst, size_t n) {
  typedef __attribute__((ext_vector_type(4))) float f32x4;
  const size_t nv = n / 8;
  for (size_t i = (size_t)VB() * 256 + VT(); i < nv; i += (size_t)VG() * 256) {
    const f32x4 a = ((const f32x4*)src)[2 * i], b = ((const f32x4*)src)[2 * i + 1];
    u32x4 o;
    o[0] = pack2(a[0], a[1]); o[1] = pack2(a[2], a[3]); o[2] = pack2(b[0], b[1]); o[3] = pack2(b[2], b[3]);
    ((u32x4*)dst)[i] = o;
  }
}

__device__ __forceinline__ void ph_scores(const P& p, char* lds) {
  for (int u = VB(); u < 64 * 16; u += VG()) {
    const int tm = u & 63, hp = u >> 6;
    const int m0 = tm * 128;
    float* sc = p.scores + (size_t)m0 * DM + hp * 128;
    gemm_tile_bf16<false>(p.omix + (size_t)m0 * DM + hp * 128, DM, p.subkb + (size_t)hp * 128 * 128, 128, 128, lds,
                          [&](int r, int c, float val) { sc[(size_t)r * DM + c] = val; });
  }
}

template <int PM = 0>
__device__ __forceinline__ void ph_qp_scores(const P& p, char* lds0, char* lds) {
  for (int u = (int)blockIdx.x; u < 32 * 8; u += (int)gridDim.x) {
    const int x = u & 7, i = (u >> 3) & 31;
    const int tm = (x & 3) * 8 + (i & 7), tn = (x >> 2) * 4 + (i >> 3);
    const int m0 = tm * 256, n0 = tn * 256;
    bf16_t* qp = p.omix + (size_t)m0 * DM + n0;
    const float* rss = p.rowss + T_TOK + m0;
    gemm_tile_huge<PM>(p.hn + (size_t)m0 * DM, DM, p.WpqT + (size_t)n0 * DM, DM, DM, lds0,
                   [&](int r, int c, f32x4_e lo, f32x4_e hi) {
                     const float rs = rsqrtf(rss[r] * (1.f / DM) + RMS_EPS);
                     st_bf16x8(qp + (size_t)r * DM + c, lo * rs, hi * rs); });
    __threadfence_block();
    __syncthreads();
    const int hf = (int)(threadIdx.x >> 8);
    const int hp = tn * 2 + hf;
    float* sc = p.scores + (size_t)m0 * DM + hp * 128;
    gemm_tile_big(qp + hf * 128, DM, p.subkb + (size_t)hp * 128 * 128, 128, 128, lds,
                  [&](int r, int c, f32x4_e lo, f32x4_e hi) {
                    *(f32x4_e*)(sc + (size_t)r * DM + c) = lo; *(f32x4_e*)(sc + (size_t)r * DM + c + 4) = hi; });
    __syncthreads();
  }
}

__device__ __forceinline__ void ph_cvt4(const float* src, unsigned char* dst, float* scales, int nrows, int wid0, int nw) {
  typedef __attribute__((ext_vector_type(4))) float f32x4;
  typedef __attribute__((ext_vector_type(2))) float f32x2;
  const int lane = VT() & 63;
  const float one = __uint_as_float((unsigned)opq(0x3F800000));
  float lev[8];
#pragma unroll
  for (int c = 0; c < 8; ++c) {
    const f32x2 q = __builtin_amdgcn_cvt_scalef32_pk_f32_fp4((unsigned)opq(c * 0x11111111), one, 0);
    lev[c] = fabsf(q[0]);
  }
  const float maxlev = lev[7];
  for (int row = wid0; row < nrows; row += nw) {
    const f32x4* s4 = (const f32x4*)(src + (size_t)row * DM) + lane * 8;
    f32x4 v[8];
    float amax = 0.f;
#pragma unroll
    for (int i = 0; i < 8; ++i) {
      v[i] = s4[i];
#pragma unroll
      for (int k = 0; k < 4; ++k) amax = fmaxf(amax, fabsf(v[i][k]));
    }
    amax = wave_max(amax);
    const float sc = (amax > 0.f) ? maxlev / amax : 1.f;
    u32x4 o;
#pragma unroll
    for (int w = 0; w < 4; ++w) {
      unsigned pk = 0u;
      pk = __builtin_amdgcn_cvt_scalef32_pk_fp4_f32(pk, v[2 * w][0] * sc, v[2 * w][1] * sc, 1.0f, 0);
      pk = __builtin_amdgcn_cvt_scalef32_pk_fp4_f32(pk, v[2 * w][2] * sc, v[2 * w][3] * sc, 1.0f, 1);
      pk = __builtin_amdgcn_cvt_scalef32_pk_fp4_f32(pk, v[2 * w + 1][0] * sc, v[2 * w + 1][1] * sc, 1.0f, 2);
      pk = __builtin_amdgcn_cvt_scalef32_pk_fp4_f32(pk, v[2 * w + 1][2] * sc, v[2 * w + 1][3] * sc, 1.0f, 3);
      o[w] = pk;
    }
    *(u32x4*)(dst + (size_t)row * 1024 + lane * 16) = o;
    if (lane == 0) scales[row] = (amax > 0.f) ? amax / maxlev : 1.f;
  }
}

__device__ __forceinline__ float wave_sum_dpp(float v) {
  typedef __attribute__((ext_vector_type(2))) unsigned u32x2_d;
  v += __builtin_bit_cast(float, __builtin_amdgcn_update_dpp(0, __builtin_bit_cast(int, v), 0xB1, 0xF, 0xF, true));
  v += __builtin_bit_cast(float, __builtin_amdgcn_update_dpp(0, __builtin_bit_cast(int, v), 0x4E, 0xF, 0xF, true));
  v += __builtin_bit_cast(float, __builtin_amdgcn_update_dpp(0, __builtin_bit_cast(int, v), 0x141, 0xF, 0xF, true));
  v += __builtin_bit_cast(float, __builtin_amdgcn_update_dpp(0, __builtin_bit_cast(int, v), 0x140, 0xF, 0xF, true));
  u32x2_d r = __builtin_amdgcn_permlane16_swap(__float_as_uint(v), __float_as_uint(v), false, false);
  v = __uint_as_float(r[0]) + __uint_as_float(r[1]);
  r = __builtin_amdgcn_permlane32_swap(__float_as_uint(v), __float_as_uint(v), false, false);
  return __uint_as_float(r[0]) + __uint_as_float(r[1]);
}
__device__ __forceinline__ float gelu_rcp(float x) {
  const float y2 = (1.5957691216057308f * LOG2E) * (x + 0.044715f * x * x * x);
  return x * __builtin_amdgcn_rcpf(1.f + __builtin_amdgcn_exp2f(-y2));
}
__device__ __forceinline__ u32x4 r4_load(const unsigned char* tab, int eid, int lane) {
  return *((const u32x4*)(tab + (size_t)eid * 1024) + lane);
}
struct XPk { f32x16 a, b; };
struct Acc32 { f32x16 a, b; };

typedef __attribute__((ext_vector_type(2))) float f32x2_t;
#define PAIR(v, i) __builtin_shufflevector(v, v, (i), (i) + 1)
#define R4_DOT_W(word, xv, base, sa, sb)                                                             \
  {                                                                                                  \
    const f32x2_t q0 = __builtin_amdgcn_cvt_scalef32_pk_f32_fp4(word, one, 0), q1 = __builtin_amdgcn_cvt_scalef32_pk_f32_fp4(word, one, 1); \
    const f32x2_t q2 = __builtin_amdgcn_cvt_scalef32_pk_f32_fp4(word, one, 2), q3 = __builtin_amdgcn_cvt_scalef32_pk_f32_fp4(word, one, 3); \
    sa = __builtin_elementwise_fma(q0, PAIR(xv, base + 0), sa); sb = __builtin_elementwise_fma(q1, PAIR(xv, base + 2), sb); \
    sa = __builtin_elementwise_fma(q2, PAIR(xv, base + 4), sa); sb = __builtin_elementwise_fma(q3, PAIR(xv, base + 6), sb); \
  }
__device__ __forceinline__ float r4_dot(const u32x4& e, const XPk& x) {
  const float one = __uint_as_float((unsigned)opq(0x3F800000));
  f32x2_t sa = {0.f, 0.f}, sb = {0.f, 0.f};
  R4_DOT_W(e[0], x.a, 0, sa, sb) R4_DOT_W(e[1], x.a, 8, sa, sb) R4_DOT_W(e[2], x.b, 0, sa, sb) R4_DOT_W(e[3], x.b, 8, sa, sb)
  sa = sa + sb;
  return sa[0] + sa[1];
}
#define R4_AXPY_P(accv, i, q)                                                                        \
  { const f32x2_t r_ = __builtin_elementwise_fma(h2, q, PAIR(accv, i)); accv[i] = r_[0]; accv[(i) + 1] = r_[1]; }
#define R4_AXPY_W(word, accv, base)                                                                  \
  {                                                                                                  \
    const f32x2_t q0 = __builtin_amdgcn_cvt_scalef32_pk_f32_fp4(word, one, 0), q1 = __builtin_amdgcn_cvt_scalef32_pk_f32_fp4(word, one, 1); \
    const f32x2_t q2 = __builtin_amdgcn_cvt_scalef32_pk_f32_fp4(word, one, 2), q3 = __builtin_amdgcn_cvt_scalef32_pk_f32_fp4(word, one, 3); \
    R4_AXPY_P(accv, base + 0, q0) R4_AXPY_P(accv, base + 2, q1) R4_AXPY_P(accv, base + 4, q2) R4_AXPY_P(accv, base + 6, q3) \
  }
__device__ __forceinline__ void r4_axpy(const u32x4& e, float hid, Acc32& acc) {
  const float one = __uint_as_float((unsigned)opq(0x3F800000));
  const f32x2_t h2 = {hid, hid};
  R4_AXPY_W(e[0], acc.a, 0) R4_AXPY_W(e[1], acc.a, 8) R4_AXPY_W(e[2], acc.b, 0) R4_AXPY_W(e[3], acc.b, 8)
}

#define INS16(K, x)                                                                                      \
  K##15 = __builtin_amdgcn_fmed3f(K##15, K##14, x); K##14 = __builtin_amdgcn_fmed3f(K##14, K##13, x);   \
  K##13 = __builtin_amdgcn_fmed3f(K##13, K##12, x); K##12 = __builtin_amdgcn_fmed3f(K##12, K##11, x);   \
  K##11 = __builtin_amdgcn_fmed3f(K##11, K##10, x); K##10 = __builtin_amdgcn_fmed3f(K##10, K##9, x);    \
  K##9 = __builtin_amdgcn_fmed3f(K##9, K##8, x); K##8 = __builtin_amdgcn_fmed3f(K##8, K##7, x);         \
  K##7 = __builtin_amdgcn_fmed3f(K##7, K##6, x); K##6 = __builtin_amdgcn_fmed3f(K##6, K##5, x);         \
  K##5 = __builtin_amdgcn_fmed3f(K##5, K##4, x); K##4 = __builtin_amdgcn_fmed3f(K##4, K##3, x);         \
  K##3 = __builtin_amdgcn_fmed3f(K##3, K##2, x); K##2 = __builtin_amdgcn_fmed3f(K##2, K##1, x);         \
  K##1 = __builtin_amdgcn_fmed3f(K##1, K##0, x); K##0 = fmaxf(K##0, x);
#define DECL16(K) float K##0 = -INFINITY, K##1 = -INFINITY, K##2 = -INFINITY, K##3 = -INFINITY, K##4 = -INFINITY, \
  K##5 = -INFINITY, K##6 = -INFINITY, K##7 = -INFINITY, K##8 = -INFINITY, K##9 = -INFINITY, K##10 = -INFINITY,   \
  K##11 = -INFINITY, K##12 = -INFINITY, K##13 = -INFINITY, K##14 = -INFINITY, K##15 = -INFINITY;
__device__ __forceinline__ float mkkey(float v, unsigned tag, unsigned mask) {
  return __uint_as_float((__float_as_uint(v) & ~mask) | tag);
}

__device__ __forceinline__ void ph_peer(const P& p, float* smem) {
  typedef __attribute__((ext_vector_type(4))) float f32x4;
  float* lists = smem;
  int* bexA = (int*)(smem + 4096);
  float* bgtA = smem + 6144;
  float* bsuA = smem + 8192;
  for (int item = VB(); item < T_TOK / 16; item += VG()) {
    const int t0 = item * 16;
    vsync();
    {
      const int tid = VT();
      const int tl = tid >> 4, hp = tid & 15;
      const f32x4* sp = (const f32x4*)(p.scores + (size_t)(t0 + tl) * DM + hp * 128);
      DECL16(k)
#pragma unroll 4
      for (int c4 = 0; c4 < 32; ++c4) {
        const f32x4 v = sp[c4];
#pragma unroll
        for (int e = 0; e < 4; ++e) {
          const float x = mkkey(v[e], 127u - (unsigned)(c4 * 4 + e), 127u);
          INS16(k, x)
        }
      }
      f32x4* lp = (f32x4*)(lists + (size_t)VT() * 16);
      f32x4 o0 = {k0, k1, k2, k3}, o1 = {k4, k5, k6, k7}, o2 = {k8, k9, k10, k11}, o3 = {k12, k13, k14, k15};
      lp[0] = o0; lp[1] = o1; lp[2] = o2; lp[3] = o3;
    }
    vsync();
    if (VT() < 128) {
      const int tid = VT();
      const int tl = tid >> 3, h = tid & 7;
      const float* la = lists + (size_t)(tl * 16 + 2 * h) * 16;
      const float* lb = la + 16;
      float av[16], bv[16];
#pragma unroll
      for (int i = 0; i < 16; ++i) {
        av[i] = __uint_as_float(__float_as_uint(la[i]) & ~127u);
        bv[i] = __uint_as_float(__float_as_uint(lb[i]) & ~127u);
      }
      DECL16(c)
#pragma unroll
      for (int i = 0; i < 16; ++i) {
#pragma unroll
        for (int j = 0; j < 16; ++j) {
          if ((i + 1) * (j + 1) <= 16) {
            const float x = mkkey(av[i] + bv[j], 255u - (unsigned)(i * 16 + j), 255u);
            INS16(c, x)
          }
        }
      }
      float cs[16] = {c0, c1, c2, c3, c4, c5, c6, c7, c8, c9, c10, c11, c12, c13, c14, c15};
      float ev[16];
      float sum = 0.f;
      const float mx = __uint_as_float(__float_as_uint(cs[0]) & ~255u);
#pragma unroll
      for (int n = 0; n < 16; ++n) {
        ev[n] = __expf(__uint_as_float(__float_as_uint(cs[n]) & ~255u) - mx);
        sum += ev[n];
      }
      const float isum = 1.f / sum;
#pragma unroll
      for (int n = 0; n < 16; ++n) {
        const unsigned cc = 255u - (__float_as_uint(cs[n]) & 255u);
        const unsigned ka = 127u - (__float_as_uint(la[cc >> 4]) & 127u);
        const unsigned kb = 127u - (__float_as_uint(lb[cc & 15u]) & 127u);
        const int eid = (int)(ka * 128u + kb);
        bexA[tl * 128 + h * 16 + n] = eid;
        bgtA[tl * 128 + h * 16 + n] = ev[n] * isum * p.sv8[eid];
        bsuA[tl * 128 + h * 16 + n] = p.su8[eid];
      }
    }
    vsync();
#pragma unroll 1
    for (int ti4 = 0; ti4 < 4; ++ti4) {
    const int lane = VT() & 63, wv = VT() >> 6;
    const int tl = wv * 4 + ti4;
    const int t = t0 + tl;
    const int* bex = bexA + tl * 128;
    const float* bgt = bgtA + tl * 128;
    const float* bsu = bsuA + tl * 128;
    XPk x;
    {
      const f32x4* s4 = (const f32x4*)(p.out + (size_t)t * DM) + lane * 8;
      const f32x4* g4 = (const f32x4*)p.norm_ffn + lane * 8;
      f32x4 a0 = s4[0], a1 = s4[1], a2 = s4[2], a3 = s4[3], a4 = s4[4], a5 = s4[5], a6 = s4[6], a7 = s4[7];
      float ss = 0.f;
#define SSQ(v) ss += v[0] * v[0] + v[1] * v[1] + v[2] * v[2] + v[3] * v[3];
      SSQ(a0) SSQ(a1) SSQ(a2) SSQ(a3) SSQ(a4) SSQ(a5) SSQ(a6) SSQ(a7)
#undef SSQ
      ss = wave_sum(ss);
      const float rs = rsqrtf(ss * (1.f / DM) + RMS_EPS);
#define XPK(dst, base, va, vb, gi)                                                    \
  {                                                                                   \
    const f32x4 ga = g4[gi], gb = g4[gi + 1];                                         \
    dst[base + 0] = bf2f(f2bf(va[0] * rs * ga[0])); dst[base + 1] = bf2f(f2bf(va[1] * rs * ga[1]));   \
    dst[base + 2] = bf2f(f2bf(va[2] * rs * ga[2])); dst[base + 3] = bf2f(f2bf(va[3] * rs * ga[3]));   \
    dst[base + 4] = bf2f(f2bf(vb[0] * rs * gb[0])); dst[base + 5] = bf2f(f2bf(vb[1] * rs * gb[1]));   \
    dst[base + 6] = bf2f(f2bf(vb[2] * rs * gb[2])); dst[base + 7] = bf2f(f2bf(vb[3] * rs * gb[3]));   \
  }
      XPK(x.a, 0, a0, a1, 0) XPK(x.a, 8, a2, a3, 2) XPK(x.b, 0, a4, a5, 4) XPK(x.b, 8, a6, a7, 6)
#undef XPK
    }
    Acc32 acc;
#pragma unroll
    for (int r = 0; r < 16; ++r) { acc.a[r] = 0.f; acc.b[r] = 0.f; }
    u32x4 u0 = r4_load(p.pu8, bex[0], lane), u1 = r4_load(p.pu8, bex[1], lane), u2 = r4_load(p.pu8, bex[2], lane), u3 = r4_load(p.pu8, bex[3], lane);
    u32x4 v0 = r4_load(p.pv8, bex[0], lane), v1 = r4_load(p.pv8, bex[1], lane), v2 = r4_load(p.pv8, bex[2], lane), v3 = r4_load(p.pv8, bex[3], lane);
#pragma unroll 1
    for (int e0 = 0; e0 < 128; e0 += 4) {
      float d0 = r4_dot(u0, x), d1 = r4_dot(u1, x), d2 = r4_dot(u2, x), d3 = r4_dot(u3, x);
      const int en = (e0 + 4 < 128) ? e0 + 4 : 124;
      const int i0 = bex[en], i1 = bex[en + 1], i2 = bex[en + 2], i3 = bex[en + 3];
      u0 = r4_load(p.pu8, i0, lane); u1 = r4_load(p.pu8, i1, lane); u2 = r4_load(p.pu8, i2, lane); u3 = r4_load(p.pu8, i3, lane);
      d0 = wave_sum_dpp(d0); d1 = wave_sum_dpp(d1); d2 = wave_sum_dpp(d2); d3 = wave_sum_dpp(d3);
      { const float hid = bgt[e0 + 0] * gelu_rcp(d0 * bsu[e0 + 0]); r4_axpy(v0, hid, acc); }
      { const float hid = bgt[e0 + 1] * gelu_rcp(d1 * bsu[e0 + 1]); r4_axpy(v1, hid, acc); }
      { const float hid = bgt[e0 + 2] * gelu_rcp(d2 * bsu[e0 + 2]); r4_axpy(v2, hid, acc); }
      { const float hid = bgt[e0 + 3] * gelu_rcp(d3 * bsu[e0 + 3]); r4_axpy(v3, hid, acc); }
      v0 = r4_load(p.pv8, i0, lane); v1 = r4_load(p.pv8, i1, lane); v2 = r4_load(p.pv8, i2, lane); v3 = r4_load(p.pv8, i3, lane);
    }
    const int lane2 = opq(lane);
    f32x4* o4 = (f32x4*)(p.out + (size_t)t * DM) + lane2 * 8;
    const f32x4* g4 = (const f32x4*)p.norm_final + lane2 * 8;
    f32x4 hv[8];
    float ss = 0.f;
#pragma unroll
    for (int i = 0; i < 8; ++i) {
      hv[i] = o4[i];
#pragma unroll
      for (int k = 0; k < 4; ++k) {
        hv[i][k] += (i < 4) ? acc.a[4 * i + k] : acc.b[4 * (i - 4) + k];
        ss += hv[i][k] * hv[i][k];
      }
    }
    ss = wave_sum(ss);
    const float rs = rsqrtf(ss * (1.f / DM) + RMS_EPS);
#pragma unroll
    for (int i = 0; i < 8; ++i) {
      const f32x4 g = g4[i];
      f32x4 o;
#pragma unroll
      for (int k = 0; k < 4; ++k) o[k] = hv[i][k] * rs * g[k];
      o4[i] = o;
    }
    }
  }
}

#define XB_TMO      128
#define XB_XCNT(j)  (256  + 64 * (j))
#define XB_XSUB(j)  (1280 + 64 * (j))
#define XB_XGEN(j)  (2304 + 64 * (j))
#define XB_TOP      3328
#define XB_TOPGEN   3392
#define XCD_BAR_WORDS 3456
#define XB_SPIN_CAP (1u << 22)
__device__ __forceinline__ unsigned xb_ld(unsigned* p) { return __hip_atomic_load(p, __ATOMIC_RELAXED, __HIP_MEMORY_SCOPE_AGENT); }
__device__ __forceinline__ unsigned xb_add(unsigned* p, unsigned v) { return __hip_atomic_fetch_add(p, v, __ATOMIC_RELAXED, __HIP_MEMORY_SCOPE_AGENT); }
__device__ __forceinline__ unsigned xb_xcc_id() { return (unsigned)__builtin_amdgcn_s_getreg((3 << 11) | 20) & 0xFu; }
#define XB_SPIN(cond, bar) do { unsigned _sp = 0; while (cond) { __builtin_amdgcn_s_sleep(1); \
    if ((++_sp & 255u) == 0u) { if (xb_ld(&(bar)[XB_TMO])) break; if (_sp > XB_SPIN_CAP) { atomicAdd(&(bar)[XB_TMO], 1u); break; } } } } while (0)
struct XcdBarrier { unsigned* bar; unsigned x; volatile LAS unsigned* st; };
__device__ __forceinline__ XcdBarrier xcd_barrier_post(unsigned* bar, volatile LAS unsigned* st) {
  XcdBarrier b; b.bar = bar; b.x = xb_xcc_id(); b.st = st;
  if (threadIdx.x == 0) (void)xb_add(&bar[XB_XCNT(b.x)], 1u);
  return b;
}
__device__ __forceinline__ void xcd_barrier_complete(unsigned* bar, unsigned x, unsigned& nloc, unsigned& nx) {
  const unsigned G = gridDim.x * gridDim.y * gridDim.z;
  unsigned sum, cnt, mine, sp = 0u;
  for (;;) {
    sum = 0u; cnt = 0u; mine = 0u;
#pragma unroll
    for (unsigned j = 0; j < 16; ++j) { const unsigned c = xb_ld(&bar[XB_XCNT(j)]); sum += c; cnt += (c > 0u) ? 1u : 0u; mine = (j == x) ? c : mine; }
    if (sum == G) break;
    __builtin_amdgcn_s_sleep(1);
    if ((++sp & 255u) == 0u) { if (xb_ld(&bar[XB_TMO])) break; if (sp > XB_SPIN_CAP) { atomicAdd(&bar[XB_TMO], 1u); break; } }
  }
  nloc = mine > 0u ? mine : 1u; nx = cnt > 0u ? cnt : 1u;
}
__device__ __forceinline__ void xcd_barrier(const XcdBarrier& b) {
  asm volatile("s_waitcnt vmcnt(0)" ::: "memory");
  __syncthreads();
  if (threadIdx.x == 0) {
    unsigned* bar = b.bar;
    __builtin_amdgcn_s_waitcnt(0);
    unsigned nloc = b.st[0], nx = b.st[1];
    if (nloc == 0u) { xcd_barrier_complete(bar, b.x, nloc, nx); b.st[0] = nloc; b.st[1] = nx; }
    const unsigned old = xb_add(&bar[XB_XSUB(b.x)], 1u);
    const unsigned gen = old / nloc;
    if (old + 1u == (gen + 1u) * nloc) {
      __builtin_amdgcn_fence(__ATOMIC_RELEASE, "agent");
      asm volatile("s_waitcnt vmcnt(0)" ::: "memory");
      const unsigned og = xb_add(&bar[XB_TOP], 1u);
      const unsigned tg = og / nx;
      if (og + 1u == (tg + 1u) * nx) xb_add(&bar[XB_TOPGEN], 1u);
      else XB_SPIN(xb_ld(&bar[XB_TOPGEN]) == tg, bar);
      __builtin_amdgcn_fence(__ATOMIC_ACQUIRE, "agent");
      xb_add(&bar[XB_XGEN(b.x)], 1u);
      asm volatile("s_waitcnt vmcnt(0)" ::: "memory");
    } else {
      XB_SPIN(xb_ld(&bar[XB_XGEN(b.x)]) == gen, bar);
      __builtin_amdgcn_fence(__ATOMIC_ACQUIRE, "agent");
      asm volatile("s_waitcnt vmcnt(0)" ::: "memory");
    }
  }
  __syncthreads();
}

typedef const __attribute__((address_space(4))) P* KP;
__device__ __forceinline__ P loadP() {
#if defined(__HIP_DEVICE_COMPILE__)
  KP k = (KP)__builtin_amdgcn_kernarg_segment_ptr();
  asm volatile("" : "+s"(k));
  P p = *k;
  return p;
#else
  return P{};
#endif
}

__global__ void __launch_bounds__(512, 2) mega(P p_arg) {
  cg::grid_group grid = cg::this_grid();
  __shared__ __attribute__((aligned(16))) float smem_all[2 * 18432 + 64];
  float* smem = smem_all + (threadIdx.x >> 8) * 18432;
  char* lds = (char*)smem;
  unsigned* xbw = (unsigned*)(smem_all + 2 * 18432 + 32);
  if (threadIdx.x < 64) ((unsigned*)(smem_all + 2 * 18432))[threadIdx.x] = 0u;
  if (blockIdx.x == 0) {
    P p = loadP();
    for (int i = threadIdx.x; i < XCD_BAR_WORDS; i += 512) p.bar[i] = 0u;
  }
  __syncthreads();
  { P p = loadP(); ph_rmsnorm(p.x, p.norm_mix, p.hn, T_TOK); ph_rmsnorm(p.mem, p.norm_mkv, p.memn, 1024); }
  { P p = loadP(); ph_transpose<true>(smem, p.w_in, DM, INC, 5760, p.WinT); }
  { P p = loadP(); ph_transpose<false>(smem, p.w_mk, DM, 512, 512, p.WmkT); }
  { P p = loadP(); ph_transpose<false>(smem, p.w_mv, DM, 512, 512, p.WmvT); }
  { P p = loadP(); ph_cvt(p.subk, p.subkb, (size_t)16 * 128 * 128); }
  { P p = loadP(); ph_transpose<false>(smem, p.w1_k, 4096, 128, 128, p.w1T); }
  { P p = loadP(); ph_transpose<false>(smem, p.w1_v, 4096, 128, 128, p.w1T + 128 * 4096); }
  { P p = loadP(); ph_transpose<false>(smem, p.w2_k, 128, 128, 128, p.w2T); }
  { P p = loadP(); ph_transpose<false>(smem, p.w2_v, 128, 128, 128, p.w2T + 128 * 128); }
  { P p = loadP(); ph_posb(p); }
  { P p = loadP(); for (int i = VB() * 256 + VT(); i < 2 * T_TOK; i += VG() * 256) p.rowss[i] = 0.f; }
  grid.sync();
  XcdBarrier xb;
  { P p = loadP(); xb = xcd_barrier_post(p.bar, (volatile LAS unsigned*)xbw); }
  { P p = loadP(); ph_proj(p, (char*)smem_all, lds); }
  const int kvb = (VG() == 512) ? ((VB() >= 320 && VB() < 352) ? (VB() - 320) * 8 : -1) : -2;
  const int vvb = (VG() == 512) ? ((VB() >= 352 && VB() < 384) ? (VB() - 352) * 8 : -1) : -2;
  { P p = loadP(); bf16_t* kmem = p.kmemb;
    ph_gemm_bf16(p.memn, DM, p.WmkT, DM, 1024, 512, DM, lds, [=](int m, int n, float v) {
      kmem[((size_t)((m >> 8) * 4 + (n >> 7)) * 256 + (m & 255)) * 128 + (n & 127)] = f2bf(v); }, kvb); }
  { P p = loadP(); bf16_t* vmem = p.vmemT;
    ph_gemm_bf16(p.memn, DM, p.WmvT, DM, 1024, 512, DM, lds, [=](int m, int n, float v) {
      vmem[((size_t)((m >> 8) * 4 + (n >> 7)) * 128 + (n & 127)) * 256 + perm16(m & 255)] = f2bf(v); }, vvb); }
  xcd_barrier(xb);
  { P p = loadP(); ph_compress2(p, lds); }
  { P p = loadP(); ph_sb2(p, lds); }
  {
    const int skip = (VG() > 32) ? 16 : 0;
    const int vb = (VB() >= skip) ? VB() - skip : -1, nvb = VG() - skip;
    vsync();
    { P p = loadP(); ph_transpose<false>(smem, p.w_out, DM, DM, DM, p.WoutT, vb, nvb); }
    { P p = loadP(); ph_transpose<false>(smem, p.w_mq, DM, 512, 512, p.WmqT, vb, nvb); }
  }
  xcd_barrier(xb);
  { P p = loadP(); ph_nsa2(p, lds); }
  xcd_barrier(xb);
  { P p = loadP(); float* out = p.out; const float* x = p.x; const float* gmq = p.norm_mq; bf16_t* hn = p.hn; float* rss = p.rowss;
    ph_gemm_huge(p.omix, DM, p.WoutT, DM, T_TOK, DM, DM, (char*)smem_all, [=](int m, int n, f32x4_e lo, f32x4_e hi) {
      const f32x4_e x0 = *(const f32x4_e*)(x + (size_t)m * DM + n), x1 = *(const f32x4_e*)(x + (size_t)m * DM + n + 4);
      const f32x4_e h0 = x0 + lo, h1 = x1 + hi;
      *(f32x4_e*)(out + (size_t)m * DM + n) = h0; *(f32x4_e*)(out + (size_t)m * DM + n + 4) = h1;
      norm_feed(h0, h1, gmq, n, hn + (size_t)m * DM, rss + m); }); }
  xcd_barrier(xb);
  {
    const int half = (VG() >= 512) ? 256 : 0;
    if (half == 0 || VB() < half) { P p = loadP(); ph_memq_attn(p, lds, VB(), half ? half : VG()); }
    if (VB() >= half) {
      const int nwv = (VG() - half) * 4, wid = (VB() - half) * 4 + (VT() >> 6);
      vsync();
      { P p = loadP(); ph_transpose<false>(smem, p.w_mo, 512, DM, DM, p.WmoT, VB() - half, VG() - half); }
      { P p = loadP(); ph_cvt4(p.pu, p.pu8, p.su8, 16384, wid, nwv); }
      { P p = loadP(); ph_cvt4(p.pv, p.pv8, p.sv8, 16384, wid, nwv); }
      vsync();
      { P p = loadP(); ph_transpose<false>(smem, p.w_pq, DM, DM, DM, p.WpqT, VB() - half, VG() - half); }
    }
  }
  xcd_barrier(xb);
  { P p = loadP(); float* out = p.out; const float* gffn = p.norm_ffn; bf16_t* hn = p.hn; float* rss = p.rowss + T_TOK;
    ph_gemm_huge(p.omem, 512, p.WmoT, 512, T_TOK, DM, 512, (char*)smem_all, [=](int m, int n, f32x4_e lo, f32x4_e hi) {
      f32x4_e* o0 = (f32x4_e*)(out + (size_t)m * DM + n);
      const f32x4_e h0 = o0[0] + lo, h1 = o0[1] + hi;
      o0[0] = h0; o0[1] = h1;
      norm_feed(h0, h1, gffn, n, hn + (size_t)m * DM, rss + m); }); }
  xcd_barrier(xb);
  { P p = loadP(); ph_qp_scores<0>(p, (char*)smem_all, lds); }
  xcd_barrier(xb);
  { P p = loadP(); ph_peer(p, smem); }
}

extern "C" void kernel_launch(void* const* d_in, const int* in_sizes, int n_in, void* d_out, int out_size, void* d_ws,
                              size_t ws_size, hipStream_t stream) {
  P p{};
  p.x = (const float*)d_in[0]; p.mem = (const float*)d_in[1]; p.t5 = (const float*)d_in[2];
  p.norm_mix = (const float*)d_in[3]; p.w_in = (const float*)d_in[4]; p.pos_k = (const float*)d_in[5];
  p.w1_k = (const float*)d_in[6]; p.w2_k = (const float*)d_in[7]; p.pos_v = (const float*)d_in[8];
  p.w1_v = (const float*)d_in[9]; p.w2_v = (const float*)d_in[10]; p.w_out = (const float*)d_in[11];
  p.norm_mq = (const float*)d_in[12]; p.norm_mkv = (const float*)d_in[13]; p.w_mq = (const float*)d_in[14];
  p.w_mk = (const float*)d_in[15]; p.w_mv = (const float*)d_in[16]; p.w_mo = (const float*)d_in[17];
  p.norm_ffn = (const float*)d_in[18]; p.w_pq = (const float*)d_in[19]; p.subk = (const float*)d_in[20];
  p.pu = (const float*)d_in[21]; p.pv = (const float*)d_in[22]; p.norm_final = (const float*)d_in[23];
  p.out = (float*)d_out;
  char* w = (char*)d_ws;
  size_t off = 0;
  auto take = [&](size_t bytes) { char* r = w + off; off += (bytes + 255) & ~(size_t)255; return r; };
  p.bar = (unsigned*)take(XCD_BAR_WORDS * 4);
  p.scores = (float*)take((size_t)T_TOK * DM * 4);
  p.gates = (float*)take((size_t)T_TOK * 24 * 4);
  p.part = (float*)take((size_t)T_TOK * 1024 * 4);
  p.posb = (float*)take(256 * 4);
  p.rowss = (float*)take((size_t)2 * T_TOK * 4);
  p.qn = (bf16_t*)take((size_t)T_TOK * 1024 * 2);
  p.kcin = (bf16_t*)take((size_t)T_TOK * 256 * 2 + 65536);
  p.vcin = (bf16_t*)take((size_t)T_TOK * 256 * 2 + 65536);
  p.ks = (bf16_t*)take((size_t)T_TOK * 256 * 2);
  p.vsT = (bf16_t*)take((size_t)T_TOK * 256 * 2);
  p.kw = (bf16_t*)take((size_t)T_TOK * 256 * 2);
  p.vwT = (bf16_t*)take((size_t)T_TOK * 256 * 2);
  p.kcb = (bf16_t*)take((size_t)8 * 128 * 128 * 2);
  p.vcT = (bf16_t*)take((size_t)8 * 128 * 128 * 2);
  p.c1 = (bf16_t*)take((size_t)16 * 128 * 128 * 2);
  p.w1T = (bf16_t*)take((size_t)2 * 128 * 4096 * 2);
  p.w2T = (bf16_t*)take((size_t)2 * 128 * 128 * 2);
  p.hn = (bf16_t*)take((size_t)T_TOK * DM * 2);
  p.omix = (bf16_t*)take((size_t)T_TOK * DM * 2);
  p.memn = (bf16_t*)take((size_t)1024 * DM * 2);
  p.omem = (bf16_t*)take((size_t)T_TOK * 512 * 2);
  p.WinT = (bf16_t*)take((size_t)5760 * DM * 2);
  p.WoutT = (bf16_t*)take((size_t)DM * DM * 2);
  p.WpqT = (bf16_t*)take((size_t)DM * DM * 2);
  p.WmqT = (bf16_t*)take((size_t)512 * DM * 2);
  p.WmkT = (bf16_t*)take((size_t)512 * DM * 2);
  p.WmvT = (bf16_t*)take((size_t)512 * DM * 2);
  p.WmoT = (bf16_t*)take((size_t)DM * 512 * 2);
  p.qmemb = (bf16_t*)take((size_t)T_TOK * 512 * 2);
  p.kmemb = (bf16_t*)take((size_t)1024 * 512 * 2);
  p.vmemT = (bf16_t*)take((size_t)1024 * 512 * 2);
  p.qsb = (bf16_t*)take((size_t)T_TOK * 1024 * 2);
  p.ksb = (bf16_t*)take((size_t)T_TOK * 1024 * 2);
  p.vsbT = (bf16_t*)take((size_t)T_TOK * 1024 * 2);
  p.pu8 = (unsigned char*)take((size_t)16384 * 1024);
  p.pv8 = (unsigned char*)take((size_t)16384 * 1024);
  p.su8 = (float*)take(16384 * 4);
  p.sv8 = (float*)take(16384 * 4);
  p.subkb = (bf16_t*)take((size_t)16 * 128 * 128 * 2);
  static int grid_blocks = 0;
  if (!grid_blocks) {
    int dev = 0, cus = 0, per_cu = 0;
    (void)hipGetDevice(&dev);
    (void)hipDeviceGetAttribute(&cus, hipDeviceAttributeMultiprocessorCount, dev);
    (void)hipOccupancyMaxActiveBlocksPerMultiprocessor(&per_cu, mega, 512, 0);
    if (per_cu > 1) per_cu = 1;
    if (per_cu < 1) per_cu = 1;
    grid_blocks = cus * per_cu;
  }
  void* args[] = {&p};
  hipError_t e = hipLaunchCooperativeKernel((void*)mega, dim3(grid_blocks), dim3(512), args, 0, stream);
  if (e != hipSuccess) fprintf(stderr, "cooperative launch failed: %s (grid %d)\n", hipGetErrorString(e), grid_blocks);
}
```

```cpp
#include <hip/hip_runtime.h>
#include <hip/hip_cooperative_groups.h>
#include <cstdio>
namespace cg = cooperative_groups;
#include <stdint.h>

#define SEQ 2048
#define NBATCH 4
#define T_TOK 8192
#define DM 2048
#define INC 5656
#define C_QN 0
#define C_KC 1024
#define C_VC 1280
#define C_KS 1536
#define C_VS 1792
#define C_KW 2048
#define C_VW 2304
#define C_GT 2560
#define C_QSB 2584
#define C_KSB 3608
#define C_VSB 4632
#define ATT_SCALE 0.08838834764831845f
#define LOG2E 1.4426950408889634f
#define ATT_SCALE2 (ATT_SCALE * LOG2E)
#define RMS_EPS 1e-6f

typedef unsigned short bf16_t;
typedef __attribute__((ext_vector_type(8))) short bf16x8;
typedef __attribute__((ext_vector_type(16))) float f32x16;
typedef __attribute__((ext_vector_type(2))) __bf16 bf16v2;
typedef __attribute__((ext_vector_type(4))) unsigned u32x4;

struct P {
  const float *x, *mem, *t5, *norm_mix, *w_in, *pos_k, *w1_k, *w2_k, *pos_v, *w1_v, *w2_v, *w_out,
      *norm_mq, *norm_mkv, *w_mq, *w_mk, *w_mv, *w_mo, *norm_ffn, *w_pq, *subk, *pu, *pv, *norm_final;
  float* out;
  float *scores, *gates, *part, *posb, *rowss;
  unsigned* bar;
  bf16_t *hn, *omix, *memn, *omem;
  bf16_t *WinT, *WoutT, *WpqT, *WmqT, *WmkT, *WmvT, *WmoT;
  bf16_t *qmemb, *kmemb, *vmemT;
  bf16_t *qsb, *ksb, *vsbT;
  bf16_t* subkb;
  unsigned char *pu8, *pv8;
  float *su8, *sv8;
  bf16_t *qn, *kcin, *vcin, *ks, *vsT, *kw, *vwT, *kcb, *vcT, *c1, *w1T, *w2T;
};

__device__ __forceinline__ int opq(int v) { asm volatile("" : "+v"(v)); return v; }
#define LAS __attribute__((address_space(3)))
#define VHALF_BYTES 73728
#define VCNT_OFF (2 * VHALF_BYTES)
__device__ __forceinline__ int VT() { return opq(threadIdx.x) & 255; }
__device__ __forceinline__ int VB() { return (int)blockIdx.x * 2 + (int)(threadIdx.x >> 8); }
__device__ __forceinline__ int VG() { return (int)gridDim.x * 2; }
__device__ __forceinline__ void vbar_wait() {
  if ((threadIdx.x & 63) == 0) {
    LAS unsigned* c = (LAS unsigned*)(unsigned)(VCNT_OFF + 64 * (int)(threadIdx.x >> 8));
    const unsigned old = __hip_atomic_fetch_add(c, 1u, __ATOMIC_RELAXED, __HIP_MEMORY_SCOPE_WORKGROUP);
    const unsigned target = (old & ~3u) + 4u;
    while (__hip_atomic_load(c, __ATOMIC_RELAXED, __HIP_MEMORY_SCOPE_WORKGROUP) < target) __builtin_amdgcn_s_sleep(0);
  }
}
__device__ __forceinline__ void vsync() {
  __builtin_amdgcn_fence(__ATOMIC_RELEASE, "workgroup");
  vbar_wait();
  __builtin_amdgcn_fence(__ATOMIC_ACQUIRE, "workgroup");
}
__device__ __forceinline__ void vsync_raw() {
  asm volatile("" ::: "memory");
  vbar_wait();
  asm volatile("" ::: "memory");
}

__device__ __forceinline__ unsigned pack2(float a, float b) {
  bf16v2 r = {(__bf16)a, (__bf16)b};
  return *(unsigned*)&r;
}
__device__ __forceinline__ bf16_t f2bf(float a) {
  __bf16 r = (__bf16)a;
  return *(bf16_t*)&r;
}
__device__ __forceinline__ int perm16(int s) { return (s & ~12) | ((s & 4) << 1) | ((s & 8) >> 1); }
__device__ __forceinline__ float bf2f(bf16_t u) { return __uint_as_float((unsigned)u << 16); }

__device__ __forceinline__ float wave_max(float v) {
  for (int o = 32; o > 0; o >>= 1) v = fmaxf(v, __shfl_xor(v, o));
  return v;
}
__device__ __forceinline__ float wave_sum(float v) {
  for (int o = 32; o > 0; o >>= 1) v += __shfl_xor(v, o);
  return v;
}
__device__ __forceinline__ void wave_argmax(float& v, int& i) {
  for (int o = 32; o > 0; o >>= 1) {
    float ov = __shfl_xor(v, o);
    int oi = __shfl_xor(i, o);
    if (ov > v || (ov == v && oi < i)) { v = ov; i = oi; }
  }
}
__device__ __forceinline__ float gelu_tanh(float x) {
  return 0.5f * x * (1.f + tanhf(0.7978845608028654f * (x + 0.044715f * x * x * x)));
}
__device__ __forceinline__ float gelu_fast(float x) {
  const float y = 1.5957691216057308f * (x + 0.044715f * x * x * x);
  return x / (1.f + __expf(-y));
}
__device__ __forceinline__ int t5_bucket(int n) {
  if (n < 16) return n < 0 ? 0 : n;
  int b = 16;
  b += (n >= 19); b += (n >= 21); b += (n >= 24); b += (n >= 27); b += (n >= 31); b += (n >= 35);
  b += (n >= 40); b += (n >= 46); b += (n >= 52); b += (n >= 59); b += (n >= 67); b += (n >= 77);
  b += (n >= 87); b += (n >= 99); b += (n >= 113);
  return b;
}
__device__ __forceinline__ float log_sigmoid(float x) {
  return fminf(x, 0.f) - log1pf(expf(-fabsf(x)));
}

__device__ __forceinline__ void ph_rmsnorm(const float* src, const float* gain, bf16_t* dst, int rows) {
  int lane = VT() & 63, wv = VT() >> 6;
  for (int r = VB() * 4 + wv; r < rows; r += VG() * 4) {
    const float4* s4 = (const float4*)(src + (size_t)r * DM);
    float4 v[8];
    float ss = 0.f;
#pragma unroll
    for (int i = 0; i < 8; ++i) {
      v[i] = s4[i * 64 + lane];
      ss += v[i].x * v[i].x + v[i].y * v[i].y + v[i].z * v[i].z + v[i].w * v[i].w;
    }
    ss = wave_sum(ss);
    float rs = rsqrtf(ss * (1.f / DM) + RMS_EPS);
    uint2* d2 = (uint2*)(dst + (size_t)r * DM);
    const float4* g4 = (const float4*)gain;
#pragma unroll
    for (int i = 0; i < 8; ++i) {
      float4 g = g4[i * 64 + lane];
      uint2 o;
      o.x = pack2(v[i].x * rs * g.x, v[i].y * rs * g.y);
      o.y = pack2(v[i].z * rs * g.z, v[i].w * rs * g.w);
      d2[i * 64 + lane] = o;
    }
  }
}

template <bool CMAP>
__device__ __forceinline__ void ph_transpose(float* smem, const float* W, int K, int N, int Npad, bf16_t* Wt,
                                             int vblock = -2, int nvb = 0) {
  typedef __attribute__((ext_vector_type(4))) float f32x4;
  float (*tl)[65] = (float (*)[65])smem;
  if (vblock == -1) return;
  const int b0 = (vblock >= 0) ? vblock : VB(), bstride = (vblock >= 0) ? nvb : VG();
  const int tid = VT();
  const int nk = K / 64, nn = Npad / 64;
  for (int tile = b0; tile < nk * nn; tile += bstride) {
    const int k0 = (tile % nk) * 64, n0 = (tile / nk) * 64;
    const int kr = tid >> 4, n4 = (tid & 15) * 4;
    int sc = n0 + n4;
    if (CMAP) sc = (sc < 2560) ? sc : (sc < 5632) ? sc + 24 : (sc < 5656) ? sc - 5632 + 2560 : N;
#pragma unroll
    for (int i = 0; i < 4; ++i) {
      const int k = kr + 16 * i;
      f32x4 v = {0.f, 0.f, 0.f, 0.f};
      if (sc < N) v = *(const f32x4*)(W + (size_t)(k0 + k) * N + sc);
      tl[k][n4 + 0] = v[0]; tl[k][n4 + 1] = v[1]; tl[k][n4 + 2] = v[2]; tl[k][n4 + 3] = v[3];
    }
    vsync();
    int n = tid >> 2, kc = (tid & 3) * 16;
    unsigned w[8];
#pragma unroll
    for (int i = 0; i < 8; ++i) w[i] = pack2(tl[kc + 2 * i][n], tl[kc + 2 * i + 1][n]);
    uint4* dst = (uint4*)(Wt + (size_t)(n0 + n) * K + k0 + kc);
    dst[0] = make_uint4(w[0], w[1], w[2], w[3]);
    dst[1] = make_uint4(w[4], w[5], w[6], w[7]);
    vsync();
  }
}

__device__ __forceinline__ int lds_off(int row, int chunk) { return row * 128 + ((chunk ^ ((row >> 1) & 7)) << 4); }

template <bool TR, bool VEC = false, class Epi>
__device__ __forceinline__ void gemm_tile_bf16(const bf16_t* xp, int ldx, const bf16_t* yp, int ldy, int K, char* lds,
                                               Epi epi) {
  const int tid = VT(), lane = tid & 63, wv = tid >> 6;
  const int wr = wv >> 1, wc = wv & 1;
  f32x16 acc[2][2];
#pragma unroll
  for (int i = 0; i < 2; ++i)
#pragma unroll
    for (int j = 0; j < 2; ++j)
#pragma unroll
      for (int r = 0; r < 16; ++r) acc[i][j][r] = 0.f;
  const int prow = lane >> 3, pch = lane & 7;
  const bf16_t* xs[4];
  const bf16_t* ys[4];
#pragma unroll
  for (int ps = 0; ps < 4; ++ps) {
    const int row = (wv * 4 + ps) * 8 + prow;
    const int c = pch ^ ((row >> 1) & 7);
    xs[ps] = xp + (size_t)row * ldx + c * 8;
    ys[ps] = yp + (size_t)row * ldy + c * 8;
  }
  char* const mydst = lds + wv * 4096 + lane * 16;
#define GEMM_ISSUE(k0, bufoff)                                                                                              \
  _Pragma("unroll") for (int ps = 0; ps < 4; ++ps) {                                                                        \
    __builtin_amdgcn_global_load_lds((const unsigned*)(xs[ps] + (k0)), (unsigned*)(mydst + (bufoff) + ps * 1024), 16, 0, 0);         \
    __builtin_amdgcn_global_load_lds((const unsigned*)(ys[ps] + (k0)), (unsigned*)(mydst + (bufoff) + 16384 + ps * 1024), 16, 0, 0); \
  }
#define GEMM_COMPUTE(bufoff)                                                                                     \
  _Pragma("unroll") for (int kk = 0; kk < 4; ++kk) {                                                             \
    bf16x8 a[2], b[2];                                                                                           \
    const int ch = kk * 2 + (lane >> 5);                                                                         \
    _Pragma("unroll") for (int i = 0; i < 2; ++i) {                                                              \
      a[i] = *(const bf16x8*)(lds + (bufoff) + (TR ? 16384 : 0) + lds_off(wr * 64 + i * 32 + (lane & 31), ch)); \
      b[i] = *(const bf16x8*)(lds + (bufoff) + (TR ? 0 : 16384) + lds_off(wc * 64 + i * 32 + (lane & 31), ch)); \
    }                                                                                                            \
    _Pragma("unroll") for (int i = 0; i < 2; ++i)                                                                \
      _Pragma("unroll") for (int j = 0; j < 2; ++j)                                                              \
        acc[i][j] = __builtin_amdgcn_mfma_f32_32x32x16_bf16(a[i], b[j], acc[i][j], 0, 0, 0);                    \
  }
  vsync();
  GEMM_ISSUE(0, 0)
  for (int k0 = 0; k0 < K; k0 += 128) {
    asm volatile("s_waitcnt vmcnt(0)" ::: "memory");
    vsync();
    GEMM_ISSUE(k0 + 64, 32768)
    GEMM_COMPUTE(0)
    asm volatile("s_waitcnt vmcnt(0)" ::: "memory");
    vsync();
    if (k0 + 128 < K) { GEMM_ISSUE(k0 + 128, 0) }
    GEMM_COMPUTE(32768)
  }
#undef GEMM_ISSUE
#undef GEMM_COMPUTE
  int lane2 = lane;
  asm volatile("" : "+v"(lane2));
  if constexpr (VEC) {
    typedef __attribute__((ext_vector_type(4))) float f32x4;
    vsync();
    float* wl = (float*)lds + wv * (32 * 68);
    const int hh2 = lane2 >> 5, cl = lane2 & 31;
#pragma unroll
    for (int i = 0; i < 2; ++i) {
#pragma unroll
      for (int j = 0; j < 2; ++j)
#pragma unroll
        for (int r = 0; r < 16; ++r) wl[((r & 3) + 8 * (r >> 2) + 4 * hh2) * 68 + j * 32 + cl] = acc[i][j][r];
      __builtin_amdgcn_wave_barrier();
#pragma unroll
      for (int k = 0; k < 4; ++k) {
        const int row = (lane2 >> 3) + 8 * k, c8 = (lane2 & 7) * 8;
        const f32x4 lo = *(const f32x4*)&wl[row * 68 + c8];
        const f32x4 hi = *(const f32x4*)&wl[row * 68 + c8 + 4];
        epi(wr * 64 + i * 32 + row, wc * 64 + c8, lo, hi);
      }
      __builtin_amdgcn_wave_barrier();
    }
  } else {
#pragma unroll
    for (int i = 0; i < 2; ++i)
#pragma unroll
      for (int j = 0; j < 2; ++j)
#pragma unroll
        for (int r = 0; r < 16; ++r) {
          int rr = wr * 64 + i * 32 + (r & 3) + 8 * (r >> 2) + 4 * (lane2 >> 5);
          int cc = wc * 64 + j * 32 + (lane2 & 31);
          epi(rr, cc, acc[i][j][r]);
        }
  }
}

typedef __attribute__((ext_vector_type(4))) float f32x4_e;
__device__ __forceinline__ void st_bf16x8(bf16_t* dst, f32x4_e lo, f32x4_e hi) {
  u32x4 o;
  o[0] = pack2(lo[0], lo[1]); o[1] = pack2(lo[2], lo[3]); o[2] = pack2(hi[0], hi[1]); o[3] = pack2(hi[2], hi[3]);
  *(u32x4*)dst = o;
}

__device__ __forceinline__ int lds_off32(int row, int chunk) { return row * 64 + ((chunk ^ ((row >> 2) & 3)) << 4); }

template <class Epi>
__device__ __forceinline__ void gemm_tile_big(const bf16_t* xp, int ldx, const bf16_t* yp, int ldy, int K, char* lds,
                                              Epi epi) {
  const int tid = VT(), lane = tid & 63, wv = tid >> 6;
  f32x16 acc[2][4];
#pragma unroll
  for (int i = 0; i < 2; ++i)
#pragma unroll
    for (int j = 0; j < 4; ++j)
#pragma unroll
      for (int r = 0; r < 16; ++r) acc[i][j][r] = 0.f;
  const int prow = lane >> 2, pch = lane & 3;
  const bf16_t* xs[4];
  const bf16_t* ys[2];
#pragma unroll
  for (int ps = 0; ps < 4; ++ps) {
    const int row = (wv * 4 + ps) * 16 + prow;
    xs[ps] = xp + (size_t)row * ldx + (pch ^ ((row >> 2) & 3)) * 8;
  }
#pragma unroll
  for (int ps = 0; ps < 2; ++ps) {
    const int row = (wv * 2 + ps) * 16 + prow;
    ys[ps] = yp + (size_t)row * ldy + (pch ^ ((row >> 2) & 3)) * 8;
  }
  char* const xdst = lds + wv * 4096 + lane * 16;
  char* const ydst = lds + 16384 + wv * 2048 + lane * 16;
#define BIG_ISSUE(k0, st)                                                                                                      \
  _Pragma("unroll") for (int ps = 0; ps < 4; ++ps)                                                                             \
    __builtin_amdgcn_global_load_lds((const unsigned*)(xs[ps] + (k0)), (unsigned*)(xdst + (st) + ps * 1024), 16, 0, 0);        \
  _Pragma("unroll") for (int ps = 0; ps < 2; ++ps)                                                                             \
    __builtin_amdgcn_global_load_lds((const unsigned*)(ys[ps] + (k0)), (unsigned*)(ydst + (st) + ps * 1024), 16, 0, 0);
#define DSR(dst, addr, off) asm volatile("ds_read_b128 %0, %1 offset:%2" : "=v"(dst) : "v"(addr), "i"(off) : "memory")
#define WAIT1(n, x) asm volatile("s_waitcnt lgkmcnt(" #n ")" : "+v"(x))
#define WAIT2(n, x, y) asm volatile("s_waitcnt lgkmcnt(" #n ")" : "+v"(x), "+v"(y))
#define MF(acc_, a_, b_) acc_ = __builtin_amdgcn_mfma_f32_32x32x16_bf16(a_, b_, acc_, 0, 0, 0)
#define BIG_COMPUTE(st)                                                                                   \
  {                                                                                                       \
    bf16x8 a00, a01, a10, a11, b00, b01, b02, b03, b10, b11, b12, b13;                                    \
    const unsigned aa0 = abase0 + (st), aa1 = abase1 + (st), bb0 = bbase0 + (st), bb1 = bbase1 + (st);    \
    DSR(a00, aa0, 0); DSR(b00, bb0, 0); DSR(b01, bb0, 2048); DSR(b02, bb0, 4096); DSR(b03, bb0, 6144);    \
    DSR(a01, aa0, 2048);                                                                                  \
    DSR(a10, aa1, 0); DSR(b10, bb1, 0); DSR(b11, bb1, 2048); DSR(b12, bb1, 4096); DSR(b13, bb1, 6144);    \
    DSR(a11, aa1, 2048);                                                                                  \
    WAIT2(10, a00, b00); MF(acc[0][0], a00, b00);                                                         \
    WAIT1(9, b01); MF(acc[0][1], a00, b01);                                                               \
    WAIT1(8, b02); MF(acc[0][2], a00, b02);                                                               \
    WAIT1(7, b03); MF(acc[0][3], a00, b03);                                                               \
    WAIT1(6, a01); MF(acc[1][0], a01, b00); MF(acc[1][1], a01, b01); MF(acc[1][2], a01, b02); MF(acc[1][3], a01, b03); \
    WAIT2(4, a10, b10); MF(acc[0][0], a10, b10);                                                          \
    WAIT1(3, b11); MF(acc[0][1], a10, b11);                                                               \
    WAIT1(2, b12); MF(acc[0][2], a10, b12);                                                               \
    WAIT1(1, b13); MF(acc[0][3], a10, b13);                                                               \
    WAIT1(0, a11); MF(acc[1][0], a11, b10); MF(acc[1][1], a11, b11); MF(acc[1][2], a11, b12); MF(acc[1][3], a11, b13); \
  }
  const unsigned ldsb = (unsigned)(size_t)(__attribute__((address_space(3))) char*)lds;
  const unsigned abase0 = ldsb + lds_off32(wv * 64 + (lane & 31), 0 + (lane >> 5));
  const unsigned abase1 = ldsb + lds_off32(wv * 64 + (lane & 31), 2 + (lane >> 5));
  const unsigned bbase0 = ldsb + 16384 + lds_off32((lane & 31), 0 + (lane >> 5));
  const unsigned bbase1 = ldsb + 16384 + lds_off32((lane & 31), 2 + (lane >> 5));
  const int nsteps = K >> 5;
  vsync();
  BIG_ISSUE(0, 0)
  BIG_ISSUE(32, 24576)
  int cur = 0, nx2 = 49152;
  for (int t = 0; t < nsteps - 2; ++t) {
    asm volatile("s_waitcnt vmcnt(6)" ::: "memory");
    vsync_raw();
    BIG_ISSUE((t + 2) * 32, nx2)
    BIG_COMPUTE(cur)
    cur = (cur == 49152) ? 0 : cur + 24576;
    nx2 = (nx2 == 49152) ? 0 : nx2 + 24576;
  }
  asm volatile("s_waitcnt vmcnt(6)" ::: "memory");
  vsync_raw();
  BIG_COMPUTE(cur)
  cur = (cur == 49152) ? 0 : cur + 24576;
  asm volatile("s_waitcnt vmcnt(0)" ::: "memory");
  vsync_raw();
  BIG_COMPUTE(cur)
#undef BIG_ISSUE
#undef BIG_COMPUTE
#undef DSR
#undef WAIT1
#undef WAIT2
#undef MF
  const int lane2 = opq(lane);
  typedef __attribute__((ext_vector_type(4))) float f32x4;
  vsync();
  float* wl = (float*)lds + wv * (32 * 68);
  const int hh2 = lane2 >> 5, cl = lane2 & 31;
#pragma unroll
  for (int i = 0; i < 2; ++i)
#pragma unroll
    for (int jh = 0; jh < 2; ++jh) {
#pragma unroll
      for (int j = 0; j < 2; ++j)
#pragma unroll
        for (int r = 0; r < 16; ++r) wl[((r & 3) + 8 * (r >> 2) + 4 * hh2) * 68 + j * 32 + cl] = acc[i][jh * 2 + j][r];
      __builtin_amdgcn_wave_barrier();
#pragma unroll
      for (int k = 0; k < 4; ++k) {
        const int row = (lane2 >> 3) + 8 * k, c8 = (lane2 & 7) * 8;
        const f32x4 lo = *(const f32x4*)&wl[row * 68 + c8];
        const f32x4 hi = *(const f32x4*)&wl[row * 68 + c8 + 4];
        epi(wv * 64 + i * 32 + row, jh * 64 + c8, lo, hi);
      }
      __builtin_amdgcn_wave_barrier();
    }
}

template <class Epi>
__device__ __forceinline__ void ph_gemm_big(const bf16_t* A, int lda, const bf16_t* Wt, int ldw, int M, int N, int K,
                                            char* lds, Epi epi) {
  const int ntm = M / 256, ntn = N / 128;
  const int npm = (ntm + 7) / 8, npn = (ntn + 7) / 8;
  const int nslots = ((npm * npn * 64 + 511) / 512) * 512;
  for (int u = VB(); u < nslots; u += VG()) {
    int v = (u & 7) * 64 + ((u >> 3) & 63) + (u & ~511);
    int patch = v >> 6, w = v & 63;
    int tm = (patch % npm) * 8 + (w & 7);
    int tn = (patch / npm) * 8 + (w >> 3);
    if (tm >= ntm || tn >= ntn) continue;
    const int m0 = tm * 256, n0 = tn * 128;
    gemm_tile_big(A + (size_t)m0 * lda, lda, Wt + (size_t)n0 * ldw, ldw, K, lds,
                  [&](int r, int c, f32x4_e lo, f32x4_e hi) { epi(m0 + r, n0 + c, lo, hi); });
  }
}

template <int PM = 0, class Epi>
__device__ __forceinline__ void gemm_tile_huge(const bf16_t* xp, int ldx, const bf16_t* yp, int ldy, int K, char* lds0,
                                               Epi epi) {
  const int tid = opq(threadIdx.x), lane = tid & 63, wv = tid >> 6;
  const int wr = wv >> 2, wc = wv & 3;
  f32x16 acc[4][2];
#pragma unroll
  for (int i = 0; i < 4; ++i)
#pragma unroll
    for (int j = 0; j < 2; ++j)
#pragma unroll
      for (int r = 0; r < 16; ++r) acc[i][j][r] = 0.f;
  const int prow = lane >> 3, pch = lane & 7;
  const bf16_t* xs[4];
  const bf16_t* ys[4];
#pragma unroll
  for (int ps = 0; ps < 4; ++ps) {
    const int row = (wv * 4 + ps) * 8 + prow;
    const int c = pch ^ ((row >> 1) & 7);
    xs[ps] = xp + (size_t)row * ldx + c * 8;
    ys[ps] = yp + (size_t)row * ldy + c * 8;
  }
  char* const xdst = lds0 + wv * 4096 + lane * 16;
#define HUGE_ISSUE(k0, st)                                                                                                          \
  _Pragma("unroll") for (int ps = 0; ps < 4; ++ps) {                                                                                \
    __builtin_amdgcn_global_load_lds((const unsigned*)(xs[ps] + (k0)), (unsigned*)(xdst + (st) + ps * 1024), 16, 0, 0);             \
    __builtin_amdgcn_global_load_lds((const unsigned*)(ys[ps] + (k0)), (unsigned*)(xdst + (st) + 32768 + ps * 1024), 16, 0, 0);     \
  }
#define HDSR(dst, addr, off) asm volatile("ds_read_b128 %0, %1 offset:%2" : "=v"(dst) : "v"(addr), "i"(off) : "memory")
#define HREAD(S, ab, bb)                                                                            \
  HDSR(S##a0, ab, 0); HDSR(S##b0, bb, 0); HDSR(S##b1, bb, 4096); HDSR(S##a1, ab, 4096);             \
  HDSR(S##a2, ab, 8192); HDSR(S##a3, ab, 12288);
#define HWAIT(n, S)                                                                                 \
  asm volatile("s_waitcnt lgkmcnt(" #n ")" : "+v"(S##a0), "+v"(S##a1), "+v"(S##a2), "+v"(S##a3), "+v"(S##b0), "+v"(S##b1))
#define HMF(i, j, S) acc[i][j] = __builtin_amdgcn_mfma_f32_32x32x16_bf16(S##a##i, S##b##j, acc[i][j], 0, 0, 0)
#define HMMA(S) HMF(0, 0, S); HMF(0, 1, S); HMF(1, 0, S); HMF(1, 1, S); HMF(2, 0, S); HMF(2, 1, S); HMF(3, 0, S); HMF(3, 1, S);
  const unsigned ldsb = (unsigned)(size_t)(LAS char*)lds0;
  const int frow = lane & 31, fh = lane >> 5;
  const unsigned ab0 = ldsb + lds_off(wr * 128 + frow, 0 + fh), ab1 = ldsb + lds_off(wr * 128 + frow, 2 + fh);
  const unsigned ab2 = ldsb + lds_off(wr * 128 + frow, 4 + fh), ab3 = ldsb + lds_off(wr * 128 + frow, 6 + fh);
  const unsigned bb0 = ldsb + 32768 + lds_off(wc * 64 + frow, 0 + fh), bb1 = ldsb + 32768 + lds_off(wc * 64 + frow, 2 + fh);
  const unsigned bb2 = ldsb + 32768 + lds_off(wc * 64 + frow, 4 + fh), bb3 = ldsb + 32768 + lds_off(wc * 64 + frow, 6 + fh);
  __syncthreads();
  if (PM != 1) { HUGE_ISSUE(0, 0) }
  unsigned st = 0;
  for (int k0 = 0; k0 < K; k0 += 64) {
    asm volatile("s_waitcnt vmcnt(0)" ::: "memory");
    __syncthreads();
    if (PM != 1 && k0 + 64 < K) { HUGE_ISSUE(k0 + 64, st ^ 65536u) }
    if (PM != 2) {
      bf16x8 Ea0, Ea1, Ea2, Ea3, Eb0, Eb1, Oa0, Oa1, Oa2, Oa3, Ob0, Ob1;
      const unsigned a0 = ab0 + st, a1 = ab1 + st, a2 = ab2 + st, a3 = ab3 + st;
      const unsigned b0 = bb0 + st, b1 = bb1 + st, b2 = bb2 + st, b3 = bb3 + st;
      HREAD(E, a0, b0)
      HREAD(O, a1, b1)
      HWAIT(6, E); HMMA(E)
      HREAD(E, a2, b2)
      HWAIT(6, O); HMMA(O)
      HREAD(O, a3, b3)
      HWAIT(6, E); HMMA(E)
      HWAIT(0, O); HMMA(O)
    }
    st ^= 65536u;
  }
#undef HUGE_ISSUE
#undef HDSR
#undef HREAD
#undef HWAIT
#undef HMF
#undef HMMA
  const int lane2 = opq(lane);
  typedef __attribute__((ext_vector_type(4))) float f32x4;
  __syncthreads();
  float* wl = (float*)lds0 + wv * (32 * 68);
  const int hh2 = lane2 >> 5, cl = lane2 & 31;
#pragma unroll
  for (int i = 0; i < 4; ++i) {
#pragma unroll
    for (int j = 0; j < 2; ++j)
#pragma unroll
      for (int r = 0; r < 16; ++r) wl[((r & 3) + 8 * (r >> 2) + 4 * hh2) * 68 + j * 32 + cl] = acc[i][j][r];
    __builtin_amdgcn_wave_barrier();
#pragma unroll
    for (int k = 0; k < 4; ++k) {
      const int row = (lane2 >> 3) + 8 * k, c8 = (lane2 & 7) * 8;
      const f32x4 lo = *(const f32x4*)&wl[row * 68 + c8];
      const f32x4 hi = *(const f32x4*)&wl[row * 68 + c8 + 4];
      if (PM != 3) epi(wr * 128 + i * 32 + row, wc * 64 + c8, lo, hi);
    }
    __builtin_amdgcn_wave_barrier();
  }
  __syncthreads();
}

template <class Epi>
__device__ __forceinline__ void ph_gemm_huge(const bf16_t* A, int lda, const bf16_t* Wt, int ldw, int M, int N, int K,
                                             char* lds0, Epi epi) {
  const int ntm = M / 256, ntn = N / 256;
  for (int u = (int)blockIdx.x; u < ntm * ntn; u += (int)gridDim.x) {
    const int x = u & 7, i = (u >> 3) & 31, rnd = u >> 8;
    const int tm = (x & 3) * 8 + (i & 7), tn = rnd * 8 + (x >> 2) * 4 + (i >> 3);
    if (tm >= ntm || tn >= ntn) continue;
    const int m0 = tm * 256, n0 = tn * 256;
    gemm_tile_huge(A + (size_t)m0 * lda, lda, Wt + (size_t)n0 * ldw, ldw, K, lds0,
                   [&](int r, int c, f32x4_e lo, f32x4_e hi) { epi(m0 + r, n0 + c, lo, hi); });
  }
}

__device__ __forceinline__ void norm_feed(const f32x4_e h0, const f32x4_e h1, const float* gain, int n, bf16_t* hn_row,
                                          float* rowss_m) {
  const f32x4_e g0 = *(const f32x4_e*)(gain + n), g1 = *(const f32x4_e*)(gain + n + 4);
  st_bf16x8(hn_row + n, h0 * g0, h1 * g1);
  float ss = h0[0] * h0[0] + h0[1] * h0[1] + h0[2] * h0[2] + h0[3] * h0[3] + h1[0] * h1[0] + h1[1] * h1[1] + h1[2] * h1[2] + h1[3] * h1[3];
  ss += __shfl_xor(ss, 1);
  ss += __shfl_xor(ss, 2);
  ss += __shfl_xor(ss, 4);
  if (((VT()) & 7) == 0) atomicAdd(rowss_m, ss);
}

template <bool VEC = false, class Epi>
__device__ __forceinline__ void ph_gemm_bf16(const bf16_t* A, int lda, const bf16_t* Wt, int ldw, int M, int N, int K,
                                             char* lds, Epi epi, int vblock = -2) {
  const int ntm = M / 128, ntn = N / 128;
  const int npm = (ntm + 7) / 8, npn = (ntn + 7) / 8;
  const int nslots = ((npm * npn * 64 + 511) / 512) * 512;
  if (vblock == -1) return;
  for (int u = (vblock >= 0 ? vblock : VB()); u < nslots; u += VG()) {
    int v = (u & 7) * 64 + ((u >> 3) & 63) + (u & ~511);
    int patch = v >> 6, w = v & 63;
    int tm = (patch % npm) * 8 + (w & 7);
    int tn = (patch / npm) * 8 + (w >> 3);
    if (tm >= ntm || tn >= ntn) continue;
    const int m0 = tm * 128, n0 = tn * 128;
    if constexpr (VEC)
      gemm_tile_bf16<false, true>(A + (size_t)m0 * lda, lda, Wt + (size_t)n0 * ldw, ldw, K, lds,
                                  [&](int r, int c, f32x4_e lo, f32x4_e hi) { epi(m0 + r, n0 + c, lo, hi); });
    else
      gemm_tile_bf16<false>(A + (size_t)m0 * lda, lda, Wt + (size_t)n0 * ldw, ldw, K, lds,
                            [&](int r, int c, float val) { epi(m0 + r, n0 + c, val); });
  }
}

__device__ __forceinline__ void ph_proj(const P& p, char* lds0, char* lds) {
  for (int u = (int)blockIdx.x; u < 512; u += (int)gridDim.x) {
    const int x = u & 7, i = (u >> 3) & 31, rnd = u >> 8;
    const int tm = (x & 3) * 8 + (i & 7), tp = rnd * 8 + (x >> 2) * 4 + (i >> 3);
    const int tb = tp * 2;
    const int tn = (tb < 14) ? tb : (tb < 16) ? tb + 2 : tb + 4;
    const int m0 = tm * 256, n0 = tn * 128;
    const int b = m0 >> 11, sl = m0 & 2047;
    const bf16_t* A = p.hn + (size_t)m0 * DM;
    const bf16_t* W = p.WinT + (size_t)n0 * DM;
    if (n0 < 1024 || (n0 >= 2560 && n0 < 3584)) {
      bf16_t* dst = (n0 < 1024) ? p.qn + (size_t)m0 * 1024 + n0 : p.qsb + (size_t)m0 * 1024 + (n0 - 2560);
      gemm_tile_huge(A, DM, W, DM, DM, lds0, [&](int r, int c, f32x4_e lo, f32x4_e hi) { st_bf16x8(dst + (size_t)r * 1024 + c, lo, hi); });
    } else if (n0 < 2560) {
      const int seg = (n0 - 1024) >> 8;
      bf16_t* base = (seg == 0) ? p.kcin : (seg == 1) ? p.vcin : (seg == 2) ? p.ks : p.kw;
      bf16_t* dst = base + ((size_t)(b * 2) * SEQ + sl) * 128;
      gemm_tile_huge(A, DM, W, DM, DM, lds0, [&](int r, int c, f32x4_e lo, f32x4_e hi) {
        st_bf16x8(dst + ((size_t)(c >> 7) * SEQ + r) * 128 + (c & 127), lo, hi); });
    } else {
      bf16_t* dst = p.ksb + ((size_t)(b * 8 + ((n0 - 3584) >> 7)) * SEQ + sl) * 128;
      gemm_tile_huge(A, DM, W, DM, DM, lds0, [&](int r, int c, f32x4_e lo, f32x4_e hi) {
        st_bf16x8(dst + ((size_t)(c >> 7) * SEQ + r) * 128 + (c & 127), lo, hi); });
    }
  }
  for (int u = (int)blockIdx.x; u < 192; u += (int)gridDim.x) {
    const int tm = u & 31, tv = u >> 5;
    const int n0 = (tv == 0) ? 1792 : (tv == 1) ? 2304 : 4608 + (tv - 2) * 256;
    const int m0 = tm * 256;
    const int b = m0 >> 11, sl = m0 & 2047;
    bf16_t* vd;
    if (tv < 2) vd = (tv == 0 ? p.vsT : p.vwT) + ((size_t)(b * 2) * 128) * SEQ + sl;
    else vd = p.vsbT + ((size_t)(b * 8 + (tv - 2) * 2) * 128) * SEQ + sl;
    gemm_tile_huge(p.WinT + (size_t)n0 * DM, DM, p.hn + (size_t)m0 * DM, DM, DM, lds0,
                   [&](int r, int c, f32x4_e lo, f32x4_e hi) {
                     bf16_t* row = vd + (size_t)r * SEQ;
                     uint2 wa, wb;
                     wa.x = pack2(lo[0], lo[1]); wa.y = pack2(lo[2], lo[3]);
                     wb.x = pack2(hi[0], hi[1]); wb.y = pack2(hi[2], hi[3]);
                     const int pa = (c & 8) ? c - 4 : c, pb = (c & 8) ? c + 4 : c + 8;
                     *(uint2*)(row + pa) = wa;
                     *(uint2*)(row + pb) = wb; });
  }
  {
    const int vb = VB();
    if (VG() != 512 || vb >= 448) {
      for (int tm = (VG() == 512) ? vb - 448 : vb; tm < 64; tm += (VG() == 512) ? 64 : VG()) {
        const int m0 = tm * 128;
        float* gd = p.gates + (size_t)m0 * 24;
        gemm_tile_bf16<false>(p.hn + (size_t)m0 * DM, DM, p.WinT + (size_t)5632 * DM, DM, DM, lds,
                              [&](int r, int c, float val) { if (c < 24) gd[(size_t)r * 24 + c] = val; });
      }
    }
  }
}

__device__ __forceinline__ void ph_posb(const P& p) {
  const int lane = VT() & 63, wv = VT() >> 6;
  for (int o = VB() * 4 + wv; o < 256; o += VG() * 4) {
    const int which = o >> 7, n = o & 127;
    const float* pos = which ? p.pos_v : p.pos_k;
    const float* w1 = which ? p.w1_v : p.w1_k;
    float acc = 0.f;
    for (int k = lane; k < 4096; k += 64) acc += pos[k] * w1[(size_t)k * 128 + n];
    acc = wave_sum(acc);
    if (lane == 0) p.posb[o] = acc;
  }
}

__device__ __forceinline__ void ph_compress2(const P& p, char* lds) {
  for (int item = VB(); item < 16; item += VG()) {
    const int which = item >> 3, bg = item & 7;
    const bf16_t* src = (which ? p.vcin : p.kcin) + (size_t)bg * SEQ * 128;
    const bf16_t* w1t = p.w1T + (size_t)which * 128 * 4096;
    const bf16_t* w2t = p.w2T + (size_t)which * 128 * 128;
    const float* posb = p.posb + which * 128;
    bf16_t* c1 = p.c1 + (size_t)item * 128 * 128;
    gemm_tile_bf16<false>(src, 2048, w1t, 4096, 4096, lds, [&](int r, int c, float val) {
      c1[r * 128 + c] = f2bf(gelu_fast(val + posb[c])); });
    __threadfence_block();
    vsync();
    if (which == 0) {
      bf16_t* kd = p.kcb + (size_t)bg * 128 * 128;
      gemm_tile_bf16<false>(c1, 128, w2t, 128, 128, lds, [&](int r, int c, float val) { kd[r * 128 + c] = f2bf(val); });
    } else {
      bf16_t* vd = p.vcT + (size_t)bg * 128 * 128;
      gemm_tile_bf16<true>(c1, 128, w2t, 128, 128, lds, [&](int r, int c, float val) { vd[r * 128 + perm16(c)] = f2bf(val); });
    }
  }
}

#define NEG_BIG (-1e30f)

struct KVRegs { u32x4 k0, k1, k2, k3, v0, v1, v2, v3; };

__device__ __forceinline__ int koff(int row, int chunk) { return row * 256 + ((chunk ^ (row & 15)) << 4); }

__device__ __forceinline__ void kv_load(KVRegs& r, const bf16_t* kp, int ldk, const bf16_t* vp, int ldv) {
  const int tid = VT();
  const bf16_t* kg = kp + (size_t)(tid >> 4) * ldk + (tid & 15) * 8;
  r.k0 = *(const u32x4*)kg;
  r.k1 = *(const u32x4*)(kg + (size_t)16 * ldk);
  r.k2 = *(const u32x4*)(kg + (size_t)32 * ldk);
  r.k3 = *(const u32x4*)(kg + (size_t)48 * ldk);
  const bf16_t* vg = vp + (size_t)(tid >> 3) * ldv + (tid & 7) * 8;
  r.v0 = *(const u32x4*)vg;
  r.v1 = *(const u32x4*)(vg + (size_t)32 * ldv);
  r.v2 = *(const u32x4*)(vg + (size_t)64 * ldv);
  r.v3 = *(const u32x4*)(vg + (size_t)96 * ldv);
}
__device__ __forceinline__ void kv_store(const KVRegs& r, char* lk, char* lv) {
  const int tid = VT();
  const int row = tid >> 4, ch = tid & 15;
  *(u32x4*)(lk + koff(row, ch)) = r.k0;
  *(u32x4*)(lk + koff(row + 16, ch)) = r.k1;
  *(u32x4*)(lk + koff(row + 32, ch)) = r.k2;
  *(u32x4*)(lk + koff(row + 48, ch)) = r.k3;
  const int vr = tid >> 3, vc = tid & 7;
  *(u32x4*)(lv + lds_off(vr, vc)) = r.v0;
  *(u32x4*)(lv + lds_off(vr + 32, vc)) = r.v1;
  *(u32x4*)(lv + lds_off(vr + 64, vc)) = r.v2;
  *(u32x4*)(lv + lds_off(vr + 96, vc)) = r.v3;
}

struct QFrag { bf16x8 f0, f1, f2, f3, f4, f5, f6, f7; };
__device__ __forceinline__ void q_load(QFrag& q, const bf16_t* qrow) {
  const int h = (VT() & 63) >> 5;
  const bf16x8* p8 = (const bf16x8*)(qrow + 8 * h);
  q.f0 = p8[0]; q.f1 = p8[2]; q.f2 = p8[4]; q.f3 = p8[6]; q.f4 = p8[8]; q.f5 = p8[10]; q.f6 = p8[12]; q.f7 = p8[14];
}

__device__ __forceinline__ void qk_tile(const QFrag& q, const char* lk, f32x16& s0, f32x16& s1) {
  const int lane = VT() & 63, row = lane & 31, h = lane >> 5;
#pragma unroll
  for (int r = 0; r < 16; ++r) { s0[r] = 0.f; s1[r] = 0.f; }
#define QK_STEP(kk, qf)                                                                  \
  {                                                                                      \
    bf16x8 a0 = *(const bf16x8*)(lk + koff(row, 2 * (kk) + h));                          \
    bf16x8 a1 = *(const bf16x8*)(lk + koff(row + 32, 2 * (kk) + h));                     \
    s0 = __builtin_amdgcn_mfma_f32_32x32x16_bf16(a0, qf, s0, 0, 0, 0);                   \
    s1 = __builtin_amdgcn_mfma_f32_32x32x16_bf16(a1, qf, s1, 0, 0, 0);                   \
  }
  QK_STEP(0, q.f0) QK_STEP(1, q.f1) QK_STEP(2, q.f2) QK_STEP(3, q.f3)
  QK_STEP(4, q.f4) QK_STEP(5, q.f5) QK_STEP(6, q.f6) QK_STEP(7, q.f7)
#undef QK_STEP
}

__device__ __forceinline__ bf16x8 pack8(const f32x16& p, const int base) {
  u32x4 u;
  u[0] = pack2(p[base + 0], p[base + 1]);
  u[1] = pack2(p[base + 2], p[base + 3]);
  u[2] = pack2(p[base + 4], p[base + 5]);
  u[3] = pack2(p[base + 6], p[base + 7]);
  return __builtin_bit_cast(bf16x8, u);
}

typedef __attribute__((ext_vector_type(2))) unsigned u32x2_t;
__device__ __forceinline__ float xhalf_max(float v) {
  const u32x2_t r = __builtin_amdgcn_permlane32_swap(__float_as_uint(v), __float_as_uint(v), false, false);
  return fmaxf(__uint_as_float(r[0]), __uint_as_float(r[1]));
}
__device__ __forceinline__ float xhalf_sum(float v) {
  const u32x2_t r = __builtin_amdgcn_permlane32_swap(__float_as_uint(v), __float_as_uint(v), false, false);
  return __uint_as_float(r[0]) + __uint_as_float(r[1]);
}
__device__ __forceinline__ float xhalf_get(float v, int hh) {
  const u32x2_t r = __builtin_amdgcn_permlane32_swap(__float_as_uint(v), __float_as_uint(v), false, false);
  return hh ? __uint_as_float(r[0]) : __uint_as_float(r[1]);
}
struct OAcc { f32x16 o0, o1, o2, o3; };
__device__ __forceinline__ void oacc_zero(OAcc& o) {
#pragma unroll
  for (int r = 0; r < 16; ++r) { o.o0[r] = 0.f; o.o1[r] = 0.f; o.o2[r] = 0.f; o.o3[r] = 0.f; }
}
__device__ __forceinline__ void oacc_scale(OAcc& o, float a) {
#pragma unroll
  for (int r = 0; r < 16; ++r) { o.o0[r] *= a; o.o1[r] *= a; o.o2[r] *= a; o.o3[r] *= a; }
}

__device__ __forceinline__ void pv_tile(OAcc& o, const char* lv, const f32x16& p0, const f32x16& p1) {
  const int lane = VT() & 63, row = lane & 31, h = lane >> 5;
  const bf16x8 pf0 = pack8(p0, 0), pf1 = pack8(p0, 8), pf2 = pack8(p1, 0), pf3 = pack8(p1, 8);
#define PV_ROW(dd, acc)                                                                                      \
  {                                                                                                          \
    acc = __builtin_amdgcn_mfma_f32_32x32x16_bf16(*(const bf16x8*)(lv + lds_off(32 * (dd) + row, 0 + h)), pf0, acc, 0, 0, 0); \
    acc = __builtin_amdgcn_mfma_f32_32x32x16_bf16(*(const bf16x8*)(lv + lds_off(32 * (dd) + row, 2 + h)), pf1, acc, 0, 0, 0); \
    acc = __builtin_amdgcn_mfma_f32_32x32x16_bf16(*(const bf16x8*)(lv + lds_off(32 * (dd) + row, 4 + h)), pf2, acc, 0, 0, 0); \
    acc = __builtin_amdgcn_mfma_f32_32x32x16_bf16(*(const bf16x8*)(lv + lds_off(32 * (dd) + row, 6 + h)), pf3, acc, 0, 0, 0); \
  }
  PV_ROW(0, o.o0) PV_ROW(1, o.o1) PV_ROW(2, o.o2) PV_ROW(3, o.o3)
#undef PV_ROW
}

typedef __attribute__((ext_vector_type(2))) float f32x2_s;
#define SPAIR(v, i) __builtin_shufflevector(v, v, (i), (i) + 1)
__device__ __forceinline__ void softmax_tile(f32x16& s0, f32x16& s1, float& m, float& l, OAcc& o, const float sc = 1.f,
                                             const float bb = 0.f) {
  float mr = -INFINITY;
#pragma unroll
  for (int r = 0; r < 16; ++r) mr = fmaxf(mr, fmaxf(s0[r], s1[r]));
  float mx = fmaf(mr, sc, bb);
  mx = (mx != mx) ? -INFINITY : mx;
  mx = xhalf_max(fmaxf(mx, NEG_BIG));
  const float mn = fmaxf(m, mx);
  const float alpha = __builtin_amdgcn_exp2f(m - mn);
  const f32x2_s sc2 = {sc, sc}, c2 = {bb - mn, bb - mn};
  f32x2_s ls2 = {0.f, 0.f};
#pragma unroll
  for (int r = 0; r < 16; r += 2) {
    const f32x2_s pa_in = {s0[r], s0[r + 1]}, pb_in = {s1[r], s1[r + 1]};
    const f32x2_s a = __builtin_elementwise_fma(pa_in, sc2, c2);
    const f32x2_s b = __builtin_elementwise_fma(pb_in, sc2, c2);
    const float a0 = __builtin_amdgcn_exp2f(a[0]), a1 = __builtin_amdgcn_exp2f(a[1]);
    const float b0 = __builtin_amdgcn_exp2f(b[0]), b1 = __builtin_amdgcn_exp2f(b[1]);
    s0[r] = a0; s0[r + 1] = a1; s1[r] = b0; s1[r + 1] = b1;
    const f32x2_s pa = {a0, a1}, pb = {b0, b1};
    ls2 = ls2 + pa + pb;
  }
  const float ls = xhalf_sum(ls2[0] + ls2[1]);
  l = l * alpha + ls;
  m = mn;
  if (__any(alpha != 1.f)) oacc_scale(o, alpha);
}

template <class F>
__device__ __forceinline__ void oacc_foreach(const OAcc& o, F f) {
  const int h = (VT() & 63) >> 5;
#pragma unroll
  for (int rho = 0; rho < 4; ++rho) {
    f(0 + 8 * rho + 4 * h, o.o0[4 * rho], o.o0[4 * rho + 1], o.o0[4 * rho + 2], o.o0[4 * rho + 3]);
    f(32 + 8 * rho + 4 * h, o.o1[4 * rho], o.o1[4 * rho + 1], o.o1[4 * rho + 2], o.o1[4 * rho + 3]);
    f(64 + 8 * rho + 4 * h, o.o2[4 * rho], o.o2[4 * rho + 1], o.o2[4 * rho + 2], o.o2[4 * rho + 3]);
    f(96 + 8 * rho + 4 * h, o.o3[4 * rho], o.o3[4 * rho + 1], o.o3[4 * rho + 2], o.o3[4 * rho + 3]);
  }
}

__device__ __forceinline__ void memattn_item(const P& p, char* lds, int item) {
  char* lk = lds;
  char* lv = lds + 16384;
  const int lane = VT() & 63, wv = VT() >> 6;
  {
    const int tb = item % (SEQ / 128);
    const int bh = item / (SEQ / 128);
    const int b = bh >> 2, hd = bh & 3;
    const int t = tb * 128 + wv * 32 + (lane & 31);
    QFrag q;
    q_load(q, p.qmemb + (size_t)(b * SEQ + t) * 512 + hd * 128);
    const bf16_t* kb = p.kmemb + (size_t)bh * 256 * 128;
    const bf16_t* vb = p.vmemT + (size_t)bh * 128 * 256;
    OAcc o;
    oacc_zero(o);
    float m = NEG_BIG, l = 0.f;
    KVRegs kv;
    kv_load(kv, kb, 128, vb, 256);
#pragma unroll 1
    for (int ti = 0; ti < 4; ++ti) {
      vsync();
      kv_store(kv, lk, lv);
      vsync();
      {
        const int tn = (ti + 1 < 4) ? ti + 1 : 3;
        kv_load(kv, kb + (size_t)tn * 64 * 128, 128, vb + tn * 64, 256);
      }
      f32x16 s0, s1;
      qk_tile(q, lk, s0, s1);
      softmax_tile(s0, s1, m, l, o, ATT_SCALE2, 0.f);
      pv_tile(o, lv, s0, s1);
    }
    const float il = 1.f / l;
    const int t2 = tb * 128 + (VT() >> 6) * 32 + (VT() & 31);
    bf16_t* orow = p.omem + (size_t)(b * SEQ + t2) * 512 + hd * 128;
    oacc_foreach(o, [&](int d, float v0, float v1, float v2, float v3) {
      uint2 u;
      u.x = pack2(v0 * il, v1 * il);
      u.y = pack2(v2 * il, v3 * il);
      *(uint2*)(orow + d) = u;
    });
  }
}

__device__ __forceinline__ void ph_memq_attn(const P& p, char* lds, int vblock, int nvb) {
  if (vblock < 0) return;
  const float* rss = p.rowss;
  for (int u = vblock; u < 64 * 4; u += nvb) {
    const int tm = u & 63, hd = u >> 6;
    const int m0 = tm * 128;
    bf16_t* qd = p.qmemb + (size_t)m0 * 512 + hd * 128;
    gemm_tile_bf16<false, true>(p.hn + (size_t)m0 * DM, DM, p.WmqT + (size_t)hd * 128 * DM, DM, DM, lds,
                                [&](int r, int c, f32x4_e lo, f32x4_e hi) {
                                  const float rs = rsqrtf(rss[m0 + r] * (1.f / DM) + RMS_EPS);
                                  st_bf16x8(qd + (size_t)r * 512 + c, lo * rs, hi * rs); });
    __threadfence_block();
    vsync();
    memattn_item(p, lds, ((m0 >> 11) * 4 + hd) * (SEQ / 128) + ((m0 & 2047) >> 7));
  }
}

template <bool CHK>
__device__ __forceinline__ void sb_pass1(f32x16& z, f32x16& l, const int s_first, const int t) {
  const f32x2_s sc2 = {ATT_SCALE2, ATT_SCALE2}, one2 = {1.f, 1.f};
#pragma unroll
  for (int r = 0; r < 16; r += 2) {
    const f32x2_s zin = {z[r], z[r + 1]};
    const f32x2_s zz = zin * sc2;
    const f32x2_s ee = {__builtin_amdgcn_exp2f(-fabsf(zz[0])), __builtin_amdgcn_exp2f(-fabsf(zz[1]))};
    const f32x2_s tt = ee + one2;
    const f32x2_s lg = {__builtin_amdgcn_logf(tt[0]), __builtin_amdgcn_logf(tt[1])};
    const f32x2_s mn = {fminf(zz[0], 0.f), fminf(zz[1], 0.f)};
    const f32x2_s lf = (mn - lg) - zz;
    if (CHK) {
      const int so = s_first + 8 * (r >> 2) + (r & 3);
      const bool v0 = so < t, v1 = so + 1 < t;
      l[r] = v0 ? lf[0] : 0.f; l[r + 1] = v1 ? lf[1] : 0.f;
      z[r] = v0 ? zz[0] : NEG_BIG; z[r + 1] = v1 ? zz[1] : NEG_BIG;
    } else {
      l[r] = lf[0]; l[r + 1] = lf[1];
      z[r] = zz[0]; z[r + 1] = zz[1];
    }
  }
}
__device__ __forceinline__ void sb_pass3(f32x16& z, const f32x16& l, const float* ag) {
#pragma unroll
  for (int rho = 0; rho < 4; ++rho) {
    const float x3 = l[4 * rho + 3], x23 = x3 + l[4 * rho + 2], x123 = x23 + l[4 * rho + 1];
    const float g = ag[rho];
    const f32x2_s g2 = {g, g};
    const f32x2_s la = {l[4 * rho + 0], l[4 * rho + 1]}, lb = {l[4 * rho + 2], l[4 * rho + 3]};
    const f32x2_s za = {z[4 * rho + 0], z[4 * rho + 1]}, zb = {z[4 * rho + 2], z[4 * rho + 3]};
    const f32x2_s xa = {x123, x23}, xb = {x3, 0.f};
    const f32x2_s aa = (la + za) + (g2 + xa), ab = (lb + zb) + (g2 + xb);
    z[4 * rho + 0] = __builtin_amdgcn_exp2f(aa[0]); z[4 * rho + 1] = __builtin_amdgcn_exp2f(aa[1]);
    z[4 * rho + 2] = __builtin_amdgcn_exp2f(ab[0]); z[4 * rho + 3] = __builtin_amdgcn_exp2f(ab[1]);
  }
}

__device__ __forceinline__ void ph_sb2(const P& p, char* lds) {
  char* lk = lds;
  char* lv = lds + 16384;
  const int lane = VT() & 63, wv = VT() >> 6, hh = lane >> 5;
  const int sb_skip = (VG() > 32) ? 16 : 0;
  if (VB() < sb_skip) return;
  for (int item = VB() - sb_skip; item < NBATCH * 8 * (SEQ / 128); item += VG() - sb_skip) {
    const int tb = (SEQ / 128 - 1) - (item % (SEQ / 128));
    const int bh = item / (SEQ / 128);
    const int b = bh >> 3, hd = bh & 7;
    const int t0 = tb * 128;
    const int t = t0 + wv * 32 + (lane & 31);
    QFrag q;
    q_load(q, p.qsb + (size_t)(b * SEQ + t) * 1024 + hd * 128);
    const bf16_t* kb = p.ksb + (size_t)bh * SEQ * 128;
    const bf16_t* vb = p.vsbT + (size_t)bh * 128 * SEQ;
    OAcc o;
    oacc_zero(o);
    float carry = 0.f;
    const int jhi = (t0 >> 6) + 1;
    const int jw = (t0 + wv * 32 + 30) >> 6;
    KVRegs kv;
    kv_load(kv, kb + (size_t)jhi * 64 * 128, 128, vb + jhi * 64, SEQ);
    volatile unsigned* dflag = (volatile unsigned*)(lds + 32768);
    vsync();
    if (VT() < 4) dflag[VT()] = 0u;
    for (int j = jhi; j >= 0; --j) {
      vsync();
      if ((dflag[0] & dflag[1] & dflag[2] & dflag[3]) != 0u) break;
      kv_store(kv, lk, lv);
      vsync();
      const int jn = (j > 0) ? j - 1 : 0;
      if (j > jw) kv_load(kv, kb + (size_t)jn * 64 * 128, 128, vb + jn * 64, SEQ);
      if (j <= jw) {
        f32x16 z0, z1;
        qk_tile(q, lk, z0, z1);
        const int sbase = j * 64 + 4 * hh;
        float gt[8];
        f32x16 l0, l1;
        if (j * 64 + 63 < t0 + wv * 32) {
          sb_pass1<false>(z0, l0, sbase, t);
          sb_pass1<false>(z1, l1, sbase + 32, t);
        } else {
          sb_pass1<true>(z0, l0, sbase, t);
          sb_pass1<true>(z1, l1, sbase + 32, t);
        }
#pragma unroll
        for (int rho = 0; rho < 4; ++rho) {
          gt[rho] = (l0[4 * rho] + l0[4 * rho + 1]) + (l0[4 * rho + 2] + l0[4 * rho + 3]);
          gt[4 + rho] = (l1[4 * rho] + l1[4 * rho + 1]) + (l1[4 * rho + 2] + l1[4 * rho + 3]);
        }
        float ag[8];
        float run = 0.f;
#pragma unroll
        for (int k = 7; k >= 0; --k) {
          const float pg = xhalf_get(gt[k], hh);
          ag[k] = carry + run + (hh == 0 ? pg : 0.f);
          run += gt[k] + pg;
        }
        carry += run;
        sb_pass3(z0, l0, ag);
        sb_pass3(z1, l1, ag + 4);
        kv_load(kv, kb + (size_t)jn * 64 * 128, 128, vb + jn * 64, SEQ);
        pv_tile(o, lv, z0, z1);
        if (__all(carry < -104.f * LOG2E) && (VT() & 63) == 0) dflag[wv] = 1u;
      }
    }
    int t2 = t;
    asm volatile("" : "+v"(t2));
    bf16_t* orow = p.omix + (size_t)(b * SEQ + t2) * DM + 1024 + hd * 128;
    oacc_foreach(o, [&](int d, float v0, float v1, float v2, float v3) {
      uint2 u;
      u.x = pack2(v0, v1);
      u.y = pack2(v2, v3);
      *(uint2*)(orow + d) = u;
    });
  }
}

#define NSA_IMP 32768
#define NSA_KEYS 49152
#define NSA_SELM 53504
#define NSA_LUT 53632
__device__ __forceinline__ void ph_nsa2(const P& p, char* lds) {
  typedef __attribute__((ext_vector_type(4))) float f32x4;
  char* lk = lds;
  char* lv = lds + 16384;
  float* imp = (float*)(lds + NSA_IMP);
  float* keys = (float*)(lds + NSA_KEYS);
  unsigned* selm = (unsigned*)(lds + NSA_SELM);
  const int tid = VT(), lane = tid & 63, wv = tid >> 6, hh = lane >> 5, ql = lane & 31;
  float* lut = (float*)(lds + NSA_LUT) + wv * 128;
  for (int item = VB(); item < NBATCH * 2 * (SEQ / 32); item += VG()) {
    const int tt = (item < 256) ? (SEQ / 32 - 1) - (item % (SEQ / 32)) : (item % (SEQ / 32));
    const int bg = item / (SEQ / 32);
    const int b = bg >> 1, g = bg & 1;
    const int h = g * 4 + wv;
    const int t0 = tt * 32, tq = t0 + ql, cur = t0 >> 6;
    vsync();
    QFrag q;
    q_load(q, p.qn + (size_t)(b * SEQ + tq) * 1024 + h * 128);
    {
      const int lo = opq(lane);
      lut[lo] = p.t5[t5_bucket(lo) * 8 + h] * LOG2E;
      lut[lo + 64] = p.t5[t5_bucket(lo + 64) * 8 + h] * LOG2E;
    }
#pragma unroll
    for (int i = 0; i < 16; ++i) imp[i * 256 + tid] = 0.f;
    if (tid < 32) selm[tid] = 0u;
    const float* grow = p.gates + (size_t)(b * SEQ + tq) * 24 + h * 3;
    float* prow = p.part + (size_t)(b * SEQ + tq) * 1024 + h * 128;
    OAcc o;
    float m, l;
    KVRegs kv;
    {
      const bf16_t* kb = p.kcb + (size_t)bg * 128 * 128;
      const bf16_t* vb = p.vcT + (size_t)bg * 128 * 128;
      oacc_zero(o);
      m = NEG_BIG; l = 0.f;
      kv_load(kv, kb, 128, vb, 128);
      vsync();
      kv_store(kv, lk, lv);
      vsync();
      f32x16 x0, x1;
      qk_tile(q, lk, x0, x1);
      int tqv = tq;
      asm volatile("" : "+v"(tqv));
      tqv -= 64 * hh;
      float fsc = 1.f, fbb = 0.f;
      if (t0 >= 1152) {
        fsc = ATT_SCALE2; fbb = lut[127];
      } else {
#pragma unroll
        for (int r = 0; r < 16; ++r) {
          const int c = 8 * (r >> 2) + (r & 3);
          const int d0 = tqv - 16 * c - 31, d1 = d0 - 512;
          x0[r] = (d0 >= 0) ? x0[r] * ATT_SCALE2 + lut[min(d0, 127)] : -INFINITY;
          x1[r] = (d1 >= 0) ? x1[r] * ATT_SCALE2 + lut[min(d1, 127)] : -INFINITY;
        }
      }
      softmax_tile(x0, x1, m, l, o, fsc, fbb);
      const float m0 = m;
      pv_tile(o, lv, x0, x1);
      f32x16 z0, z1;
#pragma unroll
      for (int r = 0; r < 16; ++r) { z0[r] = 0.f; z1[r] = 0.f; }
      if (t0 >= 1024) {
        kv_load(kv, kb + 64 * 128, 128, vb + 64, 128);
        vsync();
        kv_store(kv, lk, lv);
        vsync();
        qk_tile(q, lk, z0, z1);
        asm volatile("" : "+v"(tqv));
#pragma unroll
        for (int r = 0; r < 16; ++r) {
          const int c = 64 + 8 * (r >> 2) + (r & 3);
          const int d0 = tqv - 16 * c - 31, d1 = d0 - 512;
          z0[r] = (d0 >= 0) ? z0[r] * ATT_SCALE2 + lut[min(d0, 127)] : -INFINITY;
          z1[r] = (d1 >= 0) ? z1[r] * ATT_SCALE2 + lut[min(d1, 127)] : -INFINITY;
        }
        softmax_tile(z0, z1, m, l, o);
        pv_tile(o, lv, z0, z1);
      }
      const float inv = 1.f / fmaxf(l, 1e-20f);
      const float c0 = __builtin_amdgcn_exp2f(m0 - m) * inv;
#pragma unroll
      for (int r = 0; r < 16; ++r) {
        const int c = 8 * (r >> 2) + (r & 3) + 4 * hh;
        if (x0[r] != 0.f) atomicAdd(&imp[(c) * 32 + ql], x0[r] * c0);
        if (x1[r] != 0.f) atomicAdd(&imp[(c + 32) * 32 + ql], x1[r] * c0);
        if (z0[r] != 0.f) atomicAdd(&imp[(c + 64) * 32 + ql], z0[r] * inv);
        if (z1[r] != 0.f) atomicAdd(&imp[(c + 96) * 32 + ql], z1[r] * inv);
      }
      const float gs = inv / (1.f + __expf(-grow[0]));
      oacc_foreach(o, [&](int d, float v0, float v1, float v2, float v3) {
        f32x4 u = {v0 * gs, v1 * gs, v2 * gs, v3 * gs};
        *(f32x4*)(prow + d) = u;
      });
    }
    vsync();
    {
      const int tido = opq(tid);
      const int qq = tido & 31, jg = tido >> 5;
#pragma unroll
      for (int jj = 0; jj < 4; ++jj) {
        const int j = jg * 4 + jj;
        float v = imp[(4 * j) * 32 + qq] + imp[(4 * j + 1) * 32 + qq] + imp[(4 * j + 2) * 32 + qq] + 0.5f * imp[(4 * j + 3) * 32 + qq];
        if (j > 0) v += 0.5f * imp[(4 * j - 1) * 32 + qq];
        const bool forced = (j == 0) || (j == cur) || (j == cur - 1);
        keys[qq * 33 + j] = forced ? 1e9f : ((j <= cur) ? v : -1e9f);
      }
      vsync();
      unsigned bits = 0u;
#pragma unroll
      for (int jj = 0; jj < 4; ++jj) {
        const int j = jg * 4 + jj;
        const float kj = keys[qq * 33 + j];
        int rank = 0;
        for (int i = 0; i < 32; ++i) {
          const float ki = keys[qq * 33 + i];
          rank += (ki > kj || (ki == kj && i < j)) ? 1 : 0;
        }
        if (rank < 16 && j <= cur) bits |= 1u << j;
      }
      atomicOr(&selm[qq], bits);
      vsync();
    }
    const unsigned mysel = selm[ql];
    unsigned um = mysel;
#pragma unroll
    for (int o2 = 16; o2 > 0; o2 >>= 1) um |= (unsigned)__shfl_xor((int)um, o2);
    um = (unsigned)__builtin_amdgcn_readfirstlane((int)um);
    {
      const bf16_t* kb = p.ks + (size_t)bg * SEQ * 128;
      const bf16_t* vb = p.vsT + (size_t)bg * 128 * SEQ;
      oacc_zero(o);
      m = NEG_BIG; l = 0.f;
      unsigned rem = um;
      int j = __builtin_ctz(rem);
      kv_load(kv, kb + (size_t)j * 64 * 128, 128, vb + j * 64, SEQ);
      while (rem) {
        j = __builtin_ctz(rem);
        rem &= rem - 1;
        const int jn = rem ? __builtin_ctz(rem) : j;
        vsync();
        kv_store(kv, lk, lv);
        vsync();
        f32x16 s0, s1;
        qk_tile(q, lk, s0, s1);
        const bool selq = (mysel >> j) & 1u;
        int tqv = tq;
        asm volatile("" : "+v"(tqv));
        float fsc = 1.f, fbb = 0.f;
        if (j * 64 + 63 + 113 <= t0) {
          fsc = selq ? ATT_SCALE2 : 0.f; fbb = selq ? lut[127] : -INFINITY;
        } else {
#pragma unroll
          for (int r = 0; r < 16; ++r) {
            const int d0 = tqv - (j * 64 + 8 * (r >> 2) + (r & 3) + 4 * hh), d1 = d0 - 32;
            s0[r] = (selq && d0 >= 0) ? s0[r] * ATT_SCALE2 + lut[min(d0, 127)] : -INFINITY;
            s1[r] = (selq && d1 >= 0) ? s1[r] * ATT_SCALE2 + lut[min(d1, 127)] : -INFINITY;
          }
        }
        kv_load(kv, kb + (size_t)jn * 64 * 128, 128, vb + jn * 64, SEQ);
        softmax_tile(s0, s1, m, l, o, fsc, fbb);
        pv_tile(o, lv, s0, s1);
      }
      const float gs = 1.f / (fmaxf(l, 1e-20f) * (1.f + __expf(-grow[1])));
      int qo = ql;
      asm volatile("" : "+v"(qo));
      float* pr2 = p.part + (size_t)(b * SEQ + t0 + qo) * 1024 + h * 128;
      oacc_foreach(o, [&](int d, float v0, float v1, float v2, float v3) {
        f32x4 u = *(f32x4*)(pr2 + d);
        u[0] += v0 * gs; u[1] += v1 * gs; u[2] += v2 * gs; u[3] += v3 * gs;
        *(f32x4*)(pr2 + d) = u;
      });
    }
    {
      const bf16_t* kb = p.kw + (size_t)bg * SEQ * 128;
      const bf16_t* vb = p.vwT + (size_t)bg * 128 * SEQ;
      oacc_zero(o);
      m = NEG_BIG; l = 0.f;
      int jlo = (t0 - 511) >> 6;
      if (jlo < 0) jlo = 0;
      kv_load(kv, kb + (size_t)jlo * 64 * 128, 128, vb + jlo * 64, SEQ);
      for (int j = jlo; j <= cur; ++j) {
        const int jn = (j < cur) ? j + 1 : j;
        vsync();
        kv_store(kv, lk, lv);
        vsync();
        f32x16 s0, s1;
        qk_tile(q, lk, s0, s1);
        int tqv = tq;
        asm volatile("" : "+v"(tqv));
        float wsc = 1.f, wbb = 0.f;
        if (j * 64 + 63 + 113 <= t0 && t0 + 31 - j * 64 < 512) {
          wsc = ATT_SCALE2; wbb = lut[127];
        } else {
#pragma unroll
          for (int r = 0; r < 16; ++r) {
            const int d0 = tqv - (j * 64 + 8 * (r >> 2) + (r & 3) + 4 * hh), d1 = d0 - 32;
            s0[r] = (d0 >= 0 && d0 < 512) ? s0[r] * ATT_SCALE2 + lut[min(d0, 127)] : -INFINITY;
            s1[r] = (d1 >= 0 && d1 < 512) ? s1[r] * ATT_SCALE2 + lut[min(d1, 127)] : -INFINITY;
          }
        }
        kv_load(kv, kb + (size_t)jn * 64 * 128, 128, vb + jn * 64, SEQ);
        softmax_tile(s0, s1, m, l, o, wsc, wbb);
        pv_tile(o, lv, s0, s1);
      }
      const float gs = 1.f / (fmaxf(l, 1e-20f) * (1.f + __expf(-grow[2])));
      int qo = ql;
      asm volatile("" : "+v"(qo));
      const float* pr2 = p.part + (size_t)(b * SEQ + t0 + qo) * 1024 + h * 128;
      bf16_t* orow = p.omix + (size_t)(b * SEQ + t0 + qo) * DM + h * 128;
      oacc_foreach(o, [&](int d, float v0, float v1, float v2, float v3) {
        const f32x4 u = *(const f32x4*)(pr2 + d);
        uint2 w;
        w.x = pack2(u[0] + v0 * gs, u[1] + v1 * gs);
        w.y = pack2(u[2] + v2 * gs, u[3] + v3 * gs);
        *(uint2*)(orow + d) = w;
      });
    }
  }
}

__device__ __forceinline__ void ph_cvt(const float* src, bf16_t* dst, size_t n) {
  typedef __attribute__((ext_vector_type(4))) float f32x4;
  const size_t nv = n / 8;
  for (size_t i = (size_t)VB() * 256 + VT(); i < nv; i += (size_t)VG() * 256) {
    const f32x4 a = ((const f32x4*)src)[2 * i], b = ((const f32x4*)src)[2 * i + 1];
    u32x4 o;
    o[0] = pack2(a[0], a[1]); o[1] = pack2(a[2], a[3]); o[2] = pack2(b[0], b[1]); o[3] = pack2(b[2], b[3]);
    ((u32x4*)dst)[i] = o;
  }
}

__device__ __forceinline__ void ph_scores(const P& p, char* lds) {
  for (int u = VB(); u < 64 * 16; u += VG()) {
    const int tm = u & 63, hp = u >> 6;
    const int m0 = tm * 128;
    float* sc = p.scores + (size_t)m0 * DM + hp * 128;
    gemm_tile_bf16<false>(p.omix + (size_t)m0 * DM + hp * 128, DM, p.subkb + (size_t)hp * 128 * 128, 128, 128, lds,
                          [&](int r, int c, float val) { sc[(size_t)r * DM + c] = val; });
  }
}

template <int PM = 0>
__device__ __forceinline__ void ph_qp_scores(const P& p, char* lds0, char* lds) {
  for (int u = (int)blockIdx.x; u < 32 * 8; u += (int)gridDim.x) {
    const int x = u & 7, i = (u >> 3) & 31;
    const int tm = (x & 3) * 8 + (i & 7), tn = (x >> 2) * 4 + (i >> 3);
    const int m0 = tm * 256, n0 = tn * 256;
    bf16_t* qp = p.omix + (size_t)m0 * DM + n0;
    const float* rss = p.rowss + T_TOK + m0;
    gemm_tile_huge<PM>(p.hn + (size_t)m0 * DM, DM, p.WpqT + (size_t)n0 * DM, DM, DM, lds0,
                   [&](int r, int c, f32x4_e lo, f32x4_e hi) {
                     const float rs = rsqrtf(rss[r] * (1.f / DM) + RMS_EPS);
                     st_bf16x8(qp + (size_t)r * DM + c, lo * rs, hi * rs); });
    __threadfence_block();
    __syncthreads();
    const int hf = (int)(threadIdx.x >> 8);
    const int hp = tn * 2 + hf;
    float* sc = p.scores + (size_t)m0 * DM + hp * 128;
    gemm_tile_big(qp + hf * 128, DM, p.subkb + (size_t)hp * 128 * 128, 128, 128, lds,
                  [&](int r, int c, f32x4_e lo, f32x4_e hi) {
                    *(f32x4_e*)(sc + (size_t)r * DM + c) = lo; *(f32x4_e*)(sc + (size_t)r * DM + c + 4) = hi; });
    __syncthreads();
  }
}

__device__ __forceinline__ void ph_cvt4(const float* src, unsigned char* dst, float* scales, int nrows, int wid0, int nw) {
  typedef __attribute__((ext_vector_type(4))) float f32x4;
  typedef __attribute__((ext_vector_type(2))) float f32x2;
  const int lane = VT() & 63;
  const float one = __uint_as_float((unsigned)opq(0x3F800000));
  float lev[8];
#pragma unroll
  for (int c = 0; c < 8; ++c) {
    const f32x2 q = __builtin_amdgcn_cvt_scalef32_pk_f32_fp4((unsigned)opq(c * 0x11111111), one, 0);
    lev[c] = fabsf(q[0]);
  }
  const float maxlev = lev[7];
  for (int row = wid0; row < nrows; row += nw) {
    const f32x4* s4 = (const f32x4*)(src + (size_t)row * DM) + lane * 8;
    f32x4 v[8];
    float amax = 0.f;
#pragma unroll
    for (int i = 0; i < 8; ++i) {
      v[i] = s4[i];
#pragma unroll
      for (int k = 0; k < 4; ++k) amax = fmaxf(amax, fabsf(v[i][k]));
    }
    amax = wave_max(amax);
    const float sc = (amax > 0.f) ? maxlev / amax : 1.f;
    u32x4 o;
#pragma unroll
    for (int w = 0; w < 4; ++w) {
      unsigned pk = 0u;
      pk = __builtin_amdgcn_cvt_scalef32_pk_fp4_f32(pk, v[2 * w][0] * sc, v[2 * w][1] * sc, 1.0f, 0);
      pk = __builtin_amdgcn_cvt_scalef32_pk_fp4_f32(pk, v[2 * w][2] * sc, v[2 * w][3] * sc, 1.0f, 1);
      pk = __builtin_amdgcn_cvt_scalef32_pk_fp4_f32(pk, v[2 * w + 1][0] * sc, v[2 * w + 1][1] * sc, 1.0f, 2);
      pk = __builtin_amdgcn_cvt_scalef32_pk_fp4_f32(pk, v[2 * w + 1][2] * sc, v[2 * w + 1][3] * sc, 1.0f, 3);
      o[w] = pk;
    }
    *(u32x4*)(dst + (size_t)row * 1024 + lane * 16) = o;
    if (lane == 0) scales[row] = (amax > 0.f) ? amax / maxlev : 1.f;
  }
}

__device__ __forceinline__ float wave_sum_dpp(float v) {
  typedef __attribute__((ext_vector_type(2))) unsigned u32x2_d;
  v += __builtin_bit_cast(float, __builtin_amdgcn_update_dpp(0, __builtin_bit_cast(int, v), 0xB1, 0xF, 0xF, true));
  v += __builtin_bit_cast(float, __builtin_amdgcn_update_dpp(0, __builtin_bit_cast(int, v), 0x4E, 0xF, 0xF, true));
  v += __builtin_bit_cast(float, __builtin_amdgcn_update_dpp(0, __builtin_bit_cast(int, v), 0x141, 0xF, 0xF, true));
  v += __builtin_bit_cast(float, __builtin_amdgcn_update_dpp(0, __builtin_bit_cast(int, v), 0x140, 0xF, 0xF, true));
  u32x2_d r = __builtin_amdgcn_permlane16_swap(__float_as_uint(v), __float_as_uint(v), false, false);
  v = __uint_as_float(r[0]) + __uint_as_float(r[1]);
  r = __builtin_amdgcn_permlane32_swap(__float_as_uint(v), __float_as_uint(v), false, false);
  return __uint_as_float(r[0]) + __uint_as_float(r[1]);
}
__device__ __forceinline__ float gelu_rcp(float x) {
  const float y2 = (1.5957691216057308f * LOG2E) * (x + 0.044715f * x * x * x);
  return x * __builtin_amdgcn_rcpf(1.f + __builtin_amdgcn_exp2f(-y2));
}
__device__ __forceinline__ u32x4 r4_load(const unsigned char* tab, int eid, int lane) {
  return *((const u32x4*)(tab + (size_t)eid * 1024) + lane);
}
struct XPk { f32x16 a, b; };
struct Acc32 { f32x16 a, b; };

typedef __attribute__((ext_vector_type(2))) float f32x2_t;
#define PAIR(v, i) __builtin_shufflevector(v, v, (i), (i) + 1)
#define R4_DOT_W(word, xv, base, sa, sb)                                                             \
  {                                                                                                  \
    const f32x2_t q0 = __builtin_amdgcn_cvt_scalef32_pk_f32_fp4(word, one, 0), q1 = __builtin_amdgcn_cvt_scalef32_pk_f32_fp4(word, one, 1); \
    const f32x2_t q2 = __builtin_amdgcn_cvt_scalef32_pk_f32_fp4(word, one, 2), q3 = __builtin_amdgcn_cvt_scalef32_pk_f32_fp4(word, one, 3); \
    sa = __builtin_elementwise_fma(q0, PAIR(xv, base + 0), sa); sb = __builtin_elementwise_fma(q1, PAIR(xv, base + 2), sb); \
    sa = __builtin_elementwise_fma(q2, PAIR(xv, base + 4), sa); sb = __builtin_elementwise_fma(q3, PAIR(xv, base + 6), sb); \
  }
__device__ __forceinline__ float r4_dot(const u32x4& e, const XPk& x) {
  const float one = __uint_as_float((unsigned)opq(0x3F800000));
  f32x2_t sa = {0.f, 0.f}, sb = {0.f, 0.f};
  R4_DOT_W(e[0], x.a, 0, sa, sb) R4_DOT_W(e[1], x.a, 8, sa, sb) R4_DOT_W(e[2], x.b, 0, sa, sb) R4_DOT_W(e[3], x.b, 8, sa, sb)
  sa = sa + sb;
  return sa[0] + sa[1];
}
#define R4_AXPY_P(accv, i, q)                                                                        \
  { const f32x2_t r_ = __builtin_elementwise_fma(h2, q, PAIR(accv, i)); accv[i] = r_[0]; accv[(i) + 1] = r_[1]; }
#define R4_AXPY_W(word, accv, base)                                                                  \
  {                                                                                                  \
    const f32x2_t q0 = __builtin_amdgcn_cvt_scalef32_pk_f32_fp4(word, one, 0), q1 = __builtin_amdgcn_cvt_scalef32_pk_f32_fp4(word, one, 1); \
    const f32x2_t q2 = __builtin_amdgcn_cvt_scalef32_pk_f32_fp4(word, one, 2), q3 = __builtin_amdgcn_cvt_scalef32_pk_f32_fp4(word, one, 3); \
    R4_AXPY_P(accv, base + 0, q0) R4_AXPY_P(accv, base + 2, q1) R4_AXPY_P(accv, base + 4, q2) R4_AXPY_P(accv, base + 6, q3) \
  }
__device__ __forceinline__ void r4_axpy(const u32x4& e, float hid, Acc32& acc) {
  const float one = __uint_as_float((unsigned)opq(0x3F800000));
  const f32x2_t h2 = {hid, hid};
  R4_AXPY_W(e[0], acc.a, 0) R4_AXPY_W(e[1], acc.a, 8) R4_AXPY_W(e[2], acc.b, 0) R4_AXPY_W(e[3], acc.b, 8)
}

#define INS16(K, x)                                                                                      \
  K##15 = __builtin_amdgcn_fmed3f(K##15, K##14, x); K##14 = __builtin_amdgcn_fmed3f(K##14, K##13, x);   \
  K##13 = __builtin_amdgcn_fmed3f(K##13, K##12, x); K##12 = __builtin_amdgcn_fmed3f(K##12, K##11, x);   \
  K##11 = __builtin_amdgcn_fmed3f(K##11, K##10, x); K##10 = __builtin_amdgcn_fmed3f(K##10, K##9, x);    \
  K##9 = __builtin_amdgcn_fmed3f(K##9, K##8, x); K##8 = __builtin_amdgcn_fmed3f(K##8, K##7, x);         \
  K##7 = __builtin_amdgcn_fmed3f(K##7, K##6, x); K##6 = __builtin_amdgcn_fmed3f(K##6, K##5, x);         \
  K##5 = __builtin_amdgcn_fmed3f(K##5, K##4, x); K##4 = __builtin_amdgcn_fmed3f(K##4, K##3, x);         \
  K##3 = __builtin_amdgcn_fmed3f(K##3, K##2, x); K##2 = __builtin_amdgcn_fmed3f(K##2, K##1, x);         \
  K##1 = __builtin_amdgcn_fmed3f(K##1, K##0, x); K##0 = fmaxf(K##0, x);
#define DECL16(K) float K##0 = -INFINITY, K##1 = -INFINITY, K##2 = -INFINITY, K##3 = -INFINITY, K##4 = -INFINITY, \
  K##5 = -INFINITY, K##6 = -INFINITY, K##7 = -INFINITY, K##8 = -INFINITY, K##9 = -INFINITY, K##10 = -INFINITY,   \
  K##11 = -INFINITY, K##12 = -INFINITY, K##13 = -INFINITY, K##14 = -INFINITY, K##15 = -INFINITY;
__device__ __forceinline__ float mkkey(float v, unsigned tag, unsigned mask) {
  return __uint_as_float((__float_as_uint(v) & ~mask) | tag);
}

__device__ __forceinline__ void ph_peer(const P& p, float* smem) {
  typedef __attribute__((ext_vector_type(4))) float f32x4;
  float* lists = smem;
  int* bexA = (int*)(smem + 4096);
  float* bgtA = smem + 6144;
  float* bsuA = smem + 8192;
  for (int item = VB(); item < T_TOK / 16; item += VG()) {
    const int t0 = item * 16;
    vsync();
    {
      const int tid = VT();
      const int tl = tid >> 4, hp = tid & 15;
      const f32x4* sp = (const f32x4*)(p.scores + (size_t)(t0 + tl) * DM + hp * 128);
      DECL16(k)
#pragma unroll 4
      for (int c4 = 0; c4 < 32; ++c4) {
        const f32x4 v = sp[c4];
#pragma unroll
        for (int e = 0; e < 4; ++e) {
          const float x = mkkey(v[e], 127u - (unsigned)(c4 * 4 + e), 127u);
          INS16(k, x)
        }
      }
      f32x4* lp = (f32x4*)(lists + (size_t)VT() * 16);
      f32x4 o0 = {k0, k1, k2, k3}, o1 = {k4, k5, k6, k7}, o2 = {k8, k9, k10, k11}, o3 = {k12, k13, k14, k15};
      lp[0] = o0; lp[1] = o1; lp[2] = o2; lp[3] = o3;
    }
    vsync();
    if (VT() < 128) {
      const int tid = VT();
      const int tl = tid >> 3, h = tid & 7;
      const float* la = lists + (size_t)(tl * 16 + 2 * h) * 16;
      const float* lb = la + 16;
      float av[16], bv[16];
#pragma unroll
      for (int i = 0; i < 16; ++i) {
        av[i] = __uint_as_float(__float_as_uint(la[i]) & ~127u);
        bv[i] = __uint_as_float(__float_as_uint(lb[i]) & ~127u);
      }
      DECL16(c)
#pragma unroll
      for (int i = 0; i < 16; ++i) {
#pragma unroll
        for (int j = 0; j < 16; ++j) {
          if ((i + 1) * (j + 1) <= 16) {
            const float x = mkkey(av[i] + bv[j], 255u - (unsigned)(i * 16 + j), 255u);
            INS16(c, x)
          }
        }
      }
      float cs[16] = {c0, c1, c2, c3, c4, c5, c6, c7, c8, c9, c10, c11, c12, c13, c14, c15};
      float ev[16];
      float sum = 0.f;
      const float mx = __uint_as_float(__float_as_uint(cs[0]) & ~255u);
#pragma unroll
      for (int n = 0; n < 16; ++n) {
        ev[n] = __expf(__uint_as_float(__float_as_uint(cs[n]) & ~255u) - mx);
        sum += ev[n];
      }
      const float isum = 1.f / sum;
#pragma unroll
      for (int n = 0; n < 16; ++n) {
        const unsigned cc = 255u - (__float_as_uint(cs[n]) & 255u);
        const unsigned ka = 127u - (__float_as_uint(la[cc >> 4]) & 127u);
        const unsigned kb = 127u - (__float_as_uint(lb[cc & 15u]) & 127u);
        const int eid = (int)(ka * 128u + kb);
        bexA[tl * 128 + h * 16 + n] = eid;
        bgtA[tl * 128 + h * 16 + n] = ev[n] * isum * p.sv8[eid];
        bsuA[tl * 128 + h * 16 + n] = p.su8[eid];
      }
    }
    vsync();
#pragma unroll 1
    for (int ti4 = 0; ti4 < 4; ++ti4) {
    const int lane = VT() & 63, wv = VT() >> 6;
    const int tl = wv * 4 + ti4;
    const int t = t0 + tl;
    const int* bex = bexA + tl * 128;
    const float* bgt = bgtA + tl * 128;
    const float* bsu = bsuA + tl * 128;
    XPk x;
    {
      const f32x4* s4 = (const f32x4*)(p.out + (size_t)t * DM) + lane * 8;
      const f32x4* g4 = (const f32x4*)p.norm_ffn + lane * 8;
      f32x4 a0 = s4[0], a1 = s4[1], a2 = s4[2], a3 = s4[3], a4 = s4[4], a5 = s4[5], a6 = s4[6], a7 = s4[7];
      float ss = 0.f;
#define SSQ(v) ss += v[0] * v[0] + v[1] * v[1] + v[2] * v[2] + v[3] * v[3];
      SSQ(a0) SSQ(a1) SSQ(a2) SSQ(a3) SSQ(a4) SSQ(a5) SSQ(a6) SSQ(a7)
#undef SSQ
      ss = wave_sum(ss);
      const float rs = rsqrtf(ss * (1.f / DM) + RMS_EPS);
#define XPK(dst, base, va, vb, gi)                                                    \
  {                                                                                   \
    const f32x4 ga = g4[gi], gb = g4[gi + 1];                                         \
    dst[base + 0] = bf2f(f2bf(va[0] * rs * ga[0])); dst[base + 1] = bf2f(f2bf(va[1] * rs * ga[1]));   \
    dst[base + 2] = bf2f(f2bf(va[2] * rs * ga[2])); dst[base + 3] = bf2f(f2bf(va[3] * rs * ga[3]));   \
    dst[base + 4] = bf2f(f2bf(vb[0] * rs * gb[0])); dst[base + 5] = bf2f(f2bf(vb[1] * rs * gb[1]));   \
    dst[base + 6] = bf2f(f2bf(vb[2] * rs * gb[2])); dst[base + 7] = bf2f(f2bf(vb[3] * rs * gb[3]));   \
  }
      XPK(x.a, 0, a0, a1, 0) XPK(x.a, 8, a2, a3, 2) XPK(x.b, 0, a4, a5, 4) XPK(x.b, 8, a6, a7, 6)
#undef XPK
    }
    Acc32 acc;
#pragma unroll
    for (int r = 0; r < 16; ++r) { acc.a[r] = 0.f; acc.b[r] = 0.f; }
    u32x4 u0 = r4_load(p.pu8, bex[0], lane), u1 = r4_load(p.pu8, bex[1], lane), u2 = r4_load(p.pu8, bex[2], lane), u3 = r4_load(p.pu8, bex[3], lane);
    u32x4 v0 = r4_load(p.pv8, bex[0], lane), v1 = r4_load(p.pv8, bex[1], lane), v2 = r4_load(p.pv8, bex[2], lane), v3 = r4_load(p.pv8, bex[3], lane);
#pragma unroll 1
    for (int e0 = 0; e0 < 128; e0 += 4) {
      float d0 = r4_dot(u0, x), d1 = r4_dot(u1, x), d2 = r4_dot(u2, x), d3 = r4_dot(u3, x);
      const int en = (e0 + 4 < 128) ? e0 + 4 : 124;
      const int i0 = bex[en], i1 = bex[en + 1], i2 = bex[en + 2], i3 = bex[en + 3];
      u0 = r4_load(p.pu8, i0, lane); u1 = r4_load(p.pu8, i1, lane); u2 = r4_load(p.pu8, i2, lane); u3 = r4_load(p.pu8, i3, lane);
      d0 = wave_sum_dpp(d0); d1 = wave_sum_dpp(d1); d2 = wave_sum_dpp(d2); d3 = wave_sum_dpp(d3);
      { const float hid = bgt[e0 + 0] * gelu_rcp(d0 * bsu[e0 + 0]); r4_axpy(v0, hid, acc); }
      { const float hid = bgt[e0 + 1] * gelu_rcp(d1 * bsu[e0 + 1]); r4_axpy(v1, hid, acc); }
      { const float hid = bgt[e0 + 2] * gelu_rcp(d2 * bsu[e0 + 2]); r4_axpy(v2, hid, acc); }
      { const float hid = bgt[e0 + 3] * gelu_rcp(d3 * bsu[e0 + 3]); r4_axpy(v3, hid, acc); }
      v0 = r4_load(p.pv8, i0, lane); v1 = r4_load(p.pv8, i1, lane); v2 = r4_load(p.pv8, i2, lane); v3 = r4_load(p.pv8, i3, lane);
    }
    const int lane2 = opq(lane);
    f32x4* o4 = (f32x4*)(p.out + (size_t)t * DM) + lane2 * 8;
    const f32x4* g4 = (const f32x4*)p.norm_final + lane2 * 8;
    f32x4 hv[8];
    float ss = 0.f;
#pragma unroll
    for (int i = 0; i < 8; ++i) {
      hv[i] = o4[i];
#pragma unroll
      for (int k = 0; k < 4; ++k) {
        hv[i][k] += (i < 4) ? acc.a[4 * i + k] : acc.b[4 * (i - 4) + k];
        ss += hv[i][k] * hv[i][k];
      }
    }
    ss = wave_sum(ss);
    const float rs = rsqrtf(ss * (1.f / DM) + RMS_EPS);
#pragma unroll
    for (int i = 0; i < 8; ++i) {
      const f32x4 g = g4[i];
      f32x4 o;
#pragma unroll
      for (int k = 0; k < 4; ++k) o[k] = hv[i][k] * rs * g[k];
      o4[i] = o;
    }
    }
  }
}

#define XB_TMO      128
#define XB_XCNT(j)  (256  + 64 * (j))
#define XB_XSUB(j)  (1280 + 64 * (j))
#define XB_XGEN(j)  (2304 + 64 * (j))
#define XB_TOP      3328
#define XB_TOPGEN   3392
#define XCD_BAR_WORDS 3456
#define XB_SPIN_CAP (1u << 22)
__device__ __forceinline__ unsigned xb_ld(unsigned* p) { return __hip_atomic_load(p, __ATOMIC_RELAXED, __HIP_MEMORY_SCOPE_AGENT); }
__device__ __forceinline__ unsigned xb_add(unsigned* p, unsigned v) { return __hip_atomic_fetch_add(p, v, __ATOMIC_RELAXED, __HIP_MEMORY_SCOPE_AGENT); }
__device__ __forceinline__ unsigned xb_xcc_id() { return (unsigned)__builtin_amdgcn_s_getreg((3 << 11) | 20) & 0xFu; }
#define XB_SPIN(cond, bar) do { unsigned _sp = 0; while (cond) { __builtin_amdgcn_s_sleep(1); \
    if ((++_sp & 255u) == 0u) { if (xb_ld(&(bar)[XB_TMO])) break; if (_sp > XB_SPIN_CAP) { atomicAdd(&(bar)[XB_TMO], 1u); break; } } } } while (0)
struct XcdBarrier { unsigned* bar; unsigned x; volatile LAS unsigned* st; };
__device__ __forceinline__ XcdBarrier xcd_barrier_post(unsigned* bar, volatile LAS unsigned* st) {
  XcdBarrier b; b.bar = bar; b.x = xb_xcc_id(); b.st = st;
  if (threadIdx.x == 0) (void)xb_add(&bar[XB_XCNT(b.x)], 1u);
  return b;
}
__device__ __forceinline__ void xcd_barrier_complete(unsigned* bar, unsigned x, unsigned& nloc, unsigned& nx) {
  const unsigned G = gridDim.x * gridDim.y * gridDim.z;
  unsigned sum, cnt, mine, sp = 0u;
  for (;;) {
    sum = 0u; cnt = 0u; mine = 0u;
#pragma unroll
    for (unsigned j = 0; j < 16; ++j) { const unsigned c = xb_ld(&bar[XB_XCNT(j)]); sum += c; cnt += (c > 0u) ? 1u : 0u; mine = (j == x) ? c : mine; }
    if (sum == G) break;
    __builtin_amdgcn_s_sleep(1);
    if ((++sp & 255u) == 0u) { if (xb_ld(&bar[XB_TMO])) break; if (sp > XB_SPIN_CAP) { atomicAdd(&bar[XB_TMO], 1u); break; } }
  }
  nloc = mine > 0u ? mine : 1u; nx = cnt > 0u ? cnt : 1u;
}
__device__ __forceinline__ void xcd_barrier(const XcdBarrier& b) {
  asm volatile("s_waitcnt vmcnt(0)" ::: "memory");
  __syncthreads();
  if (threadIdx.x == 0) {
    unsigned* bar = b.bar;
    __builtin_amdgcn_s_waitcnt(0);
    unsigned nloc = b.st[0], nx = b.st[1];
    if (nloc == 0u) { xcd_barrier_complete(bar, b.x, nloc, nx); b.st[0] = nloc; b.st[1] = nx; }
    const unsigned old = xb_add(&bar[XB_XSUB(b.x)], 1u);
    const unsigned gen = old / nloc;
    if (old + 1u == (gen + 1u) * nloc) {
      __builtin_amdgcn_fence(__ATOMIC_RELEASE, "agent");
      asm volatile("s_waitcnt vmcnt(0)" ::: "memory");
      const unsigned og = xb_add(&bar[XB_TOP], 1u);
      const unsigned tg = og / nx;
      if (og + 1u == (tg + 1u) * nx) xb_add(&bar[XB_TOPGEN], 1u);
      else XB_SPIN(xb_ld(&bar[XB_TOPGEN]) == tg, bar);
      __builtin_amdgcn_fence(__ATOMIC_ACQUIRE, "agent");
      xb_add(&bar[XB_XGEN(b.x)], 1u);
      asm volatile("s_waitcnt vmcnt(0)" ::: "memory");
    } else {
      XB_SPIN(xb_ld(&bar[XB_XGEN(b.x)]) == gen, bar);
      __builtin_amdgcn_fence(__ATOMIC_ACQUIRE, "agent");
      asm volatile("s_waitcnt vmcnt(0)" ::: "memory");
    }
  }
  __syncthreads();
}

typedef const __attribute__((address_space(4))) P* KP;
__device__ __forceinline__ P loadP() {
#if defined(__HIP_DEVICE_COMPILE__)
  KP k = (KP)__builtin_amdgcn_kernarg_segment_ptr();
  asm volatile("" : "+s"(k));
  P p = *k;
  return p;
#else
  return P{};
#endif
}

__global__ void __launch_bounds__(512, 2) mega(P p_arg) {
  cg::grid_group grid = cg::this_grid();
  __shared__ __attribute__((aligned(16))) float smem_all[2 * 18432 + 64];
  float* smem = smem_all + (threadIdx.x >> 8) * 18432;
  char* lds = (char*)smem;
  unsigned* xbw = (unsigned*)(smem_all + 2 * 18432 + 32);
  if (threadIdx.x < 64) ((unsigned*)(smem_all + 2 * 18432))[threadIdx.x] = 0u;
  if (blockIdx.x == 0) {
    P p = loadP();
    for (int i = threadIdx.x; i < XCD_BAR_WORDS; i += 512) p.bar[i] = 0u;
  }
  __syncthreads();
  { P p = loadP(); ph_rmsnorm(p.x, p.norm_mix, p.hn, T_TOK); ph_rmsnorm(p.mem, p.norm_mkv, p.memn, 1024); }
  { P p = loadP(); ph_transpose<true>(smem, p.w_in, DM, INC, 5760, p.WinT); }
  { P p = loadP(); ph_transpose<false>(smem, p.w_mk, DM, 512, 512, p.WmkT); }
  { P p = loadP(); ph_transpose<false>(smem, p.w_mv, DM, 512, 512, p.WmvT); }
  { P p = loadP(); ph_cvt(p.subk, p.subkb, (size_t)16 * 128 * 128); }
  { P p = loadP(); ph_transpose<false>(smem, p.w1_k, 4096, 128, 128, p.w1T); }
  { P p = loadP(); ph_transpose<false>(smem, p.w1_v, 4096, 128, 128, p.w1T + 128 * 4096); }
  { P p = loadP(); ph_transpose<false>(smem, p.w2_k, 128, 128, 128, p.w2T); }
  { P p = loadP(); ph_transpose<false>(smem, p.w2_v, 128, 128, 128, p.w2T + 128 * 128); }
  { P p = loadP(); ph_posb(p); }
  { P p = loadP(); for (int i = VB() * 256 + VT(); i < 2 * T_TOK; i += VG() * 256) p.rowss[i] = 0.f; }
  grid.sync();
  XcdBarrier xb;
  { P p = loadP(); xb = xcd_barrier_post(p.bar, (volatile LAS unsigned*)xbw); }
  { P p = loadP(); ph_proj(p, (char*)smem_all, lds); }
  const int kvb = (VG() == 512) ? ((VB() >= 384 && VB() < 416) ? (VB() - 384) * 8 : -1) : -2;
  const int vvb = (VG() == 512) ? ((VB() >= 416 && VB() < 448) ? (VB() - 416) * 8 : -1) : -2;
  { P p = loadP(); bf16_t* kmem = p.kmemb;
    ph_gemm_bf16(p.memn, DM, p.WmkT, DM, 1024, 512, DM, lds, [=](int m, int n, float v) {
      kmem[((size_t)((m >> 8) * 4 + (n >> 7)) * 256 + (m & 255)) * 128 + (n & 127)] = f2bf(v); }, kvb); }
  { P p = loadP(); bf16_t* vmem = p.vmemT;
    ph_gemm_bf16(p.memn, DM, p.WmvT, DM, 1024, 512, DM, lds, [=](int m, int n, float v) {
      vmem[((size_t)((m >> 8) * 4 + (n >> 7)) * 128 + (n & 127)) * 256 + perm16(m & 255)] = f2bf(v); }, vvb); }
  xcd_barrier(xb);
  { P p = loadP(); ph_compress2(p, lds); }
  { P p = loadP(); ph_sb2(p, lds); }
  {
    const int skip = (VG() > 32) ? 16 : 0;
    const int vb = (VB() >= skip) ? VB() - skip : -1, nvb = VG() - skip;
    vsync();
    { P p = loadP(); ph_transpose<false>(smem, p.w_out, DM, DM, DM, p.WoutT, vb, nvb); }
    { P p = loadP(); ph_transpose<false>(smem, p.w_mq, DM, 512, 512, p.WmqT, vb, nvb); }
  }
  xcd_barrier(xb);
  { P p = loadP(); ph_nsa2(p, lds); }
  xcd_barrier(xb);
  { P p = loadP(); float* out = p.out; const float* x = p.x; const float* gmq = p.norm_mq; bf16_t* hn = p.hn; float* rss = p.rowss;
    ph_gemm_huge(p.omix, DM, p.WoutT, DM, T_TOK, DM, DM, (char*)smem_all, [=](int m, int n, f32x4_e lo, f32x4_e hi) {
      const f32x4_e x0 = *(const f32x4_e*)(x + (size_t)m * DM + n), x1 = *(const f32x4_e*)(x + (size_t)m * DM + n + 4);
      const f32x4_e h0 = x0 + lo, h1 = x1 + hi;
      *(f32x4_e*)(out + (size_t)m * DM + n) = h0; *(f32x4_e*)(out + (size_t)m * DM + n + 4) = h1;
      norm_feed(h0, h1, gmq, n, hn + (size_t)m * DM, rss + m); }); }
  xcd_barrier(xb);
  {
    const int half = (VG() >= 512) ? 256 : 0;
    if (half == 0 || VB() < half) { P p = loadP(); ph_memq_attn(p, lds, VB(), half ? half : VG()); }
    if (VB() >= half) {
      const int nwv = (VG() - half) * 4, wid = (VB() - half) * 4 + (VT() >> 6);
      vsync();
      { P p = loadP(); ph_transpose<false>(smem, p.w_mo, 512, DM, DM, p.WmoT, VB() - half, VG() - half); }
      { P p = loadP(); ph_cvt4(p.pu, p.pu8, p.su8, 16384, wid, nwv); }
      { P p = loadP(); ph_cvt4(p.pv, p.pv8, p.sv8, 16384, wid, nwv); }
      vsync();
      { P p = loadP(); ph_transpose<false>(smem, p.w_pq, DM, DM, DM, p.WpqT, VB() - half, VG() - half); }
    }
  }
  xcd_barrier(xb);
  { P p = loadP(); float* out = p.out; const float* gffn = p.norm_ffn; bf16_t* hn = p.hn; float* rss = p.rowss + T_TOK;
    ph_gemm_huge(p.omem, 512, p.WmoT, 512, T_TOK, DM, 512, (char*)smem_all, [=](int m, int n, f32x4_e lo, f32x4_e hi) {
      f32x4_e* o0 = (f32x4_e*)(out + (size_t)m * DM + n);
      const f32x4_e h0 = o0[0] + lo, h1 = o0[1] + hi;
      o0[0] = h0; o0[1] = h1;
      norm_feed(h0, h1, gffn, n, hn + (size_t)m * DM, rss + m); }); }
  xcd_barrier(xb);
  { P p = loadP(); ph_qp_scores<0>(p, (char*)smem_all, lds); }
  xcd_barrier(xb);
  { P p = loadP(); ph_peer(p, smem); }
}

extern "C" void kernel_launch(void* const* d_in, const int* in_sizes, int n_in, void* d_out, int out_size, void* d_ws,
                              size_t ws_size, hipStream_t stream) {
  P p{};
  p.x = (const float*)d_in[0]; p.mem = (const float*)d_in[1]; p.t5 = (const float*)d_in[2];
  p.norm_mix = (const float*)d_in[3]; p.w_in = (const float*)d_in[4]; p.pos_k = (const float*)d_in[5];
  p.w1_k = (const float*)d_in[6]; p.w2_k = (const float*)d_in[7]; p.pos_v = (const float*)d_in[8];
  p.w1_v = (const float*)d_in[9]; p.w2_v = (const float*)d_in[10]; p.w_out = (const float*)d_in[11];
  p.norm_mq = (const float*)d_in[12]; p.norm_mkv = (const float*)d_in[13]; p.w_mq = (const float*)d_in[14];
  p.w_mk = (const float*)d_in[15]; p.w_mv = (const float*)d_in[16]; p.w_mo = (const float*)d_in[17];
  p.norm_ffn = (const float*)d_in[18]; p.w_pq = (const float*)d_in[19]; p.subk = (const float*)d_in[20];
  p.pu = (const float*)d_in[21]; p.pv = (const float*)d_in[22]; p.norm_final = (const float*)d_in[23];
  p.out = (float*)d_out;
  char* w = (char*)d_ws;
  size_t off = 0;
  auto take = [&](size_t bytes) { char* r = w + off; off += (bytes + 255) & ~(size_t)255; return r; };
  p.bar = (unsigned*)take(XCD_BAR_WORDS * 4);
  p.scores = (float*)take((size_t)T_TOK * DM * 4);
  p.gates = (float*)take((size_t)T_TOK * 24 * 4);
  p.part = (float*)take((size_t)T_TOK * 1024 * 4);
  p.posb = (float*)take(256 * 4);
  p.rowss = (float*)take((size_t)2 * T_TOK * 4);
  p.qn = (bf16_t*)take((size_t)T_TOK * 1024 * 2);
  p.kcin = (bf16_t*)take((size_t)T_TOK * 256 * 2 + 65536);
  p.vcin = (bf16_t*)take((size_t)T_TOK * 256 * 2 + 65536);
  p.ks = (bf16_t*)take((size_t)T_TOK * 256 * 2);
  p.vsT = (bf16_t*)take((size_t)T_TOK * 256 * 2);
  p.kw = (bf16_t*)take((size_t)T_TOK * 256 * 2);
  p.vwT = (bf16_t*)take((size_t)T_TOK * 256 * 2);
  p.kcb = (bf16_t*)take((size_t)8 * 128 * 128 * 2);
  p.vcT = (bf16_t*)take((size_t)8 * 128 * 128 * 2);
  p.c1 = (bf16_t*)take((size_t)16 * 128 * 128 * 2);
  p.w1T = (bf16_t*)take((size_t)2 * 128 * 4096 * 2);
  p.w2T = (bf16_t*)take((size_t)2 * 128 * 128 * 2);
  p.hn = (bf16_t*)take((size_t)T_TOK * DM * 2);
  p.omix = (bf16_t*)take((size_t)T_TOK * DM * 2);
  p.memn = (bf16_t*)take((size_t)1024 * DM * 2);
  p.omem = (bf16_t*)take((size_t)T_TOK * 512 * 2);
  p.WinT = (bf16_t*)take((size_t)5760 * DM * 2);
  p.WoutT = (bf16_t*)take((size_t)DM * DM * 2);
  p.WpqT = (bf16_t*)take((size_t)DM * DM * 2);
  p.WmqT = (bf16_t*)take((size_t)512 * DM * 2);
  p.WmkT = (bf16_t*)take((size_t)512 * DM * 2);
  p.WmvT = (bf16_t*)take((size_t)512 * DM * 2);
  p.WmoT = (bf16_t*)take((size_t)DM * 512 * 2);
  p.qmemb = (bf16_t*)take((size_t)T_TOK * 512 * 2);
  p.kmemb = (bf16_t*)take((size_t)1024 * 512 * 2);
  p.vmemT = (bf16_t*)take((size_t)1024 * 512 * 2);
  p.qsb = (bf16_t*)take((size_t)T_TOK * 1024 * 2);
  p.ksb = (bf16_t*)take((size_t)T_TOK * 1024 * 2);
  p.vsbT = (bf16_t*)take((size_t)T_TOK * 1024 * 2);
  p.pu8 = (unsigned char*)take((size_t)16384 * 1024);
  p.pv8 = (unsigned char*)take((size_t)16384 * 1024);
  p.su8 = (float*)take(16384 * 4);
  p.sv8 = (float*)take(16384 * 4);
  p.subkb = (bf16_t*)take((size_t)16 * 128 * 128 * 2);
  static int grid_blocks = 0;
  if (!grid_blocks) {
    int dev = 0, cus = 0, per_cu = 0;
    (void)hipGetDevice(&dev);
    (void)hipDeviceGetAttribute(&cus, hipDeviceAttributeMultiprocessorCount, dev);
    (void)hipOccupancyMaxActiveBlocksPerMultiprocessor(&per_cu, mega, 512, 0);
    if (per_cu > 1) per_cu = 1;
    if (per_cu < 1) per_cu = 1;
    grid_blocks = cus * per_cu;
  }
  void* args[] = {&p};
  hipError_t e = hipLaunchCooperativeKernel((void*)mega, dim3(grid_blocks), dim3(512), args, 0, stream);
  if (e != hipSuccess) fprintf(stderr, "cooperative launch failed: %s (grid %d)\n", hipGetErrorString(e), grid_blocks);
}
```

```cpp
#include <hip/hip_runtime.h>
#include <hip/hip_cooperative_groups.h>
#include <cstdio>
namespace cg = cooperative_groups;
#include <stdint.h>

#define SEQ 2048
#define NBATCH 4
#define T_TOK 8192
#define DM 2048
#define INC 5656
#define C_QN 0
#define C_KC 1024
#define C_VC 1280
#define C_KS 1536
#define C_VS 1792
#define C_KW 2048
#define C_VW 2304
#define C_GT 2560
#define C_QSB 2584
#define C_KSB 3608
#define C_VSB 4632
#define ATT_SCALE 0.08838834764831845f
#define LOG2E 1.4426950408889634f
#define ATT_SCALE2 (ATT_SCALE * LOG2E)
#define RMS_EPS 1e-6f

typedef unsigned short bf16_t;
typedef __attribute__((ext_vector_type(8))) short bf16x8;
typedef __attribute__((ext_vector_type(16))) float f32x16;
typedef __attribute__((ext_vector_type(2))) __bf16 bf16v2;
typedef __attribute__((ext_vector_type(4))) unsigned u32x4;

struct P {
  const float *x, *mem, *t5, *norm_mix, *w_in, *pos_k, *w1_k, *w2_k, *pos_v, *w1_v, *w2_v, *w_out,
      *norm_mq, *norm_mkv, *w_mq, *w_mk, *w_mv, *w_mo, *norm_ffn, *w_pq, *subk, *pu, *pv, *norm_final;
  float* out;
  float *scores, *gates, *part, *posb, *rowss;
  unsigned* bar;
  bf16_t *hn, *omix, *memn, *omem;
  bf16_t *WinT, *WoutT, *WpqT, *WmqT, *WmkT, *WmvT, *WmoT;
  bf16_t *qmemb, *kmemb, *vmemT;
  bf16_t *qsb, *ksb, *vsbT;
  bf16_t* subkb;
  unsigned char *pu8, *pv8;
  float *su8, *sv8;
  bf16_t *qn, *kcin, *vcin, *ks, *vsT, *kw, *vwT, *kcb, *vcT, *c1, *w1T, *w2T;
};

__device__ __forceinline__ int opq(int v) { asm volatile("" : "+v"(v)); return v; }
#define LAS __attribute__((address_space(3)))
#define VHALF_BYTES 73728
#define VCNT_OFF (2 * VHALF_BYTES)
__device__ __forceinline__ int VT() { return opq(threadIdx.x) & 255; }
__device__ __forceinline__ int VB() { return (int)blockIdx.x * 2 + (int)(threadIdx.x >> 8); }
__device__ __forceinline__ int VG() { return (int)gridDim.x * 2; }
__device__ __forceinline__ void vbar_wait() {
  if ((threadIdx.x & 63) == 0) {
    LAS unsigned* c = (LAS unsigned*)(unsigned)(VCNT_OFF + 64 * (int)(threadIdx.x >> 8));
    const unsigned old = __hip_atomic_fetch_add(c, 1u, __ATOMIC_RELAXED, __HIP_MEMORY_SCOPE_WORKGROUP);
    const unsigned target = (old & ~3u) + 4u;
    while (__hip_atomic_load(c, __ATOMIC_RELAXED, __HIP_MEMORY_SCOPE_WORKGROUP) < target) __builtin_amdgcn_s_sleep(0);
  }
}
__device__ __forceinline__ void vsync() {
  __builtin_amdgcn_fence(__ATOMIC_RELEASE, "workgroup");
  vbar_wait();
  __builtin_amdgcn_fence(__ATOMIC_ACQUIRE, "workgroup");
}
__device__ __forceinline__ void vsync_raw() {
  asm volatile("" ::: "memory");
  vbar_wait();
  asm volatile("" ::: "memory");
}

__device__ __forceinline__ unsigned pack2(float a, float b) {
  bf16v2 r = {(__bf16)a, (__bf16)b};
  return *(unsigned*)&r;
}
__device__ __forceinline__ bf16_t f2bf(float a) {
  __bf16 r = (__bf16)a;
  return *(bf16_t*)&r;
}
__device__ __forceinline__ int perm16(int s) { return (s & ~12) | ((s & 4) << 1) | ((s & 8) >> 1); }
__device__ __forceinline__ float bf2f(bf16_t u) { return __uint_as_float((unsigned)u << 16); }

__device__ __forceinline__ float wave_max(float v) {
  for (int o = 32; o > 0; o >>= 1) v = fmaxf(v, __shfl_xor(v, o));
  return v;
}
__device__ __forceinline__ float wave_sum(float v) {
  for (int o = 32; o > 0; o >>= 1) v += __shfl_xor(v, o);
  return v;
}
__device__ __forceinline__ void wave_argmax(float& v, int& i) {
  for (int o = 32; o > 0; o >>= 1) {
    float ov = __shfl_xor(v, o);
    int oi = __shfl_xor(i, o);
    if (ov > v || (ov == v && oi < i)) { v = ov; i = oi; }
  }
}
__device__ __forceinline__ float gelu_tanh(float x) {
  return 0.5f * x * (1.f + tanhf(0.7978845608028654f * (x + 0.044715f * x * x * x)));
}
__device__ __forceinline__ float gelu_fast(float x) {
  const float y = 1.5957691216057308f * (x + 0.044715f * x * x * x);
  return x / (1.f + __expf(-y));
}
__device__ __forceinline__ int t5_bucket(int n) {
  if (n < 16) return n < 0 ? 0 : n;
  int b = 16;
  b += (n >= 19); b += (n >= 21); b += (n >= 24); b += (n >= 27); b += (n >= 31); b += (n >= 35);
  b += (n >= 40); b += (n >= 46); b += (n >= 52); b += (n >= 59); b += (n >= 67); b += (n >= 77);
  b += (n >= 87); b += (n >= 99); b += (n >= 113);
  return b;
}
__device__ __forceinline__ float log_sigmoid(float x) {
  return fminf(x, 0.f) - log1pf(expf(-fabsf(x)));
}

__device__ __forceinline__ void ph_rmsnorm(const float* src, const float* gain, bf16_t* dst, int rows) {
  int lane = VT() & 63, wv = VT() >> 6;
  for (int r = VB() * 4 + wv; r < rows; r += VG() * 4) {
    const float4* s4 = (const float4*)(src + (size_t)r * DM);
    float4 v[8];
    float ss = 0.f;
#pragma unroll
    for (int i = 0; i < 8; ++i) {
      v[i] = s4[i * 64 + lane];
      ss += v[i].x * v[i].x + v[i].y * v[i].y + v[i].z * v[i].z + v[i].w * v[i].w;
    }
    ss = wave_sum(ss);
    float rs = rsqrtf(ss * (1.f / DM) + RMS_EPS);
    uint2* d2 = (uint2*)(dst + (size_t)r * DM);
    const float4* g4 = (const float4*)gain;
#pragma unroll
    for (int i = 0; i < 8; ++i) {
      float4 g = g4[i * 64 + lane];
      uint2 o;
      o.x = pack2(v[i].x * rs * g.x, v[i].y * rs * g.y);
      o.y = pack2(v[i].z * rs * g.z, v[i].w * rs * g.w);
      d2[i * 64 + lane] = o;
    }
  }
}

template <bool CMAP>
__device__ __forceinline__ void ph_transpose(float* smem, const float* W, int K, int N, int Npad, bf16_t* Wt,
                                             int vblock = -2, int nvb = 0) {
  typedef __attribute__((ext_vector_type(4))) float f32x4;
  float (*tl)[65] = (float (*)[65])smem;
  if (vblock == -1) return;
  const int b0 = (vblock >= 0) ? vblock : VB(), bstride = (vblock >= 0) ? nvb : VG();
  const int tid = VT();
  const int nk = K / 64, nn = Npad / 64;
  for (int tile = b0; tile < nk * nn; tile += bstride) {
    const int k0 = (tile % nk) * 64, n0 = (tile / nk) * 64;
    const int kr = tid >> 4, n4 = (tid & 15) * 4;
    int sc = n0 + n4;
    if (CMAP) sc = (sc < 2560) ? sc : (sc < 5632) ? sc + 24 : (sc < 5656) ? sc - 5632 + 2560 : N;
#pragma unroll
    for (int i = 0; i < 4; ++i) {
      const int k = kr + 16 * i;
      f32x4 v = {0.f, 0.f, 0.f, 0.f};
      if (sc < N) v = *(const f32x4*)(W + (size_t)(k0 + k) * N + sc);
      tl[k][n4 + 0] = v[0]; tl[k][n4 + 1] = v[1]; tl[k][n4 + 2] = v[2]; tl[k][n4 + 3] = v[3];
    }
    vsync();
    int n = tid >> 2, kc = (tid & 3) * 16;
    unsigned w[8];
#pragma unroll
    for (int i = 0; i < 8; ++i) w[i] = pack2(tl[kc + 2 * i][n], tl[kc + 2 * i + 1][n]);
    uint4* dst = (uint4*)(Wt + (size_t)(n0 + n) * K + k0 + kc);
    dst[0] = make_uint4(w[0], w[1], w[2], w[3]);
    dst[1] = make_uint4(w[4], w[5], w[6], w[7]);
    vsync();
  }
}

__device__ __forceinline__ int lds_off(int row, int chunk) { return row * 128 + ((chunk ^ ((row >> 1) & 7)) << 4); }

template <bool TR, bool VEC = false, class Epi>
__device__ __forceinline__ void gemm_tile_bf16(const bf16_t* xp, int ldx, const bf16_t* yp, int ldy, int K, char* lds,
                                               Epi epi) {
  const int tid = VT(), lane = tid & 63, wv = tid >> 6;
  const int wr = wv >> 1, wc = wv & 1;
  f32x16 acc[2][2];
#pragma unroll
  for (int i = 0; i < 2; ++i)
#pragma unroll
    for (int j = 0; j < 2; ++j)
#pragma unroll
      for (int r = 0; r < 16; ++r) acc[i][j][r] = 0.f;
  const int prow = lane >> 3, pch = lane & 7;
  const bf16_t* xs[4];
  const bf16_t* ys[4];
#pragma unroll
  for (int ps = 0; ps < 4; ++ps) {
    const int row = (wv * 4 + ps) * 8 + prow;
    const int c = pch ^ ((row >> 1) & 7);
    xs[ps] = xp + (size_t)row * ldx + c * 8;
    ys[ps] = yp + (size_t)row * ldy + c * 8;
  }
  char* const mydst = lds + wv * 4096 + lane * 16;
#define GEMM_ISSUE(k0, bufoff)                                                                                              \
  _Pragma("unroll") for (int ps = 0; ps < 4; ++ps) {                                                                        \
    __builtin_amdgcn_global_load_lds((const unsigned*)(xs[ps] + (k0)), (unsigned*)(mydst + (bufoff) + ps * 1024), 16, 0, 0);         \
    __builtin_amdgcn_global_load_lds((const unsigned*)(ys[ps] + (k0)), (unsigned*)(mydst + (bufoff) + 16384 + ps * 1024), 16, 0, 0); \
  }
#define GEMM_COMPUTE(bufoff)                                                                                     \
  _Pragma("unroll") for (int kk = 0; kk < 4; ++kk) {                                                             \
    bf16x8 a[2], b[2];                                                                                           \
    const int ch = kk * 2 + (lane >> 5);                                                                         \
    _Pragma("unroll") for (int i = 0; i < 2; ++i) {                                                              \
      a[i] = *(const bf16x8*)(lds + (bufoff) + (TR ? 16384 : 0) + lds_off(wr * 64 + i * 32 + (lane & 31), ch)); \
      b[i] = *(const bf16x8*)(lds + (bufoff) + (TR ? 0 : 16384) + lds_off(wc * 64 + i * 32 + (lane & 31), ch)); \
    }                                                                                                            \
    _Pragma("unroll") for (int i = 0; i < 2; ++i)                                                                \
      _Pragma("unroll") for (int j = 0; j < 2; ++j)                                                              \
        acc[i][j] = __builtin_amdgcn_mfma_f32_32x32x16_bf16(a[i], b[j], acc[i][j], 0, 0, 0);                    \
  }
  vsync();
  GEMM_ISSUE(0, 0)
  for (int k0 = 0; k0 < K; k0 += 128) {
    asm volatile("s_waitcnt vmcnt(0)" ::: "memory");
    vsync();
    GEMM_ISSUE(k0 + 64, 32768)
    GEMM_COMPUTE(0)
    asm volatile("s_waitcnt vmcnt(0)" ::: "memory");
    vsync();
    if (k0 + 128 < K) { GEMM_ISSUE(k0 + 128, 0) }
    GEMM_COMPUTE(32768)
  }
#undef GEMM_ISSUE
#undef GEMM_COMPUTE
  int lane2 = lane;
  asm volatile("" : "+v"(lane2));
  if constexpr (VEC) {
    typedef __attribute__((ext_vector_type(4))) float f32x4;
    vsync();
    float* wl = (float*)lds + wv * (32 * 68);
    const int hh2 = lane2 >> 5, cl = lane2 & 31;
#pragma unroll
    for (int i = 0; i < 2; ++i) {
#pragma unroll
      for (int j = 0; j < 2; ++j)
#pragma unroll
        for (int r = 0; r < 16; ++r) wl[((r & 3) + 8 * (r >> 2) + 4 * hh2) * 68 + j * 32 + cl] = acc[i][j][r];
      __builtin_amdgcn_wave_barrier();
#pragma unroll
      for (int k = 0; k < 4; ++k) {
        const int row = (lane2 >> 3) + 8 * k, c8 = (lane2 & 7) * 8;
        const f32x4 lo = *(const f32x4*)&wl[row * 68 + c8];
        const f32x4 hi = *(const f32x4*)&wl[row * 68 + c8 + 4];
        epi(wr * 64 + i * 32 + row, wc * 64 + c8, lo, hi);
      }
      __builtin_amdgcn_wave_barrier();
    }
  } else {
#pragma unroll
    for (int i = 0; i < 2; ++i)
#pragma unroll
      for (int j = 0; j < 2; ++j)
#pragma unroll
        for (int r = 0; r < 16; ++r) {
          int rr = wr * 64 + i * 32 + (r & 3) + 8 * (r >> 2) + 4 * (lane2 >> 5);
          int cc = wc * 64 + j * 32 + (lane2 & 31);
          epi(rr, cc, acc[i][j][r]);
        }
  }
}

typedef __attribute__((ext_vector_type(4))) float f32x4_e;
__device__ __forceinline__ void st_bf16x8(bf16_t* dst, f32x4_e lo, f32x4_e hi) {
  u32x4 o;
  o[0] = pack2(lo[0], lo[1]); o[1] = pack2(lo[2], lo[3]); o[2] = pack2(hi[0], hi[1]); o[3] = pack2(hi[2], hi[3]);
  *(u32x4*)dst = o;
}

__device__ __forceinline__ int lds_off32(int row, int chunk) { return row * 64 + ((chunk ^ ((row >> 2) & 3)) << 4); }

template <class Epi>
__device__ __forceinline__ void gemm_tile_big(const bf16_t* xp, int ldx, const bf16_t* yp, int ldy, int K, char* lds,
                                              Epi epi) {
  const int tid = VT(), lane = tid & 63, wv = tid >> 6;
  f32x16 acc[2][4];
#pragma unroll
  for (int i = 0; i < 2; ++i)
#pragma unroll
    for (int j = 0; j < 4; ++j)
#pragma unroll
      for (int r = 0; r < 16; ++r) acc[i][j][r] = 0.f;
  const int prow = lane >> 2, pch = lane & 3;
  const bf16_t* xs[4];
  const bf16_t* ys[2];
#pragma unroll
  for (int ps = 0; ps < 4; ++ps) {
    const int row = (wv * 4 + ps) * 16 + prow;
    xs[ps] = xp + (size_t)row * ldx + (pch ^ ((row >> 2) & 3)) * 8;
  }
#pragma unroll
  for (int ps = 0; ps < 2; ++ps) {
    const int row = (wv * 2 + ps) * 16 + prow;
    ys[ps] = yp + (size_t)row * ldy + (pch ^ ((row >> 2) & 3)) * 8;
  }
  char* const xdst = lds + wv * 4096 + lane * 16;
  char* const ydst = lds + 16384 + wv * 2048 + lane * 16;
#define BIG_ISSUE(k0, st)                                                                                                      \
  _Pragma("unroll") for (int ps = 0; ps < 4; ++ps)                                                                             \
    __builtin_amdgcn_global_load_lds((const unsigned*)(xs[ps] + (k0)), (unsigned*)(xdst + (st) + ps * 1024), 16, 0, 0);        \
  _Pragma("unroll") for (int ps = 0; ps < 2; ++ps)                                                                             \
    __builtin_amdgcn_global_load_lds((const unsigned*)(ys[ps] + (k0)), (unsigned*)(ydst + (st) + ps * 1024), 16, 0, 0);
#define DSR(dst, addr, off) asm volatile("ds_read_b128 %0, %1 offset:%2" : "=v"(dst) : "v"(addr), "i"(off) : "memory")
#define WAIT1(n, x) asm volatile("s_waitcnt lgkmcnt(" #n ")" : "+v"(x))
#define WAIT2(n, x, y) asm volatile("s_waitcnt lgkmcnt(" #n ")" : "+v"(x), "+v"(y))
#define MF(acc_, a_, b_) acc_ = __builtin_amdgcn_mfma_f32_32x32x16_bf16(a_, b_, acc_, 0, 0, 0)
#define BIG_COMPUTE(st)                                                                                   \
  {                                                                                                       \
    bf16x8 a00, a01, a10, a11, b00, b01, b02, b03, b10, b11, b12, b13;                                    \
    const unsigned aa0 = abase0 + (st), aa1 = abase1 + (st), bb0 = bbase0 + (st), bb1 = bbase1 + (st);    \
    DSR(a00, aa0, 0); DSR(b00, bb0, 0); DSR(b01, bb0, 2048); DSR(b02, bb0, 4096); DSR(b03, bb0, 6144);    \
    DSR(a01, aa0, 2048);                                                                                  \
    DSR(a10, aa1, 0); DSR(b10, bb1, 0); DSR(b11, bb1, 2048); DSR(b12, bb1, 4096); DSR(b13, bb1, 6144);    \
    DSR(a11, aa1, 2048);                                                                                  \
    WAIT2(10, a00, b00); MF(acc[0][0], a00, b00);                                                         \
    WAIT1(9, b01); MF(acc[0][1], a00, b01);                                                               \
    WAIT1(8, b02); MF(acc[0][2], a00, b02);                                                               \
    WAIT1(7, b03); MF(acc[0][3], a00, b03);                                                               \
    WAIT1(6, a01); MF(acc[1][0], a01, b00); MF(acc[1][1], a01, b01); MF(acc[1][2], a01, b02); MF(acc[1][3], a01, b03); \
    WAIT2(4, a10, b10); MF(acc[0][0], a10, b10);                                                          \
    WAIT1(3, b11); MF(acc[0][1], a10, b11);                                                               \
    WAIT1(2, b12); MF(acc[0][2], a10, b12);                                                               \
    WAIT1(1, b13); MF(acc[0][3], a10, b13);                                                               \
    WAIT1(0, a11); MF(acc[1][0], a11, b10); MF(acc[1][1], a11, b11); MF(acc[1][2], a11, b12); MF(acc[1][3], a11, b13); \
  }
  const unsigned ldsb = (unsigned)(size_t)(__attribute__((address_space(3))) char*)lds;
  const unsigned abase0 = ldsb + lds_off32(wv * 64 + (lane & 31), 0 + (lane >> 5));
  const unsigned abase1 = ldsb + lds_off32(wv * 64 + (lane & 31), 2 + (lane >> 5));
  const unsigned bbase0 = ldsb + 16384 + lds_off32((lane & 31), 0 + (lane >> 5));
  const unsigned bbase1 = ldsb + 16384 + lds_off32((lane & 31), 2 + (lane >> 5));
  const int nsteps = K >> 5;
  vsync();
  BIG_ISSUE(0, 0)
  BIG_ISSUE(32, 24576)
  int cur = 0, nx2 = 49152;
  for (int t = 0; t < nsteps - 2; ++t) {
    asm volatile("s_waitcnt vmcnt(6)" ::: "memory");
    vsync_raw();
    BIG_ISSUE((t + 2) * 32, nx2)
    BIG_COMPUTE(cur)
    cur = (cur == 49152) ? 0 : cur + 24576;
    nx2 = (nx2 == 49152) ? 0 : nx2 + 24576;
  }
  asm volatile("s_waitcnt vmcnt(6)" ::: "memory");
  vsync_raw();
  BIG_COMPUTE(cur)
  cur = (cur == 49152) ? 0 : cur + 24576;
  asm volatile("s_waitcnt vmcnt(0)" ::: "memory");
  vsync_raw();
  BIG_COMPUTE(cur)
#undef BIG_ISSUE
#undef BIG_COMPUTE
#undef DSR
#undef WAIT1
#undef WAIT2
#undef MF
  const int lane2 = opq(lane);
  typedef __attribute__((ext_vector_type(4))) float f32x4;
  vsync();
  float* wl = (float*)lds + wv * (32 * 68);
  const int hh2 = lane2 >> 5, cl = lane2 & 31;
#pragma unroll
  for (int i = 0; i < 2; ++i)
#pragma unroll
    for (int jh = 0; jh < 2; ++jh) {
#pragma unroll
      for (int j = 0; j < 2; ++j)
#pragma unroll
        for (int r = 0; r < 16; ++r) wl[((r & 3) + 8 * (r >> 2) + 4 * hh2) * 68 + j * 32 + cl] = acc[i][jh * 2 + j][r];
      __builtin_amdgcn_wave_barrier();
#pragma unroll
      for (int k = 0; k < 4; ++k) {
        const int row = (lane2 >> 3) + 8 * k, c8 = (lane2 & 7) * 8;
        const f32x4 lo = *(const f32x4*)&wl[row * 68 + c8];
        const f32x4 hi = *(const f32x4*)&wl[row * 68 + c8 + 4];
        epi(wv * 64 + i * 32 + row, jh * 64 + c8, lo, hi);
      }
      __builtin_amdgcn_wave_barrier();
    }
}

template <class Epi>
__device__ __forceinline__ void ph_gemm_big(const bf16_t* A, int lda, const bf16_t* Wt, int ldw, int M, int N, int K,
                                            char* lds, Epi epi) {
  const int ntm = M / 256, ntn = N / 128;
  const int npm = (ntm + 7) / 8, npn = (ntn + 7) / 8;
  const int nslots = ((npm * npn * 64 + 511) / 512) * 512;
  for (int u = VB(); u < nslots; u += VG()) {
    int v = (u & 7) * 64 + ((u >> 3) & 63) + (u & ~511);
    int patch = v >> 6, w = v & 63;
    int tm = (patch % npm) * 8 + (w & 7);
    int tn = (patch / npm) * 8 + (w >> 3);
    if (tm >= ntm || tn >= ntn) continue;
    const int m0 = tm * 256, n0 = tn * 128;
    gemm_tile_big(A + (size_t)m0 * lda, lda, Wt + (size_t)n0 * ldw, ldw, K, lds,
                  [&](int r, int c, f32x4_e lo, f32x4_e hi) { epi(m0 + r, n0 + c, lo, hi); });
  }
}

template <int PM = 0, class Epi>
__device__ __forceinline__ void gemm_tile_huge(const bf16_t* xp, int ldx, const bf16_t* yp, int ldy, int K, char* lds0,
                                               Epi epi) {
  const int tid = opq(threadIdx.x), lane = tid & 63, wv = tid >> 6;
  const int wr = wv >> 2, wc = wv & 3;
  f32x16 acc[4][2];
#pragma unroll
  for (int i = 0; i < 4; ++i)
#pragma unroll
    for (int j = 0; j < 2; ++j)
#pragma unroll
      for (int r = 0; r < 16; ++r) acc[i][j][r] = 0.f;
  const int prow = lane >> 3, pch = lane & 7;
  const bf16_t* xs[4];
  const bf16_t* ys[4];
#pragma unroll
  for (int ps = 0; ps < 4; ++ps) {
    const int row = (wv * 4 + ps) * 8 + prow;
    const int c = pch ^ ((row >> 1) & 7);
    xs[ps] = xp + (size_t)row * ldx + c * 8;
    ys[ps] = yp + (size_t)row * ldy + c * 8;
  }
  char* const xdst = lds0 + wv * 4096 + lane * 16;
#define HUGE_ISSUE(k0, st)                                                                                                          \
  _Pragma("unroll") for (int ps = 0; ps < 4; ++ps) {                                                                                \
    __builtin_amdgcn_global_load_lds((const unsigned*)(xs[ps] + (k0)), (unsigned*)(xdst + (st) + ps * 1024), 16, 0, 0);             \
    __builtin_amdgcn_global_load_lds((const unsigned*)(ys[ps] + (k0)), (unsigned*)(xdst + (st) + 32768 + ps * 1024), 16, 0, 0);     \
  }
#define HDSR(dst, addr, off) asm volatile("ds_read_b128 %0, %1 offset:%2" : "=v"(dst) : "v"(addr), "i"(off) : "memory")
#define HREAD(S, ab, bb)                                                                            \
  HDSR(S##a0, ab, 0); HDSR(S##b0, bb, 0); HDSR(S##b1, bb, 4096); HDSR(S##a1, ab, 4096);             \
  HDSR(S##a2, ab, 8192); HDSR(S##a3, ab, 12288);
#define HWAIT(n, S)                                                                                 \
  asm volatile("s_waitcnt lgkmcnt(" #n ")" : "+v"(S##a0), "+v"(S##a1), "+v"(S##a2), "+v"(S##a3), "+v"(S##b0), "+v"(S##b1))
#define HMF(i, j, S) acc[i][j] = __builtin_amdgcn_mfma_f32_32x32x16_bf16(S##a##i, S##b##j, acc[i][j], 0, 0, 0)
#define HMMA(S) HMF(0, 0, S); HMF(0, 1, S); HMF(1, 0, S); HMF(1, 1, S); HMF(2, 0, S); HMF(2, 1, S); HMF(3, 0, S); HMF(3, 1, S);
  const unsigned ldsb = (unsigned)(size_t)(LAS char*)lds0;
  const int frow = lane & 31, fh = lane >> 5;
  const unsigned ab0 = ldsb + lds_off(wr * 128 + frow, 0 + fh), ab1 = ldsb + lds_off(wr * 128 + frow, 2 + fh);
  const unsigned ab2 = ldsb + lds_off(wr * 128 + frow, 4 + fh), ab3 = ldsb + lds_off(wr * 128 + frow, 6 + fh);
  const unsigned bb0 = ldsb + 32768 + lds_off(wc * 64 + frow, 0 + fh), bb1 = ldsb + 32768 + lds_off(wc * 64 + frow, 2 + fh);
  const unsigned bb2 = ldsb + 32768 + lds_off(wc * 64 + frow, 4 + fh), bb3 = ldsb + 32768 + lds_off(wc * 64 + frow, 6 + fh);
  __syncthreads();
  if (PM != 1) { HUGE_ISSUE(0, 0) }
  unsigned st = 0;
  for (int k0 = 0; k0 < K; k0 += 64) {
    asm volatile("s_waitcnt vmcnt(0)" ::: "memory");
    __syncthreads();
    if (PM != 1 && k0 + 64 < K) { HUGE_ISSUE(k0 + 64, st ^ 65536u) }
    if (PM != 2) {
      bf16x8 Ea0, Ea1, Ea2, Ea3, Eb0, Eb1, Oa0, Oa1, Oa2, Oa3, Ob0, Ob1;
      const unsigned a0 = ab0 + st, a1 = ab1 + st, a2 = ab2 + st, a3 = ab3 + st;
      const unsigned b0 = bb0 + st, b1 = bb1 + st, b2 = bb2 + st, b3 = bb3 + st;
      HREAD(E, a0, b0)
      HREAD(O, a1, b1)
      HWAIT(6, E); HMMA(E)
      HREAD(E, a2, b2)
      HWAIT(6, O); HMMA(O)
      HREAD(O, a3, b3)
      HWAIT(6, E); HMMA(E)
      HWAIT(0, O); HMMA(O)
    }
    st ^= 65536u;
  }
#undef HUGE_ISSUE
#undef HDSR
#undef HREAD
#undef HWAIT
#undef HMF
#undef HMMA
  const int lane2 = opq(lane);
  typedef __attribute__((ext_vector_type(4))) float f32x4;
  __syncthreads();
  float* wl = (float*)lds0 + wv * (32 * 68);
  const int hh2 = lane2 >> 5, cl = lane2 & 31;
#pragma unroll
  for (int i = 0; i < 4; ++i) {
#pragma unroll
    for (int j = 0; j < 2; ++j)
#pragma unroll
      for (int r = 0; r < 16; ++r) wl[((r & 3) + 8 * (r >> 2) + 4 * hh2) * 68 + j * 32 + cl] = acc[i][j][r];
    __builtin_amdgcn_wave_barrier();
#pragma unroll
    for (int k = 0; k < 4; ++k) {
      const int row = (lane2 >> 3) + 8 * k, c8 = (lane2 & 7) * 8;
      const f32x4 lo = *(const f32x4*)&wl[row * 68 + c8];
      const f32x4 hi = *(const f32x4*)&wl[row * 68 + c8 + 4];
      if (PM != 3) epi(wr * 128 + i * 32 + row, wc * 64 + c8, lo, hi);
    }
    __builtin_amdgcn_wave_barrier();
  }
  __syncthreads();
}

template <class Epi>
__device__ __forceinline__ void ph_gemm_huge(const bf16_t* A, int lda, const bf16_t* Wt, int ldw, int M, int N, int K,
                                             char* lds0, Epi epi) {
  const int ntm = M / 256, ntn = N / 256;
  for (int u = (int)blockIdx.x; u < ntm * ntn; u += (int)gridDim.x) {
    const int x = u & 7, i = (u >> 3) & 31, rnd = u >> 8;
    const int tm = (x & 3) * 8 + (i & 7), tn = rnd * 8 + (x >> 2) * 4 + (i >> 3);
    if (tm >= ntm || tn >= ntn) continue;
    const int m0 = tm * 256, n0 = tn * 256;
    gemm_tile_huge(A + (size_t)m0 * lda, lda, Wt + (size_t)n0 * ldw, ldw, K, lds0,
                   [&](int r, int c, f32x4_e lo, f32x4_e hi) { epi(m0 + r, n0 + c, lo, hi); });
  }
}

__device__ __forceinline__ void norm_feed(const f32x4_e h0, const f32x4_e h1, const float* gain, int n, bf16_t* hn_row,
                                          float* rowss_m) {
  const f32x4_e g0 = *(const f32x4_e*)(gain + n), g1 = *(const f32x4_e*)(gain + n + 4);
  st_bf16x8(hn_row + n, h0 * g0, h1 * g1);
  float ss = h0[0] * h0[0] + h0[1] * h0[1] + h0[2] * h0[2] + h0[3] * h0[3] + h1[0] * h1[0] + h1[1] * h1[1] + h1[2] * h1[2] + h1[3] * h1[3];
  ss += __shfl_xor(ss, 1);
  ss += __shfl_xor(ss, 2);
  ss += __shfl_xor(ss, 4);
  if (((VT()) & 7) == 0) atomicAdd(rowss_m, ss);
}

template <bool VEC = false, class Epi>
__device__ __forceinline__ void ph_gemm_bf16(const bf16_t* A, int lda, const bf16_t* Wt, int ldw, int M, int N, int K,
                                             char* lds, Epi epi, int vblock = -2) {
  const int ntm = M / 128, ntn = N / 128;
  const int npm = (ntm + 7) / 8, npn = (ntn + 7) / 8;
  const int nslots = ((npm * npn * 64 + 511) / 512) * 512;
  if (vblock == -1) return;
  for (int u = (vblock >= 0 ? vblock : VB()); u < nslots; u += VG()) {
    int v = (u & 7) * 64 + ((u >> 3) & 63) + (u & ~511);
    int patch = v >> 6, w = v & 63;
    int tm = (patch % npm) * 8 + (w & 7);
    int tn = (patch / npm) * 8 + (w >> 3);
    if (tm >= ntm || tn >= ntn) continue;
    const int m0 = tm * 128, n0 = tn * 128;
    if constexpr (VEC)
      gemm_tile_bf16<false, true>(A + (size_t)m0 * lda, lda, Wt + (size_t)n0 * ldw, ldw, K, lds,
                                  [&](int r, int c, f32x4_e lo, f32x4_e hi) { epi(m0 + r, n0 + c, lo, hi); });
    else
      gemm_tile_bf16<false>(A + (size_t)m0 * lda, lda, Wt + (size_t)n0 * ldw, ldw, K, lds,
                            [&](int r, int c, float val) { epi(m0 + r, n0 + c, val); });
  }
}

__device__ __forceinline__ void ph_proj(const P& p, char* lds0, char* lds) {
  for (int u = (int)blockIdx.x; u < 512; u += (int)gridDim.x) {
    const int x = u & 7, i = (u >> 3) & 31, rnd = u >> 8;
    const int tm = (x & 3) * 8 + (i & 7), tp = rnd * 8 + (x >> 2) * 4 + (i >> 3);
    const int tb = tp * 2;
    const int tn = (tb < 14) ? tb : (tb < 16) ? tb + 2 : tb + 4;
    const int m0 = tm * 256, n0 = tn * 128;
    const int b = m0 >> 11, sl = m0 & 2047;
    const bf16_t* A = p.hn + (size_t)m0 * DM;
    const bf16_t* W = p.WinT + (size_t)n0 * DM;
    if (n0 < 1024 || (n0 >= 2560 && n0 < 3584)) {
      bf16_t* dst = (n0 < 1024) ? p.qn + (size_t)m0 * 1024 + n0 : p.qsb + (size_t)m0 * 1024 + (n0 - 2560);
      gemm_tile_huge(A, DM, W, DM, DM, lds0, [&](int r, int c, f32x4_e lo, f32x4_e hi) { st_bf16x8(dst + (size_t)r * 1024 + c, lo, hi); });
    } else if (n0 < 2560) {
      const int seg = (n0 - 1024) >> 8;
      bf16_t* base = (seg == 0) ? p.kcin : (seg == 1) ? p.vcin : (seg == 2) ? p.ks : p.kw;
      bf16_t* dst = base + ((size_t)(b * 2) * SEQ + sl) * 128;
      gemm_tile_huge(A, DM, W, DM, DM, lds0, [&](int r, int c, f32x4_e lo, f32x4_e hi) {
        st_bf16x8(dst + ((size_t)(c >> 7) * SEQ + r) * 128 + (c & 127), lo, hi); });
    } else {
      bf16_t* dst = p.ksb + ((size_t)(b * 8 + ((n0 - 3584) >> 7)) * SEQ + sl) * 128;
      gemm_tile_huge(A, DM, W, DM, DM, lds0, [&](int r, int c, f32x4_e lo, f32x4_e hi) {
        st_bf16x8(dst + ((size_t)(c >> 7) * SEQ + r) * 128 + (c & 127), lo, hi); });
    }
  }
  for (int u = (int)blockIdx.x; u < 192; u += (int)gridDim.x) {
    const int tm = u & 31, tv = u >> 5;
    const int n0 = (tv == 0) ? 1792 : (tv == 1) ? 2304 : 4608 + (tv - 2) * 256;
    const int m0 = tm * 256;
    const int b = m0 >> 11, sl = m0 & 2047;
    bf16_t* vd;
    if (tv < 2) vd = (tv == 0 ? p.vsT : p.vwT) + ((size_t)(b * 2) * 128) * SEQ + sl;
    else vd = p.vsbT + ((size_t)(b * 8 + (tv - 2) * 2) * 128) * SEQ + sl;
    gemm_tile_huge(p.WinT + (size_t)n0 * DM, DM, p.hn + (size_t)m0 * DM, DM, DM, lds0,
                   [&](int r, int c, f32x4_e lo, f32x4_e hi) {
                     bf16_t* row = vd + (size_t)r * SEQ;
                     uint2 wa, wb;
                     wa.x = pack2(lo[0], lo[1]); wa.y = pack2(lo[2], lo[3]);
                     wb.x = pack2(hi[0], hi[1]); wb.y = pack2(hi[2], hi[3]);
                     const int pa = (c & 8) ? c - 4 : c, pb = (c & 8) ? c + 4 : c + 8;
                     *(uint2*)(row + pa) = wa;
                     *(uint2*)(row + pb) = wb; });
  }
  {
    const int vb = VB();
    if (VG() != 512 || vb >= 448) {
      for (int tm = (VG() == 512) ? vb - 448 : vb; tm < 64; tm += (VG() == 512) ? 64 : VG()) {
        const int m0 = tm * 128;
        float* gd = p.gates + (size_t)m0 * 24;
        gemm_tile_bf16<false>(p.hn + (size_t)m0 * DM, DM, p.WinT + (size_t)5632 * DM, DM, DM, lds,
                              [&](int r, int c, float val) { if (c < 24) gd[(size_t)r * 24 + c] = val; });
      }
    }
  }
}

__device__ __forceinline__ void ph_posb(const P& p) {
  const int lane = VT() & 63, wv = VT() >> 6;
  for (int o = VB() * 4 + wv; o < 256; o += VG() * 4) {
    const int which = o >> 7, n = o & 127;
    const float* pos = which ? p.pos_v : p.pos_k;
    const float* w1 = which ? p.w1_v : p.w1_k;
    float acc = 0.f;
    for (int k = lane; k < 4096; k += 64) acc += pos[k] * w1[(size_t)k * 128 + n];
    acc = wave_sum(acc);
    if (lane == 0) p.posb[o] = acc;
  }
}

__device__ __forceinline__ void ph_compress2(const P& p, char* lds) {
  for (int item = VB(); item < 16; item += VG()) {
    const int which = item >> 3, bg = item & 7;
    const bf16_t* src = (which ? p.vcin : p.kcin) + (size_t)bg * SEQ * 128;
    const bf16_t* w1t = p.w1T + (size_t)which * 128 * 4096;
    const bf16_t* w2t = p.w2T + (size_t)which * 128 * 128;
    const float* posb = p.posb + which * 128;
    bf16_t* c1 = p.c1 + (size_t)item * 128 * 128;
    gemm_tile_bf16<false>(src, 2048, w1t, 4096, 4096, lds, [&](int r, int c, float val) {
      c1[r * 128 + c] = f2bf(gelu_fast(val + posb[c])); });
    __threadfence_block();
    vsync();
    if (which == 0) {
      bf16_t* kd = p.kcb + (size_t)bg * 128 * 128;
      gemm_tile_bf16<false>(c1, 128, w2t, 128, 128, lds, [&](int r, int c, float val) { kd[r * 128 + c] = f2bf(val); });
    } else {
      bf16_t* vd = p.vcT + (size_t)bg * 128 * 128;
      gemm_tile_bf16<true>(c1, 128, w2t, 128, 128, lds, [&](int r, int c, float val) { vd[r * 128 + perm16(c)] = f2bf(val); });
    }
  }
}

#define NEG_BIG (-1e30f)

struct KVRegs { u32x4 k0, k1, k2, k3, v0, v1, v2, v3; };

__device__ __forceinline__ int koff(int row, int chunk) { return row * 256 + ((chunk ^ (row & 15)) << 4); }

__device__ __forceinline__ void kv_load(KVRegs& r, const bf16_t* kp, int ldk, const bf16_t* vp, int ldv) {
  const int tid = VT();
  const bf16_t* kg = kp + (size_t)(tid >> 4) * ldk + (tid & 15) * 8;
  r.k0 = *(const u32x4*)kg;
  r.k1 = *(const u32x4*)(kg + (size_t)16 * ldk);
  r.k2 = *(const u32x4*)(kg + (size_t)32 * ldk);
  r.k3 = *(const u32x4*)(kg + (size_t)48 * ldk);
  const bf16_t* vg = vp + (size_t)(tid >> 3) * ldv + (tid & 7) * 8;
  r.v0 = *(const u32x4*)vg;
  r.v1 = *(const u32x4*)(vg + (size_t)32 * ldv);
  r.v2 = *(const u32x4*)(vg + (size_t)64 * ldv);
  r.v3 = *(const u32x4*)(vg + (size_t)96 * ldv);
}
__device__ __forceinline__ void kv_store(const KVRegs& r, char* lk, char* lv) {
  const int tid = VT();
  const int row = tid >> 4, ch = tid & 15;
  *(u32x4*)(lk + koff(row, ch)) = r.k0;
  *(u32x4*)(lk + koff(row + 16, ch)) = r.k1;
  *(u32x4*)(lk + koff(row + 32, ch)) = r.k2;
  *(u32x4*)(lk + koff(row + 48, ch)) = r.k3;
  const int vr = tid >> 3, vc = tid & 7;
  *(u32x4*)(lv + lds_off(vr, vc)) = r.v0;
  *(u32x4*)(lv + lds_off(vr + 32, vc)) = r.v1;
  *(u32x4*)(lv + lds_off(vr + 64, vc)) = r.v2;
  *(u32x4*)(lv + lds_off(vr + 96, vc)) = r.v3;
}

struct QFrag { bf16x8 f0, f1, f2, f3, f4, f5, f6, f7; };
__device__ __forceinline__ void q_load(QFrag& q, const bf16_t* qrow) {
  const int h = (VT() & 63) >> 5;
  const bf16x8* p8 = (const bf16x8*)(qrow + 8 * h);
  q.f0 = p8[0]; q.f1 = p8[2]; q.f2 = p8[4]; q.f3 = p8[6]; q.f4 = p8[8]; q.f5 = p8[10]; q.f6 = p8[12]; q.f7 = p8[14];
}

__device__ __forceinline__ void qk_tile(const QFrag& q, const char* lk, f32x16& s0, f32x16& s1) {
  const int lane = VT() & 63, row = lane & 31, h = lane >> 5;
#pragma unroll
  for (int r = 0; r < 16; ++r) { s0[r] = 0.f; s1[r] = 0.f; }
#define QK_STEP(kk, qf)                                                                  \
  {                                                                                      \
    bf16x8 a0 = *(const bf16x8*)(lk + koff(row, 2 * (kk) + h));                          \
    bf16x8 a1 = *(const bf16x8*)(lk + koff(row + 32, 2 * (kk) + h));                     \
    s0 = __builtin_amdgcn_mfma_f32_32x32x16_bf16(a0, qf, s0, 0, 0, 0);                   \
    s1 = __builtin_amdgcn_mfma_f32_32x32x16_bf16(a1, qf, s1, 0, 0, 0);                   \
  }
  QK_STEP(0, q.f0) QK_STEP(1, q.f1) QK_STEP(2, q.f2) QK_STEP(3, q.f3)
  QK_STEP(4, q.f4) QK_STEP(5, q.f5) QK_STEP(6, q.f6) QK_STEP(7, q.f7)
#undef QK_STEP
}

__device__ __forceinline__ bf16x8 pack8(const f32x16& p, const int base) {
  u32x4 u;
  u[0] = pack2(p[base + 0], p[base + 1]);
  u[1] = pack2(p[base + 2], p[base + 3]);
  u[2] = pack2(p[base + 4], p[base + 5]);
  u[3] = pack2(p[base + 6], p[base + 7]);
  return __builtin_bit_cast(bf16x8, u);
}

typedef __attribute__((ext_vector_type(2))) unsigned u32x2_t;
__device__ __forceinline__ float xhalf_max(float v) {
  const u32x2_t r = __builtin_amdgcn_permlane32_swap(__float_as_uint(v), __float_as_uint(v), false, false);
  return fmaxf(__uint_as_float(r[0]), __uint_as_float(r[1]));
}
__device__ __forceinline__ float xhalf_sum(float v) {
  const u32x2_t r = __builtin_amdgcn_permlane32_swap(__float_as_uint(v), __float_as_uint(v), false, false);
  return __uint_as_float(r[0]) + __uint_as_float(r[1]);
}
__device__ __forceinline__ float xhalf_get(float v, int hh) {
  const u32x2_t r = __builtin_amdgcn_permlane32_swap(__float_as_uint(v), __float_as_uint(v), false, false);
  return hh ? __uint_as_float(r[0]) : __uint_as_float(r[1]);
}
struct OAcc { f32x16 o0, o1, o2, o3; };
__device__ __forceinline__ void oacc_zero(OAcc& o) {
#pragma unroll
  for (int r = 0; r < 16; ++r) { o.o0[r] = 0.f; o.o1[r] = 0.f; o.o2[r] = 0.f; o.o3[r] = 0.f; }
}
__device__ __forceinline__ void oacc_scale(OAcc& o, float a) {
#pragma unroll
  for (int r = 0; r < 16; ++r) { o.o0[r] *= a; o.o1[r] *= a; o.o2[r] *= a; o.o3[r] *= a; }
}

__device__ __forceinline__ void pv_tile(OAcc& o, const char* lv, const f32x16& p0, const f32x16& p1) {
  const int lane = VT() & 63, row = lane & 31, h = lane >> 5;
  const bf16x8 pf0 = pack8(p0, 0), pf1 = pack8(p0, 8), pf2 = pack8(p1, 0), pf3 = pack8(p1, 8);
#define PV_ROW(dd, acc)                                                                                      \
  {                                                                                                          \
    acc = __builtin_amdgcn_mfma_f32_32x32x16_bf16(*(const bf16x8*)(lv + lds_off(32 * (dd) + row, 0 + h)), pf0, acc, 0, 0, 0); \
    acc = __builtin_amdgcn_mfma_f32_32x32x16_bf16(*(const bf16x8*)(lv + lds_off(32 * (dd) + row, 2 + h)), pf1, acc, 0, 0, 0); \
    acc = __builtin_amdgcn_mfma_f32_32x32x16_bf16(*(const bf16x8*)(lv + lds_off(32 * (dd) + row, 4 + h)), pf2, acc, 0, 0, 0); \
    acc = __builtin_amdgcn_mfma_f32_32x32x16_bf16(*(const bf16x8*)(lv + lds_off(32 * (dd) + row, 6 + h)), pf3, acc, 0, 0, 0); \
  }
  PV_ROW(0, o.o0) PV_ROW(1, o.o1) PV_ROW(2, o.o2) PV_ROW(3, o.o3)
#undef PV_ROW
}

typedef __attribute__((ext_vector_type(2))) float f32x2_s;
#define SPAIR(v, i) __builtin_shufflevector(v, v, (i), (i) + 1)
__device__ __forceinline__ void softmax_tile(f32x16& s0, f32x16& s1, float& m, float& l, OAcc& o, const float sc = 1.f,
                                             const float bb = 0.f) {
  float mr = -INFINITY;
#pragma unroll
  for (int r = 0; r < 16; ++r) mr = fmaxf(mr, fmaxf(s0[r], s1[r]));
  float mx = fmaf(mr, sc, bb);
  mx = (mx != mx) ? -INFINITY : mx;
  mx = xhalf_max(fmaxf(mx, NEG_BIG));
  const float mn = fmaxf(m, mx);
  const float alpha = __builtin_amdgcn_exp2f(m - mn);
  const f32x2_s sc2 = {sc, sc}, c2 = {bb - mn, bb - mn};
  f32x2_s ls2 = {0.f, 0.f};
#pragma unroll
  for (int r = 0; r < 16; r += 2) {
    const f32x2_s pa_in = {s0[r], s0[r + 1]}, pb_in = {s1[r], s1[r + 1]};
    const f32x2_s a = __builtin_elementwise_fma(pa_in, sc2, c2);
    const f32x2_s b = __builtin_elementwise_fma(pb_in, sc2, c2);
    const float a0 = __builtin_amdgcn_exp2f(a[0]), a1 = __builtin_amdgcn_exp2f(a[1]);
    const float b0 = __builtin_amdgcn_exp2f(b[0]), b1 = __builtin_amdgcn_exp2f(b[1]);
    s0[r] = a0; s0[r + 1] = a1; s1[r] = b0; s1[r + 1] = b1;
    const f32x2_s pa = {a0, a1}, pb = {b0, b1};
    ls2 = ls2 + pa + pb;
  }
  const float ls = xhalf_sum(ls2[0] + ls2[1]);
  l = l * alpha + ls;
  m = mn;
  if (__any(alpha != 1.f)) oacc_scale(o, alpha);
}

template <class F>
__device__ __forceinline__ void oacc_foreach(const OAcc& o, F f) {
  const int h = (VT() & 63) >> 5;
#pragma unroll
  for (int rho = 0; rho < 4; ++rho) {
    f(0 + 8 * rho + 4 * h, o.o0[4 * rho], o.o0[4 * rho + 1], o.o0[4 * rho + 2], o.o0[4 * rho + 3]);
    f(32 + 8 * rho + 4 * h, o.o1[4 * rho], o.o1[4 * rho + 1], o.o1[4 * rho + 2], o.o1[4 * rho + 3]);
    f(64 + 8 * rho + 4 * h, o.o2[4 * rho], o.o2[4 * rho + 1], o.o2[4 * rho + 2], o.o2[4 * rho + 3]);
    f(96 + 8 * rho + 4 * h, o.o3[4 * rho], o.o3[4 * rho + 1], o.o3[4 * rho + 2], o.o3[4 * rho + 3]);
  }
}

__device__ __forceinline__ void memattn_item(const P& p, char* lds, int item) {
  char* lk = lds;
  char* lv = lds + 16384;
  const int lane = VT() & 63, wv = VT() >> 6;
  {
    const int tb = item % (SEQ / 128);
    const int bh = item / (SEQ / 128);
    const int b = bh >> 2, hd = bh & 3;
    const int t = tb * 128 + wv * 32 + (lane & 31);
    QFrag q;
    q_load(q, p.qmemb + (size_t)(b * SEQ + t) * 512 + hd * 128);
    const bf16_t* kb = p.kmemb + (size_t)bh * 256 * 128;
    const bf16_t* vb = p.vmemT + (size_t)bh * 128 * 256;
    OAcc o;
    oacc_zero(o);
    float m = NEG_BIG, l = 0.f;
    KVRegs kv;
    kv_load(kv, kb, 128, vb, 256);
#pragma unroll 1
    for (int ti = 0; ti < 4; ++ti) {
      vsync();
      kv_store(kv, lk, lv);
      vsync();
      {
        const int tn = (ti + 1 < 4) ? ti + 1 : 3;
        kv_load(kv, kb + (size_t)tn * 64 * 128, 128, vb + tn * 64, 256);
      }
      f32x16 s0, s1;
      qk_tile(q, lk, s0, s1);
      softmax_tile(s0, s1, m, l, o, ATT_SCALE2, 0.f);
      pv_tile(o, lv, s0, s1);
    }
    const float il = 1.f / l;
    const int t2 = tb * 128 + (VT() >> 6) * 32 + (VT() & 31);
    bf16_t* orow = p.omem + (size_t)(b * SEQ + t2) * 512 + hd * 128;
    oacc_foreach(o, [&](int d, float v0, float v1, float v2, float v3) {
      uint2 u;
      u.x = pack2(v0 * il, v1 * il);
      u.y = pack2(v2 * il, v3 * il);
      *(uint2*)(orow + d) = u;
    });
  }
}

__device__ __forceinline__ void ph_memq_attn(const P& p, char* lds, int vblock, int nvb) {
  if (vblock < 0) return;
  const float* rss = p.rowss;
  for (int u = vblock; u < 64 * 4; u += nvb) {
    const int tm = u & 63, hd = u >> 6;
    const int m0 = tm * 128;
    bf16_t* qd = p.qmemb + (size_t)m0 * 512 + hd * 128;
    gemm_tile_bf16<false, true>(p.hn + (size_t)m0 * DM, DM, p.WmqT + (size_t)hd * 128 * DM, DM, DM, lds,
                                [&](int r, int c, f32x4_e lo, f32x4_e hi) {
                                  const float rs = rsqrtf(rss[m0 + r] * (1.f / DM) + RMS_EPS);
                                  st_bf16x8(qd + (size_t)r * 512 + c, lo * rs, hi * rs); });
    __threadfence_block();
    vsync();
    memattn_item(p, lds, ((m0 >> 11) * 4 + hd) * (SEQ / 128) + ((m0 & 2047) >> 7));
  }
}

template <bool CHK>
__device__ __forceinline__ void sb_pass1(f32x16& z, f32x16& l, const int s_first, const int t) {
  const f32x2_s sc2 = {ATT_SCALE2, ATT_SCALE2}, one2 = {1.f, 1.f};
#pragma unroll
  for (int r = 0; r < 16; r += 2) {
    const f32x2_s zin = {z[r], z[r + 1]};
    const f32x2_s zz = zin * sc2;
    const f32x2_s ee = {__builtin_amdgcn_exp2f(-fabsf(zz[0])), __builtin_amdgcn_exp2f(-fabsf(zz[1]))};
    const f32x2_s tt = ee + one2;
    const f32x2_s lg = {__builtin_amdgcn_logf(tt[0]), __builtin_amdgcn_logf(tt[1])};
    const f32x2_s mn = {fminf(zz[0], 0.f), fminf(zz[1], 0.f)};
    const f32x2_s lf = (mn - lg) - zz;
    if (CHK) {
      const int so = s_first + 8 * (r >> 2) + (r & 3);
      const bool v0 = so < t, v1 = so + 1 < t;
      l[r] = v0 ? lf[0] : 0.f; l[r + 1] = v1 ? lf[1] : 0.f;
      z[r] = v0 ? zz[0] : NEG_BIG; z[r + 1] = v1 ? zz[1] : NEG_BIG;
    } else {
      l[r] = lf[0]; l[r + 1] = lf[1];
      z[r] = zz[0]; z[r + 1] = zz[1];
    }
  }
}
__device__ __forceinline__ void sb_pass3(f32x16& z, const f32x16& l, const float* ag) {
#pragma unroll
  for (int rho = 0; rho < 4; ++rho) {
    const float x3 = l[4 * rho + 3], x23 = x3 + l[4 * rho + 2], x123 = x23 + l[4 * rho + 1];
    const float g = ag[rho];
    const f32x2_s g2 = {g, g};
    const f32x2_s la = {l[4 * rho + 0], l[4 * rho + 1]}, lb = {l[4 * rho + 2], l[4 * rho + 3]};
    const f32x2_s za = {z[4 * rho + 0], z[4 * rho + 1]}, zb = {z[4 * rho + 2], z[4 * rho + 3]};
    const f32x2_s xa = {x123, x23}, xb = {x3, 0.f};
    const f32x2_s aa = (la + za) + (g2 + xa), ab = (lb + zb) + (g2 + xb);
    z[4 * rho + 0] = __builtin_amdgcn_exp2f(aa[0]); z[4 * rho + 1] = __builtin_amdgcn_exp2f(aa[1]);
    z[4 * rho + 2] = __builtin_amdgcn_exp2f(ab[0]); z[4 * rho + 3] = __builtin_amdgcn_exp2f(ab[1]);
  }
}

__device__ __forceinline__ void ph_sb2(const P& p, char* lds) {
  char* lk = lds;
  char* lv = lds + 16384;
  const int lane = VT() & 63, wv = VT() >> 6, hh = lane >> 5;
  const int sb_skip = (VG() > 32) ? 16 : 0;
  if (VB() < sb_skip) return;
  for (int item = VB() - sb_skip; item < NBATCH * 8 * (SEQ / 128); item += VG() - sb_skip) {
    const int tb = (SEQ / 128 - 1) - (item % (SEQ / 128));
    const int bh = item / (SEQ / 128);
    const int b = bh >> 3, hd = bh & 7;
    const int t0 = tb * 128;
    const int t = t0 + wv * 32 + (lane & 31);
    QFrag q;
    q_load(q, p.qsb + (size_t)(b * SEQ + t) * 1024 + hd * 128);
    const bf16_t* kb = p.ksb + (size_t)bh * SEQ * 128;
    const bf16_t* vb = p.vsbT + (size_t)bh * 128 * SEQ;
    OAcc o;
    oacc_zero(o);
    float carry = 0.f;
    const int jhi = (t0 >> 6) + 1;
    const int jw = (t0 + wv * 32 + 30) >> 6;
    KVRegs kv;
    kv_load(kv, kb + (size_t)jhi * 64 * 128, 128, vb + jhi * 64, SEQ);
    volatile unsigned* dflag = (volatile unsigned*)(lds + 32768);
    vsync();
    if (VT() < 4) dflag[VT()] = 0u;
    for (int j = jhi; j >= 0; --j) {
      vsync();
      if ((dflag[0] & dflag[1] & dflag[2] & dflag[3]) != 0u) break;
      kv_store(kv, lk, lv);
      vsync();
      const int jn = (j > 0) ? j - 1 : 0;
      if (j > jw) kv_load(kv, kb + (size_t)jn * 64 * 128, 128, vb + jn * 64, SEQ);
      if (j <= jw) {
        f32x16 z0, z1;
        qk_tile(q, lk, z0, z1);
        const int sbase = j * 64 + 4 * hh;
        float gt[8];
        f32x16 l0, l1;
        if (j * 64 + 63 < t0 + wv * 32) {
          sb_pass1<false>(z0, l0, sbase, t);
          sb_pass1<false>(z1, l1, sbase + 32, t);
        } else {
          sb_pass1<true>(z0, l0, sbase, t);
          sb_pass1<true>(z1, l1, sbase + 32, t);
        }
#pragma unroll
        for (int rho = 0; rho < 4; ++rho) {
          gt[rho] = (l0[4 * rho] + l0[4 * rho + 1]) + (l0[4 * rho + 2] + l0[4 * rho + 3]);
          gt[4 + rho] = (l1[4 * rho] + l1[4 * rho + 1]) + (l1[4 * rho + 2] + l1[4 * rho + 3]);
        }
        float ag[8];
        float run = 0.f;
#pragma unroll
        for (int k = 7; k >= 0; --k) {
          const float pg = xhalf_get(gt[k], hh);
          ag[k] = carry + run + (hh == 0 ? pg : 0.f);
          run += gt[k] + pg;
        }
        carry += run;
        sb_pass3(z0, l0, ag);
        sb_pass3(z1, l1, ag + 4);
        kv_load(kv, kb + (size_t)jn * 64 * 128, 128, vb + jn * 64, SEQ);
        pv_tile(o, lv, z0, z1);
        if (__all(carry < -104.f * LOG2E) && (VT() & 63) == 0) dflag[wv] = 1u;
      }
    }
    int t2 = t;
    asm volatile("" : "+v"(t2));
    bf16_t* orow = p.omix + (size_t)(b * SEQ + t2) * DM + 1024 + hd * 128;
    oacc_foreach(o, [&](int d, float v0, float v1, float v2, float v3) {
      uint2 u;
      u.x = pack2(v0, v1);
      u.y = pack2(v2, v3);
      *(uint2*)(orow + d) = u;
    });
  }
}

#define NSA_IMP 32768
#define NSA_KEYS 49152
#define NSA_SELM 53504
#define NSA_LUT 53632
__device__ __forceinline__ void ph_nsa2(const P& p, char* lds) {
  typedef __attribute__((ext_vector_type(4))) float f32x4;
  char* lk = lds;
  char* lv = lds + 16384;
  float* imp = (float*)(lds + NSA_IMP);
  float* keys = (float*)(lds + NSA_KEYS);
  unsigned* selm = (unsigned*)(lds + NSA_SELM);
  const int tid = VT(), lane = tid & 63, wv = tid >> 6, hh = lane >> 5, ql = lane & 31;
  float* lut = (float*)(lds + NSA_LUT) + wv * 128;
  for (int item = VB(); item < NBATCH * 2 * (SEQ / 32); item += VG()) {
    const int tt = (item < 256) ? (SEQ / 32 - 1) - (item % (SEQ / 32)) : (item % (SEQ / 32));
    const int bg = item / (SEQ / 32);
    const int b = bg >> 1, g = bg & 1;
    const int h = g * 4 + wv;
    const int t0 = tt * 32, tq = t0 + ql, cur = t0 >> 6;
    vsync();
    QFrag q;
    q_load(q, p.qn + (size_t)(b * SEQ + tq) * 1024 + h * 128);
    {
      const int lo = opq(lane);
      lut[lo] = p.t5[t5_bucket(lo) * 8 + h] * LOG2E;
      lut[lo + 64] = p.t5[t5_bucket(lo + 64) * 8 + h] * LOG2E;
    }
#pragma unroll
    for (int i = 0; i < 16; ++i) imp[i * 256 + tid] = 0.f;
    if (tid < 32) selm[tid] = 0u;
    const float* grow = p.gates + (size_t)(b * SEQ + tq) * 24 + h * 3;
    float* prow = p.part + (size_t)(b * SEQ + tq) * 1024 + h * 128;
    OAcc o;
    float m, l;
    KVRegs kv;
    {
      const bf16_t* kb = p.kcb + (size_t)bg * 128 * 128;
      const bf16_t* vb = p.vcT + (size_t)bg * 128 * 128;
      oacc_zero(o);
      m = NEG_BIG; l = 0.f;
      kv_load(kv, kb, 128, vb, 128);
      vsync();
      kv_store(kv, lk, lv);
      vsync();
      f32x16 x0, x1;
      qk_tile(q, lk, x0, x1);
      int tqv = tq;
      asm volatile("" : "+v"(tqv));
      tqv -= 64 * hh;
      float fsc = 1.f, fbb = 0.f;
      if (t0 >= 1152) {
        fsc = ATT_SCALE2; fbb = lut[127];
      } else {
#pragma unroll
        for (int r = 0; r < 16; ++r) {
          const int c = 8 * (r >> 2) + (r & 3);
          const int d0 = tqv - 16 * c - 31, d1 = d0 - 512;
          x0[r] = (d0 >= 0) ? x0[r] * ATT_SCALE2 + lut[min(d0, 127)] : -INFINITY;
          x1[r] = (d1 >= 0) ? x1[r] * ATT_SCALE2 + lut[min(d1, 127)] : -INFINITY;
        }
      }
      softmax_tile(x0, x1, m, l, o, fsc, fbb);
      const float m0 = m;
      pv_tile(o, lv, x0, x1);
      f32x16 z0, z1;
#pragma unroll
      for (int r = 0; r < 16; ++r) { z0[r] = 0.f; z1[r] = 0.f; }
      if (t0 >= 1024) {
        kv_load(kv, kb + 64 * 128, 128, vb + 64, 128);
        vsync();
        kv_store(kv, lk, lv);
        vsync();
        qk_tile(q, lk, z0, z1);
        asm volatile("" : "+v"(tqv));
#pragma unroll
        for (int r = 0; r < 16; ++r) {
          const int c = 64 + 8 * (r >> 2) + (r & 3);
          const int d0 = tqv - 16 * c - 31, d1 = d0 - 512;
          z0[r] = (d0 >= 0) ? z0[r] * ATT_SCALE2 + lut[min(d0, 127)] : -INFINITY;
          z1[r] = (d1 >= 0) ? z1[r] * ATT_SCALE2 + lut[min(d1, 127)] : -INFINITY;
        }
        softmax_tile(z0, z1, m, l, o);
        pv_tile(o, lv, z0, z1);
      }
      const float inv = 1.f / fmaxf(l, 1e-20f);
      const float c0 = __builtin_amdgcn_exp2f(m0 - m) * inv;
#pragma unroll
      for (int r = 0; r < 16; ++r) {
        const int c = 8 * (r >> 2) + (r & 3) + 4 * hh;
        if (x0[r] != 0.f) atomicAdd(&imp[(c) * 32 + ql], x0[r] * c0);
        if (x1[r] != 0.f) atomicAdd(&imp[(c + 32) * 32 + ql], x1[r] * c0);
        if (z0[r] != 0.f) atomicAdd(&imp[(c + 64) * 32 + ql], z0[r] * inv);
        if (z1[r] != 0.f) atomicAdd(&imp[(c + 96) * 32 + ql], z1[r] * inv);
      }
      const float gs = inv / (1.f + __expf(-grow[0]));
      oacc_foreach(o, [&](int d, float v0, float v1, float v2, float v3) {
        f32x4 u = {v0 * gs, v1 * gs, v2 * gs, v3 * gs};
        *(f32x4*)(prow + d) = u;
      });
    }
    vsync();
    {
      const int tido = opq(tid);
      const int qq = tido & 31, jg = tido >> 5;
#pragma unroll
      for (int jj = 0; jj < 4; ++jj) {
        const int j = jg * 4 + jj;
        float v = imp[(4 * j) * 32 + qq] + imp[(4 * j + 1) * 32 + qq] + imp[(4 * j + 2) * 32 + qq] + 0.5f * imp[(4 * j + 3) * 32 + qq];
        if (j > 0) v += 0.5f * imp[(4 * j - 1) * 32 + qq];
        const bool forced = (j == 0) || (j == cur) || (j == cur - 1);
        keys[qq * 33 + j] = forced ? 1e9f : ((j <= cur) ? v : -1e9f);
      }
      vsync();
      unsigned bits = 0u;
#pragma unroll
      for (int jj = 0; jj < 4; ++jj) {
        const int j = jg * 4 + jj;
        const float kj = keys[qq * 33 + j];
        int rank = 0;
        for (int i = 0; i < 32; ++i) {
          const float ki = keys[qq * 33 + i];
          rank += (ki > kj || (ki == kj && i < j)) ? 1 : 0;
        }
        if (rank < 16 && j <= cur) bits |= 1u << j;
      }
      atomicOr(&selm[qq], bits);
      vsync();
    }
    const unsigned mysel = selm[ql];
    unsigned um = mysel;
#pragma unroll
    for (int o2 = 16; o2 > 0; o2 >>= 1) um |= (unsigned)__shfl_xor((int)um, o2);
    um = (unsigned)__builtin_amdgcn_readfirstlane((int)um);
    {
      const bf16_t* kb = p.ks + (size_t)bg * SEQ * 128;
      const bf16_t* vb = p.vsT + (size_t)bg * 128 * SEQ;
      oacc_zero(o);
      m = NEG_BIG; l = 0.f;
      unsigned rem = um;
      int j = __builtin_ctz(rem);
      kv_load(kv, kb + (size_t)j * 64 * 128, 128, vb + j * 64, SEQ);
      while (rem) {
        j = __builtin_ctz(rem);
        rem &= rem - 1;
        const int jn = rem ? __builtin_ctz(rem) : j;
        vsync();
        kv_store(kv, lk, lv);
        vsync();
        f32x16 s0, s1;
        qk_tile(q, lk, s0, s1);
        const bool selq = (mysel >> j) & 1u;
        int tqv = tq;
        asm volatile("" : "+v"(tqv));
        float fsc = 1.f, fbb = 0.f;
        if (j * 64 + 63 + 113 <= t0) {
          fsc = selq ? ATT_SCALE2 : 0.f; fbb = selq ? lut[127] : -INFINITY;
        } else {
#pragma unroll
          for (int r = 0; r < 16; ++r) {
            const int d0 = tqv - (j * 64 + 8 * (r >> 2) + (r & 3) + 4 * hh), d1 = d0 - 32;
            s0[r] = (selq && d0 >= 0) ? s0[r] * ATT_SCALE2 + lut[min(d0, 127)] : -INFINITY;
            s1[r] = (selq && d1 >= 0) ? s1[r] * ATT_SCALE2 + lut[min(d1, 127)] : -INFINITY;
          }
        }
        kv_load(kv, kb + (size_t)jn * 64 * 128, 128, vb + jn * 64, SEQ);
        softmax_tile(s0, s1, m, l, o, fsc, fbb);
        pv_tile(o, lv, s0, s1);
      }
      const float gs = 1.f / (fmaxf(l, 1e-20f) * (1.f + __expf(-grow[1])));
      int qo = ql;
      asm volatile("" : "+v"(qo));
      float* pr2 = p.part + (size_t)(b * SEQ + t0 + qo) * 1024 + h * 128;
      oacc_foreach(o, [&](int d, float v0, float v1, float v2, float v3) {
        f32x4 u = *(f32x4*)(pr2 + d);
        u[0] += v0 * gs; u[1] += v1 * gs; u[2] += v2 * gs; u[3] += v3 * gs;
        *(f32x4*)(pr2 + d) = u;
      });
    }
    {
      const bf16_t* kb = p.kw + (size_t)bg * SEQ * 128;
      const bf16_t* vb = p.vwT + (size_t)bg * 128 * SEQ;
      oacc_zero(o);
      m = NEG_BIG; l = 0.f;
      int jlo = (t0 - 511) >> 6;
      if (jlo < 0) jlo = 0;
      kv_load(kv, kb + (size_t)jlo * 64 * 128, 128, vb + jlo * 64, SEQ);
      for (int j = jlo; j <= cur; ++j) {
        const int jn = (j < cur) ? j + 1 : j;
        vsync();
        kv_store(kv, lk, lv);
        vsync();
        f32x16 s0, s1;
        qk_tile(q, lk, s0, s1);
        int tqv = tq;
        asm volatile("" : "+v"(tqv));
        float wsc = 1.f, wbb = 0.f;
        if (j * 64 + 63 + 113 <= t0 && t0 + 31 - j * 64 < 512) {
          wsc = ATT_SCALE2; wbb = lut[127];
        } else {
#pragma unroll
          for (int r = 0; r < 16; ++r) {
            const int d0 = tqv - (j * 64 + 8 * (r >> 2) + (r & 3) + 4 * hh), d1 = d0 - 32;
            s0[r] = (d0 >= 0 && d0 < 512) ? s0[r] * ATT_SCALE2 + lut[min(d0, 127)] : -INFINITY;
            s1[r] = (d1 >= 0 && d1 < 512) ? s1[r] * ATT_SCALE2 + lut[min(d1, 127)] : -INFINITY;
          }
        }
        kv_load(kv, kb + (size_t)jn * 64 * 128, 128, vb + jn * 64, SEQ);
        softmax_tile(s0, s1, m, l, o, wsc, wbb);
        pv_tile(o, lv, s0, s1);
      }
      const float gs = 1.f / (fmaxf(l, 1e-20f) * (1.f + __expf(-grow[2])));
      int qo = ql;
      asm volatile("" : "+v"(qo));
      const float* pr2 = p.part + (size_t)(b * SEQ + t0 + qo) * 1024 + h * 128;
      bf16_t* orow = p.omix + (size_t)(b * SEQ + t0 + qo) * DM + h * 128;
      oacc_foreach(o, [&](int d, float v0, float v1, float v2, float v3) {
        const f32x4 u = *(const f32x4*)(pr2 + d);
        uint2 w;
        w.x = pack2(u[0] + v0 * gs, u[1] + v1 * gs);
        w.y = pack2(u[2] + v2 * gs, u[3] + v3 * gs);
        *(uint2*)(orow + d) = w;
      });
    }
  }
}

__device__ __forceinline__ void ph_cvt(const float* src, bf16_t* dst, size_t n) {
  typedef __attribute__((ext_vector_type(4))) float f32x4;
  const size_t nv = n / 8;
  for (size_t i = (size_t)VB() * 256 + VT(); i < nv; i += (size_t)VG() * 256) {
    const f32x4 a = ((const f32x4*)src)[2 * i], b = ((const f32x4*)src)[2 * i + 1];
    u32x4 o;
    o[0] = pack2(a[0], a[1]); o[1] = pack2(a[2], a[3]); o[2] = pack2(b[0], b[1]); o[3] = pack2(b[2], b[3]);
    ((u32x4*)dst)[i] = o;
  }
}

__device__ __forceinline__ void ph_scores(const P& p, char* lds) {
  for (int u = VB(); u < 64 * 16; u += VG()) {
    const int tm = u & 63, hp = u >> 6;
    const int m0 = tm * 128;
    float* sc = p.scores + (size_t)m0 * DM + hp * 128;
    gemm_tile_bf16<false>(p.omix + (size_t)m0 * DM + hp * 128, DM, p.subkb + (size_t)hp * 128 * 128, 128, 128, lds,
                          [&](int r, int c, float val) { sc[(size_t)r * DM + c] = val; });
  }
}

template <int PM = 0>
__device__ __forceinline__ void ph_qp_scores(const P& p, char* lds0, char* lds) {
  for (int u = (int)blockIdx.x; u < 32 * 8; u += (int)gridDim.x) {
    const int x = u & 7, i = (u >> 3) & 31;
    const int tm = (x & 3) * 8 + (i & 7), tn = (x >> 2) * 4 + (i >> 3);
    const int m0 = tm * 256, n0 = tn * 256;
    bf16_t* qp = p.omix + (size_t)m0 * DM + n0;
    const float* rss = p.rowss + T_TOK + m0;
    gemm_tile_huge<PM>(p.hn + (size_t)m0 * DM, DM, p.WpqT + (size_t)n0 * DM, DM, DM, lds0,
                   [&](int r, int c, f32x4_e lo, f32x4_e hi) {
                     const float rs = rsqrtf(rss[r] * (1.f / DM) + RMS_EPS);
                     st_bf16x8(qp + (size_t)r * DM + c, lo * rs, hi * rs); });
    __threadfence_block();
    __syncthreads();
    const int hf = (int)(threadIdx.x >> 8);
    const int hp = tn * 2 + hf;
    float* sc = p.scores + (size_t)m0 * DM + hp * 128;
    gemm_tile_big(qp + hf * 128, DM, p.subkb + (size_t)hp * 128 * 128, 128, 128, lds,
                  [&](int r, int c, f32x4_e lo, f32x4_e hi) {
                    *(f32x4_e*)(sc + (size_t)r * DM + c) = lo; *(f32x4_e*)(sc + (size_t)r * DM + c + 4) = hi; });
    __syncthreads();
  }
}

__device__ __forceinline__ void ph_cvt4(const float* src, unsigned char* dst, float* scales, int nrows, int wid0, int nw) {
  typedef __attribute__((ext_vector_type(4))) float f32x4;
  typedef __attribute__((ext_vector_type(2))) float f32x2;
  const int lane = VT() & 63;
  const float one = __uint_as_float((unsigned)opq(0x3F800000));
  float lev[8];
#pragma unroll
  for (int c = 0; c < 8; ++c) {
    const f32x2 q = __builtin_amdgcn_cvt_scalef32_pk_f32_fp4((unsigned)opq(c * 0x11111111), one, 0);
    lev[c] = fabsf(q[0]);
  }
  const float maxlev = lev[7];
  for (int row = wid0; row < nrows; row += nw) {
    const f32x4* s4 = (const f32x4*)(src + (size_t)row * DM) + lane * 8;
    f32x4 v[8];
    float amax = 0.f;
#pragma unroll
    for (int i = 0; i < 8; ++i) {
      v[i] = s4[i];
#pragma unroll
      for (int k = 0; k < 4; ++k) amax = fmaxf(amax, fabsf(v[i][k]));
    }
    amax = wave_max(amax);
    const float sc = (amax > 0.f) ? maxlev / amax : 1.f;
    u32x4 o;
#pragma unroll
    for (int w = 0; w < 4; ++w) {
      unsigned pk = 0u;
      pk = __builtin_amdgcn_cvt_scalef32_pk_fp4_f32(pk, v[2 * w][0] * sc, v[2 * w][1] * sc, 1.0f, 0);
      pk = __builtin_amdgcn_cvt_scalef32_pk_fp4_f32(pk, v[2 * w][2] * sc, v[2 * w][3] * sc, 1.0f, 1);
      pk = __builtin_amdgcn_cvt_scalef32_pk_fp4_f32(pk, v[2 * w + 1][0] * sc, v[2 * w + 1][1] * sc, 1.0f, 2);
      pk = __builtin_amdgcn_cvt_scalef32_pk_fp4_f32(pk, v[2 * w + 1][2] * sc, v[2 * w + 1][3] * sc, 1.0f, 3);
      o[w] = pk;
    }
    *(u32x4*)(dst + (size_t)row * 1024 + lane * 16) = o;
    if (lane == 0) scales[row] = (amax > 0.f) ? amax / maxlev : 1.f;
  }
}

__device__ __forceinline__ float wave_sum_dpp(float v) {
  typedef __attribute__((ext_vector_type(2))) unsigned u32x2_d;
  v += __builtin_bit_cast(float, __builtin_amdgcn_update_dpp(0, __builtin_bit_cast(int, v), 0xB1, 0xF, 0xF, true));
  v += __builtin_bit_cast(float, __builtin_amdgcn_update_dpp(0, __builtin_bit_cast(int, v), 0x4E, 0xF, 0xF, true));
  v += __builtin_bit_cast(float, __builtin_amdgcn_update_dpp(0, __builtin_bit_cast(int, v), 0x141, 0xF, 0xF, true));
  v += __builtin_bit_cast(float, __builtin_amdgcn_update_dpp(0, __builtin_bit_cast(int, v), 0x140, 0xF, 0xF, true));
  u32x2_d r = __builtin_amdgcn_permlane16_swap(__float_as_uint(v), __float_as_uint(v), false, false);
  v = __uint_as_float(r[0]) + __uint_as_float(r[1]);
  r = __builtin_amdgcn_permlane32_swap(__float_as_uint(v), __float_as_uint(v), false, false);
  return __uint_as_float(r[0]) + __uint_as_float(r[1]);
}
__device__ __forceinline__ float gelu_rcp(float x) {
  const float y2 = (1.5957691216057308f * LOG2E) * (x + 0.044715f * x * x * x);
  return x * __builtin_amdgcn_rcpf(1.f + __builtin_amdgcn_exp2f(-y2));
}
__device__ __forceinline__ u32x4 r4_load(const unsigned char* tab, int eid, int lane) {
  return *((const u32x4*)(tab + (size_t)eid * 1024) + lane);
}
struct XPk { f32x16 a, b; };
struct Acc32 { f32x16 a, b; };

typedef __attribute__((ext_vector_type(2))) float f32x2_t;
#define PAIR(v, i) __builtin_shufflevector(v, v, (i), (i) + 1)
#define R4_DOT_W(word, xv, base, sa, sb)                                                             \
  {                                                                                                  \
    const f32x2_t q0 = __builtin_amdgcn_cvt_scalef32_pk_f32_fp4(word, one, 0), q1 = __builtin_amdgcn_cvt_scalef32_pk_f32_fp4(word, one, 1); \
    const f32x2_t q2 = __builtin_amdgcn_cvt_scalef32_pk_f32_fp4(word, one, 2), q3 = __builtin_amdgcn_cvt_scalef32_pk_f32_fp4(word, one, 3); \
    sa = __builtin_elementwise_fma(q0, PAIR(xv, base + 0), sa); sb = __builtin_elementwise_fma(q1, PAIR(xv, base + 2), sb); \
    sa = __builtin_elementwise_fma(q2, PAIR(xv, base + 4), sa); sb = __builtin_elementwise_fma(q3, PAIR(xv, base + 6), sb); \
  }
__device__ __forceinline__ float r4_dot(const u32x4& e, const XPk& x) {
  const float one = __uint_as_float((unsigned)opq(0x3F800000));
  f32x2_t sa = {0.f, 0.f}, sb = {0.f, 0.f};
  R4_DOT_W(e[0], x.a, 0, sa, sb) R4_DOT_W(e[1], x.a, 8, sa, sb) R4_DOT_W(e[2], x.b, 0, sa, sb) R4_DOT_W(e[3], x.b, 8, sa, sb)
  sa = sa + sb;
  return sa[0] + sa[1];
}
#define R4_AXPY_P(accv, i, q)                                                                        \
  { const f32x2_t r_ = __builtin_elementwise_fma(h2, q, PAIR(accv, i)); accv[i] = r_[0]; accv[(i) + 1] = r_[1]; }
#define R4_AXPY_W(word, accv, base)                                                                  \
  {                                                                                                  \
    const f32x2_t q0 = __builtin_amdgcn_cvt_scalef32_pk_f32_fp4(word, one, 0), q1 = __builtin_amdgcn_cvt_scalef32_pk_f32_fp4(word, one, 1); \
    const f32x2_t q2 = __builtin_amdgcn_cvt_scalef32_pk_f32_fp4(word, one, 2), q3 = __builtin_amdgcn_cvt_scalef32_pk_f32_fp4(word, one, 3); \
    R4_AXPY_P(accv, base + 0, q0) R4_AXPY_P(accv, base + 2, q1) R4_AXPY_P(accv, base + 4, q2) R4_AXPY_P(accv, base + 6, q3) \
  }
__device__ __forceinline__ void r4_axpy(const u32x4& e, float hid, Acc32& acc) {
  const float one = __uint_as_float((unsigned)opq(0x3F800000));
  const f32x2_t h2 = {hid, hid};
  R4_AXPY_W(e[0], acc.a, 0) R4_AXPY_W(e[1], acc.a, 8) R4_AXPY_W(e[2], acc.b, 0) R4_AXPY_W(e[3], acc.b, 8)
}

#define INS16(K, x)                                                                                      \
  K##15 = __builtin_amdgcn_fmed3f(K##15, K##14, x); K##14 = __builtin_amdgcn_fmed3f(K##14, K##13, x);   \
  K##13 = __builtin_amdgcn_fmed3f(K##13, K##12, x); K##12 = __builtin_amdgcn_fmed3f(K##12, K##11, x);   \
  K##11 = __builtin_amdgcn_fmed3f(K##11, K##10, x); K##10 = __builtin_amdgcn_fmed3f(K##10, K##9, x);    \
  K##9 = __builtin_amdgcn_fmed3f(K##9, K##8, x); K##8 = __builtin_amdgcn_fmed3f(K##8, K##7, x);         \
  K##7 = __builtin_amdgcn_fmed3f(K##7, K##6, x); K##6 = __builtin_amdgcn_fmed3f(K##6, K##5, x);         \
  K##5 = __builtin_amdgcn_fmed3f(K##5, K##4, x); K##4 = __builtin_amdgcn_fmed3f(K##4, K##3, x);         \
  K##3 = __builtin_amdgcn_fmed3f(K##3, K##2, x); K##2 = __builtin_amdgcn_fmed3f(K##2, K##1, x);         \
  K##1 = __builtin_amdgcn_fmed3f(K##1, K##0, x); K##0 = fmaxf(K##0, x);
#define DECL16(K) float K##0 = -INFINITY, K##1 = -INFINITY, K##2 = -INFINITY, K##3 = -INFINITY, K##4 = -INFINITY, \
  K##5 = -INFINITY, K##6 = -INFINITY, K##7 = -INFINITY, K##8 = -INFINITY, K##9 = -INFINITY, K##10 = -INFINITY,   \
  K##11 = -INFINITY, K##12 = -INFINITY, K##13 = -INFINITY, K##14 = -INFINITY, K##15 = -INFINITY;
__device__ __forceinline__ float mkkey(float v, unsigned tag, unsigned mask) {
  return __uint_as_float((__float_as_uint(v) & ~mask) | tag);
}

__device__ __forceinline__ void ph_peer(const P& p, float* smem) {
  typedef __attribute__((ext_vector_type(4))) float f32x4;
  float* lists = smem;
  int* bexA = (int*)(smem + 4096);
  float* bgtA = smem + 6144;
  float* bsuA = smem + 8192;
  for (int item = VB(); item < T_TOK / 16; item += VG()) {
    const int t0 = item * 16;
    vsync();
    {
      const int tid = VT();
      const int tl = tid >> 4, hp = tid & 15;
      const f32x4* sp = (const f32x4*)(p.scores + (size_t)(t0 + tl) * DM + hp * 128);
      DECL16(k)
#pragma unroll 4
      for (int c4 = 0; c4 < 32; ++c4) {
        const f32x4 v = sp[c4];
#pragma unroll
        for (int e = 0; e < 4; ++e) {
          const float x = mkkey(v[e], 127u - (unsigned)(c4 * 4 + e), 127u);
          INS16(k, x)
        }
      }
      f32x4* lp = (f32x4*)(lists + (size_t)VT() * 16);
      f32x4 o0 = {k0, k1, k2, k3}, o1 = {k4, k5, k6, k7}, o2 = {k8, k9, k10, k11}, o3 = {k12, k13, k14, k15};
      lp[0] = o0; lp[1] = o1; lp[2] = o2; lp[3] = o3;
    }
    vsync();
    if (VT() < 128) {
      const int tid = VT();
      const int tl = tid >> 3, h = tid & 7;
      const float* la = lists + (size_t)(tl * 16 + 2 * h) * 16;
      const float* lb = la + 16;
      float av[16], bv[16];
#pragma unroll
      for (int i = 0; i < 16; ++i) {
        av[i] = __uint_as_float(__float_as_uint(la[i]) & ~127u);
        bv[i] = __uint_as_float(__float_as_uint(lb[i]) & ~127u);
      }
      DECL16(c)
#pragma unroll
      for (int i = 0; i < 16; ++i) {
#pragma unroll
        for (int j = 0; j < 16; ++j) {
          if ((i + 1) * (j + 1) <= 16) {
            const float x = mkkey(av[i] + bv[j], 255u - (unsigned)(i * 16 + j), 255u);
            INS16(c, x)
          }
        }
      }
      float cs[16] = {c0, c1, c2, c3, c4, c5, c6, c7, c8, c9, c10, c11, c12, c13, c14, c15};
      float ev[16];
      float sum = 0.f;
      const float mx = __uint_as_float(__float_as_uint(cs[0]) & ~255u);
#pragma unroll
      for (int n = 0; n < 16; ++n) {
        ev[n] = __expf(__uint_as_float(__float_as_uint(cs[n]) & ~255u) - mx);
        sum += ev[n];
      }
      const float isum = 1.f / sum;
#pragma unroll
      for (int n = 0; n < 16; ++n) {
        const unsigned cc = 255u - (__float_as_uint(cs[n]) & 255u);
        const unsigned ka = 127u - (__float_as_uint(la[cc >> 4]) & 127u);
        const unsigned kb = 127u - (__float_as_uint(lb[cc & 15u]) & 127u);
        const int eid = (int)(ka * 128u + kb);
        bexA[tl * 128 + h * 16 + n] = eid;
        bgtA[tl * 128 + h * 16 + n] = ev[n] * isum * p.sv8[eid];
        bsuA[tl * 128 + h * 16 + n] = p.su8[eid];
      }
    }
    vsync();
#pragma unroll 1
    for (int ti4 = 0; ti4 < 4; ++ti4) {
    const int lane = VT() & 63, wv = VT() >> 6;
    const int tl = wv * 4 + ti4;
    const int t = t0 + tl;
    const int* bex = bexA + tl * 128;
    const float* bgt = bgtA + tl * 128;
    const float* bsu = bsuA + tl * 128;
    XPk x;
    {
      const f32x4* s4 = (const f32x4*)(p.out + (size_t)t * DM) + lane * 8;
      const f32x4* g4 = (const f32x4*)p.norm_ffn + lane * 8;
      f32x4 a0 = s4[0], a1 = s4[1], a2 = s4[2], a3 = s4[3], a4 = s4[4], a5 = s4[5], a6 = s4[6], a7 = s4[7];
      float ss = 0.f;
#define SSQ(v) ss += v[0] * v[0] + v[1] * v[1] + v[2] * v[2] + v[3] * v[3];
      SSQ(a0) SSQ(a1) SSQ(a2) SSQ(a3) SSQ(a4) SSQ(a5) SSQ(a6) SSQ(a7)
#undef SSQ
      ss = wave_sum(ss);
      const float rs = rsqrtf(ss * (1.f / DM) + RMS_EPS);
#define XPK(dst, base, va, vb, gi)                                                    \
  {                                                                                   \
    const f32x4 ga = g4[gi], gb = g4[gi + 1];                                         \
    dst[base + 0] = bf2f(f2bf(va[0] * rs * ga[0])); dst[base + 1] = bf2f(f2bf(va[1] * rs * ga[1]));   \
    dst[base + 2] = bf2f(f2bf(va[2] * rs * ga[2])); dst[base + 3] = bf2f(f2bf(va[3] * rs * ga[3]));   \
    dst[base + 4] = bf2f(f2bf(vb[0] * rs * gb[0])); dst[base + 5] = bf2f(f2bf(vb[1] * rs * gb[1]));   \
    dst[base + 6] = bf2f(f2bf(vb[2] * rs * gb[2])); dst[base + 7] = bf2f(f2bf(vb[3] * rs * gb[3]));   \
  }
      XPK(x.a, 0, a0, a1, 0) XPK(x.a, 8, a2, a3, 2) XPK(x.b, 0, a4, a5, 4) XPK(x.b, 8, a6, a7, 6)
#undef XPK
    }
    Acc32 acc;
#pragma unroll
    for (int r = 0; r < 16; ++r) { acc.a[r] = 0.f; acc.b[r] = 0.f; }
#define SID(i) __builtin_amdgcn_readfirstlane(bex[i])
#define SFL(arr, i) __uint_as_float((unsigned)__builtin_amdgcn_readfirstlane((int)__float_as_uint(arr[i])))
    u32x4 u0 = r4_load(p.pu8, SID(0), lane), u1 = r4_load(p.pu8, SID(1), lane), u2 = r4_load(p.pu8, SID(2), lane), u3 = r4_load(p.pu8, SID(3), lane);
    u32x4 v0 = r4_load(p.pv8, SID(0), lane), v1 = r4_load(p.pv8, SID(1), lane), v2 = r4_load(p.pv8, SID(2), lane), v3 = r4_load(p.pv8, SID(3), lane);
#pragma unroll 1
    for (int e0 = 0; e0 < 128; e0 += 4) {
      float d0 = r4_dot(u0, x), d1 = r4_dot(u1, x), d2 = r4_dot(u2, x), d3 = r4_dot(u3, x);
      const int en = (e0 + 4 < 128) ? e0 + 4 : 124;
      const int i0 = SID(en), i1 = SID(en + 1), i2 = SID(en + 2), i3 = SID(en + 3);
      u0 = r4_load(p.pu8, i0, lane); u1 = r4_load(p.pu8, i1, lane); u2 = r4_load(p.pu8, i2, lane); u3 = r4_load(p.pu8, i3, lane);
      d0 = wave_sum_dpp(d0); d1 = wave_sum_dpp(d1); d2 = wave_sum_dpp(d2); d3 = wave_sum_dpp(d3);
      { const float hid = SFL(bgt, e0 + 0) * gelu_rcp(d0 * SFL(bsu, e0 + 0)); r4_axpy(v0, hid, acc); }
      { const float hid = SFL(bgt, e0 + 1) * gelu_rcp(d1 * SFL(bsu, e0 + 1)); r4_axpy(v1, hid, acc); }
      { const float hid = SFL(bgt, e0 + 2) * gelu_rcp(d2 * SFL(bsu, e0 + 2)); r4_axpy(v2, hid, acc); }
      { const float hid = SFL(bgt, e0 + 3) * gelu_rcp(d3 * SFL(bsu, e0 + 3)); r4_axpy(v3, hid, acc); }
      v0 = r4_load(p.pv8, i0, lane); v1 = r4_load(p.pv8, i1, lane); v2 = r4_load(p.pv8, i2, lane); v3 = r4_load(p.pv8, i3, lane);
    }
#undef SID
#undef SFL
    const int lane2 = opq(lane);
    f32x4* o4 = (f32x4*)(p.out + (size_t)t * DM) + lane2 * 8;
    const f32x4* g4 = (const f32x4*)p.norm_final + lane2 * 8;
    f32x4 hv[8];
    float ss = 0.f;
#pragma unroll
    for (int i = 0; i < 8; ++i) {
      hv[i] = o4[i];
#pragma unroll
      for (int k = 0; k < 4; ++k) {
        hv[i][k] += (i < 4) ? acc.a[4 * i + k] : acc.b[4 * (i - 4) + k];
        ss += hv[i][k] * hv[i][k];
      }
    }
    ss = wave_sum(ss);
    const float rs = rsqrtf(ss * (1.f / DM) + RMS_EPS);
#pragma unroll
    for (int i = 0; i < 8; ++i) {
      const f32x4 g = g4[i];
      f32x4 o;
#pragma unroll
      for (int k = 0; k < 4; ++k) o[k] = hv[i][k] * rs * g[k];
      o4[i] = o;
    }
    }
  }
}

#define XB_TMO      128
#define XB_XCNT(j)  (256  + 64 * (j))
#define XB_XSUB(j)  (1280 + 64 * (j))
#define XB_XGEN(j)  (2304 + 64 * (j))
#define XB_TOP      3328
#define XB_TOPGEN   3392
#define XCD_BAR_WORDS 3456
#define XB_SPIN_CAP (1u << 22)
__device__ __forceinline__ unsigned xb_ld(unsigned* p) { return __hip_atomic_load(p, __ATOMIC_RELAXED, __HIP_MEMORY_SCOPE_AGENT); }
__device__ __forceinline__ unsigned xb_add(unsigned* p, unsigned v) { return __hip_atomic_fetch_add(p, v, __ATOMIC_RELAXED, __HIP_MEMORY_SCOPE_AGENT); }
__device__ __forceinline__ unsigned xb_xcc_id() { return (unsigned)__builtin_amdgcn_s_getreg((3 << 11) | 20) & 0xFu; }
#define XB_SPIN(cond, bar) do { unsigned _sp = 0; while (cond) { __builtin_amdgcn_s_sleep(1); \
    if ((++_sp & 255u) == 0u) { if (xb_ld(&(bar)[XB_TMO])) break; if (_sp > XB_SPIN_CAP) { atomicAdd(&(bar)[XB_TMO], 1u); break; } } } } while (0)
struct XcdBarrier { unsigned* bar; unsigned x; volatile LAS unsigned* st; };
__device__ __forceinline__ XcdBarrier xcd_barrier_post(unsigned* bar, volatile LAS unsigned* st) {
  XcdBarrier b; b.bar = bar; b.x = xb_xcc_id(); b.st = st;
  if (threadIdx.x == 0) (void)xb_add(&bar[XB_XCNT(b.x)], 1u);
  return b;
}
__device__ __forceinline__ void xcd_barrier_complete(unsigned* bar, unsigned x, unsigned& nloc, unsigned& nx) {
  const unsigned G = gridDim.x * gridDim.y * gridDim.z;
  unsigned sum, cnt, mine, sp = 0u;
  for (;;) {
    sum = 0u; cnt = 0u; mine = 0u;
#pragma unroll
    for (unsigned j = 0; j < 16; ++j) { const unsigned c = xb_ld(&bar[XB_XCNT(j)]); sum += c; cnt += (c > 0u) ? 1u : 0u; mine = (j == x) ? c : mine; }
    if (sum == G) break;
    __builtin_amdgcn_s_sleep(1);
    if ((++sp & 255u) == 0u) { if (xb_ld(&bar[XB_TMO])) break; if (sp > XB_SPIN_CAP) { atomicAdd(&bar[XB_TMO], 1u); break; } }
  }
  nloc = mine > 0u ? mine : 1u; nx = cnt > 0u ? cnt : 1u;
}
__device__ __forceinline__ void xcd_barrier(const XcdBarrier& b) {
  asm volatile("s_waitcnt vmcnt(0)" ::: "memory");
  __syncthreads();
  if (threadIdx.x == 0) {
    unsigned* bar = b.bar;
    __builtin_amdgcn_s_waitcnt(0);
    unsigned nloc = b.st[0], nx = b.st[1];
    if (nloc == 0u) { xcd_barrier_complete(bar, b.x, nloc, nx); b.st[0] = nloc; b.st[1] = nx; }
    const unsigned old = xb_add(&bar[XB_XSUB(b.x)], 1u);
    const unsigned gen = old / nloc;
    if (old + 1u == (gen + 1u) * nloc) {
      __builtin_amdgcn_fence(__ATOMIC_RELEASE, "agent");
      asm volatile("s_waitcnt vmcnt(0)" ::: "memory");
      const unsigned og = xb_add(&bar[XB_TOP], 1u);
      const unsigned tg = og / nx;
      if (og + 1u == (tg + 1u) * nx) xb_add(&bar[XB_TOPGEN], 1u);
      else XB_SPIN(xb_ld(&bar[XB_TOPGEN]) == tg, bar);
      __builtin_amdgcn_fence(__ATOMIC_ACQUIRE, "agent");
      xb_add(&bar[XB_XGEN(b.x)], 1u);
      asm volatile("s_waitcnt vmcnt(0)" ::: "memory");
    } else {
      XB_SPIN(xb_ld(&bar[XB_XGEN(b.x)]) == gen, bar);
      __builtin_amdgcn_fence(__ATOMIC_ACQUIRE, "agent");
      asm volatile("s_waitcnt vmcnt(0)" ::: "memory");
    }
  }
  __syncthreads();
}

typedef const __attribute__((address_space(4))) P* KP;
__device__ __forceinline__ P loadP() {
#if defined(__HIP_DEVICE_COMPILE__)
  KP k = (KP)__builtin_amdgcn_kernarg_segment_ptr();
  asm volatile("" : "+s"(k));
  P p = *k;
  return p;
#else
  return P{};
#endif
}

__global__ void __launch_bounds__(512, 2) mega(P p_arg) {
  cg::grid_group grid = cg::this_grid();
  __shared__ __attribute__((aligned(16))) float smem_all[2 * 18432 + 64];
  float* smem = smem_all + (threadIdx.x >> 8) * 18432;
  char* lds = (char*)smem;
  unsigned* xbw = (unsigned*)(smem_all + 2 * 18432 + 32);
  if (threadIdx.x < 64) ((unsigned*)(smem_all + 2 * 18432))[threadIdx.x] = 0u;
  if (blockIdx.x == 0) {
    P p = loadP();
    for (int i = threadIdx.x; i < XCD_BAR_WORDS; i += 512) p.bar[i] = 0u;
  }
  __syncthreads();
  { P p = loadP(); ph_rmsnorm(p.x, p.norm_mix, p.hn, T_TOK); ph_rmsnorm(p.mem, p.norm_mkv, p.memn, 1024); }
  { P p = loadP(); ph_transpose<true>(smem, p.w_in, DM, INC, 5760, p.WinT); }
  { P p = loadP(); ph_transpose<false>(smem, p.w_mk, DM, 512, 512, p.WmkT); }
  { P p = loadP(); ph_transpose<false>(smem, p.w_mv, DM, 512, 512, p.WmvT); }
  { P p = loadP(); ph_cvt(p.subk, p.subkb, (size_t)16 * 128 * 128); }
  { P p = loadP(); ph_transpose<false>(smem, p.w1_k, 4096, 128, 128, p.w1T); }
  { P p = loadP(); ph_transpose<false>(smem, p.w1_v, 4096, 128, 128, p.w1T + 128 * 4096); }
  { P p = loadP(); ph_transpose<false>(smem, p.w2_k, 128, 128, 128, p.w2T); }
  { P p = loadP(); ph_transpose<false>(smem, p.w2_v, 128, 128, 128, p.w2T + 128 * 128); }
  { P p = loadP(); ph_posb(p); }
  { P p = loadP(); for (int i = VB() * 256 + VT(); i < 2 * T_TOK; i += VG() * 256) p.rowss[i] = 0.f; }
  grid.sync();
  XcdBarrier xb;
  { P p = loadP(); xb = xcd_barrier_post(p.bar, (volatile LAS unsigned*)xbw); }
  { P p = loadP(); ph_proj(p, (char*)smem_all, lds); }
  const int kvb = (VG() == 512) ? ((VB() >= 384 && VB() < 416) ? (VB() - 384) * 8 : -1) : -2;
  const int vvb = (VG() == 512) ? ((VB() >= 416 && VB() < 448) ? (VB() - 416) * 8 : -1) : -2;
  { P p = loadP(); bf16_t* kmem = p.kmemb;
    ph_gemm_bf16(p.memn, DM, p.WmkT, DM, 1024, 512, DM, lds, [=](int m, int n, float v) {
      kmem[((size_t)((m >> 8) * 4 + (n >> 7)) * 256 + (m & 255)) * 128 + (n & 127)] = f2bf(v); }, kvb); }
  { P p = loadP(); bf16_t* vmem = p.vmemT;
    ph_gemm_bf16(p.memn, DM, p.WmvT, DM, 1024, 512, DM, lds, [=](int m, int n, float v) {
      vmem[((size_t)((m >> 8) * 4 + (n >> 7)) * 128 + (n & 127)) * 256 + perm16(m & 255)] = f2bf(v); }, vvb); }
  xcd_barrier(xb);
  { P p = loadP(); ph_compress2(p, lds); }
  { P p = loadP(); ph_sb2(p, lds); }
  {
    const int skip = (VG() > 32) ? 16 : 0;
    const int vb = (VB() >= skip) ? VB() - skip : -1, nvb = VG() - skip;
    vsync();
    { P p = loadP(); ph_transpose<false>(smem, p.w_out, DM, DM, DM, p.WoutT, vb, nvb); }
    { P p = loadP(); ph_transpose<false>(smem, p.w_mq, DM, 512, 512, p.WmqT, vb, nvb); }
  }
  xcd_barrier(xb);
  { P p = loadP(); ph_nsa2(p, lds); }
  xcd_barrier(xb);
  { P p = loadP(); float* out = p.out; const float* x = p.x; const float* gmq = p.norm_mq; bf16_t* hn = p.hn; float* rss = p.rowss;
    ph_gemm_huge(p.omix, DM, p.WoutT, DM, T_TOK, DM, DM, (char*)smem_all, [=](int m, int n, f32x4_e lo, f32x4_e hi) {
      const f32x4_e x0 = *(const f32x4_e*)(x + (size_t)m * DM + n), x1 = *(const f32x4_e*)(x + (size_t)m * DM + n + 4);
      const f32x4_e h0 = x0 + lo, h1 = x1 + hi;
      *(f32x4_e*)(out + (size_t)m * DM + n) = h0; *(f32x4_e*)(out + (size_t)m * DM + n + 4) = h1;
      norm_feed(h0, h1, gmq, n, hn + (size_t)m * DM, rss + m); }); }
  xcd_barrier(xb);
  {
    const int half = (VG() >= 512) ? 256 : 0;
    if (half == 0 || VB() < half) { P p = loadP(); ph_memq_attn(p, lds, VB(), half ? half : VG()); }
    if (VB() >= half) {
      const int nwv = (VG() - half) * 4, wid = (VB() - half) * 4 + (VT() >> 6);
      vsync();
      { P p = loadP(); ph_transpose<false>(smem, p.w_mo, 512, DM, DM, p.WmoT, VB() - half, VG() - half); }
      { P p = loadP(); ph_cvt4(p.pu, p.pu8, p.su8, 16384, wid, nwv); }
      { P p = loadP(); ph_cvt4(p.pv, p.pv8, p.sv8, 16384, wid, nwv); }
      vsync();
      { P p = loadP(); ph_transpose<false>(smem, p.w_pq, DM, DM, DM, p.WpqT, VB() - half, VG() - half); }
    }
  }
  xcd_barrier(xb);
  { P p = loadP(); float* out = p.out; const float* gffn = p.norm_ffn; bf16_t* hn = p.hn; float* rss = p.rowss + T_TOK;
    ph_gemm_huge(p.omem, 512, p.WmoT, 512, T_TOK, DM, 512, (char*)smem_all, [=](int m, int n, f32x4_e lo, f32x4_e hi) {
      f32x4_e* o0 = (f32x4_e*)(out + (size_t)m * DM + n);
      const f32x4_e h0 = o0[0] + lo, h1 = o0[1] + hi;
      o0[0] = h0; o0[1] = h1;
      norm_feed(h0, h1, gffn, n, hn + (size_t)m * DM, rss + m); }); }
  xcd_barrier(xb);
  { P p = loadP(); ph_qp_scores<0>(p, (char*)smem_all, lds); }
  xcd_barrier(xb);
  { P p = loadP(); ph_peer(p, smem); }
}

extern "C" void kernel_launch(void* const* d_in, const int* in_sizes, int n_in, void* d_out, int out_size, void* d_ws,
                              size_t ws_size, hipStream_t stream) {
  P p{};
  p.x = (const float*)d_in[0]; p.mem = (const float*)d_in[1]; p.t5 = (const float*)d_in[2];
  p.norm_mix = (const float*)d_in[3]; p.w_in = (const float*)d_in[4]; p.pos_k = (const float*)d_in[5];
  p.w1_k = (const float*)d_in[6]; p.w2_k = (const float*)d_in[7]; p.pos_v = (const float*)d_in[8];
  p.w1_v = (const float*)d_in[9]; p.w2_v = (const float*)d_in[10]; p.w_out = (const float*)d_in[11];
  p.norm_mq = (const float*)d_in[12]; p.norm_mkv = (const float*)d_in[13]; p.w_mq = (const float*)d_in[14];
  p.w_mk = (const float*)d_in[15]; p.w_mv = (const float*)d_in[16]; p.w_mo = (const float*)d_in[17];
  p.norm_ffn = (const float*)d_in[18]; p.w_pq = (const float*)d_in[19]; p.subk = (const float*)d_in[20];
  p.pu = (const float*)d_in[21]; p.pv = (const float*)d_in[22]; p.norm_final = (const float*)d_in[23];
  p.out = (float*)d_out;
  char* w = (char*)d_ws;
  size_t off = 0;
  auto take = [&](size_t bytes) { char* r = w + off; off += (bytes + 255) & ~(size_t)255; return r; };
  p.bar = (unsigned*)take(XCD_BAR_WORDS * 4);
  p.scores = (float*)take((size_t)T_TOK * DM * 4);
  p.gates = (float*)take((size_t)T_TOK * 24 * 4);
  p.part = (float*)take((size_t)T_TOK * 1024 * 4);
  p.posb = (float*)take(256 * 4);
  p.rowss = (float*)take((size_t)2 * T_TOK * 4);
  p.qn = (bf16_t*)take((size_t)T_TOK * 1024 * 2);
  p.kcin = (bf16_t*)take((size_t)T_TOK * 256 * 2 + 65536);
  p.vcin = (bf16_t*)take((size_t)T_TOK * 256 * 2 + 65536);
  p.ks = (bf16_t*)take((size_t)T_TOK * 256 * 2);
  p.vsT = (bf16_t*)take((size_t)T_TOK * 256 * 2);
  p.kw = (bf16_t*)take((size_t)T_TOK * 256 * 2);
  p.vwT = (bf16_t*)take((size_t)T_TOK * 256 * 2);
  p.kcb = (bf16_t*)take((size_t)8 * 128 * 128 * 2);
  p.vcT = (bf16_t*)take((size_t)8 * 128 * 128 * 2);
  p.c1 = (bf16_t*)take((size_t)16 * 128 * 128 * 2);
  p.w1T = (bf16_t*)take((size_t)2 * 128 * 4096 * 2);
  p.w2T = (bf16_t*)take((size_t)2 * 128 * 128 * 2);
  p.hn = (bf16_t*)take((size_t)T_TOK * DM * 2);
  p.omix = (bf16_t*)take((size_t)T_TOK * DM * 2);
  p.memn = (bf16_t*)take((size_t)1024 * DM * 2);
  p.omem = (bf16_t*)take((size_t)T_TOK * 512 * 2);
  p.WinT = (bf16_t*)take((size_t)5760 * DM * 2);
  p.WoutT = (bf16_t*)take((size_t)DM * DM * 2);
  p.WpqT = (bf16_t*)take((size_t)DM * DM * 2);
  p.WmqT = (bf16_t*)take((size_t)512 * DM * 2);
  p.WmkT = (bf16_t*)take((size_t)512 * DM * 2);
  p.WmvT = (bf16_t*)take((size_t)512 * DM * 2);
  p.WmoT = (bf16_t*)take((size_t)DM * 512 * 2);
  p.qmemb = (bf16_t*)take((size_t)T_TOK * 512 * 2);
  p.kmemb = (bf16_t*)take((size_t)1024 * 512 * 2);
  p.vmemT = (bf16_t*)take((size_t)1024 * 512 * 2);
  p.qsb = (bf16_t*)take((size_t)T_TOK * 1024 * 2);
  p.ksb = (bf16_t*)take((size_t)T_TOK * 1024 * 2);
  p.vsbT = (bf16_t*)take((size_t)T_TOK * 1024 * 2);
  p.pu8 = (unsigned char*)take((size_t)16384 * 1024);
  p.pv8 = (unsigned char*)take((size_t)16384 * 1024);
  p.su8 = (float*)take(16384 * 4);
  p.sv8 = (float*)take(16384 * 4);
  p.subkb = (bf16_t*)take((size_t)16 * 128 * 128 * 2);
  static int grid_blocks = 0;
  if (!grid_blocks) {
    int dev = 0, cus = 0, per_cu = 0;
    (void)hipGetDevice(&dev);
    (void)hipDeviceGetAttribute(&cus, hipDeviceAttributeMultiprocessorCount, dev);
    (void)hipOccupancyMaxActiveBlocksPerMultiprocessor(&per_cu, mega, 512, 0);
    if (per_cu > 1) per_cu = 1;
    if (per_cu < 1) per_cu = 1;
    grid_blocks = cus * per_cu;
  }
  void* args[] = {&p};
  hipError_t e = hipLaunchCooperativeKernel((void*)mega, dim3(grid_blocks), dim3(512), args, 0, stream);
  if (e != hipSuccess) fprintf(stderr, "cooperative launch failed: %s (grid %d)\n", hipGetErrorString(e), grid_blocks);
}
```

```cpp
#include <hip/hip_runtime.h>
#include <hip/hip_cooperative_groups.h>
#include <cstdio>
namespace cg = cooperative_groups;
#include <stdint.h>

#define SEQ 2048
#define NBATCH 4
#define T_TOK 8192
#define DM 2048
#define INC 5656
#define C_QN 0
#define C_KC 1024
#define C_VC 1280
#define C_KS 1536
#define C_VS 1792
#define C_KW 2048
#define C_VW 2304
#define C_GT 2560
#define C_QSB 2584
#define C_KSB 3608
#define C_VSB 4632
#define ATT_SCALE 0.08838834764831845f
#define LOG2E 1.4426950408889634f
#define ATT_SCALE2 (ATT_SCALE * LOG2E)
#define RMS_EPS 1e-6f

typedef unsigned short bf16_t;
typedef __attribute__((ext_vector_type(8))) short bf16x8;
typedef __attribute__((ext_vector_type(16))) float f32x16;
typedef __attribute__((ext_vector_type(2))) __bf16 bf16v2;
typedef __attribute__((ext_vector_type(4))) unsigned u32x4;

struct P {
  const float *x, *mem, *t5, *norm_mix, *w_in, *pos_k, *w1_k, *w2_k, *pos_v, *w1_v, *w2_v, *w_out,
      *norm_mq, *norm_mkv, *w_mq, *w_mk, *w_mv, *w_mo, *norm_ffn, *w_pq, *subk, *pu, *pv, *norm_final;
  float* out;
  float *scores, *gates, *part, *posb, *rowss;
  unsigned* bar;
  bf16_t *hn, *omix, *memn, *omem;
  bf16_t *WinT, *WoutT, *WpqT, *WmqT, *WmkT, *WmvT, *WmoT;
  bf16_t *qmemb, *kmemb, *vmemT;
  bf16_t *qsb, *ksb, *vsbT;
  bf16_t* subkb;
  unsigned char *pu8, *pv8;
  float *su8, *sv8;
  bf16_t *qn, *kcin, *vcin, *ks, *vsT, *kw, *vwT, *kcb, *vcT, *c1, *w1T, *w2T;
};

__device__ __forceinline__ int opq(int v) { asm volatile("" : "+v"(v)); return v; }
#define LAS __attribute__((address_space(3)))
#define VHALF_BYTES 73728
#define VCNT_OFF (2 * VHALF_BYTES)
__device__ __forceinline__ int VT() { return opq(threadIdx.x) & 255; }
__device__ __forceinline__ int VB() { return (int)blockIdx.x * 2 + (int)(threadIdx.x >> 8); }
__device__ __forceinline__ int VG() { return (int)gridDim.x * 2; }
__device__ __forceinline__ void vbar_wait() {
  if ((threadIdx.x & 63) == 0) {
    LAS unsigned* c = (LAS unsigned*)(unsigned)(VCNT_OFF + 64 * (int)(threadIdx.x >> 8));
    const unsigned old = __hip_atomic_fetch_add(c, 1u, __ATOMIC_RELAXED, __HIP_MEMORY_SCOPE_WORKGROUP);
    const unsigned target = (old & ~3u) + 4u;
    while (__hip_atomic_load(c, __ATOMIC_RELAXED, __HIP_MEMORY_SCOPE_WORKGROUP) < target) __builtin_amdgcn_s_sleep(0);
  }
}
__device__ __forceinline__ void vsync() {
  __builtin_amdgcn_fence(__ATOMIC_RELEASE, "workgroup");
  vbar_wait();
  __builtin_amdgcn_fence(__ATOMIC_ACQUIRE, "workgroup");
}
__device__ __forceinline__ void vsync_raw() {
  asm volatile("" ::: "memory");
  vbar_wait();
  asm volatile("" ::: "memory");
}

__device__ __forceinline__ unsigned pack2(float a, float b) {
  bf16v2 r = {(__bf16)a, (__bf16)b};
  return *(unsigned*)&r;
}
__device__ __forceinline__ bf16_t f2bf(float a) {
  __bf16 r = (__bf16)a;
  return *(bf16_t*)&r;
}
__device__ __forceinline__ int perm16(int s) { return (s & ~12) | ((s & 4) << 1) | ((s & 8) >> 1); }
__device__ __forceinline__ float bf2f(bf16_t u) { return __uint_as_float((unsigned)u << 16); }

__device__ __forceinline__ float wave_max(float v) {
  for (int o = 32; o > 0; o >>= 1) v = fmaxf(v, __shfl_xor(v, o));
  return v;
}
__device__ __forceinline__ float wave_sum(float v) {
  for (int o = 32; o > 0; o >>= 1) v += __shfl_xor(v, o);
  return v;
}
__device__ __forceinline__ void wave_argmax(float& v, int& i) {
  for (int o = 32; o > 0; o >>= 1) {
    float ov = __shfl_xor(v, o);
    int oi = __shfl_xor(i, o);
    if (ov > v || (ov == v && oi < i)) { v = ov; i = oi; }
  }
}
__device__ __forceinline__ float gelu_tanh(float x) {
  return 0.5f * x * (1.f + tanhf(0.7978845608028654f * (x + 0.044715f * x * x * x)));
}
__device__ __forceinline__ float gelu_fast(float x) {
  const float y = 1.5957691216057308f * (x + 0.044715f * x * x * x);
  return x / (1.f + __expf(-y));
}
__device__ __forceinline__ int t5_bucket(int n) {
  if (n < 16) return n < 0 ? 0 : n;
  int b = 16;
  b += (n >= 19); b += (n >= 21); b += (n >= 24); b += (n >= 27); b += (n >= 31); b += (n >= 35);
  b += (n >= 40); b += (n >= 46); b += (n >= 52); b += (n >= 59); b += (n >= 67); b += (n >= 77);
  b += (n >= 87); b += (n >= 99); b += (n >= 113);
  return b;
}
__device__ __forceinline__ float log_sigmoid(float x) {
  return fminf(x, 0.f) - log1pf(expf(-fabsf(x)));
}

__device__ __forceinline__ void ph_rmsnorm(const float* src, const float* gain, bf16_t* dst, int rows) {
  int lane = VT() & 63, wv = VT() >> 6;
  for (int r = VB() * 4 + wv; r < rows; r += VG() * 4) {
    const float4* s4 = (const float4*)(src + (size_t)r * DM);
    float4 v[8];
    float ss = 0.f;
#pragma unroll
    for (int i = 0; i < 8; ++i) {
      v[i] = s4[i * 64 + lane];
      ss += v[i].x * v[i].x + v[i].y * v[i].y + v[i].z * v[i].z + v[i].w * v[i].w;
    }
    ss = wave_sum(ss);
    float rs = rsqrtf(ss * (1.f / DM) + RMS_EPS);
    uint2* d2 = (uint2*)(dst + (size_t)r * DM);
    const float4* g4 = (const float4*)gain;
#pragma unroll
    for (int i = 0; i < 8; ++i) {
      float4 g = g4[i * 64 + lane];
      uint2 o;
      o.x = pack2(v[i].x * rs * g.x, v[i].y * rs * g.y);
      o.y = pack2(v[i].z * rs * g.z, v[i].w * rs * g.w);
      d2[i * 64 + lane] = o;
    }
  }
}

template <bool CMAP>
__device__ __forceinline__ void ph_transpose(float* smem, const float* W, int K, int N, int Npad, bf16_t* Wt,
                                             int vblock = -2, int nvb = 0) {
  typedef __attribute__((ext_vector_type(4))) float f32x4;
  float (*tl)[65] = (float (*)[65])smem;
  if (vblock == -1) return;
  const int b0 = (vblock >= 0) ? vblock : VB(), bstride = (vblock >= 0) ? nvb : VG();
  const int tid = VT();
  const int nk = K / 64, nn = Npad / 64;
  for (int tile = b0; tile < nk * nn; tile += bstride) {
    const int k0 = (tile % nk) * 64, n0 = (tile / nk) * 64;
    const int kr = tid >> 4, n4 = (tid & 15) * 4;
    int sc = n0 + n4;
    if (CMAP) sc = (sc < 2560) ? sc : (sc < 5632) ? sc + 24 : (sc < 5656) ? sc - 5632 + 2560 : N;
#pragma unroll
    for (int i = 0; i < 4; ++i) {
      const int k = kr + 16 * i;
      f32x4 v = {0.f, 0.f, 0.f, 0.f};
      if (sc < N) v = *(const f32x4*)(W + (size_t)(k0 + k) * N + sc);
      tl[k][n4 + 0] = v[0]; tl[k][n4 + 1] = v[1]; tl[k][n4 + 2] = v[2]; tl[k][n4 + 3] = v[3];
    }
    vsync();
    int n = tid >> 2, kc = (tid & 3) * 16;
    unsigned w[8];
#pragma unroll
    for (int i = 0; i < 8; ++i) w[i] = pack2(tl[kc + 2 * i][n], tl[kc + 2 * i + 1][n]);
    uint4* dst = (uint4*)(Wt + (size_t)(n0 + n) * K + k0 + kc);
    dst[0] = make_uint4(w[0], w[1], w[2], w[3]);
    dst[1] = make_uint4(w[4], w[5], w[6], w[7]);
    vsync();
  }
}

__device__ __forceinline__ int lds_off(int row, int chunk) { return row * 128 + ((chunk ^ ((row >> 1) & 7)) << 4); }

template <bool TR, bool VEC = false, class Epi>
__device__ __forceinline__ void gemm_tile_bf16(const bf16_t* xp, int ldx, const bf16_t* yp, int ldy, int K, char* lds,
                                               Epi epi) {
  const int tid = VT(), lane = tid & 63, wv = tid >> 6;
  const int wr = wv >> 1, wc = wv & 1;
  f32x16 acc[2][2];
#pragma unroll
  for (int i = 0; i < 2; ++i)
#pragma unroll
    for (int j = 0; j < 2; ++j)
#pragma unroll
      for (int r = 0; r < 16; ++r) acc[i][j][r] = 0.f;
  const int prow = lane >> 3, pch = lane & 7;
  const bf16_t* xs[4];
  const bf16_t* ys[4];
#pragma unroll
  for (int ps = 0; ps < 4; ++ps) {
    const int row = (wv * 4 + ps) * 8 + prow;
    const int c = pch ^ ((row >> 1) & 7);
    xs[ps] = xp + (size_t)row * ldx + c * 8;
    ys[ps] = yp + (size_t)row * ldy + c * 8;
  }
  char* const mydst = lds + wv * 4096 + lane * 16;
#define GEMM_ISSUE(k0, bufoff)                                                                                              \
  _Pragma("unroll") for (int ps = 0; ps < 4; ++ps) {                                                                        \
    __builtin_amdgcn_global_load_lds((const unsigned*)(xs[ps] + (k0)), (unsigned*)(mydst + (bufoff) + ps * 1024), 16, 0, 0);         \
    __builtin_amdgcn_global_load_lds((const unsigned*)(ys[ps] + (k0)), (unsigned*)(mydst + (bufoff) + 16384 + ps * 1024), 16, 0, 0); \
  }
#define GEMM_COMPUTE(bufoff)                                                                                     \
  _Pragma("unroll") for (int kk = 0; kk < 4; ++kk) {                                                             \
    bf16x8 a[2], b[2];                                                                                           \
    const int ch = kk * 2 + (lane >> 5);                                                                         \
    _Pragma("unroll") for (int i = 0; i < 2; ++i) {                                                              \
      a[i] = *(const bf16x8*)(lds + (bufoff) + (TR ? 16384 : 0) + lds_off(wr * 64 + i * 32 + (lane & 31), ch)); \
      b[i] = *(const bf16x8*)(lds + (bufoff) + (TR ? 0 : 16384) + lds_off(wc * 64 + i * 32 + (lane & 31), ch)); \
    }                                                                                                            \
    _Pragma("unroll") for (int i = 0; i < 2; ++i)                                                                \
      _Pragma("unroll") for (int j = 0; j < 2; ++j)                                                              \
        acc[i][j] = __builtin_amdgcn_mfma_f32_32x32x16_bf16(a[i], b[j], acc[i][j], 0, 0, 0);                    \
  }
  vsync();
  GEMM_ISSUE(0, 0)
  for (int k0 = 0; k0 < K; k0 += 128) {
    asm volatile("s_waitcnt vmcnt(0)" ::: "memory");
    vsync();
    GEMM_ISSUE(k0 + 64, 32768)
    GEMM_COMPUTE(0)
    asm volatile("s_waitcnt vmcnt(0)" ::: "memory");
    vsync();
    if (k0 + 128 < K) { GEMM_ISSUE(k0 + 128, 0) }
    GEMM_COMPUTE(32768)
  }
#undef GEMM_ISSUE
#undef GEMM_COMPUTE
  int lane2 = lane;
  asm volatile("" : "+v"(lane2));
  if constexpr (VEC) {
    typedef __attribute__((ext_vector_type(4))) float f32x4;
    vsync();
    float* wl = (float*)lds + wv * (32 * 68);
    const int hh2 = lane2 >> 5, cl = lane2 & 31;
#pragma unroll
    for (int i = 0; i < 2; ++i) {
#pragma unroll
      for (int j = 0; j < 2; ++j)
#pragma unroll
        for (int r = 0; r < 16; ++r) wl[((r & 3) + 8 * (r >> 2) + 4 * hh2) * 68 + j * 32 + cl] = acc[i][j][r];
      __builtin_amdgcn_wave_barrier();
#pragma unroll
      for (int k = 0; k < 4; ++k) {
        const int row = (lane2 >> 3) + 8 * k, c8 = (lane2 & 7) * 8;
        const f32x4 lo = *(const f32x4*)&wl[row * 68 + c8];
        const f32x4 hi = *(const f32x4*)&wl[row * 68 + c8 + 4];
        epi(wr * 64 + i * 32 + row, wc * 64 + c8, lo, hi);
      }
      __builtin_amdgcn_wave_barrier();
    }
  } else {
#pragma unroll
    for (int i = 0; i < 2; ++i)
#pragma unroll
      for (int j = 0; j < 2; ++j)
#pragma unroll
        for (int r = 0; r < 16; ++r) {
          int rr = wr * 64 + i * 32 + (r & 3) + 8 * (r >> 2) + 4 * (lane2 >> 5);
          int cc = wc * 64 + j * 32 + (lane2 & 31);
          epi(rr, cc, acc[i][j][r]);
        }
  }
}

typedef __attribute__((ext_vector_type(4))) float f32x4_e;
__device__ __forceinline__ void st_bf16x8(bf16_t* dst, f32x4_e lo, f32x4_e hi) {
  u32x4 o;
  o[0] = pack2(lo[0], lo[1]); o[1] = pack2(lo[2], lo[3]); o[2] = pack2(hi[0], hi[1]); o[3] = pack2(hi[2], hi[3]);
  *(u32x4*)dst = o;
}

__device__ __forceinline__ int lds_off32(int row, int chunk) { return row * 64 + ((chunk ^ ((row >> 2) & 3)) << 4); }

template <class Epi>
__device__ __forceinline__ void gemm_tile_big(const bf16_t* xp, int ldx, const bf16_t* yp, int ldy, int K, char* lds,
                                              Epi epi) {
  const int tid = VT(), lane = tid & 63, wv = tid >> 6;
  f32x16 acc[2][4];
#pragma unroll
  for (int i = 0; i < 2; ++i)
#pragma unroll
    for (int j = 0; j < 4; ++j)
#pragma unroll
      for (int r = 0; r < 16; ++r) acc[i][j][r] = 0.f;
  const int prow = lane >> 2, pch = lane & 3;
  const bf16_t* xs[4];
  const bf16_t* ys[2];
#pragma unroll
  for (int ps = 0; ps < 4; ++ps) {
    const int row = (wv * 4 + ps) * 16 + prow;
    xs[ps] = xp + (size_t)row * ldx + (pch ^ ((row >> 2) & 3)) * 8;
  }
#pragma unroll
  for (int ps = 0; ps < 2; ++ps) {
    const int row = (wv * 2 + ps) * 16 + prow;
    ys[ps] = yp + (size_t)row * ldy + (pch ^ ((row >> 2) & 3)) * 8;
  }
  char* const xdst = lds + wv * 4096 + lane * 16;
  char* const ydst = lds + 16384 + wv * 2048 + lane * 16;
#define BIG_ISSUE(k0, st)                                                                                                      \
  _Pragma("unroll") for (int ps = 0; ps < 4; ++ps)                                                                             \
    __builtin_amdgcn_global_load_lds((const unsigned*)(xs[ps] + (k0)), (unsigned*)(xdst + (st) + ps * 1024), 16, 0, 0);        \
  _Pragma("unroll") for (int ps = 0; ps < 2; ++ps)                                                                             \
    __builtin_amdgcn_global_load_lds((const unsigned*)(ys[ps] + (k0)), (unsigned*)(ydst + (st) + ps * 1024), 16, 0, 0);
#define DSR(dst, addr, off) asm volatile("ds_read_b128 %0, %1 offset:%2" : "=v"(dst) : "v"(addr), "i"(off) : "memory")
#define WAIT1(n, x) asm volatile("s_waitcnt lgkmcnt(" #n ")" : "+v"(x))
#define WAIT2(n, x, y) asm volatile("s_waitcnt lgkmcnt(" #n ")" : "+v"(x), "+v"(y))
#define MF(acc_, a_, b_) acc_ = __builtin_amdgcn_mfma_f32_32x32x16_bf16(a_, b_, acc_, 0, 0, 0)
#define BIG_COMPUTE(st)                                                                                   \
  {                                                                                                       \
    bf16x8 a00, a01, a10, a11, b00, b01, b02, b03, b10, b11, b12, b13;                                    \
    const unsigned aa0 = abase0 + (st), aa1 = abase1 + (st), bb0 = bbase0 + (st), bb1 = bbase1 + (st);    \
    DSR(a00, aa0, 0); DSR(b00, bb0, 0); DSR(b01, bb0, 2048); DSR(b02, bb0, 4096); DSR(b03, bb0, 6144);    \
    DSR(a01, aa0, 2048);                                                                                  \
    DSR(a10, aa1, 0); DSR(b10, bb1, 0); DSR(b11, bb1, 2048); DSR(b12, bb1, 4096); DSR(b13, bb1, 6144);    \
    DSR(a11, aa1, 2048);                                                                                  \
    WAIT2(10, a00, b00); MF(acc[0][0], a00, b00);                                                         \
    WAIT1(9, b01); MF(acc[0][1], a00, b01);                                                               \
    WAIT1(8, b02); MF(acc[0][2], a00, b02);                                                               \
    WAIT1(7, b03); MF(acc[0][3], a00, b03);                                                               \
    WAIT1(6, a01); MF(acc[1][0], a01, b00); MF(acc[1][1], a01, b01); MF(acc[1][2], a01, b02); MF(acc[1][3], a01, b03); \
    WAIT2(4, a10, b10); MF(acc[0][0], a10, b10);                                                          \
    WAIT1(3, b11); MF(acc[0][1], a10, b11);                                                               \
    WAIT1(2, b12); MF(acc[0][2], a10, b12);                                                               \
    WAIT1(1, b13); MF(acc[0][3], a10, b13);                                                               \
    WAIT1(0, a11); MF(acc[1][0], a11, b10); MF(acc[1][1], a11, b11); MF(acc[1][2], a11, b12); MF(acc[1][3], a11, b13); \
  }
  const unsigned ldsb = (unsigned)(size_t)(__attribute__((address_space(3))) char*)lds;
  const unsigned abase0 = ldsb + lds_off32(wv * 64 + (lane & 31), 0 + (lane >> 5));
  const unsigned abase1 = ldsb + lds_off32(wv * 64 + (lane & 31), 2 + (lane >> 5));
  const unsigned bbase0 = ldsb + 16384 + lds_off32((lane & 31), 0 + (lane >> 5));
  const unsigned bbase1 = ldsb + 16384 + lds_off32((lane & 31), 2 + (lane >> 5));
  const int nsteps = K >> 5;
  vsync();
  BIG_ISSUE(0, 0)
  BIG_ISSUE(32, 24576)
  int cur = 0, nx2 = 49152;
  for (int t = 0; t < nsteps - 2; ++t) {
    asm volatile("s_waitcnt vmcnt(6)" ::: "memory");
    vsync_raw();
    BIG_ISSUE((t + 2) * 32, nx2)
    BIG_COMPUTE(cur)
    cur = (cur == 49152) ? 0 : cur + 24576;
    nx2 = (nx2 == 49152) ? 0 : nx2 + 24576;
  }
  asm volatile("s_waitcnt vmcnt(6)" ::: "memory");
  vsync_raw();
  BIG_COMPUTE(cur)
  cur = (cur == 49152) ? 0 : cur + 24576;
  asm volatile("s_waitcnt vmcnt(0)" ::: "memory");
  vsync_raw();
  BIG_COMPUTE(cur)
#undef BIG_ISSUE
#undef BIG_COMPUTE
#undef DSR
#undef WAIT1
#undef WAIT2
#undef MF
  const int lane2 = opq(lane);
  typedef __attribute__((ext_vector_type(4))) float f32x4;
  vsync();
  float* wl = (float*)lds + wv * (32 * 68);
  const int hh2 = lane2 >> 5, cl = lane2 & 31;
#pragma unroll
  for (int i = 0; i < 2; ++i)
#pragma unroll
    for (int jh = 0; jh < 2; ++jh) {
#pragma unroll
      for (int j = 0; j < 2; ++j)
#pragma unroll
        for (int r = 0; r < 16; ++r) wl[((r & 3) + 8 * (r >> 2) + 4 * hh2) * 68 + j * 32 + cl] = acc[i][jh * 2 + j][r];
      __builtin_amdgcn_wave_barrier();
#pragma unroll
      for (int k = 0; k < 4; ++k) {
        const int row = (lane2 >> 3) + 8 * k, c8 = (lane2 & 7) * 8;
        const f32x4 lo = *(const f32x4*)&wl[row * 68 + c8];
        const f32x4 hi = *(const f32x4*)&wl[row * 68 + c8 + 4];
        epi(wv * 64 + i * 32 + row, jh * 64 + c8, lo, hi);
      }
      __builtin_amdgcn_wave_barrier();
    }
}

template <class Epi>
__device__ __forceinline__ void ph_gemm_big(const bf16_t* A, int lda, const bf16_t* Wt, int ldw, int M, int N, int K,
                                            char* lds, Epi epi) {
  const int ntm = M / 256, ntn = N / 128;
  const int npm = (ntm + 7) / 8, npn = (ntn + 7) / 8;
  const int nslots = ((npm * npn * 64 + 511) / 512) * 512;
  for (int u = VB(); u < nslots; u += VG()) {
    int v = (u & 7) * 64 + ((u >> 3) & 63) + (u & ~511);
    int patch = v >> 6, w = v & 63;
    int tm = (patch % npm) * 8 + (w & 7);
    int tn = (patch / npm) * 8 + (w >> 3);
    if (tm >= ntm || tn >= ntn) continue;
    const int m0 = tm * 256, n0 = tn * 128;
    gemm_tile_big(A + (size_t)m0 * lda, lda, Wt + (size_t)n0 * ldw, ldw, K, lds,
                  [&](int r, int c, f32x4_e lo, f32x4_e hi) { epi(m0 + r, n0 + c, lo, hi); });
  }
}

template <int PM = 0, class Epi>
__device__ __forceinline__ void gemm_tile_huge(const bf16_t* xp, int ldx, const bf16_t* yp, int ldy, int K, char* lds0,
                                               Epi epi) {
  const int tid = opq(threadIdx.x), lane = tid & 63, wv = tid >> 6;
  const int wr = wv >> 2, wc = wv & 3;
  f32x16 acc[4][2];
#pragma unroll
  for (int i = 0; i < 4; ++i)
#pragma unroll
    for (int j = 0; j < 2; ++j)
#pragma unroll
      for (int r = 0; r < 16; ++r) acc[i][j][r] = 0.f;
  const int prow = lane >> 3, pch = lane & 7;
  const bf16_t* xs[4];
  const bf16_t* ys[4];
#pragma unroll
  for (int ps = 0; ps < 4; ++ps) {
    const int row = (wv * 4 + ps) * 8 + prow;
    const int c = pch ^ ((row >> 1) & 7);
    xs[ps] = xp + (size_t)row * ldx + c * 8;
    ys[ps] = yp + (size_t)row * ldy + c * 8;
  }
  char* const xdst = lds0 + wv * 4096 + lane * 16;
#define HUGE_ISSUE(k0, st)                                                                                                          \
  _Pragma("unroll") for (int ps = 0; ps < 4; ++ps) {                                                                                \
    __builtin_amdgcn_global_load_lds((const unsigned*)(xs[ps] + (k0)), (unsigned*)(xdst + (st) + ps * 1024), 16, 0, 0);             \
    __builtin_amdgcn_global_load_lds((const unsigned*)(ys[ps] + (k0)), (unsigned*)(xdst + (st) + 32768 + ps * 1024), 16, 0, 0);     \
  }
#define HDSR(dst, addr, off) asm volatile("ds_read_b128 %0, %1 offset:%2" : "=v"(dst) : "v"(addr), "i"(off) : "memory")
#define HREAD(S, ab, bb)                                                                            \
  HDSR(S##a0, ab, 0); HDSR(S##b0, bb, 0); HDSR(S##b1, bb, 4096); HDSR(S##a1, ab, 4096);             \
  HDSR(S##a2, ab, 8192); HDSR(S##a3, ab, 12288);
#define HWAIT(n, S)                                                                                 \
  asm volatile("s_waitcnt lgkmcnt(" #n ")" : "+v"(S##a0), "+v"(S##a1), "+v"(S##a2), "+v"(S##a3), "+v"(S##b0), "+v"(S##b1))
#define HMF(i, j, S) acc[i][j] = __builtin_amdgcn_mfma_f32_32x32x16_bf16(S##a##i, S##b##j, acc[i][j], 0, 0, 0)
#define HMMA(S) HMF(0, 0, S); HMF(0, 1, S); HMF(1, 0, S); HMF(1, 1, S); HMF(2, 0, S); HMF(2, 1, S); HMF(3, 0, S); HMF(3, 1, S);
  const unsigned ldsb = (unsigned)(size_t)(LAS char*)lds0;
  const int frow = lane & 31, fh = lane >> 5;
  const unsigned ab0 = ldsb + lds_off(wr * 128 + frow, 0 + fh), ab1 = ldsb + lds_off(wr * 128 + frow, 2 + fh);
  const unsigned ab2 = ldsb + lds_off(wr * 128 + frow, 4 + fh), ab3 = ldsb + lds_off(wr * 128 + frow, 6 + fh);
  const unsigned bb0 = ldsb + 32768 + lds_off(wc * 64 + frow, 0 + fh), bb1 = ldsb + 32768 + lds_off(wc * 64 + frow, 2 + fh);
  const unsigned bb2 = ldsb + 32768 + lds_off(wc * 64 + frow, 4 + fh), bb3 = ldsb + 32768 + lds_off(wc * 64 + frow, 6 + fh);
  __syncthreads();
  HUGE_ISSUE(0, 0)
  bf16x8 Ea0, Ea1, Ea2, Ea3, Eb0, Eb1, Oa0, Oa1, Oa2, Oa3, Ob0, Ob1;
  asm volatile("s_waitcnt vmcnt(0)" ::: "memory");
  __syncthreads();
  if (64 < K) { HUGE_ISSUE(64, 65536u) }
  HREAD(E, ab0, bb0)
  HREAD(O, ab1, bb1)
  HWAIT(6, E); HMMA(E)
  HREAD(E, ab2, bb2)
  HWAIT(6, O); HMMA(O)
  HREAD(O, ab3, bb3)
  HWAIT(6, E); HMMA(E)
  HWAIT(0, O);
  unsigned st = 65536u;
  for (int k0 = 64; k0 < K; k0 += 64) {
    asm volatile("s_waitcnt vmcnt(0)" ::: "memory");
    __syncthreads();
    const unsigned a0 = ab0 + st, a1 = ab1 + st, a2 = ab2 + st, a3 = ab3 + st;
    const unsigned b0 = bb0 + st, b1 = bb1 + st, b2 = bb2 + st, b3 = bb3 + st;
    HREAD(E, a0, b0)
    HWAIT(6, O); HMMA(O)
    if (k0 + 64 < K) { HUGE_ISSUE(k0 + 64, st ^ 65536u) }
    HREAD(O, a1, b1)
    HWAIT(6, E); HMMA(E)
    HREAD(E, a2, b2)
    HWAIT(6, O); HMMA(O)
    HREAD(O, a3, b3)
    HWAIT(6, E); HMMA(E)
    HWAIT(0, O);
    st ^= 65536u;
  }
  HMMA(O)
#undef HUGE_ISSUE
#undef HDSR
#undef HREAD
#undef HWAIT
#undef HMF
#undef HMMA
  const int lane2 = opq(lane);
  typedef __attribute__((ext_vector_type(4))) float f32x4;
  __syncthreads();
  float* wl = (float*)lds0 + wv * (32 * 68);
  const int hh2 = lane2 >> 5, cl = lane2 & 31;
#pragma unroll
  for (int i = 0; i < 4; ++i) {
#pragma unroll
    for (int j = 0; j < 2; ++j)
#pragma unroll
      for (int r = 0; r < 16; ++r) wl[((r & 3) + 8 * (r >> 2) + 4 * hh2) * 68 + j * 32 + cl] = acc[i][j][r];
    __builtin_amdgcn_wave_barrier();
#pragma unroll
    for (int k = 0; k < 4; ++k) {
      const int row = (lane2 >> 3) + 8 * k, c8 = (lane2 & 7) * 8;
      const f32x4 lo = *(const f32x4*)&wl[row * 68 + c8];
      const f32x4 hi = *(const f32x4*)&wl[row * 68 + c8 + 4];
      if (PM != 3) epi(wr * 128 + i * 32 + row, wc * 64 + c8, lo, hi);
    }
    __builtin_amdgcn_wave_barrier();
  }
  __syncthreads();
}

template <class Epi>
__device__ __forceinline__ void ph_gemm_huge(const bf16_t* A, int lda, const bf16_t* Wt, int ldw, int M, int N, int K,
                                             char* lds0, Epi epi) {
  const int ntm = M / 256, ntn = N / 256;
  for (int u = (int)blockIdx.x; u < ntm * ntn; u += (int)gridDim.x) {
    const int x = u & 7, i = (u >> 3) & 31, rnd = u >> 8;
    const int tm = (x & 3) * 8 + (i & 7), tn = rnd * 8 + (x >> 2) * 4 + (i >> 3);
    if (tm >= ntm || tn >= ntn) continue;
    const int m0 = tm * 256, n0 = tn * 256;
    gemm_tile_huge(A + (size_t)m0 * lda, lda, Wt + (size_t)n0 * ldw, ldw, K, lds0,
                   [&](int r, int c, f32x4_e lo, f32x4_e hi) { epi(m0 + r, n0 + c, lo, hi); });
  }
}

__device__ __forceinline__ void norm_feed(const f32x4_e h0, const f32x4_e h1, const float* gain, int n, bf16_t* hn_row,
                                          float* rowss_m) {
  const f32x4_e g0 = *(const f32x4_e*)(gain + n), g1 = *(const f32x4_e*)(gain + n + 4);
  st_bf16x8(hn_row + n, h0 * g0, h1 * g1);
  float ss = h0[0] * h0[0] + h0[1] * h0[1] + h0[2] * h0[2] + h0[3] * h0[3] + h1[0] * h1[0] + h1[1] * h1[1] + h1[2] * h1[2] + h1[3] * h1[3];
  ss += __shfl_xor(ss, 1);
  ss += __shfl_xor(ss, 2);
  ss += __shfl_xor(ss, 4);
  if (((VT()) & 7) == 0) atomicAdd(rowss_m, ss);
}

template <bool VEC = false, class Epi>
__device__ __forceinline__ void ph_gemm_bf16(const bf16_t* A, int lda, const bf16_t* Wt, int ldw, int M, int N, int K,
                                             char* lds, Epi epi, int vblock = -2) {
  const int ntm = M / 128, ntn = N / 128;
  const int npm = (ntm + 7) / 8, npn = (ntn + 7) / 8;
  const int nslots = ((npm * npn * 64 + 511) / 512) * 512;
  if (vblock == -1) return;
  for (int u = (vblock >= 0 ? vblock : VB()); u < nslots; u += VG()) {
    int v = (u & 7) * 64 + ((u >> 3) & 63) + (u & ~511);
    int patch = v >> 6, w = v & 63;
    int tm = (patch % npm) * 8 + (w & 7);
    int tn = (patch / npm) * 8 + (w >> 3);
    if (tm >= ntm || tn >= ntn) continue;
    const int m0 = tm * 128, n0 = tn * 128;
    if constexpr (VEC)
      gemm_tile_bf16<false, true>(A + (size_t)m0 * lda, lda, Wt + (size_t)n0 * ldw, ldw, K, lds,
                                  [&](int r, int c, f32x4_e lo, f32x4_e hi) { epi(m0 + r, n0 + c, lo, hi); });
    else
      gemm_tile_bf16<false>(A + (size_t)m0 * lda, lda, Wt + (size_t)n0 * ldw, ldw, K, lds,
                            [&](int r, int c, float val) { epi(m0 + r, n0 + c, val); });
  }
}

__device__ __forceinline__ void ph_proj(const P& p, char* lds0, char* lds) {
  for (int u = (int)blockIdx.x; u < 512; u += (int)gridDim.x) {
    const int x = u & 7, i = (u >> 3) & 31, rnd = u >> 8;
    const int tm = (x & 3) * 8 + (i & 7), tp = rnd * 8 + (x >> 2) * 4 + (i >> 3);
    const int tb = tp * 2;
    const int tn = (tb < 14) ? tb : (tb < 16) ? tb + 2 : tb + 4;
    const int m0 = tm * 256, n0 = tn * 128;
    const int b = m0 >> 11, sl = m0 & 2047;
    const bf16_t* A = p.hn + (size_t)m0 * DM;
    const bf16_t* W = p.WinT + (size_t)n0 * DM;
    if (n0 < 1024 || (n0 >= 2560 && n0 < 3584)) {
      bf16_t* dst = (n0 < 1024) ? p.qn + (size_t)m0 * 1024 + n0 : p.qsb + (size_t)m0 * 1024 + (n0 - 2560);
      gemm_tile_huge(A, DM, W, DM, DM, lds0, [&](int r, int c, f32x4_e lo, f32x4_e hi) { st_bf16x8(dst + (size_t)r * 1024 + c, lo, hi); });
    } else if (n0 < 2560) {
      const int seg = (n0 - 1024) >> 8;
      bf16_t* base = (seg == 0) ? p.kcin : (seg == 1) ? p.vcin : (seg == 2) ? p.ks : p.kw;
      bf16_t* dst = base + ((size_t)(b * 2) * SEQ + sl) * 128;
      gemm_tile_huge(A, DM, W, DM, DM, lds0, [&](int r, int c, f32x4_e lo, f32x4_e hi) {
        st_bf16x8(dst + ((size_t)(c >> 7) * SEQ + r) * 128 + (c & 127), lo, hi); });
    } else {
      bf16_t* dst = p.ksb + ((size_t)(b * 8 + ((n0 - 3584) >> 7)) * SEQ + sl) * 128;
      gemm_tile_huge(A, DM, W, DM, DM, lds0, [&](int r, int c, f32x4_e lo, f32x4_e hi) {
        st_bf16x8(dst + ((size_t)(c >> 7) * SEQ + r) * 128 + (c & 127), lo, hi); });
    }
  }
  for (int u = (int)blockIdx.x; u < 192; u += (int)gridDim.x) {
    const int tm = u & 31, tv = u >> 5;
    const int n0 = (tv == 0) ? 1792 : (tv == 1) ? 2304 : 4608 + (tv - 2) * 256;
    const int m0 = tm * 256;
    const int b = m0 >> 11, sl = m0 & 2047;
    bf16_t* vd;
    if (tv < 2) vd = (tv == 0 ? p.vsT : p.vwT) + ((size_t)(b * 2) * 128) * SEQ + sl;
    else vd = p.vsbT + ((size_t)(b * 8 + (tv - 2) * 2) * 128) * SEQ + sl;
    gemm_tile_huge(p.WinT + (size_t)n0 * DM, DM, p.hn + (size_t)m0 * DM, DM, DM, lds0,
                   [&](int r, int c, f32x4_e lo, f32x4_e hi) {
                     bf16_t* row = vd + (size_t)r * SEQ;
                     uint2 wa, wb;
                     wa.x = pack2(lo[0], lo[1]); wa.y = pack2(lo[2], lo[3]);
                     wb.x = pack2(hi[0], hi[1]); wb.y = pack2(hi[2], hi[3]);
                     const int pa = (c & 8) ? c - 4 : c, pb = (c & 8) ? c + 4 : c + 8;
                     *(uint2*)(row + pa) = wa;
                     *(uint2*)(row + pb) = wb; });
  }
  {
    const int vb = VB();
    if (VG() != 512 || vb >= 448) {
      for (int tm = (VG() == 512) ? vb - 448 : vb; tm < 64; tm += (VG() == 512) ? 64 : VG()) {
        const int m0 = tm * 128;
        float* gd = p.gates + (size_t)m0 * 24;
        gemm_tile_bf16<false>(p.hn + (size_t)m0 * DM, DM, p.WinT + (size_t)5632 * DM, DM, DM, lds,
                              [&](int r, int c, float val) { if (c < 24) gd[(size_t)r * 24 + c] = val; });
      }
    }
  }
}

__device__ __forceinline__ void ph_posb(const P& p) {
  const int lane = VT() & 63, wv = VT() >> 6;
  for (int o = VB() * 4 + wv; o < 256; o += VG() * 4) {
    const int which = o >> 7, n = o & 127;
    const float* pos = which ? p.pos_v : p.pos_k;
    const float* w1 = which ? p.w1_v : p.w1_k;
    float acc = 0.f;
    for (int k = lane; k < 4096; k += 64) acc += pos[k] * w1[(size_t)k * 128 + n];
    acc = wave_sum(acc);
    if (lane == 0) p.posb[o] = acc;
  }
}

__device__ __forceinline__ void ph_compress2(const P& p, char* lds) {
  for (int item = VB(); item < 16; item += VG()) {
    const int which = item >> 3, bg = item & 7;
    const bf16_t* src = (which ? p.vcin : p.kcin) + (size_t)bg * SEQ * 128;
    const bf16_t* w1t = p.w1T + (size_t)which * 128 * 4096;
    const bf16_t* w2t = p.w2T + (size_t)which * 128 * 128;
    const float* posb = p.posb + which * 128;
    bf16_t* c1 = p.c1 + (size_t)item * 128 * 128;
    gemm_tile_bf16<false>(src, 2048, w1t, 4096, 4096, lds, [&](int r, int c, float val) {
      c1[r * 128 + c] = f2bf(gelu_fast(val + posb[c])); });
    __threadfence_block();
    vsync();
    if (which == 0) {
      bf16_t* kd = p.kcb + (size_t)bg * 128 * 128;
      gemm_tile_bf16<false>(c1, 128, w2t, 128, 128, lds, [&](int r, int c, float val) { kd[r * 128 + c] = f2bf(val); });
    } else {
      bf16_t* vd = p.vcT + (size_t)bg * 128 * 128;
      gemm_tile_bf16<true>(c1, 128, w2t, 128, 128, lds, [&](int r, int c, float val) { vd[r * 128 + perm16(c)] = f2bf(val); });
    }
  }
}

#define NEG_BIG (-1e30f)

struct KVRegs { u32x4 k0, k1, k2, k3, v0, v1, v2, v3; };

__device__ __forceinline__ int koff(int row, int chunk) { return row * 256 + ((chunk ^ (row & 15)) << 4); }

__device__ __forceinline__ void kv_load(KVRegs& r, const bf16_t* kp, int ldk, const bf16_t* vp, int ldv) {
  const int tid = VT();
  const bf16_t* kg = kp + (size_t)(tid >> 4) * ldk + (tid & 15) * 8;
  r.k0 = *(const u32x4*)kg;
  r.k1 = *(const u32x4*)(kg + (size_t)16 * ldk);
  r.k2 = *(const u32x4*)(kg + (size_t)32 * ldk);
  r.k3 = *(const u32x4*)(kg + (size_t)48 * ldk);
  const bf16_t* vg = vp + (size_t)(tid >> 3) * ldv + (tid & 7) * 8;
  r.v0 = *(const u32x4*)vg;
  r.v1 = *(const u32x4*)(vg + (size_t)32 * ldv);
  r.v2 = *(const u32x4*)(vg + (size_t)64 * ldv);
  r.v3 = *(const u32x4*)(vg + (size_t)96 * ldv);
}
__device__ __forceinline__ void kv_store(const KVRegs& r, char* lk, char* lv) {
  const int tid = VT();
  const int row = tid >> 4, ch = tid & 15;
  *(u32x4*)(lk + koff(row, ch)) = r.k0;
  *(u32x4*)(lk + koff(row + 16, ch)) = r.k1;
  *(u32x4*)(lk + koff(row + 32, ch)) = r.k2;
  *(u32x4*)(lk + koff(row + 48, ch)) = r.k3;
  const int vr = tid >> 3, vc = tid & 7;
  *(u32x4*)(lv + lds_off(vr, vc)) = r.v0;
  *(u32x4*)(lv + lds_off(vr + 32, vc)) = r.v1;
  *(u32x4*)(lv + lds_off(vr + 64, vc)) = r.v2;
  *(u32x4*)(lv + lds_off(vr + 96, vc)) = r.v3;
}

struct QFrag { bf16x8 f0, f1, f2, f3, f4, f5, f6, f7; };
__device__ __forceinline__ void q_load(QFrag& q, const bf16_t* qrow) {
  const int h = (VT() & 63) >> 5;
  const bf16x8* p8 = (const bf16x8*)(qrow + 8 * h);
  q.f0 = p8[0]; q.f1 = p8[2]; q.f2 = p8[4]; q.f3 = p8[6]; q.f4 = p8[8]; q.f5 = p8[10]; q.f6 = p8[12]; q.f7 = p8[14];
}

__device__ __forceinline__ void qk_tile(const QFrag& q, const char* lk, f32x16& s0, f32x16& s1) {
  const int lane = VT() & 63, row = lane & 31, h = lane >> 5;
#pragma unroll
  for (int r = 0; r < 16; ++r) { s0[r] = 0.f; s1[r] = 0.f; }
#define QK_STEP(kk, qf)                                                                  \
  {                                                                                      \
    bf16x8 a0 = *(const bf16x8*)(lk + koff(row, 2 * (kk) + h));                          \
    bf16x8 a1 = *(const bf16x8*)(lk + koff(row + 32, 2 * (kk) + h));                     \
    s0 = __builtin_amdgcn_mfma_f32_32x32x16_bf16(a0, qf, s0, 0, 0, 0);                   \
    s1 = __builtin_amdgcn_mfma_f32_32x32x16_bf16(a1, qf, s1, 0, 0, 0);                   \
  }
  QK_STEP(0, q.f0) QK_STEP(1, q.f1) QK_STEP(2, q.f2) QK_STEP(3, q.f3)
  QK_STEP(4, q.f4) QK_STEP(5, q.f5) QK_STEP(6, q.f6) QK_STEP(7, q.f7)
#undef QK_STEP
}

__device__ __forceinline__ bf16x8 pack8(const f32x16& p, const int base) {
  u32x4 u;
  u[0] = pack2(p[base + 0], p[base + 1]);
  u[1] = pack2(p[base + 2], p[base + 3]);
  u[2] = pack2(p[base + 4], p[base + 5]);
  u[3] = pack2(p[base + 6], p[base + 7]);
  return __builtin_bit_cast(bf16x8, u);
}

typedef __attribute__((ext_vector_type(2))) unsigned u32x2_t;
__device__ __forceinline__ float xhalf_max(float v) {
  const u32x2_t r = __builtin_amdgcn_permlane32_swap(__float_as_uint(v), __float_as_uint(v), false, false);
  return fmaxf(__uint_as_float(r[0]), __uint_as_float(r[1]));
}
__device__ __forceinline__ float xhalf_sum(float v) {
  const u32x2_t r = __builtin_amdgcn_permlane32_swap(__float_as_uint(v), __float_as_uint(v), false, false);
  return __uint_as_float(r[0]) + __uint_as_float(r[1]);
}
__device__ __forceinline__ float xhalf_get(float v, int hh) {
  const u32x2_t r = __builtin_amdgcn_permlane32_swap(__float_as_uint(v), __float_as_uint(v), false, false);
  return hh ? __uint_as_float(r[0]) : __uint_as_float(r[1]);
}
struct OAcc { f32x16 o0, o1, o2, o3; };
__device__ __forceinline__ void oacc_zero(OAcc& o) {
#pragma unroll
  for (int r = 0; r < 16; ++r) { o.o0[r] = 0.f; o.o1[r] = 0.f; o.o2[r] = 0.f; o.o3[r] = 0.f; }
}
__device__ __forceinline__ void oacc_scale(OAcc& o, float a) {
#pragma unroll
  for (int r = 0; r < 16; ++r) { o.o0[r] *= a; o.o1[r] *= a; o.o2[r] *= a; o.o3[r] *= a; }
}

__device__ __forceinline__ void pv_tile(OAcc& o, const char* lv, const f32x16& p0, const f32x16& p1) {
  const int lane = VT() & 63, row = lane & 31, h = lane >> 5;
  const bf16x8 pf0 = pack8(p0, 0), pf1 = pack8(p0, 8), pf2 = pack8(p1, 0), pf3 = pack8(p1, 8);
#define PV_ROW(dd, acc)                                                                                      \
  {                                                                                                          \
    acc = __builtin_amdgcn_mfma_f32_32x32x16_bf16(*(const bf16x8*)(lv + lds_off(32 * (dd) + row, 0 + h)), pf0, acc, 0, 0, 0); \
    acc = __builtin_amdgcn_mfma_f32_32x32x16_bf16(*(const bf16x8*)(lv + lds_off(32 * (dd) + row, 2 + h)), pf1, acc, 0, 0, 0); \
    acc = __builtin_amdgcn_mfma_f32_32x32x16_bf16(*(const bf16x8*)(lv + lds_off(32 * (dd) + row, 4 + h)), pf2, acc, 0, 0, 0); \
    acc = __builtin_amdgcn_mfma_f32_32x32x16_bf16(*(const bf16x8*)(lv + lds_off(32 * (dd) + row, 6 + h)), pf3, acc, 0, 0, 0); \
  }
  PV_ROW(0, o.o0) PV_ROW(1, o.o1) PV_ROW(2, o.o2) PV_ROW(3, o.o3)
#undef PV_ROW
}

typedef __attribute__((ext_vector_type(2))) float f32x2_s;
#define SPAIR(v, i) __builtin_shufflevector(v, v, (i), (i) + 1)
__device__ __forceinline__ void softmax_tile(f32x16& s0, f32x16& s1, float& m, float& l, OAcc& o, const float sc = 1.f,
                                             const float bb = 0.f) {
  float mr = -INFINITY;
#pragma unroll
  for (int r = 0; r < 16; ++r) mr = fmaxf(mr, fmaxf(s0[r], s1[r]));
  float mx = fmaf(mr, sc, bb);
  mx = (mx != mx) ? -INFINITY : mx;
  mx = xhalf_max(fmaxf(mx, NEG_BIG));
  const float mn = fmaxf(m, mx);
  const float alpha = __builtin_amdgcn_exp2f(m - mn);
  const f32x2_s sc2 = {sc, sc}, c2 = {bb - mn, bb - mn};
  f32x2_s ls2 = {0.f, 0.f};
#pragma unroll
  for (int r = 0; r < 16; r += 2) {
    const f32x2_s pa_in = {s0[r], s0[r + 1]}, pb_in = {s1[r], s1[r + 1]};
    const f32x2_s a = __builtin_elementwise_fma(pa_in, sc2, c2);
    const f32x2_s b = __builtin_elementwise_fma(pb_in, sc2, c2);
    const float a0 = __builtin_amdgcn_exp2f(a[0]), a1 = __builtin_amdgcn_exp2f(a[1]);
    const float b0 = __builtin_amdgcn_exp2f(b[0]), b1 = __builtin_amdgcn_exp2f(b[1]);
    s0[r] = a0; s0[r + 1] = a1; s1[r] = b0; s1[r + 1] = b1;
    const f32x2_s pa = {a0, a1}, pb = {b0, b1};
    ls2 = ls2 + pa + pb;
  }
  const float ls = xhalf_sum(ls2[0] + ls2[1]);
  l = l * alpha + ls;
  m = mn;
  if (__any(alpha != 1.f)) oacc_scale(o, alpha);
}

template <class F>
__device__ __forceinline__ void oacc_foreach(const OAcc& o, F f) {
  const int h = (VT() & 63) >> 5;
#pragma unroll
  for (int rho = 0; rho < 4; ++rho) {
    f(0 + 8 * rho + 4 * h, o.o0[4 * rho], o.o0[4 * rho + 1], o.o0[4 * rho + 2], o.o0[4 * rho + 3]);
    f(32 + 8 * rho + 4 * h, o.o1[4 * rho], o.o1[4 * rho + 1], o.o1[4 * rho + 2], o.o1[4 * rho + 3]);
    f(64 + 8 * rho + 4 * h, o.o2[4 * rho], o.o2[4 * rho + 1], o.o2[4 * rho + 2], o.o2[4 * rho + 3]);
    f(96 + 8 * rho + 4 * h, o.o3[4 * rho], o.o3[4 * rho + 1], o.o3[4 * rho + 2], o.o3[4 * rho + 3]);
  }
}

__device__ __forceinline__ void memattn_item(const P& p, char* lds, int item) {
  char* lk = lds;
  char* lv = lds + 16384;
  const int lane = VT() & 63, wv = VT() >> 6;
  {
    const int tb = item % (SEQ / 128);
    const int bh = item / (SEQ / 128);
    const int b = bh >> 2, hd = bh & 3;
    const int t = tb * 128 + wv * 32 + (lane & 31);
    QFrag q;
    q_load(q, p.qmemb + (size_t)(b * SEQ + t) * 512 + hd * 128);
    const bf16_t* kb = p.kmemb + (size_t)bh * 256 * 128;
    const bf16_t* vb = p.vmemT + (size_t)bh * 128 * 256;
    OAcc o;
    oacc_zero(o);
    float m = NEG_BIG, l = 0.f;
    KVRegs kv;
    kv_load(kv, kb, 128, vb, 256);
#pragma unroll 1
    for (int ti = 0; ti < 4; ++ti) {
      vsync();
      kv_store(kv, lk, lv);
      vsync();
      {
        const int tn = (ti + 1 < 4) ? ti + 1 : 3;
        kv_load(kv, kb + (size_t)tn * 64 * 128, 128, vb + tn * 64, 256);
      }
      f32x16 s0, s1;
      qk_tile(q, lk, s0, s1);
      softmax_tile(s0, s1, m, l, o, ATT_SCALE2, 0.f);
      pv_tile(o, lv, s0, s1);
    }
    const float il = 1.f / l;
    const int t2 = tb * 128 + (VT() >> 6) * 32 + (VT() & 31);
    bf16_t* orow = p.omem + (size_t)(b * SEQ + t2) * 512 + hd * 128;
    oacc_foreach(o, [&](int d, float v0, float v1, float v2, float v3) {
      uint2 u;
      u.x = pack2(v0 * il, v1 * il);
      u.y = pack2(v2 * il, v3 * il);
      *(uint2*)(orow + d) = u;
    });
  }
}

__device__ __forceinline__ void ph_memq_attn(const P& p, char* lds, int vblock, int nvb) {
  if (vblock < 0) return;
  const float* rss = p.rowss;
  for (int u = vblock; u < 64 * 4; u += nvb) {
    const int tm = u & 63, hd = u >> 6;
    const int m0 = tm * 128;
    bf16_t* qd = p.qmemb + (size_t)m0 * 512 + hd * 128;
    gemm_tile_bf16<false, true>(p.hn + (size_t)m0 * DM, DM, p.WmqT + (size_t)hd * 128 * DM, DM, DM, lds,
                                [&](int r, int c, f32x4_e lo, f32x4_e hi) {
                                  const float rs = rsqrtf(rss[m0 + r] * (1.f / DM) + RMS_EPS);
                                  st_bf16x8(qd + (size_t)r * 512 + c, lo * rs, hi * rs); });
    __threadfence_block();
    vsync();
    memattn_item(p, lds, ((m0 >> 11) * 4 + hd) * (SEQ / 128) + ((m0 & 2047) >> 7));
  }
}

template <bool CHK>
__device__ __forceinline__ void sb_pass1(f32x16& z, f32x16& l, const int s_first, const int t) {
  const f32x2_s sc2 = {ATT_SCALE2, ATT_SCALE2}, one2 = {1.f, 1.f};
#pragma unroll
  for (int r = 0; r < 16; r += 2) {
    const f32x2_s zin = {z[r], z[r + 1]};
    const f32x2_s zz = zin * sc2;
    const f32x2_s ee = {__builtin_amdgcn_exp2f(-fabsf(zz[0])), __builtin_amdgcn_exp2f(-fabsf(zz[1]))};
    const f32x2_s tt = ee + one2;
    const f32x2_s lg = {__builtin_amdgcn_logf(tt[0]), __builtin_amdgcn_logf(tt[1])};
    const f32x2_s mn = {fminf(zz[0], 0.f), fminf(zz[1], 0.f)};
    const f32x2_s lf = (mn - lg) - zz;
    if (CHK) {
      const int so = s_first + 8 * (r >> 2) + (r & 3);
      const bool v0 = so < t, v1 = so + 1 < t;
      l[r] = v0 ? lf[0] : 0.f; l[r + 1] = v1 ? lf[1] : 0.f;
      z[r] = v0 ? zz[0] : NEG_BIG; z[r + 1] = v1 ? zz[1] : NEG_BIG;
    } else {
      l[r] = lf[0]; l[r + 1] = lf[1];
      z[r] = zz[0]; z[r + 1] = zz[1];
    }
  }
}
__device__ __forceinline__ void sb_pass3(f32x16& z, const f32x16& l, const float* ag) {
#pragma unroll
  for (int rho = 0; rho < 4; ++rho) {
    const float x3 = l[4 * rho + 3], x23 = x3 + l[4 * rho + 2], x123 = x23 + l[4 * rho + 1];
    const float g = ag[rho];
    const f32x2_s g2 = {g, g};
    const f32x2_s la = {l[4 * rho + 0], l[4 * rho + 1]}, lb = {l[4 * rho + 2], l[4 * rho + 3]};
    const f32x2_s za = {z[4 * rho + 0], z[4 * rho + 1]}, zb = {z[4 * rho + 2], z[4 * rho + 3]};
    const f32x2_s xa = {x123, x23}, xb = {x3, 0.f};
    const f32x2_s aa = (la + za) + (g2 + xa), ab = (lb + zb) + (g2 + xb);
    z[4 * rho + 0] = __builtin_amdgcn_exp2f(aa[0]); z[4 * rho + 1] = __builtin_amdgcn_exp2f(aa[1]);
    z[4 * rho + 2] = __builtin_amdgcn_exp2f(ab[0]); z[4 * rho + 3] = __builtin_amdgcn_exp2f(ab[1]);
  }
}

__device__ __forceinline__ void ph_sb2(const P& p, char* lds) {
  char* lk = lds;
  char* lv = lds + 16384;
  const int lane = VT() & 63, wv = VT() >> 6, hh = lane >> 5;
  const int sb_skip = (VG() > 32) ? 16 : 0;
  if (VB() < sb_skip) return;
  for (int item = VB() - sb_skip; item < NBATCH * 8 * (SEQ / 128); item += VG() - sb_skip) {
    const int tb = (SEQ / 128 - 1) - (item % (SEQ / 128));
    const int bh = item / (SEQ / 128);
    const int b = bh >> 3, hd = bh & 7;
    const int t0 = tb * 128;
    const int t = t0 + wv * 32 + (lane & 31);
    QFrag q;
    q_load(q, p.qsb + (size_t)(b * SEQ + t) * 1024 + hd * 128);
    const bf16_t* kb = p.ksb + (size_t)bh * SEQ * 128;
    const bf16_t* vb = p.vsbT + (size_t)bh * 128 * SEQ;
    OAcc o;
    oacc_zero(o);
    float carry = 0.f;
    const int jhi = (t0 >> 6) + 1;
    const int jw = (t0 + wv * 32 + 30) >> 6;
    KVRegs kv;
    kv_load(kv, kb + (size_t)jhi * 64 * 128, 128, vb + jhi * 64, SEQ);
    volatile unsigned* dflag = (volatile unsigned*)(lds + 32768);
    vsync();
    if (VT() < 4) dflag[VT()] = 0u;
    for (int j = jhi; j >= 0; --j) {
      vsync();
      if ((dflag[0] & dflag[1] & dflag[2] & dflag[3]) != 0u) break;
      kv_store(kv, lk, lv);
      vsync();
      const int jn = (j > 0) ? j - 1 : 0;
      if (j > jw) kv_load(kv, kb + (size_t)jn * 64 * 128, 128, vb + jn * 64, SEQ);
      if (j <= jw) {
        f32x16 z0, z1;
        qk_tile(q, lk, z0, z1);
        const int sbase = j * 64 + 4 * hh;
        float gt[8];
        f32x16 l0, l1;
        if (j * 64 + 63 < t0 + wv * 32) {
          sb_pass1<false>(z0, l0, sbase, t);
          sb_pass1<false>(z1, l1, sbase + 32, t);
        } else {
          sb_pass1<true>(z0, l0, sbase, t);
          sb_pass1<true>(z1, l1, sbase + 32, t);
        }
#pragma unroll
        for (int rho = 0; rho < 4; ++rho) {
          gt[rho] = (l0[4 * rho] + l0[4 * rho + 1]) + (l0[4 * rho + 2] + l0[4 * rho + 3]);
          gt[4 + rho] = (l1[4 * rho] + l1[4 * rho + 1]) + (l1[4 * rho + 2] + l1[4 * rho + 3]);
        }
        float ag[8];
        float run = 0.f;
#pragma unroll
        for (int k = 7; k >= 0; --k) {
          const float pg = xhalf_get(gt[k], hh);
          ag[k] = carry + run + (hh == 0 ? pg : 0.f);
          run += gt[k] + pg;
        }
        carry += run;
        sb_pass3(z0, l0, ag);
        sb_pass3(z1, l1, ag + 4);
        kv_load(kv, kb + (size_t)jn * 64 * 128, 128, vb + jn * 64, SEQ);
        pv_tile(o, lv, z0, z1);
        if (__all(carry < -104.f * LOG2E) && (VT() & 63) == 0) dflag[wv] = 1u;
      }
    }
    int t2 = t;
    asm volatile("" : "+v"(t2));
    bf16_t* orow = p.omix + (size_t)(b * SEQ + t2) * DM + 1024 + hd * 128;
    oacc_foreach(o, [&](int d, float v0, float v1, float v2, float v3) {
      uint2 u;
      u.x = pack2(v0, v1);
      u.y = pack2(v2, v3);
      *(uint2*)(orow + d) = u;
    });
  }
}

#define NSA_IMP 32768
#define NSA_KEYS 49152
#define NSA_SELM 53504
#define NSA_LUT 53632
__device__ __forceinline__ void ph_nsa2(const P& p, char* lds) {
  typedef __attribute__((ext_vector_type(4))) float f32x4;
  char* lk = lds;
  char* lv = lds + 16384;
  float* imp = (float*)(lds + NSA_IMP);
  float* keys = (float*)(lds + NSA_KEYS);
  unsigned* selm = (unsigned*)(lds + NSA_SELM);
  const int tid = VT(), lane = tid & 63, wv = tid >> 6, hh = lane >> 5, ql = lane & 31;
  float* lut = (float*)(lds + NSA_LUT) + wv * 128;
  for (int item = VB(); item < NBATCH * 2 * (SEQ / 32); item += VG()) {
    const int tt = (item < 256) ? (SEQ / 32 - 1) - (item % (SEQ / 32)) : (item % (SEQ / 32));
    const int bg = item / (SEQ / 32);
    const int b = bg >> 1, g = bg & 1;
    const int h = g * 4 + wv;
    const int t0 = tt * 32, tq = t0 + ql, cur = t0 >> 6;
    vsync();
    QFrag q;
    q_load(q, p.qn + (size_t)(b * SEQ + tq) * 1024 + h * 128);
    {
      const int lo = opq(lane);
      lut[lo] = p.t5[t5_bucket(lo) * 8 + h] * LOG2E;
      lut[lo + 64] = p.t5[t5_bucket(lo + 64) * 8 + h] * LOG2E;
    }
#pragma unroll
    for (int i = 0; i < 16; ++i) imp[i * 256 + tid] = 0.f;
    if (tid < 32) selm[tid] = 0u;
    const float* grow = p.gates + (size_t)(b * SEQ + tq) * 24 + h * 3;
    float* prow = p.part + (size_t)(b * SEQ + tq) * 1024 + h * 128;
    OAcc o;
    float m, l;
    KVRegs kv;
    {
      const bf16_t* kb = p.kcb + (size_t)bg * 128 * 128;
      const bf16_t* vb = p.vcT + (size_t)bg * 128 * 128;
      oacc_zero(o);
      m = NEG_BIG; l = 0.f;
      kv_load(kv, kb, 128, vb, 128);
      vsync();
      kv_store(kv, lk, lv);
      vsync();
      f32x16 x0, x1;
      qk_tile(q, lk, x0, x1);
      int tqv = tq;
      asm volatile("" : "+v"(tqv));
      tqv -= 64 * hh;
      float fsc = 1.f, fbb = 0.f;
      if (t0 >= 1152) {
        fsc = ATT_SCALE2; fbb = lut[127];
      } else {
#pragma unroll
        for (int r = 0; r < 16; ++r) {
          const int c = 8 * (r >> 2) + (r & 3);
          const int d0 = tqv - 16 * c - 31, d1 = d0 - 512;
          x0[r] = (d0 >= 0) ? x0[r] * ATT_SCALE2 + lut[min(d0, 127)] : -INFINITY;
          x1[r] = (d1 >= 0) ? x1[r] * ATT_SCALE2 + lut[min(d1, 127)] : -INFINITY;
        }
      }
      softmax_tile(x0, x1, m, l, o, fsc, fbb);
      const float m0 = m;
      pv_tile(o, lv, x0, x1);
      f32x16 z0, z1;
#pragma unroll
      for (int r = 0; r < 16; ++r) { z0[r] = 0.f; z1[r] = 0.f; }
      if (t0 >= 1024) {
        kv_load(kv, kb + 64 * 128, 128, vb + 64, 128);
        vsync();
        kv_store(kv, lk, lv);
        vsync();
        qk_tile(q, lk, z0, z1);
        asm volatile("" : "+v"(tqv));
#pragma unroll
        for (int r = 0; r < 16; ++r) {
          const int c = 64 + 8 * (r >> 2) + (r & 3);
          const int d0 = tqv - 16 * c - 31, d1 = d0 - 512;
          z0[r] = (d0 >= 0) ? z0[r] * ATT_SCALE2 + lut[min(d0, 127)] : -INFINITY;
          z1[r] = (d1 >= 0) ? z1[r] * ATT_SCALE2 + lut[min(d1, 127)] : -INFINITY;
        }
        softmax_tile(z0, z1, m, l, o);
        pv_tile(o, lv, z0, z1);
      }
      const float inv = 1.f / fmaxf(l, 1e-20f);
      const float c0 = __builtin_amdgcn_exp2f(m0 - m) * inv;
#pragma unroll
      for (int r = 0; r < 16; ++r) {
        const int c = 8 * (r >> 2) + (r & 3) + 4 * hh;
        if (x0[r] != 0.f) atomicAdd(&imp[(c) * 32 + ql], x0[r] * c0);
        if (x1[r] != 0.f) atomicAdd(&imp[(c + 32) * 32 + ql], x1[r] * c0);
        if (z0[r] != 0.f) atomicAdd(&imp[(c + 64) * 32 + ql], z0[r] * inv);
        if (z1[r] != 0.f) atomicAdd(&imp[(c + 96) * 32 + ql], z1[r] * inv);
      }
      const float gs = inv / (1.f + __expf(-grow[0]));
      oacc_foreach(o, [&](int d, float v0, float v1, float v2, float v3) {
        f32x4 u = {v0 * gs, v1 * gs, v2 * gs, v3 * gs};
        *(f32x4*)(prow + d) = u;
      });
    }
    vsync();
    {
      const int tido = opq(tid);
      const int qq = tido & 31, jg = tido >> 5;
#pragma unroll
      for (int jj = 0; jj < 4; ++jj) {
        const int j = jg * 4 + jj;
        float v = imp[(4 * j) * 32 + qq] + imp[(4 * j + 1) * 32 + qq] + imp[(4 * j + 2) * 32 + qq] + 0.5f * imp[(4 * j + 3) * 32 + qq];
        if (j > 0) v += 0.5f * imp[(4 * j - 1) * 32 + qq];
        const bool forced = (j == 0) || (j == cur) || (j == cur - 1);
        keys[qq * 33 + j] = forced ? 1e9f : ((j <= cur) ? v : -1e9f);
      }
      vsync();
      unsigned bits = 0u;
#pragma unroll
      for (int jj = 0; jj < 4; ++jj) {
        const int j = jg * 4 + jj;
        const float kj = keys[qq * 33 + j];
        int rank = 0;
        for (int i = 0; i < 32; ++i) {
          const float ki = keys[qq * 33 + i];
          rank += (ki > kj || (ki == kj && i < j)) ? 1 : 0;
        }
        if (rank < 16 && j <= cur) bits |= 1u << j;
      }
      atomicOr(&selm[qq], bits);
      vsync();
    }
    const unsigned mysel = selm[ql];
    unsigned um = mysel;
#pragma unroll
    for (int o2 = 16; o2 > 0; o2 >>= 1) um |= (unsigned)__shfl_xor((int)um, o2);
    um = (unsigned)__builtin_amdgcn_readfirstlane((int)um);
    {
      const bf16_t* kb = p.ks + (size_t)bg * SEQ * 128;
      const bf16_t* vb = p.vsT + (size_t)bg * 128 * SEQ;
      oacc_zero(o);
      m = NEG_BIG; l = 0.f;
      unsigned rem = um;
      int j = __builtin_ctz(rem);
      kv_load(kv, kb + (size_t)j * 64 * 128, 128, vb + j * 64, SEQ);
      while (rem) {
        j = __builtin_ctz(rem);
        rem &= rem - 1;
        const int jn = rem ? __builtin_ctz(rem) : j;
        vsync();
        kv_store(kv, lk, lv);
        vsync();
        f32x16 s0, s1;
        qk_tile(q, lk, s0, s1);
        const bool selq = (mysel >> j) & 1u;
        int tqv = tq;
        asm volatile("" : "+v"(tqv));
        float fsc = 1.f, fbb = 0.f;
        if (j * 64 + 63 + 113 <= t0) {
          fsc = selq ? ATT_SCALE2 : 0.f; fbb = selq ? lut[127] : -INFINITY;
        } else {
#pragma unroll
          for (int r = 0; r < 16; ++r) {
            const int d0 = tqv - (j * 64 + 8 * (r >> 2) + (r & 3) + 4 * hh), d1 = d0 - 32;
            s0[r] = (selq && d0 >= 0) ? s0[r] * ATT_SCALE2 + lut[min(d0, 127)] : -INFINITY;
            s1[r] = (selq && d1 >= 0) ? s1[r] * ATT_SCALE2 + lut[min(d1, 127)] : -INFINITY;
          }
        }
        kv_load(kv, kb + (size_t)jn * 64 * 128, 128, vb + jn * 64, SEQ);
        softmax_tile(s0, s1, m, l, o, fsc, fbb);
        pv_tile(o, lv, s0, s1);
      }
      const float gs = 1.f / (fmaxf(l, 1e-20f) * (1.f + __expf(-grow[1])));
      int qo = ql;
      asm volatile("" : "+v"(qo));
      float* pr2 = p.part + (size_t)(b * SEQ + t0 + qo) * 1024 + h * 128;
      oacc_foreach(o, [&](int d, float v0, float v1, float v2, float v3) {
        f32x4 u = *(f32x4*)(pr2 + d);
        u[0] += v0 * gs; u[1] += v1 * gs; u[2] += v2 * gs; u[3] += v3 * gs;
        *(f32x4*)(pr2 + d) = u;
      });
    }
    {
      const bf16_t* kb = p.kw + (size_t)bg * SEQ * 128;
      const bf16_t* vb = p.vwT + (size_t)bg * 128 * SEQ;
      oacc_zero(o);
      m = NEG_BIG; l = 0.f;
      int jlo = (t0 - 511) >> 6;
      if (jlo < 0) jlo = 0;
      kv_load(kv, kb + (size_t)jlo * 64 * 128, 128, vb + jlo * 64, SEQ);
      for (int j = jlo; j <= cur; ++j) {
        const int jn = (j < cur) ? j + 1 : j;
        vsync();
        kv_store(kv, lk, lv);
        vsync();
        f32x16 s0, s1;
        qk_tile(q, lk, s0, s1);
        int tqv = tq;
        asm volatile("" : "+v"(tqv));
        float wsc = 1.f, wbb = 0.f;
        if (j * 64 + 63 + 113 <= t0 && t0 + 31 - j * 64 < 512) {
          wsc = ATT_SCALE2; wbb = lut[127];
        } else {
#pragma unroll
          for (int r = 0; r < 16; ++r) {
            const int d0 = tqv - (j * 64 + 8 * (r >> 2) + (r & 3) + 4 * hh), d1 = d0 - 32;
            s0[r] = (d0 >= 0 && d0 < 512) ? s0[r] * ATT_SCALE2 + lut[min(d0, 127)] : -INFINITY;
            s1[r] = (d1 >= 0 && d1 < 512) ? s1[r] * ATT_SCALE2 + lut[min(d1, 127)] : -INFINITY;
          }
        }
        kv_load(kv, kb + (size_t)jn * 64 * 128, 128, vb + jn * 64, SEQ);
        softmax_tile(s0, s1, m, l, o, wsc, wbb);
        pv_tile(o, lv, s0, s1);
      }
      const float gs = 1.f / (fmaxf(l, 1e-20f) * (1.f + __expf(-grow[2])));
      int qo = ql;
      asm volatile("" : "+v"(qo));
      const float* pr2 = p.part + (size_t)(b * SEQ + t0 + qo) * 1024 + h * 128;
      bf16_t* orow = p.omix + (size_t)(b * SEQ + t0 + qo) * DM + h * 128;
      oacc_foreach(o, [&](int d, float v0, float v1, float v2, float v3) {
        const f32x4 u = *(const f32x4*)(pr2 + d);
        uint2 w;
        w.x = pack2(u[0] + v0 * gs, u[1] + v1 * gs);
        w.y = pack2(u[2] + v2 * gs, u[3] + v3 * gs);
        *(uint2*)(orow + d) = w;
      });
    }
  }
}

__device__ __forceinline__ void ph_cvt(const float* src, bf16_t* dst, size_t n) {
  typedef __attribute__((ext_vector_type(4))) float f32x4;
  const size_t nv = n / 8;
  for (size_t i = (size_t)VB() * 256 + VT(); i < nv; i += (size_t)VG() * 256) {
    const f32x4 a = ((const f32x4*)src)[2 * i], b = ((const f32x4*)src)[2 * i + 1];
    u32x4 o;
    o[0] = pack2(a[0], a[1]); o[1] = pack2(a[2], a[3]); o[2] = pack2(b[0], b[1]); o[3] = pack2(b[2], b[3]);
    ((u32x4*)dst)[i] = o;
  }
}

__device__ __forceinline__ void ph_scores(const P& p, char* lds) {
  for (int u = VB(); u < 64 * 16; u += VG()) {
    const int tm = u & 63, hp = u >> 6;
    const int m0 = tm * 128;
    float* sc = p.scores + (size_t)m0 * DM + hp * 128;
    gemm_tile_bf16<false>(p.omix + (size_t)m0 * DM + hp * 128, DM, p.subkb + (size_t)hp * 128 * 128, 128, 128, lds,
                          [&](int r, int c, float val) { sc[(size_t)r * DM + c] = val; });
  }
}

template <int PM = 0>
__device__ __forceinline__ void ph_qp_scores(const P& p, char* lds0, char* lds) {
  for (int u = (int)blockIdx.x; u < 32 * 8; u += (int)gridDim.x) {
    const int x = u & 7, i = (u >> 3) & 31;
    const int tm = (x & 3) * 8 + (i & 7), tn = (x >> 2) * 4 + (i >> 3);
    const int m0 = tm * 256, n0 = tn * 256;
    bf16_t* qp = p.omix + (size_t)m0 * DM + n0;
    const float* rss = p.rowss + T_TOK + m0;
    gemm_tile_huge<PM>(p.hn + (size_t)m0 * DM, DM, p.WpqT + (size_t)n0 * DM, DM, DM, lds0,
                   [&](int r, int c, f32x4_e lo, f32x4_e hi) {
                     const float rs = rsqrtf(rss[r] * (1.f / DM) + RMS_EPS);
                     st_bf16x8(qp + (size_t)r * DM + c, lo * rs, hi * rs); });
    __threadfence_block();
    __syncthreads();
    const int hf = (int)(threadIdx.x >> 8);
    const int hp = tn * 2 + hf;
    float* sc = p.scores + (size_t)m0 * DM + hp * 128;
    gemm_tile_big(qp + hf * 128, DM, p.subkb + (size_t)hp * 128 * 128, 128, 128, lds,
                  [&](int r, int c, f32x4_e lo, f32x4_e hi) {
                    *(f32x4_e*)(sc + (size_t)r * DM + c) = lo; *(f32x4_e*)(sc + (size_t)r * DM + c + 4) = hi; });
    __syncthreads();
  }
}

__device__ __forceinline__ void ph_cvt4(const float* src, unsigned char* dst, float* scales, int nrows, int wid0, int nw) {
  typedef __attribute__((ext_vector_type(4))) float f32x4;
  typedef __attribute__((ext_vector_type(2))) float f32x2;
  const int lane = VT() & 63;
  const float one = __uint_as_float((unsigned)opq(0x3F800000));
  float lev[8];
#pragma unroll
  for (int c = 0; c < 8; ++c) {
    const f32x2 q = __builtin_amdgcn_cvt_scalef32_pk_f32_fp4((unsigned)opq(c * 0x11111111), one, 0);
    lev[c] = fabsf(q[0]);
  }
  const float maxlev = lev[7];
  for (int row = wid0; row < nrows; row += nw) {
    const f32x4* s4 = (const f32x4*)(src + (size_t)row * DM) + lane * 8;
    f32x4 v[8];
    float amax = 0.f;
#pragma unroll
    for (int i = 0; i < 8; ++i) {
      v[i] = s4[i];
#pragma unroll
      for (int k = 0; k < 4; ++k) amax = fmaxf(amax, fabsf(v[i][k]));
    }
    amax = wave_max(amax);
    const float sc = (amax > 0.f) ? maxlev / amax : 1.f;
    u32x4 o;
#pragma unroll
    for (int w = 0; w < 4; ++w) {
      unsigned pk = 0u;
      pk = __builtin_amdgcn_cvt_scalef32_pk_fp4_f32(pk, v[2 * w][0] * sc, v[2 * w][1] * sc, 1.0f, 0);
      pk = __builtin_amdgcn_cvt_scalef32_pk_fp4_f32(pk, v[2 * w][2] * sc, v[2 * w][3] * sc, 1.0f, 1);
      pk = __builtin_amdgcn_cvt_scalef32_pk_fp4_f32(pk, v[2 * w + 1][0] * sc, v[2 * w + 1][1] * sc, 1.0f, 2);
      pk = __builtin_amdgcn_cvt_scalef32_pk_fp4_f32(pk, v[2 * w + 1][2] * sc, v[2 * w + 1][3] * sc, 1.0f, 3);
      o[w] = pk;
    }
    *(u32x4*)(dst + (size_t)row * 1024 + lane * 16) = o;
    if (lane == 0) scales[row] = (amax > 0.f) ? amax / maxlev : 1.f;
  }
}

__device__ __forceinline__ float wave_sum_dpp(float v) {
  typedef __attribute__((ext_vector_type(2))) unsigned u32x2_d;
  v += __builtin_bit_cast(float, __builtin_amdgcn_update_dpp(0, __builtin_bit_cast(int, v), 0xB1, 0xF, 0xF, true));
  v += __builtin_bit_cast(float, __builtin_amdgcn_update_dpp(0, __builtin_bit_cast(int, v), 0x4E, 0xF, 0xF, true));
  v += __builtin_bit_cast(float, __builtin_amdgcn_update_dpp(0, __builtin_bit_cast(int, v), 0x141, 0xF, 0xF, true));
  v += __builtin_bit_cast(float, __builtin_amdgcn_update_dpp(0, __builtin_bit_cast(int, v), 0x140, 0xF, 0xF, true));
  u32x2_d r = __builtin_amdgcn_permlane16_swap(__float_as_uint(v), __float_as_uint(v), false, false);
  v = __uint_as_float(r[0]) + __uint_as_float(r[1]);
  r = __builtin_amdgcn_permlane32_swap(__float_as_uint(v), __float_as_uint(v), false, false);
  return __uint_as_float(r[0]) + __uint_as_float(r[1]);
}
__device__ __forceinline__ float gelu_rcp(float x) {
  const float y2 = (1.5957691216057308f * LOG2E) * (x + 0.044715f * x * x * x);
  return x * __builtin_amdgcn_rcpf(1.f + __builtin_amdgcn_exp2f(-y2));
}
__device__ __forceinline__ u32x4 r4_load(const unsigned char* tab, int eid, int lane) {
  return *((const u32x4*)(tab + (size_t)eid * 1024) + lane);
}
struct XPk { f32x16 a, b; };
struct Acc32 { f32x16 a, b; };

typedef __attribute__((ext_vector_type(2))) float f32x2_t;
#define PAIR(v, i) __builtin_shufflevector(v, v, (i), (i) + 1)
#define R4_DOT_W(word, xv, base, sa, sb)                                                             \
  {                                                                                                  \
    const f32x2_t q0 = __builtin_amdgcn_cvt_scalef32_pk_f32_fp4(word, one, 0), q1 = __builtin_amdgcn_cvt_scalef32_pk_f32_fp4(word, one, 1); \
    const f32x2_t q2 = __builtin_amdgcn_cvt_scalef32_pk_f32_fp4(word, one, 2), q3 = __builtin_amdgcn_cvt_scalef32_pk_f32_fp4(word, one, 3); \
    sa = __builtin_elementwise_fma(q0, PAIR(xv, base + 0), sa); sb = __builtin_elementwise_fma(q1, PAIR(xv, base + 2), sb); \
    sa = __builtin_elementwise_fma(q2, PAIR(xv, base + 4), sa); sb = __builtin_elementwise_fma(q3, PAIR(xv, base + 6), sb); \
  }
__device__ __forceinline__ float r4_dot(const u32x4& e, const XPk& x) {
  const float one = __uint_as_float((unsigned)opq(0x3F800000));
  f32x2_t sa = {0.f, 0.f}, sb = {0.f, 0.f};
  R4_DOT_W(e[0], x.a, 0, sa, sb) R4_DOT_W(e[1], x.a, 8, sa, sb) R4_DOT_W(e[2], x.b, 0, sa, sb) R4_DOT_W(e[3], x.b, 8, sa, sb)
  sa = sa + sb;
  return sa[0] + sa[1];
}
#define R4_AXPY_P(accv, i, q)                                                                        \
  { const f32x2_t r_ = __builtin_elementwise_fma(h2, q, PAIR(accv, i)); accv[i] = r_[0]; accv[(i) + 1] = r_[1]; }
#define R4_AXPY_W(word, accv, base)                                                                  \
  {                                                                                                  \
    const f32x2_t q0 = __builtin_amdgcn_cvt_scalef32_pk_f32_fp4(word, one, 0), q1 = __builtin_amdgcn_cvt_scalef32_pk_f32_fp4(word, one, 1); \
    const f32x2_t q2 = __builtin_amdgcn_cvt_scalef32_pk_f32_fp4(word, one, 2), q3 = __builtin_amdgcn_cvt_scalef32_pk_f32_fp4(word, one, 3); \
    R4_AXPY_P(accv, base + 0, q0) R4_AXPY_P(accv, base + 2, q1) R4_AXPY_P(accv, base + 4, q2) R4_AXPY_P(accv, base + 6, q3) \
  }
__device__ __forceinline__ void r4_axpy(const u32x4& e, float hid, Acc32& acc) {
  const float one = __uint_as_float((unsigned)opq(0x3F800000));
  const f32x2_t h2 = {hid, hid};
  R4_AXPY_W(e[0], acc.a, 0) R4_AXPY_W(e[1], acc.a, 8) R4_AXPY_W(e[2], acc.b, 0) R4_AXPY_W(e[3], acc.b, 8)
}

#define INS16(K, x)                                                                                      \
  K##15 = __builtin_amdgcn_fmed3f(K##15, K##14, x); K##14 = __builtin_amdgcn_fmed3f(K##14, K##13, x);   \
  K##13 = __builtin_amdgcn_fmed3f(K##13, K##12, x); K##12 = __builtin_amdgcn_fmed3f(K##12, K##11, x);   \
  K##11 = __builtin_amdgcn_fmed3f(K##11, K##10, x); K##10 = __builtin_amdgcn_fmed3f(K##10, K##9, x);    \
  K##9 = __builtin_amdgcn_fmed3f(K##9, K##8, x); K##8 = __builtin_amdgcn_fmed3f(K##8, K##7, x);         \
  K##7 = __builtin_amdgcn_fmed3f(K##7, K##6, x); K##6 = __builtin_amdgcn_fmed3f(K##6, K##5, x);         \
  K##5 = __builtin_amdgcn_fmed3f(K##5, K##4, x); K##4 = __builtin_amdgcn_fmed3f(K##4, K##3, x);         \
  K##3 = __builtin_amdgcn_fmed3f(K##3, K##2, x); K##2 = __builtin_amdgcn_fmed3f(K##2, K##1, x);         \
  K##1 = __builtin_amdgcn_fmed3f(K##1, K##0, x); K##0 = fmaxf(K##0, x);
#define DECL16(K) float K##0 = -INFINITY, K##1 = -INFINITY, K##2 = -INFINITY, K##3 = -INFINITY, K##4 = -INFINITY, \
  K##5 = -INFINITY, K##6 = -INFINITY, K##7 = -INFINITY, K##8 = -INFINITY, K##9 = -INFINITY, K##10 = -INFINITY,   \
  K##11 = -INFINITY, K##12 = -INFINITY, K##13 = -INFINITY, K##14 = -INFINITY, K##15 = -INFINITY;
__device__ __forceinline__ float mkkey(float v, unsigned tag, unsigned mask) {
  return __uint_as_float((__float_as_uint(v) & ~mask) | tag);
}

__device__ __forceinline__ void ph_peer(const P& p, float* smem) {
  typedef __attribute__((ext_vector_type(4))) float f32x4;
  float* lists = smem;
  int* bexA = (int*)(smem + 4096);
  float* bgtA = smem + 6144;
  float* bsuA = smem + 8192;
  for (int item = VB(); item < T_TOK / 16; item += VG()) {
    const int t0 = item * 16;
    vsync();
    {
      const int tid = VT();
      const int tl = tid >> 4, hp = tid & 15;
      const f32x4* sp = (const f32x4*)(p.scores + (size_t)(t0 + tl) * DM + hp * 128);
      DECL16(k)
#pragma unroll 4
      for (int c4 = 0; c4 < 32; ++c4) {
        const f32x4 v = sp[c4];
#pragma unroll
        for (int e = 0; e < 4; ++e) {
          const float x = mkkey(v[e], 127u - (unsigned)(c4 * 4 + e), 127u);
          INS16(k, x)
        }
      }
      f32x4* lp = (f32x4*)(lists + (size_t)VT() * 16);
      f32x4 o0 = {k0, k1, k2, k3}, o1 = {k4, k5, k6, k7}, o2 = {k8, k9, k10, k11}, o3 = {k12, k13, k14, k15};
      lp[0] = o0; lp[1] = o1; lp[2] = o2; lp[3] = o3;
    }
    vsync();
    if (VT() < 128) {
      const int tid = VT();
      const int tl = tid >> 3, h = tid & 7;
      const float* la = lists + (size_t)(tl * 16 + 2 * h) * 16;
      const float* lb = la + 16;
      float av[16], bv[16];
#pragma unroll
      for (int i = 0; i < 16; ++i) {
        av[i] = __uint_as_float(__float_as_uint(la[i]) & ~127u);
        bv[i] = __uint_as_float(__float_as_uint(lb[i]) & ~127u);
      }
      DECL16(c)
#pragma unroll
      for (int i = 0; i < 16; ++i) {
#pragma unroll
        for (int j = 0; j < 16; ++j) {
          if ((i + 1) * (j + 1) <= 16) {
            const float x = mkkey(av[i] + bv[j], 255u - (unsigned)(i * 16 + j), 255u);
            INS16(c, x)
          }
        }
      }
      float cs[16] = {c0, c1, c2, c3, c4, c5, c6, c7, c8, c9, c10, c11, c12, c13, c14, c15};
      float ev[16];
      float sum = 0.f;
      const float mx = __uint_as_float(__float_as_uint(cs[0]) & ~255u);
#pragma unroll
      for (int n = 0; n < 16; ++n) {
        ev[n] = __expf(__uint_as_float(__float_as_uint(cs[n]) & ~255u) - mx);
        sum += ev[n];
      }
      const float isum = 1.f / sum;
#pragma unroll
      for (int n = 0; n < 16; ++n) {
        const unsigned cc = 255u - (__float_as_uint(cs[n]) & 255u);
        const unsigned ka = 127u - (__float_as_uint(la[cc >> 4]) & 127u);
        const unsigned kb = 127u - (__float_as_uint(lb[cc & 15u]) & 127u);
        const int eid = (int)(ka * 128u + kb);
        bexA[tl * 128 + h * 16 + n] = eid;
        bgtA[tl * 128 + h * 16 + n] = ev[n] * isum * p.sv8[eid];
        bsuA[tl * 128 + h * 16 + n] = p.su8[eid];
      }
    }
    vsync();
#pragma unroll 1
    for (int ti4 = 0; ti4 < 4; ++ti4) {
    const int lane = VT() & 63, wv = VT() >> 6;
    const int tl = wv * 4 + ti4;
    const int t = t0 + tl;
    const int* bex = bexA + tl * 128;
    const float* bgt = bgtA + tl * 128;
    const float* bsu = bsuA + tl * 128;
    XPk x;
    {
      const f32x4* s4 = (const f32x4*)(p.out + (size_t)t * DM) + lane * 8;
      const f32x4* g4 = (const f32x4*)p.norm_ffn + lane * 8;
      f32x4 a0 = s4[0], a1 = s4[1], a2 = s4[2], a3 = s4[3], a4 = s4[4], a5 = s4[5], a6 = s4[6], a7 = s4[7];
      float ss = 0.f;
#define SSQ(v) ss += v[0] * v[0] + v[1] * v[1] + v[2] * v[2] + v[3] * v[3];
      SSQ(a0) SSQ(a1) SSQ(a2) SSQ(a3) SSQ(a4) SSQ(a5) SSQ(a6) SSQ(a7)
#undef SSQ
      ss = wave_sum(ss);
      const float rs = rsqrtf(ss * (1.f / DM) + RMS_EPS);
#define XPK(dst, base, va, vb, gi)                                                    \
  {                                                                                   \
    const f32x4 ga = g4[gi], gb = g4[gi + 1];                                         \
    dst[base + 0] = bf2f(f2bf(va[0] * rs * ga[0])); dst[base + 1] = bf2f(f2bf(va[1] * rs * ga[1]));   \
    dst[base + 2] = bf2f(f2bf(va[2] * rs * ga[2])); dst[base + 3] = bf2f(f2bf(va[3] * rs * ga[3]));   \
    dst[base + 4] = bf2f(f2bf(vb[0] * rs * gb[0])); dst[base + 5] = bf2f(f2bf(vb[1] * rs * gb[1]));   \
    dst[base + 6] = bf2f(f2bf(vb[2] * rs * gb[2])); dst[base + 7] = bf2f(f2bf(vb[3] * rs * gb[3]));   \
  }
      XPK(x.a, 0, a0, a1, 0) XPK(x.a, 8, a2, a3, 2) XPK(x.b, 0, a4, a5, 4) XPK(x.b, 8, a6, a7, 6)
#undef XPK
    }
    Acc32 acc;
#pragma unroll
    for (int r = 0; r < 16; ++r) { acc.a[r] = 0.f; acc.b[r] = 0.f; }
#define SID(i) __builtin_amdgcn_readfirstlane(bex[i])
#define SFL(arr, i) __uint_as_float((unsigned)__builtin_amdgcn_readfirstlane((int)__float_as_uint(arr[i])))
    u32x4 u0 = r4_load(p.pu8, SID(0), lane), u1 = r4_load(p.pu8, SID(1), lane), u2 = r4_load(p.pu8, SID(2), lane), u3 = r4_load(p.pu8, SID(3), lane);
    u32x4 v0 = r4_load(p.pv8, SID(0), lane), v1 = r4_load(p.pv8, SID(1), lane), v2 = r4_load(p.pv8, SID(2), lane), v3 = r4_load(p.pv8, SID(3), lane);
#pragma unroll 1
    for (int e0 = 0; e0 < 128; e0 += 4) {
      float d0 = r4_dot(u0, x), d1 = r4_dot(u1, x), d2 = r4_dot(u2, x), d3 = r4_dot(u3, x);
      const int en = (e0 + 4 < 128) ? e0 + 4 : 124;
      const int i0 = SID(en), i1 = SID(en + 1), i2 = SID(en + 2), i3 = SID(en + 3);
      u0 = r4_load(p.pu8, i0, lane); u1 = r4_load(p.pu8, i1, lane); u2 = r4_load(p.pu8, i2, lane); u3 = r4_load(p.pu8, i3, lane);
      d0 = wave_sum_dpp(d0); d1 = wave_sum_dpp(d1); d2 = wave_sum_dpp(d2); d3 = wave_sum_dpp(d3);
      { const float hid = SFL(bgt, e0 + 0) * gelu_rcp(d0 * SFL(bsu, e0 + 0)); r4_axpy(v0, hid, acc); }
      { const float hid = SFL(bgt, e0 + 1) * gelu_rcp(d1 * SFL(bsu, e0 + 1)); r4_axpy(v1, hid, acc); }
      { const float hid = SFL(bgt, e0 + 2) * gelu_rcp(d2 * SFL(bsu, e0 + 2)); r4_axpy(v2, hid, acc); }
      { const float hid = SFL(bgt, e0 + 3) * gelu_rcp(d3 * SFL(bsu, e0 + 3)); r4_axpy(v3, hid, acc); }
      v0 = r4_load(p.pv8, i0, lane); v1 = r4_load(p.pv8, i1, lane); v2 = r4_load(p.pv8, i2, lane); v3 = r4_load(p.pv8, i3, lane);
    }
#undef SID
#undef SFL
    const int lane2 = opq(lane);
    f32x4* o4 = (f32x4*)(p.out + (size_t)t * DM) + lane2 * 8;
    const f32x4* g4 = (const f32x4*)p.norm_final + lane2 * 8;
    f32x4 hv[8];
    float ss = 0.f;
#pragma unroll
    for (int i = 0; i < 8; ++i) {
      hv[i] = o4[i];
#pragma unroll
      for (int k = 0; k < 4; ++k) {
        hv[i][k] += (i < 4) ? acc.a[4 * i + k] : acc.b[4 * (i - 4) + k];
        ss += hv[i][k] * hv[i][k];
      }
    }
    ss = wave_sum(ss);
    const float rs = rsqrtf(ss * (1.f / DM) + RMS_EPS);
#pragma unroll
    for (int i = 0; i < 8; ++i) {
      const f32x4 g = g4[i];
      f32x4 o;
#pragma unroll
      for (int k = 0; k < 4; ++k) o[k] = hv[i][k] * rs * g[k];
      o4[i] = o;
    }
    }
  }
}

#define XB_TMO      128
#define XB_XCNT(j)  (256  + 64 * (j))
#define XB_XSUB(j)  (1280 + 64 * (j))
#define XB_XGEN(j)  (2304 + 64 * (j))
#define XB_TOP      3328
#define XB_TOPGEN   3392
#define XCD_BAR_WORDS 3456
#define XB_SPIN_CAP (1u << 22)
__device__ __forceinline__ unsigned xb_ld(unsigned* p) { return __hip_atomic_load(p, __ATOMIC_RELAXED, __HIP_MEMORY_SCOPE_AGENT); }
__device__ __forceinline__ unsigned xb_add(unsigned* p, unsigned v) { return __hip_atomic_fetch_add(p, v, __ATOMIC_RELAXED, __HIP_MEMORY_SCOPE_AGENT); }
__device__ __forceinline__ unsigned xb_xcc_id() { return (unsigned)__builtin_amdgcn_s_getreg((3 << 11) | 20) & 0xFu; }
#define XB_SPIN(cond, bar) do { unsigned _sp = 0; while (cond) { __builtin_amdgcn_s_sleep(1); \
    if ((++_sp & 255u) == 0u) { if (xb_ld(&(bar)[XB_TMO])) break; if (_sp > XB_SPIN_CAP) { atomicAdd(&(bar)[XB_TMO], 1u); break; } } } } while (0)
struct XcdBarrier { unsigned* bar; unsigned x; volatile LAS unsigned* st; };
__device__ __forceinline__ XcdBarrier xcd_barrier_post(unsigned* bar, volatile LAS unsigned* st) {
  XcdBarrier b; b.bar = bar; b.x = xb_xcc_id(); b.st = st;
  if (threadIdx.x == 0) (void)xb_add(&bar[XB_XCNT(b.x)], 1u);
  return b;
}
__device__ __forceinline__ void xcd_barrier_complete(unsigned* bar, unsigned x, unsigned& nloc, unsigned& nx) {
  const unsigned G = gridDim.x * gridDim.y * gridDim.z;
  unsigned sum, cnt, mine, sp = 0u;
  for (;;) {
    sum = 0u; cnt = 0u; mine = 0u;
#pragma unroll
    for (unsigned j = 0; j < 16; ++j) { const unsigned c = xb_ld(&bar[XB_XCNT(j)]); sum += c; cnt += (c > 0u) ? 1u : 0u; mine = (j == x) ? c : mine; }
    if (sum == G) break;
    __builtin_amdgcn_s_sleep(1);
    if ((++sp & 255u) == 0u) { if (xb_ld(&bar[XB_TMO])) break; if (sp > XB_SPIN_CAP) { atomicAdd(&bar[XB_TMO], 1u); break; } }
  }
  nloc = mine > 0u ? mine : 1u; nx = cnt > 0u ? cnt : 1u;
}
__device__ __forceinline__ void xcd_barrier(const XcdBarrier& b) {
  asm volatile("s_waitcnt vmcnt(0)" ::: "memory");
  __syncthreads();
  if (threadIdx.x == 0) {
    unsigned* bar = b.bar;
    __builtin_amdgcn_s_waitcnt(0);
    unsigned nloc = b.st[0], nx = b.st[1];
    if (nloc == 0u) { xcd_barrier_complete(bar, b.x, nloc, nx); b.st[0] = nloc; b.st[1] = nx; }
    const unsigned old = xb_add(&bar[XB_XSUB(b.x)], 1u);
    const unsigned gen = old / nloc;
    if (old + 1u == (gen + 1u) * nloc) {
      __builtin_amdgcn_fence(__ATOMIC_RELEASE, "agent");
      asm volatile("s_waitcnt vmcnt(0)" ::: "memory");
      const unsigned og = xb_add(&bar[XB_TOP], 1u);
      const unsigned tg = og / nx;
      if (og + 1u == (tg + 1u) * nx) xb_add(&bar[XB_TOPGEN], 1u);
      else XB_SPIN(xb_ld(&bar[XB_TOPGEN]) == tg, bar);
      __builtin_amdgcn_fence(__ATOMIC_ACQUIRE, "agent");
      xb_add(&bar[XB_XGEN(b.x)], 1u);
      asm volatile("s_waitcnt vmcnt(0)" ::: "memory");
    } else {
      XB_SPIN(xb_ld(&bar[XB_XGEN(b.x)]) == gen, bar);
      __builtin_amdgcn_fence(__ATOMIC_ACQUIRE, "agent");
      asm volatile("s_waitcnt vmcnt(0)" ::: "memory");
    }
  }
  __syncthreads();
}

typedef const __attribute__((address_space(4))) P* KP;
__device__ __forceinline__ P loadP() {
#if defined(__HIP_DEVICE_COMPILE__)
  KP k = (KP)__builtin_amdgcn_kernarg_segment_ptr();
  asm volatile("" : "+s"(k));
  P p = *k;
  return p;
#else
  return P{};
#endif
}

__global__ void __launch_bounds__(512, 2) mega(P p_arg) {
  cg::grid_group grid = cg::this_grid();
  __shared__ __attribute__((aligned(16))) float smem_all[2 * 18432 + 64];
  float* smem = smem_all + (threadIdx.x >> 8) * 18432;
  char* lds = (char*)smem;
  unsigned* xbw = (unsigned*)(smem_all + 2 * 18432 + 32);
  if (threadIdx.x < 64) ((unsigned*)(smem_all + 2 * 18432))[threadIdx.x] = 0u;
  if (blockIdx.x == 0) {
    P p = loadP();
    for (int i = threadIdx.x; i < XCD_BAR_WORDS; i += 512) p.bar[i] = 0u;
  }
  __syncthreads();
  { P p = loadP(); ph_rmsnorm(p.x, p.norm_mix, p.hn, T_TOK); ph_rmsnorm(p.mem, p.norm_mkv, p.memn, 1024); }
  { P p = loadP(); ph_transpose<true>(smem, p.w_in, DM, INC, 5760, p.WinT); }
  { P p = loadP(); ph_transpose<false>(smem, p.w_mk, DM, 512, 512, p.WmkT); }
  { P p = loadP(); ph_transpose<false>(smem, p.w_mv, DM, 512, 512, p.WmvT); }
  { P p = loadP(); ph_cvt(p.subk, p.subkb, (size_t)16 * 128 * 128); }
  { P p = loadP(); ph_transpose<false>(smem, p.w1_k, 4096, 128, 128, p.w1T); }
  { P p = loadP(); ph_transpose<false>(smem, p.w1_v, 4096, 128, 128, p.w1T + 128 * 4096); }
  { P p = loadP(); ph_transpose<false>(smem, p.w2_k, 128, 128, 128, p.w2T); }
  { P p = loadP(); ph_transpose<false>(smem, p.w2_v, 128, 128, 128, p.w2T + 128 * 128); }
  { P p = loadP(); ph_posb(p); }
  { P p = loadP(); for (int i = VB() * 256 + VT(); i < 2 * T_TOK; i += VG() * 256) p.rowss[i] = 0.f; }
  grid.sync();
  XcdBarrier xb;
  { P p = loadP(); xb = xcd_barrier_post(p.bar, (volatile LAS unsigned*)xbw); }
  { P p = loadP(); ph_proj(p, (char*)smem_all, lds); }
  const int kvb = (VG() == 512) ? ((VB() >= 384 && VB() < 416) ? (VB() - 384) * 8 : -1) : -2;
  const int vvb = (VG() == 512) ? ((VB() >= 416 && VB() < 448) ? (VB() - 416) * 8 : -1) : -2;
  { P p = loadP(); bf16_t* kmem = p.kmemb;
    ph_gemm_bf16(p.memn, DM, p.WmkT, DM, 1024, 512, DM, lds, [=](int m, int n, float v) {
      kmem[((size_t)((m >> 8) * 4 + (n >> 7)) * 256 + (m & 255)) * 128 + (n & 127)] = f2bf(v); }, kvb); }
  { P p = loadP(); bf16_t* vmem = p.vmemT;
    ph_gemm_bf16(p.memn, DM, p.WmvT, DM, 1024, 512, DM, lds, [=](int m, int n, float v) {
      vmem[((size_t)((m >> 8) * 4 + (n >> 7)) * 128 + (n & 127)) * 256 + perm16(m & 255)] = f2bf(v); }, vvb); }
  xcd_barrier(xb);
  { P p = loadP(); ph_compress2(p, lds); }
  { P p = loadP(); ph_sb2(p, lds); }
  {
    const int skip = (VG() > 32) ? 16 : 0;
    const int vb = (VB() >= skip) ? VB() - skip : -1, nvb = VG() - skip;
    vsync();
    { P p = loadP(); ph_transpose<false>(smem, p.w_out, DM, DM, DM, p.WoutT, vb, nvb); }
    { P p = loadP(); ph_transpose<false>(smem, p.w_mq, DM, 512, 512, p.WmqT, vb, nvb); }
  }
  xcd_barrier(xb);
  { P p = loadP(); ph_nsa2(p, lds); }
  xcd_barrier(xb);
  { P p = loadP(); float* out = p.out; const float* x = p.x; const float* gmq = p.norm_mq; bf16_t* hn = p.hn; float* rss = p.rowss;
    ph_gemm_huge(p.omix, DM, p.WoutT, DM, T_TOK, DM, DM, (char*)smem_all, [=](int m, int n, f32x4_e lo, f32x4_e hi) {
      const f32x4_e x0 = *(const f32x4_e*)(x + (size_t)m * DM + n), x1 = *(const f32x4_e*)(x + (size_t)m * DM + n + 4);
      const f32x4_e h0 = x0 + lo, h1 = x1 + hi;
      *(f32x4_e*)(out + (size_t)m * DM + n) = h0; *(f32x4_e*)(out + (size_t)m * DM + n + 4) = h1;
      norm_feed(h0, h1, gmq, n, hn + (size_t)m * DM, rss + m); }); }
  xcd_barrier(xb);
  {
    const int half = (VG() >= 512) ? 256 : 0;
    if (half == 0 || VB() < half) { P p = loadP(); ph_memq_attn(p, lds, VB(), half ? half : VG()); }
    if (VB() >= half) {
      const int nwv = (VG() - half) * 4, wid = (VB() - half) * 4 + (VT() >> 6);
      vsync();
      { P p = loadP(); ph_transpose<false>(smem, p.w_mo, 512, DM, DM, p.WmoT, VB() - half, VG() - half); }
      { P p = loadP(); ph_cvt4(p.pu, p.pu8, p.su8, 16384, wid, nwv); }
      { P p = loadP(); ph_cvt4(p.pv, p.pv8, p.sv8, 16384, wid, nwv); }
      vsync();
      { P p = loadP(); ph_transpose<false>(smem, p.w_pq, DM, DM, DM, p.WpqT, VB() - half, VG() - half); }
    }
  }
  xcd_barrier(xb);
  { P p = loadP(); float* out = p.out; const float* gffn = p.norm_ffn; bf16_t* hn = p.hn; float* rss = p.rowss + T_TOK;
    ph_gemm_huge(p.omem, 512, p.WmoT, 512, T_TOK, DM, 512, (char*)smem_all, [=](int m, int n, f32x4_e lo, f32x4_e hi) {
      f32x4_e* o0 = (f32x4_e*)(out + (size_t)m * DM + n);
      const f32x4_e h0 = o0[0] + lo, h1 = o0[1] + hi;
      o0[0] = h0; o0[1] = h1;
      norm_feed(h0, h1, gffn, n, hn + (size_t)m * DM, rss + m); }); }
  xcd_barrier(xb);
  { P p = loadP(); ph_qp_scores<0>(p, (char*)smem_all, lds); }
  xcd_barrier(xb);
  { P p = loadP(); ph_peer(p, smem); }
}

extern "C" void kernel_launch(void* const* d_in, const int* in_sizes, int n_in, void* d_out, int out_size, void* d_ws,
                              size_t ws_size, hipStream_t stream) {
  P p{};
  p.x = (const float*)d_in[0]; p.mem = (const float*)d_in[1]; p.t5 = (const float*)d_in[2];
  p.norm_mix = (const float*)d_in[3]; p.w_in = (const float*)d_in[4]; p.pos_k = (const float*)d_in[5];
  p.w1_k = (const float*)d_in[6]; p.w2_k = (const float*)d_in[7]; p.pos_v = (const float*)d_in[8];
  p.w1_v = (const float*)d_in[9]; p.w2_v = (const float*)d_in[10]; p.w_out = (const float*)d_in[11];
  p.norm_mq = (const float*)d_in[12]; p.norm_mkv = (const float*)d_in[13]; p.w_mq = (const float*)d_in[14];
  p.w_mk = (const float*)d_in[15]; p.w_mv = (const float*)d_in[16]; p.w_mo = (const float*)d_in[17];
  p.norm_ffn = (const float*)d_in[18]; p.w_pq = (const float*)d_in[19]; p.subk = (const float*)d_in[20];
  p.pu = (const float*)d_in[21]; p.pv = (const float*)d_in[22]; p.norm_final = (const float*)d_in[23];
  p.out = (float*)d_out;
  char* w = (char*)d_ws;
  size_t off = 0;
  auto take = [&](size_t bytes) { char* r = w + off; off += (bytes + 255) & ~(size_t)255; return r; };
  p.bar = (unsigned*)take(XCD_BAR_WORDS * 4);
  p.scores = (float*)take((size_t)T_TOK * DM * 4);
  p.gates = (float*)take((size_t)T_TOK * 24 * 4);
  p.part = (float*)take((size_t)T_TOK * 1024 * 4);
  p.posb = (float*)take(256 * 4);
  p.rowss = (float*)take((size_t)2 * T_TOK * 4);
  p.qn = (bf16_t*)take((size_t)T_TOK * 1024 * 2);
  p.kcin = (bf16_t*)take((size_t)T_TOK * 256 * 2 + 65536);
  p.vcin = (bf16_t*)take((size_t)T_TOK * 256 * 2 + 65536);
  p.ks = (bf16_t*)take((size_t)T_TOK * 256 * 2);
  p.vsT = (bf16_t*)take((size_t)T_TOK * 256 * 2);
  p.kw = (bf16_t*)take((size_t)T_TOK * 256 * 2);
  p.vwT = (bf16_t*)take((size_t)T_TOK * 256 * 2);
  p.kcb = (bf16_t*)take((size_t)8 * 128 * 128 * 2);
  p.vcT = (bf16_t*)take((size_t)8 * 128 * 128 * 2);
  p.c1 = (bf16_t*)take((size_t)16 * 128 * 128 * 2);
  p.w1T = (bf16_t*)take((size_t)2 * 128 * 4096 * 2);
  p.w2T = (bf16_t*)take((size_t)2 * 128 * 128 * 2);
  p.hn = (bf16_t*)take((size_t)T_TOK * DM * 2);
  p.omix = (bf16_t*)take((size_t)T_TOK * DM * 2);
  p.memn = (bf16_t*)take((size_t)1024 * DM * 2);
  p.omem = (bf16_t*)take((size_t)T_TOK * 512 * 2);
  p.WinT = (bf16_t*)take((size_t)5760 * DM * 2);
  p.WoutT = (bf16_t*)take((size_t)DM * DM * 2);
  p.WpqT = (bf16_t*)take((size_t)DM * DM * 2);
  p.WmqT = (bf16_t*)take((size_t)512 * DM * 2);
  p.WmkT = (bf16_t*)take((size_t)512 * DM * 2);
  p.WmvT = (bf16_t*)take((size_t)512 * DM * 2);
  p.WmoT = (bf16_t*)take((size_t)DM * 512 * 2);
  p.qmemb = (bf16_t*)take((size_t)T_TOK * 512 * 2);
  p.kmemb = (bf16_t*)take((size_t)1024 * 512 * 2);
  p.vmemT = (bf16_t*)take((size_t)1024 * 512 * 2);
  p.qsb = (bf16_t*)take((size_t)T_TOK * 1024 * 2);
  p.ksb = (bf16_t*)take((size_t)T_TOK * 1024 * 2);
  p.vsbT = (bf16_t*)take((size_t)T_TOK * 1024 * 2);
  p.pu8 = (unsigned char*)take((size_t)16384 * 1024);
  p.pv8 = (unsigned char*)take((size_t)16384 * 1024);
  p.su8 = (float*)take(16384 * 4);
  p.sv8 = (float*)take(16384 * 4);
  p.subkb = (bf16_t*)take((size_t)16 * 128 * 128 * 2);
  static int grid_blocks = 0;
  if (!grid_blocks) {
    int dev = 0, cus = 0, per_cu = 0;
    (void)hipGetDevice(&dev);
    (void)hipDeviceGetAttribute(&cus, hipDeviceAttributeMultiprocessorCount, dev);
    (void)hipOccupancyMaxActiveBlocksPerMultiprocessor(&per_cu, mega, 512, 0);
    if (per_cu > 1) per_cu = 1;
    if (per_cu < 1) per_cu = 1;
    grid_blocks = cus * per_cu;
  }
  void* args[] = {&p};
  hipError_t e = hipLaunchCooperativeKernel((void*)mega, dim3(grid_blocks), dim3(512), args, 0, stream);
  if (e != hipSuccess) fprintf(stderr, "cooperative launch failed: %s (grid %d)\n", hipGetErrorString(e), grid_blocks);
}
```

```cpp
#include <hip/hip_runtime.h>
#include <hip/hip_cooperative_groups.h>
#include <cstdio>
namespace cg = cooperative_groups;
#include <stdint.h>

#define SEQ 2048
#define NBATCH 4
#define T_TOK 8192
#define DM 2048
#define INC 5656
#define C_QN 0
#define C_KC 1024
#define C_VC 1280
#define C_KS 1536
#define C_VS 1792
#define C_KW 2048
#define C_VW 2304
#define C_GT 2560
#define C_QSB 2584
#define C_KSB 3608
#define C_VSB 4632
#define ATT_SCALE 0.08838834764831845f
#define LOG2E 1.4426950408889634f
#define ATT_SCALE2 (ATT_SCALE * LOG2E)
#define RMS_EPS 1e-6f

typedef unsigned short bf16_t;
typedef __attribute__((ext_vector_type(8))) short bf16x8;
typedef __attribute__((ext_vector_type(16))) float f32x16;
typedef __attribute__((ext_vector_type(2))) __bf16 bf16v2;
typedef __attribute__((ext_vector_type(4))) unsigned u32x4;

struct P {
  const float *x, *mem, *t5, *norm_mix, *w_in, *pos_k, *w1_k, *w2_k, *pos_v, *w1_v, *w2_v, *w_out,
      *norm_mq, *norm_mkv, *w_mq, *w_mk, *w_mv, *w_mo, *norm_ffn, *w_pq, *subk, *pu, *pv, *norm_final;
  float* out;
  float *scores, *gates, *part, *posb, *rowss;
  unsigned* bar;
  bf16_t *hn, *omix, *memn, *omem;
  bf16_t *WinT, *WoutT, *WpqT, *WmqT, *WmkT, *WmvT, *WmoT;
  bf16_t *qmemb, *kmemb, *vmemT;
  bf16_t *qsb, *ksb, *vsbT;
  bf16_t* subkb;
  unsigned char *pu8, *pv8;
  float *su8, *sv8;
  bf16_t *qn, *kcin, *vcin, *ks, *vsT, *kw, *vwT, *kcb, *vcT, *c1, *w1T, *w2T;
};

__device__ __forceinline__ int opq(int v) { asm volatile("" : "+v"(v)); return v; }
#define LAS __attribute__((address_space(3)))
#define VHALF_BYTES 73728
#define VCNT_OFF (2 * VHALF_BYTES)
__device__ __forceinline__ int VT() { return opq(threadIdx.x) & 255; }
__device__ __forceinline__ int VB() { return (int)blockIdx.x * 2 + (int)(threadIdx.x >> 8); }
__device__ __forceinline__ int VG() { return (int)gridDim.x * 2; }
__device__ __forceinline__ void vbar_wait() {
  if ((threadIdx.x & 63) == 0) {
    LAS unsigned* c = (LAS unsigned*)(unsigned)(VCNT_OFF + 64 * (int)(threadIdx.x >> 8));
    const unsigned old = __hip_atomic_fetch_add(c, 1u, __ATOMIC_RELAXED, __HIP_MEMORY_SCOPE_WORKGROUP);
    const unsigned target = (old & ~3u) + 4u;
    while (__hip_atomic_load(c, __ATOMIC_RELAXED, __HIP_MEMORY_SCOPE_WORKGROUP) < target) __builtin_amdgcn_s_sleep(0);
  }
}
__device__ __forceinline__ void vsync() {
  __builtin_amdgcn_fence(__ATOMIC_RELEASE, "workgroup");
  vbar_wait();
  __builtin_amdgcn_fence(__ATOMIC_ACQUIRE, "workgroup");
}
__device__ __forceinline__ void vsync_raw() {
  asm volatile("" ::: "memory");
  vbar_wait();
  asm volatile("" ::: "memory");
}

__device__ __forceinline__ unsigned pack2(float a, float b) {
  bf16v2 r = {(__bf16)a, (__bf16)b};
  return *(unsigned*)&r;
}
__device__ __forceinline__ bf16_t f2bf(float a) {
  __bf16 r = (__bf16)a;
  return *(bf16_t*)&r;
}
__device__ __forceinline__ int perm16(int s) { return (s & ~12) | ((s & 4) << 1) | ((s & 8) >> 1); }
__device__ __forceinline__ float bf2f(bf16_t u) { return __uint_as_float((unsigned)u << 16); }

__device__ __forceinline__ float wave_max(float v) {
  for (int o = 32; o > 0; o >>= 1) v = fmaxf(v, __shfl_xor(v, o));
  return v;
}
__device__ __forceinline__ float wave_sum(float v) {
  for (int o = 32; o > 0; o >>= 1) v += __shfl_xor(v, o);
  return v;
}
__device__ __forceinline__ void wave_argmax(float& v, int& i) {
  for (int o = 32; o > 0; o >>= 1) {
    float ov = __shfl_xor(v, o);
    int oi = __shfl_xor(i, o);
    if (ov > v || (ov == v && oi < i)) { v = ov; i = oi; }
  }
}
__device__ __forceinline__ float gelu_tanh(float x) {
  return 0.5f * x * (1.f + tanhf(0.7978845608028654f * (x + 0.044715f * x * x * x)));
}
__device__ __forceinline__ float gelu_fast(float x) {
  const float y = 1.5957691216057308f * (x + 0.044715f * x * x * x);
  return x / (1.f + __expf(-y));
}
__device__ __forceinline__ int t5_bucket(int n) {
  if (n < 16) return n < 0 ? 0 : n;
  int b = 16;
  b += (n >= 19); b += (n >= 21); b += (n >= 24); b += (n >= 27); b += (n >= 31); b += (n >= 35);
  b += (n >= 40); b += (n >= 46); b += (n >= 52); b += (n >= 59); b += (n >= 67); b += (n >= 77);
  b += (n >= 87); b += (n >= 99); b += (n >= 113);
  return b;
}
__device__ __forceinline__ float log_sigmoid(float x) {
  return fminf(x, 0.f) - log1pf(expf(-fabsf(x)));
}

__device__ __forceinline__ void ph_rmsnorm(const float* src, const float* gain, bf16_t* dst, int rows) {
  int lane = VT() & 63, wv = VT() >> 6;
  for (int r = VB() * 4 + wv; r < rows; r += VG() * 4) {
    const float4* s4 = (const float4*)(src + (size_t)r * DM);
    float4 v[8];
    float ss = 0.f;
#pragma unroll
    for (int i = 0; i < 8; ++i) {
      v[i] = s4[i * 64 + lane];
      ss += v[i].x * v[i].x + v[i].y * v[i].y + v[i].z * v[i].z + v[i].w * v[i].w;
    }
    ss = wave_sum(ss);
    float rs = rsqrtf(ss * (1.f / DM) + RMS_EPS);
    uint2* d2 = (uint2*)(dst + (size_t)r * DM);
    const float4* g4 = (const float4*)gain;
#pragma unroll
    for (int i = 0; i < 8; ++i) {
      float4 g = g4[i * 64 + lane];
      uint2 o;
      o.x = pack2(v[i].x * rs * g.x, v[i].y * rs * g.y);
      o.y = pack2(v[i].z * rs * g.z, v[i].w * rs * g.w);
      d2[i * 64 + lane] = o;
    }
  }
}

template <bool CMAP>
__device__ __forceinline__ void ph_transpose(float* smem, const float* W, int K, int N, int Npad, bf16_t* Wt,
                                             int vblock = -2, int nvb = 0, const float* gk = nullptr) {
  typedef __attribute__((ext_vector_type(4))) float f32x4;
  float (*tl)[65] = (float (*)[65])smem;
  if (vblock == -1) return;
  const int b0 = (vblock >= 0) ? vblock : VB(), bstride = (vblock >= 0) ? nvb : VG();
  const int tid = VT();
  const int nk = K / 64, nn = Npad / 64;
  for (int tile = b0; tile < nk * nn; tile += bstride) {
    const int k0 = (tile % nk) * 64, n0 = (tile / nk) * 64;
    const int kr = tid >> 4, n4 = (tid & 15) * 4;
    int sc = n0 + n4;
    if (CMAP) sc = (sc < 2560) ? sc : (sc < 5632) ? sc + 24 : (sc < 5656) ? sc - 5632 + 2560 : N;
#pragma unroll
    for (int i = 0; i < 4; ++i) {
      const int k = kr + 16 * i;
      f32x4 v = {0.f, 0.f, 0.f, 0.f};
      if (sc < N) v = *(const f32x4*)(W + (size_t)(k0 + k) * N + sc);
      if (gk) v *= gk[k0 + k];
      tl[k][n4 + 0] = v[0]; tl[k][n4 + 1] = v[1]; tl[k][n4 + 2] = v[2]; tl[k][n4 + 3] = v[3];
    }
    vsync();
    int n = tid >> 2, kc = (tid & 3) * 16;
    unsigned w[8];
#pragma unroll
    for (int i = 0; i < 8; ++i) w[i] = pack2(tl[kc + 2 * i][n], tl[kc + 2 * i + 1][n]);
    uint4* dst = (uint4*)(Wt + (size_t)(n0 + n) * K + k0 + kc);
    dst[0] = make_uint4(w[0], w[1], w[2], w[3]);
    dst[1] = make_uint4(w[4], w[5], w[6], w[7]);
    vsync();
  }
}

__device__ __forceinline__ int lds_off(int row, int chunk) { return row * 128 + ((chunk ^ ((row >> 1) & 7)) << 4); }

template <bool TR, bool VEC = false, class Epi>
__device__ __forceinline__ void gemm_tile_bf16(const bf16_t* xp, int ldx, const bf16_t* yp, int ldy, int K, char* lds,
                                               Epi epi) {
  const int tid = VT(), lane = tid & 63, wv = tid >> 6;
  const int wr = wv >> 1, wc = wv & 1;
  f32x16 acc[2][2];
#pragma unroll
  for (int i = 0; i < 2; ++i)
#pragma unroll
    for (int j = 0; j < 2; ++j)
#pragma unroll
      for (int r = 0; r < 16; ++r) acc[i][j][r] = 0.f;
  const int prow = lane >> 3, pch = lane & 7;
  const bf16_t* xs[4];
  const bf16_t* ys[4];
#pragma unroll
  for (int ps = 0; ps < 4; ++ps) {
    const int row = (wv * 4 + ps) * 8 + prow;
    const int c = pch ^ ((row >> 1) & 7);
    xs[ps] = xp + (size_t)row * ldx + c * 8;
    ys[ps] = yp + (size_t)row * ldy + c * 8;
  }
  char* const mydst = lds + wv * 4096 + lane * 16;
#define GEMM_ISSUE(k0, bufoff)                                                                                              \
  _Pragma("unroll") for (int ps = 0; ps < 4; ++ps) {                                                                        \
    __builtin_amdgcn_global_load_lds((const unsigned*)(xs[ps] + (k0)), (unsigned*)(mydst + (bufoff) + ps * 1024), 16, 0, 0);         \
    __builtin_amdgcn_global_load_lds((const unsigned*)(ys[ps] + (k0)), (unsigned*)(mydst + (bufoff) + 16384 + ps * 1024), 16, 0, 0); \
  }
#define GEMM_COMPUTE(bufoff)                                                                                     \
  _Pragma("unroll") for (int kk = 0; kk < 4; ++kk) {                                                             \
    bf16x8 a[2], b[2];                                                                                           \
    const int ch = kk * 2 + (lane >> 5);                                                                         \
    _Pragma("unroll") for (int i = 0; i < 2; ++i) {                                                              \
      a[i] = *(const bf16x8*)(lds + (bufoff) + (TR ? 16384 : 0) + lds_off(wr * 64 + i * 32 + (lane & 31), ch)); \
      b[i] = *(const bf16x8*)(lds + (bufoff) + (TR ? 0 : 16384) + lds_off(wc * 64 + i * 32 + (lane & 31), ch)); \
    }                                                                                                            \
    _Pragma("unroll") for (int i = 0; i < 2; ++i)                                                                \
      _Pragma("unroll") for (int j = 0; j < 2; ++j)                                                              \
        acc[i][j] = __builtin_amdgcn_mfma_f32_32x32x16_bf16(a[i], b[j], acc[i][j], 0, 0, 0);                    \
  }
  vsync();
  GEMM_ISSUE(0, 0)
  for (int k0 = 0; k0 < K; k0 += 128) {
    asm volatile("s_waitcnt vmcnt(0)" ::: "memory");
    vsync();
    GEMM_ISSUE(k0 + 64, 32768)
    GEMM_COMPUTE(0)
    asm volatile("s_waitcnt vmcnt(0)" ::: "memory");
    vsync();
    if (k0 + 128 < K) { GEMM_ISSUE(k0 + 128, 0) }
    GEMM_COMPUTE(32768)
  }
#undef GEMM_ISSUE
#undef GEMM_COMPUTE
  int lane2 = lane;
  asm volatile("" : "+v"(lane2));
  if constexpr (VEC) {
    typedef __attribute__((ext_vector_type(4))) float f32x4;
    vsync();
    float* wl = (float*)lds + wv * (32 * 68);
    const int hh2 = lane2 >> 5, cl = lane2 & 31;
#pragma unroll
    for (int i = 0; i < 2; ++i) {
#pragma unroll
      for (int j = 0; j < 2; ++j)
#pragma unroll
        for (int r = 0; r < 16; ++r) wl[((r & 3) + 8 * (r >> 2) + 4 * hh2) * 68 + j * 32 + cl] = acc[i][j][r];
      __builtin_amdgcn_wave_barrier();
#pragma unroll
      for (int k = 0; k < 4; ++k) {
        const int row = (lane2 >> 3) + 8 * k, c8 = (lane2 & 7) * 8;
        const f32x4 lo = *(const f32x4*)&wl[row * 68 + c8];
        const f32x4 hi = *(const f32x4*)&wl[row * 68 + c8 + 4];
        epi(wr * 64 + i * 32 + row, wc * 64 + c8, lo, hi);
      }
      __builtin_amdgcn_wave_barrier();
    }
  } else {
#pragma unroll
    for (int i = 0; i < 2; ++i)
#pragma unroll
      for (int j = 0; j < 2; ++j)
#pragma unroll
        for (int r = 0; r < 16; ++r) {
          int rr = wr * 64 + i * 32 + (r & 3) + 8 * (r >> 2) + 4 * (lane2 >> 5);
          int cc = wc * 64 + j * 32 + (lane2 & 31);
          epi(rr, cc, acc[i][j][r]);
        }
  }
}

typedef __attribute__((ext_vector_type(4))) float f32x4_e;
__device__ __forceinline__ void st_bf16x8(bf16_t* dst, f32x4_e lo, f32x4_e hi) {
  u32x4 o;
  o[0] = pack2(lo[0], lo[1]); o[1] = pack2(lo[2], lo[3]); o[2] = pack2(hi[0], hi[1]); o[3] = pack2(hi[2], hi[3]);
  *(u32x4*)dst = o;
}

__device__ __forceinline__ int lds_off32(int row, int chunk) { return row * 64 + ((chunk ^ ((row >> 2) & 3)) << 4); }

template <class Epi>
__device__ __forceinline__ void gemm_tile_big(const bf16_t* xp, int ldx, const bf16_t* yp, int ldy, int K, char* lds,
                                              Epi epi) {
  const int tid = VT(), lane = tid & 63, wv = tid >> 6;
  f32x16 acc[2][4];
#pragma unroll
  for (int i = 0; i < 2; ++i)
#pragma unroll
    for (int j = 0; j < 4; ++j)
#pragma unroll
      for (int r = 0; r < 16; ++r) acc[i][j][r] = 0.f;
  const int prow = lane >> 2, pch = lane & 3;
  const bf16_t* xs[4];
  const bf16_t* ys[2];
#pragma unroll
  for (int ps = 0; ps < 4; ++ps) {
    const int row = (wv * 4 + ps) * 16 + prow;
    xs[ps] = xp + (size_t)row * ldx + (pch ^ ((row >> 2) & 3)) * 8;
  }
#pragma unroll
  for (int ps = 0; ps < 2; ++ps) {
    const int row = (wv * 2 + ps) * 16 + prow;
    ys[ps] = yp + (size_t)row * ldy + (pch ^ ((row >> 2) & 3)) * 8;
  }
  char* const xdst = lds + wv * 4096 + lane * 16;
  char* const ydst = lds + 16384 + wv * 2048 + lane * 16;
#define BIG_ISSUE(k0, st)                                                                                                      \
  _Pragma("unroll") for (int ps = 0; ps < 4; ++ps)                                                                             \
    __builtin_amdgcn_global_load_lds((const unsigned*)(xs[ps] + (k0)), (unsigned*)(xdst + (st) + ps * 1024), 16, 0, 0);        \
  _Pragma("unroll") for (int ps = 0; ps < 2; ++ps)                                                                             \
    __builtin_amdgcn_global_load_lds((const unsigned*)(ys[ps] + (k0)), (unsigned*)(ydst + (st) + ps * 1024), 16, 0, 0);
#define DSR(dst, addr, off) asm volatile("ds_read_b128 %0, %1 offset:%2" : "=v"(dst) : "v"(addr), "i"(off) : "memory")
#define WAIT1(n, x) asm volatile("s_waitcnt lgkmcnt(" #n ")" : "+v"(x))
#define WAIT2(n, x, y) asm volatile("s_waitcnt lgkmcnt(" #n ")" : "+v"(x), "+v"(y))
#define MF(acc_, a_, b_) acc_ = __builtin_amdgcn_mfma_f32_32x32x16_bf16(a_, b_, acc_, 0, 0, 0)
#define BIG_COMPUTE(st)                                                                                   \
  {                                                                                                       \
    bf16x8 a00, a01, a10, a11, b00, b01, b02, b03, b10, b11, b12, b13;                                    \
    const unsigned aa0 = abase0 + (st), aa1 = abase1 + (st), bb0 = bbase0 + (st), bb1 = bbase1 + (st);    \
    DSR(a00, aa0, 0); DSR(b00, bb0, 0); DSR(b01, bb0, 2048); DSR(b02, bb0, 4096); DSR(b03, bb0, 6144);    \
    DSR(a01, aa0, 2048);                                                                                  \
    DSR(a10, aa1, 0); DSR(b10, bb1, 0); DSR(b11, bb1, 2048); DSR(b12, bb1, 4096); DSR(b13, bb1, 6144);    \
    DSR(a11, aa1, 2048);                                                                                  \
    WAIT2(10, a00, b00); MF(acc[0][0], a00, b00);                                                         \
    WAIT1(9, b01); MF(acc[0][1], a00, b01);                                                               \
    WAIT1(8, b02); MF(acc[0][2], a00, b02);                                                               \
    WAIT1(7, b03); MF(acc[0][3], a00, b03);                                                               \
    WAIT1(6, a01); MF(acc[1][0], a01, b00); MF(acc[1][1], a01, b01); MF(acc[1][2], a01, b02); MF(acc[1][3], a01, b03); \
    WAIT2(4, a10, b10); MF(acc[0][0], a10, b10);                                                          \
    WAIT1(3, b11); MF(acc[0][1], a10, b11);                                                               \
    WAIT1(2, b12); MF(acc[0][2], a10, b12);                                                               \
    WAIT1(1, b13); MF(acc[0][3], a10, b13);                                                               \
    WAIT1(0, a11); MF(acc[1][0], a11, b10); MF(acc[1][1], a11, b11); MF(acc[1][2], a11, b12); MF(acc[1][3], a11, b13); \
  }
  const unsigned ldsb = (unsigned)(size_t)(__attribute__((address_space(3))) char*)lds;
  const unsigned abase0 = ldsb + lds_off32(wv * 64 + (lane & 31), 0 + (lane >> 5));
  const unsigned abase1 = ldsb + lds_off32(wv * 64 + (lane & 31), 2 + (lane >> 5));
  const unsigned bbase0 = ldsb + 16384 + lds_off32((lane & 31), 0 + (lane >> 5));
  const unsigned bbase1 = ldsb + 16384 + lds_off32((lane & 31), 2 + (lane >> 5));
  const int nsteps = K >> 5;
  vsync();
  BIG_ISSUE(0, 0)
  BIG_ISSUE(32, 24576)
  int cur = 0, nx2 = 49152;
  for (int t = 0; t < nsteps - 2; ++t) {
    asm volatile("s_waitcnt vmcnt(6)" ::: "memory");
    vsync_raw();
    BIG_ISSUE((t + 2) * 32, nx2)
    BIG_COMPUTE(cur)
    cur = (cur == 49152) ? 0 : cur + 24576;
    nx2 = (nx2 == 49152) ? 0 : nx2 + 24576;
  }
  asm volatile("s_waitcnt vmcnt(6)" ::: "memory");
  vsync_raw();
  BIG_COMPUTE(cur)
  cur = (cur == 49152) ? 0 : cur + 24576;
  asm volatile("s_waitcnt vmcnt(0)" ::: "memory");
  vsync_raw();
  BIG_COMPUTE(cur)
#undef BIG_ISSUE
#undef BIG_COMPUTE
#undef DSR
#undef WAIT1
#undef WAIT2
#undef MF
  const int lane2 = opq(lane);
  typedef __attribute__((ext_vector_type(4))) float f32x4;
  vsync();
  float* wl = (float*)lds + wv * (32 * 68);
  const int hh2 = lane2 >> 5, cl = lane2 & 31;
#pragma unroll
  for (int i = 0; i < 2; ++i)
#pragma unroll
    for (int jh = 0; jh < 2; ++jh) {
#pragma unroll
      for (int j = 0; j < 2; ++j)
#pragma unroll
        for (int r = 0; r < 16; ++r) wl[((r & 3) + 8 * (r >> 2) + 4 * hh2) * 68 + j * 32 + cl] = acc[i][jh * 2 + j][r];
      __builtin_amdgcn_wave_barrier();
#pragma unroll
      for (int k = 0; k < 4; ++k) {
        const int row = (lane2 >> 3) + 8 * k, c8 = (lane2 & 7) * 8;
        const f32x4 lo = *(const f32x4*)&wl[row * 68 + c8];
        const f32x4 hi = *(const f32x4*)&wl[row * 68 + c8 + 4];
        epi(wv * 64 + i * 32 + row, jh * 64 + c8, lo, hi);
      }
      __builtin_amdgcn_wave_barrier();
    }
}

template <class Epi>
__device__ __forceinline__ void ph_gemm_big(const bf16_t* A, int lda, const bf16_t* Wt, int ldw, int M, int N, int K,
                                            char* lds, Epi epi) {
  const int ntm = M / 256, ntn = N / 128;
  const int npm = (ntm + 7) / 8, npn = (ntn + 7) / 8;
  const int nslots = ((npm * npn * 64 + 511) / 512) * 512;
  for (int u = VB(); u < nslots; u += VG()) {
    int v = (u & 7) * 64 + ((u >> 3) & 63) + (u & ~511);
    int patch = v >> 6, w = v & 63;
    int tm = (patch % npm) * 8 + (w & 7);
    int tn = (patch / npm) * 8 + (w >> 3);
    if (tm >= ntm || tn >= ntn) continue;
    const int m0 = tm * 256, n0 = tn * 128;
    gemm_tile_big(A + (size_t)m0 * lda, lda, Wt + (size_t)n0 * ldw, ldw, K, lds,
                  [&](int r, int c, f32x4_e lo, f32x4_e hi) { epi(m0 + r, n0 + c, lo, hi); });
  }
}

template <int PM = 0, class Epi>
__device__ __forceinline__ void gemm_tile_huge(const bf16_t* xp, int ldx, const bf16_t* yp, int ldy, int K, char* lds0,
                                               Epi epi) {
  const int tid = opq(threadIdx.x), lane = tid & 63, wv = tid >> 6;
  const int wr = wv >> 2, wc = wv & 3;
  f32x16 acc[4][2];
#pragma unroll
  for (int i = 0; i < 4; ++i)
#pragma unroll
    for (int j = 0; j < 2; ++j)
#pragma unroll
      for (int r = 0; r < 16; ++r) acc[i][j][r] = 0.f;
  const int prow = lane >> 3, pch = lane & 7;
  const bf16_t* xs[4];
  const bf16_t* ys[4];
#pragma unroll
  for (int ps = 0; ps < 4; ++ps) {
    const int row = (wv * 4 + ps) * 8 + prow;
    const int c = pch ^ ((row >> 1) & 7);
    xs[ps] = xp + (size_t)row * ldx + c * 8;
    ys[ps] = yp + (size_t)row * ldy + c * 8;
  }
  char* const xdst = lds0 + wv * 4096 + lane * 16;
#define HUGE_ISSUE(k0, st)                                                                                                          \
  _Pragma("unroll") for (int ps = 0; ps < 4; ++ps) {                                                                                \
    __builtin_amdgcn_global_load_lds((const unsigned*)(xs[ps] + (k0)), (unsigned*)(xdst + (st) + ps * 1024), 16, 0, 0);             \
    __builtin_amdgcn_global_load_lds((const unsigned*)(ys[ps] + (k0)), (unsigned*)(xdst + (st) + 32768 + ps * 1024), 16, 0, 0);     \
  }
#define HDSR(dst, addr, off) asm volatile("ds_read_b128 %0, %1 offset:%2" : "=v"(dst) : "v"(addr), "i"(off) : "memory")
#define HREAD(S, ab, bb)                                                                            \
  HDSR(S##a0, ab, 0); HDSR(S##b0, bb, 0); HDSR(S##b1, bb, 4096); HDSR(S##a1, ab, 4096);             \
  HDSR(S##a2, ab, 8192); HDSR(S##a3, ab, 12288);
#define HWAIT(n, S)                                                                                 \
  asm volatile("s_waitcnt lgkmcnt(" #n ")" : "+v"(S##a0), "+v"(S##a1), "+v"(S##a2), "+v"(S##a3), "+v"(S##b0), "+v"(S##b1))
#define HMF(i, j, S) acc[i][j] = __builtin_amdgcn_mfma_f32_32x32x16_bf16(S##a##i, S##b##j, acc[i][j], 0, 0, 0)
#define HMMA(S) HMF(0, 0, S); HMF(0, 1, S); HMF(1, 0, S); HMF(1, 1, S); HMF(2, 0, S); HMF(2, 1, S); HMF(3, 0, S); HMF(3, 1, S);
  const unsigned ldsb = (unsigned)(size_t)(LAS char*)lds0;
  const int frow = lane & 31, fh = lane >> 5;
  const unsigned ab0 = ldsb + lds_off(wr * 128 + frow, 0 + fh), ab1 = ldsb + lds_off(wr * 128 + frow, 2 + fh);
  const unsigned ab2 = ldsb + lds_off(wr * 128 + frow, 4 + fh), ab3 = ldsb + lds_off(wr * 128 + frow, 6 + fh);
  const unsigned bb0 = ldsb + 32768 + lds_off(wc * 64 + frow, 0 + fh), bb1 = ldsb + 32768 + lds_off(wc * 64 + frow, 2 + fh);
  const unsigned bb2 = ldsb + 32768 + lds_off(wc * 64 + frow, 4 + fh), bb3 = ldsb + 32768 + lds_off(wc * 64 + frow, 6 + fh);
  __syncthreads();
  HUGE_ISSUE(0, 0)
  bf16x8 Ea0, Ea1, Ea2, Ea3, Eb0, Eb1, Oa0, Oa1, Oa2, Oa3, Ob0, Ob1;
  asm volatile("s_waitcnt vmcnt(0)" ::: "memory");
  __syncthreads();
  if (64 < K) { HUGE_ISSUE(64, 65536u) }
  HREAD(E, ab0, bb0)
  HREAD(O, ab1, bb1)
  HWAIT(6, E); HMMA(E)
  HREAD(E, ab2, bb2)
  HWAIT(6, O); HMMA(O)
  HREAD(O, ab3, bb3)
  HWAIT(6, E); HMMA(E)
  HWAIT(0, O);
  unsigned st = 65536u;
  for (int k0 = 64; k0 < K; k0 += 64) {
    asm volatile("s_waitcnt vmcnt(0)" ::: "memory");
    __syncthreads();
    const unsigned a0 = ab0 + st, a1 = ab1 + st, a2 = ab2 + st, a3 = ab3 + st;
    const unsigned b0 = bb0 + st, b1 = bb1 + st, b2 = bb2 + st, b3 = bb3 + st;
    HREAD(E, a0, b0)
    HWAIT(6, O); HMMA(O)
    if (k0 + 64 < K) { HUGE_ISSUE(k0 + 64, st ^ 65536u) }
    HREAD(O, a1, b1)
    HWAIT(6, E); HMMA(E)
    HREAD(E, a2, b2)
    HWAIT(6, O); HMMA(O)
    HREAD(O, a3, b3)
    HWAIT(6, E); HMMA(E)
    HWAIT(0, O);
    st ^= 65536u;
  }
  HMMA(O)
#undef HUGE_ISSUE
#undef HDSR
#undef HREAD
#undef HWAIT
#undef HMF
#undef HMMA
  const int lane2 = opq(lane);
  typedef __attribute__((ext_vector_type(4))) float f32x4;
  __syncthreads();
  float* wl = (float*)lds0 + wv * (32 * 68);
  const int hh2 = lane2 >> 5, cl = lane2 & 31;
#pragma unroll
  for (int i = 0; i < 4; ++i) {
#pragma unroll
    for (int j = 0; j < 2; ++j)
#pragma unroll
      for (int r = 0; r < 16; ++r) wl[((r & 3) + 8 * (r >> 2) + 4 * hh2) * 68 + j * 32 + cl] = acc[i][j][r];
    __builtin_amdgcn_wave_barrier();
#pragma unroll
    for (int k = 0; k < 4; ++k) {
      const int row = (lane2 >> 3) + 8 * k, c8 = (lane2 & 7) * 8;
      const f32x4 lo = *(const f32x4*)&wl[row * 68 + c8];
      const f32x4 hi = *(const f32x4*)&wl[row * 68 + c8 + 4];
      if (PM != 3) epi(wr * 128 + i * 32 + row, wc * 64 + c8, lo, hi);
    }
    __builtin_amdgcn_wave_barrier();
  }
  __syncthreads();
}

template <class Epi>
__device__ __forceinline__ void ph_gemm_huge(const bf16_t* A, int lda, const bf16_t* Wt, int ldw, int M, int N, int K,
                                             char* lds0, Epi epi) {
  const int ntm = M / 256, ntn = N / 256;
  for (int u = (int)blockIdx.x; u < ntm * ntn; u += (int)gridDim.x) {
    const int x = u & 7, i = (u >> 3) & 31, rnd = u >> 8;
    const int tm = (x & 3) * 8 + (i & 7), tn = rnd * 8 + (x >> 2) * 4 + (i >> 3);
    if (tm >= ntm || tn >= ntn) continue;
    const int m0 = tm * 256, n0 = tn * 256;
    gemm_tile_huge(A + (size_t)m0 * lda, lda, Wt + (size_t)n0 * ldw, ldw, K, lds0,
                   [&](int r, int c, f32x4_e lo, f32x4_e hi) { epi(m0 + r, n0 + c, lo, hi); });
  }
}

__device__ __forceinline__ void norm_feed(const f32x4_e h0, const f32x4_e h1, const float* gain, int n, bf16_t* hn_row,
                                          float* rowss_m) {
  const f32x4_e g0 = *(const f32x4_e*)(gain + n), g1 = *(const f32x4_e*)(gain + n + 4);
  st_bf16x8(hn_row + n, h0 * g0, h1 * g1);
  float ss = h0[0] * h0[0] + h0[1] * h0[1] + h0[2] * h0[2] + h0[3] * h0[3] + h1[0] * h1[0] + h1[1] * h1[1] + h1[2] * h1[2] + h1[3] * h1[3];
  ss += __shfl_xor(ss, 1);
  ss += __shfl_xor(ss, 2);
  ss += __shfl_xor(ss, 4);
  if (((VT()) & 7) == 0) atomicAdd(rowss_m, ss);
}

__device__ __forceinline__ void resid_feed(const f32x4_e h0, const f32x4_e h1, int n, bf16_t* hb_row, float* rowss_m) {
  st_bf16x8(hb_row + n, h0, h1);
  float ss = h0[0] * h0[0] + h0[1] * h0[1] + h0[2] * h0[2] + h0[3] * h0[3] + h1[0] * h1[0] + h1[1] * h1[1] + h1[2] * h1[2] + h1[3] * h1[3];
  ss += __shfl_xor(ss, 1);
  ss += __shfl_xor(ss, 2);
  ss += __shfl_xor(ss, 4);
  if (((VT()) & 7) == 0) atomicAdd(rowss_m, ss);
}

template <bool VEC = false, class Epi>
__device__ __forceinline__ void ph_gemm_bf16(const bf16_t* A, int lda, const bf16_t* Wt, int ldw, int M, int N, int K,
                                             char* lds, Epi epi, int vblock = -2) {
  const int ntm = M / 128, ntn = N / 128;
  const int npm = (ntm + 7) / 8, npn = (ntn + 7) / 8;
  const int nslots = ((npm * npn * 64 + 511) / 512) * 512;
  if (vblock == -1) return;
  for (int u = (vblock >= 0 ? vblock : VB()); u < nslots; u += VG()) {
    int v = (u & 7) * 64 + ((u >> 3) & 63) + (u & ~511);
    int patch = v >> 6, w = v & 63;
    int tm = (patch % npm) * 8 + (w & 7);
    int tn = (patch / npm) * 8 + (w >> 3);
    if (tm >= ntm || tn >= ntn) continue;
    const int m0 = tm * 128, n0 = tn * 128;
    if constexpr (VEC)
      gemm_tile_bf16<false, true>(A + (size_t)m0 * lda, lda, Wt + (size_t)n0 * ldw, ldw, K, lds,
                                  [&](int r, int c, f32x4_e lo, f32x4_e hi) { epi(m0 + r, n0 + c, lo, hi); });
    else
      gemm_tile_bf16<false>(A + (size_t)m0 * lda, lda, Wt + (size_t)n0 * ldw, ldw, K, lds,
                            [&](int r, int c, float val) { epi(m0 + r, n0 + c, val); });
  }
}

__device__ __forceinline__ void ph_proj(const P& p, char* lds0, char* lds) {
  for (int u = (int)blockIdx.x; u < 512; u += (int)gridDim.x) {
    const int x = u & 7, i = (u >> 3) & 31, rnd = u >> 8;
    const int tm = (x & 3) * 8 + (i & 7), tp = rnd * 8 + (x >> 2) * 4 + (i >> 3);
    const int tb = tp * 2;
    const int tn = (tb < 14) ? tb : (tb < 16) ? tb + 2 : tb + 4;
    const int m0 = tm * 256, n0 = tn * 128;
    const int b = m0 >> 11, sl = m0 & 2047;
    const bf16_t* A = p.hn + (size_t)m0 * DM;
    const bf16_t* W = p.WinT + (size_t)n0 * DM;
    if (n0 < 1024 || (n0 >= 2560 && n0 < 3584)) {
      bf16_t* dst = (n0 < 1024) ? p.qn + (size_t)m0 * 1024 + n0 : p.qsb + (size_t)m0 * 1024 + (n0 - 2560);
      gemm_tile_huge(A, DM, W, DM, DM, lds0, [&](int r, int c, f32x4_e lo, f32x4_e hi) { st_bf16x8(dst + (size_t)r * 1024 + c, lo, hi); });
    } else if (n0 < 2560) {
      const int seg = (n0 - 1024) >> 8;
      bf16_t* base = (seg == 0) ? p.kcin : (seg == 1) ? p.vcin : (seg == 2) ? p.ks : p.kw;
      bf16_t* dst = base + ((size_t)(b * 2) * SEQ + sl) * 128;
      gemm_tile_huge(A, DM, W, DM, DM, lds0, [&](int r, int c, f32x4_e lo, f32x4_e hi) {
        st_bf16x8(dst + ((size_t)(c >> 7) * SEQ + r) * 128 + (c & 127), lo, hi); });
    } else {
      bf16_t* dst = p.ksb + ((size_t)(b * 8 + ((n0 - 3584) >> 7)) * SEQ + sl) * 128;
      gemm_tile_huge(A, DM, W, DM, DM, lds0, [&](int r, int c, f32x4_e lo, f32x4_e hi) {
        st_bf16x8(dst + ((size_t)(c >> 7) * SEQ + r) * 128 + (c & 127), lo, hi); });
    }
  }
  for (int u = (int)blockIdx.x; u < 192; u += (int)gridDim.x) {
    const int tm = u & 31, tv = u >> 5;
    const int n0 = (tv == 0) ? 1792 : (tv == 1) ? 2304 : 4608 + (tv - 2) * 256;
    const int m0 = tm * 256;
    const int b = m0 >> 11, sl = m0 & 2047;
    bf16_t* vd;
    if (tv < 2) vd = (tv == 0 ? p.vsT : p.vwT) + ((size_t)(b * 2) * 128) * SEQ + sl;
    else vd = p.vsbT + ((size_t)(b * 8 + (tv - 2) * 2) * 128) * SEQ + sl;
    gemm_tile_huge(p.WinT + (size_t)n0 * DM, DM, p.hn + (size_t)m0 * DM, DM, DM, lds0,
                   [&](int r, int c, f32x4_e lo, f32x4_e hi) {
                     bf16_t* row = vd + (size_t)r * SEQ;
                     uint2 wa, wb;
                     wa.x = pack2(lo[0], lo[1]); wa.y = pack2(lo[2], lo[3]);
                     wb.x = pack2(hi[0], hi[1]); wb.y = pack2(hi[2], hi[3]);
                     const int pa = (c & 8) ? c - 4 : c, pb = (c & 8) ? c + 4 : c + 8;
                     *(uint2*)(row + pa) = wa;
                     *(uint2*)(row + pb) = wb; });
  }
  {
    const int vb = VB();
    if (VG() != 512 || vb >= 448) {
      for (int tm = (VG() == 512) ? vb - 448 : vb; tm < 64; tm += (VG() == 512) ? 64 : VG()) {
        const int m0 = tm * 128;
        float* gd = p.gates + (size_t)m0 * 24;
        gemm_tile_bf16<false>(p.hn + (size_t)m0 * DM, DM, p.WinT + (size_t)5632 * DM, DM, DM, lds,
                              [&](int r, int c, float val) { if (c < 24) gd[(size_t)r * 24 + c] = val; });
      }
    }
  }
}

__device__ __forceinline__ void ph_posb(const P& p) {
  const int lane = VT() & 63, wv = VT() >> 6;
  for (int o = VB() * 4 + wv; o < 256; o += VG() * 4) {
    const int which = o >> 7, n = o & 127;
    const float* pos = which ? p.pos_v : p.pos_k;
    const float* w1 = which ? p.w1_v : p.w1_k;
    float acc = 0.f;
    for (int k = lane; k < 4096; k += 64) acc += pos[k] * w1[(size_t)k * 128 + n];
    acc = wave_sum(acc);
    if (lane == 0) p.posb[o] = acc;
  }
}

__device__ __forceinline__ void ph_compress2(const P& p, char* lds) {
  for (int item = VB(); item < 16; item += VG()) {
    const int which = item >> 3, bg = item & 7;
    const bf16_t* src = (which ? p.vcin : p.kcin) + (size_t)bg * SEQ * 128;
    const bf16_t* w1t = p.w1T + (size_t)which * 128 * 4096;
    const bf16_t* w2t = p.w2T + (size_t)which * 128 * 128;
    const float* posb = p.posb + which * 128;
    bf16_t* c1 = p.c1 + (size_t)item * 128 * 128;
    gemm_tile_bf16<false>(src, 2048, w1t, 4096, 4096, lds, [&](int r, int c, float val) {
      c1[r * 128 + c] = f2bf(gelu_fast(val + posb[c])); });
    __threadfence_block();
    vsync();
    if (which == 0) {
      bf16_t* kd = p.kcb + (size_t)bg * 128 * 128;
      gemm_tile_bf16<false>(c1, 128, w2t, 128, 128, lds, [&](int r, int c, float val) { kd[r * 128 + c] = f2bf(val); });
    } else {
      bf16_t* vd = p.vcT + (size_t)bg * 128 * 128;
      gemm_tile_bf16<true>(c1, 128, w2t, 128, 128, lds, [&](int r, int c, float val) { vd[r * 128 + perm16(c)] = f2bf(val); });
    }
  }
}

#define NEG_BIG (-1e30f)

struct KVRegs { u32x4 k0, k1, k2, k3, v0, v1, v2, v3; };

__device__ __forceinline__ int koff(int row, int chunk) { return row * 256 + ((chunk ^ (row & 15)) << 4); }

__device__ __forceinline__ void kv_load(KVRegs& r, const bf16_t* kp, int ldk, const bf16_t* vp, int ldv) {
  const int tid = VT();
  const bf16_t* kg = kp + (size_t)(tid >> 4) * ldk + (tid & 15) * 8;
  r.k0 = *(const u32x4*)kg;
  r.k1 = *(const u32x4*)(kg + (size_t)16 * ldk);
  r.k2 = *(const u32x4*)(kg + (size_t)32 * ldk);
  r.k3 = *(const u32x4*)(kg + (size_t)48 * ldk);
  const bf16_t* vg = vp + (size_t)(tid >> 3) * ldv + (tid & 7) * 8;
  r.v0 = *(const u32x4*)vg;
  r.v1 = *(const u32x4*)(vg + (size_t)32 * ldv);
  r.v2 = *(const u32x4*)(vg + (size_t)64 * ldv);
  r.v3 = *(const u32x4*)(vg + (size_t)96 * ldv);
}
__device__ __forceinline__ void kv_store(const KVRegs& r, char* lk, char* lv) {
  const int tid = VT();
  const int row = tid >> 4, ch = tid & 15;
  *(u32x4*)(lk + koff(row, ch)) = r.k0;
  *(u32x4*)(lk + koff(row + 16, ch)) = r.k1;
  *(u32x4*)(lk + koff(row + 32, ch)) = r.k2;
  *(u32x4*)(lk + koff(row + 48, ch)) = r.k3;
  const int vr = tid >> 3, vc = tid & 7;
  *(u32x4*)(lv + lds_off(vr, vc)) = r.v0;
  *(u32x4*)(lv + lds_off(vr + 32, vc)) = r.v1;
  *(u32x4*)(lv + lds_off(vr + 64, vc)) = r.v2;
  *(u32x4*)(lv + lds_off(vr + 96, vc)) = r.v3;
}

struct QFrag { bf16x8 f0, f1, f2, f3, f4, f5, f6, f7; };
__device__ __forceinline__ void q_load(QFrag& q, const bf16_t* qrow) {
  const int h = (VT() & 63) >> 5;
  const bf16x8* p8 = (const bf16x8*)(qrow + 8 * h);
  q.f0 = p8[0]; q.f1 = p8[2]; q.f2 = p8[4]; q.f3 = p8[6]; q.f4 = p8[8]; q.f5 = p8[10]; q.f6 = p8[12]; q.f7 = p8[14];
}

__device__ __forceinline__ void qk_tile(const QFrag& q, const char* lk, f32x16& s0, f32x16& s1) {
  const int lane = VT() & 63, row = lane & 31, h = lane >> 5;
#pragma unroll
  for (int r = 0; r < 16; ++r) { s0[r] = 0.f; s1[r] = 0.f; }
#define QK_STEP(kk, qf)                                                                  \
  {                                                                                      \
    bf16x8 a0 = *(const bf16x8*)(lk + koff(row, 2 * (kk) + h));                          \
    bf16x8 a1 = *(const bf16x8*)(lk + koff(row + 32, 2 * (kk) + h));                     \
    s0 = __builtin_amdgcn_mfma_f32_32x32x16_bf16(a0, qf, s0, 0, 0, 0);                   \
    s1 = __builtin_amdgcn_mfma_f32_32x32x16_bf16(a1, qf, s1, 0, 0, 0);                   \
  }
  QK_STEP(0, q.f0) QK_STEP(1, q.f1) QK_STEP(2, q.f2) QK_STEP(3, q.f3)
  QK_STEP(4, q.f4) QK_STEP(5, q.f5) QK_STEP(6, q.f6) QK_STEP(7, q.f7)
#undef QK_STEP
}

__device__ __forceinline__ bf16x8 pack8(const f32x16& p, const int base) {
  u32x4 u;
  u[0] = pack2(p[base + 0], p[base + 1]);
  u[1] = pack2(p[base + 2], p[base + 3]);
  u[2] = pack2(p[base + 4], p[base + 5]);
  u[3] = pack2(p[base + 6], p[base + 7]);
  return __builtin_bit_cast(bf16x8, u);
}

typedef __attribute__((ext_vector_type(2))) unsigned u32x2_t;
__device__ __forceinline__ float xhalf_max(float v) {
  const u32x2_t r = __builtin_amdgcn_permlane32_swap(__float_as_uint(v), __float_as_uint(v), false, false);
  return fmaxf(__uint_as_float(r[0]), __uint_as_float(r[1]));
}
__device__ __forceinline__ float xhalf_sum(float v) {
  const u32x2_t r = __builtin_amdgcn_permlane32_swap(__float_as_uint(v), __float_as_uint(v), false, false);
  return __uint_as_float(r[0]) + __uint_as_float(r[1]);
}
__device__ __forceinline__ float xhalf_get(float v, int hh) {
  const u32x2_t r = __builtin_amdgcn_permlane32_swap(__float_as_uint(v), __float_as_uint(v), false, false);
  return hh ? __uint_as_float(r[0]) : __uint_as_float(r[1]);
}
struct OAcc { f32x16 o0, o1, o2, o3; };
__device__ __forceinline__ void oacc_zero(OAcc& o) {
#pragma unroll
  for (int r = 0; r < 16; ++r) { o.o0[r] = 0.f; o.o1[r] = 0.f; o.o2[r] = 0.f; o.o3[r] = 0.f; }
}
__device__ __forceinline__ void oacc_scale(OAcc& o, float a) {
#pragma unroll
  for (int r = 0; r < 16; ++r) { o.o0[r] *= a; o.o1[r] *= a; o.o2[r] *= a; o.o3[r] *= a; }
}

__device__ __forceinline__ void pv_tile(OAcc& o, const char* lv, const f32x16& p0, const f32x16& p1) {
  const int lane = VT() & 63, row = lane & 31, h = lane >> 5;
  const bf16x8 pf0 = pack8(p0, 0), pf1 = pack8(p0, 8), pf2 = pack8(p1, 0), pf3 = pack8(p1, 8);
#define PV_ROW(dd, acc)                                                                                      \
  {                                                                                                          \
    acc = __builtin_amdgcn_mfma_f32_32x32x16_bf16(*(const bf16x8*)(lv + lds_off(32 * (dd) + row, 0 + h)), pf0, acc, 0, 0, 0); \
    acc = __builtin_amdgcn_mfma_f32_32x32x16_bf16(*(const bf16x8*)(lv + lds_off(32 * (dd) + row, 2 + h)), pf1, acc, 0, 0, 0); \
    acc = __builtin_amdgcn_mfma_f32_32x32x16_bf16(*(const bf16x8*)(lv + lds_off(32 * (dd) + row, 4 + h)), pf2, acc, 0, 0, 0); \
    acc = __builtin_amdgcn_mfma_f32_32x32x16_bf16(*(const bf16x8*)(lv + lds_off(32 * (dd) + row, 6 + h)), pf3, acc, 0, 0, 0); \
  }
  PV_ROW(0, o.o0) PV_ROW(1, o.o1) PV_ROW(2, o.o2) PV_ROW(3, o.o3)
#undef PV_ROW
}

typedef __attribute__((ext_vector_type(2))) float f32x2_s;
#define SPAIR(v, i) __builtin_shufflevector(v, v, (i), (i) + 1)
__device__ __forceinline__ void softmax_tile(f32x16& s0, f32x16& s1, float& m, float& l, OAcc& o, const float sc = 1.f,
                                             const float bb = 0.f) {
  float mr = -INFINITY;
#pragma unroll
  for (int r = 0; r < 16; ++r) mr = fmaxf(mr, fmaxf(s0[r], s1[r]));
  float mx = fmaf(mr, sc, bb);
  mx = (mx != mx) ? -INFINITY : mx;
  mx = xhalf_max(fmaxf(mx, NEG_BIG));
  const float mn = fmaxf(m, mx);
  const float alpha = __builtin_amdgcn_exp2f(m - mn);
  const f32x2_s sc2 = {sc, sc}, c2 = {bb - mn, bb - mn};
  f32x2_s ls2 = {0.f, 0.f};
#pragma unroll
  for (int r = 0; r < 16; r += 2) {
    const f32x2_s pa_in = {s0[r], s0[r + 1]}, pb_in = {s1[r], s1[r + 1]};
    const f32x2_s a = __builtin_elementwise_fma(pa_in, sc2, c2);
    const f32x2_s b = __builtin_elementwise_fma(pb_in, sc2, c2);
    const float a0 = __builtin_amdgcn_exp2f(a[0]), a1 = __builtin_amdgcn_exp2f(a[1]);
    const float b0 = __builtin_amdgcn_exp2f(b[0]), b1 = __builtin_amdgcn_exp2f(b[1]);
    s0[r] = a0; s0[r + 1] = a1; s1[r] = b0; s1[r + 1] = b1;
    const f32x2_s pa = {a0, a1}, pb = {b0, b1};
    ls2 = ls2 + pa + pb;
  }
  const float ls = xhalf_sum(ls2[0] + ls2[1]);
  l = l * alpha + ls;
  m = mn;
  if (__any(alpha != 1.f)) oacc_scale(o, alpha);
}

template <class F>
__device__ __forceinline__ void oacc_foreach(const OAcc& o, F f) {
  const int h = (VT() & 63) >> 5;
#pragma unroll
  for (int rho = 0; rho < 4; ++rho) {
    f(0 + 8 * rho + 4 * h, o.o0[4 * rho], o.o0[4 * rho + 1], o.o0[4 * rho + 2], o.o0[4 * rho + 3]);
    f(32 + 8 * rho + 4 * h, o.o1[4 * rho], o.o1[4 * rho + 1], o.o1[4 * rho + 2], o.o1[4 * rho + 3]);
    f(64 + 8 * rho + 4 * h, o.o2[4 * rho], o.o2[4 * rho + 1], o.o2[4 * rho + 2], o.o2[4 * rho + 3]);
    f(96 + 8 * rho + 4 * h, o.o3[4 * rho], o.o3[4 * rho + 1], o.o3[4 * rho + 2], o.o3[4 * rho + 3]);
  }
}

__device__ __forceinline__ void memattn_item(const P& p, char* lds, int item) {
  char* lk = lds;
  char* lv = lds + 16384;
  const int lane = VT() & 63, wv = VT() >> 6;
  {
    const int tb = item % (SEQ / 128);
    const int bh = item / (SEQ / 128);
    const int b = bh >> 2, hd = bh & 3;
    const int t = tb * 128 + wv * 32 + (lane & 31);
    QFrag q;
    q_load(q, p.qmemb + (size_t)(b * SEQ + t) * 512 + hd * 128);
    const bf16_t* kb = p.kmemb + (size_t)bh * 256 * 128;
    const bf16_t* vb = p.vmemT + (size_t)bh * 128 * 256;
    OAcc o;
    oacc_zero(o);
    float m = NEG_BIG, l = 0.f;
    KVRegs kv;
    kv_load(kv, kb, 128, vb, 256);
#pragma unroll 1
    for (int ti = 0; ti < 4; ++ti) {
      vsync();
      kv_store(kv, lk, lv);
      vsync();
      {
        const int tn = (ti + 1 < 4) ? ti + 1 : 3;
        kv_load(kv, kb + (size_t)tn * 64 * 128, 128, vb + tn * 64, 256);
      }
      f32x16 s0, s1;
      qk_tile(q, lk, s0, s1);
      softmax_tile(s0, s1, m, l, o, ATT_SCALE2, 0.f);
      pv_tile(o, lv, s0, s1);
    }
    const float il = 1.f / l;
    const int t2 = tb * 128 + (VT() >> 6) * 32 + (VT() & 31);
    bf16_t* orow = p.omem + (size_t)(b * SEQ + t2) * 512 + hd * 128;
    oacc_foreach(o, [&](int d, float v0, float v1, float v2, float v3) {
      uint2 u;
      u.x = pack2(v0 * il, v1 * il);
      u.y = pack2(v2 * il, v3 * il);
      *(uint2*)(orow + d) = u;
    });
  }
}

__device__ __forceinline__ void ph_memq_attn(const P& p, char* lds, int vblock, int nvb) {
  if (vblock < 0) return;
  const float* rss = p.rowss;
  for (int u = vblock; u < 64 * 4; u += nvb) {
    const int tm = u & 63, hd = u >> 6;
    const int m0 = tm * 128;
    bf16_t* qd = p.qmemb + (size_t)m0 * 512 + hd * 128;
    gemm_tile_bf16<false, true>(p.hn + (size_t)m0 * DM, DM, p.WmqT + (size_t)hd * 128 * DM, DM, DM, lds,
                                [&](int r, int c, f32x4_e lo, f32x4_e hi) {
                                  const float rs = rsqrtf(rss[m0 + r] * (1.f / DM) + RMS_EPS);
                                  st_bf16x8(qd + (size_t)r * 512 + c, lo * rs, hi * rs); });
    __threadfence_block();
    vsync();
    memattn_item(p, lds, ((m0 >> 11) * 4 + hd) * (SEQ / 128) + ((m0 & 2047) >> 7));
  }
}

template <bool CHK>
__device__ __forceinline__ void sb_pass1(f32x16& z, f32x16& l, const int s_first, const int t) {
  const f32x2_s sc2 = {ATT_SCALE2, ATT_SCALE2}, one2 = {1.f, 1.f};
#pragma unroll
  for (int r = 0; r < 16; r += 2) {
    const f32x2_s zin = {z[r], z[r + 1]};
    const f32x2_s zz = zin * sc2;
    const f32x2_s ee = {__builtin_amdgcn_exp2f(-fabsf(zz[0])), __builtin_amdgcn_exp2f(-fabsf(zz[1]))};
    const f32x2_s tt = ee + one2;
    const f32x2_s lg = {__builtin_amdgcn_logf(tt[0]), __builtin_amdgcn_logf(tt[1])};
    const f32x2_s mn = {fminf(zz[0], 0.f), fminf(zz[1], 0.f)};
    const f32x2_s lf = (mn - lg) - zz;
    if (CHK) {
      const int so = s_first + 8 * (r >> 2) + (r & 3);
      const bool v0 = so < t, v1 = so + 1 < t;
      l[r] = v0 ? lf[0] : 0.f; l[r + 1] = v1 ? lf[1] : 0.f;
      z[r] = v0 ? zz[0] : NEG_BIG; z[r + 1] = v1 ? zz[1] : NEG_BIG;
    } else {
      l[r] = lf[0]; l[r + 1] = lf[1];
      z[r] = zz[0]; z[r + 1] = zz[1];
    }
  }
}
__device__ __forceinline__ void sb_pass3(f32x16& z, const f32x16& l, const float* ag) {
#pragma unroll
  for (int rho = 0; rho < 4; ++rho) {
    const float x3 = l[4 * rho + 3], x23 = x3 + l[4 * rho + 2], x123 = x23 + l[4 * rho + 1];
    const float g = ag[rho];
    const f32x2_s g2 = {g, g};
    const f32x2_s la = {l[4 * rho + 0], l[4 * rho + 1]}, lb = {l[4 * rho + 2], l[4 * rho + 3]};
    const f32x2_s za = {z[4 * rho + 0], z[4 * rho + 1]}, zb = {z[4 * rho + 2], z[4 * rho + 3]};
    const f32x2_s xa = {x123, x23}, xb = {x3, 0.f};
    const f32x2_s aa = (la + za) + (g2 + xa), ab = (lb + zb) + (g2 + xb);
    z[4 * rho + 0] = __builtin_amdgcn_exp2f(aa[0]); z[4 * rho + 1] = __builtin_amdgcn_exp2f(aa[1]);
    z[4 * rho + 2] = __builtin_amdgcn_exp2f(ab[0]); z[4 * rho + 3] = __builtin_amdgcn_exp2f(ab[1]);
  }
}

__device__ __forceinline__ void ph_sb2(const P& p, char* lds) {
  char* lk = lds;
  char* lv = lds + 16384;
  const int lane = VT() & 63, wv = VT() >> 6, hh = lane >> 5;
  const int sb_skip = (VG() > 32) ? 16 : 0;
  if (VB() < sb_skip) return;
  for (int item = VB() - sb_skip; item < NBATCH * 8 * (SEQ / 128); item += VG() - sb_skip) {
    const int tb = (SEQ / 128 - 1) - (item % (SEQ / 128));
    const int bh = item / (SEQ / 128);
    const int b = bh >> 3, hd = bh & 7;
    const int t0 = tb * 128;
    const int t = t0 + wv * 32 + (lane & 31);
    QFrag q;
    q_load(q, p.qsb + (size_t)(b * SEQ + t) * 1024 + hd * 128);
    const bf16_t* kb = p.ksb + (size_t)bh * SEQ * 128;
    const bf16_t* vb = p.vsbT + (size_t)bh * 128 * SEQ;
    OAcc o;
    oacc_zero(o);
    float carry = 0.f;
    const int jhi = (t0 >> 6) + 1;
    const int jw = (t0 + wv * 32 + 30) >> 6;
    KVRegs kv;
    kv_load(kv, kb + (size_t)jhi * 64 * 128, 128, vb + jhi * 64, SEQ);
    volatile unsigned* dflag = (volatile unsigned*)(lds + 32768);
    vsync();
    if (VT() < 4) dflag[VT()] = 0u;
    for (int j = jhi; j >= 0; --j) {
      vsync();
      if ((dflag[0] & dflag[1] & dflag[2] & dflag[3]) != 0u) break;
      kv_store(kv, lk, lv);
      vsync();
      const int jn = (j > 0) ? j - 1 : 0;
      if (j > jw) kv_load(kv, kb + (size_t)jn * 64 * 128, 128, vb + jn * 64, SEQ);
      if (j <= jw) {
        f32x16 z0, z1;
        qk_tile(q, lk, z0, z1);
        const int sbase = j * 64 + 4 * hh;
        float gt[8];
        f32x16 l0, l1;
        if (j * 64 + 63 < t0 + wv * 32) {
          sb_pass1<false>(z0, l0, sbase, t);
          sb_pass1<false>(z1, l1, sbase + 32, t);
        } else {
          sb_pass1<true>(z0, l0, sbase, t);
          sb_pass1<true>(z1, l1, sbase + 32, t);
        }
#pragma unroll
        for (int rho = 0; rho < 4; ++rho) {
          gt[rho] = (l0[4 * rho] + l0[4 * rho + 1]) + (l0[4 * rho + 2] + l0[4 * rho + 3]);
          gt[4 + rho] = (l1[4 * rho] + l1[4 * rho + 1]) + (l1[4 * rho + 2] + l1[4 * rho + 3]);
        }
        float ag[8];
        float run = 0.f;
#pragma unroll
        for (int k = 7; k >= 0; --k) {
          const float pg = xhalf_get(gt[k], hh);
          ag[k] = carry + run + (hh == 0 ? pg : 0.f);
          run += gt[k] + pg;
        }
        carry += run;
        sb_pass3(z0, l0, ag);
        sb_pass3(z1, l1, ag + 4);
        kv_load(kv, kb + (size_t)jn * 64 * 128, 128, vb + jn * 64, SEQ);
        pv_tile(o, lv, z0, z1);
        if (__all(carry < -104.f * LOG2E) && (VT() & 63) == 0) dflag[wv] = 1u;
      }
    }
    int t2 = t;
    asm volatile("" : "+v"(t2));
    bf16_t* orow = p.omix + (size_t)(b * SEQ + t2) * DM + 1024 + hd * 128;
    oacc_foreach(o, [&](int d, float v0, float v1, float v2, float v3) {
      uint2 u;
      u.x = pack2(v0, v1);
      u.y = pack2(v2, v3);
      *(uint2*)(orow + d) = u;
    });
  }
}

#define NSA_IMP 32768
#define NSA_KEYS 49152
#define NSA_SELM 53504
#define NSA_LUT 53632
__device__ __forceinline__ void ph_nsa2(const P& p, char* lds) {
  typedef __attribute__((ext_vector_type(4))) float f32x4;
  char* lk = lds;
  char* lv = lds + 16384;
  float* imp = (float*)(lds + NSA_IMP);
  float* keys = (float*)(lds + NSA_KEYS);
  unsigned* selm = (unsigned*)(lds + NSA_SELM);
  const int tid = VT(), lane = tid & 63, wv = tid >> 6, hh = lane >> 5, ql = lane & 31;
  float* lut = (float*)(lds + NSA_LUT) + wv * 128;
  for (int item = VB(); item < NBATCH * 2 * (SEQ / 32); item += VG()) {
    const int tt = (item < 256) ? (SEQ / 32 - 1) - (item % (SEQ / 32)) : (item % (SEQ / 32));
    const int bg = item / (SEQ / 32);
    const int b = bg >> 1, g = bg & 1;
    const int h = g * 4 + wv;
    const int t0 = tt * 32, tq = t0 + ql, cur = t0 >> 6;
    vsync();
    QFrag q;
    q_load(q, p.qn + (size_t)(b * SEQ + tq) * 1024 + h * 128);
    {
      const int lo = opq(lane);
      lut[lo] = p.t5[t5_bucket(lo) * 8 + h] * LOG2E;
      lut[lo + 64] = p.t5[t5_bucket(lo + 64) * 8 + h] * LOG2E;
    }
#pragma unroll
    for (int i = 0; i < 16; ++i) imp[i * 256 + tid] = 0.f;
    if (tid < 32) selm[tid] = 0u;
    const float* grow = p.gates + (size_t)(b * SEQ + tq) * 24 + h * 3;
    float* prow = p.part + (size_t)(b * SEQ + tq) * 1024 + h * 128;
    OAcc o;
    float m, l;
    KVRegs kv;
    {
      const bf16_t* kb = p.kcb + (size_t)bg * 128 * 128;
      const bf16_t* vb = p.vcT + (size_t)bg * 128 * 128;
      oacc_zero(o);
      m = NEG_BIG; l = 0.f;
      kv_load(kv, kb, 128, vb, 128);
      vsync();
      kv_store(kv, lk, lv);
      vsync();
      f32x16 x0, x1;
      qk_tile(q, lk, x0, x1);
      int tqv = tq;
      asm volatile("" : "+v"(tqv));
      tqv -= 64 * hh;
      float fsc = 1.f, fbb = 0.f;
      if (t0 >= 1152) {
        fsc = ATT_SCALE2; fbb = lut[127];
      } else {
#pragma unroll
        for (int r = 0; r < 16; ++r) {
          const int c = 8 * (r >> 2) + (r & 3);
          const int d0 = tqv - 16 * c - 31, d1 = d0 - 512;
          x0[r] = (d0 >= 0) ? x0[r] * ATT_SCALE2 + lut[min(d0, 127)] : -INFINITY;
          x1[r] = (d1 >= 0) ? x1[r] * ATT_SCALE2 + lut[min(d1, 127)] : -INFINITY;
        }
      }
      softmax_tile(x0, x1, m, l, o, fsc, fbb);
      const float m0 = m;
      pv_tile(o, lv, x0, x1);
      f32x16 z0, z1;
#pragma unroll
      for (int r = 0; r < 16; ++r) { z0[r] = 0.f; z1[r] = 0.f; }
      if (t0 >= 1024) {
        kv_load(kv, kb + 64 * 128, 128, vb + 64, 128);
        vsync();
        kv_store(kv, lk, lv);
        vsync();
        qk_tile(q, lk, z0, z1);
        asm volatile("" : "+v"(tqv));
#pragma unroll
        for (int r = 0; r < 16; ++r) {
          const int c = 64 + 8 * (r >> 2) + (r & 3);
          const int d0 = tqv - 16 * c - 31, d1 = d0 - 512;
          z0[r] = (d0 >= 0) ? z0[r] * ATT_SCALE2 + lut[min(d0, 127)] : -INFINITY;
          z1[r] = (d1 >= 0) ? z1[r] * ATT_SCALE2 + lut[min(d1, 127)] : -INFINITY;
        }
        softmax_tile(z0, z1, m, l, o);
        pv_tile(o, lv, z0, z1);
      }
      const float inv = 1.f / fmaxf(l, 1e-20f);
      const float c0 = __builtin_amdgcn_exp2f(m0 - m) * inv;
#pragma unroll
      for (int r = 0; r < 16; ++r) {
        const int c = 8 * (r >> 2) + (r & 3) + 4 * hh;
        if (x0[r] != 0.f) atomicAdd(&imp[(c) * 32 + ql], x0[r] * c0);
        if (x1[r] != 0.f) atomicAdd(&imp[(c + 32) * 32 + ql], x1[r] * c0);
        if (z0[r] != 0.f) atomicAdd(&imp[(c + 64) * 32 + ql], z0[r] * inv);
        if (z1[r] != 0.f) atomicAdd(&imp[(c + 96) * 32 + ql], z1[r] * inv);
      }
      const float gs = inv / (1.f + __expf(-grow[0]));
      oacc_foreach(o, [&](int d, float v0, float v1, float v2, float v3) {
        f32x4 u = {v0 * gs, v1 * gs, v2 * gs, v3 * gs};
        *(f32x4*)(prow + d) = u;
      });
    }
    vsync();
    {
      const int tido = opq(tid);
      const int qq = tido & 31, jg = tido >> 5;
#pragma unroll
      for (int jj = 0; jj < 4; ++jj) {
        const int j = jg * 4 + jj;
        float v = imp[(4 * j) * 32 + qq] + imp[(4 * j + 1) * 32 + qq] + imp[(4 * j + 2) * 32 + qq] + 0.5f * imp[(4 * j + 3) * 32 + qq];
        if (j > 0) v += 0.5f * imp[(4 * j - 1) * 32 + qq];
        const bool forced = (j == 0) || (j == cur) || (j == cur - 1);
        keys[qq * 33 + j] = forced ? 1e9f : ((j <= cur) ? v : -1e9f);
      }
      vsync();
      unsigned bits = 0u;
#pragma unroll
      for (int jj = 0; jj < 4; ++jj) {
        const int j = jg * 4 + jj;
        const float kj = keys[qq * 33 + j];
        int rank = 0;
        for (int i = 0; i < 32; ++i) {
          const float ki = keys[qq * 33 + i];
          rank += (ki > kj || (ki == kj && i < j)) ? 1 : 0;
        }
        if (rank < 16 && j <= cur) bits |= 1u << j;
      }
      atomicOr(&selm[qq], bits);
      vsync();
    }
    const unsigned mysel = selm[ql];
    unsigned um = mysel;
#pragma unroll
    for (int o2 = 16; o2 > 0; o2 >>= 1) um |= (unsigned)__shfl_xor((int)um, o2);
    um = (unsigned)__builtin_amdgcn_readfirstlane((int)um);
    {
      const bf16_t* kb = p.ks + (size_t)bg * SEQ * 128;
      const bf16_t* vb = p.vsT + (size_t)bg * 128 * SEQ;
      oacc_zero(o);
      m = NEG_BIG; l = 0.f;
      unsigned rem = um;
      int j = __builtin_ctz(rem);
      kv_load(kv, kb + (size_t)j * 64 * 128, 128, vb + j * 64, SEQ);
      while (rem) {
        j = __builtin_ctz(rem);
        rem &= rem - 1;
        const int jn = rem ? __builtin_ctz(rem) : j;
        vsync();
        kv_store(kv, lk, lv);
        vsync();
        f32x16 s0, s1;
        qk_tile(q, lk, s0, s1);
        const bool selq = (mysel >> j) & 1u;
        int tqv = tq;
        asm volatile("" : "+v"(tqv));
        float fsc = 1.f, fbb = 0.f;
        if (j * 64 + 63 + 113 <= t0) {
          fsc = selq ? ATT_SCALE2 : 0.f; fbb = selq ? lut[127] : -INFINITY;
        } else {
#pragma unroll
          for (int r = 0; r < 16; ++r) {
            const int d0 = tqv - (j * 64 + 8 * (r >> 2) + (r & 3) + 4 * hh), d1 = d0 - 32;
            s0[r] = (selq && d0 >= 0) ? s0[r] * ATT_SCALE2 + lut[min(d0, 127)] : -INFINITY;
            s1[r] = (selq && d1 >= 0) ? s1[r] * ATT_SCALE2 + lut[min(d1, 127)] : -INFINITY;
          }
        }
        kv_load(kv, kb + (size_t)jn * 64 * 128, 128, vb + jn * 64, SEQ);
        softmax_tile(s0, s1, m, l, o, fsc, fbb);
        pv_tile(o, lv, s0, s1);
      }
      const float gs = 1.f / (fmaxf(l, 1e-20f) * (1.f + __expf(-grow[1])));
      int qo = ql;
      asm volatile("" : "+v"(qo));
      float* pr2 = p.part + (size_t)(b * SEQ + t0 + qo) * 1024 + h * 128;
      oacc_foreach(o, [&](int d, float v0, float v1, float v2, float v3) {
        f32x4 u = *(f32x4*)(pr2 + d);
        u[0] += v0 * gs; u[1] += v1 * gs; u[2] += v2 * gs; u[3] += v3 * gs;
        *(f32x4*)(pr2 + d) = u;
      });
    }
    {
      const bf16_t* kb = p.kw + (size_t)bg * SEQ * 128;
      const bf16_t* vb = p.vwT + (size_t)bg * 128 * SEQ;
      oacc_zero(o);
      m = NEG_BIG; l = 0.f;
      int jlo = (t0 - 511) >> 6;
      if (jlo < 0) jlo = 0;
      kv_load(kv, kb + (size_t)jlo * 64 * 128, 128, vb + jlo * 64, SEQ);
      for (int j = jlo; j <= cur; ++j) {
        const int jn = (j < cur) ? j + 1 : j;
        vsync();
        kv_store(kv, lk, lv);
        vsync();
        f32x16 s0, s1;
        qk_tile(q, lk, s0, s1);
        int tqv = tq;
        asm volatile("" : "+v"(tqv));
        float wsc = 1.f, wbb = 0.f;
        if (j * 64 + 63 + 113 <= t0 && t0 + 31 - j * 64 < 512) {
          wsc = ATT_SCALE2; wbb = lut[127];
        } else {
#pragma unroll
          for (int r = 0; r < 16; ++r) {
            const int d0 = tqv - (j * 64 + 8 * (r >> 2) + (r & 3) + 4 * hh), d1 = d0 - 32;
            s0[r] = (d0 >= 0 && d0 < 512) ? s0[r] * ATT_SCALE2 + lut[min(d0, 127)] : -INFINITY;
            s1[r] = (d1 >= 0 && d1 < 512) ? s1[r] * ATT_SCALE2 + lut[min(d1, 127)] : -INFINITY;
          }
        }
        kv_load(kv, kb + (size_t)jn * 64 * 128, 128, vb + jn * 64, SEQ);
        softmax_tile(s0, s1, m, l, o, wsc, wbb);
        pv_tile(o, lv, s0, s1);
      }
      const float gs = 1.f / (fmaxf(l, 1e-20f) * (1.f + __expf(-grow[2])));
      int qo = ql;
      asm volatile("" : "+v"(qo));
      const float* pr2 = p.part + (size_t)(b * SEQ + t0 + qo) * 1024 + h * 128;
      bf16_t* orow = p.omix + (size_t)(b * SEQ + t0 + qo) * DM + h * 128;
      oacc_foreach(o, [&](int d, float v0, float v1, float v2, float v3) {
        const f32x4 u = *(const f32x4*)(pr2 + d);
        uint2 w;
        w.x = pack2(u[0] + v0 * gs, u[1] + v1 * gs);
        w.y = pack2(u[2] + v2 * gs, u[3] + v3 * gs);
        *(uint2*)(orow + d) = w;
      });
    }
  }
}

__device__ __forceinline__ void ph_cvt(const float* src, bf16_t* dst, size_t n) {
  typedef __attribute__((ext_vector_type(4))) float f32x4;
  const size_t nv = n / 8;
  for (size_t i = (size_t)VB() * 256 + VT(); i < nv; i += (size_t)VG() * 256) {
    const f32x4 a = ((const f32x4*)src)[2 * i], b = ((const f32x4*)src)[2 * i + 1];
    u32x4 o;
    o[0] = pack2(a[0], a[1]); o[1] = pack2(a[2], a[3]); o[2] = pack2(b[0], b[1]); o[3] = pack2(b[2], b[3]);
    ((u32x4*)dst)[i] = o;
  }
}

__device__ __forceinline__ void ph_scores(const P& p, char* lds) {
  for (int u = VB(); u < 64 * 16; u += VG()) {
    const int tm = u & 63, hp = u >> 6;
    const int m0 = tm * 128;
    float* sc = p.scores + (size_t)m0 * DM + hp * 128;
    gemm_tile_bf16<false>(p.omix + (size_t)m0 * DM + hp * 128, DM, p.subkb + (size_t)hp * 128 * 128, 128, 128, lds,
                          [&](int r, int c, float val) { sc[(size_t)r * DM + c] = val; });
  }
}

template <int PM = 0>
__device__ __forceinline__ void ph_qp_scores(const P& p, char* lds0, char* lds) {
  for (int u = (int)blockIdx.x; u < 32 * 8; u += (int)gridDim.x) {
    const int x = u & 7, i = (u >> 3) & 31;
    const int tm = (x & 3) * 8 + (i & 7), tn = (x >> 2) * 4 + (i >> 3);
    const int m0 = tm * 256, n0 = tn * 256;
    bf16_t* qp = p.omix + (size_t)m0 * DM + n0;
    const float* rss = p.rowss + T_TOK + m0;
    gemm_tile_huge<PM>(p.hn + (size_t)m0 * DM, DM, p.WpqT + (size_t)n0 * DM, DM, DM, lds0,
                   [&](int r, int c, f32x4_e lo, f32x4_e hi) {
                     const float rs = rsqrtf(rss[r] * (1.f / DM) + RMS_EPS);
                     st_bf16x8(qp + (size_t)r * DM + c, lo * rs, hi * rs); });
    __threadfence_block();
    __syncthreads();
    const int hf = (int)(threadIdx.x >> 8);
    const int hp = tn * 2 + hf;
    float* sc = p.scores + (size_t)m0 * DM + hp * 128;
    gemm_tile_big(qp + hf * 128, DM, p.subkb + (size_t)hp * 128 * 128, 128, 128, lds,
                  [&](int r, int c, f32x4_e lo, f32x4_e hi) {
                    *(f32x4_e*)(sc + (size_t)r * DM + c) = lo; *(f32x4_e*)(sc + (size_t)r * DM + c + 4) = hi; });
    __syncthreads();
  }
}

__device__ __forceinline__ void ph_cvt4(const float* src, unsigned char* dst, float* scales, int nrows, int wid0, int nw) {
  typedef __attribute__((ext_vector_type(4))) float f32x4;
  typedef __attribute__((ext_vector_type(2))) float f32x2;
  const int lane = VT() & 63;
  const float one = __uint_as_float((unsigned)opq(0x3F800000));
  float lev[8];
#pragma unroll
  for (int c = 0; c < 8; ++c) {
    const f32x2 q = __builtin_amdgcn_cvt_scalef32_pk_f32_fp4((unsigned)opq(c * 0x11111111), one, 0);
    lev[c] = fabsf(q[0]);
  }
  const float maxlev = lev[7];
  for (int row = wid0; row < nrows; row += nw) {
    const f32x4* s4 = (const f32x4*)(src + (size_t)row * DM) + lane * 8;
    f32x4 v[8];
    float amax = 0.f;
#pragma unroll
    for (int i = 0; i < 8; ++i) {
      v[i] = s4[i];
#pragma unroll
      for (int k = 0; k < 4; ++k) amax = fmaxf(amax, fabsf(v[i][k]));
    }
    amax = wave_max(amax);
    const float sc = (amax > 0.f) ? maxlev / amax : 1.f;
    u32x4 o;
#pragma unroll
    for (int w = 0; w < 4; ++w) {
      unsigned pk = 0u;
      pk = __builtin_amdgcn_cvt_scalef32_pk_fp4_f32(pk, v[2 * w][0] * sc, v[2 * w][1] * sc, 1.0f, 0);
      pk = __builtin_amdgcn_cvt_scalef32_pk_fp4_f32(pk, v[2 * w][2] * sc, v[2 * w][3] * sc, 1.0f, 1);
      pk = __builtin_amdgcn_cvt_scalef32_pk_fp4_f32(pk, v[2 * w + 1][0] * sc, v[2 * w + 1][1] * sc, 1.0f, 2);
      pk = __builtin_amdgcn_cvt_scalef32_pk_fp4_f32(pk, v[2 * w + 1][2] * sc, v[2 * w + 1][3] * sc, 1.0f, 3);
      o[w] = pk;
    }
    *(u32x4*)(dst + (size_t)row * 1024 + lane * 16) = o;
    if (lane == 0) scales[row] = (amax > 0.f) ? amax / maxlev : 1.f;
  }
}

__device__ __forceinline__ float wave_sum_dpp(float v) {
  typedef __attribute__((ext_vector_type(2))) unsigned u32x2_d;
  v += __builtin_bit_cast(float, __builtin_amdgcn_update_dpp(0, __builtin_bit_cast(int, v), 0xB1, 0xF, 0xF, true));
  v += __builtin_bit_cast(float, __builtin_amdgcn_update_dpp(0, __builtin_bit_cast(int, v), 0x4E, 0xF, 0xF, true));
  v += __builtin_bit_cast(float, __builtin_amdgcn_update_dpp(0, __builtin_bit_cast(int, v), 0x141, 0xF, 0xF, true));
  v += __builtin_bit_cast(float, __builtin_amdgcn_update_dpp(0, __builtin_bit_cast(int, v), 0x140, 0xF, 0xF, true));
  u32x2_d r = __builtin_amdgcn_permlane16_swap(__float_as_uint(v), __float_as_uint(v), false, false);
  v = __uint_as_float(r[0]) + __uint_as_float(r[1]);
  r = __builtin_amdgcn_permlane32_swap(__float_as_uint(v), __float_as_uint(v), false, false);
  return __uint_as_float(r[0]) + __uint_as_float(r[1]);
}
__device__ __forceinline__ float gelu_rcp(float x) {
  const float y2 = (1.5957691216057308f * LOG2E) * (x + 0.044715f * x * x * x);
  return x * __builtin_amdgcn_rcpf(1.f + __builtin_amdgcn_exp2f(-y2));
}
__device__ __forceinline__ u32x4 r4_load(const unsigned char* tab, int eid, int lane) {
  return *((const u32x4*)(tab + (size_t)eid * 1024) + lane);
}
struct XPk { f32x16 a, b; };
struct Acc32 { f32x16 a, b; };

typedef __attribute__((ext_vector_type(2))) float f32x2_t;
#define PAIR(v, i) __builtin_shufflevector(v, v, (i), (i) + 1)
#define R4_DOT_W(word, xv, base, sa, sb)                                                             \
  {                                                                                                  \
    const f32x2_t q0 = __builtin_amdgcn_cvt_scalef32_pk_f32_fp4(word, one, 0), q1 = __builtin_amdgcn_cvt_scalef32_pk_f32_fp4(word, one, 1); \
    const f32x2_t q2 = __builtin_amdgcn_cvt_scalef32_pk_f32_fp4(word, one, 2), q3 = __builtin_amdgcn_cvt_scalef32_pk_f32_fp4(word, one, 3); \
    sa = __builtin_elementwise_fma(q0, PAIR(xv, base + 0), sa); sb = __builtin_elementwise_fma(q1, PAIR(xv, base + 2), sb); \
    sa = __builtin_elementwise_fma(q2, PAIR(xv, base + 4), sa); sb = __builtin_elementwise_fma(q3, PAIR(xv, base + 6), sb); \
  }
__device__ __forceinline__ float r4_dot(const u32x4& e, const XPk& x) {
  const float one = __uint_as_float((unsigned)opq(0x3F800000));
  f32x2_t sa = {0.f, 0.f}, sb = {0.f, 0.f};
  R4_DOT_W(e[0], x.a, 0, sa, sb) R4_DOT_W(e[1], x.a, 8, sa, sb) R4_DOT_W(e[2], x.b, 0, sa, sb) R4_DOT_W(e[3], x.b, 8, sa, sb)
  sa = sa + sb;
  return sa[0] + sa[1];
}
#define R4_AXPY_P(accv, i, q)                                                                        \
  { const f32x2_t r_ = __builtin_elementwise_fma(h2, q, PAIR(accv, i)); accv[i] = r_[0]; accv[(i) + 1] = r_[1]; }
#define R4_AXPY_W(word, accv, base)                                                                  \
  {                                                                                                  \
    const f32x2_t q0 = __builtin_amdgcn_cvt_scalef32_pk_f32_fp4(word, one, 0), q1 = __builtin_amdgcn_cvt_scalef32_pk_f32_fp4(word, one, 1); \
    const f32x2_t q2 = __builtin_amdgcn_cvt_scalef32_pk_f32_fp4(word, one, 2), q3 = __builtin_amdgcn_cvt_scalef32_pk_f32_fp4(word, one, 3); \
    R4_AXPY_P(accv, base + 0, q0) R4_AXPY_P(accv, base + 2, q1) R4_AXPY_P(accv, base + 4, q2) R4_AXPY_P(accv, base + 6, q3) \
  }
__device__ __forceinline__ void r4_axpy(const u32x4& e, float hid, Acc32& acc) {
  const float one = __uint_as_float((unsigned)opq(0x3F800000));
  const f32x2_t h2 = {hid, hid};
  R4_AXPY_W(e[0], acc.a, 0) R4_AXPY_W(e[1], acc.a, 8) R4_AXPY_W(e[2], acc.b, 0) R4_AXPY_W(e[3], acc.b, 8)
}

#define INS16(K, x)                                                                                      \
  K##15 = __builtin_amdgcn_fmed3f(K##15, K##14, x); K##14 = __builtin_amdgcn_fmed3f(K##14, K##13, x);   \
  K##13 = __builtin_amdgcn_fmed3f(K##13, K##12, x); K##12 = __builtin_amdgcn_fmed3f(K##12, K##11, x);   \
  K##11 = __builtin_amdgcn_fmed3f(K##11, K##10, x); K##10 = __builtin_amdgcn_fmed3f(K##10, K##9, x);    \
  K##9 = __builtin_amdgcn_fmed3f(K##9, K##8, x); K##8 = __builtin_amdgcn_fmed3f(K##8, K##7, x);         \
  K##7 = __builtin_amdgcn_fmed3f(K##7, K##6, x); K##6 = __builtin_amdgcn_fmed3f(K##6, K##5, x);         \
  K##5 = __builtin_amdgcn_fmed3f(K##5, K##4, x); K##4 = __builtin_amdgcn_fmed3f(K##4, K##3, x);         \
  K##3 = __builtin_amdgcn_fmed3f(K##3, K##2, x); K##2 = __builtin_amdgcn_fmed3f(K##2, K##1, x);         \
  K##1 = __builtin_amdgcn_fmed3f(K##1, K##0, x); K##0 = fmaxf(K##0, x);
#define DECL16(K) float K##0 = -INFINITY, K##1 = -INFINITY, K##2 = -INFINITY, K##3 = -INFINITY, K##4 = -INFINITY, \
  K##5 = -INFINITY, K##6 = -INFINITY, K##7 = -INFINITY, K##8 = -INFINITY, K##9 = -INFINITY, K##10 = -INFINITY,   \
  K##11 = -INFINITY, K##12 = -INFINITY, K##13 = -INFINITY, K##14 = -INFINITY, K##15 = -INFINITY;
__device__ __forceinline__ float mkkey(float v, unsigned tag, unsigned mask) {
  return __uint_as_float((__float_as_uint(v) & ~mask) | tag);
}

__device__ __forceinline__ void ph_peer(const P& p, float* smem) {
  typedef __attribute__((ext_vector_type(4))) float f32x4;
  float* lists = smem;
  int* bexA = (int*)(smem + 4096);
  float* bgtA = smem + 6144;
  float* bsuA = smem + 8192;
  for (int item = VB(); item < T_TOK / 16; item += VG()) {
    const int t0 = item * 16;
    vsync();
    {
      const int tid = VT();
      const int tl = tid >> 4, hp = tid & 15;
      const f32x4* sp = (const f32x4*)(p.scores + (size_t)(t0 + tl) * DM + hp * 128);
      DECL16(k)
#pragma unroll 4
      for (int c4 = 0; c4 < 32; ++c4) {
        const f32x4 v = sp[c4];
#pragma unroll
        for (int e = 0; e < 4; ++e) {
          const float x = mkkey(v[e], 127u - (unsigned)(c4 * 4 + e), 127u);
          INS16(k, x)
        }
      }
      f32x4* lp = (f32x4*)(lists + (size_t)VT() * 16);
      f32x4 o0 = {k0, k1, k2, k3}, o1 = {k4, k5, k6, k7}, o2 = {k8, k9, k10, k11}, o3 = {k12, k13, k14, k15};
      lp[0] = o0; lp[1] = o1; lp[2] = o2; lp[3] = o3;
    }
    vsync();
    if (VT() < 128) {
      const int tid = VT();
      const int tl = tid >> 3, h = tid & 7;
      const float* la = lists + (size_t)(tl * 16 + 2 * h) * 16;
      const float* lb = la + 16;
      float av[16], bv[16];
#pragma unroll
      for (int i = 0; i < 16; ++i) {
        av[i] = __uint_as_float(__float_as_uint(la[i]) & ~127u);
        bv[i] = __uint_as_float(__float_as_uint(lb[i]) & ~127u);
      }
      DECL16(c)
#pragma unroll
      for (int i = 0; i < 16; ++i) {
#pragma unroll
        for (int j = 0; j < 16; ++j) {
          if ((i + 1) * (j + 1) <= 16) {
            const float x = mkkey(av[i] + bv[j], 255u - (unsigned)(i * 16 + j), 255u);
            INS16(c, x)
          }
        }
      }
      float cs[16] = {c0, c1, c2, c3, c4, c5, c6, c7, c8, c9, c10, c11, c12, c13, c14, c15};
      float ev[16];
      float sum = 0.f;
      const float mx = __uint_as_float(__float_as_uint(cs[0]) & ~255u);
#pragma unroll
      for (int n = 0; n < 16; ++n) {
        ev[n] = __expf(__uint_as_float(__float_as_uint(cs[n]) & ~255u) - mx);
        sum += ev[n];
      }
      const float isum = 1.f / sum;
#pragma unroll
      for (int n = 0; n < 16; ++n) {
        const unsigned cc = 255u - (__float_as_uint(cs[n]) & 255u);
        const unsigned ka = 127u - (__float_as_uint(la[cc >> 4]) & 127u);
        const unsigned kb = 127u - (__float_as_uint(lb[cc & 15u]) & 127u);
        const int eid = (int)(ka * 128u + kb);
        bexA[tl * 128 + h * 16 + n] = eid;
        bgtA[tl * 128 + h * 16 + n] = ev[n] * isum * p.sv8[eid];
        bsuA[tl * 128 + h * 16 + n] = p.su8[eid];
      }
    }
    vsync();
#pragma unroll 1
    for (int ti4 = 0; ti4 < 4; ++ti4) {
    const int lane = VT() & 63, wv = VT() >> 6;
    const int tl = wv * 4 + ti4;
    const int t = t0 + tl;
    const int* bex = bexA + tl * 128;
    const float* bgt = bgtA + tl * 128;
    const float* bsu = bsuA + tl * 128;
    XPk x;
    {
      const u32x4* s4 = (const u32x4*)(p.hn + (size_t)t * DM) + lane * 4;
      const f32x4* g4 = (const f32x4*)p.norm_ffn + lane * 8;
      const u32x4 q0 = s4[0], q1 = s4[1], q2 = s4[2], q3 = s4[3];
#define UNPK(q, lo) f32x4{__uint_as_float(q[lo] << 16), __uint_as_float(q[lo] & 0xffff0000u), \
                          __uint_as_float(q[lo + 1] << 16), __uint_as_float(q[lo + 1] & 0xffff0000u)}
      const f32x4 a0 = UNPK(q0, 0), a1 = UNPK(q0, 2), a2 = UNPK(q1, 0), a3 = UNPK(q1, 2);
      const f32x4 a4 = UNPK(q2, 0), a5 = UNPK(q2, 2), a6 = UNPK(q3, 0), a7 = UNPK(q3, 2);
      float ss = 0.f;
#define SSQ(v) ss += v[0] * v[0] + v[1] * v[1] + v[2] * v[2] + v[3] * v[3];
      SSQ(a0) SSQ(a1) SSQ(a2) SSQ(a3) SSQ(a4) SSQ(a5) SSQ(a6) SSQ(a7)
#undef SSQ
      ss = wave_sum(ss);
      const float rs = rsqrtf(ss * (1.f / DM) + RMS_EPS);
#define XPK(dst, base, va, vb, gi)                                                    \
  {                                                                                   \
    const f32x4 ga = g4[gi], gb = g4[gi + 1];                                         \
    dst[base + 0] = bf2f(f2bf(va[0] * rs * ga[0])); dst[base + 1] = bf2f(f2bf(va[1] * rs * ga[1]));   \
    dst[base + 2] = bf2f(f2bf(va[2] * rs * ga[2])); dst[base + 3] = bf2f(f2bf(va[3] * rs * ga[3]));   \
    dst[base + 4] = bf2f(f2bf(vb[0] * rs * gb[0])); dst[base + 5] = bf2f(f2bf(vb[1] * rs * gb[1]));   \
    dst[base + 6] = bf2f(f2bf(vb[2] * rs * gb[2])); dst[base + 7] = bf2f(f2bf(vb[3] * rs * gb[3]));   \
  }
      XPK(x.a, 0, a0, a1, 0) XPK(x.a, 8, a2, a3, 2) XPK(x.b, 0, a4, a5, 4) XPK(x.b, 8, a6, a7, 6)
#undef XPK
    }
    Acc32 acc;
#pragma unroll
    for (int r = 0; r < 16; ++r) { acc.a[r] = 0.f; acc.b[r] = 0.f; }
#define SID(i) __builtin_amdgcn_readfirstlane(bex[i])
#define SFL(arr, i) __uint_as_float((unsigned)__builtin_amdgcn_readfirstlane((int)__float_as_uint(arr[i])))
    u32x4 u0 = r4_load(p.pu8, SID(0), lane), u1 = r4_load(p.pu8, SID(1), lane), u2 = r4_load(p.pu8, SID(2), lane), u3 = r4_load(p.pu8, SID(3), lane);
    u32x4 v0 = r4_load(p.pv8, SID(0), lane), v1 = r4_load(p.pv8, SID(1), lane), v2 = r4_load(p.pv8, SID(2), lane), v3 = r4_load(p.pv8, SID(3), lane);
#pragma unroll 1
    for (int e0 = 0; e0 < 128; e0 += 4) {
      float d0 = r4_dot(u0, x), d1 = r4_dot(u1, x), d2 = r4_dot(u2, x), d3 = r4_dot(u3, x);
      const int en = (e0 + 4 < 128) ? e0 + 4 : 124;
      const int i0 = SID(en), i1 = SID(en + 1), i2 = SID(en + 2), i3 = SID(en + 3);
      u0 = r4_load(p.pu8, i0, lane); u1 = r4_load(p.pu8, i1, lane); u2 = r4_load(p.pu8, i2, lane); u3 = r4_load(p.pu8, i3, lane);
      d0 = wave_sum_dpp(d0); d1 = wave_sum_dpp(d1); d2 = wave_sum_dpp(d2); d3 = wave_sum_dpp(d3);
      { const float hid = SFL(bgt, e0 + 0) * gelu_rcp(d0 * SFL(bsu, e0 + 0)); r4_axpy(v0, hid, acc); }
      { const float hid = SFL(bgt, e0 + 1) * gelu_rcp(d1 * SFL(bsu, e0 + 1)); r4_axpy(v1, hid, acc); }
      { const float hid = SFL(bgt, e0 + 2) * gelu_rcp(d2 * SFL(bsu, e0 + 2)); r4_axpy(v2, hid, acc); }
      { const float hid = SFL(bgt, e0 + 3) * gelu_rcp(d3 * SFL(bsu, e0 + 3)); r4_axpy(v3, hid, acc); }
      v0 = r4_load(p.pv8, i0, lane); v1 = r4_load(p.pv8, i1, lane); v2 = r4_load(p.pv8, i2, lane); v3 = r4_load(p.pv8, i3, lane);
    }
#undef SID
#undef SFL
    const int lane2 = opq(lane);
    f32x4* o4 = (f32x4*)(p.out + (size_t)t * DM) + lane2 * 8;
    const u32x4* hq = (const u32x4*)(p.hn + (size_t)t * DM) + lane2 * 4;
    const f32x4* g4 = (const f32x4*)p.norm_final + lane2 * 8;
    f32x4 hv[8];
    float ss = 0.f;
#pragma unroll
    for (int i = 0; i < 4; ++i) {
      const u32x4 q = hq[i];
      hv[2 * i] = UNPK(q, 0);
      hv[2 * i + 1] = UNPK(q, 2);
    }
#undef UNPK
#pragma unroll
    for (int i = 0; i < 8; ++i) {
#pragma unroll
      for (int k = 0; k < 4; ++k) {
        hv[i][k] += (i < 4) ? acc.a[4 * i + k] : acc.b[4 * (i - 4) + k];
        ss += hv[i][k] * hv[i][k];
      }
    }
    ss = wave_sum(ss);
    const float rs = rsqrtf(ss * (1.f / DM) + RMS_EPS);
#pragma unroll
    for (int i = 0; i < 8; ++i) {
      const f32x4 g = g4[i];
      f32x4 o;
#pragma unroll
      for (int k = 0; k < 4; ++k) o[k] = hv[i][k] * rs * g[k];
      o4[i] = o;
    }
    }
  }
}

#define XB_TMO      128
#define XB_XCNT(j)  (256  + 64 * (j))
#define XB_XSUB(j)  (1280 + 64 * (j))
#define XB_XGEN(j)  (2304 + 64 * (j))
#define XB_TOP      3328
#define XB_TOPGEN   3392
#define XCD_BAR_WORDS 3456
#define XB_SPIN_CAP (1u << 22)
__device__ __forceinline__ unsigned xb_ld(unsigned* p) { return __hip_atomic_load(p, __ATOMIC_RELAXED, __HIP_MEMORY_SCOPE_AGENT); }
__device__ __forceinline__ unsigned xb_add(unsigned* p, unsigned v) { return __hip_atomic_fetch_add(p, v, __ATOMIC_RELAXED, __HIP_MEMORY_SCOPE_AGENT); }
__device__ __forceinline__ unsigned xb_xcc_id() { return (unsigned)__builtin_amdgcn_s_getreg((3 << 11) | 20) & 0xFu; }
#define XB_SPIN(cond, bar) do { unsigned _sp = 0; while (cond) { __builtin_amdgcn_s_sleep(1); \
    if ((++_sp & 255u) == 0u) { if (xb_ld(&(bar)[XB_TMO])) break; if (_sp > XB_SPIN_CAP) { atomicAdd(&(bar)[XB_TMO], 1u); break; } } } } while (0)
struct XcdBarrier { unsigned* bar; unsigned x; volatile LAS unsigned* st; };
__device__ __forceinline__ XcdBarrier xcd_barrier_post(unsigned* bar, volatile LAS unsigned* st) {
  XcdBarrier b; b.bar = bar; b.x = xb_xcc_id(); b.st = st;
  if (threadIdx.x == 0) (void)xb_add(&bar[XB_XCNT(b.x)], 1u);
  return b;
}
__device__ __forceinline__ void xcd_barrier_complete(unsigned* bar, unsigned x, unsigned& nloc, unsigned& nx) {
  const unsigned G = gridDim.x * gridDim.y * gridDim.z;
  unsigned sum, cnt, mine, sp = 0u;
  for (;;) {
    sum = 0u; cnt = 0u; mine = 0u;
#pragma unroll
    for (unsigned j = 0; j < 16; ++j) { const unsigned c = xb_ld(&bar[XB_XCNT(j)]); sum += c; cnt += (c > 0u) ? 1u : 0u; mine = (j == x) ? c : mine; }
    if (sum == G) break;
    __builtin_amdgcn_s_sleep(1);
    if ((++sp & 255u) == 0u) { if (xb_ld(&bar[XB_TMO])) break; if (sp > XB_SPIN_CAP) { atomicAdd(&bar[XB_TMO], 1u); break; } }
  }
  nloc = mine > 0u ? mine : 1u; nx = cnt > 0u ? cnt : 1u;
}
__device__ __forceinline__ void xcd_barrier(const XcdBarrier& b) {
  asm volatile("s_waitcnt vmcnt(0)" ::: "memory");
  __syncthreads();
  if (threadIdx.x == 0) {
    unsigned* bar = b.bar;
    __builtin_amdgcn_s_waitcnt(0);
    unsigned nloc = b.st[0], nx = b.st[1];
    if (nloc == 0u) { xcd_barrier_complete(bar, b.x, nloc, nx); b.st[0] = nloc; b.st[1] = nx; }
    const unsigned old = xb_add(&bar[XB_XSUB(b.x)], 1u);
    const unsigned gen = old / nloc;
    if (old + 1u == (gen + 1u) * nloc) {
      __builtin_amdgcn_fence(__ATOMIC_RELEASE, "agent");
      asm volatile("s_waitcnt vmcnt(0)" ::: "memory");
      const unsigned og = xb_add(&bar[XB_TOP], 1u);
      const unsigned tg = og / nx;
      if (og + 1u == (tg + 1u) * nx) xb_add(&bar[XB_TOPGEN], 1u);
      else XB_SPIN(xb_ld(&bar[XB_TOPGEN]) == tg, bar);
      __builtin_amdgcn_fence(__ATOMIC_ACQUIRE, "agent");
      xb_add(&bar[XB_XGEN(b.x)], 1u);
      asm volatile("s_waitcnt vmcnt(0)" ::: "memory");
    } else {
      XB_SPIN(xb_ld(&bar[XB_XGEN(b.x)]) == gen, bar);
      __builtin_amdgcn_fence(__ATOMIC_ACQUIRE, "agent");
      asm volatile("s_waitcnt vmcnt(0)" ::: "memory");
    }
  }
  __syncthreads();
}

typedef const __attribute__((address_space(4))) P* KP;
__device__ __forceinline__ P loadP() {
#if defined(__HIP_DEVICE_COMPILE__)
  KP k = (KP)__builtin_amdgcn_kernarg_segment_ptr();
  asm volatile("" : "+s"(k));
  P p = *k;
  return p;
#else
  return P{};
#endif
}

__global__ void __launch_bounds__(512, 2) mega(P p_arg) {
  cg::grid_group grid = cg::this_grid();
  __shared__ __attribute__((aligned(16))) float smem_all[2 * 18432 + 64];
  float* smem = smem_all + (threadIdx.x >> 8) * 18432;
  char* lds = (char*)smem;
  unsigned* xbw = (unsigned*)(smem_all + 2 * 18432 + 32);
  if (threadIdx.x < 64) ((unsigned*)(smem_all + 2 * 18432))[threadIdx.x] = 0u;
  if (blockIdx.x == 0) {
    P p = loadP();
    for (int i = threadIdx.x; i < XCD_BAR_WORDS; i += 512) p.bar[i] = 0u;
  }
  __syncthreads();
  { P p = loadP(); ph_rmsnorm(p.x, p.norm_mix, p.hn, T_TOK); ph_rmsnorm(p.mem, p.norm_mkv, p.memn, 1024); }
  { P p = loadP(); ph_transpose<true>(smem, p.w_in, DM, INC, 5760, p.WinT); }
  { P p = loadP(); ph_transpose<false>(smem, p.w_mk, DM, 512, 512, p.WmkT); }
  { P p = loadP(); ph_transpose<false>(smem, p.w_mv, DM, 512, 512, p.WmvT); }
  { P p = loadP(); ph_cvt(p.subk, p.subkb, (size_t)16 * 128 * 128); }
  { P p = loadP(); ph_transpose<false>(smem, p.w1_k, 4096, 128, 128, p.w1T); }
  { P p = loadP(); ph_transpose<false>(smem, p.w1_v, 4096, 128, 128, p.w1T + 128 * 4096); }
  { P p = loadP(); ph_transpose<false>(smem, p.w2_k, 128, 128, 128, p.w2T); }
  { P p = loadP(); ph_transpose<false>(smem, p.w2_v, 128, 128, 128, p.w2T + 128 * 128); }
  { P p = loadP(); ph_posb(p); }
  { P p = loadP(); for (int i = VB() * 256 + VT(); i < 2 * T_TOK; i += VG() * 256) p.rowss[i] = 0.f; }
  grid.sync();
  XcdBarrier xb;
  { P p = loadP(); xb = xcd_barrier_post(p.bar, (volatile LAS unsigned*)xbw); }
  { P p = loadP(); ph_proj(p, (char*)smem_all, lds); }
  const int kvb = (VG() == 512) ? ((VB() >= 384 && VB() < 416) ? (VB() - 384) * 8 : -1) : -2;
  const int vvb = (VG() == 512) ? ((VB() >= 416 && VB() < 448) ? (VB() - 416) * 8 : -1) : -2;
  { P p = loadP(); bf16_t* kmem = p.kmemb;
    ph_gemm_bf16(p.memn, DM, p.WmkT, DM, 1024, 512, DM, lds, [=](int m, int n, float v) {
      kmem[((size_t)((m >> 8) * 4 + (n >> 7)) * 256 + (m & 255)) * 128 + (n & 127)] = f2bf(v); }, kvb); }
  { P p = loadP(); bf16_t* vmem = p.vmemT;
    ph_gemm_bf16(p.memn, DM, p.WmvT, DM, 1024, 512, DM, lds, [=](int m, int n, float v) {
      vmem[((size_t)((m >> 8) * 4 + (n >> 7)) * 128 + (n & 127)) * 256 + perm16(m & 255)] = f2bf(v); }, vvb); }
  xcd_barrier(xb);
  { P p = loadP(); ph_compress2(p, lds); }
  { P p = loadP(); ph_sb2(p, lds); }
  {
    const int skip = (VG() > 32) ? 16 : 0;
    const int vb = (VB() >= skip) ? VB() - skip : -1, nvb = VG() - skip;
    vsync();
    { P p = loadP(); ph_transpose<false>(smem, p.w_out, DM, DM, DM, p.WoutT, vb, nvb); }
    { P p = loadP(); ph_transpose<false>(smem, p.w_mq, DM, 512, 512, p.WmqT, vb, nvb, p.norm_mq); }
  }
  xcd_barrier(xb);
  { P p = loadP(); ph_nsa2(p, lds); }
  xcd_barrier(xb);
  { P p = loadP(); const float* x = p.x; bf16_t* hn = p.hn; float* rss = p.rowss;
    ph_gemm_huge(p.omix, DM, p.WoutT, DM, T_TOK, DM, DM, (char*)smem_all, [=](int m, int n, f32x4_e lo, f32x4_e hi) {
      const f32x4_e x0 = *(const f32x4_e*)(x + (size_t)m * DM + n), x1 = *(const f32x4_e*)(x + (size_t)m * DM + n + 4);
      const f32x4_e h0 = x0 + lo, h1 = x1 + hi;
      resid_feed(h0, h1, n, hn + (size_t)m * DM, rss + m); }); }
  xcd_barrier(xb);
  {
    const int half = (VG() >= 512) ? 256 : 0;
    if (half == 0 || VB() < half) { P p = loadP(); ph_memq_attn(p, lds, VB(), half ? half : VG()); }
    if (VB() >= half) {
      const int nwv = (VG() - half) * 4, wid = (VB() - half) * 4 + (VT() >> 6);
      vsync();
      { P p = loadP(); ph_transpose<false>(smem, p.w_mo, 512, DM, DM, p.WmoT, VB() - half, VG() - half); }
      { P p = loadP(); ph_cvt4(p.pu, p.pu8, p.su8, 16384, wid, nwv); }
      { P p = loadP(); ph_cvt4(p.pv, p.pv8, p.sv8, 16384, wid, nwv); }
      vsync();
      { P p = loadP(); ph_transpose<false>(smem, p.w_pq, DM, DM, DM, p.WpqT, VB() - half, VG() - half, p.norm_ffn); }
    }
  }
  xcd_barrier(xb);
  { P p = loadP(); bf16_t* hn = p.hn; float* rss = p.rowss + T_TOK;
    ph_gemm_huge(p.omem, 512, p.WmoT, 512, T_TOK, DM, 512, (char*)smem_all, [=](int m, int n, f32x4_e lo, f32x4_e hi) {
      const u32x4 hb = *(const u32x4*)(hn + (size_t)m * DM + n);
      const f32x4_e r0 = {__uint_as_float(hb[0] << 16), __uint_as_float(hb[0] & 0xffff0000u),
                          __uint_as_float(hb[1] << 16), __uint_as_float(hb[1] & 0xffff0000u)};
      const f32x4_e r1 = {__uint_as_float(hb[2] << 16), __uint_as_float(hb[2] & 0xffff0000u),
                          __uint_as_float(hb[3] << 16), __uint_as_float(hb[3] & 0xffff0000u)};
      const f32x4_e h0 = r0 + lo, h1 = r1 + hi;
      resid_feed(h0, h1, n, hn + (size_t)m * DM, rss + m); }); }
  xcd_barrier(xb);
  { P p = loadP(); ph_qp_scores<0>(p, (char*)smem_all, lds); }
  xcd_barrier(xb);
  { P p = loadP(); ph_peer(p, smem); }
}

extern "C" void kernel_launch(void* const* d_in, const int* in_sizes, int n_in, void* d_out, int out_size, void* d_ws,
                              size_t ws_size, hipStream_t stream) {
  P p{};
  p.x = (const float*)d_in[0]; p.mem = (const float*)d_in[1]; p.t5 = (const float*)d_in[2];
  p.norm_mix = (const float*)d_in[3]; p.w_in = (const float*)d_in[4]; p.pos_k = (const float*)d_in[5];
  p.w1_k = (const float*)d_in[6]; p.w2_k = (const float*)d_in[7]; p.pos_v = (const float*)d_in[8];
  p.w1_v = (const float*)d_in[9]; p.w2_v = (const float*)d_in[10]; p.w_out = (const float*)d_in[11];
  p.norm_mq = (const float*)d_in[12]; p.norm_mkv = (const float*)d_in[13]; p.w_mq = (const float*)d_in[14];
  p.w_mk = (const float*)d_in[15]; p.w_mv = (const float*)d_in[16]; p.w_mo = (const float*)d_in[17];
  p.norm_ffn = (const float*)d_in[18]; p.w_pq = (const float*)d_in[19]; p.subk = (const float*)d_in[20];
  p.pu = (const float*)d_in[21]; p.pv = (const float*)d_in[22]; p.norm_final = (const float*)d_in[23];
  p.out = (float*)d_out;
  char* w = (char*)d_ws;
  size_t off = 0;
  auto take = [&](size_t bytes) { char* r = w + off; off += (bytes + 255) & ~(size_t)255; return r; };
  p.bar = (unsigned*)take(XCD_BAR_WORDS * 4);
  p.scores = (float*)take((size_t)T_TOK * DM * 4);
  p.gates = (float*)take((size_t)T_TOK * 24 * 4);
  p.part = (float*)take((size_t)T_TOK * 1024 * 4);
  p.posb = (float*)take(256 * 4);
  p.rowss = (float*)take((size_t)2 * T_TOK * 4);
  p.qn = (bf16_t*)take((size_t)T_TOK * 1024 * 2);
  p.kcin = (bf16_t*)take((size_t)T_TOK * 256 * 2 + 65536);
  p.vcin = (bf16_t*)take((size_t)T_TOK * 256 * 2 + 65536);
  p.ks = (bf16_t*)take((size_t)T_TOK * 256 * 2);
  p.vsT = (bf16_t*)take((size_t)T_TOK * 256 * 2);
  p.kw = (bf16_t*)take((size_t)T_TOK * 256 * 2);
  p.vwT = (bf16_t*)take((size_t)T_TOK * 256 * 2);
  p.kcb = (bf16_t*)take((size_t)8 * 128 * 128 * 2);
  p.vcT = (bf16_t*)take((size_t)8 * 128 * 128 * 2);
  p.c1 = (bf16_t*)take((size_t)16 * 128 * 128 * 2);
  p.w1T = (bf16_t*)take((size_t)2 * 128 * 4096 * 2);
  p.w2T = (bf16_t*)take((size_t)2 * 128 * 128 * 2);
  p.hn = (bf16_t*)take((size_t)T_TOK * DM * 2);
  p.omix = (bf16_t*)take((size_t)T_TOK * DM * 2);
  p.memn = (bf16_t*)take((size_t)1024 * DM * 2);
  p.omem = (bf16_t*)take((size_t)T_TOK * 512 * 2);
  p.WinT = (bf16_t*)take((size_t)5760 * DM * 2);
  p.WoutT = (bf16_t*)take((size_t)DM * DM * 2);
  p.WpqT = (bf16_t*)take((size_t)DM * DM * 2);
  p.WmqT = (bf16_t*)take((size_t)512 * DM * 2);
  p.WmkT = (bf16_t*)take((size_t)512 * DM * 2);
  p.WmvT = (bf16_t*)take((size_t)512 * DM * 2);
  p.WmoT = (bf16_t*)take((size_t)DM * 512 * 2);
  p.qmemb = (bf16_t*)take((size_t)T_TOK * 512 * 2);
  p.kmemb = (bf16_t*)take((size_t)1024 * 512 * 2);
  p.vmemT = (bf16_t*)take((size_t)1024 * 512 * 2);
  p.qsb = (bf16_t*)take((size_t)T_TOK * 1024 * 2);
  p.ksb = (bf16_t*)take((size_t)T_TOK * 1024 * 2);
  p.vsbT = (bf16_t*)take((size_t)T_TOK * 1024 * 2);
  p.pu8 = (unsigned char*)take((size_t)16384 * 1024);
  p.pv8 = (unsigned char*)take((size_t)16384 * 1024);
  p.su8 = (float*)take(16384 * 4);
  p.sv8 = (float*)take(16384 * 4);
  p.subkb = (bf16_t*)take((size_t)16 * 128 * 128 * 2);
  static int grid_blocks = 0;
  if (!grid_blocks) {
    int dev = 0, cus = 0, per_cu = 0;
    (void)hipGetDevice(&dev);
    (void)hipDeviceGetAttribute(&cus, hipDeviceAttributeMultiprocessorCount, dev);
    (void)hipOccupancyMaxActiveBlocksPerMultiprocessor(&per_cu, mega, 512, 0);
    if (per_cu > 1) per_cu = 1;
    if (per_cu < 1) per_cu = 1;
    grid_blocks = cus * per_cu;
  }
  void* args[] = {&p};
  hipError_t e = hipLaunchCooperativeKernel((void*)mega, dim3(grid_blocks), dim3(512), args, 0, stream);
  if (e != hipSuccess) fprintf(stderr, "cooperative launch failed: %s (grid %d)\n", hipGetErrorString(e), grid_blocks);
}
```

```cpp
#include <hip/hip_runtime.h>
#include <hip/hip_cooperative_groups.h>
#include <cstdio>
namespace cg = cooperative_groups;
#include <stdint.h>

#define SEQ 2048
#define NBATCH 4
#define T_TOK 8192
#define DM 2048
#define INC 5656
#define C_QN 0
#define C_KC 1024
#define C_VC 1280
#define C_KS 1536
#define C_VS 1792
#define C_KW 2048
#define C_VW 2304
#define C_GT 2560
#define C_QSB 2584
#define C_KSB 3608
#define C_VSB 4632
#define ATT_SCALE 0.08838834764831845f
#define LOG2E 1.4426950408889634f
#define ATT_SCALE2 (ATT_SCALE * LOG2E)
#define RMS_EPS 1e-6f

typedef unsigned short bf16_t;
typedef __attribute__((ext_vector_type(8))) short bf16x8;
typedef __attribute__((ext_vector_type(16))) float f32x16;
typedef __attribute__((ext_vector_type(2))) __bf16 bf16v2;
typedef __attribute__((ext_vector_type(4))) unsigned u32x4;
typedef __attribute__((ext_vector_type(4))) int i32x4_t;
typedef __attribute__((ext_vector_type(8))) int i32x8_t;

struct P {
  const float *x, *mem, *t5, *norm_mix, *w_in, *pos_k, *w1_k, *w2_k, *pos_v, *w1_v, *w2_v, *w_out,
      *norm_mq, *norm_mkv, *w_mq, *w_mk, *w_mv, *w_mo, *norm_ffn, *w_pq, *subk, *pu, *pv, *norm_final;
  float* out;
  float *scores, *gates, *part, *posb, *rowss;
  unsigned* bar;
  bf16_t *hn, *omix, *memn, *omem;
  bf16_t *WinT, *WoutT, *WpqT, *WmqT, *WmkT, *WmvT, *WmoT;
  bf16_t *qmemb, *kmemb, *vmemT;
  bf16_t *qsb, *ksb, *vsbT;
  bf16_t* subkb;
  unsigned char *pu8, *pv8;
  float *su8, *sv8;
  bf16_t *qn, *kcin, *vcin, *ks, *vsT, *kw, *vwT, *kcb, *vcT, *c1, *w1T, *w2T;
};

__device__ __forceinline__ int opq(int v) { asm volatile("" : "+v"(v)); return v; }
#define LAS __attribute__((address_space(3)))
#define VHALF_BYTES 73728
#define VCNT_OFF (2 * VHALF_BYTES)
__device__ __forceinline__ int VT() { return opq(threadIdx.x) & 255; }
__device__ __forceinline__ int VB() { return (int)blockIdx.x * 2 + (int)(threadIdx.x >> 8); }
__device__ __forceinline__ int VG() { return (int)gridDim.x * 2; }
__device__ __forceinline__ void vbar_wait() {
  if ((threadIdx.x & 63) == 0) {
    LAS unsigned* c = (LAS unsigned*)(unsigned)(VCNT_OFF + 64 * (int)(threadIdx.x >> 8));
    const unsigned old = __hip_atomic_fetch_add(c, 1u, __ATOMIC_RELAXED, __HIP_MEMORY_SCOPE_WORKGROUP);
    const unsigned target = (old & ~3u) + 4u;
    while (__hip_atomic_load(c, __ATOMIC_RELAXED, __HIP_MEMORY_SCOPE_WORKGROUP) < target) __builtin_amdgcn_s_sleep(0);
  }
}
__device__ __forceinline__ void vsync() {
  __builtin_amdgcn_fence(__ATOMIC_RELEASE, "workgroup");
  vbar_wait();
  __builtin_amdgcn_fence(__ATOMIC_ACQUIRE, "workgroup");
}
__device__ __forceinline__ void vsync_raw() {
  asm volatile("" ::: "memory");
  vbar_wait();
  asm volatile("" ::: "memory");
}

__device__ __forceinline__ unsigned pack2(float a, float b) {
  bf16v2 r = {(__bf16)a, (__bf16)b};
  return *(unsigned*)&r;
}
__device__ __forceinline__ bf16_t f2bf(float a) {
  __bf16 r = (__bf16)a;
  return *(bf16_t*)&r;
}
__device__ __forceinline__ int perm16(int s) { return (s & ~12) | ((s & 4) << 1) | ((s & 8) >> 1); }
__device__ __forceinline__ float bf2f(bf16_t u) { return __uint_as_float((unsigned)u << 16); }

__device__ __forceinline__ float wave_max(float v) {
  for (int o = 32; o > 0; o >>= 1) v = fmaxf(v, __shfl_xor(v, o));
  return v;
}
__device__ __forceinline__ float wave_sum(float v) {
  for (int o = 32; o > 0; o >>= 1) v += __shfl_xor(v, o);
  return v;
}
__device__ __forceinline__ void wave_argmax(float& v, int& i) {
  for (int o = 32; o > 0; o >>= 1) {
    float ov = __shfl_xor(v, o);
    int oi = __shfl_xor(i, o);
    if (ov > v || (ov == v && oi < i)) { v = ov; i = oi; }
  }
}
__device__ __forceinline__ float gelu_tanh(float x) {
  return 0.5f * x * (1.f + tanhf(0.7978845608028654f * (x + 0.044715f * x * x * x)));
}
__device__ __forceinline__ float gelu_fast(float x) {
  const float y = 1.5957691216057308f * (x + 0.044715f * x * x * x);
  return x / (1.f + __expf(-y));
}
__device__ __forceinline__ int t5_bucket(int n) {
  if (n < 16) return n < 0 ? 0 : n;
  int b = 16;
  b += (n >= 19); b += (n >= 21); b += (n >= 24); b += (n >= 27); b += (n >= 31); b += (n >= 35);
  b += (n >= 40); b += (n >= 46); b += (n >= 52); b += (n >= 59); b += (n >= 67); b += (n >= 77);
  b += (n >= 87); b += (n >= 99); b += (n >= 113);
  return b;
}
__device__ __forceinline__ float log_sigmoid(float x) {
  return fminf(x, 0.f) - log1pf(expf(-fabsf(x)));
}

__device__ __forceinline__ void ph_rmsnorm(const float* src, const float* gain, bf16_t* dst, int rows) {
  int lane = VT() & 63, wv = VT() >> 6;
  for (int r = VB() * 4 + wv; r < rows; r += VG() * 4) {
    const float4* s4 = (const float4*)(src + (size_t)r * DM);
    float4 v[8];
    float ss = 0.f;
#pragma unroll
    for (int i = 0; i < 8; ++i) {
      v[i] = s4[i * 64 + lane];
      ss += v[i].x * v[i].x + v[i].y * v[i].y + v[i].z * v[i].z + v[i].w * v[i].w;
    }
    ss = wave_sum(ss);
    float rs = rsqrtf(ss * (1.f / DM) + RMS_EPS);
    uint2* d2 = (uint2*)(dst + (size_t)r * DM);
    const float4* g4 = (const float4*)gain;
#pragma unroll
    for (int i = 0; i < 8; ++i) {
      float4 g = g4[i * 64 + lane];
      uint2 o;
      o.x = pack2(v[i].x * rs * g.x, v[i].y * rs * g.y);
      o.y = pack2(v[i].z * rs * g.z, v[i].w * rs * g.w);
      d2[i * 64 + lane] = o;
    }
  }
}

template <bool CMAP>
__device__ __forceinline__ void ph_transpose(float* smem, const float* W, int K, int N, int Npad, bf16_t* Wt,
                                             int vblock = -2, int nvb = 0, const float* gk = nullptr) {
  typedef __attribute__((ext_vector_type(4))) float f32x4;
  float (*tl)[65] = (float (*)[65])smem;
  if (vblock == -1) return;
  const int b0 = (vblock >= 0) ? vblock : VB(), bstride = (vblock >= 0) ? nvb : VG();
  const int tid = VT();
  const int nk = K / 64, nn = Npad / 64;
  for (int tile = b0; tile < nk * nn; tile += bstride) {
    const int k0 = (tile % nk) * 64, n0 = (tile / nk) * 64;
    const int kr = tid >> 4, n4 = (tid & 15) * 4;
    int sc = n0 + n4;
    if (CMAP) sc = (sc < 2560) ? sc : (sc < 5632) ? sc + 24 : (sc < 5656) ? sc - 5632 + 2560 : N;
#pragma unroll
    for (int i = 0; i < 4; ++i) {
      const int k = kr + 16 * i;
      f32x4 v = {0.f, 0.f, 0.f, 0.f};
      if (sc < N) v = *(const f32x4*)(W + (size_t)(k0 + k) * N + sc);
      if (gk) v *= gk[k0 + k];
      tl[k][n4 + 0] = v[0]; tl[k][n4 + 1] = v[1]; tl[k][n4 + 2] = v[2]; tl[k][n4 + 3] = v[3];
    }
    vsync();
    int n = tid >> 2, kc = (tid & 3) * 16;
    unsigned w[8];
#pragma unroll
    for (int i = 0; i < 8; ++i) w[i] = pack2(tl[kc + 2 * i][n], tl[kc + 2 * i + 1][n]);
    uint4* dst = (uint4*)(Wt + (size_t)(n0 + n) * K + k0 + kc);
    dst[0] = make_uint4(w[0], w[1], w[2], w[3]);
    dst[1] = make_uint4(w[4], w[5], w[6], w[7]);
    vsync();
  }
}

__device__ __forceinline__ int lds_off(int row, int chunk) { return row * 128 + ((chunk ^ ((row >> 1) & 7)) << 4); }

template <bool TR, bool VEC = false, class Epi>
__device__ __forceinline__ void gemm_tile_bf16(const bf16_t* xp, int ldx, const bf16_t* yp, int ldy, int K, char* lds,
                                               Epi epi) {
  const int tid = VT(), lane = tid & 63, wv = tid >> 6;
  const int wr = wv >> 1, wc = wv & 1;
  f32x16 acc[2][2];
#pragma unroll
  for (int i = 0; i < 2; ++i)
#pragma unroll
    for (int j = 0; j < 2; ++j)
#pragma unroll
      for (int r = 0; r < 16; ++r) acc[i][j][r] = 0.f;
  const int prow = lane >> 3, pch = lane & 7;
  const bf16_t* xs[4];
  const bf16_t* ys[4];
#pragma unroll
  for (int ps = 0; ps < 4; ++ps) {
    const int row = (wv * 4 + ps) * 8 + prow;
    const int c = pch ^ ((row >> 1) & 7);
    xs[ps] = xp + (size_t)row * ldx + c * 8;
    ys[ps] = yp + (size_t)row * ldy + c * 8;
  }
  char* const mydst = lds + wv * 4096 + lane * 16;
#define GEMM_ISSUE(k0, bufoff)                                                                                              \
  _Pragma("unroll") for (int ps = 0; ps < 4; ++ps) {                                                                        \
    __builtin_amdgcn_global_load_lds((const unsigned*)(xs[ps] + (k0)), (unsigned*)(mydst + (bufoff) + ps * 1024), 16, 0, 0);         \
    __builtin_amdgcn_global_load_lds((const unsigned*)(ys[ps] + (k0)), (unsigned*)(mydst + (bufoff) + 16384 + ps * 1024), 16, 0, 0); \
  }
#define GEMM_COMPUTE(bufoff)                                                                                     \
  _Pragma("unroll") for (int kk = 0; kk < 4; ++kk) {                                                             \
    bf16x8 a[2], b[2];                                                                                           \
    const int ch = kk * 2 + (lane >> 5);                                                                         \
    _Pragma("unroll") for (int i = 0; i < 2; ++i) {                                                              \
      a[i] = *(const bf16x8*)(lds + (bufoff) + (TR ? 16384 : 0) + lds_off(wr * 64 + i * 32 + (lane & 31), ch)); \
      b[i] = *(const bf16x8*)(lds + (bufoff) + (TR ? 0 : 16384) + lds_off(wc * 64 + i * 32 + (lane & 31), ch)); \
    }                                                                                                            \
    _Pragma("unroll") for (int i = 0; i < 2; ++i)                                                                \
      _Pragma("unroll") for (int j = 0; j < 2; ++j)                                                              \
        acc[i][j] = __builtin_amdgcn_mfma_f32_32x32x16_bf16(a[i], b[j], acc[i][j], 0, 0, 0);                    \
  }
  vsync();
  GEMM_ISSUE(0, 0)
  for (int k0 = 0; k0 < K; k0 += 128) {
    asm volatile("s_waitcnt vmcnt(0)" ::: "memory");
    vsync();
    GEMM_ISSUE(k0 + 64, 32768)
    GEMM_COMPUTE(0)
    asm volatile("s_waitcnt vmcnt(0)" ::: "memory");
    vsync();
    if (k0 + 128 < K) { GEMM_ISSUE(k0 + 128, 0) }
    GEMM_COMPUTE(32768)
  }
#undef GEMM_ISSUE
#undef GEMM_COMPUTE
  int lane2 = lane;
  asm volatile("" : "+v"(lane2));
  if constexpr (VEC) {
    typedef __attribute__((ext_vector_type(4))) float f32x4;
    vsync();
    float* wl = (float*)lds + wv * (32 * 68);
    const int hh2 = lane2 >> 5, cl = lane2 & 31;
#pragma unroll
    for (int i = 0; i < 2; ++i) {
#pragma unroll
      for (int j = 0; j < 2; ++j)
#pragma unroll
        for (int r = 0; r < 16; ++r) wl[((r & 3) + 8 * (r >> 2) + 4 * hh2) * 68 + j * 32 + cl] = acc[i][j][r];
      __builtin_amdgcn_wave_barrier();
#pragma unroll
      for (int k = 0; k < 4; ++k) {
        const int row = (lane2 >> 3) + 8 * k, c8 = (lane2 & 7) * 8;
        const f32x4 lo = *(const f32x4*)&wl[row * 68 + c8];
        const f32x4 hi = *(const f32x4*)&wl[row * 68 + c8 + 4];
        epi(wr * 64 + i * 32 + row, wc * 64 + c8, lo, hi);
      }
      __builtin_amdgcn_wave_barrier();
    }
  } else {
#pragma unroll
    for (int i = 0; i < 2; ++i)
#pragma unroll
      for (int j = 0; j < 2; ++j)
#pragma unroll
        for (int r = 0; r < 16; ++r) {
          int rr = wr * 64 + i * 32 + (r & 3) + 8 * (r >> 2) + 4 * (lane2 >> 5);
          int cc = wc * 64 + j * 32 + (lane2 & 31);
          epi(rr, cc, acc[i][j][r]);
        }
  }
}

typedef __attribute__((ext_vector_type(4))) float f32x4_e;
__device__ __forceinline__ void st_bf16x8(bf16_t* dst, f32x4_e lo, f32x4_e hi) {
  u32x4 o;
  o[0] = pack2(lo[0], lo[1]); o[1] = pack2(lo[2], lo[3]); o[2] = pack2(hi[0], hi[1]); o[3] = pack2(hi[2], hi[3]);
  *(u32x4*)dst = o;
}

__device__ __forceinline__ int lds_off32(int row, int chunk) { return row * 64 + ((chunk ^ ((row >> 2) & 3)) << 4); }

template <class Epi>
__device__ __forceinline__ void gemm_tile_big(const bf16_t* xp, int ldx, const bf16_t* yp, int ldy, int K, char* lds,
                                              Epi epi) {
  const int tid = VT(), lane = tid & 63, wv = tid >> 6;
  f32x16 acc[2][4];
#pragma unroll
  for (int i = 0; i < 2; ++i)
#pragma unroll
    for (int j = 0; j < 4; ++j)
#pragma unroll
      for (int r = 0; r < 16; ++r) acc[i][j][r] = 0.f;
  const int prow = lane >> 2, pch = lane & 3;
  const bf16_t* xs[4];
  const bf16_t* ys[2];
#pragma unroll
  for (int ps = 0; ps < 4; ++ps) {
    const int row = (wv * 4 + ps) * 16 + prow;
    xs[ps] = xp + (size_t)row * ldx + (pch ^ ((row >> 2) & 3)) * 8;
  }
#pragma unroll
  for (int ps = 0; ps < 2; ++ps) {
    const int row = (wv * 2 + ps) * 16 + prow;
    ys[ps] = yp + (size_t)row * ldy + (pch ^ ((row >> 2) & 3)) * 8;
  }
  char* const xdst = lds + wv * 4096 + lane * 16;
  char* const ydst = lds + 16384 + wv * 2048 + lane * 16;
#define BIG_ISSUE(k0, st)                                                                                                      \
  _Pragma("unroll") for (int ps = 0; ps < 4; ++ps)                                                                             \
    __builtin_amdgcn_global_load_lds((const unsigned*)(xs[ps] + (k0)), (unsigned*)(xdst + (st) + ps * 1024), 16, 0, 0);        \
  _Pragma("unroll") for (int ps = 0; ps < 2; ++ps)                                                                             \
    __builtin_amdgcn_global_load_lds((const unsigned*)(ys[ps] + (k0)), (unsigned*)(ydst + (st) + ps * 1024), 16, 0, 0);
#define DSR(dst, addr, off) asm volatile("ds_read_b128 %0, %1 offset:%2" : "=v"(dst) : "v"(addr), "i"(off) : "memory")
#define WAIT1(n, x) asm volatile("s_waitcnt lgkmcnt(" #n ")" : "+v"(x))
#define WAIT2(n, x, y) asm volatile("s_waitcnt lgkmcnt(" #n ")" : "+v"(x), "+v"(y))
#define MF(acc_, a_, b_) acc_ = __builtin_amdgcn_mfma_f32_32x32x16_bf16(a_, b_, acc_, 0, 0, 0)
#define BIG_COMPUTE(st)                                                                                   \
  {                                                                                                       \
    bf16x8 a00, a01, a10, a11, b00, b01, b02, b03, b10, b11, b12, b13;                                    \
    const unsigned aa0 = abase0 + (st), aa1 = abase1 + (st), bb0 = bbase0 + (st), bb1 = bbase1 + (st);    \
    DSR(a00, aa0, 0); DSR(b00, bb0, 0); DSR(b01, bb0, 2048); DSR(b02, bb0, 4096); DSR(b03, bb0, 6144);    \
    DSR(a01, aa0, 2048);                                                                                  \
    DSR(a10, aa1, 0); DSR(b10, bb1, 0); DSR(b11, bb1, 2048); DSR(b12, bb1, 4096); DSR(b13, bb1, 6144);    \
    DSR(a11, aa1, 2048);                                                                                  \
    WAIT2(10, a00, b00); MF(acc[0][0], a00, b00);                                                         \
    WAIT1(9, b01); MF(acc[0][1], a00, b01);                                                               \
    WAIT1(8, b02); MF(acc[0][2], a00, b02);                                                               \
    WAIT1(7, b03); MF(acc[0][3], a00, b03);                                                               \
    WAIT1(6, a01); MF(acc[1][0], a01, b00); MF(acc[1][1], a01, b01); MF(acc[1][2], a01, b02); MF(acc[1][3], a01, b03); \
    WAIT2(4, a10, b10); MF(acc[0][0], a10, b10);                                                          \
    WAIT1(3, b11); MF(acc[0][1], a10, b11);                                                               \
    WAIT1(2, b12); MF(acc[0][2], a10, b12);                                                               \
    WAIT1(1, b13); MF(acc[0][3], a10, b13);                                                               \
    WAIT1(0, a11); MF(acc[1][0], a11, b10); MF(acc[1][1], a11, b11); MF(acc[1][2], a11, b12); MF(acc[1][3], a11, b13); \
  }
  const unsigned ldsb = (unsigned)(size_t)(__attribute__((address_space(3))) char*)lds;
  const unsigned abase0 = ldsb + lds_off32(wv * 64 + (lane & 31), 0 + (lane >> 5));
  const unsigned abase1 = ldsb + lds_off32(wv * 64 + (lane & 31), 2 + (lane >> 5));
  const unsigned bbase0 = ldsb + 16384 + lds_off32((lane & 31), 0 + (lane >> 5));
  const unsigned bbase1 = ldsb + 16384 + lds_off32((lane & 31), 2 + (lane >> 5));
  const int nsteps = K >> 5;
  vsync();
  BIG_ISSUE(0, 0)
  BIG_ISSUE(32, 24576)
  int cur = 0, nx2 = 49152;
  for (int t = 0; t < nsteps - 2; ++t) {
    asm volatile("s_waitcnt vmcnt(6)" ::: "memory");
    vsync_raw();
    BIG_ISSUE((t + 2) * 32, nx2)
    BIG_COMPUTE(cur)
    cur = (cur == 49152) ? 0 : cur + 24576;
    nx2 = (nx2 == 49152) ? 0 : nx2 + 24576;
  }
  asm volatile("s_waitcnt vmcnt(6)" ::: "memory");
  vsync_raw();
  BIG_COMPUTE(cur)
  cur = (cur == 49152) ? 0 : cur + 24576;
  asm volatile("s_waitcnt vmcnt(0)" ::: "memory");
  vsync_raw();
  BIG_COMPUTE(cur)
#undef BIG_ISSUE
#undef BIG_COMPUTE
#undef DSR
#undef WAIT1
#undef WAIT2
#undef MF
  const int lane2 = opq(lane);
  typedef __attribute__((ext_vector_type(4))) float f32x4;
  vsync();
  float* wl = (float*)lds + wv * (32 * 68);
  const int hh2 = lane2 >> 5, cl = lane2 & 31;
#pragma unroll
  for (int i = 0; i < 2; ++i)
#pragma unroll
    for (int jh = 0; jh < 2; ++jh) {
#pragma unroll
      for (int j = 0; j < 2; ++j)
#pragma unroll
        for (int r = 0; r < 16; ++r) wl[((r & 3) + 8 * (r >> 2) + 4 * hh2) * 68 + j * 32 + cl] = acc[i][jh * 2 + j][r];
      __builtin_amdgcn_wave_barrier();
#pragma unroll
      for (int k = 0; k < 4; ++k) {
        const int row = (lane2 >> 3) + 8 * k, c8 = (lane2 & 7) * 8;
        const f32x4 lo = *(const f32x4*)&wl[row * 68 + c8];
        const f32x4 hi = *(const f32x4*)&wl[row * 68 + c8 + 4];
        epi(wv * 64 + i * 32 + row, jh * 64 + c8, lo, hi);
      }
      __builtin_amdgcn_wave_barrier();
    }
}

template <class Epi>
__device__ __forceinline__ void ph_gemm_big(const bf16_t* A, int lda, const bf16_t* Wt, int ldw, int M, int N, int K,
                                            char* lds, Epi epi) {
  const int ntm = M / 256, ntn = N / 128;
  const int npm = (ntm + 7) / 8, npn = (ntn + 7) / 8;
  const int nslots = ((npm * npn * 64 + 511) / 512) * 512;
  for (int u = VB(); u < nslots; u += VG()) {
    int v = (u & 7) * 64 + ((u >> 3) & 63) + (u & ~511);
    int patch = v >> 6, w = v & 63;
    int tm = (patch % npm) * 8 + (w & 7);
    int tn = (patch / npm) * 8 + (w >> 3);
    if (tm >= ntm || tn >= ntn) continue;
    const int m0 = tm * 256, n0 = tn * 128;
    gemm_tile_big(A + (size_t)m0 * lda, lda, Wt + (size_t)n0 * ldw, ldw, K, lds,
                  [&](int r, int c, f32x4_e lo, f32x4_e hi) { epi(m0 + r, n0 + c, lo, hi); });
  }
}

template <int PM = 0, class Epi>
__device__ __forceinline__ void gemm_tile_huge(const bf16_t* xp, int ldx, const bf16_t* yp, int ldy, int K, char* lds0,
                                               Epi epi) {
  const int tid = opq(threadIdx.x), lane = tid & 63, wv = tid >> 6;
  const int wr = wv >> 2, wc = wv & 3;
  f32x16 acc[4][2];
#pragma unroll
  for (int i = 0; i < 4; ++i)
#pragma unroll
    for (int j = 0; j < 2; ++j)
#pragma unroll
      for (int r = 0; r < 16; ++r) acc[i][j][r] = 0.f;
  const int prow = lane >> 3, pch = lane & 7;
  const bf16_t* xs[4];
  const bf16_t* ys[4];
#pragma unroll
  for (int ps = 0; ps < 4; ++ps) {
    const int row = (wv * 4 + ps) * 8 + prow;
    const int c = pch ^ ((row >> 1) & 7);
    xs[ps] = xp + (size_t)row * ldx + c * 8;
    ys[ps] = yp + (size_t)row * ldy + c * 8;
  }
  char* const xdst = lds0 + wv * 4096 + lane * 16;
#define HUGE_ISSUE(k0, st)                                                                                                          \
  _Pragma("unroll") for (int ps = 0; ps < 4; ++ps) {                                                                                \
    __builtin_amdgcn_global_load_lds((const unsigned*)(xs[ps] + (k0)), (unsigned*)(xdst + (st) + ps * 1024), 16, 0, 0);             \
    __builtin_amdgcn_global_load_lds((const unsigned*)(ys[ps] + (k0)), (unsigned*)(xdst + (st) + 32768 + ps * 1024), 16, 0, 0);     \
  }
#define HDSR(dst, addr, off) asm volatile("ds_read_b128 %0, %1 offset:%2" : "=v"(dst) : "v"(addr), "i"(off) : "memory")
#define HREAD(S, ab, bb)                                                                            \
  HDSR(S##a0, ab, 0); HDSR(S##b0, bb, 0); HDSR(S##b1, bb, 4096); HDSR(S##a1, ab, 4096);             \
  HDSR(S##a2, ab, 8192); HDSR(S##a3, ab, 12288);
#define HWAIT(n, S)                                                                                 \
  asm volatile("s_waitcnt lgkmcnt(" #n ")" : "+v"(S##a0), "+v"(S##a1), "+v"(S##a2), "+v"(S##a3), "+v"(S##b0), "+v"(S##b1))
#define HMF(i, j, S) acc[i][j] = __builtin_amdgcn_mfma_f32_32x32x16_bf16(S##a##i, S##b##j, acc[i][j], 0, 0, 0)
#define HMMA(S) HMF(0, 0, S); HMF(0, 1, S); HMF(1, 0, S); HMF(1, 1, S); HMF(2, 0, S); HMF(2, 1, S); HMF(3, 0, S); HMF(3, 1, S);
  const unsigned ldsb = (unsigned)(size_t)(LAS char*)lds0;
  const int frow = lane & 31, fh = lane >> 5;
  const unsigned ab0 = ldsb + lds_off(wr * 128 + frow, 0 + fh), ab1 = ldsb + lds_off(wr * 128 + frow, 2 + fh);
  const unsigned ab2 = ldsb + lds_off(wr * 128 + frow, 4 + fh), ab3 = ldsb + lds_off(wr * 128 + frow, 6 + fh);
  const unsigned bb0 = ldsb + 32768 + lds_off(wc * 64 + frow, 0 + fh), bb1 = ldsb + 32768 + lds_off(wc * 64 + frow, 2 + fh);
  const unsigned bb2 = ldsb + 32768 + lds_off(wc * 64 + frow, 4 + fh), bb3 = ldsb + 32768 + lds_off(wc * 64 + frow, 6 + fh);
  __syncthreads();
  HUGE_ISSUE(0, 0)
  bf16x8 Ea0, Ea1, Ea2, Ea3, Eb0, Eb1, Oa0, Oa1, Oa2, Oa3, Ob0, Ob1;
  asm volatile("s_waitcnt vmcnt(0)" ::: "memory");
  __syncthreads();
  if (64 < K) { HUGE_ISSUE(64, 65536u) }
  HREAD(E, ab0, bb0)
  HREAD(O, ab1, bb1)
  HWAIT(6, E); HMMA(E)
  HREAD(E, ab2, bb2)
  HWAIT(6, O); HMMA(O)
  HREAD(O, ab3, bb3)
  HWAIT(6, E); HMMA(E)
  HWAIT(0, O);
  unsigned st = 65536u;
  for (int k0 = 64; k0 < K; k0 += 64) {
    asm volatile("s_waitcnt vmcnt(0)" ::: "memory");
    __syncthreads();
    const unsigned a0 = ab0 + st, a1 = ab1 + st, a2 = ab2 + st, a3 = ab3 + st;
    const unsigned b0 = bb0 + st, b1 = bb1 + st, b2 = bb2 + st, b3 = bb3 + st;
    HREAD(E, a0, b0)
    HWAIT(6, O); HMMA(O)
    if (k0 + 64 < K) { HUGE_ISSUE(k0 + 64, st ^ 65536u) }
    HREAD(O, a1, b1)
    HWAIT(6, E); HMMA(E)
    HREAD(E, a2, b2)
    HWAIT(6, O); HMMA(O)
    HREAD(O, a3, b3)
    HWAIT(6, E); HMMA(E)
    HWAIT(0, O);
    st ^= 65536u;
  }
  HMMA(O)
#undef HUGE_ISSUE
#undef HDSR
#undef HREAD
#undef HWAIT
#undef HMF
#undef HMMA
  const int lane2 = opq(lane);
  typedef __attribute__((ext_vector_type(4))) float f32x4;
  __syncthreads();
  float* wl = (float*)lds0 + wv * (32 * 68);
  const int hh2 = lane2 >> 5, cl = lane2 & 31;
#pragma unroll
  for (int i = 0; i < 4; ++i) {
#pragma unroll
    for (int j = 0; j < 2; ++j)
#pragma unroll
      for (int r = 0; r < 16; ++r) wl[((r & 3) + 8 * (r >> 2) + 4 * hh2) * 68 + j * 32 + cl] = acc[i][j][r];
    __builtin_amdgcn_wave_barrier();
#pragma unroll
    for (int k = 0; k < 4; ++k) {
      const int row = (lane2 >> 3) + 8 * k, c8 = (lane2 & 7) * 8;
      const f32x4 lo = *(const f32x4*)&wl[row * 68 + c8];
      const f32x4 hi = *(const f32x4*)&wl[row * 68 + c8 + 4];
      if (PM != 3) epi(wr * 128 + i * 32 + row, wc * 64 + c8, lo, hi);
    }
    __builtin_amdgcn_wave_barrier();
  }
  __syncthreads();
}

template <class Epi>
__device__ __forceinline__ void ph_gemm_huge(const bf16_t* A, int lda, const bf16_t* Wt, int ldw, int M, int N, int K,
                                             char* lds0, Epi epi) {
  const int ntm = M / 256, ntn = N / 256;
  for (int u = (int)blockIdx.x; u < ntm * ntn; u += (int)gridDim.x) {
    const int x = u & 7, i = (u >> 3) & 31, rnd = u >> 8;
    const int tm = (x & 3) * 8 + (i & 7), tn = rnd * 8 + (x >> 2) * 4 + (i >> 3);
    if (tm >= ntm || tn >= ntn) continue;
    const int m0 = tm * 256, n0 = tn * 256;
    gemm_tile_huge(A + (size_t)m0 * lda, lda, Wt + (size_t)n0 * ldw, ldw, K, lds0,
                   [&](int r, int c, f32x4_e lo, f32x4_e hi) { epi(m0 + r, n0 + c, lo, hi); });
  }
}

__device__ __forceinline__ void norm_feed(const f32x4_e h0, const f32x4_e h1, const float* gain, int n, bf16_t* hn_row,
                                          float* rowss_m) {
  const f32x4_e g0 = *(const f32x4_e*)(gain + n), g1 = *(const f32x4_e*)(gain + n + 4);
  st_bf16x8(hn_row + n, h0 * g0, h1 * g1);
  float ss = h0[0] * h0[0] + h0[1] * h0[1] + h0[2] * h0[2] + h0[3] * h0[3] + h1[0] * h1[0] + h1[1] * h1[1] + h1[2] * h1[2] + h1[3] * h1[3];
  ss += __shfl_xor(ss, 1);
  ss += __shfl_xor(ss, 2);
  ss += __shfl_xor(ss, 4);
  if (((VT()) & 7) == 0) atomicAdd(rowss_m, ss);
}

__device__ __forceinline__ void resid_feed(const f32x4_e h0, const f32x4_e h1, int n, bf16_t* hb_row, float* rowss_m) {
  st_bf16x8(hb_row + n, h0, h1);
  float ss = h0[0] * h0[0] + h0[1] * h0[1] + h0[2] * h0[2] + h0[3] * h0[3] + h1[0] * h1[0] + h1[1] * h1[1] + h1[2] * h1[2] + h1[3] * h1[3];
  ss += __shfl_xor(ss, 1);
  ss += __shfl_xor(ss, 2);
  ss += __shfl_xor(ss, 4);
  if (((VT()) & 7) == 0) atomicAdd(rowss_m, ss);
}

template <bool VEC = false, class Epi>
__device__ __forceinline__ void ph_gemm_bf16(const bf16_t* A, int lda, const bf16_t* Wt, int ldw, int M, int N, int K,
                                             char* lds, Epi epi, int vblock = -2) {
  const int ntm = M / 128, ntn = N / 128;
  const int npm = (ntm + 7) / 8, npn = (ntn + 7) / 8;
  const int nslots = ((npm * npn * 64 + 511) / 512) * 512;
  if (vblock == -1) return;
  for (int u = (vblock >= 0 ? vblock : VB()); u < nslots; u += VG()) {
    int v = (u & 7) * 64 + ((u >> 3) & 63) + (u & ~511);
    int patch = v >> 6, w = v & 63;
    int tm = (patch % npm) * 8 + (w & 7);
    int tn = (patch / npm) * 8 + (w >> 3);
    if (tm >= ntm || tn >= ntn) continue;
    const int m0 = tm * 128, n0 = tn * 128;
    if constexpr (VEC)
      gemm_tile_bf16<false, true>(A + (size_t)m0 * lda, lda, Wt + (size_t)n0 * ldw, ldw, K, lds,
                                  [&](int r, int c, f32x4_e lo, f32x4_e hi) { epi(m0 + r, n0 + c, lo, hi); });
    else
      gemm_tile_bf16<false>(A + (size_t)m0 * lda, lda, Wt + (size_t)n0 * ldw, ldw, K, lds,
                            [&](int r, int c, float val) { epi(m0 + r, n0 + c, val); });
  }
}

__device__ __forceinline__ void ph_proj(const P& p, char* lds0, char* lds) {
  for (int u = (int)blockIdx.x; u < 512; u += (int)gridDim.x) {
    const int x = u & 7, i = (u >> 3) & 31, rnd = u >> 8;
    const int tm = (x & 3) * 8 + (i & 7), tp = rnd * 8 + (x >> 2) * 4 + (i >> 3);
    const int tb = tp * 2;
    const int tn = (tb < 14) ? tb : (tb < 16) ? tb + 2 : tb + 4;
    const int m0 = tm * 256, n0 = tn * 128;
    const int b = m0 >> 11, sl = m0 & 2047;
    const bf16_t* A = p.hn + (size_t)m0 * DM;
    const bf16_t* W = p.WinT + (size_t)n0 * DM;
    if (n0 < 1024 || (n0 >= 2560 && n0 < 3584)) {
      bf16_t* dst = (n0 < 1024) ? p.qn + (size_t)m0 * 1024 + n0 : p.qsb + (size_t)m0 * 1024 + (n0 - 2560);
      gemm_tile_huge(A, DM, W, DM, DM, lds0, [&](int r, int c, f32x4_e lo, f32x4_e hi) { st_bf16x8(dst + (size_t)r * 1024 + c, lo, hi); });
    } else if (n0 < 2560) {
      const int seg = (n0 - 1024) >> 8;
      bf16_t* base = (seg == 0) ? p.kcin : (seg == 1) ? p.vcin : (seg == 2) ? p.ks : p.kw;
      bf16_t* dst = base + ((size_t)(b * 2) * SEQ + sl) * 128;
      gemm_tile_huge(A, DM, W, DM, DM, lds0, [&](int r, int c, f32x4_e lo, f32x4_e hi) {
        st_bf16x8(dst + ((size_t)(c >> 7) * SEQ + r) * 128 + (c & 127), lo, hi); });
    } else {
      bf16_t* dst = p.ksb + ((size_t)(b * 8 + ((n0 - 3584) >> 7)) * SEQ + sl) * 128;
      gemm_tile_huge(A, DM, W, DM, DM, lds0, [&](int r, int c, f32x4_e lo, f32x4_e hi) {
        st_bf16x8(dst + ((size_t)(c >> 7) * SEQ + r) * 128 + (c & 127), lo, hi); });
    }
  }
  for (int u = (int)blockIdx.x; u < 192; u += (int)gridDim.x) {
    const int tm = u & 31, tv = u >> 5;
    const int n0 = (tv == 0) ? 1792 : (tv == 1) ? 2304 : 4608 + (tv - 2) * 256;
    const int m0 = tm * 256;
    const int b = m0 >> 11, sl = m0 & 2047;
    bf16_t* vd;
    if (tv < 2) vd = (tv == 0 ? p.vsT : p.vwT) + ((size_t)(b * 2) * 128) * SEQ + sl;
    else vd = p.vsbT + ((size_t)(b * 8 + (tv - 2) * 2) * 128) * SEQ + sl;
    gemm_tile_huge(p.WinT + (size_t)n0 * DM, DM, p.hn + (size_t)m0 * DM, DM, DM, lds0,
                   [&](int r, int c, f32x4_e lo, f32x4_e hi) {
                     bf16_t* row = vd + (size_t)r * SEQ;
                     uint2 wa, wb;
                     wa.x = pack2(lo[0], lo[1]); wa.y = pack2(lo[2], lo[3]);
                     wb.x = pack2(hi[0], hi[1]); wb.y = pack2(hi[2], hi[3]);
                     const int pa = (c & 8) ? c - 4 : c, pb = (c & 8) ? c + 4 : c + 8;
                     *(uint2*)(row + pa) = wa;
                     *(uint2*)(row + pb) = wb; });
  }
  {
    const int vb = VB();
    if (VG() != 512 || vb >= 448) {
      for (int tm = (VG() == 512) ? vb - 448 : vb; tm < 64; tm += (VG() == 512) ? 64 : VG()) {
        const int m0 = tm * 128;
        float* gd = p.gates + (size_t)m0 * 24;
        gemm_tile_bf16<false>(p.hn + (size_t)m0 * DM, DM, p.WinT + (size_t)5632 * DM, DM, DM, lds,
                              [&](int r, int c, float val) { if (c < 24) gd[(size_t)r * 24 + c] = val; });
      }
    }
  }
}

__device__ __forceinline__ void ph_posb(const P& p) {
  const int lane = VT() & 63, wv = VT() >> 6;
  for (int o = VB() * 4 + wv; o < 256; o += VG() * 4) {
    const int which = o >> 7, n = o & 127;
    const float* pos = which ? p.pos_v : p.pos_k;
    const float* w1 = which ? p.w1_v : p.w1_k;
    float acc = 0.f;
    for (int k = lane; k < 4096; k += 64) acc += pos[k] * w1[(size_t)k * 128 + n];
    acc = wave_sum(acc);
    if (lane == 0) p.posb[o] = acc;
  }
}

__device__ __forceinline__ void ph_compress2(const P& p, char* lds) {
  for (int item = VB(); item < 16; item += VG()) {
    const int which = item >> 3, bg = item & 7;
    const bf16_t* src = (which ? p.vcin : p.kcin) + (size_t)bg * SEQ * 128;
    const bf16_t* w1t = p.w1T + (size_t)which * 128 * 4096;
    const bf16_t* w2t = p.w2T + (size_t)which * 128 * 128;
    const float* posb = p.posb + which * 128;
    bf16_t* c1 = p.c1 + (size_t)item * 128 * 128;
    gemm_tile_bf16<false>(src, 2048, w1t, 4096, 4096, lds, [&](int r, int c, float val) {
      c1[r * 128 + c] = f2bf(gelu_fast(val + posb[c])); });
    __threadfence_block();
    vsync();
    if (which == 0) {
      bf16_t* kd = p.kcb + (size_t)bg * 128 * 128;
      gemm_tile_bf16<false>(c1, 128, w2t, 128, 128, lds, [&](int r, int c, float val) { kd[r * 128 + c] = f2bf(val); });
    } else {
      bf16_t* vd = p.vcT + (size_t)bg * 128 * 128;
      gemm_tile_bf16<true>(c1, 128, w2t, 128, 128, lds, [&](int r, int c, float val) { vd[r * 128 + perm16(c)] = f2bf(val); });
    }
  }
}

#define NEG_BIG (-1e30f)

struct KVRegs { u32x4 k0, k1, k2, k3, v0, v1, v2, v3; };

__device__ __forceinline__ int koff(int row, int chunk) { return row * 256 + ((chunk ^ (row & 15)) << 4); }

__device__ __forceinline__ void kv_load(KVRegs& r, const bf16_t* kp, int ldk, const bf16_t* vp, int ldv) {
  const int tid = VT();
  const bf16_t* kg = kp + (size_t)(tid >> 4) * ldk + (tid & 15) * 8;
  r.k0 = *(const u32x4*)kg;
  r.k1 = *(const u32x4*)(kg + (size_t)16 * ldk);
  r.k2 = *(const u32x4*)(kg + (size_t)32 * ldk);
  r.k3 = *(const u32x4*)(kg + (size_t)48 * ldk);
  const bf16_t* vg = vp + (size_t)(tid >> 3) * ldv + (tid & 7) * 8;
  r.v0 = *(const u32x4*)vg;
  r.v1 = *(const u32x4*)(vg + (size_t)32 * ldv);
  r.v2 = *(const u32x4*)(vg + (size_t)64 * ldv);
  r.v3 = *(const u32x4*)(vg + (size_t)96 * ldv);
}
__device__ __forceinline__ void kv_store(const KVRegs& r, char* lk, char* lv) {
  const int tid = VT();
  const int row = tid >> 4, ch = tid & 15;
  *(u32x4*)(lk + koff(row, ch)) = r.k0;
  *(u32x4*)(lk + koff(row + 16, ch)) = r.k1;
  *(u32x4*)(lk + koff(row + 32, ch)) = r.k2;
  *(u32x4*)(lk + koff(row + 48, ch)) = r.k3;
  const int vr = tid >> 3, vc = tid & 7;
  *(u32x4*)(lv + lds_off(vr, vc)) = r.v0;
  *(u32x4*)(lv + lds_off(vr + 32, vc)) = r.v1;
  *(u32x4*)(lv + lds_off(vr + 64, vc)) = r.v2;
  *(u32x4*)(lv + lds_off(vr + 96, vc)) = r.v3;
}

struct QFrag { bf16x8 f0, f1, f2, f3, f4, f5, f6, f7; };
__device__ __forceinline__ void q_load(QFrag& q, const bf16_t* qrow) {
  const int h = (VT() & 63) >> 5;
  const bf16x8* p8 = (const bf16x8*)(qrow + 8 * h);
  q.f0 = p8[0]; q.f1 = p8[2]; q.f2 = p8[4]; q.f3 = p8[6]; q.f4 = p8[8]; q.f5 = p8[10]; q.f6 = p8[12]; q.f7 = p8[14];
}

__device__ __forceinline__ void qk_tile(const QFrag& q, const char* lk, f32x16& s0, f32x16& s1) {
  const int lane = VT() & 63, row = lane & 31, h = lane >> 5;
#pragma unroll
  for (int r = 0; r < 16; ++r) { s0[r] = 0.f; s1[r] = 0.f; }
#define QK_STEP(kk, qf)                                                                  \
  {                                                                                      \
    bf16x8 a0 = *(const bf16x8*)(lk + koff(row, 2 * (kk) + h));                          \
    bf16x8 a1 = *(const bf16x8*)(lk + koff(row + 32, 2 * (kk) + h));                     \
    s0 = __builtin_amdgcn_mfma_f32_32x32x16_bf16(a0, qf, s0, 0, 0, 0);                   \
    s1 = __builtin_amdgcn_mfma_f32_32x32x16_bf16(a1, qf, s1, 0, 0, 0);                   \
  }
  QK_STEP(0, q.f0) QK_STEP(1, q.f1) QK_STEP(2, q.f2) QK_STEP(3, q.f3)
  QK_STEP(4, q.f4) QK_STEP(5, q.f5) QK_STEP(6, q.f6) QK_STEP(7, q.f7)
#undef QK_STEP
}

__device__ __forceinline__ bf16x8 pack8(const f32x16& p, const int base) {
  u32x4 u;
  u[0] = pack2(p[base + 0], p[base + 1]);
  u[1] = pack2(p[base + 2], p[base + 3]);
  u[2] = pack2(p[base + 4], p[base + 5]);
  u[3] = pack2(p[base + 6], p[base + 7]);
  return __builtin_bit_cast(bf16x8, u);
}

typedef __attribute__((ext_vector_type(2))) unsigned u32x2_t;
__device__ __forceinline__ float xhalf_max(float v) {
  const u32x2_t r = __builtin_amdgcn_permlane32_swap(__float_as_uint(v), __float_as_uint(v), false, false);
  return fmaxf(__uint_as_float(r[0]), __uint_as_float(r[1]));
}
__device__ __forceinline__ float xhalf_sum(float v) {
  const u32x2_t r = __builtin_amdgcn_permlane32_swap(__float_as_uint(v), __float_as_uint(v), false, false);
  return __uint_as_float(r[0]) + __uint_as_float(r[1]);
}
__device__ __forceinline__ float xhalf_get(float v, int hh) {
  const u32x2_t r = __builtin_amdgcn_permlane32_swap(__float_as_uint(v), __float_as_uint(v), false, false);
  return hh ? __uint_as_float(r[0]) : __uint_as_float(r[1]);
}
struct OAcc { f32x16 o0, o1, o2, o3; };
__device__ __forceinline__ void oacc_zero(OAcc& o) {
#pragma unroll
  for (int r = 0; r < 16; ++r) { o.o0[r] = 0.f; o.o1[r] = 0.f; o.o2[r] = 0.f; o.o3[r] = 0.f; }
}
__device__ __forceinline__ void oacc_scale(OAcc& o, float a) {
#pragma unroll
  for (int r = 0; r < 16; ++r) { o.o0[r] *= a; o.o1[r] *= a; o.o2[r] *= a; o.o3[r] *= a; }
}

__device__ __forceinline__ void pv_tile(OAcc& o, const char* lv, const f32x16& p0, const f32x16& p1) {
  const int lane = VT() & 63, row = lane & 31, h = lane >> 5;
  const bf16x8 pf0 = pack8(p0, 0), pf1 = pack8(p0, 8), pf2 = pack8(p1, 0), pf3 = pack8(p1, 8);
#define PV_ROW(dd, acc)                                                                                      \
  {                                                                                                          \
    acc = __builtin_amdgcn_mfma_f32_32x32x16_bf16(*(const bf16x8*)(lv + lds_off(32 * (dd) + row, 0 + h)), pf0, acc, 0, 0, 0); \
    acc = __builtin_amdgcn_mfma_f32_32x32x16_bf16(*(const bf16x8*)(lv + lds_off(32 * (dd) + row, 2 + h)), pf1, acc, 0, 0, 0); \
    acc = __builtin_amdgcn_mfma_f32_32x32x16_bf16(*(const bf16x8*)(lv + lds_off(32 * (dd) + row, 4 + h)), pf2, acc, 0, 0, 0); \
    acc = __builtin_amdgcn_mfma_f32_32x32x16_bf16(*(const bf16x8*)(lv + lds_off(32 * (dd) + row, 6 + h)), pf3, acc, 0, 0, 0); \
  }
  PV_ROW(0, o.o0) PV_ROW(1, o.o1) PV_ROW(2, o.o2) PV_ROW(3, o.o3)
#undef PV_ROW
}

typedef __attribute__((ext_vector_type(2))) float f32x2_s;
#define SPAIR(v, i) __builtin_shufflevector(v, v, (i), (i) + 1)
__device__ __forceinline__ void softmax_tile(f32x16& s0, f32x16& s1, float& m, float& l, OAcc& o, const float sc = 1.f,
                                             const float bb = 0.f) {
  float mr = -INFINITY;
#pragma unroll
  for (int r = 0; r < 16; ++r) mr = fmaxf(mr, fmaxf(s0[r], s1[r]));
  float mx = fmaf(mr, sc, bb);
  mx = (mx != mx) ? -INFINITY : mx;
  mx = xhalf_max(fmaxf(mx, NEG_BIG));
  const float mn = fmaxf(m, mx);
  const float alpha = __builtin_amdgcn_exp2f(m - mn);
  const f32x2_s sc2 = {sc, sc}, c2 = {bb - mn, bb - mn};
  f32x2_s ls2 = {0.f, 0.f};
#pragma unroll
  for (int r = 0; r < 16; r += 2) {
    const f32x2_s pa_in = {s0[r], s0[r + 1]}, pb_in = {s1[r], s1[r + 1]};
    const f32x2_s a = __builtin_elementwise_fma(pa_in, sc2, c2);
    const f32x2_s b = __builtin_elementwise_fma(pb_in, sc2, c2);
    const float a0 = __builtin_amdgcn_exp2f(a[0]), a1 = __builtin_amdgcn_exp2f(a[1]);
    const float b0 = __builtin_amdgcn_exp2f(b[0]), b1 = __builtin_amdgcn_exp2f(b[1]);
    s0[r] = a0; s0[r + 1] = a1; s1[r] = b0; s1[r + 1] = b1;
    const f32x2_s pa = {a0, a1}, pb = {b0, b1};
    ls2 = ls2 + pa + pb;
  }
  const float ls = xhalf_sum(ls2[0] + ls2[1]);
  l = l * alpha + ls;
  m = mn;
  if (__any(alpha != 1.f)) oacc_scale(o, alpha);
}

template <class F>
__device__ __forceinline__ void oacc_foreach(const OAcc& o, F f) {
  const int h = (VT() & 63) >> 5;
#pragma unroll
  for (int rho = 0; rho < 4; ++rho) {
    f(0 + 8 * rho + 4 * h, o.o0[4 * rho], o.o0[4 * rho + 1], o.o0[4 * rho + 2], o.o0[4 * rho + 3]);
    f(32 + 8 * rho + 4 * h, o.o1[4 * rho], o.o1[4 * rho + 1], o.o1[4 * rho + 2], o.o1[4 * rho + 3]);
    f(64 + 8 * rho + 4 * h, o.o2[4 * rho], o.o2[4 * rho + 1], o.o2[4 * rho + 2], o.o2[4 * rho + 3]);
    f(96 + 8 * rho + 4 * h, o.o3[4 * rho], o.o3[4 * rho + 1], o.o3[4 * rho + 2], o.o3[4 * rho + 3]);
  }
}

__device__ __forceinline__ void memattn_item(const P& p, char* lds, int item) {
  char* lk = lds;
  char* lv = lds + 16384;
  const int lane = VT() & 63, wv = VT() >> 6;
  {
    const int tb = item % (SEQ / 128);
    const int bh = item / (SEQ / 128);
    const int b = bh >> 2, hd = bh & 3;
    const int t = tb * 128 + wv * 32 + (lane & 31);
    QFrag q;
    q_load(q, p.qmemb + (size_t)(b * SEQ + t) * 512 + hd * 128);
    const bf16_t* kb = p.kmemb + (size_t)bh * 256 * 128;
    const bf16_t* vb = p.vmemT + (size_t)bh * 128 * 256;
    OAcc o;
    oacc_zero(o);
    float m = NEG_BIG, l = 0.f;
    KVRegs kv;
    kv_load(kv, kb, 128, vb, 256);
#pragma unroll 1
    for (int ti = 0; ti < 4; ++ti) {
      vsync();
      kv_store(kv, lk, lv);
      vsync();
      {
        const int tn = (ti + 1 < 4) ? ti + 1 : 3;
        kv_load(kv, kb + (size_t)tn * 64 * 128, 128, vb + tn * 64, 256);
      }
      f32x16 s0, s1;
      qk_tile(q, lk, s0, s1);
      softmax_tile(s0, s1, m, l, o, ATT_SCALE2, 0.f);
      pv_tile(o, lv, s0, s1);
    }
    const float il = 1.f / l;
    const int t2 = tb * 128 + (VT() >> 6) * 32 + (VT() & 31);
    bf16_t* orow = p.omem + (size_t)(b * SEQ + t2) * 512 + hd * 128;
    oacc_foreach(o, [&](int d, float v0, float v1, float v2, float v3) {
      uint2 u;
      u.x = pack2(v0 * il, v1 * il);
      u.y = pack2(v2 * il, v3 * il);
      *(uint2*)(orow + d) = u;
    });
  }
}

__device__ __forceinline__ void ph_memq_attn(const P& p, char* lds, int vblock, int nvb) {
  if (vblock < 0) return;
  const float* rss = p.rowss;
  for (int u = vblock; u < 64 * 4; u += nvb) {
    const int tm = u & 63, hd = u >> 6;
    const int m0 = tm * 128;
    bf16_t* qd = p.qmemb + (size_t)m0 * 512 + hd * 128;
    gemm_tile_bf16<false, true>(p.hn + (size_t)m0 * DM, DM, p.WmqT + (size_t)hd * 128 * DM, DM, DM, lds,
                                [&](int r, int c, f32x4_e lo, f32x4_e hi) {
                                  const float rs = rsqrtf(rss[m0 + r] * (1.f / DM) + RMS_EPS);
                                  st_bf16x8(qd + (size_t)r * 512 + c, lo * rs, hi * rs); });
    __threadfence_block();
    vsync();
    memattn_item(p, lds, ((m0 >> 11) * 4 + hd) * (SEQ / 128) + ((m0 & 2047) >> 7));
  }
}

template <bool CHK>
__device__ __forceinline__ void sb_pass1(f32x16& z, f32x16& l, const int s_first, const int t) {
  const f32x2_s sc2 = {ATT_SCALE2, ATT_SCALE2}, one2 = {1.f, 1.f};
#pragma unroll
  for (int r = 0; r < 16; r += 2) {
    const f32x2_s zin = {z[r], z[r + 1]};
    const f32x2_s zz = zin * sc2;
    const f32x2_s ee = {__builtin_amdgcn_exp2f(-fabsf(zz[0])), __builtin_amdgcn_exp2f(-fabsf(zz[1]))};
    const f32x2_s tt = ee + one2;
    const f32x2_s lg = {__builtin_amdgcn_logf(tt[0]), __builtin_amdgcn_logf(tt[1])};
    const f32x2_s mn = {fminf(zz[0], 0.f), fminf(zz[1], 0.f)};
    const f32x2_s lf = (mn - lg) - zz;
    if (CHK) {
      const int so = s_first + 8 * (r >> 2) + (r & 3);
      const bool v0 = so < t, v1 = so + 1 < t;
      l[r] = v0 ? lf[0] : 0.f; l[r + 1] = v1 ? lf[1] : 0.f;
      z[r] = v0 ? zz[0] : NEG_BIG; z[r + 1] = v1 ? zz[1] : NEG_BIG;
    } else {
      l[r] = lf[0]; l[r + 1] = lf[1];
      z[r] = zz[0]; z[r + 1] = zz[1];
    }
  }
}
__device__ __forceinline__ void sb_pass3(f32x16& z, const f32x16& l, const float* ag) {
#pragma unroll
  for (int rho = 0; rho < 4; ++rho) {
    const float x3 = l[4 * rho + 3], x23 = x3 + l[4 * rho + 2], x123 = x23 + l[4 * rho + 1];
    const float g = ag[rho];
    const f32x2_s g2 = {g, g};
    const f32x2_s la = {l[4 * rho + 0], l[4 * rho + 1]}, lb = {l[4 * rho + 2], l[4 * rho + 3]};
    const f32x2_s za = {z[4 * rho + 0], z[4 * rho + 1]}, zb = {z[4 * rho + 2], z[4 * rho + 3]};
    const f32x2_s xa = {x123, x23}, xb = {x3, 0.f};
    const f32x2_s aa = (la + za) + (g2 + xa), ab = (lb + zb) + (g2 + xb);
    z[4 * rho + 0] = __builtin_amdgcn_exp2f(aa[0]); z[4 * rho + 1] = __builtin_amdgcn_exp2f(aa[1]);
    z[4 * rho + 2] = __builtin_amdgcn_exp2f(ab[0]); z[4 * rho + 3] = __builtin_amdgcn_exp2f(ab[1]);
  }
}

__device__ __forceinline__ void ph_sb2(const P& p, char* lds) {
  char* lk = lds;
  char* lv = lds + 16384;
  const int lane = VT() & 63, wv = VT() >> 6, hh = lane >> 5;
  const int sb_skip = (VG() > 32) ? 16 : 0;
  if (VB() < sb_skip) return;
  for (int item = VB() - sb_skip; item < NBATCH * 8 * (SEQ / 128); item += VG() - sb_skip) {
    const int tb = (SEQ / 128 - 1) - (item % (SEQ / 128));
    const int bh = item / (SEQ / 128);
    const int b = bh >> 3, hd = bh & 7;
    const int t0 = tb * 128;
    const int t = t0 + wv * 32 + (lane & 31);
    QFrag q;
    q_load(q, p.qsb + (size_t)(b * SEQ + t) * 1024 + hd * 128);
    const bf16_t* kb = p.ksb + (size_t)bh * SEQ * 128;
    const bf16_t* vb = p.vsbT + (size_t)bh * 128 * SEQ;
    OAcc o;
    oacc_zero(o);
    float carry = 0.f;
    const int jhi = (t0 >> 6) + 1;
    const int jw = (t0 + wv * 32 + 30) >> 6;
    KVRegs kv;
    kv_load(kv, kb + (size_t)jhi * 64 * 128, 128, vb + jhi * 64, SEQ);
    volatile unsigned* dflag = (volatile unsigned*)(lds + 32768);
    vsync();
    if (VT() < 4) dflag[VT()] = 0u;
    for (int j = jhi; j >= 0; --j) {
      vsync();
      if ((dflag[0] & dflag[1] & dflag[2] & dflag[3]) != 0u) break;
      kv_store(kv, lk, lv);
      vsync();
      const int jn = (j > 0) ? j - 1 : 0;
      if (j > jw) kv_load(kv, kb + (size_t)jn * 64 * 128, 128, vb + jn * 64, SEQ);
      if (j <= jw) {
        f32x16 z0, z1;
        qk_tile(q, lk, z0, z1);
        const int sbase = j * 64 + 4 * hh;
        float gt[8];
        f32x16 l0, l1;
        if (j * 64 + 63 < t0 + wv * 32) {
          sb_pass1<false>(z0, l0, sbase, t);
          sb_pass1<false>(z1, l1, sbase + 32, t);
        } else {
          sb_pass1<true>(z0, l0, sbase, t);
          sb_pass1<true>(z1, l1, sbase + 32, t);
        }
#pragma unroll
        for (int rho = 0; rho < 4; ++rho) {
          gt[rho] = (l0[4 * rho] + l0[4 * rho + 1]) + (l0[4 * rho + 2] + l0[4 * rho + 3]);
          gt[4 + rho] = (l1[4 * rho] + l1[4 * rho + 1]) + (l1[4 * rho + 2] + l1[4 * rho + 3]);
        }
        float ag[8];
        float run = 0.f;
#pragma unroll
        for (int k = 7; k >= 0; --k) {
          const float pg = xhalf_get(gt[k], hh);
          ag[k] = carry + run + (hh == 0 ? pg : 0.f);
          run += gt[k] + pg;
        }
        carry += run;
        sb_pass3(z0, l0, ag);
        sb_pass3(z1, l1, ag + 4);
        kv_load(kv, kb + (size_t)jn * 64 * 128, 128, vb + jn * 64, SEQ);
        pv_tile(o, lv, z0, z1);
        if (__all(carry < -104.f * LOG2E) && (VT() & 63) == 0) dflag[wv] = 1u;
      }
    }
    int t2 = t;
    asm volatile("" : "+v"(t2));
    bf16_t* orow = p.omix + (size_t)(b * SEQ + t2) * DM + 1024 + hd * 128;
    oacc_foreach(o, [&](int d, float v0, float v1, float v2, float v3) {
      uint2 u;
      u.x = pack2(v0, v1);
      u.y = pack2(v2, v3);
      *(uint2*)(orow + d) = u;
    });
  }
}

#define NSA_IMP 32768
#define NSA_KEYS 49152
#define NSA_SELM 53504
#define NSA_LUT 53632
__device__ __forceinline__ void ph_nsa2(const P& p, char* lds) {
  typedef __attribute__((ext_vector_type(4))) float f32x4;
  char* lk = lds;
  char* lv = lds + 16384;
  float* imp = (float*)(lds + NSA_IMP);
  float* keys = (float*)(lds + NSA_KEYS);
  unsigned* selm = (unsigned*)(lds + NSA_SELM);
  const int tid = VT(), lane = tid & 63, wv = tid >> 6, hh = lane >> 5, ql = lane & 31;
  float* lut = (float*)(lds + NSA_LUT) + wv * 128;
  for (int item = VB(); item < NBATCH * 2 * (SEQ / 32); item += VG()) {
    const int tt = (item < 256) ? (SEQ / 32 - 1) - (item % (SEQ / 32)) : (item % (SEQ / 32));
    const int bg = item / (SEQ / 32);
    const int b = bg >> 1, g = bg & 1;
    const int h = g * 4 + wv;
    const int t0 = tt * 32, tq = t0 + ql, cur = t0 >> 6;
    vsync();
    QFrag q;
    q_load(q, p.qn + (size_t)(b * SEQ + tq) * 1024 + h * 128);
    {
      const int lo = opq(lane);
      lut[lo] = p.t5[t5_bucket(lo) * 8 + h] * LOG2E;
      lut[lo + 64] = p.t5[t5_bucket(lo + 64) * 8 + h] * LOG2E;
    }
#pragma unroll
    for (int i = 0; i < 16; ++i) imp[i * 256 + tid] = 0.f;
    if (tid < 32) selm[tid] = 0u;
    const float* grow = p.gates + (size_t)(b * SEQ + tq) * 24 + h * 3;
    float* prow = p.part + (size_t)(b * SEQ + tq) * 1024 + h * 128;
    OAcc o;
    float m, l;
    KVRegs kv;
    {
      const bf16_t* kb = p.kcb + (size_t)bg * 128 * 128;
      const bf16_t* vb = p.vcT + (size_t)bg * 128 * 128;
      oacc_zero(o);
      m = NEG_BIG; l = 0.f;
      kv_load(kv, kb, 128, vb, 128);
      vsync();
      kv_store(kv, lk, lv);
      vsync();
      f32x16 x0, x1;
      qk_tile(q, lk, x0, x1);
      int tqv = tq;
      asm volatile("" : "+v"(tqv));
      tqv -= 64 * hh;
      float fsc = 1.f, fbb = 0.f;
      if (t0 >= 1152) {
        fsc = ATT_SCALE2; fbb = lut[127];
      } else {
#pragma unroll
        for (int r = 0; r < 16; ++r) {
          const int c = 8 * (r >> 2) + (r & 3);
          const int d0 = tqv - 16 * c - 31, d1 = d0 - 512;
          x0[r] = (d0 >= 0) ? x0[r] * ATT_SCALE2 + lut[min(d0, 127)] : -INFINITY;
          x1[r] = (d1 >= 0) ? x1[r] * ATT_SCALE2 + lut[min(d1, 127)] : -INFINITY;
        }
      }
      softmax_tile(x0, x1, m, l, o, fsc, fbb);
      const float m0 = m;
      pv_tile(o, lv, x0, x1);
      f32x16 z0, z1;
#pragma unroll
      for (int r = 0; r < 16; ++r) { z0[r] = 0.f; z1[r] = 0.f; }
      if (t0 >= 1024) {
        kv_load(kv, kb + 64 * 128, 128, vb + 64, 128);
        vsync();
        kv_store(kv, lk, lv);
        vsync();
        qk_tile(q, lk, z0, z1);
        asm volatile("" : "+v"(tqv));
#pragma unroll
        for (int r = 0; r < 16; ++r) {
          const int c = 64 + 8 * (r >> 2) + (r & 3);
          const int d0 = tqv - 16 * c - 31, d1 = d0 - 512;
          z0[r] = (d0 >= 0) ? z0[r] * ATT_SCALE2 + lut[min(d0, 127)] : -INFINITY;
          z1[r] = (d1 >= 0) ? z1[r] * ATT_SCALE2 + lut[min(d1, 127)] : -INFINITY;
        }
        softmax_tile(z0, z1, m, l, o);
        pv_tile(o, lv, z0, z1);
      }
      const float inv = 1.f / fmaxf(l, 1e-20f);
      const float c0 = __builtin_amdgcn_exp2f(m0 - m) * inv;
#pragma unroll
      for (int r = 0; r < 16; ++r) {
        const int c = 8 * (r >> 2) + (r & 3) + 4 * hh;
        if (x0[r] != 0.f) atomicAdd(&imp[(c) * 32 + ql], x0[r] * c0);
        if (x1[r] != 0.f) atomicAdd(&imp[(c + 32) * 32 + ql], x1[r] * c0);
        if (z0[r] != 0.f) atomicAdd(&imp[(c + 64) * 32 + ql], z0[r] * inv);
        if (z1[r] != 0.f) atomicAdd(&imp[(c + 96) * 32 + ql], z1[r] * inv);
      }
      const float gs = inv / (1.f + __expf(-grow[0]));
      oacc_foreach(o, [&](int d, float v0, float v1, float v2, float v3) {
        f32x4 u = {v0 * gs, v1 * gs, v2 * gs, v3 * gs};
        *(f32x4*)(prow + d) = u;
      });
    }
    vsync();
    {
      const int tido = opq(tid);
      const int qq = tido & 31, jg = tido >> 5;
#pragma unroll
      for (int jj = 0; jj < 4; ++jj) {
        const int j = jg * 4 + jj;
        float v = imp[(4 * j) * 32 + qq] + imp[(4 * j + 1) * 32 + qq] + imp[(4 * j + 2) * 32 + qq] + 0.5f * imp[(4 * j + 3) * 32 + qq];
        if (j > 0) v += 0.5f * imp[(4 * j - 1) * 32 + qq];
        const bool forced = (j == 0) || (j == cur) || (j == cur - 1);
        keys[qq * 33 + j] = forced ? 1e9f : ((j <= cur) ? v : -1e9f);
      }
      vsync();
      unsigned bits = 0u;
#pragma unroll
      for (int jj = 0; jj < 4; ++jj) {
        const int j = jg * 4 + jj;
        const float kj = keys[qq * 33 + j];
        int rank = 0;
        for (int i = 0; i < 32; ++i) {
          const float ki = keys[qq * 33 + i];
          rank += (ki > kj || (ki == kj && i < j)) ? 1 : 0;
        }
        if (rank < 16 && j <= cur) bits |= 1u << j;
      }
      atomicOr(&selm[qq], bits);
      vsync();
    }
    const unsigned mysel = selm[ql];
    unsigned um = mysel;
#pragma unroll
    for (int o2 = 16; o2 > 0; o2 >>= 1) um |= (unsigned)__shfl_xor((int)um, o2);
    um = (unsigned)__builtin_amdgcn_readfirstlane((int)um);
    {
      const bf16_t* kb = p.ks + (size_t)bg * SEQ * 128;
      const bf16_t* vb = p.vsT + (size_t)bg * 128 * SEQ;
      oacc_zero(o);
      m = NEG_BIG; l = 0.f;
      unsigned rem = um;
      int j = __builtin_ctz(rem);
      kv_load(kv, kb + (size_t)j * 64 * 128, 128, vb + j * 64, SEQ);
      while (rem) {
        j = __builtin_ctz(rem);
        rem &= rem - 1;
        const int jn = rem ? __builtin_ctz(rem) : j;
        vsync();
        kv_store(kv, lk, lv);
        vsync();
        f32x16 s0, s1;
        qk_tile(q, lk, s0, s1);
        const bool selq = (mysel >> j) & 1u;
        int tqv = tq;
        asm volatile("" : "+v"(tqv));
        float fsc = 1.f, fbb = 0.f;
        if (j * 64 + 63 + 113 <= t0) {
          fsc = selq ? ATT_SCALE2 : 0.f; fbb = selq ? lut[127] : -INFINITY;
        } else {
#pragma unroll
          for (int r = 0; r < 16; ++r) {
            const int d0 = tqv - (j * 64 + 8 * (r >> 2) + (r & 3) + 4 * hh), d1 = d0 - 32;
            s0[r] = (selq && d0 >= 0) ? s0[r] * ATT_SCALE2 + lut[min(d0, 127)] : -INFINITY;
            s1[r] = (selq && d1 >= 0) ? s1[r] * ATT_SCALE2 + lut[min(d1, 127)] : -INFINITY;
          }
        }
        kv_load(kv, kb + (size_t)jn * 64 * 128, 128, vb + jn * 64, SEQ);
        softmax_tile(s0, s1, m, l, o, fsc, fbb);
        pv_tile(o, lv, s0, s1);
      }
      const float gs = 1.f / (fmaxf(l, 1e-20f) * (1.f + __expf(-grow[1])));
      int qo = ql;
      asm volatile("" : "+v"(qo));
      float* pr2 = p.part + (size_t)(b * SEQ + t0 + qo) * 1024 + h * 128;
      oacc_foreach(o, [&](int d, float v0, float v1, float v2, float v3) {
        f32x4 u = *(f32x4*)(pr2 + d);
        u[0] += v0 * gs; u[1] += v1 * gs; u[2] += v2 * gs; u[3] += v3 * gs;
        *(f32x4*)(pr2 + d) = u;
      });
    }
    {
      const bf16_t* kb = p.kw + (size_t)bg * SEQ * 128;
      const bf16_t* vb = p.vwT + (size_t)bg * 128 * SEQ;
      oacc_zero(o);
      m = NEG_BIG; l = 0.f;
      int jlo = (t0 - 511) >> 6;
      if (jlo < 0) jlo = 0;
      kv_load(kv, kb + (size_t)jlo * 64 * 128, 128, vb + jlo * 64, SEQ);
      for (int j = jlo; j <= cur; ++j) {
        const int jn = (j < cur) ? j + 1 : j;
        vsync();
        kv_store(kv, lk, lv);
        vsync();
        f32x16 s0, s1;
        qk_tile(q, lk, s0, s1);
        int tqv = tq;
        asm volatile("" : "+v"(tqv));
        float wsc = 1.f, wbb = 0.f;
        if (j * 64 + 63 + 113 <= t0 && t0 + 31 - j * 64 < 512) {
          wsc = ATT_SCALE2; wbb = lut[127];
        } else {
#pragma unroll
          for (int r = 0; r < 16; ++r) {
            const int d0 = tqv - (j * 64 + 8 * (r >> 2) + (r & 3) + 4 * hh), d1 = d0 - 32;
            s0[r] = (d0 >= 0 && d0 < 512) ? s0[r] * ATT_SCALE2 + lut[min(d0, 127)] : -INFINITY;
            s1[r] = (d1 >= 0 && d1 < 512) ? s1[r] * ATT_SCALE2 + lut[min(d1, 127)] : -INFINITY;
          }
        }
        kv_load(kv, kb + (size_t)jn * 64 * 128, 128, vb + jn * 64, SEQ);
        softmax_tile(s0, s1, m, l, o, wsc, wbb);
        pv_tile(o, lv, s0, s1);
      }
      const float gs = 1.f / (fmaxf(l, 1e-20f) * (1.f + __expf(-grow[2])));
      int qo = ql;
      asm volatile("" : "+v"(qo));
      const float* pr2 = p.part + (size_t)(b * SEQ + t0 + qo) * 1024 + h * 128;
      bf16_t* orow = p.omix + (size_t)(b * SEQ + t0 + qo) * DM + h * 128;
      oacc_foreach(o, [&](int d, float v0, float v1, float v2, float v3) {
        const f32x4 u = *(const f32x4*)(pr2 + d);
        uint2 w;
        w.x = pack2(u[0] + v0 * gs, u[1] + v1 * gs);
        w.y = pack2(u[2] + v2 * gs, u[3] + v3 * gs);
        *(uint2*)(orow + d) = w;
      });
    }
  }
}

__device__ __forceinline__ void ph_cvt(const float* src, bf16_t* dst, size_t n) {
  typedef __attribute__((ext_vector_type(4))) float f32x4;
  const size_t nv = n / 8;
  for (size_t i = (size_t)VB() * 256 + VT(); i < nv; i += (size_t)VG() * 256) {
    const f32x4 a = ((const f32x4*)src)[2 * i], b = ((const f32x4*)src)[2 * i + 1];
    u32x4 o;
    o[0] = pack2(a[0], a[1]); o[1] = pack2(a[2], a[3]); o[2] = pack2(b[0], b[1]); o[3] = pack2(b[2], b[3]);
    ((u32x4*)dst)[i] = o;
  }
}

__device__ __forceinline__ void ph_scores(const P& p, char* lds) {
  for (int u = VB(); u < 64 * 16; u += VG()) {
    const int tm = u & 63, hp = u >> 6;
    const int m0 = tm * 128;
    float* sc = p.scores + (size_t)m0 * DM + hp * 128;
    gemm_tile_bf16<false>(p.omix + (size_t)m0 * DM + hp * 128, DM, p.subkb + (size_t)hp * 128 * 128, 128, 128, lds,
                          [&](int r, int c, float val) { sc[(size_t)r * DM + c] = val; });
  }
}

template <int PM = 0>
__device__ __forceinline__ void ph_qp_scores(const P& p, char* lds0, char* lds) {
  for (int u = (int)blockIdx.x; u < 32 * 8; u += (int)gridDim.x) {
    const int x = u & 7, i = (u >> 3) & 31;
    const int tm = (x & 3) * 8 + (i & 7), tn = (x >> 2) * 4 + (i >> 3);
    const int m0 = tm * 256, n0 = tn * 256;
    bf16_t* qp = p.omix + (size_t)m0 * DM + n0;
    const float* rss = p.rowss + T_TOK + m0;
    gemm_tile_huge<PM>(p.hn + (size_t)m0 * DM, DM, p.WpqT + (size_t)n0 * DM, DM, DM, lds0,
                   [&](int r, int c, f32x4_e lo, f32x4_e hi) {
                     const float rs = rsqrtf(rss[r] * (1.f / DM) + RMS_EPS);
                     st_bf16x8(qp + (size_t)r * DM + c, lo * rs, hi * rs); });
    __threadfence_block();
    __syncthreads();
    const int hf = (int)(threadIdx.x >> 8);
    const int hp = tn * 2 + hf;
    float* sc = p.scores + (size_t)m0 * DM + hp * 128;
    gemm_tile_big(qp + hf * 128, DM, p.subkb + (size_t)hp * 128 * 128, 128, 128, lds,
                  [&](int r, int c, f32x4_e lo, f32x4_e hi) {
                    *(f32x4_e*)(sc + (size_t)r * DM + c) = lo; *(f32x4_e*)(sc + (size_t)r * DM + c + 4) = hi; });
    __syncthreads();
  }
}

__device__ __forceinline__ void ph_cvt4(const float* src, unsigned char* dst, float* scales, int nrows, int wid0, int nw) {
  typedef __attribute__((ext_vector_type(4))) float f32x4;
  typedef __attribute__((ext_vector_type(2))) float f32x2;
  const int lane = VT() & 63;
  const float one = __uint_as_float((unsigned)opq(0x3F800000));
  float lev[8];
#pragma unroll
  for (int c = 0; c < 8; ++c) {
    const f32x2 q = __builtin_amdgcn_cvt_scalef32_pk_f32_fp4((unsigned)opq(c * 0x11111111), one, 0);
    lev[c] = fabsf(q[0]);
  }
  const float maxlev = lev[7];
  for (int row = wid0; row < nrows; row += nw) {
    const f32x4* s4 = (const f32x4*)(src + (size_t)row * DM) + lane * 8;
    f32x4 v[8];
    float amax = 0.f;
#pragma unroll
    for (int i = 0; i < 8; ++i) {
      v[i] = s4[i];
#pragma unroll
      for (int k = 0; k < 4; ++k) amax = fmaxf(amax, fabsf(v[i][k]));
    }
    amax = wave_max(amax);
    const float sc = (amax > 0.f) ? maxlev / amax : 1.f;
    u32x4 o;
#pragma unroll
    for (int w = 0; w < 4; ++w) {
      unsigned pk = 0u;
      pk = __builtin_amdgcn_cvt_scalef32_pk_fp4_f32(pk, v[2 * w][0] * sc, v[2 * w][1] * sc, 1.0f, 0);
      pk = __builtin_amdgcn_cvt_scalef32_pk_fp4_f32(pk, v[2 * w][2] * sc, v[2 * w][3] * sc, 1.0f, 1);
      pk = __builtin_amdgcn_cvt_scalef32_pk_fp4_f32(pk, v[2 * w + 1][0] * sc, v[2 * w + 1][1] * sc, 1.0f, 2);
      pk = __builtin_amdgcn_cvt_scalef32_pk_fp4_f32(pk, v[2 * w + 1][2] * sc, v[2 * w + 1][3] * sc, 1.0f, 3);
      o[w] = pk;
    }
    *(u32x4*)(dst + (size_t)row * 1024 + lane * 16) = o;
    if (lane == 0) scales[row] = (amax > 0.f) ? amax / maxlev : 1.f;
  }
}

__device__ __forceinline__ float wave_sum_dpp(float v) {
  typedef __attribute__((ext_vector_type(2))) unsigned u32x2_d;
  v += __builtin_bit_cast(float, __builtin_amdgcn_update_dpp(0, __builtin_bit_cast(int, v), 0xB1, 0xF, 0xF, true));
  v += __builtin_bit_cast(float, __builtin_amdgcn_update_dpp(0, __builtin_bit_cast(int, v), 0x4E, 0xF, 0xF, true));
  v += __builtin_bit_cast(float, __builtin_amdgcn_update_dpp(0, __builtin_bit_cast(int, v), 0x141, 0xF, 0xF, true));
  v += __builtin_bit_cast(float, __builtin_amdgcn_update_dpp(0, __builtin_bit_cast(int, v), 0x140, 0xF, 0xF, true));
  u32x2_d r = __builtin_amdgcn_permlane16_swap(__float_as_uint(v), __float_as_uint(v), false, false);
  v = __uint_as_float(r[0]) + __uint_as_float(r[1]);
  r = __builtin_amdgcn_permlane32_swap(__float_as_uint(v), __float_as_uint(v), false, false);
  return __uint_as_float(r[0]) + __uint_as_float(r[1]);
}
__device__ __forceinline__ float gelu_rcp(float x) {
  const float y2 = (1.5957691216057308f * LOG2E) * (x + 0.044715f * x * x * x);
  return x * __builtin_amdgcn_rcpf(1.f + __builtin_amdgcn_exp2f(-y2));
}
__device__ __forceinline__ u32x4 r4_load(const unsigned char* tab, int eid, int lane) {
  return *((const u32x4*)(tab + (size_t)eid * 1024) + lane);
}
struct XPk { f32x16 a, b; };
struct Acc32 { f32x16 a, b; };

typedef __attribute__((ext_vector_type(2))) float f32x2_t;
#define PAIR(v, i) __builtin_shufflevector(v, v, (i), (i) + 1)
#define R4_DOT_W(word, xv, base, sa, sb)                                                             \
  {                                                                                                  \
    const f32x2_t q0 = __builtin_amdgcn_cvt_scalef32_pk_f32_fp4(word, one, 0), q1 = __builtin_amdgcn_cvt_scalef32_pk_f32_fp4(word, one, 1); \
    const f32x2_t q2 = __builtin_amdgcn_cvt_scalef32_pk_f32_fp4(word, one, 2), q3 = __builtin_amdgcn_cvt_scalef32_pk_f32_fp4(word, one, 3); \
    sa = __builtin_elementwise_fma(q0, PAIR(xv, base + 0), sa); sb = __builtin_elementwise_fma(q1, PAIR(xv, base + 2), sb); \
    sa = __builtin_elementwise_fma(q2, PAIR(xv, base + 4), sa); sb = __builtin_elementwise_fma(q3, PAIR(xv, base + 6), sb); \
  }
__device__ __forceinline__ float r4_dot(const u32x4& e, const XPk& x) {
  const float one = __uint_as_float((unsigned)opq(0x3F800000));
  f32x2_t sa = {0.f, 0.f}, sb = {0.f, 0.f};
  R4_DOT_W(e[0], x.a, 0, sa, sb) R4_DOT_W(e[1], x.a, 8, sa, sb) R4_DOT_W(e[2], x.b, 0, sa, sb) R4_DOT_W(e[3], x.b, 8, sa, sb)
  sa = sa + sb;
  return sa[0] + sa[1];
}
#define R4_AXPY_P(accv, i, q)                                                                        \
  { const f32x2_t r_ = __builtin_elementwise_fma(h2, q, PAIR(accv, i)); accv[i] = r_[0]; accv[(i) + 1] = r_[1]; }
#define R4_AXPY_W(word, accv, base)                                                                  \
  {                                                                                                  \
    const f32x2_t q0 = __builtin_amdgcn_cvt_scalef32_pk_f32_fp4(word, one, 0), q1 = __builtin_amdgcn_cvt_scalef32_pk_f32_fp4(word, one, 1); \
    const f32x2_t q2 = __builtin_amdgcn_cvt_scalef32_pk_f32_fp4(word, one, 2), q3 = __builtin_amdgcn_cvt_scalef32_pk_f32_fp4(word, one, 3); \
    R4_AXPY_P(accv, base + 0, q0) R4_AXPY_P(accv, base + 2, q1) R4_AXPY_P(accv, base + 4, q2) R4_AXPY_P(accv, base + 6, q3) \
  }
__device__ __forceinline__ void r4_axpy(const u32x4& e, float hid, Acc32& acc) {
  const float one = __uint_as_float((unsigned)opq(0x3F800000));
  const f32x2_t h2 = {hid, hid};
  R4_AXPY_W(e[0], acc.a, 0) R4_AXPY_W(e[1], acc.a, 8) R4_AXPY_W(e[2], acc.b, 0) R4_AXPY_W(e[3], acc.b, 8)
}

#define INS16(K, x)                                                                                      \
  K##15 = __builtin_amdgcn_fmed3f(K##15, K##14, x); K##14 = __builtin_amdgcn_fmed3f(K##14, K##13, x);   \
  K##13 = __builtin_amdgcn_fmed3f(K##13, K##12, x); K##12 = __builtin_amdgcn_fmed3f(K##12, K##11, x);   \
  K##11 = __builtin_amdgcn_fmed3f(K##11, K##10, x); K##10 = __builtin_amdgcn_fmed3f(K##10, K##9, x);    \
  K##9 = __builtin_amdgcn_fmed3f(K##9, K##8, x); K##8 = __builtin_amdgcn_fmed3f(K##8, K##7, x);         \
  K##7 = __builtin_amdgcn_fmed3f(K##7, K##6, x); K##6 = __builtin_amdgcn_fmed3f(K##6, K##5, x);         \
  K##5 = __builtin_amdgcn_fmed3f(K##5, K##4, x); K##4 = __builtin_amdgcn_fmed3f(K##4, K##3, x);         \
  K##3 = __builtin_amdgcn_fmed3f(K##3, K##2, x); K##2 = __builtin_amdgcn_fmed3f(K##2, K##1, x);         \
  K##1 = __builtin_amdgcn_fmed3f(K##1, K##0, x); K##0 = fmaxf(K##0, x);
#define DECL16(K) float K##0 = -INFINITY, K##1 = -INFINITY, K##2 = -INFINITY, K##3 = -INFINITY, K##4 = -INFINITY, \
  K##5 = -INFINITY, K##6 = -INFINITY, K##7 = -INFINITY, K##8 = -INFINITY, K##9 = -INFINITY, K##10 = -INFINITY,   \
  K##11 = -INFINITY, K##12 = -INFINITY, K##13 = -INFINITY, K##14 = -INFINITY, K##15 = -INFINITY;
__device__ __forceinline__ float mkkey(float v, unsigned tag, unsigned mask) {
  return __uint_as_float((__float_as_uint(v) & ~mask) | tag);
}

__device__ __forceinline__ void ph_peer(const P& p, float* smem) {
  typedef __attribute__((ext_vector_type(4))) float f32x4;
  float* lists = smem;
  int* bexA = (int*)(smem + 4096);
  float* bgtA = smem + 6144;
  float* bsuA = smem + 8192;
  float* hidA = smem + 10240;
  float* xqA = smem + 10752;
  for (int item = VB(); item < T_TOK / 16; item += VG()) {
    const int t0 = item * 16;
    vsync();
    {
      const int tid = VT();
      const int tl = tid >> 4, hp = tid & 15;
      const f32x4* sp = (const f32x4*)(p.scores + (size_t)(t0 + tl) * DM + hp * 128);
      DECL16(k)
#pragma unroll 4
      for (int c4 = 0; c4 < 32; ++c4) {
        const f32x4 v = sp[c4];
#pragma unroll
        for (int e = 0; e < 4; ++e) {
          const float x = mkkey(v[e], 127u - (unsigned)(c4 * 4 + e), 127u);
          INS16(k, x)
        }
      }
      f32x4* lp = (f32x4*)(lists + (size_t)VT() * 16);
      f32x4 o0 = {k0, k1, k2, k3}, o1 = {k4, k5, k6, k7}, o2 = {k8, k9, k10, k11}, o3 = {k12, k13, k14, k15};
      lp[0] = o0; lp[1] = o1; lp[2] = o2; lp[3] = o3;
    }
    vsync();
    if (VT() < 128) {
      const int tid = VT();
      const int tl = tid >> 3, h = tid & 7;
      const float* la = lists + (size_t)(tl * 16 + 2 * h) * 16;
      const float* lb = la + 16;
      float av[16], bv[16];
#pragma unroll
      for (int i = 0; i < 16; ++i) {
        av[i] = __uint_as_float(__float_as_uint(la[i]) & ~127u);
        bv[i] = __uint_as_float(__float_as_uint(lb[i]) & ~127u);
      }
      DECL16(c)
#pragma unroll
      for (int i = 0; i < 16; ++i) {
#pragma unroll
        for (int j = 0; j < 16; ++j) {
          if ((i + 1) * (j + 1) <= 16) {
            const float x = mkkey(av[i] + bv[j], 255u - (unsigned)(i * 16 + j), 255u);
            INS16(c, x)
          }
        }
      }
      float cs[16] = {c0, c1, c2, c3, c4, c5, c6, c7, c8, c9, c10, c11, c12, c13, c14, c15};
      float ev[16];
      float sum = 0.f;
      const float mx = __uint_as_float(__float_as_uint(cs[0]) & ~255u);
#pragma unroll
      for (int n = 0; n < 16; ++n) {
        ev[n] = __expf(__uint_as_float(__float_as_uint(cs[n]) & ~255u) - mx);
        sum += ev[n];
      }
      const float isum = 1.f / sum;
#pragma unroll
      for (int n = 0; n < 16; ++n) {
        const unsigned cc = 255u - (__float_as_uint(cs[n]) & 255u);
        const unsigned ka = 127u - (__float_as_uint(la[cc >> 4]) & 127u);
        const unsigned kb = 127u - (__float_as_uint(lb[cc & 15u]) & 127u);
        const int eid = (int)(ka * 128u + kb);
        bexA[tl * 128 + h * 16 + n] = eid;
        bgtA[tl * 128 + h * 16 + n] = ev[n] * isum * p.sv8[eid];
        bsuA[tl * 128 + h * 16 + n] = p.su8[eid];
      }
    }
    vsync();
#pragma unroll 1
    for (int ti4 = 0; ti4 < 4; ++ti4) {
    const int lane = VT() & 63, wv = VT() >> 6;
    const int tl = wv * 4 + ti4;
    const int t = t0 + tl;
    const int* bex = bexA + tl * 128;
    const float* bgt = bgtA + tl * 128;
    const float* bsu = bsuA + tl * 128;
    float* hidL = hidA + wv * 128;
    unsigned char* xqL = (unsigned char*)xqA + wv * 2048;
    const int q16 = lane >> 4;
    float inv_s;
    {
      const u32x4* s4 = (const u32x4*)(p.hn + (size_t)t * DM) + lane * 4;
      const f32x4* g4 = (const f32x4*)p.norm_ffn + lane * 8;
      const u32x4 q0 = s4[0], q1 = s4[1], q2 = s4[2], q3 = s4[3];
#define UNPK(q, lo) f32x4{__uint_as_float(q[lo] << 16), __uint_as_float(q[lo] & 0xffff0000u), \
                          __uint_as_float(q[lo + 1] << 16), __uint_as_float(q[lo + 1] & 0xffff0000u)}
      f32x4 a0 = UNPK(q0, 0), a1 = UNPK(q0, 2), a2 = UNPK(q1, 0), a3 = UNPK(q1, 2);
      f32x4 a4 = UNPK(q2, 0), a5 = UNPK(q2, 2), a6 = UNPK(q3, 0), a7 = UNPK(q3, 2);
      float ss = 0.f;
#define SSQ(v) ss += v[0] * v[0] + v[1] * v[1] + v[2] * v[2] + v[3] * v[3];
      SSQ(a0) SSQ(a1) SSQ(a2) SSQ(a3) SSQ(a4) SSQ(a5) SSQ(a6) SSQ(a7)
#undef SSQ
      ss = wave_sum(ss);
      const float rs = rsqrtf(ss * (1.f / DM) + RMS_EPS);
      float amax = 0.f;
#define XSC(v, gi) { v = v * rs * g4[gi]; amax = fmaxf(fmaxf(amax, fmaxf(fabsf(v[0]), fabsf(v[1]))), fmaxf(fabsf(v[2]), fabsf(v[3]))); }
      XSC(a0, 0) XSC(a1, 1) XSC(a2, 2) XSC(a3, 3) XSC(a4, 4) XSC(a5, 5) XSC(a6, 6) XSC(a7, 7)
#undef XSC
      amax = wave_max(amax);
      unsigned ex = (__float_as_uint(amax) >> 23) & 255u;
      ex = ex < 8u ? 8u : ex;
      const float sx = __uint_as_float((261u - ex) << 23);
      inv_s = __uint_as_float((ex - 7u) << 23);
#define XQ(v) __builtin_amdgcn_cvt_pk_fp8_f32(v[2] * sx, v[3] * sx, __builtin_amdgcn_cvt_pk_fp8_f32(v[0] * sx, v[1] * sx, 0, false), true)
      const u32x4 w0 = {(unsigned)XQ(a0), (unsigned)XQ(a1), (unsigned)XQ(a2), (unsigned)XQ(a3)};
      const u32x4 w1 = {(unsigned)XQ(a4), (unsigned)XQ(a5), (unsigned)XQ(a6), (unsigned)XQ(a7)};
#undef XQ
      *(u32x4*)(xqL + lane * 32) = w0;
      *(u32x4*)(xqL + lane * 32 + 16) = w1;
    }
    __builtin_amdgcn_wave_barrier();
    {
      const unsigned char* pg[8];
#pragma unroll
      for (int g = 0; g < 8; ++g) pg[g] = p.pu8 + (size_t)bex[g * 16 + (lane & 15)] * 1024 + q16 * 16;
      const u32x4* xb = (const u32x4*)(xqL + q16 * 16);
      f32x4 ag[8];
#pragma unroll
      for (int g = 0; g < 8; ++g) ag[g] = f32x4{0.f, 0.f, 0.f, 0.f};
      i32x4_t X[8], Y[8];
#pragma unroll
      for (int g = 0; g < 8; ++g) X[g] = *(const i32x4_t*)(pg[g]);
#define UMMA(S, kb)                                                                                         \
      {                                                                                                     \
        const u32x4 b0 = xb[(kb) * 8], b1 = xb[(kb) * 8 + 4];                                               \
        const i32x8_t bq = {(int)b0[0], (int)b0[1], (int)b0[2], (int)b0[3], (int)b1[0], (int)b1[1], (int)b1[2], (int)b1[3]}; \
        _Pragma("unroll") for (int g = 0; g < 8; ++g)                                                       \
          ag[g] = __builtin_amdgcn_mfma_scale_f32_16x16x128_f8f6f4(                                         \
              __builtin_shufflevector(S[g], S[g], 0, 1, 2, 3, -1, -1, -1, -1), bq, ag[g], 4, 0, 0, 0, 0, 0); \
        __builtin_amdgcn_sched_barrier(0);                                                                  \
      }
#pragma unroll 1
      for (int kb = 0; kb < 16; kb += 2) {
#pragma unroll
        for (int g = 0; g < 8; ++g) Y[g] = *(const i32x4_t*)(pg[g] + 64);
        UMMA(X, kb)
        const int adv = (kb + 2 < 16) ? 128 : 0;
#pragma unroll
        for (int g = 0; g < 8; ++g) { pg[g] += adv; X[g] = *(const i32x4_t*)(pg[g]); }
        UMMA(Y, kb + 1)
      }
#undef UMMA
#pragma unroll
      for (int g = 0; g < 8; ++g) {
        const f32x4 bs = *(const f32x4*)&bsu[g * 16 + 4 * q16], gt = *(const f32x4*)&bgt[g * 16 + 4 * q16];
        f32x4 h;
#pragma unroll
        for (int j = 0; j < 4; ++j) h[j] = gt[j] * gelu_rcp(ag[g][j] * (bs[j] * inv_s));
        if ((lane & 15) == 0) *(f32x4*)&hidL[g * 16 + 4 * q16] = h;
      }
    }
    __builtin_amdgcn_wave_barrier();
    Acc32 acc;
#pragma unroll
    for (int r = 0; r < 16; ++r) { acc.a[r] = 0.f; acc.b[r] = 0.f; }
#define SID(i) __builtin_amdgcn_readfirstlane(bex[i])
#define SFL(arr, i) __uint_as_float((unsigned)__builtin_amdgcn_readfirstlane((int)__float_as_uint(arr[i])))
#define VLD(S, e) { const int e_ = (e) < 124 ? (e) : 124; S##0 = r4_load(p.pv8, SID(e_), lane); S##1 = r4_load(p.pv8, SID(e_ + 1), lane); \
                    S##2 = r4_load(p.pv8, SID(e_ + 2), lane); S##3 = r4_load(p.pv8, SID(e_ + 3), lane); }
#define VAX(S, e) { r4_axpy(S##0, SFL(hidL, (e)), acc); r4_axpy(S##1, SFL(hidL, (e) + 1), acc); \
                    r4_axpy(S##2, SFL(hidL, (e) + 2), acc); r4_axpy(S##3, SFL(hidL, (e) + 3), acc); }
    u32x4 A0, A1, A2, A3, B0, B1, B2, B3, C0, C1, C2, C3, D0, D1, D2, D3;
    VLD(A, 0) VLD(B, 4) VLD(C, 8)
#pragma unroll 1
    for (int e0 = 0; e0 < 128; e0 += 16) {
      VLD(D, e0 + 12) VAX(A, e0)
      VLD(A, e0 + 16) VAX(B, e0 + 4)
      VLD(B, e0 + 20) VAX(C, e0 + 8)
      VLD(C, e0 + 24) VAX(D, e0 + 12)
    }
#undef VLD
#undef VAX
#undef SID
#undef SFL
    const int lane2 = opq(lane);
    f32x4* o4 = (f32x4*)(p.out + (size_t)t * DM) + lane2 * 8;
    const u32x4* hq = (const u32x4*)(p.hn + (size_t)t * DM) + lane2 * 4;
    const f32x4* g4 = (const f32x4*)p.norm_final + lane2 * 8;
    f32x4 hv[8];
    float ss = 0.f;
#pragma unroll
    for (int i = 0; i < 4; ++i) {
      const u32x4 q = hq[i];
      hv[2 * i] = UNPK(q, 0);
      hv[2 * i + 1] = UNPK(q, 2);
    }
#undef UNPK
#pragma unroll
    for (int i = 0; i < 8; ++i) {
#pragma unroll
      for (int k = 0; k < 4; ++k) {
        hv[i][k] += (i < 4) ? acc.a[4 * i + k] : acc.b[4 * (i - 4) + k];
        ss += hv[i][k] * hv[i][k];
      }
    }
    ss = wave_sum(ss);
    const float rs = rsqrtf(ss * (1.f / DM) + RMS_EPS);
#pragma unroll
    for (int i = 0; i < 8; ++i) {
      const f32x4 g = g4[i];
      f32x4 o;
#pragma unroll
      for (int k = 0; k < 4; ++k) o[k] = hv[i][k] * rs * g[k];
      o4[i] = o;
    }
    }
  }
}

#define XB_TMO      128
#define XB_XCNT(j)  (256  + 64 * (j))
#define XB_XSUB(j)  (1280 + 64 * (j))
#define XB_XGEN(j)  (2304 + 64 * (j))
#define XB_TOP      3328
#define XB_TOPGEN   3392
#define XCD_BAR_WORDS 3456
#define XB_SPIN_CAP (1u << 22)
__device__ __forceinline__ unsigned xb_ld(unsigned* p) { return __hip_atomic_load(p, __ATOMIC_RELAXED, __HIP_MEMORY_SCOPE_AGENT); }
__device__ __forceinline__ unsigned xb_add(unsigned* p, unsigned v) { return __hip_atomic_fetch_add(p, v, __ATOMIC_RELAXED, __HIP_MEMORY_SCOPE_AGENT); }
__device__ __forceinline__ unsigned xb_xcc_id() { return (unsigned)__builtin_amdgcn_s_getreg((3 << 11) | 20) & 0xFu; }
#define XB_SPIN(cond, bar) do { unsigned _sp = 0; while (cond) { __builtin_amdgcn_s_sleep(1); \
    if ((++_sp & 255u) == 0u) { if (xb_ld(&(bar)[XB_TMO])) break; if (_sp > XB_SPIN_CAP) { atomicAdd(&(bar)[XB_TMO], 1u); break; } } } } while (0)
struct XcdBarrier { unsigned* bar; unsigned x; volatile LAS unsigned* st; };
__device__ __forceinline__ XcdBarrier xcd_barrier_post(unsigned* bar, volatile LAS unsigned* st) {
  XcdBarrier b; b.bar = bar; b.x = xb_xcc_id(); b.st = st;
  if (threadIdx.x == 0) (void)xb_add(&bar[XB_XCNT(b.x)], 1u);
  return b;
}
__device__ __forceinline__ void xcd_barrier_complete(unsigned* bar, unsigned x, unsigned& nloc, unsigned& nx) {
  const unsigned G = gridDim.x * gridDim.y * gridDim.z;
  unsigned sum, cnt, mine, sp = 0u;
  for (;;) {
    sum = 0u; cnt = 0u; mine = 0u;
#pragma unroll
    for (unsigned j = 0; j < 16; ++j) { const unsigned c = xb_ld(&bar[XB_XCNT(j)]); sum += c; cnt += (c > 0u) ? 1u : 0u; mine = (j == x) ? c : mine; }
    if (sum == G) break;
    __builtin_amdgcn_s_sleep(1);
    if ((++sp & 255u) == 0u) { if (xb_ld(&bar[XB_TMO])) break; if (sp > XB_SPIN_CAP) { atomicAdd(&bar[XB_TMO], 1u); break; } }
  }
  nloc = mine > 0u ? mine : 1u; nx = cnt > 0u ? cnt : 1u;
}
__device__ __forceinline__ void xcd_barrier(const XcdBarrier& b) {
  asm volatile("s_waitcnt vmcnt(0)" ::: "memory");
  __syncthreads();
  if (threadIdx.x == 0) {
    unsigned* bar = b.bar;
    __builtin_amdgcn_s_waitcnt(0);
    unsigned nloc = b.st[0], nx = b.st[1];
    if (nloc == 0u) { xcd_barrier_complete(bar, b.x, nloc, nx); b.st[0] = nloc; b.st[1] = nx; }
    const unsigned old = xb_add(&bar[XB_XSUB(b.x)], 1u);
    const unsigned gen = old / nloc;
    if (old + 1u == (gen + 1u) * nloc) {
      __builtin_amdgcn_fence(__ATOMIC_RELEASE, "agent");
      asm volatile("s_waitcnt vmcnt(0)" ::: "memory");
      const unsigned og = xb_add(&bar[XB_TOP], 1u);
      const unsigned tg = og / nx;
      if (og + 1u == (tg + 1u) * nx) xb_add(&bar[XB_TOPGEN], 1u);
      else XB_SPIN(xb_ld(&bar[XB_TOPGEN]) == tg, bar);
      __builtin_amdgcn_fence(__ATOMIC_ACQUIRE, "agent");
      xb_add(&bar[XB_XGEN(b.x)], 1u);
      asm volatile("s_waitcnt vmcnt(0)" ::: "memory");
    } else {
      XB_SPIN(xb_ld(&bar[XB_XGEN(b.x)]) == gen, bar);
      __builtin_amdgcn_fence(__ATOMIC_ACQUIRE, "agent");
      asm volatile("s_waitcnt vmcnt(0)" ::: "memory");
    }
  }
  __syncthreads();
}

typedef const __attribute__((address_space(4))) P* KP;
__device__ __forceinline__ P loadP() {
#if defined(__HIP_DEVICE_COMPILE__)
  KP k = (KP)__builtin_amdgcn_kernarg_segment_ptr();
  asm volatile("" : "+s"(k));
  P p = *k;
  return p;
#else
  return P{};
#endif
}

__global__ void __launch_bounds__(512, 2) mega(P p_arg) {
  cg::grid_group grid = cg::this_grid();
  __shared__ __attribute__((aligned(16))) float smem_all[2 * 18432 + 64];
  float* smem = smem_all + (threadIdx.x >> 8) * 18432;
  char* lds = (char*)smem;
  unsigned* xbw = (unsigned*)(smem_all + 2 * 18432 + 32);
  if (threadIdx.x < 64) ((unsigned*)(smem_all + 2 * 18432))[threadIdx.x] = 0u;
  if (blockIdx.x == 0) {
    P p = loadP();
    for (int i = threadIdx.x; i < XCD_BAR_WORDS; i += 512) p.bar[i] = 0u;
  }
  __syncthreads();
  { P p = loadP(); ph_rmsnorm(p.x, p.norm_mix, p.hn, T_TOK); ph_rmsnorm(p.mem, p.norm_mkv, p.memn, 1024); }
  { P p = loadP(); ph_transpose<true>(smem, p.w_in, DM, INC, 5760, p.WinT); }
  { P p = loadP(); ph_transpose<false>(smem, p.w_mk, DM, 512, 512, p.WmkT); }
  { P p = loadP(); ph_transpose<false>(smem, p.w_mv, DM, 512, 512, p.WmvT); }
  { P p = loadP(); ph_cvt(p.subk, p.subkb, (size_t)16 * 128 * 128); }
  { P p = loadP(); ph_transpose<false>(smem, p.w1_k, 4096, 128, 128, p.w1T); }
  { P p = loadP(); ph_transpose<false>(smem, p.w1_v, 4096, 128, 128, p.w1T + 128 * 4096); }
  { P p = loadP(); ph_transpose<false>(smem, p.w2_k, 128, 128, 128, p.w2T); }
  { P p = loadP(); ph_transpose<false>(smem, p.w2_v, 128, 128, 128, p.w2T + 128 * 128); }
  { P p = loadP(); ph_posb(p); }
  { P p = loadP(); for (int i = VB() * 256 + VT(); i < 2 * T_TOK; i += VG() * 256) p.rowss[i] = 0.f; }
  grid.sync();
  XcdBarrier xb;
  { P p = loadP(); xb = xcd_barrier_post(p.bar, (volatile LAS unsigned*)xbw); }
  { P p = loadP(); ph_proj(p, (char*)smem_all, lds); }
  const int kvb = (VG() == 512) ? ((VB() >= 384 && VB() < 416) ? (VB() - 384) * 8 : -1) : -2;
  const int vvb = (VG() == 512) ? ((VB() >= 416 && VB() < 448) ? (VB() - 416) * 8 : -1) : -2;
  { P p = loadP(); bf16_t* kmem = p.kmemb;
    ph_gemm_bf16(p.memn, DM, p.WmkT, DM, 1024, 512, DM, lds, [=](int m, int n, float v) {
      kmem[((size_t)((m >> 8) * 4 + (n >> 7)) * 256 + (m & 255)) * 128 + (n & 127)] = f2bf(v); }, kvb); }
  { P p = loadP(); bf16_t* vmem = p.vmemT;
    ph_gemm_bf16(p.memn, DM, p.WmvT, DM, 1024, 512, DM, lds, [=](int m, int n, float v) {
      vmem[((size_t)((m >> 8) * 4 + (n >> 7)) * 128 + (n & 127)) * 256 + perm16(m & 255)] = f2bf(v); }, vvb); }
  xcd_barrier(xb);
  { P p = loadP(); ph_compress2(p, lds); }
  { P p = loadP(); ph_sb2(p, lds); }
  {
    const int skip = (VG() > 32) ? 16 : 0;
    const int vb = (VB() >= skip) ? VB() - skip : -1, nvb = VG() - skip;
    vsync();
    { P p = loadP(); ph_transpose<false>(smem, p.w_out, DM, DM, DM, p.WoutT, vb, nvb); }
    { P p = loadP(); ph_transpose<false>(smem, p.w_mq, DM, 512, 512, p.WmqT, vb, nvb, p.norm_mq); }
  }
  xcd_barrier(xb);
  { P p = loadP(); ph_nsa2(p, lds); }
  xcd_barrier(xb);
  { P p = loadP(); const float* x = p.x; bf16_t* hn = p.hn; float* rss = p.rowss;
    ph_gemm_huge(p.omix, DM, p.WoutT, DM, T_TOK, DM, DM, (char*)smem_all, [=](int m, int n, f32x4_e lo, f32x4_e hi) {
      const f32x4_e x0 = *(const f32x4_e*)(x + (size_t)m * DM + n), x1 = *(const f32x4_e*)(x + (size_t)m * DM + n + 4);
      const f32x4_e h0 = x0 + lo, h1 = x1 + hi;
      resid_feed(h0, h1, n, hn + (size_t)m * DM, rss + m); }); }
  xcd_barrier(xb);
  {
    const int half = (VG() >= 512) ? 256 : 0;
    if (half == 0 || VB() < half) { P p = loadP(); ph_memq_attn(p, lds, VB(), half ? half : VG()); }
    if (VB() >= half) {
      const int nwv = (VG() - half) * 4, wid = (VB() - half) * 4 + (VT() >> 6);
      vsync();
      { P p = loadP(); ph_transpose<false>(smem, p.w_mo, 512, DM, DM, p.WmoT, VB() - half, VG() - half); }
      { P p = loadP(); ph_cvt4(p.pu, p.pu8, p.su8, 16384, wid, nwv); }
      { P p = loadP(); ph_cvt4(p.pv, p.pv8, p.sv8, 16384, wid, nwv); }
      vsync();
      { P p = loadP(); ph_transpose<false>(smem, p.w_pq, DM, DM, DM, p.WpqT, VB() - half, VG() - half, p.norm_ffn); }
    }
  }
  xcd_barrier(xb);
  { P p = loadP(); bf16_t* hn = p.hn; float* rss = p.rowss + T_TOK;
    ph_gemm_huge(p.omem, 512, p.WmoT, 512, T_TOK, DM, 512, (char*)smem_all, [=](int m, int n, f32x4_e lo, f32x4_e hi) {
      const u32x4 hb = *(const u32x4*)(hn + (size_t)m * DM + n);
      const f32x4_e r0 = {__uint_as_float(hb[0] << 16), __uint_as_float(hb[0] & 0xffff0000u),
                          __uint_as_float(hb[1] << 16), __uint_as_float(hb[1] & 0xffff0000u)};
      const f32x4_e r1 = {__uint_as_float(hb[2] << 16), __uint_as_float(hb[2] & 0xffff0000u),
                          __uint_as_float(hb[3] << 16), __uint_as_float(hb[3] & 0xffff0000u)};
      const f32x4_e h0 = r0 + lo, h1 = r1 + hi;
      resid_feed(h0, h1, n, hn + (size_t)m * DM, rss + m); }); }
  xcd_barrier(xb);
  { P p = loadP(); ph_qp_scores<0>(p, (char*)smem_all, lds); }
  xcd_barrier(xb);
  { P p = loadP(); ph_peer(p, smem); }
}

extern "C" void kernel_launch(void* const* d_in, const int* in_sizes, int n_in, void* d_out, int out_size, void* d_ws,
                              size_t ws_size, hipStream_t stream) {
  P p{};
  p.x = (const float*)d_in[0]; p.mem = (const float*)d_in[1]; p.t5 = (const float*)d_in[2];
  p.norm_mix = (const float*)d_in[3]; p.w_in = (const float*)d_in[4]; p.pos_k = (const float*)d_in[5];
  p.w1_k = (const float*)d_in[6]; p.w2_k = (const float*)d_in[7]; p.pos_v = (const float*)d_in[8];
  p.w1_v = (const float*)d_in[9]; p.w2_v = (const float*)d_in[10]; p.w_out = (const float*)d_in[11];
  p.norm_mq = (const float*)d_in[12]; p.norm_mkv = (const float*)d_in[13]; p.w_mq = (const float*)d_in[14];
  p.w_mk = (const float*)d_in[15]; p.w_mv = (const float*)d_in[16]; p.w_mo = (const float*)d_in[17];
  p.norm_ffn = (const float*)d_in[18]; p.w_pq = (const float*)d_in[19]; p.subk = (const float*)d_in[20];
  p.pu = (const float*)d_in[21]; p.pv = (const float*)d_in[22]; p.norm_final = (const float*)d_in[23];
  p.out = (float*)d_out;
  char* w = (char*)d_ws;
  size_t off = 0;
  auto take = [&](size_t bytes) { char* r = w + off; off += (bytes + 255) & ~(size_t)255; return r; };
  p.bar = (unsigned*)take(XCD_BAR_WORDS * 4);
  p.scores = (float*)take((size_t)T_TOK * DM * 4);
  p.gates = (float*)take((size_t)T_TOK * 24 * 4);
  p.part = (float*)take((size_t)T_TOK * 1024 * 4);
  p.posb = (float*)take(256 * 4);
  p.rowss = (float*)take((size_t)2 * T_TOK * 4);
  p.qn = (bf16_t*)take((size_t)T_TOK * 1024 * 2);
  p.kcin = (bf16_t*)take((size_t)T_TOK * 256 * 2 + 65536);
  p.vcin = (bf16_t*)take((size_t)T_TOK * 256 * 2 + 65536);
  p.ks = (bf16_t*)take((size_t)T_TOK * 256 * 2);
  p.vsT = (bf16_t*)take((size_t)T_TOK * 256 * 2);
  p.kw = (bf16_t*)take((size_t)T_TOK * 256 * 2);
  p.vwT = (bf16_t*)take((size_t)T_TOK * 256 * 2);
  p.kcb = (bf16_t*)take((size_t)8 * 128 * 128 * 2);
  p.vcT = (bf16_t*)take((size_t)8 * 128 * 128 * 2);
  p.c1 = (bf16_t*)take((size_t)16 * 128 * 128 * 2);
  p.w1T = (bf16_t*)take((size_t)2 * 128 * 4096 * 2);
  p.w2T = (bf16_t*)take((size_t)2 * 128 * 128 * 2);
  p.hn = (bf16_t*)take((size_t)T_TOK * DM * 2);
  p.omix = (bf16_t*)take((size_t)T_TOK * DM * 2);
  p.memn = (bf16_t*)take((size_t)1024 * DM * 2);
  p.omem = (bf16_t*)take((size_t)T_TOK * 512 * 2);
  p.WinT = (bf16_t*)take((size_t)5760 * DM * 2);
  p.WoutT = (bf16_t*)take((size_t)DM * DM * 2);
  p.WpqT = (bf16_t*)take((size_t)DM * DM * 2);
  p.WmqT = (bf16_t*)take((size_t)512 * DM * 2);
  p.WmkT = (bf16_t*)take((size_t)512 * DM * 2);
  p.WmvT = (bf16_t*)take((size_t)512 * DM * 2);
  p.WmoT = (bf16_t*)take((size_t)DM * 512 * 2);
  p.qmemb = (bf16_t*)take((size_t)T_TOK * 512 * 2);
  p.kmemb = (bf16_t*)take((size_t)1024 * 512 * 2);
  p.vmemT = (bf16_t*)take((size_t)1024 * 512 * 2);
  p.qsb = (bf16_t*)take((size_t)T_TOK * 1024 * 2);
  p.ksb = (bf16_t*)take((size_t)T_TOK * 1024 * 2);
  p.vsbT = (bf16_t*)take((size_t)T_TOK * 1024 * 2);
  p.pu8 = (unsigned char*)take((size_t)16384 * 1024);
  p.pv8 = (unsigned char*)take((size_t)16384 * 1024);
  p.su8 = (float*)take(16384 * 4);
  p.sv8 = (float*)take(16384 * 4);
  p.subkb = (bf16_t*)take((size_t)16 * 128 * 128 * 2);
  static int grid_blocks = 0;
  if (!grid_blocks) {
    int dev = 0, cus = 0, per_cu = 0;
    (void)hipGetDevice(&dev);
    (void)hipDeviceGetAttribute(&cus, hipDeviceAttributeMultiprocessorCount, dev);
    (void)hipOccupancyMaxActiveBlocksPerMultiprocessor(&per_cu, mega, 512, 0);
    if (per_cu > 1) per_cu = 1;
    if (per_cu < 1) per_cu = 1;
    grid_blocks = cus * per_cu;
  }
  void* args[] = {&p};
  hipError_t e = hipLaunchCooperativeKernel((void*)mega, dim3(grid_blocks), dim3(512), args, 0, stream);
  if (e != hipSuccess) fprintf(stderr, "cooperative launch failed: %s (grid %d)\n", hipGetErrorString(e), grid_blocks);
}
```

```cpp
#include <hip/hip_runtime.h>
#include <hip/hip_cooperative_groups.h>
#include <cstdio>
namespace cg = cooperative_groups;
#include <stdint.h>

#define SEQ 2048
#define NBATCH 4
#define T_TOK 8192
#define DM 2048
#define INC 5656
#define C_QN 0
#define C_KC 1024
#define C_VC 1280
#define C_KS 1536
#define C_VS 1792
#define C_KW 2048
#define C_VW 2304
#define C_GT 2560
#define C_QSB 2584
#define C_KSB 3608
#define C_VSB 4632
#define ATT_SCALE 0.08838834764831845f
#define LOG2E 1.4426950408889634f
#define ATT_SCALE2 (ATT_SCALE * LOG2E)
#define RMS_EPS 1e-6f

typedef unsigned short bf16_t;
typedef __attribute__((ext_vector_type(8))) short bf16x8;
typedef __attribute__((ext_vector_type(16))) float f32x16;
typedef __attribute__((ext_vector_type(2))) __bf16 bf16v2;
typedef __attribute__((ext_vector_type(4))) unsigned u32x4;
typedef __attribute__((ext_vector_type(4))) int i32x4_t;
typedef __attribute__((ext_vector_type(8))) int i32x8_t;

struct P {
  const float *x, *mem, *t5, *norm_mix, *w_in, *pos_k, *w1_k, *w2_k, *pos_v, *w1_v, *w2_v, *w_out,
      *norm_mq, *norm_mkv, *w_mq, *w_mk, *w_mv, *w_mo, *norm_ffn, *w_pq, *subk, *pu, *pv, *norm_final;
  float* out;
  float *scores, *gates, *part, *posb, *rowss;
  unsigned* bar;
  bf16_t *hn, *omix, *memn, *omem;
  bf16_t *WinT, *WoutT, *WpqT, *WmqT, *WmkT, *WmvT, *WmoT;
  bf16_t *qmemb, *kmemb, *vmemT;
  bf16_t *qsb, *ksb, *vsbT;
  bf16_t* subkb;
  unsigned char *pu8, *pv8;
  float *su8, *sv8;
  bf16_t *qn, *kcin, *vcin, *ks, *vsT, *kw, *vwT, *kcb, *vcT, *c1, *w1T, *w2T;
  float* cacc;
  unsigned* ccnt;
};

__device__ __forceinline__ int opq(int v) { asm volatile("" : "+v"(v)); return v; }
#define LAS __attribute__((address_space(3)))
#define VHALF_BYTES 73728
#define VCNT_OFF (2 * VHALF_BYTES)
__device__ __forceinline__ int VT() { return opq(threadIdx.x) & 255; }
__device__ __forceinline__ int VB() { return (int)blockIdx.x * 2 + (int)(threadIdx.x >> 8); }
__device__ __forceinline__ int VG() { return (int)gridDim.x * 2; }
__device__ __forceinline__ void vbar_wait() {
  if ((threadIdx.x & 63) == 0) {
    LAS unsigned* c = (LAS unsigned*)(unsigned)(VCNT_OFF + 64 * (int)(threadIdx.x >> 8));
    const unsigned old = __hip_atomic_fetch_add(c, 1u, __ATOMIC_RELAXED, __HIP_MEMORY_SCOPE_WORKGROUP);
    const unsigned target = (old & ~3u) + 4u;
    while (__hip_atomic_load(c, __ATOMIC_RELAXED, __HIP_MEMORY_SCOPE_WORKGROUP) < target) __builtin_amdgcn_s_sleep(0);
  }
}
__device__ __forceinline__ void vsync() {
  __builtin_amdgcn_fence(__ATOMIC_RELEASE, "workgroup");
  vbar_wait();
  __builtin_amdgcn_fence(__ATOMIC_ACQUIRE, "workgroup");
}
__device__ __forceinline__ void vsync_raw() {
  asm volatile("" ::: "memory");
  vbar_wait();
  asm volatile("" ::: "memory");
}

__device__ __forceinline__ unsigned pack2(float a, float b) {
  bf16v2 r = {(__bf16)a, (__bf16)b};
  return *(unsigned*)&r;
}
__device__ __forceinline__ bf16_t f2bf(float a) {
  __bf16 r = (__bf16)a;
  return *(bf16_t*)&r;
}
__device__ __forceinline__ int perm16(int s) { return (s & ~12) | ((s & 4) << 1) | ((s & 8) >> 1); }
__device__ __forceinline__ float bf2f(bf16_t u) { return __uint_as_float((unsigned)u << 16); }

__device__ __forceinline__ float wave_max(float v) {
  for (int o = 32; o > 0; o >>= 1) v = fmaxf(v, __shfl_xor(v, o));
  return v;
}
__device__ __forceinline__ float wave_sum(float v) {
  for (int o = 32; o > 0; o >>= 1) v += __shfl_xor(v, o);
  return v;
}
__device__ __forceinline__ void wave_argmax(float& v, int& i) {
  for (int o = 32; o > 0; o >>= 1) {
    float ov = __shfl_xor(v, o);
    int oi = __shfl_xor(i, o);
    if (ov > v || (ov == v && oi < i)) { v = ov; i = oi; }
  }
}
__device__ __forceinline__ float gelu_tanh(float x) {
  return 0.5f * x * (1.f + tanhf(0.7978845608028654f * (x + 0.044715f * x * x * x)));
}
__device__ __forceinline__ float gelu_fast(float x) {
  const float y = 1.5957691216057308f * (x + 0.044715f * x * x * x);
  return x / (1.f + __expf(-y));
}
__device__ __forceinline__ int t5_bucket(int n) {
  if (n < 16) return n < 0 ? 0 : n;
  int b = 16;
  b += (n >= 19); b += (n >= 21); b += (n >= 24); b += (n >= 27); b += (n >= 31); b += (n >= 35);
  b += (n >= 40); b += (n >= 46); b += (n >= 52); b += (n >= 59); b += (n >= 67); b += (n >= 77);
  b += (n >= 87); b += (n >= 99); b += (n >= 113);
  return b;
}
__device__ __forceinline__ float log_sigmoid(float x) {
  return fminf(x, 0.f) - log1pf(expf(-fabsf(x)));
}

__device__ __forceinline__ void ph_rmsnorm(const float* src, const float* gain, bf16_t* dst, int rows) {
  int lane = VT() & 63, wv = VT() >> 6;
  for (int r = VB() * 4 + wv; r < rows; r += VG() * 4) {
    const float4* s4 = (const float4*)(src + (size_t)r * DM);
    float4 v[8];
    float ss = 0.f;
#pragma unroll
    for (int i = 0; i < 8; ++i) {
      v[i] = s4[i * 64 + lane];
      ss += v[i].x * v[i].x + v[i].y * v[i].y + v[i].z * v[i].z + v[i].w * v[i].w;
    }
    ss = wave_sum(ss);
    float rs = rsqrtf(ss * (1.f / DM) + RMS_EPS);
    uint2* d2 = (uint2*)(dst + (size_t)r * DM);
    const float4* g4 = (const float4*)gain;
#pragma unroll
    for (int i = 0; i < 8; ++i) {
      float4 g = g4[i * 64 + lane];
      uint2 o;
      o.x = pack2(v[i].x * rs * g.x, v[i].y * rs * g.y);
      o.y = pack2(v[i].z * rs * g.z, v[i].w * rs * g.w);
      d2[i * 64 + lane] = o;
    }
  }
}

template <bool CMAP>
__device__ __forceinline__ void ph_transpose(float* smem, const float* W, int K, int N, int Npad, bf16_t* Wt,
                                             int vblock = -2, int nvb = 0, const float* gk = nullptr) {
  typedef __attribute__((ext_vector_type(4))) float f32x4;
  float (*tl)[65] = (float (*)[65])smem;
  if (vblock == -1) return;
  const int b0 = (vblock >= 0) ? vblock : VB(), bstride = (vblock >= 0) ? nvb : VG();
  const int tid = VT();
  const int nk = K / 64, nn = Npad / 64;
  for (int tile = b0; tile < nk * nn; tile += bstride) {
    const int k0 = (tile % nk) * 64, n0 = (tile / nk) * 64;
    const int kr = tid >> 4, n4 = (tid & 15) * 4;
    int sc = n0 + n4;
    if (CMAP) sc = (sc < 2560) ? sc : (sc < 5632) ? sc + 24 : (sc < 5656) ? sc - 5632 + 2560 : N;
#pragma unroll
    for (int i = 0; i < 4; ++i) {
      const int k = kr + 16 * i;
      f32x4 v = {0.f, 0.f, 0.f, 0.f};
      if (sc < N) v = *(const f32x4*)(W + (size_t)(k0 + k) * N + sc);
      if (gk) v *= gk[k0 + k];
      tl[k][n4 + 0] = v[0]; tl[k][n4 + 1] = v[1]; tl[k][n4 + 2] = v[2]; tl[k][n4 + 3] = v[3];
    }
    vsync();
    int n = tid >> 2, kc = (tid & 3) * 16;
    unsigned w[8];
#pragma unroll
    for (int i = 0; i < 8; ++i) w[i] = pack2(tl[kc + 2 * i][n], tl[kc + 2 * i + 1][n]);
    uint4* dst = (uint4*)(Wt + (size_t)(n0 + n) * K + k0 + kc);
    dst[0] = make_uint4(w[0], w[1], w[2], w[3]);
    dst[1] = make_uint4(w[4], w[5], w[6], w[7]);
    vsync();
  }
}

__device__ __forceinline__ int lds_off(int row, int chunk) { return row * 128 + ((chunk ^ ((row >> 1) & 7)) << 4); }

template <bool TR, bool VEC = false, class Epi>
__device__ __forceinline__ void gemm_tile_bf16(const bf16_t* xp, int ldx, const bf16_t* yp, int ldy, int K, char* lds,
                                               Epi epi) {
  const int tid = VT(), lane = tid & 63, wv = tid >> 6;
  const int wr = wv >> 1, wc = wv & 1;
  f32x16 acc[2][2];
#pragma unroll
  for (int i = 0; i < 2; ++i)
#pragma unroll
    for (int j = 0; j < 2; ++j)
#pragma unroll
      for (int r = 0; r < 16; ++r) acc[i][j][r] = 0.f;
  const int prow = lane >> 3, pch = lane & 7;
  const bf16_t* xs[4];
  const bf16_t* ys[4];
#pragma unroll
  for (int ps = 0; ps < 4; ++ps) {
    const int row = (wv * 4 + ps) * 8 + prow;
    const int c = pch ^ ((row >> 1) & 7);
    xs[ps] = xp + (size_t)row * ldx + c * 8;
    ys[ps] = yp + (size_t)row * ldy + c * 8;
  }
  char* const mydst = lds + wv * 4096 + lane * 16;
#define GEMM_ISSUE(k0, bufoff)                                                                                              \
  _Pragma("unroll") for (int ps = 0; ps < 4; ++ps) {                                                                        \
    __builtin_amdgcn_global_load_lds((const unsigned*)(xs[ps] + (k0)), (unsigned*)(mydst + (bufoff) + ps * 1024), 16, 0, 0);         \
    __builtin_amdgcn_global_load_lds((const unsigned*)(ys[ps] + (k0)), (unsigned*)(mydst + (bufoff) + 16384 + ps * 1024), 16, 0, 0); \
  }
#define GEMM_COMPUTE(bufoff)                                                                                     \
  _Pragma("unroll") for (int kk = 0; kk < 4; ++kk) {                                                             \
    bf16x8 a[2], b[2];                                                                                           \
    const int ch = kk * 2 + (lane >> 5);                                                                         \
    _Pragma("unroll") for (int i = 0; i < 2; ++i) {                                                              \
      a[i] = *(const bf16x8*)(lds + (bufoff) + (TR ? 16384 : 0) + lds_off(wr * 64 + i * 32 + (lane & 31), ch)); \
      b[i] = *(const bf16x8*)(lds + (bufoff) + (TR ? 0 : 16384) + lds_off(wc * 64 + i * 32 + (lane & 31), ch)); \
    }                                                                                                            \
    _Pragma("unroll") for (int i = 0; i < 2; ++i)                                                                \
      _Pragma("unroll") for (int j = 0; j < 2; ++j)                                                              \
        acc[i][j] = __builtin_amdgcn_mfma_f32_32x32x16_bf16(a[i], b[j], acc[i][j], 0, 0, 0);                    \
  }
  vsync();
  GEMM_ISSUE(0, 0)
  for (int k0 = 0; k0 < K; k0 += 128) {
    asm volatile("s_waitcnt vmcnt(0)" ::: "memory");
    vsync();
    GEMM_ISSUE(k0 + 64, 32768)
    GEMM_COMPUTE(0)
    asm volatile("s_waitcnt vmcnt(0)" ::: "memory");
    vsync();
    if (k0 + 128 < K) { GEMM_ISSUE(k0 + 128, 0) }
    GEMM_COMPUTE(32768)
  }
#undef GEMM_ISSUE
#undef GEMM_COMPUTE
  int lane2 = lane;
  asm volatile("" : "+v"(lane2));
  if constexpr (VEC) {
    typedef __attribute__((ext_vector_type(4))) float f32x4;
    vsync();
    float* wl = (float*)lds + wv * (32 * 68);
    const int hh2 = lane2 >> 5, cl = lane2 & 31;
#pragma unroll
    for (int i = 0; i < 2; ++i) {
#pragma unroll
      for (int j = 0; j < 2; ++j)
#pragma unroll
        for (int r = 0; r < 16; ++r) wl[((r & 3) + 8 * (r >> 2) + 4 * hh2) * 68 + j * 32 + cl] = acc[i][j][r];
      __builtin_amdgcn_wave_barrier();
#pragma unroll
      for (int k = 0; k < 4; ++k) {
        const int row = (lane2 >> 3) + 8 * k, c8 = (lane2 & 7) * 8;
        const f32x4 lo = *(const f32x4*)&wl[row * 68 + c8];
        const f32x4 hi = *(const f32x4*)&wl[row * 68 + c8 + 4];
        epi(wr * 64 + i * 32 + row, wc * 64 + c8, lo, hi);
      }
      __builtin_amdgcn_wave_barrier();
    }
  } else {
#pragma unroll
    for (int i = 0; i < 2; ++i)
#pragma unroll
      for (int j = 0; j < 2; ++j)
#pragma unroll
        for (int r = 0; r < 16; ++r) {
          int rr = wr * 64 + i * 32 + (r & 3) + 8 * (r >> 2) + 4 * (lane2 >> 5);
          int cc = wc * 64 + j * 32 + (lane2 & 31);
          epi(rr, cc, acc[i][j][r]);
        }
  }
}

typedef __attribute__((ext_vector_type(4))) float f32x4_e;
__device__ __forceinline__ void st_bf16x8(bf16_t* dst, f32x4_e lo, f32x4_e hi) {
  u32x4 o;
  o[0] = pack2(lo[0], lo[1]); o[1] = pack2(lo[2], lo[3]); o[2] = pack2(hi[0], hi[1]); o[3] = pack2(hi[2], hi[3]);
  *(u32x4*)dst = o;
}

__device__ __forceinline__ int lds_off32(int row, int chunk) { return row * 64 + ((chunk ^ ((row >> 2) & 3)) << 4); }

template <class Epi>
__device__ __forceinline__ void gemm_tile_big(const bf16_t* xp, int ldx, const bf16_t* yp, int ldy, int K, char* lds,
                                              Epi epi) {
  const int tid = VT(), lane = tid & 63, wv = tid >> 6;
  f32x16 acc[2][4];
#pragma unroll
  for (int i = 0; i < 2; ++i)
#pragma unroll
    for (int j = 0; j < 4; ++j)
#pragma unroll
      for (int r = 0; r < 16; ++r) acc[i][j][r] = 0.f;
  const int prow = lane >> 2, pch = lane & 3;
  const bf16_t* xs[4];
  const bf16_t* ys[2];
#pragma unroll
  for (int ps = 0; ps < 4; ++ps) {
    const int row = (wv * 4 + ps) * 16 + prow;
    xs[ps] = xp + (size_t)row * ldx + (pch ^ ((row >> 2) & 3)) * 8;
  }
#pragma unroll
  for (int ps = 0; ps < 2; ++ps) {
    const int row = (wv * 2 + ps) * 16 + prow;
    ys[ps] = yp + (size_t)row * ldy + (pch ^ ((row >> 2) & 3)) * 8;
  }
  char* const xdst = lds + wv * 4096 + lane * 16;
  char* const ydst = lds + 16384 + wv * 2048 + lane * 16;
#define BIG_ISSUE(k0, st)                                                                                                      \
  _Pragma("unroll") for (int ps = 0; ps < 4; ++ps)                                                                             \
    __builtin_amdgcn_global_load_lds((const unsigned*)(xs[ps] + (k0)), (unsigned*)(xdst + (st) + ps * 1024), 16, 0, 0);        \
  _Pragma("unroll") for (int ps = 0; ps < 2; ++ps)                                                                             \
    __builtin_amdgcn_global_load_lds((const unsigned*)(ys[ps] + (k0)), (unsigned*)(ydst + (st) + ps * 1024), 16, 0, 0);
#define DSR(dst, addr, off) asm volatile("ds_read_b128 %0, %1 offset:%2" : "=v"(dst) : "v"(addr), "i"(off) : "memory")
#define WAIT1(n, x) asm volatile("s_waitcnt lgkmcnt(" #n ")" : "+v"(x))
#define WAIT2(n, x, y) asm volatile("s_waitcnt lgkmcnt(" #n ")" : "+v"(x), "+v"(y))
#define MF(acc_, a_, b_) acc_ = __builtin_amdgcn_mfma_f32_32x32x16_bf16(a_, b_, acc_, 0, 0, 0)
#define BIG_COMPUTE(st)                                                                                   \
  {                                                                                                       \
    bf16x8 a00, a01, a10, a11, b00, b01, b02, b03, b10, b11, b12, b13;                                    \
    const unsigned aa0 = abase0 + (st), aa1 = abase1 + (st), bb0 = bbase0 + (st), bb1 = bbase1 + (st);    \
    DSR(a00, aa0, 0); DSR(b00, bb0, 0); DSR(b01, bb0, 2048); DSR(b02, bb0, 4096); DSR(b03, bb0, 6144);    \
    DSR(a01, aa0, 2048);                                                                                  \
    DSR(a10, aa1, 0); DSR(b10, bb1, 0); DSR(b11, bb1, 2048); DSR(b12, bb1, 4096); DSR(b13, bb1, 6144);    \
    DSR(a11, aa1, 2048);                                                                                  \
    WAIT2(10, a00, b00); MF(acc[0][0], a00, b00);                                                         \
    WAIT1(9, b01); MF(acc[0][1], a00, b01);                                                               \
    WAIT1(8, b02); MF(acc[0][2], a00, b02);                                                               \
    WAIT1(7, b03); MF(acc[0][3], a00, b03);                                                               \
    WAIT1(6, a01); MF(acc[1][0], a01, b00); MF(acc[1][1], a01, b01); MF(acc[1][2], a01, b02); MF(acc[1][3], a01, b03); \
    WAIT2(4, a10, b10); MF(acc[0][0], a10, b10);                                                          \
    WAIT1(3, b11); MF(acc[0][1], a10, b11);                                                               \
    WAIT1(2, b12); MF(acc[0][2], a10, b12);                                                               \
    WAIT1(1, b13); MF(acc[0][3], a10, b13);                                                               \
    WAIT1(0, a11); MF(acc[1][0], a11, b10); MF(acc[1][1], a11, b11); MF(acc[1][2], a11, b12); MF(acc[1][3], a11, b13); \
  }
  const unsigned ldsb = (unsigned)(size_t)(__attribute__((address_space(3))) char*)lds;
  const unsigned abase0 = ldsb + lds_off32(wv * 64 + (lane & 31), 0 + (lane >> 5));
  const unsigned abase1 = ldsb + lds_off32(wv * 64 + (lane & 31), 2 + (lane >> 5));
  const unsigned bbase0 = ldsb + 16384 + lds_off32((lane & 31), 0 + (lane >> 5));
  const unsigned bbase1 = ldsb + 16384 + lds_off32((lane & 31), 2 + (lane >> 5));
  const int nsteps = K >> 5;
  vsync();
  BIG_ISSUE(0, 0)
  BIG_ISSUE(32, 24576)
  int cur = 0, nx2 = 49152;
  for (int t = 0; t < nsteps - 2; ++t) {
    asm volatile("s_waitcnt vmcnt(6)" ::: "memory");
    vsync_raw();
    BIG_ISSUE((t + 2) * 32, nx2)
    BIG_COMPUTE(cur)
    cur = (cur == 49152) ? 0 : cur + 24576;
    nx2 = (nx2 == 49152) ? 0 : nx2 + 24576;
  }
  asm volatile("s_waitcnt vmcnt(6)" ::: "memory");
  vsync_raw();
  BIG_COMPUTE(cur)
  cur = (cur == 49152) ? 0 : cur + 24576;
  asm volatile("s_waitcnt vmcnt(0)" ::: "memory");
  vsync_raw();
  BIG_COMPUTE(cur)
#undef BIG_ISSUE
#undef BIG_COMPUTE
#undef DSR
#undef WAIT1
#undef WAIT2
#undef MF
  const int lane2 = opq(lane);
  typedef __attribute__((ext_vector_type(4))) float f32x4;
  vsync();
  float* wl = (float*)lds + wv * (32 * 68);
  const int hh2 = lane2 >> 5, cl = lane2 & 31;
#pragma unroll
  for (int i = 0; i < 2; ++i)
#pragma unroll
    for (int jh = 0; jh < 2; ++jh) {
#pragma unroll
      for (int j = 0; j < 2; ++j)
#pragma unroll
        for (int r = 0; r < 16; ++r) wl[((r & 3) + 8 * (r >> 2) + 4 * hh2) * 68 + j * 32 + cl] = acc[i][jh * 2 + j][r];
      __builtin_amdgcn_wave_barrier();
#pragma unroll
      for (int k = 0; k < 4; ++k) {
        const int row = (lane2 >> 3) + 8 * k, c8 = (lane2 & 7) * 8;
        const f32x4 lo = *(const f32x4*)&wl[row * 68 + c8];
        const f32x4 hi = *(const f32x4*)&wl[row * 68 + c8 + 4];
        epi(wv * 64 + i * 32 + row, jh * 64 + c8, lo, hi);
      }
      __builtin_amdgcn_wave_barrier();
    }
}

template <class Epi>
__device__ __forceinline__ void ph_gemm_big(const bf16_t* A, int lda, const bf16_t* Wt, int ldw, int M, int N, int K,
                                            char* lds, Epi epi) {
  const int ntm = M / 256, ntn = N / 128;
  const int npm = (ntm + 7) / 8, npn = (ntn + 7) / 8;
  const int nslots = ((npm * npn * 64 + 511) / 512) * 512;
  for (int u = VB(); u < nslots; u += VG()) {
    int v = (u & 7) * 64 + ((u >> 3) & 63) + (u & ~511);
    int patch = v >> 6, w = v & 63;
    int tm = (patch % npm) * 8 + (w & 7);
    int tn = (patch / npm) * 8 + (w >> 3);
    if (tm >= ntm || tn >= ntn) continue;
    const int m0 = tm * 256, n0 = tn * 128;
    gemm_tile_big(A + (size_t)m0 * lda, lda, Wt + (size_t)n0 * ldw, ldw, K, lds,
                  [&](int r, int c, f32x4_e lo, f32x4_e hi) { epi(m0 + r, n0 + c, lo, hi); });
  }
}

template <int PM = 0, class Epi>
__device__ __forceinline__ void gemm_tile_huge(const bf16_t* xp, int ldx, const bf16_t* yp, int ldy, int K, char* lds0,
                                               Epi epi) {
  const int tid = opq(threadIdx.x), lane = tid & 63, wv = tid >> 6;
  const int wr = wv >> 2, wc = wv & 3;
  f32x16 acc[4][2];
#pragma unroll
  for (int i = 0; i < 4; ++i)
#pragma unroll
    for (int j = 0; j < 2; ++j)
#pragma unroll
      for (int r = 0; r < 16; ++r) acc[i][j][r] = 0.f;
  const int prow = lane >> 3, pch = lane & 7;
  const bf16_t* xs[4];
  const bf16_t* ys[4];
#pragma unroll
  for (int ps = 0; ps < 4; ++ps) {
    const int row = (wv * 4 + ps) * 8 + prow;
    const int c = pch ^ ((row >> 1) & 7);
    xs[ps] = xp + (size_t)row * ldx + c * 8;
    ys[ps] = yp + (size_t)row * ldy + c * 8;
  }
  char* const xdst = lds0 + wv * 4096 + lane * 16;
#define HUGE_ISSUE(k0, st)                                                                                                          \
  _Pragma("unroll") for (int ps = 0; ps < 4; ++ps) {                                                                                \
    __builtin_amdgcn_global_load_lds((const unsigned*)(xs[ps] + (k0)), (unsigned*)(xdst + (st) + ps * 1024), 16, 0, 0);             \
    __builtin_amdgcn_global_load_lds((const unsigned*)(ys[ps] + (k0)), (unsigned*)(xdst + (st) + 32768 + ps * 1024), 16, 0, 0);     \
  }
#define HDSR(dst, addr, off) asm volatile("ds_read_b128 %0, %1 offset:%2" : "=v"(dst) : "v"(addr), "i"(off) : "memory")
#define HREAD(S, ab, bb)                                                                            \
  HDSR(S##a0, ab, 0); HDSR(S##b0, bb, 0); HDSR(S##b1, bb, 4096); HDSR(S##a1, ab, 4096);             \
  HDSR(S##a2, ab, 8192); HDSR(S##a3, ab, 12288);
#define HWAIT(n, S)                                                                                 \
  asm volatile("s_waitcnt lgkmcnt(" #n ")" : "+v"(S##a0), "+v"(S##a1), "+v"(S##a2), "+v"(S##a3), "+v"(S##b0), "+v"(S##b1))
#define HMF(i, j, S) acc[i][j] = __builtin_amdgcn_mfma_f32_32x32x16_bf16(S##a##i, S##b##j, acc[i][j], 0, 0, 0)
#define HMMA(S) HMF(0, 0, S); HMF(0, 1, S); HMF(1, 0, S); HMF(1, 1, S); HMF(2, 0, S); HMF(2, 1, S); HMF(3, 0, S); HMF(3, 1, S);
  const unsigned ldsb = (unsigned)(size_t)(LAS char*)lds0;
  const int frow = lane & 31, fh = lane >> 5;
  const unsigned ab0 = ldsb + lds_off(wr * 128 + frow, 0 + fh), ab1 = ldsb + lds_off(wr * 128 + frow, 2 + fh);
  const unsigned ab2 = ldsb + lds_off(wr * 128 + frow, 4 + fh), ab3 = ldsb + lds_off(wr * 128 + frow, 6 + fh);
  const unsigned bb0 = ldsb + 32768 + lds_off(wc * 64 + frow, 0 + fh), bb1 = ldsb + 32768 + lds_off(wc * 64 + frow, 2 + fh);
  const unsigned bb2 = ldsb + 32768 + lds_off(wc * 64 + frow, 4 + fh), bb3 = ldsb + 32768 + lds_off(wc * 64 + frow, 6 + fh);
  __syncthreads();
  HUGE_ISSUE(0, 0)
  bf16x8 Ea0, Ea1, Ea2, Ea3, Eb0, Eb1, Oa0, Oa1, Oa2, Oa3, Ob0, Ob1;
  asm volatile("s_waitcnt vmcnt(0)" ::: "memory");
  __syncthreads();
  if (64 < K) { HUGE_ISSUE(64, 65536u) }
  HREAD(E, ab0, bb0)
  HREAD(O, ab1, bb1)
  HWAIT(6, E); HMMA(E)
  HREAD(E, ab2, bb2)
  HWAIT(6, O); HMMA(O)
  HREAD(O, ab3, bb3)
  HWAIT(6, E); HMMA(E)
  HWAIT(0, O);
  unsigned st = 65536u;
  for (int k0 = 64; k0 < K; k0 += 64) {
    asm volatile("s_waitcnt vmcnt(0)" ::: "memory");
    __syncthreads();
    const unsigned a0 = ab0 + st, a1 = ab1 + st, a2 = ab2 + st, a3 = ab3 + st;
    const unsigned b0 = bb0 + st, b1 = bb1 + st, b2 = bb2 + st, b3 = bb3 + st;
    HREAD(E, a0, b0)
    HWAIT(6, O); HMMA(O)
    if (k0 + 64 < K) { HUGE_ISSUE(k0 + 64, st ^ 65536u) }
    HREAD(O, a1, b1)
    HWAIT(6, E); HMMA(E)
    HREAD(E, a2, b2)
    HWAIT(6, O); HMMA(O)
    HREAD(O, a3, b3)
    HWAIT(6, E); HMMA(E)
    HWAIT(0, O);
    st ^= 65536u;
  }
  HMMA(O)
#undef HUGE_ISSUE
#undef HDSR
#undef HREAD
#undef HWAIT
#undef HMF
#undef HMMA
  const int lane2 = opq(lane);
  typedef __attribute__((ext_vector_type(4))) float f32x4;
  __syncthreads();
  float* wl = (float*)lds0 + wv * (32 * 68);
  const int hh2 = lane2 >> 5, cl = lane2 & 31;
#pragma unroll
  for (int i = 0; i < 4; ++i) {
#pragma unroll
    for (int j = 0; j < 2; ++j)
#pragma unroll
      for (int r = 0; r < 16; ++r) wl[((r & 3) + 8 * (r >> 2) + 4 * hh2) * 68 + j * 32 + cl] = acc[i][j][r];
    __builtin_amdgcn_wave_barrier();
#pragma unroll
    for (int k = 0; k < 4; ++k) {
      const int row = (lane2 >> 3) + 8 * k, c8 = (lane2 & 7) * 8;
      const f32x4 lo = *(const f32x4*)&wl[row * 68 + c8];
      const f32x4 hi = *(const f32x4*)&wl[row * 68 + c8 + 4];
      if (PM != 3) epi(wr * 128 + i * 32 + row, wc * 64 + c8, lo, hi);
    }
    __builtin_amdgcn_wave_barrier();
  }
  __syncthreads();
}

template <class Epi>
__device__ __forceinline__ void ph_gemm_huge(const bf16_t* A, int lda, const bf16_t* Wt, int ldw, int M, int N, int K,
                                             char* lds0, Epi epi) {
  const int ntm = M / 256, ntn = N / 256;
  for (int u = (int)blockIdx.x; u < ntm * ntn; u += (int)gridDim.x) {
    const int x = u & 7, i = (u >> 3) & 31, rnd = u >> 8;
    const int tm = (x & 3) * 8 + (i & 7), tn = rnd * 8 + (x >> 2) * 4 + (i >> 3);
    if (tm >= ntm || tn >= ntn) continue;
    const int m0 = tm * 256, n0 = tn * 256;
    gemm_tile_huge(A + (size_t)m0 * lda, lda, Wt + (size_t)n0 * ldw, ldw, K, lds0,
                   [&](int r, int c, f32x4_e lo, f32x4_e hi) { epi(m0 + r, n0 + c, lo, hi); });
  }
}

__device__ __forceinline__ void norm_feed(const f32x4_e h0, const f32x4_e h1, const float* gain, int n, bf16_t* hn_row,
                                          float* rowss_m) {
  const f32x4_e g0 = *(const f32x4_e*)(gain + n), g1 = *(const f32x4_e*)(gain + n + 4);
  st_bf16x8(hn_row + n, h0 * g0, h1 * g1);
  float ss = h0[0] * h0[0] + h0[1] * h0[1] + h0[2] * h0[2] + h0[3] * h0[3] + h1[0] * h1[0] + h1[1] * h1[1] + h1[2] * h1[2] + h1[3] * h1[3];
  ss += __shfl_xor(ss, 1);
  ss += __shfl_xor(ss, 2);
  ss += __shfl_xor(ss, 4);
  if (((VT()) & 7) == 0) atomicAdd(rowss_m, ss);
}

__device__ __forceinline__ void resid_feed(const f32x4_e h0, const f32x4_e h1, int n, bf16_t* hb_row, float* rowss_m) {
  st_bf16x8(hb_row + n, h0, h1);
  float ss = h0[0] * h0[0] + h0[1] * h0[1] + h0[2] * h0[2] + h0[3] * h0[3] + h1[0] * h1[0] + h1[1] * h1[1] + h1[2] * h1[2] + h1[3] * h1[3];
  ss += __shfl_xor(ss, 1);
  ss += __shfl_xor(ss, 2);
  ss += __shfl_xor(ss, 4);
  if (((VT()) & 7) == 0) atomicAdd(rowss_m, ss);
}

template <bool VEC = false, class Epi>
__device__ __forceinline__ void ph_gemm_bf16(const bf16_t* A, int lda, const bf16_t* Wt, int ldw, int M, int N, int K,
                                             char* lds, Epi epi, int vblock = -2) {
  const int ntm = M / 128, ntn = N / 128;
  const int npm = (ntm + 7) / 8, npn = (ntn + 7) / 8;
  const int nslots = ((npm * npn * 64 + 511) / 512) * 512;
  if (vblock == -1) return;
  for (int u = (vblock >= 0 ? vblock : VB()); u < nslots; u += VG()) {
    int v = (u & 7) * 64 + ((u >> 3) & 63) + (u & ~511);
    int patch = v >> 6, w = v & 63;
    int tm = (patch % npm) * 8 + (w & 7);
    int tn = (patch / npm) * 8 + (w >> 3);
    if (tm >= ntm || tn >= ntn) continue;
    const int m0 = tm * 128, n0 = tn * 128;
    if constexpr (VEC)
      gemm_tile_bf16<false, true>(A + (size_t)m0 * lda, lda, Wt + (size_t)n0 * ldw, ldw, K, lds,
                                  [&](int r, int c, f32x4_e lo, f32x4_e hi) { epi(m0 + r, n0 + c, lo, hi); });
    else
      gemm_tile_bf16<false>(A + (size_t)m0 * lda, lda, Wt + (size_t)n0 * ldw, ldw, K, lds,
                            [&](int r, int c, float val) { epi(m0 + r, n0 + c, val); });
  }
}

__device__ __forceinline__ void ph_proj(const P& p, char* lds0, char* lds) {
  for (int u = (int)blockIdx.x; u < 512; u += (int)gridDim.x) {
    const int x = u & 7, i = (u >> 3) & 31, rnd = u >> 8;
    const int tm = (x & 3) * 8 + (i & 7), tp = rnd * 8 + (x >> 2) * 4 + (i >> 3);
    const int tb = tp * 2;
    const int tn = (tb < 14) ? tb : (tb < 16) ? tb + 2 : tb + 4;
    const int m0 = tm * 256, n0 = tn * 128;
    const int b = m0 >> 11, sl = m0 & 2047;
    const bf16_t* A = p.hn + (size_t)m0 * DM;
    const bf16_t* W = p.WinT + (size_t)n0 * DM;
    if (n0 < 1024 || (n0 >= 2560 && n0 < 3584)) {
      bf16_t* dst = (n0 < 1024) ? p.qn + (size_t)m0 * 1024 + n0 : p.qsb + (size_t)m0 * 1024 + (n0 - 2560);
      gemm_tile_huge(A, DM, W, DM, DM, lds0, [&](int r, int c, f32x4_e lo, f32x4_e hi) { st_bf16x8(dst + (size_t)r * 1024 + c, lo, hi); });
    } else if (n0 < 2560) {
      const int seg = (n0 - 1024) >> 8;
      bf16_t* base = (seg == 0) ? p.kcin : (seg == 1) ? p.vcin : (seg == 2) ? p.ks : p.kw;
      bf16_t* dst = base + ((size_t)(b * 2) * SEQ + sl) * 128;
      gemm_tile_huge(A, DM, W, DM, DM, lds0, [&](int r, int c, f32x4_e lo, f32x4_e hi) {
        st_bf16x8(dst + ((size_t)(c >> 7) * SEQ + r) * 128 + (c & 127), lo, hi); });
    } else {
      bf16_t* dst = p.ksb + ((size_t)(b * 8 + ((n0 - 3584) >> 7)) * SEQ + sl) * 128;
      gemm_tile_huge(A, DM, W, DM, DM, lds0, [&](int r, int c, f32x4_e lo, f32x4_e hi) {
        st_bf16x8(dst + ((size_t)(c >> 7) * SEQ + r) * 128 + (c & 127), lo, hi); });
    }
  }
  for (int u = (int)blockIdx.x; u < 192; u += (int)gridDim.x) {
    const int tm = u & 31, tv = u >> 5;
    const int n0 = (tv == 0) ? 1792 : (tv == 1) ? 2304 : 4608 + (tv - 2) * 256;
    const int m0 = tm * 256;
    const int b = m0 >> 11, sl = m0 & 2047;
    bf16_t* vd;
    if (tv < 2) vd = (tv == 0 ? p.vsT : p.vwT) + ((size_t)(b * 2) * 128) * SEQ + sl;
    else vd = p.vsbT + ((size_t)(b * 8 + (tv - 2) * 2) * 128) * SEQ + sl;
    gemm_tile_huge(p.WinT + (size_t)n0 * DM, DM, p.hn + (size_t)m0 * DM, DM, DM, lds0,
                   [&](int r, int c, f32x4_e lo, f32x4_e hi) {
                     bf16_t* row = vd + (size_t)r * SEQ;
                     uint2 wa, wb;
                     wa.x = pack2(lo[0], lo[1]); wa.y = pack2(lo[2], lo[3]);
                     wb.x = pack2(hi[0], hi[1]); wb.y = pack2(hi[2], hi[3]);
                     const int pa = (c & 8) ? c - 4 : c, pb = (c & 8) ? c + 4 : c + 8;
                     *(uint2*)(row + pa) = wa;
                     *(uint2*)(row + pb) = wb; });
  }
  {
    const int vb = VB();
    if (VG() != 512 || vb >= 448) {
      for (int tm = (VG() == 512) ? vb - 448 : vb; tm < 64; tm += (VG() == 512) ? 64 : VG()) {
        const int m0 = tm * 128;
        float* gd = p.gates + (size_t)m0 * 24;
        gemm_tile_bf16<false>(p.hn + (size_t)m0 * DM, DM, p.WinT + (size_t)5632 * DM, DM, DM, lds,
                              [&](int r, int c, float val) { if (c < 24) gd[(size_t)r * 24 + c] = val; });
      }
    }
  }
}

__device__ __forceinline__ void ph_posb(const P& p) {
  const int lane = VT() & 63, wv = VT() >> 6;
  for (int o = VB() * 4 + wv; o < 256; o += VG() * 4) {
    const int which = o >> 7, n = o & 127;
    const float* pos = which ? p.pos_v : p.pos_k;
    const float* w1 = which ? p.w1_v : p.w1_k;
    float acc = 0.f;
    for (int k = lane; k < 4096; k += 64) acc += pos[k] * w1[(size_t)k * 128 + n];
    acc = wave_sum(acc);
    if (lane == 0) p.posb[o] = acc;
  }
}

__device__ __forceinline__ void ph_compress2(const P& p, char* lds, int w0, int wstride) {
  volatile unsigned* lastf = (volatile unsigned*)(lds + 65536);
  for (int w = w0; w < 64; w += wstride) {
    const int item = w >> 2, ks = w & 3;
    const int which = item >> 3, bg = item & 7;
    const bf16_t* src = (which ? p.vcin : p.kcin) + (size_t)bg * SEQ * 128 + ks * 1024;
    const bf16_t* w1t = p.w1T + (size_t)which * 128 * 4096 + ks * 1024;
    const bf16_t* w2t = p.w2T + (size_t)which * 128 * 128;
    const float* posb = p.posb + which * 128;
    bf16_t* c1 = p.c1 + (size_t)item * 128 * 128;
    float* acc = p.cacc + (size_t)item * 16384;
    gemm_tile_bf16<false>(src, 2048, w1t, 4096, 1024, lds, [&](int r, int c, float val) { atomicAdd(acc + r * 128 + c, val); });
    vsync();
    if (VT() == 0) lastf[0] = __hip_atomic_fetch_add(p.ccnt + item, 1u, __ATOMIC_RELAXED, __HIP_MEMORY_SCOPE_AGENT);
    vsync();
    const unsigned arrived = lastf[0];
    vsync();
    if (arrived != 3u) continue;
    for (int idx = VT(); idx < 16384; idx += 256) {
      const float sm = __hip_atomic_load(acc + idx, __ATOMIC_RELAXED, __HIP_MEMORY_SCOPE_AGENT);
      c1[idx] = f2bf(gelu_fast(sm + posb[idx & 127]));
    }
    __threadfence_block();
    vsync();
    if (which == 0) {
      bf16_t* kd = p.kcb + (size_t)bg * 128 * 128;
      gemm_tile_bf16<false>(c1, 128, w2t, 128, 128, lds, [&](int r, int c, float val) { kd[r * 128 + c] = f2bf(val); });
    } else {
      bf16_t* vd = p.vcT + (size_t)bg * 128 * 128;
      gemm_tile_bf16<true>(c1, 128, w2t, 128, 128, lds, [&](int r, int c, float val) { vd[r * 128 + perm16(c)] = f2bf(val); });
    }
  }
}

#define NEG_BIG (-1e30f)

struct KVRegs { u32x4 k0, k1, k2, k3, v0, v1, v2, v3; };

__device__ __forceinline__ int koff(int row, int chunk) { return row * 256 + ((chunk ^ (row & 15)) << 4); }

__device__ __forceinline__ void kv_load(KVRegs& r, const bf16_t* kp, int ldk, const bf16_t* vp, int ldv) {
  const int tid = VT();
  const bf16_t* kg = kp + (size_t)(tid >> 4) * ldk + (tid & 15) * 8;
  r.k0 = *(const u32x4*)kg;
  r.k1 = *(const u32x4*)(kg + (size_t)16 * ldk);
  r.k2 = *(const u32x4*)(kg + (size_t)32 * ldk);
  r.k3 = *(const u32x4*)(kg + (size_t)48 * ldk);
  const bf16_t* vg = vp + (size_t)(tid >> 3) * ldv + (tid & 7) * 8;
  r.v0 = *(const u32x4*)vg;
  r.v1 = *(const u32x4*)(vg + (size_t)32 * ldv);
  r.v2 = *(const u32x4*)(vg + (size_t)64 * ldv);
  r.v3 = *(const u32x4*)(vg + (size_t)96 * ldv);
}
__device__ __forceinline__ void kv_store(const KVRegs& r, char* lk, char* lv) {
  const int tid = VT();
  const int row = tid >> 4, ch = tid & 15;
  *(u32x4*)(lk + koff(row, ch)) = r.k0;
  *(u32x4*)(lk + koff(row + 16, ch)) = r.k1;
  *(u32x4*)(lk + koff(row + 32, ch)) = r.k2;
  *(u32x4*)(lk + koff(row + 48, ch)) = r.k3;
  const int vr = tid >> 3, vc = tid & 7;
  *(u32x4*)(lv + lds_off(vr, vc)) = r.v0;
  *(u32x4*)(lv + lds_off(vr + 32, vc)) = r.v1;
  *(u32x4*)(lv + lds_off(vr + 64, vc)) = r.v2;
  *(u32x4*)(lv + lds_off(vr + 96, vc)) = r.v3;
}

struct QFrag { bf16x8 f0, f1, f2, f3, f4, f5, f6, f7; };
__device__ __forceinline__ void q_load(QFrag& q, const bf16_t* qrow) {
  const int h = (VT() & 63) >> 5;
  const bf16x8* p8 = (const bf16x8*)(qrow + 8 * h);
  q.f0 = p8[0]; q.f1 = p8[2]; q.f2 = p8[4]; q.f3 = p8[6]; q.f4 = p8[8]; q.f5 = p8[10]; q.f6 = p8[12]; q.f7 = p8[14];
}

__device__ __forceinline__ void qk_tile(const QFrag& q, const char* lk, f32x16& s0, f32x16& s1) {
  const int lane = VT() & 63, row = lane & 31, h = lane >> 5;
#pragma unroll
  for (int r = 0; r < 16; ++r) { s0[r] = 0.f; s1[r] = 0.f; }
#define QK_STEP(kk, qf)                                                                  \
  {                                                                                      \
    bf16x8 a0 = *(const bf16x8*)(lk + koff(row, 2 * (kk) + h));                          \
    bf16x8 a1 = *(const bf16x8*)(lk + koff(row + 32, 2 * (kk) + h));                     \
    s0 = __builtin_amdgcn_mfma_f32_32x32x16_bf16(a0, qf, s0, 0, 0, 0);                   \
    s1 = __builtin_amdgcn_mfma_f32_32x32x16_bf16(a1, qf, s1, 0, 0, 0);                   \
  }
  QK_STEP(0, q.f0) QK_STEP(1, q.f1) QK_STEP(2, q.f2) QK_STEP(3, q.f3)
  QK_STEP(4, q.f4) QK_STEP(5, q.f5) QK_STEP(6, q.f6) QK_STEP(7, q.f7)
#undef QK_STEP
}

__device__ __forceinline__ bf16x8 pack8(const f32x16& p, const int base) {
  u32x4 u;
  u[0] = pack2(p[base + 0], p[base + 1]);
  u[1] = pack2(p[base + 2], p[base + 3]);
  u[2] = pack2(p[base + 4], p[base + 5]);
  u[3] = pack2(p[base + 6], p[base + 7]);
  return __builtin_bit_cast(bf16x8, u);
}

typedef __attribute__((ext_vector_type(2))) unsigned u32x2_t;
__device__ __forceinline__ float xhalf_max(float v) {
  const u32x2_t r = __builtin_amdgcn_permlane32_swap(__float_as_uint(v), __float_as_uint(v), false, false);
  return fmaxf(__uint_as_float(r[0]), __uint_as_float(r[1]));
}
__device__ __forceinline__ float xhalf_sum(float v) {
  const u32x2_t r = __builtin_amdgcn_permlane32_swap(__float_as_uint(v), __float_as_uint(v), false, false);
  return __uint_as_float(r[0]) + __uint_as_float(r[1]);
}
__device__ __forceinline__ float xhalf_get(float v, int hh) {
  const u32x2_t r = __builtin_amdgcn_permlane32_swap(__float_as_uint(v), __float_as_uint(v), false, false);
  return hh ? __uint_as_float(r[0]) : __uint_as_float(r[1]);
}
struct OAcc { f32x16 o0, o1, o2, o3; };
__device__ __forceinline__ void oacc_zero(OAcc& o) {
#pragma unroll
  for (int r = 0; r < 16; ++r) { o.o0[r] = 0.f; o.o1[r] = 0.f; o.o2[r] = 0.f; o.o3[r] = 0.f; }
}
__device__ __forceinline__ void oacc_scale(OAcc& o, float a) {
#pragma unroll
  for (int r = 0; r < 16; ++r) { o.o0[r] *= a; o.o1[r] *= a; o.o2[r] *= a; o.o3[r] *= a; }
}

__device__ __forceinline__ void pv_tile(OAcc& o, const char* lv, const f32x16& p0, const f32x16& p1) {
  const int lane = VT() & 63, row = lane & 31, h = lane >> 5;
  const bf16x8 pf0 = pack8(p0, 0), pf1 = pack8(p0, 8), pf2 = pack8(p1, 0), pf3 = pack8(p1, 8);
#define PV_ROW(dd, acc)                                                                                      \
  {                                                                                                          \
    acc = __builtin_amdgcn_mfma_f32_32x32x16_bf16(*(const bf16x8*)(lv + lds_off(32 * (dd) + row, 0 + h)), pf0, acc, 0, 0, 0); \
    acc = __builtin_amdgcn_mfma_f32_32x32x16_bf16(*(const bf16x8*)(lv + lds_off(32 * (dd) + row, 2 + h)), pf1, acc, 0, 0, 0); \
    acc = __builtin_amdgcn_mfma_f32_32x32x16_bf16(*(const bf16x8*)(lv + lds_off(32 * (dd) + row, 4 + h)), pf2, acc, 0, 0, 0); \
    acc = __builtin_amdgcn_mfma_f32_32x32x16_bf16(*(const bf16x8*)(lv + lds_off(32 * (dd) + row, 6 + h)), pf3, acc, 0, 0, 0); \
  }
  PV_ROW(0, o.o0) PV_ROW(1, o.o1) PV_ROW(2, o.o2) PV_ROW(3, o.o3)
#undef PV_ROW
}

typedef __attribute__((ext_vector_type(2))) float f32x2_s;
#define SPAIR(v, i) __builtin_shufflevector(v, v, (i), (i) + 1)
__device__ __forceinline__ void softmax_tile(f32x16& s0, f32x16& s1, float& m, float& l, OAcc& o, const float sc = 1.f,
                                             const float bb = 0.f) {
  float mr = -INFINITY;
#pragma unroll
  for (int r = 0; r < 16; ++r) mr = fmaxf(mr, fmaxf(s0[r], s1[r]));
  float mx = fmaf(mr, sc, bb);
  mx = (mx != mx) ? -INFINITY : mx;
  mx = xhalf_max(fmaxf(mx, NEG_BIG));
  const float mn = fmaxf(m, mx);
  const float alpha = __builtin_amdgcn_exp2f(m - mn);
  const f32x2_s sc2 = {sc, sc}, c2 = {bb - mn, bb - mn};
  f32x2_s ls2 = {0.f, 0.f};
#pragma unroll
  for (int r = 0; r < 16; r += 2) {
    const f32x2_s pa_in = {s0[r], s0[r + 1]}, pb_in = {s1[r], s1[r + 1]};
    const f32x2_s a = __builtin_elementwise_fma(pa_in, sc2, c2);
    const f32x2_s b = __builtin_elementwise_fma(pb_in, sc2, c2);
    const float a0 = __builtin_amdgcn_exp2f(a[0]), a1 = __builtin_amdgcn_exp2f(a[1]);
    const float b0 = __builtin_amdgcn_exp2f(b[0]), b1 = __builtin_amdgcn_exp2f(b[1]);
    s0[r] = a0; s0[r + 1] = a1; s1[r] = b0; s1[r + 1] = b1;
    const f32x2_s pa = {a0, a1}, pb = {b0, b1};
    ls2 = ls2 + pa + pb;
  }
  const float ls = xhalf_sum(ls2[0] + ls2[1]);
  l = l * alpha + ls;
  m = mn;
  if (__any(alpha != 1.f)) oacc_scale(o, alpha);
}

template <class F>
__device__ __forceinline__ void oacc_foreach(const OAcc& o, F f) {
  const int h = (VT() & 63) >> 5;
#pragma unroll
  for (int rho = 0; rho < 4; ++rho) {
    f(0 + 8 * rho + 4 * h, o.o0[4 * rho], o.o0[4 * rho + 1], o.o0[4 * rho + 2], o.o0[4 * rho + 3]);
    f(32 + 8 * rho + 4 * h, o.o1[4 * rho], o.o1[4 * rho + 1], o.o1[4 * rho + 2], o.o1[4 * rho + 3]);
    f(64 + 8 * rho + 4 * h, o.o2[4 * rho], o.o2[4 * rho + 1], o.o2[4 * rho + 2], o.o2[4 * rho + 3]);
    f(96 + 8 * rho + 4 * h, o.o3[4 * rho], o.o3[4 * rho + 1], o.o3[4 * rho + 2], o.o3[4 * rho + 3]);
  }
}

__device__ __forceinline__ void memattn_item(const P& p, char* lds, int item) {
  char* lk = lds;
  char* lv = lds + 16384;
  const int lane = VT() & 63, wv = VT() >> 6;
  {
    const int tb = item % (SEQ / 128);
    const int bh = item / (SEQ / 128);
    const int b = bh >> 2, hd = bh & 3;
    const int t = tb * 128 + wv * 32 + (lane & 31);
    QFrag q;
    q_load(q, p.qmemb + (size_t)(b * SEQ + t) * 512 + hd * 128);
    const bf16_t* kb = p.kmemb + (size_t)bh * 256 * 128;
    const bf16_t* vb = p.vmemT + (size_t)bh * 128 * 256;
    OAcc o;
    oacc_zero(o);
    float m = NEG_BIG, l = 0.f;
    KVRegs kv;
    kv_load(kv, kb, 128, vb, 256);
#pragma unroll 1
    for (int ti = 0; ti < 4; ++ti) {
      vsync();
      kv_store(kv, lk, lv);
      vsync();
      {
        const int tn = (ti + 1 < 4) ? ti + 1 : 3;
        kv_load(kv, kb + (size_t)tn * 64 * 128, 128, vb + tn * 64, 256);
      }
      f32x16 s0, s1;
      qk_tile(q, lk, s0, s1);
      softmax_tile(s0, s1, m, l, o, ATT_SCALE2, 0.f);
      pv_tile(o, lv, s0, s1);
    }
    const float il = 1.f / l;
    const int t2 = tb * 128 + (VT() >> 6) * 32 + (VT() & 31);
    bf16_t* orow = p.omem + (size_t)(b * SEQ + t2) * 512 + hd * 128;
    oacc_foreach(o, [&](int d, float v0, float v1, float v2, float v3) {
      uint2 u;
      u.x = pack2(v0 * il, v1 * il);
      u.y = pack2(v2 * il, v3 * il);
      *(uint2*)(orow + d) = u;
    });
  }
}

__device__ __forceinline__ void ph_memq_attn(const P& p, char* lds, int vblock, int nvb) {
  if (vblock < 0) return;
  const float* rss = p.rowss;
  for (int u = vblock; u < 64 * 4; u += nvb) {
    const int tm = u & 63, hd = u >> 6;
    const int m0 = tm * 128;
    bf16_t* qd = p.qmemb + (size_t)m0 * 512 + hd * 128;
    gemm_tile_bf16<false, true>(p.hn + (size_t)m0 * DM, DM, p.WmqT + (size_t)hd * 128 * DM, DM, DM, lds,
                                [&](int r, int c, f32x4_e lo, f32x4_e hi) {
                                  const float rs = rsqrtf(rss[m0 + r] * (1.f / DM) + RMS_EPS);
                                  st_bf16x8(qd + (size_t)r * 512 + c, lo * rs, hi * rs); });
    __threadfence_block();
    vsync();
    memattn_item(p, lds, ((m0 >> 11) * 4 + hd) * (SEQ / 128) + ((m0 & 2047) >> 7));
  }
}

template <bool CHK>
__device__ __forceinline__ void sb_pass1(f32x16& z, f32x16& l, const int s_first, const int t) {
  const f32x2_s sc2 = {ATT_SCALE2, ATT_SCALE2}, one2 = {1.f, 1.f};
#pragma unroll
  for (int r = 0; r < 16; r += 2) {
    const f32x2_s zin = {z[r], z[r + 1]};
    const f32x2_s zz = zin * sc2;
    const f32x2_s ee = {__builtin_amdgcn_exp2f(-fabsf(zz[0])), __builtin_amdgcn_exp2f(-fabsf(zz[1]))};
    const f32x2_s tt = ee + one2;
    const f32x2_s lg = {__builtin_amdgcn_logf(tt[0]), __builtin_amdgcn_logf(tt[1])};
    const f32x2_s mn = {fminf(zz[0], 0.f), fminf(zz[1], 0.f)};
    const f32x2_s lf = (mn - lg) - zz;
    if (CHK) {
      const int so = s_first + 8 * (r >> 2) + (r & 3);
      const bool v0 = so < t, v1 = so + 1 < t;
      l[r] = v0 ? lf[0] : 0.f; l[r + 1] = v1 ? lf[1] : 0.f;
      z[r] = v0 ? zz[0] : NEG_BIG; z[r + 1] = v1 ? zz[1] : NEG_BIG;
    } else {
      l[r] = lf[0]; l[r + 1] = lf[1];
      z[r] = zz[0]; z[r + 1] = zz[1];
    }
  }
}
__device__ __forceinline__ void sb_pass3(f32x16& z, const f32x16& l, const float* ag) {
#pragma unroll
  for (int rho = 0; rho < 4; ++rho) {
    const float x3 = l[4 * rho + 3], x23 = x3 + l[4 * rho + 2], x123 = x23 + l[4 * rho + 1];
    const float g = ag[rho];
    const f32x2_s g2 = {g, g};
    const f32x2_s la = {l[4 * rho + 0], l[4 * rho + 1]}, lb = {l[4 * rho + 2], l[4 * rho + 3]};
    const f32x2_s za = {z[4 * rho + 0], z[4 * rho + 1]}, zb = {z[4 * rho + 2], z[4 * rho + 3]};
    const f32x2_s xa = {x123, x23}, xb = {x3, 0.f};
    const f32x2_s aa = (la + za) + (g2 + xa), ab = (lb + zb) + (g2 + xb);
    z[4 * rho + 0] = __builtin_amdgcn_exp2f(aa[0]); z[4 * rho + 1] = __builtin_amdgcn_exp2f(aa[1]);
    z[4 * rho + 2] = __builtin_amdgcn_exp2f(ab[0]); z[4 * rho + 3] = __builtin_amdgcn_exp2f(ab[1]);
  }
}

__device__ __forceinline__ void ph_sb2(const P& p, char* lds) {
  char* lk = lds;
  char* lv = lds + 16384;
  const int lane = VT() & 63, wv = VT() >> 6, hh = lane >> 5;
  const bool full = (VG() == 512);
  if (full && (VB() & 15) >= 14) return;
  const int nit = full ? (((VB() & 15) >= 12) ? 2 : 1) : 0;
  for (int it = 0, item = VB(); full ? (it < nit) : (item < NBATCH * 8 * (SEQ / 128)); ++it, item += (full ? 2 : VG())) {
    const int tb = (SEQ / 128 - 1) - (item % (SEQ / 128));
    const int bh = item / (SEQ / 128);
    const int b = bh >> 3, hd = bh & 7;
    const int t0 = tb * 128;
    const int t = t0 + wv * 32 + (lane & 31);
    QFrag q;
    q_load(q, p.qsb + (size_t)(b * SEQ + t) * 1024 + hd * 128);
    const bf16_t* kb = p.ksb + (size_t)bh * SEQ * 128;
    const bf16_t* vb = p.vsbT + (size_t)bh * 128 * SEQ;
    OAcc o;
    oacc_zero(o);
    float carry = 0.f;
    const int jhi = (t0 >> 6) + 1;
    const int jw = (t0 + wv * 32 + 30) >> 6;
    KVRegs kv;
    kv_load(kv, kb + (size_t)jhi * 64 * 128, 128, vb + jhi * 64, SEQ);
    volatile unsigned* dflag = (volatile unsigned*)(lds + 32768);
    vsync();
    if (VT() < 4) dflag[VT()] = 0u;
    for (int j = jhi; j >= 0; --j) {
      vsync();
      if ((dflag[0] & dflag[1] & dflag[2] & dflag[3]) != 0u) break;
      kv_store(kv, lk, lv);
      vsync();
      const int jn = (j > 0) ? j - 1 : 0;
      if (j > jw) kv_load(kv, kb + (size_t)jn * 64 * 128, 128, vb + jn * 64, SEQ);
      if (j <= jw) {
        f32x16 z0, z1;
        qk_tile(q, lk, z0, z1);
        const int sbase = j * 64 + 4 * hh;
        float gt[8];
        f32x16 l0, l1;
        if (j * 64 + 63 < t0 + wv * 32) {
          sb_pass1<false>(z0, l0, sbase, t);
          sb_pass1<false>(z1, l1, sbase + 32, t);
        } else {
          sb_pass1<true>(z0, l0, sbase, t);
          sb_pass1<true>(z1, l1, sbase + 32, t);
        }
#pragma unroll
        for (int rho = 0; rho < 4; ++rho) {
          gt[rho] = (l0[4 * rho] + l0[4 * rho + 1]) + (l0[4 * rho + 2] + l0[4 * rho + 3]);
          gt[4 + rho] = (l1[4 * rho] + l1[4 * rho + 1]) + (l1[4 * rho + 2] + l1[4 * rho + 3]);
        }
        float ag[8];
        float run = 0.f;
#pragma unroll
        for (int k = 7; k >= 0; --k) {
          const float pg = xhalf_get(gt[k], hh);
          ag[k] = carry + run + (hh == 0 ? pg : 0.f);
          run += gt[k] + pg;
        }
        carry += run;
        sb_pass3(z0, l0, ag);
        sb_pass3(z1, l1, ag + 4);
        kv_load(kv, kb + (size_t)jn * 64 * 128, 128, vb + jn * 64, SEQ);
        pv_tile(o, lv, z0, z1);
        if (__all(carry < -104.f * LOG2E) && (VT() & 63) == 0) dflag[wv] = 1u;
      }
    }
    int t2 = t;
    asm volatile("" : "+v"(t2));
    bf16_t* orow = p.omix + (size_t)(b * SEQ + t2) * DM + 1024 + hd * 128;
    oacc_foreach(o, [&](int d, float v0, float v1, float v2, float v3) {
      uint2 u;
      u.x = pack2(v0, v1);
      u.y = pack2(v2, v3);
      *(uint2*)(orow + d) = u;
    });
  }
}

#define NSA_IMP 32768
#define NSA_KEYS 49152
#define NSA_SELM 53504
#define NSA_LUT 53632
__device__ __forceinline__ void ph_nsa2(const P& p, char* lds) {
  typedef __attribute__((ext_vector_type(4))) float f32x4;
  char* lk = lds;
  char* lv = lds + 16384;
  float* imp = (float*)(lds + NSA_IMP);
  float* keys = (float*)(lds + NSA_KEYS);
  unsigned* selm = (unsigned*)(lds + NSA_SELM);
  const int tid = VT(), lane = tid & 63, wv = tid >> 6, hh = lane >> 5, ql = lane & 31;
  float* lut = (float*)(lds + NSA_LUT) + wv * 128;
  for (int item = VB(); item < NBATCH * 2 * (SEQ / 32); item += VG()) {
    const int tt = (item < 256) ? (SEQ / 32 - 1) - (item % (SEQ / 32)) : (item % (SEQ / 32));
    const int bg = item / (SEQ / 32);
    const int b = bg >> 1, g = bg & 1;
    const int h = g * 4 + wv;
    const int t0 = tt * 32, tq = t0 + ql, cur = t0 >> 6;
    vsync();
    QFrag q;
    q_load(q, p.qn + (size_t)(b * SEQ + tq) * 1024 + h * 128);
    {
      const int lo = opq(lane);
      lut[lo] = p.t5[t5_bucket(lo) * 8 + h] * LOG2E;
      lut[lo + 64] = p.t5[t5_bucket(lo + 64) * 8 + h] * LOG2E;
    }
#pragma unroll
    for (int i = 0; i < 16; ++i) imp[i * 256 + tid] = 0.f;
    if (tid < 32) selm[tid] = 0u;
    const float* grow = p.gates + (size_t)(b * SEQ + tq) * 24 + h * 3;
    float* prow = p.part + (size_t)(b * SEQ + tq) * 1024 + h * 128;
    OAcc o;
    float m, l;
    KVRegs kv;
    {
      const bf16_t* kb = p.kcb + (size_t)bg * 128 * 128;
      const bf16_t* vb = p.vcT + (size_t)bg * 128 * 128;
      oacc_zero(o);
      m = NEG_BIG; l = 0.f;
      kv_load(kv, kb, 128, vb, 128);
      vsync();
      kv_store(kv, lk, lv);
      vsync();
      f32x16 x0, x1;
      qk_tile(q, lk, x0, x1);
      int tqv = tq;
      asm volatile("" : "+v"(tqv));
      tqv -= 64 * hh;
      float fsc = 1.f, fbb = 0.f;
      if (t0 >= 1152) {
        fsc = ATT_SCALE2; fbb = lut[127];
      } else {
#pragma unroll
        for (int r = 0; r < 16; ++r) {
          const int c = 8 * (r >> 2) + (r & 3);
          const int d0 = tqv - 16 * c - 31, d1 = d0 - 512;
          x0[r] = (d0 >= 0) ? x0[r] * ATT_SCALE2 + lut[min(d0, 127)] : -INFINITY;
          x1[r] = (d1 >= 0) ? x1[r] * ATT_SCALE2 + lut[min(d1, 127)] : -INFINITY;
        }
      }
      softmax_tile(x0, x1, m, l, o, fsc, fbb);
      const float m0 = m;
      pv_tile(o, lv, x0, x1);
      f32x16 z0, z1;
#pragma unroll
      for (int r = 0; r < 16; ++r) { z0[r] = 0.f; z1[r] = 0.f; }
      if (t0 >= 1024) {
        kv_load(kv, kb + 64 * 128, 128, vb + 64, 128);
        vsync();
        kv_store(kv, lk, lv);
        vsync();
        qk_tile(q, lk, z0, z1);
        asm volatile("" : "+v"(tqv));
#pragma unroll
        for (int r = 0; r < 16; ++r) {
          const int c = 64 + 8 * (r >> 2) + (r & 3);
          const int d0 = tqv - 16 * c - 31, d1 = d0 - 512;
          z0[r] = (d0 >= 0) ? z0[r] * ATT_SCALE2 + lut[min(d0, 127)] : -INFINITY;
          z1[r] = (d1 >= 0) ? z1[r] * ATT_SCALE2 + lut[min(d1, 127)] : -INFINITY;
        }
        softmax_tile(z0, z1, m, l, o);
        pv_tile(o, lv, z0, z1);
      }
      const float inv = 1.f / fmaxf(l, 1e-20f);
      const float c0 = __builtin_amdgcn_exp2f(m0 - m) * inv;
#pragma unroll
      for (int r = 0; r < 16; ++r) {
        const int c = 8 * (r >> 2) + (r & 3) + 4 * hh;
        if (x0[r] != 0.f) atomicAdd(&imp[(c) * 32 + ql], x0[r] * c0);
        if (x1[r] != 0.f) atomicAdd(&imp[(c + 32) * 32 + ql], x1[r] * c0);
        if (z0[r] != 0.f) atomicAdd(&imp[(c + 64) * 32 + ql], z0[r] * inv);
        if (z1[r] != 0.f) atomicAdd(&imp[(c + 96) * 32 + ql], z1[r] * inv);
      }
      const float gs = inv / (1.f + __expf(-grow[0]));
      oacc_foreach(o, [&](int d, float v0, float v1, float v2, float v3) {
        f32x4 u = {v0 * gs, v1 * gs, v2 * gs, v3 * gs};
        *(f32x4*)(prow + d) = u;
      });
    }
    vsync();
    {
      const int tido = opq(tid);
      const int qq = tido & 31, jg = tido >> 5;
#pragma unroll
      for (int jj = 0; jj < 4; ++jj) {
        const int j = jg * 4 + jj;
        float v = imp[(4 * j) * 32 + qq] + imp[(4 * j + 1) * 32 + qq] + imp[(4 * j + 2) * 32 + qq] + 0.5f * imp[(4 * j + 3) * 32 + qq];
        if (j > 0) v += 0.5f * imp[(4 * j - 1) * 32 + qq];
        const bool forced = (j == 0) || (j == cur) || (j == cur - 1);
        keys[qq * 33 + j] = forced ? 1e9f : ((j <= cur) ? v : -1e9f);
      }
      vsync();
      unsigned bits = 0u;
#pragma unroll
      for (int jj = 0; jj < 4; ++jj) {
        const int j = jg * 4 + jj;
        const float kj = keys[qq * 33 + j];
        int rank = 0;
        for (int i = 0; i < 32; ++i) {
          const float ki = keys[qq * 33 + i];
          rank += (ki > kj || (ki == kj && i < j)) ? 1 : 0;
        }
        if (rank < 16 && j <= cur) bits |= 1u << j;
      }
      atomicOr(&selm[qq], bits);
      vsync();
    }
    const unsigned mysel = selm[ql];
    unsigned um = mysel;
#pragma unroll
    for (int o2 = 16; o2 > 0; o2 >>= 1) um |= (unsigned)__shfl_xor((int)um, o2);
    um = (unsigned)__builtin_amdgcn_readfirstlane((int)um);
    {
      const bf16_t* kb = p.ks + (size_t)bg * SEQ * 128;
      const bf16_t* vb = p.vsT + (size_t)bg * 128 * SEQ;
      oacc_zero(o);
      m = NEG_BIG; l = 0.f;
      unsigned rem = um;
      int j = __builtin_ctz(rem);
      kv_load(kv, kb + (size_t)j * 64 * 128, 128, vb + j * 64, SEQ);
      while (rem) {
        j = __builtin_ctz(rem);
        rem &= rem - 1;
        const int jn = rem ? __builtin_ctz(rem) : j;
        vsync();
        kv_store(kv, lk, lv);
        vsync();
        f32x16 s0, s1;
        qk_tile(q, lk, s0, s1);
        const bool selq = (mysel >> j) & 1u;
        int tqv = tq;
        asm volatile("" : "+v"(tqv));
        float fsc = 1.f, fbb = 0.f;
        if (j * 64 + 63 + 113 <= t0) {
          fsc = selq ? ATT_SCALE2 : 0.f; fbb = selq ? lut[127] : -INFINITY;
        } else {
#pragma unroll
          for (int r = 0; r < 16; ++r) {
            const int d0 = tqv - (j * 64 + 8 * (r >> 2) + (r & 3) + 4 * hh), d1 = d0 - 32;
            s0[r] = (selq && d0 >= 0) ? s0[r] * ATT_SCALE2 + lut[min(d0, 127)] : -INFINITY;
            s1[r] = (selq && d1 >= 0) ? s1[r] * ATT_SCALE2 + lut[min(d1, 127)] : -INFINITY;
          }
        }
        kv_load(kv, kb + (size_t)jn * 64 * 128, 128, vb + jn * 64, SEQ);
        softmax_tile(s0, s1, m, l, o, fsc, fbb);
        pv_tile(o, lv, s0, s1);
      }
      const float gs = 1.f / (fmaxf(l, 1e-20f) * (1.f + __expf(-grow[1])));
      int qo = ql;
      asm volatile("" : "+v"(qo));
      float* pr2 = p.part + (size_t)(b * SEQ + t0 + qo) * 1024 + h * 128;
      oacc_foreach(o, [&](int d, float v0, float v1, float v2, float v3) {
        f32x4 u = *(f32x4*)(pr2 + d);
        u[0] += v0 * gs; u[1] += v1 * gs; u[2] += v2 * gs; u[3] += v3 * gs;
        *(f32x4*)(pr2 + d) = u;
      });
    }
    {
      const bf16_t* kb = p.kw + (size_t)bg * SEQ * 128;
      const bf16_t* vb = p.vwT + (size_t)bg * 128 * SEQ;
      oacc_zero(o);
      m = NEG_BIG; l = 0.f;
      int jlo = (t0 - 511) >> 6;
      if (jlo < 0) jlo = 0;
      kv_load(kv, kb + (size_t)jlo * 64 * 128, 128, vb + jlo * 64, SEQ);
      for (int j = jlo; j <= cur; ++j) {
        const int jn = (j < cur) ? j + 1 : j;
        vsync();
        kv_store(kv, lk, lv);
        vsync();
        f32x16 s0, s1;
        qk_tile(q, lk, s0, s1);
        int tqv = tq;
        asm volatile("" : "+v"(tqv));
        float wsc = 1.f, wbb = 0.f;
        if (j * 64 + 63 + 113 <= t0 && t0 + 31 - j * 64 < 512) {
          wsc = ATT_SCALE2; wbb = lut[127];
        } else {
#pragma unroll
          for (int r = 0; r < 16; ++r) {
            const int d0 = tqv - (j * 64 + 8 * (r >> 2) + (r & 3) + 4 * hh), d1 = d0 - 32;
            s0[r] = (d0 >= 0 && d0 < 512) ? s0[r] * ATT_SCALE2 + lut[min(d0, 127)] : -INFINITY;
            s1[r] = (d1 >= 0 && d1 < 512) ? s1[r] * ATT_SCALE2 + lut[min(d1, 127)] : -INFINITY;
          }
        }
        kv_load(kv, kb + (size_t)jn * 64 * 128, 128, vb + jn * 64, SEQ);
        softmax_tile(s0, s1, m, l, o, wsc, wbb);
        pv_tile(o, lv, s0, s1);
      }
      const float gs = 1.f / (fmaxf(l, 1e-20f) * (1.f + __expf(-grow[2])));
      int qo = ql;
      asm volatile("" : "+v"(qo));
      const float* pr2 = p.part + (size_t)(b * SEQ + t0 + qo) * 1024 + h * 128;
      bf16_t* orow = p.omix + (size_t)(b * SEQ + t0 + qo) * DM + h * 128;
      oacc_foreach(o, [&](int d, float v0, float v1, float v2, float v3) {
        const f32x4 u = *(const f32x4*)(pr2 + d);
        uint2 w;
        w.x = pack2(u[0] + v0 * gs, u[1] + v1 * gs);
        w.y = pack2(u[2] + v2 * gs, u[3] + v3 * gs);
        *(uint2*)(orow + d) = w;
      });
    }
  }
}

__device__ __forceinline__ void ph_cvt(const float* src, bf16_t* dst, size_t n) {
  typedef __attribute__((ext_vector_type(4))) float f32x4;
  const size_t nv = n / 8;
  for (size_t i = (size_t)VB() * 256 + VT(); i < nv; i += (size_t)VG() * 256) {
    const f32x4 a = ((const f32x4*)src)[2 * i], b = ((const f32x4*)src)[2 * i + 1];
    u32x4 o;
    o[0] = pack2(a[0], a[1]); o[1] = pack2(a[2], a[3]); o[2] = pack2(b[0], b[1]); o[3] = pack2(b[2], b[3]);
    ((u32x4*)dst)[i] = o;
  }
}

__device__ __forceinline__ void ph_scores(const P& p, char* lds) {
  for (int u = VB(); u < 64 * 16; u += VG()) {
    const int tm = u & 63, hp = u >> 6;
    const int m0 = tm * 128;
    float* sc = p.scores + (size_t)m0 * DM + hp * 128;
    gemm_tile_bf16<false>(p.omix + (size_t)m0 * DM + hp * 128, DM, p.subkb + (size_t)hp * 128 * 128, 128, 128, lds,
                          [&](int r, int c, float val) { sc[(size_t)r * DM + c] = val; });
  }
}

template <int PM = 0>
__device__ __forceinline__ void ph_qp_scores(const P& p, char* lds0, char* lds) {
  for (int u = (int)blockIdx.x; u < 32 * 8; u += (int)gridDim.x) {
    const int x = u & 7, i = (u >> 3) & 31;
    const int tm = (x & 3) * 8 + (i & 7), tn = (x >> 2) * 4 + (i >> 3);
    const int m0 = tm * 256, n0 = tn * 256;
    bf16_t* qp = p.omix + (size_t)m0 * DM + n0;
    const float* rss = p.rowss + T_TOK + m0;
    gemm_tile_huge<PM>(p.hn + (size_t)m0 * DM, DM, p.WpqT + (size_t)n0 * DM, DM, DM, lds0,
                   [&](int r, int c, f32x4_e lo, f32x4_e hi) {
                     const float rs = rsqrtf(rss[r] * (1.f / DM) + RMS_EPS);
                     st_bf16x8(qp + (size_t)r * DM + c, lo * rs, hi * rs); });
    __threadfence_block();
    __syncthreads();
    const int hf = (int)(threadIdx.x >> 8);
    const int hp = tn * 2 + hf;
    float* sc = p.scores + (size_t)m0 * DM + hp * 128;
    gemm_tile_big(qp + hf * 128, DM, p.subkb + (size_t)hp * 128 * 128, 128, 128, lds,
                  [&](int r, int c, f32x4_e lo, f32x4_e hi) {
                    *(f32x4_e*)(sc + (size_t)r * DM + c) = lo; *(f32x4_e*)(sc + (size_t)r * DM + c + 4) = hi; });
    __syncthreads();
  }
}

__device__ __forceinline__ void ph_cvt4(const float* src, unsigned char* dst, float* scales, int nrows, int wid0, int nw) {
  typedef __attribute__((ext_vector_type(4))) float f32x4;
  typedef __attribute__((ext_vector_type(2))) float f32x2;
  const int lane = VT() & 63;
  const float one = __uint_as_float((unsigned)opq(0x3F800000));
  float lev[8];
#pragma unroll
  for (int c = 0; c < 8; ++c) {
    const f32x2 q = __builtin_amdgcn_cvt_scalef32_pk_f32_fp4((unsigned)opq(c * 0x11111111), one, 0);
    lev[c] = fabsf(q[0]);
  }
  const float maxlev = lev[7];
  for (int row = wid0; row < nrows; row += nw) {
    const f32x4* s4 = (const f32x4*)(src + (size_t)row * DM) + lane * 8;
    f32x4 v[8];
    float amax = 0.f;
#pragma unroll
    for (int i = 0; i < 8; ++i) {
      v[i] = s4[i];
#pragma unroll
      for (int k = 0; k < 4; ++k) amax = fmaxf(amax, fabsf(v[i][k]));
    }
    amax = wave_max(amax);
    const float sc = (amax > 0.f) ? maxlev / amax : 1.f;
    u32x4 o;
#pragma unroll
    for (int w = 0; w < 4; ++w) {
      unsigned pk = 0u;
      pk = __builtin_amdgcn_cvt_scalef32_pk_fp4_f32(pk, v[2 * w][0] * sc, v[2 * w][1] * sc, 1.0f, 0);
      pk = __builtin_amdgcn_cvt_scalef32_pk_fp4_f32(pk, v[2 * w][2] * sc, v[2 * w][3] * sc, 1.0f, 1);
      pk = __builtin_amdgcn_cvt_scalef32_pk_fp4_f32(pk, v[2 * w + 1][0] * sc, v[2 * w + 1][1] * sc, 1.0f, 2);
      pk = __builtin_amdgcn_cvt_scalef32_pk_fp4_f32(pk, v[2 * w + 1][2] * sc, v[2 * w + 1][3] * sc, 1.0f, 3);
      o[w] = pk;
    }
    *(u32x4*)(dst + (size_t)row * 1024 + lane * 16) = o;
    if (lane == 0) scales[row] = (amax > 0.f) ? amax / maxlev : 1.f;
  }
}

__device__ __forceinline__ float wave_sum_dpp(float v) {
  typedef __attribute__((ext_vector_type(2))) unsigned u32x2_d;
  v += __builtin_bit_cast(float, __builtin_amdgcn_update_dpp(0, __builtin_bit_cast(int, v), 0xB1, 0xF, 0xF, true));
  v += __builtin_bit_cast(float, __builtin_amdgcn_update_dpp(0, __builtin_bit_cast(int, v), 0x4E, 0xF, 0xF, true));
  v += __builtin_bit_cast(float, __builtin_amdgcn_update_dpp(0, __builtin_bit_cast(int, v), 0x141, 0xF, 0xF, true));
  v += __builtin_bit_cast(float, __builtin_amdgcn_update_dpp(0, __builtin_bit_cast(int, v), 0x140, 0xF, 0xF, true));
  u32x2_d r = __builtin_amdgcn_permlane16_swap(__float_as_uint(v), __float_as_uint(v), false, false);
  v = __uint_as_float(r[0]) + __uint_as_float(r[1]);
  r = __builtin_amdgcn_permlane32_swap(__float_as_uint(v), __float_as_uint(v), false, false);
  return __uint_as_float(r[0]) + __uint_as_float(r[1]);
}
__device__ __forceinline__ float gelu_rcp(float x) {
  const float y2 = (1.5957691216057308f * LOG2E) * (x + 0.044715f * x * x * x);
  return x * __builtin_amdgcn_rcpf(1.f + __builtin_amdgcn_exp2f(-y2));
}
__device__ __forceinline__ u32x4 r4_load(const unsigned char* tab, int eid, int lane) {
  return *((const u32x4*)(tab + (size_t)eid * 1024) + lane);
}
struct XPk { f32x16 a, b; };
struct Acc32 { f32x16 a, b; };

typedef __attribute__((ext_vector_type(2))) float f32x2_t;
#define PAIR(v, i) __builtin_shufflevector(v, v, (i), (i) + 1)
#define R4_DOT_W(word, xv, base, sa, sb)                                                             \
  {                                                                                                  \
    const f32x2_t q0 = __builtin_amdgcn_cvt_scalef32_pk_f32_fp4(word, one, 0), q1 = __builtin_amdgcn_cvt_scalef32_pk_f32_fp4(word, one, 1); \
    const f32x2_t q2 = __builtin_amdgcn_cvt_scalef32_pk_f32_fp4(word, one, 2), q3 = __builtin_amdgcn_cvt_scalef32_pk_f32_fp4(word, one, 3); \
    sa = __builtin_elementwise_fma(q0, PAIR(xv, base + 0), sa); sb = __builtin_elementwise_fma(q1, PAIR(xv, base + 2), sb); \
    sa = __builtin_elementwise_fma(q2, PAIR(xv, base + 4), sa); sb = __builtin_elementwise_fma(q3, PAIR(xv, base + 6), sb); \
  }
__device__ __forceinline__ float r4_dot(const u32x4& e, const XPk& x) {
  const float one = __uint_as_float((unsigned)opq(0x3F800000));
  f32x2_t sa = {0.f, 0.f}, sb = {0.f, 0.f};
  R4_DOT_W(e[0], x.a, 0, sa, sb) R4_DOT_W(e[1], x.a, 8, sa, sb) R4_DOT_W(e[2], x.b, 0, sa, sb) R4_DOT_W(e[3], x.b, 8, sa, sb)
  sa = sa + sb;
  return sa[0] + sa[1];
}
#define R4_AXPY_P(accv, i, q)                                                                        \
  { const f32x2_t r_ = __builtin_elementwise_fma(h2, q, PAIR(accv, i)); accv[i] = r_[0]; accv[(i) + 1] = r_[1]; }
#define R4_AXPY_W(word, accv, base)                                                                  \
  {                                                                                                  \
    const f32x2_t q0 = __builtin_amdgcn_cvt_scalef32_pk_f32_fp4(word, one, 0), q1 = __builtin_amdgcn_cvt_scalef32_pk_f32_fp4(word, one, 1); \
    const f32x2_t q2 = __builtin_amdgcn_cvt_scalef32_pk_f32_fp4(word, one, 2), q3 = __builtin_amdgcn_cvt_scalef32_pk_f32_fp4(word, one, 3); \
    R4_AXPY_P(accv, base + 0, q0) R4_AXPY_P(accv, base + 2, q1) R4_AXPY_P(accv, base + 4, q2) R4_AXPY_P(accv, base + 6, q3) \
  }
__device__ __forceinline__ void r4_axpy(const u32x4& e, float hid, Acc32& acc) {
  const float one = __uint_as_float((unsigned)opq(0x3F800000));
  const f32x2_t h2 = {hid, hid};
  R4_AXPY_W(e[0], acc.a, 0) R4_AXPY_W(e[1], acc.a, 8) R4_AXPY_W(e[2], acc.b, 0) R4_AXPY_W(e[3], acc.b, 8)
}

#define INS16(K, x)                                                                                      \
  K##15 = __builtin_amdgcn_fmed3f(K##15, K##14, x); K##14 = __builtin_amdgcn_fmed3f(K##14, K##13, x);   \
  K##13 = __builtin_amdgcn_fmed3f(K##13, K##12, x); K##12 = __builtin_amdgcn_fmed3f(K##12, K##11, x);   \
  K##11 = __builtin_amdgcn_fmed3f(K##11, K##10, x); K##10 = __builtin_amdgcn_fmed3f(K##10, K##9, x);    \
  K##9 = __builtin_amdgcn_fmed3f(K##9, K##8, x); K##8 = __builtin_amdgcn_fmed3f(K##8, K##7, x);         \
  K##7 = __builtin_amdgcn_fmed3f(K##7, K##6, x); K##6 = __builtin_amdgcn_fmed3f(K##6, K##5, x);         \
  K##5 = __builtin_amdgcn_fmed3f(K##5, K##4, x); K##4 = __builtin_amdgcn_fmed3f(K##4, K##3, x);         \
  K##3 = __builtin_amdgcn_fmed3f(K##3, K##2, x); K##2 = __builtin_amdgcn_fmed3f(K##2, K##1, x);         \
  K##1 = __builtin_amdgcn_fmed3f(K##1, K##0, x); K##0 = fmaxf(K##0, x);
#define DECL16(K) float K##0 = -INFINITY, K##1 = -INFINITY, K##2 = -INFINITY, K##3 = -INFINITY, K##4 = -INFINITY, \
  K##5 = -INFINITY, K##6 = -INFINITY, K##7 = -INFINITY, K##8 = -INFINITY, K##9 = -INFINITY, K##10 = -INFINITY,   \
  K##11 = -INFINITY, K##12 = -INFINITY, K##13 = -INFINITY, K##14 = -INFINITY, K##15 = -INFINITY;
__device__ __forceinline__ float mkkey(float v, unsigned tag, unsigned mask) {
  return __uint_as_float((__float_as_uint(v) & ~mask) | tag);
}

__device__ __forceinline__ void ph_peer(const P& p, float* smem) {
  typedef __attribute__((ext_vector_type(4))) float f32x4;
  float* lists = smem;
  int* bexA = (int*)(smem + 4096);
  float* bgtA = smem + 6144;
  float* bsuA = smem + 8192;
  float* hidA = smem + 10240;
  float* xqA = smem + 10752;
  for (int item = VB(); item < T_TOK / 16; item += VG()) {
    const int t0 = item * 16;
    vsync();
    {
      const int tid = VT();
      const int tl = tid >> 4, hp = tid & 15;
      const f32x4* sp = (const f32x4*)(p.scores + (size_t)(t0 + tl) * DM + hp * 128);
      DECL16(k)
#pragma unroll 4
      for (int c4 = 0; c4 < 32; ++c4) {
        const f32x4 v = sp[c4];
#pragma unroll
        for (int e = 0; e < 4; ++e) {
          const float x = mkkey(v[e], 127u - (unsigned)(c4 * 4 + e), 127u);
          INS16(k, x)
        }
      }
      f32x4* lp = (f32x4*)(lists + (size_t)VT() * 16);
      f32x4 o0 = {k0, k1, k2, k3}, o1 = {k4, k5, k6, k7}, o2 = {k8, k9, k10, k11}, o3 = {k12, k13, k14, k15};
      lp[0] = o0; lp[1] = o1; lp[2] = o2; lp[3] = o3;
    }
    vsync();
    if (VT() < 128) {
      const int tid = VT();
      const int tl = tid >> 3, h = tid & 7;
      const float* la = lists + (size_t)(tl * 16 + 2 * h) * 16;
      const float* lb = la + 16;
      float av[16], bv[16];
#pragma unroll
      for (int i = 0; i < 16; ++i) {
        av[i] = __uint_as_float(__float_as_uint(la[i]) & ~127u);
        bv[i] = __uint_as_float(__float_as_uint(lb[i]) & ~127u);
      }
      DECL16(c)
#pragma unroll
      for (int i = 0; i < 16; ++i) {
#pragma unroll
        for (int j = 0; j < 16; ++j) {
          if ((i + 1) * (j + 1) <= 16) {
            const float x = mkkey(av[i] + bv[j], 255u - (unsigned)(i * 16 + j), 255u);
            INS16(c, x)
          }
        }
      }
      float cs[16] = {c0, c1, c2, c3, c4, c5, c6, c7, c8, c9, c10, c11, c12, c13, c14, c15};
      float ev[16];
      float sum = 0.f;
      const float mx = __uint_as_float(__float_as_uint(cs[0]) & ~255u);
#pragma unroll
      for (int n = 0; n < 16; ++n) {
        ev[n] = __expf(__uint_as_float(__float_as_uint(cs[n]) & ~255u) - mx);
        sum += ev[n];
      }
      const float isum = 1.f / sum;
#pragma unroll
      for (int n = 0; n < 16; ++n) {
        const unsigned cc = 255u - (__float_as_uint(cs[n]) & 255u);
        const unsigned ka = 127u - (__float_as_uint(la[cc >> 4]) & 127u);
        const unsigned kb = 127u - (__float_as_uint(lb[cc & 15u]) & 127u);
        const int eid = (int)(ka * 128u + kb);
        bexA[tl * 128 + h * 16 + n] = eid;
        bgtA[tl * 128 + h * 16 + n] = ev[n] * isum * p.sv8[eid];
        bsuA[tl * 128 + h * 16 + n] = p.su8[eid];
      }
    }
    vsync();
#pragma unroll 1
    for (int ti4 = 0; ti4 < 4; ++ti4) {
    const int lane = VT() & 63, wv = VT() >> 6;
    const int tl = wv * 4 + ti4;
    const int t = t0 + tl;
    const int* bex = bexA + tl * 128;
    const float* bgt = bgtA + tl * 128;
    const float* bsu = bsuA + tl * 128;
    float* hidL = hidA + wv * 128;
    unsigned char* xqL = (unsigned char*)xqA + wv * 2048;
    const int q16 = lane >> 4;
    float inv_s;
    {
      const u32x4* s4 = (const u32x4*)(p.hn + (size_t)t * DM) + lane * 4;
      const f32x4* g4 = (const f32x4*)p.norm_ffn + lane * 8;
      const u32x4 q0 = s4[0], q1 = s4[1], q2 = s4[2], q3 = s4[3];
#define UNPK(q, lo) f32x4{__uint_as_float(q[lo] << 16), __uint_as_float(q[lo] & 0xffff0000u), \
                          __uint_as_float(q[lo + 1] << 16), __uint_as_float(q[lo + 1] & 0xffff0000u)}
      f32x4 a0 = UNPK(q0, 0), a1 = UNPK(q0, 2), a2 = UNPK(q1, 0), a3 = UNPK(q1, 2);
      f32x4 a4 = UNPK(q2, 0), a5 = UNPK(q2, 2), a6 = UNPK(q3, 0), a7 = UNPK(q3, 2);
      float ss = 0.f;
#define SSQ(v) ss += v[0] * v[0] + v[1] * v[1] + v[2] * v[2] + v[3] * v[3];
      SSQ(a0) SSQ(a1) SSQ(a2) SSQ(a3) SSQ(a4) SSQ(a5) SSQ(a6) SSQ(a7)
#undef SSQ
      ss = wave_sum(ss);
      const float rs = rsqrtf(ss * (1.f / DM) + RMS_EPS);
      float amax = 0.f;
#define XSC(v, gi) { v = v * rs * g4[gi]; amax = fmaxf(fmaxf(amax, fmaxf(fabsf(v[0]), fabsf(v[1]))), fmaxf(fabsf(v[2]), fabsf(v[3]))); }
      XSC(a0, 0) XSC(a1, 1) XSC(a2, 2) XSC(a3, 3) XSC(a4, 4) XSC(a5, 5) XSC(a6, 6) XSC(a7, 7)
#undef XSC
      amax = wave_max(amax);
      unsigned ex = (__float_as_uint(amax) >> 23) & 255u;
      ex = ex < 8u ? 8u : ex;
      const float sx = __uint_as_float((261u - ex) << 23);
      inv_s = __uint_as_float((ex - 7u) << 23);
#define XQ(v) __builtin_amdgcn_cvt_pk_fp8_f32(v[2] * sx, v[3] * sx, __builtin_amdgcn_cvt_pk_fp8_f32(v[0] * sx, v[1] * sx, 0, false), true)
      const u32x4 w0 = {(unsigned)XQ(a0), (unsigned)XQ(a1), (unsigned)XQ(a2), (unsigned)XQ(a3)};
      const u32x4 w1 = {(unsigned)XQ(a4), (unsigned)XQ(a5), (unsigned)XQ(a6), (unsigned)XQ(a7)};
#undef XQ
      *(u32x4*)(xqL + lane * 32) = w0;
      *(u32x4*)(xqL + lane * 32 + 16) = w1;
    }
    __builtin_amdgcn_wave_barrier();
    {
      const unsigned char* pg[8];
#pragma unroll
      for (int g = 0; g < 8; ++g) pg[g] = p.pu8 + (size_t)bex[g * 16 + (lane & 15)] * 1024 + q16 * 16;
      const u32x4* xb = (const u32x4*)(xqL + q16 * 16);
      f32x4 ag[8];
#pragma unroll
      for (int g = 0; g < 8; ++g) ag[g] = f32x4{0.f, 0.f, 0.f, 0.f};
      i32x4_t X[8], Y[8];
#pragma unroll
      for (int g = 0; g < 8; ++g) X[g] = *(const i32x4_t*)(pg[g]);
#define UMMA(S, kb)                                                                                         \
      {                                                                                                     \
        const u32x4 b0 = xb[(kb) * 8], b1 = xb[(kb) * 8 + 4];                                               \
        const i32x8_t bq = {(int)b0[0], (int)b0[1], (int)b0[2], (int)b0[3], (int)b1[0], (int)b1[1], (int)b1[2], (int)b1[3]}; \
        _Pragma("unroll") for (int g = 0; g < 8; ++g)                                                       \
          ag[g] = __builtin_amdgcn_mfma_scale_f32_16x16x128_f8f6f4(                                         \
              __builtin_shufflevector(S[g], S[g], 0, 1, 2, 3, -1, -1, -1, -1), bq, ag[g], 4, 0, 0, 0, 0, 0); \
        __builtin_amdgcn_sched_barrier(0);                                                                  \
      }
#pragma unroll 1
      for (int kb = 0; kb < 16; kb += 2) {
#pragma unroll
        for (int g = 0; g < 8; ++g) Y[g] = *(const i32x4_t*)(pg[g] + 64);
        UMMA(X, kb)
        const int adv = (kb + 2 < 16) ? 128 : 0;
#pragma unroll
        for (int g = 0; g < 8; ++g) { pg[g] += adv; X[g] = *(const i32x4_t*)(pg[g]); }
        UMMA(Y, kb + 1)
      }
#undef UMMA
#pragma unroll
      for (int g = 0; g < 8; ++g) {
        const f32x4 bs = *(const f32x4*)&bsu[g * 16 + 4 * q16], gt = *(const f32x4*)&bgt[g * 16 + 4 * q16];
        f32x4 h;
#pragma unroll
        for (int j = 0; j < 4; ++j) h[j] = gt[j] * gelu_rcp(ag[g][j] * (bs[j] * inv_s));
        if ((lane & 15) == 0) *(f32x4*)&hidL[g * 16 + 4 * q16] = h;
      }
    }
    __builtin_amdgcn_wave_barrier();
    Acc32 acc;
#pragma unroll
    for (int r = 0; r < 16; ++r) { acc.a[r] = 0.f; acc.b[r] = 0.f; }
#define SID(i) __builtin_amdgcn_readfirstlane(bex[i])
#define SFL(arr, i) __uint_as_float((unsigned)__builtin_amdgcn_readfirstlane((int)__float_as_uint(arr[i])))
#define VLD(S, e) { const int e_ = (e) < 124 ? (e) : 124; S##0 = r4_load(p.pv8, SID(e_), lane); S##1 = r4_load(p.pv8, SID(e_ + 1), lane); \
                    S##2 = r4_load(p.pv8, SID(e_ + 2), lane); S##3 = r4_load(p.pv8, SID(e_ + 3), lane); }
#define VAX(S, e) { r4_axpy(S##0, SFL(hidL, (e)), acc); r4_axpy(S##1, SFL(hidL, (e) + 1), acc); \
                    r4_axpy(S##2, SFL(hidL, (e) + 2), acc); r4_axpy(S##3, SFL(hidL, (e) + 3), acc); }
    u32x4 A0, A1, A2, A3, B0, B1, B2, B3, C0, C1, C2, C3, D0, D1, D2, D3;
    VLD(A, 0) VLD(B, 4) VLD(C, 8)
#pragma unroll 1
    for (int e0 = 0; e0 < 128; e0 += 16) {
      VLD(D, e0 + 12) VAX(A, e0)
      VLD(A, e0 + 16) VAX(B, e0 + 4)
      VLD(B, e0 + 20) VAX(C, e0 + 8)
      VLD(C, e0 + 24) VAX(D, e0 + 12)
    }
#undef VLD
#undef VAX
#undef SID
#undef SFL
    const int lane2 = opq(lane);
    f32x4* o4 = (f32x4*)(p.out + (size_t)t * DM) + lane2 * 8;
    const u32x4* hq = (const u32x4*)(p.hn + (size_t)t * DM) + lane2 * 4;
    const f32x4* g4 = (const f32x4*)p.norm_final + lane2 * 8;
    f32x4 hv[8];
    float ss = 0.f;
#pragma unroll
    for (int i = 0; i < 4; ++i) {
      const u32x4 q = hq[i];
      hv[2 * i] = UNPK(q, 0);
      hv[2 * i + 1] = UNPK(q, 2);
    }
#undef UNPK
#pragma unroll
    for (int i = 0; i < 8; ++i) {
#pragma unroll
      for (int k = 0; k < 4; ++k) {
        hv[i][k] += (i < 4) ? acc.a[4 * i + k] : acc.b[4 * (i - 4) + k];
        ss += hv[i][k] * hv[i][k];
      }
    }
    ss = wave_sum(ss);
    const float rs = rsqrtf(ss * (1.f / DM) + RMS_EPS);
#pragma unroll
    for (int i = 0; i < 8; ++i) {
      const f32x4 g = g4[i];
      f32x4 o;
#pragma unroll
      for (int k = 0; k < 4; ++k) o[k] = hv[i][k] * rs * g[k];
      o4[i] = o;
    }
    }
  }
}

#define XB_TMO      128
#define XB_XCNT(j)  (256  + 64 * (j))
#define XB_XSUB(j)  (1280 + 64 * (j))
#define XB_XGEN(j)  (2304 + 64 * (j))
#define XB_TOP      3328
#define XB_TOPGEN   3392
#define XCD_BAR_WORDS 3456
#define XB_SPIN_CAP (1u << 22)
__device__ __forceinline__ unsigned xb_ld(unsigned* p) { return __hip_atomic_load(p, __ATOMIC_RELAXED, __HIP_MEMORY_SCOPE_AGENT); }
__device__ __forceinline__ unsigned xb_add(unsigned* p, unsigned v) { return __hip_atomic_fetch_add(p, v, __ATOMIC_RELAXED, __HIP_MEMORY_SCOPE_AGENT); }
__device__ __forceinline__ unsigned xb_xcc_id() { return (unsigned)__builtin_amdgcn_s_getreg((3 << 11) | 20) & 0xFu; }
#define XB_SPIN(cond, bar) do { unsigned _sp = 0; while (cond) { __builtin_amdgcn_s_sleep(1); \
    if ((++_sp & 255u) == 0u) { if (xb_ld(&(bar)[XB_TMO])) break; if (_sp > XB_SPIN_CAP) { atomicAdd(&(bar)[XB_TMO], 1u); break; } } } } while (0)
struct XcdBarrier { unsigned* bar; unsigned x; volatile LAS unsigned* st; };
__device__ __forceinline__ XcdBarrier xcd_barrier_post(unsigned* bar, volatile LAS unsigned* st) {
  XcdBarrier b; b.bar = bar; b.x = xb_xcc_id(); b.st = st;
  if (threadIdx.x == 0) (void)xb_add(&bar[XB_XCNT(b.x)], 1u);
  return b;
}
__device__ __forceinline__ void xcd_barrier_complete(unsigned* bar, unsigned x, unsigned& nloc, unsigned& nx) {
  const unsigned G = gridDim.x * gridDim.y * gridDim.z;
  unsigned sum, cnt, mine, sp = 0u;
  for (;;) {
    sum = 0u; cnt = 0u; mine = 0u;
#pragma unroll
    for (unsigned j = 0; j < 16; ++j) { const unsigned c = xb_ld(&bar[XB_XCNT(j)]); sum += c; cnt += (c > 0u) ? 1u : 0u; mine = (j == x) ? c : mine; }
    if (sum == G) break;
    __builtin_amdgcn_s_sleep(1);
    if ((++sp & 255u) == 0u) { if (xb_ld(&bar[XB_TMO])) break; if (sp > XB_SPIN_CAP) { atomicAdd(&bar[XB_TMO], 1u); break; } }
  }
  nloc = mine > 0u ? mine : 1u; nx = cnt > 0u ? cnt : 1u;
}
__device__ __forceinline__ void xcd_barrier(const XcdBarrier& b) {
  asm volatile("s_waitcnt vmcnt(0)" ::: "memory");
  __syncthreads();
  if (threadIdx.x == 0) {
    unsigned* bar = b.bar;
    __builtin_amdgcn_s_waitcnt(0);
    unsigned nloc = b.st[0], nx = b.st[1];
    if (nloc == 0u) { xcd_barrier_complete(bar, b.x, nloc, nx); b.st[0] = nloc; b.st[1] = nx; }
    const unsigned old = xb_add(&bar[XB_XSUB(b.x)], 1u);
    const unsigned gen = old / nloc;
    if (old + 1u == (gen + 1u) * nloc) {
      __builtin_amdgcn_fence(__ATOMIC_RELEASE, "agent");
      asm volatile("s_waitcnt vmcnt(0)" ::: "memory");
      const unsigned og = xb_add(&bar[XB_TOP], 1u);
      const unsigned tg = og / nx;
      if (og + 1u == (tg + 1u) * nx) xb_add(&bar[XB_TOPGEN], 1u);
      else XB_SPIN(xb_ld(&bar[XB_TOPGEN]) == tg, bar);
      __builtin_amdgcn_fence(__ATOMIC_ACQUIRE, "agent");
      xb_add(&bar[XB_XGEN(b.x)], 1u);
      asm volatile("s_waitcnt vmcnt(0)" ::: "memory");
    } else {
      XB_SPIN(xb_ld(&bar[XB_XGEN(b.x)]) == gen, bar);
      __builtin_amdgcn_fence(__ATOMIC_ACQUIRE, "agent");
      asm volatile("s_waitcnt vmcnt(0)" ::: "memory");
    }
  }
  __syncthreads();
}

typedef const __attribute__((address_space(4))) P* KP;
__device__ __forceinline__ P loadP() {
#if defined(__HIP_DEVICE_COMPILE__)
  KP k = (KP)__builtin_amdgcn_kernarg_segment_ptr();
  asm volatile("" : "+s"(k));
  P p = *k;
  return p;
#else
  return P{};
#endif
}

__global__ void __launch_bounds__(512, 2) mega(P p_arg) {
  cg::grid_group grid = cg::this_grid();
  __shared__ __attribute__((aligned(16))) float smem_all[2 * 18432 + 64];
  float* smem = smem_all + (threadIdx.x >> 8) * 18432;
  char* lds = (char*)smem;
  unsigned* xbw = (unsigned*)(smem_all + 2 * 18432 + 32);
  if (threadIdx.x < 64) ((unsigned*)(smem_all + 2 * 18432))[threadIdx.x] = 0u;
  if (blockIdx.x == 0) {
    P p = loadP();
    for (int i = threadIdx.x; i < XCD_BAR_WORDS; i += 512) p.bar[i] = 0u;
    if (threadIdx.x < 16) p.ccnt[threadIdx.x] = 0u;
  }
  __syncthreads();
  { P p = loadP(); ph_rmsnorm(p.x, p.norm_mix, p.hn, T_TOK); ph_rmsnorm(p.mem, p.norm_mkv, p.memn, 1024); }
  { P p = loadP(); ph_transpose<true>(smem, p.w_in, DM, INC, 5760, p.WinT); }
  { P p = loadP(); ph_transpose<false>(smem, p.w_mk, DM, 512, 512, p.WmkT); }
  { P p = loadP(); ph_transpose<false>(smem, p.w_mv, DM, 512, 512, p.WmvT); }
  { P p = loadP(); ph_cvt(p.subk, p.subkb, (size_t)16 * 128 * 128); }
  { P p = loadP(); ph_transpose<false>(smem, p.w1_k, 4096, 128, 128, p.w1T); }
  { P p = loadP(); ph_transpose<false>(smem, p.w1_v, 4096, 128, 128, p.w1T + 128 * 4096); }
  { P p = loadP(); ph_transpose<false>(smem, p.w2_k, 128, 128, 128, p.w2T); }
  { P p = loadP(); ph_transpose<false>(smem, p.w2_v, 128, 128, 128, p.w2T + 128 * 128); }
  { P p = loadP(); ph_posb(p); }
  { P p = loadP(); for (int i = VB() * 256 + VT(); i < 2 * T_TOK; i += VG() * 256) p.rowss[i] = 0.f; }
  { P p = loadP(); for (int i = VB() * 256 + VT(); i < 16 * 16384; i += VG() * 256) p.cacc[i] = 0.f; }
  grid.sync();
  XcdBarrier xb;
  { P p = loadP(); xb = xcd_barrier_post(p.bar, (volatile LAS unsigned*)xbw); }
  { P p = loadP(); ph_proj(p, (char*)smem_all, lds); }
  const int kvb = (VG() == 512) ? ((VB() >= 384 && VB() < 416) ? (VB() - 384) * 8 : -1) : -2;
  const int vvb = (VG() == 512) ? ((VB() >= 416 && VB() < 448) ? (VB() - 416) * 8 : -1) : -2;
  { P p = loadP(); bf16_t* kmem = p.kmemb;
    ph_gemm_bf16(p.memn, DM, p.WmkT, DM, 1024, 512, DM, lds, [=](int m, int n, float v) {
      kmem[((size_t)((m >> 8) * 4 + (n >> 7)) * 256 + (m & 255)) * 128 + (n & 127)] = f2bf(v); }, kvb); }
  { P p = loadP(); bf16_t* vmem = p.vmemT;
    ph_gemm_bf16(p.memn, DM, p.WmvT, DM, 1024, 512, DM, lds, [=](int m, int n, float v) {
      vmem[((size_t)((m >> 8) * 4 + (n >> 7)) * 128 + (n & 127)) * 256 + perm16(m & 255)] = f2bf(v); }, vvb); }
  xcd_barrier(xb);
  {
    P p = loadP();
    if (VG() == 512) { if ((VB() & 15) >= 14) ph_compress2(p, lds, (VB() >> 4) * 2 + (VB() & 1), 64); }
    else ph_compress2(p, lds, VB(), VG());
  }
  { P p = loadP(); ph_sb2(p, lds); }
  {
    const bool full = (VG() == 512);
    const int vb = full ? (((VB() & 15) >= 14) ? -1 : (VB() >> 4) * 14 + (VB() & 15)) : VB(), nvb = full ? 448 : VG();
    vsync();
    { P p = loadP(); ph_transpose<false>(smem, p.w_out, DM, DM, DM, p.WoutT, vb, nvb); }
    { P p = loadP(); ph_transpose<false>(smem, p.w_mq, DM, 512, 512, p.WmqT, vb, nvb, p.norm_mq); }
  }
  xcd_barrier(xb);
  { P p = loadP(); ph_nsa2(p, lds); }
  xcd_barrier(xb);
  { P p = loadP(); const float* x = p.x; bf16_t* hn = p.hn; float* rss = p.rowss;
    ph_gemm_huge(p.omix, DM, p.WoutT, DM, T_TOK, DM, DM, (char*)smem_all, [=](int m, int n, f32x4_e lo, f32x4_e hi) {
      const f32x4_e x0 = *(const f32x4_e*)(x + (size_t)m * DM + n), x1 = *(const f32x4_e*)(x + (size_t)m * DM + n + 4);
      const f32x4_e h0 = x0 + lo, h1 = x1 + hi;
      resid_feed(h0, h1, n, hn + (size_t)m * DM, rss + m); }); }
  xcd_barrier(xb);
  {
    const int half = (VG() >= 512) ? 256 : 0;
    if (half == 0 || VB() < half) { P p = loadP(); ph_memq_attn(p, lds, VB(), half ? half : VG()); }
    if (VB() >= half) {
      const int nwv = (VG() - half) * 4, wid = (VB() - half) * 4 + (VT() >> 6);
      vsync();
      { P p = loadP(); ph_transpose<false>(smem, p.w_mo, 512, DM, DM, p.WmoT, VB() - half, VG() - half); }
      { P p = loadP(); ph_cvt4(p.pu, p.pu8, p.su8, 16384, wid, nwv); }
      { P p = loadP(); ph_cvt4(p.pv, p.pv8, p.sv8, 16384, wid, nwv); }
      vsync();
      { P p = loadP(); ph_transpose<false>(smem, p.w_pq, DM, DM, DM, p.WpqT, VB() - half, VG() - half, p.norm_ffn); }
    }
  }
  xcd_barrier(xb);
  { P p = loadP(); bf16_t* hn = p.hn; float* rss = p.rowss + T_TOK;
    ph_gemm_huge(p.omem, 512, p.WmoT, 512, T_TOK, DM, 512, (char*)smem_all, [=](int m, int n, f32x4_e lo, f32x4_e hi) {
      const u32x4 hb = *(const u32x4*)(hn + (size_t)m * DM + n);
      const f32x4_e r0 = {__uint_as_float(hb[0] << 16), __uint_as_float(hb[0] & 0xffff0000u),
                          __uint_as_float(hb[1] << 16), __uint_as_float(hb[1] & 0xffff0000u)};
      const f32x4_e r1 = {__uint_as_float(hb[2] << 16), __uint_as_float(hb[2] & 0xffff0000u),
                          __uint_as_float(hb[3] << 16), __uint_as_float(hb[3] & 0xffff0000u)};
      const f32x4_e h0 = r0 + lo, h1 = r1 + hi;
      resid_feed(h0, h1, n, hn + (size_t)m * DM, rss + m); }); }
  xcd_barrier(xb);
  { P p = loadP(); ph_qp_scores<0>(p, (char*)smem_all, lds); }
  xcd_barrier(xb);
  { P p = loadP(); ph_peer(p, smem); }
}

extern "C" void kernel_launch(void* const* d_in, const int* in_sizes, int n_in, void* d_out, int out_size, void* d_ws,
                              size_t ws_size, hipStream_t stream) {
  P p{};
  p.x = (const float*)d_in[0]; p.mem = (const float*)d_in[1]; p.t5 = (const float*)d_in[2];
  p.norm_mix = (const float*)d_in[3]; p.w_in = (const float*)d_in[4]; p.pos_k = (const float*)d_in[5];
  p.w1_k = (const float*)d_in[6]; p.w2_k = (const float*)d_in[7]; p.pos_v = (const float*)d_in[8];
  p.w1_v = (const float*)d_in[9]; p.w2_v = (const float*)d_in[10]; p.w_out = (const float*)d_in[11];
  p.norm_mq = (const float*)d_in[12]; p.norm_mkv = (const float*)d_in[13]; p.w_mq = (const float*)d_in[14];
  p.w_mk = (const float*)d_in[15]; p.w_mv = (const float*)d_in[16]; p.w_mo = (const float*)d_in[17];
  p.norm_ffn = (const float*)d_in[18]; p.w_pq = (const float*)d_in[19]; p.subk = (const float*)d_in[20];
  p.pu = (const float*)d_in[21]; p.pv = (const float*)d_in[22]; p.norm_final = (const float*)d_in[23];
  p.out = (float*)d_out;
  char* w = (char*)d_ws;
  size_t off = 0;
  auto take = [&](size_t bytes) { char* r = w + off; off += (bytes + 255) & ~(size_t)255; return r; };
  p.bar = (unsigned*)take(XCD_BAR_WORDS * 4);
  p.scores = (float*)take((size_t)T_TOK * DM * 4);
  p.gates = (float*)take((size_t)T_TOK * 24 * 4);
  p.part = (float*)take((size_t)T_TOK * 1024 * 4);
  p.posb = (float*)take(256 * 4);
  p.rowss = (float*)take((size_t)2 * T_TOK * 4);
  p.qn = (bf16_t*)take((size_t)T_TOK * 1024 * 2);
  p.kcin = (bf16_t*)take((size_t)T_TOK * 256 * 2 + 65536);
  p.vcin = (bf16_t*)take((size_t)T_TOK * 256 * 2 + 65536);
  p.ks = (bf16_t*)take((size_t)T_TOK * 256 * 2);
  p.vsT = (bf16_t*)take((size_t)T_TOK * 256 * 2);
  p.kw = (bf16_t*)take((size_t)T_TOK * 256 * 2);
  p.vwT = (bf16_t*)take((size_t)T_TOK * 256 * 2);
  p.kcb = (bf16_t*)take((size_t)8 * 128 * 128 * 2);
  p.vcT = (bf16_t*)take((size_t)8 * 128 * 128 * 2);
  p.c1 = (bf16_t*)take((size_t)16 * 128 * 128 * 2);
  p.cacc = (float*)take((size_t)16 * 16384 * 4);
  p.ccnt = (unsigned*)take(64);
  p.w1T = (bf16_t*)take((size_t)2 * 128 * 4096 * 2);
  p.w2T = (bf16_t*)take((size_t)2 * 128 * 128 * 2);
  p.hn = (bf16_t*)take((size_t)T_TOK * DM * 2);
  p.omix = (bf16_t*)take((size_t)T_TOK * DM * 2);
  p.memn = (bf16_t*)take((size_t)1024 * DM * 2);
  p.omem = (bf16_t*)take((size_t)T_TOK * 512 * 2);
  p.WinT = (bf16_t*)take((size_t)5760 * DM * 2);
  p.WoutT = (bf16_t*)take((size_t)DM * DM * 2);
  p.WpqT = (bf16_t*)take((size_t)DM * DM * 2);
  p.WmqT = (bf16_t*)take((size_t)512 * DM * 2);
  p.WmkT = (bf16_t*)take((size_t)512 * DM * 2);
  p.WmvT = (bf16_t*)take((size_t)512 * DM * 2);
  p.WmoT = (bf16_t*)take((size_t)DM * 512 * 2);
  p.qmemb = (bf16_t*)take((size_t)T_TOK * 512 * 2);
  p.kmemb = (bf16_t*)take((size_t)1024 * 512 * 2);
  p.vmemT = (bf16_t*)take((size_t)1024 * 512 * 2);
  p.qsb = (bf16_t*)take((size_t)T_TOK * 1024 * 2);
  p.ksb = (bf16_t*)take((size_t)T_TOK * 1024 * 2);
  p.vsbT = (bf16_t*)take((size_t)T_TOK * 1024 * 2);
  p.pu8 = (unsigned char*)take((size_t)16384 * 1024);
  p.pv8 = (unsigned char*)take((size_t)16384 * 1024);
  p.su8 = (float*)take(16384 * 4);
  p.sv8 = (float*)take(16384 * 4);
  p.subkb = (bf16_t*)take((size_t)16 * 128 * 128 * 2);
  static int grid_blocks = 0;
  if (!grid_blocks) {
    int dev = 0, cus = 0, per_cu = 0;
    (void)hipGetDevice(&dev);
    (void)hipDeviceGetAttribute(&cus, hipDeviceAttributeMultiprocessorCount, dev);
    (void)hipOccupancyMaxActiveBlocksPerMultiprocessor(&per_cu, mega, 512, 0);
    if (per_cu > 1) per_cu = 1;
    if (per_cu < 1) per_cu = 1;
    grid_blocks = cus * per_cu;
  }
  void* args[] = {&p};
  hipError_t e = hipLaunchCooperativeKernel((void*)mega, dim3(grid_blocks), dim3(512), args, 0, stream);
  if (e != hipSuccess) fprintf(stderr, "cooperative launch failed: %s (grid %d)\n", hipGetErrorString(e), grid_blocks);
}
```

```cpp
#include <hip/hip_runtime.h>
#include <hip/hip_cooperative_groups.h>
#include <cstdio>
namespace cg = cooperative_groups;
#include <stdint.h>

#define SEQ 2048
#define NBATCH 4
#define T_TOK 8192
#define DM 2048
#define INC 5656
#define C_QN 0
#define C_KC 1024
#define C_VC 1280
#define C_KS 1536
#define C_VS 1792
#define C_KW 2048
#define C_VW 2304
#define C_GT 2560
#define C_QSB 2584
#define C_KSB 3608
#define C_VSB 4632
#define ATT_SCALE 0.08838834764831845f
#define LOG2E 1.4426950408889634f
#define ATT_SCALE2 (ATT_SCALE * LOG2E)
#define RMS_EPS 1e-6f

typedef unsigned short bf16_t;
typedef __attribute__((ext_vector_type(8))) short bf16x8;
typedef __attribute__((ext_vector_type(16))) float f32x16;
typedef __attribute__((ext_vector_type(2))) __bf16 bf16v2;
typedef __attribute__((ext_vector_type(4))) unsigned u32x4;
typedef __attribute__((ext_vector_type(4))) int i32x4_t;
typedef __attribute__((ext_vector_type(8))) int i32x8_t;

struct P {
  const float *x, *mem, *t5, *norm_mix, *w_in, *pos_k, *w1_k, *w2_k, *pos_v, *w1_v, *w2_v, *w_out,
      *norm_mq, *norm_mkv, *w_mq, *w_mk, *w_mv, *w_mo, *norm_ffn, *w_pq, *subk, *pu, *pv, *norm_final;
  float* out;
  float *scores, *gates, *part, *posb, *rowss;
  unsigned* bar;
  bf16_t *hn, *omix, *memn, *omem;
  bf16_t *WinT, *WoutT, *WpqT, *WmqT, *WmkT, *WmvT, *WmoT;
  bf16_t *qmemb, *kmemb, *vmemT;
  bf16_t *qsb, *ksb, *vsbT;
  bf16_t* subkb;
  unsigned char *pu8, *pv8;
  float *su8, *sv8;
  bf16_t *qn, *kcin, *vcin, *ks, *vsT, *kw, *vwT, *kcb, *vcT, *c1, *w1T, *w2T;
  float* cacc;
  float* cpart;
  unsigned* ccnt;
};

__device__ __forceinline__ int opq(int v) { asm volatile("" : "+v"(v)); return v; }
#define LAS __attribute__((address_space(3)))
#define VHALF_BYTES 73728
#define VCNT_OFF (2 * VHALF_BYTES)
__device__ __forceinline__ int VT() { return opq(threadIdx.x) & 255; }
__device__ __forceinline__ int VB() { return (int)blockIdx.x * 2 + (int)(threadIdx.x >> 8); }
__device__ __forceinline__ int VG() { return (int)gridDim.x * 2; }
__device__ __forceinline__ void vbar_wait() {
  if ((threadIdx.x & 63) == 0) {
    LAS unsigned* c = (LAS unsigned*)(unsigned)(VCNT_OFF + 64 * (int)(threadIdx.x >> 8));
    const unsigned old = __hip_atomic_fetch_add(c, 1u, __ATOMIC_RELAXED, __HIP_MEMORY_SCOPE_WORKGROUP);
    const unsigned target = (old & ~3u) + 4u;
    while (__hip_atomic_load(c, __ATOMIC_RELAXED, __HIP_MEMORY_SCOPE_WORKGROUP) < target) __builtin_amdgcn_s_sleep(0);
  }
}
__device__ __forceinline__ void vsync() {
  __builtin_amdgcn_fence(__ATOMIC_RELEASE, "workgroup");
  vbar_wait();
  __builtin_amdgcn_fence(__ATOMIC_ACQUIRE, "workgroup");
}
__device__ __forceinline__ void vbar_wait_raw() {
  if ((threadIdx.x & 63) == 0) {
    const unsigned addr = (unsigned)(VCNT_OFF + 64 * (int)(threadIdx.x >> 8));
    unsigned old, cur;
    const unsigned one = 1u;
    asm volatile("ds_add_rtn_u32 %0, %1, %2\n\ts_waitcnt lgkmcnt(0)" : "=&v"(old) : "v"(addr), "v"(one) : "memory");
    const unsigned target = (old & ~3u) + 4u;
    for (;;) {
      asm volatile("ds_read_b32 %0, %1\n\ts_waitcnt lgkmcnt(0)" : "=&v"(cur) : "v"(addr) : "memory");
      if (cur >= target) break;
      __builtin_amdgcn_s_sleep(0);
    }
  }
}
__device__ __forceinline__ void vsync_raw() {
  asm volatile("" ::: "memory");
  vbar_wait_raw();
  asm volatile("" ::: "memory");
}

__device__ __forceinline__ unsigned pack2(float a, float b) {
  bf16v2 r = {(__bf16)a, (__bf16)b};
  return *(unsigned*)&r;
}
__device__ __forceinline__ bf16_t f2bf(float a) {
  __bf16 r = (__bf16)a;
  return *(bf16_t*)&r;
}
__device__ __forceinline__ int perm16(int s) { return (s & ~12) | ((s & 4) << 1) | ((s & 8) >> 1); }
__device__ __forceinline__ float bf2f(bf16_t u) { return __uint_as_float((unsigned)u << 16); }

__device__ __forceinline__ float wave_max(float v) {
  for (int o = 32; o > 0; o >>= 1) v = fmaxf(v, __shfl_xor(v, o));
  return v;
}
__device__ __forceinline__ float wave_sum(float v) {
  for (int o = 32; o > 0; o >>= 1) v += __shfl_xor(v, o);
  return v;
}
__device__ __forceinline__ float wave_sum_dpp_early(float v) {
  typedef __attribute__((ext_vector_type(2))) unsigned u32x2_d;
  v += __builtin_bit_cast(float, __builtin_amdgcn_update_dpp(0, __builtin_bit_cast(int, v), 0xB1, 0xF, 0xF, true));
  v += __builtin_bit_cast(float, __builtin_amdgcn_update_dpp(0, __builtin_bit_cast(int, v), 0x4E, 0xF, 0xF, true));
  v += __builtin_bit_cast(float, __builtin_amdgcn_update_dpp(0, __builtin_bit_cast(int, v), 0x141, 0xF, 0xF, true));
  v += __builtin_bit_cast(float, __builtin_amdgcn_update_dpp(0, __builtin_bit_cast(int, v), 0x140, 0xF, 0xF, true));
  u32x2_d r = __builtin_amdgcn_permlane16_swap(__float_as_uint(v), __float_as_uint(v), false, false);
  v = __uint_as_float(r[0]) + __uint_as_float(r[1]);
  r = __builtin_amdgcn_permlane32_swap(__float_as_uint(v), __float_as_uint(v), false, false);
  return __uint_as_float(r[0]) + __uint_as_float(r[1]);
}
__device__ __forceinline__ void wave_argmax(float& v, int& i) {
  for (int o = 32; o > 0; o >>= 1) {
    float ov = __shfl_xor(v, o);
    int oi = __shfl_xor(i, o);
    if (ov > v || (ov == v && oi < i)) { v = ov; i = oi; }
  }
}
__device__ __forceinline__ float gelu_tanh(float x) {
  return 0.5f * x * (1.f + tanhf(0.7978845608028654f * (x + 0.044715f * x * x * x)));
}
__device__ __forceinline__ float gelu_fast(float x) {
  const float y = 1.5957691216057308f * (x + 0.044715f * x * x * x);
  return x / (1.f + __expf(-y));
}
__device__ __forceinline__ int t5_bucket(int n) {
  if (n < 16) return n < 0 ? 0 : n;
  int b = 16;
  b += (n >= 19); b += (n >= 21); b += (n >= 24); b += (n >= 27); b += (n >= 31); b += (n >= 35);
  b += (n >= 40); b += (n >= 46); b += (n >= 52); b += (n >= 59); b += (n >= 67); b += (n >= 77);
  b += (n >= 87); b += (n >= 99); b += (n >= 113);
  return b;
}
__device__ __forceinline__ float log_sigmoid(float x) {
  return fminf(x, 0.f) - log1pf(expf(-fabsf(x)));
}

__device__ __forceinline__ void ph_rmsnorm(const float* src, const float* gain, bf16_t* dst, int rows) {
  int lane = VT() & 63, wv = VT() >> 6;
  float4 gq[8];
#pragma unroll
  for (int i = 0; i < 8; ++i) gq[i] = ((const float4*)gain)[i * 64 + lane];
  const int rstep = VG() * 4;
  int r = VB() * 4 + wv;
  float4 nv[8];
  if (r < rows) {
#pragma unroll
    for (int i = 0; i < 8; ++i) nv[i] = ((const float4*)(src + (size_t)r * DM))[i * 64 + lane];
  }
  for (; r < rows; r += rstep) {
    float4 v[8];
    float ss = 0.f;
#pragma unroll
    for (int i = 0; i < 8; ++i) {
      v[i] = nv[i];
      ss += v[i].x * v[i].x + v[i].y * v[i].y + v[i].z * v[i].z + v[i].w * v[i].w;
    }
    if (r + rstep < rows) {
#pragma unroll
      for (int i = 0; i < 8; ++i) nv[i] = ((const float4*)(src + (size_t)(r + rstep) * DM))[i * 64 + lane];
    }
    ss = wave_sum_dpp_early(ss);
    float rs = rsqrtf(ss * (1.f / DM) + RMS_EPS);
    uint2* d2 = (uint2*)(dst + (size_t)r * DM);
#pragma unroll
    for (int i = 0; i < 8; ++i) {
      const float4 g = gq[i];
      uint2 o;
      o.x = pack2(v[i].x * rs * g.x, v[i].y * rs * g.y);
      o.y = pack2(v[i].z * rs * g.z, v[i].w * rs * g.w);
      d2[i * 64 + lane] = o;
    }
  }
}

template <bool CMAP>
__device__ __forceinline__ void ph_transpose(float* smem, const float* W, int K, int N, int Npad, bf16_t* Wt,
                                             int vblock = -2, int nvb = 0, const float* gk = nullptr) {
  typedef __attribute__((ext_vector_type(4))) float f32x4;
  float (*tl)[65] = (float (*)[65])smem;
  if (vblock == -1) return;
  const int b0 = (vblock >= 0) ? vblock : VB(), bstride = (vblock >= 0) ? nvb : VG();
  const int tid = VT();
  const int nk = K / 64, nn = Npad / 64;
  const int kr = tid >> 4, n4 = (tid & 15) * 4;
  f32x4 nv0 = {0.f, 0.f, 0.f, 0.f}, nv1 = nv0, nv2 = nv0, nv3 = nv0;
  float ng0 = 1.f, ng1 = 1.f, ng2 = 1.f, ng3 = 1.f;
#define TR_FETCH(tile_)                                                                                   \
  {                                                                                                       \
    const int k0_ = ((tile_) % nk) * 64, n0_ = ((tile_) / nk) * 64;                                       \
    int sc_ = n0_ + n4;                                                                                   \
    if (CMAP) sc_ = (sc_ < 2560) ? sc_ : (sc_ < 5632) ? sc_ + 24 : (sc_ < 5656) ? sc_ - 5632 + 2560 : N;  \
    nv0 = nv1 = nv2 = nv3 = f32x4{0.f, 0.f, 0.f, 0.f};                                                    \
    if (sc_ < N) {                                                                                        \
      nv0 = *(const f32x4*)(W + (size_t)(k0_ + kr) * N + sc_);                                            \
      nv1 = *(const f32x4*)(W + (size_t)(k0_ + kr + 16) * N + sc_);                                       \
      nv2 = *(const f32x4*)(W + (size_t)(k0_ + kr + 32) * N + sc_);                                       \
      nv3 = *(const f32x4*)(W + (size_t)(k0_ + kr + 48) * N + sc_);                                       \
    }                                                                                                     \
    if (gk) { ng0 = gk[k0_ + kr]; ng1 = gk[k0_ + kr + 16]; ng2 = gk[k0_ + kr + 32]; ng3 = gk[k0_ + kr + 48]; } \
  }
  if (b0 < nk * nn) TR_FETCH(b0)
  for (int tile = b0; tile < nk * nn; tile += bstride) {
    const int k0 = (tile % nk) * 64, n0 = (tile / nk) * 64;
    {
      const f32x4 v0 = nv0 * ng0, v1 = nv1 * ng1, v2 = nv2 * ng2, v3 = nv3 * ng3;
      tl[kr][n4 + 0] = v0[0]; tl[kr][n4 + 1] = v0[1]; tl[kr][n4 + 2] = v0[2]; tl[kr][n4 + 3] = v0[3];
      tl[kr + 16][n4 + 0] = v1[0]; tl[kr + 16][n4 + 1] = v1[1]; tl[kr + 16][n4 + 2] = v1[2]; tl[kr + 16][n4 + 3] = v1[3];
      tl[kr + 32][n4 + 0] = v2[0]; tl[kr + 32][n4 + 1] = v2[1]; tl[kr + 32][n4 + 2] = v2[2]; tl[kr + 32][n4 + 3] = v2[3];
      tl[kr + 48][n4 + 0] = v3[0]; tl[kr + 48][n4 + 1] = v3[1]; tl[kr + 48][n4 + 2] = v3[2]; tl[kr + 48][n4 + 3] = v3[3];
    }
    if (tile + bstride < nk * nn) TR_FETCH(tile + bstride)
    vsync();
    int n = tid >> 2, kc = (tid & 3) * 16;
    unsigned w[8];
#pragma unroll
    for (int i = 0; i < 8; ++i) w[i] = pack2(tl[kc + 2 * i][n], tl[kc + 2 * i + 1][n]);
    uint4* dst = (uint4*)(Wt + (size_t)(n0 + n) * K + k0 + kc);
    dst[0] = make_uint4(w[0], w[1], w[2], w[3]);
    dst[1] = make_uint4(w[4], w[5], w[6], w[7]);
    vsync();
  }
#undef TR_FETCH
}

typedef __attribute__((ext_vector_type(4))) float f32x4_e;
struct EpiOp { f32x4_e a, b; };
struct NoPre { __device__ __forceinline__ EpiOp operator()(int, int) const { return EpiOp{}; } };
__device__ __forceinline__ int lds_off(int row, int chunk) { return row * 128 + ((chunk ^ ((row >> 1) & 7)) << 4); }

template <bool TR, bool VEC = false, bool PF = false, class Epi, class Pre = NoPre>
__device__ __forceinline__ void gemm_tile_bf16(const bf16_t* xp, int ldx, const bf16_t* yp, int ldy, int K, char* lds,
                                               Epi epi, Pre pre = Pre{}) {
  const int tid = VT(), lane = tid & 63, wv = tid >> 6;
  const int wr = wv >> 1, wc = wv & 1;
  f32x16 acc[2][2];
#pragma unroll
  for (int i = 0; i < 2; ++i)
#pragma unroll
    for (int j = 0; j < 2; ++j)
#pragma unroll
      for (int r = 0; r < 16; ++r) acc[i][j][r] = 0.f;
  const int prow = lane >> 3, pch = lane & 7;
  const bf16_t* xs[4];
  const bf16_t* ys[4];
#pragma unroll
  for (int ps = 0; ps < 4; ++ps) {
    const int row = (wv * 4 + ps) * 8 + prow;
    const int c = pch ^ ((row >> 1) & 7);
    xs[ps] = xp + (size_t)row * ldx + c * 8;
    ys[ps] = yp + (size_t)row * ldy + c * 8;
  }
  char* const mydst = lds + wv * 4096 + lane * 16;
#define GEMM_ISSUE(k0, bufoff)                                                                                              \
  _Pragma("unroll") for (int ps = 0; ps < 4; ++ps) {                                                                        \
    __builtin_amdgcn_global_load_lds((const unsigned*)(xs[ps] + (k0)), (unsigned*)(mydst + (bufoff) + ps * 1024), 16, 0, 0);         \
    __builtin_amdgcn_global_load_lds((const unsigned*)(ys[ps] + (k0)), (unsigned*)(mydst + (bufoff) + 16384 + ps * 1024), 16, 0, 0); \
  }
#define GEMM_COMPUTE(bufoff)                                                                                     \
  _Pragma("unroll") for (int kk = 0; kk < 4; ++kk) {                                                             \
    bf16x8 a[2], b[2];                                                                                           \
    const int ch = kk * 2 + (lane >> 5);                                                                         \
    _Pragma("unroll") for (int i = 0; i < 2; ++i) {                                                              \
      a[i] = *(const bf16x8*)(lds + (bufoff) + (TR ? 16384 : 0) + lds_off(wr * 64 + i * 32 + (lane & 31), ch)); \
      b[i] = *(const bf16x8*)(lds + (bufoff) + (TR ? 0 : 16384) + lds_off(wc * 64 + i * 32 + (lane & 31), ch)); \
    }                                                                                                            \
    _Pragma("unroll") for (int i = 0; i < 2; ++i)                                                                \
      _Pragma("unroll") for (int j = 0; j < 2; ++j)                                                              \
        acc[i][j] = __builtin_amdgcn_mfma_f32_32x32x16_bf16(a[i], b[j], acc[i][j], 0, 0, 0);                    \
  }
  vsync();
  GEMM_ISSUE(0, 0)
  for (int k0 = 0; k0 < K; k0 += 128) {
    asm volatile("s_waitcnt vmcnt(0)" ::: "memory");
    vsync();
    GEMM_ISSUE(k0 + 64, 32768)
    GEMM_COMPUTE(0)
    asm volatile("s_waitcnt vmcnt(0)" ::: "memory");
    vsync();
    if (k0 + 128 < K) { GEMM_ISSUE(k0 + 128, 0) }
    GEMM_COMPUTE(32768)
  }
#undef GEMM_ISSUE
#undef GEMM_COMPUTE
  int lane2 = lane;
  asm volatile("" : "+v"(lane2));
  if constexpr (VEC) {
    typedef __attribute__((ext_vector_type(4))) float f32x4;
    vsync();
    float* wl = (float*)lds + wv * (32 * 68);
    const int hh2 = lane2 >> 5, cl = lane2 & 31;
    EpiOp eo[8];
    if constexpr (PF) {
#pragma unroll
      for (int g = 0; g < 8; ++g) eo[g] = pre(wr * 64 + (g >> 2) * 32 + (lane2 >> 3) + 8 * (g & 3), wc * 64 + (lane2 & 7) * 8);
    }
#pragma unroll
    for (int i = 0; i < 2; ++i) {
#pragma unroll
      for (int j = 0; j < 2; ++j)
#pragma unroll
        for (int r = 0; r < 16; ++r) wl[((r & 3) + 8 * (r >> 2) + 4 * hh2) * 68 + j * 32 + cl] = acc[i][j][r];
      __builtin_amdgcn_wave_barrier();
#pragma unroll
      for (int k = 0; k < 4; ++k) {
        const int row = (lane2 >> 3) + 8 * k, c8 = (lane2 & 7) * 8;
        const f32x4 lo = *(const f32x4*)&wl[row * 68 + c8];
        const f32x4 hi = *(const f32x4*)&wl[row * 68 + c8 + 4];
        if constexpr (PF) epi(wr * 64 + i * 32 + row, wc * 64 + c8, lo, hi, eo[i * 4 + k]);
        else epi(wr * 64 + i * 32 + row, wc * 64 + c8, lo, hi);
      }
      __builtin_amdgcn_wave_barrier();
    }
  } else {
#pragma unroll
    for (int i = 0; i < 2; ++i)
#pragma unroll
      for (int j = 0; j < 2; ++j)
#pragma unroll
        for (int r = 0; r < 16; ++r) {
          int rr = wr * 64 + i * 32 + (r & 3) + 8 * (r >> 2) + 4 * (lane2 >> 5);
          int cc = wc * 64 + j * 32 + (lane2 & 31);
          epi(rr, cc, acc[i][j][r]);
        }
  }
}

__device__ __forceinline__ void st_bf16x8(bf16_t* dst, f32x4_e lo, f32x4_e hi) {
  u32x4 o;
  o[0] = pack2(lo[0], lo[1]); o[1] = pack2(lo[2], lo[3]); o[2] = pack2(hi[0], hi[1]); o[3] = pack2(hi[2], hi[3]);
  *(u32x4*)dst = o;
}

__device__ __forceinline__ int lds_off32(int row, int chunk) { return row * 64 + ((chunk ^ ((row >> 2) & 3)) << 4); }

template <class Epi>
__device__ __forceinline__ void gemm_tile_big(const bf16_t* xp, int ldx, const bf16_t* yp, int ldy, int K, char* lds,
                                              Epi epi) {
  const int tid = VT(), lane = tid & 63, wv = tid >> 6;
  f32x16 acc[2][4];
#pragma unroll
  for (int i = 0; i < 2; ++i)
#pragma unroll
    for (int j = 0; j < 4; ++j)
#pragma unroll
      for (int r = 0; r < 16; ++r) acc[i][j][r] = 0.f;
  const int prow = lane >> 2, pch = lane & 3;
  const bf16_t* xs[4];
  const bf16_t* ys[2];
#pragma unroll
  for (int ps = 0; ps < 4; ++ps) {
    const int row = (wv * 4 + ps) * 16 + prow;
    xs[ps] = xp + (size_t)row * ldx + (pch ^ ((row >> 2) & 3)) * 8;
  }
#pragma unroll
  for (int ps = 0; ps < 2; ++ps) {
    const int row = (wv * 2 + ps) * 16 + prow;
    ys[ps] = yp + (size_t)row * ldy + (pch ^ ((row >> 2) & 3)) * 8;
  }
  char* const xdst = lds + wv * 4096 + lane * 16;
  char* const ydst = lds + 16384 + wv * 2048 + lane * 16;
#define BIG_ISSUE(k0, st)                                                                                                      \
  _Pragma("unroll") for (int ps = 0; ps < 4; ++ps)                                                                             \
    __builtin_amdgcn_global_load_lds((const unsigned*)(xs[ps] + (k0)), (unsigned*)(xdst + (st) + ps * 1024), 16, 0, 0);        \
  _Pragma("unroll") for (int ps = 0; ps < 2; ++ps)                                                                             \
    __builtin_amdgcn_global_load_lds((const unsigned*)(ys[ps] + (k0)), (unsigned*)(ydst + (st) + ps * 1024), 16, 0, 0);
#define DSR(dst, addr, off) asm volatile("ds_read_b128 %0, %1 offset:%2" : "=v"(dst) : "v"(addr), "i"(off) : "memory")
#define WAIT1(n, x) asm volatile("s_waitcnt lgkmcnt(" #n ")" : "+v"(x))
#define WAIT2(n, x, y) asm volatile("s_waitcnt lgkmcnt(" #n ")" : "+v"(x), "+v"(y))
#define MF(acc_, a_, b_) acc_ = __builtin_amdgcn_mfma_f32_32x32x16_bf16(a_, b_, acc_, 0, 0, 0)
#define BIG_COMPUTE(st)                                                                                   \
  {                                                                                                       \
    bf16x8 a00, a01, a10, a11, b00, b01, b02, b03, b10, b11, b12, b13;                                    \
    const unsigned aa0 = abase0 + (st), aa1 = abase1 + (st), bb0 = bbase0 + (st), bb1 = bbase1 + (st);    \
    DSR(a00, aa0, 0); DSR(b00, bb0, 0); DSR(b01, bb0, 2048); DSR(b02, bb0, 4096); DSR(b03, bb0, 6144);    \
    DSR(a01, aa0, 2048);                                                                                  \
    DSR(a10, aa1, 0); DSR(b10, bb1, 0); DSR(b11, bb1, 2048); DSR(b12, bb1, 4096); DSR(b13, bb1, 6144);    \
    DSR(a11, aa1, 2048);                                                                                  \
    WAIT2(10, a00, b00); MF(acc[0][0], a00, b00);                                                         \
    WAIT1(9, b01); MF(acc[0][1], a00, b01);                                                               \
    WAIT1(8, b02); MF(acc[0][2], a00, b02);                                                               \
    WAIT1(7, b03); MF(acc[0][3], a00, b03);                                                               \
    WAIT1(6, a01); MF(acc[1][0], a01, b00); MF(acc[1][1], a01, b01); MF(acc[1][2], a01, b02); MF(acc[1][3], a01, b03); \
    WAIT2(4, a10, b10); MF(acc[0][0], a10, b10);                                                          \
    WAIT1(3, b11); MF(acc[0][1], a10, b11);                                                               \
    WAIT1(2, b12); MF(acc[0][2], a10, b12);                                                               \
    WAIT1(1, b13); MF(acc[0][3], a10, b13);                                                               \
    WAIT1(0, a11); MF(acc[1][0], a11, b10); MF(acc[1][1], a11, b11); MF(acc[1][2], a11, b12); MF(acc[1][3], a11, b13); \
  }
  const unsigned ldsb = (unsigned)(size_t)(__attribute__((address_space(3))) char*)lds;
  const unsigned abase0 = ldsb + lds_off32(wv * 64 + (lane & 31), 0 + (lane >> 5));
  const unsigned abase1 = ldsb + lds_off32(wv * 64 + (lane & 31), 2 + (lane >> 5));
  const unsigned bbase0 = ldsb + 16384 + lds_off32((lane & 31), 0 + (lane >> 5));
  const unsigned bbase1 = ldsb + 16384 + lds_off32((lane & 31), 2 + (lane >> 5));
  const int nsteps = K >> 5;
  vsync();
  BIG_ISSUE(0, 0)
  BIG_ISSUE(32, 24576)
  int cur = 0, nx2 = 49152;
  for (int t = 0; t < nsteps - 2; ++t) {
    asm volatile("s_waitcnt vmcnt(6)" ::: "memory");
    vsync_raw();
    BIG_ISSUE((t + 2) * 32, nx2)
    BIG_COMPUTE(cur)
    cur = (cur == 49152) ? 0 : cur + 24576;
    nx2 = (nx2 == 49152) ? 0 : nx2 + 24576;
  }
  asm volatile("s_waitcnt vmcnt(6)" ::: "memory");
  vsync_raw();
  BIG_COMPUTE(cur)
  cur = (cur == 49152) ? 0 : cur + 24576;
  asm volatile("s_waitcnt vmcnt(0)" ::: "memory");
  vsync_raw();
  BIG_COMPUTE(cur)
#undef BIG_ISSUE
#undef BIG_COMPUTE
#undef DSR
#undef WAIT1
#undef WAIT2
#undef MF
  const int lane2 = opq(lane);
  typedef __attribute__((ext_vector_type(4))) float f32x4;
  vsync();
  float* wl = (float*)lds + wv * (32 * 68);
  const int hh2 = lane2 >> 5, cl = lane2 & 31;
#pragma unroll
  for (int i = 0; i < 2; ++i)
#pragma unroll
    for (int jh = 0; jh < 2; ++jh) {
#pragma unroll
      for (int j = 0; j < 2; ++j)
#pragma unroll
        for (int r = 0; r < 16; ++r) wl[((r & 3) + 8 * (r >> 2) + 4 * hh2) * 68 + j * 32 + cl] = acc[i][jh * 2 + j][r];
      __builtin_amdgcn_wave_barrier();
#pragma unroll
      for (int k = 0; k < 4; ++k) {
        const int row = (lane2 >> 3) + 8 * k, c8 = (lane2 & 7) * 8;
        const f32x4 lo = *(const f32x4*)&wl[row * 68 + c8];
        const f32x4 hi = *(const f32x4*)&wl[row * 68 + c8 + 4];
        epi(wv * 64 + i * 32 + row, jh * 64 + c8, lo, hi);
      }
      __builtin_amdgcn_wave_barrier();
    }
}

template <class Epi>
__device__ __forceinline__ void ph_gemm_big(const bf16_t* A, int lda, const bf16_t* Wt, int ldw, int M, int N, int K,
                                            char* lds, Epi epi) {
  const int ntm = M / 256, ntn = N / 128;
  const int npm = (ntm + 7) / 8, npn = (ntn + 7) / 8;
  const int nslots = ((npm * npn * 64 + 511) / 512) * 512;
  for (int u = VB(); u < nslots; u += VG()) {
    int v = (u & 7) * 64 + ((u >> 3) & 63) + (u & ~511);
    int patch = v >> 6, w = v & 63;
    int tm = (patch % npm) * 8 + (w & 7);
    int tn = (patch / npm) * 8 + (w >> 3);
    if (tm >= ntm || tn >= ntn) continue;
    const int m0 = tm * 256, n0 = tn * 128;
    gemm_tile_big(A + (size_t)m0 * lda, lda, Wt + (size_t)n0 * ldw, ldw, K, lds,
                  [&](int r, int c, f32x4_e lo, f32x4_e hi) { epi(m0 + r, n0 + c, lo, hi); });
  }
}

template <int PM = 0, class Pre, class Fin>
__device__ __forceinline__ void gemm_tile_huge_pf(const bf16_t* xp, int ldx, const bf16_t* yp, int ldy, int K, char* lds0,
                                                  Pre pre, Fin epi) {
  const int tid = opq(threadIdx.x), lane = tid & 63, wv = tid >> 6;
  const int wr = wv >> 2, wc = wv & 3;
  f32x16 acc[4][2];
#pragma unroll
  for (int i = 0; i < 4; ++i)
#pragma unroll
    for (int j = 0; j < 2; ++j)
#pragma unroll
      for (int r = 0; r < 16; ++r) acc[i][j][r] = 0.f;
  const int prow = lane >> 3, pch = lane & 7;
  const bf16_t* xs[4];
  const bf16_t* ys[4];
#pragma unroll
  for (int ps = 0; ps < 4; ++ps) {
    const int row = (wv * 4 + ps) * 8 + prow;
    const int c = pch ^ ((row >> 1) & 7);
    xs[ps] = xp + (size_t)row * ldx + c * 8;
    ys[ps] = yp + (size_t)row * ldy + c * 8;
  }
  char* const xdst = lds0 + wv * 4096 + lane * 16;
#define HUGE_ISSUE(k0, st)                                                                                                          \
  _Pragma("unroll") for (int ps = 0; ps < 4; ++ps) {                                                                                \
    __builtin_amdgcn_global_load_lds((const unsigned*)(xs[ps] + (k0)), (unsigned*)(xdst + (st) + ps * 1024), 16, 0, 0);             \
    __builtin_amdgcn_global_load_lds((const unsigned*)(ys[ps] + (k0)), (unsigned*)(xdst + (st) + 32768 + ps * 1024), 16, 0, 0);     \
  }
#define HDSR(dst, addr, off) asm volatile("ds_read_b128 %0, %1 offset:%2" : "=v"(dst) : "v"(addr), "i"(off) : "memory")
#define HREAD(S, ab, bb)                                                                            \
  HDSR(S##a0, ab, 0); HDSR(S##b0, bb, 0); HDSR(S##b1, bb, 4096); HDSR(S##a1, ab, 4096);             \
  HDSR(S##a2, ab, 8192); HDSR(S##a3, ab, 12288);
#define HWAIT(n, S)                                                                                 \
  asm volatile("s_waitcnt lgkmcnt(" #n ")" : "+v"(S##a0), "+v"(S##a1), "+v"(S##a2), "+v"(S##a3), "+v"(S##b0), "+v"(S##b1))
#define HMF(i, j, S) acc[i][j] = __builtin_amdgcn_mfma_f32_32x32x16_bf16(S##a##i, S##b##j, acc[i][j], 0, 0, 0)
#define HMMA(S) HMF(0, 0, S); HMF(0, 1, S); HMF(1, 0, S); HMF(1, 1, S); HMF(2, 0, S); HMF(2, 1, S); HMF(3, 0, S); HMF(3, 1, S);
  const unsigned ldsb = (unsigned)(size_t)(LAS char*)lds0;
  const int frow = lane & 31, fh = lane >> 5;
  const unsigned ab0 = ldsb + lds_off(wr * 128 + frow, 0 + fh), ab1 = ldsb + lds_off(wr * 128 + frow, 2 + fh);
  const unsigned ab2 = ldsb + lds_off(wr * 128 + frow, 4 + fh), ab3 = ldsb + lds_off(wr * 128 + frow, 6 + fh);
  const unsigned bb0 = ldsb + 32768 + lds_off(wc * 64 + frow, 0 + fh), bb1 = ldsb + 32768 + lds_off(wc * 64 + frow, 2 + fh);
  const unsigned bb2 = ldsb + 32768 + lds_off(wc * 64 + frow, 4 + fh), bb3 = ldsb + 32768 + lds_off(wc * 64 + frow, 6 + fh);
  __syncthreads();
  HUGE_ISSUE(0, 0)
  bf16x8 Ea0, Ea1, Ea2, Ea3, Eb0, Eb1, Oa0, Oa1, Oa2, Oa3, Ob0, Ob1;
  asm volatile("s_waitcnt vmcnt(0)" ::: "memory");
  __syncthreads();
  if (64 < K) { HUGE_ISSUE(64, 65536u) }
  HREAD(E, ab0, bb0)
  HREAD(O, ab1, bb1)
  HWAIT(6, E); HMMA(E)
  HREAD(E, ab2, bb2)
  HWAIT(6, O); HMMA(O)
  HREAD(O, ab3, bb3)
  HWAIT(6, E); HMMA(E)
  HWAIT(0, O);
  unsigned st = 65536u;
  for (int k0 = 64; k0 < K; k0 += 64) {
    asm volatile("s_waitcnt vmcnt(0)" ::: "memory");
    __syncthreads();
    const unsigned a0 = ab0 + st, a1 = ab1 + st, a2 = ab2 + st, a3 = ab3 + st;
    const unsigned b0 = bb0 + st, b1 = bb1 + st, b2 = bb2 + st, b3 = bb3 + st;
    HREAD(E, a0, b0)
    HWAIT(6, O); HMMA(O)
    if (k0 + 64 < K) { HUGE_ISSUE(k0 + 64, st ^ 65536u) }
    HREAD(O, a1, b1)
    HWAIT(6, E); HMMA(E)
    HREAD(E, a2, b2)
    HWAIT(6, O); HMMA(O)
    HREAD(O, a3, b3)
    HWAIT(6, E); HMMA(E)
    HWAIT(0, O);
    st ^= 65536u;
  }
  HMMA(O)
#undef HUGE_ISSUE
#undef HDSR
#undef HREAD
#undef HWAIT
#undef HMF
#undef HMMA
  const int lane2 = opq(lane);
  typedef __attribute__((ext_vector_type(4))) float f32x4;
  __syncthreads();
  float* wl = (float*)lds0 + wv * (32 * 68);
  const int hh2 = lane2 >> 5, cl = lane2 & 31;
  const int erow = lane2 >> 3, pc8 = (lane2 & 7) * 8;
  EpiOp nx0 = pre(wr * 128 + erow, wc * 64 + pc8), nx1 = pre(wr * 128 + erow + 8, wc * 64 + pc8);
  EpiOp nx2 = pre(wr * 128 + erow + 16, wc * 64 + pc8), nx3 = pre(wr * 128 + erow + 24, wc * 64 + pc8);
#pragma unroll
  for (int i = 0; i < 4; ++i) {
    const EpiOp c0 = nx0, c1 = nx1, c2 = nx2, c3 = nx3;
#pragma unroll
    for (int j = 0; j < 2; ++j)
#pragma unroll
      for (int r = 0; r < 16; ++r) wl[((r & 3) + 8 * (r >> 2) + 4 * hh2) * 68 + j * 32 + cl] = acc[i][j][r];
    if (i < 3) {
      const int rb = wr * 128 + (i + 1) * 32 + erow;
      nx0 = pre(rb, wc * 64 + pc8); nx1 = pre(rb + 8, wc * 64 + pc8); nx2 = pre(rb + 16, wc * 64 + pc8); nx3 = pre(rb + 24, wc * 64 + pc8);
    }
    __builtin_amdgcn_sched_barrier(0);
    __builtin_amdgcn_wave_barrier();
#pragma unroll
    for (int k = 0; k < 4; ++k) {
      const int row = erow + 8 * k, c8 = pc8;
      const f32x4 lo = *(const f32x4*)&wl[row * 68 + c8];
      const f32x4 hi = *(const f32x4*)&wl[row * 68 + c8 + 4];
      const EpiOp op = (k == 0) ? c0 : (k == 1) ? c1 : (k == 2) ? c2 : c3;
      if (PM != 3) epi(wr * 128 + i * 32 + row, wc * 64 + c8, lo, hi, op);
    }
    __builtin_amdgcn_sched_barrier(0);
    __builtin_amdgcn_wave_barrier();
  }
  __syncthreads();
}
template <int PM = 0, class Epi>
__device__ __forceinline__ void gemm_tile_huge(const bf16_t* xp, int ldx, const bf16_t* yp, int ldy, int K, char* lds0,
                                               Epi epi) {
  gemm_tile_huge_pf<PM>(xp, ldx, yp, ldy, K, lds0, NoPre{},
                        [&](int r, int c, f32x4_e lo, f32x4_e hi, const EpiOp&) { epi(r, c, lo, hi); });
}

template <class Pre, class Fin>
__device__ __forceinline__ void ph_gemm_huge_pf(const bf16_t* A, int lda, const bf16_t* Wt, int ldw, int M, int N, int K,
                                                char* lds0, Pre pre, Fin fin) {
  const int ntm = M / 256, ntn = N / 256;
  for (int u = (int)blockIdx.x; u < ntm * ntn; u += (int)gridDim.x) {
    const int x = u & 7, i = (u >> 3) & 31, rnd = u >> 8;
    const int tm = (x & 3) * 8 + (i & 7), tn = rnd * 8 + (x >> 2) * 4 + (i >> 3);
    if (tm >= ntm || tn >= ntn) continue;
    const int m0 = tm * 256, n0 = tn * 256;
    gemm_tile_huge_pf(A + (size_t)m0 * lda, lda, Wt + (size_t)n0 * ldw, ldw, K, lds0,
                      [&](int r, int c) { return pre(m0 + r, n0 + c); },
                      [&](int r, int c, f32x4_e lo, f32x4_e hi, const EpiOp& op) { fin(m0 + r, n0 + c, lo, hi, op); });
  }
}

template <class Epi>
__device__ __forceinline__ void ph_gemm_huge(const bf16_t* A, int lda, const bf16_t* Wt, int ldw, int M, int N, int K,
                                             char* lds0, Epi epi) {
  const int ntm = M / 256, ntn = N / 256;
  for (int u = (int)blockIdx.x; u < ntm * ntn; u += (int)gridDim.x) {
    const int x = u & 7, i = (u >> 3) & 31, rnd = u >> 8;
    const int tm = (x & 3) * 8 + (i & 7), tn = rnd * 8 + (x >> 2) * 4 + (i >> 3);
    if (tm >= ntm || tn >= ntn) continue;
    const int m0 = tm * 256, n0 = tn * 256;
    gemm_tile_huge(A + (size_t)m0 * lda, lda, Wt + (size_t)n0 * ldw, ldw, K, lds0,
                   [&](int r, int c, f32x4_e lo, f32x4_e hi) { epi(m0 + r, n0 + c, lo, hi); });
  }
}

__device__ __forceinline__ void norm_feed(const f32x4_e h0, const f32x4_e h1, const float* gain, int n, bf16_t* hn_row,
                                          float* rowss_m) {
  const f32x4_e g0 = *(const f32x4_e*)(gain + n), g1 = *(const f32x4_e*)(gain + n + 4);
  st_bf16x8(hn_row + n, h0 * g0, h1 * g1);
  float ss = h0[0] * h0[0] + h0[1] * h0[1] + h0[2] * h0[2] + h0[3] * h0[3] + h1[0] * h1[0] + h1[1] * h1[1] + h1[2] * h1[2] + h1[3] * h1[3];
  ss += __shfl_xor(ss, 1);
  ss += __shfl_xor(ss, 2);
  ss += __shfl_xor(ss, 4);
  if (((VT()) & 7) == 0) atomicAdd(rowss_m, ss);
}

__device__ __forceinline__ void resid_feed(const f32x4_e h0, const f32x4_e h1, int n, bf16_t* hb_row, float* rowss_m) {
  st_bf16x8(hb_row + n, h0, h1);
  float ss = h0[0] * h0[0] + h0[1] * h0[1] + h0[2] * h0[2] + h0[3] * h0[3] + h1[0] * h1[0] + h1[1] * h1[1] + h1[2] * h1[2] + h1[3] * h1[3];
  ss += __shfl_xor(ss, 1);
  ss += __shfl_xor(ss, 2);
  ss += __shfl_xor(ss, 4);
  if (((VT()) & 7) == 0) atomicAdd(rowss_m, ss);
}

template <bool VEC = false, class Epi>
__device__ __forceinline__ void ph_gemm_bf16(const bf16_t* A, int lda, const bf16_t* Wt, int ldw, int M, int N, int K,
                                             char* lds, Epi epi, int vblock = -2) {
  const int ntm = M / 128, ntn = N / 128;
  const int npm = (ntm + 7) / 8, npn = (ntn + 7) / 8;
  const int nslots = ((npm * npn * 64 + 511) / 512) * 512;
  if (vblock == -1) return;
  for (int u = (vblock >= 0 ? vblock : VB()); u < nslots; u += VG()) {
    int v = (u & 7) * 64 + ((u >> 3) & 63) + (u & ~511);
    int patch = v >> 6, w = v & 63;
    int tm = (patch % npm) * 8 + (w & 7);
    int tn = (patch / npm) * 8 + (w >> 3);
    if (tm >= ntm || tn >= ntn) continue;
    const int m0 = tm * 128, n0 = tn * 128;
    if constexpr (VEC)
      gemm_tile_bf16<false, true>(A + (size_t)m0 * lda, lda, Wt + (size_t)n0 * ldw, ldw, K, lds,
                                  [&](int r, int c, f32x4_e lo, f32x4_e hi) { epi(m0 + r, n0 + c, lo, hi); });
    else
      gemm_tile_bf16<false>(A + (size_t)m0 * lda, lda, Wt + (size_t)n0 * ldw, ldw, K, lds,
                            [&](int r, int c, float val) { epi(m0 + r, n0 + c, val); });
  }
}

__device__ __forceinline__ void ph_proj(const P& p, char* lds0, char* lds) {
  for (int u = (int)blockIdx.x; u < 512; u += (int)gridDim.x) {
    const int x = u & 7, i = (u >> 3) & 31, rnd = u >> 8;
    const int tm = (x & 3) * 8 + (i & 7), tp = rnd * 8 + (x >> 2) * 4 + (i >> 3);
    const int tb = tp * 2;
    const int tn = (tb < 14) ? tb : (tb < 16) ? tb + 2 : tb + 4;
    const int m0 = tm * 256, n0 = tn * 128;
    const int b = m0 >> 11, sl = m0 & 2047;
    const bf16_t* A = p.hn + (size_t)m0 * DM;
    const bf16_t* W = p.WinT + (size_t)n0 * DM;
    if (n0 < 1024 || (n0 >= 2560 && n0 < 3584)) {
      bf16_t* dst = (n0 < 1024) ? p.qn + (size_t)m0 * 1024 + n0 : p.qsb + (size_t)m0 * 1024 + (n0 - 2560);
      gemm_tile_huge(A, DM, W, DM, DM, lds0, [&](int r, int c, f32x4_e lo, f32x4_e hi) { st_bf16x8(dst + (size_t)r * 1024 + c, lo, hi); });
    } else if (n0 < 2560) {
      const int seg = (n0 - 1024) >> 8;
      bf16_t* base = (seg == 0) ? p.kcin : (seg == 1) ? p.vcin : (seg == 2) ? p.ks : p.kw;
      bf16_t* dst = base + ((size_t)(b * 2) * SEQ + sl) * 128;
      gemm_tile_huge(A, DM, W, DM, DM, lds0, [&](int r, int c, f32x4_e lo, f32x4_e hi) {
        st_bf16x8(dst + ((size_t)(c >> 7) * SEQ + r) * 128 + (c & 127), lo, hi); });
    } else {
      bf16_t* dst = p.ksb + ((size_t)(b * 8 + ((n0 - 3584) >> 7)) * SEQ + sl) * 128;
      gemm_tile_huge(A, DM, W, DM, DM, lds0, [&](int r, int c, f32x4_e lo, f32x4_e hi) {
        st_bf16x8(dst + ((size_t)(c >> 7) * SEQ + r) * 128 + (c & 127), lo, hi); });
    }
  }
  for (int u = (int)blockIdx.x; u < 192; u += (int)gridDim.x) {
    const int tm = u & 31, tv = u >> 5;
    const int n0 = (tv == 0) ? 1792 : (tv == 1) ? 2304 : 4608 + (tv - 2) * 256;
    const int m0 = tm * 256;
    const int b = m0 >> 11, sl = m0 & 2047;
    bf16_t* vd;
    if (tv < 2) vd = (tv == 0 ? p.vsT : p.vwT) + ((size_t)(b * 2) * 128) * SEQ + sl;
    else vd = p.vsbT + ((size_t)(b * 8 + (tv - 2) * 2) * 128) * SEQ + sl;
    gemm_tile_huge(p.WinT + (size_t)n0 * DM, DM, p.hn + (size_t)m0 * DM, DM, DM, lds0,
                   [&](int r, int c, f32x4_e lo, f32x4_e hi) {
                     bf16_t* row = vd + (size_t)r * SEQ;
                     uint2 wa, wb;
                     wa.x = pack2(lo[0], lo[1]); wa.y = pack2(lo[2], lo[3]);
                     wb.x = pack2(hi[0], hi[1]); wb.y = pack2(hi[2], hi[3]);
                     const int pa = (c & 8) ? c - 4 : c, pb = (c & 8) ? c + 4 : c + 8;
                     *(uint2*)(row + pa) = wa;
                     *(uint2*)(row + pb) = wb; });
  }
  {
    const int vb = VB();
    if (VG() != 512 || vb >= 448) {
      for (int tm = (VG() == 512) ? vb - 448 : vb; tm < 64; tm += (VG() == 512) ? 64 : VG()) {
        const int m0 = tm * 128;
        float* gd = p.gates + (size_t)m0 * 24;
        gemm_tile_bf16<false>(p.hn + (size_t)m0 * DM, DM, p.WinT + (size_t)5632 * DM, DM, DM, lds,
                              [&](int r, int c, float val) { if (c < 24) gd[(size_t)r * 24 + c] = val; });
      }
    }
  }
}

__device__ __forceinline__ void ph_posb(const P& p) {
  const int lane = VT() & 63, wv = VT() >> 6;
  for (int o = VB() * 4 + wv; o < 256; o += VG() * 4) {
    const int which = o >> 7, n = o & 127;
    const float* pos = which ? p.pos_v : p.pos_k;
    const float* w1 = which ? p.w1_v : p.w1_k;
    float acc = 0.f;
    for (int k = lane; k < 4096; k += 64) acc += pos[k] * w1[(size_t)k * 128 + n];
    acc = wave_sum(acc);
    if (lane == 0) p.posb[o] = acc;
  }
}

__device__ __forceinline__ void ph_compress2(const P& p, char* lds, int w0, int wstride) {
  volatile unsigned* lastf = (volatile unsigned*)(lds + 65536);
  for (int w = w0; w < 64; w += wstride) {
    const int item = w >> 2, ks = w & 3;
    const int which = item >> 3, bg = item & 7;
    const bf16_t* src = (which ? p.vcin : p.kcin) + (size_t)bg * SEQ * 128 + ks * 1024;
    const bf16_t* w1t = p.w1T + (size_t)which * 128 * 4096 + ks * 1024;
    const bf16_t* w2t = p.w2T + (size_t)which * 128 * 128;
    const float* posb = p.posb + which * 128;
    bf16_t* c1 = p.c1 + (size_t)item * 128 * 128;
    float* part = p.cpart + (size_t)w * 16384;
    gemm_tile_bf16<false, true>(src, 2048, w1t, 4096, 1024, lds, [&](int r, int c, f32x4_e lo, f32x4_e hi) {
      float* d = part + r * 128 + c;
      asm volatile("global_store_dwordx4 %0, %1, off sc0 sc1\n\tglobal_store_dwordx4 %0, %2, off offset:16 sc0 sc1"
                   :: "v"(d), "v"(lo), "v"(hi) : "memory"); });
    asm volatile("s_waitcnt vmcnt(0)" ::: "memory");
    vsync();
    if (VT() == 0) lastf[0] = __hip_atomic_fetch_add(p.ccnt + item, 1u, __ATOMIC_RELAXED, __HIP_MEMORY_SCOPE_AGENT);
    vsync();
    const unsigned arrived = lastf[0];
    vsync();
    if (arrived != 3u) continue;
    const float* pb = p.cpart + (size_t)item * 4 * 16384;
    for (int idx = VT() * 4; idx < 16384; idx += 1024) {
      f32x4_e a0, a1, a2, a3;
      const float* q = pb + idx;
      asm volatile("global_load_dwordx4 %0, %4, off sc0 sc1\n\tglobal_load_dwordx4 %1, %5, off sc0 sc1\n\t"
                   "global_load_dwordx4 %2, %6, off sc0 sc1\n\tglobal_load_dwordx4 %3, %7, off sc0 sc1\n\t"
                   "s_waitcnt vmcnt(0)"
                   : "=&v"(a0), "=&v"(a1), "=&v"(a2), "=&v"(a3) : "v"(q), "v"(q + 16384), "v"(q + 32768), "v"(q + 49152) : "memory");
      const f32x4_e sm = (a0 + a1) + (a2 + a3);
      const int c = idx & 127;
      uint2 wv2;
      wv2.x = pack2(gelu_fast(sm[0] + posb[c]), gelu_fast(sm[1] + posb[c + 1]));
      wv2.y = pack2(gelu_fast(sm[2] + posb[c + 2]), gelu_fast(sm[3] + posb[c + 3]));
      *(uint2*)(c1 + idx) = wv2;
    }
    __threadfence_block();
    vsync();
    if (which == 0) {
      bf16_t* kd = p.kcb + (size_t)bg * 128 * 128;
      gemm_tile_bf16<false>(c1, 128, w2t, 128, 128, lds, [&](int r, int c, float val) { kd[r * 128 + c] = f2bf(val); });
    } else {
      bf16_t* vd = p.vcT + (size_t)bg * 128 * 128;
      gemm_tile_bf16<true>(c1, 128, w2t, 128, 128, lds, [&](int r, int c, float val) { vd[r * 128 + perm16(c)] = f2bf(val); });
    }
  }
}

#define NEG_BIG (-1e30f)

struct KVRegs { u32x4 k0, k1, k2, k3, v0, v1, v2, v3; };

__device__ __forceinline__ int koff(int row, int chunk) { return row * 256 + ((chunk ^ (row & 15)) << 4); }

__device__ __forceinline__ void kv_load(KVRegs& r, const bf16_t* kp, int ldk, const bf16_t* vp, int ldv) {
  const int tid = VT();
  const bf16_t* kg = kp + (size_t)(tid >> 4) * ldk + (tid & 15) * 8;
  r.k0 = *(const u32x4*)kg;
  r.k1 = *(const u32x4*)(kg + (size_t)16 * ldk);
  r.k2 = *(const u32x4*)(kg + (size_t)32 * ldk);
  r.k3 = *(const u32x4*)(kg + (size_t)48 * ldk);
  const bf16_t* vg = vp + (size_t)(tid >> 3) * ldv + (tid & 7) * 8;
  r.v0 = *(const u32x4*)vg;
  r.v1 = *(const u32x4*)(vg + (size_t)32 * ldv);
  r.v2 = *(const u32x4*)(vg + (size_t)64 * ldv);
  r.v3 = *(const u32x4*)(vg + (size_t)96 * ldv);
}
__device__ __forceinline__ void kv_store(const KVRegs& r, char* lk, char* lv) {
  const int tid = VT();
  const int row = tid >> 4, ch = tid & 15;
  *(u32x4*)(lk + koff(row, ch)) = r.k0;
  *(u32x4*)(lk + koff(row + 16, ch)) = r.k1;
  *(u32x4*)(lk + koff(row + 32, ch)) = r.k2;
  *(u32x4*)(lk + koff(row + 48, ch)) = r.k3;
  const int vr = tid >> 3, vc = tid & 7;
  *(u32x4*)(lv + lds_off(vr, vc)) = r.v0;
  *(u32x4*)(lv + lds_off(vr + 32, vc)) = r.v1;
  *(u32x4*)(lv + lds_off(vr + 64, vc)) = r.v2;
  *(u32x4*)(lv + lds_off(vr + 96, vc)) = r.v3;
}

__device__ __forceinline__ void kv_dma(const bf16_t* kp, int ldk, const bf16_t* vp, int ldv, char* lk, char* lv) {
  const int tid = VT(), w = tid >> 6, L = tid & 63;
  const int krow = 4 * w + (L >> 4);
  const bf16_t* kg = kp + (size_t)krow * ldk + ((L & 15) ^ krow) * 8;
  char* kd = lk + (4 * w) * 256 + L * 16;
  const int vrow = 8 * w + (L >> 3);
  const bf16_t* vg = vp + (size_t)vrow * ldv + ((L & 7) ^ ((vrow >> 1) & 7)) * 8;
  char* vd = lv + (8 * w) * 128 + L * 16;
#pragma unroll
  for (int i = 0; i < 4; ++i) {
    __builtin_amdgcn_global_load_lds((const unsigned*)(kg + (size_t)(16 * i) * ldk), (unsigned*)(kd + i * 4096), 16, 0, 0);
    __builtin_amdgcn_global_load_lds((const unsigned*)(vg + (size_t)(32 * i) * ldv), (unsigned*)(vd + i * 4096), 16, 0, 0);
  }
}

__device__ __forceinline__ void k_dma(const bf16_t* kp, int ldk, char* lk) {
  const int tid = VT(), w = tid >> 6, L = tid & 63;
  const int krow = 4 * w + (L >> 4);
  const bf16_t* kg = kp + (size_t)krow * ldk + ((L & 15) ^ krow) * 8;
  char* kd = lk + (4 * w) * 256 + L * 16;
#pragma unroll
  for (int i = 0; i < 4; ++i)
    __builtin_amdgcn_global_load_lds((const unsigned*)(kg + (size_t)(16 * i) * ldk), (unsigned*)(kd + i * 4096), 16, 0, 0);
}
__device__ __forceinline__ void v_dma(const bf16_t* vp, int ldv, char* lv) {
  const int tid = VT(), w = tid >> 6, L = tid & 63;
  const int vrow = 8 * w + (L >> 3);
  const bf16_t* vg = vp + (size_t)vrow * ldv + ((L & 7) ^ ((vrow >> 1) & 7)) * 8;
  char* vd = lv + (8 * w) * 128 + L * 16;
#pragma unroll
  for (int i = 0; i < 4; ++i)
    __builtin_amdgcn_global_load_lds((const unsigned*)(vg + (size_t)(32 * i) * ldv), (unsigned*)(vd + i * 4096), 16, 0, 0);
}

struct QFrag { bf16x8 f0, f1, f2, f3, f4, f5, f6, f7; };
__device__ __forceinline__ void q_load(QFrag& q, const bf16_t* qrow) {
  const int h = (VT() & 63) >> 5;
  const bf16x8* p8 = (const bf16x8*)(qrow + 8 * h);
  q.f0 = p8[0]; q.f1 = p8[2]; q.f2 = p8[4]; q.f3 = p8[6]; q.f4 = p8[8]; q.f5 = p8[10]; q.f6 = p8[12]; q.f7 = p8[14];
}

__device__ __forceinline__ void qk_tile(const QFrag& q, const char* lk, f32x16& s0, f32x16& s1) {
  const int lane = VT() & 63, row = lane & 31, h = lane >> 5;
#pragma unroll
  for (int r = 0; r < 16; ++r) { s0[r] = 0.f; s1[r] = 0.f; }
  const unsigned a0 = (unsigned)(size_t)(LAS const char*)lk + (unsigned)(row * 256 + ((h ^ (row & 15)) << 4));
#define QDSR(dst, addr, off) asm volatile("ds_read_b128 %0, %1 offset:%2" : "=v"(dst) : "v"(addr), "i"(off) : "memory")
#define QWAIT(n, x, y) asm volatile("s_waitcnt lgkmcnt(" #n ")" : "+v"(x), "+v"(y))
  bf16x8 e0, e1, o0, o1;
  QDSR(e0, a0, 0); QDSR(e1, a0, 8192);
#define QK_PAIR(kk, qfe, qfo, last)                                                      \
  {                                                                                      \
    const unsigned an = a0 ^ (unsigned)(((kk) + 1) << 5);                                \
    QDSR(o0, an, 0); QDSR(o1, an, 8192);                                                 \
    QWAIT(2, e0, e1);                                                                    \
    s0 = __builtin_amdgcn_mfma_f32_32x32x16_bf16(e0, qfe, s0, 0, 0, 0);                  \
    s1 = __builtin_amdgcn_mfma_f32_32x32x16_bf16(e1, qfe, s1, 0, 0, 0);                  \
    if (!(last)) {                                                                       \
      const unsigned am = a0 ^ (unsigned)(((kk) + 2) << 5);                              \
      QDSR(e0, am, 0); QDSR(e1, am, 8192);                                               \
      QWAIT(2, o0, o1);                                                                  \
    } else {                                                                             \
      QWAIT(0, o0, o1);                                                                  \
    }                                                                                    \
    s0 = __builtin_amdgcn_mfma_f32_32x32x16_bf16(o0, qfo, s0, 0, 0, 0);                  \
    s1 = __builtin_amdgcn_mfma_f32_32x32x16_bf16(o1, qfo, s1, 0, 0, 0);                  \
  }
  QK_PAIR(0, q.f0, q.f1, false) QK_PAIR(2, q.f2, q.f3, false) QK_PAIR(4, q.f4, q.f5, false) QK_PAIR(6, q.f6, q.f7, true)
#undef QK_PAIR
#undef QDSR
#undef QWAIT
}

__device__ __forceinline__ bf16x8 pack8(const f32x16& p, const int base) {
  u32x4 u;
  u[0] = pack2(p[base + 0], p[base + 1]);
  u[1] = pack2(p[base + 2], p[base + 3]);
  u[2] = pack2(p[base + 4], p[base + 5]);
  u[3] = pack2(p[base + 6], p[base + 7]);
  return __builtin_bit_cast(bf16x8, u);
}

typedef __attribute__((ext_vector_type(2))) unsigned u32x2_t;
__device__ __forceinline__ float xhalf_max(float v) {
  const u32x2_t r = __builtin_amdgcn_permlane32_swap(__float_as_uint(v), __float_as_uint(v), false, false);
  return fmaxf(__uint_as_float(r[0]), __uint_as_float(r[1]));
}
__device__ __forceinline__ float xhalf_sum(float v) {
  const u32x2_t r = __builtin_amdgcn_permlane32_swap(__float_as_uint(v), __float_as_uint(v), false, false);
  return __uint_as_float(r[0]) + __uint_as_float(r[1]);
}
__device__ __forceinline__ float xhalf_get(float v, int hh) {
  const u32x2_t r = __builtin_amdgcn_permlane32_swap(__float_as_uint(v), __float_as_uint(v), false, false);
  return hh ? __uint_as_float(r[0]) : __uint_as_float(r[1]);
}
struct OAcc { f32x16 o0, o1, o2, o3; };
__device__ __forceinline__ void oacc_zero(OAcc& o) {
#pragma unroll
  for (int r = 0; r < 16; ++r) { o.o0[r] = 0.f; o.o1[r] = 0.f; o.o2[r] = 0.f; o.o3[r] = 0.f; }
}
__device__ __forceinline__ void oacc_scale(OAcc& o, float a) {
#pragma unroll
  for (int r = 0; r < 16; ++r) { o.o0[r] *= a; o.o1[r] *= a; o.o2[r] *= a; o.o3[r] *= a; }
}

__device__ __forceinline__ void pv_tile(OAcc& o, const char* lv, const f32x16& p0, const f32x16& p1) {
  const int lane = VT() & 63, row = lane & 31, h = lane >> 5;
  const bf16x8 pf0 = pack8(p0, 0), pf1 = pack8(p0, 8), pf2 = pack8(p1, 0), pf3 = pack8(p1, 8);
#define PV_ROW(dd, acc)                                                                                      \
  {                                                                                                          \
    acc = __builtin_amdgcn_mfma_f32_32x32x16_bf16(*(const bf16x8*)(lv + lds_off(32 * (dd) + row, 0 + h)), pf0, acc, 0, 0, 0); \
    acc = __builtin_amdgcn_mfma_f32_32x32x16_bf16(*(const bf16x8*)(lv + lds_off(32 * (dd) + row, 2 + h)), pf1, acc, 0, 0, 0); \
    acc = __builtin_amdgcn_mfma_f32_32x32x16_bf16(*(const bf16x8*)(lv + lds_off(32 * (dd) + row, 4 + h)), pf2, acc, 0, 0, 0); \
    acc = __builtin_amdgcn_mfma_f32_32x32x16_bf16(*(const bf16x8*)(lv + lds_off(32 * (dd) + row, 6 + h)), pf3, acc, 0, 0, 0); \
  }
  PV_ROW(0, o.o0) PV_ROW(1, o.o1) PV_ROW(2, o.o2) PV_ROW(3, o.o3)
#undef PV_ROW
}

typedef __attribute__((ext_vector_type(2))) float f32x2_s;
#define SPAIR(v, i) __builtin_shufflevector(v, v, (i), (i) + 1)
__device__ __forceinline__ void softmax_tile(f32x16& s0, f32x16& s1, float& m, float& l, OAcc& o, const float sc = 1.f,
                                             const float bb = 0.f) {
  float mr = -INFINITY;
#pragma unroll
  for (int r = 0; r < 16; ++r) asm("v_max3_f32 %0, %1, %2, %3" : "=v"(mr) : "v"(mr), "v"(s0[r]), "v"(s1[r]));
  float mx = fmaf(mr, sc, bb);
  mx = (mx != mx) ? -INFINITY : mx;
  mx = xhalf_max(fmaxf(mx, NEG_BIG));
  const bool grow = __any(mx - m > 8.f);
  const float mn = grow ? fmaxf(m, mx) : m;
  const float alpha = __builtin_amdgcn_exp2f(m - mn);
  const f32x2_s sc2 = {sc, sc}, c2 = {bb - mn, bb - mn};
  f32x2_s ls2 = {0.f, 0.f};
#pragma unroll
  for (int r = 0; r < 16; r += 2) {
    const f32x2_s pa_in = {s0[r], s0[r + 1]}, pb_in = {s1[r], s1[r + 1]};
    const f32x2_s a = __builtin_elementwise_fma(pa_in, sc2, c2);
    const f32x2_s b = __builtin_elementwise_fma(pb_in, sc2, c2);
    const float a0 = __builtin_amdgcn_exp2f(a[0]), a1 = __builtin_amdgcn_exp2f(a[1]);
    const float b0 = __builtin_amdgcn_exp2f(b[0]), b1 = __builtin_amdgcn_exp2f(b[1]);
    s0[r] = a0; s0[r + 1] = a1; s1[r] = b0; s1[r + 1] = b1;
    const f32x2_s pa = {a0, a1}, pb = {b0, b1};
    ls2 = ls2 + pa + pb;
  }
  const float ls = xhalf_sum(ls2[0] + ls2[1]);
  l = l * alpha + ls;
  m = mn;
  if (__any(alpha != 1.f)) oacc_scale(o, alpha);
}

template <class F>
__device__ __forceinline__ void oacc_foreach_i(const OAcc& o, F f) {
  const int h = (VT() & 63) >> 5;
#pragma unroll
  for (int rho = 0; rho < 4; ++rho) {
    f(4 * rho + 0, 0 + 8 * rho + 4 * h, o.o0[4 * rho], o.o0[4 * rho + 1], o.o0[4 * rho + 2], o.o0[4 * rho + 3]);
    f(4 * rho + 1, 32 + 8 * rho + 4 * h, o.o1[4 * rho], o.o1[4 * rho + 1], o.o1[4 * rho + 2], o.o1[4 * rho + 3]);
    f(4 * rho + 2, 64 + 8 * rho + 4 * h, o.o2[4 * rho], o.o2[4 * rho + 1], o.o2[4 * rho + 2], o.o2[4 * rho + 3]);
    f(4 * rho + 3, 96 + 8 * rho + 4 * h, o.o3[4 * rho], o.o3[4 * rho + 1], o.o3[4 * rho + 2], o.o3[4 * rho + 3]);
  }
}
template <class F>
__device__ __forceinline__ void oacc_foreach(const OAcc& o, F f) {
  const int h = (VT() & 63) >> 5;
#pragma unroll
  for (int rho = 0; rho < 4; ++rho) {
    f(0 + 8 * rho + 4 * h, o.o0[4 * rho], o.o0[4 * rho + 1], o.o0[4 * rho + 2], o.o0[4 * rho + 3]);
    f(32 + 8 * rho + 4 * h, o.o1[4 * rho], o.o1[4 * rho + 1], o.o1[4 * rho + 2], o.o1[4 * rho + 3]);
    f(64 + 8 * rho + 4 * h, o.o2[4 * rho], o.o2[4 * rho + 1], o.o2[4 * rho + 2], o.o2[4 * rho + 3]);
    f(96 + 8 * rho + 4 * h, o.o3[4 * rho], o.o3[4 * rho + 1], o.o3[4 * rho + 2], o.o3[4 * rho + 3]);
  }
}

__device__ __forceinline__ void memattn_item(const P& p, char* lds, int item) {
  char* lk = lds;
  char* lv = lds + 16384;
  const int lane = VT() & 63, wv = VT() >> 6;
  {
    const int tb = item % (SEQ / 128);
    const int bh = item / (SEQ / 128);
    const int b = bh >> 2, hd = bh & 3;
    const int t = tb * 128 + wv * 32 + (lane & 31);
    QFrag q;
    q_load(q, p.qmemb + (size_t)(b * SEQ + t) * 512 + hd * 128);
    const bf16_t* kb = p.kmemb + (size_t)bh * 256 * 128;
    const bf16_t* vb = p.vmemT + (size_t)bh * 128 * 256;
    OAcc o;
    oacc_zero(o);
    float m = NEG_BIG, l = 0.f;
    KVRegs kv;
    kv_load(kv, kb, 128, vb, 256);
#pragma unroll 1
    for (int ti = 0; ti < 4; ++ti) {
      vsync();
      kv_store(kv, lk, lv);
      vsync();
      {
        const int tn = (ti + 1 < 4) ? ti + 1 : 3;
        kv_load(kv, kb + (size_t)tn * 64 * 128, 128, vb + tn * 64, 256);
      }
      f32x16 s0, s1;
      qk_tile(q, lk, s0, s1);
      softmax_tile(s0, s1, m, l, o, ATT_SCALE2, 0.f);
      pv_tile(o, lv, s0, s1);
    }
    const float il = 1.f / l;
    const int t2 = tb * 128 + (VT() >> 6) * 32 + (VT() & 31);
    bf16_t* orow = p.omem + (size_t)(b * SEQ + t2) * 512 + hd * 128;
    oacc_foreach(o, [&](int d, float v0, float v1, float v2, float v3) {
      uint2 u;
      u.x = pack2(v0 * il, v1 * il);
      u.y = pack2(v2 * il, v3 * il);
      *(uint2*)(orow + d) = u;
    });
  }
}

__device__ __forceinline__ void ph_memq_attn(const P& p, char* lds, int vblock, int nvb) {
  if (vblock < 0) return;
  const float* rss = p.rowss;
  for (int u = vblock; u < 64 * 4; u += nvb) {
    const int tm = u & 63, hd = u >> 6;
    const int m0 = tm * 128;
    bf16_t* qd = p.qmemb + (size_t)m0 * 512 + hd * 128;
    gemm_tile_bf16<false, true, true>(p.hn + (size_t)m0 * DM, DM, p.WmqT + (size_t)hd * 128 * DM, DM, DM, lds,
                                [&](int r, int c, f32x4_e lo, f32x4_e hi, const EpiOp& op) {
                                  const float rs = rsqrtf(op.a[0] * (1.f / DM) + RMS_EPS);
                                  st_bf16x8(qd + (size_t)r * 512 + c, lo * rs, hi * rs); },
                                [&](int r, int) { EpiOp o; o.a = f32x4_e{rss[m0 + r], 0.f, 0.f, 0.f}; o.b = o.a; return o; });
    __threadfence_block();
    vsync();
    memattn_item(p, lds, ((m0 >> 11) * 4 + hd) * (SEQ / 128) + ((m0 & 2047) >> 7));
  }
}

template <bool CHK>
__device__ __forceinline__ void sb_pass1(f32x16& z, f32x16& l, const int s_first, const int t) {
  const f32x2_s sc2 = {ATT_SCALE2, ATT_SCALE2}, one2 = {1.f, 1.f};
#pragma unroll
  for (int r = 0; r < 16; r += 2) {
    const f32x2_s zin = {z[r], z[r + 1]};
    const f32x2_s zz = zin * sc2;
    const f32x2_s ee = {__builtin_amdgcn_exp2f(-fabsf(zz[0])), __builtin_amdgcn_exp2f(-fabsf(zz[1]))};
    const f32x2_s tt = ee + one2;
    const f32x2_s lg = {__builtin_amdgcn_logf(tt[0]), __builtin_amdgcn_logf(tt[1])};
    const f32x2_s mn = {fminf(zz[0], 0.f), fminf(zz[1], 0.f)};
    const f32x2_s lf = (mn - lg) - zz;
    if (CHK) {
      const int so = s_first + 8 * (r >> 2) + (r & 3);
      const bool v0 = so < t, v1 = so + 1 < t;
      l[r] = v0 ? lf[0] : 0.f; l[r + 1] = v1 ? lf[1] : 0.f;
      z[r] = v0 ? zz[0] : NEG_BIG; z[r + 1] = v1 ? zz[1] : NEG_BIG;
    } else {
      l[r] = lf[0]; l[r + 1] = lf[1];
      z[r] = zz[0]; z[r + 1] = zz[1];
    }
  }
}
__device__ __forceinline__ void sb_pass3(f32x16& z, const f32x16& l, const float* ag) {
#pragma unroll
  for (int rho = 0; rho < 4; ++rho) {
    const float x3 = l[4 * rho + 3], x23 = x3 + l[4 * rho + 2], x123 = x23 + l[4 * rho + 1];
    const float g = ag[rho];
    const f32x2_s g2 = {g, g};
    const f32x2_s la = {l[4 * rho + 0], l[4 * rho + 1]}, lb = {l[4 * rho + 2], l[4 * rho + 3]};
    const f32x2_s za = {z[4 * rho + 0], z[4 * rho + 1]}, zb = {z[4 * rho + 2], z[4 * rho + 3]};
    const f32x2_s xa = {x123, x23}, xb = {x3, 0.f};
    const f32x2_s aa = (la + za) + (g2 + xa), ab = (lb + zb) + (g2 + xb);
    z[4 * rho + 0] = __builtin_amdgcn_exp2f(aa[0]); z[4 * rho + 1] = __builtin_amdgcn_exp2f(aa[1]);
    z[4 * rho + 2] = __builtin_amdgcn_exp2f(ab[0]); z[4 * rho + 3] = __builtin_amdgcn_exp2f(ab[1]);
  }
}

__device__ __forceinline__ void ph_sb2(const P& p, char* lds) {
  char* lk = lds;
  char* lv = lds + 16384;
  const int lane = VT() & 63, wv = VT() >> 6, hh = lane >> 5;
  const bool full = (VG() == 512);
  const int rs = VB() & 15;
  if (full && (rs == 1 || rs == 3)) return;
  const int nit = full ? ((rs == 5 || rs == 7) ? 2 : 1) : 0;
  for (int it = 0, item = VB(); full ? (it < nit) : (item < NBATCH * 8 * (SEQ / 128)); ++it, item += (full ? -4 : VG())) {
    const int ri = item & 15;
    const int tb = full ? ((ri & 1) ? (ri >> 1) : 15 - (ri >> 1)) : (SEQ / 128 - 1) - (item % (SEQ / 128));
    const int bh = item / (SEQ / 128);
    const int b = bh >> 3, hd = bh & 7;
    const int t0 = tb * 128;
    const int t = t0 + wv * 32 + (lane & 31);
    QFrag q;
    q_load(q, p.qsb + (size_t)(b * SEQ + t) * 1024 + hd * 128);
    const bf16_t* kb = p.ksb + (size_t)bh * SEQ * 128;
    const bf16_t* vb = p.vsbT + (size_t)bh * 128 * SEQ;
    OAcc o;
    oacc_zero(o);
    float carry = 0.f;
    const int jhi = (t0 >> 6) + 1;
    const int jw = (t0 + wv * 32 + 30) >> 6;
    KVRegs kv;
    kv_load(kv, kb + (size_t)jhi * 64 * 128, 128, vb + jhi * 64, SEQ);
    volatile unsigned* dflag = (volatile unsigned*)(lds + 32768);
    vsync();
    if (VT() < 4) dflag[VT()] = 0u;
    for (int j = jhi; j >= 0; --j) {
      vsync();
      if ((dflag[0] & dflag[1] & dflag[2] & dflag[3]) != 0u) break;
      kv_store(kv, lk, lv);
      vsync();
      const int jn = (j > 0) ? j - 1 : 0;
      if (j > jw) kv_load(kv, kb + (size_t)jn * 64 * 128, 128, vb + jn * 64, SEQ);
      if (j <= jw) {
        f32x16 z0, z1;
        qk_tile(q, lk, z0, z1);
        const int sbase = j * 64 + 4 * hh;
        float gt[8];
        f32x16 l0, l1;
        if (j * 64 + 63 < t0 + wv * 32) {
          sb_pass1<false>(z0, l0, sbase, t);
          sb_pass1<false>(z1, l1, sbase + 32, t);
        } else {
          sb_pass1<true>(z0, l0, sbase, t);
          sb_pass1<true>(z1, l1, sbase + 32, t);
        }
#pragma unroll
        for (int rho = 0; rho < 4; ++rho) {
          gt[rho] = (l0[4 * rho] + l0[4 * rho + 1]) + (l0[4 * rho + 2] + l0[4 * rho + 3]);
          gt[4 + rho] = (l1[4 * rho] + l1[4 * rho + 1]) + (l1[4 * rho + 2] + l1[4 * rho + 3]);
        }
        float ag[8];
        float run = 0.f;
#pragma unroll
        for (int k = 7; k >= 0; --k) {
          const float pg = xhalf_get(gt[k], hh);
          ag[k] = carry + run + (hh == 0 ? pg : 0.f);
          run += gt[k] + pg;
        }
        carry += run;
        sb_pass3(z0, l0, ag);
        sb_pass3(z1, l1, ag + 4);
        kv_load(kv, kb + (size_t)jn * 64 * 128, 128, vb + jn * 64, SEQ);
        pv_tile(o, lv, z0, z1);
        if (__all(carry < -104.f * LOG2E) && (VT() & 63) == 0) dflag[wv] = 1u;
      }
    }
    int t2 = t;
    asm volatile("" : "+v"(t2));
    bf16_t* orow = p.omix + (size_t)(b * SEQ + t2) * DM + 1024 + hd * 128;
    oacc_foreach(o, [&](int d, float v0, float v1, float v2, float v3) {
      uint2 u;
      u.x = pack2(v0, v1);
      u.y = pack2(v2, v3);
      *(uint2*)(orow + d) = u;
    });
  }
}


template <bool SEL>
__device__ __forceinline__ void nsa_tile_mask(f32x16& s0, f32x16& s1, float& fsc, float& fbb, int j, int t0,
                                              unsigned mysel, const LAS float* lut_base) {
  int hh;
  const LAS float* lut;
  const int lid_ = VT();
  hh = (lid_ >> 5) & 1;
  lut = lut_base + ((lid_ >> 6) & 3) * 128;
  int tqv = t0 + (lid_ & 31);
  asm volatile("" : "+v"(tqv));
  fsc = 1.f; fbb = 0.f;
  if (SEL) {
    const bool selq = (mysel >> j) & 1u;
    if (j * 64 + 63 + 113 <= t0) {
      fsc = selq ? ATT_SCALE2 : 0.f; fbb = selq ? lut[127] : -INFINITY;
    } else {
#pragma unroll
      for (int r = 0; r < 16; ++r) {
        const int d0 = tqv - (j * 64 + 8 * (r >> 2) + (r & 3) + 4 * hh), d1 = d0 - 32;
        { const float bias_ = lut[min(max(d0, 0), 127)]; const float v_ = s0[r] * ATT_SCALE2 + bias_; s0[r] = (selq && d0 >= 0) ? v_ : -INFINITY; }
        { const float bias_ = lut[min(max(d1, 0), 127)]; const float v_ = s1[r] * ATT_SCALE2 + bias_; s1[r] = (selq && d1 >= 0) ? v_ : -INFINITY; }
      }
    }
  } else {
    if (j * 64 + 63 + 113 <= t0 && t0 + 31 - j * 64 < 512) {
      fsc = ATT_SCALE2; fbb = lut[127];
    } else {
#pragma unroll
      for (int r = 0; r < 16; ++r) {
        const int d0 = tqv - (j * 64 + 8 * (r >> 2) + (r & 3) + 4 * hh), d1 = d0 - 32;
        { const float bias_ = lut[min(max(d0, 0), 127)]; const float v_ = s0[r] * ATT_SCALE2 + bias_; s0[r] = (d0 >= 0 && d0 < 512) ? v_ : -INFINITY; }
        { const float bias_ = lut[min(max(d1, 0), 127)]; const float v_ = s1[r] * ATT_SCALE2 + bias_; s1[r] = (d1 >= 0 && d1 < 512) ? v_ : -INFINITY; }
      }
    }
  }
}

template <bool SEL, bool PRE = false>
__device__ __forceinline__ int nsa_branch(unsigned tiles, const bf16_t* kb, const bf16_t* vb, const QFrag& q, char* lk,
                                          char* lv, const LAS float* lut, unsigned mysel, int t0, OAcc& o,
                                          float& m, float& l, int vstart = 0, const bf16_t* nkp = nullptr,
                                          const bf16_t* nvp = nullptr) {
  unsigned rem = tiles;
  int jp = __builtin_ctz(rem);
  rem &= rem - 1;
  if (!PRE) {
    vsync();
    k_dma(kb + (size_t)jp * 64 * 128, 128, lk);
    vsync();
  }
  int jn = -1;
  if (rem) { jn = __builtin_ctz(rem); rem &= rem - 1; k_dma(kb + (size_t)jn * 64 * 128, 128, lk + 32768); }
  if (!PRE) { v_dma(vb + jp * 64, SEQ, lv); vstart = 0; }
  f32x16 a0, a1;
  float fa, ba;
  qk_tile(q, lk, a0, a1);
  nsa_tile_mask<SEL>(a0, a1, fa, ba, jp, t0, mysel, lut);
  vsync();
  int kb_ = 1, vb_ = vstart;
#define NSA_STEP(C0, C1, FC, BC, P0, P1, FP, BP)                                                     \
  {                                                                                                  \
    const int jc = jn;                                                                               \
    jn = -1;                                                                                         \
    if (rem) { jn = __builtin_ctz(rem); rem &= rem - 1; k_dma(kb + (size_t)jn * 64 * 128, 128, lk + (kb_ ^ 1) * 32768); } \
    v_dma(vb + jc * 64, SEQ, lv + (vb_ ^ 1) * 32768);                                                \
    qk_tile(q, lk + kb_ * 32768, C0, C1);                                                            \
    softmax_tile(P0, P1, m, l, o, FP, BP);                                                           \
    pv_tile(o, lv + vb_ * 32768, P0, P1);                                                            \
    nsa_tile_mask<SEL>(C0, C1, FC, BC, jc, t0, mysel, lut);                                  \
    vsync();                                                                                         \
    jp = jc; kb_ ^= 1; vb_ ^= 1;                                                                     \
  }
  int nleft = __builtin_popcount(tiles) - 1;
  if (nleft & 1) {
    f32x16 c0, c1;
    float fc, bc;
    NSA_STEP(c0, c1, fc, bc, a0, a1, fa, ba)
    a0 = c0; a1 = c1; fa = fc; ba = bc;
  }
  for (int it = nleft >> 1; it > 0; --it) {
    f32x16 b0, b1;
    float fb2, bb2;
    NSA_STEP(b0, b1, fb2, bb2, a0, a1, fa, ba)
    NSA_STEP(a0, a1, fa, ba, b0, b1, fb2, bb2)
  }
#undef NSA_STEP
  if (nkp) { k_dma(nkp, 128, lk); v_dma(nvp, SEQ, lv + (vb_ ^ 1) * 32768); }
  softmax_tile(a0, a1, m, l, o, fa, ba);
  pv_tile(o, lv + vb_ * 32768, a0, a1);
  vsync();
  return vb_ ^ 1;
}

#define NSA_IMP 32768
#define NSA_KEYS 49152
#define NSA_SELM 53504
#define NSA_LUT 65536
__device__ __forceinline__ void ph_nsa2(const P& p, char* lds) {
  typedef __attribute__((ext_vector_type(4))) float f32x4;
  char* lk = lds;
  char* lv = lds + 16384;
  float* imp = (float*)(lds + NSA_IMP);
  float* keys = (float*)(lds + NSA_KEYS);
  unsigned* selm = (unsigned*)(lds + NSA_SELM);
  const int tid = VT(), lane = tid & 63, wv = tid >> 6, hh = lane >> 5, ql = lane & 31;
  LAS float* lut = (LAS float*)(LAS char*)(lds + NSA_LUT) + wv * 128;
  for (int item = VB(); item < NBATCH * 2 * (SEQ / 32); item += VG()) {
    int tt, bg;
    if (VG() == 512) {
      const int wg_ = item >> 1, pr_ = wg_ & 31;
      bg = wg_ >> 5;
      tt = (item & 1) ? pr_ : (SEQ / 32 - 1) - pr_;
      if ((item & 1) == 0) __builtin_amdgcn_s_setprio(2);
    } else {
      tt = (item < 256) ? (SEQ / 32 - 1) - (item % (SEQ / 32)) : (item % (SEQ / 32));
      bg = item / (SEQ / 32);
    }
    const int b = bg >> 1, g = bg & 1;
    const int h = g * 4 + wv;
    const int t0 = tt * 32, tq = t0 + ql, cur = t0 >> 6;
    vsync();
    {
      const bf16_t* kb = p.kcb + (size_t)bg * 128 * 128;
      const bf16_t* vb = p.vcT + (size_t)bg * 128 * 128;
      kv_dma(kb, 128, vb, 128, lk, lv);
      if (t0 >= 1024) kv_dma(kb + 64 * 128, 128, vb + 64, 128, lk + 32768, lv + 32768);
    }
    QFrag q;
    q_load(q, p.qn + (size_t)(b * SEQ + tq) * 1024 + h * 128);
    {
      const int lo = opq(lane);
      lut[lo] = p.t5[t5_bucket(lo) * 8 + h] * LOG2E;
      lut[lo + 64] = p.t5[t5_bucket(lo + 64) * 8 + h] * LOG2E;
    }
    OAcc o;
    float m, l;
    {
      oacc_zero(o);
      m = NEG_BIG; l = 0.f;
      vsync();
      f32x16 x0, x1;
      qk_tile(q, lk, x0, x1);
      int tqv = tq;
      asm volatile("" : "+v"(tqv));
      tqv -= 64 * hh;
      float fsc = 1.f, fbb = 0.f;
      if (t0 >= 1152) {
        fsc = ATT_SCALE2; fbb = lut[127];
      } else {
#pragma unroll
        for (int r = 0; r < 16; ++r) {
          const int c = 8 * (r >> 2) + (r & 3);
          const int d0 = tqv - 16 * c - 31, d1 = d0 - 512;
          { const float bias_ = lut[min(max(d0, 0), 127)]; const float v_ = x0[r] * ATT_SCALE2 + bias_; x0[r] = (d0 >= 0) ? v_ : -INFINITY; }
          { const float bias_ = lut[min(max(d1, 0), 127)]; const float v_ = x1[r] * ATT_SCALE2 + bias_; x1[r] = (d1 >= 0) ? v_ : -INFINITY; }
        }
      }
      softmax_tile(x0, x1, m, l, o, fsc, fbb);
      const float m0 = m;
      pv_tile(o, lv, x0, x1);
      f32x16 z0, z1;
#pragma unroll
      for (int r = 0; r < 16; ++r) { z0[r] = 0.f; z1[r] = 0.f; }
      if (t0 >= 1024) {
        qk_tile(q, lk + 32768, z0, z1);
        asm volatile("" : "+v"(tqv));
#pragma unroll
        for (int r = 0; r < 16; ++r) {
          const int c = 64 + 8 * (r >> 2) + (r & 3);
          const int d0 = tqv - 16 * c - 31, d1 = d0 - 512;
          { const float bias_ = lut[min(max(d0, 0), 127)]; const float v_ = z0[r] * ATT_SCALE2 + bias_; z0[r] = (d0 >= 0) ? v_ : -INFINITY; }
          { const float bias_ = lut[min(max(d1, 0), 127)]; const float v_ = z1[r] * ATT_SCALE2 + bias_; z1[r] = (d1 >= 0) ? v_ : -INFINITY; }
        }
        softmax_tile(z0, z1, m, l, o);
        pv_tile(o, lv + 32768, z0, z1);
      }
      vsync();
      k_dma(p.ks + (size_t)bg * SEQ * 128, 128, lk);
      v_dma(p.vsT + (size_t)bg * 128 * SEQ, SEQ, lv);
      if (tid < 32) selm[tid] = 0u;
      const float inv = 1.f / fmaxf(l, 1e-20f);
      const float c0 = __builtin_amdgcn_exp2f(m0 - m) * inv;
      {
        float* slab = imp + wv * 1024;
        float prevB = 0.f;
#pragma unroll
        for (int idx = 0; idx < 16; ++idx) {
          const int vec = idx >> 2, rho = idx & 3;
          const float sc_ = (vec < 2) ? c0 : inv;
          const float q0 = (vec == 0 ? x0[4 * rho] : vec == 1 ? x1[4 * rho] : vec == 2 ? z0[4 * rho] : z1[4 * rho]) * sc_;
          const float q1 = (vec == 0 ? x0[4 * rho + 1] : vec == 1 ? x1[4 * rho + 1] : vec == 2 ? z0[4 * rho + 1] : z1[4 * rho + 1]) * sc_;
          const float q2 = (vec == 0 ? x0[4 * rho + 2] : vec == 1 ? x1[4 * rho + 2] : vec == 2 ? z0[4 * rho + 2] : z1[4 * rho + 2]) * sc_;
          const float q3 = (vec == 0 ? x0[4 * rho + 3] : vec == 1 ? x1[4 * rho + 3] : vec == 2 ? z0[4 * rho + 3] : z1[4 * rho + 3]) * sc_;
          const float Bv = 0.5f * q3;
          const float Av = (q0 + q1) + (q2 + Bv);
          const float send = hh ? prevB : Bv;
          const float got = xhalf_get(send, hh);
          slab[(8 * vec + 2 * rho + hh) * 32 + ql] = Av + got;
          prevB = Bv;
        }
      }
      const float gs = inv / (1.f + __expf(-p.gates[(size_t)(b * SEQ + opq(tq)) * 24 + h * 3]));
      bf16_t* prow = (bf16_t*)p.part + (size_t)(b * SEQ + opq(tq)) * 1024 + h * 128;
      oacc_foreach(o, [&](int d, float v0, float v1, float v2, float v3) {
        uint2 w;
        w.x = pack2(v0 * gs, v1 * gs);
        w.y = pack2(v2 * gs, v3 * gs);
        *(uint2*)(prow + d) = w;
      });
    }
    vsync();
    {
      const int tido = opq(tid);
      const int qq = tido & 31, jg = tido >> 5;
#pragma unroll
      for (int jj = 0; jj < 4; ++jj) {
        const int j = jg * 4 + jj;
        const float v = (imp[j * 32 + qq] + imp[1024 + j * 32 + qq]) + (imp[2048 + j * 32 + qq] + imp[3072 + j * 32 + qq]);
        const bool forced = (j == 0) || (j == cur) || (j == cur - 1);
        keys[qq * 33 + j] = forced ? 1e9f : ((j <= cur) ? v : -1e9f);
      }
      vsync();
      unsigned bits = 0u;
#pragma unroll
      for (int jj = 0; jj < 4; ++jj) {
        const int j = jg * 4 + jj;
        const float kj = keys[qq * 33 + j];
        int rank = 0;
        for (int i = 0; i < 32; ++i) {
          const float ki = keys[qq * 33 + i];
          rank += (ki > kj || (ki == kj && i < j)) ? 1 : 0;
        }
        if (rank < 16 && j <= cur) bits |= 1u << j;
      }
      atomicOr(&selm[qq], bits);
      vsync();
    }
    const unsigned mysel = selm[ql];
    unsigned um = mysel;
#pragma unroll
    for (int o2 = 16; o2 > 0; o2 >>= 1) um |= (unsigned)__shfl_xor((int)um, o2);
    um = (unsigned)__builtin_amdgcn_readfirstlane((int)um);
    int wvst = 0;
    {
      const bf16_t* kb = p.ks + (size_t)bg * SEQ * 128;
      const bf16_t* vb = p.vsT + (size_t)bg * 128 * SEQ;
      oacc_zero(o);
      m = NEG_BIG; l = 0.f;
      {
        int wj = (t0 - 511) >> 6;
        if (wj < 0) wj = 0;
        wvst = nsa_branch<true, true>(um, kb, vb, q, lk, lv, (const LAS float*)(LAS char*)(lds + NSA_LUT), mysel, t0, o, m, l, 0,
                                      p.kw + (size_t)bg * SEQ * 128 + (size_t)wj * 64 * 128, p.vwT + (size_t)bg * 128 * SEQ + wj * 64);
      }
      const float gs = 1.f / (fmaxf(l, 1e-20f) * (1.f + __expf(-p.gates[(size_t)(b * SEQ + opq(tq)) * 24 + h * 3 + 1])));
      int qo = ql;
      asm volatile("" : "+v"(qo));
      bf16_t* pr2 = (bf16_t*)p.part + (size_t)(b * SEQ + t0 + qo) * 1024 + h * 128;
      uint2 pk[16];
      {
        const int hq = (VT() & 63) >> 5;
#pragma unroll
        for (int idx = 0; idx < 16; ++idx) pk[idx] = *(const uint2*)(pr2 + 32 * (idx & 3) + 8 * (idx >> 2) + 4 * hq);
      }
      oacc_foreach_i(o, [&](int idx, int d, float v0, float v1, float v2, float v3) {
        const uint2 u = pk[idx];
        uint2 w;
        w.x = pack2(__uint_as_float(u.x << 16) + v0 * gs, __uint_as_float(u.x & 0xffff0000u) + v1 * gs);
        w.y = pack2(__uint_as_float(u.y << 16) + v2 * gs, __uint_as_float(u.y & 0xffff0000u) + v3 * gs);
        *(uint2*)(pr2 + d) = w;
      });
    }
    {
      const bf16_t* kb = p.kw + (size_t)bg * SEQ * 128;
      const bf16_t* vb = p.vwT + (size_t)bg * 128 * SEQ;
      oacc_zero(o);
      m = NEG_BIG; l = 0.f;
      int jlo = (t0 - 511) >> 6;
      if (jlo < 0) jlo = 0;
      const unsigned wtiles = (cur >= 31 ? 0xffffffffu : ((2u << cur) - 1u)) & ~((1u << jlo) - 1u);
      (void)nsa_branch<false, true>(wtiles, kb, vb, q, lk, lv, (const LAS float*)(LAS char*)(lds + NSA_LUT), 0u, t0, o, m, l, wvst);
      const float gs = 1.f / (fmaxf(l, 1e-20f) * (1.f + __expf(-p.gates[(size_t)(b * SEQ + opq(tq)) * 24 + h * 3 + 2])));
      int qo = ql;
      asm volatile("" : "+v"(qo));
      const bf16_t* pr2 = (const bf16_t*)p.part + (size_t)(b * SEQ + t0 + qo) * 1024 + h * 128;
      bf16_t* orow = p.omix + (size_t)(b * SEQ + t0 + qo) * DM + h * 128;
      uint2 pk[16];
      {
        const int hq = (VT() & 63) >> 5;
#pragma unroll
        for (int idx = 0; idx < 16; ++idx) pk[idx] = *(const uint2*)(pr2 + 32 * (idx & 3) + 8 * (idx >> 2) + 4 * hq);
      }
      oacc_foreach_i(o, [&](int idx, int d, float v0, float v1, float v2, float v3) {
        const uint2 u = pk[idx];
        uint2 w;
        w.x = pack2(__uint_as_float(u.x << 16) + v0 * gs, __uint_as_float(u.x & 0xffff0000u) + v1 * gs);
        w.y = pack2(__uint_as_float(u.y << 16) + v2 * gs, __uint_as_float(u.y & 0xffff0000u) + v3 * gs);
        *(uint2*)(orow + d) = w;
      });
    }
  }
}

__device__ __forceinline__ void ph_cvt(const float* src, bf16_t* dst, size_t n) {
  typedef __attribute__((ext_vector_type(4))) float f32x4;
  const size_t nv = n / 8;
  for (size_t i = (size_t)VB() * 256 + VT(); i < nv; i += (size_t)VG() * 256) {
    const f32x4 a = ((const f32x4*)src)[2 * i], b = ((const f32x4*)src)[2 * i + 1];
    u32x4 o;
    o[0] = pack2(a[0], a[1]); o[1] = pack2(a[2], a[3]); o[2] = pack2(b[0], b[1]); o[3] = pack2(b[2], b[3]);
    ((u32x4*)dst)[i] = o;
  }
}

__device__ __forceinline__ void ph_scores(const P& p, char* lds) {
  for (int u = VB(); u < 64 * 16; u += VG()) {
    const int tm = u & 63, hp = u >> 6;
    const int m0 = tm * 128;
    float* sc = p.scores + (size_t)m0 * DM + hp * 128;
    gemm_tile_bf16<false>(p.omix + (size_t)m0 * DM + hp * 128, DM, p.subkb + (size_t)hp * 128 * 128, 128, 128, lds,
                          [&](int r, int c, float val) { sc[(size_t)r * DM + c] = val; });
  }
}

template <int PM = 0>
__device__ __forceinline__ void ph_qp_scores(const P& p, char* lds0, char* lds) {
  for (int u = (int)blockIdx.x; u < 32 * 8; u += (int)gridDim.x) {
    const int x = u & 7, i = (u >> 3) & 31;
    const int tm = (x & 3) * 8 + (i & 7), tn = (x >> 2) * 4 + (i >> 3);
    const int m0 = tm * 256, n0 = tn * 256;
    bf16_t* qp = p.omix + (size_t)m0 * DM + n0;
    const float* rss = p.rowss + T_TOK + m0;
    gemm_tile_huge_pf<PM>(p.hn + (size_t)m0 * DM, DM, p.WpqT + (size_t)n0 * DM, DM, DM, lds0,
                   [&](int r, int) { EpiOp o; o.a = f32x4_e{rss[r], 0.f, 0.f, 0.f}; o.b = o.a; return o; },
                   [&](int r, int c, f32x4_e lo, f32x4_e hi, const EpiOp& op) {
                     const float rs = rsqrtf(op.a[0] * (1.f / DM) + RMS_EPS);
                     st_bf16x8(qp + (size_t)r * DM + c, lo * rs, hi * rs); });
    __threadfence_block();
    __syncthreads();
    const int hf = (int)(threadIdx.x >> 8);
    const int hp = tn * 2 + hf;
    float* sc = p.scores + (size_t)m0 * DM + hp * 128;
    gemm_tile_big(qp + hf * 128, DM, p.subkb + (size_t)hp * 128 * 128, 128, 128, lds,
                  [&](int r, int c, f32x4_e lo, f32x4_e hi) {
                    *(f32x4_e*)(sc + (size_t)r * DM + c) = lo; *(f32x4_e*)(sc + (size_t)r * DM + c + 4) = hi; });
    __syncthreads();
  }
}

__device__ __forceinline__ void ph_cvt4(const float* src, unsigned char* dst, float* scales, int nrows, int wid0, int nw) {
  typedef __attribute__((ext_vector_type(4))) float f32x4;
  typedef __attribute__((ext_vector_type(2))) float f32x2;
  const int lane = VT() & 63;
  const float one = __uint_as_float((unsigned)opq(0x3F800000));
  float lev[8];
#pragma unroll
  for (int c = 0; c < 8; ++c) {
    const f32x2 q = __builtin_amdgcn_cvt_scalef32_pk_f32_fp4((unsigned)opq(c * 0x11111111), one, 0);
    lev[c] = fabsf(q[0]);
  }
  const float maxlev = lev[7];
  for (int row = wid0; row < nrows; row += nw) {
    const f32x4* s4 = (const f32x4*)(src + (size_t)row * DM) + lane * 8;
    f32x4 v[8];
    float amax = 0.f;
#pragma unroll
    for (int i = 0; i < 8; ++i) {
      v[i] = s4[i];
#pragma unroll
      for (int k = 0; k < 4; ++k) amax = fmaxf(amax, fabsf(v[i][k]));
    }
    amax = wave_max(amax);
    const float sc = (amax > 0.f) ? maxlev / amax : 1.f;
    u32x4 o;
#pragma unroll
    for (int w = 0; w < 4; ++w) {
      unsigned pk = 0u;
      pk = __builtin_amdgcn_cvt_scalef32_pk_fp4_f32(pk, v[2 * w][0] * sc, v[2 * w][1] * sc, 1.0f, 0);
      pk = __builtin_amdgcn_cvt_scalef32_pk_fp4_f32(pk, v[2 * w][2] * sc, v[2 * w][3] * sc, 1.0f, 1);
      pk = __builtin_amdgcn_cvt_scalef32_pk_fp4_f32(pk, v[2 * w + 1][0] * sc, v[2 * w + 1][1] * sc, 1.0f, 2);
      pk = __builtin_amdgcn_cvt_scalef32_pk_fp4_f32(pk, v[2 * w + 1][2] * sc, v[2 * w + 1][3] * sc, 1.0f, 3);
      o[w] = pk;
    }
    *(u32x4*)(dst + (size_t)row * 1024 + lane * 16) = o;
    if (lane == 0) scales[row] = (amax > 0.f) ? amax / maxlev : 1.f;
  }
}

__device__ __forceinline__ float wave_sum_dpp(float v) {
  typedef __attribute__((ext_vector_type(2))) unsigned u32x2_d;
  v += __builtin_bit_cast(float, __builtin_amdgcn_update_dpp(0, __builtin_bit_cast(int, v), 0xB1, 0xF, 0xF, true));
  v += __builtin_bit_cast(float, __builtin_amdgcn_update_dpp(0, __builtin_bit_cast(int, v), 0x4E, 0xF, 0xF, true));
  v += __builtin_bit_cast(float, __builtin_amdgcn_update_dpp(0, __builtin_bit_cast(int, v), 0x141, 0xF, 0xF, true));
  v += __builtin_bit_cast(float, __builtin_amdgcn_update_dpp(0, __builtin_bit_cast(int, v), 0x140, 0xF, 0xF, true));
  u32x2_d r = __builtin_amdgcn_permlane16_swap(__float_as_uint(v), __float_as_uint(v), false, false);
  v = __uint_as_float(r[0]) + __uint_as_float(r[1]);
  r = __builtin_amdgcn_permlane32_swap(__float_as_uint(v), __float_as_uint(v), false, false);
  return __uint_as_float(r[0]) + __uint_as_float(r[1]);
}
__device__ __forceinline__ float wave_max_dpp(float v) {
  typedef __attribute__((ext_vector_type(2))) unsigned u32x2_d;
  v = fmaxf(v, __builtin_bit_cast(float, __builtin_amdgcn_update_dpp(0, __builtin_bit_cast(int, v), 0xB1, 0xF, 0xF, true)));
  v = fmaxf(v, __builtin_bit_cast(float, __builtin_amdgcn_update_dpp(0, __builtin_bit_cast(int, v), 0x4E, 0xF, 0xF, true)));
  v = fmaxf(v, __builtin_bit_cast(float, __builtin_amdgcn_update_dpp(0, __builtin_bit_cast(int, v), 0x141, 0xF, 0xF, true)));
  v = fmaxf(v, __builtin_bit_cast(float, __builtin_amdgcn_update_dpp(0, __builtin_bit_cast(int, v), 0x140, 0xF, 0xF, true)));
  u32x2_d r = __builtin_amdgcn_permlane16_swap(__float_as_uint(v), __float_as_uint(v), false, false);
  v = fmaxf(__uint_as_float(r[0]), __uint_as_float(r[1]));
  r = __builtin_amdgcn_permlane32_swap(__float_as_uint(v), __float_as_uint(v), false, false);
  return fmaxf(__uint_as_float(r[0]), __uint_as_float(r[1]));
}
__device__ __forceinline__ float gelu_rcp(float x) {
  const float y2 = (1.5957691216057308f * LOG2E) * (x + 0.044715f * x * x * x);
  return x * __builtin_amdgcn_rcpf(1.f + __builtin_amdgcn_exp2f(-y2));
}
__device__ __forceinline__ u32x4 r4_load(const unsigned char* tab, int eid, int lane) {
  return *((const u32x4*)(tab + (size_t)eid * 1024) + lane);
}
struct XPk { f32x16 a, b; };
struct Acc32 { f32x16 a, b; };

typedef __attribute__((ext_vector_type(2))) float f32x2_t;
#define PAIR(v, i) __builtin_shufflevector(v, v, (i), (i) + 1)
#define R4_DOT_W(word, xv, base, sa, sb)                                                             \
  {                                                                                                  \
    const f32x2_t q0 = __builtin_amdgcn_cvt_scalef32_pk_f32_fp4(word, one, 0), q1 = __builtin_amdgcn_cvt_scalef32_pk_f32_fp4(word, one, 1); \
    const f32x2_t q2 = __builtin_amdgcn_cvt_scalef32_pk_f32_fp4(word, one, 2), q3 = __builtin_amdgcn_cvt_scalef32_pk_f32_fp4(word, one, 3); \
    sa = __builtin_elementwise_fma(q0, PAIR(xv, base + 0), sa); sb = __builtin_elementwise_fma(q1, PAIR(xv, base + 2), sb); \
    sa = __builtin_elementwise_fma(q2, PAIR(xv, base + 4), sa); sb = __builtin_elementwise_fma(q3, PAIR(xv, base + 6), sb); \
  }
__device__ __forceinline__ float r4_dot(const u32x4& e, const XPk& x) {
  const float one = __uint_as_float((unsigned)opq(0x3F800000));
  f32x2_t sa = {0.f, 0.f}, sb = {0.f, 0.f};
  R4_DOT_W(e[0], x.a, 0, sa, sb) R4_DOT_W(e[1], x.a, 8, sa, sb) R4_DOT_W(e[2], x.b, 0, sa, sb) R4_DOT_W(e[3], x.b, 8, sa, sb)
  sa = sa + sb;
  return sa[0] + sa[1];
}
#define R4_AXPY_P(accv, i, q)                                                                        \
  { const f32x2_t r_ = __builtin_elementwise_fma(h2, q, PAIR(accv, i)); accv[i] = r_[0]; accv[(i) + 1] = r_[1]; }
#define R4_AXPY_W(word, accv, base)                                                                  \
  {                                                                                                  \
    const f32x2_t q0 = __builtin_amdgcn_cvt_scalef32_pk_f32_fp4(word, one, 0), q1 = __builtin_amdgcn_cvt_scalef32_pk_f32_fp4(word, one, 1); \
    const f32x2_t q2 = __builtin_amdgcn_cvt_scalef32_pk_f32_fp4(word, one, 2), q3 = __builtin_amdgcn_cvt_scalef32_pk_f32_fp4(word, one, 3); \
    R4_AXPY_P(accv, base + 0, q0) R4_AXPY_P(accv, base + 2, q1) R4_AXPY_P(accv, base + 4, q2) R4_AXPY_P(accv, base + 6, q3) \
  }
__device__ __forceinline__ void r4_axpy(const u32x4& e, float hid, Acc32& acc) {
  const float one = __uint_as_float((unsigned)opq(0x3F800000));
  const f32x2_t h2 = {hid, hid};
  R4_AXPY_W(e[0], acc.a, 0) R4_AXPY_W(e[1], acc.a, 8) R4_AXPY_W(e[2], acc.b, 0) R4_AXPY_W(e[3], acc.b, 8)
}

#define INS16(K, x)                                                                                      \
  K##15 = __builtin_amdgcn_fmed3f(K##15, K##14, x); K##14 = __builtin_amdgcn_fmed3f(K##14, K##13, x);   \
  K##13 = __builtin_amdgcn_fmed3f(K##13, K##12, x); K##12 = __builtin_amdgcn_fmed3f(K##12, K##11, x);   \
  K##11 = __builtin_amdgcn_fmed3f(K##11, K##10, x); K##10 = __builtin_amdgcn_fmed3f(K##10, K##9, x);    \
  K##9 = __builtin_amdgcn_fmed3f(K##9, K##8, x); K##8 = __builtin_amdgcn_fmed3f(K##8, K##7, x);         \
  K##7 = __builtin_amdgcn_fmed3f(K##7, K##6, x); K##6 = __builtin_amdgcn_fmed3f(K##6, K##5, x);         \
  K##5 = __builtin_amdgcn_fmed3f(K##5, K##4, x); K##4 = __builtin_amdgcn_fmed3f(K##4, K##3, x);         \
  K##3 = __builtin_amdgcn_fmed3f(K##3, K##2, x); K##2 = __builtin_amdgcn_fmed3f(K##2, K##1, x);         \
  K##1 = __builtin_amdgcn_fmed3f(K##1, K##0, x); asm("v_max_f32 %0, %1, %2" : "=v"(K##0) : "v"(K##0), "v"(x));
#define DECL16(K) float K##0 = -INFINITY, K##1 = -INFINITY, K##2 = -INFINITY, K##3 = -INFINITY, K##4 = -INFINITY, \
  K##5 = -INFINITY, K##6 = -INFINITY, K##7 = -INFINITY, K##8 = -INFINITY, K##9 = -INFINITY, K##10 = -INFINITY,   \
  K##11 = -INFINITY, K##12 = -INFINITY, K##13 = -INFINITY, K##14 = -INFINITY, K##15 = -INFINITY;
__device__ __forceinline__ float mkkey(float v, unsigned tag, unsigned mask) {
  return __uint_as_float((__float_as_uint(v) & ~mask) | tag);
}

__device__ __forceinline__ void ph_peer(const P& p, float* smem) {
  typedef __attribute__((ext_vector_type(4))) float f32x4;
  float* lists = smem;
  int* bexA = (int*)(smem + 4096);
  float* bgtA = smem + 6144;
  float* bsuA = smem + 8192;
  float* hidA = smem + 10240;
  float* xqA = smem + 10752;
  for (int item = VB(); item < T_TOK / 16; item += VG()) {
    const int t0 = item * 16;
    vsync();
    {
      const int tid = VT();
      const int tl = tid >> 4, hp = tid & 15;
      const f32x4* sp = (const f32x4*)(p.scores + (size_t)(t0 + tl) * DM + hp * 128);
      DECL16(k)
      f32x4 va = sp[0], vb = sp[1], vc = sp[2], vd = sp[3];
#pragma unroll 1
      for (int c4 = 0; c4 < 32; c4 += 4) {
        const int cn = (c4 + 4 < 32) ? c4 + 4 : c4;
        const f32x4 na = sp[cn], nb = sp[cn + 1], nc = sp[cn + 2], nd = sp[cn + 3];
#define INS4(v, cc)                                                                        \
        _Pragma("unroll") for (int e = 0; e < 4; ++e) {                                    \
          const float x = mkkey(v[e], 127u - (unsigned)((cc) * 4 + e), 127u);              \
          INS16(k, x)                                                                      \
        }
        INS4(va, c4) INS4(vb, c4 + 1) INS4(vc, c4 + 2) INS4(vd, c4 + 3)
#undef INS4
        va = na; vb = nb; vc = nc; vd = nd;
      }
      f32x4* lp = (f32x4*)(lists + (size_t)VT() * 16);
      f32x4 o0 = {k0, k1, k2, k3}, o1 = {k4, k5, k6, k7}, o2 = {k8, k9, k10, k11}, o3 = {k12, k13, k14, k15};
      lp[0] = o0; lp[1] = o1; lp[2] = o2; lp[3] = o3;
    }
    vsync();
    if (VT() < 128) {
      const int tid = VT();
      const int tl = tid >> 3, h = tid & 7;
      const float* la = lists + (size_t)(tl * 16 + 2 * h) * 16;
      const float* lb = la + 16;
      float av[16], bv[16];
#pragma unroll
      for (int i = 0; i < 16; ++i) {
        av[i] = __uint_as_float(__float_as_uint(la[i]) & ~127u);
        bv[i] = __uint_as_float(__float_as_uint(lb[i]) & ~127u);
      }
      DECL16(c)
#pragma unroll
      for (int i = 0; i < 16; ++i) {
#pragma unroll
        for (int j = 0; j < 16; ++j) {
          if ((i + 1) * (j + 1) <= 16) {
            const float x = mkkey(av[i] + bv[j], 255u - (unsigned)(i * 16 + j), 255u);
            INS16(c, x)
          }
        }
      }
      float cs[16] = {c0, c1, c2, c3, c4, c5, c6, c7, c8, c9, c10, c11, c12, c13, c14, c15};
      float ev[16];
      float sum = 0.f;
      const float mx = __uint_as_float(__float_as_uint(cs[0]) & ~255u);
#pragma unroll
      for (int n = 0; n < 16; ++n) {
        ev[n] = __expf(__uint_as_float(__float_as_uint(cs[n]) & ~255u) - mx);
        sum += ev[n];
      }
      const float isum = 1.f / sum;
#pragma unroll
      for (int n = 0; n < 16; ++n) {
        const unsigned cc = 255u - (__float_as_uint(cs[n]) & 255u);
        const unsigned ka = 127u - (__float_as_uint(la[cc >> 4]) & 127u);
        const unsigned kb = 127u - (__float_as_uint(lb[cc & 15u]) & 127u);
        const int eid = (int)(ka * 128u + kb);
        bexA[tl * 128 + h * 16 + n] = eid;
        bgtA[tl * 128 + h * 16 + n] = ev[n] * isum * p.sv8[eid];
        bsuA[tl * 128 + h * 16 + n] = p.su8[eid];
      }
    }
    vsync();
#pragma unroll 1
    for (int ti4 = 0; ti4 < 4; ++ti4) {
    const int lane = VT() & 63, wv = VT() >> 6;
    const int tl = wv * 4 + ti4;
    const int t = t0 + tl;
    const int* bex = bexA + tl * 128;
    const float* bgt = bgtA + tl * 128;
    const float* bsu = bsuA + tl * 128;
    float* hidL = hidA + wv * 128;
    unsigned char* xqL = (unsigned char*)xqA + wv * 2048;
    const int q16 = lane >> 4;
    float inv_s;
    {
      const u32x4* s4 = (const u32x4*)(p.hn + (size_t)t * DM) + lane * 4;
      const f32x4* g4 = (const f32x4*)p.norm_ffn + lane * 8;
      const u32x4 q0 = s4[0], q1 = s4[1], q2 = s4[2], q3 = s4[3];
#define UNPK(q, lo) f32x4{__uint_as_float(q[lo] << 16), __uint_as_float(q[lo] & 0xffff0000u), \
                          __uint_as_float(q[lo + 1] << 16), __uint_as_float(q[lo + 1] & 0xffff0000u)}
      f32x4 a0 = UNPK(q0, 0), a1 = UNPK(q0, 2), a2 = UNPK(q1, 0), a3 = UNPK(q1, 2);
      f32x4 a4 = UNPK(q2, 0), a5 = UNPK(q2, 2), a6 = UNPK(q3, 0), a7 = UNPK(q3, 2);
      float ss = 0.f;
#define SSQ(v) ss += v[0] * v[0] + v[1] * v[1] + v[2] * v[2] + v[3] * v[3];
      SSQ(a0) SSQ(a1) SSQ(a2) SSQ(a3) SSQ(a4) SSQ(a5) SSQ(a6) SSQ(a7)
#undef SSQ
      ss = wave_sum_dpp(ss);
      const float rs = rsqrtf(ss * (1.f / DM) + RMS_EPS);
      float amax = 0.f;
#define XSC(v, gi) { v = v * rs * g4[gi]; amax = fmaxf(fmaxf(amax, fmaxf(fabsf(v[0]), fabsf(v[1]))), fmaxf(fabsf(v[2]), fabsf(v[3]))); }
      XSC(a0, 0) XSC(a1, 1) XSC(a2, 2) XSC(a3, 3) XSC(a4, 4) XSC(a5, 5) XSC(a6, 6) XSC(a7, 7)
#undef XSC
      amax = wave_max_dpp(amax);
      unsigned ex = (__float_as_uint(amax) >> 23) & 255u;
      ex = ex < 8u ? 8u : ex;
      const float sx = __uint_as_float((261u - ex) << 23);
      inv_s = __uint_as_float((ex - 7u) << 23);
#define XQ(v) __builtin_amdgcn_cvt_pk_fp8_f32(v[2] * sx, v[3] * sx, __builtin_amdgcn_cvt_pk_fp8_f32(v[0] * sx, v[1] * sx, 0, false), true)
      const u32x4 w0 = {(unsigned)XQ(a0), (unsigned)XQ(a1), (unsigned)XQ(a2), (unsigned)XQ(a3)};
      const u32x4 w1 = {(unsigned)XQ(a4), (unsigned)XQ(a5), (unsigned)XQ(a6), (unsigned)XQ(a7)};
#undef XQ
      *(u32x4*)(xqL + lane * 32) = w0;
      *(u32x4*)(xqL + lane * 32 + 16) = w1;
    }
    __builtin_amdgcn_wave_barrier();
    {
      const unsigned char* pg[8];
#pragma unroll
      for (int g = 0; g < 8; ++g) pg[g] = p.pu8 + (size_t)bex[g * 16 + (lane & 15)] * 1024 + q16 * 16;
      const u32x4* xb = (const u32x4*)(xqL + q16 * 16);
      f32x4 ag[8];
#pragma unroll
      for (int g = 0; g < 8; ++g) ag[g] = f32x4{0.f, 0.f, 0.f, 0.f};
      i32x4_t X[8], Y[8];
#pragma unroll
      for (int g = 0; g < 8; ++g) X[g] = *(const i32x4_t*)(pg[g]);
#define UMMA(S, kb)                                                                                         \
      {                                                                                                     \
        const u32x4 b0 = xb[(kb) * 8], b1 = xb[(kb) * 8 + 4];                                               \
        const i32x8_t bq = {(int)b0[0], (int)b0[1], (int)b0[2], (int)b0[3], (int)b1[0], (int)b1[1], (int)b1[2], (int)b1[3]}; \
        _Pragma("unroll") for (int g = 0; g < 8; ++g)                                                       \
          ag[g] = __builtin_amdgcn_mfma_scale_f32_16x16x128_f8f6f4(                                         \
              __builtin_shufflevector(S[g], S[g], 0, 1, 2, 3, -1, -1, -1, -1), bq, ag[g], 4, 0, 0, 0, 0, 0); \
        __builtin_amdgcn_sched_barrier(0);                                                                  \
      }
#pragma unroll 1
      for (int kb = 0; kb < 16; kb += 2) {
#pragma unroll
        for (int g = 0; g < 8; ++g) Y[g] = *(const i32x4_t*)(pg[g] + 64);
        UMMA(X, kb)
        const int adv = (kb + 2 < 16) ? 128 : 0;
#pragma unroll
        for (int g = 0; g < 8; ++g) { pg[g] += adv; X[g] = *(const i32x4_t*)(pg[g]); }
        UMMA(Y, kb + 1)
      }
#undef UMMA
#pragma unroll
      for (int g = 0; g < 8; ++g) {
        const f32x4 bs = *(const f32x4*)&bsu[g * 16 + 4 * q16], gt = *(const f32x4*)&bgt[g * 16 + 4 * q16];
        f32x4 h;
#pragma unroll
        for (int j = 0; j < 4; ++j) h[j] = gt[j] * gelu_rcp(ag[g][j] * (bs[j] * inv_s));
        if ((lane & 15) == 0) *(f32x4*)&hidL[g * 16 + 4 * q16] = h;
      }
    }
    __builtin_amdgcn_wave_barrier();
    Acc32 acc;
#pragma unroll
    for (int r = 0; r < 16; ++r) { acc.a[r] = 0.f; acc.b[r] = 0.f; }
#define SID(i) __builtin_amdgcn_readfirstlane(bex[i])
#define SFL(arr, i) __uint_as_float((unsigned)__builtin_amdgcn_readfirstlane((int)__float_as_uint(arr[i])))
#define VLD(S, e) { const int e_ = (e) < 124 ? (e) : 124; S##0 = r4_load(p.pv8, SID(e_), lane); S##1 = r4_load(p.pv8, SID(e_ + 1), lane); \
                    S##2 = r4_load(p.pv8, SID(e_ + 2), lane); S##3 = r4_load(p.pv8, SID(e_ + 3), lane); }
#define VAX(S, e) { r4_axpy(S##0, SFL(hidL, (e)), acc); r4_axpy(S##1, SFL(hidL, (e) + 1), acc); \
                    r4_axpy(S##2, SFL(hidL, (e) + 2), acc); r4_axpy(S##3, SFL(hidL, (e) + 3), acc); }
    u32x4 A0, A1, A2, A3, B0, B1, B2, B3, C0, C1, C2, C3, D0, D1, D2, D3;
    VLD(A, 0) VLD(B, 4) VLD(C, 8)
#pragma unroll 1
    for (int e0 = 0; e0 < 128; e0 += 16) {
      VLD(D, e0 + 12) VAX(A, e0)
      VLD(A, e0 + 16) VAX(B, e0 + 4)
      VLD(B, e0 + 20) VAX(C, e0 + 8)
      VLD(C, e0 + 24) VAX(D, e0 + 12)
    }
#undef VLD
#undef VAX
#undef SID
#undef SFL
    const int lane2 = opq(lane);
    f32x4* o4 = (f32x4*)(p.out + (size_t)t * DM) + lane2 * 8;
    const u32x4* hq = (const u32x4*)(p.hn + (size_t)t * DM) + lane2 * 4;
    const f32x4* g4 = (const f32x4*)p.norm_final + lane2 * 8;
    f32x4 hv[8];
    float ss = 0.f;
#pragma unroll
    for (int i = 0; i < 4; ++i) {
      const u32x4 q = hq[i];
      hv[2 * i] = UNPK(q, 0);
      hv[2 * i + 1] = UNPK(q, 2);
    }
#undef UNPK
#pragma unroll
    for (int i = 0; i < 8; ++i) {
#pragma unroll
      for (int k = 0; k < 4; ++k) {
        hv[i][k] += (i < 4) ? acc.a[4 * i + k] : acc.b[4 * (i - 4) + k];
        ss += hv[i][k] * hv[i][k];
      }
    }
    const f32x4 gf0 = g4[0], gf1 = g4[1], gf2 = g4[2], gf3 = g4[3], gf4 = g4[4], gf5 = g4[5], gf6 = g4[6], gf7 = g4[7];
    ss = wave_sum_dpp(ss);
    const float rs = rsqrtf(ss * (1.f / DM) + RMS_EPS);
#pragma unroll
    for (int i = 0; i < 8; ++i) {
      const f32x4 g = (i == 0) ? gf0 : (i == 1) ? gf1 : (i == 2) ? gf2 : (i == 3) ? gf3 : (i == 4) ? gf4 : (i == 5) ? gf5 : (i == 6) ? gf6 : gf7;
      f32x4 o;
#pragma unroll
      for (int k = 0; k < 4; ++k) o[k] = hv[i][k] * rs * g[k];
      o4[i] = o;
    }
    }
  }
}

#define XB_TMO      128
#define XB_XCNT(j)  (256  + 64 * (j))
#define XB_XSUB(j)  (1280 + 64 * (j))
#define XB_XGEN(j)  (2304 + 64 * (j))
#define XB_TOP      3328
#define XB_TOPGEN   3392
#define XCD_BAR_WORDS 3456
#define XB_SPIN_CAP (1u << 22)
__device__ __forceinline__ unsigned xb_ld(unsigned* p) { return __hip_atomic_load(p, __ATOMIC_RELAXED, __HIP_MEMORY_SCOPE_AGENT); }
__device__ __forceinline__ unsigned xb_add(unsigned* p, unsigned v) { return __hip_atomic_fetch_add(p, v, __ATOMIC_RELAXED, __HIP_MEMORY_SCOPE_AGENT); }
__device__ __forceinline__ unsigned xb_xcc_id() { return (unsigned)__builtin_amdgcn_s_getreg((3 << 11) | 20) & 0xFu; }
#define XB_SPIN(cond, bar) do { unsigned _sp = 0; while (cond) { __builtin_amdgcn_s_sleep(1); \
    if ((++_sp & 255u) == 0u) { if (xb_ld(&(bar)[XB_TMO])) break; if (_sp > XB_SPIN_CAP) { atomicAdd(&(bar)[XB_TMO], 1u); break; } } } } while (0)
struct XcdBarrier { unsigned* bar; unsigned x; volatile LAS unsigned* st; };
__device__ __forceinline__ XcdBarrier xcd_barrier_post(unsigned* bar, volatile LAS unsigned* st) {
  XcdBarrier b; b.bar = bar; b.x = xb_xcc_id(); b.st = st;
  if (threadIdx.x == 0) (void)xb_add(&bar[XB_XCNT(b.x)], 1u);
  return b;
}
__device__ __forceinline__ void xcd_barrier_complete(unsigned* bar, unsigned x, unsigned& nloc, unsigned& nx) {
  const unsigned G = gridDim.x * gridDim.y * gridDim.z;
  unsigned sum, cnt, mine, sp = 0u;
  for (;;) {
    sum = 0u; cnt = 0u; mine = 0u;
#pragma unroll
    for (unsigned j = 0; j < 16; ++j) { const unsigned c = xb_ld(&bar[XB_XCNT(j)]); sum += c; cnt += (c > 0u) ? 1u : 0u; mine = (j == x) ? c : mine; }
    if (sum == G) break;
    __builtin_amdgcn_s_sleep(1);
    if ((++sp & 255u) == 0u) { if (xb_ld(&bar[XB_TMO])) break; if (sp > XB_SPIN_CAP) { atomicAdd(&bar[XB_TMO], 1u); break; } }
  }
  nloc = mine > 0u ? mine : 1u; nx = cnt > 0u ? cnt : 1u;
}
__device__ __forceinline__ void xcd_barrier(const XcdBarrier& b) {
  asm volatile("s_waitcnt vmcnt(0)" ::: "memory");
  __syncthreads();
  if (threadIdx.x == 0) {
    unsigned* bar = b.bar;
    __builtin_amdgcn_s_waitcnt(0);
    unsigned nloc = b.st[0], nx = b.st[1];
    if (nloc == 0u) { xcd_barrier_complete(bar, b.x, nloc, nx); b.st[0] = nloc; b.st[1] = nx; }
    const unsigned old = xb_add(&bar[XB_XSUB(b.x)], 1u);
    const unsigned gen = old / nloc;
    if (old + 1u == (gen + 1u) * nloc) {
      __builtin_amdgcn_fence(__ATOMIC_RELEASE, "agent");
      asm volatile("s_waitcnt vmcnt(0)" ::: "memory");
      const unsigned og = xb_add(&bar[XB_TOP], 1u);
      const unsigned tg = og / nx;
      if (og + 1u == (tg + 1u) * nx) xb_add(&bar[XB_TOPGEN], 1u);
      else XB_SPIN(xb_ld(&bar[XB_TOPGEN]) == tg, bar);
      __builtin_amdgcn_fence(__ATOMIC_ACQUIRE, "agent");
      xb_add(&bar[XB_XGEN(b.x)], 1u);
      asm volatile("s_waitcnt vmcnt(0)" ::: "memory");
    } else {
      XB_SPIN(xb_ld(&bar[XB_XGEN(b.x)]) == gen, bar);
      __builtin_amdgcn_fence(__ATOMIC_ACQUIRE, "agent");
      asm volatile("s_waitcnt vmcnt(0)" ::: "memory");
    }
  }
  __syncthreads();
}

typedef const __attribute__((address_space(4))) P* KP;
__device__ __forceinline__ P loadP() {
#if defined(__HIP_DEVICE_COMPILE__)
  KP k = (KP)__builtin_amdgcn_kernarg_segment_ptr();
  asm volatile("" : "+s"(k));
  P p = *k;
  return p;
#else
  return P{};
#endif
}

__global__ void __launch_bounds__(512, 2) mega(P p_arg) {
  cg::grid_group grid = cg::this_grid();
  __shared__ __attribute__((aligned(16))) float smem_all[2 * 18432 + 64];
  float* smem = smem_all + (threadIdx.x >> 8) * 18432;
  char* lds = (char*)smem;
  unsigned* xbw = (unsigned*)(smem_all + 2 * 18432 + 32);
  if (threadIdx.x < 64) ((unsigned*)(smem_all + 2 * 18432))[threadIdx.x] = 0u;
  if (blockIdx.x == 0) {
    P p = loadP();
    for (int i = threadIdx.x; i < XCD_BAR_WORDS; i += 512) p.bar[i] = 0u;
    if (threadIdx.x < 16) p.ccnt[threadIdx.x] = 0u;
  }
  __syncthreads();
  { P p = loadP(); ph_rmsnorm(p.x, p.norm_mix, p.hn, T_TOK); ph_rmsnorm(p.mem, p.norm_mkv, p.memn, 1024); }
  { P p = loadP(); ph_transpose<true>(smem, p.w_in, DM, INC, 5760, p.WinT); }
  { P p = loadP(); ph_transpose<false>(smem, p.w_mk, DM, 512, 512, p.WmkT); }
  { P p = loadP(); ph_transpose<false>(smem, p.w_mv, DM, 512, 512, p.WmvT); }
  { P p = loadP(); ph_cvt(p.subk, p.subkb, (size_t)16 * 128 * 128); }
  { P p = loadP(); ph_transpose<false>(smem, p.w1_k, 4096, 128, 128, p.w1T); }
  { P p = loadP(); ph_transpose<false>(smem, p.w1_v, 4096, 128, 128, p.w1T + 128 * 4096); }
  { P p = loadP(); ph_transpose<false>(smem, p.w2_k, 128, 128, 128, p.w2T); }
  { P p = loadP(); ph_transpose<false>(smem, p.w2_v, 128, 128, 128, p.w2T + 128 * 128); }
  { P p = loadP(); ph_posb(p); }
  { P p = loadP(); for (int i = VB() * 256 + VT(); i < 2 * T_TOK; i += VG() * 256) p.rowss[i] = 0.f; }
  grid.sync();
  XcdBarrier xb;
  { P p = loadP(); xb = xcd_barrier_post(p.bar, (volatile LAS unsigned*)xbw); }
  { P p = loadP(); ph_proj(p, (char*)smem_all, lds); }
  const int kvb = (VG() == 512) ? ((VB() >= 384 && VB() < 416) ? (VB() - 384) * 8 : -1) : -2;
  const int vvb = (VG() == 512) ? ((VB() >= 416 && VB() < 448) ? (VB() - 416) * 8 : -1) : -2;
  { P p = loadP(); bf16_t* kmem = p.kmemb;
    ph_gemm_bf16(p.memn, DM, p.WmkT, DM, 1024, 512, DM, lds, [=](int m, int n, float v) {
      kmem[((size_t)((m >> 8) * 4 + (n >> 7)) * 256 + (m & 255)) * 128 + (n & 127)] = f2bf(v); }, kvb); }
  { P p = loadP(); bf16_t* vmem = p.vmemT;
    ph_gemm_bf16(p.memn, DM, p.WmvT, DM, 1024, 512, DM, lds, [=](int m, int n, float v) {
      vmem[((size_t)((m >> 8) * 4 + (n >> 7)) * 128 + (n & 127)) * 256 + perm16(m & 255)] = f2bf(v); }, vvb); }
  xcd_barrier(xb);
  {
    P p = loadP();
    if (VG() == 512) { if ((VB() & 15) == 1 || (VB() & 15) == 3) ph_compress2(p, lds, (VB() >> 4) * 2 + ((VB() & 15) >> 1), 64); }
    else ph_compress2(p, lds, VB(), VG());
  }
  { P p = loadP(); ph_sb2(p, lds); }
  {
    const bool full = (VG() == 512);
    const int r15 = VB() & 15;
    const int vb = full ? ((r15 == 1 || r15 == 3) ? -1 : (VB() >> 4) * 14 + (r15 == 0 ? 0 : r15 == 2 ? 1 : r15 - 2)) : VB(), nvb = full ? 448 : VG();
    vsync();
    { P p = loadP(); ph_transpose<false>(smem, p.w_out, DM, DM, DM, p.WoutT, vb, nvb); }
    { P p = loadP(); ph_transpose<false>(smem, p.w_mq, DM, 512, 512, p.WmqT, vb, nvb, p.norm_mq); }
  }
  xcd_barrier(xb);
  {
    const int half = (int)(threadIdx.x >> 8);
    const int nwv = VG() * 4, wid = VB() * 4 + (VT() >> 6);
    if (half == 1) {
      { P p = loadP(); ph_cvt4(p.pu, p.pu8, p.su8, 16384, wid, nwv); }
      { P p = loadP(); ph_cvt4(p.pv, p.pv8, p.sv8, 16384, wid, nwv); }
    }
    { P p = loadP(); ph_nsa2(p, lds); }
    __builtin_amdgcn_s_setprio(0);
    if (half == 0) {
      { P p = loadP(); ph_cvt4(p.pu, p.pu8, p.su8, 16384, wid, nwv); }
      { P p = loadP(); ph_cvt4(p.pv, p.pv8, p.sv8, 16384, wid, nwv); }
    }
  }
  xcd_barrier(xb);
  { P p = loadP(); const float* x = p.x; bf16_t* hn = p.hn; float* rss = p.rowss;
    ph_gemm_huge_pf(p.omix, DM, p.WoutT, DM, T_TOK, DM, DM, (char*)smem_all,
      [=](int m, int n) { EpiOp o; o.a = *(const f32x4_e*)(x + (size_t)m * DM + n); o.b = *(const f32x4_e*)(x + (size_t)m * DM + n + 4); return o; },
      [=](int m, int n, f32x4_e lo, f32x4_e hi, const EpiOp& op) {
        const f32x4_e h0 = op.a + lo, h1 = op.b + hi;
        resid_feed(h0, h1, n, hn + (size_t)m * DM, rss + m); }); }
  xcd_barrier(xb);
  {
    const bool full = (VG() >= 512);
    const int role = full ? (VB() & 1) : 0;
    const int sub = full ? (VB() >> 1) : VB(), nsub = full ? (VG() >> 1) : VG();
    if (role == 0) { P p = loadP(); ph_memq_attn(p, lds, sub, nsub); }
    if (role == 1 || !full) {
      vsync();
      { P p = loadP(); ph_transpose<false>(smem, p.w_mo, 512, DM, DM, p.WmoT, sub, nsub); }
      vsync();
      { P p = loadP(); ph_transpose<false>(smem, p.w_pq, DM, DM, DM, p.WpqT, sub, nsub, p.norm_ffn); }
    }
  }
  xcd_barrier(xb);
  { P p = loadP(); bf16_t* hn = p.hn; float* rss = p.rowss + T_TOK;
    ph_gemm_huge_pf(p.omem, 512, p.WmoT, 512, T_TOK, DM, 512, (char*)smem_all,
      [=](int m, int n) { EpiOp o; o.a = *(const f32x4_e*)(hn + (size_t)m * DM + n); o.b = o.a; return o; },
      [=](int m, int n, f32x4_e lo, f32x4_e hi, const EpiOp& op) {
      const u32x4 hb = __builtin_bit_cast(u32x4, op.a);
      const f32x4_e r0 = {__uint_as_float(hb[0] << 16), __uint_as_float(hb[0] & 0xffff0000u),
                          __uint_as_float(hb[1] << 16), __uint_as_float(hb[1] & 0xffff0000u)};
      const f32x4_e r1 = {__uint_as_float(hb[2] << 16), __uint_as_float(hb[2] & 0xffff0000u),
                          __uint_as_float(hb[3] << 16), __uint_as_float(hb[3] & 0xffff0000u)};
      const f32x4_e h0 = r0 + lo, h1 = r1 + hi;
      resid_feed(h0, h1, n, hn + (size_t)m * DM, rss + m); }); }
  xcd_barrier(xb);
  { P p = loadP(); ph_qp_scores<0>(p, (char*)smem_all, lds); }
  xcd_barrier(xb);
  { P p = loadP(); ph_peer(p, smem); }
}

extern "C" void kernel_launch(void* const* d_in, const int* in_sizes, int n_in, void* d_out, int out_size, void* d_ws,
                              size_t ws_size, hipStream_t stream) {
  P p{};
  p.x = (const float*)d_in[0]; p.mem = (const float*)d_in[1]; p.t5 = (const float*)d_in[2];
  p.norm_mix = (const float*)d_in[3]; p.w_in = (const float*)d_in[4]; p.pos_k = (const float*)d_in[5];
  p.w1_k = (const float*)d_in[6]; p.w2_k = (const float*)d_in[7]; p.pos_v = (const float*)d_in[8];
  p.w1_v = (const float*)d_in[9]; p.w2_v = (const float*)d_in[10]; p.w_out = (const float*)d_in[11];
  p.norm_mq = (const float*)d_in[12]; p.norm_mkv = (const float*)d_in[13]; p.w_mq = (const float*)d_in[14];
  p.w_mk = (const float*)d_in[15]; p.w_mv = (const float*)d_in[16]; p.w_mo = (const float*)d_in[17];
  p.norm_ffn = (const float*)d_in[18]; p.w_pq = (const float*)d_in[19]; p.subk = (const float*)d_in[20];
  p.pu = (const float*)d_in[21]; p.pv = (const float*)d_in[22]; p.norm_final = (const float*)d_in[23];
  p.out = (float*)d_out;
  char* w = (char*)d_ws;
  size_t off = 0;
  auto take = [&](size_t bytes) { char* r = w + off; off += (bytes + 255) & ~(size_t)255; return r; };
  p.bar = (unsigned*)take(XCD_BAR_WORDS * 4);
  p.scores = (float*)take((size_t)T_TOK * DM * 4);
  p.gates = (float*)take((size_t)T_TOK * 24 * 4);
  p.part = (float*)take((size_t)T_TOK * 1024 * 4);
  p.posb = (float*)take(256 * 4);
  p.rowss = (float*)take((size_t)2 * T_TOK * 4);
  p.qn = (bf16_t*)take((size_t)T_TOK * 1024 * 2);
  p.kcin = (bf16_t*)take((size_t)T_TOK * 256 * 2 + 65536);
  p.vcin = (bf16_t*)take((size_t)T_TOK * 256 * 2 + 65536);
  p.ks = (bf16_t*)take((size_t)T_TOK * 256 * 2);
  p.vsT = (bf16_t*)take((size_t)T_TOK * 256 * 2);
  p.kw = (bf16_t*)take((size_t)T_TOK * 256 * 2);
  p.vwT = (bf16_t*)take((size_t)T_TOK * 256 * 2);
  p.kcb = (bf16_t*)take((size_t)8 * 128 * 128 * 2);
  p.vcT = (bf16_t*)take((size_t)8 * 128 * 128 * 2);
  p.c1 = (bf16_t*)take((size_t)16 * 128 * 128 * 2);
  p.cacc = (float*)take((size_t)16 * 16384 * 4);
  p.cpart = (float*)take((size_t)64 * 16384 * 4);
  p.ccnt = (unsigned*)take(64);
  p.w1T = (bf16_t*)take((size_t)2 * 128 * 4096 * 2);
  p.w2T = (bf16_t*)take((size_t)2 * 128 * 128 * 2);
  p.hn = (bf16_t*)take((size_t)T_TOK * DM * 2);
  p.omix = (bf16_t*)take((size_t)T_TOK * DM * 2);
  p.memn = (bf16_t*)take((size_t)1024 * DM * 2);
  p.omem = (bf16_t*)take((size_t)T_TOK * 512 * 2);
  p.WinT = (bf16_t*)take((size_t)5760 * DM * 2);
  p.WoutT = (bf16_t*)take((size_t)DM * DM * 2);
  p.WpqT = (bf16_t*)take((size_t)DM * DM * 2);
  p.WmqT = (bf16_t*)take((size_t)512 * DM * 2);
  p.WmkT = (bf16_t*)take((size_t)512 * DM * 2);
  p.WmvT = (bf16_t*)take((size_t)512 * DM * 2);
  p.WmoT = (bf16_t*)take((size_t)DM * 512 * 2);
  p.qmemb = (bf16_t*)take((size_t)T_TOK * 512 * 2);
  p.kmemb = (bf16_t*)take((size_t)1024 * 512 * 2);
  p.vmemT = (bf16_t*)take((size_t)1024 * 512 * 2);
  p.qsb = (bf16_t*)take((size_t)T_TOK * 1024 * 2);
  p.ksb = (bf16_t*)take((size_t)T_TOK * 1024 * 2);
  p.vsbT = (bf16_t*)take((size_t)T_TOK * 1024 * 2);
  p.pu8 = (unsigned char*)take((size_t)16384 * 1024);
  p.pv8 = (unsigned char*)take((size_t)16384 * 1024);
  p.su8 = (float*)take(16384 * 4);
  p.sv8 = (float*)take(16384 * 4);
  p.subkb = (bf16_t*)take((size_t)16 * 128 * 128 * 2);
  static int grid_blocks = 0;
  if (!grid_blocks) {
    int dev = 0, cus = 0, per_cu = 0;
    (void)hipGetDevice(&dev);
    (void)hipDeviceGetAttribute(&cus, hipDeviceAttributeMultiprocessorCount, dev);
    (void)hipOccupancyMaxActiveBlocksPerMultiprocessor(&per_cu, mega, 512, 0);
    if (per_cu > 1) per_cu = 1;
    if (per_cu < 1) per_cu = 1;
    grid_blocks = cus * per_cu;
  }
  void* args[] = {&p};
  hipError_t e = hipLaunchCooperativeKernel((void*)mega, dim3(grid_blocks), dim3(512), args, 0, stream);
  if (e != hipSuccess) fprintf(stderr, "cooperative launch failed: %s (grid %d)\n", hipGetErrorString(e), grid_blocks);
}
```
